# Optimizing an MI355X kernel written in HIP

```python
import math
import jax, jax.numpy as jnp
from jax import lax
import numpy as np

D_MODEL = 1024
BATCH = 8
SEQ = 4096
DEPTH = 2

D_MIX = D_MODEL
A_HEADS = 4
A_HEAD_DIM = 64
A_WIDTH = A_HEADS * A_HEAD_DIM
CHUNK = 128
B_HEADS = 8
B_HEAD_DIM = 64
B_WIDTH = B_HEADS * B_HEAD_DIM
DILATED_PAIRS = ((128, 1), (512, 4), (2048, 16))
ROT_DIM = B_HEAD_DIM // 4
ROPE_THETA = 500000.0
C_WIDTH = D_MIX - A_WIDTH - B_WIDTH
SSM_GROUP = 16
SSM_GROUPS = C_WIDTH // SSM_GROUP
SSM_STATE = 64
DT_MIN = 0.001
DT_MAX = 0.1
PROJ_WIDTH = 2 * A_WIDTH + 3 * B_WIDTH + C_WIDTH
N_EXPERTS = 16
N_EXPERT_GROUPS = 4
EXPERTS_PER_GROUP = N_EXPERTS // N_EXPERT_GROUPS
TOP_K = 2
D_EXPERT = D_MODEL // 2
MOE_BLOCK = 128
ALPHA = (2.0 * DEPTH) ** 0.25
BETA = (8.0 * DEPTH) ** -0.25
LN_EPS = 1e-5
NEG_INF = -1e30

kernel_name = 'hybrid_gmlp_dilated_s5_moe_deepnorm'


def layer_norm(x):
    x32 = x.astype(jnp.float32)
    mu = x32.mean(-1, keepdims=True)
    var = jnp.square(x32 - mu).mean(-1, keepdims=True)
    return (x32 - mu) * lax.rsqrt(var + LN_EPS)


def partial_rope(x, positions):
    half = ROT_DIM // 2
    freqs = ROPE_THETA ** (-jnp.arange(half, dtype=jnp.float32) * 2.0 / ROT_DIM)
    ang = positions.astype(jnp.float32)[..., None] * freqs
    cos = jnp.cos(ang)[:, :, None, :]
    sin = jnp.sin(ang)[:, :, None, :]
    x1 = x[..., :half]
    x2 = x[..., half:ROT_DIM]
    return jnp.concatenate([x1 * cos - x2 * sin, x2 * cos + x1 * sin, x[..., ROT_DIM:]], axis=-1)


def chunked_spatial_gating(uv, ln_g, ln_b, w_s, b_s):
    u, v = jnp.split(jax.nn.gelu(uv), 2, axis=-1)
    v = layer_norm(v) * ln_g + ln_b
    bsz, t, _ = v.shape
    vh = v.reshape(bsz, t // CHUNK, CHUNK, A_HEADS, A_HEAD_DIM)
    causal = jnp.tril(jnp.ones((CHUNK, CHUNK), dtype=bool))
    w = jnp.where(causal[None], w_s, 0.0)
    sv = jnp.einsum('hts,bnshe->bnthe', w, vh) + b_s.T[:, :, None]
    return u * sv.reshape(bsz, t, A_WIDTH)


def dilated_branch(q, k, v, window, dilation):
    bsz, t, h, e = q.shape
    blk = window // dilation
    seg = blk * dilation
    tp = -(-t // seg) * seg
    nb = tp // seg
    pad = ((0, 0), (0, tp - t), (0, 0), (0, 0))

    def split(z):
        return jnp.pad(z, pad).reshape(bsz, nb, blk, dilation, h, e)

    def with_prev(z):
        prev = jnp.pad(z[:, :-1], ((0, 0), (1, 0), (0, 0), (0, 0), (0, 0), (0, 0)))
        return jnp.concatenate([prev, z], axis=2)

    qb = split(q)
    kb = with_prev(split(k))
    vb = with_prev(split(v))
    s = jnp.einsum('bnqrhe,bnkrhe->bnrhqk', qb, kb) * (e ** -0.5)
    qi = jnp.arange(blk)[:, None]
    kk = jnp.arange(2 * blk)[None, :]
    band = (kk >= qi) & (kk <= qi + blk)
    valid = band[None] & ((jnp.arange(nb)[:, None, None] > 0) | (kk >= blk)[None])
    s = jnp.where(valid[None, :, None, None], s, NEG_INF)
    m = s.max(-1)
    p = jnp.exp(s - m[..., None])
    den = p.sum(-1)
    o = jnp.einsum('bnrhqk,bnkrhe->bnqrhe', p, vb) / jnp.moveaxis(den, -1, 2)[..., None]
    o = o.reshape(bsz, tp, h, e)[:, :t]
    m = jnp.moveaxis(m, -1, 2).reshape(bsz, tp, h)[:, :t]
    den = jnp.moveaxis(den, -1, 2).reshape(bsz, tp, h)[:, :t]
    return o, m, den


def dilated_attention(q, k, v):
    outs = [dilated_branch(q, k, v, w, d) for (w, d) in DILATED_PAIRS]
    o_all = jnp.stack([o for o, _, _ in outs])
    m_all = jnp.stack([m for _, m, _ in outs])
    d_all = jnp.stack([dn for _, _, dn in outs])
    wts = d_all * jnp.exp(m_all - m_all.max(0))
    return jnp.einsum('gbth,gbthe->bthe', wts, o_all) / wts.sum(0)[..., None]


def s5_mixer(u, lam_re, lam_im, log_dt, b_re, b_im, c_re, c_im, d_skip, glu_w, glu_b):
    f32 = jnp.float32
    u = u.astype(f32)
    bsz, t, _ = u.shape
    ug = u.reshape(bsz, t, SSM_GROUPS, SSM_GROUP)
    lam_re = lam_re.astype(f32)
    lam_im = lam_im.astype(f32)
    dt = jnp.exp(log_dt.astype(f32))[:, None]
    mag = jnp.exp(lam_re * dt)
    ab_re = mag * jnp.cos(lam_im * dt)
    ab_im = mag * jnp.sin(lam_im * dt)
    nr = ab_re - 1.0
    ni = ab_im
    mod2 = lam_re * lam_re + lam_im * lam_im
    f_re = (nr * lam_re + ni * lam_im) / mod2
    f_im = (ni * lam_re - nr * lam_im) / mod2
    b_re = b_re.astype(f32)
    b_im = b_im.astype(f32)
    bb_re = f_re[..., None] * b_re - f_im[..., None] * b_im
    bb_im = f_re[..., None] * b_im + f_im[..., None] * b_re
    bu_re = jnp.einsum('btgc,gnc->btgn', ug, bb_re)
    bu_im = jnp.einsum('btgc,gnc->btgn', ug, bb_im)
    a_re = jnp.broadcast_to(ab_re, bu_re.shape)
    a_im = jnp.broadcast_to(ab_im, bu_im.shape)

    def combine(e1, e2):
        a1r, a1i, b1r, b1i = e1
        a2r, a2i, b2r, b2i = e2
        return (a2r * a1r - a2i * a1i,
                a2r * a1i + a2i * a1r,
                a2r * b1r - a2i * b1i + b2r,
                a2r * b1i + a2i * b1r + b2i)

    _, _, x_re, x_im = lax.associative_scan(combine, (a_re, a_im, bu_re, bu_im), axis=1)
    y = (jnp.einsum('btgn,gcn->btgc', x_re, c_re.astype(f32))
         - jnp.einsum('btgn,gcn->btgc', x_im, c_im.astype(f32))
         + d_skip.astype(f32) * ug)
    y = jax.nn.gelu(y.reshape(bsz, t, C_WIDTH))
    return y * jax.nn.sigmoid(y @ glu_w + glu_b)


def grouped_moe(h, router_w, router_bias, w_gate, w_up, w_down):
    bsz, t, d = h.shape
    n_tok = bsz * t
    ht = h.reshape(n_tok, d)
    scores = jax.nn.sigmoid(ht.astype(jnp.float32) @ router_w.astype(jnp.float32))
    sel = scores + router_bias.astype(jnp.float32)
    sel_g = sel.reshape(n_tok, N_EXPERT_GROUPS, EXPERTS_PER_GROUP)
    group_score = lax.top_k(sel_g, 2)[0].sum(-1)
    g_idx = jnp.argmax(group_score, axis=-1)
    sel_in = jnp.take_along_axis(sel_g, g_idx[:, None, None], axis=1)[:, 0]
    _, loc = lax.top_k(sel_in, TOP_K)
    e_idx = g_idx[:, None] * EXPERTS_PER_GROUP + loc
    gate = jnp.take_along_axis(scores, e_idx, axis=1)
    gate = gate / gate.sum(-1, keepdims=True)

    n_asg = n_tok * TOP_K
    flat_e = e_idx.reshape(n_asg)
    flat_tok = jnp.repeat(jnp.arange(n_tok, dtype=jnp.int32), TOP_K)
    flat_w = gate.reshape(n_asg)
    order = jnp.argsort(flat_e)
    se = flat_e[order]
    counts = jnp.bincount(flat_e, length=N_EXPERTS)
    starts = jnp.cumsum(counts) - counts
    pcounts = (counts + MOE_BLOCK - 1) // MOE_BLOCK * MOE_BLOCK
    pends = jnp.cumsum(pcounts)
    pstarts = pends - pcounts
    dest = pstarts[se] + (jnp.arange(n_asg) - starts[se])
    cap = n_asg + N_EXPERTS * MOE_BLOCK
    n_blk = cap // MOE_BLOCK
    slot_tok = jnp.zeros((cap,), jnp.int32).at[dest].set(flat_tok[order])
    slot_w = jnp.zeros((cap,), jnp.float32).at[dest].set(flat_w[order])
    blk_e = jnp.minimum(jnp.searchsorted(pends, jnp.arange(n_blk) * MOE_BLOCK, side='right'),
                        N_EXPERTS - 1)

    def run_block(args):
        tok, w, e = args
        rows = ht[tok]
        hid = jax.nn.silu(rows @ w_gate[e]) * (rows @ w_up[e])
        return ((hid @ w_down[e]) * w[:, None]).astype(jnp.float32)

    out = lax.map(run_block, (slot_tok.reshape(n_blk, MOE_BLOCK),
                              slot_w.reshape(n_blk, MOE_BLOCK), blk_e))
    y = jnp.zeros((n_tok, d), jnp.float32).at[slot_tok].add(out.reshape(cap, d))
    return y.reshape(bsz, t, d)


def setup_inputs(seed: int = 0) -> dict:
    key = jax.random.key(seed)
    ks = jax.random.split(key, 32)

    def nrm(k, shape, scale):
        return jax.random.normal(k, shape, jnp.float32) * scale

    n = jnp.arange(SSM_STATE, dtype=jnp.float32)
    return {
        'x': nrm(ks[0], (BATCH, SEQ, D_MODEL), 1.0),
        'c': nrm(ks[1], (BATCH, D_MODEL), 1.0),
        'positions': jnp.broadcast_to(jnp.arange(SEQ, dtype=jnp.int32)[None], (BATCH, SEQ)),
        'ada_w': nrm(ks[2], (DEPTH, D_MODEL, 6 * D_MODEL), 0.1 * D_MODEL ** -0.5),
        'ada_b': nrm(ks[3], (DEPTH, 6 * D_MODEL), 0.01),
        'w_in': nrm(ks[4], (DEPTH, D_MODEL, PROJ_WIDTH), D_MODEL ** -0.5),
        'gm_ln_g': 1.0 + nrm(ks[5], (DEPTH, A_WIDTH), 0.01),
        'gm_ln_b': nrm(ks[6], (DEPTH, A_WIDTH), 0.01),
        'gm_ws': nrm(ks[7], (DEPTH, A_HEADS, CHUNK, CHUNK), 0.5 * CHUNK ** -0.5),
        'gm_bs': 1.0 + nrm(ks[8], (DEPTH, A_HEADS, CHUNK), 0.01),
        'ssm_lam_re': -0.5 + nrm(ks[9], (DEPTH, SSM_GROUPS, SSM_STATE), 0.01),
        'ssm_lam_im': math.pi * n + nrm(ks[10], (DEPTH, SSM_GROUPS, SSM_STATE), 0.01),
        'ssm_log_dt': jax.random.uniform(ks[11], (DEPTH, SSM_GROUPS), jnp.float32,
                                         math.log(DT_MIN), math.log(DT_MAX)),
        'ssm_b_re': nrm(ks[12], (DEPTH, SSM_GROUPS, SSM_STATE, SSM_GROUP), (2 * SSM_GROUP) ** -0.5),
        'ssm_b_im': nrm(ks[13], (DEPTH, SSM_GROUPS, SSM_STATE, SSM_GROUP), (2 * SSM_GROUP) ** -0.5),
        'ssm_c_re': nrm(ks[14], (DEPTH, SSM_GROUPS, SSM_GROUP, SSM_STATE), SSM_STATE ** -0.5),
        'ssm_c_im': nrm(ks[15], (DEPTH, SSM_GROUPS, SSM_GROUP, SSM_STATE), SSM_STATE ** -0.5),
        'ssm_d': nrm(ks[16], (DEPTH, SSM_GROUPS, SSM_GROUP), 1.0),
        'glu_w': nrm(ks[17], (DEPTH, C_WIDTH, C_WIDTH), C_WIDTH ** -0.5),
        'glu_b': nrm(ks[18], (DEPTH, C_WIDTH), 0.01),
        'w_out': nrm(ks[19], (DEPTH, D_MIX, D_MODEL), BETA * D_MIX ** -0.5),
        'ln1_g': 1.0 + nrm(ks[20], (DEPTH, D_MODEL), 0.01),
        'ln1_b': nrm(ks[21], (DEPTH, D_MODEL), 0.01),
        'router_w': nrm(ks[22], (D_MODEL, N_EXPERTS), D_MODEL ** -0.5),
        'router_bias': nrm(ks[23], (N_EXPERTS,), 0.01),
        'exp_w_gate': nrm(ks[24], (DEPTH, N_EXPERTS, D_MODEL, D_EXPERT), D_MODEL ** -0.5),
        'exp_w_up': nrm(ks[25], (DEPTH, N_EXPERTS, D_MODEL, D_EXPERT), D_MODEL ** -0.5),
        'exp_w_down': nrm(ks[26], (DEPTH, N_EXPERTS, D_EXPERT, D_MODEL), BETA * D_EXPERT ** -0.5),
        'ln2_g': 1.0 + nrm(ks[27], (DEPTH, D_MODEL), 0.01),
        'ln2_b': nrm(ks[28], (DEPTH, D_MODEL), 0.01),
    }


def reference(x, c, positions, ada_w, ada_b, w_in, gm_ln_g, gm_ln_b, gm_ws, gm_bs,
              ssm_lam_re, ssm_lam_im, ssm_log_dt, ssm_b_re, ssm_b_im, ssm_c_re, ssm_c_im,
              ssm_d, glu_w, glu_b, w_out, ln1_g, ln1_b, router_w, router_bias,
              exp_w_gate, exp_w_up, exp_w_down, ln2_g, ln2_b):
    bsz, t, _ = x.shape
    cond = jax.nn.silu(c.astype(jnp.float32))
    for l in range(DEPTH):
        mod = cond @ ada_w[l] + ada_b[l]
        sh1, sc1, g1, sh2, sc2, g2 = [m[:, None, :] for m in jnp.split(mod, 6, axis=-1)]

        h = layer_norm(x) * (1.0 + sc1) + sh1
        proj = h @ w_in[l]
        a_uv, qkv, s_in = jnp.split(proj, [2 * A_WIDTH, 2 * A_WIDTH + 3 * B_WIDTH], axis=-1)
        a_out = chunked_spatial_gating(a_uv, gm_ln_g[l], gm_ln_b[l], gm_ws[l], gm_bs[l])
        qkv = qkv.reshape(bsz, t, 3, B_HEADS, B_HEAD_DIM)
        q = partial_rope(qkv[:, :, 0], positions)
        k = partial_rope(qkv[:, :, 1], positions)
        b_out = dilated_attention(q, k, qkv[:, :, 2]).reshape(bsz, t, B_WIDTH)
        c_out = s5_mixer(s_in, ssm_lam_re[l], ssm_lam_im[l], ssm_log_dt[l], ssm_b_re[l],
                         ssm_b_im[l], ssm_c_re[l], ssm_c_im[l], ssm_d[l], glu_w[l], glu_b[l])
        mix = jnp.concatenate([a_out, b_out, c_out], axis=-1) @ w_out[l]
        x = layer_norm(ALPHA * x + (1.0 + g1) * mix) * ln1_g[l] + ln1_b[l]

        h2 = layer_norm(x) * (1.0 + sc2) + sh2
        ffn = grouped_moe(h2, router_w, router_bias, exp_w_gate[l], exp_w_up[l], exp_w_down[l])
        x = layer_norm(ALPHA * x + (1.0 + g2) * ffn) * ln2_g[l] + ln2_b[l]
    return x
```

```cpp
#include <hip/hip_runtime.h>
#include <cstdio>
#include <cstdint>
namespace pg8 {
#define PG8_LAS __attribute__((address_space(3)))
typedef unsigned short bf16_t;
typedef short bf16x8 __attribute__((ext_vector_type(8)));
typedef float f32x4 __attribute__((ext_vector_type(4)));
typedef unsigned u32x4 __attribute__((ext_vector_type(4)));
constexpr int BM = 256, BK = 64, HALF = 128, HTB = HALF * BK * 2  , STAGE_BYTES = 8 * HTB, NXCD = 8, WGM = 8;

__host__ __device__ __forceinline__ int lds_byte(int r, int c) { const int st = (r >> 4) * 2 + (c >> 5), rr = r & 15, cc = c & 31, ob = rr * 64 + cc * 2; return st * 1024 + (ob ^ (((ob >> 9) & 1) << 5)); }
__host__ __device__ __forceinline__ void stage_rc(int b, int& R, int& C) { const int st = b / 1024, sb = b % 1024, swz = sb ^ (((sb >> 9) & 1) << 5); R = (st >> 1) * 16 + swz / 64; C = (st & 1) * 32 + (swz % 64) / 2; }
__host__ __device__ __forceinline__ int perm32(int rho) { const int n = rho >> 4, i = rho & 15; return 8 * (i >> 2) + 4 * n + (i & 3); }

struct Unit { int pm, pn; };
struct Gemm { const bf16_t* A; const bf16_t* Bt; int M, N, K; };

struct StaticOrder {
    int nM, nN, nwg, G, c;
    __host__ __device__ void init(int M, int N, int G_, int c_) { nM = M / BM; nN = N / BM; nwg = nM * nN; G = G_; c = c_; }
    __host__ __device__ bool next(int i, Unit& u) const {
        const long L = (long)i * G + c; if (L >= nwg) return false;
        int wgid = (int)L; { const int q = nwg / NXCD, r = nwg % NXCD, xcd = wgid % NXCD, off = wgid / NXCD; wgid = (xcd < r ? xcd * (q + 1) : r * (q + 1) + (xcd - r) * q) + off; }
        const int nig = WGM * nN, gid = wgid / nig, fm = gid * WGM, gsz = (nM - fm) < WGM ? (nM - fm) : WGM;
        u.pm = fm + ((wgid % nig) % gsz); u.pn = (wgid % nig) / gsz; return true;
    }
    __device__ __forceinline__ void a_ready(const Unit&) const {}
    __device__ __forceinline__ void done(const Unit&) const {}
};

__device__ __forceinline__ unsigned cvt_pk_bf16(float lo, float hi) { unsigned r; asm volatile("v_cvt_pk_bf16_f32 %0, %1, %2" : "=v"(r) : "v"(lo), "v"(hi)); return r; }
template <class Epi, class Sched, bool ALIGN_EPI = false, bool SP2 = false>
__device__ __forceinline__ void gemm_phase(PG8_LAS unsigned char* lds, const Gemm g, const Sched& S, const Epi& E) {
    const int tid = threadIdx.x, wid = __builtin_amdgcn_readfirstlane(tid >> 6), lane = tid & 63, wr = wid >> 2, wc = wid & 3, fr = lane & 15, fq = lane >> 4;
    const int K = g.K, nt = K / BK;
    unsigned voffA[2], voffB[2];
#pragma unroll
    for (int i = 0; i < 2; ++i) { int R, C; stage_rc(tid * 16 + i * 8192, R, C); const int Rb = Epi::PERM ? ((R & ~31) + perm32(R & 31)) : R;
        voffA[i] = (unsigned)(R * K + C) * 2u; voffB[i] = (unsigned)(Rb * K + C) * 2u; }
    const size_t kstep = (size_t)(BK * 2);
    const size_t hstep = (size_t)HALF * K * 2;
    const size_t tstep = 2 * hstep;
    const unsigned ldsw = (unsigned)wid * 1024u;
    const int aoff = lds_byte(wr * 64 + fr, fq * 8), boff = lds_byte(wc * 32 + fr, fq * 8);
#define PG8_SA(b, h) (((b) * 2 + (h)) * HTB)
#define PG8_SB(b, h) ((4 + (b) * 2 + (h)) * HTB)
#define PG8_STAGE(bufoff, gbase, voff) do { _Pragma("unroll") for (int _i = 0; _i < 2; ++_i) \
        __builtin_amdgcn_global_load_lds((const unsigned*)((const char*)(gbase) + (voff)[_i]), (PG8_LAS unsigned*)(lds + (bufoff) + ldsw + _i * 8192), 16, 0, 0); } while (0)
#define PG8_LDA(dst, b, h) do { _Pragma("unroll") for (int m = 0; m < 4; ++m) _Pragma("unroll") for (int k = 0; k < 2; ++k) dst[m][k] = *(const PG8_LAS bf16x8*)(lds + PG8_SA(b, h) + aoff + m * 2048 + k * 1024); } while (0)
#define PG8_LDB(dst, b, h) do { _Pragma("unroll") for (int n = 0; n < 2; ++n) _Pragma("unroll") for (int k = 0; k < 2; ++k) dst[n][k] = *(const PG8_LAS bf16x8*)(lds + PG8_SB(b, h) + boff + n * 2048 + k * 1024); } while (0)
#define PG8_MMA(ai, bj, At, Bt) do { __builtin_amdgcn_s_setprio(1); _Pragma("unroll") for (int m = 0; m < 4; ++m) _Pragma("unroll") for (int n = 0; n < 2; ++n) _Pragma("unroll") for (int k = 0; k < 2; ++k) \
        acc[ai][bj][m][n] = __builtin_amdgcn_mfma_f32_16x16x32_bf16(Bt[n][k], At[m][k], acc[ai][bj][m][n], 0, 0, 0); __builtin_amdgcn_s_setprio(0); } while (0)
#define PG8_WAIT_V(n) asm volatile("s_waitcnt vmcnt(" #n ")" ::: "memory")
#define PG8_WAIT_L(n) asm volatile("s_waitcnt lgkmcnt(" #n ")" ::: "memory")
#define PG8_BAR __builtin_amdgcn_s_barrier()
#define PG8_SCHED __builtin_amdgcn_sched_barrier(0)
    Unit cur, nxt; int ui = 0;
    if (!S.next(0, cur)) return;
    f32x4 acc[2][2][4][2];
#pragma unroll
    for (int a = 0; a < 2; ++a)
#pragma unroll
        for (int b = 0; b < 2; ++b)
#pragma unroll
            for (int m = 0; m < 4; ++m)
#pragma unroll
                for (int n = 0; n < 2; ++n) acc[a][b][m][n] = (f32x4){0.f, 0.f, 0.f, 0.f};
    bf16x8 At[4][2], B0[2][2], B1[2][2];
    const char* cA = (const char*)g.A + (size_t)cur.pm * tstep; const char* cB = (const char*)g.Bt + (size_t)cur.pn * tstep;
    S.a_ready(cur);
    if constexpr (SP2) {
        PG8_STAGE(PG8_SB(0, 0), cB, voffB); PG8_STAGE(PG8_SB(0, 1), cB + hstep, voffB); PG8_STAGE(PG8_SA(0, 0), cA, voffA); PG8_STAGE(PG8_SA(0, 1), cA + hstep, voffA);
        if (wr == 1) PG8_BAR;
        PG8_WAIT_V(2); PG8_BAR;
        PG8_STAGE(PG8_SB(1, 0), cB + kstep, voffB); PG8_STAGE(PG8_SA(1, 0), cA + kstep, voffA); PG8_STAGE(PG8_SB(1, 1), cB + hstep + kstep, voffB);
        PG8_WAIT_V(6); PG8_BAR;
    } else {
        PG8_STAGE(PG8_SB(0, 0), cB, voffB); PG8_STAGE(PG8_SA(0, 0), cA, voffA); PG8_STAGE(PG8_SB(0, 1), cB + hstep, voffB); PG8_STAGE(PG8_SA(0, 1), cA + hstep, voffA);
        if (wr == 1) PG8_BAR;
        PG8_WAIT_V(4); PG8_BAR;
        PG8_STAGE(PG8_SB(1, 0), cB + kstep, voffB); PG8_STAGE(PG8_SA(1, 0), cA + kstep, voffA); PG8_STAGE(PG8_SB(1, 1), cB + hstep + kstep, voffB);
        PG8_WAIT_V(6); PG8_BAR;
    }
    for (;;) {
        const bool has_next = S.next(ui + 1, nxt);
        const char* nA = has_next ? (const char*)g.A + (size_t)nxt.pm * tstep : cA; const char* nB = has_next ? (const char*)g.Bt + (size_t)nxt.pn * tstep : cB;
        for (int t = 0; t < nt; t += 2) {
            const bool last = (t == nt - 2);
            const char* a1 = cA + (size_t)(t + 1) * kstep;
            const char* a2 = last ? nA : cA + (size_t)(t + 2) * kstep; const char* b2 = last ? nB : cB + (size_t)(t + 2) * kstep;
            const char* a3 = a2 + kstep; const char* b3 = b2 + kstep;
            if (last && has_next) S.a_ready(nxt);
            if constexpr (SP2) {
            PG8_LDB(B0, 0, 0); PG8_LDB(B1, 0, 1); PG8_SCHED; PG8_LDA(At, 0, 0); PG8_STAGE(PG8_SA(1, 1), a1 + hstep, voffA);
            PG8_WAIT_V(8); PG8_WAIT_L(0); PG8_BAR; PG8_MMA(0, 0, At, B0); PG8_MMA(0, 1, At, B1); PG8_BAR; PG8_SCHED;
            PG8_LDA(At, 0, 1); PG8_STAGE(PG8_SB(0, 0), b2, voffB); PG8_STAGE(PG8_SB(0, 1), b2 + hstep, voffB); PG8_STAGE(PG8_SA(0, 0), a2, voffA);
            PG8_WAIT_V(8); PG8_WAIT_L(0); PG8_BAR; PG8_MMA(1, 0, At, B0); PG8_MMA(1, 1, At, B1); PG8_BAR; PG8_SCHED;
            PG8_LDB(B0, 1, 0); PG8_LDB(B1, 1, 1); PG8_SCHED; PG8_LDA(At, 1, 0); PG8_STAGE(PG8_SA(0, 1), a2 + hstep, voffA);
            PG8_WAIT_V(8); PG8_WAIT_L(0); PG8_BAR; PG8_MMA(0, 0, At, B0); PG8_MMA(0, 1, At, B1); PG8_BAR; PG8_SCHED;
            PG8_LDA(At, 1, 1); PG8_STAGE(PG8_SB(1, 0), b3, voffB); PG8_STAGE(PG8_SB(1, 1), b3 + hstep, voffB); PG8_STAGE(PG8_SA(1, 0), a3, voffA);
            PG8_WAIT_V(8); PG8_WAIT_L(0); PG8_BAR; PG8_MMA(1, 0, At, B0); PG8_MMA(1, 1, At, B1); PG8_BAR; PG8_SCHED;
            } else {
            PG8_LDB(B0, 0, 0); PG8_SCHED; PG8_LDA(At, 0, 0); PG8_STAGE(PG8_SA(1, 1), a1 + hstep, voffA);
            PG8_WAIT_L(8); PG8_BAR; PG8_WAIT_L(0); PG8_MMA(0, 0, At, B0); PG8_BAR; PG8_SCHED;
            PG8_LDB(B1, 0, 1); PG8_STAGE(PG8_SB(0, 0), b2, voffB);
            PG8_BAR; PG8_WAIT_L(0); PG8_MMA(0, 1, At, B1); PG8_BAR;
            PG8_LDA(At, 0, 1); PG8_STAGE(PG8_SA(0, 0), a2, voffA);
            PG8_BAR; PG8_WAIT_L(0); PG8_MMA(1, 0, At, B0); PG8_BAR; PG8_SCHED;
            PG8_STAGE(PG8_SB(0, 1), b2 + hstep, voffB);
            PG8_WAIT_V(6); PG8_BAR; PG8_MMA(1, 1, At, B1); PG8_BAR;
            PG8_LDB(B0, 1, 0); PG8_SCHED; PG8_LDA(At, 1, 0); PG8_STAGE(PG8_SA(0, 1), a2 + hstep, voffA);
            PG8_WAIT_L(8); PG8_BAR; PG8_WAIT_L(0); PG8_MMA(0, 0, At, B0); PG8_BAR; PG8_SCHED;
            PG8_LDB(B1, 1, 1); PG8_STAGE(PG8_SB(1, 0), b3, voffB);
            PG8_BAR; PG8_WAIT_L(0); PG8_MMA(0, 1, At, B1); PG8_BAR;
            PG8_LDA(At, 1, 1); PG8_STAGE(PG8_SA(1, 0), a3, voffA);
            PG8_BAR; PG8_WAIT_L(0); PG8_MMA(1, 0, At, B0); PG8_BAR; PG8_SCHED;
            PG8_STAGE(PG8_SB(1, 1), b3 + hstep, voffB);
            PG8_WAIT_V(6); PG8_BAR; PG8_MMA(1, 1, At, B1); PG8_BAR;
            }
        }
        if constexpr (ALIGN_EPI) { if (wr == 0) PG8_BAR; }
        if constexpr (!Epi::AFTER_DRAIN) { E(acc, cur, wr, wc, fr, fq); S.done(cur); }
        if (!has_next) break;
#pragma unroll
        for (int a = 0; a < 2; ++a)
#pragma unroll
            for (int b = 0; b < 2; ++b)
#pragma unroll
                for (int m = 0; m < 4; ++m)
#pragma unroll
                    for (int n = 0; n < 2; ++n) acc[a][b][m][n] = (f32x4){0.f, 0.f, 0.f, 0.f};
        cur = nxt; cA = nA; cB = nB; ++ui;
        if constexpr (ALIGN_EPI) { if (wr == 1) PG8_BAR; }
    }
    PG8_WAIT_V(0);
    if constexpr (!ALIGN_EPI) { if (wr == 0) PG8_BAR; }
    PG8_BAR;
    if constexpr (Epi::AFTER_DRAIN) { E.fused(acc, cur, wr, wc, fr, fq, lds, wid, lane); S.done(cur); }
#undef PG8_SA
#undef PG8_SB
#undef PG8_STAGE
#undef PG8_LDA
#undef PG8_LDB
#undef PG8_MMA
#undef PG8_WAIT_V
#undef PG8_WAIT_L
#undef PG8_BAR
#undef PG8_SCHED
}
}

#ifndef PG8_SP2
#define PG8_SP2 true
#endif
#ifndef PG8_ALIGN
#define PG8_ALIGN true
#endif
#ifndef MK_ONE_LAUNCH
#define MK_ONE_LAUNCH 0
#endif

constexpr int NWAVES = 8, NTHR = 512;
constexpr int BATCH = 8, T = 4096, D = 1024, M = BATCH * T, DEPTH = 2;
constexpr int PROJW = 2304, AW = 256, BW = 512, CW = 256, NH = 8, HD = 64;
constexpr int COL_U = 0, COL_V = 256, COL_Q = 512, COL_K = 1024, COL_VA = 1536, COL_S = 2048;
constexpr int NEXP = 16, DEXP = 512, NGRP = 4;
constexpr int SSM_G = 16, SSM_N = 64, SSM_C = 16;
constexpr float LN_EPS = 1e-5f;
constexpr float ALPHA = 1.41421356237309515f;
constexpr float QSCALE = 0.125f * 1.4426950408889634f;
constexpr int NSLOT_MAX = 2 * M + NEXP * 256;

constexpr size_t MiB = 1u << 20;
constexpr size_t WS_CTL = 0, CTL_ZERO_BYTES = 1 * MiB;
constexpr size_t WS_MOD = 1 * MiB;
constexpr size_t WS_ROPE = WS_MOD + 512 * 1024;
constexpr size_t WS_SSM = WS_ROPE + 2 * MiB;
constexpr int SSM_TAB = 2 * 1024 + 2 * 16384;
constexpr size_t WS_TOKE = 4 * MiB;
constexpr size_t WS_TOKG = WS_TOKE + 256 * 1024;
constexpr size_t WS_SLOT_TOK = WS_TOKG + 256 * 1024;
constexpr size_t WS_SLOT_DEST = WS_SLOT_TOK + 512 * 1024;
constexpr size_t WS_SLOT_W = WS_SLOT_DEST + 512 * 1024;
constexpr size_t WS_WSMALL = 6 * MiB;
constexpr size_t WSMALL_LAYER = 7 * MiB, WOFF_IN = 0, WOFF_OUT = (size_t)PROJW * D * 2, WOFF_GLU = WOFF_OUT + (size_t)D * D * 2;
constexpr size_t WS_WGU = 20 * MiB;
constexpr size_t WS_WD = 52 * MiB;
constexpr size_t WS_XN = 68 * MiB;
constexpr size_t WS_YG = 132 * MiB;
constexpr size_t WS_R = 148 * MiB;
constexpr size_t WS_PROJ = WS_R, WS_MIXCAT = WS_R + 144 * MiB, WS_PRE = WS_R, WS_HID = WS_R + 64 * MiB, WS_X1 = WS_R + 132 * MiB;
constexpr size_t WS_ROWS2 = 356 * MiB;
constexpr size_t WS_END = 356 * MiB + (size_t)NSLOT_MAX * D * 2;
static_assert(WOFF_GLU + 256 * 256 * 2 <= WSMALL_LAYER && WS_WSMALL + 2 * WSMALL_LAYER <= WS_WGU, "ws map");
static_assert(WS_SSM + 2 * SSM_TAB * 4 <= WS_TOKE && WS_HID + (size_t)NSLOT_MAX * DEXP * 2 <= WS_X1 && WS_X1 + (size_t)M * D * 2 <= WS_ROWS2, "ws map 2");
constexpr int CW_TMO = 0;
constexpr int CW_BAR = 4096;
constexpr int CW_CNT = 8192;

constexpr int RING_OFF = 0, RING_BYTES = 131072;
constexpr int LDSCTL_OFF = RING_BYTES, MISC_OFF = LDSCTL_OFF + 320;
constexpr int LDS_BYTES = 147456;

#define GAS __attribute__((address_space(1)))
#define LAS __attribute__((address_space(3)))
#define DI __device__ __forceinline__
typedef unsigned short bf16;
typedef unsigned v4u __attribute__((ext_vector_type(4)));
typedef unsigned v2u __attribute__((ext_vector_type(2)));
typedef float f32x4 __attribute__((ext_vector_type(4)));
typedef short bf16x8 __attribute__((ext_vector_type(8)));
typedef GAS unsigned gu32;
#define RLX_AGENT __ATOMIC_RELAXED, __HIP_MEMORY_SCOPE_AGENT
#define LDS_WAIT() asm volatile("s_waitcnt lgkmcnt(0)" ::: "memory")
#define VM_WAIT() asm volatile("s_waitcnt vmcnt(0)" ::: "memory")
DI unsigned f2bf(float f) { unsigned u = __builtin_bit_cast(unsigned, f); return (u + 0x7fffu + ((u >> 16) & 1u)) >> 16; }
DI unsigned pk2(float lo, float hi) { return f2bf(lo) | (f2bf(hi) << 16); }
DI float bflo(unsigned w) { return __uint_as_float(w << 16); }
DI float bfhi(unsigned w) { return __uint_as_float(w & 0xffff0000u); }
DI float bf2f(bf16 h) { return __uint_as_float((unsigned)h << 16); }
DI float wave_sum(float v) {
#pragma unroll
    for (int o = 1; o < 64; o <<= 1) v += __shfl_xor(v, o);
    return v;
}
DI float fast_rcp(float x) { return __builtin_amdgcn_rcpf(x); }
DI float sigmoid_f(float x) { return fast_rcp(1.0f + __builtin_amdgcn_exp2f(-1.4426950408889634f * x)); }
DI float silu_f(float x) { return x * sigmoid_f(x); }
DI float gelu_tanh_f(float x) { const float z2 = 1.5957691216057308f * (x + 0.044715f * x * x * x); return x * sigmoid_f(z2); }

#define XB_TMO      128
#define XB_XCNT(j)  (256  + 64 * (j))
#define XB_XSUB(j)  (1280 + 64 * (j))
#define XB_XGEN(j)  (2304 + 64 * (j))
#define XB_TOP      3328
#define XB_TOPGEN   3392
#define XCD_BAR_WORDS 3456
#define XB_SPIN_CAP (1u << 22)
DI unsigned xb_ld(unsigned* p)              { return __hip_atomic_load(p, __ATOMIC_RELAXED, __HIP_MEMORY_SCOPE_AGENT); }
DI unsigned xb_add(unsigned* p, unsigned v) { return __hip_atomic_fetch_add(p, v, __ATOMIC_RELAXED, __HIP_MEMORY_SCOPE_AGENT); }
DI unsigned xb_xcc_id() { return (unsigned)__builtin_amdgcn_s_getreg((3 << 11) | 20) & 0xFu; }
#define XB_SPIN(cond, bar) do { unsigned _sp = 0; while (cond) { __builtin_amdgcn_s_sleep(1); \
    if ((++_sp & 255u) == 0u) { if (xb_ld(&(bar)[XB_TMO])) break; if (_sp > XB_SPIN_CAP) { atomicAdd(&(bar)[XB_TMO], 1u); break; } } } } while (0)
struct XcdBarrier { unsigned* bar; unsigned x; volatile LAS unsigned* st; };
DI XcdBarrier xcd_barrier_post(unsigned* bar, volatile LAS unsigned* st) {
    XcdBarrier b; b.bar = bar; b.x = xb_xcc_id(); b.st = st;
    if (threadIdx.x == 0) (void)xb_add(&bar[XB_XCNT(b.x)], 1u);
    return b;
}
DI void xcd_barrier_complete(unsigned* bar, unsigned x, unsigned& nloc, unsigned& nx) {
    const unsigned G = gridDim.x * gridDim.y * gridDim.z;
    unsigned sum, cnt, mine, sp = 0u;
    for (;;) {
        sum = 0u; cnt = 0u; mine = 0u;
#pragma unroll
        for (unsigned j = 0; j < 16; ++j) { const unsigned c = xb_ld(&bar[XB_XCNT(j)]); sum += c; cnt += (c > 0u) ? 1u : 0u; mine = (j == x) ? c : mine; }
        if (sum == G) break;
        __builtin_amdgcn_s_sleep(1);
        if ((++sp & 255u) == 0u) { if (xb_ld(&bar[XB_TMO])) break; if (sp > XB_SPIN_CAP) { atomicAdd(&bar[XB_TMO], 1u); break; } }
    }
    nloc = mine > 0u ? mine : 1u; nx = cnt > 0u ? cnt : 1u;
}
DI void xcd_barrier(const XcdBarrier& b) {
    asm volatile("s_waitcnt vmcnt(0)" ::: "memory");
    __syncthreads();
    if (threadIdx.x == 0) {
        unsigned* bar = b.bar;
        __builtin_amdgcn_s_waitcnt(0);
        unsigned nloc = b.st[0], nx = b.st[1];
        if (nloc == 0u) { xcd_barrier_complete(bar, b.x, nloc, nx); b.st[0] = nloc; b.st[1] = nx; }
        const unsigned old = xb_add(&bar[XB_XSUB(b.x)], 1u);
        const unsigned gen = old / nloc;
        if (old + 1u == (gen + 1u) * nloc) {
            __builtin_amdgcn_fence(__ATOMIC_RELEASE, "agent");
            asm volatile("s_waitcnt vmcnt(0)" ::: "memory");
            const unsigned og = xb_add(&bar[XB_TOP], 1u);
            const unsigned tg = og / nx;
            if (og + 1u == (tg + 1u) * nx) xb_add(&bar[XB_TOPGEN], 1u);
            else XB_SPIN(xb_ld(&bar[XB_TOPGEN]) == tg, bar);
            __builtin_amdgcn_fence(__ATOMIC_ACQUIRE, "agent");
            xb_add(&bar[XB_XGEN(b.x)], 1u);
            asm volatile("s_waitcnt vmcnt(0)" ::: "memory");
        } else {
            XB_SPIN(xb_ld(&bar[XB_XGEN(b.x)]) == gen, bar);
            __builtin_amdgcn_fence(__ATOMIC_ACQUIRE, "agent");
            asm volatile("s_waitcnt vmcnt(0)" ::: "memory");
        }
    }
    __syncthreads();
}

struct Args { const void* in[30]; float* out; unsigned char* ws; int ph_lo, ph_hi, li, pad; };
enum { I_X = 0, I_C, I_POS, I_ADAW, I_ADAB, I_WIN, I_GMLNG, I_GMLNB, I_GMWS, I_GMBS, I_LAMRE, I_LAMIM, I_LOGDT, I_BRE, I_BIM, I_CRE, I_CIM, I_SSMD,
       I_GLUW, I_GLUB, I_WOUT, I_LN1G, I_LN1B, I_RW, I_RB, I_EWG, I_EWU, I_EWD, I_LN2G, I_LN2B };
struct Frame {
    LAS unsigned char* lds;
    volatile LAS unsigned* MISC;
    gu32* ctl;
    unsigned char* ws;
    int vcu, G;
};
DI int ftid() { int t = threadIdx.x; asm volatile("" : "+v"(t)); return t; }
#define FRAME_IDS const int tid_ = ftid(), lane_ = tid_ & 63, wave_ = __builtin_amdgcn_readfirstlane(tid_ >> 6); (void)lane_; (void)wave_;

template <class RowMap>
DI void transpose_item(const float* W, int K, int N, bf16* WT, const RowMap& rm, LAS float* scr, int item, int lane) {
    const int nblk = N / 32, kb = item / nblk, nb = item % nblk, k0 = 64 * kb, n0 = 32 * nb;
#pragma unroll 8
    for (int i = 0; i < 32; ++i) { const int kk = 2 * i + (lane >> 5); scr[kk * 33 + (lane & 31)] = W[(size_t)(k0 + kk) * N + n0 + (lane & 31)]; }
    LDS_WAIT(); asm volatile("" ::: "memory");
    const int c = lane & 7;
#pragma unroll
    for (int j = 0; j < 4; ++j) { const int n = (lane >> 3) + 8 * j; const LAS float* s = scr + (8 * c) * 33 + n;
        v4u o; o.x = pk2(s[0 * 33], s[1 * 33]); o.y = pk2(s[2 * 33], s[3 * 33]); o.z = pk2(s[4 * 33], s[5 * 33]); o.w = pk2(s[6 * 33], s[7 * 33]);
        *(GAS v4u*)(WT + (size_t)rm(n0 + n) * K + k0 + 8 * c) = o; }
    LDS_WAIT(); asm volatile("" ::: "memory");
}
struct RmIdent { int off; DI int operator()(int n) const { return off + n; } };
struct RmWin { DI int operator()(int n) const {
        if (n >= COL_Q && n < COL_VA) { const int d = n & 63; if (d < 16) return (n - d) + 2 * (d & 7) + (d >> 3); }
        return n; } };
struct RmGU { int e, up; DI int operator()(int n) const { return e * 1024 + (n >> 7) * 256 + (n & 127) + up * 128; } };

DI void p0_tables(Frame& F, const Args& A) {
    FRAME_IDS
    const float* c = (const float*)A.in[I_C];
    LAS float* condS = (LAS float*)(F.lds + RING_OFF);
    LAS float* red = (LAS float*)(F.lds + RING_OFF + 32768);
    for (int i = tid_; i < BATCH * D; i += NTHR) condS[i] = silu_f(c[i]);
    __syncthreads();
    float* mod = (float*)(F.ws + WS_MOD);
    for (int it = F.vcu; it < DEPTH * 96; it += F.G) {
        const int l = it / 96, jb = it % 96, ks = tid_ >> 6, jj = tid_ & 63, j = jb * 64 + jj;
        const float* w = (const float*)A.in[I_ADAW] + (size_t)l * D * 6 * D + j;
        float acc[8];
#pragma unroll
        for (int b = 0; b < 8; ++b) acc[b] = 0.f;
        for (int k = ks * 128; k < ks * 128 + 128; ++k) { const float wv = w[(size_t)k * (6 * D)];
#pragma unroll
            for (int b = 0; b < 8; ++b) acc[b] += condS[b * D + k] * wv; }
#pragma unroll
        for (int b = 0; b < 8; ++b) red[(ks * 8 + b) * 64 + jj] = acc[b];
        __syncthreads();
        { const int b = tid_ >> 6; float s = ((const float*)A.in[I_ADAB])[l * 6 * D + j];
#pragma unroll
          for (int k2 = 0; k2 < 8; ++k2) s += red[(k2 * 8 + b) * 64 + jj];
          mod[((size_t)l * BATCH + b) * 6 * D + j] = s; }
        __syncthreads();
    }
    const int gt = F.vcu * NTHR + tid_, NGT = F.G * NTHR;
    const int* pos = (const int*)A.in[I_POS]; float* rope = (float*)(F.ws + WS_ROPE);
    for (int w = gt; w < M * 8; w += NGT) { const int m = w >> 3, i = w & 7;
        const float freq = exp2f(-(float)i * 0.125f * 18.931568569324174f);
        const float ang = (float)pos[m] * freq; float s, cs; sincosf(ang, &s, &cs);
        rope[m * 16 + i] = cs; rope[m * 16 + 8 + i] = s; }
    for (int w = gt; w < DEPTH * SSM_G * SSM_N; w += NGT) { const int l = w / 1024, gn = w % 1024, g = gn >> 6;
        float* tab = (float*)(F.ws + WS_SSM) + (size_t)l * SSM_TAB;
        const float lre = ((const float*)A.in[I_LAMRE])[w], lim = ((const float*)A.in[I_LAMIM])[w];
        const float dt = expf(((const float*)A.in[I_LOGDT])[l * 16 + g]);
        const float mag = expf(lre * dt); float sn, cs; sincosf(lim * dt, &sn, &cs);
        const float are = mag * cs, aim = mag * sn, nr = are - 1.0f, ni = aim, mod2 = lre * lre + lim * lim;
        const float fre = (nr * lre + ni * lim) / mod2, fim = (ni * lre - nr * lim) / mod2;
        tab[gn] = are; tab[1024 + gn] = aim;
        const float* bre = (const float*)A.in[I_BRE] + (size_t)w * 16; const float* bim = (const float*)A.in[I_BIM] + (size_t)w * 16;
#pragma unroll
        for (int cc = 0; cc < 16; ++cc) { tab[2048 + gn * 16 + cc] = fre * bre[cc] - fim * bim[cc]; tab[2048 + 16384 + gn * 16 + cc] = fre * bim[cc] + fim * bre[cc]; } }
}

DI void p_wconv(Frame& F, const Args& A, int l) {
    FRAME_IDS
    LAS float* scr = (LAS float*)(F.lds + RING_OFF + wave_ * 16384);
    const int gw = F.vcu * NWAVES + wave_, NGW = F.G * NWAVES;
    bf16* WinT = (bf16*)(F.ws + WS_WSMALL + l * WSMALL_LAYER + WOFF_IN);
    bf16* WoutT = (bf16*)(F.ws + WS_WSMALL + l * WSMALL_LAYER + WOFF_OUT);
    bf16* GluT = (bf16*)(F.ws + WS_WSMALL + l * WSMALL_LAYER + WOFF_GLU);
    bf16* WguT = (bf16*)(F.ws + WS_WGU); bf16* WdT = (bf16*)(F.ws + WS_WD);
    constexpr int I_IN = 16 * 72, I_OUTW = 16 * 32, I_GLU = 4 * 8, I_G = 16 * 16, I_DN = 8 * 32;
    constexpr int NIT = I_IN + I_OUTW + I_GLU + 16 * (2 * I_G + I_DN);
    for (int it = gw; it < NIT; it += NGW) {
        int r = it;
        if (r < I_IN) { transpose_item((const float*)A.in[I_WIN] + (size_t)l * D * PROJW, D, PROJW, WinT, RmWin{}, scr, r, lane_); continue; } r -= I_IN;
        if (r < I_OUTW) { transpose_item((const float*)A.in[I_WOUT] + (size_t)l * D * D, D, D, WoutT, RmIdent{0}, scr, r, lane_); continue; } r -= I_OUTW;
        if (r < I_GLU) { transpose_item((const float*)A.in[I_GLUW] + (size_t)l * 256 * 256, 256, 256, GluT, RmIdent{0}, scr, r, lane_); continue; } r -= I_GLU;
        const int e = r / (2 * I_G + I_DN); r -= e * (2 * I_G + I_DN);
        const size_t eo = ((size_t)l * NEXP + e) * D * DEXP;
        if (r < I_G) { transpose_item((const float*)A.in[I_EWG] + eo, D, DEXP, WguT, RmGU{e, 0}, scr, r, lane_); continue; } r -= I_G;
        if (r < I_G) { transpose_item((const float*)A.in[I_EWU] + eo, D, DEXP, WguT, RmGU{e, 1}, scr, r, lane_); continue; } r -= I_G;
        transpose_item((const float*)A.in[I_EWD] + eo, DEXP, D, WdT, RmIdent{e * 1024}, scr, r, lane_);
    }
}

struct Row16 { float v[16]; };
DI void row_load_f32(Row16& r, const float* p, int lane) {
    const f32x4* q = (const f32x4*)p;
#pragma unroll
    for (int s = 0; s < 2; ++s) { const f32x4 a = q[s * 128 + 2 * lane], b = q[s * 128 + 2 * lane + 1];
        r.v[8 * s + 0] = a.x; r.v[8 * s + 1] = a.y; r.v[8 * s + 2] = a.z; r.v[8 * s + 3] = a.w; r.v[8 * s + 4] = b.x; r.v[8 * s + 5] = b.y; r.v[8 * s + 6] = b.z; r.v[8 * s + 7] = b.w; }
}
DI void row_load_bf16(Row16& r, const bf16* p, int lane) {
    const v4u* q = (const v4u*)p;
#pragma unroll
    for (int s = 0; s < 2; ++s) { const v4u a = q[s * 64 + lane];
        r.v[8 * s + 0] = bflo(a.x); r.v[8 * s + 1] = bfhi(a.x); r.v[8 * s + 2] = bflo(a.y); r.v[8 * s + 3] = bfhi(a.y);
        r.v[8 * s + 4] = bflo(a.z); r.v[8 * s + 5] = bfhi(a.z); r.v[8 * s + 6] = bflo(a.w); r.v[8 * s + 7] = bfhi(a.w); }
}
DI void row_store_bf16(const Row16& r, bf16* p, int lane) {
    v4u* q = (v4u*)p;
#pragma unroll
    for (int s = 0; s < 2; ++s) { v4u o; o.x = pk2(r.v[8 * s], r.v[8 * s + 1]); o.y = pk2(r.v[8 * s + 2], r.v[8 * s + 3]); o.z = pk2(r.v[8 * s + 4], r.v[8 * s + 5]); o.w = pk2(r.v[8 * s + 6], r.v[8 * s + 7]);
        q[s * 64 + lane] = o; }
}
DI void row_store_f32(const Row16& r, float* p, int lane) {
    f32x4* q = (f32x4*)p;
#pragma unroll
    for (int s = 0; s < 2; ++s) { q[s * 128 + 2 * lane] = (f32x4){r.v[8 * s], r.v[8 * s + 1], r.v[8 * s + 2], r.v[8 * s + 3]}; q[s * 128 + 2 * lane + 1] = (f32x4){r.v[8 * s + 4], r.v[8 * s + 5], r.v[8 * s + 6], r.v[8 * s + 7]}; }
}
DI void row_ln(Row16& r) {
    float s = 0.f;
#pragma unroll
    for (int i = 0; i < 16; ++i) s += r.v[i];
    const float mean = wave_sum(s) * (1.f / D); float s2 = 0.f;
#pragma unroll
    for (int i = 0; i < 16; ++i) { r.v[i] -= mean; s2 += r.v[i] * r.v[i]; }
    const float rstd = 1.0f / sqrtf(wave_sum(s2) * (1.f / D) + LN_EPS);
#pragma unroll
    for (int i = 0; i < 16; ++i) r.v[i] *= rstd;
}
DI void row_mod(Row16& r, const float* a, const float* b, int lane) {
    Row16 av, bv; row_load_f32(av, a, lane); row_load_f32(bv, b, lane);
#pragma unroll
    for (int i = 0; i < 16; ++i) r.v[i] = r.v[i] * (1.0f + av.v[i]) + bv.v[i];
}
DI void row_affine(Row16& r, const float* g, const float* b, int lane) {
    Row16 av, bv; row_load_f32(av, g, lane); row_load_f32(bv, b, lane);
#pragma unroll
    for (int i = 0; i < 16; ++i) r.v[i] = r.v[i] * av.v[i] + bv.v[i];
}

DI void p_ln_a0(Frame& F, const Args& A) {
    FRAME_IDS
    const int gw = F.vcu * NWAVES + wave_, NGW = F.G * NWAVES;
    const float* x = (const float*)A.in[I_X]; bf16* XN = (bf16*)(F.ws + WS_XN); const float* mod = (const float*)(F.ws + WS_MOD);
    for (int m = gw; m < M; m += NGW) { const int b = m / T; const float* md = mod + (size_t)b * 6 * D;
        Row16 r; row_load_f32(r, x + (size_t)m * D, lane_); row_ln(r); row_mod(r, md + 1 * D, md + 0 * D, lane_); row_store_bf16(r, XN + (size_t)m * D, lane_); }
}

using pg8::Unit; using pg8::BM; using pg8::HALF;
struct EpiInProj {
    static constexpr bool PERM = true, AFTER_DRAIN = false;
    bf16* P; const float* rope;
    DI void operator()(const pg8::f32x4 (&acc)[2][2][4][2], const Unit& u, int wr, int wc, int fr, int fq) const {
        const int row0 = u.pm * BM + wr * 64 + fr, pn = u.pn;
        const bool isrope = (pn >= 2 && pn <= 5), dorope = isrope && ((wc & 1) == 0) && (fq < 2);
        const float sc = (pn == 2 || pn == 3) ? QSCALE : 1.0f;
#pragma unroll
        for (int ai = 0; ai < 2; ++ai)
#pragma unroll
            for (int m = 0; m < 4; ++m) { const int row = row0 + ai * HALF + m * 16; bf16* rowp = P + (size_t)row * PROJW + pn * BM + wc * 32 + 8 * fq;
                f32x4 cs = (f32x4){1.f, 1.f, 1.f, 1.f}, sn = (f32x4){0.f, 0.f, 0.f, 0.f};
                if (isrope) { const float* rp = rope + (size_t)row * 16 + 4 * (fq & 1); cs = *(const f32x4*)rp; sn = *(const f32x4*)(rp + 8); }
#pragma unroll
                for (int bj = 0; bj < 2; ++bj) { pg8::f32x4 v0 = acc[ai][bj][m][0], v1 = acc[ai][bj][m][1];
                    if (pn < 2) {
#pragma unroll
                        for (int i = 0; i < 4; ++i) { v0[i] = gelu_tanh_f(v0[i]); v1[i] = gelu_tanh_f(v1[i]); }
                    } else if (isrope) {
                        if (dorope) { const float a0 = v0[0] * cs.x - v0[1] * sn.x, b0 = v0[1] * cs.x + v0[0] * sn.x, a1 = v0[2] * cs.y - v0[3] * sn.y, b1 = v0[3] * cs.y + v0[2] * sn.y;
                            const float a2 = v1[0] * cs.z - v1[1] * sn.z, b2 = v1[1] * cs.z + v1[0] * sn.z, a3 = v1[2] * cs.w - v1[3] * sn.w, b3 = v1[3] * cs.w + v1[2] * sn.w;
                            v0 = (pg8::f32x4){a0, b0, a1, b1}; v1 = (pg8::f32x4){a2, b2, a3, b3}; }
                        v0 = v0 * sc; v1 = v1 * sc;
                    }
                    pg8::u32x4 w; w.x = pg8::cvt_pk_bf16(v0[0], v0[1]); w.y = pg8::cvt_pk_bf16(v0[2], v0[3]); w.z = pg8::cvt_pk_bf16(v1[0], v1[1]); w.w = pg8::cvt_pk_bf16(v1[2], v1[3]);
                    *(pg8::u32x4*)(rowp + bj * HALF) = w; } }
    }
};
template <bool XF32> struct EpiOut {
    static constexpr bool PERM = true, AFTER_DRAIN = false;
    bf16* PRE; const void* x; int xpitch; const float* mod;
    DI void operator()(const pg8::f32x4 (&acc)[2][2][4][2], const Unit& u, int wr, int wc, int fr, int fq) const {
        const int row0 = u.pm * BM + wr * 64 + fr, b = (u.pm * BM) / T, colb = u.pn * BM + wc * 32 + 8 * fq;
        const float* g1 = mod + (size_t)b * 6 * D + 2 * D;
        pg8::f32x4 gv[2][2];
#pragma unroll
        for (int bj = 0; bj < 2; ++bj) { gv[bj][0] = *(const pg8::f32x4*)(g1 + colb + bj * HALF) + 1.0f; gv[bj][1] = *(const pg8::f32x4*)(g1 + colb + bj * HALF + 4) + 1.0f; }
#pragma unroll
        for (int ai = 0; ai < 2; ++ai)
#pragma unroll
            for (int m = 0; m < 4; ++m) { const int row = row0 + ai * HALF + m * 16;
#pragma unroll
                for (int bj = 0; bj < 2; ++bj) { const int col = colb + bj * HALF; pg8::f32x4 x0, x1;
                    if (XF32) { const float* xp = (const float*)x + (size_t)row * xpitch + col; x0 = *(const pg8::f32x4*)xp; x1 = *(const pg8::f32x4*)(xp + 4); }
                    else { const pg8::u32x4 xw = *(const pg8::u32x4*)((const bf16*)x + (size_t)row * xpitch + col);
                        x0 = (pg8::f32x4){bflo(xw.x), bfhi(xw.x), bflo(xw.y), bfhi(xw.y)}; x1 = (pg8::f32x4){bflo(xw.z), bfhi(xw.z), bflo(xw.w), bfhi(xw.w)}; }
                    const pg8::f32x4 v0 = x0 * ALPHA + gv[bj][0] * acc[ai][bj][m][0], v1 = x1 * ALPHA + gv[bj][1] * acc[ai][bj][m][1];
                    pg8::u32x4 w; w.x = pg8::cvt_pk_bf16(v0[0], v0[1]); w.y = pg8::cvt_pk_bf16(v0[2], v0[3]); w.z = pg8::cvt_pk_bf16(v1[0], v1[1]); w.w = pg8::cvt_pk_bf16(v1[2], v1[3]);
                    *(pg8::u32x4*)(PRE + (size_t)row * D + col) = w; } }
    }
};
struct EpiGlu {
    static constexpr bool PERM = true, AFTER_DRAIN = false;
    const bf16* YG; bf16* MIX; const float* gb;
    DI void operator()(const pg8::f32x4 (&acc)[2][2][4][2], const Unit& u, int wr, int wc, int fr, int fq) const {
        const int row0 = u.pm * BM + wr * 64 + fr, colb = wc * 32 + 8 * fq;
#pragma unroll
        for (int ai = 0; ai < 2; ++ai)
#pragma unroll
            for (int m = 0; m < 4; ++m) { const int row = row0 + ai * HALF + m * 16;
#pragma unroll
                for (int bj = 0; bj < 2; ++bj) { const int col = colb + bj * HALF;
                    const pg8::u32x4 yw = *(const pg8::u32x4*)(YG + (size_t)row * 256 + col);
                    const pg8::f32x4 b0 = *(const pg8::f32x4*)(gb + col), b1 = *(const pg8::f32x4*)(gb + col + 4);
                    const pg8::f32x4 a0 = acc[ai][bj][m][0] + b0, a1 = acc[ai][bj][m][1] + b1;
                    const float y[8] = {bflo(yw.x), bfhi(yw.x), bflo(yw.y), bfhi(yw.y), bflo(yw.z), bfhi(yw.z), bflo(yw.w), bfhi(yw.w)};
                    float o[8];
#pragma unroll
                    for (int i = 0; i < 4; ++i) { o[i] = y[i] * sigmoid_f(a0[i]); o[4 + i] = y[4 + i] * sigmoid_f(a1[i]); }
                    pg8::u32x4 w; w.x = pg8::cvt_pk_bf16(o[0], o[1]); w.y = pg8::cvt_pk_bf16(o[2], o[3]); w.z = pg8::cvt_pk_bf16(o[4], o[5]); w.w = pg8::cvt_pk_bf16(o[6], o[7]);
                    *(pg8::u32x4*)(MIX + (size_t)row * D + 768 + col) = w; asm volatile("" ::: "memory"); } }
    }
};
struct MoeOrder {
    const volatile LAS int* tstart; int G, c;
    DI bool next(int i, Unit& u) const {
        const int nwg = tstart[16] * 4; const long L = (long)i * G + c; if (L >= nwg) return false;
        int wgid = (int)L; { const int q = nwg / 8, r = nwg % 8, xcd = wgid % 8, off = wgid / 8; wgid = (xcd < r ? xcd * (q + 1) : r * (q + 1) + (xcd - r) * q) + off; }
        const int tm = wgid >> 2, j = wgid & 3; int e = 0;
#pragma unroll
        for (int k = 1; k < 16; ++k) e += (tstart[k] <= tm) ? 1 : 0;
        u.pm = tm; u.pn = e * 4 + j; return true;
    }
    DI void a_ready(const Unit&) const {}
    DI void done(const Unit&) const {}
};
struct EpiG1 {
    static constexpr bool PERM = true, AFTER_DRAIN = false;
    bf16* HID;
    DI void operator()(const pg8::f32x4 (&acc)[2][2][4][2], const Unit& u, int wr, int wc, int fr, int fq) const {
        const int row0 = u.pm * BM + wr * 64 + fr, col = (u.pn & 3) * 128 + wc * 32 + 8 * fq;
#pragma unroll
        for (int ai = 0; ai < 2; ++ai)
#pragma unroll
            for (int m = 0; m < 4; ++m) { const int row = row0 + ai * HALF + m * 16; float o[8];
#pragma unroll
                for (int i = 0; i < 4; ++i) { o[i] = silu_f(acc[ai][0][m][0][i]) * acc[ai][1][m][0][i]; o[4 + i] = silu_f(acc[ai][0][m][1][i]) * acc[ai][1][m][1][i]; }
                pg8::u32x4 w; w.x = pg8::cvt_pk_bf16(o[0], o[1]); w.y = pg8::cvt_pk_bf16(o[2], o[3]); w.z = pg8::cvt_pk_bf16(o[4], o[5]); w.w = pg8::cvt_pk_bf16(o[6], o[7]);
                *(pg8::u32x4*)(HID + (size_t)row * DEXP + col) = w; }
    }
};
struct EpiG2 {
    static constexpr bool PERM = true, AFTER_DRAIN = false;
    bf16* ROWS; const int* dest; const float* sw;
    DI void operator()(const pg8::f32x4 (&acc)[2][2][4][2], const Unit& u, int wr, int wc, int fr, int fq) const {
        const int row0 = u.pm * BM + wr * 64 + fr, colb = (u.pn & 3) * BM + wc * 32 + 8 * fq;
#pragma unroll
        for (int ai = 0; ai < 2; ++ai)
#pragma unroll
            for (int m = 0; m < 4; ++m) { const int row = row0 + ai * HALF + m * 16; const int d = dest[row]; const float wt = sw[row];
                if (d >= 0) {
#pragma unroll
                    for (int bj = 0; bj < 2; ++bj) { const pg8::f32x4 v0 = acc[ai][bj][m][0] * wt, v1 = acc[ai][bj][m][1] * wt;
                        pg8::u32x4 w; w.x = pg8::cvt_pk_bf16(v0[0], v0[1]); w.y = pg8::cvt_pk_bf16(v0[2], v0[3]); w.z = pg8::cvt_pk_bf16(v1[0], v1[1]); w.w = pg8::cvt_pk_bf16(v1[2], v1[3]);
                        *(pg8::u32x4*)(ROWS + (size_t)d * D + colb + bj * HALF) = w; } } }
    }
};

DI void mix_gating_simple(Frame& F, const Args& A, int l) {
    FRAME_IDS
    const bf16* P = (const bf16*)(F.ws + WS_PROJ); bf16* MIX = (bf16*)(F.ws + WS_MIXCAT);
    const float* lng = (const float*)A.in[I_GMLNG] + l * AW; const float* lnb = (const float*)A.in[I_GMLNB] + l * AW;
    const float* ws_ = (const float*)A.in[I_GMWS] + (size_t)l * 4 * 128 * 128; const float* bs_ = (const float*)A.in[I_GMBS] + l * 4 * 128;
    LAS float* vln = (LAS float*)(F.lds + RING_OFF);
    for (int it = F.vcu; it < BATCH * (T / 128); it += F.G) {
        const int m0 = it * 128;
        for (int r = wave_; r < 128; r += NWAVES) {
            const v2u w = *(const v2u*)(P + (size_t)(m0 + r) * PROJW + COL_V + 4 * lane_);
            float v[4] = {bflo(w.x), bfhi(w.x), bflo(w.y), bfhi(w.y)};
            const float mean = wave_sum(v[0] + v[1] + v[2] + v[3]) * (1.f / 256.f);
            float s2 = 0.f;
#pragma unroll
            for (int i = 0; i < 4; ++i) { v[i] -= mean; s2 += v[i] * v[i]; }
            const float rstd = 1.0f / sqrtf(wave_sum(s2) * (1.f / 256.f) + LN_EPS);
#pragma unroll
            for (int i = 0; i < 4; ++i) vln[r * 256 + 4 * lane_ + i] = v[i] * rstd * lng[4 * lane_ + i] + lnb[4 * lane_ + i];
        }
        __syncthreads();
        { const int c = tid_ & 255, tp = tid_ >> 8, h = c >> 6;
          for (int t = tp; t < 128; t += 2) { const float* wrow = ws_ + ((size_t)h * 128 + t) * 128; float acc = 0.f;
              for (int s = 0; s <= t; ++s) acc += wrow[s] * vln[s * 256 + c];
              const float uu = bf2f(P[(size_t)(m0 + t) * PROJW + COL_U + c]);
              MIX[(size_t)(m0 + t) * D + c] = (bf16)f2bf(uu * (acc + bs_[h * 128 + t])); } }
        __syncthreads();
    }
}
DI void mix_attn_simple(Frame& F, int l) {
    FRAME_IDS
    const bf16* P = (const bf16*)(F.ws + WS_PROJ); bf16* MIX = (bf16*)(F.ws + WS_MIXCAT);
    const int gw = F.vcu * NWAVES + wave_, NGW = F.G * NWAVES;
    for (int it = gw; it < M * NH; it += NGW) {
        const int m = it >> 3, h = it & 7, t = m & (T - 1);
        const float q = bf2f(P[(size_t)m * PROJW + COL_Q + h * 64 + lane_]);
        float mx = -1e30f, den = 0.f, o = 0.f;
#pragma unroll 1
        for (int g = 0; g < 3; ++g) { const int dl = (g == 0) ? 1 : (g == 1 ? 4 : 16);
            int nk = t / dl; if (nk > 128) nk = 128;
#pragma unroll 2
            for (int j = 0; j <= nk; ++j) { const size_t mk = (size_t)(m - j * dl);
                const float kv = bf2f(P[mk * PROJW + COL_K + h * 64 + lane_]); const float vv = bf2f(P[mk * PROJW + COL_VA + h * 64 + lane_]);
                const float s = wave_sum(q * kv);
                const float mn = fmaxf(mx, s), f = __builtin_amdgcn_exp2f(mx - mn), p = __builtin_amdgcn_exp2f(s - mn);
                den = den * f + p; o = o * f + p * vv; mx = mn; } }
        MIX[(size_t)m * D + AW + h * 64 + lane_] = (bf16)f2bf(o / den);
    }
}
DI void mix_ssm_simple(Frame& F, const Args& A, int l) {
    FRAME_IDS
    const bf16* P = (const bf16*)(F.ws + WS_PROJ); bf16* YG = (bf16*)(F.ws + WS_YG);
    const float* tab = (const float*)(F.ws + WS_SSM) + (size_t)l * SSM_TAB;
    LAS float* fin = (LAS float*)(F.lds + RING_OFF);
    for (int it = F.vcu; it < BATCH * SSM_G; it += F.G) {
        const int b = it >> 4, g = it & 15, n = lane_, seg = wave_, gn = g * 64 + n;
        const float are = tab[gn], aim = tab[1024 + gn];
        float bre[16], bim[16], cre[16], cim[16];
#pragma unroll
        for (int c = 0; c < 16; ++c) { bre[c] = tab[2048 + gn * 16 + c]; bim[c] = tab[2048 + 16384 + gn * 16 + c];
            cre[c] = ((const float*)A.in[I_CRE])[(((size_t)l * 16 + g) * 16 + c) * 64 + n]; cim[c] = ((const float*)A.in[I_CIM])[(((size_t)l * 16 + g) * 16 + c) * 64 + n]; }
        const float dsk = ((const float*)A.in[I_SSMD])[(l * 16 + g) * 16 + (lane_ & 15)];
        const size_t mbase = (size_t)b * T + seg * 512;
        float xr = 0.f, xi = 0.f;
        for (int tt = 0; tt < 512; ++tt) { const v4u* up = (const v4u*)(P + (mbase + tt) * PROJW + COL_S + g * 16); const v4u u0 = up[0], u1 = up[1];
            const float u[16] = {bflo(u0.x), bfhi(u0.x), bflo(u0.y), bfhi(u0.y), bflo(u0.z), bfhi(u0.z), bflo(u0.w), bfhi(u0.w), bflo(u1.x), bfhi(u1.x), bflo(u1.y), bfhi(u1.y), bflo(u1.z), bfhi(u1.z), bflo(u1.w), bfhi(u1.w)};
            float br = 0.f, bi = 0.f;
#pragma unroll
            for (int c = 0; c < 16; ++c) { br += u[c] * bre[c]; bi += u[c] * bim[c]; }
            const float nr = are * xr - aim * xi + br, ni = are * xi + aim * xr + bi; xr = nr; xi = ni; }
        fin[(seg * 64 + n) * 2] = xr; fin[(seg * 64 + n) * 2 + 1] = xi;
        __syncthreads();
        float pr = are, pi = aim;
#pragma unroll
        for (int k = 0; k < 9; ++k) { const float t0 = pr * pr - pi * pi, t1 = 2.f * pr * pi; pr = t0; pi = t1; }
        xr = 0.f; xi = 0.f;
        for (int s = 0; s < seg; ++s) { const float fr_ = fin[(s * 64 + n) * 2], fi_ = fin[(s * 64 + n) * 2 + 1];
            const float nr = pr * xr - pi * xi + fr_, ni = pr * xi + pi * xr + fi_; xr = nr; xi = ni; }
        for (int tt = 0; tt < 512; ++tt) { const v4u* up = (const v4u*)(P + (mbase + tt) * PROJW + COL_S + g * 16); const v4u u0 = up[0], u1 = up[1];
            const float u[16] = {bflo(u0.x), bfhi(u0.x), bflo(u0.y), bfhi(u0.y), bflo(u0.z), bfhi(u0.z), bflo(u0.w), bfhi(u0.w), bflo(u1.x), bfhi(u1.x), bflo(u1.y), bfhi(u1.y), bflo(u1.z), bfhi(u1.z), bflo(u1.w), bfhi(u1.w)};
            float br = 0.f, bi = 0.f;
#pragma unroll
            for (int c = 0; c < 16; ++c) { br += u[c] * bre[c]; bi += u[c] * bim[c]; }
            const float nr = are * xr - aim * xi + br, ni = are * xi + aim * xr + bi; xr = nr; xi = ni;
            float ysel = 0.f, usel = 0.f;
#pragma unroll
            for (int c = 0; c < 16; ++c) { const float r = wave_sum(xr * cre[c] - xi * cim[c]); if ((lane_ & 15) == c) { ysel = r; usel = u[c]; } }
            if (lane_ < 16) { const float y = ysel + dsk * usel; YG[(mbase + tt) * 256 + g * 16 + lane_] = (bf16)f2bf(gelu_tanh_f(y)); } }
        __syncthreads();
    }
}

DI void p_row_b(Frame& F, const Args& A, int l) {
    FRAME_IDS
    const int gw = F.vcu * NWAVES + wave_, NGW = F.G * NWAVES;
    const bf16* PRE = (const bf16*)(F.ws + WS_PRE); bf16* X1 = (bf16*)(F.ws + WS_X1); bf16* XN = (bf16*)(F.ws + WS_XN);
    const float* mod = (const float*)(F.ws + WS_MOD) + (size_t)l * BATCH * 6 * D;
    const float* ln1g = (const float*)A.in[I_LN1G] + l * D; const float* ln1b = (const float*)A.in[I_LN1B] + l * D;
    const float* rw = (const float*)A.in[I_RW]; const float* rb = (const float*)A.in[I_RB];
    int* toke = (int*)(F.ws + WS_TOKE); float* tokg = (float*)(F.ws + WS_TOKG);
    LAS float* rwS = (LAS float*)(F.lds + RING_OFF);
    volatile LAS unsigned* hist = (volatile LAS unsigned*)(F.lds + RING_OFF + 65536);
    for (int i = tid_; i < D * NEXP; i += NTHR) rwS[i] = rw[i];
    if (tid_ < 16) hist[tid_] = 0u;
    __syncthreads();
    for (int m = gw; m < M; m += NGW) { const int b = m / T; const float* md = mod + (size_t)b * 6 * D;
        Row16 r; row_load_bf16(r, PRE + (size_t)m * D, lane_); row_ln(r); row_affine(r, ln1g, ln1b, lane_);
        row_store_bf16(r, X1 + (size_t)m * D, lane_);
        row_ln(r); row_mod(r, md + 4 * D, md + 3 * D, lane_);
        row_store_bf16(r, XN + (size_t)m * D, lane_);
        float lg[16];
#pragma unroll
        for (int e = 0; e < 16; ++e) lg[e] = 0.f;
#pragma unroll
        for (int s = 0; s < 2; ++s)
#pragma unroll
            for (int i = 0; i < 8; ++i) { const LAS f32x4* wp = (const LAS f32x4*)(rwS + (size_t)(s * 512 + 8 * lane_ + i) * 16); const float hv = r.v[8 * s + i];
#pragma unroll
                for (int q = 0; q < 4; ++q) { const f32x4 w4 = wp[q]; lg[4 * q] += hv * w4.x; lg[4 * q + 1] += hv * w4.y; lg[4 * q + 2] += hv * w4.z; lg[4 * q + 3] += hv * w4.w; } }
        float sc[16], sel[16];
#pragma unroll
        for (int e = 0; e < 16; ++e) { const float z = wave_sum(lg[e]); sc[e] = 1.0f / (1.0f + expf(-z)); sel[e] = sc[e] + rb[e]; }
        int bg = 0; float bgs = -1e30f;
#pragma unroll
        for (int g = 0; g < 4; ++g) { float m1 = -1e30f, m2 = -1e30f;
#pragma unroll
            for (int k = 0; k < 4; ++k) { const float v = sel[4 * g + k]; if (v > m1) { m2 = m1; m1 = v; } else if (v > m2) m2 = v; }
            const float gs = m1 + m2; if (gs > bgs) { bgs = gs; bg = g; } }
        int i1 = 0, i2 = 0; float v1 = -1e30f, v2 = -1e30f;
#pragma unroll
        for (int g = 0; g < 4; ++g) if (g == bg) {
#pragma unroll
            for (int k = 0; k < 4; ++k) { const float v = sel[4 * g + k]; if (v > v1) { v2 = v1; i2 = i1; v1 = v; i1 = 4 * g + k; } else if (v > v2) { v2 = v; i2 = 4 * g + k; } } }
        float s1 = 0.f, s2 = 0.f;
#pragma unroll
        for (int e = 0; e < 16; ++e) { if (e == i1) s1 = sc[e]; if (e == i2) s2 = sc[e]; }
        if (lane_ == 0) { const float inv = 1.0f / (s1 + s2); toke[2 * m] = i1; toke[2 * m + 1] = i2; tokg[2 * m] = s1 * inv; tokg[2 * m + 1] = s2 * inv;
            atomicAdd((unsigned*)&hist[i1], 1u); atomicAdd((unsigned*)&hist[i2], 1u); }
    }
    __syncthreads();
    if (tid_ < 16) { const unsigned hv = hist[tid_]; if (hv) atomicAdd((unsigned*)(F.ctl + CW_CNT + l * 128 + tid_), hv); }
}

DI void moe_tstart(Frame& F, int l) {
    FRAME_IDS
    volatile LAS int* ts = (volatile LAS int*)(F.lds + LDSCTL_OFF);
    if (tid_ == 0) { int acc = 0;
        for (int e = 0; e < 16; ++e) { ts[e] = acc; const unsigned c = __hip_atomic_load(F.ctl + CW_CNT + l * 128 + e, RLX_AGENT); acc += (int)((c + 255u) >> 8); }
        ts[16] = acc; }
    __syncthreads();
}
DI void p_moe_prep(Frame& F, int l) {
    FRAME_IDS
    moe_tstart(F, l);
    volatile LAS int* ts = (volatile LAS int*)(F.lds + LDSCTL_OFF);
    volatile LAS unsigned* lc = (volatile LAS unsigned*)(F.lds + RING_OFF);
    const int* toke = (const int*)(F.ws + WS_TOKE); const float* tokg = (const float*)(F.ws + WS_TOKG);
    int* stok = (int*)(F.ws + WS_SLOT_TOK); int* sdest = (int*)(F.ws + WS_SLOT_DEST); float* sw = (float*)(F.ws + WS_SLOT_W);
    for (int blk = F.vcu; blk < M / 128; blk += F.G) {
        if (tid_ < 32) lc[tid_] = 0u;
        __syncthreads();
        int e = 0, rank = 0; const int a = blk * 256 + tid_;
        if (tid_ < 256) { e = toke[a]; rank = (int)atomicAdd((unsigned*)&lc[e], 1u); }
        __syncthreads();
        if (tid_ < 16) { const unsigned n = lc[tid_]; lc[16 + tid_] = n ? atomicAdd((unsigned*)(F.ctl + CW_CNT + l * 128 + 64 + tid_), n) : 0u; }
        __syncthreads();
        if (tid_ < 256) { const int slot = ts[e] * 256 + (int)lc[16 + e] + rank; stok[slot] = a >> 1; sdest[slot] = a; sw[slot] = tokg[a]; }
        __syncthreads();
    }
    if (F.vcu < 16) { const int e = F.vcu; const int cnt = (int)__hip_atomic_load(F.ctl + CW_CNT + l * 128 + e, RLX_AGENT);
        const int lo = ts[e] * 256 + cnt, hi = ts[e + 1] * 256;
        for (int s = lo + tid_; s < hi; s += NTHR) { stok[s] = 0; sdest[s] = -1; sw[s] = 0.f; } }
}
DI void p_gather(Frame& F, int l) {
    FRAME_IDS
    moe_tstart(F, l);
    volatile LAS int* ts = (volatile LAS int*)(F.lds + LDSCTL_OFF);
    const int ns = ts[16] * 256; const int gw = F.vcu * NWAVES + wave_, NGW = F.G * NWAVES;
    const int* stok = (const int*)(F.ws + WS_SLOT_TOK); const bf16* XN = (const bf16*)(F.ws + WS_XN); bf16* XG = (bf16*)(F.ws + WS_ROWS2);
    for (int s = gw; s < ns; s += NGW) { const int tk = stok[s]; const v4u* src = (const v4u*)(XN + (size_t)tk * D); v4u* dst = (v4u*)(XG + (size_t)s * D);
        const v4u a = src[lane_], b = src[64 + lane_]; dst[lane_] = a; dst[64 + lane_] = b; }
}
DI void p_row_c(Frame& F, const Args& A, int l) {
    FRAME_IDS
    const int gw = F.vcu * NWAVES + wave_, NGW = F.G * NWAVES;
    const bf16* X1 = (const bf16*)(F.ws + WS_X1); bf16* R2 = (bf16*)(F.ws + WS_ROWS2); bf16* XN = (bf16*)(F.ws + WS_XN);
    const float* mod = (const float*)(F.ws + WS_MOD) + (size_t)l * BATCH * 6 * D;
    const float* modn = (const float*)(F.ws + WS_MOD) + (size_t)(l + 1) * BATCH * 6 * D;
    const float* ln2g = (const float*)A.in[I_LN2G] + l * D; const float* ln2b = (const float*)A.in[I_LN2B] + l * D;
    for (int m = gw; m < M; m += NGW) { const int b = m / T; const float* md = mod + (size_t)b * 6 * D;
        Row16 x1, r0, r1, g2; row_load_bf16(x1, X1 + (size_t)m * D, lane_); row_load_bf16(r0, R2 + (size_t)(2 * m) * D, lane_); row_load_bf16(r1, R2 + (size_t)(2 * m + 1) * D, lane_);
        row_load_f32(g2, md + 5 * D, lane_);
#pragma unroll
        for (int i = 0; i < 16; ++i) x1.v[i] = ALPHA * x1.v[i] + (1.0f + g2.v[i]) * (r0.v[i] + r1.v[i]);
        row_ln(x1); row_affine(x1, ln2g, ln2b, lane_);
        if (l == DEPTH - 1) row_store_f32(x1, A.out + (size_t)m * D, lane_);
        else { row_store_bf16(x1, R2 + (size_t)(2 * m) * D, lane_);
            const float* mdn = modn + (size_t)b * 6 * D; row_ln(x1); row_mod(x1, mdn + 1 * D, mdn + 0 * D, lane_); row_store_bf16(x1, XN + (size_t)m * D, lane_); }
    }
}


#ifndef PHMASK
#define PHMASK 0xFFFFFFFFu
#endif
#define IN(k) (lo <= (k) && (k) < hi && ((PHMASK >> (((k) == 0) ? 31 : (((k) - 1) % PH_PER_LAYER))) & 1u))
#define SEAM(k) do { if (IN((k) + 1) && MK_ONE_LAUNCH) xcd_barrier(bar); else __syncthreads(); } while (0)
constexpr int PH_PER_LAYER = 11, N_PHASES = 1 + DEPTH * PH_PER_LAYER;
template <int l> DI void layer_body(Frame& F, const Args& args, const XcdBarrier& bar, const int lo, const int hi) {
    unsigned char* ws = args.ws;

        const int pb = 1 + l * PH_PER_LAYER;
        const bf16* WinT = (const bf16*)(ws + WS_WSMALL + l * WSMALL_LAYER + WOFF_IN);
        const bf16* WoutT = (const bf16*)(ws + WS_WSMALL + l * WSMALL_LAYER + WOFF_OUT);
        const bf16* GluT = (const bf16*)(ws + WS_WSMALL + l * WSMALL_LAYER + WOFF_GLU);
        const float* modl = (const float*)(ws + WS_MOD) + (size_t)l * BATCH * 6 * D;
        if (IN(pb + 0)) { p_wconv(F, args, l); if (l == 0) p_ln_a0(F, args); SEAM(pb + 0); }
        if (IN(pb + 1)) {
            pg8::Gemm g{(const bf16*)(ws + WS_XN), WinT, M, PROJW, D}; pg8::StaticOrder S; S.init(M, PROJW, F.G, (int)blockIdx.x);
            EpiInProj E{(bf16*)(ws + WS_PROJ), (const float*)(ws + WS_ROPE)};
            pg8::gemm_phase<EpiInProj, pg8::StaticOrder, PG8_ALIGN, PG8_SP2>(F.lds + RING_OFF, g, S, E);
            SEAM(pb + 1); }
        if (IN(pb + 2)) { mix_gating_simple(F, args, l); mix_ssm_simple(F, args, l); mix_attn_simple(F, l); SEAM(pb + 2); }
        if (IN(pb + 3)) {
            pg8::Gemm g{(const bf16*)(ws + WS_YG), GluT, M, 256, 256}; pg8::StaticOrder S; S.init(M, 256, F.G, (int)blockIdx.x);
            EpiGlu E{(const bf16*)(ws + WS_YG), (bf16*)(ws + WS_MIXCAT), (const float*)args.in[I_GLUB] + l * 256};
            pg8::gemm_phase<EpiGlu, pg8::StaticOrder, PG8_ALIGN, PG8_SP2>(F.lds + RING_OFF, g, S, E);
            SEAM(pb + 3); }
        if (IN(pb + 4)) {
            pg8::Gemm g{(const bf16*)(ws + WS_MIXCAT), WoutT, M, D, D}; pg8::StaticOrder S; S.init(M, D, F.G, (int)blockIdx.x);
            if (l == 0) { EpiOut<true> E{(bf16*)(ws + WS_PRE), args.in[I_X], D, modl}; pg8::gemm_phase<EpiOut<true>, pg8::StaticOrder, PG8_ALIGN, PG8_SP2>(F.lds + RING_OFF, g, S, E); }
            else { EpiOut<false> E{(bf16*)(ws + WS_PRE), (const void*)(ws + WS_ROWS2), 2 * D, modl}; pg8::gemm_phase<EpiOut<false>, pg8::StaticOrder, PG8_ALIGN, PG8_SP2>(F.lds + RING_OFF, g, S, E); }
            SEAM(pb + 4); }
        if (IN(pb + 5)) { p_row_b(F, args, l); SEAM(pb + 5); }
        if (IN(pb + 6)) { p_moe_prep(F, l); SEAM(pb + 6); }
        if (IN(pb + 7)) { p_gather(F, l); SEAM(pb + 7); }
        if (IN(pb + 8)) { moe_tstart(F, l);
            pg8::Gemm g{(const bf16*)(ws + WS_ROWS2), (const bf16*)(ws + WS_WGU), NSLOT_MAX, NEXP * 1024, D};
            MoeOrder S{(const volatile LAS int*)(F.lds + LDSCTL_OFF), F.G, (int)blockIdx.x}; EpiG1 E{(bf16*)(ws + WS_HID)};
            pg8::gemm_phase<EpiG1, MoeOrder, PG8_ALIGN, PG8_SP2>(F.lds + RING_OFF, g, S, E);
            SEAM(pb + 8); }
        if (IN(pb + 9)) { moe_tstart(F, l);
            pg8::Gemm g{(const bf16*)(ws + WS_HID), (const bf16*)(ws + WS_WD), NSLOT_MAX, NEXP * 1024, DEXP};
            MoeOrder S{(const volatile LAS int*)(F.lds + LDSCTL_OFF), F.G, (int)blockIdx.x}; EpiG2 E{(bf16*)(ws + WS_ROWS2), (const int*)(ws + WS_SLOT_DEST), (const float*)(ws + WS_SLOT_W)};
            pg8::gemm_phase<EpiG2, MoeOrder, PG8_ALIGN, PG8_SP2>(F.lds + RING_OFF, g, S, E);
            SEAM(pb + 9); }
        if (IN(pb + 10)) { p_row_c(F, args, l); SEAM(pb + 10); }
    }
__global__ void __launch_bounds__(NTHR, 2) mk_fwd(Args args) {
    extern __shared__ __attribute__((aligned(16))) unsigned char lds[];
    Frame F;
    F.lds = (LAS unsigned char*)lds; F.MISC = (volatile LAS unsigned*)(F.lds + MISC_OFF);
    F.G = gridDim.x; { const int bx = blockIdx.x; F.vcu = (F.G % 8 == 0) ? (bx % 8) * (F.G / 8) + bx / 8 : bx; }
    F.ws = args.ws; F.ctl = (gu32*)(args.ws + WS_CTL);
    for (int u = threadIdx.x; u < (LDS_BYTES - LDSCTL_OFF) / 4; u += NTHR) ((LAS unsigned*)(F.lds + LDSCTL_OFF))[u] = 0u;
    __syncthreads();
    XcdBarrier bar; bar.bar = (unsigned*)(F.ctl + CW_BAR); bar.x = 0; bar.st = nullptr;
    if (MK_ONE_LAUNCH) bar = xcd_barrier_post((unsigned*)(F.ctl + CW_BAR), F.MISC + 8);
    const int lo = args.ph_lo, hi = args.ph_hi;
    unsigned char* ws = args.ws; (void)ws;
    if (IN(0)) { p0_tables(F, args); SEAM(0); }
    layer_body<0>(F, args, bar, lo, hi);
    layer_body<1>(F, args, bar, lo, hi);
#undef IN
#undef SEAM
}

extern "C" void kernel_launch(void* const* d_in, const int* in_sizes, int n_in, void* d_out, int out_size, void* d_ws, size_t ws_size, hipStream_t stream) {
    static int grid = 0;
    if (grid == 0) {
        if (n_in != 30 || in_sizes[0] != M * D || out_size != M * D || ws_size < WS_END) { fprintf(stderr, "kernel_launch: unexpected shapes (n_in %d, in0 %d, out %d, ws %zu, need %zu)\n", n_in, n_in > 0 ? in_sizes[0] : -1, out_size, ws_size, (size_t)WS_END); grid = -1; return; }
        int dev = 0, cus = 0, per_cu = 0;
        if (hipGetDevice(&dev) != hipSuccess || hipDeviceGetAttribute(&cus, hipDeviceAttributeMultiprocessorCount, dev) != hipSuccess) { grid = -1; return; }
        if (hipFuncSetAttribute((const void*)mk_fwd, hipFuncAttributeMaxDynamicSharedMemorySize, LDS_BYTES) != hipSuccess) { fprintf(stderr, "kernel_launch: hipFuncSetAttribute failed\n"); grid = -1; return; }
        if (hipOccupancyMaxActiveBlocksPerMultiprocessor(&per_cu, (const void*)mk_fwd, NTHR, LDS_BYTES) != hipSuccess || per_cu < 1) fprintf(stderr, "kernel_launch: occupancy query says %d\n", per_cu);
        (void)hipGetLastError();
        grid = cus;
    }
    if (grid < 0) return;
    if (hipMemsetAsync((char*)d_ws + WS_CTL, 0, CTL_ZERO_BYTES, stream) != hipSuccess) return;
    Args a{};
    for (int i = 0; i < 30; ++i) a.in[i] = d_in[i];
    a.out = (float*)d_out; a.ws = (unsigned char*)d_ws;
#if MK_ONE_LAUNCH
    a.ph_lo = 0; a.ph_hi = N_PHASES; a.li = 0;
    hipLaunchKernelGGL(mk_fwd, dim3(grid), dim3(NTHR), LDS_BYTES, stream, a);
#else
    for (int p = 0; p < N_PHASES; ++p) { a.ph_lo = p; a.ph_hi = p + 1; a.li = p; hipLaunchKernelGGL(mk_fwd, dim3(grid), dim3(NTHR), LDS_BYTES, stream, a); }
#endif
}
```

```cpp
#include <hip/hip_runtime.h>
#include <cstdio>
#include <cstdint>
namespace pg8 {
#define PG8_LAS __attribute__((address_space(3)))
typedef unsigned short bf16_t;
typedef short bf16x8 __attribute__((ext_vector_type(8)));
typedef float f32x4 __attribute__((ext_vector_type(4)));
typedef unsigned u32x4 __attribute__((ext_vector_type(4)));
constexpr int BM = 256, BK = 64, HALF = 128, HTB = HALF * BK * 2  , STAGE_BYTES = 8 * HTB, NXCD = 8, WGM = 8;

__host__ __device__ __forceinline__ int lds_byte(int r, int c) { const int st = (r >> 4) * 2 + (c >> 5), rr = r & 15, cc = c & 31, ob = rr * 64 + cc * 2; return st * 1024 + (ob ^ (((ob >> 9) & 1) << 5)); }
__host__ __device__ __forceinline__ void stage_rc(int b, int& R, int& C) { const int st = b / 1024, sb = b % 1024, swz = sb ^ (((sb >> 9) & 1) << 5); R = (st >> 1) * 16 + swz / 64; C = (st & 1) * 32 + (swz % 64) / 2; }
__host__ __device__ __forceinline__ int perm32(int rho) { const int n = rho >> 4, i = rho & 15; return 8 * (i >> 2) + 4 * n + (i & 3); }

struct Unit { int pm, pn; };
struct Gemm { const bf16_t* A; const bf16_t* Bt; int M, N, K; };

struct StaticOrder {
    int nM, nN, nwg, G, c;
    __host__ __device__ void init(int M, int N, int G_, int c_) { nM = M / BM; nN = N / BM; nwg = nM * nN; G = G_; c = c_; }
    __host__ __device__ bool next(int i, Unit& u) const {
        const long L = (long)i * G + c; if (L >= nwg) return false;
        int wgid = (int)L; { const int q = nwg / NXCD, r = nwg % NXCD, xcd = wgid % NXCD, off = wgid / NXCD; wgid = (xcd < r ? xcd * (q + 1) : r * (q + 1) + (xcd - r) * q) + off; }
        const int nig = WGM * nN, gid = wgid / nig, fm = gid * WGM, gsz = (nM - fm) < WGM ? (nM - fm) : WGM;
        u.pm = fm + ((wgid % nig) % gsz); u.pn = (wgid % nig) / gsz; return true;
    }
    __device__ __forceinline__ void a_ready(const Unit&) const {}
    __device__ __forceinline__ void done(const Unit&) const {}
};

__device__ __forceinline__ unsigned cvt_pk_bf16(float lo, float hi) { unsigned r; asm volatile("v_cvt_pk_bf16_f32 %0, %1, %2" : "=v"(r) : "v"(lo), "v"(hi)); return r; }
template <class Epi, class Sched, bool ALIGN_EPI = false, bool SP2 = false>
__device__ __forceinline__ void gemm_phase(PG8_LAS unsigned char* lds, const Gemm g, const Sched& S, const Epi& E) {
    const int tid = threadIdx.x, wid = __builtin_amdgcn_readfirstlane(tid >> 6), lane = tid & 63, wr = wid >> 2, wc = wid & 3, fr = lane & 15, fq = lane >> 4;
    const int K = g.K, nt = K / BK;
    unsigned voffA[2], voffB[2];
#pragma unroll
    for (int i = 0; i < 2; ++i) { int R, C; stage_rc(tid * 16 + i * 8192, R, C); const int Rb = Epi::PERM ? ((R & ~31) + perm32(R & 31)) : R;
        voffA[i] = (unsigned)(R * K + C) * 2u; voffB[i] = (unsigned)(Rb * K + C) * 2u; }
    const size_t kstep = (size_t)(BK * 2);
    const size_t hstep = (size_t)HALF * K * 2;
    const size_t tstep = 2 * hstep;
    const unsigned ldsw = (unsigned)wid * 1024u;
    const int aoff = lds_byte(wr * 64 + fr, fq * 8), boff = lds_byte(wc * 32 + fr, fq * 8);
#define PG8_SA(b, h) (((b) * 2 + (h)) * HTB)
#define PG8_SB(b, h) ((4 + (b) * 2 + (h)) * HTB)
#define PG8_STAGE(bufoff, gbase, voff) do { _Pragma("unroll") for (int _i = 0; _i < 2; ++_i) \
        __builtin_amdgcn_global_load_lds((const unsigned*)((const char*)(gbase) + (voff)[_i]), (PG8_LAS unsigned*)(lds + (bufoff) + ldsw + _i * 8192), 16, 0, 0); } while (0)
#define PG8_LDA(dst, b, h) do { _Pragma("unroll") for (int m = 0; m < 4; ++m) _Pragma("unroll") for (int k = 0; k < 2; ++k) dst[m][k] = *(const PG8_LAS bf16x8*)(lds + PG8_SA(b, h) + aoff + m * 2048 + k * 1024); } while (0)
#define PG8_LDB(dst, b, h) do { _Pragma("unroll") for (int n = 0; n < 2; ++n) _Pragma("unroll") for (int k = 0; k < 2; ++k) dst[n][k] = *(const PG8_LAS bf16x8*)(lds + PG8_SB(b, h) + boff + n * 2048 + k * 1024); } while (0)
#define PG8_MMA(ai, bj, At, Bt) do { __builtin_amdgcn_s_setprio(1); _Pragma("unroll") for (int m = 0; m < 4; ++m) _Pragma("unroll") for (int n = 0; n < 2; ++n) _Pragma("unroll") for (int k = 0; k < 2; ++k) \
        acc[ai][bj][m][n] = __builtin_amdgcn_mfma_f32_16x16x32_bf16(Bt[n][k], At[m][k], acc[ai][bj][m][n], 0, 0, 0); __builtin_amdgcn_s_setprio(0); } while (0)
#define PG8_WAIT_V(n) asm volatile("s_waitcnt vmcnt(" #n ")" ::: "memory")
#define PG8_WAIT_L(n) asm volatile("s_waitcnt lgkmcnt(" #n ")" ::: "memory")
#define PG8_BAR __builtin_amdgcn_s_barrier()
#define PG8_SCHED __builtin_amdgcn_sched_barrier(0)
    Unit cur, nxt; int ui = 0;
    if (!S.next(0, cur)) return;
    f32x4 acc[2][2][4][2];
#pragma unroll
    for (int a = 0; a < 2; ++a)
#pragma unroll
        for (int b = 0; b < 2; ++b)
#pragma unroll
            for (int m = 0; m < 4; ++m)
#pragma unroll
                for (int n = 0; n < 2; ++n) acc[a][b][m][n] = (f32x4){0.f, 0.f, 0.f, 0.f};
    bf16x8 At[4][2], B0[2][2], B1[2][2];
    const char* cA = (const char*)g.A + (size_t)cur.pm * tstep; const char* cB = (const char*)g.Bt + (size_t)cur.pn * tstep;
    S.a_ready(cur);
    if constexpr (SP2) {
        PG8_STAGE(PG8_SB(0, 0), cB, voffB); PG8_STAGE(PG8_SB(0, 1), cB + hstep, voffB); PG8_STAGE(PG8_SA(0, 0), cA, voffA); PG8_STAGE(PG8_SA(0, 1), cA + hstep, voffA);
        if (wr == 1) PG8_BAR;
        PG8_WAIT_V(2); PG8_BAR;
        PG8_STAGE(PG8_SB(1, 0), cB + kstep, voffB); PG8_STAGE(PG8_SA(1, 0), cA + kstep, voffA); PG8_STAGE(PG8_SB(1, 1), cB + hstep + kstep, voffB);
        PG8_WAIT_V(6); PG8_BAR;
    } else {
        PG8_STAGE(PG8_SB(0, 0), cB, voffB); PG8_STAGE(PG8_SA(0, 0), cA, voffA); PG8_STAGE(PG8_SB(0, 1), cB + hstep, voffB); PG8_STAGE(PG8_SA(0, 1), cA + hstep, voffA);
        if (wr == 1) PG8_BAR;
        PG8_WAIT_V(4); PG8_BAR;
        PG8_STAGE(PG8_SB(1, 0), cB + kstep, voffB); PG8_STAGE(PG8_SA(1, 0), cA + kstep, voffA); PG8_STAGE(PG8_SB(1, 1), cB + hstep + kstep, voffB);
        PG8_WAIT_V(6); PG8_BAR;
    }
    for (;;) {
        const bool has_next = S.next(ui + 1, nxt);
        const char* nA = has_next ? (const char*)g.A + (size_t)nxt.pm * tstep : cA; const char* nB = has_next ? (const char*)g.Bt + (size_t)nxt.pn * tstep : cB;
        for (int t = 0; t < nt; t += 2) {
            const bool last = (t == nt - 2);
            const char* a1 = cA + (size_t)(t + 1) * kstep;
            const char* a2 = last ? nA : cA + (size_t)(t + 2) * kstep; const char* b2 = last ? nB : cB + (size_t)(t + 2) * kstep;
            const char* a3 = a2 + kstep; const char* b3 = b2 + kstep;
            if (last && has_next) S.a_ready(nxt);
            if constexpr (SP2) {
            PG8_LDB(B0, 0, 0); PG8_LDB(B1, 0, 1); PG8_SCHED; PG8_LDA(At, 0, 0); PG8_STAGE(PG8_SA(1, 1), a1 + hstep, voffA);
            PG8_WAIT_V(8); PG8_WAIT_L(0); PG8_BAR; PG8_MMA(0, 0, At, B0); PG8_MMA(0, 1, At, B1); PG8_BAR; PG8_SCHED;
            PG8_LDA(At, 0, 1); PG8_STAGE(PG8_SB(0, 0), b2, voffB); PG8_STAGE(PG8_SB(0, 1), b2 + hstep, voffB); PG8_STAGE(PG8_SA(0, 0), a2, voffA);
            PG8_WAIT_V(8); PG8_WAIT_L(0); PG8_BAR; PG8_MMA(1, 0, At, B0); PG8_MMA(1, 1, At, B1); PG8_BAR; PG8_SCHED;
            PG8_LDB(B0, 1, 0); PG8_LDB(B1, 1, 1); PG8_SCHED; PG8_LDA(At, 1, 0); PG8_STAGE(PG8_SA(0, 1), a2 + hstep, voffA);
            PG8_WAIT_V(8); PG8_WAIT_L(0); PG8_BAR; PG8_MMA(0, 0, At, B0); PG8_MMA(0, 1, At, B1); PG8_BAR; PG8_SCHED;
            PG8_LDA(At, 1, 1); PG8_STAGE(PG8_SB(1, 0), b3, voffB); PG8_STAGE(PG8_SB(1, 1), b3 + hstep, voffB); PG8_STAGE(PG8_SA(1, 0), a3, voffA);
            PG8_WAIT_V(8); PG8_WAIT_L(0); PG8_BAR; PG8_MMA(1, 0, At, B0); PG8_MMA(1, 1, At, B1); PG8_BAR; PG8_SCHED;
            } else {
            PG8_LDB(B0, 0, 0); PG8_SCHED; PG8_LDA(At, 0, 0); PG8_STAGE(PG8_SA(1, 1), a1 + hstep, voffA);
            PG8_WAIT_L(8); PG8_BAR; PG8_WAIT_L(0); PG8_MMA(0, 0, At, B0); PG8_BAR; PG8_SCHED;
            PG8_LDB(B1, 0, 1); PG8_STAGE(PG8_SB(0, 0), b2, voffB);
            PG8_BAR; PG8_WAIT_L(0); PG8_MMA(0, 1, At, B1); PG8_BAR;
            PG8_LDA(At, 0, 1); PG8_STAGE(PG8_SA(0, 0), a2, voffA);
            PG8_BAR; PG8_WAIT_L(0); PG8_MMA(1, 0, At, B0); PG8_BAR; PG8_SCHED;
            PG8_STAGE(PG8_SB(0, 1), b2 + hstep, voffB);
            PG8_WAIT_V(6); PG8_BAR; PG8_MMA(1, 1, At, B1); PG8_BAR;
            PG8_LDB(B0, 1, 0); PG8_SCHED; PG8_LDA(At, 1, 0); PG8_STAGE(PG8_SA(0, 1), a2 + hstep, voffA);
            PG8_WAIT_L(8); PG8_BAR; PG8_WAIT_L(0); PG8_MMA(0, 0, At, B0); PG8_BAR; PG8_SCHED;
            PG8_LDB(B1, 1, 1); PG8_STAGE(PG8_SB(1, 0), b3, voffB);
            PG8_BAR; PG8_WAIT_L(0); PG8_MMA(0, 1, At, B1); PG8_BAR;
            PG8_LDA(At, 1, 1); PG8_STAGE(PG8_SA(1, 0), a3, voffA);
            PG8_BAR; PG8_WAIT_L(0); PG8_MMA(1, 0, At, B0); PG8_BAR; PG8_SCHED;
            PG8_STAGE(PG8_SB(1, 1), b3 + hstep, voffB);
            PG8_WAIT_V(6); PG8_BAR; PG8_MMA(1, 1, At, B1); PG8_BAR;
            }
        }
        if constexpr (ALIGN_EPI) { if (wr == 0) PG8_BAR; }
        if constexpr (!Epi::AFTER_DRAIN) { E(acc, cur, wr, wc, fr, fq); S.done(cur); }
        if (!has_next) break;
#pragma unroll
        for (int a = 0; a < 2; ++a)
#pragma unroll
            for (int b = 0; b < 2; ++b)
#pragma unroll
                for (int m = 0; m < 4; ++m)
#pragma unroll
                    for (int n = 0; n < 2; ++n) acc[a][b][m][n] = (f32x4){0.f, 0.f, 0.f, 0.f};
        cur = nxt; cA = nA; cB = nB; ++ui;
        if constexpr (ALIGN_EPI) { if (wr == 1) PG8_BAR; }
    }
    PG8_WAIT_V(0);
    if constexpr (!ALIGN_EPI) { if (wr == 0) PG8_BAR; }
    PG8_BAR;
    if constexpr (Epi::AFTER_DRAIN) { E.fused(acc, cur, wr, wc, fr, fq, lds, wid, lane); S.done(cur); }
#undef PG8_SA
#undef PG8_SB
#undef PG8_STAGE
#undef PG8_LDA
#undef PG8_LDB
#undef PG8_MMA
#undef PG8_WAIT_V
#undef PG8_WAIT_L
#undef PG8_BAR
#undef PG8_SCHED
}
}

#ifndef PG8_SP2
#define PG8_SP2 true
#endif
#ifndef PG8_ALIGN
#define PG8_ALIGN true
#endif
#ifndef MK_ONE_LAUNCH
#define MK_ONE_LAUNCH 1
#endif

constexpr int NWAVES = 8, NTHR = 512;
constexpr int BATCH = 8, T = 4096, D = 1024, M = BATCH * T, DEPTH = 2;
constexpr int PROJW = 2304, AW = 256, BW = 512, CW = 256, NH = 8, HD = 64;
constexpr int COL_U = 0, COL_V = 256, COL_Q = 512, COL_K = 1024, COL_VA = 1536, COL_S = 2048;
constexpr int NEXP = 16, DEXP = 512, NGRP = 4;
constexpr int SSM_G = 16, SSM_N = 64, SSM_C = 16;
constexpr float LN_EPS = 1e-5f;
constexpr float ALPHA = 1.41421356237309515f;
constexpr float QSCALE = 0.125f * 1.4426950408889634f;
constexpr int NSLOT_MAX = 2 * M + NEXP * 256;

constexpr size_t MiB = 1u << 20;
constexpr size_t WS_CTL = 0, CTL_ZERO_BYTES = 1 * MiB;
constexpr size_t WS_MOD = 1 * MiB;
constexpr size_t WS_ROPE = WS_MOD + 512 * 1024;
constexpr size_t WS_SSM = WS_ROPE + 2 * MiB;
constexpr int SSM_TAB = 2 * 1024 + 2 * 16384;
constexpr size_t WS_TOKE = 4 * MiB;
constexpr size_t WS_TOKG = WS_TOKE + 256 * 1024;
constexpr size_t WS_SLOT_TOK = WS_TOKG + 256 * 1024;
constexpr size_t WS_SLOT_DEST = WS_SLOT_TOK + 512 * 1024;
constexpr size_t WS_SLOT_W = WS_SLOT_DEST + 512 * 1024;
constexpr size_t WS_WSMALL = 6 * MiB;
constexpr size_t WSMALL_LAYER = 7 * MiB, WOFF_IN = 0, WOFF_OUT = (size_t)PROJW * D * 2, WOFF_GLU = WOFF_OUT + (size_t)D * D * 2;
constexpr size_t WS_WGU = 20 * MiB;
constexpr size_t WS_WD = 52 * MiB;
constexpr size_t WS_XN = 68 * MiB;
constexpr size_t WS_YG = 132 * MiB;
constexpr size_t WS_R = 148 * MiB;
constexpr size_t WS_PROJ = WS_R, WS_MIXCAT = WS_R + 144 * MiB, WS_PRE = WS_R, WS_HID = WS_R + 64 * MiB, WS_X1 = WS_R + 132 * MiB;
constexpr size_t WS_ROWS2 = 356 * MiB;
constexpr size_t WS_STAT = 356 * MiB + (size_t)NSLOT_MAX * D * 2;
constexpr size_t WS_SSM2 = WS_STAT + 4 * MiB;
constexpr size_t SSM2_LAYER = 3 * MiB, S2_APW = 0, S2_KT = 288 * 1024, S2_CT = S2_KT + 256 * 1024, S2_WIN = S2_CT + 64 * 1024, S2_GW = S2_WIN + 2 * MiB;
static_assert(S2_GW + 4 * 128 * 128 * 2 <= SSM2_LAYER, "ssm2 tables");
constexpr size_t WS_XLOC = WS_SSM2 + 2 * SSM2_LAYER;
constexpr size_t WS_XSUP = WS_XLOC + 8 * MiB;
constexpr size_t WS_END = WS_XSUP + 512 * 1024;
static_assert(WOFF_GLU + 256 * 256 * 2 <= WSMALL_LAYER && WS_WSMALL + 2 * WSMALL_LAYER <= WS_WGU, "ws map");
static_assert(WS_SSM + 2 * SSM_TAB * 4 <= WS_TOKE && WS_HID + (size_t)NSLOT_MAX * DEXP * 2 <= WS_X1 && WS_X1 + (size_t)M * D * 2 <= WS_ROWS2, "ws map 2");
constexpr int CW_TMO = 0;
constexpr int CW_BAR = 4096;
constexpr int CW_CNT = 8192;

constexpr int RING_OFF = 0, RING_BYTES = 131072;
constexpr int LDSCTL_OFF = RING_BYTES, MISC_OFF = LDSCTL_OFF + 320;
constexpr int LDS_BYTES = 147456;

#define GAS __attribute__((address_space(1)))
#define LAS __attribute__((address_space(3)))
#define DI __device__ __forceinline__
typedef unsigned short bf16;
typedef unsigned v4u __attribute__((ext_vector_type(4)));
typedef unsigned v2u __attribute__((ext_vector_type(2)));
typedef float f32x4 __attribute__((ext_vector_type(4)));
typedef short bf16x8 __attribute__((ext_vector_type(8)));
typedef GAS unsigned gu32;
#define RLX_AGENT __ATOMIC_RELAXED, __HIP_MEMORY_SCOPE_AGENT
#define LDS_WAIT() asm volatile("s_waitcnt lgkmcnt(0)" ::: "memory")
#define VM_WAIT() asm volatile("s_waitcnt vmcnt(0)" ::: "memory")
DI unsigned f2bf(float f) { unsigned u = __builtin_bit_cast(unsigned, f); return (u + 0x7fffu + ((u >> 16) & 1u)) >> 16; }
DI unsigned pk2(float lo, float hi) { return f2bf(lo) | (f2bf(hi) << 16); }
DI float bflo(unsigned w) { return __uint_as_float(w << 16); }
DI float bfhi(unsigned w) { return __uint_as_float(w & 0xffff0000u); }
DI float bf2f(bf16 h) { return __uint_as_float((unsigned)h << 16); }
DI float wave_sum(float v) {
#pragma unroll
    for (int o = 1; o < 64; o <<= 1) v += __shfl_xor(v, o);
    return v;
}
DI float fast_rcp(float x) { return __builtin_amdgcn_rcpf(x); }
DI float sigmoid_f(float x) { return fast_rcp(1.0f + __builtin_amdgcn_exp2f(-1.4426950408889634f * x)); }
DI float silu_f(float x) { return x * sigmoid_f(x); }
DI float gelu_tanh_f(float x) { const float z2 = 1.5957691216057308f * (x + 0.044715f * x * x * x); return x * sigmoid_f(z2); }

#define XB_TMO      128
#define XB_XCNT(j)  (256  + 64 * (j))
#define XB_XSUB(j)  (1280 + 64 * (j))
#define XB_XGEN(j)  (2304 + 64 * (j))
#define XB_TOP      3328
#define XB_TOPGEN   3392
#define XCD_BAR_WORDS 3456
#define XB_SPIN_CAP (1u << 22)
DI unsigned xb_ld(unsigned* p)              { return __hip_atomic_load(p, __ATOMIC_RELAXED, __HIP_MEMORY_SCOPE_AGENT); }
DI unsigned xb_add(unsigned* p, unsigned v) { return __hip_atomic_fetch_add(p, v, __ATOMIC_RELAXED, __HIP_MEMORY_SCOPE_AGENT); }
DI unsigned xb_xcc_id() { return (unsigned)__builtin_amdgcn_s_getreg((3 << 11) | 20) & 0xFu; }
#define XB_SPIN(cond, bar) do { unsigned _sp = 0; while (cond) { __builtin_amdgcn_s_sleep(1); \
    if ((++_sp & 255u) == 0u) { if (xb_ld(&(bar)[XB_TMO])) break; if (_sp > XB_SPIN_CAP) { atomicAdd(&(bar)[XB_TMO], 1u); break; } } } } while (0)
struct XcdBarrier { unsigned* bar; unsigned x; volatile LAS unsigned* st; };
DI XcdBarrier xcd_barrier_post(unsigned* bar, volatile LAS unsigned* st) {
    XcdBarrier b; b.bar = bar; b.x = xb_xcc_id(); b.st = st;
    if (threadIdx.x == 0) (void)xb_add(&bar[XB_XCNT(b.x)], 1u);
    return b;
}
DI void xcd_barrier_complete(unsigned* bar, unsigned x, unsigned& nloc, unsigned& nx) {
    const unsigned G = gridDim.x * gridDim.y * gridDim.z;
    unsigned sum, cnt, mine, sp = 0u;
    for (;;) {
        sum = 0u; cnt = 0u; mine = 0u;
#pragma unroll
        for (unsigned j = 0; j < 16; ++j) { const unsigned c = xb_ld(&bar[XB_XCNT(j)]); sum += c; cnt += (c > 0u) ? 1u : 0u; mine = (j == x) ? c : mine; }
        if (sum == G) break;
        __builtin_amdgcn_s_sleep(1);
        if ((++sp & 255u) == 0u) { if (xb_ld(&bar[XB_TMO])) break; if (sp > XB_SPIN_CAP) { atomicAdd(&bar[XB_TMO], 1u); break; } }
    }
    nloc = mine > 0u ? mine : 1u; nx = cnt > 0u ? cnt : 1u;
}
DI void xcd_barrier(const XcdBarrier& b) {
    asm volatile("s_waitcnt vmcnt(0)" ::: "memory");
    __syncthreads();
    if (threadIdx.x == 0) {
        unsigned* bar = b.bar;
        __builtin_amdgcn_s_waitcnt(0);
        unsigned nloc = b.st[0], nx = b.st[1];
        if (nloc == 0u) { xcd_barrier_complete(bar, b.x, nloc, nx); b.st[0] = nloc; b.st[1] = nx; }
        const unsigned old = xb_add(&bar[XB_XSUB(b.x)], 1u);
        const unsigned gen = old / nloc;
        if (old + 1u == (gen + 1u) * nloc) {
            __builtin_amdgcn_fence(__ATOMIC_RELEASE, "agent");
            asm volatile("s_waitcnt vmcnt(0)" ::: "memory");
            const unsigned og = xb_add(&bar[XB_TOP], 1u);
            const unsigned tg = og / nx;
            if (og + 1u == (tg + 1u) * nx) xb_add(&bar[XB_TOPGEN], 1u);
            else XB_SPIN(xb_ld(&bar[XB_TOPGEN]) == tg, bar);
            __builtin_amdgcn_fence(__ATOMIC_ACQUIRE, "agent");
            xb_add(&bar[XB_XGEN(b.x)], 1u);
            asm volatile("s_waitcnt vmcnt(0)" ::: "memory");
        } else {
            XB_SPIN(xb_ld(&bar[XB_XGEN(b.x)]) == gen, bar);
            __builtin_amdgcn_fence(__ATOMIC_ACQUIRE, "agent");
            asm volatile("s_waitcnt vmcnt(0)" ::: "memory");
        }
    }
    __syncthreads();
}

struct Args { const void* in[30]; float* out; unsigned char* ws; int ph_lo, ph_hi, li, pad; };
enum { I_X = 0, I_C, I_POS, I_ADAW, I_ADAB, I_WIN, I_GMLNG, I_GMLNB, I_GMWS, I_GMBS, I_LAMRE, I_LAMIM, I_LOGDT, I_BRE, I_BIM, I_CRE, I_CIM, I_SSMD,
       I_GLUW, I_GLUB, I_WOUT, I_LN1G, I_LN1B, I_RW, I_RB, I_EWG, I_EWU, I_EWD, I_LN2G, I_LN2B };
struct Frame {
    LAS unsigned char* lds;
    volatile LAS unsigned* MISC;
    gu32* ctl;
    unsigned char* ws;
    int vcu, G;
};
DI int ftid() { int t = threadIdx.x; asm volatile("" : "+v"(t)); return t; }
#define FRAME_IDS const int tid_ = ftid(), lane_ = tid_ & 63, wave_ = __builtin_amdgcn_readfirstlane(tid_ >> 6); (void)lane_; (void)wave_;

template <class RowMap>
DI void transpose_item(const float* W, int K, int N, bf16* WT, const RowMap& rm, LAS float* scr, int item, int lane) {
    const int nblk = N / 32, kb = item / nblk, nb = item % nblk, k0 = 64 * kb, n0 = 32 * nb;
#pragma unroll 8
    for (int i = 0; i < 32; ++i) { const int kk = 2 * i + (lane >> 5); scr[kk * 33 + (lane & 31)] = W[(size_t)(k0 + kk) * N + n0 + (lane & 31)]; }
    LDS_WAIT(); asm volatile("" ::: "memory");
    const int c = lane & 7;
#pragma unroll
    for (int j = 0; j < 4; ++j) { const int n = (lane >> 3) + 8 * j; const LAS float* s = scr + (8 * c) * 33 + n;
        v4u o; o.x = pk2(s[0 * 33], s[1 * 33]); o.y = pk2(s[2 * 33], s[3 * 33]); o.z = pk2(s[4 * 33], s[5 * 33]); o.w = pk2(s[6 * 33], s[7 * 33]);
        *(GAS v4u*)(WT + (size_t)rm(n0 + n) * K + k0 + 8 * c) = o; }
    LDS_WAIT(); asm volatile("" ::: "memory");
}
struct RmIdent { int off; DI int operator()(int n) const { return off + n; } };
struct RmWin { DI int operator()(int n) const {
        if (n >= COL_Q && n < COL_VA) { const int d = n & 63; if (d < 16) return (n - d) + 2 * (d & 7) + (d >> 3); }
        return n; } };
struct RmGU { int e, up; DI int operator()(int n) const { return e * 1024 + (n >> 7) * 256 + (n & 127) + up * 128; } };

DI void p0_tables(Frame& F, const Args& A) {
    FRAME_IDS
    const float* c = (const float*)A.in[I_C];
    LAS float* condS = (LAS float*)(F.lds + RING_OFF);
    LAS float* red = (LAS float*)(F.lds + RING_OFF + 32768);
    for (int i = tid_; i < BATCH * D; i += NTHR) condS[i] = silu_f(c[i]);
    __syncthreads();
    float* mod = (float*)(F.ws + WS_MOD);
    for (int it = F.vcu; it < DEPTH * 96; it += F.G) {
        const int l = it / 96, jb = it % 96, ks = tid_ >> 6, jj = tid_ & 63, j = jb * 64 + jj;
        const float* w = (const float*)A.in[I_ADAW] + (size_t)l * D * 6 * D + j;
        float acc[8];
#pragma unroll
        for (int b = 0; b < 8; ++b) acc[b] = 0.f;
        for (int k = ks * 128; k < ks * 128 + 128; ++k) { const float wv = w[(size_t)k * (6 * D)];
#pragma unroll
            for (int b = 0; b < 8; ++b) acc[b] += condS[b * D + k] * wv; }
#pragma unroll
        for (int b = 0; b < 8; ++b) red[(ks * 8 + b) * 64 + jj] = acc[b];
        __syncthreads();
        { const int b = tid_ >> 6; float s = ((const float*)A.in[I_ADAB])[l * 6 * D + j];
#pragma unroll
          for (int k2 = 0; k2 < 8; ++k2) s += red[(k2 * 8 + b) * 64 + jj];
          mod[((size_t)l * BATCH + b) * 6 * D + j] = s; }
        __syncthreads();
    }
    const int gt = F.vcu * NTHR + tid_, NGT = F.G * NTHR;
    const int* pos = (const int*)A.in[I_POS]; float* rope = (float*)(F.ws + WS_ROPE);
    for (int w = gt; w < M * 8; w += NGT) { const int m = w >> 3, i = w & 7;
        const float freq = exp2f(-(float)i * 0.125f * 18.931568569324174f);
        const float ang = (float)pos[m] * freq; float s, cs; sincosf(ang, &s, &cs);
        rope[m * 16 + i] = cs; rope[m * 16 + 8 + i] = s; }
    for (int w = gt; w < DEPTH * 16 * 33 * 64; w += NGT) { const int n = w & 63, m = (w >> 6) % 33, g = ((w >> 6) / 33) & 15, l = (w >> 6) / (33 * 16);
        const int li = (l * 16 + g) * 64 + n;
        const float lre = ((const float*)A.in[I_LAMRE])[li], lim = ((const float*)A.in[I_LAMIM])[li], dt = expf(((const float*)A.in[I_LOGDT])[l * 16 + g]);
        const float mag = expf((float)m * (lre * dt)); float sn, cs; sincosf((float)m * (lim * dt), &sn, &cs);
        float* apw = (float*)(F.ws + WS_SSM2 + l * SSM2_LAYER + S2_APW) + ((size_t)(g * 33 + m) * 64 + n) * 2; apw[0] = mag * cs; apw[1] = mag * sn; }
    for (int w = gt; w < DEPTH * SSM_G * SSM_N; w += NGT) { const int l = w / 1024, gn = w % 1024, g = gn >> 6;
        float* tab = (float*)(F.ws + WS_SSM) + (size_t)l * SSM_TAB;
        const float lre = ((const float*)A.in[I_LAMRE])[w], lim = ((const float*)A.in[I_LAMIM])[w];
        const float dt = expf(((const float*)A.in[I_LOGDT])[l * 16 + g]);
        const float mag = expf(lre * dt); float sn, cs; sincosf(lim * dt, &sn, &cs);
        const float are = mag * cs, aim = mag * sn, nr = are - 1.0f, ni = aim, mod2 = lre * lre + lim * lim;
        const float fre = (nr * lre + ni * lim) / mod2, fim = (ni * lre - nr * lim) / mod2;
        tab[gn] = are; tab[1024 + gn] = aim;
        const float* bre = (const float*)A.in[I_BRE] + (size_t)w * 16; const float* bim = (const float*)A.in[I_BIM] + (size_t)w * 16;
#pragma unroll
        for (int cc = 0; cc < 16; ++cc) { tab[2048 + gn * 16 + cc] = fre * bre[cc] - fim * bim[cc]; tab[2048 + 16384 + gn * 16 + cc] = fre * bim[cc] + fim * bre[cc]; } }
}

DI void p_wconv(Frame& F, const Args& A, int l) {
    FRAME_IDS
    {
        const int gt = F.vcu * NTHR + tid_, NGT = F.G * NTHR;
        const float* tab = (const float*)(F.ws + WS_SSM) + (size_t)l * SSM_TAB;
        const float* apw = (const float*)(F.ws + WS_SSM2 + l * SSM2_LAYER + S2_APW);
        const float* cre = (const float*)A.in[I_CRE] + (size_t)l * 16 * 16 * 64; const float* cim = (const float*)A.in[I_CIM] + (size_t)l * 16 * 16 * 64;
        bf16* KT = (bf16*)(F.ws + WS_SSM2 + l * SSM2_LAYER + S2_KT); bf16* CT = (bf16*)(F.ws + WS_SSM2 + l * SSM2_LAYER + S2_CT);
        bf16* WIN = (bf16*)(F.ws + WS_SSM2 + l * SSM2_LAYER + S2_WIN); bf16* GW = (bf16*)(F.ws + WS_SSM2 + l * SSM2_LAYER + S2_GW);
        for (int w = gt; w < 16 * 16 * 64 * 8; w += NGT) { const int j = w & 7, ln = (w >> 3) & 63, p = (w >> 9) & 15, g = w >> 13;
            const int co = ln & 15, q = ln >> 4, m = 2 * p + (q >> 1), ci = 8 * (q & 1) + j; float acc = 0.f;
            for (int n = 0; n < 64; ++n) { const int gn = g * 64 + n; const float ar = apw[((g * 33 + m) * 64 + n) * 2], ai = apw[((g * 33 + m) * 64 + n) * 2 + 1];
                const float br = tab[2048 + gn * 16 + ci], bi = tab[2048 + 16384 + gn * 16 + ci], tre = ar * br - ai * bi, tim = ar * bi + ai * br;
                acc += cre[(g * 16 + co) * 64 + n] * tre - cim[(g * 16 + co) * 64 + n] * tim; }
            KT[w] = (bf16)f2bf(acc); }
        for (int w = gt; w < 16 * 4 * 64 * 8; w += NGT) { const int j = w & 7, ln = (w >> 3) & 63, sx = (w >> 9) & 3, g = w >> 11;
            const int co = ln & 15, q = ln >> 4, n = 16 * sx + 4 * q + (j >> 1);
            CT[w] = (bf16)f2bf((j & 1) ? -cim[(g * 16 + co) * 64 + n] : cre[(g * 16 + co) * 64 + n]); }
        for (int w = gt; w < 16 * 16 * 8 * 64 * 8; w += NGT) { const int jj = w & 7, ln = (w >> 3) & 63, ct = (w >> 9) & 7, sp = (w >> 12) & 15, g = w >> 16;
            const int cc = ln & 15, q = ln >> 4, n = 8 * ct + (cc >> 1), part = cc & 1, tj = 2 * sp + (q >> 1), ci = 8 * (q & 1) + jj, gn = g * 64 + n, m = 31 - tj;
            const float ar = apw[((g * 33 + m) * 64 + n) * 2], ai = apw[((g * 33 + m) * 64 + n) * 2 + 1], br = tab[2048 + gn * 16 + ci], bi = tab[2048 + 16384 + gn * 16 + ci];
            WIN[w] = (bf16)f2bf(part ? (ar * bi + ai * br) : (ar * br - ai * bi)); }
        const float* gws = (const float*)A.in[I_GMWS] + (size_t)l * 4 * 128 * 128;
        for (int w = gt; w < 4 * 128 * 128; w += NGT) { const int sx = w & 127, t = (w >> 7) & 127; GW[w] = (bf16)f2bf(sx <= t ? gws[w] : 0.f); }
    }
    LAS float* scr = (LAS float*)(F.lds + RING_OFF + wave_ * 16384);
    const int gw = F.vcu * NWAVES + wave_, NGW = F.G * NWAVES;
    bf16* WinT = (bf16*)(F.ws + WS_WSMALL + l * WSMALL_LAYER + WOFF_IN);
    bf16* WoutT = (bf16*)(F.ws + WS_WSMALL + l * WSMALL_LAYER + WOFF_OUT);
    bf16* GluT = (bf16*)(F.ws + WS_WSMALL + l * WSMALL_LAYER + WOFF_GLU);
    bf16* WguT = (bf16*)(F.ws + WS_WGU); bf16* WdT = (bf16*)(F.ws + WS_WD);
    constexpr int I_IN = 16 * 72, I_OUTW = 16 * 32, I_GLU = 4 * 8, I_G = 16 * 16, I_DN = 8 * 32;
    constexpr int NIT = I_IN + I_OUTW + I_GLU + 16 * (2 * I_G + I_DN);
    for (int it = gw; it < NIT; it += NGW) {
        int r = it;
        if (r < I_IN) { transpose_item((const float*)A.in[I_WIN] + (size_t)l * D * PROJW, D, PROJW, WinT, RmWin{}, scr, r, lane_); continue; } r -= I_IN;
        if (r < I_OUTW) { transpose_item((const float*)A.in[I_WOUT] + (size_t)l * D * D, D, D, WoutT, RmIdent{0}, scr, r, lane_); continue; } r -= I_OUTW;
        if (r < I_GLU) { transpose_item((const float*)A.in[I_GLUW] + (size_t)l * 256 * 256, 256, 256, GluT, RmIdent{0}, scr, r, lane_); continue; } r -= I_GLU;
        const int e = r / (2 * I_G + I_DN); r -= e * (2 * I_G + I_DN);
        const size_t eo = ((size_t)l * NEXP + e) * D * DEXP;
        if (r < I_G) { transpose_item((const float*)A.in[I_EWG] + eo, D, DEXP, WguT, RmGU{e, 0}, scr, r, lane_); continue; } r -= I_G;
        if (r < I_G) { transpose_item((const float*)A.in[I_EWU] + eo, D, DEXP, WguT, RmGU{e, 1}, scr, r, lane_); continue; } r -= I_G;
        transpose_item((const float*)A.in[I_EWD] + eo, DEXP, D, WdT, RmIdent{e * 1024}, scr, r, lane_);
    }
}

struct Row16 { float v[16]; };
DI void row_load_f32(Row16& r, const float* p, int lane) {
    const f32x4* q = (const f32x4*)p;
#pragma unroll
    for (int s = 0; s < 2; ++s) { const f32x4 a = q[s * 128 + 2 * lane], b = q[s * 128 + 2 * lane + 1];
        r.v[8 * s + 0] = a.x; r.v[8 * s + 1] = a.y; r.v[8 * s + 2] = a.z; r.v[8 * s + 3] = a.w; r.v[8 * s + 4] = b.x; r.v[8 * s + 5] = b.y; r.v[8 * s + 6] = b.z; r.v[8 * s + 7] = b.w; }
}
DI void row_load_bf16(Row16& r, const bf16* p, int lane) {
    const v4u* q = (const v4u*)p;
#pragma unroll
    for (int s = 0; s < 2; ++s) { const v4u a = q[s * 64 + lane];
        r.v[8 * s + 0] = bflo(a.x); r.v[8 * s + 1] = bfhi(a.x); r.v[8 * s + 2] = bflo(a.y); r.v[8 * s + 3] = bfhi(a.y);
        r.v[8 * s + 4] = bflo(a.z); r.v[8 * s + 5] = bfhi(a.z); r.v[8 * s + 6] = bflo(a.w); r.v[8 * s + 7] = bfhi(a.w); }
}
DI void row_store_bf16(const Row16& r, bf16* p, int lane) {
    v4u* q = (v4u*)p;
#pragma unroll
    for (int s = 0; s < 2; ++s) { v4u o; o.x = pk2(r.v[8 * s], r.v[8 * s + 1]); o.y = pk2(r.v[8 * s + 2], r.v[8 * s + 3]); o.z = pk2(r.v[8 * s + 4], r.v[8 * s + 5]); o.w = pk2(r.v[8 * s + 6], r.v[8 * s + 7]);
        q[s * 64 + lane] = o; }
}
DI void row_store_f32(const Row16& r, float* p, int lane) {
    f32x4* q = (f32x4*)p;
#pragma unroll
    for (int s = 0; s < 2; ++s) { q[s * 128 + 2 * lane] = (f32x4){r.v[8 * s], r.v[8 * s + 1], r.v[8 * s + 2], r.v[8 * s + 3]}; q[s * 128 + 2 * lane + 1] = (f32x4){r.v[8 * s + 4], r.v[8 * s + 5], r.v[8 * s + 6], r.v[8 * s + 7]}; }
}
DI void row_ln(Row16& r) {
    float s = 0.f;
#pragma unroll
    for (int i = 0; i < 16; ++i) s += r.v[i];
    const float mean = wave_sum(s) * (1.f / D); float s2 = 0.f;
#pragma unroll
    for (int i = 0; i < 16; ++i) { r.v[i] -= mean; s2 += r.v[i] * r.v[i]; }
    const float rstd = 1.0f / sqrtf(wave_sum(s2) * (1.f / D) + LN_EPS);
#pragma unroll
    for (int i = 0; i < 16; ++i) r.v[i] *= rstd;
}
DI void row_mod(Row16& r, const float* a, const float* b, int lane) {
    Row16 av, bv; row_load_f32(av, a, lane); row_load_f32(bv, b, lane);
#pragma unroll
    for (int i = 0; i < 16; ++i) r.v[i] = r.v[i] * (1.0f + av.v[i]) + bv.v[i];
}
DI void row_affine(Row16& r, const float* g, const float* b, int lane) {
    Row16 av, bv; row_load_f32(av, g, lane); row_load_f32(bv, b, lane);
#pragma unroll
    for (int i = 0; i < 16; ++i) r.v[i] = r.v[i] * av.v[i] + bv.v[i];
}

DI void p_ln_a0(Frame& F, const Args& A) {
    FRAME_IDS
    const int gw = F.vcu * NWAVES + wave_, NGW = F.G * NWAVES;
    const float* x = (const float*)A.in[I_X]; bf16* XN = (bf16*)(F.ws + WS_XN); const float* mod = (const float*)(F.ws + WS_MOD);
    for (int m = gw; m < M; m += NGW) { const int b = m / T; const float* md = mod + (size_t)b * 6 * D;
        Row16 r; row_load_f32(r, x + (size_t)m * D, lane_); row_ln(r); row_mod(r, md + 1 * D, md + 0 * D, lane_); row_store_bf16(r, XN + (size_t)m * D, lane_); }
}

using pg8::Unit; using pg8::BM; using pg8::HALF;
struct EpiInProj {
    static constexpr bool PERM = true, AFTER_DRAIN = false;
    bf16* P; const float* rope;
    DI void operator()(const pg8::f32x4 (&acc)[2][2][4][2], const Unit& u, int wr, int wc, int fr, int fq) const {
        const int row0 = u.pm * BM + wr * 64 + fr, pn = u.pn;
        const bool isrope = (pn >= 2 && pn <= 5), dorope = isrope && ((wc & 1) == 0) && (fq < 2);
        const float sc = (pn == 2 || pn == 3) ? QSCALE : 1.0f;
#pragma unroll
        for (int ai = 0; ai < 2; ++ai)
#pragma unroll
            for (int m = 0; m < 4; ++m) { const int row = row0 + ai * HALF + m * 16; bf16* rowp = P + (size_t)row * PROJW + pn * BM + wc * 32 + 8 * fq;
                f32x4 cs = (f32x4){1.f, 1.f, 1.f, 1.f}, sn = (f32x4){0.f, 0.f, 0.f, 0.f};
                if (isrope) { const float* rp = rope + (size_t)row * 16 + 4 * (fq & 1); cs = *(const f32x4*)rp; sn = *(const f32x4*)(rp + 8); }
#pragma unroll
                for (int bj = 0; bj < 2; ++bj) { pg8::f32x4 v0 = acc[ai][bj][m][0], v1 = acc[ai][bj][m][1];
                    if (pn < 2) {
#pragma unroll
                        for (int i = 0; i < 4; ++i) { v0[i] = gelu_tanh_f(v0[i]); v1[i] = gelu_tanh_f(v1[i]); }
                    } else if (isrope) {
                        if (dorope) { const float a0 = v0[0] * cs.x - v0[1] * sn.x, b0 = v0[1] * cs.x + v0[0] * sn.x, a1 = v0[2] * cs.y - v0[3] * sn.y, b1 = v0[3] * cs.y + v0[2] * sn.y;
                            const float a2 = v1[0] * cs.z - v1[1] * sn.z, b2 = v1[1] * cs.z + v1[0] * sn.z, a3 = v1[2] * cs.w - v1[3] * sn.w, b3 = v1[3] * cs.w + v1[2] * sn.w;
                            v0 = (pg8::f32x4){a0, b0, a1, b1}; v1 = (pg8::f32x4){a2, b2, a3, b3}; }
                        v0 = v0 * sc; v1 = v1 * sc;
                    }
                    pg8::u32x4 w; w.x = pg8::cvt_pk_bf16(v0[0], v0[1]); w.y = pg8::cvt_pk_bf16(v0[2], v0[3]); w.z = pg8::cvt_pk_bf16(v1[0], v1[1]); w.w = pg8::cvt_pk_bf16(v1[2], v1[3]);
                    *(pg8::u32x4*)(rowp + bj * HALF) = w; } }
    }
};
template <bool XF32> struct EpiOut {
    static constexpr bool PERM = true, AFTER_DRAIN = false;
    bf16* PRE; const void* x; int xpitch; const float* mod;
    DI void operator()(const pg8::f32x4 (&acc)[2][2][4][2], const Unit& u, int wr, int wc, int fr, int fq) const {
        const int row0 = u.pm * BM + wr * 64 + fr, b = (u.pm * BM) / T, colb = u.pn * BM + wc * 32 + 8 * fq;
        const float* g1 = mod + (size_t)b * 6 * D + 2 * D;
        pg8::f32x4 gv[2][2];
#pragma unroll
        for (int bj = 0; bj < 2; ++bj) { gv[bj][0] = *(const pg8::f32x4*)(g1 + colb + bj * HALF) + 1.0f; gv[bj][1] = *(const pg8::f32x4*)(g1 + colb + bj * HALF + 4) + 1.0f; }
#pragma unroll
        for (int ai = 0; ai < 2; ++ai)
#pragma unroll
            for (int m = 0; m < 4; ++m) { const int row = row0 + ai * HALF + m * 16;
#pragma unroll
                for (int bj = 0; bj < 2; ++bj) { const int col = colb + bj * HALF; pg8::f32x4 x0, x1;
                    if (XF32) { const float* xp = (const float*)x + (size_t)row * xpitch + col; x0 = *(const pg8::f32x4*)xp; x1 = *(const pg8::f32x4*)(xp + 4); }
                    else { const pg8::u32x4 xw = *(const pg8::u32x4*)((const bf16*)x + (size_t)row * xpitch + col);
                        x0 = (pg8::f32x4){bflo(xw.x), bfhi(xw.x), bflo(xw.y), bfhi(xw.y)}; x1 = (pg8::f32x4){bflo(xw.z), bfhi(xw.z), bflo(xw.w), bfhi(xw.w)}; }
                    const pg8::f32x4 v0 = x0 * ALPHA + gv[bj][0] * acc[ai][bj][m][0], v1 = x1 * ALPHA + gv[bj][1] * acc[ai][bj][m][1];
                    pg8::u32x4 w; w.x = pg8::cvt_pk_bf16(v0[0], v0[1]); w.y = pg8::cvt_pk_bf16(v0[2], v0[3]); w.z = pg8::cvt_pk_bf16(v1[0], v1[1]); w.w = pg8::cvt_pk_bf16(v1[2], v1[3]);
                    *(pg8::u32x4*)(PRE + (size_t)row * D + col) = w; } }
    }
};
struct EpiGlu {
    static constexpr bool PERM = true, AFTER_DRAIN = false;
    const bf16* YG; bf16* MIX; const float* gb;
    DI void operator()(const pg8::f32x4 (&acc)[2][2][4][2], const Unit& u, int wr, int wc, int fr, int fq) const {
        const int row0 = u.pm * BM + wr * 64 + fr, colb = wc * 32 + 8 * fq;
#pragma unroll
        for (int ai = 0; ai < 2; ++ai)
#pragma unroll
            for (int m = 0; m < 4; ++m) { const int row = row0 + ai * HALF + m * 16;
#pragma unroll
                for (int bj = 0; bj < 2; ++bj) { const int col = colb + bj * HALF;
                    const pg8::u32x4 yw = *(const pg8::u32x4*)(YG + (size_t)row * 256 + col);
                    const pg8::f32x4 b0 = *(const pg8::f32x4*)(gb + col), b1 = *(const pg8::f32x4*)(gb + col + 4);
                    const pg8::f32x4 a0 = acc[ai][bj][m][0] + b0, a1 = acc[ai][bj][m][1] + b1;
                    const float y[8] = {bflo(yw.x), bfhi(yw.x), bflo(yw.y), bfhi(yw.y), bflo(yw.z), bfhi(yw.z), bflo(yw.w), bfhi(yw.w)};
                    float o[8];
#pragma unroll
                    for (int i = 0; i < 4; ++i) { o[i] = y[i] * sigmoid_f(a0[i]); o[4 + i] = y[4 + i] * sigmoid_f(a1[i]); }
                    pg8::u32x4 w; w.x = pg8::cvt_pk_bf16(o[0], o[1]); w.y = pg8::cvt_pk_bf16(o[2], o[3]); w.z = pg8::cvt_pk_bf16(o[4], o[5]); w.w = pg8::cvt_pk_bf16(o[6], o[7]);
                    *(pg8::u32x4*)(MIX + (size_t)row * D + 768 + col) = w; asm volatile("" ::: "memory"); } }
    }
};
struct MoeOrder {
    const volatile LAS int* tstart; int G, c;
    DI bool next(int i, Unit& u) const {
        const int nwg = tstart[16] * 4; const long L = (long)i * G + c; if (L >= nwg) return false;
        int wgid = (int)L; { const int q = nwg / 8, r = nwg % 8, xcd = wgid % 8, off = wgid / 8; wgid = (xcd < r ? xcd * (q + 1) : r * (q + 1) + (xcd - r) * q) + off; }
        const int tm = wgid >> 2, j = wgid & 3; int e = 0;
#pragma unroll
        for (int k = 1; k < 16; ++k) e += (tstart[k] <= tm) ? 1 : 0;
        u.pm = tm; u.pn = e * 4 + j; return true;
    }
    DI void a_ready(const Unit&) const {}
    DI void done(const Unit&) const {}
};
struct EpiG1 {
    static constexpr bool PERM = true, AFTER_DRAIN = false;
    bf16* HID;
    DI void operator()(const pg8::f32x4 (&acc)[2][2][4][2], const Unit& u, int wr, int wc, int fr, int fq) const {
        const int row0 = u.pm * BM + wr * 64 + fr, col = (u.pn & 3) * 128 + wc * 32 + 8 * fq;
#pragma unroll
        for (int ai = 0; ai < 2; ++ai)
#pragma unroll
            for (int m = 0; m < 4; ++m) { const int row = row0 + ai * HALF + m * 16; float o[8];
#pragma unroll
                for (int i = 0; i < 4; ++i) { o[i] = silu_f(acc[ai][0][m][0][i]) * acc[ai][1][m][0][i]; o[4 + i] = silu_f(acc[ai][0][m][1][i]) * acc[ai][1][m][1][i]; }
                pg8::u32x4 w; w.x = pg8::cvt_pk_bf16(o[0], o[1]); w.y = pg8::cvt_pk_bf16(o[2], o[3]); w.z = pg8::cvt_pk_bf16(o[4], o[5]); w.w = pg8::cvt_pk_bf16(o[6], o[7]);
                *(pg8::u32x4*)(HID + (size_t)row * DEXP + col) = w; }
    }
};
struct EpiG2 {
    static constexpr bool PERM = true, AFTER_DRAIN = false;
    bf16* ROWS; const int* dest; const float* sw;
    DI void operator()(const pg8::f32x4 (&acc)[2][2][4][2], const Unit& u, int wr, int wc, int fr, int fq) const {
        const int row0 = u.pm * BM + wr * 64 + fr, colb = (u.pn & 3) * BM + wc * 32 + 8 * fq;
#pragma unroll
        for (int ai = 0; ai < 2; ++ai)
#pragma unroll
            for (int m = 0; m < 4; ++m) { const int row = row0 + ai * HALF + m * 16; const int d = dest[row]; const float wt = sw[row];
                if (d >= 0) {
#pragma unroll
                    for (int bj = 0; bj < 2; ++bj) { const pg8::f32x4 v0 = acc[ai][bj][m][0] * wt, v1 = acc[ai][bj][m][1] * wt;
                        pg8::u32x4 w; w.x = pg8::cvt_pk_bf16(v0[0], v0[1]); w.y = pg8::cvt_pk_bf16(v0[2], v0[3]); w.z = pg8::cvt_pk_bf16(v1[0], v1[1]); w.w = pg8::cvt_pk_bf16(v1[2], v1[3]);
                        *(pg8::u32x4*)(ROWS + (size_t)d * D + colb + bj * HALF) = w; } } }
    }
};

DI void mix_gating_simple(Frame& F, const Args& A, int l) {
    FRAME_IDS
    const bf16* P = (const bf16*)(F.ws + WS_PROJ); bf16* MIX = (bf16*)(F.ws + WS_MIXCAT);
    const float* lng = (const float*)A.in[I_GMLNG] + l * AW; const float* lnb = (const float*)A.in[I_GMLNB] + l * AW;
    const float* ws_ = (const float*)A.in[I_GMWS] + (size_t)l * 4 * 128 * 128; const float* bs_ = (const float*)A.in[I_GMBS] + l * 4 * 128;
    LAS float* vln = (LAS float*)(F.lds + RING_OFF);
    for (int it = F.vcu; it < BATCH * (T / 128); it += F.G) {
        const int m0 = it * 128;
        for (int r = wave_; r < 128; r += NWAVES) {
            const v2u w = *(const v2u*)(P + (size_t)(m0 + r) * PROJW + COL_V + 4 * lane_);
            float v[4] = {bflo(w.x), bfhi(w.x), bflo(w.y), bfhi(w.y)};
            const float mean = wave_sum(v[0] + v[1] + v[2] + v[3]) * (1.f / 256.f);
            float s2 = 0.f;
#pragma unroll
            for (int i = 0; i < 4; ++i) { v[i] -= mean; s2 += v[i] * v[i]; }
            const float rstd = 1.0f / sqrtf(wave_sum(s2) * (1.f / 256.f) + LN_EPS);
#pragma unroll
            for (int i = 0; i < 4; ++i) vln[r * 256 + 4 * lane_ + i] = v[i] * rstd * lng[4 * lane_ + i] + lnb[4 * lane_ + i];
        }
        __syncthreads();
        { const int c = tid_ & 255, tp = tid_ >> 8, h = c >> 6;
          for (int t = tp; t < 128; t += 2) { const float* wrow = ws_ + ((size_t)h * 128 + t) * 128; float acc = 0.f;
              for (int s = 0; s <= t; ++s) acc += wrow[s] * vln[s * 256 + c];
              const float uu = bf2f(P[(size_t)(m0 + t) * PROJW + COL_U + c]);
              MIX[(size_t)(m0 + t) * D + c] = (bf16)f2bf(uu * (acc + bs_[h * 128 + t])); } }
        __syncthreads();
    }
}
DI void mix_attn_simple(Frame& F, int l) {
    FRAME_IDS
    const bf16* P = (const bf16*)(F.ws + WS_PROJ); bf16* MIX = (bf16*)(F.ws + WS_MIXCAT);
    const int gw = F.vcu * NWAVES + wave_, NGW = F.G * NWAVES;
    for (int it = gw; it < M * NH; it += NGW) {
        const int m = it >> 3, h = it & 7, t = m & (T - 1);
        const float q = bf2f(P[(size_t)m * PROJW + COL_Q + h * 64 + lane_]);
        float mx = -1e30f, den = 0.f, o = 0.f;
#pragma unroll 1
        for (int g = 0; g < 3; ++g) { const int dl = (g == 0) ? 1 : (g == 1 ? 4 : 16);
            int nk = t / dl; if (nk > 128) nk = 128;
#pragma unroll 2
            for (int j = 0; j <= nk; ++j) { const size_t mk = (size_t)(m - j * dl);
                const float kv = bf2f(P[mk * PROJW + COL_K + h * 64 + lane_]); const float vv = bf2f(P[mk * PROJW + COL_VA + h * 64 + lane_]);
                const float s = wave_sum(q * kv);
                const float mn = fmaxf(mx, s), f = __builtin_amdgcn_exp2f(mx - mn), p = __builtin_amdgcn_exp2f(s - mn);
                den = den * f + p; o = o * f + p * vv; mx = mn; } }
        MIX[(size_t)m * D + AW + h * 64 + lane_] = (bf16)f2bf(o / den);
    }
}

typedef float f32x16 __attribute__((ext_vector_type(16)));
typedef short v4i16_t __attribute__((ext_vector_type(4)));
typedef float f32x2_t __attribute__((ext_vector_type(2)));
typedef __bf16 bf16x2_t __attribute__((ext_vector_type(2)));
DI unsigned cvtpk(float lo, float hi) { f32x2_t v = {lo, hi}; bf16x2_t b = __builtin_convertvector(v, bf16x2_t); return __builtin_bit_cast(unsigned, b); }
DI int crow16(int r, int hi) { return (r & 3) + 8 * (r >> 2) + 4 * hi; }
template <int SUB> DI void mix_attn_mfma(Frame& F, int l) {
    FRAME_IDS
    const bf16* P = (const bf16*)(F.ws + WS_PROJ);
    LAS unsigned char* Ks = F.lds + RING_OFF; LAS unsigned char* Vs = Ks + 49152;
    const int ql = lane_ & 31, hi = lane_ >> 5;
    constexpr int nitems = SUB == 0 ? 2048 : 1024;
    for (int it = F.vcu; it < nitems; it += F.G) {
        int d, r, tile; const int idx = it & 1023, b = idx >> 7, h = (idx >> 4) & 7;
        if (SUB == 1) { d = 1; r = 0; tile = idx & 15; }
        else if (it < 1024) { d = 16; r = idx & 15; tile = 0; }
        else { d = 4; r = (idx >> 2) & 3; tile = idx & 3; }
        const int s0 = tile * 256; const size_t tokbase = (size_t)b * T + r;
        {
            v4u kreg[6], vreg[6];
#pragma unroll
            for (int i = 0; i < 6; ++i) { const int idx2 = tid_ + 512 * i, row = idx2 >> 3, ch = idx2 & 7, step = s0 - 128 + row;
                if (step >= 0) { const bf16* src = P + (tokbase + (size_t)step * d) * PROJW + h * 64 + ch * 8; kreg[i] = *(const v4u*)(src + COL_K); vreg[i] = *(const v4u*)(src + COL_VA); }
                else { kreg[i] = (v4u){0u, 0u, 0u, 0u}; vreg[i] = (v4u){0u, 0u, 0u, 0u}; } }
#pragma unroll
            for (int i = 0; i < 6; ++i) { const int idx2 = tid_ + 512 * i, row = idx2 >> 3, ch = idx2 & 7;
                *(LAS v4u*)(Ks + row * 128 + ((ch ^ ((row >> 1) & 7)) << 4)) = kreg[i];
                *(LAS v4u*)(Vs + row * 128 + ((ch ^ (((row >> 1) & 1) << 2)) << 4)) = vreg[i]; }
        }
        const size_t qtok = tokbase + (size_t)(s0 + 32 * wave_ + ql) * d;
        bf16x8 qf[4];
        { const bf16* qsrc = P + qtok * PROJW + COL_Q + h * 64 + hi * 8;
#pragma unroll
          for (int ks = 0; ks < 4; ++ks) qf[ks] = *(const bf16x8*)(qsrc + ks * 16); }
        __syncthreads();
        const int i0 = 32 * wave_;
        f32x16 S[5];
#pragma unroll
        for (int kb = 0; kb < 5; ++kb) { f32x16 acc;
#pragma unroll
            for (int i = 0; i < 16; ++i) acc[i] = 0.f;
            const int krow = i0 + 32 * kb + ql;
#pragma unroll
            for (int ks = 0; ks < 4; ++ks) { const bf16x8 a = *(const LAS bf16x8*)(Ks + krow * 128 + (((2 * ks + hi) ^ ((krow >> 1) & 7)) << 4)); acc = __builtin_amdgcn_mfma_f32_32x32x16_bf16(a, qf[ks], acc, 0, 0, 0); }
            S[kb] = acc; }
        const bool first = (s0 == 0);
        int qrel = ql - 4 * hi; asm volatile("" : "+v"(qrel));
        float mx = -1e30f;
#pragma unroll
        for (int kb = 0; kb < 5; ++kb) {
            const bool bvalid = !first || (wave_ + kb >= 4);
            if (!bvalid) {
#pragma unroll
                for (int i = 0; i < 16; ++i) S[kb][i] = -1e30f;
            } else {
#pragma unroll
                for (int i = 0; i < 16; ++i) { const int c0 = crow16(i, 0); float v = S[kb][i];
                    if (kb == 0) v = (c0 >= qrel) ? v : -1e30f;
                    if (kb == 4) v = (c0 <= qrel) ? v : -1e30f;
                    S[kb][i] = v; mx = fmaxf(mx, v); }
            }
        }
        mx = fmaxf(mx, __shfl_xor(mx, 32));
        float lsum = 0.f;
#pragma unroll
        for (int kb = 0; kb < 5; ++kb)
#pragma unroll
            for (int i = 0; i < 16; ++i) { const float p = __builtin_amdgcn_exp2f(S[kb][i] - mx); S[kb][i] = p; lsum += p; }
        lsum += __shfl_xor(lsum, 32);
        f32x16 O[2];
#pragma unroll
        for (int i = 0; i < 16; ++i) { O[0][i] = 0.f; O[1][i] = 0.f; }
        const int trq = (lane_ & 15) >> 2, trg = (lane_ >> 4) & 1, trp = lane_ & 3;
#pragma unroll
        for (int kb = 0; kb < 5; ++kb)
#pragma unroll
            for (int s = 0; s < 2; ++s) {
                v4u pw; pw.x = cvtpk(S[kb][8 * s], S[kb][8 * s + 1]); pw.y = cvtpk(S[kb][8 * s + 2], S[kb][8 * s + 3]); pw.z = cvtpk(S[kb][8 * s + 4], S[kb][8 * s + 5]); pw.w = cvtpk(S[kb][8 * s + 6], S[kb][8 * s + 7]);
                const bf16x8 pb = __builtin_bit_cast(bf16x8, pw);
                const int rlo = i0 + 32 * kb + 16 * s + 4 * hi + trq, rhi = rlo + 8;
#pragma unroll
                for (int dh = 0; dh < 2; ++dh) { const int chunk = 4 * dh + 2 * trg + (trp >> 1);
                    const v4i16_t lo = __builtin_amdgcn_ds_read_tr16_b64_v4i16((LAS v4i16_t*)(Vs + rlo * 128 + ((chunk ^ (((rlo >> 1) & 1) << 2)) << 4) + 8 * (trp & 1)));
                    const v4i16_t hh = __builtin_amdgcn_ds_read_tr16_b64_v4i16((LAS v4i16_t*)(Vs + rhi * 128 + ((chunk ^ (((rhi >> 1) & 1) << 2)) << 4) + 8 * (trp & 1)));
                    const bf16x8 va = (bf16x8){lo[0], lo[1], lo[2], lo[3], hh[0], hh[1], hh[2], hh[3]};
                    O[dh] = __builtin_amdgcn_mfma_f32_32x32x16_bf16(va, pb, O[dh], 0, 0, 0); } }
        if (SUB == 0) {
            bf16* PART = (bf16*)(F.ws + WS_XN) + (it < 1024 ? 0 : (size_t)M * BW); float* ST = (float*)(F.ws + WS_STAT) + (it < 1024 ? 0 : (size_t)M * NH * 2);
            const float inv = 1.0f / lsum; bf16* op = PART + qtok * BW + h * 64 + 4 * hi;
#pragma unroll
            for (int dh = 0; dh < 2; ++dh)
#pragma unroll
                for (int g4 = 0; g4 < 4; ++g4) { v2u w; w.x = cvtpk(O[dh][4 * g4] * inv, O[dh][4 * g4 + 1] * inv); w.y = cvtpk(O[dh][4 * g4 + 2] * inv, O[dh][4 * g4 + 3] * inv); *(v2u*)(op + 32 * dh + 8 * g4) = w; }
            if (hi == 0) { f32x2_t st = {mx, lsum}; *(f32x2_t*)(ST + (qtok * NH + h) * 2) = st; }
        } else {
            const bf16* P16 = (const bf16*)(F.ws + WS_XN) + qtok * BW + h * 64 + 4 * hi; const bf16* P4 = P16 + (size_t)M * BW;
            const float* ST16 = (const float*)(F.ws + WS_STAT) + (qtok * NH + h) * 2; const float* ST4 = ST16 + (size_t)M * NH * 2;
            const f32x2_t s16 = *(const f32x2_t*)ST16, s4 = *(const f32x2_t*)ST4;
            const float MM = fmaxf(mx, fmaxf(s16.x, s4.x)), a1 = __builtin_amdgcn_exp2f(mx - MM), a16 = s16.y * __builtin_amdgcn_exp2f(s16.x - MM), a4 = s4.y * __builtin_amdgcn_exp2f(s4.x - MM);
            const float inv = 1.0f / (lsum * a1 + a16 + a4);
            bf16* op = (bf16*)(F.ws + WS_MIXCAT) + qtok * D + AW + h * 64 + 4 * hi;
#pragma unroll
            for (int dh = 0; dh < 2; ++dh)
#pragma unroll
                for (int g4 = 0; g4 < 4; ++g4) { const v2u x16 = *(const v2u*)(P16 + 32 * dh + 8 * g4), x4 = *(const v2u*)(P4 + 32 * dh + 8 * g4);
                    const float o0 = (O[dh][4 * g4] * a1 + a16 * bflo(x16.x) + a4 * bflo(x4.x)) * inv, o1 = (O[dh][4 * g4 + 1] * a1 + a16 * bfhi(x16.x) + a4 * bfhi(x4.x)) * inv;
                    const float o2 = (O[dh][4 * g4 + 2] * a1 + a16 * bflo(x16.y) + a4 * bflo(x4.y)) * inv, o3 = (O[dh][4 * g4 + 3] * a1 + a16 * bfhi(x16.y) + a4 * bfhi(x4.y)) * inv;
                    v2u w; w.x = cvtpk(o0, o1); w.y = cvtpk(o2, o3); *(v2u*)(op + 32 * dh + 8 * g4) = w; }
        }
        __syncthreads();
    }
}

typedef float f32x4_t __attribute__((ext_vector_type(4)));
DI void cmul_acc(float& xr, float& xi, float ar, float ai, float br, float bi) { const float nr = ar * xr - ai * xi + br, ni = ar * xi + ai * xr + bi; xr = nr; xi = ni; }
DI void mix_ssm_in(Frame& F, int l) {
    FRAME_IDS
    const bf16* P = (const bf16*)(F.ws + WS_PROJ);
    const bf16* WIN = (const bf16*)(F.ws + WS_SSM2 + l * SSM2_LAYER + S2_WIN);
    const float* apw = (const float*)(F.ws + WS_SSM2 + l * SSM2_LAYER + S2_APW);
    float* XLOC = (float*)(F.ws + WS_XLOC); float* XSUP = (float*)(F.ws + WS_XSUP);
    const int row = lane_ & 15, q = lane_ >> 4;
    for (int it = F.vcu; it < 256; it += F.G) {
        const int b = it >> 5, sc = (it >> 2) & 7, g = 4 * (it & 3) + (wave_ >> 1), half = wave_ & 1;
        bf16x8 af[16];
        { const bf16* src = P + ((size_t)b * T + (size_t)(16 * sc + row) * 32 + (q >> 1)) * PROJW + COL_S + g * 16 + 8 * (q & 1);
#pragma unroll
          for (int sp = 0; sp < 16; ++sp) af[sp] = *(const bf16x8*)(src + (size_t)(2 * sp) * PROJW); }
#pragma unroll 1
        for (int c4 = 0; c4 < 4; ++c4) { const int ct = 4 * half + c4;
            f32x4_t acc = {0.f, 0.f, 0.f, 0.f};
            const bf16* wp = WIN + (((size_t)(g * 16) * 8 + ct) * 64 + lane_) * 8;
#pragma unroll
            for (int sp = 0; sp < 16; ++sp) { const bf16x8 bfr = *(const bf16x8*)(wp + (size_t)sp * 8 * 64 * 8); acc = __builtin_amdgcn_mfma_f32_16x16x32_bf16(af[sp], bfr, acc, 0, 0, 0); }
            const int comp = 16 * ct + row, n = comp >> 1, part = comp & 1;
#pragma unroll
            for (int r = 0; r < 4; ++r) XLOC[(((size_t)b * 128 + 16 * sc + 4 * q + r) * 16 + g) * 128 + comp] = acc[r];
            const float a32r = apw[((g * 33 + 32) * 64 + n) * 2], a32i = apw[((g * 33 + 32) * 64 + n) * 2 + 1];
            const float sg = part ? 1.f : -1.f;
            float h = acc[0];
#pragma unroll
            for (int r = 1; r < 4; ++r) { const float o = __shfl_xor(h, 1); h = a32r * h + sg * a32i * o + acc[r]; }
            float p64r = a32r * a32r - a32i * a32i, p64i = 2.f * a32r * a32i;
            float p128r = p64r * p64r - p64i * p64i, p128i = 2.f * p64r * p64i;
            float wr = 1.f, wi = 0.f;
            for (int k = 0; k < 3 - q; ++k) { const float t0 = wr * p128r - wi * p128i, t1 = wr * p128i + wi * p128r; wr = t0; wi = t1; }
            { const float o = __shfl_xor(h, 1); h = wr * h + sg * wi * o; }
            h += __shfl_xor(h, 16); h += __shfl_xor(h, 32);
            if (q == 0) XSUP[(((size_t)b * 8 + sc) * 16 + g) * 128 + comp] = h;
        }
    }
}
DI void mix_ssm_out(Frame& F, const Args& A, int l) {
    FRAME_IDS
    const bf16* P = (const bf16*)(F.ws + WS_PROJ); bf16* YG = (bf16*)(F.ws + WS_YG);
    const bf16* KT = (const bf16*)(F.ws + WS_SSM2 + l * SSM2_LAYER + S2_KT); const bf16* CT = (const bf16*)(F.ws + WS_SSM2 + l * SSM2_LAYER + S2_CT);
    const float* apw = (const float*)(F.ws + WS_SSM2 + l * SSM2_LAYER + S2_APW);
    const float* XLOC = (const float*)(F.ws + WS_XLOC); const float* XSUP = (const float*)(F.ws + WS_XSUP);
    LAS unsigned char* Ut = F.lds + RING_OFF + wave_ * 4096;
    LAS float* Xs = (LAS float*)(F.lds + RING_OFF + wave_ * 4096 + 2048);
    for (int i = lane_; i < 256; i += 64) ((LAS unsigned*)Ut)[i] = 0u;
    const int row = lane_ & 15, q = lane_ >> 4;
    for (int it = F.vcu; it < 256; it += F.G) {
        const int b = it >> 5, sc = (it >> 2) & 7, g = 4 * (it & 3) + (wave_ >> 1), half = wave_ & 1, n = lane_;
        bf16x8 kt[16], ctf[4];
#pragma unroll
        for (int p = 0; p < 16; ++p) kt[p] = *(const bf16x8*)(KT + ((size_t)(g * 16 + p) * 64 + lane_) * 8);
#pragma unroll
        for (int sx = 0; sx < 4; ++sx) ctf[sx] = *(const bf16x8*)(CT + ((size_t)(g * 4 + sx) * 64 + lane_) * 8);
        const float dsk = ((const float*)A.in[I_SSMD])[(l * 16 + g) * 16 + row];
        const float a32r = apw[((g * 33 + 32) * 64 + n) * 2], a32i = apw[((g * 33 + 32) * 64 + n) * 2 + 1];
        float a512r = a32r, a512i = a32i;
#pragma unroll
        for (int k = 0; k < 4; ++k) { const float t0 = a512r * a512r - a512i * a512i, t1 = 2.f * a512r * a512i; a512r = t0; a512i = t1; }
        float xr = 0.f, xi = 0.f;
        for (int s2 = 0; s2 < sc; ++s2) { const f32x2_t v = *(const f32x2_t*)(XSUP + (((size_t)b * 8 + s2) * 16 + g) * 128 + 2 * n); cmul_acc(xr, xi, a512r, a512i, v.x, v.y); }
        for (int k2 = 0; k2 < 8 * half; ++k2) { const f32x2_t v = *(const f32x2_t*)(XLOC + (((size_t)b * 128 + 16 * sc + k2) * 16 + g) * 128 + 2 * n); cmul_acc(xr, xi, a32r, a32i, v.x, v.y); }
#pragma unroll 1
        for (int kk = 8 * half; kk < 8 * half + 8; ++kk) {
            const size_t tok0 = (size_t)b * T + (size_t)(16 * sc + kk) * 32;
            const f32x2_t xl = *(const f32x2_t*)(XLOC + (((size_t)b * 128 + 16 * sc + kk) * 16 + g) * 128 + 2 * n);
            { const v4u uv = *(const v4u*)(P + (tok0 + (lane_ >> 1)) * PROJW + COL_S + g * 16 + 8 * (lane_ & 1)); *(LAS v4u*)(Ut + 1024 + lane_ * 16) = uv; }
            Xs[2 * n] = xr; Xs[2 * n + 1] = xi;
#pragma unroll
            for (int tau = 0; tau < 2; ++tau) { f32x4_t acc = (f32x4_t){0.f, 0.f, 0.f, 0.f};
                const int ti = 16 * tau + row;
#pragma unroll
                for (int sx = 0; sx < 4; ++sx) { const LAS f32x4_t* xp = (const LAS f32x4_t*)(Xs + 2 * (16 * sx + 4 * q)); const f32x4_t x01 = xp[0], x23 = xp[1];
                    const f32x4_t* ap = (const f32x4_t*)(apw + ((size_t)(g * 33 + ti + 1) * 64 + 16 * sx + 4 * q) * 2); const f32x4_t a01 = ap[0], a23 = ap[1];
                    v4u zw; zw.x = cvtpk(a01.x * x01.x - a01.y * x01.y, a01.x * x01.y + a01.y * x01.x); zw.y = cvtpk(a01.z * x01.z - a01.w * x01.w, a01.z * x01.w + a01.w * x01.z);
                    zw.z = cvtpk(a23.x * x23.x - a23.y * x23.y, a23.x * x23.y + a23.y * x23.x); zw.w = cvtpk(a23.z * x23.z - a23.w * x23.w, a23.z * x23.w + a23.w * x23.z);
                    acc = __builtin_amdgcn_mfma_f32_16x16x32_bf16(__builtin_bit_cast(bf16x8, zw), ctf[sx], acc, 0, 0, 0);
                    asm volatile("" ::: "memory"); }
#pragma unroll
                for (int p = 0; p < 16; ++p) if (p < 8 * tau + 8) { const bf16x8 ua = *(const LAS bf16x8*)(Ut + (32 + ti - 2 * p - (q >> 1)) * 32 + 16 * (q & 1));
                    acc = __builtin_amdgcn_mfma_f32_16x16x32_bf16(ua, kt[p], acc, 0, 0, 0); if ((p & 3) == 3) asm volatile("" ::: "memory"); }
#pragma unroll
                for (int r = 0; r < 4; ++r) { const int t2 = 16 * tau + 4 * q + r; const float uu = bf2f(*(const LAS bf16*)(Ut + (32 + t2) * 32 + 2 * row));
                    YG[(tok0 + t2) * 256 + g * 16 + row] = (bf16)f2bf(gelu_tanh_f(acc[r] + dsk * uu)); }
                asm volatile("" ::: "memory");
            }
            cmul_acc(xr, xi, a32r, a32i, xl.x, xl.y);
        }
    }
}
DI void mix_gating_mfma(Frame& F, const Args& A, int l) {
    FRAME_IDS
    const bf16* P = (const bf16*)(F.ws + WS_PROJ); bf16* MIX = (bf16*)(F.ws + WS_MIXCAT);
    const bf16* GW = (const bf16*)(F.ws + WS_SSM2 + l * SSM2_LAYER + S2_GW);
    const float* lng = (const float*)A.in[I_GMLNG] + l * AW; const float* lnb = (const float*)A.in[I_GMLNB] + l * AW;
    const float* bs_ = (const float*)A.in[I_GMBS] + l * 4 * 128;
    LAS unsigned char* VT = F.lds + RING_OFF + 32768;
    const int ql = lane_ & 31, hi = lane_ >> 5;
    for (int it = F.vcu; it < BATCH * (T / 128); it += F.G) {
        const int m0 = it * 128;
        __syncthreads();
        for (int r = wave_; r < 128; r += NWAVES) {
            const v2u w = *(const v2u*)(P + (size_t)(m0 + r) * PROJW + COL_V + 4 * lane_);
            float v[4] = {bflo(w.x), bfhi(w.x), bflo(w.y), bfhi(w.y)};
            const float mean = wave_sum(v[0] + v[1] + v[2] + v[3]) * (1.f / 256.f);
            float s2 = 0.f;
#pragma unroll
            for (int i = 0; i < 4; ++i) { v[i] -= mean; s2 += v[i] * v[i]; }
            const float rstd = 1.0f / sqrtf(wave_sum(s2) * (1.f / 256.f) + LN_EPS);
            const f32x4 gg = *(const f32x4*)(lng + 4 * lane_), bb = *(const f32x4*)(lnb + 4 * lane_);
            *(LAS bf16*)(VT + (4 * lane_ + 0) * 272 + 2 * r) = (bf16)f2bf(v[0] * rstd * gg.x + bb.x);
            *(LAS bf16*)(VT + (4 * lane_ + 1) * 272 + 2 * r) = (bf16)f2bf(v[1] * rstd * gg.y + bb.y);
            *(LAS bf16*)(VT + (4 * lane_ + 2) * 272 + 2 * r) = (bf16)f2bf(v[2] * rstd * gg.z + bb.z);
            *(LAS bf16*)(VT + (4 * lane_ + 3) * 272 + 2 * r) = (bf16)f2bf(v[3] * rstd * gg.w + bb.w);
        }
        __syncthreads();
        const int h = wave_ >> 1, cb = 64 * h + 32 * (wave_ & 1);
#pragma unroll 1
        for (int rt = 0; rt < 4; ++rt) {
            f32x16 acc;
#pragma unroll
            for (int i = 0; i < 16; ++i) acc[i] = 0.f;
            for (int ks = 0; ks < 2 * rt + 2; ++ks) {
                const bf16x8 wa = *(const bf16x8*)(GW + ((size_t)h * 128 + 32 * rt + ql) * 128 + 16 * ks + 8 * hi);
                const bf16x8 vb = *(const LAS bf16x8*)(VT + (cb + ql) * 272 + 2 * (16 * ks + 8 * hi));
                acc = __builtin_amdgcn_mfma_f32_32x32x16_bf16(wa, vb, acc, 0, 0, 0); }
#pragma unroll
            for (int i = 0; i < 16; ++i) { const int t = 32 * rt + crow16(i, hi); const int c = cb + ql;
                const float uu = bf2f(P[(size_t)(m0 + t) * PROJW + COL_U + c]);
                MIX[(size_t)(m0 + t) * D + c] = (bf16)f2bf(uu * (acc[i] + bs_[h * 128 + t])); }
        }
    }
}
DI void mix_ssm_simple(Frame& F, const Args& A, int l) {
    FRAME_IDS
    const bf16* P = (const bf16*)(F.ws + WS_PROJ); bf16* YG = (bf16*)(F.ws + WS_YG);
    const float* tab = (const float*)(F.ws + WS_SSM) + (size_t)l * SSM_TAB;
    LAS float* fin = (LAS float*)(F.lds + RING_OFF);
    for (int it = F.vcu; it < BATCH * SSM_G; it += F.G) {
        const int b = it >> 4, g = it & 15, n = lane_, seg = wave_, gn = g * 64 + n;
        const float are = tab[gn], aim = tab[1024 + gn];
        float bre[16], bim[16], cre[16], cim[16];
#pragma unroll
        for (int c = 0; c < 16; ++c) { bre[c] = tab[2048 + gn * 16 + c]; bim[c] = tab[2048 + 16384 + gn * 16 + c];
            cre[c] = ((const float*)A.in[I_CRE])[(((size_t)l * 16 + g) * 16 + c) * 64 + n]; cim[c] = ((const float*)A.in[I_CIM])[(((size_t)l * 16 + g) * 16 + c) * 64 + n]; }
        const float dsk = ((const float*)A.in[I_SSMD])[(l * 16 + g) * 16 + (lane_ & 15)];
        const size_t mbase = (size_t)b * T + seg * 512;
        float xr = 0.f, xi = 0.f;
        for (int tt = 0; tt < 512; ++tt) { const v4u* up = (const v4u*)(P + (mbase + tt) * PROJW + COL_S + g * 16); const v4u u0 = up[0], u1 = up[1];
            const float u[16] = {bflo(u0.x), bfhi(u0.x), bflo(u0.y), bfhi(u0.y), bflo(u0.z), bfhi(u0.z), bflo(u0.w), bfhi(u0.w), bflo(u1.x), bfhi(u1.x), bflo(u1.y), bfhi(u1.y), bflo(u1.z), bfhi(u1.z), bflo(u1.w), bfhi(u1.w)};
            float br = 0.f, bi = 0.f;
#pragma unroll
            for (int c = 0; c < 16; ++c) { br += u[c] * bre[c]; bi += u[c] * bim[c]; }
            const float nr = are * xr - aim * xi + br, ni = are * xi + aim * xr + bi; xr = nr; xi = ni; }
        fin[(seg * 64 + n) * 2] = xr; fin[(seg * 64 + n) * 2 + 1] = xi;
        __syncthreads();
        float pr = are, pi = aim;
#pragma unroll
        for (int k = 0; k < 9; ++k) { const float t0 = pr * pr - pi * pi, t1 = 2.f * pr * pi; pr = t0; pi = t1; }
        xr = 0.f; xi = 0.f;
        for (int s = 0; s < seg; ++s) { const float fr_ = fin[(s * 64 + n) * 2], fi_ = fin[(s * 64 + n) * 2 + 1];
            const float nr = pr * xr - pi * xi + fr_, ni = pr * xi + pi * xr + fi_; xr = nr; xi = ni; }
        for (int tt = 0; tt < 512; ++tt) { const v4u* up = (const v4u*)(P + (mbase + tt) * PROJW + COL_S + g * 16); const v4u u0 = up[0], u1 = up[1];
            const float u[16] = {bflo(u0.x), bfhi(u0.x), bflo(u0.y), bfhi(u0.y), bflo(u0.z), bfhi(u0.z), bflo(u0.w), bfhi(u0.w), bflo(u1.x), bfhi(u1.x), bflo(u1.y), bfhi(u1.y), bflo(u1.z), bfhi(u1.z), bflo(u1.w), bfhi(u1.w)};
            float br = 0.f, bi = 0.f;
#pragma unroll
            for (int c = 0; c < 16; ++c) { br += u[c] * bre[c]; bi += u[c] * bim[c]; }
            const float nr = are * xr - aim * xi + br, ni = are * xi + aim * xr + bi; xr = nr; xi = ni;
            float ysel = 0.f, usel = 0.f;
#pragma unroll
            for (int c = 0; c < 16; ++c) { const float r = wave_sum(xr * cre[c] - xi * cim[c]); if ((lane_ & 15) == c) { ysel = r; usel = u[c]; } }
            if (lane_ < 16) { const float y = ysel + dsk * usel; YG[(mbase + tt) * 256 + g * 16 + lane_] = (bf16)f2bf(gelu_tanh_f(y)); } }
        __syncthreads();
    }
}

DI void p_row_b(Frame& F, const Args& A, int l) {
    FRAME_IDS
    const int gw = F.vcu * NWAVES + wave_, NGW = F.G * NWAVES;
    const bf16* PRE = (const bf16*)(F.ws + WS_PRE); bf16* X1 = (bf16*)(F.ws + WS_X1); bf16* XN = (bf16*)(F.ws + WS_XN);
    const float* mod = (const float*)(F.ws + WS_MOD) + (size_t)l * BATCH * 6 * D;
    const float* ln1g = (const float*)A.in[I_LN1G] + l * D; const float* ln1b = (const float*)A.in[I_LN1B] + l * D;
    const float* rw = (const float*)A.in[I_RW]; const float* rb = (const float*)A.in[I_RB];
    int* toke = (int*)(F.ws + WS_TOKE); float* tokg = (float*)(F.ws + WS_TOKG);
    LAS float* rwS = (LAS float*)(F.lds + RING_OFF);
    volatile LAS unsigned* hist = (volatile LAS unsigned*)(F.lds + RING_OFF + 65536);
    for (int i = tid_; i < D * NEXP; i += NTHR) rwS[i] = rw[i];
    if (tid_ < 16) hist[tid_] = 0u;
    __syncthreads();
    for (int m = gw; m < M; m += NGW) { const int b = m / T; const float* md = mod + (size_t)b * 6 * D;
        Row16 r; row_load_bf16(r, PRE + (size_t)m * D, lane_); row_ln(r); row_affine(r, ln1g, ln1b, lane_);
        row_store_bf16(r, X1 + (size_t)m * D, lane_);
        row_ln(r); row_mod(r, md + 4 * D, md + 3 * D, lane_);
        row_store_bf16(r, XN + (size_t)m * D, lane_);
        float lg[16];
#pragma unroll
        for (int e = 0; e < 16; ++e) lg[e] = 0.f;
#pragma unroll
        for (int s = 0; s < 2; ++s)
#pragma unroll
            for (int i = 0; i < 8; ++i) { const LAS f32x4* wp = (const LAS f32x4*)(rwS + (size_t)(s * 512 + 8 * lane_ + i) * 16); const float hv = r.v[8 * s + i];
#pragma unroll
                for (int q = 0; q < 4; ++q) { const f32x4 w4 = wp[q]; lg[4 * q] += hv * w4.x; lg[4 * q + 1] += hv * w4.y; lg[4 * q + 2] += hv * w4.z; lg[4 * q + 3] += hv * w4.w; } }
        float sc[16], sel[16];
#pragma unroll
        for (int e = 0; e < 16; ++e) { const float z = wave_sum(lg[e]); sc[e] = 1.0f / (1.0f + expf(-z)); sel[e] = sc[e] + rb[e]; }
        int bg = 0; float bgs = -1e30f;
#pragma unroll
        for (int g = 0; g < 4; ++g) { float m1 = -1e30f, m2 = -1e30f;
#pragma unroll
            for (int k = 0; k < 4; ++k) { const float v = sel[4 * g + k]; if (v > m1) { m2 = m1; m1 = v; } else if (v > m2) m2 = v; }
            const float gs = m1 + m2; if (gs > bgs) { bgs = gs; bg = g; } }
        int i1 = 0, i2 = 0; float v1 = -1e30f, v2 = -1e30f;
#pragma unroll
        for (int g = 0; g < 4; ++g) if (g == bg) {
#pragma unroll
            for (int k = 0; k < 4; ++k) { const float v = sel[4 * g + k]; if (v > v1) { v2 = v1; i2 = i1; v1 = v; i1 = 4 * g + k; } else if (v > v2) { v2 = v; i2 = 4 * g + k; } } }
        float s1 = 0.f, s2 = 0.f;
#pragma unroll
        for (int e = 0; e < 16; ++e) { if (e == i1) s1 = sc[e]; if (e == i2) s2 = sc[e]; }
        if (lane_ == 0) { const float inv = 1.0f / (s1 + s2); toke[2 * m] = i1; toke[2 * m + 1] = i2; tokg[2 * m] = s1 * inv; tokg[2 * m + 1] = s2 * inv;
            atomicAdd((unsigned*)&hist[i1], 1u); atomicAdd((unsigned*)&hist[i2], 1u); }
    }
    __syncthreads();
    if (tid_ < 16) { const unsigned hv = hist[tid_]; if (hv) atomicAdd((unsigned*)(F.ctl + CW_CNT + l * 128 + tid_), hv); }
}

DI void moe_tstart(Frame& F, int l) {
    FRAME_IDS
    volatile LAS int* ts = (volatile LAS int*)(F.lds + LDSCTL_OFF);
    if (tid_ == 0) { int acc = 0;
        for (int e = 0; e < 16; ++e) { ts[e] = acc; const unsigned c = __hip_atomic_load(F.ctl + CW_CNT + l * 128 + e, RLX_AGENT); acc += (int)((c + 255u) >> 8); }
        ts[16] = acc; }
    __syncthreads();
}
DI void p_moe_prep(Frame& F, int l) {
    FRAME_IDS
    moe_tstart(F, l);
    volatile LAS int* ts = (volatile LAS int*)(F.lds + LDSCTL_OFF);
    volatile LAS unsigned* lc = (volatile LAS unsigned*)(F.lds + RING_OFF);
    const int* toke = (const int*)(F.ws + WS_TOKE); const float* tokg = (const float*)(F.ws + WS_TOKG);
    int* stok = (int*)(F.ws + WS_SLOT_TOK); int* sdest = (int*)(F.ws + WS_SLOT_DEST); float* sw = (float*)(F.ws + WS_SLOT_W);
    for (int blk = F.vcu; blk < M / 128; blk += F.G) {
        if (tid_ < 32) lc[tid_] = 0u;
        __syncthreads();
        int e = 0, rank = 0; const int a = blk * 256 + tid_;
        if (tid_ < 256) { e = toke[a]; rank = (int)atomicAdd((unsigned*)&lc[e], 1u); }
        __syncthreads();
        if (tid_ < 16) { const unsigned n = lc[tid_]; lc[16 + tid_] = n ? atomicAdd((unsigned*)(F.ctl + CW_CNT + l * 128 + 64 + tid_), n) : 0u; }
        __syncthreads();
        if (tid_ < 256) { const int slot = ts[e] * 256 + (int)lc[16 + e] + rank; stok[slot] = a >> 1; sdest[slot] = a; sw[slot] = tokg[a]; }
        __syncthreads();
    }
    if (F.vcu < 16) { const int e = F.vcu; const int cnt = (int)__hip_atomic_load(F.ctl + CW_CNT + l * 128 + e, RLX_AGENT);
        const int lo = ts[e] * 256 + cnt, hi = ts[e + 1] * 256;
        for (int s = lo + tid_; s < hi; s += NTHR) { stok[s] = 0; sdest[s] = -1; sw[s] = 0.f; } }
}
DI void p_gather(Frame& F, int l) {
    FRAME_IDS
    moe_tstart(F, l);
    volatile LAS int* ts = (volatile LAS int*)(F.lds + LDSCTL_OFF);
    const int ns = ts[16] * 256; const int gw = F.vcu * NWAVES + wave_, NGW = F.G * NWAVES;
    const int* stok = (const int*)(F.ws + WS_SLOT_TOK); const bf16* XN = (const bf16*)(F.ws + WS_XN); bf16* XG = (bf16*)(F.ws + WS_ROWS2);
    for (int s = gw; s < ns; s += NGW) { const int tk = stok[s]; const v4u* src = (const v4u*)(XN + (size_t)tk * D); v4u* dst = (v4u*)(XG + (size_t)s * D);
        const v4u a = src[lane_], b = src[64 + lane_]; dst[lane_] = a; dst[64 + lane_] = b; }
}
DI void p_row_c(Frame& F, const Args& A, int l) {
    FRAME_IDS
    const int gw = F.vcu * NWAVES + wave_, NGW = F.G * NWAVES;
    const bf16* X1 = (const bf16*)(F.ws + WS_X1); bf16* R2 = (bf16*)(F.ws + WS_ROWS2); bf16* XN = (bf16*)(F.ws + WS_XN);
    const float* mod = (const float*)(F.ws + WS_MOD) + (size_t)l * BATCH * 6 * D;
    const float* modn = (const float*)(F.ws + WS_MOD) + (size_t)(l + 1) * BATCH * 6 * D;
    const float* ln2g = (const float*)A.in[I_LN2G] + l * D; const float* ln2b = (const float*)A.in[I_LN2B] + l * D;
    for (int m = gw; m < M; m += NGW) { const int b = m / T; const float* md = mod + (size_t)b * 6 * D;
        Row16 x1, r0, r1, g2; row_load_bf16(x1, X1 + (size_t)m * D, lane_); row_load_bf16(r0, R2 + (size_t)(2 * m) * D, lane_); row_load_bf16(r1, R2 + (size_t)(2 * m + 1) * D, lane_);
        row_load_f32(g2, md + 5 * D, lane_);
#pragma unroll
        for (int i = 0; i < 16; ++i) x1.v[i] = ALPHA * x1.v[i] + (1.0f + g2.v[i]) * (r0.v[i] + r1.v[i]);
        row_ln(x1); row_affine(x1, ln2g, ln2b, lane_);
        if (l == DEPTH - 1) row_store_f32(x1, A.out + (size_t)m * D, lane_);
        else { row_store_bf16(x1, R2 + (size_t)(2 * m) * D, lane_);
            const float* mdn = modn + (size_t)b * 6 * D; row_ln(x1); row_mod(x1, mdn + 1 * D, mdn + 0 * D, lane_); row_store_bf16(x1, XN + (size_t)m * D, lane_); }
    }
}


#ifndef PHMASK
#define PHMASK 0xFFFFFFFFu
#endif
#define IN(k) (lo <= (k) && (k) < hi && ((PHMASK >> (((k) == 0) ? 31 : (((k) - 1) % PH_PER_LAYER))) & 1u))
#define SEAM(k) do { if (IN((k) + 1) && MK_ONE_LAUNCH) xcd_barrier(bar); else __syncthreads(); } while (0)
constexpr int PH_PER_LAYER = 12, N_PHASES = 1 + DEPTH * PH_PER_LAYER;
template <int l> DI void layer_body(Frame& F, const Args& args, const XcdBarrier& bar, const int lo, const int hi) {
    unsigned char* ws = args.ws;

        const int pb = 1 + l * PH_PER_LAYER;
        const bf16* WinT = (const bf16*)(ws + WS_WSMALL + l * WSMALL_LAYER + WOFF_IN);
        const bf16* WoutT = (const bf16*)(ws + WS_WSMALL + l * WSMALL_LAYER + WOFF_OUT);
        const bf16* GluT = (const bf16*)(ws + WS_WSMALL + l * WSMALL_LAYER + WOFF_GLU);
        const float* modl = (const float*)(ws + WS_MOD) + (size_t)l * BATCH * 6 * D;
        if (IN(pb + 0)) { p_wconv(F, args, l); if (l == 0) p_ln_a0(F, args); SEAM(pb + 0); }
        if (IN(pb + 1)) {
            pg8::Gemm g{(const bf16*)(ws + WS_XN), WinT, M, PROJW, D}; pg8::StaticOrder S; S.init(M, PROJW, F.G, (int)blockIdx.x);
            EpiInProj E{(bf16*)(ws + WS_PROJ), (const float*)(ws + WS_ROPE)};
            pg8::gemm_phase<EpiInProj, pg8::StaticOrder, PG8_ALIGN, PG8_SP2>(F.lds + RING_OFF, g, S, E);
            SEAM(pb + 1); }
        if (IN(pb + 2)) { mix_gating_mfma(F, args, l); __syncthreads(); mix_ssm_in(F, l); mix_attn_mfma<0>(F, l); SEAM(pb + 2); }
        if (IN(pb + 3)) { mix_ssm_out(F, args, l); __syncthreads(); mix_attn_mfma<1>(F, l); SEAM(pb + 3); }
        if (IN(pb + 4)) {
            pg8::Gemm g{(const bf16*)(ws + WS_YG), GluT, M, 256, 256}; pg8::StaticOrder S; S.init(M, 256, F.G, (int)blockIdx.x);
            EpiGlu E{(const bf16*)(ws + WS_YG), (bf16*)(ws + WS_MIXCAT), (const float*)args.in[I_GLUB] + l * 256};
            pg8::gemm_phase<EpiGlu, pg8::StaticOrder, PG8_ALIGN, PG8_SP2>(F.lds + RING_OFF, g, S, E);
            SEAM(pb + 4); }
        if (IN(pb + 5)) {
            pg8::Gemm g{(const bf16*)(ws + WS_MIXCAT), WoutT, M, D, D}; pg8::StaticOrder S; S.init(M, D, F.G, (int)blockIdx.x);
            if (l == 0) { EpiOut<true> E{(bf16*)(ws + WS_PRE), args.in[I_X], D, modl}; pg8::gemm_phase<EpiOut<true>, pg8::StaticOrder, PG8_ALIGN, PG8_SP2>(F.lds + RING_OFF, g, S, E); }
            else { EpiOut<false> E{(bf16*)(ws + WS_PRE), (const void*)(ws + WS_ROWS2), 2 * D, modl}; pg8::gemm_phase<EpiOut<false>, pg8::StaticOrder, PG8_ALIGN, PG8_SP2>(F.lds + RING_OFF, g, S, E); }
            SEAM(pb + 5); }
        if (IN(pb + 6)) { p_row_b(F, args, l); SEAM(pb + 6); }
        if (IN(pb + 7)) { p_moe_prep(F, l); SEAM(pb + 7); }
        if (IN(pb + 8)) { p_gather(F, l); SEAM(pb + 8); }
        if (IN(pb + 9)) { moe_tstart(F, l);
            pg8::Gemm g{(const bf16*)(ws + WS_ROWS2), (const bf16*)(ws + WS_WGU), NSLOT_MAX, NEXP * 1024, D};
            MoeOrder S{(const volatile LAS int*)(F.lds + LDSCTL_OFF), F.G, (int)blockIdx.x}; EpiG1 E{(bf16*)(ws + WS_HID)};
            pg8::gemm_phase<EpiG1, MoeOrder, PG8_ALIGN, PG8_SP2>(F.lds + RING_OFF, g, S, E);
            SEAM(pb + 9); }
        if (IN(pb + 10)) { moe_tstart(F, l);
            pg8::Gemm g{(const bf16*)(ws + WS_HID), (const bf16*)(ws + WS_WD), NSLOT_MAX, NEXP * 1024, DEXP};
            MoeOrder S{(const volatile LAS int*)(F.lds + LDSCTL_OFF), F.G, (int)blockIdx.x}; EpiG2 E{(bf16*)(ws + WS_ROWS2), (const int*)(ws + WS_SLOT_DEST), (const float*)(ws + WS_SLOT_W)};
            pg8::gemm_phase<EpiG2, MoeOrder, PG8_ALIGN, PG8_SP2>(F.lds + RING_OFF, g, S, E);
            SEAM(pb + 10); }
        if (IN(pb + 11)) { p_row_c(F, args, l); SEAM(pb + 11); }
    }
__global__ void __launch_bounds__(NTHR, 2) mk_fwd(Args args) {
    extern __shared__ __attribute__((aligned(16))) unsigned char lds[];
    Frame F;
    F.lds = (LAS unsigned char*)lds; F.MISC = (volatile LAS unsigned*)(F.lds + MISC_OFF);
    F.G = gridDim.x; { const int bx = blockIdx.x; F.vcu = (F.G % 8 == 0) ? (bx % 8) * (F.G / 8) + bx / 8 : bx; }
    F.ws = args.ws; F.ctl = (gu32*)(args.ws + WS_CTL);
    for (int u = threadIdx.x; u < (LDS_BYTES - LDSCTL_OFF) / 4; u += NTHR) ((LAS unsigned*)(F.lds + LDSCTL_OFF))[u] = 0u;
    __syncthreads();
    XcdBarrier bar; bar.bar = (unsigned*)(F.ctl + CW_BAR); bar.x = 0; bar.st = nullptr;
    if (MK_ONE_LAUNCH) bar = xcd_barrier_post((unsigned*)(F.ctl + CW_BAR), F.MISC + 8);
    const int lo = args.ph_lo, hi = args.ph_hi;
    unsigned char* ws = args.ws; (void)ws;
    if (IN(0)) { p0_tables(F, args); SEAM(0); }
    layer_body<0>(F, args, bar, lo, hi);
    layer_body<1>(F, args, bar, lo, hi);
#undef IN
#undef SEAM
}

extern "C" void kernel_launch(void* const* d_in, const int* in_sizes, int n_in, void* d_out, int out_size, void* d_ws, size_t ws_size, hipStream_t stream) {
    static int grid = 0;
    if (grid == 0) {
        if (n_in != 30 || in_sizes[0] != M * D || out_size != M * D || ws_size < WS_END) { fprintf(stderr, "kernel_launch: unexpected shapes (n_in %d, in0 %d, out %d, ws %zu, need %zu)\n", n_in, n_in > 0 ? in_sizes[0] : -1, out_size, ws_size, (size_t)WS_END); grid = -1; return; }
        int dev = 0, cus = 0, per_cu = 0;
        if (hipGetDevice(&dev) != hipSuccess || hipDeviceGetAttribute(&cus, hipDeviceAttributeMultiprocessorCount, dev) != hipSuccess) { grid = -1; return; }
        if (hipFuncSetAttribute((const void*)mk_fwd, hipFuncAttributeMaxDynamicSharedMemorySize, LDS_BYTES) != hipSuccess) { fprintf(stderr, "kernel_launch: hipFuncSetAttribute failed\n"); grid = -1; return; }
        if (hipOccupancyMaxActiveBlocksPerMultiprocessor(&per_cu, (const void*)mk_fwd, NTHR, LDS_BYTES) != hipSuccess || per_cu < 1) fprintf(stderr, "kernel_launch: occupancy query says %d\n", per_cu);
        (void)hipGetLastError();
        grid = cus;
    }
    if (grid < 0) return;
    if (hipMemsetAsync((char*)d_ws + WS_CTL, 0, CTL_ZERO_BYTES, stream) != hipSuccess) return;
    Args a{};
    for (int i = 0; i < 30; ++i) a.in[i] = d_in[i];
    a.out = (float*)d_out; a.ws = (unsigned char*)d_ws;
#if MK_ONE_LAUNCH
    a.ph_lo = 0; a.ph_hi = N_PHASES; a.li = 0;
    hipLaunchKernelGGL(mk_fwd, dim3(grid), dim3(NTHR), LDS_BYTES, stream, a);
#else
    for (int p = 0; p < N_PHASES; ++p) { a.ph_lo = p; a.ph_hi = p + 1; a.li = p; hipLaunchKernelGGL(mk_fwd, dim3(grid), dim3(NTHR), LDS_BYTES, stream, a); }
#endif
}
```

```cpp
#include <hip/hip_runtime.h>
#include <cstdio>
#include <cstdint>
namespace pg8 {
#define PG8_LAS __attribute__((address_space(3)))
typedef unsigned short bf16_t;
typedef short bf16x8 __attribute__((ext_vector_type(8)));
typedef float f32x4 __attribute__((ext_vector_type(4)));
typedef unsigned u32x4 __attribute__((ext_vector_type(4)));
constexpr int BM = 256, BK = 64, HALF = 128, HTB = HALF * BK * 2  , STAGE_BYTES = 8 * HTB, NXCD = 8, WGM = 8;

__host__ __device__ __forceinline__ int lds_byte(int r, int c) { const int st = (r >> 4) * 2 + (c >> 5), rr = r & 15, cc = c & 31, ob = rr * 64 + cc * 2; return st * 1024 + (ob ^ (((ob >> 9) & 1) << 5)); }
__host__ __device__ __forceinline__ void stage_rc(int b, int& R, int& C) { const int st = b / 1024, sb = b % 1024, swz = sb ^ (((sb >> 9) & 1) << 5); R = (st >> 1) * 16 + swz / 64; C = (st & 1) * 32 + (swz % 64) / 2; }
__host__ __device__ __forceinline__ int perm32(int rho) { const int n = rho >> 4, i = rho & 15; return 8 * (i >> 2) + 4 * n + (i & 3); }

struct Unit { int pm, pn; };
struct Gemm { const bf16_t* A; const bf16_t* Bt; int M, N, K; };

struct StaticOrder {
    int nM, nN, nwg, G, c;
    __host__ __device__ void init(int M, int N, int G_, int c_) { nM = M / BM; nN = N / BM; nwg = nM * nN; G = G_; c = c_; }
    __host__ __device__ bool next(int i, Unit& u) const {
        const long L = (long)i * G + c; if (L >= nwg) return false;
        int wgid = (int)L; { const int q = nwg / NXCD, r = nwg % NXCD, xcd = wgid % NXCD, off = wgid / NXCD; wgid = (xcd < r ? xcd * (q + 1) : r * (q + 1) + (xcd - r) * q) + off; }
        const int nig = WGM * nN, gid = wgid / nig, fm = gid * WGM, gsz = (nM - fm) < WGM ? (nM - fm) : WGM;
        u.pm = fm + ((wgid % nig) % gsz); u.pn = (wgid % nig) / gsz; return true;
    }
    __device__ __forceinline__ void a_ready(const Unit&) const {}
    __device__ __forceinline__ void done(const Unit&) const {}
};

__device__ __forceinline__ unsigned cvt_pk_bf16(float lo, float hi) { unsigned r; asm volatile("v_cvt_pk_bf16_f32 %0, %1, %2" : "=v"(r) : "v"(lo), "v"(hi)); return r; }
template <class Epi, class Sched, bool ALIGN_EPI = false, bool SP2 = false>
__device__ __forceinline__ void gemm_phase(PG8_LAS unsigned char* lds, const Gemm g, const Sched& S, const Epi& E) {
    const int tid = threadIdx.x, wid = __builtin_amdgcn_readfirstlane(tid >> 6), lane = tid & 63, wr = wid >> 2, wc = wid & 3, fr = lane & 15, fq = lane >> 4;
    const int K = g.K, nt = K / BK;
    unsigned voffA[2], voffB[2];
#pragma unroll
    for (int i = 0; i < 2; ++i) { int R, C; stage_rc(tid * 16 + i * 8192, R, C); const int Rb = Epi::PERM ? ((R & ~31) + perm32(R & 31)) : R;
        voffA[i] = (unsigned)(R * K + C) * 2u; voffB[i] = (unsigned)(Rb * K + C) * 2u; }
    const size_t kstep = (size_t)(BK * 2);
    const size_t hstep = (size_t)HALF * K * 2;
    const size_t tstep = 2 * hstep;
    const unsigned ldsw = (unsigned)wid * 1024u;
    const int aoff = lds_byte(wr * 64 + fr, fq * 8), boff = lds_byte(wc * 32 + fr, fq * 8);
#define PG8_SA(b, h) (((b) * 2 + (h)) * HTB)
#define PG8_SB(b, h) ((4 + (b) * 2 + (h)) * HTB)
#define PG8_STAGE(bufoff, gbase, voff) do { _Pragma("unroll") for (int _i = 0; _i < 2; ++_i) \
        __builtin_amdgcn_global_load_lds((const unsigned*)((const char*)(gbase) + (voff)[_i]), (PG8_LAS unsigned*)(lds + (bufoff) + ldsw + _i * 8192), 16, 0, 0); } while (0)
#define PG8_LDA(dst, b, h) do { _Pragma("unroll") for (int m = 0; m < 4; ++m) _Pragma("unroll") for (int k = 0; k < 2; ++k) dst[m][k] = *(const PG8_LAS bf16x8*)(lds + PG8_SA(b, h) + aoff + m * 2048 + k * 1024); } while (0)
#define PG8_LDB(dst, b, h) do { _Pragma("unroll") for (int n = 0; n < 2; ++n) _Pragma("unroll") for (int k = 0; k < 2; ++k) dst[n][k] = *(const PG8_LAS bf16x8*)(lds + PG8_SB(b, h) + boff + n * 2048 + k * 1024); } while (0)
#define PG8_MMA(ai, bj, At, Bt) do { __builtin_amdgcn_s_setprio(1); _Pragma("unroll") for (int m = 0; m < 4; ++m) _Pragma("unroll") for (int n = 0; n < 2; ++n) _Pragma("unroll") for (int k = 0; k < 2; ++k) \
        acc[ai][bj][m][n] = __builtin_amdgcn_mfma_f32_16x16x32_bf16(Bt[n][k], At[m][k], acc[ai][bj][m][n], 0, 0, 0); __builtin_amdgcn_s_setprio(0); } while (0)
#define PG8_WAIT_V(n) asm volatile("s_waitcnt vmcnt(" #n ")" ::: "memory")
#define PG8_WAIT_L(n) asm volatile("s_waitcnt lgkmcnt(" #n ")" ::: "memory")
#define PG8_BAR __builtin_amdgcn_s_barrier()
#define PG8_SCHED __builtin_amdgcn_sched_barrier(0)
    Unit cur, nxt; int ui = 0;
    if (!S.next(0, cur)) return;
    f32x4 acc[2][2][4][2];
#pragma unroll
    for (int a = 0; a < 2; ++a)
#pragma unroll
        for (int b = 0; b < 2; ++b)
#pragma unroll
            for (int m = 0; m < 4; ++m)
#pragma unroll
                for (int n = 0; n < 2; ++n) acc[a][b][m][n] = (f32x4){0.f, 0.f, 0.f, 0.f};
    bf16x8 At[4][2], B0[2][2], B1[2][2];
    const char* cA = (const char*)g.A + (size_t)cur.pm * tstep; const char* cB = (const char*)g.Bt + (size_t)cur.pn * tstep;
    S.a_ready(cur);
    if constexpr (SP2) {
        PG8_STAGE(PG8_SB(0, 0), cB, voffB); PG8_STAGE(PG8_SB(0, 1), cB + hstep, voffB); PG8_STAGE(PG8_SA(0, 0), cA, voffA); PG8_STAGE(PG8_SA(0, 1), cA + hstep, voffA);
        if (wr == 1) PG8_BAR;
        PG8_WAIT_V(2); PG8_BAR;
        PG8_STAGE(PG8_SB(1, 0), cB + kstep, voffB); PG8_STAGE(PG8_SA(1, 0), cA + kstep, voffA); PG8_STAGE(PG8_SB(1, 1), cB + hstep + kstep, voffB);
        PG8_WAIT_V(6); PG8_BAR;
    } else {
        PG8_STAGE(PG8_SB(0, 0), cB, voffB); PG8_STAGE(PG8_SA(0, 0), cA, voffA); PG8_STAGE(PG8_SB(0, 1), cB + hstep, voffB); PG8_STAGE(PG8_SA(0, 1), cA + hstep, voffA);
        if (wr == 1) PG8_BAR;
        PG8_WAIT_V(4); PG8_BAR;
        PG8_STAGE(PG8_SB(1, 0), cB + kstep, voffB); PG8_STAGE(PG8_SA(1, 0), cA + kstep, voffA); PG8_STAGE(PG8_SB(1, 1), cB + hstep + kstep, voffB);
        PG8_WAIT_V(6); PG8_BAR;
    }
    for (;;) {
        const bool has_next = S.next(ui + 1, nxt);
        const char* nA = has_next ? (const char*)g.A + (size_t)nxt.pm * tstep : cA; const char* nB = has_next ? (const char*)g.Bt + (size_t)nxt.pn * tstep : cB;
        for (int t = 0; t < nt; t += 2) {
            const bool last = (t == nt - 2);
            const char* a1 = cA + (size_t)(t + 1) * kstep;
            const char* a2 = last ? nA : cA + (size_t)(t + 2) * kstep; const char* b2 = last ? nB : cB + (size_t)(t + 2) * kstep;
            const char* a3 = a2 + kstep; const char* b3 = b2 + kstep;
            if (last && has_next) S.a_ready(nxt);
            if constexpr (SP2) {
            PG8_LDB(B0, 0, 0); PG8_LDB(B1, 0, 1); PG8_SCHED; PG8_LDA(At, 0, 0); PG8_STAGE(PG8_SA(1, 1), a1 + hstep, voffA);
            PG8_WAIT_V(8); PG8_WAIT_L(0); PG8_BAR; PG8_MMA(0, 0, At, B0); PG8_MMA(0, 1, At, B1); PG8_BAR; PG8_SCHED;
            PG8_LDA(At, 0, 1); PG8_STAGE(PG8_SB(0, 0), b2, voffB); PG8_STAGE(PG8_SB(0, 1), b2 + hstep, voffB); PG8_STAGE(PG8_SA(0, 0), a2, voffA);
            PG8_WAIT_V(8); PG8_WAIT_L(0); PG8_BAR; PG8_MMA(1, 0, At, B0); PG8_MMA(1, 1, At, B1); PG8_BAR; PG8_SCHED;
            PG8_LDB(B0, 1, 0); PG8_LDB(B1, 1, 1); PG8_SCHED; PG8_LDA(At, 1, 0); PG8_STAGE(PG8_SA(0, 1), a2 + hstep, voffA);
            PG8_WAIT_V(8); PG8_WAIT_L(0); PG8_BAR; PG8_MMA(0, 0, At, B0); PG8_MMA(0, 1, At, B1); PG8_BAR; PG8_SCHED;
            PG8_LDA(At, 1, 1); PG8_STAGE(PG8_SB(1, 0), b3, voffB); PG8_STAGE(PG8_SB(1, 1), b3 + hstep, voffB); PG8_STAGE(PG8_SA(1, 0), a3, voffA);
            PG8_WAIT_V(8); PG8_WAIT_L(0); PG8_BAR; PG8_MMA(1, 0, At, B0); PG8_MMA(1, 1, At, B1); PG8_BAR; PG8_SCHED;
            } else {
            PG8_LDB(B0, 0, 0); PG8_SCHED; PG8_LDA(At, 0, 0); PG8_STAGE(PG8_SA(1, 1), a1 + hstep, voffA);
            PG8_WAIT_L(8); PG8_BAR; PG8_WAIT_L(0); PG8_MMA(0, 0, At, B0); PG8_BAR; PG8_SCHED;
            PG8_LDB(B1, 0, 1); PG8_STAGE(PG8_SB(0, 0), b2, voffB);
            PG8_BAR; PG8_WAIT_L(0); PG8_MMA(0, 1, At, B1); PG8_BAR;
            PG8_LDA(At, 0, 1); PG8_STAGE(PG8_SA(0, 0), a2, voffA);
            PG8_BAR; PG8_WAIT_L(0); PG8_MMA(1, 0, At, B0); PG8_BAR; PG8_SCHED;
            PG8_STAGE(PG8_SB(0, 1), b2 + hstep, voffB);
            PG8_WAIT_V(6); PG8_BAR; PG8_MMA(1, 1, At, B1); PG8_BAR;
            PG8_LDB(B0, 1, 0); PG8_SCHED; PG8_LDA(At, 1, 0); PG8_STAGE(PG8_SA(0, 1), a2 + hstep, voffA);
            PG8_WAIT_L(8); PG8_BAR; PG8_WAIT_L(0); PG8_MMA(0, 0, At, B0); PG8_BAR; PG8_SCHED;
            PG8_LDB(B1, 1, 1); PG8_STAGE(PG8_SB(1, 0), b3, voffB);
            PG8_BAR; PG8_WAIT_L(0); PG8_MMA(0, 1, At, B1); PG8_BAR;
            PG8_LDA(At, 1, 1); PG8_STAGE(PG8_SA(1, 0), a3, voffA);
            PG8_BAR; PG8_WAIT_L(0); PG8_MMA(1, 0, At, B0); PG8_BAR; PG8_SCHED;
            PG8_STAGE(PG8_SB(1, 1), b3 + hstep, voffB);
            PG8_WAIT_V(6); PG8_BAR; PG8_MMA(1, 1, At, B1); PG8_BAR;
            }
        }
        if constexpr (ALIGN_EPI) { if (wr == 0) PG8_BAR; }
        if constexpr (!Epi::AFTER_DRAIN) { E(acc, cur, wr, wc, fr, fq); S.done(cur); }
        if (!has_next) break;
#pragma unroll
        for (int a = 0; a < 2; ++a)
#pragma unroll
            for (int b = 0; b < 2; ++b)
#pragma unroll
                for (int m = 0; m < 4; ++m)
#pragma unroll
                    for (int n = 0; n < 2; ++n) acc[a][b][m][n] = (f32x4){0.f, 0.f, 0.f, 0.f};
        cur = nxt; cA = nA; cB = nB; ++ui;
        if constexpr (ALIGN_EPI) { if (wr == 1) PG8_BAR; }
    }
    PG8_WAIT_V(0);
    if constexpr (!ALIGN_EPI) { if (wr == 0) PG8_BAR; }
    PG8_BAR;
    if constexpr (Epi::AFTER_DRAIN) { E.fused(acc, cur, wr, wc, fr, fq, lds, wid, lane); S.done(cur); }
#undef PG8_SA
#undef PG8_SB
#undef PG8_STAGE
#undef PG8_LDA
#undef PG8_LDB
#undef PG8_MMA
#undef PG8_WAIT_V
#undef PG8_WAIT_L
#undef PG8_BAR
#undef PG8_SCHED
}
template <class Epi, class Sched, bool ALIGN_EPI = false, bool SP2 = false>
__device__ __forceinline__ void gemm_phase_g(PG8_LAS unsigned char* lds, PG8_LAS unsigned char* gt, const Gemm g, const Sched& S, const Epi& E) {
    const int tid = threadIdx.x, wid = __builtin_amdgcn_readfirstlane(tid >> 6), lane = tid & 63, wr = wid >> 2, wc = wid & 3, fr = lane & 15, fq = lane >> 4;
    const int K = g.K, nt = K / BK;
    unsigned gpk[2], voffB[2];
#pragma unroll
    for (int i = 0; i < 2; ++i) { int R, C; stage_rc(tid * 16 + i * 8192, R, C); const int Rb = Epi::PERM ? ((R & ~31) + perm32(R & 31)) : R;
        gpk[i] = (unsigned)(R * 4) | ((unsigned)(C * 2) << 16); voffB[i] = (unsigned)(Rb * K + C) * 2u; }
    int par = 0;
    const size_t kstep = (size_t)(BK * 2);
    const size_t hstep = (size_t)HALF * K * 2;
    const size_t tstep = 2 * hstep;
    const unsigned ldsw = (unsigned)wid * 1024u;
    const int aoff = lds_byte(wr * 64 + fr, fq * 8), boff = lds_byte(wc * 32 + fr, fq * 8);
#define PG8_SA(b, h) (((b) * 2 + (h)) * HTB)
#define PG8_SB(b, h) ((4 + (b) * 2 + (h)) * HTB)
#define PG8_STAGE(bufoff, gbase, voff) do { _Pragma("unroll") for (int _i = 0; _i < 2; ++_i) \
        __builtin_amdgcn_global_load_lds((const unsigned*)((const char*)(gbase) + (voff)[_i]), (PG8_LAS unsigned*)(lds + (bufoff) + ldsw + _i * 8192), 16, 0, 0); } while (0)
#define PG8_STAGE_A(bufoff, h, kbyte, PAR) do { _Pragma("unroll") for (int _i = 0; _i < 2; ++_i) { \
        const unsigned _ro = *(const PG8_LAS unsigned*)(gt + ((PAR) * 256 + (h) * 128) * 4 + (gpk[_i] & 0xffffu)); \
        __builtin_amdgcn_global_load_lds((const unsigned*)((const char*)g.A + (size_t)(kbyte) + _ro + (gpk[_i] >> 16)), (PG8_LAS unsigned*)(lds + (bufoff) + ldsw + _i * 8192), 16, 0, 0); } } while (0)
#define PG8_FILL(u, PAR) do { if (tid < 256) *(PG8_LAS unsigned*)(gt + ((PAR) * 256 + tid) * 4) = S.row_off(u, tid); asm volatile("s_waitcnt lgkmcnt(0)" ::: "memory"); __builtin_amdgcn_s_barrier(); asm volatile("" ::: "memory"); } while (0)
#define PG8_LDA(dst, b, h) do { _Pragma("unroll") for (int m = 0; m < 4; ++m) _Pragma("unroll") for (int k = 0; k < 2; ++k) dst[m][k] = *(const PG8_LAS bf16x8*)(lds + PG8_SA(b, h) + aoff + m * 2048 + k * 1024); } while (0)
#define PG8_LDB(dst, b, h) do { _Pragma("unroll") for (int n = 0; n < 2; ++n) _Pragma("unroll") for (int k = 0; k < 2; ++k) dst[n][k] = *(const PG8_LAS bf16x8*)(lds + PG8_SB(b, h) + boff + n * 2048 + k * 1024); } while (0)
#define PG8_MMA(ai, bj, At, Bt) do { __builtin_amdgcn_s_setprio(1); _Pragma("unroll") for (int m = 0; m < 4; ++m) _Pragma("unroll") for (int n = 0; n < 2; ++n) _Pragma("unroll") for (int k = 0; k < 2; ++k) \
        acc[ai][bj][m][n] = __builtin_amdgcn_mfma_f32_16x16x32_bf16(Bt[n][k], At[m][k], acc[ai][bj][m][n], 0, 0, 0); __builtin_amdgcn_s_setprio(0); } while (0)
#define PG8_WAIT_V(n) asm volatile("s_waitcnt vmcnt(" #n ")" ::: "memory")
#define PG8_WAIT_L(n) asm volatile("s_waitcnt lgkmcnt(" #n ")" ::: "memory")
#define PG8_BAR __builtin_amdgcn_s_barrier()
#define PG8_SCHED __builtin_amdgcn_sched_barrier(0)
    Unit cur, nxt; int ui = 0;
    if (!S.next(0, cur)) return;
    f32x4 acc[2][2][4][2];
#pragma unroll
    for (int a = 0; a < 2; ++a)
#pragma unroll
        for (int b = 0; b < 2; ++b)
#pragma unroll
            for (int m = 0; m < 4; ++m)
#pragma unroll
                for (int n = 0; n < 2; ++n) acc[a][b][m][n] = (f32x4){0.f, 0.f, 0.f, 0.f};
    bf16x8 At[4][2], B0[2][2], B1[2][2];
    const char* cB = (const char*)g.Bt + (size_t)cur.pn * tstep;
    PG8_FILL(cur, 0);
    if constexpr (SP2) {
        PG8_STAGE(PG8_SB(0, 0), cB, voffB); PG8_STAGE(PG8_SB(0, 1), cB + hstep, voffB); PG8_STAGE_A(PG8_SA(0, 0), 0, 0, par); PG8_STAGE_A(PG8_SA(0, 1), 1, 0, par);
        if (wr == 1) PG8_BAR;
        PG8_WAIT_V(2); PG8_BAR;
        PG8_STAGE(PG8_SB(1, 0), cB + kstep, voffB); PG8_STAGE_A(PG8_SA(1, 0), 0, kstep, par); PG8_STAGE(PG8_SB(1, 1), cB + hstep + kstep, voffB);
        PG8_WAIT_V(6); PG8_BAR;
    } else {
        PG8_STAGE(PG8_SB(0, 0), cB, voffB); PG8_STAGE_A(PG8_SA(0, 0), 0, 0, par); PG8_STAGE(PG8_SB(0, 1), cB + hstep, voffB); PG8_STAGE_A(PG8_SA(0, 1), 1, 0, par);
        if (wr == 1) PG8_BAR;
        PG8_WAIT_V(4); PG8_BAR;
        PG8_STAGE(PG8_SB(1, 0), cB + kstep, voffB); PG8_STAGE_A(PG8_SA(1, 0), 0, kstep, par); PG8_STAGE(PG8_SB(1, 1), cB + hstep + kstep, voffB);
        PG8_WAIT_V(6); PG8_BAR;
    }
    for (;;) {
        const bool has_next = S.next(ui + 1, nxt);
        const char* nB = has_next ? (const char*)g.Bt + (size_t)nxt.pn * tstep : cB;
        for (int t = 0; t < nt; t += 2) {
            const bool last = (t == nt - 2);
            const char* b2 = last ? nB : cB + (size_t)(t + 2) * kstep;
            const char* b3 = b2 + kstep;
            if (last && has_next) PG8_FILL(nxt, par ^ 1);
            const size_t kA2 = last ? (size_t)0 : (size_t)(t + 2) * kstep; const int pA2 = (last && has_next) ? (par ^ 1) : par;
            if constexpr (SP2) {
            PG8_LDB(B0, 0, 0); PG8_LDB(B1, 0, 1); PG8_SCHED; PG8_LDA(At, 0, 0); PG8_STAGE_A(PG8_SA(1, 1), 1, (size_t)(t + 1) * kstep, par);
            PG8_WAIT_V(8); PG8_WAIT_L(0); PG8_BAR; PG8_MMA(0, 0, At, B0); PG8_MMA(0, 1, At, B1); PG8_BAR; PG8_SCHED;
            PG8_LDA(At, 0, 1); PG8_STAGE(PG8_SB(0, 0), b2, voffB); PG8_STAGE(PG8_SB(0, 1), b2 + hstep, voffB); PG8_STAGE_A(PG8_SA(0, 0), 0, kA2, pA2);
            PG8_WAIT_V(8); PG8_WAIT_L(0); PG8_BAR; PG8_MMA(1, 0, At, B0); PG8_MMA(1, 1, At, B1); PG8_BAR; PG8_SCHED;
            PG8_LDB(B0, 1, 0); PG8_LDB(B1, 1, 1); PG8_SCHED; PG8_LDA(At, 1, 0); PG8_STAGE_A(PG8_SA(0, 1), 1, kA2, pA2);
            PG8_WAIT_V(8); PG8_WAIT_L(0); PG8_BAR; PG8_MMA(0, 0, At, B0); PG8_MMA(0, 1, At, B1); PG8_BAR; PG8_SCHED;
            PG8_LDA(At, 1, 1); PG8_STAGE(PG8_SB(1, 0), b3, voffB); PG8_STAGE(PG8_SB(1, 1), b3 + hstep, voffB); PG8_STAGE_A(PG8_SA(1, 0), 0, kA2 + kstep, pA2);
            PG8_WAIT_V(8); PG8_WAIT_L(0); PG8_BAR; PG8_MMA(1, 0, At, B0); PG8_MMA(1, 1, At, B1); PG8_BAR; PG8_SCHED;
            } else {
            PG8_LDB(B0, 0, 0); PG8_SCHED; PG8_LDA(At, 0, 0); PG8_STAGE_A(PG8_SA(1, 1), 1, (size_t)(t + 1) * kstep, par);
            PG8_WAIT_L(8); PG8_BAR; PG8_WAIT_L(0); PG8_MMA(0, 0, At, B0); PG8_BAR; PG8_SCHED;
            PG8_LDB(B1, 0, 1); PG8_STAGE(PG8_SB(0, 0), b2, voffB);
            PG8_BAR; PG8_WAIT_L(0); PG8_MMA(0, 1, At, B1); PG8_BAR;
            PG8_LDA(At, 0, 1); PG8_STAGE_A(PG8_SA(0, 0), 0, kA2, pA2);
            PG8_BAR; PG8_WAIT_L(0); PG8_MMA(1, 0, At, B0); PG8_BAR; PG8_SCHED;
            PG8_STAGE(PG8_SB(0, 1), b2 + hstep, voffB);
            PG8_WAIT_V(6); PG8_BAR; PG8_MMA(1, 1, At, B1); PG8_BAR;
            PG8_LDB(B0, 1, 0); PG8_SCHED; PG8_LDA(At, 1, 0); PG8_STAGE_A(PG8_SA(0, 1), 1, kA2, pA2);
            PG8_WAIT_L(8); PG8_BAR; PG8_WAIT_L(0); PG8_MMA(0, 0, At, B0); PG8_BAR; PG8_SCHED;
            PG8_LDB(B1, 1, 1); PG8_STAGE(PG8_SB(1, 0), b3, voffB);
            PG8_BAR; PG8_WAIT_L(0); PG8_MMA(0, 1, At, B1); PG8_BAR;
            PG8_LDA(At, 1, 1); PG8_STAGE_A(PG8_SA(1, 0), 0, kA2 + kstep, pA2);
            PG8_BAR; PG8_WAIT_L(0); PG8_MMA(1, 0, At, B0); PG8_BAR; PG8_SCHED;
            PG8_STAGE(PG8_SB(1, 1), b3 + hstep, voffB);
            PG8_WAIT_V(6); PG8_BAR; PG8_MMA(1, 1, At, B1); PG8_BAR;
            }
        }
        if constexpr (ALIGN_EPI) { if (wr == 0) PG8_BAR; }
        if constexpr (!Epi::AFTER_DRAIN) { E(acc, cur, wr, wc, fr, fq); S.done(cur); }
        if (!has_next) break;
#pragma unroll
        for (int a = 0; a < 2; ++a)
#pragma unroll
            for (int b = 0; b < 2; ++b)
#pragma unroll
                for (int m = 0; m < 4; ++m)
#pragma unroll
                    for (int n = 0; n < 2; ++n) acc[a][b][m][n] = (f32x4){0.f, 0.f, 0.f, 0.f};
        cur = nxt; cB = nB; ++ui; par ^= 1;
        if constexpr (ALIGN_EPI) { if (wr == 1) PG8_BAR; }
    }
    PG8_WAIT_V(0);
    if constexpr (!ALIGN_EPI) { if (wr == 0) PG8_BAR; }
    PG8_BAR;
    if constexpr (Epi::AFTER_DRAIN) { E.fused(acc, cur, wr, wc, fr, fq, lds, wid, lane); S.done(cur); }
#undef PG8_SA
#undef PG8_SB
#undef PG8_STAGE
#undef PG8_STAGE_A
#undef PG8_FILL
#undef PG8_LDA
#undef PG8_LDB
#undef PG8_MMA
#undef PG8_WAIT_V
#undef PG8_WAIT_L
#undef PG8_BAR
#undef PG8_SCHED
}
}

#ifndef PG8_SP2
#define PG8_SP2 true
#endif
#ifndef PG8_ALIGN
#define PG8_ALIGN true
#endif
#ifndef MK_ONE_LAUNCH
#define MK_ONE_LAUNCH 1
#endif

constexpr int NWAVES = 8, NTHR = 512;
constexpr int BATCH = 8, T = 4096, D = 1024, M = BATCH * T, DEPTH = 2;
constexpr int PROJW = 2304, AW = 256, BW = 512, CW = 256, NH = 8, HD = 64;
constexpr int COL_U = 0, COL_V = 256, COL_Q = 512, COL_K = 1024, COL_VA = 1536, COL_S = 2048;
constexpr int NEXP = 16, DEXP = 512, NGRP = 4;
constexpr int SSM_G = 16, SSM_N = 64, SSM_C = 16;
constexpr float LN_EPS = 1e-5f;
constexpr float ALPHA = 1.41421356237309515f;
constexpr float QSCALE = 0.125f * 1.4426950408889634f;
constexpr int NSLOT_MAX = 2 * M + NEXP * 256;

constexpr size_t MiB = 1u << 20;
constexpr size_t WS_CTL = 0, CTL_ZERO_BYTES = 1 * MiB;
constexpr size_t WS_MOD = 1 * MiB;
constexpr size_t WS_ROPE = WS_MOD + 512 * 1024;
constexpr size_t WS_SSM = WS_ROPE + 2 * MiB;
constexpr int SSM_TAB = 2 * 1024 + 2 * 16384;
constexpr int SLOT_CAP = 32768;
constexpr size_t WS_SLOT_A = 4 * MiB;
constexpr size_t WS_WSMALL = 6 * MiB;
constexpr size_t WSMALL_LAYER = 7 * MiB, WOFF_IN = 0, WOFF_OUT = (size_t)PROJW * D * 2, WOFF_GLU = WOFF_OUT + (size_t)D * D * 2;
constexpr size_t WS_WGU = 20 * MiB;
constexpr size_t WS_WD = 52 * MiB;
constexpr size_t WS_XN = 68 * MiB;
constexpr size_t WS_YG = 132 * MiB;
constexpr size_t WS_R = 148 * MiB;
constexpr size_t WS_PROJ = WS_R, WS_MIXCAT = WS_R + 144 * MiB, WS_PRE = WS_R, WS_HID = WS_R + 64 * MiB, WS_X1 = WS_R + 132 * MiB;
constexpr size_t WS_ROWS2 = 356 * MiB;
constexpr size_t WS_STAT = 356 * MiB + (size_t)2 * M * D * 2;
constexpr size_t WS_SSM2 = WS_STAT + 4 * MiB;
constexpr size_t SSM2_LAYER = 3 * MiB, S2_APW = 0, S2_KT = 288 * 1024, S2_CT = S2_KT + 256 * 1024, S2_WIN = S2_CT + 64 * 1024, S2_GW = S2_WIN + 2 * MiB;
static_assert(S2_GW + 4 * 128 * 128 * 2 <= SSM2_LAYER, "ssm2 tables");
constexpr size_t WS_XLOC = WS_SSM2 + 2 * SSM2_LAYER;
constexpr size_t WS_XSUP = WS_XLOC + 8 * MiB;
constexpr size_t WS_SLOT_W = WS_XSUP + 512 * 1024;
constexpr size_t WS_END = WS_SLOT_W + 2 * MiB;
static_assert(WOFF_GLU + 256 * 256 * 2 <= WSMALL_LAYER && WS_WSMALL + 2 * WSMALL_LAYER <= WS_WGU, "ws map");
static_assert(WS_SSM + 2 * SSM_TAB * 4 <= WS_SLOT_A && WS_HID + (size_t)NSLOT_MAX * DEXP * 2 <= WS_X1 && WS_X1 + (size_t)M * D * 2 <= WS_ROWS2, "ws map 2");
constexpr int CW_TMO = 0;
constexpr int CW_BAR = 4096;
constexpr int CW_CNT = 8192;

constexpr int RING_OFF = 0, RING_BYTES = 131072;
constexpr int LDSCTL_OFF = RING_BYTES, MISC_OFF = LDSCTL_OFF + 320;
constexpr int GT_OFF = RING_BYTES + 1024;
constexpr int LDS_BYTES = 147456;

#define GAS __attribute__((address_space(1)))
#define LAS __attribute__((address_space(3)))
#define DI __device__ __forceinline__
typedef unsigned short bf16;
typedef unsigned v4u __attribute__((ext_vector_type(4)));
typedef unsigned v2u __attribute__((ext_vector_type(2)));
typedef float f32x4 __attribute__((ext_vector_type(4)));
typedef short bf16x8 __attribute__((ext_vector_type(8)));
typedef GAS unsigned gu32;
#define RLX_AGENT __ATOMIC_RELAXED, __HIP_MEMORY_SCOPE_AGENT
#define LDS_WAIT() asm volatile("s_waitcnt lgkmcnt(0)" ::: "memory")
#define VM_WAIT() asm volatile("s_waitcnt vmcnt(0)" ::: "memory")
DI unsigned f2bf(float f) { unsigned u = __builtin_bit_cast(unsigned, f); return (u + 0x7fffu + ((u >> 16) & 1u)) >> 16; }
DI unsigned pk2(float lo, float hi) { return f2bf(lo) | (f2bf(hi) << 16); }
DI float bflo(unsigned w) { return __uint_as_float(w << 16); }
DI float bfhi(unsigned w) { return __uint_as_float(w & 0xffff0000u); }
DI float bf2f(bf16 h) { return __uint_as_float((unsigned)h << 16); }
DI float wave_sum(float v) {
#pragma unroll
    for (int o = 1; o < 64; o <<= 1) v += __shfl_xor(v, o);
    return v;
}
DI float fast_rcp(float x) { return __builtin_amdgcn_rcpf(x); }
DI float sigmoid_f(float x) { return fast_rcp(1.0f + __builtin_amdgcn_exp2f(-1.4426950408889634f * x)); }
DI float silu_f(float x) { return x * sigmoid_f(x); }
DI float gelu_tanh_f(float x) { const float z2 = 1.5957691216057308f * (x + 0.044715f * x * x * x); return x * sigmoid_f(z2); }

#define XB_TMO      128
#define XB_XCNT(j)  (256  + 64 * (j))
#define XB_XSUB(j)  (1280 + 64 * (j))
#define XB_XGEN(j)  (2304 + 64 * (j))
#define XB_TOP      3328
#define XB_TOPGEN   3392
#define XCD_BAR_WORDS 3456
#define XB_SPIN_CAP (1u << 22)
DI unsigned xb_ld(unsigned* p)              { return __hip_atomic_load(p, __ATOMIC_RELAXED, __HIP_MEMORY_SCOPE_AGENT); }
DI unsigned xb_add(unsigned* p, unsigned v) { return __hip_atomic_fetch_add(p, v, __ATOMIC_RELAXED, __HIP_MEMORY_SCOPE_AGENT); }
DI unsigned xb_xcc_id() { return (unsigned)__builtin_amdgcn_s_getreg((3 << 11) | 20) & 0xFu; }
#define XB_SPIN(cond, bar) do { unsigned _sp = 0; while (cond) { __builtin_amdgcn_s_sleep(1); \
    if ((++_sp & 255u) == 0u) { if (xb_ld(&(bar)[XB_TMO])) break; if (_sp > XB_SPIN_CAP) { atomicAdd(&(bar)[XB_TMO], 1u); break; } } } } while (0)
struct XcdBarrier { unsigned* bar; unsigned x; volatile LAS unsigned* st; };
DI XcdBarrier xcd_barrier_post(unsigned* bar, volatile LAS unsigned* st) {
    XcdBarrier b; b.bar = bar; b.x = xb_xcc_id(); b.st = st;
    if (threadIdx.x == 0) (void)xb_add(&bar[XB_XCNT(b.x)], 1u);
    return b;
}
DI void xcd_barrier_complete(unsigned* bar, unsigned x, unsigned& nloc, unsigned& nx) {
    const unsigned G = gridDim.x * gridDim.y * gridDim.z;
    unsigned sum, cnt, mine, sp = 0u;
    for (;;) {
        sum = 0u; cnt = 0u; mine = 0u;
#pragma unroll
        for (unsigned j = 0; j < 16; ++j) { const unsigned c = xb_ld(&bar[XB_XCNT(j)]); sum += c; cnt += (c > 0u) ? 1u : 0u; mine = (j == x) ? c : mine; }
        if (sum == G) break;
        __builtin_amdgcn_s_sleep(1);
        if ((++sp & 255u) == 0u) { if (xb_ld(&bar[XB_TMO])) break; if (sp > XB_SPIN_CAP) { atomicAdd(&bar[XB_TMO], 1u); break; } }
    }
    nloc = mine > 0u ? mine : 1u; nx = cnt > 0u ? cnt : 1u;
}
DI void xcd_barrier(const XcdBarrier& b) {
    asm volatile("s_waitcnt vmcnt(0)" ::: "memory");
    __syncthreads();
    if (threadIdx.x == 0) {
        unsigned* bar = b.bar;
        __builtin_amdgcn_s_waitcnt(0);
        unsigned nloc = b.st[0], nx = b.st[1];
        if (nloc == 0u) { xcd_barrier_complete(bar, b.x, nloc, nx); b.st[0] = nloc; b.st[1] = nx; }
        const unsigned old = xb_add(&bar[XB_XSUB(b.x)], 1u);
        const unsigned gen = old / nloc;
        if (old + 1u == (gen + 1u) * nloc) {
            __builtin_amdgcn_fence(__ATOMIC_RELEASE, "agent");
            asm volatile("s_waitcnt vmcnt(0)" ::: "memory");
            const unsigned og = xb_add(&bar[XB_TOP], 1u);
            const unsigned tg = og / nx;
            if (og + 1u == (tg + 1u) * nx) xb_add(&bar[XB_TOPGEN], 1u);
            else XB_SPIN(xb_ld(&bar[XB_TOPGEN]) == tg, bar);
            __builtin_amdgcn_fence(__ATOMIC_ACQUIRE, "agent");
            xb_add(&bar[XB_XGEN(b.x)], 1u);
            asm volatile("s_waitcnt vmcnt(0)" ::: "memory");
        } else {
            XB_SPIN(xb_ld(&bar[XB_XGEN(b.x)]) == gen, bar);
            __builtin_amdgcn_fence(__ATOMIC_ACQUIRE, "agent");
            asm volatile("s_waitcnt vmcnt(0)" ::: "memory");
        }
    }
    __syncthreads();
}

struct Args { const void* in[30]; float* out; unsigned char* ws; int ph_lo, ph_hi, li, pad; };
enum { I_X = 0, I_C, I_POS, I_ADAW, I_ADAB, I_WIN, I_GMLNG, I_GMLNB, I_GMWS, I_GMBS, I_LAMRE, I_LAMIM, I_LOGDT, I_BRE, I_BIM, I_CRE, I_CIM, I_SSMD,
       I_GLUW, I_GLUB, I_WOUT, I_LN1G, I_LN1B, I_RW, I_RB, I_EWG, I_EWU, I_EWD, I_LN2G, I_LN2B };
struct Frame {
    LAS unsigned char* lds;
    volatile LAS unsigned* MISC;
    gu32* ctl;
    unsigned char* ws;
    int vcu, G;
};
DI int ftid() { int t = threadIdx.x; asm volatile("" : "+v"(t)); return t; }
#define FRAME_IDS const int tid_ = ftid(), lane_ = tid_ & 63, wave_ = __builtin_amdgcn_readfirstlane(tid_ >> 6); (void)lane_; (void)wave_;

template <class RowMap>
DI void transpose_item(const float* W, int K, int N, bf16* WT, const RowMap& rm, LAS float* scr, int item, int lane) {
    const int nblk = N / 32, kb = item / nblk, nb = item % nblk, k0 = 64 * kb, n0 = 32 * nb;
#pragma unroll 8
    for (int i = 0; i < 32; ++i) { const int kk = 2 * i + (lane >> 5); scr[kk * 33 + (lane & 31)] = W[(size_t)(k0 + kk) * N + n0 + (lane & 31)]; }
    LDS_WAIT(); asm volatile("" ::: "memory");
    const int c = lane & 7;
#pragma unroll
    for (int j = 0; j < 4; ++j) { const int n = (lane >> 3) + 8 * j; const LAS float* s = scr + (8 * c) * 33 + n;
        v4u o; o.x = pk2(s[0 * 33], s[1 * 33]); o.y = pk2(s[2 * 33], s[3 * 33]); o.z = pk2(s[4 * 33], s[5 * 33]); o.w = pk2(s[6 * 33], s[7 * 33]);
        *(GAS v4u*)(WT + (size_t)rm(n0 + n) * K + k0 + 8 * c) = o; }
    LDS_WAIT(); asm volatile("" ::: "memory");
}
struct RmIdent { int off; DI int operator()(int n) const { return off + n; } };
struct RmWin { DI int operator()(int n) const {
        if (n >= COL_Q && n < COL_VA) { const int d = n & 63; if (d < 16) return (n - d) + 2 * (d & 7) + (d >> 3); }
        return n; } };
struct RmGU { int e, up; DI int operator()(int n) const { return e * 1024 + (n >> 7) * 256 + (n & 127) + up * 128; } };

DI void p0_tables(Frame& F, const Args& A) {
    FRAME_IDS
    const float* c = (const float*)A.in[I_C];
    LAS float* condS = (LAS float*)(F.lds + RING_OFF);
    LAS float* red = (LAS float*)(F.lds + RING_OFF + 32768);
    for (int i = tid_; i < BATCH * D; i += NTHR) condS[i] = silu_f(c[i]);
    __syncthreads();
    float* mod = (float*)(F.ws + WS_MOD);
    for (int it = F.vcu; it < DEPTH * 96; it += F.G) {
        const int l = it / 96, jb = it % 96, ks = tid_ >> 6, jj = tid_ & 63, j = jb * 64 + jj;
        const float* w = (const float*)A.in[I_ADAW] + (size_t)l * D * 6 * D + j;
        float acc[8];
#pragma unroll
        for (int b = 0; b < 8; ++b) acc[b] = 0.f;
        for (int k = ks * 128; k < ks * 128 + 128; ++k) { const float wv = w[(size_t)k * (6 * D)];
#pragma unroll
            for (int b = 0; b < 8; ++b) acc[b] += condS[b * D + k] * wv; }
#pragma unroll
        for (int b = 0; b < 8; ++b) red[(ks * 8 + b) * 64 + jj] = acc[b];
        __syncthreads();
        { const int b = tid_ >> 6; float s = ((const float*)A.in[I_ADAB])[l * 6 * D + j];
#pragma unroll
          for (int k2 = 0; k2 < 8; ++k2) s += red[(k2 * 8 + b) * 64 + jj];
          mod[((size_t)l * BATCH + b) * 6 * D + j] = s; }
        __syncthreads();
    }
    const int gt = F.vcu * NTHR + tid_, NGT = F.G * NTHR;
    const int* pos = (const int*)A.in[I_POS]; float* rope = (float*)(F.ws + WS_ROPE);
    for (int w = gt; w < M * 8; w += NGT) { const int m = w >> 3, i = w & 7;
        const float freq = exp2f(-(float)i * 0.125f * 18.931568569324174f);
        const float ang = (float)pos[m] * freq; float s, cs; sincosf(ang, &s, &cs);
        rope[m * 16 + i] = cs; rope[m * 16 + 8 + i] = s; }
    for (int w = gt; w < DEPTH * 16 * 33 * 64; w += NGT) { const int n = w & 63, m = (w >> 6) % 33, g = ((w >> 6) / 33) & 15, l = (w >> 6) / (33 * 16);
        const int li = (l * 16 + g) * 64 + n;
        const float lre = ((const float*)A.in[I_LAMRE])[li], lim = ((const float*)A.in[I_LAMIM])[li], dt = expf(((const float*)A.in[I_LOGDT])[l * 16 + g]);
        const float mag = expf((float)m * (lre * dt)); float sn, cs; sincosf((float)m * (lim * dt), &sn, &cs);
        float* apw = (float*)(F.ws + WS_SSM2 + l * SSM2_LAYER + S2_APW) + ((size_t)(g * 33 + m) * 64 + n) * 2; apw[0] = mag * cs; apw[1] = mag * sn; }
    for (int w = gt; w < DEPTH * SSM_G * SSM_N; w += NGT) { const int l = w / 1024, gn = w % 1024, g = gn >> 6;
        float* tab = (float*)(F.ws + WS_SSM) + (size_t)l * SSM_TAB;
        const float lre = ((const float*)A.in[I_LAMRE])[w], lim = ((const float*)A.in[I_LAMIM])[w];
        const float dt = expf(((const float*)A.in[I_LOGDT])[l * 16 + g]);
        const float mag = expf(lre * dt); float sn, cs; sincosf(lim * dt, &sn, &cs);
        const float are = mag * cs, aim = mag * sn, nr = are - 1.0f, ni = aim, mod2 = lre * lre + lim * lim;
        const float fre = (nr * lre + ni * lim) / mod2, fim = (ni * lre - nr * lim) / mod2;
        tab[gn] = are; tab[1024 + gn] = aim;
        const float* bre = (const float*)A.in[I_BRE] + (size_t)w * 16; const float* bim = (const float*)A.in[I_BIM] + (size_t)w * 16;
#pragma unroll
        for (int cc = 0; cc < 16; ++cc) { tab[2048 + gn * 16 + cc] = fre * bre[cc] - fim * bim[cc]; tab[2048 + 16384 + gn * 16 + cc] = fre * bim[cc] + fim * bre[cc]; } }
}

DI void p_wconv(Frame& F, const Args& A, int l) {
    FRAME_IDS
    {
        const int gt = F.vcu * NTHR + tid_, NGT = F.G * NTHR;
        const float* tab = (const float*)(F.ws + WS_SSM) + (size_t)l * SSM_TAB;
        const float* apw = (const float*)(F.ws + WS_SSM2 + l * SSM2_LAYER + S2_APW);
        const float* cre = (const float*)A.in[I_CRE] + (size_t)l * 16 * 16 * 64; const float* cim = (const float*)A.in[I_CIM] + (size_t)l * 16 * 16 * 64;
        bf16* KT = (bf16*)(F.ws + WS_SSM2 + l * SSM2_LAYER + S2_KT); bf16* CT = (bf16*)(F.ws + WS_SSM2 + l * SSM2_LAYER + S2_CT);
        bf16* WIN = (bf16*)(F.ws + WS_SSM2 + l * SSM2_LAYER + S2_WIN); bf16* GW = (bf16*)(F.ws + WS_SSM2 + l * SSM2_LAYER + S2_GW);
        for (int w = gt; w < 16 * 16 * 64 * 8; w += NGT) { const int j = w & 7, ln = (w >> 3) & 63, p = (w >> 9) & 15, g = w >> 13;
            const int co = ln & 15, q = ln >> 4, m = 2 * p + (q >> 1), ci = 8 * (q & 1) + j; float acc = 0.f;
            for (int n = 0; n < 64; ++n) { const int gn = g * 64 + n; const float ar = apw[((g * 33 + m) * 64 + n) * 2], ai = apw[((g * 33 + m) * 64 + n) * 2 + 1];
                const float br = tab[2048 + gn * 16 + ci], bi = tab[2048 + 16384 + gn * 16 + ci], tre = ar * br - ai * bi, tim = ar * bi + ai * br;
                acc += cre[(g * 16 + co) * 64 + n] * tre - cim[(g * 16 + co) * 64 + n] * tim; }
            KT[w] = (bf16)f2bf(acc); }
        for (int w = gt; w < 16 * 4 * 64 * 8; w += NGT) { const int j = w & 7, ln = (w >> 3) & 63, sx = (w >> 9) & 3, g = w >> 11;
            const int co = ln & 15, q = ln >> 4, n = 16 * sx + 4 * q + (j >> 1);
            CT[w] = (bf16)f2bf((j & 1) ? -cim[(g * 16 + co) * 64 + n] : cre[(g * 16 + co) * 64 + n]); }
        for (int w = gt; w < 16 * 16 * 8 * 64 * 8; w += NGT) { const int jj = w & 7, ln = (w >> 3) & 63, ct = (w >> 9) & 7, sp = (w >> 12) & 15, g = w >> 16;
            const int cc = ln & 15, q = ln >> 4, n = 8 * ct + (cc >> 1), part = cc & 1, tj = 2 * sp + (q >> 1), ci = 8 * (q & 1) + jj, gn = g * 64 + n, m = 31 - tj;
            const float ar = apw[((g * 33 + m) * 64 + n) * 2], ai = apw[((g * 33 + m) * 64 + n) * 2 + 1], br = tab[2048 + gn * 16 + ci], bi = tab[2048 + 16384 + gn * 16 + ci];
            WIN[w] = (bf16)f2bf(part ? (ar * bi + ai * br) : (ar * br - ai * bi)); }
        const float* gws = (const float*)A.in[I_GMWS] + (size_t)l * 4 * 128 * 128;
        for (int w = gt; w < 4 * 128 * 128; w += NGT) { const int sx = w & 127, t = (w >> 7) & 127; GW[w] = (bf16)f2bf(sx <= t ? gws[w] : 0.f); }
    }
    LAS float* scr = (LAS float*)(F.lds + RING_OFF + wave_ * 16384);
    const int gw = F.vcu * NWAVES + wave_, NGW = F.G * NWAVES;
    bf16* WinT = (bf16*)(F.ws + WS_WSMALL + l * WSMALL_LAYER + WOFF_IN);
    bf16* WoutT = (bf16*)(F.ws + WS_WSMALL + l * WSMALL_LAYER + WOFF_OUT);
    bf16* GluT = (bf16*)(F.ws + WS_WSMALL + l * WSMALL_LAYER + WOFF_GLU);
    bf16* WguT = (bf16*)(F.ws + WS_WGU); bf16* WdT = (bf16*)(F.ws + WS_WD);
    constexpr int I_IN = 16 * 72, I_OUTW = 16 * 32, I_GLU = 4 * 8, I_G = 16 * 16, I_DN = 8 * 32;
    constexpr int NIT = I_IN + I_OUTW + I_GLU + 16 * (2 * I_G + I_DN);
    for (int it = gw; it < NIT; it += NGW) {
        int r = it;
        if (r < I_IN) { transpose_item((const float*)A.in[I_WIN] + (size_t)l * D * PROJW, D, PROJW, WinT, RmWin{}, scr, r, lane_); continue; } r -= I_IN;
        if (r < I_OUTW) { transpose_item((const float*)A.in[I_WOUT] + (size_t)l * D * D, D, D, WoutT, RmIdent{0}, scr, r, lane_); continue; } r -= I_OUTW;
        if (r < I_GLU) { transpose_item((const float*)A.in[I_GLUW] + (size_t)l * 256 * 256, 256, 256, GluT, RmIdent{0}, scr, r, lane_); continue; } r -= I_GLU;
        const int e = r / (2 * I_G + I_DN); r -= e * (2 * I_G + I_DN);
        const size_t eo = ((size_t)l * NEXP + e) * D * DEXP;
        if (r < I_G) { transpose_item((const float*)A.in[I_EWG] + eo, D, DEXP, WguT, RmGU{e, 0}, scr, r, lane_); continue; } r -= I_G;
        if (r < I_G) { transpose_item((const float*)A.in[I_EWU] + eo, D, DEXP, WguT, RmGU{e, 1}, scr, r, lane_); continue; } r -= I_G;
        transpose_item((const float*)A.in[I_EWD] + eo, DEXP, D, WdT, RmIdent{e * 1024}, scr, r, lane_);
    }
}

typedef float f32x2_t __attribute__((ext_vector_type(2)));
typedef __bf16 bf16x2_t __attribute__((ext_vector_type(2)));
DI unsigned cvtpk(float lo, float hi) { f32x2_t v = {lo, hi}; bf16x2_t b = __builtin_convertvector(v, bf16x2_t); return __builtin_bit_cast(unsigned, b); }
struct Row16 { float v[16]; };
DI void row_load_f32(Row16& r, const float* p, int lane) {
    const f32x4* q = (const f32x4*)p;
#pragma unroll
    for (int k = 0; k < 4; ++k) { const f32x4 a = q[k * 64 + lane]; r.v[4 * k] = a.x; r.v[4 * k + 1] = a.y; r.v[4 * k + 2] = a.z; r.v[4 * k + 3] = a.w; }
}
DI void row_load_bf16(Row16& r, const bf16* p, int lane) {
    const v2u* q = (const v2u*)p;
#pragma unroll
    for (int k = 0; k < 4; ++k) { const v2u a = q[k * 64 + lane]; r.v[4 * k] = bflo(a.x); r.v[4 * k + 1] = bfhi(a.x); r.v[4 * k + 2] = bflo(a.y); r.v[4 * k + 3] = bfhi(a.y); }
}
DI void row_store_bf16(const Row16& r, bf16* p, int lane) {
    v2u* q = (v2u*)p;
#pragma unroll
    for (int k = 0; k < 4; ++k) { v2u o; o.x = cvtpk(r.v[4 * k], r.v[4 * k + 1]); o.y = cvtpk(r.v[4 * k + 2], r.v[4 * k + 3]); q[k * 64 + lane] = o; }
}
DI void row_store_f32(const Row16& r, float* p, int lane) {
    f32x4* q = (f32x4*)p;
#pragma unroll
    for (int k = 0; k < 4; ++k) q[k * 64 + lane] = (f32x4){r.v[4 * k], r.v[4 * k + 1], r.v[4 * k + 2], r.v[4 * k + 3]};
}
DI void row_ln(Row16& r) {
    float s = 0.f;
#pragma unroll
    for (int i = 0; i < 16; ++i) s += r.v[i];
    const float mean = wave_sum(s) * (1.f / D); float s2 = 0.f;
#pragma unroll
    for (int i = 0; i < 16; ++i) { r.v[i] -= mean; s2 += r.v[i] * r.v[i]; }
    const float rstd = 1.0f / sqrtf(wave_sum(s2) * (1.f / D) + LN_EPS);
#pragma unroll
    for (int i = 0; i < 16; ++i) r.v[i] *= rstd;
}
DI void row_mod(Row16& r, const float* a, const float* b, int lane) {
    Row16 av, bv; row_load_f32(av, a, lane); row_load_f32(bv, b, lane);
#pragma unroll
    for (int i = 0; i < 16; ++i) r.v[i] = r.v[i] * (1.0f + av.v[i]) + bv.v[i];
}
DI void row_affine(Row16& r, const float* g, const float* b, int lane) {
    Row16 av, bv; row_load_f32(av, g, lane); row_load_f32(bv, b, lane);
#pragma unroll
    for (int i = 0; i < 16; ++i) r.v[i] = r.v[i] * av.v[i] + bv.v[i];
}

DI void p_ln_a0(Frame& F, const Args& A) {
    FRAME_IDS
    const int gw = F.vcu * NWAVES + wave_, NGW = F.G * NWAVES;
    const float* x = (const float*)A.in[I_X]; bf16* XN = (bf16*)(F.ws + WS_XN); const float* mod = (const float*)(F.ws + WS_MOD);
    for (int m = gw; m < M; m += NGW) { const int b = m / T; const float* md = mod + (size_t)b * 6 * D;
        Row16 r; row_load_f32(r, x + (size_t)m * D, lane_); row_ln(r); row_mod(r, md + 1 * D, md + 0 * D, lane_); row_store_bf16(r, XN + (size_t)m * D, lane_); }
}

using pg8::Unit; using pg8::BM; using pg8::HALF;
struct EpiInProj {
    static constexpr bool PERM = true, AFTER_DRAIN = false;
    bf16* P; const float* rope;
    DI void operator()(const pg8::f32x4 (&acc)[2][2][4][2], const Unit& u, int wr, int wc, int fr, int fq) const {
        const int row0 = u.pm * BM + wr * 64 + fr, pn = u.pn;
        const bool isrope = (pn >= 2 && pn <= 5), dorope = isrope && ((wc & 1) == 0) && (fq < 2);
        const float sc = (pn == 2 || pn == 3) ? QSCALE : 1.0f;
#pragma unroll
        for (int ai = 0; ai < 2; ++ai)
#pragma unroll
            for (int m = 0; m < 4; ++m) { const int row = row0 + ai * HALF + m * 16; bf16* rowp = P + (size_t)row * PROJW + pn * BM + wc * 32 + 8 * fq;
                f32x4 cs = (f32x4){1.f, 1.f, 1.f, 1.f}, sn = (f32x4){0.f, 0.f, 0.f, 0.f};
                if (isrope) { const float* rp = rope + (size_t)row * 16 + 4 * (fq & 1); cs = *(const f32x4*)rp; sn = *(const f32x4*)(rp + 8); }
#pragma unroll
                for (int bj = 0; bj < 2; ++bj) { pg8::f32x4 v0 = acc[ai][bj][m][0], v1 = acc[ai][bj][m][1];
                    if (pn < 2) {
#pragma unroll
                        for (int i = 0; i < 4; ++i) { v0[i] = gelu_tanh_f(v0[i]); v1[i] = gelu_tanh_f(v1[i]); }
                    } else if (isrope) {
                        if (dorope) { const float a0 = v0[0] * cs.x - v0[1] * sn.x, b0 = v0[1] * cs.x + v0[0] * sn.x, a1 = v0[2] * cs.y - v0[3] * sn.y, b1 = v0[3] * cs.y + v0[2] * sn.y;
                            const float a2 = v1[0] * cs.z - v1[1] * sn.z, b2 = v1[1] * cs.z + v1[0] * sn.z, a3 = v1[2] * cs.w - v1[3] * sn.w, b3 = v1[3] * cs.w + v1[2] * sn.w;
                            v0 = (pg8::f32x4){a0, b0, a1, b1}; v1 = (pg8::f32x4){a2, b2, a3, b3}; }
                        v0 = v0 * sc; v1 = v1 * sc;
                    }
                    pg8::u32x4 w; w.x = pg8::cvt_pk_bf16(v0[0], v0[1]); w.y = pg8::cvt_pk_bf16(v0[2], v0[3]); w.z = pg8::cvt_pk_bf16(v1[0], v1[1]); w.w = pg8::cvt_pk_bf16(v1[2], v1[3]);
                    *(pg8::u32x4*)(rowp + bj * HALF) = w; } }
    }
};
template <bool XF32> struct EpiOut {
    static constexpr bool PERM = true, AFTER_DRAIN = false;
    bf16* PRE; const void* x; int xpitch; const float* mod;
    DI void operator()(const pg8::f32x4 (&acc)[2][2][4][2], const Unit& u, int wr, int wc, int fr, int fq) const {
        const int row0 = u.pm * BM + wr * 64 + fr, b = (u.pm * BM) / T, colb = u.pn * BM + wc * 32 + 8 * fq;
        const float* g1 = mod + (size_t)b * 6 * D + 2 * D;
        pg8::f32x4 gv[2][2];
#pragma unroll
        for (int bj = 0; bj < 2; ++bj) { gv[bj][0] = *(const pg8::f32x4*)(g1 + colb + bj * HALF) + 1.0f; gv[bj][1] = *(const pg8::f32x4*)(g1 + colb + bj * HALF + 4) + 1.0f; }
#pragma unroll
        for (int ai = 0; ai < 2; ++ai)
#pragma unroll
            for (int m = 0; m < 4; ++m) { const int row = row0 + ai * HALF + m * 16;
#pragma unroll
                for (int bj = 0; bj < 2; ++bj) { const int col = colb + bj * HALF; pg8::f32x4 x0, x1;
                    if (XF32) { const float* xp = (const float*)x + (size_t)row * xpitch + col; x0 = *(const pg8::f32x4*)xp; x1 = *(const pg8::f32x4*)(xp + 4); }
                    else { const pg8::u32x4 xw = *(const pg8::u32x4*)((const bf16*)x + (size_t)row * xpitch + col);
                        x0 = (pg8::f32x4){bflo(xw.x), bfhi(xw.x), bflo(xw.y), bfhi(xw.y)}; x1 = (pg8::f32x4){bflo(xw.z), bfhi(xw.z), bflo(xw.w), bfhi(xw.w)}; }
                    const pg8::f32x4 v0 = x0 * ALPHA + gv[bj][0] * acc[ai][bj][m][0], v1 = x1 * ALPHA + gv[bj][1] * acc[ai][bj][m][1];
                    pg8::u32x4 w; w.x = pg8::cvt_pk_bf16(v0[0], v0[1]); w.y = pg8::cvt_pk_bf16(v0[2], v0[3]); w.z = pg8::cvt_pk_bf16(v1[0], v1[1]); w.w = pg8::cvt_pk_bf16(v1[2], v1[3]);
                    *(pg8::u32x4*)(PRE + (size_t)row * D + col) = w; } }
    }
};
struct EpiGlu {
    static constexpr bool PERM = true, AFTER_DRAIN = false;
    const bf16* YG; bf16* MIX; const float* gb;
    DI void operator()(const pg8::f32x4 (&acc)[2][2][4][2], const Unit& u, int wr, int wc, int fr, int fq) const {
        const int row0 = u.pm * BM + wr * 64 + fr, colb = wc * 32 + 8 * fq;
#pragma unroll
        for (int ai = 0; ai < 2; ++ai)
#pragma unroll
            for (int m = 0; m < 4; ++m) { const int row = row0 + ai * HALF + m * 16;
#pragma unroll
                for (int bj = 0; bj < 2; ++bj) { const int col = colb + bj * HALF;
                    const pg8::u32x4 yw = *(const pg8::u32x4*)(YG + (size_t)row * 256 + col);
                    const pg8::f32x4 b0 = *(const pg8::f32x4*)(gb + col), b1 = *(const pg8::f32x4*)(gb + col + 4);
                    const pg8::f32x4 a0 = acc[ai][bj][m][0] + b0, a1 = acc[ai][bj][m][1] + b1;
                    const float y[8] = {bflo(yw.x), bfhi(yw.x), bflo(yw.y), bfhi(yw.y), bflo(yw.z), bfhi(yw.z), bflo(yw.w), bfhi(yw.w)};
                    float o[8];
#pragma unroll
                    for (int i = 0; i < 4; ++i) { o[i] = y[i] * sigmoid_f(a0[i]); o[4 + i] = y[4 + i] * sigmoid_f(a1[i]); }
                    pg8::u32x4 w; w.x = pg8::cvt_pk_bf16(o[0], o[1]); w.y = pg8::cvt_pk_bf16(o[2], o[3]); w.z = pg8::cvt_pk_bf16(o[4], o[5]); w.w = pg8::cvt_pk_bf16(o[6], o[7]);
                    *(pg8::u32x4*)(MIX + (size_t)row * D + 768 + col) = w; asm volatile("" ::: "memory"); } }
    }
};
struct MoeOrder {
    const volatile LAS int* ts; int G, c; const int* slot_a; unsigned rowbytes;
    DI bool next(int i, Unit& u) const {
        const int nwg = ts[16] * 4; const long L = (long)i * G + c; if (L >= nwg) return false;
        int wgid = (int)L; { const int q = nwg / 8, r = nwg % 8, xcd = wgid % 8, off = wgid / 8; wgid = (xcd < r ? xcd * (q + 1) : r * (q + 1) + (xcd - r) * q) + off; }
        const int tm = wgid >> 2, j = wgid & 3; int e = 0;
#pragma unroll
        for (int k = 1; k < 16; ++k) e += (ts[k] <= tm) ? 1 : 0;
        u.pm = tm; u.pn = e * 4 + j; return true;
    }
    DI unsigned row_off(const Unit& u, int r) const {
        const int e = u.pn >> 2, idx = (u.pm - ts[e]) * 256 + r;
        const int tok = (idx < ts[32 + e]) ? (slot_a[(size_t)e * SLOT_CAP + idx] >> 1) : 0;
        return (unsigned)tok * rowbytes;
    }
    DI void a_ready(const Unit&) const {}
    DI void done(const Unit&) const {}
};
struct EpiG1 {
    static constexpr bool PERM = true, AFTER_DRAIN = false;
    bf16* HID;
    DI void operator()(const pg8::f32x4 (&acc)[2][2][4][2], const Unit& u, int wr, int wc, int fr, int fq) const {
        const int row0 = u.pm * BM + wr * 64 + fr, col = (u.pn & 3) * 128 + wc * 32 + 8 * fq;
#pragma unroll
        for (int ai = 0; ai < 2; ++ai)
#pragma unroll
            for (int m = 0; m < 4; ++m) { const int row = row0 + ai * HALF + m * 16; float o[8];
#pragma unroll
                for (int i = 0; i < 4; ++i) { o[i] = silu_f(acc[ai][0][m][0][i]) * acc[ai][1][m][0][i]; o[4 + i] = silu_f(acc[ai][0][m][1][i]) * acc[ai][1][m][1][i]; }
                pg8::u32x4 w; w.x = pg8::cvt_pk_bf16(o[0], o[1]); w.y = pg8::cvt_pk_bf16(o[2], o[3]); w.z = pg8::cvt_pk_bf16(o[4], o[5]); w.w = pg8::cvt_pk_bf16(o[6], o[7]);
                *(pg8::u32x4*)(HID + (size_t)row * DEXP + col) = w; }
    }
};
struct EpiG2 {
    static constexpr bool PERM = true, AFTER_DRAIN = false;
    bf16* ROWS; const int* slot_a; const float* slot_w; const volatile LAS int* ts;
    DI void operator()(const pg8::f32x4 (&acc)[2][2][4][2], const Unit& u, int wr, int wc, int fr, int fq) const {
        const int e = u.pn >> 2, idx0 = (u.pm - ts[e]) * 256 + wr * 64 + fr, cnt = ts[32 + e], colb = (u.pn & 3) * BM + wc * 32 + 8 * fq;
#pragma unroll
        for (int ai = 0; ai < 2; ++ai)
#pragma unroll
            for (int m = 0; m < 4; ++m) { const int idx = idx0 + ai * HALF + m * 16;
                if (idx < cnt) { const int d = slot_a[(size_t)e * SLOT_CAP + idx]; const float wt = slot_w[(size_t)e * SLOT_CAP + idx];
#pragma unroll
                    for (int bj = 0; bj < 2; ++bj) { const pg8::f32x4 v0 = acc[ai][bj][m][0] * wt, v1 = acc[ai][bj][m][1] * wt;
                        pg8::u32x4 w; w.x = pg8::cvt_pk_bf16(v0[0], v0[1]); w.y = pg8::cvt_pk_bf16(v0[2], v0[3]); w.z = pg8::cvt_pk_bf16(v1[0], v1[1]); w.w = pg8::cvt_pk_bf16(v1[2], v1[3]);
                        *(pg8::u32x4*)(ROWS + (size_t)d * D + colb + bj * HALF) = w; } } }
    }
};

DI void mix_gating_simple(Frame& F, const Args& A, int l) {
    FRAME_IDS
    const bf16* P = (const bf16*)(F.ws + WS_PROJ); bf16* MIX = (bf16*)(F.ws + WS_MIXCAT);
    const float* lng = (const float*)A.in[I_GMLNG] + l * AW; const float* lnb = (const float*)A.in[I_GMLNB] + l * AW;
    const float* ws_ = (const float*)A.in[I_GMWS] + (size_t)l * 4 * 128 * 128; const float* bs_ = (const float*)A.in[I_GMBS] + l * 4 * 128;
    LAS float* vln = (LAS float*)(F.lds + RING_OFF);
    for (int it = F.vcu; it < BATCH * (T / 128); it += F.G) {
        const int m0 = it * 128;
        for (int r = wave_; r < 128; r += NWAVES) {
            const v2u w = *(const v2u*)(P + (size_t)(m0 + r) * PROJW + COL_V + 4 * lane_);
            float v[4] = {bflo(w.x), bfhi(w.x), bflo(w.y), bfhi(w.y)};
            const float mean = wave_sum(v[0] + v[1] + v[2] + v[3]) * (1.f / 256.f);
            float s2 = 0.f;
#pragma unroll
            for (int i = 0; i < 4; ++i) { v[i] -= mean; s2 += v[i] * v[i]; }
            const float rstd = 1.0f / sqrtf(wave_sum(s2) * (1.f / 256.f) + LN_EPS);
#pragma unroll
            for (int i = 0; i < 4; ++i) vln[r * 256 + 4 * lane_ + i] = v[i] * rstd * lng[4 * lane_ + i] + lnb[4 * lane_ + i];
        }
        __syncthreads();
        { const int c = tid_ & 255, tp = tid_ >> 8, h = c >> 6;
          for (int t = tp; t < 128; t += 2) { const float* wrow = ws_ + ((size_t)h * 128 + t) * 128; float acc = 0.f;
              for (int s = 0; s <= t; ++s) acc += wrow[s] * vln[s * 256 + c];
              const float uu = bf2f(P[(size_t)(m0 + t) * PROJW + COL_U + c]);
              MIX[(size_t)(m0 + t) * D + c] = (bf16)f2bf(uu * (acc + bs_[h * 128 + t])); } }
        __syncthreads();
    }
}
DI void mix_attn_simple(Frame& F, int l) {
    FRAME_IDS
    const bf16* P = (const bf16*)(F.ws + WS_PROJ); bf16* MIX = (bf16*)(F.ws + WS_MIXCAT);
    const int gw = F.vcu * NWAVES + wave_, NGW = F.G * NWAVES;
    for (int it = gw; it < M * NH; it += NGW) {
        const int m = it >> 3, h = it & 7, t = m & (T - 1);
        const float q = bf2f(P[(size_t)m * PROJW + COL_Q + h * 64 + lane_]);
        float mx = -1e30f, den = 0.f, o = 0.f;
#pragma unroll 1
        for (int g = 0; g < 3; ++g) { const int dl = (g == 0) ? 1 : (g == 1 ? 4 : 16);
            int nk = t / dl; if (nk > 128) nk = 128;
#pragma unroll 2
            for (int j = 0; j <= nk; ++j) { const size_t mk = (size_t)(m - j * dl);
                const float kv = bf2f(P[mk * PROJW + COL_K + h * 64 + lane_]); const float vv = bf2f(P[mk * PROJW + COL_VA + h * 64 + lane_]);
                const float s = wave_sum(q * kv);
                const float mn = fmaxf(mx, s), f = __builtin_amdgcn_exp2f(mx - mn), p = __builtin_amdgcn_exp2f(s - mn);
                den = den * f + p; o = o * f + p * vv; mx = mn; } }
        MIX[(size_t)m * D + AW + h * 64 + lane_] = (bf16)f2bf(o / den);
    }
}

typedef float f32x16 __attribute__((ext_vector_type(16)));
typedef short v4i16_t __attribute__((ext_vector_type(4)));
DI int crow16(int r, int hi) { return (r & 3) + 8 * (r >> 2) + 4 * hi; }
template <int SUB> DI void mix_attn_mfma(Frame& F, int l) {
    FRAME_IDS
    const bf16* P = (const bf16*)(F.ws + WS_PROJ);
    LAS unsigned char* Ks = F.lds + RING_OFF; LAS unsigned char* Vs = Ks + 49152;
    const int ql = lane_ & 31, hi = lane_ >> 5;
    constexpr int nitems = SUB == 0 ? 2048 : 1024;
    v4u kreg[6], vreg[6]; bf16x8 qn[4], qf[4];
    int it = F.vcu; if (it >= nitems) return;
    int d, r, s0, b, h; size_t tokbase;
#define ATT_DECODE(IT) do { const int idx_ = (IT) & 1023; b = idx_ >> 7; h = (idx_ >> 4) & 7; int tile_; \
        if (SUB == 1) { d = 1; r = 0; tile_ = idx_ & 15; } else if ((IT) < 1024) { d = 16; r = idx_ & 15; tile_ = 0; } else { d = 4; r = (idx_ >> 2) & 3; tile_ = idx_ & 3; } \
        s0 = tile_ * 256; tokbase = (size_t)b * T + r; } while (0)
#define ATT_LOAD() do { _Pragma("unroll") for (int i = 0; i < 6; ++i) { const int idx2 = tid_ + 512 * i, row = idx2 >> 3, ch = idx2 & 7, step = s0 - 128 + row; \
            if (step >= 0) { const bf16* src = P + (tokbase + (size_t)step * d) * PROJW + h * 64 + ch * 8; kreg[i] = *(const v4u*)(src + COL_K); vreg[i] = *(const v4u*)(src + COL_VA); } \
            else { kreg[i] = (v4u){0u, 0u, 0u, 0u}; vreg[i] = (v4u){0u, 0u, 0u, 0u}; } } \
        { const bf16* qsrc = P + (tokbase + (size_t)(s0 + 32 * wave_ + ql) * d) * PROJW + COL_Q + h * 64 + hi * 8; \
          _Pragma("unroll") for (int ks = 0; ks < 4; ++ks) qn[ks] = *(const bf16x8*)(qsrc + ks * 16); } } while (0)
#define ATT_WRITE() do { _Pragma("unroll") for (int i = 0; i < 6; ++i) { const int idx2 = tid_ + 512 * i, row = idx2 >> 3, ch = idx2 & 7; \
            *(LAS v4u*)(Ks + row * 128 + ((ch ^ ((row >> 1) & 7)) << 4)) = kreg[i]; \
            *(LAS v4u*)(Vs + row * 128 + ((ch ^ (((row >> 1) & 1) << 2)) << 4)) = vreg[i]; } \
        _Pragma("unroll") for (int ks = 0; ks < 4; ++ks) qf[ks] = qn[ks]; } while (0)
    ATT_DECODE(it); ATT_LOAD(); ATT_WRITE();
    __syncthreads();
    for (;;) {
        const size_t qtok = tokbase + (size_t)(s0 + 32 * wave_ + ql) * d;
        const bool first = (s0 == 0); const int hcur = h, itcur = it;
        const int itn = it + F.G; const bool has_next = itn < nitems;
        if (has_next) { ATT_DECODE(itn); ATT_LOAD(); }
        const int i0 = 32 * wave_;
        f32x16 S[5];
#pragma unroll
        for (int kb = 0; kb < 5; ++kb) { f32x16 acc;
#pragma unroll
            for (int i = 0; i < 16; ++i) acc[i] = 0.f;
            const int krow = i0 + 32 * kb + ql;
#pragma unroll
            for (int ks = 0; ks < 4; ++ks) { const bf16x8 a = *(const LAS bf16x8*)(Ks + krow * 128 + (((2 * ks + hi) ^ ((krow >> 1) & 7)) << 4)); acc = __builtin_amdgcn_mfma_f32_32x32x16_bf16(a, qf[ks], acc, 0, 0, 0); }
            S[kb] = acc; }
        int qrel = ql - 4 * hi; asm volatile("" : "+v"(qrel));
        float mx = -1e30f;
#pragma unroll
        for (int kb = 0; kb < 5; ++kb) {
            const bool bvalid = !first || (wave_ + kb >= 4);
            if (!bvalid) {
#pragma unroll
                for (int i = 0; i < 16; ++i) S[kb][i] = -1e30f;
            } else {
#pragma unroll
                for (int i = 0; i < 16; ++i) { const int c0 = crow16(i, 0); float v = S[kb][i];
                    if (kb == 0) v = (c0 >= qrel) ? v : -1e30f;
                    if (kb == 4) v = (c0 <= qrel) ? v : -1e30f;
                    S[kb][i] = v; mx = fmaxf(mx, v); }
            }
        }
        mx = fmaxf(mx, __shfl_xor(mx, 32));
        float lsum = 0.f;
#pragma unroll
        for (int kb = 0; kb < 5; ++kb)
#pragma unroll
            for (int i = 0; i < 16; ++i) { const float p = __builtin_amdgcn_exp2f(S[kb][i] - mx); S[kb][i] = p; lsum += p; }
        lsum += __shfl_xor(lsum, 32);
        f32x16 O[2];
#pragma unroll
        for (int i = 0; i < 16; ++i) { O[0][i] = 0.f; O[1][i] = 0.f; }
        const int trq = (lane_ & 15) >> 2, trg = (lane_ >> 4) & 1, trp = lane_ & 3;
#pragma unroll
        for (int kb = 0; kb < 5; ++kb)
#pragma unroll
            for (int s = 0; s < 2; ++s) {
                v4u pw; pw.x = cvtpk(S[kb][8 * s], S[kb][8 * s + 1]); pw.y = cvtpk(S[kb][8 * s + 2], S[kb][8 * s + 3]); pw.z = cvtpk(S[kb][8 * s + 4], S[kb][8 * s + 5]); pw.w = cvtpk(S[kb][8 * s + 6], S[kb][8 * s + 7]);
                const bf16x8 pb = __builtin_bit_cast(bf16x8, pw);
                const int rlo = i0 + 32 * kb + 16 * s + 4 * hi + trq, rhi = rlo + 8;
#pragma unroll
                for (int dh = 0; dh < 2; ++dh) { const int chunk = 4 * dh + 2 * trg + (trp >> 1);
                    const v4i16_t lo = __builtin_amdgcn_ds_read_tr16_b64_v4i16((LAS v4i16_t*)(Vs + rlo * 128 + ((chunk ^ (((rlo >> 1) & 1) << 2)) << 4) + 8 * (trp & 1)));
                    const v4i16_t hh = __builtin_amdgcn_ds_read_tr16_b64_v4i16((LAS v4i16_t*)(Vs + rhi * 128 + ((chunk ^ (((rhi >> 1) & 1) << 2)) << 4) + 8 * (trp & 1)));
                    const bf16x8 va = (bf16x8){lo[0], lo[1], lo[2], lo[3], hh[0], hh[1], hh[2], hh[3]};
                    O[dh] = __builtin_amdgcn_mfma_f32_32x32x16_bf16(va, pb, O[dh], 0, 0, 0); } }
        if (SUB == 0) {
            bf16* PART = (bf16*)(F.ws + WS_XN) + (itcur < 1024 ? 0 : (size_t)M * BW); float* ST = (float*)(F.ws + WS_STAT) + (itcur < 1024 ? 0 : (size_t)M * NH * 2);
            const float inv = 1.0f / lsum; bf16* op = PART + qtok * BW + hcur * 64 + 4 * hi;
#pragma unroll
            for (int dh = 0; dh < 2; ++dh)
#pragma unroll
                for (int g4 = 0; g4 < 4; ++g4) { v2u w; w.x = cvtpk(O[dh][4 * g4] * inv, O[dh][4 * g4 + 1] * inv); w.y = cvtpk(O[dh][4 * g4 + 2] * inv, O[dh][4 * g4 + 3] * inv); *(v2u*)(op + 32 * dh + 8 * g4) = w; }
            if (hi == 0) { f32x2_t st = {mx, lsum}; *(f32x2_t*)(ST + (qtok * NH + hcur) * 2) = st; }
        } else {
            const bf16* P16 = (const bf16*)(F.ws + WS_XN) + qtok * BW + hcur * 64 + 4 * hi; const bf16* P4 = P16 + (size_t)M * BW;
            const float* ST16 = (const float*)(F.ws + WS_STAT) + (qtok * NH + hcur) * 2; const float* ST4 = ST16 + (size_t)M * NH * 2;
            const f32x2_t s16 = *(const f32x2_t*)ST16, s4 = *(const f32x2_t*)ST4;
            const float MM = fmaxf(mx, fmaxf(s16.x, s4.x)), a1 = __builtin_amdgcn_exp2f(mx - MM), a16 = s16.y * __builtin_amdgcn_exp2f(s16.x - MM), a4 = s4.y * __builtin_amdgcn_exp2f(s4.x - MM);
            const float inv = 1.0f / (lsum * a1 + a16 + a4);
            bf16* op = (bf16*)(F.ws + WS_MIXCAT) + qtok * D + AW + hcur * 64 + 4 * hi;
#pragma unroll
            for (int dh = 0; dh < 2; ++dh)
#pragma unroll
                for (int g4 = 0; g4 < 4; ++g4) { const v2u x16 = *(const v2u*)(P16 + 32 * dh + 8 * g4), x4 = *(const v2u*)(P4 + 32 * dh + 8 * g4);
                    const float o0 = (O[dh][4 * g4] * a1 + a16 * bflo(x16.x) + a4 * bflo(x4.x)) * inv, o1 = (O[dh][4 * g4 + 1] * a1 + a16 * bfhi(x16.x) + a4 * bfhi(x4.x)) * inv;
                    const float o2 = (O[dh][4 * g4 + 2] * a1 + a16 * bflo(x16.y) + a4 * bflo(x4.y)) * inv, o3 = (O[dh][4 * g4 + 3] * a1 + a16 * bfhi(x16.y) + a4 * bfhi(x4.y)) * inv;
                    v2u w; w.x = cvtpk(o0, o1); w.y = cvtpk(o2, o3); *(v2u*)(op + 32 * dh + 8 * g4) = w; }
        }
        __syncthreads();
        if (!has_next) break;
        ATT_WRITE(); it = itn;
        __syncthreads();
    }
#undef ATT_DECODE
#undef ATT_LOAD
#undef ATT_WRITE
}

typedef float f32x4_t __attribute__((ext_vector_type(4)));
DI void cmul_acc(float& xr, float& xi, float ar, float ai, float br, float bi) { const float nr = ar * xr - ai * xi + br, ni = ar * xi + ai * xr + bi; xr = nr; xi = ni; }
DI void mix_ssm_in(Frame& F, int l) {
    FRAME_IDS
    const bf16* P = (const bf16*)(F.ws + WS_PROJ);
    const bf16* WIN = (const bf16*)(F.ws + WS_SSM2 + l * SSM2_LAYER + S2_WIN);
    const float* apw = (const float*)(F.ws + WS_SSM2 + l * SSM2_LAYER + S2_APW);
    float* XLOC = (float*)(F.ws + WS_XLOC); float* XSUP = (float*)(F.ws + WS_XSUP);
    const int row = lane_ & 15, q = lane_ >> 4;
    for (int it = F.vcu; it < 256; it += F.G) {
        const int b = it >> 5, sc = (it >> 2) & 7, g = 4 * (it & 3) + (wave_ >> 1), half = wave_ & 1;
        bf16x8 af[16];
        { const bf16* src = P + ((size_t)b * T + (size_t)(16 * sc + row) * 32 + (q >> 1)) * PROJW + COL_S + g * 16 + 8 * (q & 1);
#pragma unroll
          for (int sp = 0; sp < 16; ++sp) af[sp] = *(const bf16x8*)(src + (size_t)(2 * sp) * PROJW); }
#pragma unroll 1
        for (int c4 = 0; c4 < 4; ++c4) { const int ct = 4 * half + c4;
            f32x4_t acc = {0.f, 0.f, 0.f, 0.f};
            const bf16* wp = WIN + (((size_t)(g * 16) * 8 + ct) * 64 + lane_) * 8;
#pragma unroll
            for (int sp = 0; sp < 16; ++sp) { const bf16x8 bfr = *(const bf16x8*)(wp + (size_t)sp * 8 * 64 * 8); acc = __builtin_amdgcn_mfma_f32_16x16x32_bf16(af[sp], bfr, acc, 0, 0, 0); }
            const int comp = 16 * ct + row, n = comp >> 1, part = comp & 1;
#pragma unroll
            for (int r = 0; r < 4; ++r) XLOC[(((size_t)b * 128 + 16 * sc + 4 * q + r) * 16 + g) * 128 + comp] = acc[r];
            const float a32r = apw[((g * 33 + 32) * 64 + n) * 2], a32i = apw[((g * 33 + 32) * 64 + n) * 2 + 1];
            const float sg = part ? 1.f : -1.f;
            float h = acc[0];
#pragma unroll
            for (int r = 1; r < 4; ++r) { const float o = __shfl_xor(h, 1); h = a32r * h + sg * a32i * o + acc[r]; }
            float p64r = a32r * a32r - a32i * a32i, p64i = 2.f * a32r * a32i;
            float p128r = p64r * p64r - p64i * p64i, p128i = 2.f * p64r * p64i;
            float wr = 1.f, wi = 0.f;
            for (int k = 0; k < 3 - q; ++k) { const float t0 = wr * p128r - wi * p128i, t1 = wr * p128i + wi * p128r; wr = t0; wi = t1; }
            { const float o = __shfl_xor(h, 1); h = wr * h + sg * wi * o; }
            h += __shfl_xor(h, 16); h += __shfl_xor(h, 32);
            if (q == 0) XSUP[(((size_t)b * 8 + sc) * 16 + g) * 128 + comp] = h;
        }
    }
}
DI void mix_ssm_out(Frame& F, const Args& A, int l) {
    FRAME_IDS
    const bf16* P = (const bf16*)(F.ws + WS_PROJ); bf16* YG = (bf16*)(F.ws + WS_YG);
    const bf16* KT = (const bf16*)(F.ws + WS_SSM2 + l * SSM2_LAYER + S2_KT); const bf16* CT = (const bf16*)(F.ws + WS_SSM2 + l * SSM2_LAYER + S2_CT);
    const float* apw = (const float*)(F.ws + WS_SSM2 + l * SSM2_LAYER + S2_APW);
    const float* XLOC = (const float*)(F.ws + WS_XLOC); const float* XSUP = (const float*)(F.ws + WS_XSUP);
    LAS unsigned char* Ut = F.lds + RING_OFF + wave_ * 4096;
    LAS float* Xs = (LAS float*)(F.lds + RING_OFF + wave_ * 4096 + 2048);
    for (int i = lane_; i < 256; i += 64) ((LAS unsigned*)Ut)[i] = 0u;
    const int row = lane_ & 15, q = lane_ >> 4;
    for (int it = F.vcu; it < 256; it += F.G) {
        const int b = it >> 5, sc = (it >> 2) & 7, g = 4 * (it & 3) + (wave_ >> 1), half = wave_ & 1, n = lane_;
        bf16x8 kt[16], ctf[4];
#pragma unroll
        for (int p = 0; p < 16; ++p) kt[p] = *(const bf16x8*)(KT + ((size_t)(g * 16 + p) * 64 + lane_) * 8);
#pragma unroll
        for (int sx = 0; sx < 4; ++sx) ctf[sx] = *(const bf16x8*)(CT + ((size_t)(g * 4 + sx) * 64 + lane_) * 8);
        const float dsk = ((const float*)A.in[I_SSMD])[(l * 16 + g) * 16 + row];
        const float a32r = apw[((g * 33 + 32) * 64 + n) * 2], a32i = apw[((g * 33 + 32) * 64 + n) * 2 + 1];
        float a512r = a32r, a512i = a32i;
#pragma unroll
        for (int k = 0; k < 4; ++k) { const float t0 = a512r * a512r - a512i * a512i, t1 = 2.f * a512r * a512i; a512r = t0; a512i = t1; }
        float xr = 0.f, xi = 0.f;
        for (int s2 = 0; s2 < sc; ++s2) { const f32x2_t v = *(const f32x2_t*)(XSUP + (((size_t)b * 8 + s2) * 16 + g) * 128 + 2 * n); cmul_acc(xr, xi, a512r, a512i, v.x, v.y); }
        for (int k2 = 0; k2 < 8 * half; ++k2) { const f32x2_t v = *(const f32x2_t*)(XLOC + (((size_t)b * 128 + 16 * sc + k2) * 16 + g) * 128 + 2 * n); cmul_acc(xr, xi, a32r, a32i, v.x, v.y); }
#pragma unroll 1
        for (int kk = 8 * half; kk < 8 * half + 8; ++kk) {
            const size_t tok0 = (size_t)b * T + (size_t)(16 * sc + kk) * 32;
            const f32x2_t xl = *(const f32x2_t*)(XLOC + (((size_t)b * 128 + 16 * sc + kk) * 16 + g) * 128 + 2 * n);
            { const v4u uv = *(const v4u*)(P + (tok0 + (lane_ >> 1)) * PROJW + COL_S + g * 16 + 8 * (lane_ & 1)); *(LAS v4u*)(Ut + 1024 + lane_ * 16) = uv; }
            Xs[2 * n] = xr; Xs[2 * n + 1] = xi;
#pragma unroll
            for (int tau = 0; tau < 2; ++tau) { f32x4_t acc = (f32x4_t){0.f, 0.f, 0.f, 0.f};
                const int ti = 16 * tau + row;
#pragma unroll
                for (int sx = 0; sx < 4; ++sx) { const LAS f32x4_t* xp = (const LAS f32x4_t*)(Xs + 2 * (16 * sx + 4 * q)); const f32x4_t x01 = xp[0], x23 = xp[1];
                    const f32x4_t* ap = (const f32x4_t*)(apw + ((size_t)(g * 33 + ti + 1) * 64 + 16 * sx + 4 * q) * 2); const f32x4_t a01 = ap[0], a23 = ap[1];
                    v4u zw; zw.x = cvtpk(a01.x * x01.x - a01.y * x01.y, a01.x * x01.y + a01.y * x01.x); zw.y = cvtpk(a01.z * x01.z - a01.w * x01.w, a01.z * x01.w + a01.w * x01.z);
                    zw.z = cvtpk(a23.x * x23.x - a23.y * x23.y, a23.x * x23.y + a23.y * x23.x); zw.w = cvtpk(a23.z * x23.z - a23.w * x23.w, a23.z * x23.w + a23.w * x23.z);
                    acc = __builtin_amdgcn_mfma_f32_16x16x32_bf16(__builtin_bit_cast(bf16x8, zw), ctf[sx], acc, 0, 0, 0);
                    asm volatile("" ::: "memory"); }
#pragma unroll
                for (int p = 0; p < 16; ++p) if (p < 8 * tau + 8) { const bf16x8 ua = *(const LAS bf16x8*)(Ut + (32 + ti - 2 * p - (q >> 1)) * 32 + 16 * (q & 1));
                    acc = __builtin_amdgcn_mfma_f32_16x16x32_bf16(ua, kt[p], acc, 0, 0, 0); if ((p & 3) == 3) asm volatile("" ::: "memory"); }
#pragma unroll
                for (int r = 0; r < 4; ++r) { const int t2 = 16 * tau + 4 * q + r; const float uu = bf2f(*(const LAS bf16*)(Ut + (32 + t2) * 32 + 2 * row));
                    YG[(tok0 + t2) * 256 + g * 16 + row] = (bf16)f2bf(gelu_tanh_f(acc[r] + dsk * uu)); }
                asm volatile("" ::: "memory");
            }
            cmul_acc(xr, xi, a32r, a32i, xl.x, xl.y);
        }
    }
}
DI void mix_gating_mfma(Frame& F, const Args& A, int l) {
    FRAME_IDS
    const bf16* P = (const bf16*)(F.ws + WS_PROJ); bf16* MIX = (bf16*)(F.ws + WS_MIXCAT);
    const bf16* GW = (const bf16*)(F.ws + WS_SSM2 + l * SSM2_LAYER + S2_GW);
    const float* lng = (const float*)A.in[I_GMLNG] + l * AW; const float* lnb = (const float*)A.in[I_GMLNB] + l * AW;
    const float* bs_ = (const float*)A.in[I_GMBS] + l * 4 * 128;
    LAS unsigned char* VT = F.lds + RING_OFF + 32768;
    const int ql = lane_ & 31, hi = lane_ >> 5;
    for (int it = F.vcu; it < BATCH * (T / 128); it += F.G) {
        const int m0 = it * 128;
        __syncthreads();
        v2u wv[16];
#pragma unroll
        for (int j = 0; j < 16; ++j) wv[j] = *(const v2u*)(P + (size_t)(m0 + wave_ + 8 * j) * PROJW + COL_V + 4 * lane_);
        const f32x4 gg = *(const f32x4*)(lng + 4 * lane_), bb = *(const f32x4*)(lnb + 4 * lane_);
#pragma unroll
        for (int j = 0; j < 16; ++j) { const int r = wave_ + 8 * j; const v2u w = wv[j];
            float v[4] = {bflo(w.x), bfhi(w.x), bflo(w.y), bfhi(w.y)};
            const float mean = wave_sum(v[0] + v[1] + v[2] + v[3]) * (1.f / 256.f);
            float s2 = 0.f;
#pragma unroll
            for (int i = 0; i < 4; ++i) { v[i] -= mean; s2 += v[i] * v[i]; }
            const float rstd = 1.0f / sqrtf(wave_sum(s2) * (1.f / 256.f) + LN_EPS);
            *(LAS bf16*)(VT + (4 * lane_ + 0) * 272 + 2 * r) = (bf16)f2bf(v[0] * rstd * gg.x + bb.x);
            *(LAS bf16*)(VT + (4 * lane_ + 1) * 272 + 2 * r) = (bf16)f2bf(v[1] * rstd * gg.y + bb.y);
            *(LAS bf16*)(VT + (4 * lane_ + 2) * 272 + 2 * r) = (bf16)f2bf(v[2] * rstd * gg.z + bb.z);
            *(LAS bf16*)(VT + (4 * lane_ + 3) * 272 + 2 * r) = (bf16)f2bf(v[3] * rstd * gg.w + bb.w);
        }
        __syncthreads();
        const int h = wave_ >> 1, cb = 64 * h + 32 * (wave_ & 1);
#pragma unroll 1
        for (int rt = 0; rt < 4; ++rt) {
            f32x16 acc;
#pragma unroll
            for (int i = 0; i < 16; ++i) acc[i] = 0.f;
            for (int ks = 0; ks < 2 * rt + 2; ++ks) {
                const bf16x8 wa = *(const bf16x8*)(GW + ((size_t)h * 128 + 32 * rt + ql) * 128 + 16 * ks + 8 * hi);
                const bf16x8 vb = *(const LAS bf16x8*)(VT + (cb + ql) * 272 + 2 * (16 * ks + 8 * hi));
                acc = __builtin_amdgcn_mfma_f32_32x32x16_bf16(wa, vb, acc, 0, 0, 0); }
#pragma unroll
            for (int i = 0; i < 16; ++i) { const int t = 32 * rt + crow16(i, hi); const int c = cb + ql;
                const float uu = bf2f(P[(size_t)(m0 + t) * PROJW + COL_U + c]);
                MIX[(size_t)(m0 + t) * D + c] = (bf16)f2bf(uu * (acc[i] + bs_[h * 128 + t])); }
        }
    }
}
DI void mix_ssm_simple(Frame& F, const Args& A, int l) {
    FRAME_IDS
    const bf16* P = (const bf16*)(F.ws + WS_PROJ); bf16* YG = (bf16*)(F.ws + WS_YG);
    const float* tab = (const float*)(F.ws + WS_SSM) + (size_t)l * SSM_TAB;
    LAS float* fin = (LAS float*)(F.lds + RING_OFF);
    for (int it = F.vcu; it < BATCH * SSM_G; it += F.G) {
        const int b = it >> 4, g = it & 15, n = lane_, seg = wave_, gn = g * 64 + n;
        const float are = tab[gn], aim = tab[1024 + gn];
        float bre[16], bim[16], cre[16], cim[16];
#pragma unroll
        for (int c = 0; c < 16; ++c) { bre[c] = tab[2048 + gn * 16 + c]; bim[c] = tab[2048 + 16384 + gn * 16 + c];
            cre[c] = ((const float*)A.in[I_CRE])[(((size_t)l * 16 + g) * 16 + c) * 64 + n]; cim[c] = ((const float*)A.in[I_CIM])[(((size_t)l * 16 + g) * 16 + c) * 64 + n]; }
        const float dsk = ((const float*)A.in[I_SSMD])[(l * 16 + g) * 16 + (lane_ & 15)];
        const size_t mbase = (size_t)b * T + seg * 512;
        float xr = 0.f, xi = 0.f;
        for (int tt = 0; tt < 512; ++tt) { const v4u* up = (const v4u*)(P + (mbase + tt) * PROJW + COL_S + g * 16); const v4u u0 = up[0], u1 = up[1];
            const float u[16] = {bflo(u0.x), bfhi(u0.x), bflo(u0.y), bfhi(u0.y), bflo(u0.z), bfhi(u0.z), bflo(u0.w), bfhi(u0.w), bflo(u1.x), bfhi(u1.x), bflo(u1.y), bfhi(u1.y), bflo(u1.z), bfhi(u1.z), bflo(u1.w), bfhi(u1.w)};
            float br = 0.f, bi = 0.f;
#pragma unroll
            for (int c = 0; c < 16; ++c) { br += u[c] * bre[c]; bi += u[c] * bim[c]; }
            const float nr = are * xr - aim * xi + br, ni = are * xi + aim * xr + bi; xr = nr; xi = ni; }
        fin[(seg * 64 + n) * 2] = xr; fin[(seg * 64 + n) * 2 + 1] = xi;
        __syncthreads();
        float pr = are, pi = aim;
#pragma unroll
        for (int k = 0; k < 9; ++k) { const float t0 = pr * pr - pi * pi, t1 = 2.f * pr * pi; pr = t0; pi = t1; }
        xr = 0.f; xi = 0.f;
        for (int s = 0; s < seg; ++s) { const float fr_ = fin[(s * 64 + n) * 2], fi_ = fin[(s * 64 + n) * 2 + 1];
            const float nr = pr * xr - pi * xi + fr_, ni = pr * xi + pi * xr + fi_; xr = nr; xi = ni; }
        for (int tt = 0; tt < 512; ++tt) { const v4u* up = (const v4u*)(P + (mbase + tt) * PROJW + COL_S + g * 16); const v4u u0 = up[0], u1 = up[1];
            const float u[16] = {bflo(u0.x), bfhi(u0.x), bflo(u0.y), bfhi(u0.y), bflo(u0.z), bfhi(u0.z), bflo(u0.w), bfhi(u0.w), bflo(u1.x), bfhi(u1.x), bflo(u1.y), bfhi(u1.y), bflo(u1.z), bfhi(u1.z), bflo(u1.w), bfhi(u1.w)};
            float br = 0.f, bi = 0.f;
#pragma unroll
            for (int c = 0; c < 16; ++c) { br += u[c] * bre[c]; bi += u[c] * bim[c]; }
            const float nr = are * xr - aim * xi + br, ni = are * xi + aim * xr + bi; xr = nr; xi = ni;
            float ysel = 0.f, usel = 0.f;
#pragma unroll
            for (int c = 0; c < 16; ++c) { const float r = wave_sum(xr * cre[c] - xi * cim[c]); if ((lane_ & 15) == c) { ysel = r; usel = u[c]; } }
            if (lane_ < 16) { const float y = ysel + dsk * usel; YG[(mbase + tt) * 256 + g * 16 + lane_] = (bf16)f2bf(gelu_tanh_f(y)); } }
        __syncthreads();
    }
}

DI bool beats(float x, int i, float y, int j) { return x > y || (x == y && i < j); }
DI void p_row_b(Frame& F, const Args& A, int l, bool count = true) {
    FRAME_IDS
    const int gw = F.vcu * NWAVES + wave_, NGW = F.G * NWAVES;
    const bf16* PRE = (const bf16*)(F.ws + WS_PRE); bf16* X1 = (bf16*)(F.ws + WS_X1); bf16* XN = (bf16*)(F.ws + WS_XN);
    const float* mod = (const float*)(F.ws + WS_MOD) + (size_t)l * BATCH * 6 * D;
    const float* ln1g = (const float*)A.in[I_LN1G] + l * D; const float* ln1b = (const float*)A.in[I_LN1B] + l * D;
    const float* rw = (const float*)A.in[I_RW]; const float* rb = (const float*)A.in[I_RB];
    int* slot_a = (int*)(F.ws + WS_SLOT_A); float* slot_w = (float*)(F.ws + WS_SLOT_W);
    LAS float* rwS = (LAS float*)(F.lds + RING_OFF);
    volatile LAS unsigned* lcnt = (volatile LAS unsigned*)(F.lds + RING_OFF + 65536);
    LAS int* list_a = (LAS int*)(F.lds + RING_OFF + 66048); LAS float* list_w = (LAS float*)(F.lds + RING_OFF + 66048 + 8192);
    for (int i = tid_; i < D * NEXP; i += NTHR) rwS[(i & 15) * D + (i >> 4)] = rw[i];
    if (tid_ < 32) lcnt[tid_] = 0u;
    __syncthreads();
    const int hi5 = lane_ >> 5, b4 = (lane_ >> 4) & 1, b3 = (lane_ >> 3) & 1, b2 = (lane_ >> 2) & 1, emine = 8 * hi5 + 4 * b4 + 2 * b3 + b2;
    const int wi = 2 * b3 + b2, mygrp = 2 * hi5 + b4;
    const float rbm = rb[emine];
    Row16 lg1, lb1; row_load_f32(lg1, ln1g, lane_); row_load_f32(lb1, ln1b, lane_);
    v2u nraw[4];
    { const v2u* q = (const v2u*)(PRE + (size_t)gw * D);
#pragma unroll
      for (int k = 0; k < 4; ++k) nraw[k] = q[k * 64 + lane_]; }
    for (int m = gw; m < M; m += NGW) { const int b = m / T; const float* md = mod + (size_t)b * 6 * D;
        Row16 r;
#pragma unroll
        for (int k = 0; k < 4; ++k) { r.v[4 * k] = bflo(nraw[k].x); r.v[4 * k + 1] = bfhi(nraw[k].x); r.v[4 * k + 2] = bflo(nraw[k].y); r.v[4 * k + 3] = bfhi(nraw[k].y); }
        if (m + NGW < M) { const v2u* q = (const v2u*)(PRE + (size_t)(m + NGW) * D);
#pragma unroll
            for (int k = 0; k < 4; ++k) nraw[k] = q[k * 64 + lane_]; }
        Row16 msc, msh; row_load_f32(msc, md + 4 * D, lane_); row_load_f32(msh, md + 3 * D, lane_);
        row_ln(r);
#pragma unroll
        for (int i = 0; i < 16; ++i) r.v[i] = r.v[i] * lg1.v[i] + lb1.v[i];
        row_store_bf16(r, X1 + (size_t)m * D, lane_);
        row_ln(r);
#pragma unroll
        for (int i = 0; i < 16; ++i) r.v[i] = r.v[i] * (1.0f + msc.v[i]) + msh.v[i];
        row_store_bf16(r, XN + (size_t)m * D, lane_);
        float lg[16];
#pragma unroll
        for (int e = 0; e < 16; ++e) { float a = 0.f;
#pragma unroll
            for (int k = 0; k < 4; ++k) { const f32x4 w4 = *(const LAS f32x4*)(rwS + e * D + 256 * k + 4 * lane_); a += r.v[4 * k] * w4.x + r.v[4 * k + 1] * w4.y + r.v[4 * k + 2] * w4.z + r.v[4 * k + 3] * w4.w; }
            lg[e] = a; }
        float t8[8], t4[4], t2[2];
#pragma unroll
        for (int i = 0; i < 8; ++i) { const float keep = hi5 ? lg[8 + i] : lg[i], give = hi5 ? lg[i] : lg[8 + i]; t8[i] = keep + __shfl_xor(give, 32); }
#pragma unroll
        for (int i = 0; i < 4; ++i) { const float keep = b4 ? t8[4 + i] : t8[i], give = b4 ? t8[i] : t8[4 + i]; t4[i] = keep + __shfl_xor(give, 16); }
#pragma unroll
        for (int i = 0; i < 2; ++i) { const float keep = b3 ? t4[2 + i] : t4[i], give = b3 ? t4[i] : t4[2 + i]; t2[i] = keep + __shfl_xor(give, 8); }
        float z = (b2 ? t2[1] : t2[0]) + __shfl_xor(b2 ? t2[0] : t2[1], 4);
        z += __shfl_xor(z, 2); z += __shfl_xor(z, 1);
        const float scm = 1.0f / (1.0f + __builtin_amdgcn_exp2f(-1.4426950408889634f * z)), a = scm + rbm;
        const float p4 = __shfl_xor(a, 4), p8 = __shfl_xor(a, 8), p12 = __shfl_xor(a, 12);
        const float hi01 = fmaxf(a, p4), lo01 = fminf(a, p4), hi23 = fmaxf(p8, p12), lo23 = fminf(p8, p12);
        const float gs = fmaxf(hi01, hi23) + fmaxf(fmaxf(lo01, lo23), fminf(hi01, hi23));
        const float g16 = __shfl_xor(gs, 16), g32 = __shfl_xor(gs, 32), g48 = __shfl_xor(gs, 48);
        const bool best = beats(gs, mygrp, g16, mygrp ^ 1) && beats(gs, mygrp, g32, mygrp ^ 2) && beats(gs, mygrp, g48, mygrp ^ 3);
        const int rank = (beats(p4, wi ^ 1, a, wi) ? 1 : 0) + (beats(p8, wi ^ 2, a, wi) ? 1 : 0) + (beats(p12, wi ^ 3, a, wi) ? 1 : 0);
        const bool sel = best && rank < 2;
        float tot = sel ? scm : 0.f; tot += __shfl_xor(tot, 4); tot += __shfl_xor(tot, 8);
        if (count && sel && (lane_ & 3) == 0) { const unsigned rk = atomicAdd((unsigned*)&lcnt[emine], 1u);
            list_a[emine * 128 + rk] = 2 * m + rank; list_w[emine * 128 + rk] = scm / tot; }
    }
    __syncthreads();
    if (count) {
        if (tid_ < 16) { const unsigned n = lcnt[tid_]; lcnt[16 + tid_] = n ? atomicAdd((unsigned*)(F.ctl + CW_CNT + l * 128 + tid_), n) : 0u; }
        __syncthreads();
        for (int idx = tid_; idx < 16 * 128; idx += NTHR) { const int e = idx >> 7, rk = idx & 127;
            if (rk < (int)lcnt[e]) { const size_t slot = (size_t)e * SLOT_CAP + lcnt[16 + e] + rk; slot_a[slot] = list_a[idx]; slot_w[slot] = list_w[idx]; } }
    }
}

DI void moe_tstart(Frame& F, int l) {
    FRAME_IDS
    volatile LAS int* ts = (volatile LAS int*)(F.lds + LDSCTL_OFF);
    __syncthreads();
    if (tid_ == 0) { int acc = 0;
        for (int e = 0; e < 16; ++e) { ts[e] = acc; const unsigned c = __hip_atomic_load(F.ctl + CW_CNT + l * 128 + e, RLX_AGENT); ts[32 + e] = (int)c; acc += (int)((c + 255u) >> 8); }
        ts[16] = acc; }
    __syncthreads();
}
DI void p_row_c(Frame& F, const Args& A, int l) {
    FRAME_IDS
    const int gw = F.vcu * NWAVES + wave_, NGW = F.G * NWAVES;
    const bf16* X1 = (const bf16*)(F.ws + WS_X1); bf16* R2 = (bf16*)(F.ws + WS_ROWS2); bf16* XN = (bf16*)(F.ws + WS_XN);
    const float* mod = (const float*)(F.ws + WS_MOD) + (size_t)l * BATCH * 6 * D;
    const float* modn = (const float*)(F.ws + WS_MOD) + (size_t)(l + 1) * BATCH * 6 * D;
    const float* ln2g = (const float*)A.in[I_LN2G] + l * D; const float* ln2b = (const float*)A.in[I_LN2B] + l * D;
    Row16 lg2, lb2; row_load_f32(lg2, ln2g, lane_); row_load_f32(lb2, ln2b, lane_);
    v2u nx[4], n0[4], n1[4];
#define RC_LOAD(mm) do { const v2u* qa = (const v2u*)(X1 + (size_t)(mm) * D); const v2u* qb = (const v2u*)(R2 + (size_t)(2 * (mm)) * D); \
        _Pragma("unroll") for (int k = 0; k < 4; ++k) { nx[k] = qa[k * 64 + lane_]; n0[k] = qb[k * 64 + lane_]; n1[k] = qb[256 + k * 64 + lane_]; } } while (0)
    RC_LOAD(gw);
    for (int m = gw; m < M; m += NGW) { const int b = m / T; const float* md = mod + (size_t)b * 6 * D;
        Row16 x1, g2;
#pragma unroll
        for (int k = 0; k < 4; ++k) {
            x1.v[4 * k] = ALPHA * bflo(nx[k].x); x1.v[4 * k + 1] = ALPHA * bfhi(nx[k].x); x1.v[4 * k + 2] = ALPHA * bflo(nx[k].y); x1.v[4 * k + 3] = ALPHA * bfhi(nx[k].y);
            g2.v[4 * k] = bflo(n0[k].x) + bflo(n1[k].x); g2.v[4 * k + 1] = bfhi(n0[k].x) + bfhi(n1[k].x); g2.v[4 * k + 2] = bflo(n0[k].y) + bflo(n1[k].y); g2.v[4 * k + 3] = bfhi(n0[k].y) + bfhi(n1[k].y); }
        if (m + NGW < M) RC_LOAD(m + NGW);
        Row16 gm; row_load_f32(gm, md + 5 * D, lane_);
        Row16 msc, msh;
        if (l != DEPTH - 1) { const float* mdn = modn + (size_t)b * 6 * D; row_load_f32(msc, mdn + 1 * D, lane_); row_load_f32(msh, mdn + 0 * D, lane_); }
#pragma unroll
        for (int i = 0; i < 16; ++i) x1.v[i] = x1.v[i] + (1.0f + gm.v[i]) * g2.v[i];
        row_ln(x1);
#pragma unroll
        for (int i = 0; i < 16; ++i) x1.v[i] = x1.v[i] * lg2.v[i] + lb2.v[i];
        if (l == DEPTH - 1) row_store_f32(x1, A.out + (size_t)m * D, lane_);
        else { row_store_bf16(x1, R2 + (size_t)(2 * m) * D, lane_);
            row_ln(x1);
#pragma unroll
            for (int i = 0; i < 16; ++i) x1.v[i] = x1.v[i] * (1.0f + msc.v[i]) + msh.v[i];
            row_store_bf16(x1, XN + (size_t)m * D, lane_); }
    }
#undef RC_LOAD
}

#ifndef PHMASK
#define PHMASK 0xFFFFFFFFu
#endif
#define IN(k) (lo <= (k) && (k) < hi && ((PHMASK >> (((k) == 0) ? 31 : (((k) - 1) % PH_PER_LAYER))) & 1u))
#define SEAM(k) do { if (IN((k) + 1) && MK_ONE_LAUNCH) xcd_barrier(bar); else __syncthreads(); } while (0)
constexpr int PH_PER_LAYER = 10, N_PHASES = 1 + DEPTH * PH_PER_LAYER;
#ifndef REP_PH
#define REP_PH -1
#endif
#define NREP(k) (((k) == REP_PH) ? 2 : 1)
template <int l> DI void layer_body(Frame& F, const Args& args, const XcdBarrier& bar, const int lo, const int hi) {
    unsigned char* ws = args.ws;

        const int pb = 1 + l * PH_PER_LAYER;
        const bf16* WinT = (const bf16*)(ws + WS_WSMALL + l * WSMALL_LAYER + WOFF_IN);
        const bf16* WoutT = (const bf16*)(ws + WS_WSMALL + l * WSMALL_LAYER + WOFF_OUT);
        const bf16* GluT = (const bf16*)(ws + WS_WSMALL + l * WSMALL_LAYER + WOFF_GLU);
        const float* modl = (const float*)(ws + WS_MOD) + (size_t)l * BATCH * 6 * D;
        if (IN(pb + 0)) for (int rep_ = 0; rep_ < NREP(0); ++rep_) { p_wconv(F, args, l); if (l == 0) p_ln_a0(F, args); SEAM(pb + 0); }
        if (IN(pb + 1)) for (int rep_ = 0; rep_ < NREP(1); ++rep_) {
            pg8::Gemm g{(const bf16*)(ws + WS_XN), WinT, M, PROJW, D}; pg8::StaticOrder S; S.init(M, PROJW, F.G, (int)blockIdx.x);
            EpiInProj E{(bf16*)(ws + WS_PROJ), (const float*)(ws + WS_ROPE)};
            pg8::gemm_phase<EpiInProj, pg8::StaticOrder, PG8_ALIGN, PG8_SP2>(F.lds + RING_OFF, g, S, E);
            SEAM(pb + 1); }
        if (IN(pb + 2)) for (int rep_ = 0; rep_ < NREP(2); ++rep_) {
#ifndef REP_SUB
#define REP_SUB -1
#endif
#define SUBREP(k) for (int rs_ = 0; rs_ < ((REP_SUB == (k)) ? 2 : 1); ++rs_)
            SUBREP(0) { mix_gating_mfma(F, args, l); __syncthreads(); } SUBREP(1) { mix_ssm_in(F, l); } SUBREP(2) { mix_attn_mfma<0>(F, l); __syncthreads(); } SEAM(pb + 2); }
        if (IN(pb + 3)) for (int rep_ = 0; rep_ < NREP(3); ++rep_) { SUBREP(3) { mix_ssm_out(F, args, l); __syncthreads(); } SUBREP(4) { mix_attn_mfma<1>(F, l); __syncthreads(); } SEAM(pb + 3); }
        if (IN(pb + 4)) for (int rep_ = 0; rep_ < NREP(4); ++rep_) {
            pg8::Gemm g{(const bf16*)(ws + WS_YG), GluT, M, 256, 256}; pg8::StaticOrder S; S.init(M, 256, F.G, (int)blockIdx.x);
            EpiGlu E{(const bf16*)(ws + WS_YG), (bf16*)(ws + WS_MIXCAT), (const float*)args.in[I_GLUB] + l * 256};
            pg8::gemm_phase<EpiGlu, pg8::StaticOrder, PG8_ALIGN, PG8_SP2>(F.lds + RING_OFF, g, S, E);
            SEAM(pb + 4); }
        if (IN(pb + 5)) for (int rep_ = 0; rep_ < NREP(5); ++rep_) {
            pg8::Gemm g{(const bf16*)(ws + WS_MIXCAT), WoutT, M, D, D}; pg8::StaticOrder S; S.init(M, D, F.G, (int)blockIdx.x);
            if (l == 0) { EpiOut<true> E{(bf16*)(ws + WS_PRE), args.in[I_X], D, modl}; pg8::gemm_phase<EpiOut<true>, pg8::StaticOrder, PG8_ALIGN, PG8_SP2>(F.lds + RING_OFF, g, S, E); }
            else { EpiOut<false> E{(bf16*)(ws + WS_PRE), (const void*)(ws + WS_ROWS2), 2 * D, modl}; pg8::gemm_phase<EpiOut<false>, pg8::StaticOrder, PG8_ALIGN, PG8_SP2>(F.lds + RING_OFF, g, S, E); }
            SEAM(pb + 5); }
        if (IN(pb + 6)) { p_row_b(F, args, l); SUBREP(5) { if (REP_SUB == 5 && rs_ == 0) { __syncthreads(); p_row_b(F, args, l, false); } } SEAM(pb + 6); }
        if (IN(pb + 7)) for (int rep_ = 0; rep_ < NREP(7); ++rep_) { moe_tstart(F, l);
            pg8::Gemm g{(const bf16*)(ws + WS_XN), (const bf16*)(ws + WS_WGU), NSLOT_MAX, NEXP * 1024, D};
            MoeOrder S{(const volatile LAS int*)(F.lds + LDSCTL_OFF), F.G, (int)blockIdx.x, (const int*)(ws + WS_SLOT_A), (unsigned)(D * 2)}; EpiG1 E{(bf16*)(ws + WS_HID)};
            pg8::gemm_phase_g<EpiG1, MoeOrder, PG8_ALIGN, PG8_SP2>(F.lds + RING_OFF, F.lds + GT_OFF, g, S, E);
            SEAM(pb + 7); }
        if (IN(pb + 8)) for (int rep_ = 0; rep_ < NREP(8); ++rep_) { moe_tstart(F, l);
            pg8::Gemm g{(const bf16*)(ws + WS_HID), (const bf16*)(ws + WS_WD), NSLOT_MAX, NEXP * 1024, DEXP};
            MoeOrder S{(const volatile LAS int*)(F.lds + LDSCTL_OFF), F.G, (int)blockIdx.x, (const int*)(ws + WS_SLOT_A), (unsigned)(D * 2)};
            EpiG2 E{(bf16*)(ws + WS_ROWS2), (const int*)(ws + WS_SLOT_A), (const float*)(ws + WS_SLOT_W), (const volatile LAS int*)(F.lds + LDSCTL_OFF)};
            pg8::gemm_phase<EpiG2, MoeOrder, PG8_ALIGN, PG8_SP2>(F.lds + RING_OFF, g, S, E);
            SEAM(pb + 8); }
        if (IN(pb + 9)) { p_row_c(F, args, l); SUBREP(6) { if (REP_SUB == 6 && rs_ == 0 && l == DEPTH - 1) { __syncthreads(); p_row_c(F, args, l); } } SEAM(pb + 9); }
    }
__global__ void __launch_bounds__(NTHR, 2) mk_fwd(Args args) {
    extern __shared__ __attribute__((aligned(16))) unsigned char lds[];
    Frame F;
    F.lds = (LAS unsigned char*)lds; F.MISC = (volatile LAS unsigned*)(F.lds + MISC_OFF);
    F.G = gridDim.x; { const int bx = blockIdx.x; F.vcu = (F.G % 8 == 0) ? (bx % 8) * (F.G / 8) + bx / 8 : bx; }
    F.ws = args.ws; F.ctl = (gu32*)(args.ws + WS_CTL);
    for (int u = threadIdx.x; u < (LDS_BYTES - LDSCTL_OFF) / 4; u += NTHR) ((LAS unsigned*)(F.lds + LDSCTL_OFF))[u] = 0u;
    __syncthreads();
    XcdBarrier bar; bar.bar = (unsigned*)(F.ctl + CW_BAR); bar.x = 0; bar.st = nullptr;
    if (MK_ONE_LAUNCH) bar = xcd_barrier_post((unsigned*)(F.ctl + CW_BAR), F.MISC + 8);
    const int lo = args.ph_lo, hi = args.ph_hi;
    unsigned char* ws = args.ws; (void)ws;
    if (IN(0)) { p0_tables(F, args); SEAM(0); }
    layer_body<0>(F, args, bar, lo, hi);
    layer_body<1>(F, args, bar, lo, hi);
#undef IN
#undef SEAM
}

extern "C" void kernel_launch(void* const* d_in, const int* in_sizes, int n_in, void* d_out, int out_size, void* d_ws, size_t ws_size, hipStream_t stream) {
    static int grid = 0;
    if (grid == 0) {
        if (n_in != 30 || in_sizes[0] != M * D || out_size != M * D || ws_size < WS_END) { fprintf(stderr, "kernel_launch: unexpected shapes (n_in %d, in0 %d, out %d, ws %zu, need %zu)\n", n_in, n_in > 0 ? in_sizes[0] : -1, out_size, ws_size, (size_t)WS_END); grid = -1; return; }
        int dev = 0, cus = 0, per_cu = 0;
        if (hipGetDevice(&dev) != hipSuccess || hipDeviceGetAttribute(&cus, hipDeviceAttributeMultiprocessorCount, dev) != hipSuccess) { grid = -1; return; }
        if (hipFuncSetAttribute((const void*)mk_fwd, hipFuncAttributeMaxDynamicSharedMemorySize, LDS_BYTES) != hipSuccess) { fprintf(stderr, "kernel_launch: hipFuncSetAttribute failed\n"); grid = -1; return; }
        if (hipOccupancyMaxActiveBlocksPerMultiprocessor(&per_cu, (const void*)mk_fwd, NTHR, LDS_BYTES) != hipSuccess || per_cu < 1) fprintf(stderr, "kernel_launch: occupancy query says %d\n", per_cu);
        (void)hipGetLastError();
        grid = cus;
    }
    if (grid < 0) return;
    if (hipMemsetAsync((char*)d_ws + WS_CTL, 0, CTL_ZERO_BYTES, stream) != hipSuccess) return;
    Args a{};
    for (int i = 0; i < 30; ++i) a.in[i] = d_in[i];
    a.out = (float*)d_out; a.ws = (unsigned char*)d_ws;
#if MK_ONE_LAUNCH
    a.ph_lo = 0; a.ph_hi = N_PHASES; a.li = 0;
    hipLaunchKernelGGL(mk_fwd, dim3(grid), dim3(NTHR), LDS_BYTES, stream, a);
#else
#ifndef REP_GLOBAL
#define REP_GLOBAL -1
#endif
#ifndef REP_COUNT
#define REP_COUNT 2
#endif
    for (int p = 0; p < N_PHASES; ++p) { a.ph_lo = p; a.ph_hi = p + 1; a.li = p;
        const int nrep = ((p == 0 ? 100 : (p - 1) % PH_PER_LAYER) == REP_GLOBAL) ? REP_COUNT : 1;
        for (int r = 0; r < nrep; ++r) hipLaunchKernelGGL(mk_fwd, dim3(grid), dim3(NTHR), LDS_BYTES, stream, a); }
#endif
}
```

```cpp
#include <hip/hip_runtime.h>
#include <cstdio>
#include <cstdint>
namespace pg8 {
#define PG8_LAS __attribute__((address_space(3)))
typedef unsigned short bf16_t;
typedef short bf16x8 __attribute__((ext_vector_type(8)));
typedef float f32x4 __attribute__((ext_vector_type(4)));
typedef unsigned u32x4 __attribute__((ext_vector_type(4)));
constexpr int BM = 256, BK = 64, HALF = 128, HTB = HALF * BK * 2  , STAGE_BYTES = 8 * HTB, NXCD = 8, WGM = 8;

__host__ __device__ __forceinline__ int lds_byte(int r, int c) { const int st = (r >> 4) * 2 + (c >> 5), rr = r & 15, cc = c & 31, ob = rr * 64 + cc * 2; return st * 1024 + (ob ^ (((ob >> 9) & 1) << 5)); }
__host__ __device__ __forceinline__ void stage_rc(int b, int& R, int& C) { const int st = b / 1024, sb = b % 1024, swz = sb ^ (((sb >> 9) & 1) << 5); R = (st >> 1) * 16 + swz / 64; C = (st & 1) * 32 + (swz % 64) / 2; }
__host__ __device__ __forceinline__ int perm32(int rho) { const int n = rho >> 4, i = rho & 15; return 8 * (i >> 2) + 4 * n + (i & 3); }

struct Unit { int pm, pn; };
struct Gemm { const bf16_t* A; const bf16_t* Bt; int M, N, K; };

struct StaticOrder {
    int nM, nN, nwg, G, c;
    __host__ __device__ void init(int M, int N, int G_, int c_) { nM = M / BM; nN = N / BM; nwg = nM * nN; G = G_; c = c_; }
    __host__ __device__ bool next(int i, Unit& u) const {
        const long L = (long)i * G + c; if (L >= nwg) return false;
        int wgid = (int)L; { const int q = nwg / NXCD, r = nwg % NXCD, xcd = wgid % NXCD, off = wgid / NXCD; wgid = (xcd < r ? xcd * (q + 1) : r * (q + 1) + (xcd - r) * q) + off; }
        const int nig = WGM * nN, gid = wgid / nig, fm = gid * WGM, gsz = (nM - fm) < WGM ? (nM - fm) : WGM;
        u.pm = fm + ((wgid % nig) % gsz); u.pn = (wgid % nig) / gsz; return true;
    }
    __device__ __forceinline__ void a_ready(const Unit&) const {}
    __device__ __forceinline__ void done(const Unit&) const {}
};

__device__ __forceinline__ unsigned cvt_pk_bf16(float lo, float hi) { unsigned r; asm volatile("v_cvt_pk_bf16_f32 %0, %1, %2" : "=v"(r) : "v"(lo), "v"(hi)); return r; }
template <class Epi, class Sched, bool ALIGN_EPI = false, bool SP2 = false>
__device__ __forceinline__ void gemm_phase(PG8_LAS unsigned char* lds, const Gemm g, const Sched& S, const Epi& E) {
    const int tid = threadIdx.x, wid = __builtin_amdgcn_readfirstlane(tid >> 6), lane = tid & 63, wr = wid >> 2, wc = wid & 3, fr = lane & 15, fq = lane >> 4;
    const int K = g.K, nt = K / BK;
    unsigned voffA[2], voffB[2];
#pragma unroll
    for (int i = 0; i < 2; ++i) { int R, C; stage_rc(tid * 16 + i * 8192, R, C); const int Rb = Epi::PERM ? ((R & ~31) + perm32(R & 31)) : R;
        voffA[i] = (unsigned)(R * K + C) * 2u; voffB[i] = (unsigned)(Rb * K + C) * 2u; }
    const size_t kstep = (size_t)(BK * 2);
    const size_t hstep = (size_t)HALF * K * 2;
    const size_t tstep = 2 * hstep;
    const unsigned ldsw = (unsigned)wid * 1024u;
    const int aoff = lds_byte(wr * 64 + fr, fq * 8), boff = lds_byte(wc * 32 + fr, fq * 8);
#define PG8_SA(b, h) (((b) * 2 + (h)) * HTB)
#define PG8_SB(b, h) ((4 + (b) * 2 + (h)) * HTB)
#define PG8_STAGE(bufoff, gbase, voff) do { _Pragma("unroll") for (int _i = 0; _i < 2; ++_i) \
        __builtin_amdgcn_global_load_lds((const unsigned*)((const char*)(gbase) + (voff)[_i]), (PG8_LAS unsigned*)(lds + (bufoff) + ldsw + _i * 8192), 16, 0, 0); } while (0)
#define PG8_LDA(dst, b, h) do { _Pragma("unroll") for (int m = 0; m < 4; ++m) _Pragma("unroll") for (int k = 0; k < 2; ++k) dst[m][k] = *(const PG8_LAS bf16x8*)(lds + PG8_SA(b, h) + aoff + m * 2048 + k * 1024); } while (0)
#define PG8_LDB(dst, b, h) do { _Pragma("unroll") for (int n = 0; n < 2; ++n) _Pragma("unroll") for (int k = 0; k < 2; ++k) dst[n][k] = *(const PG8_LAS bf16x8*)(lds + PG8_SB(b, h) + boff + n * 2048 + k * 1024); } while (0)
#define PG8_MMA(ai, bj, At, Bt) do { __builtin_amdgcn_s_setprio(1); _Pragma("unroll") for (int m = 0; m < 4; ++m) _Pragma("unroll") for (int n = 0; n < 2; ++n) _Pragma("unroll") for (int k = 0; k < 2; ++k) \
        acc[ai][bj][m][n] = __builtin_amdgcn_mfma_f32_16x16x32_bf16(Bt[n][k], At[m][k], acc[ai][bj][m][n], 0, 0, 0); __builtin_amdgcn_s_setprio(0); } while (0)
#define PG8_WAIT_V(n) asm volatile("s_waitcnt vmcnt(" #n ")" ::: "memory")
#define PG8_WAIT_L(n) asm volatile("s_waitcnt lgkmcnt(" #n ")" ::: "memory")
#define PG8_BAR __builtin_amdgcn_s_barrier()
#define PG8_SCHED __builtin_amdgcn_sched_barrier(0)
    Unit cur, nxt; int ui = 0;
    if (!S.next(0, cur)) return;
    f32x4 acc[2][2][4][2];
#pragma unroll
    for (int a = 0; a < 2; ++a)
#pragma unroll
        for (int b = 0; b < 2; ++b)
#pragma unroll
            for (int m = 0; m < 4; ++m)
#pragma unroll
                for (int n = 0; n < 2; ++n) acc[a][b][m][n] = (f32x4){0.f, 0.f, 0.f, 0.f};
    bf16x8 At[4][2], B0[2][2], B1[2][2];
    const char* cA = (const char*)g.A + (size_t)cur.pm * tstep; const char* cB = (const char*)g.Bt + (size_t)cur.pn * tstep;
    S.a_ready(cur);
    if constexpr (SP2) {
        PG8_STAGE(PG8_SB(0, 0), cB, voffB); PG8_STAGE(PG8_SB(0, 1), cB + hstep, voffB); PG8_STAGE(PG8_SA(0, 0), cA, voffA); PG8_STAGE(PG8_SA(0, 1), cA + hstep, voffA);
        if (wr == 1) PG8_BAR;
        PG8_WAIT_V(2); PG8_BAR;
        PG8_STAGE(PG8_SB(1, 0), cB + kstep, voffB); PG8_STAGE(PG8_SA(1, 0), cA + kstep, voffA); PG8_STAGE(PG8_SB(1, 1), cB + hstep + kstep, voffB);
        PG8_WAIT_V(6); PG8_BAR;
    } else {
        PG8_STAGE(PG8_SB(0, 0), cB, voffB); PG8_STAGE(PG8_SA(0, 0), cA, voffA); PG8_STAGE(PG8_SB(0, 1), cB + hstep, voffB); PG8_STAGE(PG8_SA(0, 1), cA + hstep, voffA);
        if (wr == 1) PG8_BAR;
        PG8_WAIT_V(4); PG8_BAR;
        PG8_STAGE(PG8_SB(1, 0), cB + kstep, voffB); PG8_STAGE(PG8_SA(1, 0), cA + kstep, voffA); PG8_STAGE(PG8_SB(1, 1), cB + hstep + kstep, voffB);
        PG8_WAIT_V(6); PG8_BAR;
    }
    for (;;) {
        const bool has_next = S.next(ui + 1, nxt);
        const char* nA = has_next ? (const char*)g.A + (size_t)nxt.pm * tstep : cA; const char* nB = has_next ? (const char*)g.Bt + (size_t)nxt.pn * tstep : cB;
        for (int t = 0; t < nt; t += 2) {
            const bool last = (t == nt - 2);
            const char* a1 = cA + (size_t)(t + 1) * kstep;
            const char* a2 = last ? nA : cA + (size_t)(t + 2) * kstep; const char* b2 = last ? nB : cB + (size_t)(t + 2) * kstep;
            const char* a3 = a2 + kstep; const char* b3 = b2 + kstep;
            if (last && has_next) S.a_ready(nxt);
            if constexpr (SP2) {
            PG8_LDB(B0, 0, 0); PG8_LDB(B1, 0, 1); PG8_SCHED; PG8_LDA(At, 0, 0); PG8_STAGE(PG8_SA(1, 1), a1 + hstep, voffA);
            PG8_WAIT_V(8); PG8_WAIT_L(0); PG8_BAR; PG8_MMA(0, 0, At, B0); PG8_MMA(0, 1, At, B1); PG8_BAR; PG8_SCHED;
            PG8_LDA(At, 0, 1); PG8_STAGE(PG8_SB(0, 0), b2, voffB); PG8_STAGE(PG8_SB(0, 1), b2 + hstep, voffB); PG8_STAGE(PG8_SA(0, 0), a2, voffA);
            PG8_WAIT_V(8); PG8_WAIT_L(0); PG8_BAR; PG8_MMA(1, 0, At, B0); PG8_MMA(1, 1, At, B1); PG8_BAR; PG8_SCHED;
            PG8_LDB(B0, 1, 0); PG8_LDB(B1, 1, 1); PG8_SCHED; PG8_LDA(At, 1, 0); PG8_STAGE(PG8_SA(0, 1), a2 + hstep, voffA);
            PG8_WAIT_V(8); PG8_WAIT_L(0); PG8_BAR; PG8_MMA(0, 0, At, B0); PG8_MMA(0, 1, At, B1); PG8_BAR; PG8_SCHED;
            PG8_LDA(At, 1, 1); PG8_STAGE(PG8_SB(1, 0), b3, voffB); PG8_STAGE(PG8_SB(1, 1), b3 + hstep, voffB); PG8_STAGE(PG8_SA(1, 0), a3, voffA);
            PG8_WAIT_V(8); PG8_WAIT_L(0); PG8_BAR; PG8_MMA(1, 0, At, B0); PG8_MMA(1, 1, At, B1); PG8_BAR; PG8_SCHED;
            } else {
            PG8_LDB(B0, 0, 0); PG8_SCHED; PG8_LDA(At, 0, 0); PG8_STAGE(PG8_SA(1, 1), a1 + hstep, voffA);
            PG8_WAIT_L(8); PG8_BAR; PG8_WAIT_L(0); PG8_MMA(0, 0, At, B0); PG8_BAR; PG8_SCHED;
            PG8_LDB(B1, 0, 1); PG8_STAGE(PG8_SB(0, 0), b2, voffB);
            PG8_BAR; PG8_WAIT_L(0); PG8_MMA(0, 1, At, B1); PG8_BAR;
            PG8_LDA(At, 0, 1); PG8_STAGE(PG8_SA(0, 0), a2, voffA);
            PG8_BAR; PG8_WAIT_L(0); PG8_MMA(1, 0, At, B0); PG8_BAR; PG8_SCHED;
            PG8_STAGE(PG8_SB(0, 1), b2 + hstep, voffB);
            PG8_WAIT_V(6); PG8_BAR; PG8_MMA(1, 1, At, B1); PG8_BAR;
            PG8_LDB(B0, 1, 0); PG8_SCHED; PG8_LDA(At, 1, 0); PG8_STAGE(PG8_SA(0, 1), a2 + hstep, voffA);
            PG8_WAIT_L(8); PG8_BAR; PG8_WAIT_L(0); PG8_MMA(0, 0, At, B0); PG8_BAR; PG8_SCHED;
            PG8_LDB(B1, 1, 1); PG8_STAGE(PG8_SB(1, 0), b3, voffB);
            PG8_BAR; PG8_WAIT_L(0); PG8_MMA(0, 1, At, B1); PG8_BAR;
            PG8_LDA(At, 1, 1); PG8_STAGE(PG8_SA(1, 0), a3, voffA);
            PG8_BAR; PG8_WAIT_L(0); PG8_MMA(1, 0, At, B0); PG8_BAR; PG8_SCHED;
            PG8_STAGE(PG8_SB(1, 1), b3 + hstep, voffB);
            PG8_WAIT_V(6); PG8_BAR; PG8_MMA(1, 1, At, B1); PG8_BAR;
            }
        }
        if constexpr (ALIGN_EPI) { if (wr == 0) PG8_BAR; }
        if constexpr (!Epi::AFTER_DRAIN) { E(acc, cur, wr, wc, fr, fq); S.done(cur); }
        if (!has_next) break;
#pragma unroll
        for (int a = 0; a < 2; ++a)
#pragma unroll
            for (int b = 0; b < 2; ++b)
#pragma unroll
                for (int m = 0; m < 4; ++m)
#pragma unroll
                    for (int n = 0; n < 2; ++n) acc[a][b][m][n] = (f32x4){0.f, 0.f, 0.f, 0.f};
        cur = nxt; cA = nA; cB = nB; ++ui;
        if constexpr (ALIGN_EPI) { if (wr == 1) PG8_BAR; }
    }
    PG8_WAIT_V(0);
    if constexpr (!ALIGN_EPI) { if (wr == 0) PG8_BAR; }
    PG8_BAR;
    if constexpr (Epi::AFTER_DRAIN) { E.fused(acc, cur, wr, wc, fr, fq, lds, wid, lane); S.done(cur); }
#undef PG8_SA
#undef PG8_SB
#undef PG8_STAGE
#undef PG8_LDA
#undef PG8_LDB
#undef PG8_MMA
#undef PG8_WAIT_V
#undef PG8_WAIT_L
#undef PG8_BAR
#undef PG8_SCHED
}
template <class Epi, class Sched, bool ALIGN_EPI = false, bool SP2 = false, int AUXA = 0>
__device__ __forceinline__ void gemm_phase_g(PG8_LAS unsigned char* lds, PG8_LAS unsigned char* gt, const Gemm g, const Sched& S, const Epi& E) {
    const int tid = threadIdx.x, wid = __builtin_amdgcn_readfirstlane(tid >> 6), lane = tid & 63, wr = wid >> 2, wc = wid & 3, fr = lane & 15, fq = lane >> 4;
    const int K = g.K, nt = K / BK;
    unsigned gpk[2], voffB[2];
#pragma unroll
    for (int i = 0; i < 2; ++i) { int R, C; stage_rc(tid * 16 + i * 8192, R, C); const int Rb = Epi::PERM ? ((R & ~31) + perm32(R & 31)) : R;
        gpk[i] = (unsigned)(R * 4) | ((unsigned)(C * 2) << 16); voffB[i] = (unsigned)(Rb * K + C) * 2u; }
    int par = 0;
    const size_t kstep = (size_t)(BK * 2);
    const size_t hstep = (size_t)HALF * K * 2;
    const size_t tstep = 2 * hstep;
    const unsigned ldsw = (unsigned)wid * 1024u;
    const int aoff = lds_byte(wr * 64 + fr, fq * 8), boff = lds_byte(wc * 32 + fr, fq * 8);
#define PG8_SA(b, h) (((b) * 2 + (h)) * HTB)
#define PG8_SB(b, h) ((4 + (b) * 2 + (h)) * HTB)
#define PG8_STAGE(bufoff, gbase, voff) do { _Pragma("unroll") for (int _i = 0; _i < 2; ++_i) \
        __builtin_amdgcn_global_load_lds((const unsigned*)((const char*)(gbase) + (voff)[_i]), (PG8_LAS unsigned*)(lds + (bufoff) + ldsw + _i * 8192), 16, 0, 0); } while (0)
#define PG8_STAGE_A(bufoff, h, kbyte, PAR) do { _Pragma("unroll") for (int _i = 0; _i < 2; ++_i) { \
        const unsigned _ro = *(const PG8_LAS unsigned*)(gt + ((PAR) * 768 + (h) * 128) * 4 + (gpk[_i] & 0xffffu)); \
        __builtin_amdgcn_global_load_lds((const unsigned*)((const char*)g.A + (size_t)(kbyte) + _ro + (gpk[_i] >> 16)), (PG8_LAS unsigned*)(lds + (bufoff) + ldsw + _i * 8192), 16, 0, AUXA); } } while (0)
#define PG8_FILL(u, PAR, PF) do { S.wait_ready(u, tid, PF); if (tid < 256) { unsigned o_, a0_, a1_; S.finish_meta(u, tid, PF, o_, a0_, a1_); PG8_LAS unsigned* t_ = (PG8_LAS unsigned*)(gt + ((PAR) * 768 + tid) * 4); t_[0] = o_; t_[256] = a0_; t_[512] = a1_; } asm volatile("s_waitcnt lgkmcnt(0)" ::: "memory"); __builtin_amdgcn_s_barrier(); asm volatile("" ::: "memory"); } while (0)
#define PG8_LDA(dst, b, h) do { _Pragma("unroll") for (int m = 0; m < 4; ++m) _Pragma("unroll") for (int k = 0; k < 2; ++k) dst[m][k] = *(const PG8_LAS bf16x8*)(lds + PG8_SA(b, h) + aoff + m * 2048 + k * 1024); } while (0)
#define PG8_LDB(dst, b, h) do { _Pragma("unroll") for (int n = 0; n < 2; ++n) _Pragma("unroll") for (int k = 0; k < 2; ++k) dst[n][k] = *(const PG8_LAS bf16x8*)(lds + PG8_SB(b, h) + boff + n * 2048 + k * 1024); } while (0)
#define PG8_MMA(ai, bj, At, Bt) do { __builtin_amdgcn_s_setprio(1); _Pragma("unroll") for (int m = 0; m < 4; ++m) _Pragma("unroll") for (int n = 0; n < 2; ++n) _Pragma("unroll") for (int k = 0; k < 2; ++k) \
        acc[ai][bj][m][n] = __builtin_amdgcn_mfma_f32_16x16x32_bf16(Bt[n][k], At[m][k], acc[ai][bj][m][n], 0, 0, 0); __builtin_amdgcn_s_setprio(0); } while (0)
#define PG8_WAIT_V(n) asm volatile("s_waitcnt vmcnt(" #n ")" ::: "memory")
#define PG8_WAIT_L(n) asm volatile("s_waitcnt lgkmcnt(" #n ")" ::: "memory")
#define PG8_BAR __builtin_amdgcn_s_barrier()
#define PG8_SCHED __builtin_amdgcn_sched_barrier(0)
    Unit cur, nxt; int ui = 0;
    if (!S.next(0, cur)) return;
    f32x4 acc[2][2][4][2];
#pragma unroll
    for (int a = 0; a < 2; ++a)
#pragma unroll
        for (int b = 0; b < 2; ++b)
#pragma unroll
            for (int m = 0; m < 4; ++m)
#pragma unroll
                for (int n = 0; n < 2; ++n) acc[a][b][m][n] = (f32x4){0.f, 0.f, 0.f, 0.f};
    bf16x8 At[4][2], B0[2][2], B1[2][2];
    const char* cB = (const char*)g.Bt + (size_t)cur.pn * tstep;
    typename Sched::Pf pf; S.prefetch(cur, tid, pf); PG8_FILL(cur, 0, pf);
    Unit pend; bool has_pend = false;
    if constexpr (SP2) {
        PG8_STAGE(PG8_SB(0, 0), cB, voffB); PG8_STAGE(PG8_SB(0, 1), cB + hstep, voffB); PG8_STAGE_A(PG8_SA(0, 0), 0, 0, par); PG8_STAGE_A(PG8_SA(0, 1), 1, 0, par);
        if (wr == 1) PG8_BAR;
        PG8_WAIT_V(2); PG8_BAR;
        PG8_STAGE(PG8_SB(1, 0), cB + kstep, voffB); PG8_STAGE_A(PG8_SA(1, 0), 0, kstep, par); PG8_STAGE(PG8_SB(1, 1), cB + hstep + kstep, voffB);
        PG8_WAIT_V(6); PG8_BAR;
    } else {
        PG8_STAGE(PG8_SB(0, 0), cB, voffB); PG8_STAGE_A(PG8_SA(0, 0), 0, 0, par); PG8_STAGE(PG8_SB(0, 1), cB + hstep, voffB); PG8_STAGE_A(PG8_SA(0, 1), 1, 0, par);
        if (wr == 1) PG8_BAR;
        PG8_WAIT_V(4); PG8_BAR;
        PG8_STAGE(PG8_SB(1, 0), cB + kstep, voffB); PG8_STAGE_A(PG8_SA(1, 0), 0, kstep, par); PG8_STAGE(PG8_SB(1, 1), cB + hstep + kstep, voffB);
        PG8_WAIT_V(6); PG8_BAR;
    }
    for (;;) {
        const bool has_next = S.next(ui + 1, nxt);
        if (has_next) S.prefetch(nxt, tid, pf);
        const char* nB = has_next ? (const char*)g.Bt + (size_t)nxt.pn * tstep : cB;
        for (int t = 0; t < nt; t += 2) {
            const bool last = (t == nt - 2);
            const char* b2 = last ? nB : cB + (size_t)(t + 2) * kstep;
            const char* b3 = b2 + kstep;
            if (last && has_next) PG8_FILL(nxt, par ^ 1, pf);
            const size_t kA2 = last ? (size_t)0 : (size_t)(t + 2) * kstep; const int pA2 = (last && has_next) ? (par ^ 1) : par;
            if constexpr (SP2) {
            PG8_LDB(B0, 0, 0); PG8_LDB(B1, 0, 1); PG8_SCHED; PG8_LDA(At, 0, 0); PG8_STAGE_A(PG8_SA(1, 1), 1, (size_t)(t + 1) * kstep, par);
            PG8_WAIT_V(8); PG8_WAIT_L(0); PG8_BAR; PG8_MMA(0, 0, At, B0); PG8_MMA(0, 1, At, B1); PG8_BAR; PG8_SCHED;
            PG8_LDA(At, 0, 1); PG8_STAGE(PG8_SB(0, 0), b2, voffB); PG8_STAGE(PG8_SB(0, 1), b2 + hstep, voffB); PG8_STAGE_A(PG8_SA(0, 0), 0, kA2, pA2);
            PG8_WAIT_V(8); PG8_WAIT_L(0); PG8_BAR; PG8_MMA(1, 0, At, B0); PG8_MMA(1, 1, At, B1); PG8_BAR; PG8_SCHED;
            PG8_LDB(B0, 1, 0); PG8_LDB(B1, 1, 1); PG8_SCHED; PG8_LDA(At, 1, 0); PG8_STAGE_A(PG8_SA(0, 1), 1, kA2, pA2);
            PG8_WAIT_V(8); PG8_WAIT_L(0); PG8_BAR; PG8_MMA(0, 0, At, B0); PG8_MMA(0, 1, At, B1); PG8_BAR; PG8_SCHED;
            PG8_LDA(At, 1, 1); PG8_STAGE(PG8_SB(1, 0), b3, voffB); PG8_STAGE(PG8_SB(1, 1), b3 + hstep, voffB); PG8_STAGE_A(PG8_SA(1, 0), 0, kA2 + kstep, pA2);
            PG8_WAIT_V(8); PG8_WAIT_L(0); PG8_BAR; PG8_MMA(1, 0, At, B0); PG8_MMA(1, 1, At, B1); PG8_BAR; PG8_SCHED;
            } else {
            PG8_LDB(B0, 0, 0); PG8_SCHED; PG8_LDA(At, 0, 0); PG8_STAGE_A(PG8_SA(1, 1), 1, (size_t)(t + 1) * kstep, par);
            PG8_WAIT_L(8); PG8_BAR; PG8_WAIT_L(0); PG8_MMA(0, 0, At, B0); PG8_BAR; PG8_SCHED;
            PG8_LDB(B1, 0, 1); PG8_STAGE(PG8_SB(0, 0), b2, voffB);
            PG8_BAR; PG8_WAIT_L(0); PG8_MMA(0, 1, At, B1); PG8_BAR;
            PG8_LDA(At, 0, 1); PG8_STAGE_A(PG8_SA(0, 0), 0, kA2, pA2);
            PG8_BAR; PG8_WAIT_L(0); PG8_MMA(1, 0, At, B0); PG8_BAR; PG8_SCHED;
            PG8_STAGE(PG8_SB(0, 1), b2 + hstep, voffB);
            PG8_WAIT_V(6); PG8_BAR; PG8_MMA(1, 1, At, B1); PG8_BAR;
            PG8_LDB(B0, 1, 0); PG8_SCHED; PG8_LDA(At, 1, 0); PG8_STAGE_A(PG8_SA(0, 1), 1, kA2, pA2);
            PG8_WAIT_L(8); PG8_BAR; PG8_WAIT_L(0); PG8_MMA(0, 0, At, B0); PG8_BAR; PG8_SCHED;
            PG8_LDB(B1, 1, 1); PG8_STAGE(PG8_SB(1, 0), b3, voffB);
            PG8_BAR; PG8_WAIT_L(0); PG8_MMA(0, 1, At, B1); PG8_BAR;
            PG8_LDA(At, 1, 1); PG8_STAGE_A(PG8_SA(1, 0), 0, kA2 + kstep, pA2);
            PG8_BAR; PG8_WAIT_L(0); PG8_MMA(1, 0, At, B0); PG8_BAR; PG8_SCHED;
            PG8_STAGE(PG8_SB(1, 1), b3 + hstep, voffB);
            PG8_WAIT_V(6); PG8_BAR; PG8_MMA(1, 1, At, B1); PG8_BAR;
            }
        }
        if constexpr (ALIGN_EPI) { if (wr == 0) PG8_BAR; }
        if constexpr (!Epi::AFTER_DRAIN) { if (has_pend) S.done_nowait(pend);     E(acc, cur, wr, wc, fr, fq, (const PG8_LAS unsigned*)(gt + par * 3072)); pend = cur; has_pend = true; }
        if (!has_next) break;
#pragma unroll
        for (int a = 0; a < 2; ++a)
#pragma unroll
            for (int b = 0; b < 2; ++b)
#pragma unroll
                for (int m = 0; m < 4; ++m)
#pragma unroll
                    for (int n = 0; n < 2; ++n) acc[a][b][m][n] = (f32x4){0.f, 0.f, 0.f, 0.f};
        cur = nxt; cB = nB; ++ui; par ^= 1;
        if constexpr (ALIGN_EPI) { if (wr == 1) PG8_BAR; }
    }
    PG8_WAIT_V(0);
    if constexpr (!ALIGN_EPI) { if (wr == 0) PG8_BAR; }
    PG8_BAR;
    if (has_pend) S.done_nowait(pend);
#undef PG8_SA
#undef PG8_SB
#undef PG8_STAGE
#undef PG8_STAGE_A
#undef PG8_FILL
#undef PG8_LDA
#undef PG8_LDB
#undef PG8_MMA
#undef PG8_WAIT_V
#undef PG8_WAIT_L
#undef PG8_BAR
#undef PG8_SCHED
}
}

#ifndef PG8_SP2
#define PG8_SP2 true
#endif
#ifndef PG8_ALIGN
#define PG8_ALIGN true
#endif
#ifndef MK_ONE_LAUNCH
#define MK_ONE_LAUNCH 1
#endif

constexpr int NWAVES = 8, NTHR = 512;
constexpr int BATCH = 8, T = 4096, D = 1024, M = BATCH * T, DEPTH = 2;
constexpr int PROJW = 2304, AW = 256, BW = 512, CW = 256, NH = 8, HD = 64;
constexpr int COL_U = 0, COL_V = 256, COL_Q = 512, COL_K = 1024, COL_VA = 1536, COL_S = 2048;
constexpr int NEXP = 16, DEXP = 512, NGRP = 4;
constexpr int SSM_G = 16, SSM_N = 64, SSM_C = 16;
constexpr float LN_EPS = 1e-5f;
constexpr float ALPHA = 1.41421356237309515f;
constexpr float QSCALE = 0.125f * 1.4426950408889634f;
constexpr int NSLOT_MAX = 2 * M + NEXP * 256;

constexpr size_t MiB = 1u << 20;
constexpr size_t WS_CTL = 0, CTL_ZERO_BYTES = 1 * MiB;
constexpr size_t WS_MOD = 1 * MiB;
constexpr size_t WS_ROPE = WS_MOD + 512 * 1024;
constexpr size_t WS_SSM = WS_ROPE + 2 * MiB;
constexpr int SSM_TAB = 2 * 1024 + 2 * 16384;
constexpr int SLOT_CAP = 32768;
constexpr size_t WS_SLOT_A = 4 * MiB;
constexpr size_t WS_WSMALL = 6 * MiB;
constexpr size_t WSMALL_LAYER = 7 * MiB, WOFF_IN = 0, WOFF_OUT = (size_t)PROJW * D * 2, WOFF_GLU = WOFF_OUT + (size_t)D * D * 2;
constexpr size_t WS_WGU = 20 * MiB;
constexpr size_t WS_WD = 52 * MiB;
constexpr size_t WS_XN = 68 * MiB;
constexpr size_t WS_YG = 132 * MiB;
constexpr size_t WS_R = 148 * MiB;
constexpr size_t WS_PROJ = WS_R, WS_MIXCAT = WS_R + 144 * MiB, WS_PRE = WS_R, WS_HID = WS_R + 64 * MiB, WS_X1 = WS_R + 132 * MiB;
constexpr size_t WS_ROWS2 = 356 * MiB;
constexpr size_t WS_STAT = 356 * MiB + (size_t)2 * M * D * 2;
constexpr size_t WS_SSM2 = WS_STAT + 4 * MiB;
constexpr size_t SSM2_LAYER = 3 * MiB, S2_APW = 0, S2_KT = 288 * 1024, S2_CT = S2_KT + 256 * 1024, S2_WIN = S2_CT + 64 * 1024, S2_GW = S2_WIN + 2 * MiB;
static_assert(S2_GW + 4 * 128 * 128 * 2 <= SSM2_LAYER, "ssm2 tables");
constexpr size_t WS_XLOC = WS_SSM2 + 2 * SSM2_LAYER;
constexpr size_t WS_XSUP = WS_XLOC + 8 * MiB;
constexpr size_t WS_SLOT_W = WS_XSUP + 512 * 1024;
constexpr size_t WS_END = WS_SLOT_W + 2 * MiB;
static_assert(WOFF_GLU + 256 * 256 * 2 <= WSMALL_LAYER && WS_WSMALL + 2 * WSMALL_LAYER <= WS_WGU, "ws map");
static_assert(WS_SSM + 2 * SSM_TAB * 4 <= WS_SLOT_A && WS_HID + (size_t)NSLOT_MAX * DEXP * 2 <= WS_X1 && WS_X1 + (size_t)M * D * 2 <= WS_ROWS2, "ws map 2");
constexpr int CW_TMO = 0;
constexpr int CW_BAR = 4096;
constexpr int CW_CNT = 8192;
constexpr int CW_DONE = 12288;

constexpr int RING_OFF = 0, RING_BYTES = 131072;
constexpr int ATT_STAGE_OFF = 98304;
constexpr int LDSCTL_OFF = 135168, MISC_OFF = LDSCTL_OFF + 320;
constexpr int GT_OFF = LDSCTL_OFF + 1024;
constexpr int LDS_BYTES = 147456;

#define GAS __attribute__((address_space(1)))
#define LAS __attribute__((address_space(3)))
#define DI __device__ __forceinline__
typedef unsigned short bf16;
typedef unsigned v4u __attribute__((ext_vector_type(4)));
typedef unsigned v2u __attribute__((ext_vector_type(2)));
typedef float f32x4 __attribute__((ext_vector_type(4)));
typedef short bf16x8 __attribute__((ext_vector_type(8)));
typedef GAS unsigned gu32;
#define RLX_AGENT __ATOMIC_RELAXED, __HIP_MEMORY_SCOPE_AGENT
#define LDS_WAIT() asm volatile("s_waitcnt lgkmcnt(0)" ::: "memory")
#define VM_WAIT() asm volatile("s_waitcnt vmcnt(0)" ::: "memory")
DI unsigned f2bf(float f) { unsigned u = __builtin_bit_cast(unsigned, f); return (u + 0x7fffu + ((u >> 16) & 1u)) >> 16; }
DI unsigned pk2(float lo, float hi) { return f2bf(lo) | (f2bf(hi) << 16); }
DI float bflo(unsigned w) { return __uint_as_float(w << 16); }
DI float bfhi(unsigned w) { return __uint_as_float(w & 0xffff0000u); }
DI float bf2f(bf16 h) { return __uint_as_float((unsigned)h << 16); }
template <int CTRL> DI float dpp_mov(float v) { return __builtin_bit_cast(float, __builtin_amdgcn_update_dpp(0, __builtin_bit_cast(int, v), CTRL, 0xf, 0xf, true)); }
DI float rdlane(float v, int l) { return __builtin_bit_cast(float, __builtin_amdgcn_readlane(__builtin_bit_cast(int, v), l)); }
DI float wave_sum(float v) {
    v += dpp_mov<0xB1>(v); v += dpp_mov<0x4E>(v); v += dpp_mov<0x141>(v); v += dpp_mov<0x140>(v);
    return (rdlane(v, 0) + rdlane(v, 16)) + (rdlane(v, 32) + rdlane(v, 48));
}
DI float fast_rcp(float x) { return __builtin_amdgcn_rcpf(x); }
DI float sigmoid_f(float x) { return fast_rcp(1.0f + __builtin_amdgcn_exp2f(-1.4426950408889634f * x)); }
DI float silu_f(float x) { return x * sigmoid_f(x); }
DI float gelu_tanh_f(float x) { const float z2 = 1.5957691216057308f * (x + 0.044715f * x * x * x); return x * sigmoid_f(z2); }

#define XB_TMO      128
#define XB_XCNT(j)  (256  + 64 * (j))
#define XB_XSUB(j)  (1280 + 64 * (j))
#define XB_XGEN(j)  (2304 + 64 * (j))
#define XB_TOP      3328
#define XB_TOPGEN   3392
#define XCD_BAR_WORDS 3456
#define XB_SPIN_CAP (1u << 22)
DI unsigned xb_ld(unsigned* p)              { return __hip_atomic_load(p, __ATOMIC_RELAXED, __HIP_MEMORY_SCOPE_AGENT); }
DI unsigned xb_add(unsigned* p, unsigned v) { return __hip_atomic_fetch_add(p, v, __ATOMIC_RELAXED, __HIP_MEMORY_SCOPE_AGENT); }
DI unsigned xb_xcc_id() { return (unsigned)__builtin_amdgcn_s_getreg((3 << 11) | 20) & 0xFu; }
#define XB_SPIN(cond, bar) do { unsigned _sp = 0; while (cond) { __builtin_amdgcn_s_sleep(1); \
    if ((++_sp & 255u) == 0u) { if (xb_ld(&(bar)[XB_TMO])) break; if (_sp > XB_SPIN_CAP) { atomicAdd(&(bar)[XB_TMO], 1u); break; } } } } while (0)
struct XcdBarrier { unsigned* bar; unsigned x; volatile LAS unsigned* st; };
DI XcdBarrier xcd_barrier_post(unsigned* bar, volatile LAS unsigned* st) {
    XcdBarrier b; b.bar = bar; b.x = xb_xcc_id(); b.st = st;
    if (threadIdx.x == 0) (void)xb_add(&bar[XB_XCNT(b.x)], 1u);
    return b;
}
DI void xcd_barrier_complete(unsigned* bar, unsigned x, unsigned& nloc, unsigned& nx) {
    const unsigned G = gridDim.x * gridDim.y * gridDim.z;
    unsigned sum, cnt, mine, sp = 0u;
    for (;;) {
        sum = 0u; cnt = 0u; mine = 0u;
#pragma unroll
        for (unsigned j = 0; j < 16; ++j) { const unsigned c = xb_ld(&bar[XB_XCNT(j)]); sum += c; cnt += (c > 0u) ? 1u : 0u; mine = (j == x) ? c : mine; }
        if (sum == G) break;
        __builtin_amdgcn_s_sleep(1);
        if ((++sp & 255u) == 0u) { if (xb_ld(&bar[XB_TMO])) break; if (sp > XB_SPIN_CAP) { atomicAdd(&bar[XB_TMO], 1u); break; } }
    }
    nloc = mine > 0u ? mine : 1u; nx = cnt > 0u ? cnt : 1u;
}
DI void xcd_barrier(const XcdBarrier& b) {
    asm volatile("s_waitcnt vmcnt(0)" ::: "memory");
    __syncthreads();
    if (threadIdx.x == 0) {
        unsigned* bar = b.bar;
        __builtin_amdgcn_s_waitcnt(0);
        unsigned nloc = b.st[0], nx = b.st[1];
        if (nloc == 0u) { xcd_barrier_complete(bar, b.x, nloc, nx); b.st[0] = nloc; b.st[1] = nx; }
        const unsigned old = xb_add(&bar[XB_XSUB(b.x)], 1u);
        const unsigned gen = old / nloc;
        if (old + 1u == (gen + 1u) * nloc) {
            __builtin_amdgcn_fence(__ATOMIC_RELEASE, "agent");
            asm volatile("s_waitcnt vmcnt(0)" ::: "memory");
            const unsigned og = xb_add(&bar[XB_TOP], 1u);
            const unsigned tg = og / nx;
            if (og + 1u == (tg + 1u) * nx) xb_add(&bar[XB_TOPGEN], 1u);
            else XB_SPIN(xb_ld(&bar[XB_TOPGEN]) == tg, bar);
            __builtin_amdgcn_fence(__ATOMIC_ACQUIRE, "agent");
            xb_add(&bar[XB_XGEN(b.x)], 1u);
            asm volatile("s_waitcnt vmcnt(0)" ::: "memory");
        } else {
            XB_SPIN(xb_ld(&bar[XB_XGEN(b.x)]) == gen, bar);
            __builtin_amdgcn_fence(__ATOMIC_ACQUIRE, "agent");
            asm volatile("s_waitcnt vmcnt(0)" ::: "memory");
        }
    }
    __syncthreads();
}

struct Args { const void* in[30]; float* out; unsigned char* ws; int ph_lo, ph_hi, li, pad; };
enum { I_X = 0, I_C, I_POS, I_ADAW, I_ADAB, I_WIN, I_GMLNG, I_GMLNB, I_GMWS, I_GMBS, I_LAMRE, I_LAMIM, I_LOGDT, I_BRE, I_BIM, I_CRE, I_CIM, I_SSMD,
       I_GLUW, I_GLUB, I_WOUT, I_LN1G, I_LN1B, I_RW, I_RB, I_EWG, I_EWU, I_EWD, I_LN2G, I_LN2B };
struct Frame {
    LAS unsigned char* lds;
    volatile LAS unsigned* MISC;
    gu32* ctl;
    unsigned char* ws;
    int vcu, G;
};
DI int ftid() { int t = threadIdx.x; asm volatile("" : "+v"(t)); return t; }
#define FRAME_IDS const int tid_ = ftid(), lane_ = tid_ & 63, wave_ = __builtin_amdgcn_readfirstlane(tid_ >> 6); (void)lane_; (void)wave_;

template <class RowMap>
DI void transpose_item(const float* W, int K, int N, bf16* WT, const RowMap& rm, LAS float* scr, int item, int lane) {
    const int nblk = N / 32, kb = item / nblk, nb = item % nblk, k0 = 64 * kb, n0 = 32 * nb;
#pragma unroll 8
    for (int i = 0; i < 32; ++i) { const int kk = 2 * i + (lane >> 5); scr[kk * 33 + (lane & 31)] = W[(size_t)(k0 + kk) * N + n0 + (lane & 31)]; }
    LDS_WAIT(); asm volatile("" ::: "memory");
    const int c = lane & 7;
#pragma unroll
    for (int j = 0; j < 4; ++j) { const int n = (lane >> 3) + 8 * j; const LAS float* s = scr + (8 * c) * 33 + n;
        v4u o; o.x = pk2(s[0 * 33], s[1 * 33]); o.y = pk2(s[2 * 33], s[3 * 33]); o.z = pk2(s[4 * 33], s[5 * 33]); o.w = pk2(s[6 * 33], s[7 * 33]);
        *(GAS v4u*)(WT + (size_t)rm(n0 + n) * K + k0 + 8 * c) = o; }
    LDS_WAIT(); asm volatile("" ::: "memory");
}
struct RmIdent { int off; DI int operator()(int n) const { return off + n; } };
struct RmWin { DI int operator()(int n) const {
        if (n >= COL_Q && n < COL_VA) { const int d = n & 63; if (d < 16) return (n - d) + 2 * (d & 7) + (d >> 3); }
        return n; } };
struct RmGU { int e, up; DI int operator()(int n) const { return e * 1024 + (n >> 7) * 256 + (n & 127) + up * 128; } };

DI void p0_tables(Frame& F, const Args& A) {
    FRAME_IDS
    const float* c = (const float*)A.in[I_C];
    LAS float* condS = (LAS float*)(F.lds + RING_OFF);
    LAS float* red = (LAS float*)(F.lds + RING_OFF + 32768);
    for (int i = tid_; i < BATCH * D; i += NTHR) condS[i] = silu_f(c[i]);
    __syncthreads();
    float* mod = (float*)(F.ws + WS_MOD);
    for (int it = F.vcu; it < DEPTH * 96; it += F.G) {
        const int l = it / 96, jb = it % 96, ks = tid_ >> 6, jj = tid_ & 63, j = jb * 64 + jj;
        const float* w = (const float*)A.in[I_ADAW] + (size_t)l * D * 6 * D + j;
        float acc[8];
#pragma unroll
        for (int b = 0; b < 8; ++b) acc[b] = 0.f;
#pragma unroll 16
        for (int k = ks * 128; k < ks * 128 + 128; ++k) { const float wv = w[(size_t)k * (6 * D)];
#pragma unroll
            for (int b = 0; b < 8; ++b) acc[b] += condS[b * D + k] * wv; }
#pragma unroll
        for (int b = 0; b < 8; ++b) red[(ks * 8 + b) * 64 + jj] = acc[b];
        __syncthreads();
        { const int b = tid_ >> 6; float s = ((const float*)A.in[I_ADAB])[l * 6 * D + j];
#pragma unroll
          for (int k2 = 0; k2 < 8; ++k2) s += red[(k2 * 8 + b) * 64 + jj];
          mod[((size_t)l * BATCH + b) * 6 * D + j] = s; }
        __syncthreads();
    }
    const int gt = F.vcu * NTHR + tid_, NGT = F.G * NTHR;
    const int* pos = (const int*)A.in[I_POS]; float* rope = (float*)(F.ws + WS_ROPE);
    for (int w = gt; w < M * 8; w += NGT) { const int m = w >> 3, i = w & 7;
        const float freq = exp2f(-(float)i * 0.125f * 18.931568569324174f);
        const float ang = (float)pos[m] * freq; float s, cs; sincosf(ang, &s, &cs);
        rope[m * 16 + i] = cs; rope[m * 16 + 8 + i] = s; }
    for (int w = gt; w < DEPTH * 16 * 33 * 64; w += NGT) { const int n = w & 63, m = (w >> 6) % 33, g = ((w >> 6) / 33) & 15, l = (w >> 6) / (33 * 16);
        const int li = (l * 16 + g) * 64 + n;
        const float lre = ((const float*)A.in[I_LAMRE])[li], lim = ((const float*)A.in[I_LAMIM])[li], dt = expf(((const float*)A.in[I_LOGDT])[l * 16 + g]);
        const float mag = expf((float)m * (lre * dt)); float sn, cs; sincosf((float)m * (lim * dt), &sn, &cs);
        float* apw = (float*)(F.ws + WS_SSM2 + l * SSM2_LAYER + S2_APW) + ((size_t)(g * 33 + m) * 64 + n) * 2; apw[0] = mag * cs; apw[1] = mag * sn; }
    for (int w = gt; w < DEPTH * SSM_G * SSM_N; w += NGT) { const int l = w / 1024, gn = w % 1024, g = gn >> 6;
        float* tab = (float*)(F.ws + WS_SSM) + (size_t)l * SSM_TAB;
        const float lre = ((const float*)A.in[I_LAMRE])[w], lim = ((const float*)A.in[I_LAMIM])[w];
        const float dt = expf(((const float*)A.in[I_LOGDT])[l * 16 + g]);
        const float mag = expf(lre * dt); float sn, cs; sincosf(lim * dt, &sn, &cs);
        const float are = mag * cs, aim = mag * sn, nr = are - 1.0f, ni = aim, mod2 = lre * lre + lim * lim;
        const float fre = (nr * lre + ni * lim) / mod2, fim = (ni * lre - nr * lim) / mod2;
        tab[gn] = are; tab[1024 + gn] = aim;
        const float* bre = (const float*)A.in[I_BRE] + (size_t)w * 16; const float* bim = (const float*)A.in[I_BIM] + (size_t)w * 16;
#pragma unroll
        for (int cc = 0; cc < 16; ++cc) { tab[2048 + gn * 16 + cc] = fre * bre[cc] - fim * bim[cc]; tab[2048 + 16384 + gn * 16 + cc] = fre * bim[cc] + fim * bre[cc]; } }
}

constexpr int WCONV_SPLIT = 16 * 72 + 16 * 32 + 4 * 8 + 8900;
DI void p_wconv(Frame& F, const Args& A, int l, int part) {
    FRAME_IDS
    if (part == 0) {
        const int gt = F.vcu * NTHR + tid_, NGT = F.G * NTHR;
        const float* tab = (const float*)(F.ws + WS_SSM) + (size_t)l * SSM_TAB;
        const float* apw = (const float*)(F.ws + WS_SSM2 + l * SSM2_LAYER + S2_APW);
        const float* cre = (const float*)A.in[I_CRE] + (size_t)l * 16 * 16 * 64; const float* cim = (const float*)A.in[I_CIM] + (size_t)l * 16 * 16 * 64;
        bf16* KT = (bf16*)(F.ws + WS_SSM2 + l * SSM2_LAYER + S2_KT); bf16* CT = (bf16*)(F.ws + WS_SSM2 + l * SSM2_LAYER + S2_CT);
        bf16* WIN = (bf16*)(F.ws + WS_SSM2 + l * SSM2_LAYER + S2_WIN); bf16* GW = (bf16*)(F.ws + WS_SSM2 + l * SSM2_LAYER + S2_GW);
        for (int w = gt; w < 16 * 16 * 64 * 8; w += NGT) { const int j = w & 7, ln = (w >> 3) & 63, p = (w >> 9) & 15, g = w >> 13;
            const int co = ln & 15, q = ln >> 4, m = 2 * p + (q >> 1), ci = 8 * (q & 1) + j; float acc = 0.f;
            for (int n = 0; n < 64; ++n) { const int gn = g * 64 + n; const float ar = apw[((g * 33 + m) * 64 + n) * 2], ai = apw[((g * 33 + m) * 64 + n) * 2 + 1];
                const float br = tab[2048 + gn * 16 + ci], bi = tab[2048 + 16384 + gn * 16 + ci], tre = ar * br - ai * bi, tim = ar * bi + ai * br;
                acc += cre[(g * 16 + co) * 64 + n] * tre - cim[(g * 16 + co) * 64 + n] * tim; }
            KT[w] = (bf16)f2bf(acc); }
        for (int w = gt; w < 16 * 4 * 64 * 8; w += NGT) { const int j = w & 7, ln = (w >> 3) & 63, sx = (w >> 9) & 3, g = w >> 11;
            const int co = ln & 15, q = ln >> 4, n = 16 * sx + 4 * q + (j >> 1);
            CT[w] = (bf16)f2bf((j & 1) ? -cim[(g * 16 + co) * 64 + n] : cre[(g * 16 + co) * 64 + n]); }
        for (int w = gt; w < 16 * 16 * 8 * 64 * 8; w += NGT) { const int jj = w & 7, ln = (w >> 3) & 63, ct = (w >> 9) & 7, sp = (w >> 12) & 15, g = w >> 16;
            const int cc = ln & 15, q = ln >> 4, n = 8 * ct + (cc >> 1), part = cc & 1, tj = 2 * sp + (q >> 1), ci = 8 * (q & 1) + jj, gn = g * 64 + n, m = 31 - tj;
            const float ar = apw[((g * 33 + m) * 64 + n) * 2], ai = apw[((g * 33 + m) * 64 + n) * 2 + 1], br = tab[2048 + gn * 16 + ci], bi = tab[2048 + 16384 + gn * 16 + ci];
            WIN[w] = (bf16)f2bf(part ? (ar * bi + ai * br) : (ar * br - ai * bi)); }
        const float* gws = (const float*)A.in[I_GMWS] + (size_t)l * 4 * 128 * 128;
        for (int w = gt; w < 4 * 128 * 128; w += NGT) { const int sx = w & 127, t = (w >> 7) & 127; GW[w] = (bf16)f2bf(sx <= t ? gws[w] : 0.f); }
    }
    LAS float* scr = (LAS float*)(F.lds + RING_OFF + wave_ * 16384);
    const int gw = (part == 0) ? F.vcu * NWAVES + wave_ : WCONV_SPLIT + ((int)blockIdx.x - 128) * NWAVES + wave_, NGW = (part == 0) ? F.G * NWAVES : 128 * NWAVES;
    bf16* WinT = (bf16*)(F.ws + WS_WSMALL + l * WSMALL_LAYER + WOFF_IN);
    bf16* WoutT = (bf16*)(F.ws + WS_WSMALL + l * WSMALL_LAYER + WOFF_OUT);
    bf16* GluT = (bf16*)(F.ws + WS_WSMALL + l * WSMALL_LAYER + WOFF_GLU);
    bf16* WguT = (bf16*)(F.ws + WS_WGU); bf16* WdT = (bf16*)(F.ws + WS_WD);
    constexpr int I_IN = 16 * 72, I_OUTW = 16 * 32, I_GLU = 4 * 8, I_G = 16 * 16, I_DN = 8 * 32;
    constexpr int NIT = I_IN + I_OUTW + I_GLU + 16 * (2 * I_G + I_DN);
    const int split = (F.G == 256) ? WCONV_SPLIT : NIT;
    for (int it = gw; it < ((part == 0) ? split : NIT); it += NGW) {
        int r = it;
        if (r < I_IN) { transpose_item((const float*)A.in[I_WIN] + (size_t)l * D * PROJW, D, PROJW, WinT, RmWin{}, scr, r, lane_); continue; } r -= I_IN;
        if (r < I_OUTW) { transpose_item((const float*)A.in[I_WOUT] + (size_t)l * D * D, D, D, WoutT, RmIdent{0}, scr, r, lane_); continue; } r -= I_OUTW;
        if (r < I_GLU) { transpose_item((const float*)A.in[I_GLUW] + (size_t)l * 256 * 256, 256, 256, GluT, RmIdent{0}, scr, r, lane_); continue; } r -= I_GLU;
        const int e = r / (2 * I_G + I_DN); r -= e * (2 * I_G + I_DN);
        const size_t eo = ((size_t)l * NEXP + e) * D * DEXP;
        if (r < I_G) { transpose_item((const float*)A.in[I_EWG] + eo, D, DEXP, WguT, RmGU{e, 0}, scr, r, lane_); continue; } r -= I_G;
        if (r < I_G) { transpose_item((const float*)A.in[I_EWU] + eo, D, DEXP, WguT, RmGU{e, 1}, scr, r, lane_); continue; } r -= I_G;
        transpose_item((const float*)A.in[I_EWD] + eo, DEXP, D, WdT, RmIdent{e * 1024}, scr, r, lane_);
    }
}

typedef float f32x2_t __attribute__((ext_vector_type(2)));
typedef __bf16 bf16x2_t __attribute__((ext_vector_type(2)));
DI unsigned cvtpk(float lo, float hi) { f32x2_t v = {lo, hi}; bf16x2_t b = __builtin_convertvector(v, bf16x2_t); return __builtin_bit_cast(unsigned, b); }
struct Row16 { float v[16]; };
DI void row_load_f32(Row16& r, const float* p, int lane) {
    const f32x4* q = (const f32x4*)p;
#pragma unroll
    for (int k = 0; k < 4; ++k) { const f32x4 a = q[k * 64 + lane]; r.v[4 * k] = a.x; r.v[4 * k + 1] = a.y; r.v[4 * k + 2] = a.z; r.v[4 * k + 3] = a.w; }
}
DI void row_load_bf16(Row16& r, const bf16* p, int lane) {
    const v2u* q = (const v2u*)p;
#pragma unroll
    for (int k = 0; k < 4; ++k) { const v2u a = q[k * 64 + lane]; r.v[4 * k] = bflo(a.x); r.v[4 * k + 1] = bfhi(a.x); r.v[4 * k + 2] = bflo(a.y); r.v[4 * k + 3] = bfhi(a.y); }
}
DI void row_store_bf16(const Row16& r, bf16* p, int lane) {
    v2u* q = (v2u*)p;
#pragma unroll
    for (int k = 0; k < 4; ++k) { v2u o; o.x = cvtpk(r.v[4 * k], r.v[4 * k + 1]); o.y = cvtpk(r.v[4 * k + 2], r.v[4 * k + 3]); q[k * 64 + lane] = o; }
}
DI void row_store_f32(const Row16& r, float* p, int lane) {
    f32x4* q = (f32x4*)p;
#pragma unroll
    for (int k = 0; k < 4; ++k) q[k * 64 + lane] = (f32x4){r.v[4 * k], r.v[4 * k + 1], r.v[4 * k + 2], r.v[4 * k + 3]};
}
DI void row_ln(Row16& r) {
    float s = 0.f;
#pragma unroll
    for (int i = 0; i < 16; ++i) s += r.v[i];
    const float mean = wave_sum(s) * (1.f / D); float s2 = 0.f;
#pragma unroll
    for (int i = 0; i < 16; ++i) { r.v[i] -= mean; s2 += r.v[i] * r.v[i]; }
    const float rstd = 1.0f / sqrtf(wave_sum(s2) * (1.f / D) + LN_EPS);
#pragma unroll
    for (int i = 0; i < 16; ++i) r.v[i] *= rstd;
}
DI void row_mod(Row16& r, const float* a, const float* b, int lane) {
    Row16 av, bv; row_load_f32(av, a, lane); row_load_f32(bv, b, lane);
#pragma unroll
    for (int i = 0; i < 16; ++i) r.v[i] = r.v[i] * (1.0f + av.v[i]) + bv.v[i];
}
DI void row_affine(Row16& r, const float* g, const float* b, int lane) {
    Row16 av, bv; row_load_f32(av, g, lane); row_load_f32(bv, b, lane);
#pragma unroll
    for (int i = 0; i < 16; ++i) r.v[i] = r.v[i] * av.v[i] + bv.v[i];
}

DI void p_ln_a0(Frame& F, const Args& A) {
    FRAME_IDS
    const int gw = F.vcu * NWAVES + wave_, NGW = F.G * NWAVES;
    const float* x = (const float*)A.in[I_X]; bf16* XN = (bf16*)(F.ws + WS_XN); const float* mod = (const float*)(F.ws + WS_MOD);
    for (int m = gw; m < M; m += NGW) { const int b = m / T; const float* md = mod + (size_t)b * 6 * D;
        Row16 r; row_load_f32(r, x + (size_t)m * D, lane_); row_ln(r); row_mod(r, md + 1 * D, md + 0 * D, lane_); row_store_bf16(r, XN + (size_t)m * D, lane_); }
}

using pg8::Unit; using pg8::BM; using pg8::HALF;
struct EpiInProj {
    static constexpr bool PERM = true, AFTER_DRAIN = false;
    bf16* P; const float* rope; int skip;
    DI void operator()(const pg8::f32x4 (&acc)[2][2][4][2], const Unit& u, int wr, int wc, int fr, int fq) const {
        if (skip == 1) { if (acc[0][0][0][0][0] == 12345.678f) P[0] = 1; return; }
        const int row0 = u.pm * BM + wr * 64 + fr, pn = u.pn;
        const bool isrope = (pn >= 2 && pn <= 5), dorope = isrope && ((wc & 1) == 0) && (fq < 2);
        const float sc = (pn == 2 || pn == 3) ? QSCALE : 1.0f;
#pragma unroll
        for (int ai = 0; ai < 2; ++ai)
#pragma unroll
            for (int m = 0; m < 4; ++m) { const int row = row0 + ai * HALF + m * 16; bf16* rowp = P + (size_t)row * PROJW + pn * BM + wc * 32 + 8 * fq;
                f32x4 cs = (f32x4){1.f, 1.f, 1.f, 1.f}, sn = (f32x4){0.f, 0.f, 0.f, 0.f};
                if (isrope) { const float* rp = rope + (size_t)row * 16 + 4 * (fq & 1); cs = *(const f32x4*)rp; sn = *(const f32x4*)(rp + 8); }
#pragma unroll
                for (int bj = 0; bj < 2; ++bj) { pg8::f32x4 v0 = acc[ai][bj][m][0], v1 = acc[ai][bj][m][1];
                    if (pn < 2) {
#pragma unroll
                        for (int i = 0; i < 4; ++i) { v0[i] = gelu_tanh_f(v0[i]); v1[i] = gelu_tanh_f(v1[i]); }
                    } else if (isrope) {
                        if (dorope) { const float a0 = v0[0] * cs.x - v0[1] * sn.x, b0 = v0[1] * cs.x + v0[0] * sn.x, a1 = v0[2] * cs.y - v0[3] * sn.y, b1 = v0[3] * cs.y + v0[2] * sn.y;
                            const float a2 = v1[0] * cs.z - v1[1] * sn.z, b2 = v1[1] * cs.z + v1[0] * sn.z, a3 = v1[2] * cs.w - v1[3] * sn.w, b3 = v1[3] * cs.w + v1[2] * sn.w;
                            v0 = (pg8::f32x4){a0, b0, a1, b1}; v1 = (pg8::f32x4){a2, b2, a3, b3}; }
                        v0 = v0 * sc; v1 = v1 * sc;
                    }
                    pg8::u32x4 w; w.x = pg8::cvt_pk_bf16(v0[0], v0[1]); w.y = pg8::cvt_pk_bf16(v0[2], v0[3]); w.z = pg8::cvt_pk_bf16(v1[0], v1[1]); w.w = pg8::cvt_pk_bf16(v1[2], v1[3]);
                    if (skip == 2) { asm volatile("" :: "v"(w.x), "v"(w.y), "v"(w.z), "v"(w.w)); } else *(pg8::u32x4*)(rowp + bj * HALF) = w; } }
    }
};
template <bool XF32> struct EpiOut {
    static constexpr bool PERM = true, AFTER_DRAIN = false;
    bf16* PRE; const void* x; int xpitch; const float* mod;
    DI void operator()(const pg8::f32x4 (&acc)[2][2][4][2], const Unit& u, int wr, int wc, int fr, int fq) const {
        const int row0 = u.pm * BM + wr * 64 + fr, b = (u.pm * BM) / T, colb = u.pn * BM + wc * 32 + 8 * fq;
        const float* g1 = mod + (size_t)b * 6 * D + 2 * D;
        pg8::f32x4 gv[2][2];
#pragma unroll
        for (int bj = 0; bj < 2; ++bj) { gv[bj][0] = *(const pg8::f32x4*)(g1 + colb + bj * HALF) + 1.0f; gv[bj][1] = *(const pg8::f32x4*)(g1 + colb + bj * HALF + 4) + 1.0f; }
#pragma unroll
        for (int ai = 0; ai < 2; ++ai)
#pragma unroll
            for (int m = 0; m < 4; ++m) { const int row = row0 + ai * HALF + m * 16;
#pragma unroll
                for (int bj = 0; bj < 2; ++bj) { const int col = colb + bj * HALF; pg8::f32x4 x0, x1;
                    if (XF32) { const float* xp = (const float*)x + (size_t)row * xpitch + col; x0 = *(const pg8::f32x4*)xp; x1 = *(const pg8::f32x4*)(xp + 4); }
                    else { const pg8::u32x4 xw = *(const pg8::u32x4*)((const bf16*)x + (size_t)row * xpitch + col);
                        x0 = (pg8::f32x4){bflo(xw.x), bfhi(xw.x), bflo(xw.y), bfhi(xw.y)}; x1 = (pg8::f32x4){bflo(xw.z), bfhi(xw.z), bflo(xw.w), bfhi(xw.w)}; }
                    const pg8::f32x4 v0 = x0 * ALPHA + gv[bj][0] * acc[ai][bj][m][0], v1 = x1 * ALPHA + gv[bj][1] * acc[ai][bj][m][1];
                    pg8::u32x4 w; w.x = pg8::cvt_pk_bf16(v0[0], v0[1]); w.y = pg8::cvt_pk_bf16(v0[2], v0[3]); w.z = pg8::cvt_pk_bf16(v1[0], v1[1]); w.w = pg8::cvt_pk_bf16(v1[2], v1[3]);
                    *(pg8::u32x4*)(PRE + (size_t)row * D + col) = w; } }
    }
};
struct EpiGlu {
    static constexpr bool PERM = true, AFTER_DRAIN = false;
    const bf16* YG; bf16* MIX; const float* gb;
    DI void operator()(const pg8::f32x4 (&acc)[2][2][4][2], const Unit& u, int wr, int wc, int fr, int fq) const {
        const int row0 = u.pm * BM + wr * 64 + fr, colb = wc * 32 + 8 * fq;
#pragma unroll
        for (int ai = 0; ai < 2; ++ai)
#pragma unroll
            for (int m = 0; m < 4; ++m) { const int row = row0 + ai * HALF + m * 16;
#pragma unroll
                for (int bj = 0; bj < 2; ++bj) { const int col = colb + bj * HALF;
                    const pg8::u32x4 yw = *(const pg8::u32x4*)(YG + (size_t)row * 256 + col);
                    const pg8::f32x4 b0 = *(const pg8::f32x4*)(gb + col), b1 = *(const pg8::f32x4*)(gb + col + 4);
                    const pg8::f32x4 a0 = acc[ai][bj][m][0] + b0, a1 = acc[ai][bj][m][1] + b1;
                    const float y[8] = {bflo(yw.x), bfhi(yw.x), bflo(yw.y), bfhi(yw.y), bflo(yw.z), bfhi(yw.z), bflo(yw.w), bfhi(yw.w)};
                    float o[8];
#pragma unroll
                    for (int i = 0; i < 4; ++i) { o[i] = y[i] * sigmoid_f(a0[i]); o[4 + i] = y[4 + i] * sigmoid_f(a1[i]); }
                    pg8::u32x4 w; w.x = pg8::cvt_pk_bf16(o[0], o[1]); w.y = pg8::cvt_pk_bf16(o[2], o[3]); w.z = pg8::cvt_pk_bf16(o[4], o[5]); w.w = pg8::cvt_pk_bf16(o[6], o[7]);
                    *(pg8::u32x4*)(MIX + (size_t)row * D + 768 + col) = w; asm volatile("" ::: "memory"); } }
    }
};
template <int KIND> struct MoeOrderK {
    const volatile LAS int* ts; int G, c; const int* slot_a; const float* slot_w; gu32* done_cnt;
    DI bool next(int i, Unit& u) const {
        const int nwg = ts[16] * 4; const int rot = (KIND == 1) ? (((nwg % G) + 7) & ~7) : 0; const int cc = (c - rot + G) % G;
        const long L = (long)i * G + cc; if (L >= nwg) return false;
        int wgid = (int)L; { const int q = nwg / 8, r = nwg % 8, xcd = wgid % 8, off = wgid / 8; wgid = (xcd < r ? xcd * (q + 1) : r * (q + 1) + (xcd - r) * q) + off; }
        const int tm = wgid >> 2, j = wgid & 3; int e = 0;
#pragma unroll
        for (int k = 1; k < 16; ++k) e += (ts[k] <= tm) ? 1 : 0;
        u.pm = tm; u.pn = e * 4 + j; return true;
    }
    struct Pf { unsigned a, w, c; };
    DI void prefetch(const Unit& u, int r, Pf& pf) const {
        const int e = u.pn >> 2, idx = (u.pm - ts[e]) * 256 + (r & 255); const bool valid = idx < ts[32 + e];
        pf.a = 0xffffffffu; pf.w = 0u; pf.c = 32u;
        if (valid && r < 256) { pf.a = (unsigned)slot_a[(size_t)e * SLOT_CAP + idx]; if (KIND == 1) pf.w = __float_as_uint(slot_w[(size_t)e * SLOT_CAP + idx]); }
        if (KIND == 1 && r < 64) pf.c = __hip_atomic_load(done_cnt + u.pm, RLX_AGENT);
    }
    DI void finish_meta(const Unit& u, int r, const Pf& pf, unsigned& off, unsigned& a0, unsigned& a1) const {
        if (KIND == 0) { off = (pf.a == 0xffffffffu ? 0u : (pf.a >> 1)) * (unsigned)(D * 2); a0 = 0u; a1 = 0u; }
        else { off = (unsigned)(u.pm * 256 + r) * (unsigned)(DEXP * 2); a0 = pf.a; a1 = pf.w; }
    }
    DI void wait_ready(const Unit& u, int tid, const Pf& pf) const {
        if (KIND == 1 && tid < 64) { unsigned sp = 0;
            if ((unsigned)__builtin_amdgcn_readfirstlane((int)pf.c) < 32u)
                while ((unsigned)__builtin_amdgcn_readfirstlane((int)__hip_atomic_load(done_cnt + u.pm, RLX_AGENT)) < 32u) { __builtin_amdgcn_s_sleep(2); if (++sp > (1u << 20)) break; } }
    }
    DI void a_ready(const Unit&) const {}
    DI void done_nowait(const Unit& u) const { if (KIND == 0 && (threadIdx.x & 63) == 0) __hip_atomic_fetch_add(done_cnt + u.pm, 1u, RLX_AGENT); }
};
struct EpiG1 {
    static constexpr bool PERM = true, AFTER_DRAIN = false;
    bf16* HID;
    DI void operator()(const pg8::f32x4 (&acc)[2][2][4][2], const Unit& u, int wr, int wc, int fr, int fq, const LAS unsigned*) const {
        const __amdgpu_buffer_rsrc_t rs = __builtin_amdgcn_make_buffer_rsrc((void*)HID, 0, (int)((size_t)NSLOT_MAX * DEXP * 2), 0x00020000);
        const int row0 = u.pm * BM + wr * 64 + fr, col = (u.pn & 3) * 128 + wc * 32 + 8 * fq;
#pragma unroll
        for (int ai = 0; ai < 2; ++ai)
#pragma unroll
            for (int m = 0; m < 4; ++m) { const int row = row0 + ai * HALF + m * 16; float o[8];
#pragma unroll
                for (int i = 0; i < 4; ++i) { o[i] = silu_f(acc[ai][0][m][0][i]) * acc[ai][1][m][0][i]; o[4 + i] = silu_f(acc[ai][0][m][1][i]) * acc[ai][1][m][1][i]; }
                pg8::u32x4 w; w.x = pg8::cvt_pk_bf16(o[0], o[1]); w.y = pg8::cvt_pk_bf16(o[2], o[3]); w.z = pg8::cvt_pk_bf16(o[4], o[5]); w.w = pg8::cvt_pk_bf16(o[6], o[7]);
                __builtin_amdgcn_raw_buffer_store_b128(w, rs, (row * DEXP + col) * 2, 0, 16); }
    }
};
struct EpiG2 {
    static constexpr bool PERM = true, AFTER_DRAIN = false;
    bf16* ROWS;
    DI void operator()(const pg8::f32x4 (&acc)[2][2][4][2], const Unit& u, int wr, int wc, int fr, int fq, const LAS unsigned* meta) const {
        const int r0 = wr * 64 + fr, colb = (u.pn & 3) * BM + wc * 32 + 8 * fq;
#pragma unroll
        for (int ai = 0; ai < 2; ++ai)
#pragma unroll
            for (int m = 0; m < 4; ++m) { const int r = r0 + ai * HALF + m * 16; const int d = (int)meta[256 + r]; const float wt = __uint_as_float(meta[512 + r]);
                if (d >= 0) {
#pragma unroll
                    for (int bj = 0; bj < 2; ++bj) { const pg8::f32x4 v0 = acc[ai][bj][m][0] * wt, v1 = acc[ai][bj][m][1] * wt;
                        pg8::u32x4 w; w.x = pg8::cvt_pk_bf16(v0[0], v0[1]); w.y = pg8::cvt_pk_bf16(v0[2], v0[3]); w.z = pg8::cvt_pk_bf16(v1[0], v1[1]); w.w = pg8::cvt_pk_bf16(v1[2], v1[3]);
                        *(pg8::u32x4*)(ROWS + (size_t)d * D + colb + bj * HALF) = w; } } }
    }
};

DI void mix_gating_simple(Frame& F, const Args& A, int l) {
    FRAME_IDS
    const bf16* P = (const bf16*)(F.ws + WS_PROJ); bf16* MIX = (bf16*)(F.ws + WS_MIXCAT);
    const float* lng = (const float*)A.in[I_GMLNG] + l * AW; const float* lnb = (const float*)A.in[I_GMLNB] + l * AW;
    const float* ws_ = (const float*)A.in[I_GMWS] + (size_t)l * 4 * 128 * 128; const float* bs_ = (const float*)A.in[I_GMBS] + l * 4 * 128;
    LAS float* vln = (LAS float*)(F.lds + RING_OFF);
    for (int it = F.vcu; it < BATCH * (T / 128); it += F.G) {
        const int m0 = it * 128;
        for (int r = wave_; r < 128; r += NWAVES) {
            const v2u w = *(const v2u*)(P + (size_t)(m0 + r) * PROJW + COL_V + 4 * lane_);
            float v[4] = {bflo(w.x), bfhi(w.x), bflo(w.y), bfhi(w.y)};
            const float mean = wave_sum(v[0] + v[1] + v[2] + v[3]) * (1.f / 256.f);
            float s2 = 0.f;
#pragma unroll
            for (int i = 0; i < 4; ++i) { v[i] -= mean; s2 += v[i] * v[i]; }
            const float rstd = 1.0f / sqrtf(wave_sum(s2) * (1.f / 256.f) + LN_EPS);
#pragma unroll
            for (int i = 0; i < 4; ++i) vln[r * 256 + 4 * lane_ + i] = v[i] * rstd * lng[4 * lane_ + i] + lnb[4 * lane_ + i];
        }
        __syncthreads();
        { const int c = tid_ & 255, tp = tid_ >> 8, h = c >> 6;
          for (int t = tp; t < 128; t += 2) { const float* wrow = ws_ + ((size_t)h * 128 + t) * 128; float acc = 0.f;
              for (int s = 0; s <= t; ++s) acc += wrow[s] * vln[s * 256 + c];
              const float uu = bf2f(P[(size_t)(m0 + t) * PROJW + COL_U + c]);
              MIX[(size_t)(m0 + t) * D + c] = (bf16)f2bf(uu * (acc + bs_[h * 128 + t])); } }
        __syncthreads();
    }
}
DI void mix_attn_simple(Frame& F, int l) {
    FRAME_IDS
    const bf16* P = (const bf16*)(F.ws + WS_PROJ); bf16* MIX = (bf16*)(F.ws + WS_MIXCAT);
    const int gw = F.vcu * NWAVES + wave_, NGW = F.G * NWAVES;
    for (int it = gw; it < M * NH; it += NGW) {
        const int m = it >> 3, h = it & 7, t = m & (T - 1);
        const float q = bf2f(P[(size_t)m * PROJW + COL_Q + h * 64 + lane_]);
        float mx = -1e30f, den = 0.f, o = 0.f;
#pragma unroll 1
        for (int g = 0; g < 3; ++g) { const int dl = (g == 0) ? 1 : (g == 1 ? 4 : 16);
            int nk = t / dl; if (nk > 128) nk = 128;
#pragma unroll 2
            for (int j = 0; j <= nk; ++j) { const size_t mk = (size_t)(m - j * dl);
                const float kv = bf2f(P[mk * PROJW + COL_K + h * 64 + lane_]); const float vv = bf2f(P[mk * PROJW + COL_VA + h * 64 + lane_]);
                const float s = wave_sum(q * kv);
                const float mn = fmaxf(mx, s), f = __builtin_amdgcn_exp2f(mx - mn), p = __builtin_amdgcn_exp2f(s - mn);
                den = den * f + p; o = o * f + p * vv; mx = mn; } }
        MIX[(size_t)m * D + AW + h * 64 + lane_] = (bf16)f2bf(o / den);
    }
}

typedef float f32x16 __attribute__((ext_vector_type(16)));
typedef short v4i16_t __attribute__((ext_vector_type(4)));
DI int crow16(int r, int hi) { return (r & 3) + 8 * (r >> 2) + 4 * hi; }
template <int SUB> DI void mix_attn_mfma(Frame& F, int l) {
    FRAME_IDS
    const bf16* P = (const bf16*)(F.ws + WS_PROJ);
    LAS unsigned char* Ks = F.lds + RING_OFF; LAS unsigned char* Vs = Ks + 49152;
    LAS unsigned char* St = F.lds + ATT_STAGE_OFF + wave_ * 4608;
    const int ql = lane_ & 31, hi = lane_ >> 5, prow = lane_ >> 3, pch = lane_ & 7;
    constexpr int nitems = SUB == 0 ? 2048 : 1024;
    v4u kreg[6], vreg[6], qraw[4]; bf16x8 qf[4];
    int it = F.vcu; if (it >= nitems) return;
    int d, r, s0, b, h; size_t tokbase;
#define ATT_DECODE(IT) do { const int idx_ = (IT) & 1023; b = idx_ >> 7; h = (idx_ >> 4) & 7; int tile_; \
        if (SUB == 1) { d = 1; r = 0; tile_ = idx_ & 15; } else if ((IT) < 1024) { d = 16; r = idx_ & 15; tile_ = 0; } else { d = 4; r = (idx_ >> 2) & 3; tile_ = idx_ & 3; } \
        s0 = tile_ * 256; tokbase = (size_t)b * T + r; } while (0)
#define ATT_LOAD() do { const int tl_ = ftid(); _Pragma("unroll") for (int i = 0; i < 6; ++i) { const int idx2 = tl_ + 512 * i, row = idx2 >> 3, ch = idx2 & 7, step = s0 - 128 + row; \
            if (step >= 0) { const bf16* src = P + (tokbase + (size_t)step * d) * PROJW + h * 64 + ch * 8; kreg[i] = *(const v4u*)(src + COL_K); vreg[i] = *(const v4u*)(src + COL_VA); } \
            else { kreg[i] = (v4u){0u, 0u, 0u, 0u}; vreg[i] = (v4u){0u, 0u, 0u, 0u}; } } \
        _Pragma("unroll") for (int p = 0; p < 4; ++p) qraw[p] = *(const v4u*)(P + (tokbase + (size_t)(s0 + 32 * wave_ + 8 * p + prow) * d) * PROJW + COL_Q + h * 64 + pch * 8); } while (0)
#define ATT_WRITE() do { const int tw_ = ftid(); _Pragma("unroll") for (int i = 0; i < 6; ++i) { const int idx2 = tw_ + 512 * i, row = idx2 >> 3, ch = idx2 & 7; \
            *(LAS v4u*)(Ks + row * 128 + ((ch ^ ((row >> 1) & 7)) << 4)) = kreg[i]; \
            *(LAS v4u*)(Vs + row * 128 + ((ch ^ (((row >> 1) & 1) << 2)) << 4)) = vreg[i]; } \
        _Pragma("unroll") for (int p = 0; p < 4; ++p) *(LAS v4u*)(St + (8 * p + prow) * 144 + pch * 16) = qraw[p]; } while (0)
    ATT_DECODE(it); ATT_LOAD(); ATT_WRITE();
    __syncthreads();
    for (;;) {
        const size_t tb = tokbase; const int s0c = s0, dc = d, hcur = h, itcur = it;
        const bool first = (s0 == 0);
#pragma unroll
        for (int ks = 0; ks < 4; ++ks) qf[ks] = *(const LAS bf16x8*)(St + ql * 144 + (2 * ks + hi) * 16);
        const int itn = it + F.G; const bool has_next = itn < nitems;
        if (has_next) { ATT_DECODE(itn); ATT_LOAD(); }
        const int i0 = 32 * wave_;
        f32x16 S[5];
#pragma unroll
        for (int kb = 0; kb < 5; ++kb) { f32x16 acc;
#pragma unroll
            for (int i = 0; i < 16; ++i) acc[i] = 0.f;
            const int krow = i0 + 32 * kb + ql;
#pragma unroll
            for (int ks = 0; ks < 4; ++ks) { const bf16x8 a = *(const LAS bf16x8*)(Ks + krow * 128 + (((2 * ks + hi) ^ ((krow >> 1) & 7)) << 4)); acc = __builtin_amdgcn_mfma_f32_32x32x16_bf16(a, qf[ks], acc, 0, 0, 0); }
            S[kb] = acc; }
        int qrel = ql - 4 * hi; asm volatile("" : "+v"(qrel));
        float mx = -1e30f;
#pragma unroll
        for (int kb = 0; kb < 5; ++kb) {
            const bool bvalid = !first || (wave_ + kb >= 4);
            if (!bvalid) {
#pragma unroll
                for (int i = 0; i < 16; ++i) S[kb][i] = -1e30f;
            } else {
#pragma unroll
                for (int i = 0; i < 16; ++i) { const int c0 = crow16(i, 0); float v = S[kb][i];
                    if (kb == 0) v = (c0 >= qrel) ? v : -1e30f;
                    if (kb == 4) v = (c0 <= qrel) ? v : -1e30f;
                    S[kb][i] = v; mx = fmaxf(mx, v); }
            }
        }
        mx = fmaxf(mx, __shfl_xor(mx, 32));
        float lsum = 0.f;
#pragma unroll
        for (int kb = 0; kb < 5; ++kb)
#pragma unroll
            for (int i = 0; i < 16; ++i) { const float p = __builtin_amdgcn_exp2f(S[kb][i] - mx); S[kb][i] = p; lsum += p; }
        lsum += __shfl_xor(lsum, 32);
        v4u x16[4], x4[4]; f32x2_t s16 = {0.f, 0.f}, s4 = {0.f, 0.f};
        if (SUB == 1) {
            const size_t qt = tb + (size_t)(s0c + i0 + ql) * dc;
            s16 = *(const f32x2_t*)((const float*)(F.ws + WS_STAT) + (qt * NH + hcur) * 2); s4 = *(const f32x2_t*)((const float*)(F.ws + WS_STAT) + (size_t)M * NH * 2 + (qt * NH + hcur) * 2);
        }
        f32x16 O[2];
#pragma unroll
        for (int i = 0; i < 16; ++i) { O[0][i] = 0.f; O[1][i] = 0.f; }
        const int trq = (lane_ & 15) >> 2, trg = (lane_ >> 4) & 1, trp = lane_ & 3;
#pragma unroll
        for (int kb = 0; kb < 5; ++kb)
#pragma unroll
            for (int s = 0; s < 2; ++s) {
                if (SUB == 1 && kb == 2 && s == 0) {
#pragma unroll
                    for (int p = 0; p < 4; ++p) { const size_t rt = tb + (size_t)(s0c + i0 + 8 * p + prow) * dc; const bf16* pp = (const bf16*)(F.ws + WS_XN) + rt * BW + hcur * 64 + pch * 8;
                        x16[p] = *(const v4u*)pp; x4[p] = *(const v4u*)(pp + (size_t)M * BW); } }
                v4u pw; pw.x = cvtpk(S[kb][8 * s], S[kb][8 * s + 1]); pw.y = cvtpk(S[kb][8 * s + 2], S[kb][8 * s + 3]); pw.z = cvtpk(S[kb][8 * s + 4], S[kb][8 * s + 5]); pw.w = cvtpk(S[kb][8 * s + 6], S[kb][8 * s + 7]);
                const bf16x8 pb = __builtin_bit_cast(bf16x8, pw);
                const int rlo = i0 + 32 * kb + 16 * s + 4 * hi + trq, rhi = rlo + 8;
#pragma unroll
                for (int dh = 0; dh < 2; ++dh) { const int chunk = 4 * dh + 2 * trg + (trp >> 1);
                    const v4i16_t lo = __builtin_amdgcn_ds_read_tr16_b64_v4i16((LAS v4i16_t*)(Vs + rlo * 128 + ((chunk ^ (((rlo >> 1) & 1) << 2)) << 4) + 8 * (trp & 1)));
                    const v4i16_t hh = __builtin_amdgcn_ds_read_tr16_b64_v4i16((LAS v4i16_t*)(Vs + rhi * 128 + ((chunk ^ (((rhi >> 1) & 1) << 2)) << 4) + 8 * (trp & 1)));
                    const bf16x8 va = (bf16x8){lo[0], lo[1], lo[2], lo[3], hh[0], hh[1], hh[2], hh[3]};
                    O[dh] = __builtin_amdgcn_mfma_f32_32x32x16_bf16(va, pb, O[dh], 0, 0, 0); } }
        float osc;
        if (SUB == 0) osc = 1.0f / lsum;
        else { const float MM = fmaxf(mx, fmaxf(s16.x, s4.x)), a1 = __builtin_amdgcn_exp2f(mx - MM), a16 = s16.y * __builtin_amdgcn_exp2f(s16.x - MM), a4 = s4.y * __builtin_amdgcn_exp2f(s4.x - MM);
            const float inv = 1.0f / (lsum * a1 + a16 + a4); osc = a1 * inv;
            if (hi == 0) { f32x2_t cc = {a16 * inv, a4 * inv}; *(LAS f32x2_t*)(St + ql * 144 + 128) = cc; } }
#pragma unroll
        for (int dh = 0; dh < 2; ++dh)
#pragma unroll
            for (int g4 = 0; g4 < 4; ++g4) { v2u w; w.x = cvtpk(O[dh][4 * g4] * osc, O[dh][4 * g4 + 1] * osc); w.y = cvtpk(O[dh][4 * g4 + 2] * osc, O[dh][4 * g4 + 3] * osc);
                *(LAS v2u*)(St + ql * 144 + (32 * dh + 8 * g4 + 4 * hi) * 2) = w; }
        if (SUB == 0) {
            bf16* PART = (bf16*)(F.ws + WS_XN) + (itcur < 1024 ? 0 : (size_t)M * BW); float* ST = (float*)(F.ws + WS_STAT) + (itcur < 1024 ? 0 : (size_t)M * NH * 2);
            if (hi == 0) { const size_t qt = tb + (size_t)(s0c + i0 + ql) * dc; f32x2_t st = {mx, lsum}; *(f32x2_t*)(ST + (qt * NH + hcur) * 2) = st; }
#pragma unroll
            for (int p = 0; p < 4; ++p) { const size_t rt = tb + (size_t)(s0c + i0 + 8 * p + prow) * dc;
                *(v4u*)(PART + rt * BW + hcur * 64 + pch * 8) = *(const LAS v4u*)(St + (8 * p + prow) * 144 + pch * 16); }
        } else {
#pragma unroll
            for (int p = 0; p < 4; ++p) { const size_t rt = tb + (size_t)(s0c + i0 + 8 * p + prow) * dc;
                const v4u ov = *(const LAS v4u*)(St + (8 * p + prow) * 144 + pch * 16); const f32x2_t cc = *(const LAS f32x2_t*)(St + (8 * p + prow) * 144 + 128);
                v4u o;
                o.x = cvtpk(bflo(ov.x) + cc.x * bflo(x16[p].x) + cc.y * bflo(x4[p].x), bfhi(ov.x) + cc.x * bfhi(x16[p].x) + cc.y * bfhi(x4[p].x));
                o.y = cvtpk(bflo(ov.y) + cc.x * bflo(x16[p].y) + cc.y * bflo(x4[p].y), bfhi(ov.y) + cc.x * bfhi(x16[p].y) + cc.y * bfhi(x4[p].y));
                o.z = cvtpk(bflo(ov.z) + cc.x * bflo(x16[p].z) + cc.y * bflo(x4[p].z), bfhi(ov.z) + cc.x * bfhi(x16[p].z) + cc.y * bfhi(x4[p].z));
                o.w = cvtpk(bflo(ov.w) + cc.x * bflo(x16[p].w) + cc.y * bflo(x4[p].w), bfhi(ov.w) + cc.x * bfhi(x16[p].w) + cc.y * bfhi(x4[p].w));
                *(v4u*)((bf16*)(F.ws + WS_MIXCAT) + rt * D + AW + hcur * 64 + pch * 8) = o; }
        }
        __syncthreads();
        if (!has_next) break;
        ATT_WRITE(); it = itn;
        __syncthreads();
    }
#undef ATT_DECODE
#undef ATT_LOAD
#undef ATT_WRITE
}
typedef float f32x4_t __attribute__((ext_vector_type(4)));
DI void cmul_acc(float& xr, float& xi, float ar, float ai, float br, float bi) { const float nr = ar * xr - ai * xi + br, ni = ar * xi + ai * xr + bi; xr = nr; xi = ni; }
DI void mix_ssm_in(Frame& F, int l) {
    FRAME_IDS
    const bf16* P = (const bf16*)(F.ws + WS_PROJ);
    const bf16* WIN = (const bf16*)(F.ws + WS_SSM2 + l * SSM2_LAYER + S2_WIN);
    const float* apw = (const float*)(F.ws + WS_SSM2 + l * SSM2_LAYER + S2_APW);
    float* XLOC = (float*)(F.ws + WS_XLOC); float* XSUP = (float*)(F.ws + WS_XSUP);
    const int row = lane_ & 15, q = lane_ >> 4;
    for (int it = F.vcu; it < 256; it += F.G) {
        const int b = it >> 5, sc = (it >> 2) & 7, g = 4 * (it & 3) + (wave_ >> 1), half = wave_ & 1;
        bf16x8 af[16];
        { const bf16* src = P + ((size_t)b * T + (size_t)(16 * sc + row) * 32 + (q >> 1)) * PROJW + COL_S + g * 16 + 8 * (q & 1);
#pragma unroll
          for (int sp = 0; sp < 16; ++sp) af[sp] = *(const bf16x8*)(src + (size_t)(2 * sp) * PROJW); }
#pragma unroll 1
        for (int c4 = 0; c4 < 4; ++c4) { const int ct = 4 * half + c4;
            f32x4_t acc = {0.f, 0.f, 0.f, 0.f};
            const bf16* wp = WIN + (((size_t)(g * 16) * 8 + ct) * 64 + lane_) * 8;
#pragma unroll
            for (int sp = 0; sp < 16; ++sp) { const bf16x8 bfr = *(const bf16x8*)(wp + (size_t)sp * 8 * 64 * 8); acc = __builtin_amdgcn_mfma_f32_16x16x32_bf16(af[sp], bfr, acc, 0, 0, 0); }
            const int comp = 16 * ct + row, n = comp >> 1, part = comp & 1;
#pragma unroll
            for (int r = 0; r < 4; ++r) XLOC[(((size_t)b * 128 + 16 * sc + 4 * q + r) * 16 + g) * 128 + comp] = acc[r];
            const float a32r = apw[((g * 33 + 32) * 64 + n) * 2], a32i = apw[((g * 33 + 32) * 64 + n) * 2 + 1];
            const float sg = part ? 1.f : -1.f;
            float h = acc[0];
#pragma unroll
            for (int r = 1; r < 4; ++r) { const float o = __shfl_xor(h, 1); h = a32r * h + sg * a32i * o + acc[r]; }
            float p64r = a32r * a32r - a32i * a32i, p64i = 2.f * a32r * a32i;
            float p128r = p64r * p64r - p64i * p64i, p128i = 2.f * p64r * p64i;
            float wr = 1.f, wi = 0.f;
            for (int k = 0; k < 3 - q; ++k) { const float t0 = wr * p128r - wi * p128i, t1 = wr * p128i + wi * p128r; wr = t0; wi = t1; }
            { const float o = __shfl_xor(h, 1); h = wr * h + sg * wi * o; }
            h += __shfl_xor(h, 16); h += __shfl_xor(h, 32);
            if (q == 0) XSUP[(((size_t)b * 8 + sc) * 16 + g) * 128 + comp] = h;
        }
    }
}
DI void mix_ssm_out(Frame& F, const Args& A, int l) {
    FRAME_IDS
    const bf16* P = (const bf16*)(F.ws + WS_PROJ); bf16* YG = (bf16*)(F.ws + WS_YG);
    const bf16* KT = (const bf16*)(F.ws + WS_SSM2 + l * SSM2_LAYER + S2_KT); const bf16* CT = (const bf16*)(F.ws + WS_SSM2 + l * SSM2_LAYER + S2_CT);
    const float* apw = (const float*)(F.ws + WS_SSM2 + l * SSM2_LAYER + S2_APW);
    const float* XLOC = (const float*)(F.ws + WS_XLOC); const float* XSUP = (const float*)(F.ws + WS_XSUP);
    LAS unsigned char* Ut = F.lds + RING_OFF + wave_ * 4096;
    LAS float* Xs = (LAS float*)(F.lds + RING_OFF + wave_ * 4096 + 2048);
    for (int i = lane_; i < 256; i += 64) ((LAS unsigned*)Ut)[i] = 0u;
    const int row = lane_ & 15, q = lane_ >> 4;
    for (int it = F.vcu; it < 256; it += F.G) {
        const int b = it >> 5, sc = (it >> 2) & 7, g = 4 * (it & 3) + (wave_ >> 1), half = wave_ & 1, n = lane_;
        const size_t tokA = (size_t)b * T + (size_t)(16 * sc + 8 * half) * 32;
        v4u unext = *(const v4u*)(P + (tokA + (lane_ >> 1)) * PROJW + COL_S + g * 16 + 8 * (lane_ & 1));
        f32x2_t psup[8], ploc[8];
#pragma unroll
        for (int s2 = 0; s2 < 8; ++s2) { psup[s2] = (f32x2_t){0.f, 0.f}; if (s2 < sc) psup[s2] = *(const f32x2_t*)(XSUP + (((size_t)b * 8 + s2) * 16 + g) * 128 + 2 * n); }
#pragma unroll
        for (int k2 = 0; k2 < 8; ++k2) { ploc[k2] = (f32x2_t){0.f, 0.f}; if (half) ploc[k2] = *(const f32x2_t*)(XLOC + (((size_t)b * 128 + 16 * sc + k2) * 16 + g) * 128 + 2 * n); }
        const float dsk = ((const float*)A.in[I_SSMD])[(l * 16 + g) * 16 + row];
        const float a32r = apw[((g * 33 + 32) * 64 + n) * 2], a32i = apw[((g * 33 + 32) * 64 + n) * 2 + 1];
        const float a16r = apw[((g * 33 + 16) * 64 + n) * 2], a16i = apw[((g * 33 + 16) * 64 + n) * 2 + 1];
        float a512r = a32r, a512i = a32i;
#pragma unroll
        for (int k = 0; k < 4; ++k) { const float t0 = a512r * a512r - a512i * a512i, t1 = 2.f * a512r * a512i; a512r = t0; a512i = t1; }
        float xr = 0.f, xi = 0.f;
#pragma unroll
        for (int s2 = 0; s2 < 8; ++s2) if (s2 < sc) cmul_acc(xr, xi, a512r, a512i, psup[s2].x, psup[s2].y);
        if (half) {
#pragma unroll
            for (int k2 = 0; k2 < 8; ++k2) cmul_acc(xr, xi, a32r, a32i, ploc[k2].x, ploc[k2].y); }
        asm volatile("" : "+v"(xr), "+v"(xi) :: "memory");
        bf16x8 kt[16], ctf[4];
#pragma unroll
        for (int p = 0; p < 16; ++p) kt[p] = *(const bf16x8*)(KT + ((size_t)(g * 16 + p) * 64 + lane_) * 8);
#pragma unroll
        for (int sx = 0; sx < 4; ++sx) ctf[sx] = *(const bf16x8*)(CT + ((size_t)(g * 4 + sx) * 64 + lane_) * 8);
        f32x4_t apr[4][2];
#pragma unroll
        for (int sx = 0; sx < 4; ++sx) { const f32x4_t* ap = (const f32x4_t*)(apw + ((size_t)(g * 33 + row + 1) * 64 + 16 * sx + 4 * q) * 2); apr[sx][0] = ap[0]; apr[sx][1] = ap[1]; }
#pragma unroll 1
        for (int kk = 0; kk < 8; ++kk) {
            const size_t tok0 = tokA + (size_t)kk * 32;
            const f32x2_t xl = *(const f32x2_t*)(XLOC + (((size_t)b * 128 + 16 * sc + 8 * half + kk) * 16 + g) * 128 + 2 * n);
            *(LAS v4u*)(Ut + 1024 + lane_ * 16) = unext;
            if (kk < 7) unext = *(const v4u*)(P + (tok0 + 32 + (lane_ >> 1)) * PROJW + COL_S + g * 16 + 8 * (lane_ & 1));
            Xs[2 * n] = xr; Xs[2 * n + 1] = xi; Xs[128 + 2 * n] = a16r * xr - a16i * xi; Xs[128 + 2 * n + 1] = a16r * xi + a16i * xr;
#pragma unroll
            for (int tau = 0; tau < 2; ++tau) { f32x4_t acc = (f32x4_t){0.f, 0.f, 0.f, 0.f};
                const int ti = 16 * tau + row;
#pragma unroll
                for (int sx = 0; sx < 4; ++sx) { const LAS f32x4_t* xp = (const LAS f32x4_t*)(Xs + 128 * tau + 2 * (16 * sx + 4 * q)); const f32x4_t x01 = xp[0], x23 = xp[1];
                    const f32x4_t a01 = apr[sx][0], a23 = apr[sx][1];
                    v4u zw; zw.x = cvtpk(a01.x * x01.x - a01.y * x01.y, a01.x * x01.y + a01.y * x01.x); zw.y = cvtpk(a01.z * x01.z - a01.w * x01.w, a01.z * x01.w + a01.w * x01.z);
                    zw.z = cvtpk(a23.x * x23.x - a23.y * x23.y, a23.x * x23.y + a23.y * x23.x); zw.w = cvtpk(a23.z * x23.z - a23.w * x23.w, a23.z * x23.w + a23.w * x23.z);
                    acc = __builtin_amdgcn_mfma_f32_16x16x32_bf16(__builtin_bit_cast(bf16x8, zw), ctf[sx], acc, 0, 0, 0);
                    asm volatile("" ::: "memory"); }
#pragma unroll
                for (int p = 0; p < 16; ++p) if (p < 8 * tau + 8) { const bf16x8 ua = *(const LAS bf16x8*)(Ut + (32 + ti - 2 * p - (q >> 1)) * 32 + 16 * (q & 1));
                    acc = __builtin_amdgcn_mfma_f32_16x16x32_bf16(ua, kt[p], acc, 0, 0, 0); if ((p & 3) == 3) asm volatile("" ::: "memory"); }
#pragma unroll
                for (int r = 0; r < 4; ++r) { const int t2 = 16 * tau + 4 * q + r; const float uu = bf2f(*(const LAS bf16*)(Ut + (32 + t2) * 32 + 2 * row));
                    YG[(tok0 + t2) * 256 + g * 16 + row] = (bf16)f2bf(gelu_tanh_f(acc[r] + dsk * uu)); }
            }
            cmul_acc(xr, xi, a32r, a32i, xl.x, xl.y);
        }
    }
}
DI void mix_gating_mfma(Frame& F, const Args& A, int l, int variant = 0) {
    FRAME_IDS
    const bf16* P = (const bf16*)(F.ws + WS_PROJ); bf16* MIX = (bf16*)(F.ws + WS_MIXCAT);
    const bf16* GW = (const bf16*)(F.ws + WS_SSM2 + l * SSM2_LAYER + S2_GW);
    const float* lng = (const float*)A.in[I_GMLNG] + l * AW; const float* lnb = (const float*)A.in[I_GMLNB] + l * AW;
    const float* bs_ = (const float*)A.in[I_GMBS] + l * 4 * 128;
    LAS unsigned char* VT = F.lds + RING_OFF;
    const int ql = lane_ & 31, hi = lane_ >> 5, trq = (lane_ & 15) >> 2, trg = (lane_ >> 4) & 1, trp = lane_ & 3;
    for (int it = F.vcu; it < BATCH * (T / 128); it += F.G) {
        const int m0 = it * 128;
        __syncthreads();
        if (variant != 2) {
        v2u wv[16];
#pragma unroll
        for (int j = 0; j < 16; ++j) wv[j] = *(const v2u*)(P + (size_t)(m0 + wave_ + 8 * j) * PROJW + COL_V + 4 * lane_);
        const f32x4 gg = *(const f32x4*)(lng + 4 * lane_), bb = *(const f32x4*)(lnb + 4 * lane_);
#pragma unroll
        for (int j = 0; j < 16; ++j) { const int r = wave_ + 8 * j; const v2u w = wv[j];
            float v[4] = {bflo(w.x), bfhi(w.x), bflo(w.y), bfhi(w.y)};
            const float mean = wave_sum(v[0] + v[1] + v[2] + v[3]) * (1.f / 256.f);
            float s2 = 0.f;
#pragma unroll
            for (int i = 0; i < 4; ++i) { v[i] -= mean; s2 += v[i] * v[i]; }
            const float rstd = 1.0f / sqrtf(wave_sum(s2) * (1.f / 256.f) + LN_EPS);
            v2u o; o.x = cvtpk(v[0] * rstd * gg.x + bb.x, v[1] * rstd * gg.y + bb.y); o.y = cvtpk(v[2] * rstd * gg.z + bb.z, v[3] * rstd * gg.w + bb.w);
            *(LAS v2u*)(VT + r * 512 + (((lane_ >> 1) ^ ((r & 3) << 2)) << 4) + 8 * (lane_ & 1)) = o;
        }
        }
        __syncthreads();
        if (variant == 1) continue;
        const int h = wave_ >> 1, cb = 64 * h + 32 * (wave_ & 1);
        const int chunk = (cb >> 3) + 2 * trg + (trp >> 1);
#pragma unroll
        for (int rt = 0; rt < 4; ++rt) {
            f32x16 acc;
#pragma unroll
            for (int i = 0; i < 16; ++i) acc[i] = 0.f;
            bf16x8 wa[8];
#pragma unroll
            for (int ks = 0; ks < 2 * rt + 2; ++ks) wa[ks] = *(const bf16x8*)(GW + ((size_t)h * 128 + 32 * rt + ql) * 128 + 16 * ks + 8 * hi);
#pragma unroll
            for (int ks = 0; ks < 2 * rt + 2; ++ks) {
                const int rlo = 16 * ks + 8 * hi + trq;
                const v4i16_t lo = __builtin_amdgcn_ds_read_tr16_b64_v4i16((LAS v4i16_t*)(VT + rlo * 512 + ((chunk ^ (trq << 2)) << 4) + 8 * (trp & 1)));
                const v4i16_t hh = __builtin_amdgcn_ds_read_tr16_b64_v4i16((LAS v4i16_t*)(VT + (rlo + 4) * 512 + ((chunk ^ (trq << 2)) << 4) + 8 * (trp & 1)));
                const bf16x8 va = (bf16x8){lo[0], lo[1], lo[2], lo[3], hh[0], hh[1], hh[2], hh[3]};
                acc = __builtin_amdgcn_mfma_f32_32x32x16_bf16(va, wa[ks], acc, 0, 0, 0); }
            { const int t = 32 * rt + ql; const float bsv = bs_[h * 128 + t];
              const bf16* up = P + (size_t)(m0 + t) * PROJW + COL_U + cb + 4 * hi; bf16* op = MIX + (size_t)(m0 + t) * D + cb + 4 * hi;
#pragma unroll
              for (int g4 = 0; g4 < 4; ++g4) { const v2u uw = *(const v2u*)(up + 8 * g4); v2u o;
                  o.x = cvtpk(bflo(uw.x) * (acc[4 * g4] + bsv), bfhi(uw.x) * (acc[4 * g4 + 1] + bsv)); o.y = cvtpk(bflo(uw.y) * (acc[4 * g4 + 2] + bsv), bfhi(uw.y) * (acc[4 * g4 + 3] + bsv));
                  *(v2u*)(op + 8 * g4) = o; } }
        }
    }
}

DI void p_glu(Frame& F, const Args& A, int l) {
    FRAME_IDS
    const bf16* YG = (const bf16*)(F.ws + WS_YG); bf16* MIX = (bf16*)(F.ws + WS_MIXCAT);
    const bf16* GluT = (const bf16*)(F.ws + WS_WSMALL + l * WSMALL_LAYER + WOFF_GLU); const float* gb = (const float*)A.in[I_GLUB] + l * 256;
    LAS unsigned char* Bs = F.lds + RING_OFF;
#pragma unroll
    for (int i = 0; i < 16; ++i) { const int idx = tid_ + 512 * i, n = idx >> 5, ch = idx & 31;
        *(LAS v4u*)(Bs + n * 512 + ((ch ^ (n & 15)) << 4)) = *(const v4u*)(GluT + (size_t)n * 256 + ch * 8); }
    __syncthreads();
    const int tk = lane_ & 15, q = lane_ >> 4;
    for (int rt = F.vcu; rt < M / 128; rt += F.G) {
        const size_t tok = (size_t)rt * 128 + wave_ * 16 + tk;
        bf16x8 yf[8];
#pragma unroll
        for (int ks = 0; ks < 8; ++ks) yf[ks] = *(const bf16x8*)(YG + tok * 256 + 32 * ks + 8 * q);
#pragma unroll 4
        for (int ct = 0; ct < 16; ++ct) {
            f32x4_t acc = {0.f, 0.f, 0.f, 0.f};
            const int n = 16 * ct + tk;
#pragma unroll
            for (int ks = 0; ks < 8; ++ks) { const bf16x8 wf = *(const LAS bf16x8*)(Bs + n * 512 + (((4 * ks + q) ^ (n & 15)) << 4));
                acc = __builtin_amdgcn_mfma_f32_16x16x32_bf16(wf, yf[ks], acc, 0, 0, 0); }
            const int n0 = 16 * ct + 4 * q; const v2u yw = *(const v2u*)(YG + tok * 256 + n0); const f32x4 bv = *(const f32x4*)(gb + n0);
            v2u o; o.x = cvtpk(bflo(yw.x) * sigmoid_f(acc[0] + bv.x), bfhi(yw.x) * sigmoid_f(acc[1] + bv.y)); o.y = cvtpk(bflo(yw.y) * sigmoid_f(acc[2] + bv.z), bfhi(yw.y) * sigmoid_f(acc[3] + bv.w));
            *(v2u*)(MIX + tok * D + 768 + n0) = o;
        }
    }
}
DI void mix_ssm_simple(Frame& F, const Args& A, int l) {
    FRAME_IDS
    const bf16* P = (const bf16*)(F.ws + WS_PROJ); bf16* YG = (bf16*)(F.ws + WS_YG);
    const float* tab = (const float*)(F.ws + WS_SSM) + (size_t)l * SSM_TAB;
    LAS float* fin = (LAS float*)(F.lds + RING_OFF);
    for (int it = F.vcu; it < BATCH * SSM_G; it += F.G) {
        const int b = it >> 4, g = it & 15, n = lane_, seg = wave_, gn = g * 64 + n;
        const float are = tab[gn], aim = tab[1024 + gn];
        float bre[16], bim[16], cre[16], cim[16];
#pragma unroll
        for (int c = 0; c < 16; ++c) { bre[c] = tab[2048 + gn * 16 + c]; bim[c] = tab[2048 + 16384 + gn * 16 + c];
            cre[c] = ((const float*)A.in[I_CRE])[(((size_t)l * 16 + g) * 16 + c) * 64 + n]; cim[c] = ((const float*)A.in[I_CIM])[(((size_t)l * 16 + g) * 16 + c) * 64 + n]; }
        const float dsk = ((const float*)A.in[I_SSMD])[(l * 16 + g) * 16 + (lane_ & 15)];
        const size_t mbase = (size_t)b * T + seg * 512;
        float xr = 0.f, xi = 0.f;
        for (int tt = 0; tt < 512; ++tt) { const v4u* up = (const v4u*)(P + (mbase + tt) * PROJW + COL_S + g * 16); const v4u u0 = up[0], u1 = up[1];
            const float u[16] = {bflo(u0.x), bfhi(u0.x), bflo(u0.y), bfhi(u0.y), bflo(u0.z), bfhi(u0.z), bflo(u0.w), bfhi(u0.w), bflo(u1.x), bfhi(u1.x), bflo(u1.y), bfhi(u1.y), bflo(u1.z), bfhi(u1.z), bflo(u1.w), bfhi(u1.w)};
            float br = 0.f, bi = 0.f;
#pragma unroll
            for (int c = 0; c < 16; ++c) { br += u[c] * bre[c]; bi += u[c] * bim[c]; }
            const float nr = are * xr - aim * xi + br, ni = are * xi + aim * xr + bi; xr = nr; xi = ni; }
        fin[(seg * 64 + n) * 2] = xr; fin[(seg * 64 + n) * 2 + 1] = xi;
        __syncthreads();
        float pr = are, pi = aim;
#pragma unroll
        for (int k = 0; k < 9; ++k) { const float t0 = pr * pr - pi * pi, t1 = 2.f * pr * pi; pr = t0; pi = t1; }
        xr = 0.f; xi = 0.f;
        for (int s = 0; s < seg; ++s) { const float fr_ = fin[(s * 64 + n) * 2], fi_ = fin[(s * 64 + n) * 2 + 1];
            const float nr = pr * xr - pi * xi + fr_, ni = pr * xi + pi * xr + fi_; xr = nr; xi = ni; }
        for (int tt = 0; tt < 512; ++tt) { const v4u* up = (const v4u*)(P + (mbase + tt) * PROJW + COL_S + g * 16); const v4u u0 = up[0], u1 = up[1];
            const float u[16] = {bflo(u0.x), bfhi(u0.x), bflo(u0.y), bfhi(u0.y), bflo(u0.z), bfhi(u0.z), bflo(u0.w), bfhi(u0.w), bflo(u1.x), bfhi(u1.x), bflo(u1.y), bfhi(u1.y), bflo(u1.z), bfhi(u1.z), bflo(u1.w), bfhi(u1.w)};
            float br = 0.f, bi = 0.f;
#pragma unroll
            for (int c = 0; c < 16; ++c) { br += u[c] * bre[c]; bi += u[c] * bim[c]; }
            const float nr = are * xr - aim * xi + br, ni = are * xi + aim * xr + bi; xr = nr; xi = ni;
            float ysel = 0.f, usel = 0.f;
#pragma unroll
            for (int c = 0; c < 16; ++c) { const float r = wave_sum(xr * cre[c] - xi * cim[c]); if ((lane_ & 15) == c) { ysel = r; usel = u[c]; } }
            if (lane_ < 16) { const float y = ysel + dsk * usel; YG[(mbase + tt) * 256 + g * 16 + lane_] = (bf16)f2bf(gelu_tanh_f(y)); } }
        __syncthreads();
    }
}

DI bool beats(float x, int i, float y, int j) { return x > y || (x == y && i < j); }
DI void p_row_b(Frame& F, const Args& A, int l, bool count = true) {
    FRAME_IDS
    const int gw = F.vcu * NWAVES + wave_, NGW = F.G * NWAVES;
    const bf16* PRE = (const bf16*)(F.ws + WS_PRE); bf16* X1 = (bf16*)(F.ws + WS_X1); bf16* XN = (bf16*)(F.ws + WS_XN);
    const float* mod = (const float*)(F.ws + WS_MOD) + (size_t)l * BATCH * 6 * D;
    const float* ln1g = (const float*)A.in[I_LN1G] + l * D; const float* ln1b = (const float*)A.in[I_LN1B] + l * D;
    const float* rw = (const float*)A.in[I_RW]; const float* rb = (const float*)A.in[I_RB];
    int* slot_a = (int*)(F.ws + WS_SLOT_A); float* slot_w = (float*)(F.ws + WS_SLOT_W);
    LAS float* rwS = (LAS float*)(F.lds + RING_OFF);
    volatile LAS unsigned* lcnt = (volatile LAS unsigned*)(F.lds + RING_OFF + 65536);
    LAS int* list_a = (LAS int*)(F.lds + RING_OFF + 66048); LAS float* list_w = (LAS float*)(F.lds + RING_OFF + 66048 + 8192);
    for (int i = tid_; i < D * NEXP; i += NTHR) rwS[(i & 15) * D + (i >> 4)] = rw[i];
    if (tid_ < 32) lcnt[tid_] = 0u;
    __syncthreads();
    const int hi5 = lane_ >> 5, b4 = (lane_ >> 4) & 1, b3 = (lane_ >> 3) & 1, b2 = (lane_ >> 2) & 1, emine = 8 * hi5 + 4 * b4 + 2 * b3 + b2;
    const int wi = 2 * b3 + b2, mygrp = 2 * hi5 + b4;
    const float rbm = rb[emine];
    Row16 lg1, lb1; row_load_f32(lg1, ln1g, lane_); row_load_f32(lb1, ln1b, lane_);
    v2u nraw[4];
    { const v2u* q = (const v2u*)(PRE + (size_t)gw * D);
#pragma unroll
      for (int k = 0; k < 4; ++k) nraw[k] = q[k * 64 + lane_]; }
    for (int m = gw; m < M; m += NGW) { const int b = m / T; const float* md = mod + (size_t)b * 6 * D;
        Row16 r;
#pragma unroll
        for (int k = 0; k < 4; ++k) { r.v[4 * k] = bflo(nraw[k].x); r.v[4 * k + 1] = bfhi(nraw[k].x); r.v[4 * k + 2] = bflo(nraw[k].y); r.v[4 * k + 3] = bfhi(nraw[k].y); }
        if (m + NGW < M) { const v2u* q = (const v2u*)(PRE + (size_t)(m + NGW) * D);
#pragma unroll
            for (int k = 0; k < 4; ++k) nraw[k] = q[k * 64 + lane_]; }
        Row16 msc, msh; row_load_f32(msc, md + 4 * D, lane_); row_load_f32(msh, md + 3 * D, lane_);
        row_ln(r);
#pragma unroll
        for (int i = 0; i < 16; ++i) r.v[i] = r.v[i] * lg1.v[i] + lb1.v[i];
        row_store_bf16(r, X1 + (size_t)m * D, lane_);
        row_ln(r);
#pragma unroll
        for (int i = 0; i < 16; ++i) r.v[i] = r.v[i] * (1.0f + msc.v[i]) + msh.v[i];
        row_store_bf16(r, XN + (size_t)m * D, lane_);
        float lg[16];
#pragma unroll
        for (int e = 0; e < 16; ++e) { float a = 0.f;
#pragma unroll
            for (int k = 0; k < 4; ++k) { const f32x4 w4 = *(const LAS f32x4*)(rwS + e * D + 256 * k + 4 * lane_); a += r.v[4 * k] * w4.x + r.v[4 * k + 1] * w4.y + r.v[4 * k + 2] * w4.z + r.v[4 * k + 3] * w4.w; }
            lg[e] = a; }
        float t8[8], t4[4], t2[2];
#pragma unroll
        for (int i = 0; i < 8; ++i) { const float keep = hi5 ? lg[8 + i] : lg[i], give = hi5 ? lg[i] : lg[8 + i]; t8[i] = keep + __shfl_xor(give, 32); }
#pragma unroll
        for (int i = 0; i < 4; ++i) { const float keep = b4 ? t8[4 + i] : t8[i], give = b4 ? t8[i] : t8[4 + i]; t4[i] = keep + __shfl_xor(give, 16); }
#pragma unroll
        for (int i = 0; i < 2; ++i) { const float keep = b3 ? t4[2 + i] : t4[i], give = b3 ? t4[i] : t4[2 + i]; t2[i] = keep + __shfl_xor(give, 8); }
        float z = (b2 ? t2[1] : t2[0]) + __shfl_xor(b2 ? t2[0] : t2[1], 4);
        z += __shfl_xor(z, 2); z += __shfl_xor(z, 1);
        const float scm = 1.0f / (1.0f + __builtin_amdgcn_exp2f(-1.4426950408889634f * z)), a = scm + rbm;
        const float p4 = __shfl_xor(a, 4), p8 = __shfl_xor(a, 8), p12 = __shfl_xor(a, 12);
        const float hi01 = fmaxf(a, p4), lo01 = fminf(a, p4), hi23 = fmaxf(p8, p12), lo23 = fminf(p8, p12);
        const float gs = fmaxf(hi01, hi23) + fmaxf(fmaxf(lo01, lo23), fminf(hi01, hi23));
        const float g16 = __shfl_xor(gs, 16), g32 = __shfl_xor(gs, 32), g48 = __shfl_xor(gs, 48);
        const bool best = beats(gs, mygrp, g16, mygrp ^ 1) && beats(gs, mygrp, g32, mygrp ^ 2) && beats(gs, mygrp, g48, mygrp ^ 3);
        const int rank = (beats(p4, wi ^ 1, a, wi) ? 1 : 0) + (beats(p8, wi ^ 2, a, wi) ? 1 : 0) + (beats(p12, wi ^ 3, a, wi) ? 1 : 0);
        const bool sel = best && rank < 2;
        float tot = sel ? scm : 0.f; tot += __shfl_xor(tot, 4); tot += __shfl_xor(tot, 8);
        if (count && sel && (lane_ & 3) == 0) { const unsigned rk = atomicAdd((unsigned*)&lcnt[emine], 1u);
            list_a[emine * 128 + rk] = 2 * m + rank; list_w[emine * 128 + rk] = scm / tot; }
    }
    __syncthreads();
    if (count) {
        if (tid_ < 16) { const unsigned n = lcnt[tid_]; lcnt[16 + tid_] = n ? atomicAdd((unsigned*)(F.ctl + CW_CNT + l * 128 + tid_), n) : 0u; }
        __syncthreads();
        for (int idx = tid_; idx < 16 * 128; idx += NTHR) { const int e = idx >> 7, rk = idx & 127;
            if (rk < (int)lcnt[e]) { const size_t slot = (size_t)e * SLOT_CAP + lcnt[16 + e] + rk; slot_a[slot] = list_a[idx]; slot_w[slot] = list_w[idx]; } }
    }
}

DI void moe_tstart(Frame& F, int l) {
    FRAME_IDS
    volatile LAS int* ts = (volatile LAS int*)(F.lds + LDSCTL_OFF);
    __syncthreads();
    if (tid_ == 0) { int acc = 0;
        for (int e = 0; e < 16; ++e) { ts[e] = acc; const unsigned c = __hip_atomic_load(F.ctl + CW_CNT + l * 128 + e, RLX_AGENT); ts[32 + e] = (int)c; acc += (int)((c + 255u) >> 8); }
        ts[16] = acc; }
    __syncthreads();
}
DI void p_row_c(Frame& F, const Args& A, int l) {
    FRAME_IDS
    const int gw = F.vcu * NWAVES + wave_, NGW = F.G * NWAVES;
    const bf16* X1 = (const bf16*)(F.ws + WS_X1); bf16* R2 = (bf16*)(F.ws + WS_ROWS2); bf16* XN = (bf16*)(F.ws + WS_XN);
    const float* mod = (const float*)(F.ws + WS_MOD) + (size_t)l * BATCH * 6 * D;
    const float* modn = (const float*)(F.ws + WS_MOD) + (size_t)(l + 1) * BATCH * 6 * D;
    const float* ln2g = (const float*)A.in[I_LN2G] + l * D; const float* ln2b = (const float*)A.in[I_LN2B] + l * D;
    Row16 lg2, lb2; row_load_f32(lg2, ln2g, lane_); row_load_f32(lb2, ln2b, lane_);
    v2u nx[4], n0[4], n1[4];
#define RC_LOAD(mm) do { const v2u* qa = (const v2u*)(X1 + (size_t)(mm) * D); const v2u* qb = (const v2u*)(R2 + (size_t)(2 * (mm)) * D); \
        _Pragma("unroll") for (int k = 0; k < 4; ++k) { nx[k] = qa[k * 64 + lane_]; n0[k] = qb[k * 64 + lane_]; n1[k] = qb[256 + k * 64 + lane_]; } } while (0)
    RC_LOAD(gw);
    for (int m = gw; m < M; m += NGW) { const int b = m / T; const float* md = mod + (size_t)b * 6 * D;
        Row16 x1, g2;
#pragma unroll
        for (int k = 0; k < 4; ++k) {
            x1.v[4 * k] = ALPHA * bflo(nx[k].x); x1.v[4 * k + 1] = ALPHA * bfhi(nx[k].x); x1.v[4 * k + 2] = ALPHA * bflo(nx[k].y); x1.v[4 * k + 3] = ALPHA * bfhi(nx[k].y);
            g2.v[4 * k] = bflo(n0[k].x) + bflo(n1[k].x); g2.v[4 * k + 1] = bfhi(n0[k].x) + bfhi(n1[k].x); g2.v[4 * k + 2] = bflo(n0[k].y) + bflo(n1[k].y); g2.v[4 * k + 3] = bfhi(n0[k].y) + bfhi(n1[k].y); }
        if (m + NGW < M) RC_LOAD(m + NGW);
        Row16 gm; row_load_f32(gm, md + 5 * D, lane_);
        Row16 msc, msh;
        if (l != DEPTH - 1) { const float* mdn = modn + (size_t)b * 6 * D; row_load_f32(msc, mdn + 1 * D, lane_); row_load_f32(msh, mdn + 0 * D, lane_); }
#pragma unroll
        for (int i = 0; i < 16; ++i) x1.v[i] = x1.v[i] + (1.0f + gm.v[i]) * g2.v[i];
        row_ln(x1);
#pragma unroll
        for (int i = 0; i < 16; ++i) x1.v[i] = x1.v[i] * lg2.v[i] + lb2.v[i];
        if (l == DEPTH - 1) row_store_f32(x1, A.out + (size_t)m * D, lane_);
        else { row_store_bf16(x1, R2 + (size_t)(2 * m) * D, lane_);
            row_ln(x1);
#pragma unroll
            for (int i = 0; i < 16; ++i) x1.v[i] = x1.v[i] * (1.0f + msc.v[i]) + msh.v[i];
            row_store_bf16(x1, XN + (size_t)m * D, lane_); }
    }
#undef RC_LOAD
}

#ifndef PHMASK
#define PHMASK 0xFFFFFFFFu
#endif
#define IN(k) (lo <= (k) && (k) < hi && ((PHMASK >> (((k) == 0) ? 31 : (((k) - 1) % PH_PER_LAYER))) & 1u))
#define SEAM(k) do { if (IN((k) + 1) && MK_ONE_LAUNCH) xcd_barrier(bar); else __syncthreads(); } while (0)
constexpr int PH_PER_LAYER = 9, N_PHASES = 1 + DEPTH * PH_PER_LAYER;
#ifndef REP_PH
#define REP_PH -1
#endif
#define NREP(k) (((k) == REP_PH) ? 2 : 1)
template <int l> DI void layer_body(Frame& F, const Args& args, const XcdBarrier& bar, const int lo, const int hi) {
    unsigned char* ws = args.ws;

        const int pb = 1 + l * PH_PER_LAYER;
        const bf16* WinT = (const bf16*)(ws + WS_WSMALL + l * WSMALL_LAYER + WOFF_IN);
        const bf16* WoutT = (const bf16*)(ws + WS_WSMALL + l * WSMALL_LAYER + WOFF_OUT);
        const bf16* GluT = (const bf16*)(ws + WS_WSMALL + l * WSMALL_LAYER + WOFF_GLU);
        const float* modl = (const float*)(ws + WS_MOD) + (size_t)l * BATCH * 6 * D;
        if (IN(pb + 0)) for (int rep_ = 0; rep_ < NREP(0); ++rep_) { p_wconv(F, args, l, 0); if (l == 0) p_ln_a0(F, args); SEAM(pb + 0); }
        if (IN(pb + 1)) for (int rep_ = 0; rep_ < NREP(1); ++rep_) {
            pg8::Gemm g{(const bf16*)(ws + WS_XN), WinT, M, PROJW, D}; pg8::StaticOrder S; S.init(M, PROJW, F.G, (int)blockIdx.x);
            EpiInProj E{(bf16*)(ws + WS_PROJ), (const float*)(ws + WS_ROPE), args.pad};
            pg8::gemm_phase<EpiInProj, pg8::StaticOrder, PG8_ALIGN, PG8_SP2>(F.lds + RING_OFF, g, S, E);
            if (F.G == 256 && blockIdx.x >= 128) { __syncthreads(); p_wconv(F, args, l, 1); }
            SEAM(pb + 1); }
        if (IN(pb + 2)) for (int rep_ = 0; rep_ < NREP(2); ++rep_) {
#ifndef REP_SUB
#define REP_SUB -1
#endif
#define SUBREP(k) for (int rs_ = 0; rs_ < ((REP_SUB == (k)) ? 2 : 1); ++rs_)
            SUBREP(0) { mix_gating_mfma(F, args, l); __syncthreads(); }
#if REP_SUB >= 10 && REP_SUB < 20
            mix_gating_mfma(F, args, l, REP_SUB - 10); __syncthreads(); mix_gating_mfma(F, args, l); __syncthreads();
#endif
 SUBREP(1) { mix_ssm_in(F, l); } SUBREP(2) { mix_attn_mfma<0>(F, l); __syncthreads(); } SEAM(pb + 2); }
        if (IN(pb + 3)) for (int rep_ = 0; rep_ < NREP(3); ++rep_) { SUBREP(3) { mix_ssm_out(F, args, l); __syncthreads(); } SUBREP(4) { mix_attn_mfma<1>(F, l); __syncthreads(); } SEAM(pb + 3); }
        if (IN(pb + 4)) for (int rep_ = 0; rep_ < NREP(4); ++rep_) { p_glu(F, args, l); SEAM(pb + 4); }
        if (IN(pb + 5)) for (int rep_ = 0; rep_ < NREP(5); ++rep_) {
            pg8::Gemm g{(const bf16*)(ws + WS_MIXCAT), WoutT, M, D, D}; pg8::StaticOrder S; S.init(M, D, F.G, (int)blockIdx.x);
            if (l == 0) { EpiOut<true> E{(bf16*)(ws + WS_PRE), args.in[I_X], D, modl}; pg8::gemm_phase<EpiOut<true>, pg8::StaticOrder, PG8_ALIGN, PG8_SP2>(F.lds + RING_OFF, g, S, E); }
            else { EpiOut<false> E{(bf16*)(ws + WS_PRE), (const void*)(ws + WS_ROWS2), 2 * D, modl}; pg8::gemm_phase<EpiOut<false>, pg8::StaticOrder, PG8_ALIGN, PG8_SP2>(F.lds + RING_OFF, g, S, E); }
            SEAM(pb + 5); }
        if (IN(pb + 6)) { p_row_b(F, args, l); SUBREP(5) { if (REP_SUB == 5 && rs_ == 0) { __syncthreads(); p_row_b(F, args, l, false); } } SEAM(pb + 6); }
        if (IN(pb + 7)) { moe_tstart(F, l);
            gu32* dcnt = F.ctl + CW_DONE + l * 512;
            { pg8::Gemm g{(const bf16*)(ws + WS_XN), (const bf16*)(ws + WS_WGU), NSLOT_MAX, NEXP * 1024, D};
              MoeOrderK<0> S{(const volatile LAS int*)(F.lds + LDSCTL_OFF), F.G, (int)blockIdx.x, (const int*)(ws + WS_SLOT_A), (const float*)(ws + WS_SLOT_W), dcnt}; EpiG1 E{(bf16*)(ws + WS_HID)};
              pg8::gemm_phase_g<EpiG1, MoeOrderK<0>, PG8_ALIGN, PG8_SP2, 0>(F.lds + RING_OFF, F.lds + GT_OFF, g, S, E); }
            { pg8::Gemm g{(const bf16*)(ws + WS_HID), (const bf16*)(ws + WS_WD), NSLOT_MAX, NEXP * 1024, DEXP};
              MoeOrderK<1> S{(const volatile LAS int*)(F.lds + LDSCTL_OFF), F.G, (int)blockIdx.x, (const int*)(ws + WS_SLOT_A), (const float*)(ws + WS_SLOT_W), dcnt}; EpiG2 E{(bf16*)(ws + WS_ROWS2)};
              pg8::gemm_phase_g<EpiG2, MoeOrderK<1>, PG8_ALIGN, PG8_SP2, 16>(F.lds + RING_OFF, F.lds + GT_OFF, g, S, E); }
            SEAM(pb + 7); }
        if (IN(pb + 8)) { p_row_c(F, args, l); SUBREP(6) { if (REP_SUB == 6 && rs_ == 0 && l == DEPTH - 1) { __syncthreads(); p_row_c(F, args, l); } } SEAM(pb + 8); }
    }
__global__ void __launch_bounds__(NTHR, 2) mk_fwd(Args args) {
    extern __shared__ __attribute__((aligned(16))) unsigned char lds[];
    Frame F;
    F.lds = (LAS unsigned char*)lds; F.MISC = (volatile LAS unsigned*)(F.lds + MISC_OFF);
    F.G = gridDim.x; { const int bx = blockIdx.x; F.vcu = (F.G % 8 == 0) ? (bx % 8) * (F.G / 8) + bx / 8 : bx; }
    F.ws = args.ws; F.ctl = (gu32*)(args.ws + WS_CTL);
    for (int u = ftid(); u < (LDS_BYTES - LDSCTL_OFF) / 4; u += NTHR) ((LAS unsigned*)(F.lds + LDSCTL_OFF))[u] = 0u;
    __syncthreads();
    XcdBarrier bar; bar.bar = (unsigned*)(F.ctl + CW_BAR); bar.x = 0; bar.st = nullptr;
    if (MK_ONE_LAUNCH) bar = xcd_barrier_post((unsigned*)(F.ctl + CW_BAR), F.MISC + 8);
    const int lo = args.ph_lo, hi = args.ph_hi;
    unsigned char* ws = args.ws; (void)ws;
    if (IN(0)) { p0_tables(F, args); SEAM(0); }
    layer_body<0>(F, args, bar, lo, hi);
    layer_body<1>(F, args, bar, lo, hi);
#ifdef EXTRA_BARS
    if (MK_ONE_LAUNCH) for (int xb_ = 0; xb_ < EXTRA_BARS; ++xb_) xcd_barrier(bar);
#endif
#undef IN
#undef SEAM
}

extern "C" void kernel_launch(void* const* d_in, const int* in_sizes, int n_in, void* d_out, int out_size, void* d_ws, size_t ws_size, hipStream_t stream) {
    static int grid = 0;
    if (grid == 0) {
        if (n_in != 30 || in_sizes[0] != M * D || out_size != M * D || ws_size < WS_END) { fprintf(stderr, "kernel_launch: unexpected shapes (n_in %d, in0 %d, out %d, ws %zu, need %zu)\n", n_in, n_in > 0 ? in_sizes[0] : -1, out_size, ws_size, (size_t)WS_END); grid = -1; return; }
        int dev = 0, cus = 0, per_cu = 0;
        if (hipGetDevice(&dev) != hipSuccess || hipDeviceGetAttribute(&cus, hipDeviceAttributeMultiprocessorCount, dev) != hipSuccess) { grid = -1; return; }
        if (hipFuncSetAttribute((const void*)mk_fwd, hipFuncAttributeMaxDynamicSharedMemorySize, LDS_BYTES) != hipSuccess) { fprintf(stderr, "kernel_launch: hipFuncSetAttribute failed\n"); grid = -1; return; }
        if (hipOccupancyMaxActiveBlocksPerMultiprocessor(&per_cu, (const void*)mk_fwd, NTHR, LDS_BYTES) != hipSuccess || per_cu < 1) fprintf(stderr, "kernel_launch: occupancy query says %d\n", per_cu);
        (void)hipGetLastError();
        grid = cus;
    }
    if (grid < 0) return;
    if (hipMemsetAsync((char*)d_ws + WS_CTL, 0, CTL_ZERO_BYTES, stream) != hipSuccess) return;
    Args a{};
    for (int i = 0; i < 30; ++i) a.in[i] = d_in[i];
    a.out = (float*)d_out; a.ws = (unsigned char*)d_ws;
#if MK_ONE_LAUNCH
    a.ph_lo = 0; a.ph_hi = N_PHASES; a.li = 0;
    hipLaunchKernelGGL(mk_fwd, dim3(grid), dim3(NTHR), LDS_BYTES, stream, a);
#else
#ifndef REP_GLOBAL
#define REP_GLOBAL -1
#endif
#ifndef PROBE_SKIP
#define PROBE_SKIP 1
#endif
#ifndef REP_COUNT
#define REP_COUNT 2
#endif
    for (int p = 0; p < N_PHASES; ++p) { a.ph_lo = p; a.ph_hi = p + 1; a.li = p;
        const int nrep = ((p == 0 ? 100 : (p - 1) % PH_PER_LAYER) == REP_GLOBAL) ? REP_COUNT : 1;
        for (int r = 0; r < nrep; ++r) { a.pad = r ? PROBE_SKIP : 0; hipLaunchKernelGGL(mk_fwd, dim3(grid), dim3(NTHR), LDS_BYTES, stream, a); } a.pad = 0; }
#endif
}
```

```cpp
#include <hip/hip_runtime.h>
#include <cstdio>
#include <cstdint>
namespace pg8 {
#define PG8_LAS __attribute__((address_space(3)))
typedef unsigned short bf16_t;
typedef short bf16x8 __attribute__((ext_vector_type(8)));
typedef float f32x4 __attribute__((ext_vector_type(4)));
typedef unsigned u32x4 __attribute__((ext_vector_type(4)));
constexpr int BM = 256, BK = 64, HALF = 128, HTB = HALF * BK * 2  , STAGE_BYTES = 8 * HTB, NXCD = 8, WGM = 8;

__host__ __device__ __forceinline__ int lds_byte(int r, int c) { const int st = (r >> 4) * 2 + (c >> 5), rr = r & 15, cc = c & 31, ob = rr * 64 + cc * 2; return st * 1024 + (ob ^ (((ob >> 9) & 1) << 5)); }
__host__ __device__ __forceinline__ void stage_rc(int b, int& R, int& C) { const int st = b / 1024, sb = b % 1024, swz = sb ^ (((sb >> 9) & 1) << 5); R = (st >> 1) * 16 + swz / 64; C = (st & 1) * 32 + (swz % 64) / 2; }
__host__ __device__ __forceinline__ int perm32(int rho) { const int n = rho >> 4, i = rho & 15; return 8 * (i >> 2) + 4 * n + (i & 3); }

struct Unit { int pm, pn; };
struct Gemm { const bf16_t* A; const bf16_t* Bt; int M, N, K; };

struct StaticOrder {
    int nM, nN, nwg, G, c;
    __host__ __device__ void init(int M, int N, int G_, int c_) { nM = M / BM; nN = N / BM; nwg = nM * nN; G = G_; c = c_; }
    __host__ __device__ bool next(int i, Unit& u) const {
        const long L = (long)i * G + c; if (L >= nwg) return false;
        int wgid = (int)L; { const int q = nwg / NXCD, r = nwg % NXCD, xcd = wgid % NXCD, off = wgid / NXCD; wgid = (xcd < r ? xcd * (q + 1) : r * (q + 1) + (xcd - r) * q) + off; }
        const int nig = WGM * nN, gid = wgid / nig, fm = gid * WGM, gsz = (nM - fm) < WGM ? (nM - fm) : WGM;
        u.pm = fm + ((wgid % nig) % gsz); u.pn = (wgid % nig) / gsz; return true;
    }
    __device__ __forceinline__ void a_ready(const Unit&) const {}
    __device__ __forceinline__ void done(const Unit&) const {}
};

__device__ __forceinline__ unsigned cvt_pk_bf16(float lo, float hi) { unsigned r; asm volatile("v_cvt_pk_bf16_f32 %0, %1, %2" : "=v"(r) : "v"(lo), "v"(hi)); return r; }
template <class Epi, class Sched, bool ALIGN_EPI = false, bool SP2 = false>
__device__ __forceinline__ void gemm_phase(PG8_LAS unsigned char* lds, const Gemm g, const Sched& S, const Epi& E) {
    const int tid = threadIdx.x, wid = __builtin_amdgcn_readfirstlane(tid >> 6), lane = tid & 63, wr = wid >> 2, wc = wid & 3, fr = lane & 15, fq = lane >> 4;
    const int K = g.K, nt = K / BK;
    unsigned voffA[2], voffB[2];
#pragma unroll
    for (int i = 0; i < 2; ++i) { int R, C; stage_rc(tid * 16 + i * 8192, R, C); const int Rb = Epi::PERM ? ((R & ~31) + perm32(R & 31)) : R;
        voffA[i] = (unsigned)(R * K + C) * 2u; voffB[i] = (unsigned)(Rb * K + C) * 2u; }
    const size_t kstep = (size_t)(BK * 2);
    const size_t hstep = (size_t)HALF * K * 2;
    const size_t tstep = 2 * hstep;
    const unsigned ldsw = (unsigned)wid * 1024u;
    const int aoff = lds_byte(wr * 64 + fr, fq * 8), boff = lds_byte(wc * 32 + fr, fq * 8);
#define PG8_SA(b, h) (((b) * 2 + (h)) * HTB)
#define PG8_SB(b, h) ((4 + (b) * 2 + (h)) * HTB)
#define PG8_STAGE(bufoff, gbase, voff) do { _Pragma("unroll") for (int _i = 0; _i < 2; ++_i) \
        __builtin_amdgcn_global_load_lds((const unsigned*)((const char*)(gbase) + (voff)[_i]), (PG8_LAS unsigned*)(lds + (bufoff) + ldsw + _i * 8192), 16, 0, 0); } while (0)
#define PG8_LDA(dst, b, h) do { _Pragma("unroll") for (int m = 0; m < 4; ++m) _Pragma("unroll") for (int k = 0; k < 2; ++k) dst[m][k] = *(const PG8_LAS bf16x8*)(lds + PG8_SA(b, h) + aoff + m * 2048 + k * 1024); } while (0)
#define PG8_LDB(dst, b, h) do { _Pragma("unroll") for (int n = 0; n < 2; ++n) _Pragma("unroll") for (int k = 0; k < 2; ++k) dst[n][k] = *(const PG8_LAS bf16x8*)(lds + PG8_SB(b, h) + boff + n * 2048 + k * 1024); } while (0)
#define PG8_MMA(ai, bj, At, Bt) do { __builtin_amdgcn_s_setprio(1); _Pragma("unroll") for (int m = 0; m < 4; ++m) _Pragma("unroll") for (int n = 0; n < 2; ++n) _Pragma("unroll") for (int k = 0; k < 2; ++k) \
        acc[ai][bj][m][n] = __builtin_amdgcn_mfma_f32_16x16x32_bf16(Bt[n][k], At[m][k], acc[ai][bj][m][n], 0, 0, 0); __builtin_amdgcn_s_setprio(0); } while (0)
#define PG8_WAIT_V(n) asm volatile("s_waitcnt vmcnt(" #n ")" ::: "memory")
#define PG8_WAIT_L(n) asm volatile("s_waitcnt lgkmcnt(" #n ")" ::: "memory")
#define PG8_BAR __builtin_amdgcn_s_barrier()
#define PG8_SCHED __builtin_amdgcn_sched_barrier(0)
    Unit cur, nxt; int ui = 0;
    if (!S.next(0, cur)) return;
    f32x4 acc[2][2][4][2];
#pragma unroll
    for (int a = 0; a < 2; ++a)
#pragma unroll
        for (int b = 0; b < 2; ++b)
#pragma unroll
            for (int m = 0; m < 4; ++m)
#pragma unroll
                for (int n = 0; n < 2; ++n) acc[a][b][m][n] = (f32x4){0.f, 0.f, 0.f, 0.f};
    bf16x8 At[4][2], B0[2][2], B1[2][2];
    const char* cA = (const char*)g.A + (size_t)cur.pm * tstep; const char* cB = (const char*)g.Bt + (size_t)cur.pn * tstep;
    S.a_ready(cur);
    if constexpr (SP2) {
        PG8_STAGE(PG8_SB(0, 0), cB, voffB); PG8_STAGE(PG8_SB(0, 1), cB + hstep, voffB); PG8_STAGE(PG8_SA(0, 0), cA, voffA); PG8_STAGE(PG8_SA(0, 1), cA + hstep, voffA);
        if (wr == 1) PG8_BAR;
        PG8_WAIT_V(2); PG8_BAR;
        PG8_STAGE(PG8_SB(1, 0), cB + kstep, voffB); PG8_STAGE(PG8_SA(1, 0), cA + kstep, voffA); PG8_STAGE(PG8_SB(1, 1), cB + hstep + kstep, voffB);
        PG8_WAIT_V(6); PG8_BAR;
    } else {
        PG8_STAGE(PG8_SB(0, 0), cB, voffB); PG8_STAGE(PG8_SA(0, 0), cA, voffA); PG8_STAGE(PG8_SB(0, 1), cB + hstep, voffB); PG8_STAGE(PG8_SA(0, 1), cA + hstep, voffA);
        if (wr == 1) PG8_BAR;
        PG8_WAIT_V(4); PG8_BAR;
        PG8_STAGE(PG8_SB(1, 0), cB + kstep, voffB); PG8_STAGE(PG8_SA(1, 0), cA + kstep, voffA); PG8_STAGE(PG8_SB(1, 1), cB + hstep + kstep, voffB);
        PG8_WAIT_V(6); PG8_BAR;
    }
    for (;;) {
        const bool has_next = S.next(ui + 1, nxt);
        const char* nA = has_next ? (const char*)g.A + (size_t)nxt.pm * tstep : cA; const char* nB = has_next ? (const char*)g.Bt + (size_t)nxt.pn * tstep : cB;
        for (int t = 0; t < nt; t += 2) {
            const bool last = (t == nt - 2);
            const char* a1 = cA + (size_t)(t + 1) * kstep;
            const char* a2 = last ? nA : cA + (size_t)(t + 2) * kstep; const char* b2 = last ? nB : cB + (size_t)(t + 2) * kstep;
            const char* a3 = a2 + kstep; const char* b3 = b2 + kstep;
            if (last && has_next) S.a_ready(nxt);
            if constexpr (SP2) {
            PG8_LDB(B0, 0, 0); PG8_LDB(B1, 0, 1); PG8_SCHED; PG8_LDA(At, 0, 0); PG8_STAGE(PG8_SA(1, 1), a1 + hstep, voffA);
            PG8_WAIT_V(8); PG8_WAIT_L(0); PG8_BAR; PG8_MMA(0, 0, At, B0); PG8_MMA(0, 1, At, B1); PG8_BAR; PG8_SCHED;
            PG8_LDA(At, 0, 1); PG8_STAGE(PG8_SB(0, 0), b2, voffB); PG8_STAGE(PG8_SB(0, 1), b2 + hstep, voffB); PG8_STAGE(PG8_SA(0, 0), a2, voffA);
            PG8_WAIT_V(8); PG8_WAIT_L(0); PG8_BAR; PG8_MMA(1, 0, At, B0); PG8_MMA(1, 1, At, B1); PG8_BAR; PG8_SCHED;
            PG8_LDB(B0, 1, 0); PG8_LDB(B1, 1, 1); PG8_SCHED; PG8_LDA(At, 1, 0); PG8_STAGE(PG8_SA(0, 1), a2 + hstep, voffA);
            PG8_WAIT_V(8); PG8_WAIT_L(0); PG8_BAR; PG8_MMA(0, 0, At, B0); PG8_MMA(0, 1, At, B1); PG8_BAR; PG8_SCHED;
            PG8_LDA(At, 1, 1); PG8_STAGE(PG8_SB(1, 0), b3, voffB); PG8_STAGE(PG8_SB(1, 1), b3 + hstep, voffB); PG8_STAGE(PG8_SA(1, 0), a3, voffA);
            PG8_WAIT_V(8); PG8_WAIT_L(0); PG8_BAR; PG8_MMA(1, 0, At, B0); PG8_MMA(1, 1, At, B1); PG8_BAR; PG8_SCHED;
            } else {
            PG8_LDB(B0, 0, 0); PG8_SCHED; PG8_LDA(At, 0, 0); PG8_STAGE(PG8_SA(1, 1), a1 + hstep, voffA);
            PG8_WAIT_L(8); PG8_BAR; PG8_WAIT_L(0); PG8_MMA(0, 0, At, B0); PG8_BAR; PG8_SCHED;
            PG8_LDB(B1, 0, 1); PG8_STAGE(PG8_SB(0, 0), b2, voffB);
            PG8_BAR; PG8_WAIT_L(0); PG8_MMA(0, 1, At, B1); PG8_BAR;
            PG8_LDA(At, 0, 1); PG8_STAGE(PG8_SA(0, 0), a2, voffA);
            PG8_BAR; PG8_WAIT_L(0); PG8_MMA(1, 0, At, B0); PG8_BAR; PG8_SCHED;
            PG8_STAGE(PG8_SB(0, 1), b2 + hstep, voffB);
            PG8_WAIT_V(6); PG8_BAR; PG8_MMA(1, 1, At, B1); PG8_BAR;
            PG8_LDB(B0, 1, 0); PG8_SCHED; PG8_LDA(At, 1, 0); PG8_STAGE(PG8_SA(0, 1), a2 + hstep, voffA);
            PG8_WAIT_L(8); PG8_BAR; PG8_WAIT_L(0); PG8_MMA(0, 0, At, B0); PG8_BAR; PG8_SCHED;
            PG8_LDB(B1, 1, 1); PG8_STAGE(PG8_SB(1, 0), b3, voffB);
            PG8_BAR; PG8_WAIT_L(0); PG8_MMA(0, 1, At, B1); PG8_BAR;
            PG8_LDA(At, 1, 1); PG8_STAGE(PG8_SA(1, 0), a3, voffA);
            PG8_BAR; PG8_WAIT_L(0); PG8_MMA(1, 0, At, B0); PG8_BAR; PG8_SCHED;
            PG8_STAGE(PG8_SB(1, 1), b3 + hstep, voffB);
            PG8_WAIT_V(6); PG8_BAR; PG8_MMA(1, 1, At, B1); PG8_BAR;
            }
        }
        if constexpr (ALIGN_EPI) { if (wr == 0) PG8_BAR; }
        if constexpr (!Epi::AFTER_DRAIN) { E(acc, cur, wr, wc, fr, fq); S.done(cur); }
        if (!has_next) break;
#pragma unroll
        for (int a = 0; a < 2; ++a)
#pragma unroll
            for (int b = 0; b < 2; ++b)
#pragma unroll
                for (int m = 0; m < 4; ++m)
#pragma unroll
                    for (int n = 0; n < 2; ++n) acc[a][b][m][n] = (f32x4){0.f, 0.f, 0.f, 0.f};
        cur = nxt; cA = nA; cB = nB; ++ui;
        if constexpr (ALIGN_EPI) { if (wr == 1) PG8_BAR; }
    }
    PG8_WAIT_V(0);
    if constexpr (!ALIGN_EPI) { if (wr == 0) PG8_BAR; }
    PG8_BAR;
    if constexpr (Epi::AFTER_DRAIN) { E.fused(acc, cur, wr, wc, fr, fq, lds, wid, lane); S.done(cur); }
#undef PG8_SA
#undef PG8_SB
#undef PG8_STAGE
#undef PG8_LDA
#undef PG8_LDB
#undef PG8_MMA
#undef PG8_WAIT_V
#undef PG8_WAIT_L
#undef PG8_BAR
#undef PG8_SCHED
}
template <class Epi, class Sched, bool ALIGN_EPI = false, bool SP2 = false, int AUXA = 0>
__device__ __forceinline__ void gemm_phase_g(PG8_LAS unsigned char* lds, PG8_LAS unsigned char* gt, const Gemm g, const Sched& S, const Epi& E) {
    const int tid = threadIdx.x, wid = __builtin_amdgcn_readfirstlane(tid >> 6), lane = tid & 63, wr = wid >> 2, wc = wid & 3, fr = lane & 15, fq = lane >> 4;
    const int K = g.K, nt = K / BK;
    unsigned gpk[2], voffB[2];
#pragma unroll
    for (int i = 0; i < 2; ++i) { int R, C; stage_rc(tid * 16 + i * 8192, R, C); const int Rb = Epi::PERM ? ((R & ~31) + perm32(R & 31)) : R;
        gpk[i] = (unsigned)(R * 4) | ((unsigned)(C * 2) << 16); voffB[i] = (unsigned)(Rb * K + C) * 2u; }
    int par = 0;
    const size_t kstep = (size_t)(BK * 2);
    const size_t hstep = (size_t)HALF * K * 2;
    const size_t tstep = 2 * hstep;
    const unsigned ldsw = (unsigned)wid * 1024u;
    const int aoff = lds_byte(wr * 64 + fr, fq * 8), boff = lds_byte(wc * 32 + fr, fq * 8);
#define PG8_SA(b, h) (((b) * 2 + (h)) * HTB)
#define PG8_SB(b, h) ((4 + (b) * 2 + (h)) * HTB)
#define PG8_STAGE(bufoff, gbase, voff) do { _Pragma("unroll") for (int _i = 0; _i < 2; ++_i) \
        __builtin_amdgcn_global_load_lds((const unsigned*)((const char*)(gbase) + (voff)[_i]), (PG8_LAS unsigned*)(lds + (bufoff) + ldsw + _i * 8192), 16, 0, 0); } while (0)
#define PG8_STAGE_A(bufoff, h, kbyte, PAR) do { _Pragma("unroll") for (int _i = 0; _i < 2; ++_i) { \
        const unsigned _ro = *(const PG8_LAS unsigned*)(gt + ((PAR) * 768 + (h) * 128) * 4 + (gpk[_i] & 0xffffu)); \
        __builtin_amdgcn_global_load_lds((const unsigned*)((const char*)g.A + (size_t)(kbyte) + _ro + (gpk[_i] >> 16)), (PG8_LAS unsigned*)(lds + (bufoff) + ldsw + _i * 8192), 16, 0, AUXA); } } while (0)
#define PG8_FILL(u, PAR, PF) do { S.wait_ready(u, tid, PF); if (tid < 256) { unsigned o_, a0_, a1_; S.finish_meta(u, tid, PF, o_, a0_, a1_); PG8_LAS unsigned* t_ = (PG8_LAS unsigned*)(gt + ((PAR) * 768 + tid) * 4); t_[0] = o_; t_[256] = a0_; t_[512] = a1_; } asm volatile("s_waitcnt lgkmcnt(0)" ::: "memory"); __builtin_amdgcn_s_barrier(); asm volatile("" ::: "memory"); } while (0)
#define PG8_LDA(dst, b, h) do { _Pragma("unroll") for (int m = 0; m < 4; ++m) _Pragma("unroll") for (int k = 0; k < 2; ++k) dst[m][k] = *(const PG8_LAS bf16x8*)(lds + PG8_SA(b, h) + aoff + m * 2048 + k * 1024); } while (0)
#define PG8_LDB(dst, b, h) do { _Pragma("unroll") for (int n = 0; n < 2; ++n) _Pragma("unroll") for (int k = 0; k < 2; ++k) dst[n][k] = *(const PG8_LAS bf16x8*)(lds + PG8_SB(b, h) + boff + n * 2048 + k * 1024); } while (0)
#define PG8_MMA(ai, bj, At, Bt) do { __builtin_amdgcn_s_setprio(1); _Pragma("unroll") for (int m = 0; m < 4; ++m) _Pragma("unroll") for (int n = 0; n < 2; ++n) _Pragma("unroll") for (int k = 0; k < 2; ++k) \
        acc[ai][bj][m][n] = __builtin_amdgcn_mfma_f32_16x16x32_bf16(Bt[n][k], At[m][k], acc[ai][bj][m][n], 0, 0, 0); __builtin_amdgcn_s_setprio(0); } while (0)
#define PG8_WAIT_V(n) asm volatile("s_waitcnt vmcnt(" #n ")" ::: "memory")
#define PG8_WAIT_L(n) asm volatile("s_waitcnt lgkmcnt(" #n ")" ::: "memory")
#define PG8_BAR __builtin_amdgcn_s_barrier()
#define PG8_SCHED __builtin_amdgcn_sched_barrier(0)
    Unit cur, nxt; int ui = 0;
    if (!S.next(0, cur)) return;
    f32x4 acc[2][2][4][2];
#pragma unroll
    for (int a = 0; a < 2; ++a)
#pragma unroll
        for (int b = 0; b < 2; ++b)
#pragma unroll
            for (int m = 0; m < 4; ++m)
#pragma unroll
                for (int n = 0; n < 2; ++n) acc[a][b][m][n] = (f32x4){0.f, 0.f, 0.f, 0.f};
    bf16x8 At[4][2], B0[2][2], B1[2][2];
    const char* cB = (const char*)g.Bt + (size_t)cur.pn * tstep;
    typename Sched::Pf pf; S.prefetch(cur, tid, pf); PG8_FILL(cur, 0, pf);
    Unit pend; bool has_pend = false;
    if constexpr (SP2) {
        PG8_STAGE(PG8_SB(0, 0), cB, voffB); PG8_STAGE(PG8_SB(0, 1), cB + hstep, voffB); PG8_STAGE_A(PG8_SA(0, 0), 0, 0, par); PG8_STAGE_A(PG8_SA(0, 1), 1, 0, par);
        if (wr == 1) PG8_BAR;
        PG8_WAIT_V(2); PG8_BAR;
        PG8_STAGE(PG8_SB(1, 0), cB + kstep, voffB); PG8_STAGE_A(PG8_SA(1, 0), 0, kstep, par); PG8_STAGE(PG8_SB(1, 1), cB + hstep + kstep, voffB);
        PG8_WAIT_V(6); PG8_BAR;
    } else {
        PG8_STAGE(PG8_SB(0, 0), cB, voffB); PG8_STAGE_A(PG8_SA(0, 0), 0, 0, par); PG8_STAGE(PG8_SB(0, 1), cB + hstep, voffB); PG8_STAGE_A(PG8_SA(0, 1), 1, 0, par);
        if (wr == 1) PG8_BAR;
        PG8_WAIT_V(4); PG8_BAR;
        PG8_STAGE(PG8_SB(1, 0), cB + kstep, voffB); PG8_STAGE_A(PG8_SA(1, 0), 0, kstep, par); PG8_STAGE(PG8_SB(1, 1), cB + hstep + kstep, voffB);
        PG8_WAIT_V(6); PG8_BAR;
    }
    for (;;) {
        const bool has_next = S.next(ui + 1, nxt);
        if (has_next) S.prefetch(nxt, tid, pf);
        const char* nB = has_next ? (const char*)g.Bt + (size_t)nxt.pn * tstep : cB;
        for (int t = 0; t < nt; t += 2) {
            const bool last = (t == nt - 2);
            const char* b2 = last ? nB : cB + (size_t)(t + 2) * kstep;
            const char* b3 = b2 + kstep;
            if (last && has_next) PG8_FILL(nxt, par ^ 1, pf);
            const size_t kA2 = last ? (size_t)0 : (size_t)(t + 2) * kstep; const int pA2 = (last && has_next) ? (par ^ 1) : par;
            if constexpr (SP2) {
            PG8_LDB(B0, 0, 0); PG8_LDB(B1, 0, 1); PG8_SCHED; PG8_LDA(At, 0, 0); PG8_STAGE_A(PG8_SA(1, 1), 1, (size_t)(t + 1) * kstep, par);
            PG8_WAIT_V(8); PG8_WAIT_L(0); PG8_BAR; PG8_MMA(0, 0, At, B0); PG8_MMA(0, 1, At, B1); PG8_BAR; PG8_SCHED;
            PG8_LDA(At, 0, 1); PG8_STAGE(PG8_SB(0, 0), b2, voffB); PG8_STAGE(PG8_SB(0, 1), b2 + hstep, voffB); PG8_STAGE_A(PG8_SA(0, 0), 0, kA2, pA2);
            PG8_WAIT_V(8); PG8_WAIT_L(0); PG8_BAR; PG8_MMA(1, 0, At, B0); PG8_MMA(1, 1, At, B1); PG8_BAR; PG8_SCHED;
            PG8_LDB(B0, 1, 0); PG8_LDB(B1, 1, 1); PG8_SCHED; PG8_LDA(At, 1, 0); PG8_STAGE_A(PG8_SA(0, 1), 1, kA2, pA2);
            PG8_WAIT_V(8); PG8_WAIT_L(0); PG8_BAR; PG8_MMA(0, 0, At, B0); PG8_MMA(0, 1, At, B1); PG8_BAR; PG8_SCHED;
            PG8_LDA(At, 1, 1); PG8_STAGE(PG8_SB(1, 0), b3, voffB); PG8_STAGE(PG8_SB(1, 1), b3 + hstep, voffB); PG8_STAGE_A(PG8_SA(1, 0), 0, kA2 + kstep, pA2);
            PG8_WAIT_V(8); PG8_WAIT_L(0); PG8_BAR; PG8_MMA(1, 0, At, B0); PG8_MMA(1, 1, At, B1); PG8_BAR; PG8_SCHED;
            } else {
            PG8_LDB(B0, 0, 0); PG8_SCHED; PG8_LDA(At, 0, 0); PG8_STAGE_A(PG8_SA(1, 1), 1, (size_t)(t + 1) * kstep, par);
            PG8_WAIT_L(8); PG8_BAR; PG8_WAIT_L(0); PG8_MMA(0, 0, At, B0); PG8_BAR; PG8_SCHED;
            PG8_LDB(B1, 0, 1); PG8_STAGE(PG8_SB(0, 0), b2, voffB);
            PG8_BAR; PG8_WAIT_L(0); PG8_MMA(0, 1, At, B1); PG8_BAR;
            PG8_LDA(At, 0, 1); PG8_STAGE_A(PG8_SA(0, 0), 0, kA2, pA2);
            PG8_BAR; PG8_WAIT_L(0); PG8_MMA(1, 0, At, B0); PG8_BAR; PG8_SCHED;
            PG8_STAGE(PG8_SB(0, 1), b2 + hstep, voffB);
            PG8_WAIT_V(6); PG8_BAR; PG8_MMA(1, 1, At, B1); PG8_BAR;
            PG8_LDB(B0, 1, 0); PG8_SCHED; PG8_LDA(At, 1, 0); PG8_STAGE_A(PG8_SA(0, 1), 1, kA2, pA2);
            PG8_WAIT_L(8); PG8_BAR; PG8_WAIT_L(0); PG8_MMA(0, 0, At, B0); PG8_BAR; PG8_SCHED;
            PG8_LDB(B1, 1, 1); PG8_STAGE(PG8_SB(1, 0), b3, voffB);
            PG8_BAR; PG8_WAIT_L(0); PG8_MMA(0, 1, At, B1); PG8_BAR;
            PG8_LDA(At, 1, 1); PG8_STAGE_A(PG8_SA(1, 0), 0, kA2 + kstep, pA2);
            PG8_BAR; PG8_WAIT_L(0); PG8_MMA(1, 0, At, B0); PG8_BAR; PG8_SCHED;
            PG8_STAGE(PG8_SB(1, 1), b3 + hstep, voffB);
            PG8_WAIT_V(6); PG8_BAR; PG8_MMA(1, 1, At, B1); PG8_BAR;
            }
        }
        if constexpr (ALIGN_EPI) { if (wr == 0) PG8_BAR; }
        if constexpr (!Epi::AFTER_DRAIN) { if (has_pend) S.done_nowait(pend);     E(acc, cur, wr, wc, fr, fq, (const PG8_LAS unsigned*)(gt + par * 3072)); pend = cur; has_pend = true; }
        if (!has_next) break;
#pragma unroll
        for (int a = 0; a < 2; ++a)
#pragma unroll
            for (int b = 0; b < 2; ++b)
#pragma unroll
                for (int m = 0; m < 4; ++m)
#pragma unroll
                    for (int n = 0; n < 2; ++n) acc[a][b][m][n] = (f32x4){0.f, 0.f, 0.f, 0.f};
        cur = nxt; cB = nB; ++ui; par ^= 1;
        if constexpr (ALIGN_EPI) { if (wr == 1) PG8_BAR; }
    }
    PG8_WAIT_V(0);
    if constexpr (!ALIGN_EPI) { if (wr == 0) PG8_BAR; }
    PG8_BAR;
    if (has_pend) S.done_nowait(pend);
#undef PG8_SA
#undef PG8_SB
#undef PG8_STAGE
#undef PG8_STAGE_A
#undef PG8_FILL
#undef PG8_LDA
#undef PG8_LDB
#undef PG8_MMA
#undef PG8_WAIT_V
#undef PG8_WAIT_L
#undef PG8_BAR
#undef PG8_SCHED
}
}

#ifndef PG8_SP2
#define PG8_SP2 true
#endif
#ifndef PG8_ALIGN
#define PG8_ALIGN true
#endif
#ifndef MK_ONE_LAUNCH
#define MK_ONE_LAUNCH 1
#endif

constexpr int NWAVES = 8, NTHR = 512;
constexpr int BATCH = 8, T = 4096, D = 1024, M = BATCH * T, DEPTH = 2;
constexpr int PROJW = 2304, AW = 256, BW = 512, CW = 256, NH = 8, HD = 64;
constexpr int COL_U = 0, COL_V = 256, COL_Q = 512, COL_K = 1024, COL_VA = 1536, COL_S = 2048;
constexpr int NEXP = 16, DEXP = 512, NGRP = 4;
constexpr int SSM_G = 16, SSM_N = 64, SSM_C = 16;
constexpr float LN_EPS = 1e-5f;
constexpr float ALPHA = 1.41421356237309515f;
constexpr float QSCALE = 0.125f * 1.4426950408889634f;
constexpr int NSLOT_MAX = 2 * M + NEXP * 256;

constexpr size_t MiB = 1u << 20;
constexpr size_t WS_CTL = 0, CTL_ZERO_BYTES = 1 * MiB;
constexpr size_t WS_MOD = 1 * MiB;
constexpr size_t WS_ROPE = WS_MOD + 512 * 1024;
constexpr size_t WS_SSM = WS_ROPE + 2 * MiB;
constexpr int SSM_TAB = 2 * 1024 + 2 * 16384;
constexpr int SLOT_CAP = 32768;
constexpr size_t WS_SLOT_A = 4 * MiB;
constexpr size_t WS_WSMALL = 6 * MiB;
constexpr size_t WSMALL_LAYER = 7 * MiB, WOFF_IN = 0, WOFF_OUT = (size_t)PROJW * D * 2, WOFF_GLU = WOFF_OUT + (size_t)D * D * 2;
constexpr size_t WS_WGU = 20 * MiB;
constexpr size_t WS_WD = 52 * MiB;
constexpr size_t WS_XN = 68 * MiB;
constexpr size_t WS_YG = 132 * MiB;
constexpr size_t WS_R = 148 * MiB;
constexpr size_t WS_PROJ = WS_R, WS_MIXCAT = WS_R + 144 * MiB, WS_PRE = WS_R, WS_HID = WS_R + 64 * MiB, WS_X1 = WS_R + 132 * MiB;
constexpr size_t WS_ROWS2 = 356 * MiB;
constexpr size_t WS_STAT = 356 * MiB + (size_t)2 * M * D * 2;
constexpr size_t WS_SSM2 = WS_STAT + 4 * MiB;
constexpr size_t SSM2_LAYER = 3 * MiB, S2_APW = 0, S2_KT = 288 * 1024, S2_CT = S2_KT + 256 * 1024, S2_WIN = S2_CT + 64 * 1024, S2_GW = S2_WIN + 2 * MiB;
static_assert(S2_GW + 4 * 128 * 128 * 2 <= SSM2_LAYER, "ssm2 tables");
constexpr size_t WS_XLOC = WS_SSM2 + 2 * SSM2_LAYER;
constexpr size_t WS_XSUP = WS_XLOC + 8 * MiB;
constexpr size_t WS_SLOT_W = WS_XSUP + 512 * 1024;
constexpr size_t WS_END = WS_SLOT_W + 2 * MiB;
static_assert(WOFF_GLU + 256 * 256 * 2 <= WSMALL_LAYER && WS_WSMALL + 2 * WSMALL_LAYER <= WS_WGU, "ws map");
static_assert(WS_SSM + 2 * SSM_TAB * 4 <= WS_SLOT_A && WS_HID + (size_t)NSLOT_MAX * DEXP * 2 <= WS_X1 && WS_X1 + (size_t)M * D * 2 <= WS_ROWS2, "ws map 2");
constexpr int CW_TMO = 0;
constexpr int CW_BAR = 4096;
constexpr int CW_CNT = 8192;
constexpr int CW_DONE = 12288;

constexpr int RING_OFF = 0, RING_BYTES = 131072;
constexpr int ATT_STAGE_OFF = 98304;
constexpr int LDSCTL_OFF = 135168, MISC_OFF = LDSCTL_OFF + 320;
constexpr int GT_OFF = LDSCTL_OFF + 1024;
constexpr int LDS_BYTES = 147456;

#define GAS __attribute__((address_space(1)))
#define LAS __attribute__((address_space(3)))
#define DI __device__ __forceinline__
typedef unsigned short bf16;
typedef unsigned v4u __attribute__((ext_vector_type(4)));
typedef unsigned v2u __attribute__((ext_vector_type(2)));
typedef float f32x4 __attribute__((ext_vector_type(4)));
typedef short bf16x8 __attribute__((ext_vector_type(8)));
typedef GAS unsigned gu32;
#define RLX_AGENT __ATOMIC_RELAXED, __HIP_MEMORY_SCOPE_AGENT
#define LDS_WAIT() asm volatile("s_waitcnt lgkmcnt(0)" ::: "memory")
#define VM_WAIT() asm volatile("s_waitcnt vmcnt(0)" ::: "memory")
DI unsigned f2bf(float f) { unsigned u = __builtin_bit_cast(unsigned, f); return (u + 0x7fffu + ((u >> 16) & 1u)) >> 16; }
DI unsigned pk2(float lo, float hi) { return f2bf(lo) | (f2bf(hi) << 16); }
DI float bflo(unsigned w) { return __uint_as_float(w << 16); }
DI float bfhi(unsigned w) { return __uint_as_float(w & 0xffff0000u); }
DI float bf2f(bf16 h) { return __uint_as_float((unsigned)h << 16); }
template <int CTRL> DI float dpp_mov(float v) { return __builtin_bit_cast(float, __builtin_amdgcn_update_dpp(0, __builtin_bit_cast(int, v), CTRL, 0xf, 0xf, true)); }
DI float rdlane(float v, int l) { return __builtin_bit_cast(float, __builtin_amdgcn_readlane(__builtin_bit_cast(int, v), l)); }
DI float wave_sum(float v) {
    v += dpp_mov<0xB1>(v); v += dpp_mov<0x4E>(v); v += dpp_mov<0x141>(v); v += dpp_mov<0x140>(v);
    return (rdlane(v, 0) + rdlane(v, 16)) + (rdlane(v, 32) + rdlane(v, 48));
}
DI void st16_wt(void* p, v4u v) { asm volatile("global_store_dwordx4 %0, %1, off sc1\n\ts_nop 1" :: "v"(p), "v"(v) : "memory"); }
DI float fast_rcp(float x) { return __builtin_amdgcn_rcpf(x); }
DI float sigmoid_f(float x) { return fast_rcp(1.0f + __builtin_amdgcn_exp2f(-1.4426950408889634f * x)); }
DI float silu_f(float x) { return x * sigmoid_f(x); }
DI float gelu_tanh_f(float x) { const float z2 = 1.5957691216057308f * (x + 0.044715f * x * x * x); return x * sigmoid_f(z2); }

#define XB_TMO      128
#define XB_XCNT(j)  (256  + 64 * (j))
#define XB_XSUB(j)  (1280 + 64 * (j))
#define XB_XGEN(j)  (2304 + 64 * (j))
#define XB_TOP      3328
#define XB_TOPGEN   3392
#define XCD_BAR_WORDS 3456
#define XB_SPIN_CAP (1u << 22)
DI unsigned xb_ld(unsigned* p)              { return __hip_atomic_load(p, __ATOMIC_RELAXED, __HIP_MEMORY_SCOPE_AGENT); }
DI unsigned xb_add(unsigned* p, unsigned v) { return __hip_atomic_fetch_add(p, v, __ATOMIC_RELAXED, __HIP_MEMORY_SCOPE_AGENT); }
DI unsigned xb_xcc_id() { return (unsigned)__builtin_amdgcn_s_getreg((3 << 11) | 20) & 0xFu; }
#define XB_SPIN(cond, bar) do { unsigned _sp = 0; while (cond) { __builtin_amdgcn_s_sleep(1); \
    if ((++_sp & 255u) == 0u) { if (xb_ld(&(bar)[XB_TMO])) break; if (_sp > XB_SPIN_CAP) { atomicAdd(&(bar)[XB_TMO], 1u); break; } } } } while (0)
struct XcdBarrier { unsigned* bar; unsigned x; volatile LAS unsigned* st; };
DI XcdBarrier xcd_barrier_post(unsigned* bar, volatile LAS unsigned* st) {
    XcdBarrier b; b.bar = bar; b.x = xb_xcc_id(); b.st = st;
    if (threadIdx.x == 0) (void)xb_add(&bar[XB_XCNT(b.x)], 1u);
    return b;
}
DI void xcd_barrier_complete(unsigned* bar, unsigned x, unsigned& nloc, unsigned& nx) {
    const unsigned G = gridDim.x * gridDim.y * gridDim.z;
    unsigned sum, cnt, mine, sp = 0u;
    for (;;) {
        sum = 0u; cnt = 0u; mine = 0u;
#pragma unroll
        for (unsigned j = 0; j < 16; ++j) { const unsigned c = xb_ld(&bar[XB_XCNT(j)]); sum += c; cnt += (c > 0u) ? 1u : 0u; mine = (j == x) ? c : mine; }
        if (sum == G) break;
        __builtin_amdgcn_s_sleep(1);
        if ((++sp & 255u) == 0u) { if (xb_ld(&bar[XB_TMO])) break; if (sp > XB_SPIN_CAP) { atomicAdd(&bar[XB_TMO], 1u); break; } }
    }
    nloc = mine > 0u ? mine : 1u; nx = cnt > 0u ? cnt : 1u;
}
DI void xcd_barrier(const XcdBarrier& b) {
    asm volatile("s_waitcnt vmcnt(0)" ::: "memory");
    __syncthreads();
    if (threadIdx.x == 0) {
        unsigned* bar = b.bar;
        __builtin_amdgcn_s_waitcnt(0);
        unsigned nloc = b.st[0], nx = b.st[1];
        if (nloc == 0u) { xcd_barrier_complete(bar, b.x, nloc, nx); b.st[0] = nloc; b.st[1] = nx; }
        const unsigned old = xb_add(&bar[XB_XSUB(b.x)], 1u);
        const unsigned gen = old / nloc;
        if (old + 1u == (gen + 1u) * nloc) {
            __builtin_amdgcn_fence(__ATOMIC_RELEASE, "agent");
            asm volatile("s_waitcnt vmcnt(0)" ::: "memory");
            const unsigned og = xb_add(&bar[XB_TOP], 1u);
            const unsigned tg = og / nx;
            if (og + 1u == (tg + 1u) * nx) xb_add(&bar[XB_TOPGEN], 1u);
            else XB_SPIN(xb_ld(&bar[XB_TOPGEN]) == tg, bar);
            __builtin_amdgcn_fence(__ATOMIC_ACQUIRE, "agent");
            xb_add(&bar[XB_XGEN(b.x)], 1u);
            asm volatile("s_waitcnt vmcnt(0)" ::: "memory");
        } else {
            XB_SPIN(xb_ld(&bar[XB_XGEN(b.x)]) == gen, bar);
            __builtin_amdgcn_fence(__ATOMIC_ACQUIRE, "agent");
            asm volatile("s_waitcnt vmcnt(0)" ::: "memory");
        }
    }
    __syncthreads();
}

struct Args { const void* in[30]; float* out; unsigned char* ws; int ph_lo, ph_hi, li, pad; };
enum { I_X = 0, I_C, I_POS, I_ADAW, I_ADAB, I_WIN, I_GMLNG, I_GMLNB, I_GMWS, I_GMBS, I_LAMRE, I_LAMIM, I_LOGDT, I_BRE, I_BIM, I_CRE, I_CIM, I_SSMD,
       I_GLUW, I_GLUB, I_WOUT, I_LN1G, I_LN1B, I_RW, I_RB, I_EWG, I_EWU, I_EWD, I_LN2G, I_LN2B };
struct Frame {
    LAS unsigned char* lds;
    volatile LAS unsigned* MISC;
    gu32* ctl;
    unsigned char* ws;
    int vcu, G;
};
DI int ftid() { int t = threadIdx.x; asm volatile("" : "+v"(t)); return t; }
#define FRAME_IDS const int tid_ = ftid(), lane_ = tid_ & 63, wave_ = __builtin_amdgcn_readfirstlane(tid_ >> 6); (void)lane_; (void)wave_;

template <class RowMap>
DI void transpose_item(const float* W, int K, int N, bf16* WT, const RowMap& rm, LAS float* scr, int item, int lane) {
    const int nblk = N / 32, kb = item / nblk, nb = item % nblk, k0 = 64 * kb, n0 = 32 * nb;
#pragma unroll 8
    for (int i = 0; i < 32; ++i) { const int kk = 2 * i + (lane >> 5); scr[kk * 33 + (lane & 31)] = W[(size_t)(k0 + kk) * N + n0 + (lane & 31)]; }
    LDS_WAIT(); asm volatile("" ::: "memory");
    const int c = lane & 7;
#pragma unroll
    for (int j = 0; j < 4; ++j) { const int n = (lane >> 3) + 8 * j; const LAS float* s = scr + (8 * c) * 33 + n;
        v4u o; o.x = pk2(s[0 * 33], s[1 * 33]); o.y = pk2(s[2 * 33], s[3 * 33]); o.z = pk2(s[4 * 33], s[5 * 33]); o.w = pk2(s[6 * 33], s[7 * 33]);
        *(GAS v4u*)(WT + (size_t)rm(n0 + n) * K + k0 + 8 * c) = o; }
    LDS_WAIT(); asm volatile("" ::: "memory");
}
struct RmIdent { int off; DI int operator()(int n) const { return off + n; } };
struct RmWin { DI int operator()(int n) const {
        if (n >= COL_Q && n < COL_VA) { const int d = n & 63; if (d < 16) return (n - d) + 2 * (d & 7) + (d >> 3); }
        return n; } };
struct RmGU { int e, up; DI int operator()(int n) const { return e * 1024 + (n >> 7) * 256 + (n & 127) + up * 128; } };

DI void p0_tables(Frame& F, const Args& A) {
    FRAME_IDS
    const float* c = (const float*)A.in[I_C];
    LAS float* condS = (LAS float*)(F.lds + RING_OFF);
    LAS float* red = (LAS float*)(F.lds + RING_OFF + 32768);
    for (int i = tid_; i < BATCH * D; i += NTHR) condS[i] = silu_f(c[i]);
    __syncthreads();
    float* mod = (float*)(F.ws + WS_MOD);
    for (int it = F.vcu; it < DEPTH * 96; it += F.G) {
        const int l = it / 96, jb = it % 96, ks = tid_ >> 6, jj = tid_ & 63, j = jb * 64 + jj;
        const float* w = (const float*)A.in[I_ADAW] + (size_t)l * D * 6 * D + j;
        float acc[8];
#pragma unroll
        for (int b = 0; b < 8; ++b) acc[b] = 0.f;
#pragma unroll 16
        for (int k = ks * 128; k < ks * 128 + 128; ++k) { const float wv = w[(size_t)k * (6 * D)];
#pragma unroll
            for (int b = 0; b < 8; ++b) acc[b] += condS[b * D + k] * wv; }
#pragma unroll
        for (int b = 0; b < 8; ++b) red[(ks * 8 + b) * 64 + jj] = acc[b];
        __syncthreads();
        { const int b = tid_ >> 6; float s = ((const float*)A.in[I_ADAB])[l * 6 * D + j];
#pragma unroll
          for (int k2 = 0; k2 < 8; ++k2) s += red[(k2 * 8 + b) * 64 + jj];
          mod[((size_t)l * BATCH + b) * 6 * D + j] = s; }
        __syncthreads();
    }
    const int gt = F.vcu * NTHR + tid_, NGT = F.G * NTHR;
    const int* pos = (const int*)A.in[I_POS]; float* rope = (float*)(F.ws + WS_ROPE);
    for (int w = gt; w < M * 8; w += NGT) { const int m = w >> 3, i = w & 7;
        const float freq = exp2f(-(float)i * 0.125f * 18.931568569324174f);
        const float ang = (float)pos[m] * freq; float s, cs; sincosf(ang, &s, &cs);
        rope[m * 16 + i] = cs; rope[m * 16 + 8 + i] = s; }
    for (int w = gt; w < DEPTH * 16 * 33 * 64; w += NGT) { const int n = w & 63, m = (w >> 6) % 33, g = ((w >> 6) / 33) & 15, l = (w >> 6) / (33 * 16);
        const int li = (l * 16 + g) * 64 + n;
        const float lre = ((const float*)A.in[I_LAMRE])[li], lim = ((const float*)A.in[I_LAMIM])[li], dt = expf(((const float*)A.in[I_LOGDT])[l * 16 + g]);
        const float mag = expf((float)m * (lre * dt)); float sn, cs; sincosf((float)m * (lim * dt), &sn, &cs);
        float* apw = (float*)(F.ws + WS_SSM2 + l * SSM2_LAYER + S2_APW) + ((size_t)(g * 33 + m) * 64 + n) * 2; apw[0] = mag * cs; apw[1] = mag * sn; }
    for (int w = gt; w < DEPTH * SSM_G * SSM_N; w += NGT) { const int l = w / 1024, gn = w % 1024, g = gn >> 6;
        float* tab = (float*)(F.ws + WS_SSM) + (size_t)l * SSM_TAB;
        const float lre = ((const float*)A.in[I_LAMRE])[w], lim = ((const float*)A.in[I_LAMIM])[w];
        const float dt = expf(((const float*)A.in[I_LOGDT])[l * 16 + g]);
        const float mag = expf(lre * dt); float sn, cs; sincosf(lim * dt, &sn, &cs);
        const float are = mag * cs, aim = mag * sn, nr = are - 1.0f, ni = aim, mod2 = lre * lre + lim * lim;
        const float fre = (nr * lre + ni * lim) / mod2, fim = (ni * lre - nr * lim) / mod2;
        tab[gn] = are; tab[1024 + gn] = aim;
        const float* bre = (const float*)A.in[I_BRE] + (size_t)w * 16; const float* bim = (const float*)A.in[I_BIM] + (size_t)w * 16;
#pragma unroll
        for (int cc = 0; cc < 16; ++cc) { tab[2048 + gn * 16 + cc] = fre * bre[cc] - fim * bim[cc]; tab[2048 + 16384 + gn * 16 + cc] = fre * bim[cc] + fim * bre[cc]; } }
}

constexpr int WCONV_SPLIT = 16 * 72 + 16 * 32 + 4 * 8 + 8900;
DI void p_wconv(Frame& F, const Args& A, int l, int part) {
    FRAME_IDS
    if (part == 0) {
        const int gt = F.vcu * NTHR + tid_, NGT = F.G * NTHR;
        const float* tab = (const float*)(F.ws + WS_SSM) + (size_t)l * SSM_TAB;
        const float* apw = (const float*)(F.ws + WS_SSM2 + l * SSM2_LAYER + S2_APW);
        const float* cre = (const float*)A.in[I_CRE] + (size_t)l * 16 * 16 * 64; const float* cim = (const float*)A.in[I_CIM] + (size_t)l * 16 * 16 * 64;
        bf16* KT = (bf16*)(F.ws + WS_SSM2 + l * SSM2_LAYER + S2_KT); bf16* CT = (bf16*)(F.ws + WS_SSM2 + l * SSM2_LAYER + S2_CT);
        bf16* WIN = (bf16*)(F.ws + WS_SSM2 + l * SSM2_LAYER + S2_WIN); bf16* GW = (bf16*)(F.ws + WS_SSM2 + l * SSM2_LAYER + S2_GW);
        for (int w = gt; w < 16 * 16 * 64 * 8; w += NGT) { const int j = w & 7, ln = (w >> 3) & 63, p = (w >> 9) & 15, g = w >> 13;
            const int co = ln & 15, q = ln >> 4, m = 2 * p + (q >> 1), ci = 8 * (q & 1) + j; float acc = 0.f;
            for (int n = 0; n < 64; ++n) { const int gn = g * 64 + n; const float ar = apw[((g * 33 + m) * 64 + n) * 2], ai = apw[((g * 33 + m) * 64 + n) * 2 + 1];
                const float br = tab[2048 + gn * 16 + ci], bi = tab[2048 + 16384 + gn * 16 + ci], tre = ar * br - ai * bi, tim = ar * bi + ai * br;
                acc += cre[(g * 16 + co) * 64 + n] * tre - cim[(g * 16 + co) * 64 + n] * tim; }
            KT[w] = (bf16)f2bf(acc); }
        for (int w = gt; w < 16 * 4 * 64 * 8; w += NGT) { const int j = w & 7, ln = (w >> 3) & 63, sx = (w >> 9) & 3, g = w >> 11;
            const int co = ln & 15, q = ln >> 4, n = 16 * sx + 4 * q + (j >> 1);
            CT[w] = (bf16)f2bf((j & 1) ? -cim[(g * 16 + co) * 64 + n] : cre[(g * 16 + co) * 64 + n]); }
        for (int w = gt; w < 16 * 16 * 8 * 64 * 8; w += NGT) { const int jj = w & 7, ln = (w >> 3) & 63, ct = (w >> 9) & 7, sp = (w >> 12) & 15, g = w >> 16;
            const int cc = ln & 15, q = ln >> 4, n = 8 * ct + (cc >> 1), part = cc & 1, tj = 2 * sp + (q >> 1), ci = 8 * (q & 1) + jj, gn = g * 64 + n, m = 31 - tj;
            const float ar = apw[((g * 33 + m) * 64 + n) * 2], ai = apw[((g * 33 + m) * 64 + n) * 2 + 1], br = tab[2048 + gn * 16 + ci], bi = tab[2048 + 16384 + gn * 16 + ci];
            WIN[w] = (bf16)f2bf(part ? (ar * bi + ai * br) : (ar * br - ai * bi)); }
        const float* gws = (const float*)A.in[I_GMWS] + (size_t)l * 4 * 128 * 128;
        for (int w = gt; w < 4 * 128 * 128; w += NGT) { const int sx = w & 127, t = (w >> 7) & 127; GW[w] = (bf16)f2bf(sx <= t ? gws[w] : 0.f); }
    }
    LAS float* scr = (LAS float*)(F.lds + RING_OFF + wave_ * 16384);
    const int gw = (part == 0) ? F.vcu * NWAVES + wave_ : WCONV_SPLIT + ((int)blockIdx.x - 128) * NWAVES + wave_, NGW = (part == 0) ? F.G * NWAVES : 128 * NWAVES;
    bf16* WinT = (bf16*)(F.ws + WS_WSMALL + l * WSMALL_LAYER + WOFF_IN);
    bf16* WoutT = (bf16*)(F.ws + WS_WSMALL + l * WSMALL_LAYER + WOFF_OUT);
    bf16* GluT = (bf16*)(F.ws + WS_WSMALL + l * WSMALL_LAYER + WOFF_GLU);
    bf16* WguT = (bf16*)(F.ws + WS_WGU); bf16* WdT = (bf16*)(F.ws + WS_WD);
    constexpr int I_IN = 16 * 72, I_OUTW = 16 * 32, I_GLU = 4 * 8, I_G = 16 * 16, I_DN = 8 * 32;
    constexpr int NIT = I_IN + I_OUTW + I_GLU + 16 * (2 * I_G + I_DN);
    const int split = (F.G == 256) ? WCONV_SPLIT : NIT;
    for (int it = gw; it < ((part == 0) ? split : NIT); it += NGW) {
        int r = it;
        if (r < I_IN) { transpose_item((const float*)A.in[I_WIN] + (size_t)l * D * PROJW, D, PROJW, WinT, RmWin{}, scr, r, lane_); continue; } r -= I_IN;
        if (r < I_OUTW) { transpose_item((const float*)A.in[I_WOUT] + (size_t)l * D * D, D, D, WoutT, RmIdent{0}, scr, r, lane_); continue; } r -= I_OUTW;
        if (r < I_GLU) { transpose_item((const float*)A.in[I_GLUW] + (size_t)l * 256 * 256, 256, 256, GluT, RmIdent{0}, scr, r, lane_); continue; } r -= I_GLU;
        const int e = r / (2 * I_G + I_DN); r -= e * (2 * I_G + I_DN);
        const size_t eo = ((size_t)l * NEXP + e) * D * DEXP;
        if (r < I_G) { transpose_item((const float*)A.in[I_EWG] + eo, D, DEXP, WguT, RmGU{e, 0}, scr, r, lane_); continue; } r -= I_G;
        if (r < I_G) { transpose_item((const float*)A.in[I_EWU] + eo, D, DEXP, WguT, RmGU{e, 1}, scr, r, lane_); continue; } r -= I_G;
        transpose_item((const float*)A.in[I_EWD] + eo, DEXP, D, WdT, RmIdent{e * 1024}, scr, r, lane_);
    }
}

typedef float f32x2_t __attribute__((ext_vector_type(2)));
typedef __bf16 bf16x2_t __attribute__((ext_vector_type(2)));
DI unsigned cvtpk(float lo, float hi) { f32x2_t v = {lo, hi}; bf16x2_t b = __builtin_convertvector(v, bf16x2_t); return __builtin_bit_cast(unsigned, b); }
struct Row16 { float v[16]; };
DI void row_load_f32(Row16& r, const float* p, int lane) {
    const f32x4* q = (const f32x4*)p;
#pragma unroll
    for (int k = 0; k < 4; ++k) { const f32x4 a = q[k * 64 + lane]; r.v[4 * k] = a.x; r.v[4 * k + 1] = a.y; r.v[4 * k + 2] = a.z; r.v[4 * k + 3] = a.w; }
}
DI void row_load_bf16(Row16& r, const bf16* p, int lane) {
    const v2u* q = (const v2u*)p;
#pragma unroll
    for (int k = 0; k < 4; ++k) { const v2u a = q[k * 64 + lane]; r.v[4 * k] = bflo(a.x); r.v[4 * k + 1] = bfhi(a.x); r.v[4 * k + 2] = bflo(a.y); r.v[4 * k + 3] = bfhi(a.y); }
}
DI void row_store_bf16(const Row16& r, bf16* p, int lane) {
    v2u* q = (v2u*)p;
#pragma unroll
    for (int k = 0; k < 4; ++k) { v2u o; o.x = cvtpk(r.v[4 * k], r.v[4 * k + 1]); o.y = cvtpk(r.v[4 * k + 2], r.v[4 * k + 3]); q[k * 64 + lane] = o; }
}
DI void row_store_f32(const Row16& r, float* p, int lane) {
    f32x4* q = (f32x4*)p;
#pragma unroll
    for (int k = 0; k < 4; ++k) q[k * 64 + lane] = (f32x4){r.v[4 * k], r.v[4 * k + 1], r.v[4 * k + 2], r.v[4 * k + 3]};
}
DI void row_ln(Row16& r) {
    float s = 0.f;
#pragma unroll
    for (int i = 0; i < 16; ++i) s += r.v[i];
    const float mean = wave_sum(s) * (1.f / D); float s2 = 0.f;
#pragma unroll
    for (int i = 0; i < 16; ++i) { r.v[i] -= mean; s2 += r.v[i] * r.v[i]; }
    const float rstd = 1.0f / sqrtf(wave_sum(s2) * (1.f / D) + LN_EPS);
#pragma unroll
    for (int i = 0; i < 16; ++i) r.v[i] *= rstd;
}
DI void row_mod(Row16& r, const float* a, const float* b, int lane) {
    Row16 av, bv; row_load_f32(av, a, lane); row_load_f32(bv, b, lane);
#pragma unroll
    for (int i = 0; i < 16; ++i) r.v[i] = r.v[i] * (1.0f + av.v[i]) + bv.v[i];
}
DI void row_affine(Row16& r, const float* g, const float* b, int lane) {
    Row16 av, bv; row_load_f32(av, g, lane); row_load_f32(bv, b, lane);
#pragma unroll
    for (int i = 0; i < 16; ++i) r.v[i] = r.v[i] * av.v[i] + bv.v[i];
}

DI void p_ln_a0(Frame& F, const Args& A) {
    FRAME_IDS
    const int gw = F.vcu * NWAVES + wave_, NGW = F.G * NWAVES;
    const float* x = (const float*)A.in[I_X]; bf16* XN = (bf16*)(F.ws + WS_XN); const float* mod = (const float*)(F.ws + WS_MOD);
    for (int m = gw; m < M; m += NGW) { const int b = m / T; const float* md = mod + (size_t)b * 6 * D;
        Row16 r; row_load_f32(r, x + (size_t)m * D, lane_); row_ln(r); row_mod(r, md + 1 * D, md + 0 * D, lane_); row_store_bf16(r, XN + (size_t)m * D, lane_); }
}

using pg8::Unit; using pg8::BM; using pg8::HALF;
struct EpiInProj {
    static constexpr bool PERM = true, AFTER_DRAIN = false;
    bf16* P; const float* rope; int skip;
    DI void operator()(const pg8::f32x4 (&acc)[2][2][4][2], const Unit& u, int wr, int wc, int fr, int fq) const {
        if (skip == 1) { if (acc[0][0][0][0][0] == 12345.678f) P[0] = 1; return; }
        const int row0 = u.pm * BM + wr * 64 + fr, pn = u.pn;
        const bool isrope = (pn >= 2 && pn <= 5), dorope = isrope && ((wc & 1) == 0) && (fq < 2);
        const float sc = (pn == 2 || pn == 3) ? QSCALE : 1.0f;
#pragma unroll
        for (int ai = 0; ai < 2; ++ai)
#pragma unroll
            for (int m = 0; m < 4; ++m) { const int row = row0 + ai * HALF + m * 16; bf16* rowp = P + (size_t)row * PROJW + pn * BM + wc * 32 + 8 * fq;
                f32x4 cs = (f32x4){1.f, 1.f, 1.f, 1.f}, sn = (f32x4){0.f, 0.f, 0.f, 0.f};
                if (isrope) { const float* rp = rope + (size_t)row * 16 + 4 * (fq & 1); cs = *(const f32x4*)rp; sn = *(const f32x4*)(rp + 8); }
#pragma unroll
                for (int bj = 0; bj < 2; ++bj) { pg8::f32x4 v0 = acc[ai][bj][m][0], v1 = acc[ai][bj][m][1];
                    if (pn < 2) {
#pragma unroll
                        for (int i = 0; i < 4; ++i) { v0[i] = gelu_tanh_f(v0[i]); v1[i] = gelu_tanh_f(v1[i]); }
                    } else if (isrope) {
                        if (dorope) { const float a0 = v0[0] * cs.x - v0[1] * sn.x, b0 = v0[1] * cs.x + v0[0] * sn.x, a1 = v0[2] * cs.y - v0[3] * sn.y, b1 = v0[3] * cs.y + v0[2] * sn.y;
                            const float a2 = v1[0] * cs.z - v1[1] * sn.z, b2 = v1[1] * cs.z + v1[0] * sn.z, a3 = v1[2] * cs.w - v1[3] * sn.w, b3 = v1[3] * cs.w + v1[2] * sn.w;
                            v0 = (pg8::f32x4){a0, b0, a1, b1}; v1 = (pg8::f32x4){a2, b2, a3, b3}; }
                        v0 = v0 * sc; v1 = v1 * sc;
                    }
                    pg8::u32x4 w; w.x = pg8::cvt_pk_bf16(v0[0], v0[1]); w.y = pg8::cvt_pk_bf16(v0[2], v0[3]); w.z = pg8::cvt_pk_bf16(v1[0], v1[1]); w.w = pg8::cvt_pk_bf16(v1[2], v1[3]);
                    if (skip == 2) { asm volatile("" :: "v"(w.x), "v"(w.y), "v"(w.z), "v"(w.w)); } else *(pg8::u32x4*)(rowp + bj * HALF) = w; } }
    }
};
template <bool XF32> struct EpiOut {
    static constexpr bool PERM = true, AFTER_DRAIN = false;
    bf16* PRE; const void* x; int xpitch; const float* mod;
    DI void operator()(const pg8::f32x4 (&acc)[2][2][4][2], const Unit& u, int wr, int wc, int fr, int fq) const {
        const int row0 = u.pm * BM + wr * 64 + fr, b = (u.pm * BM) / T, colb = u.pn * BM + wc * 32 + 8 * fq;
        const float* g1 = mod + (size_t)b * 6 * D + 2 * D;
        pg8::f32x4 gv[2][2];
#pragma unroll
        for (int bj = 0; bj < 2; ++bj) { gv[bj][0] = *(const pg8::f32x4*)(g1 + colb + bj * HALF) + 1.0f; gv[bj][1] = *(const pg8::f32x4*)(g1 + colb + bj * HALF + 4) + 1.0f; }
#pragma unroll
        for (int ai = 0; ai < 2; ++ai)
#pragma unroll
            for (int m = 0; m < 4; ++m) { const int row = row0 + ai * HALF + m * 16;
#pragma unroll
                for (int bj = 0; bj < 2; ++bj) { const int col = colb + bj * HALF; pg8::f32x4 x0, x1;
                    if (XF32) { const float* xp = (const float*)x + (size_t)row * xpitch + col; x0 = *(const pg8::f32x4*)xp; x1 = *(const pg8::f32x4*)(xp + 4); }
                    else { const pg8::u32x4 xw = *(const pg8::u32x4*)((const bf16*)x + (size_t)row * xpitch + col);
                        x0 = (pg8::f32x4){bflo(xw.x), bfhi(xw.x), bflo(xw.y), bfhi(xw.y)}; x1 = (pg8::f32x4){bflo(xw.z), bfhi(xw.z), bflo(xw.w), bfhi(xw.w)}; }
                    const pg8::f32x4 v0 = x0 * ALPHA + gv[bj][0] * acc[ai][bj][m][0], v1 = x1 * ALPHA + gv[bj][1] * acc[ai][bj][m][1];
                    pg8::u32x4 w; w.x = pg8::cvt_pk_bf16(v0[0], v0[1]); w.y = pg8::cvt_pk_bf16(v0[2], v0[3]); w.z = pg8::cvt_pk_bf16(v1[0], v1[1]); w.w = pg8::cvt_pk_bf16(v1[2], v1[3]);
                    *(pg8::u32x4*)(PRE + (size_t)row * D + col) = w; } }
    }
};
struct OutOrder : pg8::StaticOrder {
    const char* xbase; unsigned rowbytes, tilecolbytes; LAS unsigned char* dump;
    DI void a_ready(const Unit& u) const {
        const int tid = threadIdx.x, wid = __builtin_amdgcn_readfirstlane(tid >> 6), lane = tid & 63;
        const int lpr = (int)(tilecolbytes >> 7);
        const char* t0 = xbase + (size_t)u.pm * 256 * rowbytes + (size_t)u.pn * tilecolbytes;
        const int nline = 256 * lpr;
        for (int i = wid * 64 + lane; i < nline; i += 512) { const int r = i / lpr, c = i % lpr;
            __builtin_amdgcn_global_load_lds((const unsigned*)(t0 + (size_t)r * rowbytes + (size_t)c * 128), (LAS unsigned*)(dump + wid * 256), 4, 0, 0); }
    }
};
struct EpiGlu {
    static constexpr bool PERM = true, AFTER_DRAIN = false;
    const bf16* YG; bf16* MIX; const float* gb;
    DI void operator()(const pg8::f32x4 (&acc)[2][2][4][2], const Unit& u, int wr, int wc, int fr, int fq) const {
        const int row0 = u.pm * BM + wr * 64 + fr, colb = wc * 32 + 8 * fq;
#pragma unroll
        for (int ai = 0; ai < 2; ++ai)
#pragma unroll
            for (int m = 0; m < 4; ++m) { const int row = row0 + ai * HALF + m * 16;
#pragma unroll
                for (int bj = 0; bj < 2; ++bj) { const int col = colb + bj * HALF;
                    const pg8::u32x4 yw = *(const pg8::u32x4*)(YG + (size_t)row * 256 + col);
                    const pg8::f32x4 b0 = *(const pg8::f32x4*)(gb + col), b1 = *(const pg8::f32x4*)(gb + col + 4);
                    const pg8::f32x4 a0 = acc[ai][bj][m][0] + b0, a1 = acc[ai][bj][m][1] + b1;
                    const float y[8] = {bflo(yw.x), bfhi(yw.x), bflo(yw.y), bfhi(yw.y), bflo(yw.z), bfhi(yw.z), bflo(yw.w), bfhi(yw.w)};
                    float o[8];
#pragma unroll
                    for (int i = 0; i < 4; ++i) { o[i] = y[i] * sigmoid_f(a0[i]); o[4 + i] = y[4 + i] * sigmoid_f(a1[i]); }
                    pg8::u32x4 w; w.x = pg8::cvt_pk_bf16(o[0], o[1]); w.y = pg8::cvt_pk_bf16(o[2], o[3]); w.z = pg8::cvt_pk_bf16(o[4], o[5]); w.w = pg8::cvt_pk_bf16(o[6], o[7]);
                    *(pg8::u32x4*)(MIX + (size_t)row * D + 768 + col) = w; asm volatile("" ::: "memory"); } }
    }
};
template <int KIND> struct MoeOrderK {
    const volatile LAS int* ts; int G, c; const int* slot_a; const float* slot_w; gu32* done_cnt;
    DI bool next(int i, Unit& u) const {
        const int nwg = ts[16] * 4; const int rot = (KIND == 1) ? (((nwg % G) + 7) & ~7) : 0; const int cc = (c - rot + G) % G;
        const long L = (long)i * G + cc; if (L >= nwg) return false;
        int wgid = (int)L; { const int q = nwg / 8, r = nwg % 8, xcd = wgid % 8, off = wgid / 8; wgid = (xcd < r ? xcd * (q + 1) : r * (q + 1) + (xcd - r) * q) + off; }
        const int tm = wgid >> 2, j = wgid & 3; int e = 0;
#pragma unroll
        for (int k = 1; k < 16; ++k) e += (ts[k] <= tm) ? 1 : 0;
        u.pm = tm; u.pn = e * 4 + j; return true;
    }
    struct Pf { unsigned a, w, c; };
    DI void prefetch(const Unit& u, int r, Pf& pf) const {
        const int e = u.pn >> 2, idx = (u.pm - ts[e]) * 256 + (r & 255); const bool valid = idx < ts[32 + e];
        pf.a = 0xffffffffu; pf.w = 0u; pf.c = 32u;
        if (valid && r < 256) { pf.a = (unsigned)slot_a[(size_t)e * SLOT_CAP + idx]; if (KIND == 1) pf.w = __float_as_uint(slot_w[(size_t)e * SLOT_CAP + idx]); }
        if (KIND == 1 && r < 64) pf.c = __hip_atomic_load(done_cnt + u.pm, RLX_AGENT);
    }
    DI void finish_meta(const Unit& u, int r, const Pf& pf, unsigned& off, unsigned& a0, unsigned& a1) const {
        if (KIND == 0) { off = (pf.a == 0xffffffffu ? 0u : (pf.a >> 1)) * (unsigned)(D * 2); a0 = 0u; a1 = 0u; }
        else { off = (unsigned)(u.pm * 256 + r) * (unsigned)(DEXP * 2); a0 = pf.a; a1 = pf.w; }
    }
    DI void wait_ready(const Unit& u, int tid, const Pf& pf) const {
        if (KIND == 1 && tid < 64) { unsigned sp = 0;
            if ((unsigned)__builtin_amdgcn_readfirstlane((int)pf.c) < 32u)
                while ((unsigned)__builtin_amdgcn_readfirstlane((int)__hip_atomic_load(done_cnt + u.pm, RLX_AGENT)) < 32u) { __builtin_amdgcn_s_sleep(2); if (++sp > (1u << 20)) break; } }
    }
    DI void a_ready(const Unit&) const {}
    DI void done_nowait(const Unit& u) const { if (KIND == 0 && (threadIdx.x & 63) == 0) __hip_atomic_fetch_add(done_cnt + u.pm, 1u, RLX_AGENT); }
};
struct EpiG1 {
    static constexpr bool PERM = true, AFTER_DRAIN = false;
    bf16* HID;
    DI void operator()(const pg8::f32x4 (&acc)[2][2][4][2], const Unit& u, int wr, int wc, int fr, int fq, const LAS unsigned*) const {
        const __amdgpu_buffer_rsrc_t rs = __builtin_amdgcn_make_buffer_rsrc((void*)HID, 0, (int)((size_t)NSLOT_MAX * DEXP * 2), 0x00020000);
        const int row0 = u.pm * BM + wr * 64 + fr, col = (u.pn & 3) * 128 + wc * 32 + 8 * fq;
#pragma unroll
        for (int ai = 0; ai < 2; ++ai)
#pragma unroll
            for (int m = 0; m < 4; ++m) { const int row = row0 + ai * HALF + m * 16; float o[8];
#pragma unroll
                for (int i = 0; i < 4; ++i) { o[i] = silu_f(acc[ai][0][m][0][i]) * acc[ai][1][m][0][i]; o[4 + i] = silu_f(acc[ai][0][m][1][i]) * acc[ai][1][m][1][i]; }
                pg8::u32x4 w; w.x = pg8::cvt_pk_bf16(o[0], o[1]); w.y = pg8::cvt_pk_bf16(o[2], o[3]); w.z = pg8::cvt_pk_bf16(o[4], o[5]); w.w = pg8::cvt_pk_bf16(o[6], o[7]);
                __builtin_amdgcn_raw_buffer_store_b128(w, rs, (row * DEXP + col) * 2, 0, 16); }
    }
};
struct EpiG2 {
    static constexpr bool PERM = true, AFTER_DRAIN = false;
    bf16* ROWS;
    DI void operator()(const pg8::f32x4 (&acc)[2][2][4][2], const Unit& u, int wr, int wc, int fr, int fq, const LAS unsigned* meta) const {
        const int r0 = wr * 64 + fr, colb = (u.pn & 3) * BM + wc * 32 + 8 * fq;
#pragma unroll
        for (int ai = 0; ai < 2; ++ai)
#pragma unroll
            for (int m = 0; m < 4; ++m) { const int r = r0 + ai * HALF + m * 16; const int d = (int)meta[256 + r]; const float wt = __uint_as_float(meta[512 + r]);
                if (d >= 0) {
#pragma unroll
                    for (int bj = 0; bj < 2; ++bj) { const pg8::f32x4 v0 = acc[ai][bj][m][0] * wt, v1 = acc[ai][bj][m][1] * wt;
                        pg8::u32x4 w; w.x = pg8::cvt_pk_bf16(v0[0], v0[1]); w.y = pg8::cvt_pk_bf16(v0[2], v0[3]); w.z = pg8::cvt_pk_bf16(v1[0], v1[1]); w.w = pg8::cvt_pk_bf16(v1[2], v1[3]);
                        *(pg8::u32x4*)(ROWS + (size_t)d * D + colb + bj * HALF) = w; } } }
    }
};

DI void mix_gating_simple(Frame& F, const Args& A, int l) {
    FRAME_IDS
    const bf16* P = (const bf16*)(F.ws + WS_PROJ); bf16* MIX = (bf16*)(F.ws + WS_MIXCAT);
    const float* lng = (const float*)A.in[I_GMLNG] + l * AW; const float* lnb = (const float*)A.in[I_GMLNB] + l * AW;
    const float* ws_ = (const float*)A.in[I_GMWS] + (size_t)l * 4 * 128 * 128; const float* bs_ = (const float*)A.in[I_GMBS] + l * 4 * 128;
    LAS float* vln = (LAS float*)(F.lds + RING_OFF);
    for (int it = F.vcu; it < BATCH * (T / 128); it += F.G) {
        const int m0 = it * 128;
        for (int r = wave_; r < 128; r += NWAVES) {
            const v2u w = *(const v2u*)(P + (size_t)(m0 + r) * PROJW + COL_V + 4 * lane_);
            float v[4] = {bflo(w.x), bfhi(w.x), bflo(w.y), bfhi(w.y)};
            const float mean = wave_sum(v[0] + v[1] + v[2] + v[3]) * (1.f / 256.f);
            float s2 = 0.f;
#pragma unroll
            for (int i = 0; i < 4; ++i) { v[i] -= mean; s2 += v[i] * v[i]; }
            const float rstd = 1.0f / sqrtf(wave_sum(s2) * (1.f / 256.f) + LN_EPS);
#pragma unroll
            for (int i = 0; i < 4; ++i) vln[r * 256 + 4 * lane_ + i] = v[i] * rstd * lng[4 * lane_ + i] + lnb[4 * lane_ + i];
        }
        __syncthreads();
        { const int c = tid_ & 255, tp = tid_ >> 8, h = c >> 6;
          for (int t = tp; t < 128; t += 2) { const float* wrow = ws_ + ((size_t)h * 128 + t) * 128; float acc = 0.f;
              for (int s = 0; s <= t; ++s) acc += wrow[s] * vln[s * 256 + c];
              const float uu = bf2f(P[(size_t)(m0 + t) * PROJW + COL_U + c]);
              MIX[(size_t)(m0 + t) * D + c] = (bf16)f2bf(uu * (acc + bs_[h * 128 + t])); } }
        __syncthreads();
    }
}
DI void mix_attn_simple(Frame& F, int l) {
    FRAME_IDS
    const bf16* P = (const bf16*)(F.ws + WS_PROJ); bf16* MIX = (bf16*)(F.ws + WS_MIXCAT);
    const int gw = F.vcu * NWAVES + wave_, NGW = F.G * NWAVES;
    for (int it = gw; it < M * NH; it += NGW) {
        const int m = it >> 3, h = it & 7, t = m & (T - 1);
        const float q = bf2f(P[(size_t)m * PROJW + COL_Q + h * 64 + lane_]);
        float mx = -1e30f, den = 0.f, o = 0.f;
#pragma unroll 1
        for (int g = 0; g < 3; ++g) { const int dl = (g == 0) ? 1 : (g == 1 ? 4 : 16);
            int nk = t / dl; if (nk > 128) nk = 128;
#pragma unroll 2
            for (int j = 0; j <= nk; ++j) { const size_t mk = (size_t)(m - j * dl);
                const float kv = bf2f(P[mk * PROJW + COL_K + h * 64 + lane_]); const float vv = bf2f(P[mk * PROJW + COL_VA + h * 64 + lane_]);
                const float s = wave_sum(q * kv);
                const float mn = fmaxf(mx, s), f = __builtin_amdgcn_exp2f(mx - mn), p = __builtin_amdgcn_exp2f(s - mn);
                den = den * f + p; o = o * f + p * vv; mx = mn; } }
        MIX[(size_t)m * D + AW + h * 64 + lane_] = (bf16)f2bf(o / den);
    }
}

typedef float f32x16 __attribute__((ext_vector_type(16)));
typedef short v4i16_t __attribute__((ext_vector_type(4)));
DI int crow16(int r, int hi) { return (r & 3) + 8 * (r >> 2) + 4 * hi; }
template <int SUB> DI void mix_attn_mfma(Frame& F, int l) {
    FRAME_IDS
    const bf16* P = (const bf16*)(F.ws + WS_PROJ);
    LAS unsigned char* Ks = F.lds + RING_OFF; LAS unsigned char* Vs = Ks + 49152;
    LAS unsigned char* St = F.lds + ATT_STAGE_OFF + wave_ * 4608;
    const int ql = lane_ & 31, hi = lane_ >> 5, prow = lane_ >> 3, pch = lane_ & 7;
    constexpr int nitems = SUB == 0 ? 2048 : 1024;
    v4u kreg[6], vreg[6], qraw[4]; bf16x8 qf[4];
    int it = F.vcu; if (it >= nitems) return;
    int d, r, s0, b, h; size_t tokbase;
#define ATT_DECODE(IT) do { const int idx_ = (IT) & 1023; b = idx_ >> 7; h = (idx_ >> 4) & 7; int tile_; \
        if (SUB == 1) { d = 1; r = 0; tile_ = idx_ & 15; } else if ((IT) < 1024) { d = 16; r = idx_ & 15; tile_ = 0; } else { d = 4; r = (idx_ >> 2) & 3; tile_ = idx_ & 3; } \
        s0 = tile_ * 256; tokbase = (size_t)b * T + r; } while (0)
#define ATT_LOAD() do { const int tl_ = ftid(); _Pragma("unroll") for (int i = 0; i < 6; ++i) { const int idx2 = tl_ + 512 * i, row = idx2 >> 3, ch = idx2 & 7, step = s0 - 128 + row; \
            if (step >= 0) { const bf16* src = P + (tokbase + (size_t)step * d) * PROJW + h * 64 + ch * 8; kreg[i] = *(const v4u*)(src + COL_K); vreg[i] = *(const v4u*)(src + COL_VA); } \
            else { kreg[i] = (v4u){0u, 0u, 0u, 0u}; vreg[i] = (v4u){0u, 0u, 0u, 0u}; } } \
        _Pragma("unroll") for (int p = 0; p < 4; ++p) qraw[p] = *(const v4u*)(P + (tokbase + (size_t)(s0 + 32 * wave_ + 8 * p + prow) * d) * PROJW + COL_Q + h * 64 + pch * 8); } while (0)
#define ATT_WRITE() do { const int tw_ = ftid(); _Pragma("unroll") for (int i = 0; i < 6; ++i) { const int idx2 = tw_ + 512 * i, row = idx2 >> 3, ch = idx2 & 7; \
            *(LAS v4u*)(Ks + row * 128 + ((ch ^ ((row >> 1) & 7)) << 4)) = kreg[i]; \
            *(LAS v4u*)(Vs + row * 128 + ((ch ^ (((row >> 1) & 1) << 2)) << 4)) = vreg[i]; } \
        _Pragma("unroll") for (int p = 0; p < 4; ++p) *(LAS v4u*)(St + (8 * p + prow) * 144 + pch * 16) = qraw[p]; } while (0)
    ATT_DECODE(it); ATT_LOAD(); ATT_WRITE();
    __syncthreads();
    for (;;) {
        const size_t tb = tokbase; const int s0c = s0, dc = d, hcur = h, itcur = it;
        const bool first = (s0 == 0);
#pragma unroll
        for (int ks = 0; ks < 4; ++ks) qf[ks] = *(const LAS bf16x8*)(St + ql * 144 + (2 * ks + hi) * 16);
        const int itn = it + F.G; const bool has_next = itn < nitems;
        if (has_next) { ATT_DECODE(itn); ATT_LOAD(); }
        const int i0 = 32 * wave_;
        f32x16 S[5];
#pragma unroll
        for (int kb = 0; kb < 5; ++kb) { f32x16 acc;
#pragma unroll
            for (int i = 0; i < 16; ++i) acc[i] = 0.f;
            const int krow = i0 + 32 * kb + ql;
#pragma unroll
            for (int ks = 0; ks < 4; ++ks) { const bf16x8 a = *(const LAS bf16x8*)(Ks + krow * 128 + (((2 * ks + hi) ^ ((krow >> 1) & 7)) << 4)); acc = __builtin_amdgcn_mfma_f32_32x32x16_bf16(a, qf[ks], acc, 0, 0, 0); }
            S[kb] = acc; }
        int qrel = ql - 4 * hi; asm volatile("" : "+v"(qrel));
        float mx = -1e30f;
#pragma unroll
        for (int kb = 0; kb < 5; ++kb) {
            const bool bvalid = !first || (wave_ + kb >= 4);
            if (!bvalid) {
#pragma unroll
                for (int i = 0; i < 16; ++i) S[kb][i] = -1e30f;
            } else {
#pragma unroll
                for (int i = 0; i < 16; ++i) { const int c0 = crow16(i, 0); float v = S[kb][i];
                    if (kb == 0) v = (c0 >= qrel) ? v : -1e30f;
                    if (kb == 4) v = (c0 <= qrel) ? v : -1e30f;
                    S[kb][i] = v; mx = fmaxf(mx, v); }
            }
        }
        mx = fmaxf(mx, __shfl_xor(mx, 32));
        float lsum = 0.f;
#pragma unroll
        for (int kb = 0; kb < 5; ++kb)
#pragma unroll
            for (int i = 0; i < 16; ++i) { const float p = __builtin_amdgcn_exp2f(S[kb][i] - mx); S[kb][i] = p; lsum += p; }
        lsum += __shfl_xor(lsum, 32);
        v4u x16[4], x4[4]; f32x2_t s16 = {0.f, 0.f}, s4 = {0.f, 0.f};
        if (SUB == 1) {
            const size_t qt = tb + (size_t)(s0c + i0 + ql) * dc;
            s16 = *(const f32x2_t*)((const float*)(F.ws + WS_STAT) + (qt * NH + hcur) * 2); s4 = *(const f32x2_t*)((const float*)(F.ws + WS_STAT) + (size_t)M * NH * 2 + (qt * NH + hcur) * 2);
        }
        f32x16 O[2];
#pragma unroll
        for (int i = 0; i < 16; ++i) { O[0][i] = 0.f; O[1][i] = 0.f; }
        const int trq = (lane_ & 15) >> 2, trg = (lane_ >> 4) & 1, trp = lane_ & 3;
#pragma unroll
        for (int kb = 0; kb < 5; ++kb)
#pragma unroll
            for (int s = 0; s < 2; ++s) {
                if (SUB == 1 && kb == 2 && s == 0) {
#pragma unroll
                    for (int p = 0; p < 4; ++p) { const size_t rt = tb + (size_t)(s0c + i0 + 8 * p + prow) * dc; const bf16* pp = (const bf16*)(F.ws + WS_XN) + rt * BW + hcur * 64 + pch * 8;
                        x16[p] = *(const v4u*)pp; x4[p] = *(const v4u*)(pp + (size_t)M * BW); } }
                v4u pw; pw.x = cvtpk(S[kb][8 * s], S[kb][8 * s + 1]); pw.y = cvtpk(S[kb][8 * s + 2], S[kb][8 * s + 3]); pw.z = cvtpk(S[kb][8 * s + 4], S[kb][8 * s + 5]); pw.w = cvtpk(S[kb][8 * s + 6], S[kb][8 * s + 7]);
                const bf16x8 pb = __builtin_bit_cast(bf16x8, pw);
                const int rlo = i0 + 32 * kb + 16 * s + 4 * hi + trq, rhi = rlo + 8;
#pragma unroll
                for (int dh = 0; dh < 2; ++dh) { const int chunk = 4 * dh + 2 * trg + (trp >> 1);
                    const v4i16_t lo = __builtin_amdgcn_ds_read_tr16_b64_v4i16((LAS v4i16_t*)(Vs + rlo * 128 + ((chunk ^ (((rlo >> 1) & 1) << 2)) << 4) + 8 * (trp & 1)));
                    const v4i16_t hh = __builtin_amdgcn_ds_read_tr16_b64_v4i16((LAS v4i16_t*)(Vs + rhi * 128 + ((chunk ^ (((rhi >> 1) & 1) << 2)) << 4) + 8 * (trp & 1)));
                    const bf16x8 va = (bf16x8){lo[0], lo[1], lo[2], lo[3], hh[0], hh[1], hh[2], hh[3]};
                    O[dh] = __builtin_amdgcn_mfma_f32_32x32x16_bf16(va, pb, O[dh], 0, 0, 0); } }
        float osc;
        if (SUB == 0) osc = 1.0f / lsum;
        else { const float MM = fmaxf(mx, fmaxf(s16.x, s4.x)), a1 = __builtin_amdgcn_exp2f(mx - MM), a16 = s16.y * __builtin_amdgcn_exp2f(s16.x - MM), a4 = s4.y * __builtin_amdgcn_exp2f(s4.x - MM);
            const float inv = 1.0f / (lsum * a1 + a16 + a4); osc = a1 * inv;
            if (hi == 0) { f32x2_t cc = {a16 * inv, a4 * inv}; *(LAS f32x2_t*)(St + ql * 144 + 128) = cc; } }
#pragma unroll
        for (int dh = 0; dh < 2; ++dh)
#pragma unroll
            for (int g4 = 0; g4 < 4; ++g4) { v2u w; w.x = cvtpk(O[dh][4 * g4] * osc, O[dh][4 * g4 + 1] * osc); w.y = cvtpk(O[dh][4 * g4 + 2] * osc, O[dh][4 * g4 + 3] * osc);
                *(LAS v2u*)(St + ql * 144 + (32 * dh + 8 * g4 + 4 * hi) * 2) = w; }
        if (SUB == 0) {
            bf16* PART = (bf16*)(F.ws + WS_XN) + (itcur < 1024 ? 0 : (size_t)M * BW); float* ST = (float*)(F.ws + WS_STAT) + (itcur < 1024 ? 0 : (size_t)M * NH * 2);
            if (hi == 0) { const size_t qt = tb + (size_t)(s0c + i0 + ql) * dc; f32x2_t st = {mx, lsum}; *(f32x2_t*)(ST + (qt * NH + hcur) * 2) = st; }
#pragma unroll
            for (int p = 0; p < 4; ++p) { const size_t rt = tb + (size_t)(s0c + i0 + 8 * p + prow) * dc;
                *(v4u*)(PART + rt * BW + hcur * 64 + pch * 8) = *(const LAS v4u*)(St + (8 * p + prow) * 144 + pch * 16); }
        } else {
#pragma unroll
            for (int p = 0; p < 4; ++p) { const size_t rt = tb + (size_t)(s0c + i0 + 8 * p + prow) * dc;
                const v4u ov = *(const LAS v4u*)(St + (8 * p + prow) * 144 + pch * 16); const f32x2_t cc = *(const LAS f32x2_t*)(St + (8 * p + prow) * 144 + 128);
                v4u o;
                o.x = cvtpk(bflo(ov.x) + cc.x * bflo(x16[p].x) + cc.y * bflo(x4[p].x), bfhi(ov.x) + cc.x * bfhi(x16[p].x) + cc.y * bfhi(x4[p].x));
                o.y = cvtpk(bflo(ov.y) + cc.x * bflo(x16[p].y) + cc.y * bflo(x4[p].y), bfhi(ov.y) + cc.x * bfhi(x16[p].y) + cc.y * bfhi(x4[p].y));
                o.z = cvtpk(bflo(ov.z) + cc.x * bflo(x16[p].z) + cc.y * bflo(x4[p].z), bfhi(ov.z) + cc.x * bfhi(x16[p].z) + cc.y * bfhi(x4[p].z));
                o.w = cvtpk(bflo(ov.w) + cc.x * bflo(x16[p].w) + cc.y * bflo(x4[p].w), bfhi(ov.w) + cc.x * bfhi(x16[p].w) + cc.y * bfhi(x4[p].w));
                *(v4u*)((bf16*)(F.ws + WS_MIXCAT) + rt * D + AW + hcur * 64 + pch * 8) = o; }
        }
        __syncthreads();
        if (!has_next) break;
        ATT_WRITE(); it = itn;
        __syncthreads();
    }
#undef ATT_DECODE
#undef ATT_LOAD
#undef ATT_WRITE
}
typedef float f32x4_t __attribute__((ext_vector_type(4)));
DI void cmul_acc(float& xr, float& xi, float ar, float ai, float br, float bi) { const float nr = ar * xr - ai * xi + br, ni = ar * xi + ai * xr + bi; xr = nr; xi = ni; }
DI void mix_ssm_in(Frame& F, int l) {
    FRAME_IDS
    const bf16* P = (const bf16*)(F.ws + WS_PROJ);
    const bf16* WIN = (const bf16*)(F.ws + WS_SSM2 + l * SSM2_LAYER + S2_WIN);
    const float* apw = (const float*)(F.ws + WS_SSM2 + l * SSM2_LAYER + S2_APW);
    float* XLOC = (float*)(F.ws + WS_XLOC); float* XSUP = (float*)(F.ws + WS_XSUP);
    const int row = lane_ & 15, q = lane_ >> 4;
    for (int it = F.vcu; it < 256; it += F.G) {
        const int b = it >> 5, sc = (it >> 2) & 7, g = 4 * (it & 3) + (wave_ >> 1), half = wave_ & 1;
        bf16x8 af[16];
        { const bf16* src = P + ((size_t)b * T + (size_t)(16 * sc + row) * 32 + (q >> 1)) * PROJW + COL_S + g * 16 + 8 * (q & 1);
#pragma unroll
          for (int sp = 0; sp < 16; ++sp) af[sp] = *(const bf16x8*)(src + (size_t)(2 * sp) * PROJW); }
#pragma unroll 1
        for (int c4 = 0; c4 < 4; ++c4) { const int ct = 4 * half + c4;
            f32x4_t acc = {0.f, 0.f, 0.f, 0.f};
            const bf16* wp = WIN + (((size_t)(g * 16) * 8 + ct) * 64 + lane_) * 8;
#pragma unroll
            for (int sp = 0; sp < 16; ++sp) { const bf16x8 bfr = *(const bf16x8*)(wp + (size_t)sp * 8 * 64 * 8); acc = __builtin_amdgcn_mfma_f32_16x16x32_bf16(af[sp], bfr, acc, 0, 0, 0); }
            const int comp = 16 * ct + row, n = comp >> 1, part = comp & 1;
#pragma unroll
            for (int r = 0; r < 4; ++r) XLOC[(((size_t)b * 128 + 16 * sc + 4 * q + r) * 16 + g) * 128 + comp] = acc[r];
            const float a32r = apw[((g * 33 + 32) * 64 + n) * 2], a32i = apw[((g * 33 + 32) * 64 + n) * 2 + 1];
            const float sg = part ? 1.f : -1.f;
            float h = acc[0];
#pragma unroll
            for (int r = 1; r < 4; ++r) { const float o = __shfl_xor(h, 1); h = a32r * h + sg * a32i * o + acc[r]; }
            float p64r = a32r * a32r - a32i * a32i, p64i = 2.f * a32r * a32i;
            float p128r = p64r * p64r - p64i * p64i, p128i = 2.f * p64r * p64i;
            float wr = 1.f, wi = 0.f;
            for (int k = 0; k < 3 - q; ++k) { const float t0 = wr * p128r - wi * p128i, t1 = wr * p128i + wi * p128r; wr = t0; wi = t1; }
            { const float o = __shfl_xor(h, 1); h = wr * h + sg * wi * o; }
            h += __shfl_xor(h, 16); h += __shfl_xor(h, 32);
            if (q == 0) XSUP[(((size_t)b * 8 + sc) * 16 + g) * 128 + comp] = h;
        }
    }
}
DI void mix_ssm_out(Frame& F, const Args& A, int l) {
    FRAME_IDS
    const bf16* P = (const bf16*)(F.ws + WS_PROJ); bf16* YG = (bf16*)(F.ws + WS_YG);
    const bf16* KT = (const bf16*)(F.ws + WS_SSM2 + l * SSM2_LAYER + S2_KT); const bf16* CT = (const bf16*)(F.ws + WS_SSM2 + l * SSM2_LAYER + S2_CT);
    const float* apw = (const float*)(F.ws + WS_SSM2 + l * SSM2_LAYER + S2_APW);
    const float* XLOC = (const float*)(F.ws + WS_XLOC); const float* XSUP = (const float*)(F.ws + WS_XSUP);
    LAS unsigned char* Ut = F.lds + RING_OFF + wave_ * 4096;
    LAS float* Xs = (LAS float*)(F.lds + RING_OFF + wave_ * 4096 + 2048);
    for (int i = lane_; i < 256; i += 64) ((LAS unsigned*)Ut)[i] = 0u;
    const int row = lane_ & 15, q = lane_ >> 4;
    for (int it = F.vcu; it < 256; it += F.G) {
        const int b = it >> 5, sc = (it >> 2) & 7, g = 4 * (it & 3) + (wave_ >> 1), half = wave_ & 1, n = lane_;
        const size_t tokA = (size_t)b * T + (size_t)(16 * sc + 8 * half) * 32;
        v4u unext = *(const v4u*)(P + (tokA + (lane_ >> 1)) * PROJW + COL_S + g * 16 + 8 * (lane_ & 1));
        f32x2_t psup[8], ploc[8];
#pragma unroll
        for (int s2 = 0; s2 < 8; ++s2) { psup[s2] = (f32x2_t){0.f, 0.f}; if (s2 < sc) psup[s2] = *(const f32x2_t*)(XSUP + (((size_t)b * 8 + s2) * 16 + g) * 128 + 2 * n); }
#pragma unroll
        for (int k2 = 0; k2 < 8; ++k2) { ploc[k2] = (f32x2_t){0.f, 0.f}; if (half) ploc[k2] = *(const f32x2_t*)(XLOC + (((size_t)b * 128 + 16 * sc + k2) * 16 + g) * 128 + 2 * n); }
        const float dsk = ((const float*)A.in[I_SSMD])[(l * 16 + g) * 16 + row];
        const float a32r = apw[((g * 33 + 32) * 64 + n) * 2], a32i = apw[((g * 33 + 32) * 64 + n) * 2 + 1];
        const float a16r = apw[((g * 33 + 16) * 64 + n) * 2], a16i = apw[((g * 33 + 16) * 64 + n) * 2 + 1];
        float a512r = a32r, a512i = a32i;
#pragma unroll
        for (int k = 0; k < 4; ++k) { const float t0 = a512r * a512r - a512i * a512i, t1 = 2.f * a512r * a512i; a512r = t0; a512i = t1; }
        float xr = 0.f, xi = 0.f;
#pragma unroll
        for (int s2 = 0; s2 < 8; ++s2) if (s2 < sc) cmul_acc(xr, xi, a512r, a512i, psup[s2].x, psup[s2].y);
        if (half) {
#pragma unroll
            for (int k2 = 0; k2 < 8; ++k2) cmul_acc(xr, xi, a32r, a32i, ploc[k2].x, ploc[k2].y); }
        asm volatile("" : "+v"(xr), "+v"(xi) :: "memory");
        bf16x8 kt[16], ctf[4];
#pragma unroll
        for (int p = 0; p < 16; ++p) kt[p] = *(const bf16x8*)(KT + ((size_t)(g * 16 + p) * 64 + lane_) * 8);
#pragma unroll
        for (int sx = 0; sx < 4; ++sx) ctf[sx] = *(const bf16x8*)(CT + ((size_t)(g * 4 + sx) * 64 + lane_) * 8);
        f32x4_t apr[4][2];
#pragma unroll
        for (int sx = 0; sx < 4; ++sx) { const f32x4_t* ap = (const f32x4_t*)(apw + ((size_t)(g * 33 + row + 1) * 64 + 16 * sx + 4 * q) * 2); apr[sx][0] = ap[0]; apr[sx][1] = ap[1]; }
#pragma unroll 1
        for (int kk = 0; kk < 8; ++kk) {
            const size_t tok0 = tokA + (size_t)kk * 32;
            const f32x2_t xl = *(const f32x2_t*)(XLOC + (((size_t)b * 128 + 16 * sc + 8 * half + kk) * 16 + g) * 128 + 2 * n);
            *(LAS v4u*)(Ut + 1024 + lane_ * 16) = unext;
            if (kk < 7) unext = *(const v4u*)(P + (tok0 + 32 + (lane_ >> 1)) * PROJW + COL_S + g * 16 + 8 * (lane_ & 1));
            Xs[2 * n] = xr; Xs[2 * n + 1] = xi; Xs[128 + 2 * n] = a16r * xr - a16i * xi; Xs[128 + 2 * n + 1] = a16r * xi + a16i * xr;
#pragma unroll
            for (int tau = 0; tau < 2; ++tau) { f32x4_t acc = (f32x4_t){0.f, 0.f, 0.f, 0.f};
                const int ti = 16 * tau + row;
#pragma unroll
                for (int sx = 0; sx < 4; ++sx) { const LAS f32x4_t* xp = (const LAS f32x4_t*)(Xs + 128 * tau + 2 * (16 * sx + 4 * q)); const f32x4_t x01 = xp[0], x23 = xp[1];
                    const f32x4_t a01 = apr[sx][0], a23 = apr[sx][1];
                    v4u zw; zw.x = cvtpk(a01.x * x01.x - a01.y * x01.y, a01.x * x01.y + a01.y * x01.x); zw.y = cvtpk(a01.z * x01.z - a01.w * x01.w, a01.z * x01.w + a01.w * x01.z);
                    zw.z = cvtpk(a23.x * x23.x - a23.y * x23.y, a23.x * x23.y + a23.y * x23.x); zw.w = cvtpk(a23.z * x23.z - a23.w * x23.w, a23.z * x23.w + a23.w * x23.z);
                    acc = __builtin_amdgcn_mfma_f32_16x16x32_bf16(__builtin_bit_cast(bf16x8, zw), ctf[sx], acc, 0, 0, 0);
                    asm volatile("" ::: "memory"); }
#pragma unroll
                for (int p = 0; p < 16; ++p) if (p < 8 * tau + 8) { const bf16x8 ua = *(const LAS bf16x8*)(Ut + (32 + ti - 2 * p - (q >> 1)) * 32 + 16 * (q & 1));
                    acc = __builtin_amdgcn_mfma_f32_16x16x32_bf16(ua, kt[p], acc, 0, 0, 0); if ((p & 3) == 3) asm volatile("" ::: "memory"); }
#pragma unroll
                for (int r = 0; r < 4; ++r) { const int t2 = 16 * tau + 4 * q + r; const float uu = bf2f(*(const LAS bf16*)(Ut + (32 + t2) * 32 + 2 * row));
                    YG[(tok0 + t2) * 256 + g * 16 + row] = (bf16)f2bf(gelu_tanh_f(acc[r] + dsk * uu)); }
            }
            cmul_acc(xr, xi, a32r, a32i, xl.x, xl.y);
        }
    }
}
DI void mix_gating_mfma(Frame& F, const Args& A, int l, int variant = 0) {
    FRAME_IDS
    const bf16* P = (const bf16*)(F.ws + WS_PROJ); bf16* MIX = (bf16*)(F.ws + WS_MIXCAT);
    const bf16* GW = (const bf16*)(F.ws + WS_SSM2 + l * SSM2_LAYER + S2_GW);
    const float* lng = (const float*)A.in[I_GMLNG] + l * AW; const float* lnb = (const float*)A.in[I_GMLNB] + l * AW;
    const float* bs_ = (const float*)A.in[I_GMBS] + l * 4 * 128;
    LAS unsigned char* VT = F.lds + RING_OFF;
    const int ql = lane_ & 31, hi = lane_ >> 5, trq = (lane_ & 15) >> 2, trg = (lane_ >> 4) & 1, trp = lane_ & 3;
    for (int it = F.vcu; it < BATCH * (T / 128); it += F.G) {
        const int m0 = it * 128;
        __syncthreads();
        if (variant != 2) {
        v2u wv[16];
#pragma unroll
        for (int j = 0; j < 16; ++j) wv[j] = *(const v2u*)(P + (size_t)(m0 + wave_ + 8 * j) * PROJW + COL_V + 4 * lane_);
        const f32x4 gg = *(const f32x4*)(lng + 4 * lane_), bb = *(const f32x4*)(lnb + 4 * lane_);
#pragma unroll
        for (int j = 0; j < 16; ++j) { const int r = wave_ + 8 * j; const v2u w = wv[j];
            float v[4] = {bflo(w.x), bfhi(w.x), bflo(w.y), bfhi(w.y)};
            const float mean = wave_sum(v[0] + v[1] + v[2] + v[3]) * (1.f / 256.f);
            float s2 = 0.f;
#pragma unroll
            for (int i = 0; i < 4; ++i) { v[i] -= mean; s2 += v[i] * v[i]; }
            const float rstd = 1.0f / sqrtf(wave_sum(s2) * (1.f / 256.f) + LN_EPS);
            v2u o; o.x = cvtpk(v[0] * rstd * gg.x + bb.x, v[1] * rstd * gg.y + bb.y); o.y = cvtpk(v[2] * rstd * gg.z + bb.z, v[3] * rstd * gg.w + bb.w);
            *(LAS v2u*)(VT + r * 512 + (((lane_ >> 1) ^ ((r & 3) << 2)) << 4) + 8 * (lane_ & 1)) = o;
        }
        }
        __syncthreads();
        if (variant == 1) continue;
        const int h = wave_ >> 1, cb = 64 * h + 32 * (wave_ & 1);
        const int chunk = (cb >> 3) + 2 * trg + (trp >> 1);
#pragma unroll
        for (int rt = 0; rt < 4; ++rt) {
            f32x16 acc;
#pragma unroll
            for (int i = 0; i < 16; ++i) acc[i] = 0.f;
            bf16x8 wa[8];
#pragma unroll
            for (int ks = 0; ks < 2 * rt + 2; ++ks) wa[ks] = *(const bf16x8*)(GW + ((size_t)h * 128 + 32 * rt + ql) * 128 + 16 * ks + 8 * hi);
#pragma unroll
            for (int ks = 0; ks < 2 * rt + 2; ++ks) {
                const int rlo = 16 * ks + 8 * hi + trq;
                const v4i16_t lo = __builtin_amdgcn_ds_read_tr16_b64_v4i16((LAS v4i16_t*)(VT + rlo * 512 + ((chunk ^ (trq << 2)) << 4) + 8 * (trp & 1)));
                const v4i16_t hh = __builtin_amdgcn_ds_read_tr16_b64_v4i16((LAS v4i16_t*)(VT + (rlo + 4) * 512 + ((chunk ^ (trq << 2)) << 4) + 8 * (trp & 1)));
                const bf16x8 va = (bf16x8){lo[0], lo[1], lo[2], lo[3], hh[0], hh[1], hh[2], hh[3]};
                acc = __builtin_amdgcn_mfma_f32_32x32x16_bf16(va, wa[ks], acc, 0, 0, 0); }
            { const int t = 32 * rt + ql; const float bsv = bs_[h * 128 + t];
              const bf16* up = P + (size_t)(m0 + t) * PROJW + COL_U + cb + 4 * hi; bf16* op = MIX + (size_t)(m0 + t) * D + cb + 4 * hi;
#pragma unroll
              for (int g4 = 0; g4 < 4; ++g4) { const v2u uw = *(const v2u*)(up + 8 * g4); v2u o;
                  o.x = cvtpk(bflo(uw.x) * (acc[4 * g4] + bsv), bfhi(uw.x) * (acc[4 * g4 + 1] + bsv)); o.y = cvtpk(bflo(uw.y) * (acc[4 * g4 + 2] + bsv), bfhi(uw.y) * (acc[4 * g4 + 3] + bsv));
                  *(v2u*)(op + 8 * g4) = o; } }
        }
    }
}

DI void p_glu(Frame& F, const Args& A, int l) {
    FRAME_IDS
    const bf16* YG = (const bf16*)(F.ws + WS_YG); bf16* MIX = (bf16*)(F.ws + WS_MIXCAT);
    const bf16* GluT = (const bf16*)(F.ws + WS_WSMALL + l * WSMALL_LAYER + WOFF_GLU); const float* gb = (const float*)A.in[I_GLUB] + l * 256;
    LAS unsigned char* Bs = F.lds + RING_OFF;
#pragma unroll
    for (int i = 0; i < 16; ++i) { const int idx = tid_ + 512 * i, n = idx >> 5, ch = idx & 31;
        *(LAS v4u*)(Bs + n * 512 + ((ch ^ (n & 15)) << 4)) = *(const v4u*)(GluT + (size_t)n * 256 + ch * 8); }
    __syncthreads();
    const int tk = lane_ & 15, q = lane_ >> 4;
    for (int rt = F.vcu; rt < M / 128; rt += F.G) {
        const size_t tok = (size_t)rt * 128 + wave_ * 16 + tk;
        bf16x8 yf[8];
#pragma unroll
        for (int ks = 0; ks < 8; ++ks) yf[ks] = *(const bf16x8*)(YG + tok * 256 + 32 * ks + 8 * q);
#pragma unroll 4
        for (int ct = 0; ct < 16; ++ct) {
            f32x4_t acc = {0.f, 0.f, 0.f, 0.f};
            const int n = 16 * ct + tk;
#pragma unroll
            for (int ks = 0; ks < 8; ++ks) { const bf16x8 wf = *(const LAS bf16x8*)(Bs + n * 512 + (((4 * ks + q) ^ (n & 15)) << 4));
                acc = __builtin_amdgcn_mfma_f32_16x16x32_bf16(wf, yf[ks], acc, 0, 0, 0); }
            const int n0 = 16 * ct + 4 * q; const v2u yw = *(const v2u*)(YG + tok * 256 + n0); const f32x4 bv = *(const f32x4*)(gb + n0);
            v2u o; o.x = cvtpk(bflo(yw.x) * sigmoid_f(acc[0] + bv.x), bfhi(yw.x) * sigmoid_f(acc[1] + bv.y)); o.y = cvtpk(bflo(yw.y) * sigmoid_f(acc[2] + bv.z), bfhi(yw.y) * sigmoid_f(acc[3] + bv.w));
            *(v2u*)(MIX + tok * D + 768 + n0) = o;
        }
    }
}
DI void mix_ssm_simple(Frame& F, const Args& A, int l) {
    FRAME_IDS
    const bf16* P = (const bf16*)(F.ws + WS_PROJ); bf16* YG = (bf16*)(F.ws + WS_YG);
    const float* tab = (const float*)(F.ws + WS_SSM) + (size_t)l * SSM_TAB;
    LAS float* fin = (LAS float*)(F.lds + RING_OFF);
    for (int it = F.vcu; it < BATCH * SSM_G; it += F.G) {
        const int b = it >> 4, g = it & 15, n = lane_, seg = wave_, gn = g * 64 + n;
        const float are = tab[gn], aim = tab[1024 + gn];
        float bre[16], bim[16], cre[16], cim[16];
#pragma unroll
        for (int c = 0; c < 16; ++c) { bre[c] = tab[2048 + gn * 16 + c]; bim[c] = tab[2048 + 16384 + gn * 16 + c];
            cre[c] = ((const float*)A.in[I_CRE])[(((size_t)l * 16 + g) * 16 + c) * 64 + n]; cim[c] = ((const float*)A.in[I_CIM])[(((size_t)l * 16 + g) * 16 + c) * 64 + n]; }
        const float dsk = ((const float*)A.in[I_SSMD])[(l * 16 + g) * 16 + (lane_ & 15)];
        const size_t mbase = (size_t)b * T + seg * 512;
        float xr = 0.f, xi = 0.f;
        for (int tt = 0; tt < 512; ++tt) { const v4u* up = (const v4u*)(P + (mbase + tt) * PROJW + COL_S + g * 16); const v4u u0 = up[0], u1 = up[1];
            const float u[16] = {bflo(u0.x), bfhi(u0.x), bflo(u0.y), bfhi(u0.y), bflo(u0.z), bfhi(u0.z), bflo(u0.w), bfhi(u0.w), bflo(u1.x), bfhi(u1.x), bflo(u1.y), bfhi(u1.y), bflo(u1.z), bfhi(u1.z), bflo(u1.w), bfhi(u1.w)};
            float br = 0.f, bi = 0.f;
#pragma unroll
            for (int c = 0; c < 16; ++c) { br += u[c] * bre[c]; bi += u[c] * bim[c]; }
            const float nr = are * xr - aim * xi + br, ni = are * xi + aim * xr + bi; xr = nr; xi = ni; }
        fin[(seg * 64 + n) * 2] = xr; fin[(seg * 64 + n) * 2 + 1] = xi;
        __syncthreads();
        float pr = are, pi = aim;
#pragma unroll
        for (int k = 0; k < 9; ++k) { const float t0 = pr * pr - pi * pi, t1 = 2.f * pr * pi; pr = t0; pi = t1; }
        xr = 0.f; xi = 0.f;
        for (int s = 0; s < seg; ++s) { const float fr_ = fin[(s * 64 + n) * 2], fi_ = fin[(s * 64 + n) * 2 + 1];
            const float nr = pr * xr - pi * xi + fr_, ni = pr * xi + pi * xr + fi_; xr = nr; xi = ni; }
        for (int tt = 0; tt < 512; ++tt) { const v4u* up = (const v4u*)(P + (mbase + tt) * PROJW + COL_S + g * 16); const v4u u0 = up[0], u1 = up[1];
            const float u[16] = {bflo(u0.x), bfhi(u0.x), bflo(u0.y), bfhi(u0.y), bflo(u0.z), bfhi(u0.z), bflo(u0.w), bfhi(u0.w), bflo(u1.x), bfhi(u1.x), bflo(u1.y), bfhi(u1.y), bflo(u1.z), bfhi(u1.z), bflo(u1.w), bfhi(u1.w)};
            float br = 0.f, bi = 0.f;
#pragma unroll
            for (int c = 0; c < 16; ++c) { br += u[c] * bre[c]; bi += u[c] * bim[c]; }
            const float nr = are * xr - aim * xi + br, ni = are * xi + aim * xr + bi; xr = nr; xi = ni;
            float ysel = 0.f, usel = 0.f;
#pragma unroll
            for (int c = 0; c < 16; ++c) { const float r = wave_sum(xr * cre[c] - xi * cim[c]); if ((lane_ & 15) == c) { ysel = r; usel = u[c]; } }
            if (lane_ < 16) { const float y = ysel + dsk * usel; YG[(mbase + tt) * 256 + g * 16 + lane_] = (bf16)f2bf(gelu_tanh_f(y)); } }
        __syncthreads();
    }
}

DI bool beats(float x, int i, float y, int j) { return x > y || (x == y && i < j); }
DI void p_row_b(Frame& F, const Args& A, int l, bool count = true) {
    FRAME_IDS
    const int gw = F.vcu * NWAVES + wave_, NGW = F.G * NWAVES;
    const bf16* PRE = (const bf16*)(F.ws + WS_PRE); bf16* X1 = (bf16*)(F.ws + WS_X1); bf16* XN = (bf16*)(F.ws + WS_XN);
    const float* mod = (const float*)(F.ws + WS_MOD) + (size_t)l * BATCH * 6 * D;
    const float* ln1g = (const float*)A.in[I_LN1G] + l * D; const float* ln1b = (const float*)A.in[I_LN1B] + l * D;
    const float* rw = (const float*)A.in[I_RW]; const float* rb = (const float*)A.in[I_RB];
    int* slot_a = (int*)(F.ws + WS_SLOT_A); float* slot_w = (float*)(F.ws + WS_SLOT_W);
    LAS float* rwS = (LAS float*)(F.lds + RING_OFF);
    volatile LAS unsigned* lcnt = (volatile LAS unsigned*)(F.lds + RING_OFF + 65536);
    LAS int* list_a = (LAS int*)(F.lds + RING_OFF + 66048); LAS float* list_w = (LAS float*)(F.lds + RING_OFF + 66048 + 8192);
    for (int i = tid_; i < D * NEXP; i += NTHR) rwS[(i & 15) * D + (i >> 4)] = rw[i];
    if (tid_ < 32) lcnt[tid_] = 0u;
    __syncthreads();
    const int hi5 = lane_ >> 5, b4 = (lane_ >> 4) & 1, b3 = (lane_ >> 3) & 1, b2 = (lane_ >> 2) & 1, emine = 8 * hi5 + 4 * b4 + 2 * b3 + b2;
    const int wi = 2 * b3 + b2, mygrp = 2 * hi5 + b4;
    const float rbm = rb[emine];
    Row16 lg1, lb1; row_load_f32(lg1, ln1g, lane_); row_load_f32(lb1, ln1b, lane_);
    v2u nraw[4];
    { const v2u* q = (const v2u*)(PRE + (size_t)gw * D);
#pragma unroll
      for (int k = 0; k < 4; ++k) nraw[k] = q[k * 64 + lane_]; }
    for (int m = gw; m < M; m += NGW) { const int b = m / T; const float* md = mod + (size_t)b * 6 * D;
        Row16 r;
#pragma unroll
        for (int k = 0; k < 4; ++k) { r.v[4 * k] = bflo(nraw[k].x); r.v[4 * k + 1] = bfhi(nraw[k].x); r.v[4 * k + 2] = bflo(nraw[k].y); r.v[4 * k + 3] = bfhi(nraw[k].y); }
        if (m + NGW < M) { const v2u* q = (const v2u*)(PRE + (size_t)(m + NGW) * D);
#pragma unroll
            for (int k = 0; k < 4; ++k) nraw[k] = q[k * 64 + lane_]; }
        Row16 msc, msh; row_load_f32(msc, md + 4 * D, lane_); row_load_f32(msh, md + 3 * D, lane_);
        row_ln(r);
#pragma unroll
        for (int i = 0; i < 16; ++i) r.v[i] = r.v[i] * lg1.v[i] + lb1.v[i];
        row_ln(r);
#pragma unroll
        for (int i = 0; i < 16; ++i) r.v[i] = r.v[i] * (1.0f + msc.v[i]) + msh.v[i];
        row_store_bf16(r, XN + (size_t)m * D, lane_);
        float lg[16];
#pragma unroll
        for (int e = 0; e < 16; ++e) { float a = 0.f;
#pragma unroll
            for (int k = 0; k < 4; ++k) { const f32x4 w4 = *(const LAS f32x4*)(rwS + e * D + 256 * k + 4 * lane_); a += r.v[4 * k] * w4.x + r.v[4 * k + 1] * w4.y + r.v[4 * k + 2] * w4.z + r.v[4 * k + 3] * w4.w; }
            lg[e] = a; }
        float t8[8], t4[4], t2[2];
#pragma unroll
        for (int i = 0; i < 8; ++i) { const float keep = hi5 ? lg[8 + i] : lg[i], give = hi5 ? lg[i] : lg[8 + i]; t8[i] = keep + __shfl_xor(give, 32); }
#pragma unroll
        for (int i = 0; i < 4; ++i) { const float keep = b4 ? t8[4 + i] : t8[i], give = b4 ? t8[i] : t8[4 + i]; t4[i] = keep + __shfl_xor(give, 16); }
#pragma unroll
        for (int i = 0; i < 2; ++i) { const float keep = b3 ? t4[2 + i] : t4[i], give = b3 ? t4[i] : t4[2 + i]; t2[i] = keep + __shfl_xor(give, 8); }
        float z = (b2 ? t2[1] : t2[0]) + __shfl_xor(b2 ? t2[0] : t2[1], 4);
        z += __shfl_xor(z, 2); z += __shfl_xor(z, 1);
        const float scm = 1.0f / (1.0f + __builtin_amdgcn_exp2f(-1.4426950408889634f * z)), a = scm + rbm;
        const float p4 = __shfl_xor(a, 4), p8 = __shfl_xor(a, 8), p12 = __shfl_xor(a, 12);
        const float hi01 = fmaxf(a, p4), lo01 = fminf(a, p4), hi23 = fmaxf(p8, p12), lo23 = fminf(p8, p12);
        const float gs = fmaxf(hi01, hi23) + fmaxf(fmaxf(lo01, lo23), fminf(hi01, hi23));
        const float g16 = __shfl_xor(gs, 16), g32 = __shfl_xor(gs, 32), g48 = __shfl_xor(gs, 48);
        const bool best = beats(gs, mygrp, g16, mygrp ^ 1) && beats(gs, mygrp, g32, mygrp ^ 2) && beats(gs, mygrp, g48, mygrp ^ 3);
        const int rank = (beats(p4, wi ^ 1, a, wi) ? 1 : 0) + (beats(p8, wi ^ 2, a, wi) ? 1 : 0) + (beats(p12, wi ^ 3, a, wi) ? 1 : 0);
        const bool sel = best && rank < 2;
        float tot = sel ? scm : 0.f; tot += __shfl_xor(tot, 4); tot += __shfl_xor(tot, 8);
        if (count && sel && (lane_ & 3) == 0) { const unsigned rk = atomicAdd((unsigned*)&lcnt[emine], 1u);
            list_a[emine * 128 + rk] = 2 * m + rank; list_w[emine * 128 + rk] = scm / tot; }
    }
    __syncthreads();
    if (count) {
        if (tid_ < 16) { const unsigned n = lcnt[tid_]; lcnt[16 + tid_] = n ? atomicAdd((unsigned*)(F.ctl + CW_CNT + l * 128 + tid_), n) : 0u; }
        __syncthreads();
        for (int idx = tid_; idx < 16 * 128; idx += NTHR) { const int e = idx >> 7, rk = idx & 127;
            if (rk < (int)lcnt[e]) { const size_t slot = (size_t)e * SLOT_CAP + lcnt[16 + e] + rk; slot_a[slot] = list_a[idx]; slot_w[slot] = list_w[idx]; } }
    }
}

DI void moe_tstart(Frame& F, int l) {
    FRAME_IDS
    volatile LAS int* ts = (volatile LAS int*)(F.lds + LDSCTL_OFF);
    __syncthreads();
    if (tid_ == 0) { int acc = 0;
        for (int e = 0; e < 16; ++e) { ts[e] = acc; const unsigned c = __hip_atomic_load(F.ctl + CW_CNT + l * 128 + e, RLX_AGENT); ts[32 + e] = (int)c; acc += (int)((c + 255u) >> 8); }
        ts[16] = acc; }
    __syncthreads();
}
DI void p_row_c(Frame& F, const Args& A, int l) {
    FRAME_IDS
    const int gw = F.vcu * NWAVES + wave_, NGW = F.G * NWAVES;
    const bf16* X1 = (const bf16*)(F.ws + WS_PRE); bf16* R2 = (bf16*)(F.ws + WS_ROWS2); bf16* XN = (bf16*)(F.ws + WS_XN);
    const float* ln1g = (const float*)A.in[I_LN1G] + l * D; const float* ln1b = (const float*)A.in[I_LN1B] + l * D;
    Row16 lg1, lb1; row_load_f32(lg1, ln1g, lane_); row_load_f32(lb1, ln1b, lane_);
    const float* mod = (const float*)(F.ws + WS_MOD) + (size_t)l * BATCH * 6 * D;
    const float* modn = (const float*)(F.ws + WS_MOD) + (size_t)(l + 1) * BATCH * 6 * D;
    const float* ln2g = (const float*)A.in[I_LN2G] + l * D; const float* ln2b = (const float*)A.in[I_LN2B] + l * D;
    Row16 lg2, lb2; row_load_f32(lg2, ln2g, lane_); row_load_f32(lb2, ln2b, lane_);
    v2u nx[4], n0[4], n1[4];
#define RC_LOAD(mm) do { const v2u* qa = (const v2u*)(X1 + (size_t)(mm) * D); const v2u* qb = (const v2u*)(R2 + (size_t)(2 * (mm)) * D); \
        _Pragma("unroll") for (int k = 0; k < 4; ++k) { nx[k] = qa[k * 64 + lane_]; n0[k] = qb[k * 64 + lane_]; n1[k] = qb[256 + k * 64 + lane_]; } } while (0)
    RC_LOAD(gw);
    for (int m = gw; m < M; m += NGW) { const int b = m / T; const float* md = mod + (size_t)b * 6 * D;
        Row16 x1, g2;
#pragma unroll
        for (int k = 0; k < 4; ++k) {
            x1.v[4 * k] = bflo(nx[k].x); x1.v[4 * k + 1] = bfhi(nx[k].x); x1.v[4 * k + 2] = bflo(nx[k].y); x1.v[4 * k + 3] = bfhi(nx[k].y);
            g2.v[4 * k] = bflo(n0[k].x) + bflo(n1[k].x); g2.v[4 * k + 1] = bfhi(n0[k].x) + bfhi(n1[k].x); g2.v[4 * k + 2] = bflo(n0[k].y) + bflo(n1[k].y); g2.v[4 * k + 3] = bfhi(n0[k].y) + bfhi(n1[k].y); }
        if (m + NGW < M) RC_LOAD(m + NGW);
        Row16 gm; row_load_f32(gm, md + 5 * D, lane_);
        Row16 msc, msh;
        if (l != DEPTH - 1) { const float* mdn = modn + (size_t)b * 6 * D; row_load_f32(msc, mdn + 1 * D, lane_); row_load_f32(msh, mdn + 0 * D, lane_); }
        row_ln(x1);
#pragma unroll
        for (int i = 0; i < 16; ++i) x1.v[i] = ALPHA * (x1.v[i] * lg1.v[i] + lb1.v[i]) + (1.0f + gm.v[i]) * g2.v[i];
        row_ln(x1);
#pragma unroll
        for (int i = 0; i < 16; ++i) x1.v[i] = x1.v[i] * lg2.v[i] + lb2.v[i];
        if (l == DEPTH - 1) row_store_f32(x1, A.out + (size_t)m * D, lane_);
        else { row_store_bf16(x1, R2 + (size_t)(2 * m) * D, lane_);
            row_ln(x1);
#pragma unroll
            for (int i = 0; i < 16; ++i) x1.v[i] = x1.v[i] * (1.0f + msc.v[i]) + msh.v[i];
            row_store_bf16(x1, XN + (size_t)m * D, lane_); }
    }
#undef RC_LOAD
}

#ifndef PHMASK
#define PHMASK 0xFFFFFFFFu
#endif
#define IN(k) (lo <= (k) && (k) < hi && ((PHMASK >> (((k) == 0) ? 31 : (((k) - 1) % PH_PER_LAYER))) & 1u))
#define SEAM(k) do { if (IN((k) + 1) && MK_ONE_LAUNCH) xcd_barrier(bar); else __syncthreads(); } while (0)
constexpr int PH_PER_LAYER = 9, N_PHASES = 1 + DEPTH * PH_PER_LAYER;
#ifndef REP_PH
#define REP_PH -1
#endif
#define NREP(k) (((k) == REP_PH) ? 2 : 1)
template <int l> DI void layer_body(Frame& F, const Args& args, const XcdBarrier& bar, const int lo, const int hi) {
    unsigned char* ws = args.ws;

        const int pb = 1 + l * PH_PER_LAYER;
        const bf16* WinT = (const bf16*)(ws + WS_WSMALL + l * WSMALL_LAYER + WOFF_IN);
        const bf16* WoutT = (const bf16*)(ws + WS_WSMALL + l * WSMALL_LAYER + WOFF_OUT);
        const bf16* GluT = (const bf16*)(ws + WS_WSMALL + l * WSMALL_LAYER + WOFF_GLU);
        const float* modl = (const float*)(ws + WS_MOD) + (size_t)l * BATCH * 6 * D;
        if (IN(pb + 0)) for (int rep_ = 0; rep_ < NREP(0); ++rep_) { p_wconv(F, args, l, 0); if (l == 0) p_ln_a0(F, args); SEAM(pb + 0); }
        if (IN(pb + 1)) for (int rep_ = 0; rep_ < NREP(1); ++rep_) {
            pg8::Gemm g{(const bf16*)(ws + WS_XN), WinT, M, PROJW, D}; pg8::StaticOrder S; S.init(M, PROJW, F.G, (int)blockIdx.x);
            EpiInProj E{(bf16*)(ws + WS_PROJ), (const float*)(ws + WS_ROPE), args.pad};
            pg8::gemm_phase<EpiInProj, pg8::StaticOrder, PG8_ALIGN, PG8_SP2>(F.lds + RING_OFF, g, S, E);
            if (F.G == 256 && blockIdx.x >= 128) { __syncthreads(); p_wconv(F, args, l, 1); }
            SEAM(pb + 1); }
        if (IN(pb + 2)) for (int rep_ = 0; rep_ < NREP(2); ++rep_) {
#ifndef REP_SUB
#define REP_SUB -1
#endif
#define SUBREP(k) for (int rs_ = 0; rs_ < ((REP_SUB == (k)) ? 2 : 1); ++rs_)
            SUBREP(0) { mix_gating_mfma(F, args, l); __syncthreads(); }
#if REP_SUB >= 10 && REP_SUB < 20
            mix_gating_mfma(F, args, l, REP_SUB - 10); __syncthreads(); mix_gating_mfma(F, args, l); __syncthreads();
#endif
 SUBREP(1) { mix_ssm_in(F, l); } SUBREP(2) { mix_attn_mfma<0>(F, l); __syncthreads(); } SEAM(pb + 2); }
        if (IN(pb + 3)) for (int rep_ = 0; rep_ < NREP(3); ++rep_) { SUBREP(3) { mix_ssm_out(F, args, l); __syncthreads(); } SUBREP(4) { mix_attn_mfma<1>(F, l); __syncthreads(); } SEAM(pb + 3); }
        if (IN(pb + 4)) for (int rep_ = 0; rep_ < NREP(4); ++rep_) { p_glu(F, args, l); SEAM(pb + 4); }
        if (IN(pb + 5)) for (int rep_ = 0; rep_ < NREP(5); ++rep_) {
            pg8::Gemm g{(const bf16*)(ws + WS_MIXCAT), WoutT, M, D, D}; pg8::StaticOrder S; S.init(M, D, F.G, (int)blockIdx.x);
            if (l == 0) { EpiOut<true> E{(bf16*)(ws + WS_PRE), args.in[I_X], D, modl}; pg8::gemm_phase<EpiOut<true>, pg8::StaticOrder, PG8_ALIGN, PG8_SP2>(F.lds + RING_OFF, g, S, E); }
            else { EpiOut<false> E{(bf16*)(ws + WS_PRE), (const void*)(ws + WS_ROWS2), 2 * D, modl}; pg8::gemm_phase<EpiOut<false>, pg8::StaticOrder, PG8_ALIGN, PG8_SP2>(F.lds + RING_OFF, g, S, E); }
            SEAM(pb + 5); }
        if (IN(pb + 6)) { p_row_b(F, args, l); SUBREP(5) { if (REP_SUB == 5 && rs_ == 0) { __syncthreads(); p_row_b(F, args, l, false); } } SEAM(pb + 6); }
        if (IN(pb + 7)) { moe_tstart(F, l);
            gu32* dcnt = F.ctl + CW_DONE + l * 512;
            { pg8::Gemm g{(const bf16*)(ws + WS_XN), (const bf16*)(ws + WS_WGU), NSLOT_MAX, NEXP * 1024, D};
              MoeOrderK<0> S{(const volatile LAS int*)(F.lds + LDSCTL_OFF), F.G, (int)blockIdx.x, (const int*)(ws + WS_SLOT_A), (const float*)(ws + WS_SLOT_W), dcnt}; EpiG1 E{(bf16*)(ws + WS_HID)};
              pg8::gemm_phase_g<EpiG1, MoeOrderK<0>, PG8_ALIGN, PG8_SP2, 0>(F.lds + RING_OFF, F.lds + GT_OFF, g, S, E); }
            { pg8::Gemm g{(const bf16*)(ws + WS_HID), (const bf16*)(ws + WS_WD), NSLOT_MAX, NEXP * 1024, DEXP};
              MoeOrderK<1> S{(const volatile LAS int*)(F.lds + LDSCTL_OFF), F.G, (int)blockIdx.x, (const int*)(ws + WS_SLOT_A), (const float*)(ws + WS_SLOT_W), dcnt}; EpiG2 E{(bf16*)(ws + WS_ROWS2)};
              pg8::gemm_phase_g<EpiG2, MoeOrderK<1>, PG8_ALIGN, PG8_SP2, 16>(F.lds + RING_OFF, F.lds + GT_OFF, g, S, E); }
            SEAM(pb + 7); }
        if (IN(pb + 8)) { p_row_c(F, args, l); SUBREP(6) { if (REP_SUB == 6 && rs_ == 0 && l == DEPTH - 1) { __syncthreads(); p_row_c(F, args, l); } } SEAM(pb + 8); }
    }
__global__ void __launch_bounds__(NTHR, 2) mk_fwd(Args args) {
    extern __shared__ __attribute__((aligned(16))) unsigned char lds[];
    Frame F;
    F.lds = (LAS unsigned char*)lds; F.MISC = (volatile LAS unsigned*)(F.lds + MISC_OFF);
    F.G = gridDim.x; { const int bx = blockIdx.x; F.vcu = (F.G % 8 == 0) ? (bx % 8) * (F.G / 8) + bx / 8 : bx; }
    F.ws = args.ws; F.ctl = (gu32*)(args.ws + WS_CTL);
    for (int u = ftid(); u < (LDS_BYTES - LDSCTL_OFF) / 4; u += NTHR) ((LAS unsigned*)(F.lds + LDSCTL_OFF))[u] = 0u;
    __syncthreads();
    XcdBarrier bar; bar.bar = (unsigned*)(F.ctl + CW_BAR); bar.x = 0; bar.st = nullptr;
    if (MK_ONE_LAUNCH) bar = xcd_barrier_post((unsigned*)(F.ctl + CW_BAR), F.MISC + 8);
    const int lo = args.ph_lo, hi = args.ph_hi;
    unsigned char* ws = args.ws; (void)ws;
    if (IN(0)) { p0_tables(F, args); SEAM(0); }
    layer_body<0>(F, args, bar, lo, hi);
    layer_body<1>(F, args, bar, lo, hi);
#ifdef EXTRA_BARS
    if (MK_ONE_LAUNCH) for (int xb_ = 0; xb_ < EXTRA_BARS; ++xb_) xcd_barrier(bar);
#endif
#undef IN
#undef SEAM
}

extern "C" void kernel_launch(void* const* d_in, const int* in_sizes, int n_in, void* d_out, int out_size, void* d_ws, size_t ws_size, hipStream_t stream) {
    static int grid = 0;
    if (grid == 0) {
        if (n_in != 30 || in_sizes[0] != M * D || out_size != M * D || ws_size < WS_END) { fprintf(stderr, "kernel_launch: unexpected shapes (n_in %d, in0 %d, out %d, ws %zu, need %zu)\n", n_in, n_in > 0 ? in_sizes[0] : -1, out_size, ws_size, (size_t)WS_END); grid = -1; return; }
        int dev = 0, cus = 0, per_cu = 0;
        if (hipGetDevice(&dev) != hipSuccess || hipDeviceGetAttribute(&cus, hipDeviceAttributeMultiprocessorCount, dev) != hipSuccess) { grid = -1; return; }
        if (hipFuncSetAttribute((const void*)mk_fwd, hipFuncAttributeMaxDynamicSharedMemorySize, LDS_BYTES) != hipSuccess) { fprintf(stderr, "kernel_launch: hipFuncSetAttribute failed\n"); grid = -1; return; }
        if (hipOccupancyMaxActiveBlocksPerMultiprocessor(&per_cu, (const void*)mk_fwd, NTHR, LDS_BYTES) != hipSuccess || per_cu < 1) fprintf(stderr, "kernel_launch: occupancy query says %d\n", per_cu);
        (void)hipGetLastError();
        grid = cus;
    }
    if (grid < 0) return;
    if (hipMemsetAsync((char*)d_ws + WS_CTL, 0, CTL_ZERO_BYTES, stream) != hipSuccess) return;
    Args a{};
    for (int i = 0; i < 30; ++i) a.in[i] = d_in[i];
    a.out = (float*)d_out; a.ws = (unsigned char*)d_ws;
#if MK_ONE_LAUNCH
    a.ph_lo = 0; a.ph_hi = N_PHASES; a.li = 0;
    hipLaunchKernelGGL(mk_fwd, dim3(grid), dim3(NTHR), LDS_BYTES, stream, a);
#else
#ifndef REP_GLOBAL
#define REP_GLOBAL -1
#endif
#ifndef PROBE_SKIP
#define PROBE_SKIP 1
#endif
#ifndef REP_COUNT
#define REP_COUNT 2
#endif
    for (int p = 0; p < N_PHASES; ++p) { a.ph_lo = p; a.ph_hi = p + 1; a.li = p;
        const int nrep = ((p == 0 ? 100 : (p - 1) % PH_PER_LAYER) == REP_GLOBAL) ? REP_COUNT : 1;
        for (int r = 0; r < nrep; ++r) { a.pad = r ? PROBE_SKIP : 0; hipLaunchKernelGGL(mk_fwd, dim3(grid), dim3(NTHR), LDS_BYTES, stream, a); } a.pad = 0; }
#endif
}
```

```cpp
#include <hip/hip_runtime.h>
#include <cstdio>
#include <cstdint>
namespace pg8 {
#define PG8_LAS __attribute__((address_space(3)))
typedef unsigned short bf16_t;
typedef short bf16x8 __attribute__((ext_vector_type(8)));
typedef float f32x4 __attribute__((ext_vector_type(4)));
typedef unsigned u32x4 __attribute__((ext_vector_type(4)));
constexpr int BM = 256, BK = 64, HALF = 128, HTB = HALF * BK * 2  , STAGE_BYTES = 8 * HTB, NXCD = 8, WGM = 8;

__host__ __device__ __forceinline__ int lds_byte(int r, int c) { const int st = (r >> 4) * 2 + (c >> 5), rr = r & 15, cc = c & 31, ob = rr * 64 + cc * 2; return st * 1024 + (ob ^ (((ob >> 9) & 1) << 5)); }
__host__ __device__ __forceinline__ void stage_rc(int b, int& R, int& C) { const int st = b / 1024, sb = b % 1024, swz = sb ^ (((sb >> 9) & 1) << 5); R = (st >> 1) * 16 + swz / 64; C = (st & 1) * 32 + (swz % 64) / 2; }
__host__ __device__ __forceinline__ int perm32(int rho) { const int n = rho >> 4, i = rho & 15; return 8 * (i >> 2) + 4 * n + (i & 3); }

struct Unit { int pm, pn; };
struct Gemm { const bf16_t* A; const bf16_t* Bt; int M, N, K; };

struct StaticOrder {
    int nM, nN, nwg, G, c;
    __host__ __device__ void init(int M, int N, int G_, int c_) { nM = M / BM; nN = N / BM; nwg = nM * nN; G = G_; c = c_; }
    __host__ __device__ bool next(int i, Unit& u) const {
        const long L = (long)i * G + c; if (L >= nwg) return false;
        int wgid = (int)L; { const int q = nwg / NXCD, r = nwg % NXCD, xcd = wgid % NXCD, off = wgid / NXCD; wgid = (xcd < r ? xcd * (q + 1) : r * (q + 1) + (xcd - r) * q) + off; }
        const int nig = WGM * nN, gid = wgid / nig, fm = gid * WGM, gsz = (nM - fm) < WGM ? (nM - fm) : WGM;
        u.pm = fm + ((wgid % nig) % gsz); u.pn = (wgid % nig) / gsz; return true;
    }
    __device__ __forceinline__ void a_ready(const Unit&) const {}
    __device__ __forceinline__ void done(const Unit&) const {}
};

__device__ __forceinline__ unsigned cvt_pk_bf16(float lo, float hi) { unsigned r; asm volatile("v_cvt_pk_bf16_f32 %0, %1, %2" : "=v"(r) : "v"(lo), "v"(hi)); return r; }
template <class Epi, class Sched, bool ALIGN_EPI = false, bool SP2 = false>
__device__ __forceinline__ void gemm_phase(PG8_LAS unsigned char* lds, const Gemm g, const Sched& S, const Epi& E) {
    const int tid = threadIdx.x, wid = __builtin_amdgcn_readfirstlane(tid >> 6), lane = tid & 63, wr = wid >> 2, wc = wid & 3, fr = lane & 15, fq = lane >> 4;
    const int K = g.K, nt = K / BK;
    unsigned voffA[2], voffB[2];
#pragma unroll
    for (int i = 0; i < 2; ++i) { int R, C; stage_rc(tid * 16 + i * 8192, R, C); const int Rb = Epi::PERM ? ((R & ~31) + perm32(R & 31)) : R;
        voffA[i] = (unsigned)(R * K + C) * 2u; voffB[i] = (unsigned)(Rb * K + C) * 2u; }
    const size_t kstep = (size_t)(BK * 2);
    const size_t hstep = (size_t)HALF * K * 2;
    const size_t tstep = 2 * hstep;
    const unsigned ldsw = (unsigned)wid * 1024u;
    const int aoff = lds_byte(wr * 64 + fr, fq * 8), boff = lds_byte(wc * 32 + fr, fq * 8);
#define PG8_SA(b, h) (((b) * 2 + (h)) * HTB)
#define PG8_SB(b, h) ((4 + (b) * 2 + (h)) * HTB)
#define PG8_STAGE(bufoff, gbase, voff) do { _Pragma("unroll") for (int _i = 0; _i < 2; ++_i) \
        __builtin_amdgcn_global_load_lds((const unsigned*)((const char*)(gbase) + (voff)[_i]), (PG8_LAS unsigned*)(lds + (bufoff) + ldsw + _i * 8192), 16, 0, 0); } while (0)
#define PG8_LDA(dst, b, h) do { _Pragma("unroll") for (int m = 0; m < 4; ++m) _Pragma("unroll") for (int k = 0; k < 2; ++k) dst[m][k] = *(const PG8_LAS bf16x8*)(lds + PG8_SA(b, h) + aoff + m * 2048 + k * 1024); } while (0)
#define PG8_LDB(dst, b, h) do { _Pragma("unroll") for (int n = 0; n < 2; ++n) _Pragma("unroll") for (int k = 0; k < 2; ++k) dst[n][k] = *(const PG8_LAS bf16x8*)(lds + PG8_SB(b, h) + boff + n * 2048 + k * 1024); } while (0)
#define PG8_MMA(ai, bj, At, Bt) do { __builtin_amdgcn_s_setprio(1); _Pragma("unroll") for (int m = 0; m < 4; ++m) _Pragma("unroll") for (int n = 0; n < 2; ++n) _Pragma("unroll") for (int k = 0; k < 2; ++k) \
        acc[ai][bj][m][n] = __builtin_amdgcn_mfma_f32_16x16x32_bf16(Bt[n][k], At[m][k], acc[ai][bj][m][n], 0, 0, 0); __builtin_amdgcn_s_setprio(0); } while (0)
#define PG8_WAIT_V(n) asm volatile("s_waitcnt vmcnt(" #n ")" ::: "memory")
#define PG8_WAIT_L(n) asm volatile("s_waitcnt lgkmcnt(" #n ")" ::: "memory")
#define PG8_BAR __builtin_amdgcn_s_barrier()
#define PG8_SCHED __builtin_amdgcn_sched_barrier(0)
    Unit cur, nxt; int ui = 0;
    if (!S.next(0, cur)) return;
    f32x4 acc[2][2][4][2];
#pragma unroll
    for (int a = 0; a < 2; ++a)
#pragma unroll
        for (int b = 0; b < 2; ++b)
#pragma unroll
            for (int m = 0; m < 4; ++m)
#pragma unroll
                for (int n = 0; n < 2; ++n) acc[a][b][m][n] = (f32x4){0.f, 0.f, 0.f, 0.f};
    bf16x8 At[4][2], B0[2][2], B1[2][2];
    const char* cA = (const char*)g.A + (size_t)cur.pm * tstep; const char* cB = (const char*)g.Bt + (size_t)cur.pn * tstep;
    S.a_ready(cur);
    if constexpr (SP2) {
        PG8_STAGE(PG8_SB(0, 0), cB, voffB); PG8_STAGE(PG8_SB(0, 1), cB + hstep, voffB); PG8_STAGE(PG8_SA(0, 0), cA, voffA); PG8_STAGE(PG8_SA(0, 1), cA + hstep, voffA);
        if (wr == 1) PG8_BAR;
        PG8_WAIT_V(2); PG8_BAR;
        PG8_STAGE(PG8_SB(1, 0), cB + kstep, voffB); PG8_STAGE(PG8_SA(1, 0), cA + kstep, voffA); PG8_STAGE(PG8_SB(1, 1), cB + hstep + kstep, voffB);
        PG8_WAIT_V(6); PG8_BAR;
    } else {
        PG8_STAGE(PG8_SB(0, 0), cB, voffB); PG8_STAGE(PG8_SA(0, 0), cA, voffA); PG8_STAGE(PG8_SB(0, 1), cB + hstep, voffB); PG8_STAGE(PG8_SA(0, 1), cA + hstep, voffA);
        if (wr == 1) PG8_BAR;
        PG8_WAIT_V(4); PG8_BAR;
        PG8_STAGE(PG8_SB(1, 0), cB + kstep, voffB); PG8_STAGE(PG8_SA(1, 0), cA + kstep, voffA); PG8_STAGE(PG8_SB(1, 1), cB + hstep + kstep, voffB);
        PG8_WAIT_V(6); PG8_BAR;
    }
    for (;;) {
        const bool has_next = S.next(ui + 1, nxt);
        const char* nA = has_next ? (const char*)g.A + (size_t)nxt.pm * tstep : cA; const char* nB = has_next ? (const char*)g.Bt + (size_t)nxt.pn * tstep : cB;
        for (int t = 0; t < nt; t += 2) {
            const bool last = (t == nt - 2);
            const char* a1 = cA + (size_t)(t + 1) * kstep;
            const char* a2 = last ? nA : cA + (size_t)(t + 2) * kstep; const char* b2 = last ? nB : cB + (size_t)(t + 2) * kstep;
            const char* a3 = a2 + kstep; const char* b3 = b2 + kstep;
            if (last && has_next) S.a_ready(nxt);
            if constexpr (SP2) {
            PG8_LDB(B0, 0, 0); PG8_LDB(B1, 0, 1); PG8_SCHED; PG8_LDA(At, 0, 0); PG8_STAGE(PG8_SA(1, 1), a1 + hstep, voffA);
            PG8_WAIT_V(8); PG8_WAIT_L(0); PG8_BAR; PG8_MMA(0, 0, At, B0); PG8_MMA(0, 1, At, B1); PG8_BAR; PG8_SCHED;
            PG8_LDA(At, 0, 1); PG8_STAGE(PG8_SB(0, 0), b2, voffB); PG8_STAGE(PG8_SB(0, 1), b2 + hstep, voffB); PG8_STAGE(PG8_SA(0, 0), a2, voffA);
            PG8_WAIT_V(8); PG8_WAIT_L(0); PG8_BAR; PG8_MMA(1, 0, At, B0); PG8_MMA(1, 1, At, B1); PG8_BAR; PG8_SCHED;
            PG8_LDB(B0, 1, 0); PG8_LDB(B1, 1, 1); PG8_SCHED; PG8_LDA(At, 1, 0); PG8_STAGE(PG8_SA(0, 1), a2 + hstep, voffA);
            PG8_WAIT_V(8); PG8_WAIT_L(0); PG8_BAR; PG8_MMA(0, 0, At, B0); PG8_MMA(0, 1, At, B1); PG8_BAR; PG8_SCHED;
            PG8_LDA(At, 1, 1); PG8_STAGE(PG8_SB(1, 0), b3, voffB); PG8_STAGE(PG8_SB(1, 1), b3 + hstep, voffB); PG8_STAGE(PG8_SA(1, 0), a3, voffA);
            PG8_WAIT_V(8); PG8_WAIT_L(0); PG8_BAR; PG8_MMA(1, 0, At, B0); PG8_MMA(1, 1, At, B1); PG8_BAR; PG8_SCHED;
            } else {
            PG8_LDB(B0, 0, 0); PG8_SCHED; PG8_LDA(At, 0, 0); PG8_STAGE(PG8_SA(1, 1), a1 + hstep, voffA);
            PG8_WAIT_L(8); PG8_BAR; PG8_WAIT_L(0); PG8_MMA(0, 0, At, B0); PG8_BAR; PG8_SCHED;
            PG8_LDB(B1, 0, 1); PG8_STAGE(PG8_SB(0, 0), b2, voffB);
            PG8_BAR; PG8_WAIT_L(0); PG8_MMA(0, 1, At, B1); PG8_BAR;
            PG8_LDA(At, 0, 1); PG8_STAGE(PG8_SA(0, 0), a2, voffA);
            PG8_BAR; PG8_WAIT_L(0); PG8_MMA(1, 0, At, B0); PG8_BAR; PG8_SCHED;
            PG8_STAGE(PG8_SB(0, 1), b2 + hstep, voffB);
            PG8_WAIT_V(6); PG8_BAR; PG8_MMA(1, 1, At, B1); PG8_BAR;
            PG8_LDB(B0, 1, 0); PG8_SCHED; PG8_LDA(At, 1, 0); PG8_STAGE(PG8_SA(0, 1), a2 + hstep, voffA);
            PG8_WAIT_L(8); PG8_BAR; PG8_WAIT_L(0); PG8_MMA(0, 0, At, B0); PG8_BAR; PG8_SCHED;
            PG8_LDB(B1, 1, 1); PG8_STAGE(PG8_SB(1, 0), b3, voffB);
            PG8_BAR; PG8_WAIT_L(0); PG8_MMA(0, 1, At, B1); PG8_BAR;
            PG8_LDA(At, 1, 1); PG8_STAGE(PG8_SA(1, 0), a3, voffA);
            PG8_BAR; PG8_WAIT_L(0); PG8_MMA(1, 0, At, B0); PG8_BAR; PG8_SCHED;
            PG8_STAGE(PG8_SB(1, 1), b3 + hstep, voffB);
            PG8_WAIT_V(6); PG8_BAR; PG8_MMA(1, 1, At, B1); PG8_BAR;
            }
        }
        if constexpr (ALIGN_EPI) { if (wr == 0) PG8_BAR; }
        if constexpr (!Epi::AFTER_DRAIN) { E(acc, cur, wr, wc, fr, fq); S.done(cur); }
        if (!has_next) break;
#pragma unroll
        for (int a = 0; a < 2; ++a)
#pragma unroll
            for (int b = 0; b < 2; ++b)
#pragma unroll
                for (int m = 0; m < 4; ++m)
#pragma unroll
                    for (int n = 0; n < 2; ++n) acc[a][b][m][n] = (f32x4){0.f, 0.f, 0.f, 0.f};
        cur = nxt; cA = nA; cB = nB; ++ui;
        if constexpr (ALIGN_EPI) { if (wr == 1) PG8_BAR; }
    }
    PG8_WAIT_V(0);
    if constexpr (!ALIGN_EPI) { if (wr == 0) PG8_BAR; }
    PG8_BAR;
    if constexpr (Epi::AFTER_DRAIN) { E.fused(acc, cur, wr, wc, fr, fq, lds, wid, lane); S.done(cur); }
#undef PG8_SA
#undef PG8_SB
#undef PG8_STAGE
#undef PG8_LDA
#undef PG8_LDB
#undef PG8_MMA
#undef PG8_WAIT_V
#undef PG8_WAIT_L
#undef PG8_BAR
#undef PG8_SCHED
}
template <class Epi, class Sched, bool ALIGN_EPI = false, bool SP2 = false, int AUXA = 0>
__device__ __forceinline__ void gemm_phase_g(PG8_LAS unsigned char* lds, PG8_LAS unsigned char* gt, const Gemm g, const Sched& S, const Epi& E) {
    const int tid = threadIdx.x, wid = __builtin_amdgcn_readfirstlane(tid >> 6), lane = tid & 63, wr = wid >> 2, wc = wid & 3, fr = lane & 15, fq = lane >> 4;
    const int K = g.K, nt = K / BK;
    unsigned gpk[2], voffB[2];
#pragma unroll
    for (int i = 0; i < 2; ++i) { int R, C; stage_rc(tid * 16 + i * 8192, R, C); const int Rb = Epi::PERM ? ((R & ~31) + perm32(R & 31)) : R;
        gpk[i] = (unsigned)(R * 4) | ((unsigned)(C * 2) << 16); voffB[i] = (unsigned)(Rb * K + C) * 2u; }
    int par = 0;
    const size_t kstep = (size_t)(BK * 2);
    const size_t hstep = (size_t)HALF * K * 2;
    const size_t tstep = 2 * hstep;
    const unsigned ldsw = (unsigned)wid * 1024u;
    const int aoff = lds_byte(wr * 64 + fr, fq * 8), boff = lds_byte(wc * 32 + fr, fq * 8);
#define PG8_SA(b, h) (((b) * 2 + (h)) * HTB)
#define PG8_SB(b, h) ((4 + (b) * 2 + (h)) * HTB)
#define PG8_STAGE(bufoff, gbase, voff) do { _Pragma("unroll") for (int _i = 0; _i < 2; ++_i) \
        __builtin_amdgcn_global_load_lds((const unsigned*)((const char*)(gbase) + (voff)[_i]), (PG8_LAS unsigned*)(lds + (bufoff) + ldsw + _i * 8192), 16, 0, 0); } while (0)
#define PG8_STAGE_A(bufoff, h, kbyte, PAR) do { _Pragma("unroll") for (int _i = 0; _i < 2; ++_i) { \
        const unsigned _ro = *(const PG8_LAS unsigned*)(gt + ((PAR) * 768 + (h) * 128) * 4 + (gpk[_i] & 0xffffu)); \
        __builtin_amdgcn_global_load_lds((const unsigned*)((const char*)g.A + (size_t)(kbyte) + _ro + (gpk[_i] >> 16)), (PG8_LAS unsigned*)(lds + (bufoff) + ldsw + _i * 8192), 16, 0, AUXA); } } while (0)
#define PG8_FILL(u, PAR, PF, UI) do { S.wait_ready(u, tid, PF); if (tid < 256) { unsigned o_, a0_, a1_; S.finish_meta(u, tid, PF, o_, a0_, a1_); PG8_LAS unsigned* t_ = (PG8_LAS unsigned*)(gt + ((PAR) * 768 + tid) * 4); t_[0] = o_; t_[256] = a0_; t_[512] = a1_; } S.pull_publish(tid, PF, UI); asm volatile("s_waitcnt lgkmcnt(0)" ::: "memory"); __builtin_amdgcn_s_barrier(); asm volatile("" ::: "memory"); } while (0)
#define PG8_LDA(dst, b, h) do { _Pragma("unroll") for (int m = 0; m < 4; ++m) _Pragma("unroll") for (int k = 0; k < 2; ++k) dst[m][k] = *(const PG8_LAS bf16x8*)(lds + PG8_SA(b, h) + aoff + m * 2048 + k * 1024); } while (0)
#define PG8_LDB(dst, b, h) do { _Pragma("unroll") for (int n = 0; n < 2; ++n) _Pragma("unroll") for (int k = 0; k < 2; ++k) dst[n][k] = *(const PG8_LAS bf16x8*)(lds + PG8_SB(b, h) + boff + n * 2048 + k * 1024); } while (0)
#define PG8_MMA(ai, bj, At, Bt) do { __builtin_amdgcn_s_setprio(1); _Pragma("unroll") for (int m = 0; m < 4; ++m) _Pragma("unroll") for (int n = 0; n < 2; ++n) _Pragma("unroll") for (int k = 0; k < 2; ++k) \
        acc[ai][bj][m][n] = __builtin_amdgcn_mfma_f32_16x16x32_bf16(Bt[n][k], At[m][k], acc[ai][bj][m][n], 0, 0, 0); __builtin_amdgcn_s_setprio(0); } while (0)
#define PG8_WAIT_V(n) asm volatile("s_waitcnt vmcnt(" #n ")" ::: "memory")
#define PG8_WAIT_L(n) asm volatile("s_waitcnt lgkmcnt(" #n ")" ::: "memory")
#define PG8_BAR __builtin_amdgcn_s_barrier()
#define PG8_SCHED __builtin_amdgcn_sched_barrier(0)
    Unit cur, nxt; int ui = 0;
    if (!S.first(cur)) return;
    f32x4 acc[2][2][4][2];
#pragma unroll
    for (int a = 0; a < 2; ++a)
#pragma unroll
        for (int b = 0; b < 2; ++b)
#pragma unroll
            for (int m = 0; m < 4; ++m)
#pragma unroll
                for (int n = 0; n < 2; ++n) acc[a][b][m][n] = (f32x4){0.f, 0.f, 0.f, 0.f};
    bf16x8 At[4][2], B0[2][2], B1[2][2];
    const char* cB = (const char*)g.Bt + (size_t)cur.pn * tstep;
    typename Sched::Pf pf; S.prefetch(cur, tid, pf); PG8_FILL(cur, 0, pf, -1);
    Unit pend; bool has_pend = false;
    if constexpr (SP2) {
        PG8_STAGE(PG8_SB(0, 0), cB, voffB); PG8_STAGE(PG8_SB(0, 1), cB + hstep, voffB); PG8_STAGE_A(PG8_SA(0, 0), 0, 0, par); PG8_STAGE_A(PG8_SA(0, 1), 1, 0, par);
        if (wr == 1) PG8_BAR;
        PG8_WAIT_V(2); PG8_BAR;
        PG8_STAGE(PG8_SB(1, 0), cB + kstep, voffB); PG8_STAGE_A(PG8_SA(1, 0), 0, kstep, par); PG8_STAGE(PG8_SB(1, 1), cB + hstep + kstep, voffB);
        PG8_WAIT_V(6); PG8_BAR;
    } else {
        PG8_STAGE(PG8_SB(0, 0), cB, voffB); PG8_STAGE_A(PG8_SA(0, 0), 0, 0, par); PG8_STAGE(PG8_SB(0, 1), cB + hstep, voffB); PG8_STAGE_A(PG8_SA(0, 1), 1, 0, par);
        if (wr == 1) PG8_BAR;
        PG8_WAIT_V(4); PG8_BAR;
        PG8_STAGE(PG8_SB(1, 0), cB + kstep, voffB); PG8_STAGE_A(PG8_SA(1, 0), 0, kstep, par); PG8_STAGE(PG8_SB(1, 1), cB + hstep + kstep, voffB);
        PG8_WAIT_V(6); PG8_BAR;
    }
    for (;;) {
        const bool has_next = S.more(ui + 1, nxt);
        if (has_next) { S.prefetch(nxt, tid, pf); S.pull_issue(tid, pf); }
        const char* nB = has_next ? (const char*)g.Bt + (size_t)nxt.pn * tstep : cB;
        for (int t = 0; t < nt; t += 2) {
            const bool last = (t == nt - 2);
            const char* b2 = last ? nB : cB + (size_t)(t + 2) * kstep;
            const char* b3 = b2 + kstep;
            if (last && has_next) PG8_FILL(nxt, par ^ 1, pf, ui);
            const size_t kA2 = last ? (size_t)0 : (size_t)(t + 2) * kstep; const int pA2 = (last && has_next) ? (par ^ 1) : par;
            if constexpr (SP2) {
            PG8_LDB(B0, 0, 0); PG8_LDB(B1, 0, 1); PG8_SCHED; PG8_LDA(At, 0, 0); PG8_STAGE_A(PG8_SA(1, 1), 1, (size_t)(t + 1) * kstep, par);
            PG8_WAIT_V(8); PG8_WAIT_L(0); PG8_BAR; PG8_MMA(0, 0, At, B0); PG8_MMA(0, 1, At, B1); PG8_BAR; PG8_SCHED;
            PG8_LDA(At, 0, 1); PG8_STAGE(PG8_SB(0, 0), b2, voffB); PG8_STAGE(PG8_SB(0, 1), b2 + hstep, voffB); PG8_STAGE_A(PG8_SA(0, 0), 0, kA2, pA2);
            PG8_WAIT_V(8); PG8_WAIT_L(0); PG8_BAR; PG8_MMA(1, 0, At, B0); PG8_MMA(1, 1, At, B1); PG8_BAR; PG8_SCHED;
            PG8_LDB(B0, 1, 0); PG8_LDB(B1, 1, 1); PG8_SCHED; PG8_LDA(At, 1, 0); PG8_STAGE_A(PG8_SA(0, 1), 1, kA2, pA2);
            PG8_WAIT_V(8); PG8_WAIT_L(0); PG8_BAR; PG8_MMA(0, 0, At, B0); PG8_MMA(0, 1, At, B1); PG8_BAR; PG8_SCHED;
            PG8_LDA(At, 1, 1); PG8_STAGE(PG8_SB(1, 0), b3, voffB); PG8_STAGE(PG8_SB(1, 1), b3 + hstep, voffB); PG8_STAGE_A(PG8_SA(1, 0), 0, kA2 + kstep, pA2);
            PG8_WAIT_V(8); PG8_WAIT_L(0); PG8_BAR; PG8_MMA(1, 0, At, B0); PG8_MMA(1, 1, At, B1); PG8_BAR; PG8_SCHED;
            } else {
            PG8_LDB(B0, 0, 0); PG8_SCHED; PG8_LDA(At, 0, 0); PG8_STAGE_A(PG8_SA(1, 1), 1, (size_t)(t + 1) * kstep, par);
            PG8_WAIT_L(8); PG8_BAR; PG8_WAIT_L(0); PG8_MMA(0, 0, At, B0); PG8_BAR; PG8_SCHED;
            PG8_LDB(B1, 0, 1); PG8_STAGE(PG8_SB(0, 0), b2, voffB);
            PG8_BAR; PG8_WAIT_L(0); PG8_MMA(0, 1, At, B1); PG8_BAR;
            PG8_LDA(At, 0, 1); PG8_STAGE_A(PG8_SA(0, 0), 0, kA2, pA2);
            PG8_BAR; PG8_WAIT_L(0); PG8_MMA(1, 0, At, B0); PG8_BAR; PG8_SCHED;
            PG8_STAGE(PG8_SB(0, 1), b2 + hstep, voffB);
            PG8_WAIT_V(6); PG8_BAR; PG8_MMA(1, 1, At, B1); PG8_BAR;
            PG8_LDB(B0, 1, 0); PG8_SCHED; PG8_LDA(At, 1, 0); PG8_STAGE_A(PG8_SA(0, 1), 1, kA2, pA2);
            PG8_WAIT_L(8); PG8_BAR; PG8_WAIT_L(0); PG8_MMA(0, 0, At, B0); PG8_BAR; PG8_SCHED;
            PG8_LDB(B1, 1, 1); PG8_STAGE(PG8_SB(1, 0), b3, voffB);
            PG8_BAR; PG8_WAIT_L(0); PG8_MMA(0, 1, At, B1); PG8_BAR;
            PG8_LDA(At, 1, 1); PG8_STAGE_A(PG8_SA(1, 0), 0, kA2 + kstep, pA2);
            PG8_BAR; PG8_WAIT_L(0); PG8_MMA(1, 0, At, B0); PG8_BAR; PG8_SCHED;
            PG8_STAGE(PG8_SB(1, 1), b3 + hstep, voffB);
            PG8_WAIT_V(6); PG8_BAR; PG8_MMA(1, 1, At, B1); PG8_BAR;
            }
        }
        if constexpr (ALIGN_EPI) { if (wr == 0) PG8_BAR; }
        if constexpr (!Epi::AFTER_DRAIN) { if (has_pend) S.done_nowait(pend);     E(acc, cur, wr, wc, fr, fq, (const PG8_LAS unsigned*)(gt + par * 3072)); pend = cur; has_pend = true; }
        if (!has_next) break;
#pragma unroll
        for (int a = 0; a < 2; ++a)
#pragma unroll
            for (int b = 0; b < 2; ++b)
#pragma unroll
                for (int m = 0; m < 4; ++m)
#pragma unroll
                    for (int n = 0; n < 2; ++n) acc[a][b][m][n] = (f32x4){0.f, 0.f, 0.f, 0.f};
        cur = nxt; cB = nB; ++ui; par ^= 1;
        if constexpr (ALIGN_EPI) { if (wr == 1) PG8_BAR; }
    }
    PG8_WAIT_V(0);
    if constexpr (!ALIGN_EPI) { if (wr == 0) PG8_BAR; }
    PG8_BAR;
    if (has_pend) S.done_nowait(pend);
#undef PG8_SA
#undef PG8_SB
#undef PG8_STAGE
#undef PG8_STAGE_A
#undef PG8_FILL
#undef PG8_LDA
#undef PG8_LDB
#undef PG8_MMA
#undef PG8_WAIT_V
#undef PG8_WAIT_L
#undef PG8_BAR
#undef PG8_SCHED
}
}

#ifndef PG8_SP2
#define PG8_SP2 true
#endif
#ifndef PG8_ALIGN
#define PG8_ALIGN true
#endif
#ifndef MK_ONE_LAUNCH
#define MK_ONE_LAUNCH 1
#endif

constexpr int NWAVES = 8, NTHR = 512;
constexpr int BATCH = 8, T = 4096, D = 1024, M = BATCH * T, DEPTH = 2;
constexpr int PROJW = 2304, AW = 256, BW = 512, CW = 256, NH = 8, HD = 64;
constexpr int COL_U = 0, COL_V = 256, COL_Q = 512, COL_K = 1024, COL_VA = 1536, COL_S = 2048;
constexpr int NEXP = 16, DEXP = 512, NGRP = 4;
constexpr int SSM_G = 16, SSM_N = 64, SSM_C = 16;
constexpr float LN_EPS = 1e-5f;
constexpr float ALPHA = 1.41421356237309515f;
constexpr float QSCALE = 0.125f * 1.4426950408889634f;
constexpr int NSLOT_MAX = 2 * M + NEXP * 256;

constexpr size_t MiB = 1u << 20;
constexpr size_t WS_CTL = 0, CTL_ZERO_BYTES = 1 * MiB;
constexpr size_t WS_MOD = 1 * MiB;
constexpr size_t WS_ROPE = WS_MOD + 512 * 1024;
constexpr size_t WS_SSM = WS_ROPE + 2 * MiB;
constexpr int SSM_TAB = 2 * 1024 + 2 * 16384;
constexpr int SLOT_CAP = 32768;
constexpr size_t WS_SLOT_A = 4 * MiB;
constexpr size_t WS_WSMALL = 6 * MiB;
constexpr size_t WSMALL_LAYER = 7 * MiB, WOFF_IN = 0, WOFF_OUT = (size_t)PROJW * D * 2, WOFF_GLU = WOFF_OUT + (size_t)D * D * 2;
constexpr size_t WS_WGU = 20 * MiB;
constexpr size_t WS_WD = 52 * MiB;
constexpr size_t WS_XN = 68 * MiB;
constexpr size_t WS_YG = 132 * MiB;
constexpr size_t WS_R = 148 * MiB;
constexpr size_t WS_PROJ = WS_R, WS_MIXCAT = WS_R + 144 * MiB, WS_PRE = WS_R, WS_HID = WS_R + 64 * MiB, WS_X1 = WS_R + 132 * MiB;
constexpr size_t WS_ROWS2 = 356 * MiB;
constexpr size_t WS_STAT = 356 * MiB + (size_t)2 * M * D * 2;
constexpr size_t WS_SSM2 = WS_STAT + 4 * MiB;
constexpr size_t SSM2_LAYER = 3 * MiB, S2_APW = 0, S2_KT = 288 * 1024, S2_CT = S2_KT + 256 * 1024, S2_WIN = S2_CT + 64 * 1024, S2_GW = S2_WIN + 2 * MiB;
static_assert(S2_GW + 4 * 128 * 128 * 2 <= SSM2_LAYER, "ssm2 tables");
constexpr size_t WS_XLOC = WS_SSM2 + 2 * SSM2_LAYER;
constexpr size_t WS_XSUP = WS_XLOC + 8 * MiB;
constexpr size_t WS_SLOT_W = WS_XSUP + 512 * 1024;
constexpr size_t WS_END = WS_SLOT_W + 2 * MiB;
static_assert(WOFF_GLU + 256 * 256 * 2 <= WSMALL_LAYER && WS_WSMALL + 2 * WSMALL_LAYER <= WS_WGU, "ws map");
static_assert(WS_SSM + 2 * SSM_TAB * 4 <= WS_SLOT_A && WS_HID + (size_t)NSLOT_MAX * DEXP * 2 <= WS_X1 && WS_X1 + (size_t)M * D * 2 <= WS_ROWS2, "ws map 2");
constexpr int CW_TMO = 0;
constexpr int CW_BAR = 4096;
constexpr int CW_CNT = 8192;
constexpr int CW_QUEUE = 11264;
constexpr int CW_DONE = 12288;

constexpr int RING_OFF = 0, RING_BYTES = 131072;
constexpr int ATT_STAGE_OFF = 98304;
constexpr int LDSCTL_OFF = 135168, MISC_OFF = LDSCTL_OFF + 320;
constexpr int GT_OFF = LDSCTL_OFF + 1024;
constexpr int LDS_BYTES = 147456;

#define GAS __attribute__((address_space(1)))
#define LAS __attribute__((address_space(3)))
#define DI __device__ __forceinline__
typedef unsigned short bf16;
typedef unsigned v4u __attribute__((ext_vector_type(4)));
typedef unsigned v2u __attribute__((ext_vector_type(2)));
typedef float f32x4 __attribute__((ext_vector_type(4)));
typedef short bf16x8 __attribute__((ext_vector_type(8)));
typedef GAS unsigned gu32;
#define RLX_AGENT __ATOMIC_RELAXED, __HIP_MEMORY_SCOPE_AGENT
#define LDS_WAIT() asm volatile("s_waitcnt lgkmcnt(0)" ::: "memory")
#define VM_WAIT() asm volatile("s_waitcnt vmcnt(0)" ::: "memory")
DI unsigned f2bf(float f) { unsigned u = __builtin_bit_cast(unsigned, f); return (u + 0x7fffu + ((u >> 16) & 1u)) >> 16; }
DI unsigned pk2(float lo, float hi) { return f2bf(lo) | (f2bf(hi) << 16); }
DI float bflo(unsigned w) { return __uint_as_float(w << 16); }
DI float bfhi(unsigned w) { return __uint_as_float(w & 0xffff0000u); }
DI float bf2f(bf16 h) { return __uint_as_float((unsigned)h << 16); }
template <int CTRL> DI float dpp_mov(float v) { return __builtin_bit_cast(float, __builtin_amdgcn_update_dpp(0, __builtin_bit_cast(int, v), CTRL, 0xf, 0xf, true)); }
DI float rdlane(float v, int l) { return __builtin_bit_cast(float, __builtin_amdgcn_readlane(__builtin_bit_cast(int, v), l)); }
DI float wave_sum(float v) {
    v += dpp_mov<0xB1>(v); v += dpp_mov<0x4E>(v); v += dpp_mov<0x141>(v); v += dpp_mov<0x140>(v);
    return (rdlane(v, 0) + rdlane(v, 16)) + (rdlane(v, 32) + rdlane(v, 48));
}
DI void st16_wt(void* p, v4u v) { asm volatile("global_store_dwordx4 %0, %1, off sc1\n\ts_nop 1" :: "v"(p), "v"(v) : "memory"); }
DI float fast_rcp(float x) { return __builtin_amdgcn_rcpf(x); }
DI float sigmoid_f(float x) { return fast_rcp(1.0f + __builtin_amdgcn_exp2f(-1.4426950408889634f * x)); }
DI float silu_f(float x) { return x * sigmoid_f(x); }
DI float gelu_tanh_f(float x) { const float z2 = 1.5957691216057308f * (x + 0.044715f * x * x * x); return x * sigmoid_f(z2); }

#define XB_TMO      128
#define XB_XCNT(j)  (256  + 64 * (j))
#define XB_XSUB(j)  (1280 + 64 * (j))
#define XB_XGEN(j)  (2304 + 64 * (j))
#define XB_TOP      3328
#define XB_TOPGEN   3392
#define XCD_BAR_WORDS 3456
#define XB_SPIN_CAP (1u << 22)
DI unsigned xb_ld(unsigned* p)              { return __hip_atomic_load(p, __ATOMIC_RELAXED, __HIP_MEMORY_SCOPE_AGENT); }
DI unsigned xb_add(unsigned* p, unsigned v) { return __hip_atomic_fetch_add(p, v, __ATOMIC_RELAXED, __HIP_MEMORY_SCOPE_AGENT); }
DI unsigned xb_xcc_id() { return (unsigned)__builtin_amdgcn_s_getreg((3 << 11) | 20) & 0xFu; }
#define XB_SPIN(cond, bar) do { unsigned _sp = 0; while (cond) { __builtin_amdgcn_s_sleep(1); \
    if ((++_sp & 255u) == 0u) { if (xb_ld(&(bar)[XB_TMO])) break; if (_sp > XB_SPIN_CAP) { atomicAdd(&(bar)[XB_TMO], 1u); break; } } } } while (0)
struct XcdBarrier { unsigned* bar; unsigned x; volatile LAS unsigned* st; };
DI XcdBarrier xcd_barrier_post(unsigned* bar, volatile LAS unsigned* st) {
    XcdBarrier b; b.bar = bar; b.x = xb_xcc_id(); b.st = st;
    if (threadIdx.x == 0) (void)xb_add(&bar[XB_XCNT(b.x)], 1u);
    return b;
}
DI void xcd_barrier_complete(unsigned* bar, unsigned x, unsigned& nloc, unsigned& nx) {
    const unsigned G = gridDim.x * gridDim.y * gridDim.z;
    unsigned sum, cnt, mine, sp = 0u;
    for (;;) {
        sum = 0u; cnt = 0u; mine = 0u;
#pragma unroll
        for (unsigned j = 0; j < 16; ++j) { const unsigned c = xb_ld(&bar[XB_XCNT(j)]); sum += c; cnt += (c > 0u) ? 1u : 0u; mine = (j == x) ? c : mine; }
        if (sum == G) break;
        __builtin_amdgcn_s_sleep(1);
        if ((++sp & 255u) == 0u) { if (xb_ld(&bar[XB_TMO])) break; if (sp > XB_SPIN_CAP) { atomicAdd(&bar[XB_TMO], 1u); break; } }
    }
    nloc = mine > 0u ? mine : 1u; nx = cnt > 0u ? cnt : 1u;
}
DI void xcd_barrier(const XcdBarrier& b) {
    asm volatile("s_waitcnt vmcnt(0)" ::: "memory");
    __syncthreads();
    if (threadIdx.x == 0) {
        unsigned* bar = b.bar;
        __builtin_amdgcn_s_waitcnt(0);
        unsigned nloc = b.st[0], nx = b.st[1];
        if (nloc == 0u) { xcd_barrier_complete(bar, b.x, nloc, nx); b.st[0] = nloc; b.st[1] = nx; }
        const unsigned old = xb_add(&bar[XB_XSUB(b.x)], 1u);
        const unsigned gen = old / nloc;
        if (old + 1u == (gen + 1u) * nloc) {
            __builtin_amdgcn_fence(__ATOMIC_RELEASE, "agent");
            asm volatile("s_waitcnt vmcnt(0)" ::: "memory");
            const unsigned og = xb_add(&bar[XB_TOP], 1u);
            const unsigned tg = og / nx;
            if (og + 1u == (tg + 1u) * nx) xb_add(&bar[XB_TOPGEN], 1u);
            else XB_SPIN(xb_ld(&bar[XB_TOPGEN]) == tg, bar);
            __builtin_amdgcn_fence(__ATOMIC_ACQUIRE, "agent");
            xb_add(&bar[XB_XGEN(b.x)], 1u);
            asm volatile("s_waitcnt vmcnt(0)" ::: "memory");
        } else {
            XB_SPIN(xb_ld(&bar[XB_XGEN(b.x)]) == gen, bar);
            __builtin_amdgcn_fence(__ATOMIC_ACQUIRE, "agent");
            asm volatile("s_waitcnt vmcnt(0)" ::: "memory");
        }
    }
    __syncthreads();
}

struct Args { const void* in[30]; float* out; unsigned char* ws; int ph_lo, ph_hi, li, pad; };
enum { I_X = 0, I_C, I_POS, I_ADAW, I_ADAB, I_WIN, I_GMLNG, I_GMLNB, I_GMWS, I_GMBS, I_LAMRE, I_LAMIM, I_LOGDT, I_BRE, I_BIM, I_CRE, I_CIM, I_SSMD,
       I_GLUW, I_GLUB, I_WOUT, I_LN1G, I_LN1B, I_RW, I_RB, I_EWG, I_EWU, I_EWD, I_LN2G, I_LN2B };
struct Frame {
    LAS unsigned char* lds;
    volatile LAS unsigned* MISC;
    gu32* ctl;
    unsigned char* ws;
    int vcu, G;
};
DI int ftid() { int t = threadIdx.x; asm volatile("" : "+v"(t)); return t; }
#define FRAME_IDS const int tid_ = ftid(), lane_ = tid_ & 63, wave_ = __builtin_amdgcn_readfirstlane(tid_ >> 6); (void)lane_; (void)wave_;

template <class RowMap>
DI void transpose_item(const float* W, int K, int N, bf16* WT, const RowMap& rm, LAS float* scr, int item, int lane) {
    const int nblk = N / 32, kb = item / nblk, nb = item % nblk, k0 = 64 * kb, n0 = 32 * nb;
#pragma unroll 8
    for (int i = 0; i < 32; ++i) { const int kk = 2 * i + (lane >> 5); scr[kk * 33 + (lane & 31)] = W[(size_t)(k0 + kk) * N + n0 + (lane & 31)]; }
    LDS_WAIT(); asm volatile("" ::: "memory");
    const int c = lane & 7;
#pragma unroll
    for (int j = 0; j < 4; ++j) { const int n = (lane >> 3) + 8 * j; const LAS float* s = scr + (8 * c) * 33 + n;
        v4u o; o.x = pk2(s[0 * 33], s[1 * 33]); o.y = pk2(s[2 * 33], s[3 * 33]); o.z = pk2(s[4 * 33], s[5 * 33]); o.w = pk2(s[6 * 33], s[7 * 33]);
        *(GAS v4u*)(WT + (size_t)rm(n0 + n) * K + k0 + 8 * c) = o; }
    LDS_WAIT(); asm volatile("" ::: "memory");
}
struct RmIdent { int off; DI int operator()(int n) const { return off + n; } };
struct RmWin { DI int operator()(int n) const {
        if (n >= COL_Q && n < COL_VA) { const int d = n & 63; if (d < 16) return (n - d) + 2 * (d & 7) + (d >> 3); }
        return n; } };
struct RmGU { int e, up; DI int operator()(int n) const { return e * 1024 + (n >> 7) * 256 + (n & 127) + up * 128; } };

DI void p0_tables(Frame& F, const Args& A) {
    FRAME_IDS
    const float* c = (const float*)A.in[I_C];
    LAS float* condS = (LAS float*)(F.lds + RING_OFF);
    LAS float* red = (LAS float*)(F.lds + RING_OFF + 32768);
    for (int i = tid_; i < BATCH * D; i += NTHR) condS[i] = silu_f(c[i]);
    __syncthreads();
    float* mod = (float*)(F.ws + WS_MOD);
    for (int it = F.vcu; it < DEPTH * 96; it += F.G) {
        const int l = it / 96, jb = it % 96, ks = tid_ >> 6, jj = tid_ & 63, j = jb * 64 + jj;
        const float* w = (const float*)A.in[I_ADAW] + (size_t)l * D * 6 * D + j;
        float acc[8];
#pragma unroll
        for (int b = 0; b < 8; ++b) acc[b] = 0.f;
#pragma unroll 16
        for (int k = ks * 128; k < ks * 128 + 128; ++k) { const float wv = w[(size_t)k * (6 * D)];
#pragma unroll
            for (int b = 0; b < 8; ++b) acc[b] += condS[b * D + k] * wv; }
#pragma unroll
        for (int b = 0; b < 8; ++b) red[(ks * 8 + b) * 64 + jj] = acc[b];
        __syncthreads();
        { const int b = tid_ >> 6; float s = ((const float*)A.in[I_ADAB])[l * 6 * D + j];
#pragma unroll
          for (int k2 = 0; k2 < 8; ++k2) s += red[(k2 * 8 + b) * 64 + jj];
          mod[((size_t)l * BATCH + b) * 6 * D + j] = s; }
        __syncthreads();
    }
    const int gt = F.vcu * NTHR + tid_, NGT = F.G * NTHR;
    const int* pos = (const int*)A.in[I_POS]; float* rope = (float*)(F.ws + WS_ROPE);
    for (int w = gt; w < M * 8; w += NGT) { const int m = w >> 3, i = w & 7;
        const float freq = exp2f(-(float)i * 0.125f * 18.931568569324174f);
        const float ang = (float)pos[m] * freq; float s, cs; sincosf(ang, &s, &cs);
        rope[m * 16 + i] = cs; rope[m * 16 + 8 + i] = s; }
    for (int w = gt; w < DEPTH * 16 * 33 * 64; w += NGT) { const int n = w & 63, m = (w >> 6) % 33, g = ((w >> 6) / 33) & 15, l = (w >> 6) / (33 * 16);
        const int li = (l * 16 + g) * 64 + n;
        const float lre = ((const float*)A.in[I_LAMRE])[li], lim = ((const float*)A.in[I_LAMIM])[li], dt = expf(((const float*)A.in[I_LOGDT])[l * 16 + g]);
        const float mag = expf((float)m * (lre * dt)); float sn, cs; sincosf((float)m * (lim * dt), &sn, &cs);
        float* apw = (float*)(F.ws + WS_SSM2 + l * SSM2_LAYER + S2_APW) + ((size_t)(g * 33 + m) * 64 + n) * 2; apw[0] = mag * cs; apw[1] = mag * sn; }
    for (int w = gt; w < DEPTH * SSM_G * SSM_N; w += NGT) { const int l = w / 1024, gn = w % 1024, g = gn >> 6;
        float* tab = (float*)(F.ws + WS_SSM) + (size_t)l * SSM_TAB;
        const float lre = ((const float*)A.in[I_LAMRE])[w], lim = ((const float*)A.in[I_LAMIM])[w];
        const float dt = expf(((const float*)A.in[I_LOGDT])[l * 16 + g]);
        const float mag = expf(lre * dt); float sn, cs; sincosf(lim * dt, &sn, &cs);
        const float are = mag * cs, aim = mag * sn, nr = are - 1.0f, ni = aim, mod2 = lre * lre + lim * lim;
        const float fre = (nr * lre + ni * lim) / mod2, fim = (ni * lre - nr * lim) / mod2;
        tab[gn] = are; tab[1024 + gn] = aim;
        const float* bre = (const float*)A.in[I_BRE] + (size_t)w * 16; const float* bim = (const float*)A.in[I_BIM] + (size_t)w * 16;
#pragma unroll
        for (int cc = 0; cc < 16; ++cc) { tab[2048 + gn * 16 + cc] = fre * bre[cc] - fim * bim[cc]; tab[2048 + 16384 + gn * 16 + cc] = fre * bim[cc] + fim * bre[cc]; } }
}

constexpr int WCONV_SPLIT = 16 * 72 + 16 * 32 + 4 * 8 + 8900;
DI void p_wconv(Frame& F, const Args& A, int l, int part) {
    FRAME_IDS
    if (part == 0) {
        const int gt = F.vcu * NTHR + tid_, NGT = F.G * NTHR;
        const float* tab = (const float*)(F.ws + WS_SSM) + (size_t)l * SSM_TAB;
        const float* apw = (const float*)(F.ws + WS_SSM2 + l * SSM2_LAYER + S2_APW);
        const float* cre = (const float*)A.in[I_CRE] + (size_t)l * 16 * 16 * 64; const float* cim = (const float*)A.in[I_CIM] + (size_t)l * 16 * 16 * 64;
        bf16* KT = (bf16*)(F.ws + WS_SSM2 + l * SSM2_LAYER + S2_KT); bf16* CT = (bf16*)(F.ws + WS_SSM2 + l * SSM2_LAYER + S2_CT);
        bf16* WIN = (bf16*)(F.ws + WS_SSM2 + l * SSM2_LAYER + S2_WIN); bf16* GW = (bf16*)(F.ws + WS_SSM2 + l * SSM2_LAYER + S2_GW);
        for (int w = gt; w < 16 * 16 * 64 * 8; w += NGT) { const int j = w & 7, ln = (w >> 3) & 63, p = (w >> 9) & 15, g = w >> 13;
            const int co = ln & 15, q = ln >> 4, m = 2 * p + (q >> 1), ci = 8 * (q & 1) + j; float acc = 0.f;
            for (int n = 0; n < 64; ++n) { const int gn = g * 64 + n; const float ar = apw[((g * 33 + m) * 64 + n) * 2], ai = apw[((g * 33 + m) * 64 + n) * 2 + 1];
                const float br = tab[2048 + gn * 16 + ci], bi = tab[2048 + 16384 + gn * 16 + ci], tre = ar * br - ai * bi, tim = ar * bi + ai * br;
                acc += cre[(g * 16 + co) * 64 + n] * tre - cim[(g * 16 + co) * 64 + n] * tim; }
            KT[w] = (bf16)f2bf(acc); }
        for (int w = gt; w < 16 * 4 * 64 * 8; w += NGT) { const int j = w & 7, ln = (w >> 3) & 63, sx = (w >> 9) & 3, g = w >> 11;
            const int co = ln & 15, q = ln >> 4, n = 16 * sx + 4 * q + (j >> 1);
            CT[w] = (bf16)f2bf((j & 1) ? -cim[(g * 16 + co) * 64 + n] : cre[(g * 16 + co) * 64 + n]); }
        for (int w = gt; w < 16 * 16 * 8 * 64 * 8; w += NGT) { const int jj = w & 7, ln = (w >> 3) & 63, ct = (w >> 9) & 7, sp = (w >> 12) & 15, g = w >> 16;
            const int cc = ln & 15, q = ln >> 4, n = 8 * ct + (cc >> 1), part = cc & 1, tj = 2 * sp + (q >> 1), ci = 8 * (q & 1) + jj, gn = g * 64 + n, m = 31 - tj;
            const float ar = apw[((g * 33 + m) * 64 + n) * 2], ai = apw[((g * 33 + m) * 64 + n) * 2 + 1], br = tab[2048 + gn * 16 + ci], bi = tab[2048 + 16384 + gn * 16 + ci];
            WIN[w] = (bf16)f2bf(part ? (ar * bi + ai * br) : (ar * br - ai * bi)); }
        const float* gws = (const float*)A.in[I_GMWS] + (size_t)l * 4 * 128 * 128;
        for (int w = gt; w < 4 * 128 * 128; w += NGT) { const int sx = w & 127, t = (w >> 7) & 127; GW[w] = (bf16)f2bf(sx <= t ? gws[w] : 0.f); }
    }
    LAS float* scr = (LAS float*)(F.lds + RING_OFF + wave_ * 16384);
    const int gw = (part == 0) ? F.vcu * NWAVES + wave_ : WCONV_SPLIT + ((int)blockIdx.x - 128) * NWAVES + wave_, NGW = (part == 0) ? F.G * NWAVES : 128 * NWAVES;
    bf16* WinT = (bf16*)(F.ws + WS_WSMALL + l * WSMALL_LAYER + WOFF_IN);
    bf16* WoutT = (bf16*)(F.ws + WS_WSMALL + l * WSMALL_LAYER + WOFF_OUT);
    bf16* GluT = (bf16*)(F.ws + WS_WSMALL + l * WSMALL_LAYER + WOFF_GLU);
    bf16* WguT = (bf16*)(F.ws + WS_WGU); bf16* WdT = (bf16*)(F.ws + WS_WD);
    constexpr int I_IN = 16 * 72, I_OUTW = 16 * 32, I_GLU = 4 * 8, I_G = 16 * 16, I_DN = 8 * 32;
    constexpr int NIT = I_IN + I_OUTW + I_GLU + 16 * (2 * I_G + I_DN);
    const int split = (F.G == 256) ? WCONV_SPLIT : NIT;
    for (int it = gw; it < ((part == 0) ? split : NIT); it += NGW) {
        int r = it;
        if (r < I_IN) { transpose_item((const float*)A.in[I_WIN] + (size_t)l * D * PROJW, D, PROJW, WinT, RmWin{}, scr, r, lane_); continue; } r -= I_IN;
        if (r < I_OUTW) { transpose_item((const float*)A.in[I_WOUT] + (size_t)l * D * D, D, D, WoutT, RmIdent{0}, scr, r, lane_); continue; } r -= I_OUTW;
        if (r < I_GLU) { transpose_item((const float*)A.in[I_GLUW] + (size_t)l * 256 * 256, 256, 256, GluT, RmIdent{0}, scr, r, lane_); continue; } r -= I_GLU;
        const int e = r / (2 * I_G + I_DN); r -= e * (2 * I_G + I_DN);
        const size_t eo = ((size_t)l * NEXP + e) * D * DEXP;
        if (r < I_G) { transpose_item((const float*)A.in[I_EWG] + eo, D, DEXP, WguT, RmGU{e, 0}, scr, r, lane_); continue; } r -= I_G;
        if (r < I_G) { transpose_item((const float*)A.in[I_EWU] + eo, D, DEXP, WguT, RmGU{e, 1}, scr, r, lane_); continue; } r -= I_G;
        transpose_item((const float*)A.in[I_EWD] + eo, DEXP, D, WdT, RmIdent{e * 1024}, scr, r, lane_);
    }
}

typedef float f32x2_t __attribute__((ext_vector_type(2)));
typedef __bf16 bf16x2_t __attribute__((ext_vector_type(2)));
DI unsigned cvtpk(float lo, float hi) { f32x2_t v = {lo, hi}; bf16x2_t b = __builtin_convertvector(v, bf16x2_t); return __builtin_bit_cast(unsigned, b); }
struct Row16 { float v[16]; };
DI void row_load_f32(Row16& r, const float* p, int lane) {
    const f32x4* q = (const f32x4*)p;
#pragma unroll
    for (int k = 0; k < 4; ++k) { const f32x4 a = q[k * 64 + lane]; r.v[4 * k] = a.x; r.v[4 * k + 1] = a.y; r.v[4 * k + 2] = a.z; r.v[4 * k + 3] = a.w; }
}
DI void row_load_bf16(Row16& r, const bf16* p, int lane) {
    const v2u* q = (const v2u*)p;
#pragma unroll
    for (int k = 0; k < 4; ++k) { const v2u a = q[k * 64 + lane]; r.v[4 * k] = bflo(a.x); r.v[4 * k + 1] = bfhi(a.x); r.v[4 * k + 2] = bflo(a.y); r.v[4 * k + 3] = bfhi(a.y); }
}
DI void row_store_bf16(const Row16& r, bf16* p, int lane) {
    v2u* q = (v2u*)p;
#pragma unroll
    for (int k = 0; k < 4; ++k) { v2u o; o.x = cvtpk(r.v[4 * k], r.v[4 * k + 1]); o.y = cvtpk(r.v[4 * k + 2], r.v[4 * k + 3]); q[k * 64 + lane] = o; }
}
DI void row_store_f32(const Row16& r, float* p, int lane) {
    f32x4* q = (f32x4*)p;
#pragma unroll
    for (int k = 0; k < 4; ++k) q[k * 64 + lane] = (f32x4){r.v[4 * k], r.v[4 * k + 1], r.v[4 * k + 2], r.v[4 * k + 3]};
}
DI void row_ln(Row16& r) {
    float s = 0.f;
#pragma unroll
    for (int i = 0; i < 16; ++i) s += r.v[i];
    const float mean = wave_sum(s) * (1.f / D); float s2 = 0.f;
#pragma unroll
    for (int i = 0; i < 16; ++i) { r.v[i] -= mean; s2 += r.v[i] * r.v[i]; }
    const float rstd = 1.0f / sqrtf(wave_sum(s2) * (1.f / D) + LN_EPS);
#pragma unroll
    for (int i = 0; i < 16; ++i) r.v[i] *= rstd;
}
DI void row_mod(Row16& r, const float* a, const float* b, int lane) {
    Row16 av, bv; row_load_f32(av, a, lane); row_load_f32(bv, b, lane);
#pragma unroll
    for (int i = 0; i < 16; ++i) r.v[i] = r.v[i] * (1.0f + av.v[i]) + bv.v[i];
}
DI void row_affine(Row16& r, const float* g, const float* b, int lane) {
    Row16 av, bv; row_load_f32(av, g, lane); row_load_f32(bv, b, lane);
#pragma unroll
    for (int i = 0; i < 16; ++i) r.v[i] = r.v[i] * av.v[i] + bv.v[i];
}

DI void p_ln_a0(Frame& F, const Args& A) {
    FRAME_IDS
    const int gw = F.vcu * NWAVES + wave_, NGW = F.G * NWAVES;
    const float* x = (const float*)A.in[I_X]; bf16* XN = (bf16*)(F.ws + WS_XN); const float* mod = (const float*)(F.ws + WS_MOD);
    for (int m = gw; m < M; m += NGW) { const int b = m / T; const float* md = mod + (size_t)b * 6 * D;
        Row16 r; row_load_f32(r, x + (size_t)m * D, lane_); row_ln(r); row_mod(r, md + 1 * D, md + 0 * D, lane_); row_store_bf16(r, XN + (size_t)m * D, lane_); }
}

using pg8::Unit; using pg8::BM; using pg8::HALF;
struct EpiInProj {
    static constexpr bool PERM = true, AFTER_DRAIN = false;
    bf16* P; const float* rope; int skip;
    DI void operator()(const pg8::f32x4 (&acc)[2][2][4][2], const Unit& u, int wr, int wc, int fr, int fq) const {
        if (skip == 1) { if (acc[0][0][0][0][0] == 12345.678f) P[0] = 1; return; }
        const int row0 = u.pm * BM + wr * 64 + fr, pn = u.pn;
        const bool isrope = (pn >= 2 && pn <= 5), dorope = isrope && ((wc & 1) == 0) && (fq < 2);
        const float sc = (pn == 2 || pn == 3) ? QSCALE : 1.0f;
#pragma unroll
        for (int ai = 0; ai < 2; ++ai)
#pragma unroll
            for (int m = 0; m < 4; ++m) { const int row = row0 + ai * HALF + m * 16; bf16* rowp = P + (size_t)row * PROJW + pn * BM + wc * 32 + 8 * fq;
                f32x4 cs = (f32x4){1.f, 1.f, 1.f, 1.f}, sn = (f32x4){0.f, 0.f, 0.f, 0.f};
                if (isrope) { const float* rp = rope + (size_t)row * 16 + 4 * (fq & 1); cs = *(const f32x4*)rp; sn = *(const f32x4*)(rp + 8); }
#pragma unroll
                for (int bj = 0; bj < 2; ++bj) { pg8::f32x4 v0 = acc[ai][bj][m][0], v1 = acc[ai][bj][m][1];
                    if (pn < 2) {
#pragma unroll
                        for (int i = 0; i < 4; ++i) { v0[i] = gelu_tanh_f(v0[i]); v1[i] = gelu_tanh_f(v1[i]); }
                    } else if (isrope) {
                        if (dorope) { const float a0 = v0[0] * cs.x - v0[1] * sn.x, b0 = v0[1] * cs.x + v0[0] * sn.x, a1 = v0[2] * cs.y - v0[3] * sn.y, b1 = v0[3] * cs.y + v0[2] * sn.y;
                            const float a2 = v1[0] * cs.z - v1[1] * sn.z, b2 = v1[1] * cs.z + v1[0] * sn.z, a3 = v1[2] * cs.w - v1[3] * sn.w, b3 = v1[3] * cs.w + v1[2] * sn.w;
                            v0 = (pg8::f32x4){a0, b0, a1, b1}; v1 = (pg8::f32x4){a2, b2, a3, b3}; }
                        v0 = v0 * sc; v1 = v1 * sc;
                    }
                    pg8::u32x4 w; w.x = pg8::cvt_pk_bf16(v0[0], v0[1]); w.y = pg8::cvt_pk_bf16(v0[2], v0[3]); w.z = pg8::cvt_pk_bf16(v1[0], v1[1]); w.w = pg8::cvt_pk_bf16(v1[2], v1[3]);
                    if (skip == 2) { asm volatile("" :: "v"(w.x), "v"(w.y), "v"(w.z), "v"(w.w)); } else *(pg8::u32x4*)(rowp + bj * HALF) = w; } }
    }
};
template <bool XF32> struct EpiOut {
    static constexpr bool PERM = true, AFTER_DRAIN = false;
    bf16* PRE; const void* x; int xpitch; const float* mod;
    DI void operator()(const pg8::f32x4 (&acc)[2][2][4][2], const Unit& u, int wr, int wc, int fr, int fq) const {
        const int row0 = u.pm * BM + wr * 64 + fr, b = (u.pm * BM) / T, colb = u.pn * BM + wc * 32 + 8 * fq;
        const float* g1 = mod + (size_t)b * 6 * D + 2 * D;
        pg8::f32x4 gv[2][2];
#pragma unroll
        for (int bj = 0; bj < 2; ++bj) { gv[bj][0] = *(const pg8::f32x4*)(g1 + colb + bj * HALF) + 1.0f; gv[bj][1] = *(const pg8::f32x4*)(g1 + colb + bj * HALF + 4) + 1.0f; }
#pragma unroll
        for (int ai = 0; ai < 2; ++ai)
#pragma unroll
            for (int m = 0; m < 4; ++m) { const int row = row0 + ai * HALF + m * 16;
#pragma unroll
                for (int bj = 0; bj < 2; ++bj) { const int col = colb + bj * HALF; pg8::f32x4 x0, x1;
                    if (XF32) { const float* xp = (const float*)x + (size_t)row * xpitch + col; x0 = *(const pg8::f32x4*)xp; x1 = *(const pg8::f32x4*)(xp + 4); }
                    else { const pg8::u32x4 xw = *(const pg8::u32x4*)((const bf16*)x + (size_t)row * xpitch + col);
                        x0 = (pg8::f32x4){bflo(xw.x), bfhi(xw.x), bflo(xw.y), bfhi(xw.y)}; x1 = (pg8::f32x4){bflo(xw.z), bfhi(xw.z), bflo(xw.w), bfhi(xw.w)}; }
                    const pg8::f32x4 v0 = x0 * ALPHA + gv[bj][0] * acc[ai][bj][m][0], v1 = x1 * ALPHA + gv[bj][1] * acc[ai][bj][m][1];
                    pg8::u32x4 w; w.x = pg8::cvt_pk_bf16(v0[0], v0[1]); w.y = pg8::cvt_pk_bf16(v0[2], v0[3]); w.z = pg8::cvt_pk_bf16(v1[0], v1[1]); w.w = pg8::cvt_pk_bf16(v1[2], v1[3]);
                    *(pg8::u32x4*)(PRE + (size_t)row * D + col) = w; } }
    }
};
struct OutOrder : pg8::StaticOrder {
    const char* xbase; unsigned rowbytes, tilecolbytes; LAS unsigned char* dump;
    DI void a_ready(const Unit& u) const {
        const int tid = threadIdx.x, wid = __builtin_amdgcn_readfirstlane(tid >> 6), lane = tid & 63;
        const int lpr = (int)(tilecolbytes >> 7);
        const char* t0 = xbase + (size_t)u.pm * 256 * rowbytes + (size_t)u.pn * tilecolbytes;
        const int nline = 256 * lpr;
        for (int i = wid * 64 + lane; i < nline; i += 512) { const int r = i / lpr, c = i % lpr;
            __builtin_amdgcn_global_load_lds((const unsigned*)(t0 + (size_t)r * rowbytes + (size_t)c * 128), (LAS unsigned*)(dump + wid * 256), 4, 0, 0); }
    }
};
struct EpiGlu {
    static constexpr bool PERM = true, AFTER_DRAIN = false;
    const bf16* YG; bf16* MIX; const float* gb;
    DI void operator()(const pg8::f32x4 (&acc)[2][2][4][2], const Unit& u, int wr, int wc, int fr, int fq) const {
        const int row0 = u.pm * BM + wr * 64 + fr, colb = wc * 32 + 8 * fq;
#pragma unroll
        for (int ai = 0; ai < 2; ++ai)
#pragma unroll
            for (int m = 0; m < 4; ++m) { const int row = row0 + ai * HALF + m * 16;
#pragma unroll
                for (int bj = 0; bj < 2; ++bj) { const int col = colb + bj * HALF;
                    const pg8::u32x4 yw = *(const pg8::u32x4*)(YG + (size_t)row * 256 + col);
                    const pg8::f32x4 b0 = *(const pg8::f32x4*)(gb + col), b1 = *(const pg8::f32x4*)(gb + col + 4);
                    const pg8::f32x4 a0 = acc[ai][bj][m][0] + b0, a1 = acc[ai][bj][m][1] + b1;
                    const float y[8] = {bflo(yw.x), bfhi(yw.x), bflo(yw.y), bfhi(yw.y), bflo(yw.z), bfhi(yw.z), bflo(yw.w), bfhi(yw.w)};
                    float o[8];
#pragma unroll
                    for (int i = 0; i < 4; ++i) { o[i] = y[i] * sigmoid_f(a0[i]); o[4 + i] = y[4 + i] * sigmoid_f(a1[i]); }
                    pg8::u32x4 w; w.x = pg8::cvt_pk_bf16(o[0], o[1]); w.y = pg8::cvt_pk_bf16(o[2], o[3]); w.z = pg8::cvt_pk_bf16(o[4], o[5]); w.w = pg8::cvt_pk_bf16(o[6], o[7]);
                    *(pg8::u32x4*)(MIX + (size_t)row * D + 768 + col) = w; asm volatile("" ::: "memory"); } }
    }
};
template <int KIND> struct MoeOrderK {
    const volatile LAS int* ts; int G, c; const int* slot_a; const float* slot_w; gu32* done_cnt; gu32* queue; volatile LAS int* qs;
    DI bool decode(int off, Unit& u) const {
        const int nwg = ts[16] * 4, q = nwg / 8, r = nwg % 8, xcd = c % 8; const int cntx = q + (xcd < r ? 1 : 0); if (off >= cntx) return false;
        const int wgid = (xcd < r ? xcd * (q + 1) : r * (q + 1) + (xcd - r) * q) + off;
        const int tm = wgid >> 2, j = wgid & 3; int e = 0;
#pragma unroll
        for (int k = 1; k < 16; ++k) e += (ts[k] <= tm) ? 1 : 0;
        u.pm = tm; u.pn = e * 4 + j; return true; }
    DI bool first(Unit& u) const {
        if (KIND == 0) return next(0, u);
        if (threadIdx.x == 0) { const unsigned a = __hip_atomic_fetch_add(queue + 16 * (c % 8), 2u, RLX_AGENT); qs[0] = (int)a; qs[1] = (int)a + 1; }
        asm volatile("s_waitcnt vmcnt(0) lgkmcnt(0)" ::: "memory"); __builtin_amdgcn_s_barrier(); asm volatile("" ::: "memory");
        return decode(qs[0], u);
    }
    DI bool more(int i, Unit& u) const {
        if (KIND == 0) return next(i, u);
        return decode(qs[i & 1], u);
    }
    DI bool next(int i, Unit& u) const {
        const int nwg = ts[16] * 4; const int cc = c;
        const long L = (long)i * G + cc; if (L >= nwg) return false;
        int wgid = (int)L; { const int q = nwg / 8, r = nwg % 8, xcd = wgid % 8, off = wgid / 8; wgid = (xcd < r ? xcd * (q + 1) : r * (q + 1) + (xcd - r) * q) + off; }
        const int tm = wgid >> 2, j = wgid & 3; int e = 0;
#pragma unroll
        for (int k = 1; k < 16; ++k) e += (ts[k] <= tm) ? 1 : 0;
        u.pm = tm; u.pn = e * 4 + j; return true;
    }
    struct Pf { unsigned a, w, c, q; };
    DI void pull_issue(int tid, Pf& pf) const { if (KIND == 1 && tid == 0) pf.q = __hip_atomic_fetch_add(queue + 16 * (c % 8), 1u, RLX_AGENT); }
    DI void pull_publish(int tid, const Pf& pf, int ui) const { if (KIND == 1 && tid == 0 && ui >= 0) qs[ui & 1] = (int)pf.q; }
    DI void prefetch(const Unit& u, int r, Pf& pf) const {
        const int e = u.pn >> 2, idx = (u.pm - ts[e]) * 256 + (r & 255); const bool valid = idx < ts[32 + e];
        pf.a = 0xffffffffu; pf.w = 0u; pf.c = 32u;
        if (valid && r < 256) { pf.a = (unsigned)slot_a[(size_t)e * SLOT_CAP + idx]; if (KIND == 1) pf.w = __float_as_uint(slot_w[(size_t)e * SLOT_CAP + idx]); }
        if (KIND == 1 && r < 64) pf.c = __hip_atomic_load(done_cnt + u.pm, RLX_AGENT);
    }
    DI void finish_meta(const Unit& u, int r, const Pf& pf, unsigned& off, unsigned& a0, unsigned& a1) const {
        if (KIND == 0) { off = (pf.a == 0xffffffffu ? 0u : (pf.a >> 1)) * (unsigned)(D * 2); a0 = 0u; a1 = 0u; }
        else { off = (unsigned)(u.pm * 256 + r) * (unsigned)(DEXP * 2); a0 = pf.a; a1 = pf.w; }
    }
    DI void wait_ready(const Unit& u, int tid, const Pf& pf) const {
        if (KIND == 1 && tid < 64) { unsigned sp = 0;
            if ((unsigned)__builtin_amdgcn_readfirstlane((int)pf.c) < 32u)
                while ((unsigned)__builtin_amdgcn_readfirstlane((int)__hip_atomic_load(done_cnt + u.pm, RLX_AGENT)) < 32u) { __builtin_amdgcn_s_sleep(2); if (++sp > (1u << 20)) break; } }
    }
    DI void a_ready(const Unit&) const {}
    DI void done_nowait(const Unit& u) const { if (KIND == 0 && (threadIdx.x & 63) == 0) __hip_atomic_fetch_add(done_cnt + u.pm, 1u, RLX_AGENT); }
};
struct EpiG1 {
    static constexpr bool PERM = true, AFTER_DRAIN = false;
    bf16* HID; int skip;
    DI void operator()(const pg8::f32x4 (&acc)[2][2][4][2], const Unit& u, int wr, int wc, int fr, int fq, const LAS unsigned*) const {
        if (skip == 1) { if (acc[0][0][0][0][0] == 12345.678f) HID[0] = 1; return; }
        const __amdgpu_buffer_rsrc_t rs = __builtin_amdgcn_make_buffer_rsrc((void*)HID, 0, (int)((size_t)NSLOT_MAX * DEXP * 2), 0x00020000);
        const int row0 = u.pm * BM + wr * 64 + fr, col = (u.pn & 3) * 128 + wc * 32 + 8 * fq;
#pragma unroll
        for (int ai = 0; ai < 2; ++ai)
#pragma unroll
            for (int m = 0; m < 4; ++m) { const int row = row0 + ai * HALF + m * 16; float o[8];
#pragma unroll
                for (int i = 0; i < 4; ++i) { o[i] = silu_f(acc[ai][0][m][0][i]) * acc[ai][1][m][0][i]; o[4 + i] = silu_f(acc[ai][0][m][1][i]) * acc[ai][1][m][1][i]; }
                pg8::u32x4 w; w.x = pg8::cvt_pk_bf16(o[0], o[1]); w.y = pg8::cvt_pk_bf16(o[2], o[3]); w.z = pg8::cvt_pk_bf16(o[4], o[5]); w.w = pg8::cvt_pk_bf16(o[6], o[7]);
                __builtin_amdgcn_raw_buffer_store_b128(w, rs, (row * DEXP + col) * 2, 0, 16); }
    }
};
struct EpiG2 {
    static constexpr bool PERM = true, AFTER_DRAIN = false;
    bf16* ROWS; int skip;
    DI void operator()(const pg8::f32x4 (&acc)[2][2][4][2], const Unit& u, int wr, int wc, int fr, int fq, const LAS unsigned* meta) const {
        if (skip == 1) { if (acc[0][0][0][0][0] == 12345.678f) ROWS[0] = 1; return; }
        const int r0 = wr * 64 + fr, colb = (u.pn & 3) * BM + wc * 32 + 8 * fq;
#pragma unroll
        for (int ai = 0; ai < 2; ++ai)
#pragma unroll
            for (int m = 0; m < 4; ++m) { const int r = r0 + ai * HALF + m * 16; const int d = (int)meta[256 + r]; const float wt = __uint_as_float(meta[512 + r]);
                if (d >= 0) {
#pragma unroll
                    for (int bj = 0; bj < 2; ++bj) { const pg8::f32x4 v0 = acc[ai][bj][m][0] * wt, v1 = acc[ai][bj][m][1] * wt;
                        pg8::u32x4 w; w.x = pg8::cvt_pk_bf16(v0[0], v0[1]); w.y = pg8::cvt_pk_bf16(v0[2], v0[3]); w.z = pg8::cvt_pk_bf16(v1[0], v1[1]); w.w = pg8::cvt_pk_bf16(v1[2], v1[3]);
                        *(pg8::u32x4*)(ROWS + (size_t)d * D + colb + bj * HALF) = w; } } }
    }
};

DI void mix_gating_simple(Frame& F, const Args& A, int l) {
    FRAME_IDS
    const bf16* P = (const bf16*)(F.ws + WS_PROJ); bf16* MIX = (bf16*)(F.ws + WS_MIXCAT);
    const float* lng = (const float*)A.in[I_GMLNG] + l * AW; const float* lnb = (const float*)A.in[I_GMLNB] + l * AW;
    const float* ws_ = (const float*)A.in[I_GMWS] + (size_t)l * 4 * 128 * 128; const float* bs_ = (const float*)A.in[I_GMBS] + l * 4 * 128;
    LAS float* vln = (LAS float*)(F.lds + RING_OFF);
    for (int it = F.vcu; it < BATCH * (T / 128); it += F.G) {
        const int m0 = it * 128;
        for (int r = wave_; r < 128; r += NWAVES) {
            const v2u w = *(const v2u*)(P + (size_t)(m0 + r) * PROJW + COL_V + 4 * lane_);
            float v[4] = {bflo(w.x), bfhi(w.x), bflo(w.y), bfhi(w.y)};
            const float mean = wave_sum(v[0] + v[1] + v[2] + v[3]) * (1.f / 256.f);
            float s2 = 0.f;
#pragma unroll
            for (int i = 0; i < 4; ++i) { v[i] -= mean; s2 += v[i] * v[i]; }
            const float rstd = 1.0f / sqrtf(wave_sum(s2) * (1.f / 256.f) + LN_EPS);
#pragma unroll
            for (int i = 0; i < 4; ++i) vln[r * 256 + 4 * lane_ + i] = v[i] * rstd * lng[4 * lane_ + i] + lnb[4 * lane_ + i];
        }
        __syncthreads();
        { const int c = tid_ & 255, tp = tid_ >> 8, h = c >> 6;
          for (int t = tp; t < 128; t += 2) { const float* wrow = ws_ + ((size_t)h * 128 + t) * 128; float acc = 0.f;
              for (int s = 0; s <= t; ++s) acc += wrow[s] * vln[s * 256 + c];
              const float uu = bf2f(P[(size_t)(m0 + t) * PROJW + COL_U + c]);
              MIX[(size_t)(m0 + t) * D + c] = (bf16)f2bf(uu * (acc + bs_[h * 128 + t])); } }
        __syncthreads();
    }
}
DI void mix_attn_simple(Frame& F, int l) {
    FRAME_IDS
    const bf16* P = (const bf16*)(F.ws + WS_PROJ); bf16* MIX = (bf16*)(F.ws + WS_MIXCAT);
    const int gw = F.vcu * NWAVES + wave_, NGW = F.G * NWAVES;
    for (int it = gw; it < M * NH; it += NGW) {
        const int m = it >> 3, h = it & 7, t = m & (T - 1);
        const float q = bf2f(P[(size_t)m * PROJW + COL_Q + h * 64 + lane_]);
        float mx = -1e30f, den = 0.f, o = 0.f;
#pragma unroll 1
        for (int g = 0; g < 3; ++g) { const int dl = (g == 0) ? 1 : (g == 1 ? 4 : 16);
            int nk = t / dl; if (nk > 128) nk = 128;
#pragma unroll 2
            for (int j = 0; j <= nk; ++j) { const size_t mk = (size_t)(m - j * dl);
                const float kv = bf2f(P[mk * PROJW + COL_K + h * 64 + lane_]); const float vv = bf2f(P[mk * PROJW + COL_VA + h * 64 + lane_]);
                const float s = wave_sum(q * kv);
                const float mn = fmaxf(mx, s), f = __builtin_amdgcn_exp2f(mx - mn), p = __builtin_amdgcn_exp2f(s - mn);
                den = den * f + p; o = o * f + p * vv; mx = mn; } }
        MIX[(size_t)m * D + AW + h * 64 + lane_] = (bf16)f2bf(o / den);
    }
}

typedef float f32x16 __attribute__((ext_vector_type(16)));
typedef short v4i16_t __attribute__((ext_vector_type(4)));
DI int crow16(int r, int hi) { return (r & 3) + 8 * (r >> 2) + 4 * hi; }
template <int SUB> DI void mix_attn_mfma(Frame& F, int l) {
    FRAME_IDS
    const bf16* P = (const bf16*)(F.ws + WS_PROJ);
    LAS unsigned char* Ks = F.lds + RING_OFF; LAS unsigned char* Vs = Ks + 49152;
    LAS unsigned char* St = F.lds + ATT_STAGE_OFF + wave_ * 4608;
    const int ql = lane_ & 31, hi = lane_ >> 5, prow = lane_ >> 3, pch = lane_ & 7;
    constexpr int nitems = SUB == 0 ? 2048 : 1024;
    v4u kreg[6], vreg[6], qraw[4]; bf16x8 qf[4];
    int it = F.vcu; if (it >= nitems) return;
    int d, r, s0, b, h; size_t tokbase;
#define ATT_DECODE(IT) do { const int idx_ = (IT) & 1023; b = idx_ >> 7; h = (idx_ >> 4) & 7; int tile_; \
        if (SUB == 1) { d = 1; r = 0; tile_ = idx_ & 15; } else if ((IT) < 1024) { d = 16; r = idx_ & 15; tile_ = 0; } else { d = 4; r = (idx_ >> 2) & 3; tile_ = idx_ & 3; } \
        s0 = tile_ * 256; tokbase = (size_t)b * T + r; } while (0)
#define ATT_LOAD() do { const int tl_ = ftid(); _Pragma("unroll") for (int i = 0; i < 6; ++i) { const int idx2 = tl_ + 512 * i, row = idx2 >> 3, ch = idx2 & 7, step = s0 - 128 + row; \
            if (step >= 0) { const bf16* src = P + (tokbase + (size_t)step * d) * PROJW + h * 64 + ch * 8; kreg[i] = *(const v4u*)(src + COL_K); vreg[i] = *(const v4u*)(src + COL_VA); } \
            else { kreg[i] = (v4u){0u, 0u, 0u, 0u}; vreg[i] = (v4u){0u, 0u, 0u, 0u}; } } \
        _Pragma("unroll") for (int p = 0; p < 4; ++p) qraw[p] = *(const v4u*)(P + (tokbase + (size_t)(s0 + 32 * wave_ + 8 * p + prow) * d) * PROJW + COL_Q + h * 64 + pch * 8); } while (0)
#define ATT_WRITE() do { const int tw_ = ftid(); _Pragma("unroll") for (int i = 0; i < 6; ++i) { const int idx2 = tw_ + 512 * i, row = idx2 >> 3, ch = idx2 & 7; \
            *(LAS v4u*)(Ks + row * 128 + ((ch ^ ((row >> 1) & 7)) << 4)) = kreg[i]; \
            *(LAS v4u*)(Vs + row * 128 + ((ch ^ (((row >> 1) & 1) << 2)) << 4)) = vreg[i]; } \
        _Pragma("unroll") for (int p = 0; p < 4; ++p) *(LAS v4u*)(St + (8 * p + prow) * 144 + pch * 16) = qraw[p]; } while (0)
    ATT_DECODE(it); ATT_LOAD(); ATT_WRITE();
    __syncthreads();
    for (;;) {
        const size_t tb = tokbase; const int s0c = s0, dc = d, hcur = h, itcur = it;
        const bool first = (s0 == 0);
#pragma unroll
        for (int ks = 0; ks < 4; ++ks) qf[ks] = *(const LAS bf16x8*)(St + ql * 144 + (2 * ks + hi) * 16);
        const int itn = it + F.G; const bool has_next = itn < nitems;
        if (has_next) { ATT_DECODE(itn); ATT_LOAD(); }
        const int i0 = 32 * wave_;
        f32x16 S[5];
#pragma unroll
        for (int kb = 0; kb < 5; ++kb) { f32x16 acc;
#pragma unroll
            for (int i = 0; i < 16; ++i) acc[i] = 0.f;
            const int krow = i0 + 32 * kb + ql;
#pragma unroll
            for (int ks = 0; ks < 4; ++ks) { const bf16x8 a = *(const LAS bf16x8*)(Ks + krow * 128 + (((2 * ks + hi) ^ ((krow >> 1) & 7)) << 4)); acc = __builtin_amdgcn_mfma_f32_32x32x16_bf16(a, qf[ks], acc, 0, 0, 0); }
            S[kb] = acc; }
        int qrel = ql - 4 * hi; asm volatile("" : "+v"(qrel));
        float mx = -1e30f;
#pragma unroll
        for (int kb = 0; kb < 5; ++kb) {
            const bool bvalid = !first || (wave_ + kb >= 4);
            if (!bvalid) {
#pragma unroll
                for (int i = 0; i < 16; ++i) S[kb][i] = -1e30f;
            } else {
#pragma unroll
                for (int i = 0; i < 16; ++i) { const int c0 = crow16(i, 0); float v = S[kb][i];
                    if (kb == 0) v = (c0 >= qrel) ? v : -1e30f;
                    if (kb == 4) v = (c0 <= qrel) ? v : -1e30f;
                    S[kb][i] = v; mx = fmaxf(mx, v); }
            }
        }
        mx = fmaxf(mx, __shfl_xor(mx, 32));
        float lsum = 0.f;
#pragma unroll
        for (int kb = 0; kb < 5; ++kb)
#pragma unroll
            for (int i = 0; i < 16; ++i) { const float p = __builtin_amdgcn_exp2f(S[kb][i] - mx); S[kb][i] = p; lsum += p; }
        lsum += __shfl_xor(lsum, 32);
        v4u x16[4], x4[4]; f32x2_t s16 = {0.f, 0.f}, s4 = {0.f, 0.f};
        if (SUB == 1) {
            const size_t qt = tb + (size_t)(s0c + i0 + ql) * dc;
            s16 = *(const f32x2_t*)((const float*)(F.ws + WS_STAT) + (qt * NH + hcur) * 2); s4 = *(const f32x2_t*)((const float*)(F.ws + WS_STAT) + (size_t)M * NH * 2 + (qt * NH + hcur) * 2);
        }
        f32x16 O[2];
#pragma unroll
        for (int i = 0; i < 16; ++i) { O[0][i] = 0.f; O[1][i] = 0.f; }
        const int trq = (lane_ & 15) >> 2, trg = (lane_ >> 4) & 1, trp = lane_ & 3;
#pragma unroll
        for (int kb = 0; kb < 5; ++kb)
#pragma unroll
            for (int s = 0; s < 2; ++s) {
                if (SUB == 1 && kb == 2 && s == 0) {
#pragma unroll
                    for (int p = 0; p < 4; ++p) { const size_t rt = tb + (size_t)(s0c + i0 + 8 * p + prow) * dc; const bf16* pp = (const bf16*)(F.ws + WS_XN) + rt * BW + hcur * 64 + pch * 8;
                        x16[p] = *(const v4u*)pp; x4[p] = *(const v4u*)(pp + (size_t)M * BW); } }
                v4u pw; pw.x = cvtpk(S[kb][8 * s], S[kb][8 * s + 1]); pw.y = cvtpk(S[kb][8 * s + 2], S[kb][8 * s + 3]); pw.z = cvtpk(S[kb][8 * s + 4], S[kb][8 * s + 5]); pw.w = cvtpk(S[kb][8 * s + 6], S[kb][8 * s + 7]);
                const bf16x8 pb = __builtin_bit_cast(bf16x8, pw);
                const int rlo = i0 + 32 * kb + 16 * s + 4 * hi + trq, rhi = rlo + 8;
#pragma unroll
                for (int dh = 0; dh < 2; ++dh) { const int chunk = 4 * dh + 2 * trg + (trp >> 1);
                    const v4i16_t lo = __builtin_amdgcn_ds_read_tr16_b64_v4i16((LAS v4i16_t*)(Vs + rlo * 128 + ((chunk ^ (((rlo >> 1) & 1) << 2)) << 4) + 8 * (trp & 1)));
                    const v4i16_t hh = __builtin_amdgcn_ds_read_tr16_b64_v4i16((LAS v4i16_t*)(Vs + rhi * 128 + ((chunk ^ (((rhi >> 1) & 1) << 2)) << 4) + 8 * (trp & 1)));
                    const bf16x8 va = (bf16x8){lo[0], lo[1], lo[2], lo[3], hh[0], hh[1], hh[2], hh[3]};
                    O[dh] = __builtin_amdgcn_mfma_f32_32x32x16_bf16(va, pb, O[dh], 0, 0, 0); } }
        float osc;
        if (SUB == 0) osc = 1.0f / lsum;
        else { const float MM = fmaxf(mx, fmaxf(s16.x, s4.x)), a1 = __builtin_amdgcn_exp2f(mx - MM), a16 = s16.y * __builtin_amdgcn_exp2f(s16.x - MM), a4 = s4.y * __builtin_amdgcn_exp2f(s4.x - MM);
            const float inv = 1.0f / (lsum * a1 + a16 + a4); osc = a1 * inv;
            if (hi == 0) { f32x2_t cc = {a16 * inv, a4 * inv}; *(LAS f32x2_t*)(St + ql * 144 + 128) = cc; } }
#pragma unroll
        for (int dh = 0; dh < 2; ++dh)
#pragma unroll
            for (int g4 = 0; g4 < 4; ++g4) { v2u w; w.x = cvtpk(O[dh][4 * g4] * osc, O[dh][4 * g4 + 1] * osc); w.y = cvtpk(O[dh][4 * g4 + 2] * osc, O[dh][4 * g4 + 3] * osc);
                *(LAS v2u*)(St + ql * 144 + (32 * dh + 8 * g4 + 4 * hi) * 2) = w; }
        if (SUB == 0) {
            bf16* PART = (bf16*)(F.ws + WS_XN) + (itcur < 1024 ? 0 : (size_t)M * BW); float* ST = (float*)(F.ws + WS_STAT) + (itcur < 1024 ? 0 : (size_t)M * NH * 2);
            if (hi == 0) { const size_t qt = tb + (size_t)(s0c + i0 + ql) * dc; f32x2_t st = {mx, lsum}; *(f32x2_t*)(ST + (qt * NH + hcur) * 2) = st; }
#pragma unroll
            for (int p = 0; p < 4; ++p) { const size_t rt = tb + (size_t)(s0c + i0 + 8 * p + prow) * dc;
                *(v4u*)(PART + rt * BW + hcur * 64 + pch * 8) = *(const LAS v4u*)(St + (8 * p + prow) * 144 + pch * 16); }
        } else {
#pragma unroll
            for (int p = 0; p < 4; ++p) { const size_t rt = tb + (size_t)(s0c + i0 + 8 * p + prow) * dc;
                const v4u ov = *(const LAS v4u*)(St + (8 * p + prow) * 144 + pch * 16); const f32x2_t cc = *(const LAS f32x2_t*)(St + (8 * p + prow) * 144 + 128);
                v4u o;
                o.x = cvtpk(bflo(ov.x) + cc.x * bflo(x16[p].x) + cc.y * bflo(x4[p].x), bfhi(ov.x) + cc.x * bfhi(x16[p].x) + cc.y * bfhi(x4[p].x));
                o.y = cvtpk(bflo(ov.y) + cc.x * bflo(x16[p].y) + cc.y * bflo(x4[p].y), bfhi(ov.y) + cc.x * bfhi(x16[p].y) + cc.y * bfhi(x4[p].y));
                o.z = cvtpk(bflo(ov.z) + cc.x * bflo(x16[p].z) + cc.y * bflo(x4[p].z), bfhi(ov.z) + cc.x * bfhi(x16[p].z) + cc.y * bfhi(x4[p].z));
                o.w = cvtpk(bflo(ov.w) + cc.x * bflo(x16[p].w) + cc.y * bflo(x4[p].w), bfhi(ov.w) + cc.x * bfhi(x16[p].w) + cc.y * bfhi(x4[p].w));
                *(v4u*)((bf16*)(F.ws + WS_MIXCAT) + rt * D + AW + hcur * 64 + pch * 8) = o; }
        }
        __syncthreads();
        if (!has_next) break;
        ATT_WRITE(); it = itn;
        __syncthreads();
    }
#undef ATT_DECODE
#undef ATT_LOAD
#undef ATT_WRITE
}
typedef float f32x4_t __attribute__((ext_vector_type(4)));
DI void cmul_acc(float& xr, float& xi, float ar, float ai, float br, float bi) { const float nr = ar * xr - ai * xi + br, ni = ar * xi + ai * xr + bi; xr = nr; xi = ni; }
DI void mix_ssm_in(Frame& F, int l) {
    FRAME_IDS
    const bf16* P = (const bf16*)(F.ws + WS_PROJ);
    const bf16* WIN = (const bf16*)(F.ws + WS_SSM2 + l * SSM2_LAYER + S2_WIN);
    const float* apw = (const float*)(F.ws + WS_SSM2 + l * SSM2_LAYER + S2_APW);
    float* XLOC = (float*)(F.ws + WS_XLOC); float* XSUP = (float*)(F.ws + WS_XSUP);
    const int row = lane_ & 15, q = lane_ >> 4;
    for (int it = F.vcu; it < 256; it += F.G) {
        const int b = it >> 5, sc = (it >> 2) & 7, g = 4 * (it & 3) + (wave_ >> 1), half = wave_ & 1;
        bf16x8 af[16];
        { const bf16* src = P + ((size_t)b * T + (size_t)(16 * sc + row) * 32 + (q >> 1)) * PROJW + COL_S + g * 16 + 8 * (q & 1);
#pragma unroll
          for (int sp = 0; sp < 16; ++sp) af[sp] = *(const bf16x8*)(src + (size_t)(2 * sp) * PROJW); }
#pragma unroll 1
        for (int c4 = 0; c4 < 4; ++c4) { const int ct = 4 * half + c4;
            f32x4_t acc = {0.f, 0.f, 0.f, 0.f};
            const bf16* wp = WIN + (((size_t)(g * 16) * 8 + ct) * 64 + lane_) * 8;
#pragma unroll
            for (int sp = 0; sp < 16; ++sp) { const bf16x8 bfr = *(const bf16x8*)(wp + (size_t)sp * 8 * 64 * 8); acc = __builtin_amdgcn_mfma_f32_16x16x32_bf16(af[sp], bfr, acc, 0, 0, 0); }
            const int comp = 16 * ct + row, n = comp >> 1, part = comp & 1;
#pragma unroll
            for (int r = 0; r < 4; ++r) XLOC[(((size_t)b * 128 + 16 * sc + 4 * q + r) * 16 + g) * 128 + comp] = acc[r];
            const float a32r = apw[((g * 33 + 32) * 64 + n) * 2], a32i = apw[((g * 33 + 32) * 64 + n) * 2 + 1];
            const float sg = part ? 1.f : -1.f;
            float h = acc[0];
#pragma unroll
            for (int r = 1; r < 4; ++r) { const float o = __shfl_xor(h, 1); h = a32r * h + sg * a32i * o + acc[r]; }
            float p64r = a32r * a32r - a32i * a32i, p64i = 2.f * a32r * a32i;
            float p128r = p64r * p64r - p64i * p64i, p128i = 2.f * p64r * p64i;
            float wr = 1.f, wi = 0.f;
            for (int k = 0; k < 3 - q; ++k) { const float t0 = wr * p128r - wi * p128i, t1 = wr * p128i + wi * p128r; wr = t0; wi = t1; }
            { const float o = __shfl_xor(h, 1); h = wr * h + sg * wi * o; }
            h += __shfl_xor(h, 16); h += __shfl_xor(h, 32);
            if (q == 0) XSUP[(((size_t)b * 8 + sc) * 16 + g) * 128 + comp] = h;
        }
    }
}
DI void mix_ssm_out(Frame& F, const Args& A, int l) {
    FRAME_IDS
    const bf16* P = (const bf16*)(F.ws + WS_PROJ); bf16* YG = (bf16*)(F.ws + WS_YG);
    const bf16* KT = (const bf16*)(F.ws + WS_SSM2 + l * SSM2_LAYER + S2_KT); const bf16* CT = (const bf16*)(F.ws + WS_SSM2 + l * SSM2_LAYER + S2_CT);
    const float* apw = (const float*)(F.ws + WS_SSM2 + l * SSM2_LAYER + S2_APW);
    const float* XLOC = (const float*)(F.ws + WS_XLOC); const float* XSUP = (const float*)(F.ws + WS_XSUP);
    LAS unsigned char* Ut = F.lds + RING_OFF + wave_ * 4096;
    LAS float* Xs = (LAS float*)(F.lds + RING_OFF + wave_ * 4096 + 2048);
    for (int i = lane_; i < 256; i += 64) ((LAS unsigned*)Ut)[i] = 0u;
    const int row = lane_ & 15, q = lane_ >> 4;
    for (int it = F.vcu; it < 256; it += F.G) {
        const int b = it >> 5, sc = (it >> 2) & 7, g = 4 * (it & 3) + (wave_ >> 1), half = wave_ & 1, n = lane_;
        const size_t tokA = (size_t)b * T + (size_t)(16 * sc + 8 * half) * 32;
        v4u unext = *(const v4u*)(P + (tokA + (lane_ >> 1)) * PROJW + COL_S + g * 16 + 8 * (lane_ & 1));
        f32x2_t psup[8], ploc[8];
#pragma unroll
        for (int s2 = 0; s2 < 8; ++s2) { psup[s2] = (f32x2_t){0.f, 0.f}; if (s2 < sc) psup[s2] = *(const f32x2_t*)(XSUP + (((size_t)b * 8 + s2) * 16 + g) * 128 + 2 * n); }
#pragma unroll
        for (int k2 = 0; k2 < 8; ++k2) { ploc[k2] = (f32x2_t){0.f, 0.f}; if (half) ploc[k2] = *(const f32x2_t*)(XLOC + (((size_t)b * 128 + 16 * sc + k2) * 16 + g) * 128 + 2 * n); }
        const float dsk = ((const float*)A.in[I_SSMD])[(l * 16 + g) * 16 + row];
        const float a32r = apw[((g * 33 + 32) * 64 + n) * 2], a32i = apw[((g * 33 + 32) * 64 + n) * 2 + 1];
        const float a16r = apw[((g * 33 + 16) * 64 + n) * 2], a16i = apw[((g * 33 + 16) * 64 + n) * 2 + 1];
        float a512r = a32r, a512i = a32i;
#pragma unroll
        for (int k = 0; k < 4; ++k) { const float t0 = a512r * a512r - a512i * a512i, t1 = 2.f * a512r * a512i; a512r = t0; a512i = t1; }
        float xr = 0.f, xi = 0.f;
#pragma unroll
        for (int s2 = 0; s2 < 8; ++s2) if (s2 < sc) cmul_acc(xr, xi, a512r, a512i, psup[s2].x, psup[s2].y);
        if (half) {
#pragma unroll
            for (int k2 = 0; k2 < 8; ++k2) cmul_acc(xr, xi, a32r, a32i, ploc[k2].x, ploc[k2].y); }
        asm volatile("" : "+v"(xr), "+v"(xi) :: "memory");
        bf16x8 kt[16], ctf[4];
#pragma unroll
        for (int p = 0; p < 16; ++p) kt[p] = *(const bf16x8*)(KT + ((size_t)(g * 16 + p) * 64 + lane_) * 8);
#pragma unroll
        for (int sx = 0; sx < 4; ++sx) ctf[sx] = *(const bf16x8*)(CT + ((size_t)(g * 4 + sx) * 64 + lane_) * 8);
        f32x4_t apr[4][2];
#pragma unroll
        for (int sx = 0; sx < 4; ++sx) { const f32x4_t* ap = (const f32x4_t*)(apw + ((size_t)(g * 33 + row + 1) * 64 + 16 * sx + 4 * q) * 2); apr[sx][0] = ap[0]; apr[sx][1] = ap[1]; }
#pragma unroll 1
        for (int kk = 0; kk < 8; ++kk) {
            const size_t tok0 = tokA + (size_t)kk * 32;
            const f32x2_t xl = *(const f32x2_t*)(XLOC + (((size_t)b * 128 + 16 * sc + 8 * half + kk) * 16 + g) * 128 + 2 * n);
            *(LAS v4u*)(Ut + 1024 + lane_ * 16) = unext;
            if (kk < 7) unext = *(const v4u*)(P + (tok0 + 32 + (lane_ >> 1)) * PROJW + COL_S + g * 16 + 8 * (lane_ & 1));
            Xs[2 * n] = xr; Xs[2 * n + 1] = xi; Xs[128 + 2 * n] = a16r * xr - a16i * xi; Xs[128 + 2 * n + 1] = a16r * xi + a16i * xr;
#pragma unroll
            for (int tau = 0; tau < 2; ++tau) { f32x4_t acc = (f32x4_t){0.f, 0.f, 0.f, 0.f};
                const int ti = 16 * tau + row;
#pragma unroll
                for (int sx = 0; sx < 4; ++sx) { const LAS f32x4_t* xp = (const LAS f32x4_t*)(Xs + 128 * tau + 2 * (16 * sx + 4 * q)); const f32x4_t x01 = xp[0], x23 = xp[1];
                    const f32x4_t a01 = apr[sx][0], a23 = apr[sx][1];
                    v4u zw; zw.x = cvtpk(a01.x * x01.x - a01.y * x01.y, a01.x * x01.y + a01.y * x01.x); zw.y = cvtpk(a01.z * x01.z - a01.w * x01.w, a01.z * x01.w + a01.w * x01.z);
                    zw.z = cvtpk(a23.x * x23.x - a23.y * x23.y, a23.x * x23.y + a23.y * x23.x); zw.w = cvtpk(a23.z * x23.z - a23.w * x23.w, a23.z * x23.w + a23.w * x23.z);
                    acc = __builtin_amdgcn_mfma_f32_16x16x32_bf16(__builtin_bit_cast(bf16x8, zw), ctf[sx], acc, 0, 0, 0);
                    asm volatile("" ::: "memory"); }
#pragma unroll
                for (int p = 0; p < 16; ++p) if (p < 8 * tau + 8) { const bf16x8 ua = *(const LAS bf16x8*)(Ut + (32 + ti - 2 * p - (q >> 1)) * 32 + 16 * (q & 1));
                    acc = __builtin_amdgcn_mfma_f32_16x16x32_bf16(ua, kt[p], acc, 0, 0, 0); if ((p & 3) == 3) asm volatile("" ::: "memory"); }
#pragma unroll
                for (int r = 0; r < 4; ++r) { const int t2 = 16 * tau + 4 * q + r; const float uu = bf2f(*(const LAS bf16*)(Ut + (32 + t2) * 32 + 2 * row));
                    YG[(tok0 + t2) * 256 + g * 16 + row] = (bf16)f2bf(gelu_tanh_f(acc[r] + dsk * uu)); }
            }
            cmul_acc(xr, xi, a32r, a32i, xl.x, xl.y);
        }
    }
}
DI void mix_gating_mfma(Frame& F, const Args& A, int l, int variant = 0) {
    FRAME_IDS
    const bf16* P = (const bf16*)(F.ws + WS_PROJ); bf16* MIX = (bf16*)(F.ws + WS_MIXCAT);
    const bf16* GW = (const bf16*)(F.ws + WS_SSM2 + l * SSM2_LAYER + S2_GW);
    const float* lng = (const float*)A.in[I_GMLNG] + l * AW; const float* lnb = (const float*)A.in[I_GMLNB] + l * AW;
    const float* bs_ = (const float*)A.in[I_GMBS] + l * 4 * 128;
    LAS unsigned char* VT = F.lds + RING_OFF;
    const int ql = lane_ & 31, hi = lane_ >> 5, trq = (lane_ & 15) >> 2, trg = (lane_ >> 4) & 1, trp = lane_ & 3;
    for (int it = F.vcu; it < BATCH * (T / 128); it += F.G) {
        const int m0 = it * 128;
        __syncthreads();
        if (variant != 2) {
        v2u wv[16];
#pragma unroll
        for (int j = 0; j < 16; ++j) wv[j] = *(const v2u*)(P + (size_t)(m0 + wave_ + 8 * j) * PROJW + COL_V + 4 * lane_);
        const f32x4 gg = *(const f32x4*)(lng + 4 * lane_), bb = *(const f32x4*)(lnb + 4 * lane_);
#pragma unroll
        for (int j = 0; j < 16; ++j) { const int r = wave_ + 8 * j; const v2u w = wv[j];
            float v[4] = {bflo(w.x), bfhi(w.x), bflo(w.y), bfhi(w.y)};
            const float mean = wave_sum(v[0] + v[1] + v[2] + v[3]) * (1.f / 256.f);
            float s2 = 0.f;
#pragma unroll
            for (int i = 0; i < 4; ++i) { v[i] -= mean; s2 += v[i] * v[i]; }
            const float rstd = 1.0f / sqrtf(wave_sum(s2) * (1.f / 256.f) + LN_EPS);
            v2u o; o.x = cvtpk(v[0] * rstd * gg.x + bb.x, v[1] * rstd * gg.y + bb.y); o.y = cvtpk(v[2] * rstd * gg.z + bb.z, v[3] * rstd * gg.w + bb.w);
            *(LAS v2u*)(VT + r * 512 + (((lane_ >> 1) ^ ((r & 3) << 2)) << 4) + 8 * (lane_ & 1)) = o;
        }
        }
        __syncthreads();
        if (variant == 1) continue;
        const int h = wave_ >> 1, cb = 64 * h + 32 * (wave_ & 1);
        const int chunk = (cb >> 3) + 2 * trg + (trp >> 1);
#pragma unroll
        for (int rt = 0; rt < 4; ++rt) {
            f32x16 acc;
#pragma unroll
            for (int i = 0; i < 16; ++i) acc[i] = 0.f;
            bf16x8 wa[8];
#pragma unroll
            for (int ks = 0; ks < 2 * rt + 2; ++ks) wa[ks] = *(const bf16x8*)(GW + ((size_t)h * 128 + 32 * rt + ql) * 128 + 16 * ks + 8 * hi);
#pragma unroll
            for (int ks = 0; ks < 2 * rt + 2; ++ks) {
                const int rlo = 16 * ks + 8 * hi + trq;
                const v4i16_t lo = __builtin_amdgcn_ds_read_tr16_b64_v4i16((LAS v4i16_t*)(VT + rlo * 512 + ((chunk ^ (trq << 2)) << 4) + 8 * (trp & 1)));
                const v4i16_t hh = __builtin_amdgcn_ds_read_tr16_b64_v4i16((LAS v4i16_t*)(VT + (rlo + 4) * 512 + ((chunk ^ (trq << 2)) << 4) + 8 * (trp & 1)));
                const bf16x8 va = (bf16x8){lo[0], lo[1], lo[2], lo[3], hh[0], hh[1], hh[2], hh[3]};
                acc = __builtin_amdgcn_mfma_f32_32x32x16_bf16(va, wa[ks], acc, 0, 0, 0); }
            { const int t = 32 * rt + ql; const float bsv = bs_[h * 128 + t];
              const bf16* up = P + (size_t)(m0 + t) * PROJW + COL_U + cb + 4 * hi; bf16* op = MIX + (size_t)(m0 + t) * D + cb + 4 * hi;
#pragma unroll
              for (int g4 = 0; g4 < 4; ++g4) { const v2u uw = *(const v2u*)(up + 8 * g4); v2u o;
                  o.x = cvtpk(bflo(uw.x) * (acc[4 * g4] + bsv), bfhi(uw.x) * (acc[4 * g4 + 1] + bsv)); o.y = cvtpk(bflo(uw.y) * (acc[4 * g4 + 2] + bsv), bfhi(uw.y) * (acc[4 * g4 + 3] + bsv));
                  *(v2u*)(op + 8 * g4) = o; } }
        }
    }
}

DI void p_glu(Frame& F, const Args& A, int l) {
    FRAME_IDS
    const bf16* YG = (const bf16*)(F.ws + WS_YG); bf16* MIX = (bf16*)(F.ws + WS_MIXCAT);
    const bf16* GluT = (const bf16*)(F.ws + WS_WSMALL + l * WSMALL_LAYER + WOFF_GLU); const float* gb = (const float*)A.in[I_GLUB] + l * 256;
    LAS unsigned char* Bs = F.lds + RING_OFF;
#pragma unroll
    for (int i = 0; i < 16; ++i) { const int idx = tid_ + 512 * i, n = idx >> 5, ch = idx & 31;
        *(LAS v4u*)(Bs + n * 512 + ((ch ^ (n & 15)) << 4)) = *(const v4u*)(GluT + (size_t)n * 256 + ch * 8); }
    __syncthreads();
    const int tk = lane_ & 15, q = lane_ >> 4;
    for (int rt = F.vcu; rt < M / 128; rt += F.G) {
        const size_t tok = (size_t)rt * 128 + wave_ * 16 + tk;
        bf16x8 yf[8];
#pragma unroll
        for (int ks = 0; ks < 8; ++ks) yf[ks] = *(const bf16x8*)(YG + tok * 256 + 32 * ks + 8 * q);
#pragma unroll 4
        for (int ct = 0; ct < 16; ++ct) {
            f32x4_t acc = {0.f, 0.f, 0.f, 0.f};
            const int n = 16 * ct + tk;
#pragma unroll
            for (int ks = 0; ks < 8; ++ks) { const bf16x8 wf = *(const LAS bf16x8*)(Bs + n * 512 + (((4 * ks + q) ^ (n & 15)) << 4));
                acc = __builtin_amdgcn_mfma_f32_16x16x32_bf16(wf, yf[ks], acc, 0, 0, 0); }
            const int n0 = 16 * ct + 4 * q; const v2u yw = *(const v2u*)(YG + tok * 256 + n0); const f32x4 bv = *(const f32x4*)(gb + n0);
            v2u o; o.x = cvtpk(bflo(yw.x) * sigmoid_f(acc[0] + bv.x), bfhi(yw.x) * sigmoid_f(acc[1] + bv.y)); o.y = cvtpk(bflo(yw.y) * sigmoid_f(acc[2] + bv.z), bfhi(yw.y) * sigmoid_f(acc[3] + bv.w));
            *(v2u*)(MIX + tok * D + 768 + n0) = o;
        }
    }
}
DI void mix_ssm_simple(Frame& F, const Args& A, int l) {
    FRAME_IDS
    const bf16* P = (const bf16*)(F.ws + WS_PROJ); bf16* YG = (bf16*)(F.ws + WS_YG);
    const float* tab = (const float*)(F.ws + WS_SSM) + (size_t)l * SSM_TAB;
    LAS float* fin = (LAS float*)(F.lds + RING_OFF);
    for (int it = F.vcu; it < BATCH * SSM_G; it += F.G) {
        const int b = it >> 4, g = it & 15, n = lane_, seg = wave_, gn = g * 64 + n;
        const float are = tab[gn], aim = tab[1024 + gn];
        float bre[16], bim[16], cre[16], cim[16];
#pragma unroll
        for (int c = 0; c < 16; ++c) { bre[c] = tab[2048 + gn * 16 + c]; bim[c] = tab[2048 + 16384 + gn * 16 + c];
            cre[c] = ((const float*)A.in[I_CRE])[(((size_t)l * 16 + g) * 16 + c) * 64 + n]; cim[c] = ((const float*)A.in[I_CIM])[(((size_t)l * 16 + g) * 16 + c) * 64 + n]; }
        const float dsk = ((const float*)A.in[I_SSMD])[(l * 16 + g) * 16 + (lane_ & 15)];
        const size_t mbase = (size_t)b * T + seg * 512;
        float xr = 0.f, xi = 0.f;
        for (int tt = 0; tt < 512; ++tt) { const v4u* up = (const v4u*)(P + (mbase + tt) * PROJW + COL_S + g * 16); const v4u u0 = up[0], u1 = up[1];
            const float u[16] = {bflo(u0.x), bfhi(u0.x), bflo(u0.y), bfhi(u0.y), bflo(u0.z), bfhi(u0.z), bflo(u0.w), bfhi(u0.w), bflo(u1.x), bfhi(u1.x), bflo(u1.y), bfhi(u1.y), bflo(u1.z), bfhi(u1.z), bflo(u1.w), bfhi(u1.w)};
            float br = 0.f, bi = 0.f;
#pragma unroll
            for (int c = 0; c < 16; ++c) { br += u[c] * bre[c]; bi += u[c] * bim[c]; }
            const float nr = are * xr - aim * xi + br, ni = are * xi + aim * xr + bi; xr = nr; xi = ni; }
        fin[(seg * 64 + n) * 2] = xr; fin[(seg * 64 + n) * 2 + 1] = xi;
        __syncthreads();
        float pr = are, pi = aim;
#pragma unroll
        for (int k = 0; k < 9; ++k) { const float t0 = pr * pr - pi * pi, t1 = 2.f * pr * pi; pr = t0; pi = t1; }
        xr = 0.f; xi = 0.f;
        for (int s = 0; s < seg; ++s) { const float fr_ = fin[(s * 64 + n) * 2], fi_ = fin[(s * 64 + n) * 2 + 1];
            const float nr = pr * xr - pi * xi + fr_, ni = pr * xi + pi * xr + fi_; xr = nr; xi = ni; }
        for (int tt = 0; tt < 512; ++tt) { const v4u* up = (const v4u*)(P + (mbase + tt) * PROJW + COL_S + g * 16); const v4u u0 = up[0], u1 = up[1];
            const float u[16] = {bflo(u0.x), bfhi(u0.x), bflo(u0.y), bfhi(u0.y), bflo(u0.z), bfhi(u0.z), bflo(u0.w), bfhi(u0.w), bflo(u1.x), bfhi(u1.x), bflo(u1.y), bfhi(u1.y), bflo(u1.z), bfhi(u1.z), bflo(u1.w), bfhi(u1.w)};
            float br = 0.f, bi = 0.f;
#pragma unroll
            for (int c = 0; c < 16; ++c) { br += u[c] * bre[c]; bi += u[c] * bim[c]; }
            const float nr = are * xr - aim * xi + br, ni = are * xi + aim * xr + bi; xr = nr; xi = ni;
            float ysel = 0.f, usel = 0.f;
#pragma unroll
            for (int c = 0; c < 16; ++c) { const float r = wave_sum(xr * cre[c] - xi * cim[c]); if ((lane_ & 15) == c) { ysel = r; usel = u[c]; } }
            if (lane_ < 16) { const float y = ysel + dsk * usel; YG[(mbase + tt) * 256 + g * 16 + lane_] = (bf16)f2bf(gelu_tanh_f(y)); } }
        __syncthreads();
    }
}

DI bool beats(float x, int i, float y, int j) { return x > y || (x == y && i < j); }
DI void p_row_b(Frame& F, const Args& A, int l, bool count = true) {
    FRAME_IDS
    const int gw = F.vcu * NWAVES + wave_, NGW = F.G * NWAVES;
    const bf16* PRE = (const bf16*)(F.ws + WS_PRE); bf16* X1 = (bf16*)(F.ws + WS_X1); bf16* XN = (bf16*)(F.ws + WS_XN);
    const float* mod = (const float*)(F.ws + WS_MOD) + (size_t)l * BATCH * 6 * D;
    const float* ln1g = (const float*)A.in[I_LN1G] + l * D; const float* ln1b = (const float*)A.in[I_LN1B] + l * D;
    const float* rw = (const float*)A.in[I_RW]; const float* rb = (const float*)A.in[I_RB];
    int* slot_a = (int*)(F.ws + WS_SLOT_A); float* slot_w = (float*)(F.ws + WS_SLOT_W);
    LAS float* rwS = (LAS float*)(F.lds + RING_OFF);
    volatile LAS unsigned* lcnt = (volatile LAS unsigned*)(F.lds + RING_OFF + 65536);
    LAS int* list_a = (LAS int*)(F.lds + RING_OFF + 66048); LAS float* list_w = (LAS float*)(F.lds + RING_OFF + 66048 + 8192);
    for (int i = tid_; i < D * NEXP; i += NTHR) rwS[(i & 15) * D + (i >> 4)] = rw[i];
    if (tid_ < 32) lcnt[tid_] = 0u;
    __syncthreads();
    const int hi5 = lane_ >> 5, b4 = (lane_ >> 4) & 1, b3 = (lane_ >> 3) & 1, b2 = (lane_ >> 2) & 1, emine = 8 * hi5 + 4 * b4 + 2 * b3 + b2;
    const int wi = 2 * b3 + b2, mygrp = 2 * hi5 + b4;
    const float rbm = rb[emine];
    Row16 lg1, lb1; row_load_f32(lg1, ln1g, lane_); row_load_f32(lb1, ln1b, lane_);
    v2u nraw[4];
    { const v2u* q = (const v2u*)(PRE + (size_t)gw * D);
#pragma unroll
      for (int k = 0; k < 4; ++k) nraw[k] = q[k * 64 + lane_]; }
    for (int m = gw; m < M; m += NGW) { const int b = m / T; const float* md = mod + (size_t)b * 6 * D;
        Row16 r;
#pragma unroll
        for (int k = 0; k < 4; ++k) { r.v[4 * k] = bflo(nraw[k].x); r.v[4 * k + 1] = bfhi(nraw[k].x); r.v[4 * k + 2] = bflo(nraw[k].y); r.v[4 * k + 3] = bfhi(nraw[k].y); }
        if (m + NGW < M) { const v2u* q = (const v2u*)(PRE + (size_t)(m + NGW) * D);
#pragma unroll
            for (int k = 0; k < 4; ++k) nraw[k] = q[k * 64 + lane_]; }
        Row16 msc, msh; row_load_f32(msc, md + 4 * D, lane_); row_load_f32(msh, md + 3 * D, lane_);
        row_ln(r);
#pragma unroll
        for (int i = 0; i < 16; ++i) r.v[i] = r.v[i] * lg1.v[i] + lb1.v[i];
        row_ln(r);
#pragma unroll
        for (int i = 0; i < 16; ++i) r.v[i] = r.v[i] * (1.0f + msc.v[i]) + msh.v[i];
        row_store_bf16(r, XN + (size_t)m * D, lane_);
        float lg[16];
#pragma unroll
        for (int e = 0; e < 16; ++e) { float a = 0.f;
#pragma unroll
            for (int k = 0; k < 4; ++k) { const f32x4 w4 = *(const LAS f32x4*)(rwS + e * D + 256 * k + 4 * lane_); a += r.v[4 * k] * w4.x + r.v[4 * k + 1] * w4.y + r.v[4 * k + 2] * w4.z + r.v[4 * k + 3] * w4.w; }
            lg[e] = a; }
        float t8[8], t4[4], t2[2];
#pragma unroll
        for (int i = 0; i < 8; ++i) { const float keep = hi5 ? lg[8 + i] : lg[i], give = hi5 ? lg[i] : lg[8 + i]; t8[i] = keep + __shfl_xor(give, 32); }
#pragma unroll
        for (int i = 0; i < 4; ++i) { const float keep = b4 ? t8[4 + i] : t8[i], give = b4 ? t8[i] : t8[4 + i]; t4[i] = keep + __shfl_xor(give, 16); }
#pragma unroll
        for (int i = 0; i < 2; ++i) { const float keep = b3 ? t4[2 + i] : t4[i], give = b3 ? t4[i] : t4[2 + i]; t2[i] = keep + __shfl_xor(give, 8); }
        float z = (b2 ? t2[1] : t2[0]) + __shfl_xor(b2 ? t2[0] : t2[1], 4);
        z += __shfl_xor(z, 2); z += __shfl_xor(z, 1);
        const float scm = 1.0f / (1.0f + __builtin_amdgcn_exp2f(-1.4426950408889634f * z)), a = scm + rbm;
        const float p4 = __shfl_xor(a, 4), p8 = __shfl_xor(a, 8), p12 = __shfl_xor(a, 12);
        const float hi01 = fmaxf(a, p4), lo01 = fminf(a, p4), hi23 = fmaxf(p8, p12), lo23 = fminf(p8, p12);
        const float gs = fmaxf(hi01, hi23) + fmaxf(fmaxf(lo01, lo23), fminf(hi01, hi23));
        const float g16 = __shfl_xor(gs, 16), g32 = __shfl_xor(gs, 32), g48 = __shfl_xor(gs, 48);
        const bool best = beats(gs, mygrp, g16, mygrp ^ 1) && beats(gs, mygrp, g32, mygrp ^ 2) && beats(gs, mygrp, g48, mygrp ^ 3);
        const int rank = (beats(p4, wi ^ 1, a, wi) ? 1 : 0) + (beats(p8, wi ^ 2, a, wi) ? 1 : 0) + (beats(p12, wi ^ 3, a, wi) ? 1 : 0);
        const bool sel = best && rank < 2;
        float tot = sel ? scm : 0.f; tot += __shfl_xor(tot, 4); tot += __shfl_xor(tot, 8);
        if (count && sel && (lane_ & 3) == 0) { const unsigned rk = atomicAdd((unsigned*)&lcnt[emine], 1u);
            list_a[emine * 128 + rk] = 2 * m + rank; list_w[emine * 128 + rk] = scm / tot; }
    }
    __syncthreads();
    if (count) {
        if (tid_ < 16) { const unsigned n = lcnt[tid_]; lcnt[16 + tid_] = n ? atomicAdd((unsigned*)(F.ctl + CW_CNT + l * 128 + tid_), n) : 0u; }
        __syncthreads();
        for (int idx = tid_; idx < 16 * 128; idx += NTHR) { const int e = idx >> 7, rk = idx & 127;
            if (rk < (int)lcnt[e]) { const size_t slot = (size_t)e * SLOT_CAP + lcnt[16 + e] + rk; slot_a[slot] = list_a[idx]; slot_w[slot] = list_w[idx]; } }
    }
}

DI void moe_tstart(Frame& F, int l) {
    FRAME_IDS
    volatile LAS int* ts = (volatile LAS int*)(F.lds + LDSCTL_OFF);
    __syncthreads();
    if (tid_ == 0) { int acc = 0;
        for (int e = 0; e < 16; ++e) { ts[e] = acc; const unsigned c = __hip_atomic_load(F.ctl + CW_CNT + l * 128 + e, RLX_AGENT); ts[32 + e] = (int)c; acc += (int)((c + 255u) >> 8); }
        ts[16] = acc; }
    __syncthreads();
}
DI void p_row_c(Frame& F, const Args& A, int l) {
    FRAME_IDS
    const int gw = F.vcu * NWAVES + wave_, NGW = F.G * NWAVES;
    const bf16* X1 = (const bf16*)(F.ws + WS_PRE); bf16* R2 = (bf16*)(F.ws + WS_ROWS2); bf16* XN = (bf16*)(F.ws + WS_XN);
    const float* ln1g = (const float*)A.in[I_LN1G] + l * D; const float* ln1b = (const float*)A.in[I_LN1B] + l * D;
    Row16 lg1, lb1; row_load_f32(lg1, ln1g, lane_); row_load_f32(lb1, ln1b, lane_);
    const float* mod = (const float*)(F.ws + WS_MOD) + (size_t)l * BATCH * 6 * D;
    const float* modn = (const float*)(F.ws + WS_MOD) + (size_t)(l + 1) * BATCH * 6 * D;
    const float* ln2g = (const float*)A.in[I_LN2G] + l * D; const float* ln2b = (const float*)A.in[I_LN2B] + l * D;
    Row16 lg2, lb2; row_load_f32(lg2, ln2g, lane_); row_load_f32(lb2, ln2b, lane_);
    v2u nx[4], n0[4], n1[4];
#define RC_LOAD(mm) do { const v2u* qa = (const v2u*)(X1 + (size_t)(mm) * D); const v2u* qb = (const v2u*)(R2 + (size_t)(2 * (mm)) * D); \
        _Pragma("unroll") for (int k = 0; k < 4; ++k) { nx[k] = qa[k * 64 + lane_]; n0[k] = qb[k * 64 + lane_]; n1[k] = qb[256 + k * 64 + lane_]; } } while (0)
    RC_LOAD(gw);
    for (int m = gw; m < M; m += NGW) { const int b = m / T; const float* md = mod + (size_t)b * 6 * D;
        Row16 x1, g2;
#pragma unroll
        for (int k = 0; k < 4; ++k) {
            x1.v[4 * k] = bflo(nx[k].x); x1.v[4 * k + 1] = bfhi(nx[k].x); x1.v[4 * k + 2] = bflo(nx[k].y); x1.v[4 * k + 3] = bfhi(nx[k].y);
            g2.v[4 * k] = bflo(n0[k].x) + bflo(n1[k].x); g2.v[4 * k + 1] = bfhi(n0[k].x) + bfhi(n1[k].x); g2.v[4 * k + 2] = bflo(n0[k].y) + bflo(n1[k].y); g2.v[4 * k + 3] = bfhi(n0[k].y) + bfhi(n1[k].y); }
        if (m + NGW < M) RC_LOAD(m + NGW);
        Row16 gm; row_load_f32(gm, md + 5 * D, lane_);
        Row16 msc, msh;
        if (l != DEPTH - 1) { const float* mdn = modn + (size_t)b * 6 * D; row_load_f32(msc, mdn + 1 * D, lane_); row_load_f32(msh, mdn + 0 * D, lane_); }
        row_ln(x1);
#pragma unroll
        for (int i = 0; i < 16; ++i) x1.v[i] = ALPHA * (x1.v[i] * lg1.v[i] + lb1.v[i]) + (1.0f + gm.v[i]) * g2.v[i];
        row_ln(x1);
#pragma unroll
        for (int i = 0; i < 16; ++i) x1.v[i] = x1.v[i] * lg2.v[i] + lb2.v[i];
        if (l == DEPTH - 1) row_store_f32(x1, A.out + (size_t)m * D, lane_);
        else { row_store_bf16(x1, R2 + (size_t)(2 * m) * D, lane_);
            row_ln(x1);
#pragma unroll
            for (int i = 0; i < 16; ++i) x1.v[i] = x1.v[i] * (1.0f + msc.v[i]) + msh.v[i];
            row_store_bf16(x1, XN + (size_t)m * D, lane_); }
    }
#undef RC_LOAD
}

#ifndef PHMASK
#define PHMASK 0xFFFFFFFFu
#endif
#define IN(k) (lo <= (k) && (k) < hi && ((PHMASK >> (((k) == 0) ? 31 : (((k) - 1) % PH_PER_LAYER))) & 1u))
#define SEAM(k) do { if (IN((k) + 1) && MK_ONE_LAUNCH) xcd_barrier(bar); else __syncthreads(); } while (0)
constexpr int PH_PER_LAYER = 9, N_PHASES = 1 + DEPTH * PH_PER_LAYER;
#ifndef REP_PH
#define REP_PH -1
#endif
#define NREP(k) (((k) == REP_PH) ? 2 : 1)
template <int l> DI void layer_body(Frame& F, const Args& args, const XcdBarrier& bar, const int lo, const int hi) {
    unsigned char* ws = args.ws;

        const int pb = 1 + l * PH_PER_LAYER;
        const bf16* WinT = (const bf16*)(ws + WS_WSMALL + l * WSMALL_LAYER + WOFF_IN);
        const bf16* WoutT = (const bf16*)(ws + WS_WSMALL + l * WSMALL_LAYER + WOFF_OUT);
        const bf16* GluT = (const bf16*)(ws + WS_WSMALL + l * WSMALL_LAYER + WOFF_GLU);
        const float* modl = (const float*)(ws + WS_MOD) + (size_t)l * BATCH * 6 * D;
        if (IN(pb + 0)) for (int rep_ = 0; rep_ < NREP(0); ++rep_) { p_wconv(F, args, l, 0); if (l == 0) p_ln_a0(F, args); SEAM(pb + 0); }
        if (IN(pb + 1)) for (int rep_ = 0; rep_ < NREP(1); ++rep_) {
            pg8::Gemm g{(const bf16*)(ws + WS_XN), WinT, M, PROJW, D}; pg8::StaticOrder S; S.init(M, PROJW, F.G, (int)blockIdx.x);
            EpiInProj E{(bf16*)(ws + WS_PROJ), (const float*)(ws + WS_ROPE), args.pad};
            pg8::gemm_phase<EpiInProj, pg8::StaticOrder, PG8_ALIGN, PG8_SP2>(F.lds + RING_OFF, g, S, E);
            if (F.G == 256 && blockIdx.x >= 128) { __syncthreads(); p_wconv(F, args, l, 1); }
            SEAM(pb + 1); }
        if (IN(pb + 2)) for (int rep_ = 0; rep_ < NREP(2); ++rep_) {
#ifndef REP_SUB
#define REP_SUB -1
#endif
#define SUBREP(k) for (int rs_ = 0; rs_ < ((REP_SUB == (k)) ? 2 : 1); ++rs_)
            SUBREP(0) { mix_gating_mfma(F, args, l); __syncthreads(); }
#if REP_SUB >= 10 && REP_SUB < 20
            mix_gating_mfma(F, args, l, REP_SUB - 10); __syncthreads(); mix_gating_mfma(F, args, l); __syncthreads();
#endif
 SUBREP(1) { mix_ssm_in(F, l); } SUBREP(2) { mix_attn_mfma<0>(F, l); __syncthreads(); } SEAM(pb + 2); }
        if (IN(pb + 3)) for (int rep_ = 0; rep_ < NREP(3); ++rep_) { SUBREP(3) { mix_ssm_out(F, args, l); __syncthreads(); } SUBREP(4) { mix_attn_mfma<1>(F, l); __syncthreads(); } SEAM(pb + 3); }
        if (IN(pb + 4)) for (int rep_ = 0; rep_ < NREP(4); ++rep_) { p_glu(F, args, l); SEAM(pb + 4); }
        if (IN(pb + 5)) for (int rep_ = 0; rep_ < NREP(5); ++rep_) {
            pg8::Gemm g{(const bf16*)(ws + WS_MIXCAT), WoutT, M, D, D}; pg8::StaticOrder S; S.init(M, D, F.G, (int)blockIdx.x);
            if (l == 0) { EpiOut<true> E{(bf16*)(ws + WS_PRE), args.in[I_X], D, modl}; pg8::gemm_phase<EpiOut<true>, pg8::StaticOrder, PG8_ALIGN, PG8_SP2>(F.lds + RING_OFF, g, S, E); }
            else { EpiOut<false> E{(bf16*)(ws + WS_PRE), (const void*)(ws + WS_ROWS2), 2 * D, modl}; pg8::gemm_phase<EpiOut<false>, pg8::StaticOrder, PG8_ALIGN, PG8_SP2>(F.lds + RING_OFF, g, S, E); }
            SEAM(pb + 5); }
        if (IN(pb + 6)) { p_row_b(F, args, l); SUBREP(5) { if (REP_SUB == 5 && rs_ == 0) { __syncthreads(); p_row_b(F, args, l, false); } } SEAM(pb + 6); }
        if (IN(pb + 7)) { moe_tstart(F, l);
            gu32* dcnt = F.ctl + CW_DONE + l * 512;
            if (args.pad != 4)
            { pg8::Gemm g{(const bf16*)(ws + WS_XN), (const bf16*)(ws + WS_WGU), NSLOT_MAX, NEXP * 1024, D};
              MoeOrderK<0> S{(const volatile LAS int*)(F.lds + LDSCTL_OFF), F.G, (int)blockIdx.x, (const int*)(ws + WS_SLOT_A), (const float*)(ws + WS_SLOT_W), dcnt, F.ctl + CW_QUEUE + l * 128, (volatile LAS int*)(F.lds + LDSCTL_OFF + 256)}; EpiG1 E{(bf16*)(ws + WS_HID), args.pad};
              pg8::gemm_phase_g<EpiG1, MoeOrderK<0>, PG8_ALIGN, PG8_SP2, 0>(F.lds + RING_OFF, F.lds + GT_OFF, g, S, E); }
            if (args.pad != 3)
            { pg8::Gemm g{(const bf16*)(ws + WS_HID), (const bf16*)(ws + WS_WD), NSLOT_MAX, NEXP * 1024, DEXP};
              MoeOrderK<1> S{(const volatile LAS int*)(F.lds + LDSCTL_OFF), F.G, (int)blockIdx.x, (const int*)(ws + WS_SLOT_A), (const float*)(ws + WS_SLOT_W), dcnt, F.ctl + CW_QUEUE + l * 128, (volatile LAS int*)(F.lds + LDSCTL_OFF + 256)}; EpiG2 E{(bf16*)(ws + WS_ROWS2), args.pad};
              pg8::gemm_phase_g<EpiG2, MoeOrderK<1>, PG8_ALIGN, PG8_SP2, 0>(F.lds + RING_OFF, F.lds + GT_OFF, g, S, E); }
            SEAM(pb + 7); }
        if (IN(pb + 8)) { p_row_c(F, args, l); SUBREP(6) { if (REP_SUB == 6 && rs_ == 0 && l == DEPTH - 1) { __syncthreads(); p_row_c(F, args, l); } } SEAM(pb + 8); }
    }
__global__ void __launch_bounds__(NTHR, 2) mk_fwd(Args args) {
    extern __shared__ __attribute__((aligned(16))) unsigned char lds[];
    Frame F;
    F.lds = (LAS unsigned char*)lds; F.MISC = (volatile LAS unsigned*)(F.lds + MISC_OFF);
    F.G = gridDim.x; { const int bx = blockIdx.x; F.vcu = (F.G % 8 == 0) ? (bx % 8) * (F.G / 8) + bx / 8 : bx; }
    F.ws = args.ws; F.ctl = (gu32*)(args.ws + WS_CTL);
    for (int u = ftid(); u < (LDS_BYTES - LDSCTL_OFF) / 4; u += NTHR) ((LAS unsigned*)(F.lds + LDSCTL_OFF))[u] = 0u;
    __syncthreads();
    XcdBarrier bar; bar.bar = (unsigned*)(F.ctl + CW_BAR); bar.x = 0; bar.st = nullptr;
    if (MK_ONE_LAUNCH) bar = xcd_barrier_post((unsigned*)(F.ctl + CW_BAR), F.MISC + 8);
    const int lo = args.ph_lo, hi = args.ph_hi;
    unsigned char* ws = args.ws; (void)ws;
    if (IN(0)) { p0_tables(F, args); SEAM(0); }
    layer_body<0>(F, args, bar, lo, hi);
    layer_body<1>(F, args, bar, lo, hi);
#ifdef EXTRA_BARS
    if (MK_ONE_LAUNCH) for (int xb_ = 0; xb_ < EXTRA_BARS; ++xb_) xcd_barrier(bar);
#endif
#undef IN
#undef SEAM
}

extern "C" void kernel_launch(void* const* d_in, const int* in_sizes, int n_in, void* d_out, int out_size, void* d_ws, size_t ws_size, hipStream_t stream) {
    static int grid = 0;
    if (grid == 0) {
        if (n_in != 30 || in_sizes[0] != M * D || out_size != M * D || ws_size < WS_END) { fprintf(stderr, "kernel_launch: unexpected shapes (n_in %d, in0 %d, out %d, ws %zu, need %zu)\n", n_in, n_in > 0 ? in_sizes[0] : -1, out_size, ws_size, (size_t)WS_END); grid = -1; return; }
        int dev = 0, cus = 0, per_cu = 0;
        if (hipGetDevice(&dev) != hipSuccess || hipDeviceGetAttribute(&cus, hipDeviceAttributeMultiprocessorCount, dev) != hipSuccess) { grid = -1; return; }
        if (hipFuncSetAttribute((const void*)mk_fwd, hipFuncAttributeMaxDynamicSharedMemorySize, LDS_BYTES) != hipSuccess) { fprintf(stderr, "kernel_launch: hipFuncSetAttribute failed\n"); grid = -1; return; }
        if (hipOccupancyMaxActiveBlocksPerMultiprocessor(&per_cu, (const void*)mk_fwd, NTHR, LDS_BYTES) != hipSuccess || per_cu < 1) fprintf(stderr, "kernel_launch: occupancy query says %d\n", per_cu);
        (void)hipGetLastError();
        grid = cus;
    }
    if (grid < 0) return;
    if (hipMemsetAsync((char*)d_ws + WS_CTL, 0, CTL_ZERO_BYTES, stream) != hipSuccess) return;
    Args a{};
    for (int i = 0; i < 30; ++i) a.in[i] = d_in[i];
    a.out = (float*)d_out; a.ws = (unsigned char*)d_ws;
#if MK_ONE_LAUNCH
    a.ph_lo = 0; a.ph_hi = N_PHASES; a.li = 0;
    hipLaunchKernelGGL(mk_fwd, dim3(grid), dim3(NTHR), LDS_BYTES, stream, a);
#else
#ifndef REP_GLOBAL
#define REP_GLOBAL -1
#endif
#ifndef PROBE_SKIP
#define PROBE_SKIP 1
#endif
#ifndef REP_COUNT
#define REP_COUNT 2
#endif
    for (int p = 0; p < N_PHASES; ++p) { a.ph_lo = p; a.ph_hi = p + 1; a.li = p;
        const int nrep = ((p == 0 ? 100 : (p - 1) % PH_PER_LAYER) == REP_GLOBAL) ? REP_COUNT : 1;
        for (int r = 0; r < nrep; ++r) { a.pad = r ? PROBE_SKIP : 0; hipLaunchKernelGGL(mk_fwd, dim3(grid), dim3(NTHR), LDS_BYTES, stream, a); } a.pad = 0; }
#endif
}
```

```cpp
#include <hip/hip_runtime.h>
#include <cstdio>
#include <cstdint>
namespace pg8 {
#define PG8_LAS __attribute__((address_space(3)))
typedef unsigned short bf16_t;
typedef short bf16x8 __attribute__((ext_vector_type(8)));
typedef float f32x4 __attribute__((ext_vector_type(4)));
typedef unsigned u32x4 __attribute__((ext_vector_type(4)));
constexpr int BM = 256, BK = 64, HALF = 128, HTB = HALF * BK * 2  , STAGE_BYTES = 8 * HTB, NXCD = 8, WGM = 8;

__host__ __device__ __forceinline__ int lds_byte(int r, int c) { const int st = (r >> 4) * 2 + (c >> 5), rr = r & 15, cc = c & 31, ob = rr * 64 + cc * 2; return st * 1024 + (ob ^ (((ob >> 9) & 1) << 5)); }
__host__ __device__ __forceinline__ void stage_rc(int b, int& R, int& C) { const int st = b / 1024, sb = b % 1024, swz = sb ^ (((sb >> 9) & 1) << 5); R = (st >> 1) * 16 + swz / 64; C = (st & 1) * 32 + (swz % 64) / 2; }
__host__ __device__ __forceinline__ int perm32(int rho) { const int n = rho >> 4, i = rho & 15; return 8 * (i >> 2) + 4 * n + (i & 3); }

struct Unit { int pm, pn; };
struct Gemm { const bf16_t* A; const bf16_t* Bt; int M, N, K; };

struct StaticOrder {
    int nM, nN, nwg, G, c;
    __host__ __device__ void init(int M, int N, int G_, int c_) { nM = M / BM; nN = N / BM; nwg = nM * nN; G = G_; c = c_; }
    __host__ __device__ bool next(int i, Unit& u) const {
        const long L = (long)i * G + c; if (L >= nwg) return false;
        int wgid = (int)L; { const int q = nwg / NXCD, r = nwg % NXCD, xcd = wgid % NXCD, off = wgid / NXCD; wgid = (xcd < r ? xcd * (q + 1) : r * (q + 1) + (xcd - r) * q) + off; }
        const int nig = WGM * nN, gid = wgid / nig, fm = gid * WGM, gsz = (nM - fm) < WGM ? (nM - fm) : WGM;
        u.pm = fm + ((wgid % nig) % gsz); u.pn = (wgid % nig) / gsz; return true;
    }
    __device__ __forceinline__ void a_ready(const Unit&) const {}
    __device__ __forceinline__ void done(const Unit&) const {}
};

__device__ __forceinline__ unsigned cvt_pk_bf16(float lo, float hi) { unsigned r; asm volatile("v_cvt_pk_bf16_f32 %0, %1, %2" : "=v"(r) : "v"(lo), "v"(hi)); return r; }
template <class Epi, class Sched, bool ALIGN_EPI = false, bool SP2 = false>
__device__ __forceinline__ void gemm_phase(PG8_LAS unsigned char* lds, const Gemm g, const Sched& S, const Epi& E) {
    const int tid = threadIdx.x, wid = __builtin_amdgcn_readfirstlane(tid >> 6), lane = tid & 63, wr = wid >> 2, wc = wid & 3, fr = lane & 15, fq = lane >> 4;
    const int K = g.K, nt = K / BK;
    unsigned voffA[2], voffB[2];
#pragma unroll
    for (int i = 0; i < 2; ++i) { int R, C; stage_rc(tid * 16 + i * 8192, R, C); const int Rb = Epi::PERM ? ((R & ~31) + perm32(R & 31)) : R;
        voffA[i] = (unsigned)(R * K + C) * 2u; voffB[i] = (unsigned)(Rb * K + C) * 2u; }
    const size_t kstep = (size_t)(BK * 2);
    const size_t hstep = (size_t)HALF * K * 2;
    const size_t tstep = 2 * hstep;
    const unsigned ldsw = (unsigned)wid * 1024u;
    const int aoff = lds_byte(wr * 64 + fr, fq * 8), boff = lds_byte(wc * 32 + fr, fq * 8);
#define PG8_SA(b, h) (((b) * 2 + (h)) * HTB)
#define PG8_SB(b, h) ((4 + (b) * 2 + (h)) * HTB)
#define PG8_STAGE(bufoff, gbase, voff) do { _Pragma("unroll") for (int _i = 0; _i < 2; ++_i) \
        __builtin_amdgcn_global_load_lds((const unsigned*)((const char*)(gbase) + (voff)[_i]), (PG8_LAS unsigned*)(lds + (bufoff) + ldsw + _i * 8192), 16, 0, 0); } while (0)
#define PG8_LDA(dst, b, h) do { _Pragma("unroll") for (int m = 0; m < 4; ++m) _Pragma("unroll") for (int k = 0; k < 2; ++k) dst[m][k] = *(const PG8_LAS bf16x8*)(lds + PG8_SA(b, h) + aoff + m * 2048 + k * 1024); } while (0)
#define PG8_LDB(dst, b, h) do { _Pragma("unroll") for (int n = 0; n < 2; ++n) _Pragma("unroll") for (int k = 0; k < 2; ++k) dst[n][k] = *(const PG8_LAS bf16x8*)(lds + PG8_SB(b, h) + boff + n * 2048 + k * 1024); } while (0)
#define PG8_MMA(ai, bj, At, Bt) do { __builtin_amdgcn_s_setprio(1); _Pragma("unroll") for (int m = 0; m < 4; ++m) _Pragma("unroll") for (int n = 0; n < 2; ++n) _Pragma("unroll") for (int k = 0; k < 2; ++k) \
        acc[ai][bj][m][n] = __builtin_amdgcn_mfma_f32_16x16x32_bf16(Bt[n][k], At[m][k], acc[ai][bj][m][n], 0, 0, 0); __builtin_amdgcn_s_setprio(0); } while (0)
#define PG8_WAIT_V(n) asm volatile("s_waitcnt vmcnt(" #n ")" ::: "memory")
#define PG8_WAIT_L(n) asm volatile("s_waitcnt lgkmcnt(" #n ")" ::: "memory")
#define PG8_BAR __builtin_amdgcn_s_barrier()
#define PG8_SCHED __builtin_amdgcn_sched_barrier(0)
    Unit cur, nxt; int ui = 0;
    if (!S.next(0, cur)) return;
    f32x4 acc[2][2][4][2];
#pragma unroll
    for (int a = 0; a < 2; ++a)
#pragma unroll
        for (int b = 0; b < 2; ++b)
#pragma unroll
            for (int m = 0; m < 4; ++m)
#pragma unroll
                for (int n = 0; n < 2; ++n) acc[a][b][m][n] = (f32x4){0.f, 0.f, 0.f, 0.f};
    bf16x8 At[4][2], B0[2][2], B1[2][2];
    const char* cA = (const char*)g.A + (size_t)cur.pm * tstep; const char* cB = (const char*)g.Bt + (size_t)cur.pn * tstep;
    S.a_ready(cur);
    if constexpr (SP2) {
        PG8_STAGE(PG8_SB(0, 0), cB, voffB); PG8_STAGE(PG8_SB(0, 1), cB + hstep, voffB); PG8_STAGE(PG8_SA(0, 0), cA, voffA); PG8_STAGE(PG8_SA(0, 1), cA + hstep, voffA);
        if (wr == 1) PG8_BAR;
        PG8_WAIT_V(2); PG8_BAR;
        PG8_STAGE(PG8_SB(1, 0), cB + kstep, voffB); PG8_STAGE(PG8_SA(1, 0), cA + kstep, voffA); PG8_STAGE(PG8_SB(1, 1), cB + hstep + kstep, voffB);
        PG8_WAIT_V(6); PG8_BAR;
    } else {
        PG8_STAGE(PG8_SB(0, 0), cB, voffB); PG8_STAGE(PG8_SA(0, 0), cA, voffA); PG8_STAGE(PG8_SB(0, 1), cB + hstep, voffB); PG8_STAGE(PG8_SA(0, 1), cA + hstep, voffA);
        if (wr == 1) PG8_BAR;
        PG8_WAIT_V(4); PG8_BAR;
        PG8_STAGE(PG8_SB(1, 0), cB + kstep, voffB); PG8_STAGE(PG8_SA(1, 0), cA + kstep, voffA); PG8_STAGE(PG8_SB(1, 1), cB + hstep + kstep, voffB);
        PG8_WAIT_V(6); PG8_BAR;
    }
    for (;;) {
        const bool has_next = S.next(ui + 1, nxt);
        const char* nA = has_next ? (const char*)g.A + (size_t)nxt.pm * tstep : cA; const char* nB = has_next ? (const char*)g.Bt + (size_t)nxt.pn * tstep : cB;
        for (int t = 0; t < nt; t += 2) {
            const bool last = (t == nt - 2);
            const char* a1 = cA + (size_t)(t + 1) * kstep;
            const char* a2 = last ? nA : cA + (size_t)(t + 2) * kstep; const char* b2 = last ? nB : cB + (size_t)(t + 2) * kstep;
            const char* a3 = a2 + kstep; const char* b3 = b2 + kstep;
            if (last && has_next) S.a_ready(nxt);
            if constexpr (SP2) {
            PG8_LDB(B0, 0, 0); PG8_LDB(B1, 0, 1); PG8_SCHED; PG8_LDA(At, 0, 0); PG8_STAGE(PG8_SA(1, 1), a1 + hstep, voffA);
            PG8_WAIT_V(8); PG8_WAIT_L(0); PG8_BAR; PG8_MMA(0, 0, At, B0); PG8_MMA(0, 1, At, B1); PG8_BAR; PG8_SCHED;
            PG8_LDA(At, 0, 1); PG8_STAGE(PG8_SB(0, 0), b2, voffB); PG8_STAGE(PG8_SB(0, 1), b2 + hstep, voffB); PG8_STAGE(PG8_SA(0, 0), a2, voffA);
            PG8_WAIT_V(8); PG8_WAIT_L(0); PG8_BAR; PG8_MMA(1, 0, At, B0); PG8_MMA(1, 1, At, B1); PG8_BAR; PG8_SCHED;
            PG8_LDB(B0, 1, 0); PG8_LDB(B1, 1, 1); PG8_SCHED; PG8_LDA(At, 1, 0); PG8_STAGE(PG8_SA(0, 1), a2 + hstep, voffA);
            PG8_WAIT_V(8); PG8_WAIT_L(0); PG8_BAR; PG8_MMA(0, 0, At, B0); PG8_MMA(0, 1, At, B1); PG8_BAR; PG8_SCHED;
            PG8_LDA(At, 1, 1); PG8_STAGE(PG8_SB(1, 0), b3, voffB); PG8_STAGE(PG8_SB(1, 1), b3 + hstep, voffB); PG8_STAGE(PG8_SA(1, 0), a3, voffA);
            PG8_WAIT_V(8); PG8_WAIT_L(0); PG8_BAR; PG8_MMA(1, 0, At, B0); PG8_MMA(1, 1, At, B1); PG8_BAR; PG8_SCHED;
            } else {
            PG8_LDB(B0, 0, 0); PG8_SCHED; PG8_LDA(At, 0, 0); PG8_STAGE(PG8_SA(1, 1), a1 + hstep, voffA);
            PG8_WAIT_L(8); PG8_BAR; PG8_WAIT_L(0); PG8_MMA(0, 0, At, B0); PG8_BAR; PG8_SCHED;
            PG8_LDB(B1, 0, 1); PG8_STAGE(PG8_SB(0, 0), b2, voffB);
            PG8_BAR; PG8_WAIT_L(0); PG8_MMA(0, 1, At, B1); PG8_BAR;
            PG8_LDA(At, 0, 1); PG8_STAGE(PG8_SA(0, 0), a2, voffA);
            PG8_BAR; PG8_WAIT_L(0); PG8_MMA(1, 0, At, B0); PG8_BAR; PG8_SCHED;
            PG8_STAGE(PG8_SB(0, 1), b2 + hstep, voffB);
            PG8_WAIT_V(6); PG8_BAR; PG8_MMA(1, 1, At, B1); PG8_BAR;
            PG8_LDB(B0, 1, 0); PG8_SCHED; PG8_LDA(At, 1, 0); PG8_STAGE(PG8_SA(0, 1), a2 + hstep, voffA);
            PG8_WAIT_L(8); PG8_BAR; PG8_WAIT_L(0); PG8_MMA(0, 0, At, B0); PG8_BAR; PG8_SCHED;
            PG8_LDB(B1, 1, 1); PG8_STAGE(PG8_SB(1, 0), b3, voffB);
            PG8_BAR; PG8_WAIT_L(0); PG8_MMA(0, 1, At, B1); PG8_BAR;
            PG8_LDA(At, 1, 1); PG8_STAGE(PG8_SA(1, 0), a3, voffA);
            PG8_BAR; PG8_WAIT_L(0); PG8_MMA(1, 0, At, B0); PG8_BAR; PG8_SCHED;
            PG8_STAGE(PG8_SB(1, 1), b3 + hstep, voffB);
            PG8_WAIT_V(6); PG8_BAR; PG8_MMA(1, 1, At, B1); PG8_BAR;
            }
        }
        if constexpr (ALIGN_EPI) { if (wr == 0) PG8_BAR; }
        if constexpr (!Epi::AFTER_DRAIN) { E(acc, cur, wr, wc, fr, fq); S.done(cur); }
        if (!has_next) break;
#pragma unroll
        for (int a = 0; a < 2; ++a)
#pragma unroll
            for (int b = 0; b < 2; ++b)
#pragma unroll
                for (int m = 0; m < 4; ++m)
#pragma unroll
                    for (int n = 0; n < 2; ++n) acc[a][b][m][n] = (f32x4){0.f, 0.f, 0.f, 0.f};
        cur = nxt; cA = nA; cB = nB; ++ui;
        if constexpr (ALIGN_EPI) { if (wr == 1) PG8_BAR; }
    }
    PG8_WAIT_V(0);
    if constexpr (!ALIGN_EPI) { if (wr == 0) PG8_BAR; }
    PG8_BAR;
    if constexpr (Epi::AFTER_DRAIN) { E.fused(acc, cur, wr, wc, fr, fq, lds, wid, lane); S.done(cur); }
#undef PG8_SA
#undef PG8_SB
#undef PG8_STAGE
#undef PG8_LDA
#undef PG8_LDB
#undef PG8_MMA
#undef PG8_WAIT_V
#undef PG8_WAIT_L
#undef PG8_BAR
#undef PG8_SCHED
}
template <class Epi, class Sched, bool ALIGN_EPI = false, bool SP2 = false, int AUXA = 0>
__device__ __forceinline__ void gemm_phase_g(PG8_LAS unsigned char* lds, PG8_LAS unsigned char* gt, const Gemm g, const Sched& S, const Epi& E) {
    const int tid = threadIdx.x, wid = __builtin_amdgcn_readfirstlane(tid >> 6), lane = tid & 63, wr = wid >> 2, wc = wid & 3, fr = lane & 15, fq = lane >> 4;
    const int K = g.K, nt = K / BK;
    unsigned gpk[2], voffB[2];
#pragma unroll
    for (int i = 0; i < 2; ++i) { int R, C; stage_rc(tid * 16 + i * 8192, R, C); const int Rb = Epi::PERM ? ((R & ~31) + perm32(R & 31)) : R;
        gpk[i] = (unsigned)(R * 4) | ((unsigned)(C * 2) << 16); voffB[i] = (unsigned)(Rb * K + C) * 2u; }
    int par = 0;
    const size_t kstep = (size_t)(BK * 2);
    const size_t hstep = (size_t)HALF * K * 2;
    const size_t tstep = 2 * hstep;
    const unsigned ldsw = (unsigned)wid * 1024u;
    const int aoff = lds_byte(wr * 64 + fr, fq * 8), boff = lds_byte(wc * 32 + fr, fq * 8);
#define PG8_SA(b, h) (((b) * 2 + (h)) * HTB)
#define PG8_SB(b, h) ((4 + (b) * 2 + (h)) * HTB)
#define PG8_STAGE(bufoff, gbase, voff) do { _Pragma("unroll") for (int _i = 0; _i < 2; ++_i) \
        __builtin_amdgcn_global_load_lds((const unsigned*)((const char*)(gbase) + (voff)[_i]), (PG8_LAS unsigned*)(lds + (bufoff) + ldsw + _i * 8192), 16, 0, 0); } while (0)
#define PG8_STAGE_A(bufoff, h, kbyte, PAR) do { _Pragma("unroll") for (int _i = 0; _i < 2; ++_i) { \
        const unsigned _ro = *(const PG8_LAS unsigned*)(gt + ((PAR) * 768 + (h) * 128) * 4 + (gpk[_i] & 0xffffu)); \
        __builtin_amdgcn_global_load_lds((const unsigned*)((const char*)g.A + (size_t)(kbyte) + _ro + (gpk[_i] >> 16)), (PG8_LAS unsigned*)(lds + (bufoff) + ldsw + _i * 8192), 16, 0, AUXA); } } while (0)
#define PG8_FILL(u, PAR, PF, UI) do { S.wait_ready(u, tid, PF); if (tid < 256) { unsigned o_, a0_, a1_; S.finish_meta(u, tid, PF, o_, a0_, a1_); PG8_LAS unsigned* t_ = (PG8_LAS unsigned*)(gt + ((PAR) * 768 + tid) * 4); t_[0] = o_; t_[256] = a0_; t_[512] = a1_; } S.pull_publish(tid, PF, UI); asm volatile("s_waitcnt lgkmcnt(0)" ::: "memory"); __builtin_amdgcn_s_barrier(); asm volatile("" ::: "memory"); } while (0)
#define PG8_LDA(dst, b, h) do { _Pragma("unroll") for (int m = 0; m < 4; ++m) _Pragma("unroll") for (int k = 0; k < 2; ++k) dst[m][k] = *(const PG8_LAS bf16x8*)(lds + PG8_SA(b, h) + aoff + m * 2048 + k * 1024); } while (0)
#define PG8_LDB(dst, b, h) do { _Pragma("unroll") for (int n = 0; n < 2; ++n) _Pragma("unroll") for (int k = 0; k < 2; ++k) dst[n][k] = *(const PG8_LAS bf16x8*)(lds + PG8_SB(b, h) + boff + n * 2048 + k * 1024); } while (0)
#define PG8_MMA(ai, bj, At, Bt) do { __builtin_amdgcn_s_setprio(1); _Pragma("unroll") for (int m = 0; m < 4; ++m) _Pragma("unroll") for (int n = 0; n < 2; ++n) _Pragma("unroll") for (int k = 0; k < 2; ++k) \
        acc[ai][bj][m][n] = __builtin_amdgcn_mfma_f32_16x16x32_bf16(Bt[n][k], At[m][k], acc[ai][bj][m][n], 0, 0, 0); __builtin_amdgcn_s_setprio(0); } while (0)
#define PG8_WAIT_V(n) asm volatile("s_waitcnt vmcnt(" #n ")" ::: "memory")
#define PG8_WAIT_L(n) asm volatile("s_waitcnt lgkmcnt(" #n ")" ::: "memory")
#define PG8_BAR __builtin_amdgcn_s_barrier()
#define PG8_SCHED __builtin_amdgcn_sched_barrier(0)
    Unit cur, nxt; int ui = 0;
    if (!S.first(cur)) return;
    f32x4 acc[2][2][4][2];
#pragma unroll
    for (int a = 0; a < 2; ++a)
#pragma unroll
        for (int b = 0; b < 2; ++b)
#pragma unroll
            for (int m = 0; m < 4; ++m)
#pragma unroll
                for (int n = 0; n < 2; ++n) acc[a][b][m][n] = (f32x4){0.f, 0.f, 0.f, 0.f};
    bf16x8 At[4][2], B0[2][2], B1[2][2];
    const char* cB = (const char*)g.Bt + (size_t)cur.pn * tstep;
    typename Sched::Pf pf; S.prefetch(cur, tid, pf); PG8_FILL(cur, 0, pf, -1);
    Unit pend; bool has_pend = false;
    if constexpr (SP2) {
        PG8_STAGE(PG8_SB(0, 0), cB, voffB); PG8_STAGE(PG8_SB(0, 1), cB + hstep, voffB); PG8_STAGE_A(PG8_SA(0, 0), 0, 0, par); PG8_STAGE_A(PG8_SA(0, 1), 1, 0, par);
        if (wr == 1) PG8_BAR;
        PG8_WAIT_V(2); PG8_BAR;
        PG8_STAGE(PG8_SB(1, 0), cB + kstep, voffB); PG8_STAGE_A(PG8_SA(1, 0), 0, kstep, par); PG8_STAGE(PG8_SB(1, 1), cB + hstep + kstep, voffB);
        PG8_WAIT_V(6); PG8_BAR;
    } else {
        PG8_STAGE(PG8_SB(0, 0), cB, voffB); PG8_STAGE_A(PG8_SA(0, 0), 0, 0, par); PG8_STAGE(PG8_SB(0, 1), cB + hstep, voffB); PG8_STAGE_A(PG8_SA(0, 1), 1, 0, par);
        if (wr == 1) PG8_BAR;
        PG8_WAIT_V(4); PG8_BAR;
        PG8_STAGE(PG8_SB(1, 0), cB + kstep, voffB); PG8_STAGE_A(PG8_SA(1, 0), 0, kstep, par); PG8_STAGE(PG8_SB(1, 1), cB + hstep + kstep, voffB);
        PG8_WAIT_V(6); PG8_BAR;
    }
    for (;;) {
        const bool has_next = S.more(ui + 1, nxt);
        if (has_next) { S.prefetch(nxt, tid, pf); S.pull_issue(tid, pf); }
        const char* nB = has_next ? (const char*)g.Bt + (size_t)nxt.pn * tstep : cB;
        for (int t = 0; t < nt; t += 2) {
            const bool last = (t == nt - 2);
            const char* b2 = last ? nB : cB + (size_t)(t + 2) * kstep;
            const char* b3 = b2 + kstep;
            if (last && has_next) PG8_FILL(nxt, par ^ 1, pf, ui);
            const size_t kA2 = last ? (size_t)0 : (size_t)(t + 2) * kstep; const int pA2 = (last && has_next) ? (par ^ 1) : par;
            if constexpr (SP2) {
            PG8_LDB(B0, 0, 0); PG8_LDB(B1, 0, 1); PG8_SCHED; PG8_LDA(At, 0, 0); PG8_STAGE_A(PG8_SA(1, 1), 1, (size_t)(t + 1) * kstep, par);
            PG8_WAIT_V(8); PG8_WAIT_L(0); PG8_BAR; PG8_MMA(0, 0, At, B0); PG8_MMA(0, 1, At, B1); PG8_BAR; PG8_SCHED;
            PG8_LDA(At, 0, 1); PG8_STAGE(PG8_SB(0, 0), b2, voffB); PG8_STAGE(PG8_SB(0, 1), b2 + hstep, voffB); PG8_STAGE_A(PG8_SA(0, 0), 0, kA2, pA2);
            PG8_WAIT_V(8); PG8_WAIT_L(0); PG8_BAR; PG8_MMA(1, 0, At, B0); PG8_MMA(1, 1, At, B1); PG8_BAR; PG8_SCHED;
            PG8_LDB(B0, 1, 0); PG8_LDB(B1, 1, 1); PG8_SCHED; PG8_LDA(At, 1, 0); PG8_STAGE_A(PG8_SA(0, 1), 1, kA2, pA2);
            PG8_WAIT_V(8); PG8_WAIT_L(0); PG8_BAR; PG8_MMA(0, 0, At, B0); PG8_MMA(0, 1, At, B1); PG8_BAR; PG8_SCHED;
            PG8_LDA(At, 1, 1); PG8_STAGE(PG8_SB(1, 0), b3, voffB); PG8_STAGE(PG8_SB(1, 1), b3 + hstep, voffB); PG8_STAGE_A(PG8_SA(1, 0), 0, kA2 + kstep, pA2);
            PG8_WAIT_V(8); PG8_WAIT_L(0); PG8_BAR; PG8_MMA(1, 0, At, B0); PG8_MMA(1, 1, At, B1); PG8_BAR; PG8_SCHED;
            } else {
            PG8_LDB(B0, 0, 0); PG8_SCHED; PG8_LDA(At, 0, 0); PG8_STAGE_A(PG8_SA(1, 1), 1, (size_t)(t + 1) * kstep, par);
            PG8_WAIT_L(8); PG8_BAR; PG8_WAIT_L(0); PG8_MMA(0, 0, At, B0); PG8_BAR; PG8_SCHED;
            PG8_LDB(B1, 0, 1); PG8_STAGE(PG8_SB(0, 0), b2, voffB);
            PG8_BAR; PG8_WAIT_L(0); PG8_MMA(0, 1, At, B1); PG8_BAR;
            PG8_LDA(At, 0, 1); PG8_STAGE_A(PG8_SA(0, 0), 0, kA2, pA2);
            PG8_BAR; PG8_WAIT_L(0); PG8_MMA(1, 0, At, B0); PG8_BAR; PG8_SCHED;
            PG8_STAGE(PG8_SB(0, 1), b2 + hstep, voffB);
            PG8_WAIT_V(6); PG8_BAR; PG8_MMA(1, 1, At, B1); PG8_BAR;
            PG8_LDB(B0, 1, 0); PG8_SCHED; PG8_LDA(At, 1, 0); PG8_STAGE_A(PG8_SA(0, 1), 1, kA2, pA2);
            PG8_WAIT_L(8); PG8_BAR; PG8_WAIT_L(0); PG8_MMA(0, 0, At, B0); PG8_BAR; PG8_SCHED;
            PG8_LDB(B1, 1, 1); PG8_STAGE(PG8_SB(1, 0), b3, voffB);
            PG8_BAR; PG8_WAIT_L(0); PG8_MMA(0, 1, At, B1); PG8_BAR;
            PG8_LDA(At, 1, 1); PG8_STAGE_A(PG8_SA(1, 0), 0, kA2 + kstep, pA2);
            PG8_BAR; PG8_WAIT_L(0); PG8_MMA(1, 0, At, B0); PG8_BAR; PG8_SCHED;
            PG8_STAGE(PG8_SB(1, 1), b3 + hstep, voffB);
            PG8_WAIT_V(6); PG8_BAR; PG8_MMA(1, 1, At, B1); PG8_BAR;
            }
        }
        if constexpr (ALIGN_EPI) { if (wr == 0) PG8_BAR; }
        if constexpr (!Epi::AFTER_DRAIN) { if (has_pend) S.done_nowait(pend);     E(acc, cur, wr, wc, fr, fq, (const PG8_LAS unsigned*)(gt + par * 3072)); pend = cur; has_pend = true; }
        if (!has_next) break;
#pragma unroll
        for (int a = 0; a < 2; ++a)
#pragma unroll
            for (int b = 0; b < 2; ++b)
#pragma unroll
                for (int m = 0; m < 4; ++m)
#pragma unroll
                    for (int n = 0; n < 2; ++n) acc[a][b][m][n] = (f32x4){0.f, 0.f, 0.f, 0.f};
        cur = nxt; cB = nB; ++ui; par ^= 1;
        if constexpr (ALIGN_EPI) { if (wr == 1) PG8_BAR; }
    }
    PG8_WAIT_V(0);
    if constexpr (!ALIGN_EPI) { if (wr == 0) PG8_BAR; }
    PG8_BAR;
    if (has_pend) S.done_nowait(pend);
#undef PG8_SA
#undef PG8_SB
#undef PG8_STAGE
#undef PG8_STAGE_A
#undef PG8_FILL
#undef PG8_LDA
#undef PG8_LDB
#undef PG8_MMA
#undef PG8_WAIT_V
#undef PG8_WAIT_L
#undef PG8_BAR
#undef PG8_SCHED
}
}

#ifndef PG8_SP2
#define PG8_SP2 true
#endif
#ifndef PG8_ALIGN
#define PG8_ALIGN true
#endif
#ifndef MK_ONE_LAUNCH
#define MK_ONE_LAUNCH 1
#endif

constexpr int NWAVES = 8, NTHR = 512;
constexpr int BATCH = 8, T = 4096, D = 1024, M = BATCH * T, DEPTH = 2;
constexpr int PROJW = 2304, AW = 256, BW = 512, CW = 256, NH = 8, HD = 64;
constexpr int COL_U = 0, COL_V = 256, COL_Q = 512, COL_K = 1024, COL_VA = 1536, COL_S = 2048;
constexpr int NEXP = 16, DEXP = 512, NGRP = 4;
constexpr int SSM_G = 16, SSM_N = 64, SSM_C = 16;
constexpr float LN_EPS = 1e-5f;
constexpr float ALPHA = 1.41421356237309515f;
constexpr float QSCALE = 0.125f * 1.4426950408889634f;
constexpr int NSLOT_MAX = 2 * M + NEXP * 256;

constexpr size_t MiB = 1u << 20;
constexpr size_t WS_CTL = 0, CTL_ZERO_BYTES = 1 * MiB;
constexpr size_t WS_MOD = 1 * MiB;
constexpr size_t WS_ROPE = WS_MOD + 512 * 1024;
constexpr size_t WS_SSM = WS_ROPE + 2 * MiB;
constexpr int SSM_TAB = 2 * 1024 + 2 * 16384;
constexpr int SLOT_CAP = 32768;
constexpr size_t WS_SLOT_A = 4 * MiB;
constexpr size_t WS_WSMALL = 6 * MiB;
constexpr size_t WSMALL_LAYER = 7 * MiB, WOFF_IN = 0, WOFF_OUT = (size_t)PROJW * D * 2, WOFF_GLU = WOFF_OUT + (size_t)D * D * 2;
constexpr size_t WS_WGU = 20 * MiB;
constexpr size_t WS_WD = 52 * MiB;
constexpr size_t WS_XN = 68 * MiB;
constexpr size_t WS_YG = 132 * MiB;
constexpr size_t WS_R = 148 * MiB;
constexpr size_t WS_PROJ = WS_R, WS_MIXCAT = WS_R + 144 * MiB, WS_PRE = WS_R, WS_HID = WS_R + 64 * MiB, WS_X1 = WS_R + 132 * MiB;
constexpr size_t WS_ROWS2 = 356 * MiB;
constexpr size_t WS_STAT = 356 * MiB + (size_t)2 * M * D * 2;
constexpr size_t WS_SSM2 = WS_STAT + 4 * MiB;
constexpr size_t SSM2_LAYER = 3 * MiB, S2_APW = 0, S2_KT = 288 * 1024, S2_CT = S2_KT + 256 * 1024, S2_WIN = S2_CT + 64 * 1024, S2_GW = S2_WIN + 2 * MiB;
static_assert(S2_GW + 4 * 128 * 128 * 2 <= SSM2_LAYER, "ssm2 tables");
constexpr size_t WS_XLOC = WS_SSM2 + 2 * SSM2_LAYER;
constexpr size_t WS_XSUP = WS_XLOC + 8 * MiB;
constexpr size_t WS_SLOT_W = WS_XSUP + 512 * 1024;
constexpr size_t WS_END = WS_SLOT_W + 2 * MiB;
static_assert(WOFF_GLU + 256 * 256 * 2 <= WSMALL_LAYER && WS_WSMALL + 2 * WSMALL_LAYER <= WS_WGU, "ws map");
static_assert(WS_SSM + 2 * SSM_TAB * 4 <= WS_SLOT_A && WS_HID + (size_t)NSLOT_MAX * DEXP * 2 <= WS_X1 && WS_X1 + (size_t)M * D * 2 <= WS_ROWS2, "ws map 2");
constexpr int CW_TMO = 0;
constexpr int CW_BAR = 4096;
constexpr int CW_CNT = 8192;
constexpr int CW_QUEUE = 11264;
constexpr int CW_DONE = 12288;

constexpr int RING_OFF = 0, RING_BYTES = 131072;
constexpr int ATT_STAGE_OFF = 98304;
constexpr int LDSCTL_OFF = 135168, MISC_OFF = LDSCTL_OFF + 320;
constexpr int GT_OFF = LDSCTL_OFF + 1024;
constexpr int LDS_BYTES = 147456;

#define GAS __attribute__((address_space(1)))
#define LAS __attribute__((address_space(3)))
#define DI __device__ __forceinline__
typedef unsigned short bf16;
typedef unsigned v4u __attribute__((ext_vector_type(4)));
typedef unsigned v2u __attribute__((ext_vector_type(2)));
typedef float f32x4 __attribute__((ext_vector_type(4)));
typedef short bf16x8 __attribute__((ext_vector_type(8)));
typedef GAS unsigned gu32;
#define RLX_AGENT __ATOMIC_RELAXED, __HIP_MEMORY_SCOPE_AGENT
#define LDS_WAIT() asm volatile("s_waitcnt lgkmcnt(0)" ::: "memory")
#define VM_WAIT() asm volatile("s_waitcnt vmcnt(0)" ::: "memory")
DI unsigned f2bf(float f) { unsigned u = __builtin_bit_cast(unsigned, f); return (u + 0x7fffu + ((u >> 16) & 1u)) >> 16; }
DI unsigned pk2(float lo, float hi) { return f2bf(lo) | (f2bf(hi) << 16); }
DI float bflo(unsigned w) { return __uint_as_float(w << 16); }
DI float bfhi(unsigned w) { return __uint_as_float(w & 0xffff0000u); }
DI float bf2f(bf16 h) { return __uint_as_float((unsigned)h << 16); }
template <int CTRL> DI float dpp_mov(float v) { return __builtin_bit_cast(float, __builtin_amdgcn_update_dpp(0, __builtin_bit_cast(int, v), CTRL, 0xf, 0xf, true)); }
DI float rdlane(float v, int l) { return __builtin_bit_cast(float, __builtin_amdgcn_readlane(__builtin_bit_cast(int, v), l)); }
DI float wave_sum(float v) {
    v += dpp_mov<0xB1>(v); v += dpp_mov<0x4E>(v); v += dpp_mov<0x141>(v); v += dpp_mov<0x140>(v);
    return (rdlane(v, 0) + rdlane(v, 16)) + (rdlane(v, 32) + rdlane(v, 48));
}
DI void st16_wt(void* p, v4u v) { asm volatile("global_store_dwordx4 %0, %1, off sc1\n\ts_nop 1" :: "v"(p), "v"(v) : "memory"); }
DI float fast_rcp(float x) { return __builtin_amdgcn_rcpf(x); }
DI float sigmoid_f(float x) { return fast_rcp(1.0f + __builtin_amdgcn_exp2f(-1.4426950408889634f * x)); }
DI float silu_f(float x) { return x * sigmoid_f(x); }
DI float gelu_tanh_f(float x) { const float z2 = 1.5957691216057308f * (x + 0.044715f * x * x * x); return x * sigmoid_f(z2); }

#define XB_TMO      128
#define XB_XCNT(j)  (256  + 64 * (j))
#define XB_XSUB(j)  (1280 + 64 * (j))
#define XB_XGEN(j)  (2304 + 64 * (j))
#define XB_TOP      3328
#define XB_TOPGEN   3392
#define XCD_BAR_WORDS 3456
#define XB_SPIN_CAP (1u << 22)
DI unsigned xb_ld(unsigned* p)              { return __hip_atomic_load(p, __ATOMIC_RELAXED, __HIP_MEMORY_SCOPE_AGENT); }
DI unsigned xb_add(unsigned* p, unsigned v) { return __hip_atomic_fetch_add(p, v, __ATOMIC_RELAXED, __HIP_MEMORY_SCOPE_AGENT); }
DI unsigned xb_xcc_id() { return (unsigned)__builtin_amdgcn_s_getreg((3 << 11) | 20) & 0xFu; }
#define XB_SPIN(cond, bar) do { unsigned _sp = 0; while (cond) { __builtin_amdgcn_s_sleep(1); \
    if ((++_sp & 255u) == 0u) { if (xb_ld(&(bar)[XB_TMO])) break; if (_sp > XB_SPIN_CAP) { atomicAdd(&(bar)[XB_TMO], 1u); break; } } } } while (0)
struct XcdBarrier { unsigned* bar; unsigned x; volatile LAS unsigned* st; };
DI XcdBarrier xcd_barrier_post(unsigned* bar, volatile LAS unsigned* st) {
    XcdBarrier b; b.bar = bar; b.x = xb_xcc_id(); b.st = st;
    if (threadIdx.x == 0) (void)xb_add(&bar[XB_XCNT(b.x)], 1u);
    return b;
}
DI void xcd_barrier_complete(unsigned* bar, unsigned x, unsigned& nloc, unsigned& nx) {
    const unsigned G = gridDim.x * gridDim.y * gridDim.z;
    unsigned sum, cnt, mine, sp = 0u;
    for (;;) {
        sum = 0u; cnt = 0u; mine = 0u;
#pragma unroll
        for (unsigned j = 0; j < 16; ++j) { const unsigned c = xb_ld(&bar[XB_XCNT(j)]); sum += c; cnt += (c > 0u) ? 1u : 0u; mine = (j == x) ? c : mine; }
        if (sum == G) break;
        __builtin_amdgcn_s_sleep(1);
        if ((++sp & 255u) == 0u) { if (xb_ld(&bar[XB_TMO])) break; if (sp > XB_SPIN_CAP) { atomicAdd(&bar[XB_TMO], 1u); break; } }
    }
    nloc = mine > 0u ? mine : 1u; nx = cnt > 0u ? cnt : 1u;
}
DI void xcd_barrier(const XcdBarrier& b) {
    asm volatile("s_waitcnt vmcnt(0)" ::: "memory");
    __syncthreads();
    if (threadIdx.x == 0) {
        unsigned* bar = b.bar;
        __builtin_amdgcn_s_waitcnt(0);
        unsigned nloc = b.st[0], nx = b.st[1];
        if (nloc == 0u) { xcd_barrier_complete(bar, b.x, nloc, nx); b.st[0] = nloc; b.st[1] = nx; }
        const unsigned old = xb_add(&bar[XB_XSUB(b.x)], 1u);
        const unsigned gen = old / nloc;
        if (old + 1u == (gen + 1u) * nloc) {
            __builtin_amdgcn_fence(__ATOMIC_RELEASE, "agent");
            asm volatile("s_waitcnt vmcnt(0)" ::: "memory");
            const unsigned og = xb_add(&bar[XB_TOP], 1u);
            const unsigned tg = og / nx;
            if (og + 1u == (tg + 1u) * nx) xb_add(&bar[XB_TOPGEN], 1u);
            else XB_SPIN(xb_ld(&bar[XB_TOPGEN]) == tg, bar);
            __builtin_amdgcn_fence(__ATOMIC_ACQUIRE, "agent");
            xb_add(&bar[XB_XGEN(b.x)], 1u);
            asm volatile("s_waitcnt vmcnt(0)" ::: "memory");
        } else {
            XB_SPIN(xb_ld(&bar[XB_XGEN(b.x)]) == gen, bar);
            __builtin_amdgcn_fence(__ATOMIC_ACQUIRE, "agent");
            asm volatile("s_waitcnt vmcnt(0)" ::: "memory");
        }
    }
    __syncthreads();
}

struct Args { const void* in[30]; float* out; unsigned char* ws; int ph_lo, ph_hi, li, pad; };
enum { I_X = 0, I_C, I_POS, I_ADAW, I_ADAB, I_WIN, I_GMLNG, I_GMLNB, I_GMWS, I_GMBS, I_LAMRE, I_LAMIM, I_LOGDT, I_BRE, I_BIM, I_CRE, I_CIM, I_SSMD,
       I_GLUW, I_GLUB, I_WOUT, I_LN1G, I_LN1B, I_RW, I_RB, I_EWG, I_EWU, I_EWD, I_LN2G, I_LN2B };
struct Frame {
    LAS unsigned char* lds;
    volatile LAS unsigned* MISC;
    gu32* ctl;
    unsigned char* ws;
    int vcu, G;
};
DI int ftid() { int t = threadIdx.x; asm volatile("" : "+v"(t)); return t; }
#define FRAME_IDS const int tid_ = ftid(), lane_ = tid_ & 63, wave_ = __builtin_amdgcn_readfirstlane(tid_ >> 6); (void)lane_; (void)wave_;

template <class RowMap>
DI void transpose_item(const float* W, int K, int N, bf16* WT, const RowMap& rm, LAS float* scr, int item, int lane) {
    const int nblk = N / 32, kb = item / nblk, nb = item % nblk, k0 = 64 * kb, n0 = 32 * nb;
#pragma unroll 8
    for (int i = 0; i < 32; ++i) { const int kk = 2 * i + (lane >> 5); scr[kk * 33 + (lane & 31)] = W[(size_t)(k0 + kk) * N + n0 + (lane & 31)]; }
    LDS_WAIT(); asm volatile("" ::: "memory");
    const int c = lane & 7;
#pragma unroll
    for (int j = 0; j < 4; ++j) { const int n = (lane >> 3) + 8 * j; const LAS float* s = scr + (8 * c) * 33 + n;
        const float qs = (RowMap::SCALEQ && (n0 + n) >= COL_Q && (n0 + n) < COL_K) ? QSCALE : 1.0f;
        v4u o; o.x = pk2(s[0 * 33] * qs, s[1 * 33] * qs); o.y = pk2(s[2 * 33] * qs, s[3 * 33] * qs); o.z = pk2(s[4 * 33] * qs, s[5 * 33] * qs); o.w = pk2(s[6 * 33] * qs, s[7 * 33] * qs);
        *(GAS v4u*)(WT + (size_t)rm(n0 + n) * K + k0 + 8 * c) = o; }
    LDS_WAIT(); asm volatile("" ::: "memory");
}
struct RmIdent { static constexpr bool SCALEQ = false; int off; DI int operator()(int n) const { return off + n; } };
struct RmWin { static constexpr bool SCALEQ = true; DI int operator()(int n) const {
        if (n >= COL_Q && n < COL_VA) { const int d = n & 63; if (d < 16) return (n - d) + 2 * (d & 7) + (d >> 3); }
        return n; } };
struct RmGU { static constexpr bool SCALEQ = false; int e, up; DI int operator()(int n) const { return e * 1024 + (n >> 7) * 256 + (n & 127) + up * 128; } };

DI void p0_tables(Frame& F, const Args& A) {
    FRAME_IDS
    const float* c = (const float*)A.in[I_C];
    LAS float* condS = (LAS float*)(F.lds + RING_OFF);
    LAS float* red = (LAS float*)(F.lds + RING_OFF + 32768);
    for (int i = tid_; i < BATCH * D; i += NTHR) condS[i] = silu_f(c[i]);
    __syncthreads();
    float* mod = (float*)(F.ws + WS_MOD);
    for (int it = F.vcu; it < DEPTH * 96; it += F.G) {
        const int l = it / 96, jb = it % 96, ks = tid_ >> 6, jj = tid_ & 63, j = jb * 64 + jj;
        const float* w = (const float*)A.in[I_ADAW] + (size_t)l * D * 6 * D + j;
        float acc[8];
#pragma unroll
        for (int b = 0; b < 8; ++b) acc[b] = 0.f;
#pragma unroll 16
        for (int k = ks * 128; k < ks * 128 + 128; ++k) { const float wv = w[(size_t)k * (6 * D)];
#pragma unroll
            for (int b = 0; b < 8; ++b) acc[b] += condS[b * D + k] * wv; }
#pragma unroll
        for (int b = 0; b < 8; ++b) red[(ks * 8 + b) * 64 + jj] = acc[b];
        __syncthreads();
        { const int b = tid_ >> 6; float s = ((const float*)A.in[I_ADAB])[l * 6 * D + j];
#pragma unroll
          for (int k2 = 0; k2 < 8; ++k2) s += red[(k2 * 8 + b) * 64 + jj];
          mod[((size_t)l * BATCH + b) * 6 * D + j] = s; }
        __syncthreads();
    }
    const int gt = F.vcu * NTHR + tid_, NGT = F.G * NTHR;
    const int* pos = (const int*)A.in[I_POS]; float* rope = (float*)(F.ws + WS_ROPE);
    for (int w = gt; w < M * 8; w += NGT) { const int m = w >> 3, i = w & 7;
        const float freq = exp2f(-(float)i * 0.125f * 18.931568569324174f);
        const float ang = (float)pos[m] * freq; float s, cs; sincosf(ang, &s, &cs);
        rope[m * 16 + i] = cs; rope[m * 16 + 8 + i] = s; }
    for (int w = gt; w < DEPTH * 16 * 33 * 64; w += NGT) { const int n = w & 63, m = (w >> 6) % 33, g = ((w >> 6) / 33) & 15, l = (w >> 6) / (33 * 16);
        const int li = (l * 16 + g) * 64 + n;
        const float lre = ((const float*)A.in[I_LAMRE])[li], lim = ((const float*)A.in[I_LAMIM])[li], dt = expf(((const float*)A.in[I_LOGDT])[l * 16 + g]);
        const float mag = expf((float)m * (lre * dt)); float sn, cs; sincosf((float)m * (lim * dt), &sn, &cs);
        float* apw = (float*)(F.ws + WS_SSM2 + l * SSM2_LAYER + S2_APW) + ((size_t)(g * 33 + m) * 64 + n) * 2; apw[0] = mag * cs; apw[1] = mag * sn; }
    for (int w = gt; w < DEPTH * SSM_G * SSM_N; w += NGT) { const int l = w / 1024, gn = w % 1024, g = gn >> 6;
        float* tab = (float*)(F.ws + WS_SSM) + (size_t)l * SSM_TAB;
        const float lre = ((const float*)A.in[I_LAMRE])[w], lim = ((const float*)A.in[I_LAMIM])[w];
        const float dt = expf(((const float*)A.in[I_LOGDT])[l * 16 + g]);
        const float mag = expf(lre * dt); float sn, cs; sincosf(lim * dt, &sn, &cs);
        const float are = mag * cs, aim = mag * sn, nr = are - 1.0f, ni = aim, mod2 = lre * lre + lim * lim;
        const float fre = (nr * lre + ni * lim) / mod2, fim = (ni * lre - nr * lim) / mod2;
        tab[gn] = are; tab[1024 + gn] = aim;
        const float* bre = (const float*)A.in[I_BRE] + (size_t)w * 16; const float* bim = (const float*)A.in[I_BIM] + (size_t)w * 16;
#pragma unroll
        for (int cc = 0; cc < 16; ++cc) { tab[2048 + gn * 16 + cc] = fre * bre[cc] - fim * bim[cc]; tab[2048 + 16384 + gn * 16 + cc] = fre * bim[cc] + fim * bre[cc]; } }
}

constexpr int WCONV_SPLIT = 16 * 72 + 16 * 32 + 4 * 8 + 8900;
DI void p_wconv(Frame& F, const Args& A, int l, int part) {
    FRAME_IDS
    if (part == 4) {
        const int gt = F.vcu * NTHR + tid_, NGT = F.G * NTHR;
        const float* tab = (const float*)(F.ws + WS_SSM) + (size_t)l * SSM_TAB;
        const float* apw = (const float*)(F.ws + WS_SSM2 + l * SSM2_LAYER + S2_APW);
        const float* cre = (const float*)A.in[I_CRE] + (size_t)l * 16 * 16 * 64; const float* cim = (const float*)A.in[I_CIM] + (size_t)l * 16 * 16 * 64;
        bf16* KT = (bf16*)(F.ws + WS_SSM2 + l * SSM2_LAYER + S2_KT); bf16* CT = (bf16*)(F.ws + WS_SSM2 + l * SSM2_LAYER + S2_CT);
        bf16* WIN = (bf16*)(F.ws + WS_SSM2 + l * SSM2_LAYER + S2_WIN); bf16* GW = (bf16*)(F.ws + WS_SSM2 + l * SSM2_LAYER + S2_GW);
        for (int w = gt; w < 16 * 16 * 64 * 8; w += NGT) { const int j = w & 7, ln = (w >> 3) & 63, p = (w >> 9) & 15, g = w >> 13;
            const int co = ln & 15, q = ln >> 4, m = 2 * p + (q >> 1), ci = 8 * (q & 1) + j; float acc = 0.f;
            for (int n = 0; n < 64; ++n) { const int gn = g * 64 + n; const float ar = apw[((g * 33 + m) * 64 + n) * 2], ai = apw[((g * 33 + m) * 64 + n) * 2 + 1];
                const float br = tab[2048 + gn * 16 + ci], bi = tab[2048 + 16384 + gn * 16 + ci], tre = ar * br - ai * bi, tim = ar * bi + ai * br;
                acc += cre[(g * 16 + co) * 64 + n] * tre - cim[(g * 16 + co) * 64 + n] * tim; }
            KT[w] = (bf16)f2bf(acc); }
        for (int w = gt; w < 16 * 4 * 64 * 8; w += NGT) { const int j = w & 7, ln = (w >> 3) & 63, sx = (w >> 9) & 3, g = w >> 11;
            const int co = ln & 15, q = ln >> 4, n = 16 * sx + 4 * q + (j >> 1);
            CT[w] = (bf16)f2bf((j & 1) ? -cim[(g * 16 + co) * 64 + n] : cre[(g * 16 + co) * 64 + n]); }
        for (int w = gt; w < 16 * 16 * 8 * 64 * 8; w += NGT) { const int jj = w & 7, ln = (w >> 3) & 63, ct = (w >> 9) & 7, sp = (w >> 12) & 15, g = w >> 16;
            const int cc = ln & 15, q = ln >> 4, n = 8 * ct + (cc >> 1), part = cc & 1, tj = 2 * sp + (q >> 1), ci = 8 * (q & 1) + jj, gn = g * 64 + n, m = 31 - tj;
            const float ar = apw[((g * 33 + m) * 64 + n) * 2], ai = apw[((g * 33 + m) * 64 + n) * 2 + 1], br = tab[2048 + gn * 16 + ci], bi = tab[2048 + 16384 + gn * 16 + ci];
            WIN[w] = (bf16)f2bf(part ? (ar * bi + ai * br) : (ar * br - ai * bi)); }
        const float* gws = (const float*)A.in[I_GMWS] + (size_t)l * 4 * 128 * 128;
        for (int w = gt; w < 4 * 128 * 128; w += NGT) { const int sx = w & 127, t = (w >> 7) & 127; GW[w] = (bf16)f2bf(sx <= t ? gws[w] : 0.f); }
    }
    if (part == 4) return;
    LAS float* scr = (LAS float*)(F.lds + RING_OFF + wave_ * 16384);
    constexpr int NSMALL_ = 16 * 72 + 16 * 32 + 4 * 8;
    const int gw = (part == 1) ? WCONV_SPLIT + ((int)blockIdx.x - 128) * NWAVES + wave_ : (part == 3 ? NSMALL_ : 0) + F.vcu * NWAVES + wave_, NGW = (part == 1) ? 128 * NWAVES : F.G * NWAVES;
    bf16* WinT = (bf16*)(F.ws + WS_WSMALL + l * WSMALL_LAYER + WOFF_IN);
    bf16* WoutT = (bf16*)(F.ws + WS_WSMALL + l * WSMALL_LAYER + WOFF_OUT);
    bf16* GluT = (bf16*)(F.ws + WS_WSMALL + l * WSMALL_LAYER + WOFF_GLU);
    bf16* WguT = (bf16*)(F.ws + WS_WGU); bf16* WdT = (bf16*)(F.ws + WS_WD);
    constexpr int I_IN = 16 * 72, I_OUTW = 16 * 32, I_GLU = 4 * 8, I_G = 16 * 16, I_DN = 8 * 32;
    constexpr int NIT = I_IN + I_OUTW + I_GLU + 16 * (2 * I_G + I_DN);
    const int split = (F.G == 256) ? WCONV_SPLIT : NIT;
    for (int it = gw; it < ((part == 1) ? NIT : (part == 2 ? NSMALL_ : split)); it += NGW) {
        int r = it;
        if (r < I_IN) { transpose_item((const float*)A.in[I_WIN] + (size_t)l * D * PROJW, D, PROJW, WinT, RmWin{}, scr, r, lane_); continue; } r -= I_IN;
        if (r < I_OUTW) { transpose_item((const float*)A.in[I_WOUT] + (size_t)l * D * D, D, D, WoutT, RmIdent{0}, scr, r, lane_); continue; } r -= I_OUTW;
        if (r < I_GLU) { transpose_item((const float*)A.in[I_GLUW] + (size_t)l * 256 * 256, 256, 256, GluT, RmIdent{0}, scr, r, lane_); continue; } r -= I_GLU;
        const int e = r / (2 * I_G + I_DN); r -= e * (2 * I_G + I_DN);
        const size_t eo = ((size_t)l * NEXP + e) * D * DEXP;
        if (r < I_G) { transpose_item((const float*)A.in[I_EWG] + eo, D, DEXP, WguT, RmGU{e, 0}, scr, r, lane_); continue; } r -= I_G;
        if (r < I_G) { transpose_item((const float*)A.in[I_EWU] + eo, D, DEXP, WguT, RmGU{e, 1}, scr, r, lane_); continue; } r -= I_G;
        transpose_item((const float*)A.in[I_EWD] + eo, DEXP, D, WdT, RmIdent{e * 1024}, scr, r, lane_);
    }
}

typedef float f32x2_t __attribute__((ext_vector_type(2)));
typedef __bf16 bf16x2_t __attribute__((ext_vector_type(2)));
DI unsigned cvtpk(float lo, float hi) { f32x2_t v = {lo, hi}; bf16x2_t b = __builtin_convertvector(v, bf16x2_t); return __builtin_bit_cast(unsigned, b); }
struct Row16 { float v[16]; };
DI void row_load_f32(Row16& r, const float* p, int lane) {
    const f32x4* q = (const f32x4*)p;
#pragma unroll
    for (int k = 0; k < 4; ++k) { const f32x4 a = q[k * 64 + lane]; r.v[4 * k] = a.x; r.v[4 * k + 1] = a.y; r.v[4 * k + 2] = a.z; r.v[4 * k + 3] = a.w; }
}
DI void row_load_bf16(Row16& r, const bf16* p, int lane) {
    const v2u* q = (const v2u*)p;
#pragma unroll
    for (int k = 0; k < 4; ++k) { const v2u a = q[k * 64 + lane]; r.v[4 * k] = bflo(a.x); r.v[4 * k + 1] = bfhi(a.x); r.v[4 * k + 2] = bflo(a.y); r.v[4 * k + 3] = bfhi(a.y); }
}
DI void row_store_bf16(const Row16& r, bf16* p, int lane) {
    v2u* q = (v2u*)p;
#pragma unroll
    for (int k = 0; k < 4; ++k) { v2u o; o.x = cvtpk(r.v[4 * k], r.v[4 * k + 1]); o.y = cvtpk(r.v[4 * k + 2], r.v[4 * k + 3]); q[k * 64 + lane] = o; }
}
DI void row_store_f32(const Row16& r, float* p, int lane) {
    f32x4* q = (f32x4*)p;
#pragma unroll
    for (int k = 0; k < 4; ++k) q[k * 64 + lane] = (f32x4){r.v[4 * k], r.v[4 * k + 1], r.v[4 * k + 2], r.v[4 * k + 3]};
}
DI void row_ln(Row16& r) {
    float s = 0.f;
#pragma unroll
    for (int i = 0; i < 16; ++i) s += r.v[i];
    const float mean = wave_sum(s) * (1.f / D); float s2 = 0.f;
#pragma unroll
    for (int i = 0; i < 16; ++i) { r.v[i] -= mean; s2 += r.v[i] * r.v[i]; }
    const float rstd = 1.0f / sqrtf(wave_sum(s2) * (1.f / D) + LN_EPS);
#pragma unroll
    for (int i = 0; i < 16; ++i) r.v[i] *= rstd;
}
DI void row_mod(Row16& r, const float* a, const float* b, int lane) {
    Row16 av, bv; row_load_f32(av, a, lane); row_load_f32(bv, b, lane);
#pragma unroll
    for (int i = 0; i < 16; ++i) r.v[i] = r.v[i] * (1.0f + av.v[i]) + bv.v[i];
}
DI void row_affine(Row16& r, const float* g, const float* b, int lane) {
    Row16 av, bv; row_load_f32(av, g, lane); row_load_f32(bv, b, lane);
#pragma unroll
    for (int i = 0; i < 16; ++i) r.v[i] = r.v[i] * av.v[i] + bv.v[i];
}

DI void p_ln_a0(Frame& F, const Args& A) {
    FRAME_IDS
    const int gw = F.vcu * NWAVES + wave_, NGW = F.G * NWAVES;
    const float* x = (const float*)A.in[I_X]; bf16* XN = (bf16*)(F.ws + WS_XN); const float* mod = (const float*)(F.ws + WS_MOD);
    const int bq = gw / (NGW / BATCH), mbase = bq * T + gw % (NGW / BATCH), mstep = NGW / BATCH;
    const float* md = mod + (size_t)bq * 6 * D;
    Row16 msc, msh; row_load_f32(msc, md + 1 * D, lane_); row_load_f32(msh, md + 0 * D, lane_);
    Row16 nx; row_load_f32(nx, x + (size_t)mbase * D, lane_);
    for (int m = mbase; m < (bq + 1) * T; m += mstep) {
        Row16 r = nx; if (m + mstep < (bq + 1) * T) row_load_f32(nx, x + (size_t)(m + mstep) * D, lane_);
        row_ln(r);
#pragma unroll
        for (int i = 0; i < 16; ++i) r.v[i] = r.v[i] * (1.0f + msc.v[i]) + msh.v[i];
        row_store_bf16(r, XN + (size_t)m * D, lane_); }
}

using pg8::Unit; using pg8::BM; using pg8::HALF;
struct EpiInProj {
    static constexpr bool PERM = true, AFTER_DRAIN = false;
    bf16* P; const float* rope; int skip;
    DI void operator()(const pg8::f32x4 (&acc)[2][2][4][2], const Unit& u, int wr, int wc, int fr, int fq) const {
        if (skip == 1) { if (acc[0][0][0][0][0] == 12345.678f) P[0] = 1; return; }
        const int row0 = u.pm * BM + wr * 64 + fr, pn = u.pn;
        const bool isrope = (pn >= 2 && pn <= 5), dorope = isrope && ((wc & 1) == 0) && (fq < 2);
#pragma unroll
        for (int ai = 0; ai < 2; ++ai)
#pragma unroll
            for (int m = 0; m < 4; ++m) { const int row = row0 + ai * HALF + m * 16; bf16* rowp = P + (size_t)row * PROJW + pn * BM + wc * 32 + 8 * fq;
                f32x4 cs = (f32x4){1.f, 1.f, 1.f, 1.f}, sn = (f32x4){0.f, 0.f, 0.f, 0.f};
                if (isrope) { const float* rp = rope + (size_t)row * 16 + 4 * (fq & 1); cs = *(const f32x4*)rp; sn = *(const f32x4*)(rp + 8); }
#pragma unroll
                for (int bj = 0; bj < 2; ++bj) { pg8::f32x4 v0 = acc[ai][bj][m][0], v1 = acc[ai][bj][m][1];
                    if (isrope) {
                        if (dorope) { const float a0 = v0[0] * cs.x - v0[1] * sn.x, b0 = v0[1] * cs.x + v0[0] * sn.x, a1 = v0[2] * cs.y - v0[3] * sn.y, b1 = v0[3] * cs.y + v0[2] * sn.y;
                            const float a2 = v1[0] * cs.z - v1[1] * sn.z, b2 = v1[1] * cs.z + v1[0] * sn.z, a3 = v1[2] * cs.w - v1[3] * sn.w, b3 = v1[3] * cs.w + v1[2] * sn.w;
                            v0 = (pg8::f32x4){a0, b0, a1, b1}; v1 = (pg8::f32x4){a2, b2, a3, b3}; }
                    }
                    pg8::u32x4 w; w.x = pg8::cvt_pk_bf16(v0[0], v0[1]); w.y = pg8::cvt_pk_bf16(v0[2], v0[3]); w.z = pg8::cvt_pk_bf16(v1[0], v1[1]); w.w = pg8::cvt_pk_bf16(v1[2], v1[3]);
                    if (skip == 2) { asm volatile("" :: "v"(w.x), "v"(w.y), "v"(w.z), "v"(w.w)); } else *(pg8::u32x4*)(rowp + bj * HALF) = w; } }
    }
};
template <bool XF32> struct EpiOut {
    static constexpr bool PERM = true, AFTER_DRAIN = false;
    bf16* PRE; const void* x; int xpitch; const float* mod;
    DI void operator()(const pg8::f32x4 (&acc)[2][2][4][2], const Unit& u, int wr, int wc, int fr, int fq) const {
        const int row0 = u.pm * BM + wr * 64 + fr, b = (u.pm * BM) / T, colb = u.pn * BM + wc * 32 + 8 * fq;
        const float* g1 = mod + (size_t)b * 6 * D + 2 * D;
        pg8::f32x4 gv[2][2];
#pragma unroll
        for (int bj = 0; bj < 2; ++bj) { gv[bj][0] = *(const pg8::f32x4*)(g1 + colb + bj * HALF) + 1.0f; gv[bj][1] = *(const pg8::f32x4*)(g1 + colb + bj * HALF + 4) + 1.0f; }
#pragma unroll
        for (int ai = 0; ai < 2; ++ai)
#pragma unroll
            for (int m = 0; m < 4; ++m) { const int row = row0 + ai * HALF + m * 16;
#pragma unroll
                for (int bj = 0; bj < 2; ++bj) { const int col = colb + bj * HALF; pg8::f32x4 x0, x1;
                    if (XF32) { const float* xp = (const float*)x + (size_t)row * xpitch + col; x0 = *(const pg8::f32x4*)xp; x1 = *(const pg8::f32x4*)(xp + 4); }
                    else { const pg8::u32x4 xw = *(const pg8::u32x4*)((const bf16*)x + (size_t)row * xpitch + col);
                        x0 = (pg8::f32x4){bflo(xw.x), bfhi(xw.x), bflo(xw.y), bfhi(xw.y)}; x1 = (pg8::f32x4){bflo(xw.z), bfhi(xw.z), bflo(xw.w), bfhi(xw.w)}; }
                    const pg8::f32x4 v0 = x0 * ALPHA + gv[bj][0] * acc[ai][bj][m][0], v1 = x1 * ALPHA + gv[bj][1] * acc[ai][bj][m][1];
                    pg8::u32x4 w; w.x = pg8::cvt_pk_bf16(v0[0], v0[1]); w.y = pg8::cvt_pk_bf16(v0[2], v0[3]); w.z = pg8::cvt_pk_bf16(v1[0], v1[1]); w.w = pg8::cvt_pk_bf16(v1[2], v1[3]);
                    *(pg8::u32x4*)(PRE + (size_t)row * D + col) = w; } }
    }
};
struct OutOrder : pg8::StaticOrder {
    const char* xbase; unsigned rowbytes, tilecolbytes; LAS unsigned char* dump;
    DI void a_ready(const Unit& u) const {
        const int tid = threadIdx.x, wid = __builtin_amdgcn_readfirstlane(tid >> 6), lane = tid & 63;
        const int lpr = (int)(tilecolbytes >> 7);
        const char* t0 = xbase + (size_t)u.pm * 256 * rowbytes + (size_t)u.pn * tilecolbytes;
        const int nline = 256 * lpr;
        for (int i = wid * 64 + lane; i < nline; i += 512) { const int r = i / lpr, c = i % lpr;
            __builtin_amdgcn_global_load_lds((const unsigned*)(t0 + (size_t)r * rowbytes + (size_t)c * 128), (LAS unsigned*)(dump + wid * 256), 4, 0, 0); }
    }
};
struct EpiGlu {
    static constexpr bool PERM = true, AFTER_DRAIN = false;
    const bf16* YG; bf16* MIX; const float* gb;
    DI void operator()(const pg8::f32x4 (&acc)[2][2][4][2], const Unit& u, int wr, int wc, int fr, int fq) const {
        const int row0 = u.pm * BM + wr * 64 + fr, colb = wc * 32 + 8 * fq;
#pragma unroll
        for (int ai = 0; ai < 2; ++ai)
#pragma unroll
            for (int m = 0; m < 4; ++m) { const int row = row0 + ai * HALF + m * 16;
#pragma unroll
                for (int bj = 0; bj < 2; ++bj) { const int col = colb + bj * HALF;
                    const pg8::u32x4 yw = *(const pg8::u32x4*)(YG + (size_t)row * 256 + col);
                    const pg8::f32x4 b0 = *(const pg8::f32x4*)(gb + col), b1 = *(const pg8::f32x4*)(gb + col + 4);
                    const pg8::f32x4 a0 = acc[ai][bj][m][0] + b0, a1 = acc[ai][bj][m][1] + b1;
                    const float y[8] = {bflo(yw.x), bfhi(yw.x), bflo(yw.y), bfhi(yw.y), bflo(yw.z), bfhi(yw.z), bflo(yw.w), bfhi(yw.w)};
                    float o[8];
#pragma unroll
                    for (int i = 0; i < 4; ++i) { o[i] = y[i] * sigmoid_f(a0[i]); o[4 + i] = y[4 + i] * sigmoid_f(a1[i]); }
                    pg8::u32x4 w; w.x = pg8::cvt_pk_bf16(o[0], o[1]); w.y = pg8::cvt_pk_bf16(o[2], o[3]); w.z = pg8::cvt_pk_bf16(o[4], o[5]); w.w = pg8::cvt_pk_bf16(o[6], o[7]);
                    *(pg8::u32x4*)(MIX + (size_t)row * D + 768 + col) = w; asm volatile("" ::: "memory"); } }
    }
};
template <int KIND> struct MoeOrderK {
    const volatile LAS int* ts; int G, c; const int* slot_a; const float* slot_w; gu32* done_cnt; gu32* queue; volatile LAS int* qs;
    DI bool decode(int off, Unit& u) const {
        const int nwg = ts[16] * 4, q = nwg / 8, r = nwg % 8, xcd = c % 8; const int cntx = q + (xcd < r ? 1 : 0); if (off >= cntx) return false;
        const int wgid = (xcd < r ? xcd * (q + 1) : r * (q + 1) + (xcd - r) * q) + off;
        const int tm = wgid >> 2, j = wgid & 3; int e = 0;
#pragma unroll
        for (int k = 1; k < 16; ++k) e += (ts[k] <= tm) ? 1 : 0;
        u.pm = tm; u.pn = e * 4 + j; return true; }
    DI bool first(Unit& u) const {
        if (KIND == 0) return next(0, u);
        if (threadIdx.x == 0) { const unsigned a = __hip_atomic_fetch_add(queue + 16 * (c % 8), 2u, RLX_AGENT); qs[0] = (int)a; qs[1] = (int)a + 1; }
        asm volatile("s_waitcnt vmcnt(0) lgkmcnt(0)" ::: "memory"); __builtin_amdgcn_s_barrier(); asm volatile("" ::: "memory");
        return decode(qs[0], u);
    }
    DI bool more(int i, Unit& u) const {
        if (KIND == 0) return next(i, u);
        return decode(qs[i & 1], u);
    }
    DI bool next(int i, Unit& u) const {
        const int nwg = ts[16] * 4; const int cc = c;
        const long L = (long)i * G + cc; if (L >= nwg) return false;
        int wgid = (int)L; { const int q = nwg / 8, r = nwg % 8, xcd = wgid % 8, off = wgid / 8; wgid = (xcd < r ? xcd * (q + 1) : r * (q + 1) + (xcd - r) * q) + off; }
        const int tm = wgid >> 2, j = wgid & 3; int e = 0;
#pragma unroll
        for (int k = 1; k < 16; ++k) e += (ts[k] <= tm) ? 1 : 0;
        u.pm = tm; u.pn = e * 4 + j; return true;
    }
    struct Pf { unsigned a, w, c, q; };
    DI void pull_issue(int tid, Pf& pf) const { if (KIND == 1 && tid == 0) pf.q = __hip_atomic_fetch_add(queue + 16 * (c % 8), 1u, RLX_AGENT); }
    DI void pull_publish(int tid, const Pf& pf, int ui) const { if (KIND == 1 && tid == 0 && ui >= 0) qs[ui & 1] = (int)pf.q; }
    DI void prefetch(const Unit& u, int r, Pf& pf) const {
        const int e = u.pn >> 2, idx = (u.pm - ts[e]) * 256 + (r & 255); const bool valid = idx < ts[32 + e];
        pf.a = 0xffffffffu; pf.w = 0u; pf.c = 32u;
        if (valid && r < 256) { pf.a = (unsigned)slot_a[(size_t)e * SLOT_CAP + idx]; if (KIND == 1) pf.w = __float_as_uint(slot_w[(size_t)e * SLOT_CAP + idx]); }
        if (KIND == 1 && r < 64) pf.c = __hip_atomic_load(done_cnt + u.pm, RLX_AGENT);
    }
    DI void finish_meta(const Unit& u, int r, const Pf& pf, unsigned& off, unsigned& a0, unsigned& a1) const {
        if (KIND == 0) { off = (pf.a == 0xffffffffu ? 0u : (pf.a >> 1)) * (unsigned)(D * 2); a0 = 0u; a1 = 0u; }
        else { off = (unsigned)(u.pm * 256 + r) * (unsigned)(DEXP * 2); a0 = pf.a; a1 = pf.w; }
    }
    DI void wait_ready(const Unit& u, int tid, const Pf& pf) const {
        if (KIND == 1 && tid < 64) { unsigned sp = 0;
            if ((unsigned)__builtin_amdgcn_readfirstlane((int)pf.c) < 32u)
                while ((unsigned)__builtin_amdgcn_readfirstlane((int)__hip_atomic_load(done_cnt + u.pm, RLX_AGENT)) < 32u) { __builtin_amdgcn_s_sleep(2); if (++sp > (1u << 20)) break; } }
    }
    DI void a_ready(const Unit&) const {}
    DI void done_nowait(const Unit& u) const { if (KIND == 0 && (threadIdx.x & 63) == 0) __hip_atomic_fetch_add(done_cnt + u.pm, 1u, RLX_AGENT); }
};
struct EpiG1 {
    static constexpr bool PERM = true, AFTER_DRAIN = false;
    bf16* HID; int skip;
    DI void operator()(const pg8::f32x4 (&acc)[2][2][4][2], const Unit& u, int wr, int wc, int fr, int fq, const LAS unsigned*) const {
        if (skip == 1) { if (acc[0][0][0][0][0] == 12345.678f) HID[0] = 1; return; }
        const __amdgpu_buffer_rsrc_t rs = __builtin_amdgcn_make_buffer_rsrc((void*)HID, 0, (int)((size_t)NSLOT_MAX * DEXP * 2), 0x00020000);
        const int row0 = u.pm * BM + wr * 64 + fr, col = (u.pn & 3) * 128 + wc * 32 + 8 * fq;
#pragma unroll
        for (int ai = 0; ai < 2; ++ai)
#pragma unroll
            for (int m = 0; m < 4; ++m) { const int row = row0 + ai * HALF + m * 16; float o[8];
#pragma unroll
                for (int i = 0; i < 4; ++i) { o[i] = silu_f(acc[ai][0][m][0][i]) * acc[ai][1][m][0][i]; o[4 + i] = silu_f(acc[ai][0][m][1][i]) * acc[ai][1][m][1][i]; }
                pg8::u32x4 w; w.x = pg8::cvt_pk_bf16(o[0], o[1]); w.y = pg8::cvt_pk_bf16(o[2], o[3]); w.z = pg8::cvt_pk_bf16(o[4], o[5]); w.w = pg8::cvt_pk_bf16(o[6], o[7]);
                __builtin_amdgcn_raw_buffer_store_b128(w, rs, (row * DEXP + col) * 2, 0, 16); }
    }
};
struct EpiG2 {
    static constexpr bool PERM = true, AFTER_DRAIN = false;
    bf16* ROWS; int skip;
    DI void operator()(const pg8::f32x4 (&acc)[2][2][4][2], const Unit& u, int wr, int wc, int fr, int fq, const LAS unsigned* meta) const {
        if (skip == 1) { if (acc[0][0][0][0][0] == 12345.678f) ROWS[0] = 1; return; }
        const int r0 = wr * 64 + fr, colb = (u.pn & 3) * BM + wc * 32 + 8 * fq;
#pragma unroll
        for (int ai = 0; ai < 2; ++ai)
#pragma unroll
            for (int m = 0; m < 4; ++m) { const int r = r0 + ai * HALF + m * 16; const int d = (int)meta[256 + r]; const float wt = __uint_as_float(meta[512 + r]);
                if (d >= 0) {
#pragma unroll
                    for (int bj = 0; bj < 2; ++bj) { const pg8::f32x4 v0 = acc[ai][bj][m][0] * wt, v1 = acc[ai][bj][m][1] * wt;
                        pg8::u32x4 w; w.x = pg8::cvt_pk_bf16(v0[0], v0[1]); w.y = pg8::cvt_pk_bf16(v0[2], v0[3]); w.z = pg8::cvt_pk_bf16(v1[0], v1[1]); w.w = pg8::cvt_pk_bf16(v1[2], v1[3]);
                        *(pg8::u32x4*)(ROWS + (size_t)d * D + colb + bj * HALF) = w; } } }
    }
};

DI void mix_gating_simple(Frame& F, const Args& A, int l) {
    FRAME_IDS
    const bf16* P = (const bf16*)(F.ws + WS_PROJ); bf16* MIX = (bf16*)(F.ws + WS_MIXCAT);
    const float* lng = (const float*)A.in[I_GMLNG] + l * AW; const float* lnb = (const float*)A.in[I_GMLNB] + l * AW;
    const float* ws_ = (const float*)A.in[I_GMWS] + (size_t)l * 4 * 128 * 128; const float* bs_ = (const float*)A.in[I_GMBS] + l * 4 * 128;
    LAS float* vln = (LAS float*)(F.lds + RING_OFF);
    for (int it = F.vcu; it < BATCH * (T / 128); it += F.G) {
        const int m0 = it * 128;
        for (int r = wave_; r < 128; r += NWAVES) {
            const v2u w = *(const v2u*)(P + (size_t)(m0 + r) * PROJW + COL_V + 4 * lane_);
            float v[4] = {gelu_tanh_f(bflo(w.x)), gelu_tanh_f(bfhi(w.x)), gelu_tanh_f(bflo(w.y)), gelu_tanh_f(bfhi(w.y))};
            const float mean = wave_sum(v[0] + v[1] + v[2] + v[3]) * (1.f / 256.f);
            float s2 = 0.f;
#pragma unroll
            for (int i = 0; i < 4; ++i) { v[i] -= mean; s2 += v[i] * v[i]; }
            const float rstd = 1.0f / sqrtf(wave_sum(s2) * (1.f / 256.f) + LN_EPS);
#pragma unroll
            for (int i = 0; i < 4; ++i) vln[r * 256 + 4 * lane_ + i] = v[i] * rstd * lng[4 * lane_ + i] + lnb[4 * lane_ + i];
        }
        __syncthreads();
        { const int c = tid_ & 255, tp = tid_ >> 8, h = c >> 6;
          for (int t = tp; t < 128; t += 2) { const float* wrow = ws_ + ((size_t)h * 128 + t) * 128; float acc = 0.f;
              for (int s = 0; s <= t; ++s) acc += wrow[s] * vln[s * 256 + c];
              const float uu = gelu_tanh_f(bf2f(P[(size_t)(m0 + t) * PROJW + COL_U + c]));
              MIX[(size_t)(m0 + t) * D + c] = (bf16)f2bf(uu * (acc + bs_[h * 128 + t])); } }
        __syncthreads();
    }
}
DI void mix_attn_simple(Frame& F, int l) {
    FRAME_IDS
    const bf16* P = (const bf16*)(F.ws + WS_PROJ); bf16* MIX = (bf16*)(F.ws + WS_MIXCAT);
    const int gw = F.vcu * NWAVES + wave_, NGW = F.G * NWAVES;
    for (int it = gw; it < M * NH; it += NGW) {
        const int m = it >> 3, h = it & 7, t = m & (T - 1);
        const float q = bf2f(P[(size_t)m * PROJW + COL_Q + h * 64 + lane_]);
        float mx = -1e30f, den = 0.f, o = 0.f;
#pragma unroll 1
        for (int g = 0; g < 3; ++g) { const int dl = (g == 0) ? 1 : (g == 1 ? 4 : 16);
            int nk = t / dl; if (nk > 128) nk = 128;
#pragma unroll 2
            for (int j = 0; j <= nk; ++j) { const size_t mk = (size_t)(m - j * dl);
                const float kv = bf2f(P[mk * PROJW + COL_K + h * 64 + lane_]); const float vv = bf2f(P[mk * PROJW + COL_VA + h * 64 + lane_]);
                const float s = wave_sum(q * kv);
                const float mn = fmaxf(mx, s), f = __builtin_amdgcn_exp2f(mx - mn), p = __builtin_amdgcn_exp2f(s - mn);
                den = den * f + p; o = o * f + p * vv; mx = mn; } }
        MIX[(size_t)m * D + AW + h * 64 + lane_] = (bf16)f2bf(o / den);
    }
}

typedef float f32x16 __attribute__((ext_vector_type(16)));
typedef short v4i16_t __attribute__((ext_vector_type(4)));
DI int crow16(int r, int hi) { return (r & 3) + 8 * (r >> 2) + 4 * hi; }
template <int SUB> DI void mix_attn_mfma(Frame& F, int l) {
    FRAME_IDS
    const bf16* P = (const bf16*)(F.ws + WS_PROJ);
    LAS unsigned char* Ks = F.lds + RING_OFF; LAS unsigned char* Vs = Ks + 49152;
    LAS unsigned char* St = F.lds + ATT_STAGE_OFF + wave_ * 4608;
    const int ql = lane_ & 31, hi = lane_ >> 5, prow = lane_ >> 3, pch = lane_ & 7;
    constexpr int nitems = SUB == 0 ? 2048 : 1024;
    v4u kreg[6], vreg[6], qraw[4]; bf16x8 qf[4];
    int it = F.vcu; if (it >= nitems) return;
    int d, r, s0, b, h; size_t tokbase;
#define ATT_DECODE(IT) do { const int idx_ = (IT) & 1023; b = idx_ >> 7; h = (idx_ >> 4) & 7; int tile_; \
        if (SUB == 1) { d = 1; r = 0; tile_ = idx_ & 15; } else if ((IT) < 1024) { d = 16; r = idx_ & 15; tile_ = 0; } else { d = 4; r = (idx_ >> 2) & 3; tile_ = idx_ & 3; } \
        s0 = tile_ * 256; tokbase = (size_t)b * T + r; } while (0)
#define ATT_LOAD() do { const int tl_ = ftid(); _Pragma("unroll") for (int i = 0; i < 6; ++i) { const int idx2 = tl_ + 512 * i, row = idx2 >> 3, ch = idx2 & 7, step = s0 - 128 + row; \
            if (step >= 0) { const bf16* src = P + (tokbase + (size_t)step * d) * PROJW + h * 64 + ch * 8; kreg[i] = *(const v4u*)(src + COL_K); vreg[i] = *(const v4u*)(src + COL_VA); } \
            else { kreg[i] = (v4u){0u, 0u, 0u, 0u}; vreg[i] = (v4u){0u, 0u, 0u, 0u}; } } \
        _Pragma("unroll") for (int p = 0; p < 4; ++p) qraw[p] = *(const v4u*)(P + (tokbase + (size_t)(s0 + 32 * wave_ + 8 * p + prow) * d) * PROJW + COL_Q + h * 64 + pch * 8); } while (0)
#define ATT_WRITE() do { const int tw_ = ftid(); _Pragma("unroll") for (int i = 0; i < 6; ++i) { const int idx2 = tw_ + 512 * i, row = idx2 >> 3, ch = idx2 & 7; \
            *(LAS v4u*)(Ks + row * 128 + ((ch ^ ((row >> 1) & 7)) << 4)) = kreg[i]; \
            *(LAS v4u*)(Vs + row * 128 + ((ch ^ (((row >> 1) & 1) << 2)) << 4)) = vreg[i]; } \
        _Pragma("unroll") for (int p = 0; p < 4; ++p) *(LAS v4u*)(St + (8 * p + prow) * 144 + pch * 16) = qraw[p]; } while (0)
    ATT_DECODE(it); ATT_LOAD(); ATT_WRITE();
    __syncthreads();
    for (;;) {
        const size_t tb = tokbase; const int s0c = s0, dc = d, hcur = h, itcur = it;
        const bool first = (s0 == 0);
#pragma unroll
        for (int ks = 0; ks < 4; ++ks) qf[ks] = *(const LAS bf16x8*)(St + ql * 144 + (2 * ks + hi) * 16);
        const int itn = it + F.G; const bool has_next = itn < nitems;
        if (has_next) { ATT_DECODE(itn); ATT_LOAD(); }
        const int i0 = 32 * wave_;
        f32x16 S[5];
#pragma unroll
        for (int kb = 0; kb < 5; ++kb) { f32x16 acc;
#pragma unroll
            for (int i = 0; i < 16; ++i) acc[i] = 0.f;
            const int krow = i0 + 32 * kb + ql;
#pragma unroll
            for (int ks = 0; ks < 4; ++ks) { const bf16x8 a = *(const LAS bf16x8*)(Ks + krow * 128 + (((2 * ks + hi) ^ ((krow >> 1) & 7)) << 4)); acc = __builtin_amdgcn_mfma_f32_32x32x16_bf16(a, qf[ks], acc, 0, 0, 0); }
            S[kb] = acc; }
        int qrel = ql - 4 * hi; asm volatile("" : "+v"(qrel));
        float mx = -1e30f;
#pragma unroll
        for (int kb = 0; kb < 5; ++kb) {
            const bool bvalid = !first || (wave_ + kb >= 4);
            if (!bvalid) {
#pragma unroll
                for (int i = 0; i < 16; ++i) S[kb][i] = -1e30f;
            } else {
#pragma unroll
                for (int i = 0; i < 16; ++i) { const int c0 = crow16(i, 0); float v = S[kb][i];
                    if (kb == 0) v = (c0 >= qrel) ? v : -1e30f;
                    if (kb == 4) v = (c0 <= qrel) ? v : -1e30f;
                    S[kb][i] = v; mx = fmaxf(mx, v); }
            }
        }
        mx = fmaxf(mx, __shfl_xor(mx, 32));
        float lsum = 0.f;
#pragma unroll
        for (int kb = 0; kb < 5; ++kb)
#pragma unroll
            for (int i = 0; i < 16; ++i) { const float p = __builtin_amdgcn_exp2f(S[kb][i] - mx); S[kb][i] = p; lsum += p; }
        lsum += __shfl_xor(lsum, 32);
        v4u x16[4], x4[4]; f32x2_t s16 = {0.f, 0.f}, s4 = {0.f, 0.f};
        if (SUB == 1) {
            const size_t qt = tb + (size_t)(s0c + i0 + ql) * dc;
            s16 = *(const f32x2_t*)((const float*)(F.ws + WS_STAT) + (qt * NH + hcur) * 2); s4 = *(const f32x2_t*)((const float*)(F.ws + WS_STAT) + (size_t)M * NH * 2 + (qt * NH + hcur) * 2);
        }
        f32x16 O[2];
#pragma unroll
        for (int i = 0; i < 16; ++i) { O[0][i] = 0.f; O[1][i] = 0.f; }
        const int trq = (lane_ & 15) >> 2, trg = (lane_ >> 4) & 1, trp = lane_ & 3;
#pragma unroll
        for (int kb = 0; kb < 5; ++kb)
#pragma unroll
            for (int s = 0; s < 2; ++s) {
                if (SUB == 1 && kb == 2 && s == 0) {
#pragma unroll
                    for (int p = 0; p < 4; ++p) { const size_t rt = tb + (size_t)(s0c + i0 + 8 * p + prow) * dc; const bf16* pp = (const bf16*)(F.ws + WS_XN) + rt * BW + hcur * 64 + pch * 8;
                        x16[p] = *(const v4u*)pp; x4[p] = *(const v4u*)(pp + (size_t)M * BW); } }
                v4u pw; pw.x = cvtpk(S[kb][8 * s], S[kb][8 * s + 1]); pw.y = cvtpk(S[kb][8 * s + 2], S[kb][8 * s + 3]); pw.z = cvtpk(S[kb][8 * s + 4], S[kb][8 * s + 5]); pw.w = cvtpk(S[kb][8 * s + 6], S[kb][8 * s + 7]);
                const bf16x8 pb = __builtin_bit_cast(bf16x8, pw);
                const int rlo = i0 + 32 * kb + 16 * s + 4 * hi + trq, rhi = rlo + 8;
#pragma unroll
                for (int dh = 0; dh < 2; ++dh) { const int chunk = 4 * dh + 2 * trg + (trp >> 1);
                    const v4i16_t lo = __builtin_amdgcn_ds_read_tr16_b64_v4i16((LAS v4i16_t*)(Vs + rlo * 128 + ((chunk ^ (((rlo >> 1) & 1) << 2)) << 4) + 8 * (trp & 1)));
                    const v4i16_t hh = __builtin_amdgcn_ds_read_tr16_b64_v4i16((LAS v4i16_t*)(Vs + rhi * 128 + ((chunk ^ (((rhi >> 1) & 1) << 2)) << 4) + 8 * (trp & 1)));
                    const bf16x8 va = (bf16x8){lo[0], lo[1], lo[2], lo[3], hh[0], hh[1], hh[2], hh[3]};
                    O[dh] = __builtin_amdgcn_mfma_f32_32x32x16_bf16(va, pb, O[dh], 0, 0, 0); } }
        float osc;
        if (SUB == 0) osc = 1.0f / lsum;
        else { const float MM = fmaxf(mx, fmaxf(s16.x, s4.x)), a1 = __builtin_amdgcn_exp2f(mx - MM), a16 = s16.y * __builtin_amdgcn_exp2f(s16.x - MM), a4 = s4.y * __builtin_amdgcn_exp2f(s4.x - MM);
            const float inv = 1.0f / (lsum * a1 + a16 + a4); osc = a1 * inv;
            if (hi == 0) { f32x2_t cc = {a16 * inv, a4 * inv}; *(LAS f32x2_t*)(St + ql * 144 + 128) = cc; } }
#pragma unroll
        for (int dh = 0; dh < 2; ++dh)
#pragma unroll
            for (int g4 = 0; g4 < 4; ++g4) { v2u w; w.x = cvtpk(O[dh][4 * g4] * osc, O[dh][4 * g4 + 1] * osc); w.y = cvtpk(O[dh][4 * g4 + 2] * osc, O[dh][4 * g4 + 3] * osc);
                *(LAS v2u*)(St + ql * 144 + (32 * dh + 8 * g4 + 4 * hi) * 2) = w; }
        if (SUB == 0) {
            bf16* PART = (bf16*)(F.ws + WS_XN) + (itcur < 1024 ? 0 : (size_t)M * BW); float* ST = (float*)(F.ws + WS_STAT) + (itcur < 1024 ? 0 : (size_t)M * NH * 2);
            if (hi == 0) { const size_t qt = tb + (size_t)(s0c + i0 + ql) * dc; f32x2_t st = {mx, lsum}; *(f32x2_t*)(ST + (qt * NH + hcur) * 2) = st; }
#pragma unroll
            for (int p = 0; p < 4; ++p) { const size_t rt = tb + (size_t)(s0c + i0 + 8 * p + prow) * dc;
                *(v4u*)(PART + rt * BW + hcur * 64 + pch * 8) = *(const LAS v4u*)(St + (8 * p + prow) * 144 + pch * 16); }
        } else {
#pragma unroll
            for (int p = 0; p < 4; ++p) { const size_t rt = tb + (size_t)(s0c + i0 + 8 * p + prow) * dc;
                const v4u ov = *(const LAS v4u*)(St + (8 * p + prow) * 144 + pch * 16); const f32x2_t cc = *(const LAS f32x2_t*)(St + (8 * p + prow) * 144 + 128);
                v4u o;
                o.x = cvtpk(bflo(ov.x) + cc.x * bflo(x16[p].x) + cc.y * bflo(x4[p].x), bfhi(ov.x) + cc.x * bfhi(x16[p].x) + cc.y * bfhi(x4[p].x));
                o.y = cvtpk(bflo(ov.y) + cc.x * bflo(x16[p].y) + cc.y * bflo(x4[p].y), bfhi(ov.y) + cc.x * bfhi(x16[p].y) + cc.y * bfhi(x4[p].y));
                o.z = cvtpk(bflo(ov.z) + cc.x * bflo(x16[p].z) + cc.y * bflo(x4[p].z), bfhi(ov.z) + cc.x * bfhi(x16[p].z) + cc.y * bfhi(x4[p].z));
                o.w = cvtpk(bflo(ov.w) + cc.x * bflo(x16[p].w) + cc.y * bflo(x4[p].w), bfhi(ov.w) + cc.x * bfhi(x16[p].w) + cc.y * bfhi(x4[p].w));
                *(v4u*)((bf16*)(F.ws + WS_MIXCAT) + rt * D + AW + hcur * 64 + pch * 8) = o; }
        }
        __syncthreads();
        if (!has_next) break;
        ATT_WRITE(); it = itn;
        __syncthreads();
    }
#undef ATT_DECODE
#undef ATT_LOAD
#undef ATT_WRITE
}
typedef float f32x4_t __attribute__((ext_vector_type(4)));
DI void cmul_acc(float& xr, float& xi, float ar, float ai, float br, float bi) { const float nr = ar * xr - ai * xi + br, ni = ar * xi + ai * xr + bi; xr = nr; xi = ni; }
DI void mix_ssm_in(Frame& F, int l) {
    FRAME_IDS
    const bf16* P = (const bf16*)(F.ws + WS_PROJ);
    const bf16* WIN = (const bf16*)(F.ws + WS_SSM2 + l * SSM2_LAYER + S2_WIN);
    const float* apw = (const float*)(F.ws + WS_SSM2 + l * SSM2_LAYER + S2_APW);
    float* XLOC = (float*)(F.ws + WS_XLOC); float* XSUP = (float*)(F.ws + WS_XSUP);
    const int row = lane_ & 15, q = lane_ >> 4;
    for (int it = F.vcu; it < 256; it += F.G) {
        const int b = it >> 5, sc = (it >> 2) & 7, g = 4 * (it & 3) + (wave_ >> 1), half = wave_ & 1;
        bf16x8 af[16];
        { const bf16* src = P + ((size_t)b * T + (size_t)(16 * sc + row) * 32 + (q >> 1)) * PROJW + COL_S + g * 16 + 8 * (q & 1);
#pragma unroll
          for (int sp = 0; sp < 16; ++sp) af[sp] = *(const bf16x8*)(src + (size_t)(2 * sp) * PROJW); }
#pragma unroll 1
        for (int c4 = 0; c4 < 4; ++c4) { const int ct = 4 * half + c4;
            f32x4_t acc = {0.f, 0.f, 0.f, 0.f};
            const bf16* wp = WIN + (((size_t)(g * 16) * 8 + ct) * 64 + lane_) * 8;
#pragma unroll
            for (int sp = 0; sp < 16; ++sp) { const bf16x8 bfr = *(const bf16x8*)(wp + (size_t)sp * 8 * 64 * 8); acc = __builtin_amdgcn_mfma_f32_16x16x32_bf16(af[sp], bfr, acc, 0, 0, 0); }
            const int comp = 16 * ct + row, n = comp >> 1, part = comp & 1;
#pragma unroll
            for (int r = 0; r < 4; ++r) XLOC[(((size_t)b * 128 + 16 * sc + 4 * q + r) * 16 + g) * 128 + comp] = acc[r];
            const float a32r = apw[((g * 33 + 32) * 64 + n) * 2], a32i = apw[((g * 33 + 32) * 64 + n) * 2 + 1];
            const float sg = part ? 1.f : -1.f;
            float h = acc[0];
#pragma unroll
            for (int r = 1; r < 4; ++r) { const float o = __shfl_xor(h, 1); h = a32r * h + sg * a32i * o + acc[r]; }
            float p64r = a32r * a32r - a32i * a32i, p64i = 2.f * a32r * a32i;
            float p128r = p64r * p64r - p64i * p64i, p128i = 2.f * p64r * p64i;
            float wr = 1.f, wi = 0.f;
            for (int k = 0; k < 3 - q; ++k) { const float t0 = wr * p128r - wi * p128i, t1 = wr * p128i + wi * p128r; wr = t0; wi = t1; }
            { const float o = __shfl_xor(h, 1); h = wr * h + sg * wi * o; }
            h += __shfl_xor(h, 16); h += __shfl_xor(h, 32);
            if (q == 0) XSUP[(((size_t)b * 8 + sc) * 16 + g) * 128 + comp] = h;
        }
    }
}
DI void mix_ssm_out(Frame& F, const Args& A, int l) {
    FRAME_IDS
    const bf16* P = (const bf16*)(F.ws + WS_PROJ); bf16* YG = (bf16*)(F.ws + WS_YG);
    const bf16* KT = (const bf16*)(F.ws + WS_SSM2 + l * SSM2_LAYER + S2_KT); const bf16* CT = (const bf16*)(F.ws + WS_SSM2 + l * SSM2_LAYER + S2_CT);
    const float* apw = (const float*)(F.ws + WS_SSM2 + l * SSM2_LAYER + S2_APW);
    const float* XLOC = (const float*)(F.ws + WS_XLOC); const float* XSUP = (const float*)(F.ws + WS_XSUP);
    LAS unsigned char* Ut = F.lds + RING_OFF + wave_ * 4096;
    LAS float* Xs = (LAS float*)(F.lds + RING_OFF + wave_ * 4096 + 2048);
    for (int i = lane_; i < 256; i += 64) ((LAS unsigned*)Ut)[i] = 0u;
    const int row = lane_ & 15, q = lane_ >> 4;
    for (int it = F.vcu; it < 256; it += F.G) {
        const int b = it >> 5, sc = (it >> 2) & 7, g = 4 * (it & 3) + (wave_ >> 1), half = wave_ & 1, n = lane_;
        const size_t tokA = (size_t)b * T + (size_t)(16 * sc + 8 * half) * 32;
        v4u unext = *(const v4u*)(P + (tokA + (lane_ >> 1)) * PROJW + COL_S + g * 16 + 8 * (lane_ & 1));
        f32x2_t psup[8], ploc[8];
#pragma unroll
        for (int s2 = 0; s2 < 8; ++s2) { psup[s2] = (f32x2_t){0.f, 0.f}; if (s2 < sc) psup[s2] = *(const f32x2_t*)(XSUP + (((size_t)b * 8 + s2) * 16 + g) * 128 + 2 * n); }
#pragma unroll
        for (int k2 = 0; k2 < 8; ++k2) { ploc[k2] = (f32x2_t){0.f, 0.f}; if (half) ploc[k2] = *(const f32x2_t*)(XLOC + (((size_t)b * 128 + 16 * sc + k2) * 16 + g) * 128 + 2 * n); }
        const float dsk = ((const float*)A.in[I_SSMD])[(l * 16 + g) * 16 + row];
        const float a32r = apw[((g * 33 + 32) * 64 + n) * 2], a32i = apw[((g * 33 + 32) * 64 + n) * 2 + 1];
        const float a16r = apw[((g * 33 + 16) * 64 + n) * 2], a16i = apw[((g * 33 + 16) * 64 + n) * 2 + 1];
        float a512r = a32r, a512i = a32i;
#pragma unroll
        for (int k = 0; k < 4; ++k) { const float t0 = a512r * a512r - a512i * a512i, t1 = 2.f * a512r * a512i; a512r = t0; a512i = t1; }
        float xr = 0.f, xi = 0.f;
#pragma unroll
        for (int s2 = 0; s2 < 8; ++s2) if (s2 < sc) cmul_acc(xr, xi, a512r, a512i, psup[s2].x, psup[s2].y);
        if (half) {
#pragma unroll
            for (int k2 = 0; k2 < 8; ++k2) cmul_acc(xr, xi, a32r, a32i, ploc[k2].x, ploc[k2].y); }
        asm volatile("" : "+v"(xr), "+v"(xi) :: "memory");
        bf16x8 kt[16], ctf[4];
#pragma unroll
        for (int p = 0; p < 16; ++p) kt[p] = *(const bf16x8*)(KT + ((size_t)(g * 16 + p) * 64 + lane_) * 8);
#pragma unroll
        for (int sx = 0; sx < 4; ++sx) ctf[sx] = *(const bf16x8*)(CT + ((size_t)(g * 4 + sx) * 64 + lane_) * 8);
        f32x4_t apr[4][2];
#pragma unroll
        for (int sx = 0; sx < 4; ++sx) { const f32x4_t* ap = (const f32x4_t*)(apw + ((size_t)(g * 33 + row + 1) * 64 + 16 * sx + 4 * q) * 2); apr[sx][0] = ap[0]; apr[sx][1] = ap[1]; }
#pragma unroll 1
        for (int kk = 0; kk < 8; ++kk) {
            const size_t tok0 = tokA + (size_t)kk * 32;
            const f32x2_t xl = *(const f32x2_t*)(XLOC + (((size_t)b * 128 + 16 * sc + 8 * half + kk) * 16 + g) * 128 + 2 * n);
            *(LAS v4u*)(Ut + 1024 + lane_ * 16) = unext;
            if (kk < 7) unext = *(const v4u*)(P + (tok0 + 32 + (lane_ >> 1)) * PROJW + COL_S + g * 16 + 8 * (lane_ & 1));
            Xs[2 * n] = xr; Xs[2 * n + 1] = xi; Xs[128 + 2 * n] = a16r * xr - a16i * xi; Xs[128 + 2 * n + 1] = a16r * xi + a16i * xr;
#pragma unroll
            for (int tau = 0; tau < 2; ++tau) { f32x4_t acc = (f32x4_t){0.f, 0.f, 0.f, 0.f};
                const int ti = 16 * tau + row;
#pragma unroll
                for (int sx = 0; sx < 4; ++sx) { const LAS f32x4_t* xp = (const LAS f32x4_t*)(Xs + 128 * tau + 2 * (16 * sx + 4 * q)); const f32x4_t x01 = xp[0], x23 = xp[1];
                    const f32x4_t a01 = apr[sx][0], a23 = apr[sx][1];
                    v4u zw; zw.x = cvtpk(a01.x * x01.x - a01.y * x01.y, a01.x * x01.y + a01.y * x01.x); zw.y = cvtpk(a01.z * x01.z - a01.w * x01.w, a01.z * x01.w + a01.w * x01.z);
                    zw.z = cvtpk(a23.x * x23.x - a23.y * x23.y, a23.x * x23.y + a23.y * x23.x); zw.w = cvtpk(a23.z * x23.z - a23.w * x23.w, a23.z * x23.w + a23.w * x23.z);
                    acc = __builtin_amdgcn_mfma_f32_16x16x32_bf16(__builtin_bit_cast(bf16x8, zw), ctf[sx], acc, 0, 0, 0);
                    asm volatile("" ::: "memory"); }
#pragma unroll
                for (int p = 0; p < 16; ++p) if (p < 8 * tau + 8) { const bf16x8 ua = *(const LAS bf16x8*)(Ut + (32 + ti - 2 * p - (q >> 1)) * 32 + 16 * (q & 1));
                    acc = __builtin_amdgcn_mfma_f32_16x16x32_bf16(ua, kt[p], acc, 0, 0, 0); if ((p & 3) == 3) asm volatile("" ::: "memory"); }
#pragma unroll
                for (int r = 0; r < 4; ++r) { const int t2 = 16 * tau + 4 * q + r; const float uu = bf2f(*(const LAS bf16*)(Ut + (32 + t2) * 32 + 2 * row));
                    YG[(tok0 + t2) * 256 + g * 16 + row] = (bf16)f2bf(gelu_tanh_f(acc[r] + dsk * uu)); }
            }
            cmul_acc(xr, xi, a32r, a32i, xl.x, xl.y);
        }
    }
}
DI void mix_gating_mfma(Frame& F, const Args& A, int l, int variant = 0) {
    FRAME_IDS
    const bf16* P = (const bf16*)(F.ws + WS_PROJ); bf16* MIX = (bf16*)(F.ws + WS_MIXCAT);
    const bf16* GW = (const bf16*)(F.ws + WS_SSM2 + l * SSM2_LAYER + S2_GW);
    const float* lng = (const float*)A.in[I_GMLNG] + l * AW; const float* lnb = (const float*)A.in[I_GMLNB] + l * AW;
    const float* bs_ = (const float*)A.in[I_GMBS] + l * 4 * 128;
    LAS unsigned char* VT = F.lds + RING_OFF;
    const int ql = lane_ & 31, hi = lane_ >> 5, trq = (lane_ & 15) >> 2, trg = (lane_ >> 4) & 1, trp = lane_ & 3;
    for (int it = F.vcu; it < BATCH * (T / 128); it += F.G) {
        const int m0 = it * 128;
        __syncthreads();
        if (variant != 2) {
        v2u wv[16];
#pragma unroll
        for (int j = 0; j < 16; ++j) wv[j] = *(const v2u*)(P + (size_t)(m0 + wave_ + 8 * j) * PROJW + COL_V + 4 * lane_);
        const f32x4 gg = *(const f32x4*)(lng + 4 * lane_), bb = *(const f32x4*)(lnb + 4 * lane_);
#pragma unroll
        for (int j = 0; j < 16; ++j) { const int r = wave_ + 8 * j; const v2u w = wv[j];
            float v[4] = {gelu_tanh_f(bflo(w.x)), gelu_tanh_f(bfhi(w.x)), gelu_tanh_f(bflo(w.y)), gelu_tanh_f(bfhi(w.y))};
            const float mean = wave_sum(v[0] + v[1] + v[2] + v[3]) * (1.f / 256.f);
            float s2 = 0.f;
#pragma unroll
            for (int i = 0; i < 4; ++i) { v[i] -= mean; s2 += v[i] * v[i]; }
            const float rstd = 1.0f / sqrtf(wave_sum(s2) * (1.f / 256.f) + LN_EPS);
            v2u o; o.x = cvtpk(v[0] * rstd * gg.x + bb.x, v[1] * rstd * gg.y + bb.y); o.y = cvtpk(v[2] * rstd * gg.z + bb.z, v[3] * rstd * gg.w + bb.w);
            *(LAS v2u*)(VT + r * 512 + (((lane_ >> 1) ^ ((r & 3) << 2)) << 4) + 8 * (lane_ & 1)) = o;
        }
        }
        __syncthreads();
        if (variant == 1) continue;
        const int h = wave_ >> 1, cb = 64 * h + 32 * (wave_ & 1);
        const int chunk = (cb >> 3) + 2 * trg + (trp >> 1);
#pragma unroll
        for (int rt = 0; rt < 4; ++rt) {
            f32x16 acc;
#pragma unroll
            for (int i = 0; i < 16; ++i) acc[i] = 0.f;
            bf16x8 wa[8];
#pragma unroll
            for (int ks = 0; ks < 2 * rt + 2; ++ks) wa[ks] = *(const bf16x8*)(GW + ((size_t)h * 128 + 32 * rt + ql) * 128 + 16 * ks + 8 * hi);
#pragma unroll
            for (int ks = 0; ks < 2 * rt + 2; ++ks) {
                const int rlo = 16 * ks + 8 * hi + trq;
                const v4i16_t lo = __builtin_amdgcn_ds_read_tr16_b64_v4i16((LAS v4i16_t*)(VT + rlo * 512 + ((chunk ^ (trq << 2)) << 4) + 8 * (trp & 1)));
                const v4i16_t hh = __builtin_amdgcn_ds_read_tr16_b64_v4i16((LAS v4i16_t*)(VT + (rlo + 4) * 512 + ((chunk ^ (trq << 2)) << 4) + 8 * (trp & 1)));
                const bf16x8 va = (bf16x8){lo[0], lo[1], lo[2], lo[3], hh[0], hh[1], hh[2], hh[3]};
                acc = __builtin_amdgcn_mfma_f32_32x32x16_bf16(va, wa[ks], acc, 0, 0, 0); }
            { const int t = 32 * rt + ql; const float bsv = bs_[h * 128 + t];
              const bf16* up = P + (size_t)(m0 + t) * PROJW + COL_U + cb + 4 * hi; bf16* op = MIX + (size_t)(m0 + t) * D + cb + 4 * hi;
#pragma unroll
              for (int g4 = 0; g4 < 4; ++g4) { const v2u uw = *(const v2u*)(up + 8 * g4); v2u o;
                  o.x = cvtpk(gelu_tanh_f(bflo(uw.x)) * (acc[4 * g4] + bsv), gelu_tanh_f(bfhi(uw.x)) * (acc[4 * g4 + 1] + bsv)); o.y = cvtpk(gelu_tanh_f(bflo(uw.y)) * (acc[4 * g4 + 2] + bsv), gelu_tanh_f(bfhi(uw.y)) * (acc[4 * g4 + 3] + bsv));
                  *(v2u*)(op + 8 * g4) = o; } }
        }
    }
}

DI void p_glu(Frame& F, const Args& A, int l) {
    FRAME_IDS
    const bf16* YG = (const bf16*)(F.ws + WS_YG); bf16* MIX = (bf16*)(F.ws + WS_MIXCAT);
    const bf16* GluT = (const bf16*)(F.ws + WS_WSMALL + l * WSMALL_LAYER + WOFF_GLU); const float* gb = (const float*)A.in[I_GLUB] + l * 256;
    LAS unsigned char* Bs = F.lds + RING_OFF;
#pragma unroll
    for (int i = 0; i < 16; ++i) { const int idx = tid_ + 512 * i, n = idx >> 5, ch = idx & 31;
        *(LAS v4u*)(Bs + n * 512 + ((ch ^ (n & 15)) << 4)) = *(const v4u*)(GluT + (size_t)n * 256 + ch * 8); }
    __syncthreads();
    const int tk = lane_ & 15, q = lane_ >> 4;
    for (int rt = F.vcu; rt < M / 128; rt += F.G) {
        const size_t tok = (size_t)rt * 128 + wave_ * 16 + tk;
        bf16x8 yf[8];
#pragma unroll
        for (int ks = 0; ks < 8; ++ks) yf[ks] = *(const bf16x8*)(YG + tok * 256 + 32 * ks + 8 * q);
#pragma unroll 4
        for (int ct = 0; ct < 16; ++ct) {
            f32x4_t acc = {0.f, 0.f, 0.f, 0.f};
            const int n = 16 * ct + tk;
#pragma unroll
            for (int ks = 0; ks < 8; ++ks) { const bf16x8 wf = *(const LAS bf16x8*)(Bs + n * 512 + (((4 * ks + q) ^ (n & 15)) << 4));
                acc = __builtin_amdgcn_mfma_f32_16x16x32_bf16(wf, yf[ks], acc, 0, 0, 0); }
            const int n0 = 16 * ct + 4 * q; const v2u yw = *(const v2u*)(YG + tok * 256 + n0); const f32x4 bv = *(const f32x4*)(gb + n0);
            v2u o; o.x = cvtpk(bflo(yw.x) * sigmoid_f(acc[0] + bv.x), bfhi(yw.x) * sigmoid_f(acc[1] + bv.y)); o.y = cvtpk(bflo(yw.y) * sigmoid_f(acc[2] + bv.z), bfhi(yw.y) * sigmoid_f(acc[3] + bv.w));
            *(v2u*)(MIX + tok * D + 768 + n0) = o;
        }
    }
}
DI void mix_ssm_simple(Frame& F, const Args& A, int l) {
    FRAME_IDS
    const bf16* P = (const bf16*)(F.ws + WS_PROJ); bf16* YG = (bf16*)(F.ws + WS_YG);
    const float* tab = (const float*)(F.ws + WS_SSM) + (size_t)l * SSM_TAB;
    LAS float* fin = (LAS float*)(F.lds + RING_OFF);
    for (int it = F.vcu; it < BATCH * SSM_G; it += F.G) {
        const int b = it >> 4, g = it & 15, n = lane_, seg = wave_, gn = g * 64 + n;
        const float are = tab[gn], aim = tab[1024 + gn];
        float bre[16], bim[16], cre[16], cim[16];
#pragma unroll
        for (int c = 0; c < 16; ++c) { bre[c] = tab[2048 + gn * 16 + c]; bim[c] = tab[2048 + 16384 + gn * 16 + c];
            cre[c] = ((const float*)A.in[I_CRE])[(((size_t)l * 16 + g) * 16 + c) * 64 + n]; cim[c] = ((const float*)A.in[I_CIM])[(((size_t)l * 16 + g) * 16 + c) * 64 + n]; }
        const float dsk = ((const float*)A.in[I_SSMD])[(l * 16 + g) * 16 + (lane_ & 15)];
        const size_t mbase = (size_t)b * T + seg * 512;
        float xr = 0.f, xi = 0.f;
        for (int tt = 0; tt < 512; ++tt) { const v4u* up = (const v4u*)(P + (mbase + tt) * PROJW + COL_S + g * 16); const v4u u0 = up[0], u1 = up[1];
            const float u[16] = {bflo(u0.x), bfhi(u0.x), bflo(u0.y), bfhi(u0.y), bflo(u0.z), bfhi(u0.z), bflo(u0.w), bfhi(u0.w), bflo(u1.x), bfhi(u1.x), bflo(u1.y), bfhi(u1.y), bflo(u1.z), bfhi(u1.z), bflo(u1.w), bfhi(u1.w)};
            float br = 0.f, bi = 0.f;
#pragma unroll
            for (int c = 0; c < 16; ++c) { br += u[c] * bre[c]; bi += u[c] * bim[c]; }
            const float nr = are * xr - aim * xi + br, ni = are * xi + aim * xr + bi; xr = nr; xi = ni; }
        fin[(seg * 64 + n) * 2] = xr; fin[(seg * 64 + n) * 2 + 1] = xi;
        __syncthreads();
        float pr = are, pi = aim;
#pragma unroll
        for (int k = 0; k < 9; ++k) { const float t0 = pr * pr - pi * pi, t1 = 2.f * pr * pi; pr = t0; pi = t1; }
        xr = 0.f; xi = 0.f;
        for (int s = 0; s < seg; ++s) { const float fr_ = fin[(s * 64 + n) * 2], fi_ = fin[(s * 64 + n) * 2 + 1];
            const float nr = pr * xr - pi * xi + fr_, ni = pr * xi + pi * xr + fi_; xr = nr; xi = ni; }
        for (int tt = 0; tt < 512; ++tt) { const v4u* up = (const v4u*)(P + (mbase + tt) * PROJW + COL_S + g * 16); const v4u u0 = up[0], u1 = up[1];
            const float u[16] = {bflo(u0.x), bfhi(u0.x), bflo(u0.y), bfhi(u0.y), bflo(u0.z), bfhi(u0.z), bflo(u0.w), bfhi(u0.w), bflo(u1.x), bfhi(u1.x), bflo(u1.y), bfhi(u1.y), bflo(u1.z), bfhi(u1.z), bflo(u1.w), bfhi(u1.w)};
            float br = 0.f, bi = 0.f;
#pragma unroll
            for (int c = 0; c < 16; ++c) { br += u[c] * bre[c]; bi += u[c] * bim[c]; }
            const float nr = are * xr - aim * xi + br, ni = are * xi + aim * xr + bi; xr = nr; xi = ni;
            float ysel = 0.f, usel = 0.f;
#pragma unroll
            for (int c = 0; c < 16; ++c) { const float r = wave_sum(xr * cre[c] - xi * cim[c]); if ((lane_ & 15) == c) { ysel = r; usel = u[c]; } }
            if (lane_ < 16) { const float y = ysel + dsk * usel; YG[(mbase + tt) * 256 + g * 16 + lane_] = (bf16)f2bf(gelu_tanh_f(y)); } }
        __syncthreads();
    }
}

DI bool beats(float x, int i, float y, int j) { return x > y || (x == y && i < j); }
DI void p_row_b(Frame& F, const Args& A, int l, bool count = true) {
    FRAME_IDS
    const int gw = F.vcu * NWAVES + wave_, NGW = F.G * NWAVES;
    const bf16* PRE = (const bf16*)(F.ws + WS_PRE); bf16* X1 = (bf16*)(F.ws + WS_X1); bf16* XN = (bf16*)(F.ws + WS_XN);
    const float* mod = (const float*)(F.ws + WS_MOD) + (size_t)l * BATCH * 6 * D;
    const float* ln1g = (const float*)A.in[I_LN1G] + l * D; const float* ln1b = (const float*)A.in[I_LN1B] + l * D;
    const float* rw = (const float*)A.in[I_RW]; const float* rb = (const float*)A.in[I_RB];
    int* slot_a = (int*)(F.ws + WS_SLOT_A); float* slot_w = (float*)(F.ws + WS_SLOT_W);
    LAS float* rwS = (LAS float*)(F.lds + RING_OFF);
    volatile LAS unsigned* lcnt = (volatile LAS unsigned*)(F.lds + RING_OFF + 65536);
    LAS int* list_a = (LAS int*)(F.lds + RING_OFF + 66048); LAS float* list_w = (LAS float*)(F.lds + RING_OFF + 66048 + 8192);
    for (int i = tid_; i < D * NEXP; i += NTHR) rwS[(i & 15) * D + (i >> 4)] = rw[i];
    if (tid_ < 32) lcnt[tid_] = 0u;
    __syncthreads();
    const int hi5 = lane_ >> 5, b4 = (lane_ >> 4) & 1, b3 = (lane_ >> 3) & 1, b2 = (lane_ >> 2) & 1, emine = 8 * hi5 + 4 * b4 + 2 * b3 + b2;
    const int wi = 2 * b3 + b2, mygrp = 2 * hi5 + b4;
    const float rbm = rb[emine];
    Row16 lg1, lb1; row_load_f32(lg1, ln1g, lane_); row_load_f32(lb1, ln1b, lane_);
    v2u nraw[4];
    const int bq = gw / (NGW / BATCH), mbase = bq * T + gw % (NGW / BATCH), mstep = NGW / BATCH;
    const float* md = mod + (size_t)bq * 6 * D;
    Row16 msc, msh; row_load_f32(msc, md + 4 * D, lane_); row_load_f32(msh, md + 3 * D, lane_);
    { const v2u* q = (const v2u*)(PRE + (size_t)mbase * D);
#pragma unroll
      for (int k = 0; k < 4; ++k) nraw[k] = q[k * 64 + lane_]; }
    for (int m = mbase; m < (bq + 1) * T; m += mstep) {
        Row16 r;
#pragma unroll
        for (int k = 0; k < 4; ++k) { r.v[4 * k] = bflo(nraw[k].x); r.v[4 * k + 1] = bfhi(nraw[k].x); r.v[4 * k + 2] = bflo(nraw[k].y); r.v[4 * k + 3] = bfhi(nraw[k].y); }
        if (m + mstep < (bq + 1) * T) { const v2u* q = (const v2u*)(PRE + (size_t)(m + mstep) * D);
#pragma unroll
            for (int k = 0; k < 4; ++k) nraw[k] = q[k * 64 + lane_]; }
        row_ln(r);
#pragma unroll
        for (int i = 0; i < 16; ++i) r.v[i] = r.v[i] * lg1.v[i] + lb1.v[i];
        row_ln(r);
#pragma unroll
        for (int i = 0; i < 16; ++i) r.v[i] = r.v[i] * (1.0f + msc.v[i]) + msh.v[i];
        row_store_bf16(r, XN + (size_t)m * D, lane_);
        float lg[16];
#pragma unroll
        for (int e = 0; e < 16; ++e) { float a = 0.f;
#pragma unroll
            for (int k = 0; k < 4; ++k) { const f32x4 w4 = *(const LAS f32x4*)(rwS + e * D + 256 * k + 4 * lane_); a += r.v[4 * k] * w4.x + r.v[4 * k + 1] * w4.y + r.v[4 * k + 2] * w4.z + r.v[4 * k + 3] * w4.w; }
            lg[e] = a; }
        float t8[8], t4[4], t2[2];
#pragma unroll
        for (int i = 0; i < 8; ++i) { const float keep = hi5 ? lg[8 + i] : lg[i], give = hi5 ? lg[i] : lg[8 + i]; t8[i] = keep + __shfl_xor(give, 32); }
#pragma unroll
        for (int i = 0; i < 4; ++i) { const float keep = b4 ? t8[4 + i] : t8[i], give = b4 ? t8[i] : t8[4 + i]; t4[i] = keep + __shfl_xor(give, 16); }
#pragma unroll
        for (int i = 0; i < 2; ++i) { const float keep = b3 ? t4[2 + i] : t4[i], give = b3 ? t4[i] : t4[2 + i]; t2[i] = keep + __shfl_xor(give, 8); }
        float z = (b2 ? t2[1] : t2[0]) + __shfl_xor(b2 ? t2[0] : t2[1], 4);
        z += __shfl_xor(z, 2); z += __shfl_xor(z, 1);
        const float scm = 1.0f / (1.0f + __builtin_amdgcn_exp2f(-1.4426950408889634f * z)), a = scm + rbm;
        const float p4 = __shfl_xor(a, 4), p8 = __shfl_xor(a, 8), p12 = __shfl_xor(a, 12);
        const float hi01 = fmaxf(a, p4), lo01 = fminf(a, p4), hi23 = fmaxf(p8, p12), lo23 = fminf(p8, p12);
        const float gs = fmaxf(hi01, hi23) + fmaxf(fmaxf(lo01, lo23), fminf(hi01, hi23));
        const float g16 = __shfl_xor(gs, 16), g32 = __shfl_xor(gs, 32), g48 = __shfl_xor(gs, 48);
        const bool best = beats(gs, mygrp, g16, mygrp ^ 1) && beats(gs, mygrp, g32, mygrp ^ 2) && beats(gs, mygrp, g48, mygrp ^ 3);
        const int rank = (beats(p4, wi ^ 1, a, wi) ? 1 : 0) + (beats(p8, wi ^ 2, a, wi) ? 1 : 0) + (beats(p12, wi ^ 3, a, wi) ? 1 : 0);
        const bool sel = best && rank < 2;
        float tot = sel ? scm : 0.f; tot += __shfl_xor(tot, 4); tot += __shfl_xor(tot, 8);
        if (count && sel && (lane_ & 3) == 0) { const unsigned rk = atomicAdd((unsigned*)&lcnt[emine], 1u);
            list_a[emine * 128 + rk] = 2 * m + rank; list_w[emine * 128 + rk] = scm / tot; }
    }
    __syncthreads();
    if (count) {
        if (tid_ < 16) { const unsigned n = lcnt[tid_]; lcnt[16 + tid_] = n ? atomicAdd((unsigned*)(F.ctl + CW_CNT + l * 128 + tid_), n) : 0u; }
        __syncthreads();
        for (int idx = tid_; idx < 16 * 128; idx += NTHR) { const int e = idx >> 7, rk = idx & 127;
            if (rk < (int)lcnt[e]) { const size_t slot = (size_t)e * SLOT_CAP + lcnt[16 + e] + rk; slot_a[slot] = list_a[idx]; slot_w[slot] = list_w[idx]; } }
    }
}

DI void moe_tstart(Frame& F, int l) {
    FRAME_IDS
    volatile LAS int* ts = (volatile LAS int*)(F.lds + LDSCTL_OFF);
    __syncthreads();
    if (tid_ == 0) { int acc = 0;
        for (int e = 0; e < 16; ++e) { ts[e] = acc; const unsigned c = __hip_atomic_load(F.ctl + CW_CNT + l * 128 + e, RLX_AGENT); ts[32 + e] = (int)c; acc += (int)((c + 255u) >> 8); }
        ts[16] = acc; }
    __syncthreads();
}
DI void p_row_c(Frame& F, const Args& A, int l) {
    FRAME_IDS
    const int gw = F.vcu * NWAVES + wave_, NGW = F.G * NWAVES;
    const bf16* X1 = (const bf16*)(F.ws + WS_PRE); bf16* R2 = (bf16*)(F.ws + WS_ROWS2); bf16* XN = (bf16*)(F.ws + WS_XN);
    const float* ln1g = (const float*)A.in[I_LN1G] + l * D; const float* ln1b = (const float*)A.in[I_LN1B] + l * D;
    Row16 lg1, lb1; row_load_f32(lg1, ln1g, lane_); row_load_f32(lb1, ln1b, lane_);
    const float* mod = (const float*)(F.ws + WS_MOD) + (size_t)l * BATCH * 6 * D;
    const float* modn = (const float*)(F.ws + WS_MOD) + (size_t)(l + 1) * BATCH * 6 * D;
    const float* ln2g = (const float*)A.in[I_LN2G] + l * D; const float* ln2b = (const float*)A.in[I_LN2B] + l * D;
    Row16 lg2, lb2; row_load_f32(lg2, ln2g, lane_); row_load_f32(lb2, ln2b, lane_);
    v2u nx[4], n0[4], n1[4];
#define RC_LOAD(mm) do { const v2u* qa = (const v2u*)(X1 + (size_t)(mm) * D); const v2u* qb = (const v2u*)(R2 + (size_t)(2 * (mm)) * D); \
        _Pragma("unroll") for (int k = 0; k < 4; ++k) { nx[k] = qa[k * 64 + lane_]; n0[k] = qb[k * 64 + lane_]; n1[k] = qb[256 + k * 64 + lane_]; } } while (0)
    const int bq = gw / (NGW / BATCH), mbase = bq * T + gw % (NGW / BATCH), mstep = NGW / BATCH;
    const float* md = mod + (size_t)bq * 6 * D;
    Row16 gm; row_load_f32(gm, md + 5 * D, lane_);
    Row16 msc, msh;
    if (l != DEPTH - 1) { const float* mdn = modn + (size_t)bq * 6 * D; row_load_f32(msc, mdn + 1 * D, lane_); row_load_f32(msh, mdn + 0 * D, lane_); }
    RC_LOAD(mbase);
    for (int m = mbase; m < (bq + 1) * T; m += mstep) {
        Row16 x1, g2;
#pragma unroll
        for (int k = 0; k < 4; ++k) {
            x1.v[4 * k] = bflo(nx[k].x); x1.v[4 * k + 1] = bfhi(nx[k].x); x1.v[4 * k + 2] = bflo(nx[k].y); x1.v[4 * k + 3] = bfhi(nx[k].y);
            g2.v[4 * k] = bflo(n0[k].x) + bflo(n1[k].x); g2.v[4 * k + 1] = bfhi(n0[k].x) + bfhi(n1[k].x); g2.v[4 * k + 2] = bflo(n0[k].y) + bflo(n1[k].y); g2.v[4 * k + 3] = bfhi(n0[k].y) + bfhi(n1[k].y); }
        if (m + mstep < (bq + 1) * T) RC_LOAD(m + mstep);
        row_ln(x1);
#pragma unroll
        for (int i = 0; i < 16; ++i) x1.v[i] = ALPHA * (x1.v[i] * lg1.v[i] + lb1.v[i]) + (1.0f + gm.v[i]) * g2.v[i];
        row_ln(x1);
#pragma unroll
        for (int i = 0; i < 16; ++i) x1.v[i] = x1.v[i] * lg2.v[i] + lb2.v[i];
        if (l == DEPTH - 1) row_store_f32(x1, A.out + (size_t)m * D, lane_);
        else { row_store_bf16(x1, R2 + (size_t)(2 * m) * D, lane_);
            row_ln(x1);
#pragma unroll
            for (int i = 0; i < 16; ++i) x1.v[i] = x1.v[i] * (1.0f + msc.v[i]) + msh.v[i];
            row_store_bf16(x1, XN + (size_t)m * D, lane_); }
    }
#undef RC_LOAD
}

#ifndef PHMASK
#define PHMASK 0xFFFFFFFFu
#endif
#define IN(k) (lo <= (k) && (k) < hi && ((PHMASK >> (((k) == 0) ? 31 : (((k) - 1) % PH_PER_LAYER))) & 1u))
#define SEAM(k) do { if (IN((k) + 1) && MK_ONE_LAUNCH) xcd_barrier(bar); else __syncthreads(); } while (0)
constexpr int PH_PER_LAYER = 9, N_PHASES = 1 + DEPTH * PH_PER_LAYER;
#ifndef REP_PH
#define REP_PH -1
#endif
#define NREP(k) (((k) == REP_PH) ? 2 : 1)
template <int l> DI void layer_body(Frame& F, const Args& args, const XcdBarrier& bar, const int lo, const int hi) {
    unsigned char* ws = args.ws;

        const int pb = 1 + l * PH_PER_LAYER;
        const bf16* WinT = (const bf16*)(ws + WS_WSMALL + l * WSMALL_LAYER + WOFF_IN);
        const bf16* WoutT = (const bf16*)(ws + WS_WSMALL + l * WSMALL_LAYER + WOFF_OUT);
        const bf16* GluT = (const bf16*)(ws + WS_WSMALL + l * WSMALL_LAYER + WOFF_GLU);
        const float* modl = (const float*)(ws + WS_MOD) + (size_t)l * BATCH * 6 * D;
        if (l == 0 && IN(pb + 0)) { p_wconv(F, args, 0, 4); p_wconv(F, args, 1, 4); p_ln_a0(F, args); SEAM(pb + 0); }
        if (IN(pb + 1)) for (int rep_ = 0; rep_ < NREP(1); ++rep_) {
            pg8::Gemm g{(const bf16*)(ws + WS_XN), WinT, M, PROJW, D}; pg8::StaticOrder S; S.init(M, PROJW, F.G, (int)blockIdx.x);
            EpiInProj E{(bf16*)(ws + WS_PROJ), (const float*)(ws + WS_ROPE), args.pad};
            pg8::gemm_phase<EpiInProj, pg8::StaticOrder, PG8_ALIGN, PG8_SP2>(F.lds + RING_OFF, g, S, E);
            if (F.G == 256 && blockIdx.x >= 128) { __syncthreads(); p_wconv(F, args, l, 1); }
            SEAM(pb + 1); }
        if (IN(pb + 2)) for (int rep_ = 0; rep_ < NREP(2); ++rep_) {
#ifndef REP_SUB
#define REP_SUB -1
#endif
#define SUBREP(k) for (int rs_ = 0; rs_ < ((REP_SUB == (k)) ? 2 : 1); ++rs_)
            SUBREP(0) { mix_gating_mfma(F, args, l); __syncthreads(); }
#if REP_SUB >= 10 && REP_SUB < 20
            mix_gating_mfma(F, args, l, REP_SUB - 10); __syncthreads(); mix_gating_mfma(F, args, l); __syncthreads();
#endif
 SUBREP(1) { mix_ssm_in(F, l); } SUBREP(2) { mix_attn_mfma<0>(F, l); __syncthreads(); } SEAM(pb + 2); }
        if (IN(pb + 3)) for (int rep_ = 0; rep_ < NREP(3); ++rep_) { SUBREP(3) { mix_ssm_out(F, args, l); __syncthreads(); } SUBREP(4) { mix_attn_mfma<1>(F, l); __syncthreads(); } SEAM(pb + 3); }
        if (IN(pb + 4)) for (int rep_ = 0; rep_ < NREP(4); ++rep_) { p_glu(F, args, l); SEAM(pb + 4); }
        if (IN(pb + 5)) for (int rep_ = 0; rep_ < NREP(5); ++rep_) {
            pg8::Gemm g{(const bf16*)(ws + WS_MIXCAT), WoutT, M, D, D}; pg8::StaticOrder S; S.init(M, D, F.G, (int)blockIdx.x);
            if (l == 0) { EpiOut<true> E{(bf16*)(ws + WS_PRE), args.in[I_X], D, modl}; pg8::gemm_phase<EpiOut<true>, pg8::StaticOrder, PG8_ALIGN, PG8_SP2>(F.lds + RING_OFF, g, S, E); }
            else { EpiOut<false> E{(bf16*)(ws + WS_PRE), (const void*)(ws + WS_ROWS2), 2 * D, modl}; pg8::gemm_phase<EpiOut<false>, pg8::StaticOrder, PG8_ALIGN, PG8_SP2>(F.lds + RING_OFF, g, S, E); }
            SEAM(pb + 5); }
        if (IN(pb + 6)) { p_row_b(F, args, l); SUBREP(5) { if (REP_SUB == 5 && rs_ == 0) { __syncthreads(); p_row_b(F, args, l, false); } } SEAM(pb + 6); }
        if (IN(pb + 7)) { moe_tstart(F, l);
            gu32* dcnt = F.ctl + CW_DONE + l * 512;
            if (args.pad != 4)
            { pg8::Gemm g{(const bf16*)(ws + WS_XN), (const bf16*)(ws + WS_WGU), NSLOT_MAX, NEXP * 1024, D};
              MoeOrderK<0> S{(const volatile LAS int*)(F.lds + LDSCTL_OFF), F.G, (int)blockIdx.x, (const int*)(ws + WS_SLOT_A), (const float*)(ws + WS_SLOT_W), dcnt, F.ctl + CW_QUEUE + l * 128, (volatile LAS int*)(F.lds + LDSCTL_OFF + 256)}; EpiG1 E{(bf16*)(ws + WS_HID), args.pad};
              pg8::gemm_phase_g<EpiG1, MoeOrderK<0>, PG8_ALIGN, PG8_SP2, 0>(F.lds + RING_OFF, F.lds + GT_OFF, g, S, E); }
            if (args.pad != 3)
            { pg8::Gemm g{(const bf16*)(ws + WS_HID), (const bf16*)(ws + WS_WD), NSLOT_MAX, NEXP * 1024, DEXP};
              MoeOrderK<1> S{(const volatile LAS int*)(F.lds + LDSCTL_OFF), F.G, (int)blockIdx.x, (const int*)(ws + WS_SLOT_A), (const float*)(ws + WS_SLOT_W), dcnt, F.ctl + CW_QUEUE + l * 128, (volatile LAS int*)(F.lds + LDSCTL_OFF + 256)}; EpiG2 E{(bf16*)(ws + WS_ROWS2), args.pad};
              pg8::gemm_phase_g<EpiG2, MoeOrderK<1>, PG8_ALIGN, PG8_SP2, 0>(F.lds + RING_OFF, F.lds + GT_OFF, g, S, E); }
            SEAM(pb + 7); }
        if (IN(pb + 8)) { p_row_c(F, args, l); if (l == 0) { __syncthreads(); p_wconv(F, args, 1, 3); } SUBREP(6) { if (REP_SUB == 6 && rs_ == 0 && l == DEPTH - 1) { __syncthreads(); p_row_c(F, args, l); } } SEAM(pb + 8); }
    }
__global__ void __launch_bounds__(NTHR, 2) mk_fwd(Args args) {
    extern __shared__ __attribute__((aligned(16))) unsigned char lds[];
    Frame F;
    F.lds = (LAS unsigned char*)lds; F.MISC = (volatile LAS unsigned*)(F.lds + MISC_OFF);
    F.G = gridDim.x; { const int bx = blockIdx.x; F.vcu = (F.G % 8 == 0) ? (bx % 8) * (F.G / 8) + bx / 8 : bx; }
    F.ws = args.ws; F.ctl = (gu32*)(args.ws + WS_CTL);
    for (int u = ftid(); u < (LDS_BYTES - LDSCTL_OFF) / 4; u += NTHR) ((LAS unsigned*)(F.lds + LDSCTL_OFF))[u] = 0u;
    __syncthreads();
    XcdBarrier bar; bar.bar = (unsigned*)(F.ctl + CW_BAR); bar.x = 0; bar.st = nullptr;
    if (MK_ONE_LAUNCH) bar = xcd_barrier_post((unsigned*)(F.ctl + CW_BAR), F.MISC + 8);
    const int lo = args.ph_lo, hi = args.ph_hi;
    unsigned char* ws = args.ws; (void)ws;
    if (IN(0)) { p0_tables(F, args); __syncthreads(); p_wconv(F, args, 0, 0); p_wconv(F, args, 1, 2); SEAM(0); }
    layer_body<0>(F, args, bar, lo, hi);
    layer_body<1>(F, args, bar, lo, hi);
#ifdef EXTRA_BARS
    if (MK_ONE_LAUNCH) for (int xb_ = 0; xb_ < EXTRA_BARS; ++xb_) xcd_barrier(bar);
#endif
#undef IN
#undef SEAM
}

extern "C" void kernel_launch(void* const* d_in, const int* in_sizes, int n_in, void* d_out, int out_size, void* d_ws, size_t ws_size, hipStream_t stream) {
    static int grid = 0;
    if (grid == 0) {
        if (n_in != 30 || in_sizes[0] != M * D || out_size != M * D || ws_size < WS_END) { fprintf(stderr, "kernel_launch: unexpected shapes (n_in %d, in0 %d, out %d, ws %zu, need %zu)\n", n_in, n_in > 0 ? in_sizes[0] : -1, out_size, ws_size, (size_t)WS_END); grid = -1; return; }
        int dev = 0, cus = 0, per_cu = 0;
        if (hipGetDevice(&dev) != hipSuccess || hipDeviceGetAttribute(&cus, hipDeviceAttributeMultiprocessorCount, dev) != hipSuccess) { grid = -1; return; }
        if (hipFuncSetAttribute((const void*)mk_fwd, hipFuncAttributeMaxDynamicSharedMemorySize, LDS_BYTES) != hipSuccess) { fprintf(stderr, "kernel_launch: hipFuncSetAttribute failed\n"); grid = -1; return; }
        if (hipOccupancyMaxActiveBlocksPerMultiprocessor(&per_cu, (const void*)mk_fwd, NTHR, LDS_BYTES) != hipSuccess || per_cu < 1) fprintf(stderr, "kernel_launch: occupancy query says %d\n", per_cu);
        (void)hipGetLastError();
        grid = cus;
    }
    if (grid < 0) return;
    if (hipMemsetAsync((char*)d_ws + WS_CTL, 0, CTL_ZERO_BYTES, stream) != hipSuccess) return;
    Args a{};
    for (int i = 0; i < 30; ++i) a.in[i] = d_in[i];
    a.out = (float*)d_out; a.ws = (unsigned char*)d_ws;
#if MK_ONE_LAUNCH
    a.ph_lo = 0; a.ph_hi = N_PHASES; a.li = 0;
    hipLaunchKernelGGL(mk_fwd, dim3(grid), dim3(NTHR), LDS_BYTES, stream, a);
#else
#ifndef REP_GLOBAL
#define REP_GLOBAL -1
#endif
#ifndef PROBE_SKIP
#define PROBE_SKIP 1
#endif
#ifndef REP_COUNT
#define REP_COUNT 2
#endif
    for (int p = 0; p < N_PHASES; ++p) { a.ph_lo = p; a.ph_hi = p + 1; a.li = p;
        const int nrep = ((p == 0 ? 100 : (p - 1) % PH_PER_LAYER) == REP_GLOBAL) ? REP_COUNT : 1;
        for (int r = 0; r < nrep; ++r) { a.pad = r ? PROBE_SKIP : 0; hipLaunchKernelGGL(mk_fwd, dim3(grid), dim3(NTHR), LDS_BYTES, stream, a); } a.pad = 0; }
#endif
}
```

```cpp
#include <hip/hip_runtime.h>
#include <cstdio>
#include <cstdint>
namespace pg8 {
#define PG8_LAS __attribute__((address_space(3)))
typedef unsigned short bf16_t;
typedef short bf16x8 __attribute__((ext_vector_type(8)));
typedef float f32x4 __attribute__((ext_vector_type(4)));
typedef unsigned u32x4 __attribute__((ext_vector_type(4)));
constexpr int BM = 256, BK = 64, HALF = 128, HTB = HALF * BK * 2  , STAGE_BYTES = 8 * HTB, NXCD = 8, WGM = 8;

__host__ __device__ __forceinline__ int lds_byte(int r, int c) { const int st = (r >> 4) * 2 + (c >> 5), rr = r & 15, cc = c & 31, ob = rr * 64 + cc * 2; return st * 1024 + (ob ^ (((ob >> 9) & 1) << 5)); }
__host__ __device__ __forceinline__ void stage_rc(int b, int& R, int& C) { const int st = b / 1024, sb = b % 1024, swz = sb ^ (((sb >> 9) & 1) << 5); R = (st >> 1) * 16 + swz / 64; C = (st & 1) * 32 + (swz % 64) / 2; }
__host__ __device__ __forceinline__ int perm32(int rho) { const int n = rho >> 4, i = rho & 15; return 8 * (i >> 2) + 4 * n + (i & 3); }

struct Unit { int pm, pn; };
struct Gemm { const bf16_t* A; const bf16_t* Bt; int M, N, K; };

struct StaticOrder {
    int nM, nN, nwg, G, c;
    __host__ __device__ void init(int M, int N, int G_, int c_) { nM = M / BM; nN = N / BM; nwg = nM * nN; G = G_; c = c_; }
    __host__ __device__ bool next(int i, Unit& u) const {
        const long L = (long)i * G + c; if (L >= nwg) return false;
        int wgid = (int)L; { const int q = nwg / NXCD, r = nwg % NXCD, xcd = wgid % NXCD, off = wgid / NXCD; wgid = (xcd < r ? xcd * (q + 1) : r * (q + 1) + (xcd - r) * q) + off; }
        const int nig = WGM * nN, gid = wgid / nig, fm = gid * WGM, gsz = (nM - fm) < WGM ? (nM - fm) : WGM;
        u.pm = fm + ((wgid % nig) % gsz); u.pn = (wgid % nig) / gsz; return true;
    }
    __device__ __forceinline__ void a_ready(const Unit&) const {}
    __device__ __forceinline__ void done(const Unit&) const {}
};

__device__ __forceinline__ unsigned cvt_pk_bf16(float lo, float hi) { unsigned r; asm volatile("v_cvt_pk_bf16_f32 %0, %1, %2" : "=v"(r) : "v"(lo), "v"(hi)); return r; }
template <class Epi, class Sched, bool ALIGN_EPI = false, bool SP2 = false>
__device__ __forceinline__ void gemm_phase(PG8_LAS unsigned char* lds, const Gemm g, const Sched& S, const Epi& E) {
    const int tid = threadIdx.x, wid = __builtin_amdgcn_readfirstlane(tid >> 6), lane = tid & 63, wr = wid >> 2, wc = wid & 3, fr = lane & 15, fq = lane >> 4;
    const int K = g.K, nt = K / BK;
    unsigned voffA[2], voffB[2];
#pragma unroll
    for (int i = 0; i < 2; ++i) { int R, C; stage_rc(tid * 16 + i * 8192, R, C); const int Rb = Epi::PERM ? ((R & ~31) + perm32(R & 31)) : R;
        voffA[i] = (unsigned)(R * K + C) * 2u; voffB[i] = (unsigned)(Rb * K + C) * 2u; }
    const size_t kstep = (size_t)(BK * 2);
    const size_t hstep = (size_t)HALF * K * 2;
    const size_t tstep = 2 * hstep;
    const unsigned ldsw = (unsigned)wid * 1024u;
    const int aoff = lds_byte(wr * 64 + fr, fq * 8), boff = lds_byte(wc * 32 + fr, fq * 8);
#define PG8_SA(b, h) (((b) * 2 + (h)) * HTB)
#define PG8_SB(b, h) ((4 + (b) * 2 + (h)) * HTB)
#define PG8_STAGE(bufoff, gbase, voff) do { _Pragma("unroll") for (int _i = 0; _i < 2; ++_i) \
        __builtin_amdgcn_global_load_lds((const unsigned*)((const char*)(gbase) + (voff)[_i]), (PG8_LAS unsigned*)(lds + (bufoff) + ldsw + _i * 8192), 16, 0, 0); } while (0)
#define PG8_LDA(dst, b, h) do { _Pragma("unroll") for (int m = 0; m < 4; ++m) _Pragma("unroll") for (int k = 0; k < 2; ++k) dst[m][k] = *(const PG8_LAS bf16x8*)(lds + PG8_SA(b, h) + aoff + m * 2048 + k * 1024); } while (0)
#define PG8_LDB(dst, b, h) do { _Pragma("unroll") for (int n = 0; n < 2; ++n) _Pragma("unroll") for (int k = 0; k < 2; ++k) dst[n][k] = *(const PG8_LAS bf16x8*)(lds + PG8_SB(b, h) + boff + n * 2048 + k * 1024); } while (0)
#define PG8_MMA(ai, bj, At, Bt) do { __builtin_amdgcn_s_setprio(1); _Pragma("unroll") for (int m = 0; m < 4; ++m) _Pragma("unroll") for (int n = 0; n < 2; ++n) _Pragma("unroll") for (int k = 0; k < 2; ++k) \
        acc[ai][bj][m][n] = __builtin_amdgcn_mfma_f32_16x16x32_bf16(Bt[n][k], At[m][k], acc[ai][bj][m][n], 0, 0, 0); __builtin_amdgcn_s_setprio(0); } while (0)
#define PG8_WAIT_V(n) asm volatile("s_waitcnt vmcnt(" #n ")" ::: "memory")
#define PG8_WAIT_L(n) asm volatile("s_waitcnt lgkmcnt(" #n ")" ::: "memory")
#define PG8_BAR __builtin_amdgcn_s_barrier()
#define PG8_SCHED __builtin_amdgcn_sched_barrier(0)
    Unit cur, nxt; int ui = 0;
    if (!S.next(0, cur)) return;
    f32x4 acc[2][2][4][2];
#pragma unroll
    for (int a = 0; a < 2; ++a)
#pragma unroll
        for (int b = 0; b < 2; ++b)
#pragma unroll
            for (int m = 0; m < 4; ++m)
#pragma unroll
                for (int n = 0; n < 2; ++n) acc[a][b][m][n] = (f32x4){0.f, 0.f, 0.f, 0.f};
    bf16x8 At[4][2], B0[2][2], B1[2][2];
    const char* cA = (const char*)g.A + (size_t)cur.pm * tstep; const char* cB = (const char*)g.Bt + (size_t)cur.pn * tstep;
    S.a_ready(cur);
    if constexpr (SP2) {
        PG8_STAGE(PG8_SB(0, 0), cB, voffB); PG8_STAGE(PG8_SB(0, 1), cB + hstep, voffB); PG8_STAGE(PG8_SA(0, 0), cA, voffA); PG8_STAGE(PG8_SA(0, 1), cA + hstep, voffA);
        if (wr == 1) PG8_BAR;
        PG8_WAIT_V(2); PG8_BAR;
        PG8_STAGE(PG8_SB(1, 0), cB + kstep, voffB); PG8_STAGE(PG8_SA(1, 0), cA + kstep, voffA); PG8_STAGE(PG8_SB(1, 1), cB + hstep + kstep, voffB);
        PG8_WAIT_V(6); PG8_BAR;
    } else {
        PG8_STAGE(PG8_SB(0, 0), cB, voffB); PG8_STAGE(PG8_SA(0, 0), cA, voffA); PG8_STAGE(PG8_SB(0, 1), cB + hstep, voffB); PG8_STAGE(PG8_SA(0, 1), cA + hstep, voffA);
        if (wr == 1) PG8_BAR;
        PG8_WAIT_V(4); PG8_BAR;
        PG8_STAGE(PG8_SB(1, 0), cB + kstep, voffB); PG8_STAGE(PG8_SA(1, 0), cA + kstep, voffA); PG8_STAGE(PG8_SB(1, 1), cB + hstep + kstep, voffB);
        PG8_WAIT_V(6); PG8_BAR;
    }
    for (;;) {
        const bool has_next = S.next(ui + 1, nxt);
        const char* nA = has_next ? (const char*)g.A + (size_t)nxt.pm * tstep : cA; const char* nB = has_next ? (const char*)g.Bt + (size_t)nxt.pn * tstep : cB;
        for (int t = 0; t < nt; t += 2) {
            const bool last = (t == nt - 2);
            const char* a1 = cA + (size_t)(t + 1) * kstep;
            const char* a2 = last ? nA : cA + (size_t)(t + 2) * kstep; const char* b2 = last ? nB : cB + (size_t)(t + 2) * kstep;
            const char* a3 = a2 + kstep; const char* b3 = b2 + kstep;
            if (last && has_next) S.a_ready(nxt);
            if constexpr (SP2) {
            PG8_LDB(B0, 0, 0); PG8_LDB(B1, 0, 1); PG8_SCHED; PG8_LDA(At, 0, 0); PG8_STAGE(PG8_SA(1, 1), a1 + hstep, voffA);
            PG8_WAIT_V(8); PG8_WAIT_L(0); PG8_BAR; PG8_MMA(0, 0, At, B0); PG8_MMA(0, 1, At, B1); PG8_BAR; PG8_SCHED;
            PG8_LDA(At, 0, 1); PG8_STAGE(PG8_SB(0, 0), b2, voffB); PG8_STAGE(PG8_SB(0, 1), b2 + hstep, voffB); PG8_STAGE(PG8_SA(0, 0), a2, voffA);
            PG8_WAIT_V(8); PG8_WAIT_L(0); PG8_BAR; PG8_MMA(1, 0, At, B0); PG8_MMA(1, 1, At, B1); PG8_BAR; PG8_SCHED;
            PG8_LDB(B0, 1, 0); PG8_LDB(B1, 1, 1); PG8_SCHED; PG8_LDA(At, 1, 0); PG8_STAGE(PG8_SA(0, 1), a2 + hstep, voffA);
            PG8_WAIT_V(8); PG8_WAIT_L(0); PG8_BAR; PG8_MMA(0, 0, At, B0); PG8_MMA(0, 1, At, B1); PG8_BAR; PG8_SCHED;
            PG8_LDA(At, 1, 1); PG8_STAGE(PG8_SB(1, 0), b3, voffB); PG8_STAGE(PG8_SB(1, 1), b3 + hstep, voffB); PG8_STAGE(PG8_SA(1, 0), a3, voffA);
            PG8_WAIT_V(8); PG8_WAIT_L(0); PG8_BAR; PG8_MMA(1, 0, At, B0); PG8_MMA(1, 1, At, B1); PG8_BAR; PG8_SCHED;
            } else {
            PG8_LDB(B0, 0, 0); PG8_SCHED; PG8_LDA(At, 0, 0); PG8_STAGE(PG8_SA(1, 1), a1 + hstep, voffA);
            PG8_WAIT_L(8); PG8_BAR; PG8_WAIT_L(0); PG8_MMA(0, 0, At, B0); PG8_BAR; PG8_SCHED;
            PG8_LDB(B1, 0, 1); PG8_STAGE(PG8_SB(0, 0), b2, voffB);
            PG8_BAR; PG8_WAIT_L(0); PG8_MMA(0, 1, At, B1); PG8_BAR;
            PG8_LDA(At, 0, 1); PG8_STAGE(PG8_SA(0, 0), a2, voffA);
            PG8_BAR; PG8_WAIT_L(0); PG8_MMA(1, 0, At, B0); PG8_BAR; PG8_SCHED;
            PG8_STAGE(PG8_SB(0, 1), b2 + hstep, voffB);
            PG8_WAIT_V(6); PG8_BAR; PG8_MMA(1, 1, At, B1); PG8_BAR;
            PG8_LDB(B0, 1, 0); PG8_SCHED; PG8_LDA(At, 1, 0); PG8_STAGE(PG8_SA(0, 1), a2 + hstep, voffA);
            PG8_WAIT_L(8); PG8_BAR; PG8_WAIT_L(0); PG8_MMA(0, 0, At, B0); PG8_BAR; PG8_SCHED;
            PG8_LDB(B1, 1, 1); PG8_STAGE(PG8_SB(1, 0), b3, voffB);
            PG8_BAR; PG8_WAIT_L(0); PG8_MMA(0, 1, At, B1); PG8_BAR;
            PG8_LDA(At, 1, 1); PG8_STAGE(PG8_SA(1, 0), a3, voffA);
            PG8_BAR; PG8_WAIT_L(0); PG8_MMA(1, 0, At, B0); PG8_BAR; PG8_SCHED;
            PG8_STAGE(PG8_SB(1, 1), b3 + hstep, voffB);
            PG8_WAIT_V(6); PG8_BAR; PG8_MMA(1, 1, At, B1); PG8_BAR;
            }
        }
        if constexpr (ALIGN_EPI) { if (wr == 0) PG8_BAR; }
        if constexpr (!Epi::AFTER_DRAIN) { E(acc, cur, wr, wc, fr, fq); S.done(cur); }
        if (!has_next) break;
#pragma unroll
        for (int a = 0; a < 2; ++a)
#pragma unroll
            for (int b = 0; b < 2; ++b)
#pragma unroll
                for (int m = 0; m < 4; ++m)
#pragma unroll
                    for (int n = 0; n < 2; ++n) acc[a][b][m][n] = (f32x4){0.f, 0.f, 0.f, 0.f};
        cur = nxt; cA = nA; cB = nB; ++ui;
        if constexpr (ALIGN_EPI) { if (wr == 1) PG8_BAR; }
    }
    PG8_WAIT_V(0);
    if constexpr (!ALIGN_EPI) { if (wr == 0) PG8_BAR; }
    PG8_BAR;
    if constexpr (Epi::AFTER_DRAIN) { E.fused(acc, cur, wr, wc, fr, fq, lds, wid, lane); S.done(cur); }
#undef PG8_SA
#undef PG8_SB
#undef PG8_STAGE
#undef PG8_LDA
#undef PG8_LDB
#undef PG8_MMA
#undef PG8_WAIT_V
#undef PG8_WAIT_L
#undef PG8_BAR
#undef PG8_SCHED
}
template <class Epi, class Sched, bool ALIGN_EPI = false, bool SP2 = false, int AUXA = 0>
__device__ __forceinline__ void gemm_phase_g(PG8_LAS unsigned char* lds, PG8_LAS unsigned char* gt, const Gemm g, const Sched& S, const Epi& E) {
    const int tid = threadIdx.x, wid = __builtin_amdgcn_readfirstlane(tid >> 6), lane = tid & 63, wr = wid >> 2, wc = wid & 3, fr = lane & 15, fq = lane >> 4;
    const int K = g.K, nt = K / BK;
    unsigned gpk[2], voffB[2];
#pragma unroll
    for (int i = 0; i < 2; ++i) { int R, C; stage_rc(tid * 16 + i * 8192, R, C); const int Rb = Epi::PERM ? ((R & ~31) + perm32(R & 31)) : R;
        gpk[i] = (unsigned)(R * 4) | ((unsigned)(C * 2) << 16); voffB[i] = (unsigned)(Rb * K + C) * 2u; }
    int par = 0;
    const size_t kstep = (size_t)(BK * 2);
    const size_t hstep = (size_t)HALF * K * 2;
    const size_t tstep = 2 * hstep;
    const unsigned ldsw = (unsigned)wid * 1024u;
    const int aoff = lds_byte(wr * 64 + fr, fq * 8), boff = lds_byte(wc * 32 + fr, fq * 8);
#define PG8_SA(b, h) (((b) * 2 + (h)) * HTB)
#define PG8_SB(b, h) ((4 + (b) * 2 + (h)) * HTB)
#define PG8_STAGE(bufoff, gbase, voff) do { _Pragma("unroll") for (int _i = 0; _i < 2; ++_i) \
        __builtin_amdgcn_global_load_lds((const unsigned*)((const char*)(gbase) + (voff)[_i]), (PG8_LAS unsigned*)(lds + (bufoff) + ldsw + _i * 8192), 16, 0, 0); } while (0)
#define PG8_STAGE_A(bufoff, h, kbyte, PAR) do { _Pragma("unroll") for (int _i = 0; _i < 2; ++_i) { \
        const unsigned _ro = *(const PG8_LAS unsigned*)(gt + ((PAR) * 768 + (h) * 128) * 4 + (gpk[_i] & 0xffffu)); \
        __builtin_amdgcn_global_load_lds((const unsigned*)((const char*)g.A + (size_t)(kbyte) + _ro + (gpk[_i] >> 16)), (PG8_LAS unsigned*)(lds + (bufoff) + ldsw + _i * 8192), 16, 0, AUXA); } } while (0)
#define PG8_FILL(u, PAR, PF, UI) do { S.wait_ready(u, tid, PF); if (tid < 256) { unsigned o_, a0_, a1_; S.finish_meta(u, tid, PF, o_, a0_, a1_); PG8_LAS unsigned* t_ = (PG8_LAS unsigned*)(gt + ((PAR) * 768 + tid) * 4); t_[0] = o_; t_[256] = a0_; t_[512] = a1_; } S.pull_publish(tid, PF, UI); asm volatile("s_waitcnt lgkmcnt(0)" ::: "memory"); __builtin_amdgcn_s_barrier(); asm volatile("" ::: "memory"); } while (0)
#define PG8_LDA(dst, b, h) do { _Pragma("unroll") for (int m = 0; m < 4; ++m) _Pragma("unroll") for (int k = 0; k < 2; ++k) dst[m][k] = *(const PG8_LAS bf16x8*)(lds + PG8_SA(b, h) + aoff + m * 2048 + k * 1024); } while (0)
#define PG8_LDB(dst, b, h) do { _Pragma("unroll") for (int n = 0; n < 2; ++n) _Pragma("unroll") for (int k = 0; k < 2; ++k) dst[n][k] = *(const PG8_LAS bf16x8*)(lds + PG8_SB(b, h) + boff + n * 2048 + k * 1024); } while (0)
#define PG8_MMA(ai, bj, At, Bt) do { __builtin_amdgcn_s_setprio(1); _Pragma("unroll") for (int m = 0; m < 4; ++m) _Pragma("unroll") for (int n = 0; n < 2; ++n) _Pragma("unroll") for (int k = 0; k < 2; ++k) \
        acc[ai][bj][m][n] = __builtin_amdgcn_mfma_f32_16x16x32_bf16(Bt[n][k], At[m][k], acc[ai][bj][m][n], 0, 0, 0); __builtin_amdgcn_s_setprio(0); } while (0)
#define PG8_WAIT_V(n) asm volatile("s_waitcnt vmcnt(" #n ")" ::: "memory")
#define PG8_WAIT_L(n) asm volatile("s_waitcnt lgkmcnt(" #n ")" ::: "memory")
#define PG8_BAR __builtin_amdgcn_s_barrier()
#define PG8_SCHED __builtin_amdgcn_sched_barrier(0)
    Unit cur, nxt; int ui = 0;
    if (!S.first(cur)) return;
    f32x4 acc[2][2][4][2];
#pragma unroll
    for (int a = 0; a < 2; ++a)
#pragma unroll
        for (int b = 0; b < 2; ++b)
#pragma unroll
            for (int m = 0; m < 4; ++m)
#pragma unroll
                for (int n = 0; n < 2; ++n) acc[a][b][m][n] = (f32x4){0.f, 0.f, 0.f, 0.f};
    bf16x8 At[4][2], B0[2][2], B1[2][2];
    const char* cB = (const char*)g.Bt + (size_t)cur.pn * tstep;
    typename Sched::Pf pf; S.prefetch(cur, tid, pf); PG8_FILL(cur, 0, pf, -1);
    Unit pend; bool has_pend = false;
    if constexpr (SP2) {
        PG8_STAGE(PG8_SB(0, 0), cB, voffB); PG8_STAGE(PG8_SB(0, 1), cB + hstep, voffB); PG8_STAGE_A(PG8_SA(0, 0), 0, 0, par); PG8_STAGE_A(PG8_SA(0, 1), 1, 0, par);
        if (wr == 1) PG8_BAR;
        PG8_WAIT_V(2); PG8_BAR;
        PG8_STAGE(PG8_SB(1, 0), cB + kstep, voffB); PG8_STAGE_A(PG8_SA(1, 0), 0, kstep, par); PG8_STAGE(PG8_SB(1, 1), cB + hstep + kstep, voffB);
        PG8_WAIT_V(6); PG8_BAR;
    } else {
        PG8_STAGE(PG8_SB(0, 0), cB, voffB); PG8_STAGE_A(PG8_SA(0, 0), 0, 0, par); PG8_STAGE(PG8_SB(0, 1), cB + hstep, voffB); PG8_STAGE_A(PG8_SA(0, 1), 1, 0, par);
        if (wr == 1) PG8_BAR;
        PG8_WAIT_V(4); PG8_BAR;
        PG8_STAGE(PG8_SB(1, 0), cB + kstep, voffB); PG8_STAGE_A(PG8_SA(1, 0), 0, kstep, par); PG8_STAGE(PG8_SB(1, 1), cB + hstep + kstep, voffB);
        PG8_WAIT_V(6); PG8_BAR;
    }
    for (;;) {
        const bool has_next = S.more(ui + 1, nxt);
        if (has_next) { S.prefetch(nxt, tid, pf); S.pull_issue(tid, pf); }
        const char* nB = has_next ? (const char*)g.Bt + (size_t)nxt.pn * tstep : cB;
        for (int t = 0; t < nt; t += 2) {
            const bool last = (t == nt - 2);
            const char* b2 = last ? nB : cB + (size_t)(t + 2) * kstep;
            const char* b3 = b2 + kstep;
            if (last && has_next) PG8_FILL(nxt, par ^ 1, pf, ui);
            const size_t kA2 = last ? (size_t)0 : (size_t)(t + 2) * kstep; const int pA2 = (last && has_next) ? (par ^ 1) : par;
            if constexpr (SP2) {
            PG8_LDB(B0, 0, 0); PG8_LDB(B1, 0, 1); PG8_SCHED; PG8_LDA(At, 0, 0); PG8_STAGE_A(PG8_SA(1, 1), 1, (size_t)(t + 1) * kstep, par);
            PG8_WAIT_V(8); PG8_WAIT_L(0); PG8_BAR; PG8_MMA(0, 0, At, B0); PG8_MMA(0, 1, At, B1); PG8_BAR; PG8_SCHED;
            PG8_LDA(At, 0, 1); PG8_STAGE(PG8_SB(0, 0), b2, voffB); PG8_STAGE(PG8_SB(0, 1), b2 + hstep, voffB); PG8_STAGE_A(PG8_SA(0, 0), 0, kA2, pA2);
            PG8_WAIT_V(8); PG8_WAIT_L(0); PG8_BAR; PG8_MMA(1, 0, At, B0); PG8_MMA(1, 1, At, B1); PG8_BAR; PG8_SCHED;
            PG8_LDB(B0, 1, 0); PG8_LDB(B1, 1, 1); PG8_SCHED; PG8_LDA(At, 1, 0); PG8_STAGE_A(PG8_SA(0, 1), 1, kA2, pA2);
            PG8_WAIT_V(8); PG8_WAIT_L(0); PG8_BAR; PG8_MMA(0, 0, At, B0); PG8_MMA(0, 1, At, B1); PG8_BAR; PG8_SCHED;
            PG8_LDA(At, 1, 1); PG8_STAGE(PG8_SB(1, 0), b3, voffB); PG8_STAGE(PG8_SB(1, 1), b3 + hstep, voffB); PG8_STAGE_A(PG8_SA(1, 0), 0, kA2 + kstep, pA2);
            PG8_WAIT_V(8); PG8_WAIT_L(0); PG8_BAR; PG8_MMA(1, 0, At, B0); PG8_MMA(1, 1, At, B1); PG8_BAR; PG8_SCHED;
            } else {
            PG8_LDB(B0, 0, 0); PG8_SCHED; PG8_LDA(At, 0, 0); PG8_STAGE_A(PG8_SA(1, 1), 1, (size_t)(t + 1) * kstep, par);
            PG8_WAIT_L(8); PG8_BAR; PG8_WAIT_L(0); PG8_MMA(0, 0, At, B0); PG8_BAR; PG8_SCHED;
            PG8_LDB(B1, 0, 1); PG8_STAGE(PG8_SB(0, 0), b2, voffB);
            PG8_BAR; PG8_WAIT_L(0); PG8_MMA(0, 1, At, B1); PG8_BAR;
            PG8_LDA(At, 0, 1); PG8_STAGE_A(PG8_SA(0, 0), 0, kA2, pA2);
            PG8_BAR; PG8_WAIT_L(0); PG8_MMA(1, 0, At, B0); PG8_BAR; PG8_SCHED;
            PG8_STAGE(PG8_SB(0, 1), b2 + hstep, voffB);
            PG8_WAIT_V(6); PG8_BAR; PG8_MMA(1, 1, At, B1); PG8_BAR;
            PG8_LDB(B0, 1, 0); PG8_SCHED; PG8_LDA(At, 1, 0); PG8_STAGE_A(PG8_SA(0, 1), 1, kA2, pA2);
            PG8_WAIT_L(8); PG8_BAR; PG8_WAIT_L(0); PG8_MMA(0, 0, At, B0); PG8_BAR; PG8_SCHED;
            PG8_LDB(B1, 1, 1); PG8_STAGE(PG8_SB(1, 0), b3, voffB);
            PG8_BAR; PG8_WAIT_L(0); PG8_MMA(0, 1, At, B1); PG8_BAR;
            PG8_LDA(At, 1, 1); PG8_STAGE_A(PG8_SA(1, 0), 0, kA2 + kstep, pA2);
            PG8_BAR; PG8_WAIT_L(0); PG8_MMA(1, 0, At, B0); PG8_BAR; PG8_SCHED;
            PG8_STAGE(PG8_SB(1, 1), b3 + hstep, voffB);
            PG8_WAIT_V(6); PG8_BAR; PG8_MMA(1, 1, At, B1); PG8_BAR;
            }
        }
        if constexpr (ALIGN_EPI) { if (wr == 0) PG8_BAR; }
        if constexpr (!Epi::AFTER_DRAIN) { if (has_pend) S.done_nowait(pend);     E(acc, cur, wr, wc, fr, fq, (const PG8_LAS unsigned*)(gt + par * 3072)); pend = cur; has_pend = true; }
        if (!has_next) break;
#pragma unroll
        for (int a = 0; a < 2; ++a)
#pragma unroll
            for (int b = 0; b < 2; ++b)
#pragma unroll
                for (int m = 0; m < 4; ++m)
#pragma unroll
                    for (int n = 0; n < 2; ++n) acc[a][b][m][n] = (f32x4){0.f, 0.f, 0.f, 0.f};
        cur = nxt; cB = nB; ++ui; par ^= 1;
        if constexpr (ALIGN_EPI) { if (wr == 1) PG8_BAR; }
    }
    PG8_WAIT_V(0);
    if constexpr (!ALIGN_EPI) { if (wr == 0) PG8_BAR; }
    PG8_BAR;
    if (has_pend) S.done_nowait(pend);
#undef PG8_SA
#undef PG8_SB
#undef PG8_STAGE
#undef PG8_STAGE_A
#undef PG8_FILL
#undef PG8_LDA
#undef PG8_LDB
#undef PG8_MMA
#undef PG8_WAIT_V
#undef PG8_WAIT_L
#undef PG8_BAR
#undef PG8_SCHED
}
}

#ifndef PG8_SP2
#define PG8_SP2 true
#endif
#ifndef PG8_ALIGN
#define PG8_ALIGN true
#endif
#ifndef MK_ONE_LAUNCH
#define MK_ONE_LAUNCH 1
#endif

constexpr int NWAVES = 8, NTHR = 512;
constexpr int BATCH = 8, T = 4096, D = 1024, M = BATCH * T, DEPTH = 2;
constexpr int PROJW = 2304, AW = 256, BW = 512, CW = 256, NH = 8, HD = 64;
constexpr int COL_U = 0, COL_V = 256, COL_Q = 512, COL_K = 1024, COL_VA = 1536, COL_S = 2048;
constexpr int NEXP = 16, DEXP = 512, NGRP = 4;
constexpr int SSM_G = 16, SSM_N = 64, SSM_C = 16;
constexpr float LN_EPS = 1e-5f;
constexpr float ALPHA = 1.41421356237309515f;
constexpr float QSCALE = 0.125f * 1.4426950408889634f;
constexpr int NSLOT_MAX = 2 * M + NEXP * 256;

constexpr size_t MiB = 1u << 20;
constexpr size_t WS_CTL = 0, CTL_ZERO_BYTES = 1 * MiB;
constexpr size_t WS_MOD = 1 * MiB;
constexpr size_t WS_ROPE = WS_MOD + 512 * 1024;
constexpr size_t WS_SSM = WS_ROPE + 2 * MiB;
constexpr int SSM_TAB = 2 * 1024 + 2 * 16384;
constexpr int SLOT_CAP = 32768;
constexpr size_t WS_SLOT_A = 4 * MiB;
constexpr size_t WS_WSMALL = 6 * MiB;
constexpr size_t WSMALL_LAYER = 7 * MiB, WOFF_IN = 0, WOFF_OUT = (size_t)PROJW * D * 2, WOFF_GLU = WOFF_OUT + (size_t)D * D * 2;
constexpr size_t WS_WGU = 20 * MiB;
constexpr size_t WS_WD = 52 * MiB;
constexpr size_t WS_XN = 68 * MiB;
constexpr size_t WS_YG = 132 * MiB;
constexpr size_t WS_R = 148 * MiB;
constexpr size_t WS_PROJ = WS_R, WS_MIXCAT = WS_R + 144 * MiB, WS_PRE = WS_R, WS_HID = WS_R + 64 * MiB, WS_X1 = WS_R + 132 * MiB;
constexpr size_t WS_ROWS2 = 356 * MiB;
constexpr size_t WS_STAT = 356 * MiB + (size_t)2 * M * D * 2;
constexpr size_t WS_SSM2 = WS_STAT + 4 * MiB;
constexpr size_t SSM2_LAYER = 3 * MiB, S2_APW = 0, S2_KT = 288 * 1024, S2_CT = S2_KT + 256 * 1024, S2_WIN = S2_CT + 64 * 1024, S2_GW = S2_WIN + 2 * MiB;
static_assert(S2_GW + 4 * 128 * 128 * 2 <= SSM2_LAYER, "ssm2 tables");
constexpr size_t WS_XLOC = WS_SSM2 + 2 * SSM2_LAYER;
constexpr size_t WS_XSUP = WS_XLOC + 8 * MiB;
constexpr size_t WS_SLOT_W = WS_XSUP + 512 * 1024;
constexpr size_t WS_END = WS_SLOT_W + 2 * MiB;
static_assert(WOFF_GLU + 256 * 256 * 2 <= WSMALL_LAYER && WS_WSMALL + 2 * WSMALL_LAYER <= WS_WGU, "ws map");
static_assert(WS_SSM + 2 * SSM_TAB * 4 <= WS_SLOT_A && WS_HID + (size_t)NSLOT_MAX * DEXP * 2 <= WS_X1 && WS_X1 + (size_t)M * D * 2 <= WS_ROWS2, "ws map 2");
constexpr int CW_TMO = 0;
constexpr int CW_BAR = 4096;
constexpr int CW_CNT = 8192;
constexpr int CW_QUEUE = 11264;
constexpr int CW_DONE = 12288;

constexpr int RING_OFF = 0, RING_BYTES = 131072;
constexpr int ATT_STAGE_OFF = 98304;
constexpr int LDSCTL_OFF = 135168, MISC_OFF = LDSCTL_OFF + 320;
constexpr int GT_OFF = LDSCTL_OFF + 1024;
constexpr int LDS_BYTES = 147456;

#define GAS __attribute__((address_space(1)))
#define LAS __attribute__((address_space(3)))
#define DI __device__ __forceinline__
typedef unsigned short bf16;
typedef unsigned v4u __attribute__((ext_vector_type(4)));
typedef unsigned v2u __attribute__((ext_vector_type(2)));
typedef float f32x4 __attribute__((ext_vector_type(4)));
typedef short bf16x8 __attribute__((ext_vector_type(8)));
typedef GAS unsigned gu32;
#define RLX_AGENT __ATOMIC_RELAXED, __HIP_MEMORY_SCOPE_AGENT
#define LDS_WAIT() asm volatile("s_waitcnt lgkmcnt(0)" ::: "memory")
#define VM_WAIT() asm volatile("s_waitcnt vmcnt(0)" ::: "memory")
DI unsigned f2bf(float f) { unsigned u = __builtin_bit_cast(unsigned, f); return (u + 0x7fffu + ((u >> 16) & 1u)) >> 16; }
DI unsigned pk2(float lo, float hi) { return f2bf(lo) | (f2bf(hi) << 16); }
DI float bflo(unsigned w) { return __uint_as_float(w << 16); }
DI float bfhi(unsigned w) { return __uint_as_float(w & 0xffff0000u); }
DI float bf2f(bf16 h) { return __uint_as_float((unsigned)h << 16); }
template <int CTRL> DI float dpp_mov(float v) { return __builtin_bit_cast(float, __builtin_amdgcn_update_dpp(0, __builtin_bit_cast(int, v), CTRL, 0xf, 0xf, true)); }
DI float rdlane(float v, int l) { return __builtin_bit_cast(float, __builtin_amdgcn_readlane(__builtin_bit_cast(int, v), l)); }
DI float wave_sum(float v) {
    v += dpp_mov<0xB1>(v); v += dpp_mov<0x4E>(v); v += dpp_mov<0x141>(v); v += dpp_mov<0x140>(v);
    return (rdlane(v, 0) + rdlane(v, 16)) + (rdlane(v, 32) + rdlane(v, 48));
}
DI void st16_wt(void* p, v4u v) { asm volatile("global_store_dwordx4 %0, %1, off sc1\n\ts_nop 1" :: "v"(p), "v"(v) : "memory"); }
DI float fast_rcp(float x) { return __builtin_amdgcn_rcpf(x); }
DI float sigmoid_f(float x) { return fast_rcp(1.0f + __builtin_amdgcn_exp2f(-1.4426950408889634f * x)); }
DI float silu_f(float x) { return x * sigmoid_f(x); }
DI float gelu_tanh_f(float x) { const float z2 = 1.5957691216057308f * (x + 0.044715f * x * x * x); return x * sigmoid_f(z2); }

#define XB_TMO      128
#define XB_XCNT(j)  (256  + 64 * (j))
#define XB_XSUB(j)  (1280 + 64 * (j))
#define XB_XGEN(j)  (2304 + 64 * (j))
#define XB_TOP      3328
#define XB_TOPGEN   3392
#define XCD_BAR_WORDS 3456
#define XB_SPIN_CAP (1u << 22)
DI unsigned xb_ld(unsigned* p)              { return __hip_atomic_load(p, __ATOMIC_RELAXED, __HIP_MEMORY_SCOPE_AGENT); }
DI unsigned xb_add(unsigned* p, unsigned v) { return __hip_atomic_fetch_add(p, v, __ATOMIC_RELAXED, __HIP_MEMORY_SCOPE_AGENT); }
DI unsigned xb_xcc_id() { return (unsigned)__builtin_amdgcn_s_getreg((3 << 11) | 20) & 0xFu; }
#define XB_SPIN(cond, bar) do { unsigned _sp = 0; while (cond) { __builtin_amdgcn_s_sleep(1); \
    if ((++_sp & 255u) == 0u) { if (xb_ld(&(bar)[XB_TMO])) break; if (_sp > XB_SPIN_CAP) { atomicAdd(&(bar)[XB_TMO], 1u); break; } } } } while (0)
struct XcdBarrier { unsigned* bar; unsigned x; volatile LAS unsigned* st; };
DI XcdBarrier xcd_barrier_post(unsigned* bar, volatile LAS unsigned* st) {
    XcdBarrier b; b.bar = bar; b.x = xb_xcc_id(); b.st = st;
    if (threadIdx.x == 0) (void)xb_add(&bar[XB_XCNT(b.x)], 1u);
    return b;
}
DI void xcd_barrier_complete(unsigned* bar, unsigned x, unsigned& nloc, unsigned& nx) {
    const unsigned G = gridDim.x * gridDim.y * gridDim.z;
    unsigned sum, cnt, mine, sp = 0u;
    for (;;) {
        sum = 0u; cnt = 0u; mine = 0u;
#pragma unroll
        for (unsigned j = 0; j < 16; ++j) { const unsigned c = xb_ld(&bar[XB_XCNT(j)]); sum += c; cnt += (c > 0u) ? 1u : 0u; mine = (j == x) ? c : mine; }
        if (sum == G) break;
        __builtin_amdgcn_s_sleep(1);
        if ((++sp & 255u) == 0u) { if (xb_ld(&bar[XB_TMO])) break; if (sp > XB_SPIN_CAP) { atomicAdd(&bar[XB_TMO], 1u); break; } }
    }
    nloc = mine > 0u ? mine : 1u; nx = cnt > 0u ? cnt : 1u;
}
DI void xcd_barrier(const XcdBarrier& b) {
    asm volatile("s_waitcnt vmcnt(0)" ::: "memory");
    __syncthreads();
    if (threadIdx.x == 0) {
        unsigned* bar = b.bar;
        __builtin_amdgcn_s_waitcnt(0);
        unsigned nloc = b.st[0], nx = b.st[1];
        if (nloc == 0u) { xcd_barrier_complete(bar, b.x, nloc, nx); b.st[0] = nloc; b.st[1] = nx; }
        const unsigned old = xb_add(&bar[XB_XSUB(b.x)], 1u);
        const unsigned gen = old / nloc;
        if (old + 1u == (gen + 1u) * nloc) {
            __builtin_amdgcn_fence(__ATOMIC_RELEASE, "agent");
            asm volatile("s_waitcnt vmcnt(0)" ::: "memory");
            const unsigned og = xb_add(&bar[XB_TOP], 1u);
            const unsigned tg = og / nx;
            if (og + 1u == (tg + 1u) * nx) xb_add(&bar[XB_TOPGEN], 1u);
            else XB_SPIN(xb_ld(&bar[XB_TOPGEN]) == tg, bar);
            __builtin_amdgcn_fence(__ATOMIC_ACQUIRE, "agent");
            xb_add(&bar[XB_XGEN(b.x)], 1u);
            asm volatile("s_waitcnt vmcnt(0)" ::: "memory");
        } else {
            XB_SPIN(xb_ld(&bar[XB_XGEN(b.x)]) == gen, bar);
            __builtin_amdgcn_fence(__ATOMIC_ACQUIRE, "agent");
            asm volatile("s_waitcnt vmcnt(0)" ::: "memory");
        }
    }
    __syncthreads();
}

struct Args { const void* in[30]; float* out; unsigned char* ws; int ph_lo, ph_hi, li, pad; };
enum { I_X = 0, I_C, I_POS, I_ADAW, I_ADAB, I_WIN, I_GMLNG, I_GMLNB, I_GMWS, I_GMBS, I_LAMRE, I_LAMIM, I_LOGDT, I_BRE, I_BIM, I_CRE, I_CIM, I_SSMD,
       I_GLUW, I_GLUB, I_WOUT, I_LN1G, I_LN1B, I_RW, I_RB, I_EWG, I_EWU, I_EWD, I_LN2G, I_LN2B };
struct Frame {
    LAS unsigned char* lds;
    volatile LAS unsigned* MISC;
    gu32* ctl;
    unsigned char* ws;
    int vcu, G;
};
DI int ftid() { int t = threadIdx.x; asm volatile("" : "+v"(t)); return t; }
#define FRAME_IDS const int tid_ = ftid(), lane_ = tid_ & 63, wave_ = __builtin_amdgcn_readfirstlane(tid_ >> 6); (void)lane_; (void)wave_;

template <class RowMap>
DI void transpose_item(const float* W, int K, int N, bf16* WT, const RowMap& rm, LAS float* scr, int item, int lane) {
    const int nblk = N / 32, kb = item / nblk, nb = item % nblk, k0 = 64 * kb, n0 = 32 * nb;
#pragma unroll 8
    for (int i = 0; i < 32; ++i) { const int kk = 2 * i + (lane >> 5); scr[kk * 33 + (lane & 31)] = W[(size_t)(k0 + kk) * N + n0 + (lane & 31)]; }
    LDS_WAIT(); asm volatile("" ::: "memory");
    const int c = lane & 7;
#pragma unroll
    for (int j = 0; j < 4; ++j) { const int n = (lane >> 3) + 8 * j; const LAS float* s = scr + (8 * c) * 33 + n;
        const float qs = (RowMap::SCALEQ && (n0 + n) >= COL_Q && (n0 + n) < COL_K) ? QSCALE : 1.0f;
        v4u o; o.x = pk2(s[0 * 33] * qs, s[1 * 33] * qs); o.y = pk2(s[2 * 33] * qs, s[3 * 33] * qs); o.z = pk2(s[4 * 33] * qs, s[5 * 33] * qs); o.w = pk2(s[6 * 33] * qs, s[7 * 33] * qs);
        *(GAS v4u*)(WT + (size_t)rm(n0 + n) * K + k0 + 8 * c) = o; }
    LDS_WAIT(); asm volatile("" ::: "memory");
}
struct RmIdent { static constexpr bool SCALEQ = false; int off; DI int operator()(int n) const { return off + n; } };
struct RmWin { static constexpr bool SCALEQ = true; DI int operator()(int n) const {
        if (n >= COL_Q && n < COL_VA) { const int d = n & 63; if (d < 16) return (n - d) + 2 * (d & 7) + (d >> 3); }
        return n; } };
struct RmGU { static constexpr bool SCALEQ = false; int e, up; DI int operator()(int n) const { return e * 1024 + (n >> 7) * 256 + (n & 127) + up * 128; } };

DI void p0_tables(Frame& F, const Args& A) {
    FRAME_IDS
    const float* c = (const float*)A.in[I_C];
    LAS float* condS = (LAS float*)(F.lds + RING_OFF);
    LAS float* red = (LAS float*)(F.lds + RING_OFF + 32768);
    for (int i = tid_; i < BATCH * D; i += NTHR) condS[i] = silu_f(c[i]);
    __syncthreads();
    float* mod = (float*)(F.ws + WS_MOD);
    for (int it = F.vcu; it < DEPTH * 96; it += F.G) {
        const int l = it / 96, jb = it % 96, ks = tid_ >> 6, jj = tid_ & 63, j = jb * 64 + jj;
        const float* w = (const float*)A.in[I_ADAW] + (size_t)l * D * 6 * D + j;
        float acc[8];
#pragma unroll
        for (int b = 0; b < 8; ++b) acc[b] = 0.f;
#pragma unroll 16
        for (int k = ks * 128; k < ks * 128 + 128; ++k) { const float wv = w[(size_t)k * (6 * D)];
#pragma unroll
            for (int b = 0; b < 8; ++b) acc[b] += condS[b * D + k] * wv; }
#pragma unroll
        for (int b = 0; b < 8; ++b) red[(ks * 8 + b) * 64 + jj] = acc[b];
        __syncthreads();
        { const int b = tid_ >> 6; float s = ((const float*)A.in[I_ADAB])[l * 6 * D + j];
#pragma unroll
          for (int k2 = 0; k2 < 8; ++k2) s += red[(k2 * 8 + b) * 64 + jj];
          mod[((size_t)l * BATCH + b) * 6 * D + j] = s; }
        __syncthreads();
    }
    const int gt = F.vcu * NTHR + tid_, NGT = F.G * NTHR;
    const int* pos = (const int*)A.in[I_POS]; float* rope = (float*)(F.ws + WS_ROPE);
    for (int w = gt; w < M * 8; w += NGT) { const int m = w >> 3, i = w & 7;
        const float freq = exp2f(-(float)i * 0.125f * 18.931568569324174f);
        const float ang = (float)pos[m] * freq; float s, cs; sincosf(ang, &s, &cs);
        rope[m * 16 + i] = cs; rope[m * 16 + 8 + i] = s; }
    for (int w = gt; w < DEPTH * 16 * 33 * 64; w += NGT) { const int n = w & 63, m = (w >> 6) % 33, g = ((w >> 6) / 33) & 15, l = (w >> 6) / (33 * 16);
        const int li = (l * 16 + g) * 64 + n;
        const float lre = ((const float*)A.in[I_LAMRE])[li], lim = ((const float*)A.in[I_LAMIM])[li], dt = expf(((const float*)A.in[I_LOGDT])[l * 16 + g]);
        const float mag = expf((float)m * (lre * dt)); float sn, cs; sincosf((float)m * (lim * dt), &sn, &cs);
        float* apw = (float*)(F.ws + WS_SSM2 + l * SSM2_LAYER + S2_APW) + ((size_t)(g * 33 + m) * 64 + n) * 2; apw[0] = mag * cs; apw[1] = mag * sn; }
    for (int w = gt; w < DEPTH * SSM_G * SSM_N; w += NGT) { const int l = w / 1024, gn = w % 1024, g = gn >> 6;
        float* tab = (float*)(F.ws + WS_SSM) + (size_t)l * SSM_TAB;
        const float lre = ((const float*)A.in[I_LAMRE])[w], lim = ((const float*)A.in[I_LAMIM])[w];
        const float dt = expf(((const float*)A.in[I_LOGDT])[l * 16 + g]);
        const float mag = expf(lre * dt); float sn, cs; sincosf(lim * dt, &sn, &cs);
        const float are = mag * cs, aim = mag * sn, nr = are - 1.0f, ni = aim, mod2 = lre * lre + lim * lim;
        const float fre = (nr * lre + ni * lim) / mod2, fim = (ni * lre - nr * lim) / mod2;
        tab[gn] = are; tab[1024 + gn] = aim;
        const float* bre = (const float*)A.in[I_BRE] + (size_t)w * 16; const float* bim = (const float*)A.in[I_BIM] + (size_t)w * 16;
#pragma unroll
        for (int cc = 0; cc < 16; ++cc) { tab[2048 + gn * 16 + cc] = fre * bre[cc] - fim * bim[cc]; tab[2048 + 16384 + gn * 16 + cc] = fre * bim[cc] + fim * bre[cc]; } }
}

constexpr int WCONV_SPLIT = 16 * 72 + 16 * 32 + 4 * 8 + 8900;
DI void p_wconv(Frame& F, const Args& A, int l, int part) {
    FRAME_IDS
    if (part == 4) {
        const int gt = F.vcu * NTHR + tid_, NGT = F.G * NTHR;
        const float* tab = (const float*)(F.ws + WS_SSM) + (size_t)l * SSM_TAB;
        const float* apw = (const float*)(F.ws + WS_SSM2 + l * SSM2_LAYER + S2_APW);
        const float* cre = (const float*)A.in[I_CRE] + (size_t)l * 16 * 16 * 64; const float* cim = (const float*)A.in[I_CIM] + (size_t)l * 16 * 16 * 64;
        bf16* KT = (bf16*)(F.ws + WS_SSM2 + l * SSM2_LAYER + S2_KT); bf16* CT = (bf16*)(F.ws + WS_SSM2 + l * SSM2_LAYER + S2_CT);
        bf16* WIN = (bf16*)(F.ws + WS_SSM2 + l * SSM2_LAYER + S2_WIN); bf16* GW = (bf16*)(F.ws + WS_SSM2 + l * SSM2_LAYER + S2_GW);
        for (int w = gt; w < 16 * 16 * 64 * 8; w += NGT) { const int j = w & 7, ln = (w >> 3) & 63, p = (w >> 9) & 15, g = w >> 13;
            const int co = ln & 15, q = ln >> 4, m = 2 * p + (q >> 1), ci = 8 * (q & 1) + j; float acc = 0.f;
            for (int n = 0; n < 64; ++n) { const int gn = g * 64 + n; const float ar = apw[((g * 33 + m) * 64 + n) * 2], ai = apw[((g * 33 + m) * 64 + n) * 2 + 1];
                const float br = tab[2048 + gn * 16 + ci], bi = tab[2048 + 16384 + gn * 16 + ci], tre = ar * br - ai * bi, tim = ar * bi + ai * br;
                acc += cre[(g * 16 + co) * 64 + n] * tre - cim[(g * 16 + co) * 64 + n] * tim; }
            KT[w] = (bf16)f2bf(acc); }
        for (int w = gt; w < 16 * 4 * 64 * 8; w += NGT) { const int j = w & 7, ln = (w >> 3) & 63, sx = (w >> 9) & 3, g = w >> 11;
            const int co = ln & 15, q = ln >> 4, n = 16 * sx + 4 * q + (j >> 1);
            CT[w] = (bf16)f2bf((j & 1) ? -cim[(g * 16 + co) * 64 + n] : cre[(g * 16 + co) * 64 + n]); }
        for (int w = gt; w < 16 * 16 * 8 * 64 * 8; w += NGT) { const int jj = w & 7, ln = (w >> 3) & 63, ct = (w >> 9) & 7, sp = (w >> 12) & 15, g = w >> 16;
            const int cc = ln & 15, q = ln >> 4, n = 8 * ct + (cc >> 1), part = cc & 1, tj = 2 * sp + (q >> 1), ci = 8 * (q & 1) + jj, gn = g * 64 + n, m = 31 - tj;
            const float ar = apw[((g * 33 + m) * 64 + n) * 2], ai = apw[((g * 33 + m) * 64 + n) * 2 + 1], br = tab[2048 + gn * 16 + ci], bi = tab[2048 + 16384 + gn * 16 + ci];
            WIN[w] = (bf16)f2bf(part ? (ar * bi + ai * br) : (ar * br - ai * bi)); }
        const float* gws = (const float*)A.in[I_GMWS] + (size_t)l * 4 * 128 * 128;
        for (int w = gt; w < 4 * 128 * 128; w += NGT) { const int sx = w & 127, t = (w >> 7) & 127; GW[w] = (bf16)f2bf(sx <= t ? gws[w] : 0.f); }
    }
    if (part == 4) return;
    LAS float* scr = (LAS float*)(F.lds + RING_OFF + wave_ * 16384);
    constexpr int NSMALL_ = 16 * 72 + 16 * 32 + 4 * 8;
    const int gw = (part == 1) ? WCONV_SPLIT + ((int)blockIdx.x - 128) * NWAVES + wave_ : (part == 3 ? NSMALL_ : 0) + F.vcu * NWAVES + wave_, NGW = (part == 1) ? 128 * NWAVES : F.G * NWAVES;
    bf16* WinT = (bf16*)(F.ws + WS_WSMALL + l * WSMALL_LAYER + WOFF_IN);
    bf16* WoutT = (bf16*)(F.ws + WS_WSMALL + l * WSMALL_LAYER + WOFF_OUT);
    bf16* GluT = (bf16*)(F.ws + WS_WSMALL + l * WSMALL_LAYER + WOFF_GLU);
    bf16* WguT = (bf16*)(F.ws + WS_WGU); bf16* WdT = (bf16*)(F.ws + WS_WD);
    constexpr int I_IN = 16 * 72, I_OUTW = 16 * 32, I_GLU = 4 * 8, I_G = 16 * 16, I_DN = 8 * 32;
    constexpr int NIT = I_IN + I_OUTW + I_GLU + 16 * (2 * I_G + I_DN);
    const int split = (F.G == 256) ? WCONV_SPLIT : NIT;
    for (int it = gw; it < ((part == 1) ? NIT : (part == 2 ? NSMALL_ : split)); it += NGW) {
        int r = it;
        if (r < I_IN) { transpose_item((const float*)A.in[I_WIN] + (size_t)l * D * PROJW, D, PROJW, WinT, RmWin{}, scr, r, lane_); continue; } r -= I_IN;
        if (r < I_OUTW) { transpose_item((const float*)A.in[I_WOUT] + (size_t)l * D * D, D, D, WoutT, RmIdent{0}, scr, r, lane_); continue; } r -= I_OUTW;
        if (r < I_GLU) { transpose_item((const float*)A.in[I_GLUW] + (size_t)l * 256 * 256, 256, 256, GluT, RmIdent{0}, scr, r, lane_); continue; } r -= I_GLU;
        const int e = r / (2 * I_G + I_DN); r -= e * (2 * I_G + I_DN);
        const size_t eo = ((size_t)l * NEXP + e) * D * DEXP;
        if (r < I_G) { transpose_item((const float*)A.in[I_EWG] + eo, D, DEXP, WguT, RmGU{e, 0}, scr, r, lane_); continue; } r -= I_G;
        if (r < I_G) { transpose_item((const float*)A.in[I_EWU] + eo, D, DEXP, WguT, RmGU{e, 1}, scr, r, lane_); continue; } r -= I_G;
        transpose_item((const float*)A.in[I_EWD] + eo, DEXP, D, WdT, RmIdent{e * 1024}, scr, r, lane_);
    }
}

typedef float f32x2_t __attribute__((ext_vector_type(2)));
typedef __bf16 bf16x2_t __attribute__((ext_vector_type(2)));
DI unsigned cvtpk(float lo, float hi) { f32x2_t v = {lo, hi}; bf16x2_t b = __builtin_convertvector(v, bf16x2_t); return __builtin_bit_cast(unsigned, b); }
struct Row16 { float v[16]; };
DI void row_load_f32(Row16& r, const float* p, int lane) {
    const f32x4* q = (const f32x4*)p;
#pragma unroll
    for (int k = 0; k < 4; ++k) { const f32x4 a = q[k * 64 + lane]; r.v[4 * k] = a.x; r.v[4 * k + 1] = a.y; r.v[4 * k + 2] = a.z; r.v[4 * k + 3] = a.w; }
}
DI void row_load_f32_nt(Row16& r, const float* p, int lane) {
    const f32x4* q = (const f32x4*)p;
#pragma unroll
    for (int k = 0; k < 4; ++k) { const f32x4 a = __builtin_nontemporal_load(&q[k * 64 + lane]); r.v[4 * k] = a.x; r.v[4 * k + 1] = a.y; r.v[4 * k + 2] = a.z; r.v[4 * k + 3] = a.w; }
}
DI void row_load_bf16(Row16& r, const bf16* p, int lane) {
    const v2u* q = (const v2u*)p;
#pragma unroll
    for (int k = 0; k < 4; ++k) { const v2u a = q[k * 64 + lane]; r.v[4 * k] = bflo(a.x); r.v[4 * k + 1] = bfhi(a.x); r.v[4 * k + 2] = bflo(a.y); r.v[4 * k + 3] = bfhi(a.y); }
}
DI void row_store_bf16(const Row16& r, bf16* p, int lane) {
    v2u* q = (v2u*)p;
#pragma unroll
    for (int k = 0; k < 4; ++k) { v2u o; o.x = cvtpk(r.v[4 * k], r.v[4 * k + 1]); o.y = cvtpk(r.v[4 * k + 2], r.v[4 * k + 3]); q[k * 64 + lane] = o; }
}
DI void row_store_f32(const Row16& r, float* p, int lane) {
    f32x4* q = (f32x4*)p;
#pragma unroll
    for (int k = 0; k < 4; ++k) __builtin_nontemporal_store((f32x4){r.v[4 * k], r.v[4 * k + 1], r.v[4 * k + 2], r.v[4 * k + 3]}, &q[k * 64 + lane]);
}
DI void row_ln(Row16& r) {
    float s = 0.f;
#pragma unroll
    for (int i = 0; i < 16; ++i) s += r.v[i];
    const float mean = wave_sum(s) * (1.f / D); float s2 = 0.f;
#pragma unroll
    for (int i = 0; i < 16; ++i) { r.v[i] -= mean; s2 += r.v[i] * r.v[i]; }
    const float rstd = 1.0f / sqrtf(wave_sum(s2) * (1.f / D) + LN_EPS);
#pragma unroll
    for (int i = 0; i < 16; ++i) r.v[i] *= rstd;
}
DI void row_mod(Row16& r, const float* a, const float* b, int lane) {
    Row16 av, bv; row_load_f32(av, a, lane); row_load_f32(bv, b, lane);
#pragma unroll
    for (int i = 0; i < 16; ++i) r.v[i] = r.v[i] * (1.0f + av.v[i]) + bv.v[i];
}
DI void row_affine(Row16& r, const float* g, const float* b, int lane) {
    Row16 av, bv; row_load_f32(av, g, lane); row_load_f32(bv, b, lane);
#pragma unroll
    for (int i = 0; i < 16; ++i) r.v[i] = r.v[i] * av.v[i] + bv.v[i];
}

DI void p_ln_a0(Frame& F, const Args& A) {
    FRAME_IDS
    const int gw = F.vcu * NWAVES + wave_, NGW = F.G * NWAVES;
    const float* x = (const float*)A.in[I_X]; bf16* XN = (bf16*)(F.ws + WS_XN); const float* mod = (const float*)(F.ws + WS_MOD);
    const int bq = gw / (NGW / BATCH), mbase = bq * T + gw % (NGW / BATCH), mstep = NGW / BATCH;
    const float* md = mod + (size_t)bq * 6 * D;
    Row16 msc, msh; row_load_f32(msc, md + 1 * D, lane_); row_load_f32(msh, md + 0 * D, lane_);
    Row16 nx; row_load_f32_nt(nx, x + (size_t)mbase * D, lane_);
    for (int m = mbase; m < (bq + 1) * T; m += mstep) {
        Row16 r = nx; if (m + mstep < (bq + 1) * T) row_load_f32_nt(nx, x + (size_t)(m + mstep) * D, lane_);
        row_ln(r);
#pragma unroll
        for (int i = 0; i < 16; ++i) r.v[i] = r.v[i] * (1.0f + msc.v[i]) + msh.v[i];
        row_store_bf16(r, XN + (size_t)m * D, lane_); }
}

using pg8::Unit; using pg8::BM; using pg8::HALF;
struct EpiInProj {
    static constexpr bool PERM = true, AFTER_DRAIN = false;
    bf16* P; const float* rope; int skip;
    DI void operator()(const pg8::f32x4 (&acc)[2][2][4][2], const Unit& u, int wr, int wc, int fr, int fq) const {
        if (skip == 1) { if (acc[0][0][0][0][0] == 12345.678f) P[0] = 1; return; }
        const int row0 = u.pm * BM + wr * 64 + fr, pn = u.pn;
        const bool isrope = (pn >= 2 && pn <= 5), dorope = isrope && ((wc & 1) == 0) && (fq < 2);
#pragma unroll
        for (int ai = 0; ai < 2; ++ai)
#pragma unroll
            for (int m = 0; m < 4; ++m) { const int row = row0 + ai * HALF + m * 16; bf16* rowp = P + (size_t)row * PROJW + pn * BM + wc * 32 + 8 * fq;
                f32x4 cs = (f32x4){1.f, 1.f, 1.f, 1.f}, sn = (f32x4){0.f, 0.f, 0.f, 0.f};
                if (isrope) { const float* rp = rope + (size_t)row * 16 + 4 * (fq & 1); cs = *(const f32x4*)rp; sn = *(const f32x4*)(rp + 8); }
#pragma unroll
                for (int bj = 0; bj < 2; ++bj) { pg8::f32x4 v0 = acc[ai][bj][m][0], v1 = acc[ai][bj][m][1];
                    if (isrope) {
                        if (dorope) { const float a0 = v0[0] * cs.x - v0[1] * sn.x, b0 = v0[1] * cs.x + v0[0] * sn.x, a1 = v0[2] * cs.y - v0[3] * sn.y, b1 = v0[3] * cs.y + v0[2] * sn.y;
                            const float a2 = v1[0] * cs.z - v1[1] * sn.z, b2 = v1[1] * cs.z + v1[0] * sn.z, a3 = v1[2] * cs.w - v1[3] * sn.w, b3 = v1[3] * cs.w + v1[2] * sn.w;
                            v0 = (pg8::f32x4){a0, b0, a1, b1}; v1 = (pg8::f32x4){a2, b2, a3, b3}; }
                    }
                    pg8::u32x4 w; w.x = pg8::cvt_pk_bf16(v0[0], v0[1]); w.y = pg8::cvt_pk_bf16(v0[2], v0[3]); w.z = pg8::cvt_pk_bf16(v1[0], v1[1]); w.w = pg8::cvt_pk_bf16(v1[2], v1[3]);
                    if (skip == 2) { asm volatile("" :: "v"(w.x), "v"(w.y), "v"(w.z), "v"(w.w)); } else *(pg8::u32x4*)(rowp + bj * HALF) = w; } }
    }
};
template <bool XF32> struct EpiOut {
    static constexpr bool PERM = true, AFTER_DRAIN = false;
    bf16* PRE; const void* x; int xpitch; const float* mod;
    DI void operator()(const pg8::f32x4 (&acc)[2][2][4][2], const Unit& u, int wr, int wc, int fr, int fq) const {
        const int row0 = u.pm * BM + wr * 64 + fr, b = (u.pm * BM) / T, colb = u.pn * BM + wc * 32 + 8 * fq;
        const float* g1 = mod + (size_t)b * 6 * D + 2 * D;
        pg8::f32x4 gv[2][2];
#pragma unroll
        for (int bj = 0; bj < 2; ++bj) { gv[bj][0] = *(const pg8::f32x4*)(g1 + colb + bj * HALF) + 1.0f; gv[bj][1] = *(const pg8::f32x4*)(g1 + colb + bj * HALF + 4) + 1.0f; }
#pragma unroll
        for (int ai = 0; ai < 2; ++ai)
#pragma unroll
            for (int m = 0; m < 4; ++m) { const int row = row0 + ai * HALF + m * 16;
#pragma unroll
                for (int bj = 0; bj < 2; ++bj) { const int col = colb + bj * HALF; pg8::f32x4 x0, x1;
                    if (XF32) { const float* xp = (const float*)x + (size_t)row * xpitch + col; x0 = *(const pg8::f32x4*)xp; x1 = *(const pg8::f32x4*)(xp + 4); }
                    else { const pg8::u32x4 xw = *(const pg8::u32x4*)((const bf16*)x + (size_t)row * xpitch + col);
                        x0 = (pg8::f32x4){bflo(xw.x), bfhi(xw.x), bflo(xw.y), bfhi(xw.y)}; x1 = (pg8::f32x4){bflo(xw.z), bfhi(xw.z), bflo(xw.w), bfhi(xw.w)}; }
                    const pg8::f32x4 v0 = x0 * ALPHA + gv[bj][0] * acc[ai][bj][m][0], v1 = x1 * ALPHA + gv[bj][1] * acc[ai][bj][m][1];
                    pg8::u32x4 w; w.x = pg8::cvt_pk_bf16(v0[0], v0[1]); w.y = pg8::cvt_pk_bf16(v0[2], v0[3]); w.z = pg8::cvt_pk_bf16(v1[0], v1[1]); w.w = pg8::cvt_pk_bf16(v1[2], v1[3]);
                    *(pg8::u32x4*)(PRE + (size_t)row * D + col) = w; } }
    }
};
struct OutOrder : pg8::StaticOrder {
    const char* xbase; unsigned rowbytes, tilecolbytes; LAS unsigned char* dump;
    DI void a_ready(const Unit& u) const {
        const int tid = threadIdx.x, wid = __builtin_amdgcn_readfirstlane(tid >> 6), lane = tid & 63;
        const int lpr = (int)(tilecolbytes >> 7);
        const char* t0 = xbase + (size_t)u.pm * 256 * rowbytes + (size_t)u.pn * tilecolbytes;
        const int nline = 256 * lpr;
        for (int i = wid * 64 + lane; i < nline; i += 512) { const int r = i / lpr, c = i % lpr;
            __builtin_amdgcn_global_load_lds((const unsigned*)(t0 + (size_t)r * rowbytes + (size_t)c * 128), (LAS unsigned*)(dump + wid * 256), 4, 0, 0); }
    }
};
struct EpiGlu {
    static constexpr bool PERM = true, AFTER_DRAIN = false;
    const bf16* YG; bf16* MIX; const float* gb;
    DI void operator()(const pg8::f32x4 (&acc)[2][2][4][2], const Unit& u, int wr, int wc, int fr, int fq) const {
        const int row0 = u.pm * BM + wr * 64 + fr, colb = wc * 32 + 8 * fq;
#pragma unroll
        for (int ai = 0; ai < 2; ++ai)
#pragma unroll
            for (int m = 0; m < 4; ++m) { const int row = row0 + ai * HALF + m * 16;
#pragma unroll
                for (int bj = 0; bj < 2; ++bj) { const int col = colb + bj * HALF;
                    const pg8::u32x4 yw = *(const pg8::u32x4*)(YG + (size_t)row * 256 + col);
                    const pg8::f32x4 b0 = *(const pg8::f32x4*)(gb + col), b1 = *(const pg8::f32x4*)(gb + col + 4);
                    const pg8::f32x4 a0 = acc[ai][bj][m][0] + b0, a1 = acc[ai][bj][m][1] + b1;
                    const float y[8] = {bflo(yw.x), bfhi(yw.x), bflo(yw.y), bfhi(yw.y), bflo(yw.z), bfhi(yw.z), bflo(yw.w), bfhi(yw.w)};
                    float o[8];
#pragma unroll
                    for (int i = 0; i < 4; ++i) { o[i] = y[i] * sigmoid_f(a0[i]); o[4 + i] = y[4 + i] * sigmoid_f(a1[i]); }
                    pg8::u32x4 w; w.x = pg8::cvt_pk_bf16(o[0], o[1]); w.y = pg8::cvt_pk_bf16(o[2], o[3]); w.z = pg8::cvt_pk_bf16(o[4], o[5]); w.w = pg8::cvt_pk_bf16(o[6], o[7]);
                    *(pg8::u32x4*)(MIX + (size_t)row * D + 768 + col) = w; asm volatile("" ::: "memory"); } }
    }
};
template <int KIND> struct MoeOrderK {
    const volatile LAS int* ts; int G, c; const int* slot_a; const float* slot_w; gu32* done_cnt; gu32* queue; volatile LAS int* qs;
    DI bool decode(int off, Unit& u) const {
        const int nwg = ts[16] * 4, q = nwg / 8, r = nwg % 8, xcd = c % 8; const int cntx = q + (xcd < r ? 1 : 0); if (off >= cntx) return false;
        const int wgid = (xcd < r ? xcd * (q + 1) : r * (q + 1) + (xcd - r) * q) + off;
        const int tm = wgid >> 2, j = wgid & 3; int e = 0;
#pragma unroll
        for (int k = 1; k < 16; ++k) e += (ts[k] <= tm) ? 1 : 0;
        u.pm = tm; u.pn = e * 4 + j; return true; }
    DI bool first(Unit& u) const {
        if (KIND == 0) return next(0, u);
        if (threadIdx.x == 0) { const unsigned a = __hip_atomic_fetch_add(queue + 16 * (c % 8), 2u, RLX_AGENT); qs[0] = (int)a; qs[1] = (int)a + 1; }
        asm volatile("s_waitcnt vmcnt(0) lgkmcnt(0)" ::: "memory"); __builtin_amdgcn_s_barrier(); asm volatile("" ::: "memory");
        return decode(qs[0], u);
    }
    DI bool more(int i, Unit& u) const {
        if (KIND == 0) return next(i, u);
        return decode(qs[i & 1], u);
    }
    DI bool next(int i, Unit& u) const {
        const int nwg = ts[16] * 4; const int cc = c;
        const long L = (long)i * G + cc; if (L >= nwg) return false;
        int wgid = (int)L; { const int q = nwg / 8, r = nwg % 8, xcd = wgid % 8, off = wgid / 8; wgid = (xcd < r ? xcd * (q + 1) : r * (q + 1) + (xcd - r) * q) + off; }
        const int tm = wgid >> 2, j = wgid & 3; int e = 0;
#pragma unroll
        for (int k = 1; k < 16; ++k) e += (ts[k] <= tm) ? 1 : 0;
        u.pm = tm; u.pn = e * 4 + j; return true;
    }
    struct Pf { unsigned a, w, c, q; };
    DI void pull_issue(int tid, Pf& pf) const { if (KIND == 1 && tid == 0) pf.q = __hip_atomic_fetch_add(queue + 16 * (c % 8), 1u, RLX_AGENT); }
    DI void pull_publish(int tid, const Pf& pf, int ui) const { if (KIND == 1 && tid == 0 && ui >= 0) qs[ui & 1] = (int)pf.q; }
    DI void prefetch(const Unit& u, int r, Pf& pf) const {
        const int e = u.pn >> 2, idx = (u.pm - ts[e]) * 256 + (r & 255); const bool valid = idx < ts[32 + e];
        pf.a = 0xffffffffu; pf.w = 0u; pf.c = 32u;
        if (valid && r < 256) { pf.a = (unsigned)slot_a[(size_t)e * SLOT_CAP + idx]; if (KIND == 1) pf.w = __float_as_uint(slot_w[(size_t)e * SLOT_CAP + idx]); }
        if (KIND == 1 && r < 64) pf.c = __hip_atomic_load(done_cnt + u.pm, RLX_AGENT);
    }
    DI void finish_meta(const Unit& u, int r, const Pf& pf, unsigned& off, unsigned& a0, unsigned& a1) const {
        if (KIND == 0) { off = (pf.a == 0xffffffffu ? 0u : (pf.a >> 1)) * (unsigned)(D * 2); a0 = 0u; a1 = 0u; }
        else { off = (unsigned)(u.pm * 256 + r) * (unsigned)(DEXP * 2); a0 = pf.a; a1 = pf.w; }
    }
    DI void wait_ready(const Unit& u, int tid, const Pf& pf) const {
        if (KIND == 1 && tid < 64) { unsigned sp = 0;
            if ((unsigned)__builtin_amdgcn_readfirstlane((int)pf.c) < 32u)
                while ((unsigned)__builtin_amdgcn_readfirstlane((int)__hip_atomic_load(done_cnt + u.pm, RLX_AGENT)) < 32u) { __builtin_amdgcn_s_sleep(2); if (++sp > (1u << 20)) break; } }
    }
    DI void a_ready(const Unit&) const {}
    DI void done_nowait(const Unit& u) const { if (KIND == 0 && (threadIdx.x & 63) == 0) __hip_atomic_fetch_add(done_cnt + u.pm, 1u, RLX_AGENT); }
};
struct EpiG1 {
    static constexpr bool PERM = true, AFTER_DRAIN = false;
    bf16* HID; int skip;
    DI void operator()(const pg8::f32x4 (&acc)[2][2][4][2], const Unit& u, int wr, int wc, int fr, int fq, const LAS unsigned*) const {
        if (skip == 1) { if (acc[0][0][0][0][0] == 12345.678f) HID[0] = 1; return; }
        const __amdgpu_buffer_rsrc_t rs = __builtin_amdgcn_make_buffer_rsrc((void*)HID, 0, (int)((size_t)NSLOT_MAX * DEXP * 2), 0x00020000);
        const int row0 = u.pm * BM + wr * 64 + fr, col = (u.pn & 3) * 128 + wc * 32 + 8 * fq;
#pragma unroll
        for (int ai = 0; ai < 2; ++ai)
#pragma unroll
            for (int m = 0; m < 4; ++m) { const int row = row0 + ai * HALF + m * 16; float o[8];
#pragma unroll
                for (int i = 0; i < 4; ++i) { o[i] = silu_f(acc[ai][0][m][0][i]) * acc[ai][1][m][0][i]; o[4 + i] = silu_f(acc[ai][0][m][1][i]) * acc[ai][1][m][1][i]; }
                pg8::u32x4 w; w.x = pg8::cvt_pk_bf16(o[0], o[1]); w.y = pg8::cvt_pk_bf16(o[2], o[3]); w.z = pg8::cvt_pk_bf16(o[4], o[5]); w.w = pg8::cvt_pk_bf16(o[6], o[7]);
                __builtin_amdgcn_raw_buffer_store_b128(w, rs, (row * DEXP + col) * 2, 0, 16); }
    }
};
struct EpiG2 {
    static constexpr bool PERM = true, AFTER_DRAIN = false;
    bf16* ROWS; int skip;
    DI void operator()(const pg8::f32x4 (&acc)[2][2][4][2], const Unit& u, int wr, int wc, int fr, int fq, const LAS unsigned* meta) const {
        if (skip == 1) { if (acc[0][0][0][0][0] == 12345.678f) ROWS[0] = 1; return; }
        const int r0 = wr * 64 + fr, colb = (u.pn & 3) * BM + wc * 32 + 8 * fq;
#pragma unroll
        for (int ai = 0; ai < 2; ++ai)
#pragma unroll
            for (int m = 0; m < 4; ++m) { const int r = r0 + ai * HALF + m * 16; const int d = (int)meta[256 + r]; const float wt = __uint_as_float(meta[512 + r]);
                if (d >= 0) {
#pragma unroll
                    for (int bj = 0; bj < 2; ++bj) { const pg8::f32x4 v0 = acc[ai][bj][m][0] * wt, v1 = acc[ai][bj][m][1] * wt;
                        pg8::u32x4 w; w.x = pg8::cvt_pk_bf16(v0[0], v0[1]); w.y = pg8::cvt_pk_bf16(v0[2], v0[3]); w.z = pg8::cvt_pk_bf16(v1[0], v1[1]); w.w = pg8::cvt_pk_bf16(v1[2], v1[3]);
                        *(pg8::u32x4*)(ROWS + (size_t)d * D + colb + bj * HALF) = w; } } }
    }
};

DI void mix_gating_simple(Frame& F, const Args& A, int l) {
    FRAME_IDS
    const bf16* P = (const bf16*)(F.ws + WS_PROJ); bf16* MIX = (bf16*)(F.ws + WS_MIXCAT);
    const float* lng = (const float*)A.in[I_GMLNG] + l * AW; const float* lnb = (const float*)A.in[I_GMLNB] + l * AW;
    const float* ws_ = (const float*)A.in[I_GMWS] + (size_t)l * 4 * 128 * 128; const float* bs_ = (const float*)A.in[I_GMBS] + l * 4 * 128;
    LAS float* vln = (LAS float*)(F.lds + RING_OFF);
    for (int it = F.vcu; it < BATCH * (T / 128); it += F.G) {
        const int m0 = it * 128;
        for (int r = wave_; r < 128; r += NWAVES) {
            const v2u w = *(const v2u*)(P + (size_t)(m0 + r) * PROJW + COL_V + 4 * lane_);
            float v[4] = {gelu_tanh_f(bflo(w.x)), gelu_tanh_f(bfhi(w.x)), gelu_tanh_f(bflo(w.y)), gelu_tanh_f(bfhi(w.y))};
            const float mean = wave_sum(v[0] + v[1] + v[2] + v[3]) * (1.f / 256.f);
            float s2 = 0.f;
#pragma unroll
            for (int i = 0; i < 4; ++i) { v[i] -= mean; s2 += v[i] * v[i]; }
            const float rstd = 1.0f / sqrtf(wave_sum(s2) * (1.f / 256.f) + LN_EPS);
#pragma unroll
            for (int i = 0; i < 4; ++i) vln[r * 256 + 4 * lane_ + i] = v[i] * rstd * lng[4 * lane_ + i] + lnb[4 * lane_ + i];
        }
        __syncthreads();
        { const int c = tid_ & 255, tp = tid_ >> 8, h = c >> 6;
          for (int t = tp; t < 128; t += 2) { const float* wrow = ws_ + ((size_t)h * 128 + t) * 128; float acc = 0.f;
              for (int s = 0; s <= t; ++s) acc += wrow[s] * vln[s * 256 + c];
              const float uu = gelu_tanh_f(bf2f(P[(size_t)(m0 + t) * PROJW + COL_U + c]));
              MIX[(size_t)(m0 + t) * D + c] = (bf16)f2bf(uu * (acc + bs_[h * 128 + t])); } }
        __syncthreads();
    }
}
DI void mix_attn_simple(Frame& F, int l) {
    FRAME_IDS
    const bf16* P = (const bf16*)(F.ws + WS_PROJ); bf16* MIX = (bf16*)(F.ws + WS_MIXCAT);
    const int gw = F.vcu * NWAVES + wave_, NGW = F.G * NWAVES;
    for (int it = gw; it < M * NH; it += NGW) {
        const int m = it >> 3, h = it & 7, t = m & (T - 1);
        const float q = bf2f(P[(size_t)m * PROJW + COL_Q + h * 64 + lane_]);
        float mx = -1e30f, den = 0.f, o = 0.f;
#pragma unroll 1
        for (int g = 0; g < 3; ++g) { const int dl = (g == 0) ? 1 : (g == 1 ? 4 : 16);
            int nk = t / dl; if (nk > 128) nk = 128;
#pragma unroll 2
            for (int j = 0; j <= nk; ++j) { const size_t mk = (size_t)(m - j * dl);
                const float kv = bf2f(P[mk * PROJW + COL_K + h * 64 + lane_]); const float vv = bf2f(P[mk * PROJW + COL_VA + h * 64 + lane_]);
                const float s = wave_sum(q * kv);
                const float mn = fmaxf(mx, s), f = __builtin_amdgcn_exp2f(mx - mn), p = __builtin_amdgcn_exp2f(s - mn);
                den = den * f + p; o = o * f + p * vv; mx = mn; } }
        MIX[(size_t)m * D + AW + h * 64 + lane_] = (bf16)f2bf(o / den);
    }
}

typedef float f32x16 __attribute__((ext_vector_type(16)));
typedef short v4i16_t __attribute__((ext_vector_type(4)));
DI int crow16(int r, int hi) { return (r & 3) + 8 * (r >> 2) + 4 * hi; }
template <int SUB> DI void mix_attn_mfma(Frame& F, int l) {
    FRAME_IDS
    const bf16* P = (const bf16*)(F.ws + WS_PROJ);
    LAS unsigned char* Ks = F.lds + RING_OFF; LAS unsigned char* Vs = Ks + 49152;
    LAS unsigned char* St = F.lds + ATT_STAGE_OFF + wave_ * 4608;
    const int ql = lane_ & 31, hi = lane_ >> 5, prow = lane_ >> 3, pch = lane_ & 7;
    constexpr int nitems = SUB == 0 ? 2048 : 1024;
    v4u kreg[6], vreg[6], qraw[4]; bf16x8 qf[4];
    int it = F.vcu; if (it >= nitems) return;
    int d, r, s0, b, h; size_t tokbase;
#define ATT_DECODE(IT) do { const int idx_ = (IT) & 1023; b = idx_ >> 7; h = (idx_ >> 4) & 7; int tile_; \
        if (SUB == 1) { d = 1; r = 0; tile_ = idx_ & 15; } else if ((IT) < 1024) { d = 16; r = idx_ & 15; tile_ = 0; } else { d = 4; r = (idx_ >> 2) & 3; tile_ = idx_ & 3; } \
        s0 = tile_ * 256; tokbase = (size_t)b * T + r; } while (0)
#define ATT_LOAD() do { const int tl_ = ftid(); _Pragma("unroll") for (int i = 0; i < 6; ++i) { const int idx2 = tl_ + 512 * i, row = idx2 >> 3, ch = idx2 & 7, step = s0 - 128 + row; \
            if (step >= 0) { const bf16* src = P + (tokbase + (size_t)step * d) * PROJW + h * 64 + ch * 8; kreg[i] = *(const v4u*)(src + COL_K); vreg[i] = *(const v4u*)(src + COL_VA); } \
            else { kreg[i] = (v4u){0u, 0u, 0u, 0u}; vreg[i] = (v4u){0u, 0u, 0u, 0u}; } } \
        _Pragma("unroll") for (int p = 0; p < 4; ++p) qraw[p] = *(const v4u*)(P + (tokbase + (size_t)(s0 + 32 * wave_ + 8 * p + prow) * d) * PROJW + COL_Q + h * 64 + pch * 8); } while (0)
#define ATT_WRITE() do { const int tw_ = ftid(); _Pragma("unroll") for (int i = 0; i < 6; ++i) { const int idx2 = tw_ + 512 * i, row = idx2 >> 3, ch = idx2 & 7; \
            *(LAS v4u*)(Ks + row * 128 + ((ch ^ ((row >> 1) & 7)) << 4)) = kreg[i]; \
            *(LAS v4u*)(Vs + row * 128 + ((ch ^ (((row >> 1) & 1) << 2)) << 4)) = vreg[i]; } \
        _Pragma("unroll") for (int p = 0; p < 4; ++p) *(LAS v4u*)(St + (8 * p + prow) * 144 + pch * 16) = qraw[p]; } while (0)
    ATT_DECODE(it); ATT_LOAD(); ATT_WRITE();
    __syncthreads();
    for (;;) {
        const size_t tb = tokbase; const int s0c = s0, dc = d, hcur = h, itcur = it;
        const bool first = (s0 == 0);
#pragma unroll
        for (int ks = 0; ks < 4; ++ks) qf[ks] = *(const LAS bf16x8*)(St + ql * 144 + (2 * ks + hi) * 16);
        const int itn = it + F.G; const bool has_next = itn < nitems;
        if (has_next) { ATT_DECODE(itn); ATT_LOAD(); }
        const int i0 = 32 * wave_;
        f32x16 S[5];
#pragma unroll
        for (int kb = 0; kb < 5; ++kb) { f32x16 acc;
#pragma unroll
            for (int i = 0; i < 16; ++i) acc[i] = 0.f;
            const int krow = i0 + 32 * kb + ql;
#pragma unroll
            for (int ks = 0; ks < 4; ++ks) { const bf16x8 a = *(const LAS bf16x8*)(Ks + krow * 128 + (((2 * ks + hi) ^ ((krow >> 1) & 7)) << 4)); acc = __builtin_amdgcn_mfma_f32_32x32x16_bf16(a, qf[ks], acc, 0, 0, 0); }
            S[kb] = acc; }
        int qrel = ql - 4 * hi; asm volatile("" : "+v"(qrel));
        float mx = -1e30f;
#pragma unroll
        for (int kb = 0; kb < 5; ++kb) {
            const bool bvalid = !first || (wave_ + kb >= 4);
            if (!bvalid) {
#pragma unroll
                for (int i = 0; i < 16; ++i) S[kb][i] = -1e30f;
            } else {
#pragma unroll
                for (int i = 0; i < 16; ++i) { const int c0 = crow16(i, 0); float v = S[kb][i];
                    if (kb == 0) v = (c0 >= qrel) ? v : -1e30f;
                    if (kb == 4) v = (c0 <= qrel) ? v : -1e30f;
                    S[kb][i] = v; mx = fmaxf(mx, v); }
            }
        }
        mx = fmaxf(mx, __shfl_xor(mx, 32));
        float lsum = 0.f;
#pragma unroll
        for (int kb = 0; kb < 5; ++kb)
#pragma unroll
            for (int i = 0; i < 16; ++i) { const float p = __builtin_amdgcn_exp2f(S[kb][i] - mx); S[kb][i] = p; lsum += p; }
        lsum += __shfl_xor(lsum, 32);
        v4u x16[4], x4[4]; f32x2_t s16 = {0.f, 0.f}, s4 = {0.f, 0.f};
        if (SUB == 1) {
            const size_t qt = tb + (size_t)(s0c + i0 + ql) * dc;
            s16 = *(const f32x2_t*)((const float*)(F.ws + WS_STAT) + (qt * NH + hcur) * 2); s4 = *(const f32x2_t*)((const float*)(F.ws + WS_STAT) + (size_t)M * NH * 2 + (qt * NH + hcur) * 2);
        }
        f32x16 O[2];
#pragma unroll
        for (int i = 0; i < 16; ++i) { O[0][i] = 0.f; O[1][i] = 0.f; }
        const int trq = (lane_ & 15) >> 2, trg = (lane_ >> 4) & 1, trp = lane_ & 3;
#pragma unroll
        for (int kb = 0; kb < 5; ++kb)
#pragma unroll
            for (int s = 0; s < 2; ++s) {
                if (SUB == 1 && kb == 2 && s == 0) {
#pragma unroll
                    for (int p = 0; p < 4; ++p) { const size_t rt = tb + (size_t)(s0c + i0 + 8 * p + prow) * dc; const bf16* pp = (const bf16*)(F.ws + WS_XN) + rt * BW + hcur * 64 + pch * 8;
                        x16[p] = *(const v4u*)pp; x4[p] = *(const v4u*)(pp + (size_t)M * BW); } }
                v4u pw; pw.x = cvtpk(S[kb][8 * s], S[kb][8 * s + 1]); pw.y = cvtpk(S[kb][8 * s + 2], S[kb][8 * s + 3]); pw.z = cvtpk(S[kb][8 * s + 4], S[kb][8 * s + 5]); pw.w = cvtpk(S[kb][8 * s + 6], S[kb][8 * s + 7]);
                const bf16x8 pb = __builtin_bit_cast(bf16x8, pw);
                const int rlo = i0 + 32 * kb + 16 * s + 4 * hi + trq, rhi = rlo + 8;
#pragma unroll
                for (int dh = 0; dh < 2; ++dh) { const int chunk = 4 * dh + 2 * trg + (trp >> 1);
                    const v4i16_t lo = __builtin_amdgcn_ds_read_tr16_b64_v4i16((LAS v4i16_t*)(Vs + rlo * 128 + ((chunk ^ (((rlo >> 1) & 1) << 2)) << 4) + 8 * (trp & 1)));
                    const v4i16_t hh = __builtin_amdgcn_ds_read_tr16_b64_v4i16((LAS v4i16_t*)(Vs + rhi * 128 + ((chunk ^ (((rhi >> 1) & 1) << 2)) << 4) + 8 * (trp & 1)));
                    const bf16x8 va = (bf16x8){lo[0], lo[1], lo[2], lo[3], hh[0], hh[1], hh[2], hh[3]};
                    O[dh] = __builtin_amdgcn_mfma_f32_32x32x16_bf16(va, pb, O[dh], 0, 0, 0); } }
        float osc;
        if (SUB == 0) osc = 1.0f / lsum;
        else { const float MM = fmaxf(mx, fmaxf(s16.x, s4.x)), a1 = __builtin_amdgcn_exp2f(mx - MM), a16 = s16.y * __builtin_amdgcn_exp2f(s16.x - MM), a4 = s4.y * __builtin_amdgcn_exp2f(s4.x - MM);
            const float inv = 1.0f / (lsum * a1 + a16 + a4); osc = a1 * inv;
            if (hi == 0) { f32x2_t cc = {a16 * inv, a4 * inv}; *(LAS f32x2_t*)(St + ql * 144 + 128) = cc; } }
#pragma unroll
        for (int dh = 0; dh < 2; ++dh)
#pragma unroll
            for (int g4 = 0; g4 < 4; ++g4) { v2u w; w.x = cvtpk(O[dh][4 * g4] * osc, O[dh][4 * g4 + 1] * osc); w.y = cvtpk(O[dh][4 * g4 + 2] * osc, O[dh][4 * g4 + 3] * osc);
                *(LAS v2u*)(St + ql * 144 + (32 * dh + 8 * g4 + 4 * hi) * 2) = w; }
        if (SUB == 0) {
            bf16* PART = (bf16*)(F.ws + WS_XN) + (itcur < 1024 ? 0 : (size_t)M * BW); float* ST = (float*)(F.ws + WS_STAT) + (itcur < 1024 ? 0 : (size_t)M * NH * 2);
            if (hi == 0) { const size_t qt = tb + (size_t)(s0c + i0 + ql) * dc; f32x2_t st = {mx, lsum}; *(f32x2_t*)(ST + (qt * NH + hcur) * 2) = st; }
#pragma unroll
            for (int p = 0; p < 4; ++p) { const size_t rt = tb + (size_t)(s0c + i0 + 8 * p + prow) * dc;
                *(v4u*)(PART + rt * BW + hcur * 64 + pch * 8) = *(const LAS v4u*)(St + (8 * p + prow) * 144 + pch * 16); }
        } else {
#pragma unroll
            for (int p = 0; p < 4; ++p) { const size_t rt = tb + (size_t)(s0c + i0 + 8 * p + prow) * dc;
                const v4u ov = *(const LAS v4u*)(St + (8 * p + prow) * 144 + pch * 16); const f32x2_t cc = *(const LAS f32x2_t*)(St + (8 * p + prow) * 144 + 128);
                v4u o;
                o.x = cvtpk(bflo(ov.x) + cc.x * bflo(x16[p].x) + cc.y * bflo(x4[p].x), bfhi(ov.x) + cc.x * bfhi(x16[p].x) + cc.y * bfhi(x4[p].x));
                o.y = cvtpk(bflo(ov.y) + cc.x * bflo(x16[p].y) + cc.y * bflo(x4[p].y), bfhi(ov.y) + cc.x * bfhi(x16[p].y) + cc.y * bfhi(x4[p].y));
                o.z = cvtpk(bflo(ov.z) + cc.x * bflo(x16[p].z) + cc.y * bflo(x4[p].z), bfhi(ov.z) + cc.x * bfhi(x16[p].z) + cc.y * bfhi(x4[p].z));
                o.w = cvtpk(bflo(ov.w) + cc.x * bflo(x16[p].w) + cc.y * bflo(x4[p].w), bfhi(ov.w) + cc.x * bfhi(x16[p].w) + cc.y * bfhi(x4[p].w));
                *(v4u*)((bf16*)(F.ws + WS_MIXCAT) + rt * D + AW + hcur * 64 + pch * 8) = o; }
        }
        __syncthreads();
        if (!has_next) break;
        ATT_WRITE(); it = itn;
        __syncthreads();
    }
#undef ATT_DECODE
#undef ATT_LOAD
#undef ATT_WRITE
}
typedef float f32x4_t __attribute__((ext_vector_type(4)));
DI void cmul_acc(float& xr, float& xi, float ar, float ai, float br, float bi) { const float nr = ar * xr - ai * xi + br, ni = ar * xi + ai * xr + bi; xr = nr; xi = ni; }
DI void mix_ssm_in(Frame& F, int l) {
    FRAME_IDS
    const bf16* P = (const bf16*)(F.ws + WS_PROJ);
    const bf16* WIN = (const bf16*)(F.ws + WS_SSM2 + l * SSM2_LAYER + S2_WIN);
    const float* apw = (const float*)(F.ws + WS_SSM2 + l * SSM2_LAYER + S2_APW);
    float* XLOC = (float*)(F.ws + WS_XLOC); float* XSUP = (float*)(F.ws + WS_XSUP);
    const int row = lane_ & 15, q = lane_ >> 4;
    for (int it = F.vcu; it < 256; it += F.G) {
        const int b = it >> 5, sc = (it >> 2) & 7, g = 4 * (it & 3) + (wave_ >> 1), half = wave_ & 1;
        bf16x8 af[16];
        { const bf16* src = P + ((size_t)b * T + (size_t)(16 * sc + row) * 32 + (q >> 1)) * PROJW + COL_S + g * 16 + 8 * (q & 1);
#pragma unroll
          for (int sp = 0; sp < 16; ++sp) af[sp] = *(const bf16x8*)(src + (size_t)(2 * sp) * PROJW); }
#pragma unroll 1
        for (int c4 = 0; c4 < 4; ++c4) { const int ct = 4 * half + c4;
            f32x4_t acc = {0.f, 0.f, 0.f, 0.f};
            const bf16* wp = WIN + (((size_t)(g * 16) * 8 + ct) * 64 + lane_) * 8;
#pragma unroll
            for (int sp = 0; sp < 16; ++sp) { const bf16x8 bfr = *(const bf16x8*)(wp + (size_t)sp * 8 * 64 * 8); acc = __builtin_amdgcn_mfma_f32_16x16x32_bf16(af[sp], bfr, acc, 0, 0, 0); }
            const int comp = 16 * ct + row, n = comp >> 1, part = comp & 1;
#pragma unroll
            for (int r = 0; r < 4; ++r) XLOC[(((size_t)b * 128 + 16 * sc + 4 * q + r) * 16 + g) * 128 + comp] = acc[r];
            const float a32r = apw[((g * 33 + 32) * 64 + n) * 2], a32i = apw[((g * 33 + 32) * 64 + n) * 2 + 1];
            const float sg = part ? 1.f : -1.f;
            float h = acc[0];
#pragma unroll
            for (int r = 1; r < 4; ++r) { const float o = __shfl_xor(h, 1); h = a32r * h + sg * a32i * o + acc[r]; }
            float p64r = a32r * a32r - a32i * a32i, p64i = 2.f * a32r * a32i;
            float p128r = p64r * p64r - p64i * p64i, p128i = 2.f * p64r * p64i;
            float wr = 1.f, wi = 0.f;
            for (int k = 0; k < 3 - q; ++k) { const float t0 = wr * p128r - wi * p128i, t1 = wr * p128i + wi * p128r; wr = t0; wi = t1; }
            { const float o = __shfl_xor(h, 1); h = wr * h + sg * wi * o; }
            h += __shfl_xor(h, 16); h += __shfl_xor(h, 32);
            if (q == 0) XSUP[(((size_t)b * 8 + sc) * 16 + g) * 128 + comp] = h;
        }
    }
}
DI void mix_ssm_out(Frame& F, const Args& A, int l) {
    FRAME_IDS
    const bf16* P = (const bf16*)(F.ws + WS_PROJ); bf16* YG = (bf16*)(F.ws + WS_YG);
    const bf16* KT = (const bf16*)(F.ws + WS_SSM2 + l * SSM2_LAYER + S2_KT); const bf16* CT = (const bf16*)(F.ws + WS_SSM2 + l * SSM2_LAYER + S2_CT);
    const float* apw = (const float*)(F.ws + WS_SSM2 + l * SSM2_LAYER + S2_APW);
    const float* XLOC = (const float*)(F.ws + WS_XLOC); const float* XSUP = (const float*)(F.ws + WS_XSUP);
    LAS unsigned char* Ut = F.lds + RING_OFF + wave_ * 4096;
    LAS float* Xs = (LAS float*)(F.lds + RING_OFF + wave_ * 4096 + 2048);
    for (int i = lane_; i < 256; i += 64) ((LAS unsigned*)Ut)[i] = 0u;
    const int row = lane_ & 15, q = lane_ >> 4;
    for (int it = F.vcu; it < 256; it += F.G) {
        const int b = it >> 5, sc = (it >> 2) & 7, g = 4 * (it & 3) + (wave_ >> 1), half = wave_ & 1, n = lane_;
        const size_t tokA = (size_t)b * T + (size_t)(16 * sc + 8 * half) * 32;
        v4u unext = *(const v4u*)(P + (tokA + (lane_ >> 1)) * PROJW + COL_S + g * 16 + 8 * (lane_ & 1));
        f32x2_t psup[8], ploc[8];
#pragma unroll
        for (int s2 = 0; s2 < 8; ++s2) { psup[s2] = (f32x2_t){0.f, 0.f}; if (s2 < sc) psup[s2] = *(const f32x2_t*)(XSUP + (((size_t)b * 8 + s2) * 16 + g) * 128 + 2 * n); }
#pragma unroll
        for (int k2 = 0; k2 < 8; ++k2) { ploc[k2] = (f32x2_t){0.f, 0.f}; if (half) ploc[k2] = *(const f32x2_t*)(XLOC + (((size_t)b * 128 + 16 * sc + k2) * 16 + g) * 128 + 2 * n); }
        const float dsk = ((const float*)A.in[I_SSMD])[(l * 16 + g) * 16 + row];
        const float a32r = apw[((g * 33 + 32) * 64 + n) * 2], a32i = apw[((g * 33 + 32) * 64 + n) * 2 + 1];
        const float a16r = apw[((g * 33 + 16) * 64 + n) * 2], a16i = apw[((g * 33 + 16) * 64 + n) * 2 + 1];
        float a512r = a32r, a512i = a32i;
#pragma unroll
        for (int k = 0; k < 4; ++k) { const float t0 = a512r * a512r - a512i * a512i, t1 = 2.f * a512r * a512i; a512r = t0; a512i = t1; }
        float xr = 0.f, xi = 0.f;
#pragma unroll
        for (int s2 = 0; s2 < 8; ++s2) if (s2 < sc) cmul_acc(xr, xi, a512r, a512i, psup[s2].x, psup[s2].y);
        if (half) {
#pragma unroll
            for (int k2 = 0; k2 < 8; ++k2) cmul_acc(xr, xi, a32r, a32i, ploc[k2].x, ploc[k2].y); }
        asm volatile("" : "+v"(xr), "+v"(xi) :: "memory");
        bf16x8 kt[16], ctf[4];
#pragma unroll
        for (int p = 0; p < 16; ++p) kt[p] = *(const bf16x8*)(KT + ((size_t)(g * 16 + p) * 64 + lane_) * 8);
#pragma unroll
        for (int sx = 0; sx < 4; ++sx) ctf[sx] = *(const bf16x8*)(CT + ((size_t)(g * 4 + sx) * 64 + lane_) * 8);
        f32x4_t apr[4][2];
#pragma unroll
        for (int sx = 0; sx < 4; ++sx) { const f32x4_t* ap = (const f32x4_t*)(apw + ((size_t)(g * 33 + row + 1) * 64 + 16 * sx + 4 * q) * 2); apr[sx][0] = ap[0]; apr[sx][1] = ap[1]; }
#pragma unroll 1
        for (int kk = 0; kk < 8; ++kk) {
            const size_t tok0 = tokA + (size_t)kk * 32;
            const f32x2_t xl = *(const f32x2_t*)(XLOC + (((size_t)b * 128 + 16 * sc + 8 * half + kk) * 16 + g) * 128 + 2 * n);
            *(LAS v4u*)(Ut + 1024 + lane_ * 16) = unext;
            if (kk < 7) unext = *(const v4u*)(P + (tok0 + 32 + (lane_ >> 1)) * PROJW + COL_S + g * 16 + 8 * (lane_ & 1));
            Xs[2 * n] = xr; Xs[2 * n + 1] = xi; Xs[128 + 2 * n] = a16r * xr - a16i * xi; Xs[128 + 2 * n + 1] = a16r * xi + a16i * xr;
#pragma unroll
            for (int tau = 0; tau < 2; ++tau) { f32x4_t acc = (f32x4_t){0.f, 0.f, 0.f, 0.f};
                const int ti = 16 * tau + row;
#pragma unroll
                for (int sx = 0; sx < 4; ++sx) { const LAS f32x4_t* xp = (const LAS f32x4_t*)(Xs + 128 * tau + 2 * (16 * sx + 4 * q)); const f32x4_t x01 = xp[0], x23 = xp[1];
                    const f32x4_t a01 = apr[sx][0], a23 = apr[sx][1];
                    v4u zw; zw.x = cvtpk(a01.x * x01.x - a01.y * x01.y, a01.x * x01.y + a01.y * x01.x); zw.y = cvtpk(a01.z * x01.z - a01.w * x01.w, a01.z * x01.w + a01.w * x01.z);
                    zw.z = cvtpk(a23.x * x23.x - a23.y * x23.y, a23.x * x23.y + a23.y * x23.x); zw.w = cvtpk(a23.z * x23.z - a23.w * x23.w, a23.z * x23.w + a23.w * x23.z);
                    acc = __builtin_amdgcn_mfma_f32_16x16x32_bf16(__builtin_bit_cast(bf16x8, zw), ctf[sx], acc, 0, 0, 0);
                    asm volatile("" ::: "memory"); }
#pragma unroll
                for (int p = 0; p < 16; ++p) if (p < 8 * tau + 8) { const bf16x8 ua = *(const LAS bf16x8*)(Ut + (32 + ti - 2 * p - (q >> 1)) * 32 + 16 * (q & 1));
                    acc = __builtin_amdgcn_mfma_f32_16x16x32_bf16(ua, kt[p], acc, 0, 0, 0); if ((p & 3) == 3) asm volatile("" ::: "memory"); }
#pragma unroll
                for (int r = 0; r < 4; ++r) { const int t2 = 16 * tau + 4 * q + r; const float uu = bf2f(*(const LAS bf16*)(Ut + (32 + t2) * 32 + 2 * row));
                    YG[(tok0 + t2) * 256 + g * 16 + row] = (bf16)f2bf(gelu_tanh_f(acc[r] + dsk * uu)); }
            }
            cmul_acc(xr, xi, a32r, a32i, xl.x, xl.y);
        }
    }
}
DI void mix_gating_mfma(Frame& F, const Args& A, int l, int variant = 0) {
    FRAME_IDS
    const bf16* P = (const bf16*)(F.ws + WS_PROJ); bf16* MIX = (bf16*)(F.ws + WS_MIXCAT);
    const bf16* GW = (const bf16*)(F.ws + WS_SSM2 + l * SSM2_LAYER + S2_GW);
    const float* lng = (const float*)A.in[I_GMLNG] + l * AW; const float* lnb = (const float*)A.in[I_GMLNB] + l * AW;
    const float* bs_ = (const float*)A.in[I_GMBS] + l * 4 * 128;
    LAS unsigned char* VT = F.lds + RING_OFF;
    const int ql = lane_ & 31, hi = lane_ >> 5, trq = (lane_ & 15) >> 2, trg = (lane_ >> 4) & 1, trp = lane_ & 3;
    for (int it = F.vcu; it < BATCH * (T / 128); it += F.G) {
        const int m0 = it * 128;
        __syncthreads();
        if (variant != 2) {
        v2u wv[16];
#pragma unroll
        for (int j = 0; j < 16; ++j) wv[j] = *(const v2u*)(P + (size_t)(m0 + wave_ + 8 * j) * PROJW + COL_V + 4 * lane_);
        const f32x4 gg = *(const f32x4*)(lng + 4 * lane_), bb = *(const f32x4*)(lnb + 4 * lane_);
#pragma unroll
        for (int j = 0; j < 16; ++j) { const int r = wave_ + 8 * j; const v2u w = wv[j];
            float v[4] = {gelu_tanh_f(bflo(w.x)), gelu_tanh_f(bfhi(w.x)), gelu_tanh_f(bflo(w.y)), gelu_tanh_f(bfhi(w.y))};
            const float mean = wave_sum(v[0] + v[1] + v[2] + v[3]) * (1.f / 256.f);
            float s2 = 0.f;
#pragma unroll
            for (int i = 0; i < 4; ++i) { v[i] -= mean; s2 += v[i] * v[i]; }
            const float rstd = 1.0f / sqrtf(wave_sum(s2) * (1.f / 256.f) + LN_EPS);
            v2u o; o.x = cvtpk(v[0] * rstd * gg.x + bb.x, v[1] * rstd * gg.y + bb.y); o.y = cvtpk(v[2] * rstd * gg.z + bb.z, v[3] * rstd * gg.w + bb.w);
            *(LAS v2u*)(VT + r * 512 + (((lane_ >> 1) ^ ((r & 3) << 2)) << 4) + 8 * (lane_ & 1)) = o;
        }
        }
        __syncthreads();
        if (variant == 1) continue;
        const int h = wave_ >> 1, cb = 64 * h + 32 * (wave_ & 1);
        const int chunk = (cb >> 3) + 2 * trg + (trp >> 1);
#pragma unroll
        for (int rt = 0; rt < 4; ++rt) {
            f32x16 acc;
#pragma unroll
            for (int i = 0; i < 16; ++i) acc[i] = 0.f;
            bf16x8 wa[8];
#pragma unroll
            for (int ks = 0; ks < 2 * rt + 2; ++ks) wa[ks] = *(const bf16x8*)(GW + ((size_t)h * 128 + 32 * rt + ql) * 128 + 16 * ks + 8 * hi);
#pragma unroll
            for (int ks = 0; ks < 2 * rt + 2; ++ks) {
                const int rlo = 16 * ks + 8 * hi + trq;
                const v4i16_t lo = __builtin_amdgcn_ds_read_tr16_b64_v4i16((LAS v4i16_t*)(VT + rlo * 512 + ((chunk ^ (trq << 2)) << 4) + 8 * (trp & 1)));
                const v4i16_t hh = __builtin_amdgcn_ds_read_tr16_b64_v4i16((LAS v4i16_t*)(VT + (rlo + 4) * 512 + ((chunk ^ (trq << 2)) << 4) + 8 * (trp & 1)));
                const bf16x8 va = (bf16x8){lo[0], lo[1], lo[2], lo[3], hh[0], hh[1], hh[2], hh[3]};
                acc = __builtin_amdgcn_mfma_f32_32x32x16_bf16(va, wa[ks], acc, 0, 0, 0); }
            { const int t = 32 * rt + ql; const float bsv = bs_[h * 128 + t];
              const bf16* up = P + (size_t)(m0 + t) * PROJW + COL_U + cb + 4 * hi; bf16* op = MIX + (size_t)(m0 + t) * D + cb + 4 * hi;
#pragma unroll
              for (int g4 = 0; g4 < 4; ++g4) { const v2u uw = *(const v2u*)(up + 8 * g4); v2u o;
                  o.x = cvtpk(gelu_tanh_f(bflo(uw.x)) * (acc[4 * g4] + bsv), gelu_tanh_f(bfhi(uw.x)) * (acc[4 * g4 + 1] + bsv)); o.y = cvtpk(gelu_tanh_f(bflo(uw.y)) * (acc[4 * g4 + 2] + bsv), gelu_tanh_f(bfhi(uw.y)) * (acc[4 * g4 + 3] + bsv));
                  *(v2u*)(op + 8 * g4) = o; } }
        }
    }
}

DI void p_glu(Frame& F, const Args& A, int l) {
    FRAME_IDS
    const bf16* YG = (const bf16*)(F.ws + WS_YG); bf16* MIX = (bf16*)(F.ws + WS_MIXCAT);
    const bf16* GluT = (const bf16*)(F.ws + WS_WSMALL + l * WSMALL_LAYER + WOFF_GLU); const float* gb = (const float*)A.in[I_GLUB] + l * 256;
    LAS unsigned char* Bs = F.lds + RING_OFF;
#pragma unroll
    for (int i = 0; i < 16; ++i) { const int idx = tid_ + 512 * i, n = idx >> 5, ch = idx & 31;
        *(LAS v4u*)(Bs + n * 512 + ((ch ^ (n & 15)) << 4)) = *(const v4u*)(GluT + (size_t)n * 256 + ch * 8); }
    __syncthreads();
    const int tk = lane_ & 15, q = lane_ >> 4;
    for (int rt = F.vcu; rt < M / 128; rt += F.G) {
        const size_t tok = (size_t)rt * 128 + wave_ * 16 + tk;
        bf16x8 yf[8];
#pragma unroll
        for (int ks = 0; ks < 8; ++ks) yf[ks] = *(const bf16x8*)(YG + tok * 256 + 32 * ks + 8 * q);
#pragma unroll 4
        for (int ct = 0; ct < 16; ++ct) {
            f32x4_t acc = {0.f, 0.f, 0.f, 0.f};
            const int n = 16 * ct + tk;
#pragma unroll
            for (int ks = 0; ks < 8; ++ks) { const bf16x8 wf = *(const LAS bf16x8*)(Bs + n * 512 + (((4 * ks + q) ^ (n & 15)) << 4));
                acc = __builtin_amdgcn_mfma_f32_16x16x32_bf16(wf, yf[ks], acc, 0, 0, 0); }
            const int n0 = 16 * ct + 4 * q; const v2u yw = *(const v2u*)(YG + tok * 256 + n0); const f32x4 bv = *(const f32x4*)(gb + n0);
            v2u o; o.x = cvtpk(bflo(yw.x) * sigmoid_f(acc[0] + bv.x), bfhi(yw.x) * sigmoid_f(acc[1] + bv.y)); o.y = cvtpk(bflo(yw.y) * sigmoid_f(acc[2] + bv.z), bfhi(yw.y) * sigmoid_f(acc[3] + bv.w));
            *(v2u*)(MIX + tok * D + 768 + n0) = o;
        }
    }
}
DI void mix_ssm_simple(Frame& F, const Args& A, int l) {
    FRAME_IDS
    const bf16* P = (const bf16*)(F.ws + WS_PROJ); bf16* YG = (bf16*)(F.ws + WS_YG);
    const float* tab = (const float*)(F.ws + WS_SSM) + (size_t)l * SSM_TAB;
    LAS float* fin = (LAS float*)(F.lds + RING_OFF);
    for (int it = F.vcu; it < BATCH * SSM_G; it += F.G) {
        const int b = it >> 4, g = it & 15, n = lane_, seg = wave_, gn = g * 64 + n;
        const float are = tab[gn], aim = tab[1024 + gn];
        float bre[16], bim[16], cre[16], cim[16];
#pragma unroll
        for (int c = 0; c < 16; ++c) { bre[c] = tab[2048 + gn * 16 + c]; bim[c] = tab[2048 + 16384 + gn * 16 + c];
            cre[c] = ((const float*)A.in[I_CRE])[(((size_t)l * 16 + g) * 16 + c) * 64 + n]; cim[c] = ((const float*)A.in[I_CIM])[(((size_t)l * 16 + g) * 16 + c) * 64 + n]; }
        const float dsk = ((const float*)A.in[I_SSMD])[(l * 16 + g) * 16 + (lane_ & 15)];
        const size_t mbase = (size_t)b * T + seg * 512;
        float xr = 0.f, xi = 0.f;
        for (int tt = 0; tt < 512; ++tt) { const v4u* up = (const v4u*)(P + (mbase + tt) * PROJW + COL_S + g * 16); const v4u u0 = up[0], u1 = up[1];
            const float u[16] = {bflo(u0.x), bfhi(u0.x), bflo(u0.y), bfhi(u0.y), bflo(u0.z), bfhi(u0.z), bflo(u0.w), bfhi(u0.w), bflo(u1.x), bfhi(u1.x), bflo(u1.y), bfhi(u1.y), bflo(u1.z), bfhi(u1.z), bflo(u1.w), bfhi(u1.w)};
            float br = 0.f, bi = 0.f;
#pragma unroll
            for (int c = 0; c < 16; ++c) { br += u[c] * bre[c]; bi += u[c] * bim[c]; }
            const float nr = are * xr - aim * xi + br, ni = are * xi + aim * xr + bi; xr = nr; xi = ni; }
        fin[(seg * 64 + n) * 2] = xr; fin[(seg * 64 + n) * 2 + 1] = xi;
        __syncthreads();
        float pr = are, pi = aim;
#pragma unroll
        for (int k = 0; k < 9; ++k) { const float t0 = pr * pr - pi * pi, t1 = 2.f * pr * pi; pr = t0; pi = t1; }
        xr = 0.f; xi = 0.f;
        for (int s = 0; s < seg; ++s) { const float fr_ = fin[(s * 64 + n) * 2], fi_ = fin[(s * 64 + n) * 2 + 1];
            const float nr = pr * xr - pi * xi + fr_, ni = pr * xi + pi * xr + fi_; xr = nr; xi = ni; }
        for (int tt = 0; tt < 512; ++tt) { const v4u* up = (const v4u*)(P + (mbase + tt) * PROJW + COL_S + g * 16); const v4u u0 = up[0], u1 = up[1];
            const float u[16] = {bflo(u0.x), bfhi(u0.x), bflo(u0.y), bfhi(u0.y), bflo(u0.z), bfhi(u0.z), bflo(u0.w), bfhi(u0.w), bflo(u1.x), bfhi(u1.x), bflo(u1.y), bfhi(u1.y), bflo(u1.z), bfhi(u1.z), bflo(u1.w), bfhi(u1.w)};
            float br = 0.f, bi = 0.f;
#pragma unroll
            for (int c = 0; c < 16; ++c) { br += u[c] * bre[c]; bi += u[c] * bim[c]; }
            const float nr = are * xr - aim * xi + br, ni = are * xi + aim * xr + bi; xr = nr; xi = ni;
            float ysel = 0.f, usel = 0.f;
#pragma unroll
            for (int c = 0; c < 16; ++c) { const float r = wave_sum(xr * cre[c] - xi * cim[c]); if ((lane_ & 15) == c) { ysel = r; usel = u[c]; } }
            if (lane_ < 16) { const float y = ysel + dsk * usel; YG[(mbase + tt) * 256 + g * 16 + lane_] = (bf16)f2bf(gelu_tanh_f(y)); } }
        __syncthreads();
    }
}

DI bool beats(float x, int i, float y, int j) { return x > y || (x == y && i < j); }
DI void p_row_b(Frame& F, const Args& A, int l, bool count = true) {
    FRAME_IDS
    const int gw = F.vcu * NWAVES + wave_, NGW = F.G * NWAVES;
    const bf16* PRE = (const bf16*)(F.ws + WS_PRE); bf16* X1 = (bf16*)(F.ws + WS_X1); bf16* XN = (bf16*)(F.ws + WS_XN);
    const float* mod = (const float*)(F.ws + WS_MOD) + (size_t)l * BATCH * 6 * D;
    const float* ln1g = (const float*)A.in[I_LN1G] + l * D; const float* ln1b = (const float*)A.in[I_LN1B] + l * D;
    const float* rw = (const float*)A.in[I_RW]; const float* rb = (const float*)A.in[I_RB];
    int* slot_a = (int*)(F.ws + WS_SLOT_A); float* slot_w = (float*)(F.ws + WS_SLOT_W);
    LAS float* rwS = (LAS float*)(F.lds + RING_OFF);
    volatile LAS unsigned* lcnt = (volatile LAS unsigned*)(F.lds + RING_OFF + 65536);
    LAS int* list_a = (LAS int*)(F.lds + RING_OFF + 66048); LAS float* list_w = (LAS float*)(F.lds + RING_OFF + 66048 + 8192);
    for (int i = tid_; i < D * NEXP; i += NTHR) rwS[(i & 15) * D + (i >> 4)] = rw[i];
    if (tid_ < 32) lcnt[tid_] = 0u;
    __syncthreads();
    const int hi5 = lane_ >> 5, b4 = (lane_ >> 4) & 1, b3 = (lane_ >> 3) & 1, b2 = (lane_ >> 2) & 1, emine = 8 * hi5 + 4 * b4 + 2 * b3 + b2;
    const int wi = 2 * b3 + b2, mygrp = 2 * hi5 + b4;
    const float rbm = rb[emine];
    Row16 lg1, lb1; row_load_f32(lg1, ln1g, lane_); row_load_f32(lb1, ln1b, lane_);
    v2u nraw[4];
    const int bq = gw / (NGW / BATCH), mbase = bq * T + gw % (NGW / BATCH), mstep = NGW / BATCH;
    const float* md = mod + (size_t)bq * 6 * D;
    Row16 msc, msh; row_load_f32(msc, md + 4 * D, lane_); row_load_f32(msh, md + 3 * D, lane_);
    { const v2u* q = (const v2u*)(PRE + (size_t)mbase * D);
#pragma unroll
      for (int k = 0; k < 4; ++k) nraw[k] = q[k * 64 + lane_]; }
    for (int m = mbase; m < (bq + 1) * T; m += mstep) {
        Row16 r;
#pragma unroll
        for (int k = 0; k < 4; ++k) { r.v[4 * k] = bflo(nraw[k].x); r.v[4 * k + 1] = bfhi(nraw[k].x); r.v[4 * k + 2] = bflo(nraw[k].y); r.v[4 * k + 3] = bfhi(nraw[k].y); }
        if (m + mstep < (bq + 1) * T) { const v2u* q = (const v2u*)(PRE + (size_t)(m + mstep) * D);
#pragma unroll
            for (int k = 0; k < 4; ++k) nraw[k] = q[k * 64 + lane_]; }
        row_ln(r);
#pragma unroll
        for (int i = 0; i < 16; ++i) r.v[i] = r.v[i] * lg1.v[i] + lb1.v[i];
        row_ln(r);
#pragma unroll
        for (int i = 0; i < 16; ++i) r.v[i] = r.v[i] * (1.0f + msc.v[i]) + msh.v[i];
        row_store_bf16(r, XN + (size_t)m * D, lane_);
        float lg[16];
#pragma unroll
        for (int e = 0; e < 16; ++e) { float a = 0.f;
#pragma unroll
            for (int k = 0; k < 4; ++k) { const f32x4 w4 = *(const LAS f32x4*)(rwS + e * D + 256 * k + 4 * lane_); a += r.v[4 * k] * w4.x + r.v[4 * k + 1] * w4.y + r.v[4 * k + 2] * w4.z + r.v[4 * k + 3] * w4.w; }
            lg[e] = a; }
        float t8[8], t4[4], t2[2];
#pragma unroll
        for (int i = 0; i < 8; ++i) { const float keep = hi5 ? lg[8 + i] : lg[i], give = hi5 ? lg[i] : lg[8 + i]; t8[i] = keep + __shfl_xor(give, 32); }
#pragma unroll
        for (int i = 0; i < 4; ++i) { const float keep = b4 ? t8[4 + i] : t8[i], give = b4 ? t8[i] : t8[4 + i]; t4[i] = keep + __shfl_xor(give, 16); }
#pragma unroll
        for (int i = 0; i < 2; ++i) { const float keep = b3 ? t4[2 + i] : t4[i], give = b3 ? t4[i] : t4[2 + i]; t2[i] = keep + __shfl_xor(give, 8); }
        float z = (b2 ? t2[1] : t2[0]) + __shfl_xor(b2 ? t2[0] : t2[1], 4);
        z += __shfl_xor(z, 2); z += __shfl_xor(z, 1);
        const float scm = 1.0f / (1.0f + __builtin_amdgcn_exp2f(-1.4426950408889634f * z)), a = scm + rbm;
        const float p4 = __shfl_xor(a, 4), p8 = __shfl_xor(a, 8), p12 = __shfl_xor(a, 12);
        const float hi01 = fmaxf(a, p4), lo01 = fminf(a, p4), hi23 = fmaxf(p8, p12), lo23 = fminf(p8, p12);
        const float gs = fmaxf(hi01, hi23) + fmaxf(fmaxf(lo01, lo23), fminf(hi01, hi23));
        const float g16 = __shfl_xor(gs, 16), g32 = __shfl_xor(gs, 32), g48 = __shfl_xor(gs, 48);
        const bool best = beats(gs, mygrp, g16, mygrp ^ 1) && beats(gs, mygrp, g32, mygrp ^ 2) && beats(gs, mygrp, g48, mygrp ^ 3);
        const int rank = (beats(p4, wi ^ 1, a, wi) ? 1 : 0) + (beats(p8, wi ^ 2, a, wi) ? 1 : 0) + (beats(p12, wi ^ 3, a, wi) ? 1 : 0);
        const bool sel = best && rank < 2;
        float tot = sel ? scm : 0.f; tot += __shfl_xor(tot, 4); tot += __shfl_xor(tot, 8);
        if (count && sel && (lane_ & 3) == 0) { const unsigned rk = atomicAdd((unsigned*)&lcnt[emine], 1u);
            list_a[emine * 128 + rk] = 2 * m + rank; list_w[emine * 128 + rk] = scm / tot; }
    }
    __syncthreads();
    if (count) {
        if (tid_ < 16) { const unsigned n = lcnt[tid_]; lcnt[16 + tid_] = n ? atomicAdd((unsigned*)(F.ctl + CW_CNT + l * 128 + tid_), n) : 0u; }
        __syncthreads();
        for (int idx = tid_; idx < 16 * 128; idx += NTHR) { const int e = idx >> 7, rk = idx & 127;
            if (rk < (int)lcnt[e]) { const size_t slot = (size_t)e * SLOT_CAP + lcnt[16 + e] + rk; slot_a[slot] = list_a[idx]; slot_w[slot] = list_w[idx]; } }
    }
}

DI void moe_tstart(Frame& F, int l) {
    FRAME_IDS
    volatile LAS int* ts = (volatile LAS int*)(F.lds + LDSCTL_OFF);
    __syncthreads();
    if (tid_ == 0) { int acc = 0;
        for (int e = 0; e < 16; ++e) { ts[e] = acc; const unsigned c = __hip_atomic_load(F.ctl + CW_CNT + l * 128 + e, RLX_AGENT); ts[32 + e] = (int)c; acc += (int)((c + 255u) >> 8); }
        ts[16] = acc; }
    __syncthreads();
}
DI void p_row_c(Frame& F, const Args& A, int l) {
    FRAME_IDS
    const int gw = F.vcu * NWAVES + wave_, NGW = F.G * NWAVES;
    const bf16* X1 = (const bf16*)(F.ws + WS_PRE); bf16* R2 = (bf16*)(F.ws + WS_ROWS2); bf16* XN = (bf16*)(F.ws + WS_XN);
    const float* ln1g = (const float*)A.in[I_LN1G] + l * D; const float* ln1b = (const float*)A.in[I_LN1B] + l * D;
    Row16 lg1, lb1; row_load_f32(lg1, ln1g, lane_); row_load_f32(lb1, ln1b, lane_);
    const float* mod = (const float*)(F.ws + WS_MOD) + (size_t)l * BATCH * 6 * D;
    const float* modn = (const float*)(F.ws + WS_MOD) + (size_t)(l + 1) * BATCH * 6 * D;
    const float* ln2g = (const float*)A.in[I_LN2G] + l * D; const float* ln2b = (const float*)A.in[I_LN2B] + l * D;
    Row16 lg2, lb2; row_load_f32(lg2, ln2g, lane_); row_load_f32(lb2, ln2b, lane_);
    v2u nx[4], n0[4], n1[4];
#define RC_LOAD(mm) do { const v2u* qa = (const v2u*)(X1 + (size_t)(mm) * D); const v2u* qb = (const v2u*)(R2 + (size_t)(2 * (mm)) * D); \
        _Pragma("unroll") for (int k = 0; k < 4; ++k) { nx[k] = __builtin_nontemporal_load(&qa[k * 64 + lane_]); n0[k] = __builtin_nontemporal_load(&qb[k * 64 + lane_]); n1[k] = __builtin_nontemporal_load(&qb[256 + k * 64 + lane_]); } } while (0)
    const int bq = gw / (NGW / BATCH), mbase = bq * T + gw % (NGW / BATCH), mstep = NGW / BATCH;
    const float* md = mod + (size_t)bq * 6 * D;
    Row16 gm; row_load_f32(gm, md + 5 * D, lane_);
    Row16 msc, msh;
    if (l != DEPTH - 1) { const float* mdn = modn + (size_t)bq * 6 * D; row_load_f32(msc, mdn + 1 * D, lane_); row_load_f32(msh, mdn + 0 * D, lane_); }
    RC_LOAD(mbase);
    for (int m = mbase; m < (bq + 1) * T; m += mstep) {
        Row16 x1, g2;
#pragma unroll
        for (int k = 0; k < 4; ++k) {
            x1.v[4 * k] = bflo(nx[k].x); x1.v[4 * k + 1] = bfhi(nx[k].x); x1.v[4 * k + 2] = bflo(nx[k].y); x1.v[4 * k + 3] = bfhi(nx[k].y);
            g2.v[4 * k] = bflo(n0[k].x) + bflo(n1[k].x); g2.v[4 * k + 1] = bfhi(n0[k].x) + bfhi(n1[k].x); g2.v[4 * k + 2] = bflo(n0[k].y) + bflo(n1[k].y); g2.v[4 * k + 3] = bfhi(n0[k].y) + bfhi(n1[k].y); }
        if (m + mstep < (bq + 1) * T) RC_LOAD(m + mstep);
        row_ln(x1);
#pragma unroll
        for (int i = 0; i < 16; ++i) x1.v[i] = ALPHA * (x1.v[i] * lg1.v[i] + lb1.v[i]) + (1.0f + gm.v[i]) * g2.v[i];
        row_ln(x1);
#pragma unroll
        for (int i = 0; i < 16; ++i) x1.v[i] = x1.v[i] * lg2.v[i] + lb2.v[i];
        if (l == DEPTH - 1) row_store_f32(x1, A.out + (size_t)m * D, lane_);
        else { row_store_bf16(x1, R2 + (size_t)(2 * m) * D, lane_);
            row_ln(x1);
#pragma unroll
            for (int i = 0; i < 16; ++i) x1.v[i] = x1.v[i] * (1.0f + msc.v[i]) + msh.v[i];
            row_store_bf16(x1, XN + (size_t)m * D, lane_); }
    }
#undef RC_LOAD
}

#ifndef PHMASK
#define PHMASK 0xFFFFFFFFu
#endif
#define IN(k) (lo <= (k) && (k) < hi && ((PHMASK >> (((k) == 0) ? 31 : (((k) - 1) % PH_PER_LAYER))) & 1u))
#define SEAM(k) do { if (IN((k) + 1) && MK_ONE_LAUNCH) xcd_barrier(bar); else __syncthreads(); } while (0)
constexpr int PH_PER_LAYER = 9, N_PHASES = 1 + DEPTH * PH_PER_LAYER;
#ifndef REP_PH
#define REP_PH -1
#endif
#define NREP(k) (((k) == REP_PH) ? 2 : 1)
template <int l> DI void layer_body(Frame& F, const Args& args, const XcdBarrier& bar, const int lo, const int hi) {
    unsigned char* ws = args.ws;

        const int pb = 1 + l * PH_PER_LAYER;
        const bf16* WinT = (const bf16*)(ws + WS_WSMALL + l * WSMALL_LAYER + WOFF_IN);
        const bf16* WoutT = (const bf16*)(ws + WS_WSMALL + l * WSMALL_LAYER + WOFF_OUT);
        const bf16* GluT = (const bf16*)(ws + WS_WSMALL + l * WSMALL_LAYER + WOFF_GLU);
        const float* modl = (const float*)(ws + WS_MOD) + (size_t)l * BATCH * 6 * D;
        if (l == 0 && IN(pb + 0)) { p_wconv(F, args, 0, 4); p_wconv(F, args, 1, 4); p_ln_a0(F, args); SEAM(pb + 0); }
        if (IN(pb + 1)) for (int rep_ = 0; rep_ < NREP(1); ++rep_) {
            pg8::Gemm g{(const bf16*)(ws + WS_XN), WinT, M, PROJW, D}; pg8::StaticOrder S; S.init(M, PROJW, F.G, (int)blockIdx.x);
            EpiInProj E{(bf16*)(ws + WS_PROJ), (const float*)(ws + WS_ROPE), args.pad};
            pg8::gemm_phase<EpiInProj, pg8::StaticOrder, PG8_ALIGN, PG8_SP2>(F.lds + RING_OFF, g, S, E);
            if (F.G == 256 && blockIdx.x >= 128) { __syncthreads(); p_wconv(F, args, l, 1); }
            SEAM(pb + 1); }
        if (IN(pb + 2)) for (int rep_ = 0; rep_ < NREP(2); ++rep_) {
#ifndef REP_SUB
#define REP_SUB -1
#endif
#define SUBREP(k) for (int rs_ = 0; rs_ < ((REP_SUB == (k)) ? 2 : 1); ++rs_)
            SUBREP(0) { mix_gating_mfma(F, args, l); __syncthreads(); }
#if REP_SUB >= 10 && REP_SUB < 20
            mix_gating_mfma(F, args, l, REP_SUB - 10); __syncthreads(); mix_gating_mfma(F, args, l); __syncthreads();
#endif
 SUBREP(1) { mix_ssm_in(F, l); } SUBREP(2) { mix_attn_mfma<0>(F, l); __syncthreads(); } SEAM(pb + 2); }
        if (IN(pb + 3)) for (int rep_ = 0; rep_ < NREP(3); ++rep_) { SUBREP(3) { mix_ssm_out(F, args, l); __syncthreads(); } SUBREP(4) { mix_attn_mfma<1>(F, l); __syncthreads(); } SEAM(pb + 3); }
        if (IN(pb + 4)) for (int rep_ = 0; rep_ < NREP(4); ++rep_) { p_glu(F, args, l); SEAM(pb + 4); }
        if (IN(pb + 5)) for (int rep_ = 0; rep_ < NREP(5); ++rep_) {
            pg8::Gemm g{(const bf16*)(ws + WS_MIXCAT), WoutT, M, D, D}; pg8::StaticOrder S; S.init(M, D, F.G, (int)blockIdx.x);
            if (l == 0) { EpiOut<true> E{(bf16*)(ws + WS_PRE), args.in[I_X], D, modl}; pg8::gemm_phase<EpiOut<true>, pg8::StaticOrder, PG8_ALIGN, PG8_SP2>(F.lds + RING_OFF, g, S, E); }
            else { EpiOut<false> E{(bf16*)(ws + WS_PRE), (const void*)(ws + WS_ROWS2), 2 * D, modl}; pg8::gemm_phase<EpiOut<false>, pg8::StaticOrder, PG8_ALIGN, PG8_SP2>(F.lds + RING_OFF, g, S, E); }
            SEAM(pb + 5); }
        if (IN(pb + 6)) { p_row_b(F, args, l); SUBREP(5) { if (REP_SUB == 5 && rs_ == 0) { __syncthreads(); p_row_b(F, args, l, false); } } SEAM(pb + 6); }
        if (IN(pb + 7)) { moe_tstart(F, l);
            gu32* dcnt = F.ctl + CW_DONE + l * 512;
            if (args.pad != 4)
            { pg8::Gemm g{(const bf16*)(ws + WS_XN), (const bf16*)(ws + WS_WGU), NSLOT_MAX, NEXP * 1024, D};
              MoeOrderK<0> S{(const volatile LAS int*)(F.lds + LDSCTL_OFF), F.G, (int)blockIdx.x, (const int*)(ws + WS_SLOT_A), (const float*)(ws + WS_SLOT_W), dcnt, F.ctl + CW_QUEUE + l * 128, (volatile LAS int*)(F.lds + LDSCTL_OFF + 256)}; EpiG1 E{(bf16*)(ws + WS_HID), args.pad};
              pg8::gemm_phase_g<EpiG1, MoeOrderK<0>, PG8_ALIGN, PG8_SP2, 0>(F.lds + RING_OFF, F.lds + GT_OFF, g, S, E); }
            if (args.pad != 3)
            { pg8::Gemm g{(const bf16*)(ws + WS_HID), (const bf16*)(ws + WS_WD), NSLOT_MAX, NEXP * 1024, DEXP};
              MoeOrderK<1> S{(const volatile LAS int*)(F.lds + LDSCTL_OFF), F.G, (int)blockIdx.x, (const int*)(ws + WS_SLOT_A), (const float*)(ws + WS_SLOT_W), dcnt, F.ctl + CW_QUEUE + l * 128, (volatile LAS int*)(F.lds + LDSCTL_OFF + 256)}; EpiG2 E{(bf16*)(ws + WS_ROWS2), args.pad};
              pg8::gemm_phase_g<EpiG2, MoeOrderK<1>, PG8_ALIGN, PG8_SP2, 0>(F.lds + RING_OFF, F.lds + GT_OFF, g, S, E); }
            SEAM(pb + 7); }
        if (IN(pb + 8)) { p_row_c(F, args, l); if (l == 0) { __syncthreads(); p_wconv(F, args, 1, 3); } SUBREP(6) { if (REP_SUB == 6 && rs_ == 0 && l == DEPTH - 1) { __syncthreads(); p_row_c(F, args, l); } } SEAM(pb + 8); }
    }
__global__ void __launch_bounds__(NTHR, 2) mk_fwd(Args args) {
    extern __shared__ __attribute__((aligned(16))) unsigned char lds[];
    Frame F;
    F.lds = (LAS unsigned char*)lds; F.MISC = (volatile LAS unsigned*)(F.lds + MISC_OFF);
    F.G = gridDim.x; { const int bx = blockIdx.x; F.vcu = (F.G % 8 == 0) ? (bx % 8) * (F.G / 8) + bx / 8 : bx; }
    F.ws = args.ws; F.ctl = (gu32*)(args.ws + WS_CTL);
    for (int u = ftid(); u < (LDS_BYTES - LDSCTL_OFF) / 4; u += NTHR) ((LAS unsigned*)(F.lds + LDSCTL_OFF))[u] = 0u;
    __syncthreads();
    XcdBarrier bar; bar.bar = (unsigned*)(F.ctl + CW_BAR); bar.x = 0; bar.st = nullptr;
    if (MK_ONE_LAUNCH) bar = xcd_barrier_post((unsigned*)(F.ctl + CW_BAR), F.MISC + 8);
    const int lo = args.ph_lo, hi = args.ph_hi;
    unsigned char* ws = args.ws; (void)ws;
    if (IN(0)) { p0_tables(F, args); __syncthreads(); p_wconv(F, args, 0, 0); p_wconv(F, args, 1, 2); SEAM(0); }
    layer_body<0>(F, args, bar, lo, hi);
    layer_body<1>(F, args, bar, lo, hi);
#ifdef EXTRA_BARS
    if (MK_ONE_LAUNCH) for (int xb_ = 0; xb_ < EXTRA_BARS; ++xb_) xcd_barrier(bar);
#endif
#undef IN
#undef SEAM
}

extern "C" void kernel_launch(void* const* d_in, const int* in_sizes, int n_in, void* d_out, int out_size, void* d_ws, size_t ws_size, hipStream_t stream) {
    static int grid = 0;
    if (grid == 0) {
        if (n_in != 30 || in_sizes[0] != M * D || out_size != M * D || ws_size < WS_END) { fprintf(stderr, "kernel_launch: unexpected shapes (n_in %d, in0 %d, out %d, ws %zu, need %zu)\n", n_in, n_in > 0 ? in_sizes[0] : -1, out_size, ws_size, (size_t)WS_END); grid = -1; return; }
        int dev = 0, cus = 0, per_cu = 0;
        if (hipGetDevice(&dev) != hipSuccess || hipDeviceGetAttribute(&cus, hipDeviceAttributeMultiprocessorCount, dev) != hipSuccess) { grid = -1; return; }
        if (hipFuncSetAttribute((const void*)mk_fwd, hipFuncAttributeMaxDynamicSharedMemorySize, LDS_BYTES) != hipSuccess) { fprintf(stderr, "kernel_launch: hipFuncSetAttribute failed\n"); grid = -1; return; }
        if (hipOccupancyMaxActiveBlocksPerMultiprocessor(&per_cu, (const void*)mk_fwd, NTHR, LDS_BYTES) != hipSuccess || per_cu < 1) fprintf(stderr, "kernel_launch: occupancy query says %d\n", per_cu);
        (void)hipGetLastError();
        grid = cus;
    }
    if (grid < 0) return;
    if (hipMemsetAsync((char*)d_ws + WS_CTL, 0, CTL_ZERO_BYTES, stream) != hipSuccess) return;
    Args a{};
    for (int i = 0; i < 30; ++i) a.in[i] = d_in[i];
    a.out = (float*)d_out; a.ws = (unsigned char*)d_ws;
#if MK_ONE_LAUNCH
    a.ph_lo = 0; a.ph_hi = N_PHASES; a.li = 0;
    hipLaunchKernelGGL(mk_fwd, dim3(grid), dim3(NTHR), LDS_BYTES, stream, a);
#else
#ifndef REP_GLOBAL
#define REP_GLOBAL -1
#endif
#ifndef PROBE_SKIP
#define PROBE_SKIP 1
#endif
#ifndef REP_COUNT
#define REP_COUNT 2
#endif
    for (int p = 0; p < N_PHASES; ++p) { a.ph_lo = p; a.ph_hi = p + 1; a.li = p;
        const int nrep = ((p == 0 ? 100 : (p - 1) % PH_PER_LAYER) == REP_GLOBAL) ? REP_COUNT : 1;
        for (int r = 0; r < nrep; ++r) { a.pad = r ? PROBE_SKIP : 0; hipLaunchKernelGGL(mk_fwd, dim3(grid), dim3(NTHR), LDS_BYTES, stream, a); } a.pad = 0; }
#endif
}
```

```cpp
#include <hip/hip_runtime.h>
#include <cstdio>
#include <cstdint>
namespace pg8 {
#define PG8_LAS __attribute__((address_space(3)))
typedef unsigned short bf16_t;
typedef short bf16x8 __attribute__((ext_vector_type(8)));
typedef float f32x4 __attribute__((ext_vector_type(4)));
typedef unsigned u32x4 __attribute__((ext_vector_type(4)));
constexpr int BM = 256, BK = 64, HALF = 128, HTB = HALF * BK * 2  , STAGE_BYTES = 8 * HTB, NXCD = 8, WGM = 8;

__host__ __device__ __forceinline__ int lds_byte(int r, int c) { const int st = (r >> 4) * 2 + (c >> 5), rr = r & 15, cc = c & 31, ob = rr * 64 + cc * 2; return st * 1024 + (ob ^ (((ob >> 9) & 1) << 5)); }
__host__ __device__ __forceinline__ void stage_rc(int b, int& R, int& C) { const int st = b / 1024, sb = b % 1024, swz = sb ^ (((sb >> 9) & 1) << 5); R = (st >> 1) * 16 + swz / 64; C = (st & 1) * 32 + (swz % 64) / 2; }
__host__ __device__ __forceinline__ int perm32(int rho) { const int n = rho >> 4, i = rho & 15; return 8 * (i >> 2) + 4 * n + (i & 3); }

struct Unit { int pm, pn; };
struct Gemm { const bf16_t* A; const bf16_t* Bt; int M, N, K; };

struct StaticOrder {
    int nM, nN, nwg, G, c;
    __host__ __device__ void init(int M, int N, int G_, int c_) { nM = M / BM; nN = N / BM; nwg = nM * nN; G = G_; c = c_; }
    __host__ __device__ bool next(int i, Unit& u) const {
        const long L = (long)i * G + c; if (L >= nwg) return false;
        int wgid = (int)L; { const int q = nwg / NXCD, r = nwg % NXCD, xcd = wgid % NXCD, off = wgid / NXCD; wgid = (xcd < r ? xcd * (q + 1) : r * (q + 1) + (xcd - r) * q) + off; }
        const int nig = WGM * nN, gid = wgid / nig, fm = gid * WGM, gsz = (nM - fm) < WGM ? (nM - fm) : WGM;
        u.pm = fm + ((wgid % nig) % gsz); u.pn = (wgid % nig) / gsz; return true;
    }
    __device__ __forceinline__ void a_ready(const Unit&) const {}
    __device__ __forceinline__ void done(const Unit&) const {}
};

__device__ __forceinline__ unsigned cvt_pk_bf16(float lo, float hi) { unsigned r; asm volatile("v_cvt_pk_bf16_f32 %0, %1, %2" : "=v"(r) : "v"(lo), "v"(hi)); return r; }
template <class Epi, class Sched, bool ALIGN_EPI = false, bool SP2 = false>
__device__ __forceinline__ void gemm_phase(PG8_LAS unsigned char* lds, const Gemm g, const Sched& S, const Epi& E) {
    const int tid = threadIdx.x, wid = __builtin_amdgcn_readfirstlane(tid >> 6), lane = tid & 63, wr = wid >> 2, wc = wid & 3, fr = lane & 15, fq = lane >> 4;
    const int K = g.K, nt = K / BK;
    unsigned voffA[2], voffB[2];
#pragma unroll
    for (int i = 0; i < 2; ++i) { int R, C; stage_rc(tid * 16 + i * 8192, R, C); const int Rb = Epi::PERM ? ((R & ~31) + perm32(R & 31)) : R;
        voffA[i] = (unsigned)(R * K + C) * 2u; voffB[i] = (unsigned)(Rb * K + C) * 2u; }
    const size_t kstep = (size_t)(BK * 2);
    const size_t hstep = (size_t)HALF * K * 2;
    const size_t tstep = 2 * hstep;
    const unsigned ldsw = (unsigned)wid * 1024u;
    const int aoff = lds_byte(wr * 64 + fr, fq * 8), boff = lds_byte(wc * 32 + fr, fq * 8);
#define PG8_SA(b, h) (((b) * 2 + (h)) * HTB)
#define PG8_SB(b, h) ((4 + (b) * 2 + (h)) * HTB)
#define PG8_STAGE(bufoff, gbase, voff) do { _Pragma("unroll") for (int _i = 0; _i < 2; ++_i) \
        __builtin_amdgcn_global_load_lds((const unsigned*)((const char*)(gbase) + (voff)[_i]), (PG8_LAS unsigned*)(lds + (bufoff) + ldsw + _i * 8192), 16, 0, 0); } while (0)
#define PG8_LDA(dst, b, h) do { _Pragma("unroll") for (int m = 0; m < 4; ++m) _Pragma("unroll") for (int k = 0; k < 2; ++k) dst[m][k] = *(const PG8_LAS bf16x8*)(lds + PG8_SA(b, h) + aoff + m * 2048 + k * 1024); } while (0)
#define PG8_LDB(dst, b, h) do { _Pragma("unroll") for (int n = 0; n < 2; ++n) _Pragma("unroll") for (int k = 0; k < 2; ++k) dst[n][k] = *(const PG8_LAS bf16x8*)(lds + PG8_SB(b, h) + boff + n * 2048 + k * 1024); } while (0)
#define PG8_MMA(ai, bj, At, Bt) do { __builtin_amdgcn_s_setprio(1); _Pragma("unroll") for (int m = 0; m < 4; ++m) _Pragma("unroll") for (int n = 0; n < 2; ++n) _Pragma("unroll") for (int k = 0; k < 2; ++k) \
        acc[ai][bj][m][n] = __builtin_amdgcn_mfma_f32_16x16x32_bf16(Bt[n][k], At[m][k], acc[ai][bj][m][n], 0, 0, 0); __builtin_amdgcn_s_setprio(0); } while (0)
#define PG8_WAIT_V(n) asm volatile("s_waitcnt vmcnt(" #n ")" ::: "memory")
#define PG8_WAIT_L(n) asm volatile("s_waitcnt lgkmcnt(" #n ")" ::: "memory")
#define PG8_BAR __builtin_amdgcn_s_barrier()
#define PG8_SCHED __builtin_amdgcn_sched_barrier(0)
    Unit cur, nxt; int ui = 0;
    if (!S.next(0, cur)) return;
    f32x4 acc[2][2][4][2];
#pragma unroll
    for (int a = 0; a < 2; ++a)
#pragma unroll
        for (int b = 0; b < 2; ++b)
#pragma unroll
            for (int m = 0; m < 4; ++m)
#pragma unroll
                for (int n = 0; n < 2; ++n) acc[a][b][m][n] = (f32x4){0.f, 0.f, 0.f, 0.f};
    bf16x8 At[4][2], B0[2][2], B1[2][2];
    const char* cA = (const char*)g.A + (size_t)cur.pm * tstep; const char* cB = (const char*)g.Bt + (size_t)cur.pn * tstep;
    S.a_ready(cur);
    if constexpr (SP2) {
        PG8_STAGE(PG8_SB(0, 0), cB, voffB); PG8_STAGE(PG8_SB(0, 1), cB + hstep, voffB); PG8_STAGE(PG8_SA(0, 0), cA, voffA); PG8_STAGE(PG8_SA(0, 1), cA + hstep, voffA);
        if (wr == 1) PG8_BAR;
        PG8_WAIT_V(2); PG8_BAR;
        PG8_STAGE(PG8_SB(1, 0), cB + kstep, voffB); PG8_STAGE(PG8_SA(1, 0), cA + kstep, voffA); PG8_STAGE(PG8_SB(1, 1), cB + hstep + kstep, voffB);
        PG8_WAIT_V(6); PG8_BAR;
    } else {
        PG8_STAGE(PG8_SB(0, 0), cB, voffB); PG8_STAGE(PG8_SA(0, 0), cA, voffA); PG8_STAGE(PG8_SB(0, 1), cB + hstep, voffB); PG8_STAGE(PG8_SA(0, 1), cA + hstep, voffA);
        if (wr == 1) PG8_BAR;
        PG8_WAIT_V(4); PG8_BAR;
        PG8_STAGE(PG8_SB(1, 0), cB + kstep, voffB); PG8_STAGE(PG8_SA(1, 0), cA + kstep, voffA); PG8_STAGE(PG8_SB(1, 1), cB + hstep + kstep, voffB);
        PG8_WAIT_V(6); PG8_BAR;
    }
    for (;;) {
        const bool has_next = S.next(ui + 1, nxt);
        const char* nA = has_next ? (const char*)g.A + (size_t)nxt.pm * tstep : cA; const char* nB = has_next ? (const char*)g.Bt + (size_t)nxt.pn * tstep : cB;
        for (int t = 0; t < nt; t += 2) {
            const bool last = (t == nt - 2);
            const char* a1 = cA + (size_t)(t + 1) * kstep;
            const char* a2 = last ? nA : cA + (size_t)(t + 2) * kstep; const char* b2 = last ? nB : cB + (size_t)(t + 2) * kstep;
            const char* a3 = a2 + kstep; const char* b3 = b2 + kstep;
            if (last && has_next) S.a_ready(nxt);
            if constexpr (SP2) {
            PG8_LDB(B0, 0, 0); PG8_LDB(B1, 0, 1); PG8_SCHED; PG8_LDA(At, 0, 0); PG8_STAGE(PG8_SA(1, 1), a1 + hstep, voffA);
            PG8_WAIT_V(8); PG8_WAIT_L(0); PG8_BAR; PG8_MMA(0, 0, At, B0); PG8_MMA(0, 1, At, B1); PG8_BAR; PG8_SCHED;
            PG8_LDA(At, 0, 1); PG8_STAGE(PG8_SB(0, 0), b2, voffB); PG8_STAGE(PG8_SB(0, 1), b2 + hstep, voffB); PG8_STAGE(PG8_SA(0, 0), a2, voffA);
            PG8_WAIT_V(8); PG8_WAIT_L(0); PG8_BAR; PG8_MMA(1, 0, At, B0); PG8_MMA(1, 1, At, B1); PG8_BAR; PG8_SCHED;
            PG8_LDB(B0, 1, 0); PG8_LDB(B1, 1, 1); PG8_SCHED; PG8_LDA(At, 1, 0); PG8_STAGE(PG8_SA(0, 1), a2 + hstep, voffA);
            PG8_WAIT_V(8); PG8_WAIT_L(0); PG8_BAR; PG8_MMA(0, 0, At, B0); PG8_MMA(0, 1, At, B1); PG8_BAR; PG8_SCHED;
            PG8_LDA(At, 1, 1); PG8_STAGE(PG8_SB(1, 0), b3, voffB); PG8_STAGE(PG8_SB(1, 1), b3 + hstep, voffB); PG8_STAGE(PG8_SA(1, 0), a3, voffA);
            PG8_WAIT_V(8); PG8_WAIT_L(0); PG8_BAR; PG8_MMA(1, 0, At, B0); PG8_MMA(1, 1, At, B1); PG8_BAR; PG8_SCHED;
            } else {
            PG8_LDB(B0, 0, 0); PG8_SCHED; PG8_LDA(At, 0, 0); PG8_STAGE(PG8_SA(1, 1), a1 + hstep, voffA);
            PG8_WAIT_L(8); PG8_BAR; PG8_WAIT_L(0); PG8_MMA(0, 0, At, B0); PG8_BAR; PG8_SCHED;
            PG8_LDB(B1, 0, 1); PG8_STAGE(PG8_SB(0, 0), b2, voffB);
            PG8_BAR; PG8_WAIT_L(0); PG8_MMA(0, 1, At, B1); PG8_BAR;
            PG8_LDA(At, 0, 1); PG8_STAGE(PG8_SA(0, 0), a2, voffA);
            PG8_BAR; PG8_WAIT_L(0); PG8_MMA(1, 0, At, B0); PG8_BAR; PG8_SCHED;
            PG8_STAGE(PG8_SB(0, 1), b2 + hstep, voffB);
            PG8_WAIT_V(6); PG8_BAR; PG8_MMA(1, 1, At, B1); PG8_BAR;
            PG8_LDB(B0, 1, 0); PG8_SCHED; PG8_LDA(At, 1, 0); PG8_STAGE(PG8_SA(0, 1), a2 + hstep, voffA);
            PG8_WAIT_L(8); PG8_BAR; PG8_WAIT_L(0); PG8_MMA(0, 0, At, B0); PG8_BAR; PG8_SCHED;
            PG8_LDB(B1, 1, 1); PG8_STAGE(PG8_SB(1, 0), b3, voffB);
            PG8_BAR; PG8_WAIT_L(0); PG8_MMA(0, 1, At, B1); PG8_BAR;
            PG8_LDA(At, 1, 1); PG8_STAGE(PG8_SA(1, 0), a3, voffA);
            PG8_BAR; PG8_WAIT_L(0); PG8_MMA(1, 0, At, B0); PG8_BAR; PG8_SCHED;
            PG8_STAGE(PG8_SB(1, 1), b3 + hstep, voffB);
            PG8_WAIT_V(6); PG8_BAR; PG8_MMA(1, 1, At, B1); PG8_BAR;
            }
        }
        if constexpr (ALIGN_EPI) { if (wr == 0) PG8_BAR; }
        if constexpr (!Epi::AFTER_DRAIN) { E(acc, cur, wr, wc, fr, fq); S.done(cur); }
        if (!has_next) break;
#pragma unroll
        for (int a = 0; a < 2; ++a)
#pragma unroll
            for (int b = 0; b < 2; ++b)
#pragma unroll
                for (int m = 0; m < 4; ++m)
#pragma unroll
                    for (int n = 0; n < 2; ++n) acc[a][b][m][n] = (f32x4){0.f, 0.f, 0.f, 0.f};
        cur = nxt; cA = nA; cB = nB; ++ui;
        if constexpr (ALIGN_EPI) { if (wr == 1) PG8_BAR; }
    }
    PG8_WAIT_V(0);
    if constexpr (!ALIGN_EPI) { if (wr == 0) PG8_BAR; }
    PG8_BAR;
    if constexpr (Epi::AFTER_DRAIN) { E.fused(acc, cur, wr, wc, fr, fq, lds, wid, lane); S.done(cur); }
#undef PG8_SA
#undef PG8_SB
#undef PG8_STAGE
#undef PG8_LDA
#undef PG8_LDB
#undef PG8_MMA
#undef PG8_WAIT_V
#undef PG8_WAIT_L
#undef PG8_BAR
#undef PG8_SCHED
}
template <class Epi, class Sched, bool ALIGN_EPI = false, bool SP2 = false, int AUXA = 0, bool FP8 = false>
__device__ __forceinline__ void gemm_phase_g(PG8_LAS unsigned char* lds, PG8_LAS unsigned char* gt, const Gemm g, const Sched& S, const Epi& E) {
    const int tid = threadIdx.x, wid = __builtin_amdgcn_readfirstlane(tid >> 6), lane = tid & 63, wr = wid >> 2, wc = wid & 3, fr = lane & 15, fq = lane >> 4;
    const int K = g.K, nt = K / BK;
    unsigned gpk0, voffB[2];
#pragma unroll
    for (int i = 0; i < 2; ++i) { int R, C; stage_rc(tid * 16 + i * 8192, R, C); const int Rb = Epi::PERM ? ((R & ~31) + perm32(R & 31)) : R;
        if (i == 0) gpk0 = (unsigned)(R * 4) | ((unsigned)(C * 2) << 16); voffB[i] = (unsigned)(Rb * K + C) * 2u; }
    int par = 0;
    const size_t kstep = (size_t)(BK * 2);
    const size_t hstep = (size_t)HALF * K * 2;
    const size_t tstep = 2 * hstep;
    const unsigned ldsw = (unsigned)wid * 1024u;
    const int aoff = lds_byte(wr * 64 + fr, fq * 8), boff = lds_byte(wc * 32 + fr, fq * 8);
#define PG8_SA(b, h) (((b) * 2 + (h)) * HTB)
#define PG8_SB(b, h) ((4 + (b) * 2 + (h)) * HTB)
#define PG8_STAGE(bufoff, gbase, voff) do { _Pragma("unroll") for (int _i = 0; _i < 2; ++_i) \
        __builtin_amdgcn_global_load_lds((const unsigned*)((const char*)(gbase) + (voff)[_i]), (PG8_LAS unsigned*)(lds + (bufoff) + ldsw + _i * 8192), 16, 0, 0); } while (0)
#define PG8_STAGE_A(bufoff, h, kbyte, PAR) do { _Pragma("unroll") for (int _i = 0; _i < 2; ++_i) { \
        const unsigned _vo = *(const PG8_LAS unsigned*)(gt + ((PAR) * 768 + (h) * 128 + _i * 64) * 4 + (gpk0 & 0xffffu)) + (gpk0 >> 16); \
        __builtin_amdgcn_global_load_lds((const unsigned*)((const char*)g.A + (size_t)(kbyte) + _vo), (PG8_LAS unsigned*)(lds + (bufoff) + ldsw + _i * 8192), 16, 0, AUXA); } } while (0)
#define PG8_FILL(u, PAR, PF, UI) do { S.wait_ready(u, tid, PF); if (tid < 256) { unsigned o_, a0_, a1_; S.finish_meta(u, tid, PF, o_, a0_, a1_); PG8_LAS unsigned* t_ = (PG8_LAS unsigned*)(gt + ((PAR) * 768 + tid) * 4); t_[0] = o_; t_[256] = a0_; t_[512] = a1_; } S.pull_publish(tid, PF, UI); asm volatile("s_waitcnt lgkmcnt(0)" ::: "memory"); __builtin_amdgcn_s_barrier(); asm volatile("" ::: "memory"); } while (0)
#define PG8_LDA(dst, b, h) do { if constexpr (FP8) { _Pragma("unroll") for (int m = 0; m < 4; ++m) { const PG8_LAS unsigned char* p_ = lds + PG8_SA(b, h) + aoff + m * 2048; \
            const i32x4_t lo_ = *(const PG8_LAS i32x4_t*)p_, hi_ = *(const PG8_LAS i32x4_t*)(p_ + 1024); dst##q[m] = __builtin_shufflevector(lo_, hi_, 0, 1, 2, 3, 4, 5, 6, 7); } } \
        else { _Pragma("unroll") for (int m = 0; m < 4; ++m) _Pragma("unroll") for (int k = 0; k < 2; ++k) dst[m][k] = *(const PG8_LAS bf16x8*)(lds + PG8_SA(b, h) + aoff + m * 2048 + k * 1024); } } while (0)
#define PG8_LDB(dst, b, h) do { if constexpr (FP8) { _Pragma("unroll") for (int n = 0; n < 2; ++n) { const PG8_LAS unsigned char* p_ = lds + PG8_SB(b, h) + boff + n * 2048; \
            const i32x4_t lo_ = *(const PG8_LAS i32x4_t*)p_, hi_ = *(const PG8_LAS i32x4_t*)(p_ + 1024); dst##q[n] = __builtin_shufflevector(lo_, hi_, 0, 1, 2, 3, 4, 5, 6, 7); } } \
        else { _Pragma("unroll") for (int n = 0; n < 2; ++n) _Pragma("unroll") for (int k = 0; k < 2; ++k) dst[n][k] = *(const PG8_LAS bf16x8*)(lds + PG8_SB(b, h) + boff + n * 2048 + k * 1024); } } while (0)
#define PG8_MMA(ai, bj, At, Bt) do { __builtin_amdgcn_s_setprio(1); \
        if constexpr (FP8) { _Pragma("unroll") for (int m = 0; m < 4; ++m) _Pragma("unroll") for (int n = 0; n < 2; ++n) { const int o_ = 8 * m + 4 * n; \
                f32x4 c_ = {accq[ai][bj][o_], accq[ai][bj][o_ + 1], accq[ai][bj][o_ + 2], accq[ai][bj][o_ + 3]}; \
                c_ = __builtin_amdgcn_mfma_scale_f32_16x16x128_f8f6f4(Bt##q[n], At##q[m], c_, 0, 0, 0, 0x7f7f7f7f, 0, 0x7f7f7f7f); \
                accq[ai][bj][o_] = c_[0]; accq[ai][bj][o_ + 1] = c_[1]; accq[ai][bj][o_ + 2] = c_[2]; accq[ai][bj][o_ + 3] = c_[3]; } } \
        else { _Pragma("unroll") for (int m = 0; m < 4; ++m) _Pragma("unroll") for (int n = 0; n < 2; ++n) _Pragma("unroll") for (int k = 0; k < 2; ++k) \
            acc[ai][bj][m][n] = __builtin_amdgcn_mfma_f32_16x16x32_bf16(Bt[n][k], At[m][k], acc[ai][bj][m][n], 0, 0, 0); } \
        __builtin_amdgcn_s_setprio(0); } while (0)
#define PG8_WAIT_V(n) asm volatile("s_waitcnt vmcnt(" #n ")" ::: "memory")
#define PG8_WAIT_L(n) asm volatile("s_waitcnt lgkmcnt(" #n ")" ::: "memory")
#define PG8_BAR __builtin_amdgcn_s_barrier()
#define PG8_SCHED __builtin_amdgcn_sched_barrier(0)
    Unit cur, nxt; int ui = 0;
    if (!__builtin_amdgcn_readfirstlane((int)S.first(cur))) return;
    cur.pm = __builtin_amdgcn_readfirstlane(cur.pm); cur.pn = __builtin_amdgcn_readfirstlane(cur.pn);
    f32x4 acc[2][2][4][2];
    typedef float f32x32_t __attribute__((ext_vector_type(32)));
    f32x32_t accq[2][2];
    if constexpr (FP8) { accq[0][0] = (f32x32_t)(0.f); accq[0][1] = (f32x32_t)(0.f); accq[1][0] = (f32x32_t)(0.f); accq[1][1] = (f32x32_t)(0.f); } (void)accq;
#pragma unroll
    for (int a = 0; a < 2; ++a)
#pragma unroll
        for (int b = 0; b < 2; ++b)
#pragma unroll
            for (int m = 0; m < 4; ++m)
#pragma unroll
                for (int n = 0; n < 2; ++n) acc[a][b][m][n] = (f32x4){0.f, 0.f, 0.f, 0.f};
    typedef int v8i_t __attribute__((ext_vector_type(8))); typedef int i32x4_t __attribute__((ext_vector_type(4)));
    bf16x8 At[4][2], B0[2][2], B1[2][2]; v8i_t Atq[4], B0q[2], B1q[2];
    (void)At; (void)B0; (void)B1; (void)Atq; (void)B0q; (void)B1q;
    const char* cB = (const char*)g.Bt + (size_t)cur.pn * tstep;
    typename Sched::Pf pf; S.prefetch(cur, tid, pf); PG8_FILL(cur, 0, pf, -1);
    Unit pend; bool has_pend = false;
    if constexpr (SP2) {
        PG8_STAGE(PG8_SB(0, 0), cB, voffB); PG8_STAGE(PG8_SB(0, 1), cB + hstep, voffB); PG8_STAGE_A(PG8_SA(0, 0), 0, 0, par); PG8_STAGE_A(PG8_SA(0, 1), 1, 0, par);
        if (wr == 1) PG8_BAR;
        PG8_WAIT_V(2); PG8_BAR;
        PG8_STAGE(PG8_SB(1, 0), cB + kstep, voffB); PG8_STAGE_A(PG8_SA(1, 0), 0, kstep, par); PG8_STAGE(PG8_SB(1, 1), cB + hstep + kstep, voffB);
        PG8_WAIT_V(6); PG8_BAR;
    } else {
        PG8_STAGE(PG8_SB(0, 0), cB, voffB); PG8_STAGE_A(PG8_SA(0, 0), 0, 0, par); PG8_STAGE(PG8_SB(0, 1), cB + hstep, voffB); PG8_STAGE_A(PG8_SA(0, 1), 1, 0, par);
        if (wr == 1) PG8_BAR;
        PG8_WAIT_V(4); PG8_BAR;
        PG8_STAGE(PG8_SB(1, 0), cB + kstep, voffB); PG8_STAGE_A(PG8_SA(1, 0), 0, kstep, par); PG8_STAGE(PG8_SB(1, 1), cB + hstep + kstep, voffB);
        PG8_WAIT_V(6); PG8_BAR;
    }
    for (;;) {
        const bool has_next = __builtin_amdgcn_readfirstlane((int)S.more(ui + 1, nxt)) != 0;
        nxt.pm = __builtin_amdgcn_readfirstlane(nxt.pm); nxt.pn = __builtin_amdgcn_readfirstlane(nxt.pn);
        if (has_next) { S.prefetch(nxt, tid, pf); S.pull_issue(tid, pf); }
        const char* nB = has_next ? (const char*)g.Bt + (size_t)nxt.pn * tstep : cB;
#pragma unroll 1
        for (int t = 0; t < nt; t += 2) {
            const bool last = (t == nt - 2);
            const char* b2 = last ? nB : cB + (size_t)(t + 2) * kstep;
            const char* b3 = b2 + kstep;
            if (last && has_next) PG8_FILL(nxt, par ^ 1, pf, ui);
            const size_t kA2 = last ? (size_t)0 : (size_t)(t + 2) * kstep; const int pA2 = (last && has_next) ? (par ^ 1) : par;
            if constexpr (SP2) {
            PG8_LDB(B0, 0, 0); PG8_LDB(B1, 0, 1); PG8_SCHED; PG8_LDA(At, 0, 0); PG8_STAGE_A(PG8_SA(1, 1), 1, (size_t)(t + 1) * kstep, par);
            PG8_WAIT_V(8); PG8_WAIT_L(0); PG8_BAR; PG8_MMA(0, 0, At, B0); PG8_MMA(0, 1, At, B1); PG8_BAR; PG8_SCHED;
            PG8_LDA(At, 0, 1); PG8_STAGE(PG8_SB(0, 0), b2, voffB); PG8_STAGE(PG8_SB(0, 1), b2 + hstep, voffB); PG8_STAGE_A(PG8_SA(0, 0), 0, kA2, pA2);
            PG8_WAIT_V(8); PG8_WAIT_L(0); PG8_BAR; PG8_MMA(1, 0, At, B0); PG8_MMA(1, 1, At, B1); PG8_BAR; PG8_SCHED;
            PG8_LDB(B0, 1, 0); PG8_LDB(B1, 1, 1); PG8_SCHED; PG8_LDA(At, 1, 0); PG8_STAGE_A(PG8_SA(0, 1), 1, kA2, pA2);
            PG8_WAIT_V(8); PG8_WAIT_L(0); PG8_BAR; PG8_MMA(0, 0, At, B0); PG8_MMA(0, 1, At, B1); PG8_BAR; PG8_SCHED;
            PG8_LDA(At, 1, 1); PG8_STAGE(PG8_SB(1, 0), b3, voffB); PG8_STAGE(PG8_SB(1, 1), b3 + hstep, voffB); PG8_STAGE_A(PG8_SA(1, 0), 0, kA2 + kstep, pA2);
            PG8_WAIT_V(8); PG8_WAIT_L(0); PG8_BAR; PG8_MMA(1, 0, At, B0); PG8_MMA(1, 1, At, B1); PG8_BAR; PG8_SCHED;
            } else {
            PG8_LDB(B0, 0, 0); PG8_SCHED; PG8_LDA(At, 0, 0); PG8_STAGE_A(PG8_SA(1, 1), 1, (size_t)(t + 1) * kstep, par);
            PG8_WAIT_L(8); PG8_BAR; PG8_WAIT_L(0); PG8_MMA(0, 0, At, B0); PG8_BAR; PG8_SCHED;
            PG8_LDB(B1, 0, 1); PG8_STAGE(PG8_SB(0, 0), b2, voffB);
            PG8_BAR; PG8_WAIT_L(0); PG8_MMA(0, 1, At, B1); PG8_BAR;
            PG8_LDA(At, 0, 1); PG8_STAGE_A(PG8_SA(0, 0), 0, kA2, pA2);
            PG8_BAR; PG8_WAIT_L(0); PG8_MMA(1, 0, At, B0); PG8_BAR; PG8_SCHED;
            PG8_STAGE(PG8_SB(0, 1), b2 + hstep, voffB);
            PG8_WAIT_V(6); PG8_BAR; PG8_MMA(1, 1, At, B1); PG8_BAR;
            PG8_LDB(B0, 1, 0); PG8_SCHED; PG8_LDA(At, 1, 0); PG8_STAGE_A(PG8_SA(0, 1), 1, kA2, pA2);
            PG8_WAIT_L(8); PG8_BAR; PG8_WAIT_L(0); PG8_MMA(0, 0, At, B0); PG8_BAR; PG8_SCHED;
            PG8_LDB(B1, 1, 1); PG8_STAGE(PG8_SB(1, 0), b3, voffB);
            PG8_BAR; PG8_WAIT_L(0); PG8_MMA(0, 1, At, B1); PG8_BAR;
            PG8_LDA(At, 1, 1); PG8_STAGE_A(PG8_SA(1, 0), 0, kA2 + kstep, pA2);
            PG8_BAR; PG8_WAIT_L(0); PG8_MMA(1, 0, At, B0); PG8_BAR; PG8_SCHED;
            PG8_STAGE(PG8_SB(1, 1), b3 + hstep, voffB);
            PG8_WAIT_V(6); PG8_BAR; PG8_MMA(1, 1, At, B1); PG8_BAR;
            }
        }
        if constexpr (ALIGN_EPI) { if (wr == 0) PG8_BAR; }
        if constexpr (FP8) {
#pragma unroll
            for (int a = 0; a < 2; ++a)
#pragma unroll
                for (int b = 0; b < 2; ++b)
#pragma unroll
                    for (int m = 0; m < 4; ++m)
#pragma unroll
                        for (int n = 0; n < 2; ++n) { const int o_ = 8 * m + 4 * n; acc[a][b][m][n] = (f32x4){accq[a][b][o_], accq[a][b][o_ + 1], accq[a][b][o_ + 2], accq[a][b][o_ + 3]}; }
        }
        if constexpr (!Epi::AFTER_DRAIN) { if (has_pend) S.done_nowait(pend);     E(acc, cur, wr, wc, fr, fq, (const PG8_LAS unsigned*)(gt + par * 3072)); pend = cur; has_pend = true; }
        if (!has_next) break;
#pragma unroll
        for (int a = 0; a < 2; ++a)
#pragma unroll
            for (int b = 0; b < 2; ++b)
#pragma unroll
                for (int m = 0; m < 4; ++m)
#pragma unroll
                    for (int n = 0; n < 2; ++n) acc[a][b][m][n] = (f32x4){0.f, 0.f, 0.f, 0.f};
        if constexpr (FP8) { accq[0][0] = (f32x32_t)(0.f); accq[0][1] = (f32x32_t)(0.f); accq[1][0] = (f32x32_t)(0.f); accq[1][1] = (f32x32_t)(0.f); }
        cur = nxt; cB = nB; ++ui; par ^= 1;
        if constexpr (ALIGN_EPI) { if (wr == 1) PG8_BAR; }
    }
    PG8_WAIT_V(0);
    if constexpr (!ALIGN_EPI) { if (wr == 0) PG8_BAR; }
    PG8_BAR;
    if (has_pend) S.done_nowait(pend);
#undef PG8_SA
#undef PG8_SB
#undef PG8_STAGE
#undef PG8_STAGE_A
#undef PG8_FILL
#undef PG8_LDA
#undef PG8_LDB
#undef PG8_MMA
#undef PG8_WAIT_V
#undef PG8_WAIT_L
#undef PG8_BAR
#undef PG8_SCHED
}
}

#ifndef PG8_SP2
#define PG8_SP2 true
#endif
#ifndef PG8_ALIGN
#define PG8_ALIGN true
#endif
#ifndef MK_ONE_LAUNCH
#define MK_ONE_LAUNCH 1
#endif

constexpr int NWAVES = 8, NTHR = 512;
constexpr int BATCH = 8, T = 4096, D = 1024, M = BATCH * T, DEPTH = 2;
constexpr int PROJW = 2304, AW = 256, BW = 512, CW = 256, NH = 8, HD = 64;
constexpr int COL_U = 0, COL_V = 256, COL_Q = 512, COL_K = 1024, COL_VA = 1536, COL_S = 2048;
constexpr int NEXP = 16, DEXP = 512, NGRP = 4;
constexpr int SSM_G = 16, SSM_N = 64, SSM_C = 16;
constexpr float LN_EPS = 1e-5f;
constexpr float ALPHA = 1.41421356237309515f;
constexpr float QSCALE = 0.125f * 1.4426950408889634f;
constexpr int NSLOT_MAX = 2 * M + NEXP * 256;

constexpr size_t MiB = 1u << 20;
constexpr size_t WS_CTL = 0, CTL_ZERO_BYTES = 1 * MiB;
constexpr size_t WS_MOD = 1 * MiB;
constexpr size_t WS_ROPE = WS_MOD + 512 * 1024;
constexpr size_t WS_SSM = WS_ROPE + 2 * MiB;
constexpr int SSM_TAB = 2 * 1024 + 2 * 16384;
constexpr int SLOT_CAP = 32768;
constexpr size_t WS_SLOT_A = 4 * MiB;
constexpr size_t WS_WSMALL = 6 * MiB;
constexpr size_t WSMALL_LAYER = 7 * MiB, WOFF_IN = 0, WOFF_OUT = (size_t)PROJW * D * 2, WOFF_GLU = WOFF_OUT + (size_t)D * D * 2;
constexpr size_t WS_WGU = 20 * MiB;
constexpr size_t WS_WD = 52 * MiB;
constexpr size_t WS_XN = 68 * MiB;
constexpr size_t WS_YG = 132 * MiB;
constexpr size_t WS_R = 148 * MiB;
constexpr size_t WS_PROJ = WS_R, WS_MIXCAT = WS_R + 144 * MiB, WS_PRE = WS_R, WS_HID = WS_R + 64 * MiB, WS_X1 = WS_R + 132 * MiB;
constexpr size_t WS_ROWS2 = 356 * MiB;
constexpr size_t WS_STAT = 356 * MiB + (size_t)2 * M * D * 2;
constexpr size_t WS_SSM2 = WS_STAT + 4 * MiB;
constexpr size_t SSM2_LAYER = 3 * MiB, S2_APW = 0, S2_KT = 288 * 1024, S2_CT = S2_KT + 256 * 1024, S2_WIN = S2_CT + 64 * 1024, S2_GW = S2_WIN + 2 * MiB;
static_assert(S2_GW + 4 * 128 * 128 * 2 <= SSM2_LAYER, "ssm2 tables");
constexpr size_t WS_XLOC = WS_SSM2 + 2 * SSM2_LAYER;
constexpr size_t WS_XSUP = WS_XLOC + 8 * MiB;
constexpr size_t WS_SLOT_W = WS_XSUP + 512 * 1024;
constexpr size_t WS_CINV = WS_SLOT_W + 2 * MiB;
constexpr size_t WS_END = WS_CINV + 256 * 1024;
static_assert(WOFF_GLU + 256 * 256 * 2 <= WSMALL_LAYER && WS_WSMALL + 2 * WSMALL_LAYER <= WS_WGU, "ws map");
static_assert(WS_SSM + 2 * SSM_TAB * 4 <= WS_SLOT_A && WS_HID + (size_t)NSLOT_MAX * DEXP * 2 <= WS_X1 && WS_X1 + (size_t)M * D * 2 <= WS_ROWS2, "ws map 2");
constexpr int CW_TMO = 0;
constexpr int CW_BAR = 4096;
constexpr int CW_CNT = 8192;
constexpr int CW_QUEUE = 11264;
constexpr int CW_DONE = 12288;

constexpr int RING_OFF = 0, RING_BYTES = 131072;
constexpr int ATT_STAGE_OFF = 98304;
constexpr int LDSCTL_OFF = 135168, MISC_OFF = LDSCTL_OFF + 320;
constexpr int GT_OFF = LDSCTL_OFF + 1024;
constexpr int LDS_BYTES = 147456;

#define GAS __attribute__((address_space(1)))
#define LAS __attribute__((address_space(3)))
#define DI __device__ __forceinline__
typedef unsigned short bf16;
typedef unsigned v4u __attribute__((ext_vector_type(4)));
typedef unsigned v2u __attribute__((ext_vector_type(2)));
typedef float f32x4 __attribute__((ext_vector_type(4)));
typedef short bf16x8 __attribute__((ext_vector_type(8)));
typedef GAS unsigned gu32;
#define RLX_AGENT __ATOMIC_RELAXED, __HIP_MEMORY_SCOPE_AGENT
#define LDS_WAIT() asm volatile("s_waitcnt lgkmcnt(0)" ::: "memory")
#define VM_WAIT() asm volatile("s_waitcnt vmcnt(0)" ::: "memory")
DI unsigned f2bf(float f) { unsigned u = __builtin_bit_cast(unsigned, f); return (u + 0x7fffu + ((u >> 16) & 1u)) >> 16; }
DI unsigned pk2(float lo, float hi) { return f2bf(lo) | (f2bf(hi) << 16); }
DI float bflo(unsigned w) { return __uint_as_float(w << 16); }
DI float bfhi(unsigned w) { return __uint_as_float(w & 0xffff0000u); }
DI float bf2f(bf16 h) { return __uint_as_float((unsigned)h << 16); }
template <int CTRL> DI float dpp_mov(float v) { return __builtin_bit_cast(float, __builtin_amdgcn_update_dpp(0, __builtin_bit_cast(int, v), CTRL, 0xf, 0xf, true)); }
DI float rdlane(float v, int l) { return __builtin_bit_cast(float, __builtin_amdgcn_readlane(__builtin_bit_cast(int, v), l)); }
DI float wave_sum(float v) {
    v += dpp_mov<0xB1>(v); v += dpp_mov<0x4E>(v); v += dpp_mov<0x141>(v); v += dpp_mov<0x140>(v);
    return (rdlane(v, 0) + rdlane(v, 16)) + (rdlane(v, 32) + rdlane(v, 48));
}
DI void st16_wt(void* p, v4u v) { asm volatile("global_store_dwordx4 %0, %1, off sc1\n\ts_nop 1" :: "v"(p), "v"(v) : "memory"); }
DI float wave_max(float v) {
    v = fmaxf(v, dpp_mov<0xB1>(v)); v = fmaxf(v, dpp_mov<0x4E>(v)); v = fmaxf(v, dpp_mov<0x141>(v)); v = fmaxf(v, dpp_mov<0x140>(v));
    return fmaxf(fmaxf(rdlane(v, 0), rdlane(v, 16)), fmaxf(rdlane(v, 32), rdlane(v, 48)));
}
DI unsigned pk4_fp8(float a, float b, float c, float d) { int w = __builtin_amdgcn_cvt_pk_fp8_f32(a, b, 0, false); w = __builtin_amdgcn_cvt_pk_fp8_f32(c, d, w, true); return (unsigned)w; }
DI float fast_rcp(float x) { return __builtin_amdgcn_rcpf(x); }
DI float sigmoid_f(float x) { return fast_rcp(1.0f + __builtin_amdgcn_exp2f(-1.4426950408889634f * x)); }
DI float silu_f(float x) { return x * sigmoid_f(x); }
DI float gelu_tanh_f(float x) { const float z2 = 1.5957691216057308f * (x + 0.044715f * x * x * x); return x * sigmoid_f(z2); }

#define XB_TMO      128
#define XB_XCNT(j)  (256  + 64 * (j))
#define XB_XSUB(j)  (1280 + 64 * (j))
#define XB_XGEN(j)  (2304 + 64 * (j))
#define XB_TOP      3328
#define XB_TOPGEN   3392
#define XCD_BAR_WORDS 3456
#define XB_SPIN_CAP (1u << 22)
DI unsigned xb_ld(unsigned* p)              { return __hip_atomic_load(p, __ATOMIC_RELAXED, __HIP_MEMORY_SCOPE_AGENT); }
DI unsigned xb_add(unsigned* p, unsigned v) { return __hip_atomic_fetch_add(p, v, __ATOMIC_RELAXED, __HIP_MEMORY_SCOPE_AGENT); }
DI unsigned xb_xcc_id() { return (unsigned)__builtin_amdgcn_s_getreg((3 << 11) | 20) & 0xFu; }
#define XB_SPIN(cond, bar) do { unsigned _sp = 0; while (cond) { __builtin_amdgcn_s_sleep(1); \
    if ((++_sp & 255u) == 0u) { if (xb_ld(&(bar)[XB_TMO])) break; if (_sp > XB_SPIN_CAP) { atomicAdd(&(bar)[XB_TMO], 1u); break; } } } } while (0)
struct XcdBarrier { unsigned* bar; unsigned x; volatile LAS unsigned* st; };
DI XcdBarrier xcd_barrier_post(unsigned* bar, volatile LAS unsigned* st) {
    XcdBarrier b; b.bar = bar; b.x = xb_xcc_id(); b.st = st;
    if (threadIdx.x == 0) (void)xb_add(&bar[XB_XCNT(b.x)], 1u);
    return b;
}
DI void xcd_barrier_complete(unsigned* bar, unsigned x, unsigned& nloc, unsigned& nx) {
    const unsigned G = gridDim.x * gridDim.y * gridDim.z;
    unsigned sum, cnt, mine, sp = 0u;
    for (;;) {
        sum = 0u; cnt = 0u; mine = 0u;
#pragma unroll
        for (unsigned j = 0; j < 16; ++j) { const unsigned c = xb_ld(&bar[XB_XCNT(j)]); sum += c; cnt += (c > 0u) ? 1u : 0u; mine = (j == x) ? c : mine; }
        if (sum == G) break;
        __builtin_amdgcn_s_sleep(1);
        if ((++sp & 255u) == 0u) { if (xb_ld(&bar[XB_TMO])) break; if (sp > XB_SPIN_CAP) { atomicAdd(&bar[XB_TMO], 1u); break; } }
    }
    nloc = mine > 0u ? mine : 1u; nx = cnt > 0u ? cnt : 1u;
}
DI void xcd_barrier(const XcdBarrier& b) {
    asm volatile("s_waitcnt vmcnt(0)" ::: "memory");
    __syncthreads();
    if (threadIdx.x == 0) {
        unsigned* bar = b.bar;
        __builtin_amdgcn_s_waitcnt(0);
        unsigned nloc = b.st[0], nx = b.st[1];
        if (nloc == 0u) { xcd_barrier_complete(bar, b.x, nloc, nx); b.st[0] = nloc; b.st[1] = nx; }
        const unsigned old = xb_add(&bar[XB_XSUB(b.x)], 1u);
        const unsigned gen = old / nloc;
        if (old + 1u == (gen + 1u) * nloc) {
            __builtin_amdgcn_fence(__ATOMIC_RELEASE, "agent");
            asm volatile("s_waitcnt vmcnt(0)" ::: "memory");
            const unsigned og = xb_add(&bar[XB_TOP], 1u);
            const unsigned tg = og / nx;
            if (og + 1u == (tg + 1u) * nx) xb_add(&bar[XB_TOPGEN], 1u);
            else XB_SPIN(xb_ld(&bar[XB_TOPGEN]) == tg, bar);
            __builtin_amdgcn_fence(__ATOMIC_ACQUIRE, "agent");
            xb_add(&bar[XB_XGEN(b.x)], 1u);
            asm volatile("s_waitcnt vmcnt(0)" ::: "memory");
        } else {
            XB_SPIN(xb_ld(&bar[XB_XGEN(b.x)]) == gen, bar);
            __builtin_amdgcn_fence(__ATOMIC_ACQUIRE, "agent");
            asm volatile("s_waitcnt vmcnt(0)" ::: "memory");
        }
    }
    __syncthreads();
}

struct Args { const void* in[30]; float* out; unsigned char* ws; int ph_lo, ph_hi, li, pad; };
enum { I_X = 0, I_C, I_POS, I_ADAW, I_ADAB, I_WIN, I_GMLNG, I_GMLNB, I_GMWS, I_GMBS, I_LAMRE, I_LAMIM, I_LOGDT, I_BRE, I_BIM, I_CRE, I_CIM, I_SSMD,
       I_GLUW, I_GLUB, I_WOUT, I_LN1G, I_LN1B, I_RW, I_RB, I_EWG, I_EWU, I_EWD, I_LN2G, I_LN2B };
struct Frame {
    LAS unsigned char* lds;
    volatile LAS unsigned* MISC;
    gu32* ctl;
    unsigned char* ws;
    int vcu, G;
};
DI int ftid() { int t = threadIdx.x; asm volatile("" : "+v"(t)); return t; }
#define FRAME_IDS const int tid_ = ftid(), lane_ = tid_ & 63, wave_ = __builtin_amdgcn_readfirstlane(tid_ >> 6); (void)lane_; (void)wave_;

template <class RowMap>
DI void transpose_item(const float* W, int K, int N, bf16* WT, const RowMap& rm, LAS float* scr, int item, int lane) {
    const int nblk = N / 32, kb = item / nblk, nb = item % nblk, k0 = 64 * kb, n0 = 32 * nb;
#pragma unroll 8
    for (int i = 0; i < 32; ++i) { const int kk = 2 * i + (lane >> 5); scr[kk * 33 + (lane & 31)] = W[(size_t)(k0 + kk) * N + n0 + (lane & 31)]; }
    LDS_WAIT(); asm volatile("" ::: "memory");
    const int c = lane & 7;
#pragma unroll
    for (int j = 0; j < 4; ++j) { const int n = (lane >> 3) + 8 * j; const LAS float* s = scr + (8 * c) * 33 + n;
        const float qs = (RowMap::SCALEQ && (n0 + n) >= COL_Q && (n0 + n) < COL_K) ? QSCALE : 1.0f;
        v4u o; o.x = pk2(s[0 * 33] * qs, s[1 * 33] * qs); o.y = pk2(s[2 * 33] * qs, s[3 * 33] * qs); o.z = pk2(s[4 * 33] * qs, s[5 * 33] * qs); o.w = pk2(s[6 * 33] * qs, s[7 * 33] * qs);
        *(GAS v4u*)(WT + (size_t)rm(n0 + n) * K + k0 + 8 * c) = o; }
    LDS_WAIT(); asm volatile("" ::: "memory");
}
struct RmIdent { static constexpr bool SCALEQ = false; int off; DI int operator()(int n) const { return off + n; } };
struct RmWin { static constexpr bool SCALEQ = true; DI int operator()(int n) const {
        if (n >= COL_Q && n < COL_VA) { const int d = n & 63; if (d < 16) return (n - d) + 2 * (d & 7) + (d >> 3); }
        return n; } };
struct RmGU { static constexpr bool SCALEQ = false; int e, up; DI int operator()(int n) const { return e * 1024 + (n >> 7) * 256 + (n & 127) + up * 128; } };

DI void p0_tables(Frame& F, const Args& A) {
    FRAME_IDS
    const float* c = (const float*)A.in[I_C];
    LAS float* condS = (LAS float*)(F.lds + RING_OFF);
    LAS float* red = (LAS float*)(F.lds + RING_OFF + 32768);
    for (int i = tid_; i < BATCH * D; i += NTHR) condS[i] = silu_f(c[i]);
    __syncthreads();
    float* mod = (float*)(F.ws + WS_MOD);
    for (int it = F.vcu; it < DEPTH * 96; it += F.G) {
        const int l = it / 96, jb = it % 96, ks = tid_ >> 6, jj = tid_ & 63, j = jb * 64 + jj;
        const float* w = (const float*)A.in[I_ADAW] + (size_t)l * D * 6 * D + j;
        float acc[8];
#pragma unroll
        for (int b = 0; b < 8; ++b) acc[b] = 0.f;
#pragma unroll 16
        for (int k = ks * 128; k < ks * 128 + 128; ++k) { const float wv = w[(size_t)k * (6 * D)];
#pragma unroll
            for (int b = 0; b < 8; ++b) acc[b] += condS[b * D + k] * wv; }
#pragma unroll
        for (int b = 0; b < 8; ++b) red[(ks * 8 + b) * 64 + jj] = acc[b];
        __syncthreads();
        { const int b = tid_ >> 6; float s = ((const float*)A.in[I_ADAB])[l * 6 * D + j];
#pragma unroll
          for (int k2 = 0; k2 < 8; ++k2) s += red[(k2 * 8 + b) * 64 + jj];
          mod[((size_t)l * BATCH + b) * 6 * D + j] = s; }
        __syncthreads();
    }
    const int gt = F.vcu * NTHR + tid_, NGT = F.G * NTHR;
    const int* pos = (const int*)A.in[I_POS]; float* rope = (float*)(F.ws + WS_ROPE);
    for (int w = gt; w < M * 8; w += NGT) { const int m = w >> 3, i = w & 7;
        const float freq = exp2f(-(float)i * 0.125f * 18.931568569324174f);
        const float ang = (float)pos[m] * freq; float s, cs; sincosf(ang, &s, &cs);
        rope[m * 16 + i] = cs; rope[m * 16 + 8 + i] = s; }
    for (int w = gt; w < DEPTH * 16 * 33 * 64; w += NGT) { const int n = w & 63, m = (w >> 6) % 33, g = ((w >> 6) / 33) & 15, l = (w >> 6) / (33 * 16);
        const int li = (l * 16 + g) * 64 + n;
        const float lre = ((const float*)A.in[I_LAMRE])[li], lim = ((const float*)A.in[I_LAMIM])[li], dt = expf(((const float*)A.in[I_LOGDT])[l * 16 + g]);
        const float mag = expf((float)m * (lre * dt)); float sn, cs; sincosf((float)m * (lim * dt), &sn, &cs);
        float* apw = (float*)(F.ws + WS_SSM2 + l * SSM2_LAYER + S2_APW) + ((size_t)(g * 33 + m) * 64 + n) * 2; apw[0] = mag * cs; apw[1] = mag * sn; }
    for (int w = gt; w < DEPTH * SSM_G * SSM_N; w += NGT) { const int l = w / 1024, gn = w % 1024, g = gn >> 6;
        float* tab = (float*)(F.ws + WS_SSM) + (size_t)l * SSM_TAB;
        const float lre = ((const float*)A.in[I_LAMRE])[w], lim = ((const float*)A.in[I_LAMIM])[w];
        const float dt = expf(((const float*)A.in[I_LOGDT])[l * 16 + g]);
        const float mag = expf(lre * dt); float sn, cs; sincosf(lim * dt, &sn, &cs);
        const float are = mag * cs, aim = mag * sn, nr = are - 1.0f, ni = aim, mod2 = lre * lre + lim * lim;
        const float fre = (nr * lre + ni * lim) / mod2, fim = (ni * lre - nr * lim) / mod2;
        tab[gn] = are; tab[1024 + gn] = aim;
        const float* bre = (const float*)A.in[I_BRE] + (size_t)w * 16; const float* bim = (const float*)A.in[I_BIM] + (size_t)w * 16;
#pragma unroll
        for (int cc = 0; cc < 16; ++cc) { tab[2048 + gn * 16 + cc] = fre * bre[cc] - fim * bim[cc]; tab[2048 + 16384 + gn * 16 + cc] = fre * bim[cc] + fim * bre[cc]; } }
}

DI void p_wconv(Frame& F, const Args& A, int l, int part) {
    FRAME_IDS
    if (part == 4) {
        const int gt = F.vcu * NTHR + tid_, NGT = F.G * NTHR;
        const float* tab = (const float*)(F.ws + WS_SSM) + (size_t)l * SSM_TAB;
        const float* apw = (const float*)(F.ws + WS_SSM2 + l * SSM2_LAYER + S2_APW);
        const float* cre = (const float*)A.in[I_CRE] + (size_t)l * 16 * 16 * 64; const float* cim = (const float*)A.in[I_CIM] + (size_t)l * 16 * 16 * 64;
        bf16* KT = (bf16*)(F.ws + WS_SSM2 + l * SSM2_LAYER + S2_KT); bf16* CT = (bf16*)(F.ws + WS_SSM2 + l * SSM2_LAYER + S2_CT);
        bf16* WIN = (bf16*)(F.ws + WS_SSM2 + l * SSM2_LAYER + S2_WIN); bf16* GW = (bf16*)(F.ws + WS_SSM2 + l * SSM2_LAYER + S2_GW);
        for (int w = gt; w < 16 * 16 * 64 * 8; w += NGT) { const int j = w & 7, ln = (w >> 3) & 63, p = (w >> 9) & 15, g = w >> 13;
            const int co = ln & 15, q = ln >> 4, m = 2 * p + (q >> 1), ci = 8 * (q & 1) + j; float acc = 0.f;
            for (int n = 0; n < 64; ++n) { const int gn = g * 64 + n; const float ar = apw[((g * 33 + m) * 64 + n) * 2], ai = apw[((g * 33 + m) * 64 + n) * 2 + 1];
                const float br = tab[2048 + gn * 16 + ci], bi = tab[2048 + 16384 + gn * 16 + ci], tre = ar * br - ai * bi, tim = ar * bi + ai * br;
                acc += cre[(g * 16 + co) * 64 + n] * tre - cim[(g * 16 + co) * 64 + n] * tim; }
            KT[w] = (bf16)f2bf(acc); }
        for (int w = gt; w < 16 * 4 * 64 * 8; w += NGT) { const int j = w & 7, ln = (w >> 3) & 63, sx = (w >> 9) & 3, g = w >> 11;
            const int co = ln & 15, q = ln >> 4, n = 16 * sx + 4 * q + (j >> 1);
            CT[w] = (bf16)f2bf((j & 1) ? -cim[(g * 16 + co) * 64 + n] : cre[(g * 16 + co) * 64 + n]); }
        for (int w = gt; w < 16 * 16 * 8 * 64 * 8; w += NGT) { const int jj = w & 7, ln = (w >> 3) & 63, ct = (w >> 9) & 7, sp = (w >> 12) & 15, g = w >> 16;
            const int cc = ln & 15, q = ln >> 4, n = 8 * ct + (cc >> 1), part = cc & 1, tj = 2 * sp + (q >> 1), ci = 8 * (q & 1) + jj, gn = g * 64 + n, m = 31 - tj;
            const float ar = apw[((g * 33 + m) * 64 + n) * 2], ai = apw[((g * 33 + m) * 64 + n) * 2 + 1], br = tab[2048 + gn * 16 + ci], bi = tab[2048 + 16384 + gn * 16 + ci];
            WIN[w] = (bf16)f2bf(part ? (ar * bi + ai * br) : (ar * br - ai * bi)); }
        const float* gws = (const float*)A.in[I_GMWS] + (size_t)l * 4 * 128 * 128;
        for (int w = gt; w < 4 * 128 * 128; w += NGT) { const int sx = w & 127, t = (w >> 7) & 127; GW[w] = (bf16)f2bf(sx <= t ? gws[w] : 0.f); }
    }
}
constexpr int WC_NS = 16 * 72 + 16 * 32 + 4 * 8, WC_ND = 16 * 256, WC_NW = WC_NS + WC_ND;
DI void p_wconv_items(Frame& F, const Args& A, int l, int lo, int hi) {
    FRAME_IDS
    LAS float* scr = (LAS float*)(F.lds + RING_OFF + wave_ * 16384);
    bf16* WinT = (bf16*)(F.ws + WS_WSMALL + l * WSMALL_LAYER + WOFF_IN);
    bf16* WoutT = (bf16*)(F.ws + WS_WSMALL + l * WSMALL_LAYER + WOFF_OUT);
    bf16* GluT = (bf16*)(F.ws + WS_WSMALL + l * WSMALL_LAYER + WOFF_GLU);
    bf16* WdT = (bf16*)(F.ws + WS_WD);
    constexpr int I_IN = 16 * 72, I_OUTW = 16 * 32, I_GLU = 4 * 8;
    for (int it = lo + F.vcu * NWAVES + wave_; it < hi; it += F.G * NWAVES) {
        int r = it;
        if (r < I_IN) { transpose_item((const float*)A.in[I_WIN] + (size_t)l * D * PROJW, D, PROJW, WinT, RmWin{}, scr, r, lane_); continue; } r -= I_IN;
        if (r < I_OUTW) { transpose_item((const float*)A.in[I_WOUT] + (size_t)l * D * D, D, D, WoutT, RmIdent{0}, scr, r, lane_); continue; } r -= I_OUTW;
        if (r < I_GLU) { transpose_item((const float*)A.in[I_GLUW] + (size_t)l * 256 * 256, 256, 256, GluT, RmIdent{0}, scr, r, lane_); continue; } r -= I_GLU;
        { const int e = r >> 8; transpose_item((const float*)A.in[I_EWD] + ((size_t)l * NEXP + e) * D * DEXP, DEXP, D, WdT, RmIdent{e * 1024}, scr, r & 255, lane_); }
    }
}
constexpr int WC_NGU = 16 * 2 * 16;
DI void p_wconv_gu(Frame& F, const Args& A, int l, int first, int stride, int hi) {
    FRAME_IDS
    LAS float* scr = (LAS float*)(F.lds + RING_OFF + wave_ * 16384);
    LAS float* red = (LAS float*)(F.lds + RING_OFF + 12288);
    unsigned char* W8 = (unsigned char*)(F.ws + WS_WGU);
    float* cinv = (float*)(F.ws + WS_CINV) + (size_t)l * 16 * 2 * 512;
    for (int j = first; j < hi; j += stride) { const int e = j >> 5, up = (j >> 4) & 1, n0 = 32 * (j & 15), k0 = 128 * wave_;
        const float* W = (const float*)A.in[up ? I_EWU : I_EWG] + ((size_t)l * NEXP + e) * D * DEXP + (size_t)(k0 + (lane_ >> 5)) * DEXP + n0 + (lane_ & 31);
        float v[64]; float mx = 0.f;
#pragma unroll
        for (int i = 0; i < 64; ++i) v[i] = W[(size_t)(2 * i) * DEXP];
#pragma unroll
        for (int i = 0; i < 64; ++i) mx = fmaxf(mx, fabsf(v[i]));
        red[wave_ * 4096 + lane_] = mx;
        __syncthreads();
        float m2 = 0.f;
#pragma unroll
        for (int w2 = 0; w2 < 8; ++w2) m2 = fmaxf(m2, fmaxf(red[w2 * 4096 + (lane_ & 31)], red[w2 * 4096 + 32 + (lane_ & 31)]));
        const bool z = !(m2 > 0.f); const float sc = z ? 1.0f : 440.0f / m2;
        if (tid_ < 32) cinv[(e * 2 + up) * 512 + n0 + tid_] = z ? 1.0f : m2 / 440.0f;
        const RmGU rm{e, up}; const int c = lane_ & 7;
#pragma unroll
        for (int t = 0; t < 2; ++t) {
#pragma unroll
            for (int i = 0; i < 32; ++i) scr[(2 * i + (lane_ >> 5)) * 33 + (lane_ & 31)] = v[32 * t + i] * sc;
            LDS_WAIT(); asm volatile("" ::: "memory");
#pragma unroll
            for (int jj = 0; jj < 4; ++jj) { const int n = (lane_ >> 3) + 8 * jj; const LAS float* sp = scr + (8 * c) * 33 + n;
                v2u o; o.x = pk4_fp8(sp[0 * 33], sp[1 * 33], sp[2 * 33], sp[3 * 33]); o.y = pk4_fp8(sp[4 * 33], sp[5 * 33], sp[6 * 33], sp[7 * 33]);
                *(GAS v2u*)(W8 + (size_t)rm(n0 + n) * D + k0 + 64 * t + 8 * c) = o; }
            LDS_WAIT(); asm volatile("" ::: "memory");
        }
        __syncthreads();
    }
}

typedef float f32x2_t __attribute__((ext_vector_type(2)));
typedef __bf16 bf16x2_t __attribute__((ext_vector_type(2)));
DI unsigned cvtpk(float lo, float hi) { f32x2_t v = {lo, hi}; bf16x2_t b = __builtin_convertvector(v, bf16x2_t); return __builtin_bit_cast(unsigned, b); }
struct Row16 { float v[16]; };
DI void row_load_f32(Row16& r, const float* p, int lane) {
    const f32x4* q = (const f32x4*)p;
#pragma unroll
    for (int k = 0; k < 4; ++k) { const f32x4 a = q[k * 64 + lane]; r.v[4 * k] = a.x; r.v[4 * k + 1] = a.y; r.v[4 * k + 2] = a.z; r.v[4 * k + 3] = a.w; }
}
DI void row_load_f32_nt(Row16& r, const float* p, int lane) {
    const f32x4* q = (const f32x4*)p;
#pragma unroll
    for (int k = 0; k < 4; ++k) { const f32x4 a = __builtin_nontemporal_load(&q[k * 64 + lane]); r.v[4 * k] = a.x; r.v[4 * k + 1] = a.y; r.v[4 * k + 2] = a.z; r.v[4 * k + 3] = a.w; }
}
DI void row_load_bf16(Row16& r, const bf16* p, int lane) {
    const v2u* q = (const v2u*)p;
#pragma unroll
    for (int k = 0; k < 4; ++k) { const v2u a = q[k * 64 + lane]; r.v[4 * k] = bflo(a.x); r.v[4 * k + 1] = bfhi(a.x); r.v[4 * k + 2] = bflo(a.y); r.v[4 * k + 3] = bfhi(a.y); }
}
DI void row_store_bf16(const Row16& r, bf16* p, int lane) {
    v2u* q = (v2u*)p;
#pragma unroll
    for (int k = 0; k < 4; ++k) { v2u o; o.x = cvtpk(r.v[4 * k], r.v[4 * k + 1]); o.y = cvtpk(r.v[4 * k + 2], r.v[4 * k + 3]); q[k * 64 + lane] = o; }
}
DI void row_store_f32(const Row16& r, float* p, int lane) {
    f32x4* q = (f32x4*)p;
#pragma unroll
    for (int k = 0; k < 4; ++k) __builtin_nontemporal_store((f32x4){r.v[4 * k], r.v[4 * k + 1], r.v[4 * k + 2], r.v[4 * k + 3]}, &q[k * 64 + lane]);
}
DI void row_ln(Row16& r) {
    float s = 0.f;
#pragma unroll
    for (int i = 0; i < 16; ++i) s += r.v[i];
    const float mean = wave_sum(s) * (1.f / D); float s2 = 0.f;
#pragma unroll
    for (int i = 0; i < 16; ++i) { r.v[i] -= mean; s2 += r.v[i] * r.v[i]; }
    const float rstd = 1.0f / sqrtf(wave_sum(s2) * (1.f / D) + LN_EPS);
#pragma unroll
    for (int i = 0; i < 16; ++i) r.v[i] *= rstd;
}
DI void row_mod(Row16& r, const float* a, const float* b, int lane) {
    Row16 av, bv; row_load_f32(av, a, lane); row_load_f32(bv, b, lane);
#pragma unroll
    for (int i = 0; i < 16; ++i) r.v[i] = r.v[i] * (1.0f + av.v[i]) + bv.v[i];
}
DI void row_affine(Row16& r, const float* g, const float* b, int lane) {
    Row16 av, bv; row_load_f32(av, g, lane); row_load_f32(bv, b, lane);
#pragma unroll
    for (int i = 0; i < 16; ++i) r.v[i] = r.v[i] * av.v[i] + bv.v[i];
}

DI void p_ln_a0(Frame& F, const Args& A) {
    FRAME_IDS
    const int gw = F.vcu * NWAVES + wave_, NGW = F.G * NWAVES;
    const float* x = (const float*)A.in[I_X]; bf16* XN = (bf16*)(F.ws + WS_XN); const float* mod = (const float*)(F.ws + WS_MOD);
    const int bq = gw / (NGW / BATCH), mbase = bq * T + gw % (NGW / BATCH), mstep = NGW / BATCH;
    const float* md = mod + (size_t)bq * 6 * D;
    Row16 msc, msh; row_load_f32(msc, md + 1 * D, lane_); row_load_f32(msh, md + 0 * D, lane_);
    Row16 nx; row_load_f32_nt(nx, x + (size_t)mbase * D, lane_);
    for (int m = mbase; m < (bq + 1) * T; m += mstep) {
        Row16 r = nx; if (m + mstep < (bq + 1) * T) row_load_f32_nt(nx, x + (size_t)(m + mstep) * D, lane_);
        row_ln(r);
#pragma unroll
        for (int i = 0; i < 16; ++i) r.v[i] = r.v[i] * (1.0f + msc.v[i]) + msh.v[i];
        row_store_bf16(r, XN + (size_t)m * D, lane_); }
}

using pg8::Unit; using pg8::BM; using pg8::HALF;
struct EpiInProj {
    static constexpr bool PERM = true, AFTER_DRAIN = false;
    bf16* P; const float* rope; int skip;
    DI void operator()(const pg8::f32x4 (&acc)[2][2][4][2], const Unit& u, int wr, int wc, int fr, int fq) const {
        if (skip == 1) { if (acc[0][0][0][0][0] == 12345.678f) P[0] = 1; return; }
        const int row0 = u.pm * BM + wr * 64 + fr, pn = u.pn;
        const bool isrope = (pn >= 2 && pn <= 5), dorope = isrope && ((wc & 1) == 0) && (fq < 2);
#pragma unroll
        for (int ai = 0; ai < 2; ++ai)
#pragma unroll
            for (int m = 0; m < 4; ++m) { const int row = row0 + ai * HALF + m * 16; bf16* rowp = P + (size_t)row * PROJW + pn * BM + wc * 32 + 8 * fq;
                f32x4 cs = (f32x4){1.f, 1.f, 1.f, 1.f}, sn = (f32x4){0.f, 0.f, 0.f, 0.f};
                if (isrope) { const float* rp = rope + (size_t)row * 16 + 4 * (fq & 1); cs = *(const f32x4*)rp; sn = *(const f32x4*)(rp + 8); }
#pragma unroll
                for (int bj = 0; bj < 2; ++bj) { pg8::f32x4 v0 = acc[ai][bj][m][0], v1 = acc[ai][bj][m][1];
                    if (isrope) {
                        if (dorope) { const float a0 = v0[0] * cs.x - v0[1] * sn.x, b0 = v0[1] * cs.x + v0[0] * sn.x, a1 = v0[2] * cs.y - v0[3] * sn.y, b1 = v0[3] * cs.y + v0[2] * sn.y;
                            const float a2 = v1[0] * cs.z - v1[1] * sn.z, b2 = v1[1] * cs.z + v1[0] * sn.z, a3 = v1[2] * cs.w - v1[3] * sn.w, b3 = v1[3] * cs.w + v1[2] * sn.w;
                            v0 = (pg8::f32x4){a0, b0, a1, b1}; v1 = (pg8::f32x4){a2, b2, a3, b3}; }
                    }
                    pg8::u32x4 w; w.x = pg8::cvt_pk_bf16(v0[0], v0[1]); w.y = pg8::cvt_pk_bf16(v0[2], v0[3]); w.z = pg8::cvt_pk_bf16(v1[0], v1[1]); w.w = pg8::cvt_pk_bf16(v1[2], v1[3]);
                    if (skip == 2) { asm volatile("" :: "v"(w.x), "v"(w.y), "v"(w.z), "v"(w.w)); } else *(pg8::u32x4*)(rowp + bj * HALF) = w; } }
    }
};
template <bool XF32> struct EpiOut {
    static constexpr bool PERM = true, AFTER_DRAIN = false;
    bf16* PRE; const void* x; int xpitch; const float* mod;
    DI void operator()(const pg8::f32x4 (&acc)[2][2][4][2], const Unit& u, int wr, int wc, int fr, int fq) const {
        const int row0 = u.pm * BM + wr * 64 + fr, b = (u.pm * BM) / T, colb = u.pn * BM + wc * 32 + 8 * fq;
        const float* g1 = mod + (size_t)b * 6 * D + 2 * D;
        pg8::f32x4 gv[2][2];
#pragma unroll
        for (int bj = 0; bj < 2; ++bj) { gv[bj][0] = *(const pg8::f32x4*)(g1 + colb + bj * HALF) + 1.0f; gv[bj][1] = *(const pg8::f32x4*)(g1 + colb + bj * HALF + 4) + 1.0f; }
#pragma unroll
        for (int ai = 0; ai < 2; ++ai)
#pragma unroll
            for (int m = 0; m < 4; ++m) { const int row = row0 + ai * HALF + m * 16;
#pragma unroll
                for (int bj = 0; bj < 2; ++bj) { const int col = colb + bj * HALF; pg8::f32x4 x0, x1;
                    if (XF32) { const float* xp = (const float*)x + (size_t)row * xpitch + col; x0 = *(const pg8::f32x4*)xp; x1 = *(const pg8::f32x4*)(xp + 4); }
                    else { const pg8::u32x4 xw = *(const pg8::u32x4*)((const bf16*)x + (size_t)row * xpitch + col);
                        x0 = (pg8::f32x4){bflo(xw.x), bfhi(xw.x), bflo(xw.y), bfhi(xw.y)}; x1 = (pg8::f32x4){bflo(xw.z), bfhi(xw.z), bflo(xw.w), bfhi(xw.w)}; }
                    const pg8::f32x4 v0 = x0 * ALPHA + gv[bj][0] * acc[ai][bj][m][0], v1 = x1 * ALPHA + gv[bj][1] * acc[ai][bj][m][1];
                    pg8::u32x4 w; w.x = pg8::cvt_pk_bf16(v0[0], v0[1]); w.y = pg8::cvt_pk_bf16(v0[2], v0[3]); w.z = pg8::cvt_pk_bf16(v1[0], v1[1]); w.w = pg8::cvt_pk_bf16(v1[2], v1[3]);
                    *(pg8::u32x4*)(PRE + (size_t)row * D + col) = w; } }
    }
};
struct OutOrder : pg8::StaticOrder {
    const char* xbase; unsigned rowbytes, tilecolbytes; LAS unsigned char* dump;
    DI void a_ready(const Unit& u) const {
        const int tid = threadIdx.x, wid = __builtin_amdgcn_readfirstlane(tid >> 6), lane = tid & 63;
        const int lpr = (int)(tilecolbytes >> 7);
        const char* t0 = xbase + (size_t)u.pm * 256 * rowbytes + (size_t)u.pn * tilecolbytes;
        const int nline = 256 * lpr;
        for (int i = wid * 64 + lane; i < nline; i += 512) { const int r = i / lpr, c = i % lpr;
            __builtin_amdgcn_global_load_lds((const unsigned*)(t0 + (size_t)r * rowbytes + (size_t)c * 128), (LAS unsigned*)(dump + wid * 256), 4, 0, 0); }
    }
};
struct EpiGlu {
    static constexpr bool PERM = true, AFTER_DRAIN = false;
    const bf16* YG; bf16* MIX; const float* gb;
    DI void operator()(const pg8::f32x4 (&acc)[2][2][4][2], const Unit& u, int wr, int wc, int fr, int fq) const {
        const int row0 = u.pm * BM + wr * 64 + fr, colb = wc * 32 + 8 * fq;
#pragma unroll
        for (int ai = 0; ai < 2; ++ai)
#pragma unroll
            for (int m = 0; m < 4; ++m) { const int row = row0 + ai * HALF + m * 16;
#pragma unroll
                for (int bj = 0; bj < 2; ++bj) { const int col = colb + bj * HALF;
                    const pg8::u32x4 yw = *(const pg8::u32x4*)(YG + (size_t)row * 256 + col);
                    const pg8::f32x4 b0 = *(const pg8::f32x4*)(gb + col), b1 = *(const pg8::f32x4*)(gb + col + 4);
                    const pg8::f32x4 a0 = acc[ai][bj][m][0] + b0, a1 = acc[ai][bj][m][1] + b1;
                    const float y[8] = {bflo(yw.x), bfhi(yw.x), bflo(yw.y), bfhi(yw.y), bflo(yw.z), bfhi(yw.z), bflo(yw.w), bfhi(yw.w)};
                    float o[8];
#pragma unroll
                    for (int i = 0; i < 4; ++i) { o[i] = y[i] * sigmoid_f(a0[i]); o[4 + i] = y[4 + i] * sigmoid_f(a1[i]); }
                    pg8::u32x4 w; w.x = pg8::cvt_pk_bf16(o[0], o[1]); w.y = pg8::cvt_pk_bf16(o[2], o[3]); w.z = pg8::cvt_pk_bf16(o[4], o[5]); w.w = pg8::cvt_pk_bf16(o[6], o[7]);
                    *(pg8::u32x4*)(MIX + (size_t)row * D + 768 + col) = w; asm volatile("" ::: "memory"); } }
    }
};
template <int KIND> struct MoeOrderK {
    const volatile LAS int* ts; int G, c; const int* slot_a; const float* slot_w; gu32* done_cnt; gu32* queue; volatile LAS int* qs;
    DI bool decode(int off, Unit& u) const {
        const int nwg = ts[16] * 4, q = nwg / 8, r = nwg % 8, xcd = c % 8; const int cntx = q + (xcd < r ? 1 : 0); if (off >= cntx) return false;
        const int wgid = (xcd < r ? xcd * (q + 1) : r * (q + 1) + (xcd - r) * q) + off;
        const int tm = wgid >> 2, j = wgid & 3; int e = 0;
#pragma unroll
        for (int k = 1; k < 16; ++k) e += (ts[k] <= tm) ? 1 : 0;
        u.pm = tm; u.pn = e * 4 + j; return true; }
    DI bool first(Unit& u) const {
        if (KIND == 0) return next(0, u);
        if (threadIdx.x == 0) { const unsigned a = __hip_atomic_fetch_add(queue + 16 * (c % 8), 2u, RLX_AGENT); qs[0] = (int)a; qs[1] = (int)a + 1; }
        asm volatile("s_waitcnt vmcnt(0) lgkmcnt(0)" ::: "memory"); __builtin_amdgcn_s_barrier(); asm volatile("" ::: "memory");
        return decode(qs[0], u);
    }
    DI bool more(int i, Unit& u) const {
        if (KIND == 0) return next(i, u);
        return decode(qs[i & 1], u);
    }
    DI bool next(int i, Unit& u) const {
        const int nwg = ts[16] * 4; const int cc = c;
        const long L = (long)i * G + cc; if (L >= nwg) return false;
        int wgid = (int)L; { const int q = nwg / 8, r = nwg % 8, xcd = wgid % 8, off = wgid / 8; wgid = (xcd < r ? xcd * (q + 1) : r * (q + 1) + (xcd - r) * q) + off; }
        const int tm = wgid >> 2, j = wgid & 3; int e = 0;
#pragma unroll
        for (int k = 1; k < 16; ++k) e += (ts[k] <= tm) ? 1 : 0;
        u.pm = tm; u.pn = e * 4 + j; return true;
    }
    struct Pf { unsigned a, w, c, q; };
    DI void pull_issue(int tid, Pf& pf) const { if (KIND == 1 && tid == 0) pf.q = __hip_atomic_fetch_add(queue + 16 * (c % 8), 1u, RLX_AGENT); }
    DI void pull_publish(int tid, const Pf& pf, int ui) const { if (KIND == 1 && tid == 0 && ui >= 0) qs[ui & 1] = (int)pf.q; }
    DI void prefetch(const Unit& u, int r, Pf& pf) const {
        const int e = u.pn >> 2, idx = (u.pm - ts[e]) * 256 + (r & 255); const bool valid = idx < ts[32 + e];
        pf.a = 0xffffffffu; pf.w = 0u; pf.c = 32u;
        if (valid && r < 256) { pf.a = (unsigned)slot_a[(size_t)e * SLOT_CAP + idx]; if (KIND == 1) pf.w = __float_as_uint(slot_w[(size_t)e * SLOT_CAP + idx]); }
        if (KIND == 1 && r < 64) pf.c = __hip_atomic_load(done_cnt + u.pm, RLX_AGENT);
    }
    DI void finish_meta(const Unit& u, int r, const Pf& pf, unsigned& off, unsigned& a0, unsigned& a1) const {
        if (KIND == 0) { const bool pad = pf.a == 0xffffffffu; off = (pad ? 0u : ((pf.a & 0xffffu) >> 1)) * (unsigned)D; a0 = 0u; a1 = pad ? 0u : (pf.a & 0xffff0000u); }
        else { off = (unsigned)(u.pm * 256 + r) * (unsigned)(DEXP * 2); a0 = pf.a == 0xffffffffu ? pf.a : (pf.a & 0xffffu); a1 = pf.w; }
    }
    DI void wait_ready(const Unit& u, int tid, const Pf& pf) const {
        if (KIND == 1 && tid < 64) { unsigned sp = 0;
            if ((unsigned)__builtin_amdgcn_readfirstlane((int)pf.c) < 32u)
                while ((unsigned)__builtin_amdgcn_readfirstlane((int)__hip_atomic_load(done_cnt + u.pm, RLX_AGENT)) < 32u) { __builtin_amdgcn_s_sleep(2); if (++sp > (1u << 20)) break; } }
    }
    DI void a_ready(const Unit&) const {}
    DI void done_nowait(const Unit& u) const { if (KIND == 0 && (threadIdx.x & 63) == 0) __hip_atomic_fetch_add(done_cnt + u.pm, 1u, RLX_AGENT); }
};
struct EpiG1 {
    static constexpr bool PERM = true, AFTER_DRAIN = false;
    bf16* HID; int skip; const float* cinv;
    DI void operator()(const pg8::f32x4 (&acc)[2][2][4][2], const Unit& u, int wr, int wc, int fr, int fq, const LAS unsigned* meta) const {
        if (skip == 1) { if (acc[0][0][0][0][0] == 12345.678f) HID[0] = 1; return; }
        const __amdgpu_buffer_rsrc_t rs = __builtin_amdgcn_make_buffer_rsrc((void*)HID, 0, (int)((size_t)NSLOT_MAX * DEXP * 2), 0x00020000);
        const int ln_ = ftid() & 63, fr_ = ln_ & 15, fq_ = ln_ >> 4; (void)fr; (void)fq;
        const int e = u.pn >> 2, r0 = wr * 64 + fr_, row0 = u.pm * BM + r0, col = (u.pn & 3) * 128 + wc * 32 + 8 * fq_;
        asm volatile("" ::: "memory");
        const float* cg = cinv + (e * 2 + 0) * 512 + col; const float* cu = cinv + (e * 2 + 1) * 512 + col;
        const pg8::f32x4 cg0 = *(const pg8::f32x4*)cg, cg1 = *(const pg8::f32x4*)(cg + 4), cu0 = *(const pg8::f32x4*)cu, cu1 = *(const pg8::f32x4*)(cu + 4);
#pragma unroll
        for (int ai = 0; ai < 2; ++ai)
#pragma unroll
            for (int m = 0; m < 4; ++m) { const int rl = r0 + ai * HALF + m * 16, row = row0 + ai * HALF + m * 16; float o[8];
                const float ra = __uint_as_float(meta[512 + rl]);
#pragma unroll
                for (int i = 0; i < 4; ++i) { o[i] = silu_f(acc[ai][0][m][0][i] * (ra * cg0[i])) * (acc[ai][1][m][0][i] * (ra * cu0[i])); o[4 + i] = silu_f(acc[ai][0][m][1][i] * (ra * cg1[i])) * (acc[ai][1][m][1][i] * (ra * cu1[i])); }
                pg8::u32x4 w; w.x = pg8::cvt_pk_bf16(o[0], o[1]); w.y = pg8::cvt_pk_bf16(o[2], o[3]); w.z = pg8::cvt_pk_bf16(o[4], o[5]); w.w = pg8::cvt_pk_bf16(o[6], o[7]);
                __builtin_amdgcn_raw_buffer_store_b128(w, rs, (row * DEXP + col) * 2, 0, 16); }
    }
};
struct EpiG2 {
    static constexpr bool PERM = true, AFTER_DRAIN = false;
    bf16* ROWS; int skip;
    DI void operator()(const pg8::f32x4 (&acc)[2][2][4][2], const Unit& u, int wr, int wc, int fr, int fq, const LAS unsigned* meta) const {
        if (skip == 1) { if (acc[0][0][0][0][0] == 12345.678f) ROWS[0] = 1; return; }
        const int r0 = wr * 64 + fr, colb = (u.pn & 3) * BM + wc * 32 + 8 * fq;
#pragma unroll
        for (int ai = 0; ai < 2; ++ai)
#pragma unroll
            for (int m = 0; m < 4; ++m) { const int r = r0 + ai * HALF + m * 16; const int d = (int)meta[256 + r]; const float wt = __uint_as_float(meta[512 + r]);
                if (d >= 0) {
#pragma unroll
                    for (int bj = 0; bj < 2; ++bj) { const pg8::f32x4 v0 = acc[ai][bj][m][0] * wt, v1 = acc[ai][bj][m][1] * wt;
                        pg8::u32x4 w; w.x = pg8::cvt_pk_bf16(v0[0], v0[1]); w.y = pg8::cvt_pk_bf16(v0[2], v0[3]); w.z = pg8::cvt_pk_bf16(v1[0], v1[1]); w.w = pg8::cvt_pk_bf16(v1[2], v1[3]);
                        *(pg8::u32x4*)(ROWS + (size_t)d * D + colb + bj * HALF) = w; } } }
    }
};

DI void mix_gating_simple(Frame& F, const Args& A, int l) {
    FRAME_IDS
    const bf16* P = (const bf16*)(F.ws + WS_PROJ); bf16* MIX = (bf16*)(F.ws + WS_MIXCAT);
    const float* lng = (const float*)A.in[I_GMLNG] + l * AW; const float* lnb = (const float*)A.in[I_GMLNB] + l * AW;
    const float* ws_ = (const float*)A.in[I_GMWS] + (size_t)l * 4 * 128 * 128; const float* bs_ = (const float*)A.in[I_GMBS] + l * 4 * 128;
    LAS float* vln = (LAS float*)(F.lds + RING_OFF);
    for (int it = F.vcu; it < BATCH * (T / 128); it += F.G) {
        const int m0 = it * 128;
        for (int r = wave_; r < 128; r += NWAVES) {
            const v2u w = *(const v2u*)(P + (size_t)(m0 + r) * PROJW + COL_V + 4 * lane_);
            float v[4] = {gelu_tanh_f(bflo(w.x)), gelu_tanh_f(bfhi(w.x)), gelu_tanh_f(bflo(w.y)), gelu_tanh_f(bfhi(w.y))};
            const float mean = wave_sum(v[0] + v[1] + v[2] + v[3]) * (1.f / 256.f);
            float s2 = 0.f;
#pragma unroll
            for (int i = 0; i < 4; ++i) { v[i] -= mean; s2 += v[i] * v[i]; }
            const float rstd = 1.0f / sqrtf(wave_sum(s2) * (1.f / 256.f) + LN_EPS);
#pragma unroll
            for (int i = 0; i < 4; ++i) vln[r * 256 + 4 * lane_ + i] = v[i] * rstd * lng[4 * lane_ + i] + lnb[4 * lane_ + i];
        }
        __syncthreads();
        { const int c = tid_ & 255, tp = tid_ >> 8, h = c >> 6;
          for (int t = tp; t < 128; t += 2) { const float* wrow = ws_ + ((size_t)h * 128 + t) * 128; float acc = 0.f;
              for (int s = 0; s <= t; ++s) acc += wrow[s] * vln[s * 256 + c];
              const float uu = gelu_tanh_f(bf2f(P[(size_t)(m0 + t) * PROJW + COL_U + c]));
              MIX[(size_t)(m0 + t) * D + c] = (bf16)f2bf(uu * (acc + bs_[h * 128 + t])); } }
        __syncthreads();
    }
}
DI void mix_attn_simple(Frame& F, int l) {
    FRAME_IDS
    const bf16* P = (const bf16*)(F.ws + WS_PROJ); bf16* MIX = (bf16*)(F.ws + WS_MIXCAT);
    const int gw = F.vcu * NWAVES + wave_, NGW = F.G * NWAVES;
    for (int it = gw; it < M * NH; it += NGW) {
        const int m = it >> 3, h = it & 7, t = m & (T - 1);
        const float q = bf2f(P[(size_t)m * PROJW + COL_Q + h * 64 + lane_]);
        float mx = -1e30f, den = 0.f, o = 0.f;
#pragma unroll 1
        for (int g = 0; g < 3; ++g) { const int dl = (g == 0) ? 1 : (g == 1 ? 4 : 16);
            int nk = t / dl; if (nk > 128) nk = 128;
#pragma unroll 2
            for (int j = 0; j <= nk; ++j) { const size_t mk = (size_t)(m - j * dl);
                const float kv = bf2f(P[mk * PROJW + COL_K + h * 64 + lane_]); const float vv = bf2f(P[mk * PROJW + COL_VA + h * 64 + lane_]);
                const float s = wave_sum(q * kv);
                const float mn = fmaxf(mx, s), f = __builtin_amdgcn_exp2f(mx - mn), p = __builtin_amdgcn_exp2f(s - mn);
                den = den * f + p; o = o * f + p * vv; mx = mn; } }
        MIX[(size_t)m * D + AW + h * 64 + lane_] = (bf16)f2bf(o / den);
    }
}

typedef float f32x16 __attribute__((ext_vector_type(16)));
typedef short v4i16_t __attribute__((ext_vector_type(4)));
DI int crow16(int r, int hi) { return (r & 3) + 8 * (r >> 2) + 4 * hi; }
template <int SUB> DI void mix_attn_mfma(Frame& F, int l) {
    FRAME_IDS
    const bf16* P = (const bf16*)(F.ws + WS_PROJ);
    LAS unsigned char* Ks = F.lds + RING_OFF; LAS unsigned char* Vs = Ks + 49152;
    LAS unsigned char* St = F.lds + ATT_STAGE_OFF + wave_ * 4608;
    const int ql = lane_ & 31, hi = lane_ >> 5, prow = lane_ >> 3, pch = lane_ & 7;
    constexpr int nitems = SUB == 0 ? 2048 : 1024;
    v4u kreg[6], vreg[6], qraw[4]; bf16x8 qf[4];
    int it = F.vcu; if (it >= nitems) return;
    int d, r, s0, b, h; size_t tokbase;
#define ATT_DECODE(IT) do { const int idx_ = (IT) & 1023; b = idx_ >> 7; h = (idx_ >> 4) & 7; int tile_; \
        if (SUB == 1) { d = 1; r = 0; tile_ = idx_ & 15; } else if ((IT) < 1024) { d = 16; r = idx_ & 15; tile_ = 0; } else { d = 4; r = (idx_ >> 2) & 3; tile_ = idx_ & 3; } \
        s0 = tile_ * 256; tokbase = (size_t)b * T + r; } while (0)
#define ATT_LOAD() do { const int tl_ = ftid(); _Pragma("unroll") for (int i = 0; i < 6; ++i) { const int idx2 = tl_ + 512 * i, row = idx2 >> 3, ch = idx2 & 7, step = s0 - 128 + row; \
            if (step >= 0) { const bf16* src = P + (tokbase + (size_t)step * d) * PROJW + h * 64 + ch * 8; kreg[i] = *(const v4u*)(src + COL_K); vreg[i] = *(const v4u*)(src + COL_VA); } \
            else { kreg[i] = (v4u){0u, 0u, 0u, 0u}; vreg[i] = (v4u){0u, 0u, 0u, 0u}; } } \
        _Pragma("unroll") for (int p = 0; p < 4; ++p) qraw[p] = *(const v4u*)(P + (tokbase + (size_t)(s0 + 32 * wave_ + 8 * p + prow) * d) * PROJW + COL_Q + h * 64 + pch * 8); } while (0)
#define ATT_WRITE() do { const int tw_ = ftid(); _Pragma("unroll") for (int i = 0; i < 6; ++i) { const int idx2 = tw_ + 512 * i, row = idx2 >> 3, ch = idx2 & 7; \
            *(LAS v4u*)(Ks + row * 128 + ((ch ^ ((row >> 1) & 7)) << 4)) = kreg[i]; \
            *(LAS v4u*)(Vs + row * 128 + ((ch ^ (((row >> 1) & 1) << 2)) << 4)) = vreg[i]; } \
        _Pragma("unroll") for (int p = 0; p < 4; ++p) *(LAS v4u*)(St + (8 * p + prow) * 144 + pch * 16) = qraw[p]; } while (0)
    ATT_DECODE(it); ATT_LOAD(); ATT_WRITE();
    __syncthreads();
    for (;;) {
        const size_t tb = tokbase; const int s0c = s0, dc = d, hcur = h, itcur = it;
        const bool first = (s0 == 0);
#pragma unroll
        for (int ks = 0; ks < 4; ++ks) qf[ks] = *(const LAS bf16x8*)(St + ql * 144 + (2 * ks + hi) * 16);
        const int itn = it + F.G; const bool has_next = itn < nitems;
        if (has_next) { ATT_DECODE(itn); ATT_LOAD(); }
        const int i0 = 32 * wave_;
        f32x16 S[5];
#pragma unroll
        for (int kb = 0; kb < 5; ++kb) { f32x16 acc;
#pragma unroll
            for (int i = 0; i < 16; ++i) acc[i] = 0.f;
            const int krow = i0 + 32 * kb + ql;
#pragma unroll
            for (int ks = 0; ks < 4; ++ks) { const bf16x8 a = *(const LAS bf16x8*)(Ks + krow * 128 + (((2 * ks + hi) ^ ((krow >> 1) & 7)) << 4)); acc = __builtin_amdgcn_mfma_f32_32x32x16_bf16(a, qf[ks], acc, 0, 0, 0); }
            S[kb] = acc; }
        int qrel = ql - 4 * hi; asm volatile("" : "+v"(qrel));
        float mx = -1e30f;
#pragma unroll
        for (int kb = 0; kb < 5; ++kb) {
            const bool bvalid = !first || (wave_ + kb >= 4);
            if (!bvalid) {
#pragma unroll
                for (int i = 0; i < 16; ++i) S[kb][i] = -1e30f;
            } else {
#pragma unroll
                for (int i = 0; i < 16; ++i) { const int c0 = crow16(i, 0); float v = S[kb][i];
                    if (kb == 0) v = (c0 >= qrel) ? v : -1e30f;
                    if (kb == 4) v = (c0 <= qrel) ? v : -1e30f;
                    S[kb][i] = v; mx = fmaxf(mx, v); }
            }
        }
        mx = fmaxf(mx, __shfl_xor(mx, 32));
        float lsum = 0.f;
#pragma unroll
        for (int kb = 0; kb < 5; ++kb)
#pragma unroll
            for (int i = 0; i < 16; ++i) { const float p = __builtin_amdgcn_exp2f(S[kb][i] - mx); S[kb][i] = p; lsum += p; }
        lsum += __shfl_xor(lsum, 32);
        v4u x16[4], x4[4]; f32x2_t s16 = {0.f, 0.f}, s4 = {0.f, 0.f};
        if (SUB == 1) {
            const size_t qt = tb + (size_t)(s0c + i0 + ql) * dc;
            s16 = *(const f32x2_t*)((const float*)(F.ws + WS_STAT) + (qt * NH + hcur) * 2); s4 = *(const f32x2_t*)((const float*)(F.ws + WS_STAT) + (size_t)M * NH * 2 + (qt * NH + hcur) * 2);
        }
        f32x16 O[2];
#pragma unroll
        for (int i = 0; i < 16; ++i) { O[0][i] = 0.f; O[1][i] = 0.f; }
        const int trq = (lane_ & 15) >> 2, trg = (lane_ >> 4) & 1, trp = lane_ & 3;
#pragma unroll
        for (int kb = 0; kb < 5; ++kb)
#pragma unroll
            for (int s = 0; s < 2; ++s) {
                if (SUB == 1 && kb == 2 && s == 0) {
#pragma unroll
                    for (int p = 0; p < 4; ++p) { const size_t rt = tb + (size_t)(s0c + i0 + 8 * p + prow) * dc; const bf16* pp = (const bf16*)(F.ws + WS_XN) + rt * BW + hcur * 64 + pch * 8;
                        x16[p] = *(const v4u*)pp; x4[p] = *(const v4u*)(pp + (size_t)M * BW); } }
                v4u pw; pw.x = cvtpk(S[kb][8 * s], S[kb][8 * s + 1]); pw.y = cvtpk(S[kb][8 * s + 2], S[kb][8 * s + 3]); pw.z = cvtpk(S[kb][8 * s + 4], S[kb][8 * s + 5]); pw.w = cvtpk(S[kb][8 * s + 6], S[kb][8 * s + 7]);
                const bf16x8 pb = __builtin_bit_cast(bf16x8, pw);
                const int rlo = i0 + 32 * kb + 16 * s + 4 * hi + trq, rhi = rlo + 8;
#pragma unroll
                for (int dh = 0; dh < 2; ++dh) { const int chunk = 4 * dh + 2 * trg + (trp >> 1);
                    const v4i16_t lo = __builtin_amdgcn_ds_read_tr16_b64_v4i16((LAS v4i16_t*)(Vs + rlo * 128 + ((chunk ^ (((rlo >> 1) & 1) << 2)) << 4) + 8 * (trp & 1)));
                    const v4i16_t hh = __builtin_amdgcn_ds_read_tr16_b64_v4i16((LAS v4i16_t*)(Vs + rhi * 128 + ((chunk ^ (((rhi >> 1) & 1) << 2)) << 4) + 8 * (trp & 1)));
                    const bf16x8 va = (bf16x8){lo[0], lo[1], lo[2], lo[3], hh[0], hh[1], hh[2], hh[3]};
                    O[dh] = __builtin_amdgcn_mfma_f32_32x32x16_bf16(va, pb, O[dh], 0, 0, 0); } }
        float osc;
        if (SUB == 0) osc = 1.0f / lsum;
        else { const float MM = fmaxf(mx, fmaxf(s16.x, s4.x)), a1 = __builtin_amdgcn_exp2f(mx - MM), a16 = s16.y * __builtin_amdgcn_exp2f(s16.x - MM), a4 = s4.y * __builtin_amdgcn_exp2f(s4.x - MM);
            const float inv = 1.0f / (lsum * a1 + a16 + a4); osc = a1 * inv;
            if (hi == 0) { f32x2_t cc = {a16 * inv, a4 * inv}; *(LAS f32x2_t*)(St + ql * 144 + 128) = cc; } }
#pragma unroll
        for (int dh = 0; dh < 2; ++dh)
#pragma unroll
            for (int g4 = 0; g4 < 4; ++g4) { v2u w; w.x = cvtpk(O[dh][4 * g4] * osc, O[dh][4 * g4 + 1] * osc); w.y = cvtpk(O[dh][4 * g4 + 2] * osc, O[dh][4 * g4 + 3] * osc);
                *(LAS v2u*)(St + ql * 144 + (32 * dh + 8 * g4 + 4 * hi) * 2) = w; }
        if (SUB == 0) {
            bf16* PART = (bf16*)(F.ws + WS_XN) + (itcur < 1024 ? 0 : (size_t)M * BW); float* ST = (float*)(F.ws + WS_STAT) + (itcur < 1024 ? 0 : (size_t)M * NH * 2);
            if (hi == 0) { const size_t qt = tb + (size_t)(s0c + i0 + ql) * dc; f32x2_t st = {mx, lsum}; *(f32x2_t*)(ST + (qt * NH + hcur) * 2) = st; }
#pragma unroll
            for (int p = 0; p < 4; ++p) { const size_t rt = tb + (size_t)(s0c + i0 + 8 * p + prow) * dc;
                *(v4u*)(PART + rt * BW + hcur * 64 + pch * 8) = *(const LAS v4u*)(St + (8 * p + prow) * 144 + pch * 16); }
        } else {
#pragma unroll
            for (int p = 0; p < 4; ++p) { const size_t rt = tb + (size_t)(s0c + i0 + 8 * p + prow) * dc;
                const v4u ov = *(const LAS v4u*)(St + (8 * p + prow) * 144 + pch * 16); const f32x2_t cc = *(const LAS f32x2_t*)(St + (8 * p + prow) * 144 + 128);
                v4u o;
                o.x = cvtpk(bflo(ov.x) + cc.x * bflo(x16[p].x) + cc.y * bflo(x4[p].x), bfhi(ov.x) + cc.x * bfhi(x16[p].x) + cc.y * bfhi(x4[p].x));
                o.y = cvtpk(bflo(ov.y) + cc.x * bflo(x16[p].y) + cc.y * bflo(x4[p].y), bfhi(ov.y) + cc.x * bfhi(x16[p].y) + cc.y * bfhi(x4[p].y));
                o.z = cvtpk(bflo(ov.z) + cc.x * bflo(x16[p].z) + cc.y * bflo(x4[p].z), bfhi(ov.z) + cc.x * bfhi(x16[p].z) + cc.y * bfhi(x4[p].z));
                o.w = cvtpk(bflo(ov.w) + cc.x * bflo(x16[p].w) + cc.y * bflo(x4[p].w), bfhi(ov.w) + cc.x * bfhi(x16[p].w) + cc.y * bfhi(x4[p].w));
                *(v4u*)((bf16*)(F.ws + WS_MIXCAT) + rt * D + AW + hcur * 64 + pch * 8) = o; }
        }
        __syncthreads();
        if (!has_next) break;
        ATT_WRITE(); it = itn;
        __syncthreads();
    }
#undef ATT_DECODE
#undef ATT_LOAD
#undef ATT_WRITE
}
typedef float f32x4_t __attribute__((ext_vector_type(4)));
DI void cmul_acc(float& xr, float& xi, float ar, float ai, float br, float bi) { const float nr = ar * xr - ai * xi + br, ni = ar * xi + ai * xr + bi; xr = nr; xi = ni; }
DI void mix_ssm_in(Frame& F, int l) {
    FRAME_IDS
    const bf16* P = (const bf16*)(F.ws + WS_PROJ);
    const bf16* WIN = (const bf16*)(F.ws + WS_SSM2 + l * SSM2_LAYER + S2_WIN);
    const float* apw = (const float*)(F.ws + WS_SSM2 + l * SSM2_LAYER + S2_APW);
    float* XLOC = (float*)(F.ws + WS_XLOC); float* XSUP = (float*)(F.ws + WS_XSUP);
    const int row = lane_ & 15, q = lane_ >> 4;
    for (int it = F.vcu; it < 256; it += F.G) {
        const int b = it >> 5, sc = (it >> 2) & 7, g = 4 * (it & 3) + (wave_ >> 1), half = wave_ & 1;
        bf16x8 af[16];
        { const bf16* src = P + ((size_t)b * T + (size_t)(16 * sc + row) * 32 + (q >> 1)) * PROJW + COL_S + g * 16 + 8 * (q & 1);
#pragma unroll
          for (int sp = 0; sp < 16; ++sp) af[sp] = *(const bf16x8*)(src + (size_t)(2 * sp) * PROJW); }
#pragma unroll 1
        for (int c4 = 0; c4 < 4; ++c4) { const int ct = 4 * half + c4;
            f32x4_t acc = {0.f, 0.f, 0.f, 0.f};
            const bf16* wp = WIN + (((size_t)(g * 16) * 8 + ct) * 64 + lane_) * 8;
#pragma unroll
            for (int sp = 0; sp < 16; ++sp) { const bf16x8 bfr = *(const bf16x8*)(wp + (size_t)sp * 8 * 64 * 8); acc = __builtin_amdgcn_mfma_f32_16x16x32_bf16(af[sp], bfr, acc, 0, 0, 0); }
            const int comp = 16 * ct + row, n = comp >> 1, part = comp & 1;
#pragma unroll
            for (int r = 0; r < 4; ++r) XLOC[(((size_t)b * 128 + 16 * sc + 4 * q + r) * 16 + g) * 128 + comp] = acc[r];
            const float a32r = apw[((g * 33 + 32) * 64 + n) * 2], a32i = apw[((g * 33 + 32) * 64 + n) * 2 + 1];
            const float sg = part ? 1.f : -1.f;
            float h = acc[0];
#pragma unroll
            for (int r = 1; r < 4; ++r) { const float o = __shfl_xor(h, 1); h = a32r * h + sg * a32i * o + acc[r]; }
            float p64r = a32r * a32r - a32i * a32i, p64i = 2.f * a32r * a32i;
            float p128r = p64r * p64r - p64i * p64i, p128i = 2.f * p64r * p64i;
            float wr = 1.f, wi = 0.f;
            for (int k = 0; k < 3 - q; ++k) { const float t0 = wr * p128r - wi * p128i, t1 = wr * p128i + wi * p128r; wr = t0; wi = t1; }
            { const float o = __shfl_xor(h, 1); h = wr * h + sg * wi * o; }
            h += __shfl_xor(h, 16); h += __shfl_xor(h, 32);
            if (q == 0) XSUP[(((size_t)b * 8 + sc) * 16 + g) * 128 + comp] = h;
        }
    }
}
DI void mix_ssm_out(Frame& F, const Args& A, int l) {
    FRAME_IDS
    const bf16* P = (const bf16*)(F.ws + WS_PROJ); bf16* YG = (bf16*)(F.ws + WS_YG);
    const bf16* KT = (const bf16*)(F.ws + WS_SSM2 + l * SSM2_LAYER + S2_KT); const bf16* CT = (const bf16*)(F.ws + WS_SSM2 + l * SSM2_LAYER + S2_CT);
    const float* apw = (const float*)(F.ws + WS_SSM2 + l * SSM2_LAYER + S2_APW);
    const float* XLOC = (const float*)(F.ws + WS_XLOC); const float* XSUP = (const float*)(F.ws + WS_XSUP);
    LAS unsigned char* Ut = F.lds + RING_OFF + wave_ * 4096;
    LAS float* Xs = (LAS float*)(F.lds + RING_OFF + wave_ * 4096 + 2048);
    for (int i = lane_; i < 256; i += 64) ((LAS unsigned*)Ut)[i] = 0u;
    const int row = lane_ & 15, q = lane_ >> 4;
    for (int it = F.vcu; it < 256; it += F.G) {
        const int b = it >> 5, sc = (it >> 2) & 7, g = 4 * (it & 3) + (wave_ >> 1), half = wave_ & 1, n = lane_;
        const size_t tokA = (size_t)b * T + (size_t)(16 * sc + 8 * half) * 32;
        v4u unext = *(const v4u*)(P + (tokA + (lane_ >> 1)) * PROJW + COL_S + g * 16 + 8 * (lane_ & 1));
        f32x2_t psup[8], ploc[8];
#pragma unroll
        for (int s2 = 0; s2 < 8; ++s2) { psup[s2] = (f32x2_t){0.f, 0.f}; if (s2 < sc) psup[s2] = *(const f32x2_t*)(XSUP + (((size_t)b * 8 + s2) * 16 + g) * 128 + 2 * n); }
#pragma unroll
        for (int k2 = 0; k2 < 8; ++k2) { ploc[k2] = (f32x2_t){0.f, 0.f}; if (half) ploc[k2] = *(const f32x2_t*)(XLOC + (((size_t)b * 128 + 16 * sc + k2) * 16 + g) * 128 + 2 * n); }
        const float dsk = ((const float*)A.in[I_SSMD])[(l * 16 + g) * 16 + row];
        const float a32r = apw[((g * 33 + 32) * 64 + n) * 2], a32i = apw[((g * 33 + 32) * 64 + n) * 2 + 1];
        const float a16r = apw[((g * 33 + 16) * 64 + n) * 2], a16i = apw[((g * 33 + 16) * 64 + n) * 2 + 1];
        float a512r = a32r, a512i = a32i;
#pragma unroll
        for (int k = 0; k < 4; ++k) { const float t0 = a512r * a512r - a512i * a512i, t1 = 2.f * a512r * a512i; a512r = t0; a512i = t1; }
        float xr = 0.f, xi = 0.f;
#pragma unroll
        for (int s2 = 0; s2 < 8; ++s2) if (s2 < sc) cmul_acc(xr, xi, a512r, a512i, psup[s2].x, psup[s2].y);
        if (half) {
#pragma unroll
            for (int k2 = 0; k2 < 8; ++k2) cmul_acc(xr, xi, a32r, a32i, ploc[k2].x, ploc[k2].y); }
        asm volatile("" : "+v"(xr), "+v"(xi) :: "memory");
        bf16x8 kt[16], ctf[4];
#pragma unroll
        for (int p = 0; p < 16; ++p) kt[p] = *(const bf16x8*)(KT + ((size_t)(g * 16 + p) * 64 + lane_) * 8);
#pragma unroll
        for (int sx = 0; sx < 4; ++sx) ctf[sx] = *(const bf16x8*)(CT + ((size_t)(g * 4 + sx) * 64 + lane_) * 8);
        f32x4_t apr[4][2];
#pragma unroll
        for (int sx = 0; sx < 4; ++sx) { const f32x4_t* ap = (const f32x4_t*)(apw + ((size_t)(g * 33 + row + 1) * 64 + 16 * sx + 4 * q) * 2); apr[sx][0] = ap[0]; apr[sx][1] = ap[1]; }
#pragma unroll 1
        for (int kk = 0; kk < 8; ++kk) {
            const size_t tok0 = tokA + (size_t)kk * 32;
            const f32x2_t xl = *(const f32x2_t*)(XLOC + (((size_t)b * 128 + 16 * sc + 8 * half + kk) * 16 + g) * 128 + 2 * n);
            *(LAS v4u*)(Ut + 1024 + lane_ * 16) = unext;
            if (kk < 7) unext = *(const v4u*)(P + (tok0 + 32 + (lane_ >> 1)) * PROJW + COL_S + g * 16 + 8 * (lane_ & 1));
            Xs[2 * n] = xr; Xs[2 * n + 1] = xi; Xs[128 + 2 * n] = a16r * xr - a16i * xi; Xs[128 + 2 * n + 1] = a16r * xi + a16i * xr;
#pragma unroll
            for (int tau = 0; tau < 2; ++tau) { f32x4_t acc = (f32x4_t){0.f, 0.f, 0.f, 0.f};
                const int ti = 16 * tau + row;
#pragma unroll
                for (int sx = 0; sx < 4; ++sx) { const LAS f32x4_t* xp = (const LAS f32x4_t*)(Xs + 128 * tau + 2 * (16 * sx + 4 * q)); const f32x4_t x01 = xp[0], x23 = xp[1];
                    const f32x4_t a01 = apr[sx][0], a23 = apr[sx][1];
                    v4u zw; zw.x = cvtpk(a01.x * x01.x - a01.y * x01.y, a01.x * x01.y + a01.y * x01.x); zw.y = cvtpk(a01.z * x01.z - a01.w * x01.w, a01.z * x01.w + a01.w * x01.z);
                    zw.z = cvtpk(a23.x * x23.x - a23.y * x23.y, a23.x * x23.y + a23.y * x23.x); zw.w = cvtpk(a23.z * x23.z - a23.w * x23.w, a23.z * x23.w + a23.w * x23.z);
                    acc = __builtin_amdgcn_mfma_f32_16x16x32_bf16(__builtin_bit_cast(bf16x8, zw), ctf[sx], acc, 0, 0, 0);
                    asm volatile("" ::: "memory"); }
#pragma unroll
                for (int p = 0; p < 16; ++p) if (p < 8 * tau + 8) { const bf16x8 ua = *(const LAS bf16x8*)(Ut + (32 + ti - 2 * p - (q >> 1)) * 32 + 16 * (q & 1));
                    acc = __builtin_amdgcn_mfma_f32_16x16x32_bf16(ua, kt[p], acc, 0, 0, 0); if ((p & 3) == 3) asm volatile("" ::: "memory"); }
#pragma unroll
                for (int r = 0; r < 4; ++r) { const int t2 = 16 * tau + 4 * q + r; const float uu = bf2f(*(const LAS bf16*)(Ut + (32 + t2) * 32 + 2 * row));
                    YG[(tok0 + t2) * 256 + g * 16 + row] = (bf16)f2bf(gelu_tanh_f(acc[r] + dsk * uu)); }
            }
            cmul_acc(xr, xi, a32r, a32i, xl.x, xl.y);
        }
    }
}
DI void mix_gating_mfma(Frame& F, const Args& A, int l, int variant = 0) {
    FRAME_IDS
    const bf16* P = (const bf16*)(F.ws + WS_PROJ); bf16* MIX = (bf16*)(F.ws + WS_MIXCAT);
    const bf16* GW = (const bf16*)(F.ws + WS_SSM2 + l * SSM2_LAYER + S2_GW);
    const float* lng = (const float*)A.in[I_GMLNG] + l * AW; const float* lnb = (const float*)A.in[I_GMLNB] + l * AW;
    const float* bs_ = (const float*)A.in[I_GMBS] + l * 4 * 128;
    LAS unsigned char* VT = F.lds + RING_OFF;
    const int ql = lane_ & 31, hi = lane_ >> 5, trq = (lane_ & 15) >> 2, trg = (lane_ >> 4) & 1, trp = lane_ & 3;
    for (int it = F.vcu; it < BATCH * (T / 128); it += F.G) {
        const int m0 = it * 128;
        __syncthreads();
        if (variant != 2) {
        v2u wv[16];
#pragma unroll
        for (int j = 0; j < 16; ++j) wv[j] = *(const v2u*)(P + (size_t)(m0 + wave_ + 8 * j) * PROJW + COL_V + 4 * lane_);
        const f32x4 gg = *(const f32x4*)(lng + 4 * lane_), bb = *(const f32x4*)(lnb + 4 * lane_);
#pragma unroll
        for (int j = 0; j < 16; ++j) { const int r = wave_ + 8 * j; const v2u w = wv[j];
            float v[4] = {gelu_tanh_f(bflo(w.x)), gelu_tanh_f(bfhi(w.x)), gelu_tanh_f(bflo(w.y)), gelu_tanh_f(bfhi(w.y))};
            const float mean = wave_sum(v[0] + v[1] + v[2] + v[3]) * (1.f / 256.f);
            float s2 = 0.f;
#pragma unroll
            for (int i = 0; i < 4; ++i) { v[i] -= mean; s2 += v[i] * v[i]; }
            const float rstd = 1.0f / sqrtf(wave_sum(s2) * (1.f / 256.f) + LN_EPS);
            v2u o; o.x = cvtpk(v[0] * rstd * gg.x + bb.x, v[1] * rstd * gg.y + bb.y); o.y = cvtpk(v[2] * rstd * gg.z + bb.z, v[3] * rstd * gg.w + bb.w);
            *(LAS v2u*)(VT + r * 512 + (((lane_ >> 1) ^ ((r & 3) << 2)) << 4) + 8 * (lane_ & 1)) = o;
        }
        }
        __syncthreads();
        if (variant == 1) continue;
        const int h = wave_ >> 1, cb = 64 * h + 32 * (wave_ & 1);
        const int chunk = (cb >> 3) + 2 * trg + (trp >> 1);
#pragma unroll
        for (int rt = 0; rt < 4; ++rt) {
            f32x16 acc;
#pragma unroll
            for (int i = 0; i < 16; ++i) acc[i] = 0.f;
            bf16x8 wa[8];
#pragma unroll
            for (int ks = 0; ks < 2 * rt + 2; ++ks) wa[ks] = *(const bf16x8*)(GW + (size_t)(h * 128 + 32 * rt) * 128 + 16 * ks + (unsigned)(ql * 128 + 8 * hi));
#pragma unroll
            for (int ks = 0; ks < 2 * rt + 2; ++ks) {
                const int rlo = 16 * ks + 8 * hi + trq;
                const v4i16_t lo = __builtin_amdgcn_ds_read_tr16_b64_v4i16((LAS v4i16_t*)(VT + rlo * 512 + ((chunk ^ (trq << 2)) << 4) + 8 * (trp & 1)));
                const v4i16_t hh = __builtin_amdgcn_ds_read_tr16_b64_v4i16((LAS v4i16_t*)(VT + (rlo + 4) * 512 + ((chunk ^ (trq << 2)) << 4) + 8 * (trp & 1)));
                const bf16x8 va = (bf16x8){lo[0], lo[1], lo[2], lo[3], hh[0], hh[1], hh[2], hh[3]};
                acc = __builtin_amdgcn_mfma_f32_32x32x16_bf16(va, wa[ks], acc, 0, 0, 0); }
            { const int t = 32 * rt + ql; const float bsv = bs_[h * 128 + t];
              const bf16* up = P + (size_t)(m0 + t) * PROJW + COL_U + cb + 4 * hi; bf16* op = MIX + (size_t)(m0 + t) * D + cb + 4 * hi;
#pragma unroll
              for (int g4 = 0; g4 < 4; ++g4) { const v2u uw = *(const v2u*)(up + 8 * g4); v2u o;
                  o.x = cvtpk(gelu_tanh_f(bflo(uw.x)) * (acc[4 * g4] + bsv), gelu_tanh_f(bfhi(uw.x)) * (acc[4 * g4 + 1] + bsv)); o.y = cvtpk(gelu_tanh_f(bflo(uw.y)) * (acc[4 * g4 + 2] + bsv), gelu_tanh_f(bfhi(uw.y)) * (acc[4 * g4 + 3] + bsv));
                  *(v2u*)(op + 8 * g4) = o; } }
        }
    }
}

DI void p_glu(Frame& F, const Args& A, int l) {
    FRAME_IDS
    const bf16* YG = (const bf16*)(F.ws + WS_YG); bf16* MIX = (bf16*)(F.ws + WS_MIXCAT);
    const bf16* GluT = (const bf16*)(F.ws + WS_WSMALL + l * WSMALL_LAYER + WOFF_GLU); const float* gb = (const float*)A.in[I_GLUB] + l * 256;
    LAS unsigned char* Bs = F.lds + RING_OFF;
#pragma unroll
    for (int i = 0; i < 16; ++i) { const int idx = tid_ + 512 * i, n = idx >> 5, ch = idx & 31;
        *(LAS v4u*)(Bs + n * 512 + ((ch ^ (n & 15)) << 4)) = *(const v4u*)(GluT + (size_t)n * 256 + ch * 8); }
    __syncthreads();
    const int tk = lane_ & 15, q = lane_ >> 4;
    for (int rt = F.vcu; rt < M / 128; rt += F.G) {
        const size_t tok = (size_t)rt * 128 + wave_ * 16 + tk;
        bf16x8 yf[8];
#pragma unroll
        for (int ks = 0; ks < 8; ++ks) yf[ks] = *(const bf16x8*)(YG + tok * 256 + 32 * ks + 8 * q);
#pragma unroll 4
        for (int ct = 0; ct < 16; ++ct) {
            f32x4_t acc = {0.f, 0.f, 0.f, 0.f};
            const int n = 16 * ct + tk;
#pragma unroll
            for (int ks = 0; ks < 8; ++ks) { const bf16x8 wf = *(const LAS bf16x8*)(Bs + n * 512 + (((4 * ks + q) ^ (n & 15)) << 4));
                acc = __builtin_amdgcn_mfma_f32_16x16x32_bf16(wf, yf[ks], acc, 0, 0, 0); }
            const int n0 = 16 * ct + 4 * q; const v2u yw = *(const v2u*)(YG + tok * 256 + n0); const f32x4 bv = *(const f32x4*)(gb + n0);
            v2u o; o.x = cvtpk(bflo(yw.x) * sigmoid_f(acc[0] + bv.x), bfhi(yw.x) * sigmoid_f(acc[1] + bv.y)); o.y = cvtpk(bflo(yw.y) * sigmoid_f(acc[2] + bv.z), bfhi(yw.y) * sigmoid_f(acc[3] + bv.w));
            *(v2u*)(MIX + tok * D + 768 + n0) = o;
        }
    }
}
DI void mix_ssm_simple(Frame& F, const Args& A, int l) {
    FRAME_IDS
    const bf16* P = (const bf16*)(F.ws + WS_PROJ); bf16* YG = (bf16*)(F.ws + WS_YG);
    const float* tab = (const float*)(F.ws + WS_SSM) + (size_t)l * SSM_TAB;
    LAS float* fin = (LAS float*)(F.lds + RING_OFF);
    for (int it = F.vcu; it < BATCH * SSM_G; it += F.G) {
        const int b = it >> 4, g = it & 15, n = lane_, seg = wave_, gn = g * 64 + n;
        const float are = tab[gn], aim = tab[1024 + gn];
        float bre[16], bim[16], cre[16], cim[16];
#pragma unroll
        for (int c = 0; c < 16; ++c) { bre[c] = tab[2048 + gn * 16 + c]; bim[c] = tab[2048 + 16384 + gn * 16 + c];
            cre[c] = ((const float*)A.in[I_CRE])[(((size_t)l * 16 + g) * 16 + c) * 64 + n]; cim[c] = ((const float*)A.in[I_CIM])[(((size_t)l * 16 + g) * 16 + c) * 64 + n]; }
        const float dsk = ((const float*)A.in[I_SSMD])[(l * 16 + g) * 16 + (lane_ & 15)];
        const size_t mbase = (size_t)b * T + seg * 512;
        float xr = 0.f, xi = 0.f;
        for (int tt = 0; tt < 512; ++tt) { const v4u* up = (const v4u*)(P + (mbase + tt) * PROJW + COL_S + g * 16); const v4u u0 = up[0], u1 = up[1];
            const float u[16] = {bflo(u0.x), bfhi(u0.x), bflo(u0.y), bfhi(u0.y), bflo(u0.z), bfhi(u0.z), bflo(u0.w), bfhi(u0.w), bflo(u1.x), bfhi(u1.x), bflo(u1.y), bfhi(u1.y), bflo(u1.z), bfhi(u1.z), bflo(u1.w), bfhi(u1.w)};
            float br = 0.f, bi = 0.f;
#pragma unroll
            for (int c = 0; c < 16; ++c) { br += u[c] * bre[c]; bi += u[c] * bim[c]; }
            const float nr = are * xr - aim * xi + br, ni = are * xi + aim * xr + bi; xr = nr; xi = ni; }
        fin[(seg * 64 + n) * 2] = xr; fin[(seg * 64 + n) * 2 + 1] = xi;
        __syncthreads();
        float pr = are, pi = aim;
#pragma unroll
        for (int k = 0; k < 9; ++k) { const float t0 = pr * pr - pi * pi, t1 = 2.f * pr * pi; pr = t0; pi = t1; }
        xr = 0.f; xi = 0.f;
        for (int s = 0; s < seg; ++s) { const float fr_ = fin[(s * 64 + n) * 2], fi_ = fin[(s * 64 + n) * 2 + 1];
            const float nr = pr * xr - pi * xi + fr_, ni = pr * xi + pi * xr + fi_; xr = nr; xi = ni; }
        for (int tt = 0; tt < 512; ++tt) { const v4u* up = (const v4u*)(P + (mbase + tt) * PROJW + COL_S + g * 16); const v4u u0 = up[0], u1 = up[1];
            const float u[16] = {bflo(u0.x), bfhi(u0.x), bflo(u0.y), bfhi(u0.y), bflo(u0.z), bfhi(u0.z), bflo(u0.w), bfhi(u0.w), bflo(u1.x), bfhi(u1.x), bflo(u1.y), bfhi(u1.y), bflo(u1.z), bfhi(u1.z), bflo(u1.w), bfhi(u1.w)};
            float br = 0.f, bi = 0.f;
#pragma unroll
            for (int c = 0; c < 16; ++c) { br += u[c] * bre[c]; bi += u[c] * bim[c]; }
            const float nr = are * xr - aim * xi + br, ni = are * xi + aim * xr + bi; xr = nr; xi = ni;
            float ysel = 0.f, usel = 0.f;
#pragma unroll
            for (int c = 0; c < 16; ++c) { const float r = wave_sum(xr * cre[c] - xi * cim[c]); if ((lane_ & 15) == c) { ysel = r; usel = u[c]; } }
            if (lane_ < 16) { const float y = ysel + dsk * usel; YG[(mbase + tt) * 256 + g * 16 + lane_] = (bf16)f2bf(gelu_tanh_f(y)); } }
        __syncthreads();
    }
}

DI bool beats(float x, int i, float y, int j) { return x > y || (x == y && i < j); }
DI void p_row_b(Frame& F, const Args& A, int l, bool count = true) {
    FRAME_IDS
    const int gw = F.vcu * NWAVES + wave_, NGW = F.G * NWAVES;
    const bf16* PRE = (const bf16*)(F.ws + WS_PRE); bf16* X1 = (bf16*)(F.ws + WS_X1); bf16* XN = (bf16*)(F.ws + WS_XN);
    const float* mod = (const float*)(F.ws + WS_MOD) + (size_t)l * BATCH * 6 * D;
    const float* ln1g = (const float*)A.in[I_LN1G] + l * D; const float* ln1b = (const float*)A.in[I_LN1B] + l * D;
    const float* rw = (const float*)A.in[I_RW]; const float* rb = (const float*)A.in[I_RB];
    int* slot_a = (int*)(F.ws + WS_SLOT_A); float* slot_w = (float*)(F.ws + WS_SLOT_W);
    LAS float* rwS = (LAS float*)(F.lds + RING_OFF);
    volatile LAS unsigned* lcnt = (volatile LAS unsigned*)(F.lds + RING_OFF + 65536);
    LAS int* list_a = (LAS int*)(F.lds + RING_OFF + 66048); LAS float* list_w = (LAS float*)(F.lds + RING_OFF + 66048 + 8192);
    for (int i = tid_; i < D * NEXP; i += NTHR) rwS[(i & 15) * D + (i >> 4)] = rw[i];
    if (tid_ < 32) lcnt[tid_] = 0u;
    __syncthreads();
    const int hi5 = lane_ >> 5, b4 = (lane_ >> 4) & 1, b3 = (lane_ >> 3) & 1, b2 = (lane_ >> 2) & 1, emine = 8 * hi5 + 4 * b4 + 2 * b3 + b2;
    const int wi = 2 * b3 + b2, mygrp = 2 * hi5 + b4;
    const float rbm = rb[emine];
    Row16 lg1, lb1; row_load_f32(lg1, ln1g, lane_); row_load_f32(lb1, ln1b, lane_);
    v2u nraw[4];
    const int bq = gw / (NGW / BATCH), mbase = bq * T + gw % (NGW / BATCH), mstep = NGW / BATCH;
    const float* md = mod + (size_t)bq * 6 * D;
    Row16 msc, msh; row_load_f32(msc, md + 4 * D, lane_); row_load_f32(msh, md + 3 * D, lane_);
    { const v2u* q = (const v2u*)(PRE + (size_t)mbase * D);
#pragma unroll
      for (int k = 0; k < 4; ++k) nraw[k] = q[k * 64 + lane_]; }
    for (int m = mbase; m < (bq + 1) * T; m += mstep) {
        Row16 r;
#pragma unroll
        for (int k = 0; k < 4; ++k) { r.v[4 * k] = bflo(nraw[k].x); r.v[4 * k + 1] = bfhi(nraw[k].x); r.v[4 * k + 2] = bflo(nraw[k].y); r.v[4 * k + 3] = bfhi(nraw[k].y); }
        if (m + mstep < (bq + 1) * T) { const v2u* q = (const v2u*)(PRE + (size_t)(m + mstep) * D);
#pragma unroll
            for (int k = 0; k < 4; ++k) nraw[k] = q[k * 64 + lane_]; }
        row_ln(r);
#pragma unroll
        for (int i = 0; i < 16; ++i) r.v[i] = r.v[i] * lg1.v[i] + lb1.v[i];
        row_ln(r);
#pragma unroll
        for (int i = 0; i < 16; ++i) r.v[i] = r.v[i] * (1.0f + msc.v[i]) + msh.v[i];
        unsigned ib;
        { float am = 0.f;
#pragma unroll
          for (int i = 0; i < 16; ++i) am = fmaxf(am, fabsf(r.v[i]));
          am = wave_max(am); ib = (am > 1e-30f) ? ((__float_as_uint(am * (1.0f / 440.0f)) + 0xffffu) & 0xffff0000u) : 0x3f800000u;
          const float qs = 1.0f / __uint_as_float(ib);
          unsigned* q8 = (unsigned*)((unsigned char*)XN + (size_t)m * D);
#pragma unroll
          for (int k = 0; k < 4; ++k) q8[k * 64 + lane_] = pk4_fp8(r.v[4 * k] * qs, r.v[4 * k + 1] * qs, r.v[4 * k + 2] * qs, r.v[4 * k + 3] * qs); }
        float lg[16];
#pragma unroll
        for (int e = 0; e < 16; ++e) { float a = 0.f;
#pragma unroll
            for (int k = 0; k < 4; ++k) { const f32x4 w4 = *(const LAS f32x4*)(rwS + e * D + 256 * k + 4 * lane_); a += r.v[4 * k] * w4.x + r.v[4 * k + 1] * w4.y + r.v[4 * k + 2] * w4.z + r.v[4 * k + 3] * w4.w; }
            lg[e] = a; }
        float t8[8], t4[4], t2[2];
#pragma unroll
        for (int i = 0; i < 8; ++i) { const float keep = hi5 ? lg[8 + i] : lg[i], give = hi5 ? lg[i] : lg[8 + i]; t8[i] = keep + __shfl_xor(give, 32); }
#pragma unroll
        for (int i = 0; i < 4; ++i) { const float keep = b4 ? t8[4 + i] : t8[i], give = b4 ? t8[i] : t8[4 + i]; t4[i] = keep + __shfl_xor(give, 16); }
#pragma unroll
        for (int i = 0; i < 2; ++i) { const float keep = b3 ? t4[2 + i] : t4[i], give = b3 ? t4[i] : t4[2 + i]; t2[i] = keep + __shfl_xor(give, 8); }
        float z = (b2 ? t2[1] : t2[0]) + __shfl_xor(b2 ? t2[0] : t2[1], 4);
        z += __shfl_xor(z, 2); z += __shfl_xor(z, 1);
        const float scm = 1.0f / (1.0f + __builtin_amdgcn_exp2f(-1.4426950408889634f * z)), a = scm + rbm;
        const float p4 = __shfl_xor(a, 4), p8 = __shfl_xor(a, 8), p12 = __shfl_xor(a, 12);
        const float hi01 = fmaxf(a, p4), lo01 = fminf(a, p4), hi23 = fmaxf(p8, p12), lo23 = fminf(p8, p12);
        const float gs = fmaxf(hi01, hi23) + fmaxf(fmaxf(lo01, lo23), fminf(hi01, hi23));
        const float g16 = __shfl_xor(gs, 16), g32 = __shfl_xor(gs, 32), g48 = __shfl_xor(gs, 48);
        const bool best = beats(gs, mygrp, g16, mygrp ^ 1) && beats(gs, mygrp, g32, mygrp ^ 2) && beats(gs, mygrp, g48, mygrp ^ 3);
        const int rank = (beats(p4, wi ^ 1, a, wi) ? 1 : 0) + (beats(p8, wi ^ 2, a, wi) ? 1 : 0) + (beats(p12, wi ^ 3, a, wi) ? 1 : 0);
        const bool sel = best && rank < 2;
        float tot = sel ? scm : 0.f; tot += __shfl_xor(tot, 4); tot += __shfl_xor(tot, 8);
        if (count && sel && (lane_ & 3) == 0) { const unsigned rk = atomicAdd((unsigned*)&lcnt[emine], 1u);
            list_a[emine * 128 + rk] = (int)((unsigned)(2 * m + rank) | ib); list_w[emine * 128 + rk] = scm / tot; }
    }
    __syncthreads();
    if (count) {
        if (tid_ < 16) { const unsigned n = lcnt[tid_]; lcnt[16 + tid_] = n ? atomicAdd((unsigned*)(F.ctl + CW_CNT + l * 128 + tid_), n) : 0u; }
        __syncthreads();
        for (int idx = tid_; idx < 16 * 128; idx += NTHR) { const int e = idx >> 7, rk = idx & 127;
            if (rk < (int)lcnt[e]) { const size_t slot = (size_t)e * SLOT_CAP + lcnt[16 + e] + rk; slot_a[slot] = list_a[idx]; slot_w[slot] = list_w[idx]; } }
    }
}

DI void moe_tstart(Frame& F, int l) {
    FRAME_IDS
    volatile LAS int* ts = (volatile LAS int*)(F.lds + LDSCTL_OFF);
    __syncthreads();
    if (tid_ == 0) { int acc = 0;
        for (int e = 0; e < 16; ++e) { ts[e] = acc; const unsigned c = __hip_atomic_load(F.ctl + CW_CNT + l * 128 + e, RLX_AGENT); ts[32 + e] = (int)c; acc += (int)((c + 255u) >> 8); }
        ts[16] = acc; }
    __syncthreads();
}
DI void p_row_c(Frame& F, const Args& A, int l) {
    FRAME_IDS
    const int gw = F.vcu * NWAVES + wave_, NGW = F.G * NWAVES;
    const bf16* X1 = (const bf16*)(F.ws + WS_PRE); bf16* R2 = (bf16*)(F.ws + WS_ROWS2); bf16* XN = (bf16*)(F.ws + WS_XN);
    const float* ln1g = (const float*)A.in[I_LN1G] + l * D; const float* ln1b = (const float*)A.in[I_LN1B] + l * D;
    Row16 lg1, lb1; row_load_f32(lg1, ln1g, lane_); row_load_f32(lb1, ln1b, lane_);
    const float* mod = (const float*)(F.ws + WS_MOD) + (size_t)l * BATCH * 6 * D;
    const float* modn = (const float*)(F.ws + WS_MOD) + (size_t)(l + 1) * BATCH * 6 * D;
    const float* ln2g = (const float*)A.in[I_LN2G] + l * D; const float* ln2b = (const float*)A.in[I_LN2B] + l * D;
    Row16 lg2, lb2; row_load_f32(lg2, ln2g, lane_); row_load_f32(lb2, ln2b, lane_);
    v2u nx[4], n0[4], n1[4];
#define RC_LOAD(mm) do { const v2u* qa = (const v2u*)(X1 + (size_t)(mm) * D); const v2u* qb = (const v2u*)(R2 + (size_t)(2 * (mm)) * D); \
        _Pragma("unroll") for (int k = 0; k < 4; ++k) { nx[k] = __builtin_nontemporal_load(&qa[k * 64 + lane_]); n0[k] = __builtin_nontemporal_load(&qb[k * 64 + lane_]); n1[k] = __builtin_nontemporal_load(&qb[256 + k * 64 + lane_]); } } while (0)
    const int bq = gw / (NGW / BATCH), mbase = bq * T + gw % (NGW / BATCH), mstep = NGW / BATCH;
    const float* md = mod + (size_t)bq * 6 * D;
    Row16 gm; row_load_f32(gm, md + 5 * D, lane_);
    Row16 msc, msh;
    if (l != DEPTH - 1) { const float* mdn = modn + (size_t)bq * 6 * D; row_load_f32(msc, mdn + 1 * D, lane_); row_load_f32(msh, mdn + 0 * D, lane_); }
    RC_LOAD(mbase);
    for (int m = mbase; m < (bq + 1) * T; m += mstep) {
        Row16 x1, g2;
#pragma unroll
        for (int k = 0; k < 4; ++k) {
            x1.v[4 * k] = bflo(nx[k].x); x1.v[4 * k + 1] = bfhi(nx[k].x); x1.v[4 * k + 2] = bflo(nx[k].y); x1.v[4 * k + 3] = bfhi(nx[k].y);
            g2.v[4 * k] = bflo(n0[k].x) + bflo(n1[k].x); g2.v[4 * k + 1] = bfhi(n0[k].x) + bfhi(n1[k].x); g2.v[4 * k + 2] = bflo(n0[k].y) + bflo(n1[k].y); g2.v[4 * k + 3] = bfhi(n0[k].y) + bfhi(n1[k].y); }
        if (m + mstep < (bq + 1) * T) RC_LOAD(m + mstep);
        row_ln(x1);
#pragma unroll
        for (int i = 0; i < 16; ++i) x1.v[i] = ALPHA * (x1.v[i] * lg1.v[i] + lb1.v[i]) + (1.0f + gm.v[i]) * g2.v[i];
        row_ln(x1);
#pragma unroll
        for (int i = 0; i < 16; ++i) x1.v[i] = x1.v[i] * lg2.v[i] + lb2.v[i];
        if (l == DEPTH - 1) row_store_f32(x1, A.out + (size_t)m * D, lane_);
        else { row_store_bf16(x1, R2 + (size_t)(2 * m) * D, lane_);
            row_ln(x1);
#pragma unroll
            for (int i = 0; i < 16; ++i) x1.v[i] = x1.v[i] * (1.0f + msc.v[i]) + msh.v[i];
            row_store_bf16(x1, XN + (size_t)m * D, lane_); }
    }
#undef RC_LOAD
}

#ifndef PHMASK
#define PHMASK 0xFFFFFFFFu
#endif
#define IN(k) (lo <= (k) && (k) < hi && ((PHMASK >> (((k) == 0) ? 31 : (((k) - 1) % PH_PER_LAYER))) & 1u))
#define SEAM(k) do { if (IN((k) + 1) && MK_ONE_LAUNCH) xcd_barrier(bar); else __syncthreads(); } while (0)
constexpr int PH_PER_LAYER = 9, N_PHASES = 1 + DEPTH * PH_PER_LAYER;
#ifndef REP_PH
#define REP_PH -1
#endif
#define NREP(k) (((k) == REP_PH) ? 2 : 1)
template <int l> DI void layer_body(Frame& F, const Args& args, const XcdBarrier& bar, const int lo, const int hi) {
    unsigned char* ws = args.ws;

        const int pb = 1 + l * PH_PER_LAYER;
        const bf16* WinT = (const bf16*)(ws + WS_WSMALL + l * WSMALL_LAYER + WOFF_IN);
        const bf16* WoutT = (const bf16*)(ws + WS_WSMALL + l * WSMALL_LAYER + WOFF_OUT);
        const bf16* GluT = (const bf16*)(ws + WS_WSMALL + l * WSMALL_LAYER + WOFF_GLU);
        const float* modl = (const float*)(ws + WS_MOD) + (size_t)l * BATCH * 6 * D;
        if (l == 0 && IN(pb + 0)) { p_wconv(F, args, 0, 4); p_wconv(F, args, 1, 4); p_ln_a0(F, args); SEAM(pb + 0); }
        if (IN(pb + 1)) for (int rep_ = 0; rep_ < NREP(1); ++rep_) {
            pg8::Gemm g{(const bf16*)(ws + WS_XN), WinT, M, PROJW, D}; pg8::StaticOrder S; S.init(M, PROJW, F.G, (int)blockIdx.x);
            EpiInProj E{(bf16*)(ws + WS_PROJ), (const float*)(ws + WS_ROPE), args.pad};
            pg8::gemm_phase<EpiInProj, pg8::StaticOrder, PG8_ALIGN, PG8_SP2>(F.lds + RING_OFF, g, S, E);
            if (F.G == 256 && blockIdx.x >= 128) { __syncthreads(); p_wconv_gu(F, args, l, 256 + (int)blockIdx.x - 128, 128, WC_NGU); }
            SEAM(pb + 1); }
        if (IN(pb + 2)) for (int rep_ = 0; rep_ < NREP(2); ++rep_) {
#ifndef REP_SUB
#define REP_SUB -1
#endif
#define SUBREP(k) for (int rs_ = 0; rs_ < ((REP_SUB == (k)) ? 2 : 1); ++rs_)
            SUBREP(0) { mix_gating_mfma(F, args, l); __syncthreads(); }
#if REP_SUB >= 10 && REP_SUB < 20
            mix_gating_mfma(F, args, l, REP_SUB - 10); __syncthreads(); mix_gating_mfma(F, args, l); __syncthreads();
#endif
 SUBREP(1) { mix_ssm_in(F, l); } SUBREP(2) { mix_attn_mfma<0>(F, l); __syncthreads(); } SEAM(pb + 2); }
        if (IN(pb + 3)) for (int rep_ = 0; rep_ < NREP(3); ++rep_) { SUBREP(3) { mix_ssm_out(F, args, l); __syncthreads(); } SUBREP(4) { mix_attn_mfma<1>(F, l); __syncthreads(); } SEAM(pb + 3); }
        if (IN(pb + 4)) for (int rep_ = 0; rep_ < NREP(4); ++rep_) { p_glu(F, args, l); SEAM(pb + 4); }
        if (IN(pb + 5)) for (int rep_ = 0; rep_ < NREP(5); ++rep_) {
            pg8::Gemm g{(const bf16*)(ws + WS_MIXCAT), WoutT, M, D, D}; pg8::StaticOrder S; S.init(M, D, F.G, (int)blockIdx.x);
            if (l == 0) { EpiOut<true> E{(bf16*)(ws + WS_PRE), args.in[I_X], D, modl}; pg8::gemm_phase<EpiOut<true>, pg8::StaticOrder, PG8_ALIGN, PG8_SP2>(F.lds + RING_OFF, g, S, E); }
            else { EpiOut<false> E{(bf16*)(ws + WS_PRE), (const void*)(ws + WS_ROWS2), 2 * D, modl}; pg8::gemm_phase<EpiOut<false>, pg8::StaticOrder, PG8_ALIGN, PG8_SP2>(F.lds + RING_OFF, g, S, E); }
            SEAM(pb + 5); }
        if (IN(pb + 6)) { p_row_b(F, args, l); SUBREP(5) { if (REP_SUB == 5 && rs_ == 0) { __syncthreads(); p_row_b(F, args, l, false); } } SEAM(pb + 6); }
        if (IN(pb + 7)) { moe_tstart(F, l);
            gu32* dcnt = F.ctl + CW_DONE + l * 512;
            if (args.pad != 4)
            { pg8::Gemm g{(const bf16*)(ws + WS_XN), (const bf16*)(ws + WS_WGU), NSLOT_MAX, NEXP * 1024, D / 2};
              MoeOrderK<0> S{(const volatile LAS int*)(F.lds + LDSCTL_OFF), F.G, (int)blockIdx.x, (const int*)(ws + WS_SLOT_A), (const float*)(ws + WS_SLOT_W), dcnt, F.ctl + CW_QUEUE + l * 128, (volatile LAS int*)(F.lds + LDSCTL_OFF + 256)}; EpiG1 E{(bf16*)(ws + WS_HID), args.pad, (const float*)(ws + WS_CINV) + (size_t)l * 16 * 2 * 512};
              pg8::gemm_phase_g<EpiG1, MoeOrderK<0>, PG8_ALIGN, PG8_SP2, 0, true>(F.lds + RING_OFF, F.lds + GT_OFF, g, S, E); }
            if (args.pad != 3)
            { pg8::Gemm g{(const bf16*)(ws + WS_HID), (const bf16*)(ws + WS_WD), NSLOT_MAX, NEXP * 1024, DEXP};
              MoeOrderK<1> S{(const volatile LAS int*)(F.lds + LDSCTL_OFF), F.G, (int)blockIdx.x, (const int*)(ws + WS_SLOT_A), (const float*)(ws + WS_SLOT_W), dcnt, F.ctl + CW_QUEUE + l * 128, (volatile LAS int*)(F.lds + LDSCTL_OFF + 256)}; EpiG2 E{(bf16*)(ws + WS_ROWS2), args.pad};
              pg8::gemm_phase_g<EpiG2, MoeOrderK<1>, PG8_ALIGN, PG8_SP2, 0>(F.lds + RING_OFF, F.lds + GT_OFF, g, S, E); }
            SEAM(pb + 7); }
        if (IN(pb + 8)) { p_row_c(F, args, l); if (l == 0) { __syncthreads(); p_wconv_items(F, args, 1, WC_NS, WC_NW); __syncthreads(); p_wconv_gu(F, args, 1, F.vcu, F.G, F.G == 256 ? 256 : WC_NGU); } SUBREP(6) { if (REP_SUB == 6 && rs_ == 0 && l == DEPTH - 1) { __syncthreads(); p_row_c(F, args, l); } } SEAM(pb + 8); }
    }
__global__ void __launch_bounds__(NTHR, 2) mk_fwd(Args args) {
    extern __shared__ __attribute__((aligned(16))) unsigned char lds[];
    Frame F;
    F.lds = (LAS unsigned char*)lds; F.MISC = (volatile LAS unsigned*)(F.lds + MISC_OFF);
    F.G = gridDim.x; { const int bx = blockIdx.x; F.vcu = (F.G % 8 == 0) ? (bx % 8) * (F.G / 8) + bx / 8 : bx; }
    F.ws = args.ws; F.ctl = (gu32*)(args.ws + WS_CTL);
    for (int u = ftid(); u < (LDS_BYTES - LDSCTL_OFF) / 4; u += NTHR) ((LAS unsigned*)(F.lds + LDSCTL_OFF))[u] = 0u;
    __syncthreads();
    XcdBarrier bar; bar.bar = (unsigned*)(F.ctl + CW_BAR); bar.x = 0; bar.st = nullptr;
    if (MK_ONE_LAUNCH) bar = xcd_barrier_post((unsigned*)(F.ctl + CW_BAR), F.MISC + 8);
    const int lo = args.ph_lo, hi = args.ph_hi;
    unsigned char* ws = args.ws; (void)ws;
    if (IN(0)) { p0_tables(F, args); __syncthreads(); p_wconv_items(F, args, 0, 0, WC_NW); p_wconv_items(F, args, 1, 0, WC_NS); __syncthreads(); p_wconv_gu(F, args, 0, F.vcu, F.G, F.G == 256 ? 256 : WC_NGU); SEAM(0); }
    layer_body<0>(F, args, bar, lo, hi);
    layer_body<1>(F, args, bar, lo, hi);
#ifdef EXTRA_BARS
    if (MK_ONE_LAUNCH) for (int xb_ = 0; xb_ < EXTRA_BARS; ++xb_) xcd_barrier(bar);
#endif
#undef IN
#undef SEAM
}

extern "C" void kernel_launch(void* const* d_in, const int* in_sizes, int n_in, void* d_out, int out_size, void* d_ws, size_t ws_size, hipStream_t stream) {
    static int grid = 0;
    if (grid == 0) {
        if (n_in != 30 || in_sizes[0] != M * D || out_size != M * D || ws_size < WS_END) { fprintf(stderr, "kernel_launch: unexpected shapes (n_in %d, in0 %d, out %d, ws %zu, need %zu)\n", n_in, n_in > 0 ? in_sizes[0] : -1, out_size, ws_size, (size_t)WS_END); grid = -1; return; }
        int dev = 0, cus = 0, per_cu = 0;
        if (hipGetDevice(&dev) != hipSuccess || hipDeviceGetAttribute(&cus, hipDeviceAttributeMultiprocessorCount, dev) != hipSuccess) { grid = -1; return; }
        if (hipFuncSetAttribute((const void*)mk_fwd, hipFuncAttributeMaxDynamicSharedMemorySize, LDS_BYTES) != hipSuccess) { fprintf(stderr, "kernel_launch: hipFuncSetAttribute failed\n"); grid = -1; return; }
        if (hipOccupancyMaxActiveBlocksPerMultiprocessor(&per_cu, (const void*)mk_fwd, NTHR, LDS_BYTES) != hipSuccess || per_cu < 1) fprintf(stderr, "kernel_launch: occupancy query says %d\n", per_cu);
        (void)hipGetLastError();
        grid = cus;
    }
    if (grid < 0) return;
    if (hipMemsetAsync((char*)d_ws + WS_CTL, 0, CTL_ZERO_BYTES, stream) != hipSuccess) return;
    Args a{};
    for (int i = 0; i < 30; ++i) a.in[i] = d_in[i];
    a.out = (float*)d_out; a.ws = (unsigned char*)d_ws;
#if MK_ONE_LAUNCH
    a.ph_lo = 0; a.ph_hi = N_PHASES; a.li = 0;
    hipLaunchKernelGGL(mk_fwd, dim3(grid), dim3(NTHR), LDS_BYTES, stream, a);
#else
#ifndef REP_GLOBAL
#define REP_GLOBAL -1
#endif
#ifndef PROBE_SKIP
#define PROBE_SKIP 1
#endif
#ifndef REP_COUNT
#define REP_COUNT 2
#endif
    for (int p = 0; p < N_PHASES; ++p) { a.ph_lo = p; a.ph_hi = p + 1; a.li = p;
        const int nrep = ((p == 0 ? 100 : (p - 1) % PH_PER_LAYER) == REP_GLOBAL) ? REP_COUNT : 1;
        for (int r = 0; r < nrep; ++r) { a.pad = r ? PROBE_SKIP : 0; hipLaunchKernelGGL(mk_fwd, dim3(grid), dim3(NTHR), LDS_BYTES, stream, a); } a.pad = 0; }
#endif
}
```

```cpp
#include <hip/hip_runtime.h>
#include <cstdio>
#include <cstdint>
namespace pg8 {
#define PG8_LAS __attribute__((address_space(3)))
typedef unsigned short bf16_t;
typedef short bf16x8 __attribute__((ext_vector_type(8)));
typedef float f32x4 __attribute__((ext_vector_type(4)));
typedef unsigned u32x4 __attribute__((ext_vector_type(4)));
constexpr int BM = 256, BK = 64, HALF = 128, HTB = HALF * BK * 2  , STAGE_BYTES = 8 * HTB, NXCD = 8, WGM = 8;

__host__ __device__ __forceinline__ int lds_byte(int r, int c) { const int st = (r >> 4) * 2 + (c >> 5), rr = r & 15, cc = c & 31, ob = rr * 64 + cc * 2; return st * 1024 + (ob ^ (((ob >> 9) & 1) << 5)); }
__host__ __device__ __forceinline__ void stage_rc(int b, int& R, int& C) { const int st = b / 1024, sb = b % 1024, swz = sb ^ (((sb >> 9) & 1) << 5); R = (st >> 1) * 16 + swz / 64; C = (st & 1) * 32 + (swz % 64) / 2; }
__host__ __device__ __forceinline__ int perm32(int rho) { const int n = rho >> 4, i = rho & 15; return 8 * (i >> 2) + 4 * n + (i & 3); }

struct Unit { int pm, pn; };
struct Gemm { const bf16_t* A; const bf16_t* Bt; int M, N, K; };

struct StaticOrder {
    int nM, nN, nwg, G, c;
    __host__ __device__ void init(int M, int N, int G_, int c_) { nM = M / BM; nN = N / BM; nwg = nM * nN; G = G_; c = c_; }
    __host__ __device__ bool next(int i, Unit& u) const {
        const long L = (long)i * G + c; if (L >= nwg) return false;
        int wgid = (int)L; { const int q = nwg / NXCD, r = nwg % NXCD, xcd = wgid % NXCD, off = wgid / NXCD; wgid = (xcd < r ? xcd * (q + 1) : r * (q + 1) + (xcd - r) * q) + off; }
        const int nig = WGM * nN, gid = wgid / nig, fm = gid * WGM, gsz = (nM - fm) < WGM ? (nM - fm) : WGM;
        u.pm = fm + ((wgid % nig) % gsz); u.pn = (wgid % nig) / gsz; return true;
    }
    __device__ __forceinline__ void a_ready(const Unit&) const {}
    __device__ __forceinline__ void done(const Unit&) const {}
};

__device__ __forceinline__ unsigned cvt_pk_bf16(float lo, float hi) { unsigned r; asm volatile("v_cvt_pk_bf16_f32 %0, %1, %2" : "=v"(r) : "v"(lo), "v"(hi)); return r; }
template <class Epi, class Sched, bool ALIGN_EPI = false, bool SP2 = false, bool FP8 = false>
__device__ __forceinline__ void gemm_phase(PG8_LAS unsigned char* lds, const Gemm g, const Sched& S, const Epi& E) {
    const int tid = threadIdx.x, wid = __builtin_amdgcn_readfirstlane(tid >> 6), lane = tid & 63, wr = wid >> 2, wc = wid & 3, fr = lane & 15, fq = lane >> 4;
    const int K = g.K, nt = K / BK;
    unsigned voffA[2], voffB[2];
#pragma unroll
    for (int i = 0; i < 2; ++i) { int R, C; stage_rc(tid * 16 + i * 8192, R, C); const int Rb = Epi::PERM ? ((R & ~31) + perm32(R & 31)) : R;
        voffA[i] = (unsigned)(R * K + C) * 2u; voffB[i] = (unsigned)(Rb * K + C) * 2u; }
    const size_t kstep = (size_t)(BK * 2);
    const size_t hstep = (size_t)HALF * K * 2;
    const size_t tstep = 2 * hstep;
    const unsigned ldsw = (unsigned)wid * 1024u;
    const int aoff = lds_byte(wr * 64 + fr, fq * 8), boff = lds_byte(wc * 32 + fr, fq * 8);
#define PG8_SA(b, h) (((b) * 2 + (h)) * HTB)
#define PG8_SB(b, h) ((4 + (b) * 2 + (h)) * HTB)
#define PG8_STAGE(bufoff, gbase, voff) do { _Pragma("unroll") for (int _i = 0; _i < 2; ++_i) \
        __builtin_amdgcn_global_load_lds((const unsigned*)((const char*)(gbase) + (voff)[_i]), (PG8_LAS unsigned*)(lds + (bufoff) + ldsw + _i * 8192), 16, 0, 0); } while (0)
#define PG8_LDA(dst, b, h) do { if constexpr (FP8) { _Pragma("unroll") for (int m = 0; m < 4; ++m) { const PG8_LAS unsigned char* p_ = lds + PG8_SA(b, h) + aoff + m * 2048; \
            const i32x4_t lo_ = *(const PG8_LAS i32x4_t*)p_, hi_ = *(const PG8_LAS i32x4_t*)(p_ + 1024); dst##q[m] = __builtin_shufflevector(lo_, hi_, 0, 1, 2, 3, 4, 5, 6, 7); } } \
        else { _Pragma("unroll") for (int m = 0; m < 4; ++m) _Pragma("unroll") for (int k = 0; k < 2; ++k) dst[m][k] = *(const PG8_LAS bf16x8*)(lds + PG8_SA(b, h) + aoff + m * 2048 + k * 1024); } } while (0)
#define PG8_LDB(dst, b, h) do { if constexpr (FP8) { _Pragma("unroll") for (int n = 0; n < 2; ++n) { const PG8_LAS unsigned char* p_ = lds + PG8_SB(b, h) + boff + n * 2048; \
            const i32x4_t lo_ = *(const PG8_LAS i32x4_t*)p_, hi_ = *(const PG8_LAS i32x4_t*)(p_ + 1024); dst##q[n] = __builtin_shufflevector(lo_, hi_, 0, 1, 2, 3, 4, 5, 6, 7); } } \
        else { _Pragma("unroll") for (int n = 0; n < 2; ++n) _Pragma("unroll") for (int k = 0; k < 2; ++k) dst[n][k] = *(const PG8_LAS bf16x8*)(lds + PG8_SB(b, h) + boff + n * 2048 + k * 1024); } } while (0)
#define PG8_MMA(ai, bj, At, Bt) do { __builtin_amdgcn_s_setprio(1); \
        if constexpr (FP8) { _Pragma("unroll") for (int m = 0; m < 4; ++m) _Pragma("unroll") for (int n = 0; n < 2; ++n) { const int o_ = 8 * m + 4 * n; \
                f32x4 c_ = {accq[ai][bj][o_], accq[ai][bj][o_ + 1], accq[ai][bj][o_ + 2], accq[ai][bj][o_ + 3]}; \
                c_ = __builtin_amdgcn_mfma_scale_f32_16x16x128_f8f6f4(Bt##q[n], At##q[m], c_, 0, 0, 0, 0x7f7f7f7f, 0, 0x7f7f7f7f); \
                accq[ai][bj][o_] = c_[0]; accq[ai][bj][o_ + 1] = c_[1]; accq[ai][bj][o_ + 2] = c_[2]; accq[ai][bj][o_ + 3] = c_[3]; } } \
        else { _Pragma("unroll") for (int m = 0; m < 4; ++m) _Pragma("unroll") for (int n = 0; n < 2; ++n) _Pragma("unroll") for (int k = 0; k < 2; ++k) \
            acc[ai][bj][m][n] = __builtin_amdgcn_mfma_f32_16x16x32_bf16(Bt[n][k], At[m][k], acc[ai][bj][m][n], 0, 0, 0); } \
        __builtin_amdgcn_s_setprio(0); } while (0)
#define PG8_WAIT_V(n) asm volatile("s_waitcnt vmcnt(" #n ")" ::: "memory")
#define PG8_WAIT_L(n) asm volatile("s_waitcnt lgkmcnt(" #n ")" ::: "memory")
#define PG8_BAR __builtin_amdgcn_s_barrier()
#define PG8_SCHED __builtin_amdgcn_sched_barrier(0)
    Unit cur, nxt; int ui = 0;
    if (!S.next(0, cur)) return;
    f32x4 acc[2][2][4][2];
    typedef float f32x32_t __attribute__((ext_vector_type(32)));
    f32x32_t accq[2][2];
    if constexpr (FP8) { accq[0][0] = (f32x32_t)(0.f); accq[0][1] = (f32x32_t)(0.f); accq[1][0] = (f32x32_t)(0.f); accq[1][1] = (f32x32_t)(0.f); } (void)accq;
#pragma unroll
    for (int a = 0; a < 2; ++a)
#pragma unroll
        for (int b = 0; b < 2; ++b)
#pragma unroll
            for (int m = 0; m < 4; ++m)
#pragma unroll
                for (int n = 0; n < 2; ++n) acc[a][b][m][n] = (f32x4){0.f, 0.f, 0.f, 0.f};
    typedef int v8i_t __attribute__((ext_vector_type(8))); typedef int i32x4_t __attribute__((ext_vector_type(4)));
    bf16x8 At[4][2], B0[2][2], B1[2][2]; v8i_t Atq[4], B0q[2], B1q[2];
    (void)At; (void)B0; (void)B1; (void)Atq; (void)B0q; (void)B1q;
    const char* cA = (const char*)g.A + (size_t)cur.pm * tstep; const char* cB = (const char*)g.Bt + (size_t)cur.pn * tstep;
    S.a_ready(cur);
    if constexpr (SP2) {
        PG8_STAGE(PG8_SB(0, 0), cB, voffB); PG8_STAGE(PG8_SB(0, 1), cB + hstep, voffB); PG8_STAGE(PG8_SA(0, 0), cA, voffA); PG8_STAGE(PG8_SA(0, 1), cA + hstep, voffA);
        if (wr == 1) PG8_BAR;
        PG8_WAIT_V(2); PG8_BAR;
        PG8_STAGE(PG8_SB(1, 0), cB + kstep, voffB); PG8_STAGE(PG8_SA(1, 0), cA + kstep, voffA); PG8_STAGE(PG8_SB(1, 1), cB + hstep + kstep, voffB);
        PG8_WAIT_V(6); PG8_BAR;
    } else {
        PG8_STAGE(PG8_SB(0, 0), cB, voffB); PG8_STAGE(PG8_SA(0, 0), cA, voffA); PG8_STAGE(PG8_SB(0, 1), cB + hstep, voffB); PG8_STAGE(PG8_SA(0, 1), cA + hstep, voffA);
        if (wr == 1) PG8_BAR;
        PG8_WAIT_V(4); PG8_BAR;
        PG8_STAGE(PG8_SB(1, 0), cB + kstep, voffB); PG8_STAGE(PG8_SA(1, 0), cA + kstep, voffA); PG8_STAGE(PG8_SB(1, 1), cB + hstep + kstep, voffB);
        PG8_WAIT_V(6); PG8_BAR;
    }
    for (;;) {
        const bool has_next = S.next(ui + 1, nxt);
        const char* nA = has_next ? (const char*)g.A + (size_t)nxt.pm * tstep : cA; const char* nB = has_next ? (const char*)g.Bt + (size_t)nxt.pn * tstep : cB;
#pragma unroll 1
        for (int t = 0; t < nt; t += 2) {
            const bool last = (t == nt - 2);
            const char* a1 = cA + (size_t)(t + 1) * kstep;
            const char* a2 = last ? nA : cA + (size_t)(t + 2) * kstep; const char* b2 = last ? nB : cB + (size_t)(t + 2) * kstep;
            const char* a3 = a2 + kstep; const char* b3 = b2 + kstep;
            if (last && has_next) S.a_ready(nxt);
            if constexpr (SP2) {
            PG8_LDB(B0, 0, 0); PG8_LDB(B1, 0, 1); PG8_SCHED; PG8_LDA(At, 0, 0); PG8_STAGE(PG8_SA(1, 1), a1 + hstep, voffA);
            PG8_WAIT_V(8); PG8_WAIT_L(0); PG8_BAR; PG8_MMA(0, 0, At, B0); PG8_MMA(0, 1, At, B1); PG8_BAR; PG8_SCHED;
            PG8_LDA(At, 0, 1); PG8_STAGE(PG8_SB(0, 0), b2, voffB); PG8_STAGE(PG8_SB(0, 1), b2 + hstep, voffB); PG8_STAGE(PG8_SA(0, 0), a2, voffA);
            PG8_WAIT_V(8); PG8_WAIT_L(0); PG8_BAR; PG8_MMA(1, 0, At, B0); PG8_MMA(1, 1, At, B1); PG8_BAR; PG8_SCHED;
            PG8_LDB(B0, 1, 0); PG8_LDB(B1, 1, 1); PG8_SCHED; PG8_LDA(At, 1, 0); PG8_STAGE(PG8_SA(0, 1), a2 + hstep, voffA);
            PG8_WAIT_V(8); PG8_WAIT_L(0); PG8_BAR; PG8_MMA(0, 0, At, B0); PG8_MMA(0, 1, At, B1); PG8_BAR; PG8_SCHED;
            PG8_LDA(At, 1, 1); PG8_STAGE(PG8_SB(1, 0), b3, voffB); PG8_STAGE(PG8_SB(1, 1), b3 + hstep, voffB); PG8_STAGE(PG8_SA(1, 0), a3, voffA);
            PG8_WAIT_V(8); PG8_WAIT_L(0); PG8_BAR; PG8_MMA(1, 0, At, B0); PG8_MMA(1, 1, At, B1); PG8_BAR; PG8_SCHED;
            } else {
            PG8_LDB(B0, 0, 0); PG8_SCHED; PG8_LDA(At, 0, 0); PG8_STAGE(PG8_SA(1, 1), a1 + hstep, voffA);
            PG8_WAIT_L(8); PG8_BAR; PG8_WAIT_L(0); PG8_MMA(0, 0, At, B0); PG8_BAR; PG8_SCHED;
            PG8_LDB(B1, 0, 1); PG8_STAGE(PG8_SB(0, 0), b2, voffB);
            PG8_BAR; PG8_WAIT_L(0); PG8_MMA(0, 1, At, B1); PG8_BAR;
            PG8_LDA(At, 0, 1); PG8_STAGE(PG8_SA(0, 0), a2, voffA);
            PG8_BAR; PG8_WAIT_L(0); PG8_MMA(1, 0, At, B0); PG8_BAR; PG8_SCHED;
            PG8_STAGE(PG8_SB(0, 1), b2 + hstep, voffB);
            PG8_WAIT_V(6); PG8_BAR; PG8_MMA(1, 1, At, B1); PG8_BAR;
            PG8_LDB(B0, 1, 0); PG8_SCHED; PG8_LDA(At, 1, 0); PG8_STAGE(PG8_SA(0, 1), a2 + hstep, voffA);
            PG8_WAIT_L(8); PG8_BAR; PG8_WAIT_L(0); PG8_MMA(0, 0, At, B0); PG8_BAR; PG8_SCHED;
            PG8_LDB(B1, 1, 1); PG8_STAGE(PG8_SB(1, 0), b3, voffB);
            PG8_BAR; PG8_WAIT_L(0); PG8_MMA(0, 1, At, B1); PG8_BAR;
            PG8_LDA(At, 1, 1); PG8_STAGE(PG8_SA(1, 0), a3, voffA);
            PG8_BAR; PG8_WAIT_L(0); PG8_MMA(1, 0, At, B0); PG8_BAR; PG8_SCHED;
            PG8_STAGE(PG8_SB(1, 1), b3 + hstep, voffB);
            PG8_WAIT_V(6); PG8_BAR; PG8_MMA(1, 1, At, B1); PG8_BAR;
            }
        }
        if constexpr (ALIGN_EPI) { if (wr == 0) PG8_BAR; }
        if constexpr (FP8) {
#pragma unroll
            for (int a = 0; a < 2; ++a)
#pragma unroll
                for (int b = 0; b < 2; ++b)
#pragma unroll
                    for (int m = 0; m < 4; ++m)
#pragma unroll
                        for (int n = 0; n < 2; ++n) { const int o_ = 8 * m + 4 * n; acc[a][b][m][n] = (f32x4){accq[a][b][o_], accq[a][b][o_ + 1], accq[a][b][o_ + 2], accq[a][b][o_ + 3]}; }
        }
        if constexpr (!Epi::AFTER_DRAIN) { E(acc, cur, wr, wc, fr, fq); S.done(cur); }
        if (!has_next) break;
#pragma unroll
        for (int a = 0; a < 2; ++a)
#pragma unroll
            for (int b = 0; b < 2; ++b)
#pragma unroll
                for (int m = 0; m < 4; ++m)
#pragma unroll
                    for (int n = 0; n < 2; ++n) acc[a][b][m][n] = (f32x4){0.f, 0.f, 0.f, 0.f};
        if constexpr (FP8) { accq[0][0] = (f32x32_t)(0.f); accq[0][1] = (f32x32_t)(0.f); accq[1][0] = (f32x32_t)(0.f); accq[1][1] = (f32x32_t)(0.f); }
        cur = nxt; cA = nA; cB = nB; ++ui;
        if constexpr (ALIGN_EPI) { if (wr == 1) PG8_BAR; }
    }
    PG8_WAIT_V(0);
    if constexpr (!ALIGN_EPI) { if (wr == 0) PG8_BAR; }
    PG8_BAR;
    if constexpr (Epi::AFTER_DRAIN) { E.fused(acc, cur, wr, wc, fr, fq, lds, wid, lane); S.done(cur); }
#undef PG8_SA
#undef PG8_SB
#undef PG8_STAGE
#undef PG8_LDA
#undef PG8_LDB
#undef PG8_MMA
#undef PG8_WAIT_V
#undef PG8_WAIT_L
#undef PG8_BAR
#undef PG8_SCHED
}
template <class Epi, class Sched, bool ALIGN_EPI = false, bool SP2 = false, int AUXA = 0, bool FP8 = false>
__device__ __forceinline__ void gemm_phase_g(PG8_LAS unsigned char* lds, PG8_LAS unsigned char* gt, const Gemm g, const Sched& S, const Epi& E) {
    const int tid = threadIdx.x, wid = __builtin_amdgcn_readfirstlane(tid >> 6), lane = tid & 63, wr = wid >> 2, wc = wid & 3, fr = lane & 15, fq = lane >> 4;
    const int K = g.K, nt = K / BK;
    unsigned gpk0, voffB[2];
#pragma unroll
    for (int i = 0; i < 2; ++i) { int R, C; stage_rc(tid * 16 + i * 8192, R, C); const int Rb = Epi::PERM ? ((R & ~31) + perm32(R & 31)) : R;
        if (i == 0) gpk0 = (unsigned)(R * 4) | ((unsigned)(C * 2) << 16); voffB[i] = (unsigned)(Rb * K + C) * 2u; }
    int par = 0;
    const size_t kstep = (size_t)(BK * 2);
    const size_t hstep = (size_t)HALF * K * 2;
    const size_t tstep = 2 * hstep;
    const unsigned ldsw = (unsigned)wid * 1024u;
    const int aoff = lds_byte(wr * 64 + fr, fq * 8), boff = lds_byte(wc * 32 + fr, fq * 8);
#define PG8_SA(b, h) (((b) * 2 + (h)) * HTB)
#define PG8_SB(b, h) ((4 + (b) * 2 + (h)) * HTB)
#define PG8_STAGE(bufoff, gbase, voff) do { _Pragma("unroll") for (int _i = 0; _i < 2; ++_i) \
        __builtin_amdgcn_global_load_lds((const unsigned*)((const char*)(gbase) + (voff)[_i]), (PG8_LAS unsigned*)(lds + (bufoff) + ldsw + _i * 8192), 16, 0, 0); } while (0)
#define PG8_STAGE_A(bufoff, h, kbyte, PAR) do { _Pragma("unroll") for (int _i = 0; _i < 2; ++_i) { \
        const unsigned _vo = *(const PG8_LAS unsigned*)(gt + ((PAR) * 768 + (h) * 128 + _i * 64) * 4 + (gpk0 & 0xffffu)) + (gpk0 >> 16); \
        __builtin_amdgcn_global_load_lds((const unsigned*)((const char*)g.A + (size_t)(kbyte) + _vo), (PG8_LAS unsigned*)(lds + (bufoff) + ldsw + _i * 8192), 16, 0, AUXA); } } while (0)
#define PG8_FILL(u, PAR, PF, UI) do { S.wait_ready(u, tid, PF); if (tid < 256) { unsigned o_, a0_, a1_; S.finish_meta(u, tid, PF, o_, a0_, a1_); PG8_LAS unsigned* t_ = (PG8_LAS unsigned*)(gt + ((PAR) * 768 + tid) * 4); t_[0] = o_; t_[256] = a0_; t_[512] = a1_; } S.pull_publish(tid, PF, UI); asm volatile("s_waitcnt lgkmcnt(0)" ::: "memory"); __builtin_amdgcn_s_barrier(); asm volatile("" ::: "memory"); } while (0)
#define PG8_LDA(dst, b, h) do { if constexpr (FP8) { _Pragma("unroll") for (int m = 0; m < 4; ++m) { const PG8_LAS unsigned char* p_ = lds + PG8_SA(b, h) + aoff + m * 2048; \
            const i32x4_t lo_ = *(const PG8_LAS i32x4_t*)p_, hi_ = *(const PG8_LAS i32x4_t*)(p_ + 1024); dst##q[m] = __builtin_shufflevector(lo_, hi_, 0, 1, 2, 3, 4, 5, 6, 7); } } \
        else { _Pragma("unroll") for (int m = 0; m < 4; ++m) _Pragma("unroll") for (int k = 0; k < 2; ++k) dst[m][k] = *(const PG8_LAS bf16x8*)(lds + PG8_SA(b, h) + aoff + m * 2048 + k * 1024); } } while (0)
#define PG8_LDB(dst, b, h) do { if constexpr (FP8) { _Pragma("unroll") for (int n = 0; n < 2; ++n) { const PG8_LAS unsigned char* p_ = lds + PG8_SB(b, h) + boff + n * 2048; \
            const i32x4_t lo_ = *(const PG8_LAS i32x4_t*)p_, hi_ = *(const PG8_LAS i32x4_t*)(p_ + 1024); dst##q[n] = __builtin_shufflevector(lo_, hi_, 0, 1, 2, 3, 4, 5, 6, 7); } } \
        else { _Pragma("unroll") for (int n = 0; n < 2; ++n) _Pragma("unroll") for (int k = 0; k < 2; ++k) dst[n][k] = *(const PG8_LAS bf16x8*)(lds + PG8_SB(b, h) + boff + n * 2048 + k * 1024); } } while (0)
#define PG8_MMA(ai, bj, At, Bt) do { __builtin_amdgcn_s_setprio(1); \
        if constexpr (FP8) { _Pragma("unroll") for (int m = 0; m < 4; ++m) _Pragma("unroll") for (int n = 0; n < 2; ++n) { const int o_ = 8 * m + 4 * n; \
                f32x4 c_ = {accq[ai][bj][o_], accq[ai][bj][o_ + 1], accq[ai][bj][o_ + 2], accq[ai][bj][o_ + 3]}; \
                c_ = __builtin_amdgcn_mfma_scale_f32_16x16x128_f8f6f4(Bt##q[n], At##q[m], c_, 0, 0, 0, 0x7f7f7f7f, 0, 0x7f7f7f7f); \
                accq[ai][bj][o_] = c_[0]; accq[ai][bj][o_ + 1] = c_[1]; accq[ai][bj][o_ + 2] = c_[2]; accq[ai][bj][o_ + 3] = c_[3]; } } \
        else { _Pragma("unroll") for (int m = 0; m < 4; ++m) _Pragma("unroll") for (int n = 0; n < 2; ++n) _Pragma("unroll") for (int k = 0; k < 2; ++k) \
            acc[ai][bj][m][n] = __builtin_amdgcn_mfma_f32_16x16x32_bf16(Bt[n][k], At[m][k], acc[ai][bj][m][n], 0, 0, 0); } \
        __builtin_amdgcn_s_setprio(0); } while (0)
#define PG8_WAIT_V(n) asm volatile("s_waitcnt vmcnt(" #n ")" ::: "memory")
#define PG8_WAIT_L(n) asm volatile("s_waitcnt lgkmcnt(" #n ")" ::: "memory")
#define PG8_BAR __builtin_amdgcn_s_barrier()
#define PG8_SCHED __builtin_amdgcn_sched_barrier(0)
    Unit cur, nxt; int ui = 0;
    if (!__builtin_amdgcn_readfirstlane((int)S.first(cur))) return;
    cur.pm = __builtin_amdgcn_readfirstlane(cur.pm); cur.pn = __builtin_amdgcn_readfirstlane(cur.pn);
    f32x4 acc[2][2][4][2];
    typedef float f32x32_t __attribute__((ext_vector_type(32)));
    f32x32_t accq[2][2];
    if constexpr (FP8) { accq[0][0] = (f32x32_t)(0.f); accq[0][1] = (f32x32_t)(0.f); accq[1][0] = (f32x32_t)(0.f); accq[1][1] = (f32x32_t)(0.f); } (void)accq;
#pragma unroll
    for (int a = 0; a < 2; ++a)
#pragma unroll
        for (int b = 0; b < 2; ++b)
#pragma unroll
            for (int m = 0; m < 4; ++m)
#pragma unroll
                for (int n = 0; n < 2; ++n) acc[a][b][m][n] = (f32x4){0.f, 0.f, 0.f, 0.f};
    typedef int v8i_t __attribute__((ext_vector_type(8))); typedef int i32x4_t __attribute__((ext_vector_type(4)));
    bf16x8 At[4][2], B0[2][2], B1[2][2]; v8i_t Atq[4], B0q[2], B1q[2];
    (void)At; (void)B0; (void)B1; (void)Atq; (void)B0q; (void)B1q;
    const char* cB = (const char*)g.Bt + (size_t)cur.pn * tstep;
    typename Sched::Pf pf; S.prefetch(cur, tid, pf); PG8_FILL(cur, 0, pf, -1);
    Unit pend; bool has_pend = false;
    if constexpr (SP2) {
        PG8_STAGE(PG8_SB(0, 0), cB, voffB); PG8_STAGE(PG8_SB(0, 1), cB + hstep, voffB); PG8_STAGE_A(PG8_SA(0, 0), 0, 0, par); PG8_STAGE_A(PG8_SA(0, 1), 1, 0, par);
        if (wr == 1) PG8_BAR;
        PG8_WAIT_V(2); PG8_BAR;
        PG8_STAGE(PG8_SB(1, 0), cB + kstep, voffB); PG8_STAGE_A(PG8_SA(1, 0), 0, kstep, par); PG8_STAGE(PG8_SB(1, 1), cB + hstep + kstep, voffB);
        PG8_WAIT_V(6); PG8_BAR;
    } else {
        PG8_STAGE(PG8_SB(0, 0), cB, voffB); PG8_STAGE_A(PG8_SA(0, 0), 0, 0, par); PG8_STAGE(PG8_SB(0, 1), cB + hstep, voffB); PG8_STAGE_A(PG8_SA(0, 1), 1, 0, par);
        if (wr == 1) PG8_BAR;
        PG8_WAIT_V(4); PG8_BAR;
        PG8_STAGE(PG8_SB(1, 0), cB + kstep, voffB); PG8_STAGE_A(PG8_SA(1, 0), 0, kstep, par); PG8_STAGE(PG8_SB(1, 1), cB + hstep + kstep, voffB);
        PG8_WAIT_V(6); PG8_BAR;
    }
    for (;;) {
        const bool has_next = __builtin_amdgcn_readfirstlane((int)S.more(ui + 1, nxt)) != 0;
        nxt.pm = __builtin_amdgcn_readfirstlane(nxt.pm); nxt.pn = __builtin_amdgcn_readfirstlane(nxt.pn);
        if (has_next) { S.prefetch(nxt, tid, pf); S.pull_issue(tid, pf); }
        const char* nB = has_next ? (const char*)g.Bt + (size_t)nxt.pn * tstep : cB;
#pragma unroll 1
        for (int t = 0; t < nt; t += 2) {
            const bool last = (t == nt - 2);
            const char* b2 = last ? nB : cB + (size_t)(t + 2) * kstep;
            const char* b3 = b2 + kstep;
            if (last && has_next) PG8_FILL(nxt, par ^ 1, pf, ui);
            const size_t kA2 = last ? (size_t)0 : (size_t)(t + 2) * kstep; const int pA2 = (last && has_next) ? (par ^ 1) : par;
            if constexpr (SP2) {
            PG8_LDB(B0, 0, 0); PG8_LDB(B1, 0, 1); PG8_SCHED; PG8_LDA(At, 0, 0); PG8_STAGE_A(PG8_SA(1, 1), 1, (size_t)(t + 1) * kstep, par);
            PG8_WAIT_V(8); PG8_WAIT_L(0); PG8_BAR; PG8_MMA(0, 0, At, B0); PG8_MMA(0, 1, At, B1); PG8_BAR; PG8_SCHED;
            PG8_LDA(At, 0, 1); PG8_STAGE(PG8_SB(0, 0), b2, voffB); PG8_STAGE(PG8_SB(0, 1), b2 + hstep, voffB); PG8_STAGE_A(PG8_SA(0, 0), 0, kA2, pA2);
            PG8_WAIT_V(8); PG8_WAIT_L(0); PG8_BAR; PG8_MMA(1, 0, At, B0); PG8_MMA(1, 1, At, B1); PG8_BAR; PG8_SCHED;
            PG8_LDB(B0, 1, 0); PG8_LDB(B1, 1, 1); PG8_SCHED; PG8_LDA(At, 1, 0); PG8_STAGE_A(PG8_SA(0, 1), 1, kA2, pA2);
            PG8_WAIT_V(8); PG8_WAIT_L(0); PG8_BAR; PG8_MMA(0, 0, At, B0); PG8_MMA(0, 1, At, B1); PG8_BAR; PG8_SCHED;
            PG8_LDA(At, 1, 1); PG8_STAGE(PG8_SB(1, 0), b3, voffB); PG8_STAGE(PG8_SB(1, 1), b3 + hstep, voffB); PG8_STAGE_A(PG8_SA(1, 0), 0, kA2 + kstep, pA2);
            PG8_WAIT_V(8); PG8_WAIT_L(0); PG8_BAR; PG8_MMA(1, 0, At, B0); PG8_MMA(1, 1, At, B1); PG8_BAR; PG8_SCHED;
            } else {
            PG8_LDB(B0, 0, 0); PG8_SCHED; PG8_LDA(At, 0, 0); PG8_STAGE_A(PG8_SA(1, 1), 1, (size_t)(t + 1) * kstep, par);
            PG8_WAIT_L(8); PG8_BAR; PG8_WAIT_L(0); PG8_MMA(0, 0, At, B0); PG8_BAR; PG8_SCHED;
            PG8_LDB(B1, 0, 1); PG8_STAGE(PG8_SB(0, 0), b2, voffB);
            PG8_BAR; PG8_WAIT_L(0); PG8_MMA(0, 1, At, B1); PG8_BAR;
            PG8_LDA(At, 0, 1); PG8_STAGE_A(PG8_SA(0, 0), 0, kA2, pA2);
            PG8_BAR; PG8_WAIT_L(0); PG8_MMA(1, 0, At, B0); PG8_BAR; PG8_SCHED;
            PG8_STAGE(PG8_SB(0, 1), b2 + hstep, voffB);
            PG8_WAIT_V(6); PG8_BAR; PG8_MMA(1, 1, At, B1); PG8_BAR;
            PG8_LDB(B0, 1, 0); PG8_SCHED; PG8_LDA(At, 1, 0); PG8_STAGE_A(PG8_SA(0, 1), 1, kA2, pA2);
            PG8_WAIT_L(8); PG8_BAR; PG8_WAIT_L(0); PG8_MMA(0, 0, At, B0); PG8_BAR; PG8_SCHED;
            PG8_LDB(B1, 1, 1); PG8_STAGE(PG8_SB(1, 0), b3, voffB);
            PG8_BAR; PG8_WAIT_L(0); PG8_MMA(0, 1, At, B1); PG8_BAR;
            PG8_LDA(At, 1, 1); PG8_STAGE_A(PG8_SA(1, 0), 0, kA2 + kstep, pA2);
            PG8_BAR; PG8_WAIT_L(0); PG8_MMA(1, 0, At, B0); PG8_BAR; PG8_SCHED;
            PG8_STAGE(PG8_SB(1, 1), b3 + hstep, voffB);
            PG8_WAIT_V(6); PG8_BAR; PG8_MMA(1, 1, At, B1); PG8_BAR;
            }
        }
        if constexpr (ALIGN_EPI) { if (wr == 0) PG8_BAR; }
        if constexpr (FP8) {
#pragma unroll
            for (int a = 0; a < 2; ++a)
#pragma unroll
                for (int b = 0; b < 2; ++b)
#pragma unroll
                    for (int m = 0; m < 4; ++m)
#pragma unroll
                        for (int n = 0; n < 2; ++n) { const int o_ = 8 * m + 4 * n; acc[a][b][m][n] = (f32x4){accq[a][b][o_], accq[a][b][o_ + 1], accq[a][b][o_ + 2], accq[a][b][o_ + 3]}; }
        }
        if constexpr (!Epi::AFTER_DRAIN) { if (has_pend) S.done_nowait(pend);     E(acc, cur, wr, wc, fr, fq, (const PG8_LAS unsigned*)(gt + par * 3072)); pend = cur; has_pend = true; }
        if (!has_next) break;
#pragma unroll
        for (int a = 0; a < 2; ++a)
#pragma unroll
            for (int b = 0; b < 2; ++b)
#pragma unroll
                for (int m = 0; m < 4; ++m)
#pragma unroll
                    for (int n = 0; n < 2; ++n) acc[a][b][m][n] = (f32x4){0.f, 0.f, 0.f, 0.f};
        if constexpr (FP8) { accq[0][0] = (f32x32_t)(0.f); accq[0][1] = (f32x32_t)(0.f); accq[1][0] = (f32x32_t)(0.f); accq[1][1] = (f32x32_t)(0.f); }
        cur = nxt; cB = nB; ++ui; par ^= 1;
        if constexpr (ALIGN_EPI) { if (wr == 1) PG8_BAR; }
    }
    PG8_WAIT_V(0);
    if constexpr (!ALIGN_EPI) { if (wr == 0) PG8_BAR; }
    PG8_BAR;
    if (has_pend) S.done_nowait(pend);
#undef PG8_SA
#undef PG8_SB
#undef PG8_STAGE
#undef PG8_STAGE_A
#undef PG8_FILL
#undef PG8_LDA
#undef PG8_LDB
#undef PG8_MMA
#undef PG8_WAIT_V
#undef PG8_WAIT_L
#undef PG8_BAR
#undef PG8_SCHED
}
}

#ifndef PG8_SP2
#define PG8_SP2 true
#endif
#ifndef PG8_ALIGN
#define PG8_ALIGN true
#endif
#ifndef MK_ONE_LAUNCH
#define MK_ONE_LAUNCH 1
#endif

constexpr int NWAVES = 8, NTHR = 512;
constexpr int BATCH = 8, T = 4096, D = 1024, M = BATCH * T, DEPTH = 2;
constexpr int PROJW = 2304, AW = 256, BW = 512, CW = 256, NH = 8, HD = 64;
constexpr int COL_U = 0, COL_V = 256, COL_Q = 512, COL_K = 1024, COL_VA = 1536, COL_S = 2048;
constexpr int NEXP = 16, DEXP = 512, NGRP = 4;
constexpr int SSM_G = 16, SSM_N = 64, SSM_C = 16;
constexpr float LN_EPS = 1e-5f;
constexpr float ALPHA = 1.41421356237309515f;
constexpr float QSCALE = 0.125f * 1.4426950408889634f;
constexpr int NSLOT_MAX = 2 * M + NEXP * 256;

constexpr size_t MiB = 1u << 20;
constexpr size_t WS_CTL = 0, CTL_ZERO_BYTES = 1 * MiB;
constexpr size_t WS_MOD = 1 * MiB;
constexpr size_t WS_ROPE = WS_MOD + 512 * 1024;
constexpr size_t WS_SSM = WS_ROPE + 2 * MiB;
constexpr int SSM_TAB = 2 * 1024 + 2 * 16384;
constexpr int SLOT_CAP = 32768;
constexpr size_t WS_SLOT_A = 4 * MiB;
constexpr size_t WS_WSMALL = 6 * MiB;
constexpr size_t WSMALL_LAYER = 7 * MiB, WOFF_IN = 0, WOFF_OUT = (size_t)PROJW * D * 2, WOFF_GLU = WOFF_OUT + (size_t)D * D * 2;
constexpr size_t WS_WGU = 20 * MiB;
constexpr size_t WS_WD = 52 * MiB;
constexpr size_t WS_XN = 68 * MiB;
constexpr size_t WS_YG = 132 * MiB;
constexpr size_t WS_R = 148 * MiB;
constexpr size_t WS_PROJ = WS_R, WS_MIXCAT = WS_R + 144 * MiB, WS_PRE = WS_R, WS_HID = WS_R + 64 * MiB, WS_X1 = WS_R + 132 * MiB;
constexpr size_t WS_ROWS2 = 356 * MiB;
constexpr size_t WS_STAT = 356 * MiB + (size_t)2 * M * D * 2;
constexpr size_t WS_SSM2 = WS_STAT + 4 * MiB;
constexpr size_t SSM2_LAYER = 3 * MiB, S2_APW = 0, S2_KT = 288 * 1024, S2_CT = S2_KT + 256 * 1024, S2_WIN = S2_CT + 64 * 1024, S2_GW = S2_WIN + 2 * MiB;
static_assert(S2_GW + 4 * 128 * 128 * 2 <= SSM2_LAYER, "ssm2 tables");
constexpr size_t WS_XLOC = WS_SSM2 + 2 * SSM2_LAYER;
constexpr size_t WS_XSUP = WS_XLOC + 8 * MiB;
constexpr size_t WS_SLOT_W = WS_XSUP + 512 * 1024;
constexpr size_t WS_CINV = WS_SLOT_W + 2 * MiB;
constexpr size_t WS_CINV_IN = WS_CINV + 128 * 1024;
constexpr size_t WS_SA = WS_CINV + 256 * 1024;
constexpr size_t WS_END = WS_SA + 128 * 1024;
static_assert(WOFF_GLU + 256 * 256 * 2 <= WSMALL_LAYER && WS_WSMALL + 2 * WSMALL_LAYER <= WS_WGU, "ws map");
static_assert(WS_SSM + 2 * SSM_TAB * 4 <= WS_SLOT_A && WS_HID + (size_t)NSLOT_MAX * DEXP * 2 <= WS_X1 && WS_X1 + (size_t)M * D * 2 <= WS_ROWS2, "ws map 2");
constexpr int CW_TMO = 0;
constexpr int CW_BAR = 4096;
constexpr int CW_CNT = 8192;
constexpr int CW_QUEUE = 11264;
constexpr int CW_DONE = 12288;

constexpr int RING_OFF = 0, RING_BYTES = 131072;
constexpr int ATT_STAGE_OFF = 98304;
constexpr int LDSCTL_OFF = 135168, MISC_OFF = LDSCTL_OFF + 320;
constexpr int GT_OFF = LDSCTL_OFF + 1024;
constexpr int LDS_BYTES = 147456;

#define GAS __attribute__((address_space(1)))
#define LAS __attribute__((address_space(3)))
#define DI __device__ __forceinline__
typedef unsigned short bf16;
typedef unsigned v4u __attribute__((ext_vector_type(4)));
typedef unsigned v2u __attribute__((ext_vector_type(2)));
typedef float f32x4 __attribute__((ext_vector_type(4)));
typedef short bf16x8 __attribute__((ext_vector_type(8)));
typedef GAS unsigned gu32;
#define RLX_AGENT __ATOMIC_RELAXED, __HIP_MEMORY_SCOPE_AGENT
#define LDS_WAIT() asm volatile("s_waitcnt lgkmcnt(0)" ::: "memory")
#define VM_WAIT() asm volatile("s_waitcnt vmcnt(0)" ::: "memory")
DI unsigned f2bf(float f) { unsigned u = __builtin_bit_cast(unsigned, f); return (u + 0x7fffu + ((u >> 16) & 1u)) >> 16; }
DI unsigned pk2(float lo, float hi) { return f2bf(lo) | (f2bf(hi) << 16); }
DI float bflo(unsigned w) { return __uint_as_float(w << 16); }
DI float bfhi(unsigned w) { return __uint_as_float(w & 0xffff0000u); }
DI float bf2f(bf16 h) { return __uint_as_float((unsigned)h << 16); }
template <int CTRL> DI float dpp_mov(float v) { return __builtin_bit_cast(float, __builtin_amdgcn_update_dpp(0, __builtin_bit_cast(int, v), CTRL, 0xf, 0xf, true)); }
DI float rdlane(float v, int l) { return __builtin_bit_cast(float, __builtin_amdgcn_readlane(__builtin_bit_cast(int, v), l)); }
DI float wave_sum(float v) {
    v += dpp_mov<0xB1>(v); v += dpp_mov<0x4E>(v); v += dpp_mov<0x141>(v); v += dpp_mov<0x140>(v);
    return (rdlane(v, 0) + rdlane(v, 16)) + (rdlane(v, 32) + rdlane(v, 48));
}
DI void st16_wt(void* p, v4u v) { asm volatile("global_store_dwordx4 %0, %1, off sc1\n\ts_nop 1" :: "v"(p), "v"(v) : "memory"); }
DI float wave_max(float v) {
    v = fmaxf(v, dpp_mov<0xB1>(v)); v = fmaxf(v, dpp_mov<0x4E>(v)); v = fmaxf(v, dpp_mov<0x141>(v)); v = fmaxf(v, dpp_mov<0x140>(v));
    return fmaxf(fmaxf(rdlane(v, 0), rdlane(v, 16)), fmaxf(rdlane(v, 32), rdlane(v, 48)));
}
DI unsigned pk4_fp8(float a, float b, float c, float d) { int w = __builtin_amdgcn_cvt_pk_fp8_f32(a, b, 0, false); w = __builtin_amdgcn_cvt_pk_fp8_f32(c, d, w, true); return (unsigned)w; }
DI float fast_rcp(float x) { return __builtin_amdgcn_rcpf(x); }
DI float sigmoid_f(float x) { return fast_rcp(1.0f + __builtin_amdgcn_exp2f(-1.4426950408889634f * x)); }
DI float silu_f(float x) { return x * sigmoid_f(x); }
DI float gelu_tanh_f(float x) { const float z2 = 1.5957691216057308f * (x + 0.044715f * x * x * x); return x * sigmoid_f(z2); }

#define XB_TMO      128
#define XB_XCNT(j)  (256  + 64 * (j))
#define XB_XSUB(j)  (1280 + 64 * (j))
#define XB_XGEN(j)  (2304 + 64 * (j))
#define XB_TOP      3328
#define XB_TOPGEN   3392
#define XCD_BAR_WORDS 3456
#define XB_SPIN_CAP (1u << 22)
DI unsigned xb_ld(unsigned* p)              { return __hip_atomic_load(p, __ATOMIC_RELAXED, __HIP_MEMORY_SCOPE_AGENT); }
DI unsigned xb_add(unsigned* p, unsigned v) { return __hip_atomic_fetch_add(p, v, __ATOMIC_RELAXED, __HIP_MEMORY_SCOPE_AGENT); }
DI unsigned xb_xcc_id() { return (unsigned)__builtin_amdgcn_s_getreg((3 << 11) | 20) & 0xFu; }
#define XB_SPIN(cond, bar) do { unsigned _sp = 0; while (cond) { __builtin_amdgcn_s_sleep(1); \
    if ((++_sp & 255u) == 0u) { if (xb_ld(&(bar)[XB_TMO])) break; if (_sp > XB_SPIN_CAP) { atomicAdd(&(bar)[XB_TMO], 1u); break; } } } } while (0)
struct XcdBarrier { unsigned* bar; unsigned x; volatile LAS unsigned* st; };
DI XcdBarrier xcd_barrier_post(unsigned* bar, volatile LAS unsigned* st) {
    XcdBarrier b; b.bar = bar; b.x = xb_xcc_id(); b.st = st;
    if (threadIdx.x == 0) (void)xb_add(&bar[XB_XCNT(b.x)], 1u);
    return b;
}
DI void xcd_barrier_complete(unsigned* bar, unsigned x, unsigned& nloc, unsigned& nx) {
    const unsigned G = gridDim.x * gridDim.y * gridDim.z;
    unsigned sum, cnt, mine, sp = 0u;
    for (;;) {
        sum = 0u; cnt = 0u; mine = 0u;
#pragma unroll
        for (unsigned j = 0; j < 16; ++j) { const unsigned c = xb_ld(&bar[XB_XCNT(j)]); sum += c; cnt += (c > 0u) ? 1u : 0u; mine = (j == x) ? c : mine; }
        if (sum == G) break;
        __builtin_amdgcn_s_sleep(1);
        if ((++sp & 255u) == 0u) { if (xb_ld(&bar[XB_TMO])) break; if (sp > XB_SPIN_CAP) { atomicAdd(&bar[XB_TMO], 1u); break; } }
    }
    nloc = mine > 0u ? mine : 1u; nx = cnt > 0u ? cnt : 1u;
}
DI void xcd_barrier(const XcdBarrier& b) {
    asm volatile("s_waitcnt vmcnt(0)" ::: "memory");
    __syncthreads();
    if (threadIdx.x == 0) {
        unsigned* bar = b.bar;
        __builtin_amdgcn_s_waitcnt(0);
        unsigned nloc = b.st[0], nx = b.st[1];
        if (nloc == 0u) { xcd_barrier_complete(bar, b.x, nloc, nx); b.st[0] = nloc; b.st[1] = nx; }
        const unsigned old = xb_add(&bar[XB_XSUB(b.x)], 1u);
        const unsigned gen = old / nloc;
        if (old + 1u == (gen + 1u) * nloc) {
            __builtin_amdgcn_fence(__ATOMIC_RELEASE, "agent");
            asm volatile("s_waitcnt vmcnt(0)" ::: "memory");
            const unsigned og = xb_add(&bar[XB_TOP], 1u);
            const unsigned tg = og / nx;
            if (og + 1u == (tg + 1u) * nx) xb_add(&bar[XB_TOPGEN], 1u);
            else XB_SPIN(xb_ld(&bar[XB_TOPGEN]) == tg, bar);
            __builtin_amdgcn_fence(__ATOMIC_ACQUIRE, "agent");
            xb_add(&bar[XB_XGEN(b.x)], 1u);
            asm volatile("s_waitcnt vmcnt(0)" ::: "memory");
        } else {
            XB_SPIN(xb_ld(&bar[XB_XGEN(b.x)]) == gen, bar);
            __builtin_amdgcn_fence(__ATOMIC_ACQUIRE, "agent");
            asm volatile("s_waitcnt vmcnt(0)" ::: "memory");
        }
    }
    __syncthreads();
}

struct Args { const void* in[30]; float* out; unsigned char* ws; int ph_lo, ph_hi, li, pad; };
enum { I_X = 0, I_C, I_POS, I_ADAW, I_ADAB, I_WIN, I_GMLNG, I_GMLNB, I_GMWS, I_GMBS, I_LAMRE, I_LAMIM, I_LOGDT, I_BRE, I_BIM, I_CRE, I_CIM, I_SSMD,
       I_GLUW, I_GLUB, I_WOUT, I_LN1G, I_LN1B, I_RW, I_RB, I_EWG, I_EWU, I_EWD, I_LN2G, I_LN2B };
struct Frame {
    LAS unsigned char* lds;
    volatile LAS unsigned* MISC;
    gu32* ctl;
    unsigned char* ws;
    int vcu, G;
};
DI int ftid() { int t = threadIdx.x; asm volatile("" : "+v"(t)); return t; }
#define FRAME_IDS const int tid_ = ftid(), lane_ = tid_ & 63, wave_ = __builtin_amdgcn_readfirstlane(tid_ >> 6); (void)lane_; (void)wave_;

template <class RowMap>
DI void transpose_item(const float* W, int K, int N, bf16* WT, const RowMap& rm, LAS float* scr, int item, int lane) {
    const int nblk = N / 32, kb = item / nblk, nb = item % nblk, k0 = 64 * kb, n0 = 32 * nb;
#pragma unroll 8
    for (int i = 0; i < 32; ++i) { const int kk = 2 * i + (lane >> 5); scr[kk * 33 + (lane & 31)] = W[(size_t)(k0 + kk) * N + n0 + (lane & 31)]; }
    LDS_WAIT(); asm volatile("" ::: "memory");
    const int c = lane & 7;
#pragma unroll
    for (int j = 0; j < 4; ++j) { const int n = (lane >> 3) + 8 * j; const LAS float* s = scr + (8 * c) * 33 + n;
        const float qs = (RowMap::SCALEQ && (n0 + n) >= COL_Q && (n0 + n) < COL_K) ? QSCALE : 1.0f;
        v4u o; o.x = pk2(s[0 * 33] * qs, s[1 * 33] * qs); o.y = pk2(s[2 * 33] * qs, s[3 * 33] * qs); o.z = pk2(s[4 * 33] * qs, s[5 * 33] * qs); o.w = pk2(s[6 * 33] * qs, s[7 * 33] * qs);
        *(GAS v4u*)(WT + (size_t)rm(n0 + n) * K + k0 + 8 * c) = o; }
    LDS_WAIT(); asm volatile("" ::: "memory");
}
struct RmIdent { static constexpr bool SCALEQ = false; int off; DI int operator()(int n) const { return off + n; } };
struct RmWin { static constexpr bool SCALEQ = true; DI int operator()(int n) const {
        if (n >= COL_Q && n < COL_VA) { const int d = n & 63; if (d < 16) return (n - d) + 2 * (d & 7) + (d >> 3); }
        return n; } };
struct RmGU { static constexpr bool SCALEQ = false; int e, up; DI int operator()(int n) const { return e * 1024 + (n >> 7) * 256 + (n & 127) + up * 128; } };

DI void p0_tables(Frame& F, const Args& A) {
    FRAME_IDS
    const float* c = (const float*)A.in[I_C];
    LAS float* condS = (LAS float*)(F.lds + RING_OFF);
    LAS float* red = (LAS float*)(F.lds + RING_OFF + 32768);
    for (int i = tid_; i < BATCH * D; i += NTHR) condS[i] = silu_f(c[i]);
    __syncthreads();
    float* mod = (float*)(F.ws + WS_MOD);
    for (int it = F.vcu; it < DEPTH * 96; it += F.G) {
        const int l = it / 96, jb = it % 96, ks = tid_ >> 6, jj = tid_ & 63, j = jb * 64 + jj;
        const float* w = (const float*)A.in[I_ADAW] + (size_t)l * D * 6 * D + j;
        float acc[8];
#pragma unroll
        for (int b = 0; b < 8; ++b) acc[b] = 0.f;
#pragma unroll 16
        for (int k = ks * 128; k < ks * 128 + 128; ++k) { const float wv = w[(size_t)k * (6 * D)];
#pragma unroll
            for (int b = 0; b < 8; ++b) acc[b] += condS[b * D + k] * wv; }
#pragma unroll
        for (int b = 0; b < 8; ++b) red[(ks * 8 + b) * 64 + jj] = acc[b];
        __syncthreads();
        { const int b = tid_ >> 6; float s = ((const float*)A.in[I_ADAB])[l * 6 * D + j];
#pragma unroll
          for (int k2 = 0; k2 < 8; ++k2) s += red[(k2 * 8 + b) * 64 + jj];
          mod[((size_t)l * BATCH + b) * 6 * D + j] = s; }
        __syncthreads();
    }
    const int gt = F.vcu * NTHR + tid_, NGT = F.G * NTHR;
    const int* pos = (const int*)A.in[I_POS]; float* rope = (float*)(F.ws + WS_ROPE);
    for (int w = gt; w < M * 8; w += NGT) { const int m = w >> 3, i = w & 7;
        const float freq = exp2f(-(float)i * 0.125f * 18.931568569324174f);
        const float ang = (float)pos[m] * freq; float s, cs; sincosf(ang, &s, &cs);
        rope[m * 16 + i] = cs; rope[m * 16 + 8 + i] = s; }
    for (int w = gt; w < DEPTH * 16 * 33 * 64; w += NGT) { const int n = w & 63, m = (w >> 6) % 33, g = ((w >> 6) / 33) & 15, l = (w >> 6) / (33 * 16);
        const int li = (l * 16 + g) * 64 + n;
        const float lre = ((const float*)A.in[I_LAMRE])[li], lim = ((const float*)A.in[I_LAMIM])[li], dt = expf(((const float*)A.in[I_LOGDT])[l * 16 + g]);
        const float mag = expf((float)m * (lre * dt)); float sn, cs; sincosf((float)m * (lim * dt), &sn, &cs);
        float* apw = (float*)(F.ws + WS_SSM2 + l * SSM2_LAYER + S2_APW) + ((size_t)(g * 33 + m) * 64 + n) * 2; apw[0] = mag * cs; apw[1] = mag * sn; }
    for (int w = gt; w < DEPTH * SSM_G * SSM_N; w += NGT) { const int l = w / 1024, gn = w % 1024, g = gn >> 6;
        float* tab = (float*)(F.ws + WS_SSM) + (size_t)l * SSM_TAB;
        const float lre = ((const float*)A.in[I_LAMRE])[w], lim = ((const float*)A.in[I_LAMIM])[w];
        const float dt = expf(((const float*)A.in[I_LOGDT])[l * 16 + g]);
        const float mag = expf(lre * dt); float sn, cs; sincosf(lim * dt, &sn, &cs);
        const float are = mag * cs, aim = mag * sn, nr = are - 1.0f, ni = aim, mod2 = lre * lre + lim * lim;
        const float fre = (nr * lre + ni * lim) / mod2, fim = (ni * lre - nr * lim) / mod2;
        tab[gn] = are; tab[1024 + gn] = aim;
        const float* bre = (const float*)A.in[I_BRE] + (size_t)w * 16; const float* bim = (const float*)A.in[I_BIM] + (size_t)w * 16;
#pragma unroll
        for (int cc = 0; cc < 16; ++cc) { tab[2048 + gn * 16 + cc] = fre * bre[cc] - fim * bim[cc]; tab[2048 + 16384 + gn * 16 + cc] = fre * bim[cc] + fim * bre[cc]; } }
}

DI void p_wconv(Frame& F, const Args& A, int l, int part) {
    FRAME_IDS
    if (part == 4) {
        const int gt = F.vcu * NTHR + tid_, NGT = F.G * NTHR;
        const float* tab = (const float*)(F.ws + WS_SSM) + (size_t)l * SSM_TAB;
        const float* apw = (const float*)(F.ws + WS_SSM2 + l * SSM2_LAYER + S2_APW);
        const float* cre = (const float*)A.in[I_CRE] + (size_t)l * 16 * 16 * 64; const float* cim = (const float*)A.in[I_CIM] + (size_t)l * 16 * 16 * 64;
        bf16* KT = (bf16*)(F.ws + WS_SSM2 + l * SSM2_LAYER + S2_KT); bf16* CT = (bf16*)(F.ws + WS_SSM2 + l * SSM2_LAYER + S2_CT);
        bf16* WIN = (bf16*)(F.ws + WS_SSM2 + l * SSM2_LAYER + S2_WIN); bf16* GW = (bf16*)(F.ws + WS_SSM2 + l * SSM2_LAYER + S2_GW);
        for (int w = gt; w < 16 * 16 * 64 * 8; w += NGT) { const int j = w & 7, ln = (w >> 3) & 63, p = (w >> 9) & 15, g = w >> 13;
            const int co = ln & 15, q = ln >> 4, m = 2 * p + (q >> 1), ci = 8 * (q & 1) + j; float acc = 0.f;
            for (int n = 0; n < 64; ++n) { const int gn = g * 64 + n; const float ar = apw[((g * 33 + m) * 64 + n) * 2], ai = apw[((g * 33 + m) * 64 + n) * 2 + 1];
                const float br = tab[2048 + gn * 16 + ci], bi = tab[2048 + 16384 + gn * 16 + ci], tre = ar * br - ai * bi, tim = ar * bi + ai * br;
                acc += cre[(g * 16 + co) * 64 + n] * tre - cim[(g * 16 + co) * 64 + n] * tim; }
            KT[w] = (bf16)f2bf(acc); }
        for (int w = gt; w < 16 * 4 * 64 * 8; w += NGT) { const int j = w & 7, ln = (w >> 3) & 63, sx = (w >> 9) & 3, g = w >> 11;
            const int co = ln & 15, q = ln >> 4, n = 16 * sx + 4 * q + (j >> 1);
            CT[w] = (bf16)f2bf((j & 1) ? -cim[(g * 16 + co) * 64 + n] : cre[(g * 16 + co) * 64 + n]); }
        for (int w = gt; w < 16 * 16 * 8 * 64 * 8; w += NGT) { const int jj = w & 7, ln = (w >> 3) & 63, ct = (w >> 9) & 7, sp = (w >> 12) & 15, g = w >> 16;
            const int cc = ln & 15, q = ln >> 4, n = 8 * ct + (cc >> 1), part = cc & 1, tj = 2 * sp + (q >> 1), ci = 8 * (q & 1) + jj, gn = g * 64 + n, m = 31 - tj;
            const float ar = apw[((g * 33 + m) * 64 + n) * 2], ai = apw[((g * 33 + m) * 64 + n) * 2 + 1], br = tab[2048 + gn * 16 + ci], bi = tab[2048 + 16384 + gn * 16 + ci];
            WIN[w] = (bf16)f2bf(part ? (ar * bi + ai * br) : (ar * br - ai * bi)); }
        const float* gws = (const float*)A.in[I_GMWS] + (size_t)l * 4 * 128 * 128;
        for (int w = gt; w < 4 * 128 * 128; w += NGT) { const int sx = w & 127, t = (w >> 7) & 127; GW[w] = (bf16)f2bf(sx <= t ? gws[w] : 0.f); }
    }
}
constexpr int WC_NS = 16 * 32 + 4 * 8, WC_ND = 16 * 256, WC_NW = WC_NS + WC_ND;
DI void p_wconv_items(Frame& F, const Args& A, int l, int lo, int hi) {
    FRAME_IDS
    LAS float* scr = (LAS float*)(F.lds + RING_OFF + wave_ * 16384);
    bf16* WoutT = (bf16*)(F.ws + WS_WSMALL + l * WSMALL_LAYER + WOFF_OUT);
    bf16* GluT = (bf16*)(F.ws + WS_WSMALL + l * WSMALL_LAYER + WOFF_GLU);
    bf16* WdT = (bf16*)(F.ws + WS_WD);
    constexpr int I_OUTW = 16 * 32, I_GLU = 4 * 8;
    for (int it = lo + F.vcu * NWAVES + wave_; it < hi; it += F.G * NWAVES) {
        int r = it;
        if (r < I_OUTW) { transpose_item((const float*)A.in[I_WOUT] + (size_t)l * D * D, D, D, WoutT, RmIdent{0}, scr, r, lane_); continue; } r -= I_OUTW;
        if (r < I_GLU) { transpose_item((const float*)A.in[I_GLUW] + (size_t)l * 256 * 256, 256, 256, GluT, RmIdent{0}, scr, r, lane_); continue; } r -= I_GLU;
        { const int e = r >> 8; transpose_item((const float*)A.in[I_EWD] + ((size_t)l * NEXP + e) * D * DEXP, DEXP, D, WdT, RmIdent{e * 1024}, scr, r & 255, lane_); }
    }
}
template <bool CI_DEST, class RowMap>
DI void quant_cols32(Frame& F, const float* Wm, int ldw, int n0, unsigned char* W8, const RowMap& rm, float* cinv) {
    FRAME_IDS
    LAS float* scr = (LAS float*)(F.lds + RING_OFF + wave_ * 16384);
    LAS float* red = (LAS float*)(F.lds + RING_OFF + 12288);
    const int k0 = 128 * wave_;
    const float* W = Wm + (size_t)k0 * ldw + n0;
    const unsigned lofs = (unsigned)((lane_ >> 5) * ldw + (lane_ & 31));
    float v[64]; float mx = 0.f;
#pragma unroll
    for (int i = 0; i < 64; ++i) v[i] = W[(size_t)(2 * i) * ldw + lofs];
#pragma unroll
    for (int i = 0; i < 64; ++i) mx = fmaxf(mx, fabsf(v[i]));
    red[wave_ * 4096 + lane_] = mx;
    __syncthreads();
    float m2 = 0.f;
#pragma unroll
    for (int w2 = 0; w2 < 8; ++w2) m2 = fmaxf(m2, fmaxf(red[w2 * 4096 + (lane_ & 31)], red[w2 * 4096 + 32 + (lane_ & 31)]));
    const bool z = !(m2 > 1e-30f); const float sc = z ? 1.0f : 440.0f / m2;
    if (tid_ < 32) { const int n = n0 + tid_; const float qf = (RowMap::SCALEQ && n >= COL_Q && n < COL_K) ? QSCALE : 1.0f; cinv[CI_DEST ? rm(n) : n] = (z ? 1.0f : m2 * (1.0f / 440.0f)) * qf; }
    const int c = lane_ & 7;
#pragma unroll
    for (int t = 0; t < 2; ++t) {
#pragma unroll
        for (int i = 0; i < 32; ++i) scr[(2 * i + (lane_ >> 5)) * 33 + (lane_ & 31)] = v[32 * t + i] * sc;
        LDS_WAIT(); asm volatile("" ::: "memory");
#pragma unroll
        for (int jj = 0; jj < 4; ++jj) { const int n = (lane_ >> 3) + 8 * jj; const LAS float* sp = scr + (8 * c) * 33 + n;
            v2u o; o.x = pk4_fp8(sp[0 * 33], sp[1 * 33], sp[2 * 33], sp[3 * 33]); o.y = pk4_fp8(sp[4 * 33], sp[5 * 33], sp[6 * 33], sp[7 * 33]);
            *(GAS v2u*)(W8 + (size_t)rm(n0 + n) * D + k0 + 64 * t + 8 * c) = o; }
        LDS_WAIT(); asm volatile("" ::: "memory");
    }
    __syncthreads();
}
constexpr int WC_NGU = 16 * 2 * 16, WC_NIN = PROJW / 32;
DI void p_wconv_gu(Frame& F, const Args& A, int l, int first, int stride, int hi) {
    for (int j = first; j < hi; j += stride) { const int e = j >> 5, up = (j >> 4) & 1;
        quant_cols32<false>(F, (const float*)A.in[up ? I_EWU : I_EWG] + ((size_t)l * NEXP + e) * D * DEXP, DEXP, 32 * (j & 15), (unsigned char*)(F.ws + WS_WGU), RmGU{e, up},
                            (float*)(F.ws + WS_CINV) + (size_t)l * 16 * 2 * 512 + (e * 2 + up) * 512); }
}
DI void p_wconv_in(Frame& F, const Args& A, int l, int first, int stride) {
    for (int j = first; j < WC_NIN; j += stride)
        quant_cols32<true>(F, (const float*)A.in[I_WIN] + (size_t)l * D * PROJW, PROJW, 32 * j, (unsigned char*)(F.ws + WS_WSMALL + l * WSMALL_LAYER + WOFF_IN), RmWin{}, (float*)(F.ws + WS_CINV_IN) + l * PROJW);
}

typedef float f32x2_t __attribute__((ext_vector_type(2)));
typedef __bf16 bf16x2_t __attribute__((ext_vector_type(2)));
DI unsigned cvtpk(float lo, float hi) { f32x2_t v = {lo, hi}; bf16x2_t b = __builtin_convertvector(v, bf16x2_t); return __builtin_bit_cast(unsigned, b); }
struct Row16 { float v[16]; };
DI void row_load_f32(Row16& r, const float* p, int lane) {
    const f32x4* q = (const f32x4*)p;
#pragma unroll
    for (int k = 0; k < 4; ++k) { const f32x4 a = q[k * 64 + lane]; r.v[4 * k] = a.x; r.v[4 * k + 1] = a.y; r.v[4 * k + 2] = a.z; r.v[4 * k + 3] = a.w; }
}
DI void row_load_f32_nt(Row16& r, const float* p, int lane) {
    const f32x4* q = (const f32x4*)p;
#pragma unroll
    for (int k = 0; k < 4; ++k) { const f32x4 a = __builtin_nontemporal_load(&q[k * 64 + lane]); r.v[4 * k] = a.x; r.v[4 * k + 1] = a.y; r.v[4 * k + 2] = a.z; r.v[4 * k + 3] = a.w; }
}
DI void row_load_bf16(Row16& r, const bf16* p, int lane) {
    const v2u* q = (const v2u*)p;
#pragma unroll
    for (int k = 0; k < 4; ++k) { const v2u a = q[k * 64 + lane]; r.v[4 * k] = bflo(a.x); r.v[4 * k + 1] = bfhi(a.x); r.v[4 * k + 2] = bflo(a.y); r.v[4 * k + 3] = bfhi(a.y); }
}
DI void row_store_bf16(const Row16& r, bf16* p, int lane) {
    v2u* q = (v2u*)p;
#pragma unroll
    for (int k = 0; k < 4; ++k) { v2u o; o.x = cvtpk(r.v[4 * k], r.v[4 * k + 1]); o.y = cvtpk(r.v[4 * k + 2], r.v[4 * k + 3]); q[k * 64 + lane] = o; }
}
DI void row_store_fp8(const Row16& r, unsigned char* p, float* sinv, int lane) {
    float am = 0.f;
#pragma unroll
    for (int i = 0; i < 16; ++i) am = fmaxf(am, fabsf(r.v[i]));
    am = wave_max(am); const bool z = !(am > 1e-30f); const float qs = z ? 1.0f : 440.0f / am;
    unsigned* q8 = (unsigned*)p;
#pragma unroll
    for (int k = 0; k < 4; ++k) q8[k * 64 + lane] = pk4_fp8(r.v[4 * k] * qs, r.v[4 * k + 1] * qs, r.v[4 * k + 2] * qs, r.v[4 * k + 3] * qs);
    if (lane == 0) *sinv = z ? 1.0f : am * (1.0f / 440.0f);
}
DI void row_store_f32(const Row16& r, float* p, int lane) {
    f32x4* q = (f32x4*)p;
#pragma unroll
    for (int k = 0; k < 4; ++k) __builtin_nontemporal_store((f32x4){r.v[4 * k], r.v[4 * k + 1], r.v[4 * k + 2], r.v[4 * k + 3]}, &q[k * 64 + lane]);
}
DI void row_ln(Row16& r) {
    float s = 0.f;
#pragma unroll
    for (int i = 0; i < 16; ++i) s += r.v[i];
    const float mean = wave_sum(s) * (1.f / D); float s2 = 0.f;
#pragma unroll
    for (int i = 0; i < 16; ++i) { r.v[i] -= mean; s2 += r.v[i] * r.v[i]; }
    const float rstd = 1.0f / sqrtf(wave_sum(s2) * (1.f / D) + LN_EPS);
#pragma unroll
    for (int i = 0; i < 16; ++i) r.v[i] *= rstd;
}
DI void row_mod(Row16& r, const float* a, const float* b, int lane) {
    Row16 av, bv; row_load_f32(av, a, lane); row_load_f32(bv, b, lane);
#pragma unroll
    for (int i = 0; i < 16; ++i) r.v[i] = r.v[i] * (1.0f + av.v[i]) + bv.v[i];
}
DI void row_affine(Row16& r, const float* g, const float* b, int lane) {
    Row16 av, bv; row_load_f32(av, g, lane); row_load_f32(bv, b, lane);
#pragma unroll
    for (int i = 0; i < 16; ++i) r.v[i] = r.v[i] * av.v[i] + bv.v[i];
}

DI void p_ln_a0(Frame& F, const Args& A) {
    FRAME_IDS
    const int gw = F.vcu * NWAVES + wave_, NGW = F.G * NWAVES;
    const float* x = (const float*)A.in[I_X]; bf16* XN = (bf16*)(F.ws + WS_XN); const float* mod = (const float*)(F.ws + WS_MOD);
    const int bq = gw / (NGW / BATCH), mbase = bq * T + gw % (NGW / BATCH), mstep = NGW / BATCH;
    const float* md = mod + (size_t)bq * 6 * D;
    Row16 msc, msh; row_load_f32(msc, md + 1 * D, lane_); row_load_f32(msh, md + 0 * D, lane_);
    Row16 nx; row_load_f32_nt(nx, x + (size_t)mbase * D, lane_);
    for (int m = mbase; m < (bq + 1) * T; m += mstep) {
        Row16 r = nx; if (m + mstep < (bq + 1) * T) row_load_f32_nt(nx, x + (size_t)(m + mstep) * D, lane_);
        row_ln(r);
#pragma unroll
        for (int i = 0; i < 16; ++i) r.v[i] = r.v[i] * (1.0f + msc.v[i]) + msh.v[i];
        row_store_fp8(r, (unsigned char*)XN + (size_t)m * D, (float*)(F.ws + WS_SA) + m, lane_); }
}

using pg8::Unit; using pg8::BM; using pg8::HALF;
struct EpiInProj {
    static constexpr bool PERM = true, AFTER_DRAIN = false;
    bf16* P; const float* rope; int skip; const float* sa; const float* cinv;
    DI void operator()(const pg8::f32x4 (&acc)[2][2][4][2], const Unit& u, int wr, int wc, int fr, int fq) const {
        if (skip == 1) { if (acc[0][0][0][0][0] == 12345.678f) P[0] = 1; return; }
        const int row0 = u.pm * BM + wr * 64 + fr, pn = u.pn;
        const bool isrope = (pn >= 2 && pn <= 5), dorope = isrope && ((wc & 1) == 0) && (fq < 2);
        asm volatile("" ::: "memory");
        pg8::f32x4 ci[2][2];
#pragma unroll
        for (int bj = 0; bj < 2; ++bj) { const float* cp = cinv + pn * BM + bj * HALF + wc * 32 + 8 * fq; ci[bj][0] = *(const pg8::f32x4*)cp; ci[bj][1] = *(const pg8::f32x4*)(cp + 4); }
#pragma unroll
        for (int ai = 0; ai < 2; ++ai)
#pragma unroll
            for (int m = 0; m < 4; ++m) { const int row = row0 + ai * HALF + m * 16; bf16* rowp = P + (size_t)row * PROJW + pn * BM + wc * 32 + 8 * fq; const float ra = sa[row];
                f32x4 cs = (f32x4){1.f, 1.f, 1.f, 1.f}, sn = (f32x4){0.f, 0.f, 0.f, 0.f};
                if (isrope) { const float* rp = rope + (size_t)row * 16 + 4 * (fq & 1); cs = *(const f32x4*)rp; sn = *(const f32x4*)(rp + 8); }
#pragma unroll
                for (int bj = 0; bj < 2; ++bj) { pg8::f32x4 v0 = acc[ai][bj][m][0] * (ci[bj][0] * ra), v1 = acc[ai][bj][m][1] * (ci[bj][1] * ra);
                    if (isrope) {
                        if (dorope) { const float a0 = v0[0] * cs.x - v0[1] * sn.x, b0 = v0[1] * cs.x + v0[0] * sn.x, a1 = v0[2] * cs.y - v0[3] * sn.y, b1 = v0[3] * cs.y + v0[2] * sn.y;
                            const float a2 = v1[0] * cs.z - v1[1] * sn.z, b2 = v1[1] * cs.z + v1[0] * sn.z, a3 = v1[2] * cs.w - v1[3] * sn.w, b3 = v1[3] * cs.w + v1[2] * sn.w;
                            v0 = (pg8::f32x4){a0, b0, a1, b1}; v1 = (pg8::f32x4){a2, b2, a3, b3}; }
                    }
                    pg8::u32x4 w; w.x = pg8::cvt_pk_bf16(v0[0], v0[1]); w.y = pg8::cvt_pk_bf16(v0[2], v0[3]); w.z = pg8::cvt_pk_bf16(v1[0], v1[1]); w.w = pg8::cvt_pk_bf16(v1[2], v1[3]);
                    if (skip == 2) { asm volatile("" :: "v"(w.x), "v"(w.y), "v"(w.z), "v"(w.w)); } else *(pg8::u32x4*)(rowp + bj * HALF) = w; } }
    }
};
template <bool XF32> struct EpiOut {
    static constexpr bool PERM = true, AFTER_DRAIN = false;
    bf16* PRE; const void* x; int xpitch; const float* mod;
    DI void operator()(const pg8::f32x4 (&acc)[2][2][4][2], const Unit& u, int wr, int wc, int fr, int fq) const {
        const int row0 = u.pm * BM + wr * 64 + fr, b = (u.pm * BM) / T, colb = u.pn * BM + wc * 32 + 8 * fq;
        const float* g1 = mod + (size_t)b * 6 * D + 2 * D;
        pg8::f32x4 gv[2][2];
#pragma unroll
        for (int bj = 0; bj < 2; ++bj) { gv[bj][0] = *(const pg8::f32x4*)(g1 + colb + bj * HALF) + 1.0f; gv[bj][1] = *(const pg8::f32x4*)(g1 + colb + bj * HALF + 4) + 1.0f; }
#pragma unroll
        for (int ai = 0; ai < 2; ++ai)
#pragma unroll
            for (int m = 0; m < 4; ++m) { const int row = row0 + ai * HALF + m * 16;
#pragma unroll
                for (int bj = 0; bj < 2; ++bj) { const int col = colb + bj * HALF; pg8::f32x4 x0, x1;
                    if (XF32) { const float* xp = (const float*)x + (size_t)row * xpitch + col; x0 = *(const pg8::f32x4*)xp; x1 = *(const pg8::f32x4*)(xp + 4); }
                    else { const pg8::u32x4 xw = *(const pg8::u32x4*)((const bf16*)x + (size_t)row * xpitch + col);
                        x0 = (pg8::f32x4){bflo(xw.x), bfhi(xw.x), bflo(xw.y), bfhi(xw.y)}; x1 = (pg8::f32x4){bflo(xw.z), bfhi(xw.z), bflo(xw.w), bfhi(xw.w)}; }
                    const pg8::f32x4 v0 = x0 * ALPHA + gv[bj][0] * acc[ai][bj][m][0], v1 = x1 * ALPHA + gv[bj][1] * acc[ai][bj][m][1];
                    pg8::u32x4 w; w.x = pg8::cvt_pk_bf16(v0[0], v0[1]); w.y = pg8::cvt_pk_bf16(v0[2], v0[3]); w.z = pg8::cvt_pk_bf16(v1[0], v1[1]); w.w = pg8::cvt_pk_bf16(v1[2], v1[3]);
                    *(pg8::u32x4*)(PRE + (size_t)row * D + col) = w; } }
    }
};
struct OutOrder : pg8::StaticOrder {
    const char* xbase; unsigned rowbytes, tilecolbytes; LAS unsigned char* dump;
    DI void a_ready(const Unit& u) const {
        const int tid = threadIdx.x, wid = __builtin_amdgcn_readfirstlane(tid >> 6), lane = tid & 63;
        const int lpr = (int)(tilecolbytes >> 7);
        const char* t0 = xbase + (size_t)u.pm * 256 * rowbytes + (size_t)u.pn * tilecolbytes;
        const int nline = 256 * lpr;
        for (int i = wid * 64 + lane; i < nline; i += 512) { const int r = i / lpr, c = i % lpr;
            __builtin_amdgcn_global_load_lds((const unsigned*)(t0 + (size_t)r * rowbytes + (size_t)c * 128), (LAS unsigned*)(dump + wid * 256), 4, 0, 0); }
    }
};
struct EpiGlu {
    static constexpr bool PERM = true, AFTER_DRAIN = false;
    const bf16* YG; bf16* MIX; const float* gb;
    DI void operator()(const pg8::f32x4 (&acc)[2][2][4][2], const Unit& u, int wr, int wc, int fr, int fq) const {
        const int row0 = u.pm * BM + wr * 64 + fr, colb = wc * 32 + 8 * fq;
#pragma unroll
        for (int ai = 0; ai < 2; ++ai)
#pragma unroll
            for (int m = 0; m < 4; ++m) { const int row = row0 + ai * HALF + m * 16;
#pragma unroll
                for (int bj = 0; bj < 2; ++bj) { const int col = colb + bj * HALF;
                    const pg8::u32x4 yw = *(const pg8::u32x4*)(YG + (size_t)row * 256 + col);
                    const pg8::f32x4 b0 = *(const pg8::f32x4*)(gb + col), b1 = *(const pg8::f32x4*)(gb + col + 4);
                    const pg8::f32x4 a0 = acc[ai][bj][m][0] + b0, a1 = acc[ai][bj][m][1] + b1;
                    const float y[8] = {bflo(yw.x), bfhi(yw.x), bflo(yw.y), bfhi(yw.y), bflo(yw.z), bfhi(yw.z), bflo(yw.w), bfhi(yw.w)};
                    float o[8];
#pragma unroll
                    for (int i = 0; i < 4; ++i) { o[i] = y[i] * sigmoid_f(a0[i]); o[4 + i] = y[4 + i] * sigmoid_f(a1[i]); }
                    pg8::u32x4 w; w.x = pg8::cvt_pk_bf16(o[0], o[1]); w.y = pg8::cvt_pk_bf16(o[2], o[3]); w.z = pg8::cvt_pk_bf16(o[4], o[5]); w.w = pg8::cvt_pk_bf16(o[6], o[7]);
                    *(pg8::u32x4*)(MIX + (size_t)row * D + 768 + col) = w; asm volatile("" ::: "memory"); } }
    }
};
template <int KIND> struct MoeOrderK {
    const volatile LAS int* ts; int G, c; const int* slot_a; const float* slot_w; gu32* done_cnt; gu32* queue; volatile LAS int* qs;
    DI bool decode(int off, Unit& u) const {
        const int nwg = ts[16] * 4, q = nwg / 8, r = nwg % 8, xcd = c % 8; const int cntx = q + (xcd < r ? 1 : 0); if (off >= cntx) return false;
        const int wgid = (xcd < r ? xcd * (q + 1) : r * (q + 1) + (xcd - r) * q) + off;
        const int tm = wgid >> 2, j = wgid & 3; int e = 0;
#pragma unroll
        for (int k = 1; k < 16; ++k) e += (ts[k] <= tm) ? 1 : 0;
        u.pm = tm; u.pn = e * 4 + j; return true; }
    DI bool first(Unit& u) const {
        if (KIND == 0) return next(0, u);
        if (threadIdx.x == 0) { const unsigned a = __hip_atomic_fetch_add(queue + 16 * (c % 8), 2u, RLX_AGENT); qs[0] = (int)a; qs[1] = (int)a + 1; }
        asm volatile("s_waitcnt vmcnt(0) lgkmcnt(0)" ::: "memory"); __builtin_amdgcn_s_barrier(); asm volatile("" ::: "memory");
        return decode(qs[0], u);
    }
    DI bool more(int i, Unit& u) const {
        if (KIND == 0) return next(i, u);
        return decode(qs[i & 1], u);
    }
    DI bool next(int i, Unit& u) const {
        const int nwg = ts[16] * 4; const int cc = c;
        const long L = (long)i * G + cc; if (L >= nwg) return false;
        int wgid = (int)L; { const int q = nwg / 8, r = nwg % 8, xcd = wgid % 8, off = wgid / 8; wgid = (xcd < r ? xcd * (q + 1) : r * (q + 1) + (xcd - r) * q) + off; }
        const int tm = wgid >> 2, j = wgid & 3; int e = 0;
#pragma unroll
        for (int k = 1; k < 16; ++k) e += (ts[k] <= tm) ? 1 : 0;
        u.pm = tm; u.pn = e * 4 + j; return true;
    }
    struct Pf { unsigned a, w, c, q; };
    DI void pull_issue(int tid, Pf& pf) const { if (KIND == 1 && tid == 0) pf.q = __hip_atomic_fetch_add(queue + 16 * (c % 8), 1u, RLX_AGENT); }
    DI void pull_publish(int tid, const Pf& pf, int ui) const { if (KIND == 1 && tid == 0 && ui >= 0) qs[ui & 1] = (int)pf.q; }
    DI void prefetch(const Unit& u, int r, Pf& pf) const {
        const int e = u.pn >> 2, idx = (u.pm - ts[e]) * 256 + (r & 255); const bool valid = idx < ts[32 + e];
        pf.a = 0xffffffffu; pf.w = 0u; pf.c = 32u;
        if (valid && r < 256) { pf.a = (unsigned)slot_a[(size_t)e * SLOT_CAP + idx]; if (KIND == 1) pf.w = __float_as_uint(slot_w[(size_t)e * SLOT_CAP + idx]); }
        if (KIND == 1 && r < 64) pf.c = __hip_atomic_load(done_cnt + u.pm, RLX_AGENT);
    }
    DI void finish_meta(const Unit& u, int r, const Pf& pf, unsigned& off, unsigned& a0, unsigned& a1) const {
        if (KIND == 0) { const bool pad = pf.a == 0xffffffffu; off = (pad ? 0u : ((pf.a & 0xffffu) >> 1)) * (unsigned)D; a0 = 0u; a1 = pad ? 0u : (pf.a & 0xffff0000u); }
        else { off = (unsigned)(u.pm * 256 + r) * (unsigned)(DEXP * 2); a0 = pf.a == 0xffffffffu ? pf.a : (pf.a & 0xffffu); a1 = pf.w; }
    }
    DI void wait_ready(const Unit& u, int tid, const Pf& pf) const {
        if (KIND == 1 && tid < 64) { unsigned sp = 0;
            if ((unsigned)__builtin_amdgcn_readfirstlane((int)pf.c) < 32u)
                while ((unsigned)__builtin_amdgcn_readfirstlane((int)__hip_atomic_load(done_cnt + u.pm, RLX_AGENT)) < 32u) { __builtin_amdgcn_s_sleep(2); if (++sp > (1u << 20)) break; } }
    }
    DI void a_ready(const Unit&) const {}
    DI void done_nowait(const Unit& u) const { if (KIND == 0 && (threadIdx.x & 63) == 0) __hip_atomic_fetch_add(done_cnt + u.pm, 1u, RLX_AGENT); }
};
struct EpiG1 {
    static constexpr bool PERM = true, AFTER_DRAIN = false;
    bf16* HID; int skip; const float* cinv;
    DI void operator()(const pg8::f32x4 (&acc)[2][2][4][2], const Unit& u, int wr, int wc, int fr, int fq, const LAS unsigned* meta) const {
        if (skip == 1) { if (acc[0][0][0][0][0] == 12345.678f) HID[0] = 1; return; }
        const __amdgpu_buffer_rsrc_t rs = __builtin_amdgcn_make_buffer_rsrc((void*)HID, 0, (int)((size_t)NSLOT_MAX * DEXP * 2), 0x00020000);
        const int ln_ = ftid() & 63, fr_ = ln_ & 15, fq_ = ln_ >> 4; (void)fr; (void)fq;
        const int e = u.pn >> 2, r0 = wr * 64 + fr_, row0 = u.pm * BM + r0, col = (u.pn & 3) * 128 + wc * 32 + 8 * fq_;
        asm volatile("" ::: "memory");
        const float* cg = cinv + (e * 2 + 0) * 512 + col; const float* cu = cinv + (e * 2 + 1) * 512 + col;
        const pg8::f32x4 cg0 = *(const pg8::f32x4*)cg, cg1 = *(const pg8::f32x4*)(cg + 4), cu0 = *(const pg8::f32x4*)cu, cu1 = *(const pg8::f32x4*)(cu + 4);
#pragma unroll
        for (int ai = 0; ai < 2; ++ai)
#pragma unroll
            for (int m = 0; m < 4; ++m) { const int rl = r0 + ai * HALF + m * 16, row = row0 + ai * HALF + m * 16; float o[8];
                const float ra = __uint_as_float(meta[512 + rl]);
#pragma unroll
                for (int i = 0; i < 4; ++i) { o[i] = silu_f(acc[ai][0][m][0][i] * (ra * cg0[i])) * (acc[ai][1][m][0][i] * (ra * cu0[i])); o[4 + i] = silu_f(acc[ai][0][m][1][i] * (ra * cg1[i])) * (acc[ai][1][m][1][i] * (ra * cu1[i])); }
                pg8::u32x4 w; w.x = pg8::cvt_pk_bf16(o[0], o[1]); w.y = pg8::cvt_pk_bf16(o[2], o[3]); w.z = pg8::cvt_pk_bf16(o[4], o[5]); w.w = pg8::cvt_pk_bf16(o[6], o[7]);
                __builtin_amdgcn_raw_buffer_store_b128(w, rs, (row * DEXP + col) * 2, 0, 16); }
    }
};
struct EpiG2 {
    static constexpr bool PERM = true, AFTER_DRAIN = false;
    bf16* ROWS; int skip;
    DI void operator()(const pg8::f32x4 (&acc)[2][2][4][2], const Unit& u, int wr, int wc, int fr, int fq, const LAS unsigned* meta) const {
        if (skip == 1) { if (acc[0][0][0][0][0] == 12345.678f) ROWS[0] = 1; return; }
        const int r0 = wr * 64 + fr, colb = (u.pn & 3) * BM + wc * 32 + 8 * fq;
#pragma unroll
        for (int ai = 0; ai < 2; ++ai)
#pragma unroll
            for (int m = 0; m < 4; ++m) { const int r = r0 + ai * HALF + m * 16; const int d = (int)meta[256 + r]; const float wt = __uint_as_float(meta[512 + r]);
                if (d >= 0) {
#pragma unroll
                    for (int bj = 0; bj < 2; ++bj) { const pg8::f32x4 v0 = acc[ai][bj][m][0] * wt, v1 = acc[ai][bj][m][1] * wt;
                        pg8::u32x4 w; w.x = pg8::cvt_pk_bf16(v0[0], v0[1]); w.y = pg8::cvt_pk_bf16(v0[2], v0[3]); w.z = pg8::cvt_pk_bf16(v1[0], v1[1]); w.w = pg8::cvt_pk_bf16(v1[2], v1[3]);
                        *(pg8::u32x4*)(ROWS + (size_t)d * D + colb + bj * HALF) = w; } } }
    }
};

DI void mix_gating_simple(Frame& F, const Args& A, int l) {
    FRAME_IDS
    const bf16* P = (const bf16*)(F.ws + WS_PROJ); bf16* MIX = (bf16*)(F.ws + WS_MIXCAT);
    const float* lng = (const float*)A.in[I_GMLNG] + l * AW; const float* lnb = (const float*)A.in[I_GMLNB] + l * AW;
    const float* ws_ = (const float*)A.in[I_GMWS] + (size_t)l * 4 * 128 * 128; const float* bs_ = (const float*)A.in[I_GMBS] + l * 4 * 128;
    LAS float* vln = (LAS float*)(F.lds + RING_OFF);
    for (int it = F.vcu; it < BATCH * (T / 128); it += F.G) {
        const int m0 = it * 128;
        for (int r = wave_; r < 128; r += NWAVES) {
            const v2u w = *(const v2u*)(P + (size_t)(m0 + r) * PROJW + COL_V + 4 * lane_);
            float v[4] = {gelu_tanh_f(bflo(w.x)), gelu_tanh_f(bfhi(w.x)), gelu_tanh_f(bflo(w.y)), gelu_tanh_f(bfhi(w.y))};
            const float mean = wave_sum(v[0] + v[1] + v[2] + v[3]) * (1.f / 256.f);
            float s2 = 0.f;
#pragma unroll
            for (int i = 0; i < 4; ++i) { v[i] -= mean; s2 += v[i] * v[i]; }
            const float rstd = 1.0f / sqrtf(wave_sum(s2) * (1.f / 256.f) + LN_EPS);
#pragma unroll
            for (int i = 0; i < 4; ++i) vln[r * 256 + 4 * lane_ + i] = v[i] * rstd * lng[4 * lane_ + i] + lnb[4 * lane_ + i];
        }
        __syncthreads();
        { const int c = tid_ & 255, tp = tid_ >> 8, h = c >> 6;
          for (int t = tp; t < 128; t += 2) { const float* wrow = ws_ + ((size_t)h * 128 + t) * 128; float acc = 0.f;
              for (int s = 0; s <= t; ++s) acc += wrow[s] * vln[s * 256 + c];
              const float uu = gelu_tanh_f(bf2f(P[(size_t)(m0 + t) * PROJW + COL_U + c]));
              MIX[(size_t)(m0 + t) * D + c] = (bf16)f2bf(uu * (acc + bs_[h * 128 + t])); } }
        __syncthreads();
    }
}
DI void mix_attn_simple(Frame& F, int l) {
    FRAME_IDS
    const bf16* P = (const bf16*)(F.ws + WS_PROJ); bf16* MIX = (bf16*)(F.ws + WS_MIXCAT);
    const int gw = F.vcu * NWAVES + wave_, NGW = F.G * NWAVES;
    for (int it = gw; it < M * NH; it += NGW) {
        const int m = it >> 3, h = it & 7, t = m & (T - 1);
        const float q = bf2f(P[(size_t)m * PROJW + COL_Q + h * 64 + lane_]);
        float mx = -1e30f, den = 0.f, o = 0.f;
#pragma unroll 1
        for (int g = 0; g < 3; ++g) { const int dl = (g == 0) ? 1 : (g == 1 ? 4 : 16);
            int nk = t / dl; if (nk > 128) nk = 128;
#pragma unroll 2
            for (int j = 0; j <= nk; ++j) { const size_t mk = (size_t)(m - j * dl);
                const float kv = bf2f(P[mk * PROJW + COL_K + h * 64 + lane_]); const float vv = bf2f(P[mk * PROJW + COL_VA + h * 64 + lane_]);
                const float s = wave_sum(q * kv);
                const float mn = fmaxf(mx, s), f = __builtin_amdgcn_exp2f(mx - mn), p = __builtin_amdgcn_exp2f(s - mn);
                den = den * f + p; o = o * f + p * vv; mx = mn; } }
        MIX[(size_t)m * D + AW + h * 64 + lane_] = (bf16)f2bf(o / den);
    }
}

typedef float f32x16 __attribute__((ext_vector_type(16)));
typedef short v4i16_t __attribute__((ext_vector_type(4)));
DI int crow16(int r, int hi) { return (r & 3) + 8 * (r >> 2) + 4 * hi; }
template <int SUB> DI void mix_attn_mfma(Frame& F, int l) {
    FRAME_IDS
    const bf16* P = (const bf16*)(F.ws + WS_PROJ);
    LAS unsigned char* Ks = F.lds + RING_OFF; LAS unsigned char* Vs = Ks + 49152;
    LAS unsigned char* St = F.lds + ATT_STAGE_OFF + wave_ * 4608;
    const int ql = lane_ & 31, hi = lane_ >> 5, prow = lane_ >> 3, pch = lane_ & 7;
    constexpr int nitems = SUB == 0 ? 2048 : 1024;
    v4u kreg[6], vreg[6], qraw[4]; bf16x8 qf[4];
    int it = F.vcu; if (it >= nitems) return;
    int d, r, s0, b, h; size_t tokbase;
#define ATT_DECODE(IT) do { const int idx_ = (IT) & 1023; b = idx_ >> 7; h = (idx_ >> 4) & 7; int tile_; \
        if (SUB == 1) { d = 1; r = 0; tile_ = idx_ & 15; } else if ((IT) < 1024) { d = 16; r = idx_ & 15; tile_ = 0; } else { d = 4; r = (idx_ >> 2) & 3; tile_ = idx_ & 3; } \
        s0 = tile_ * 256; tokbase = (size_t)b * T + r; } while (0)
#define ATT_LOAD() do { const int tl_ = ftid(); _Pragma("unroll") for (int i = 0; i < 6; ++i) { const int idx2 = tl_ + 512 * i, row = idx2 >> 3, ch = idx2 & 7, step = s0 - 128 + row; \
            if (step >= 0) { const bf16* src = P + (tokbase + (size_t)step * d) * PROJW + h * 64 + ch * 8; kreg[i] = *(const v4u*)(src + COL_K); vreg[i] = *(const v4u*)(src + COL_VA); } \
            else { kreg[i] = (v4u){0u, 0u, 0u, 0u}; vreg[i] = (v4u){0u, 0u, 0u, 0u}; } } \
        _Pragma("unroll") for (int p = 0; p < 4; ++p) qraw[p] = *(const v4u*)(P + (tokbase + (size_t)(s0 + 32 * wave_ + 8 * p + prow) * d) * PROJW + COL_Q + h * 64 + pch * 8); } while (0)
#define ATT_WRITE() do { const int tw_ = ftid(); _Pragma("unroll") for (int i = 0; i < 6; ++i) { const int idx2 = tw_ + 512 * i, row = idx2 >> 3, ch = idx2 & 7; \
            *(LAS v4u*)(Ks + row * 128 + ((ch ^ ((row >> 1) & 7)) << 4)) = kreg[i]; \
            *(LAS v4u*)(Vs + row * 128 + ((ch ^ (((row >> 1) & 1) << 2)) << 4)) = vreg[i]; } \
        _Pragma("unroll") for (int p = 0; p < 4; ++p) *(LAS v4u*)(St + (8 * p + prow) * 144 + pch * 16) = qraw[p]; } while (0)
    ATT_DECODE(it); ATT_LOAD(); ATT_WRITE();
    __syncthreads();
    for (;;) {
        const size_t tb = tokbase; const int s0c = s0, dc = d, hcur = h, itcur = it;
        const bool first = (s0 == 0);
#pragma unroll
        for (int ks = 0; ks < 4; ++ks) qf[ks] = *(const LAS bf16x8*)(St + ql * 144 + (2 * ks + hi) * 16);
        const int itn = it + F.G; const bool has_next = itn < nitems;
        if (has_next) { ATT_DECODE(itn); ATT_LOAD(); }
        const int i0 = 32 * wave_;
        f32x16 S[5];
#pragma unroll
        for (int kb = 0; kb < 5; ++kb) { f32x16 acc;
#pragma unroll
            for (int i = 0; i < 16; ++i) acc[i] = 0.f;
            const int krow = i0 + 32 * kb + ql;
#pragma unroll
            for (int ks = 0; ks < 4; ++ks) { const bf16x8 a = *(const LAS bf16x8*)(Ks + krow * 128 + (((2 * ks + hi) ^ ((krow >> 1) & 7)) << 4)); acc = __builtin_amdgcn_mfma_f32_32x32x16_bf16(a, qf[ks], acc, 0, 0, 0); }
            S[kb] = acc; }
        int qrel = ql - 4 * hi; asm volatile("" : "+v"(qrel));
        float mx = -1e30f;
#pragma unroll
        for (int kb = 0; kb < 5; ++kb) {
            const bool bvalid = !first || (wave_ + kb >= 4);
            if (!bvalid) {
#pragma unroll
                for (int i = 0; i < 16; ++i) S[kb][i] = -1e30f;
            } else {
#pragma unroll
                for (int i = 0; i < 16; ++i) { const int c0 = crow16(i, 0); float v = S[kb][i];
                    if (kb == 0) v = (c0 >= qrel) ? v : -1e30f;
                    if (kb == 4) v = (c0 <= qrel) ? v : -1e30f;
                    S[kb][i] = v; mx = fmaxf(mx, v); }
            }
        }
        mx = fmaxf(mx, __shfl_xor(mx, 32));
        float lsum = 0.f;
#pragma unroll
        for (int kb = 0; kb < 5; ++kb)
#pragma unroll
            for (int i = 0; i < 16; ++i) { const float p = __builtin_amdgcn_exp2f(S[kb][i] - mx); S[kb][i] = p; lsum += p; }
        lsum += __shfl_xor(lsum, 32);
        v4u x16[4], x4[4]; f32x2_t s16 = {0.f, 0.f}, s4 = {0.f, 0.f};
        if (SUB == 1) {
            const size_t qt = tb + (size_t)(s0c + i0 + ql) * dc;
            s16 = *(const f32x2_t*)((const float*)(F.ws + WS_STAT) + (qt * NH + hcur) * 2); s4 = *(const f32x2_t*)((const float*)(F.ws + WS_STAT) + (size_t)M * NH * 2 + (qt * NH + hcur) * 2);
        }
        f32x16 O[2];
#pragma unroll
        for (int i = 0; i < 16; ++i) { O[0][i] = 0.f; O[1][i] = 0.f; }
        const int trq = (lane_ & 15) >> 2, trg = (lane_ >> 4) & 1, trp = lane_ & 3;
#pragma unroll
        for (int kb = 0; kb < 5; ++kb)
#pragma unroll
            for (int s = 0; s < 2; ++s) {
                if (SUB == 1 && kb == 2 && s == 0) {
#pragma unroll
                    for (int p = 0; p < 4; ++p) { const size_t rt = tb + (size_t)(s0c + i0 + 8 * p + prow) * dc; const bf16* pp = (const bf16*)(F.ws + WS_XN) + rt * BW + hcur * 64 + pch * 8;
                        x16[p] = *(const v4u*)pp; x4[p] = *(const v4u*)(pp + (size_t)M * BW); } }
                v4u pw; pw.x = cvtpk(S[kb][8 * s], S[kb][8 * s + 1]); pw.y = cvtpk(S[kb][8 * s + 2], S[kb][8 * s + 3]); pw.z = cvtpk(S[kb][8 * s + 4], S[kb][8 * s + 5]); pw.w = cvtpk(S[kb][8 * s + 6], S[kb][8 * s + 7]);
                const bf16x8 pb = __builtin_bit_cast(bf16x8, pw);
                const int rlo = i0 + 32 * kb + 16 * s + 4 * hi + trq, rhi = rlo + 8;
#pragma unroll
                for (int dh = 0; dh < 2; ++dh) { const int chunk = 4 * dh + 2 * trg + (trp >> 1);
                    const v4i16_t lo = __builtin_amdgcn_ds_read_tr16_b64_v4i16((LAS v4i16_t*)(Vs + rlo * 128 + ((chunk ^ (((rlo >> 1) & 1) << 2)) << 4) + 8 * (trp & 1)));
                    const v4i16_t hh = __builtin_amdgcn_ds_read_tr16_b64_v4i16((LAS v4i16_t*)(Vs + rhi * 128 + ((chunk ^ (((rhi >> 1) & 1) << 2)) << 4) + 8 * (trp & 1)));
                    const bf16x8 va = (bf16x8){lo[0], lo[1], lo[2], lo[3], hh[0], hh[1], hh[2], hh[3]};
                    O[dh] = __builtin_amdgcn_mfma_f32_32x32x16_bf16(va, pb, O[dh], 0, 0, 0); } }
        float osc;
        if (SUB == 0) osc = 1.0f / lsum;
        else { const float MM = fmaxf(mx, fmaxf(s16.x, s4.x)), a1 = __builtin_amdgcn_exp2f(mx - MM), a16 = s16.y * __builtin_amdgcn_exp2f(s16.x - MM), a4 = s4.y * __builtin_amdgcn_exp2f(s4.x - MM);
            const float inv = 1.0f / (lsum * a1 + a16 + a4); osc = a1 * inv;
            if (hi == 0) { f32x2_t cc = {a16 * inv, a4 * inv}; *(LAS f32x2_t*)(St + ql * 144 + 128) = cc; } }
#pragma unroll
        for (int dh = 0; dh < 2; ++dh)
#pragma unroll
            for (int g4 = 0; g4 < 4; ++g4) { v2u w; w.x = cvtpk(O[dh][4 * g4] * osc, O[dh][4 * g4 + 1] * osc); w.y = cvtpk(O[dh][4 * g4 + 2] * osc, O[dh][4 * g4 + 3] * osc);
                *(LAS v2u*)(St + ql * 144 + (32 * dh + 8 * g4 + 4 * hi) * 2) = w; }
        if (SUB == 0) {
            bf16* PART = (bf16*)(F.ws + WS_XN) + (itcur < 1024 ? 0 : (size_t)M * BW); float* ST = (float*)(F.ws + WS_STAT) + (itcur < 1024 ? 0 : (size_t)M * NH * 2);
            if (hi == 0) { const size_t qt = tb + (size_t)(s0c + i0 + ql) * dc; f32x2_t st = {mx, lsum}; *(f32x2_t*)(ST + (qt * NH + hcur) * 2) = st; }
#pragma unroll
            for (int p = 0; p < 4; ++p) { const size_t rt = tb + (size_t)(s0c + i0 + 8 * p + prow) * dc;
                *(v4u*)(PART + rt * BW + hcur * 64 + pch * 8) = *(const LAS v4u*)(St + (8 * p + prow) * 144 + pch * 16); }
        } else {
#pragma unroll
            for (int p = 0; p < 4; ++p) { const size_t rt = tb + (size_t)(s0c + i0 + 8 * p + prow) * dc;
                const v4u ov = *(const LAS v4u*)(St + (8 * p + prow) * 144 + pch * 16); const f32x2_t cc = *(const LAS f32x2_t*)(St + (8 * p + prow) * 144 + 128);
                v4u o;
                o.x = cvtpk(bflo(ov.x) + cc.x * bflo(x16[p].x) + cc.y * bflo(x4[p].x), bfhi(ov.x) + cc.x * bfhi(x16[p].x) + cc.y * bfhi(x4[p].x));
                o.y = cvtpk(bflo(ov.y) + cc.x * bflo(x16[p].y) + cc.y * bflo(x4[p].y), bfhi(ov.y) + cc.x * bfhi(x16[p].y) + cc.y * bfhi(x4[p].y));
                o.z = cvtpk(bflo(ov.z) + cc.x * bflo(x16[p].z) + cc.y * bflo(x4[p].z), bfhi(ov.z) + cc.x * bfhi(x16[p].z) + cc.y * bfhi(x4[p].z));
                o.w = cvtpk(bflo(ov.w) + cc.x * bflo(x16[p].w) + cc.y * bflo(x4[p].w), bfhi(ov.w) + cc.x * bfhi(x16[p].w) + cc.y * bfhi(x4[p].w));
                *(v4u*)((bf16*)(F.ws + WS_MIXCAT) + rt * D + AW + hcur * 64 + pch * 8) = o; }
        }
        __syncthreads();
        if (!has_next) break;
        ATT_WRITE(); it = itn;
        __syncthreads();
    }
#undef ATT_DECODE
#undef ATT_LOAD
#undef ATT_WRITE
}
typedef float f32x4_t __attribute__((ext_vector_type(4)));
DI void cmul_acc(float& xr, float& xi, float ar, float ai, float br, float bi) { const float nr = ar * xr - ai * xi + br, ni = ar * xi + ai * xr + bi; xr = nr; xi = ni; }
DI void mix_ssm_in(Frame& F, int l) {
    FRAME_IDS
    const bf16* P = (const bf16*)(F.ws + WS_PROJ);
    const bf16* WIN = (const bf16*)(F.ws + WS_SSM2 + l * SSM2_LAYER + S2_WIN);
    const float* apw = (const float*)(F.ws + WS_SSM2 + l * SSM2_LAYER + S2_APW);
    float* XLOC = (float*)(F.ws + WS_XLOC); float* XSUP = (float*)(F.ws + WS_XSUP);
    const int row = lane_ & 15, q = lane_ >> 4;
    for (int it = F.vcu; it < 256; it += F.G) {
        const int b = it >> 5, sc = (it >> 2) & 7, g = 4 * (it & 3) + (wave_ >> 1), half = wave_ & 1;
        bf16x8 af[16];
        { const bf16* src = P + ((size_t)b * T + (size_t)(16 * sc + row) * 32 + (q >> 1)) * PROJW + COL_S + g * 16 + 8 * (q & 1);
#pragma unroll
          for (int sp = 0; sp < 16; ++sp) af[sp] = *(const bf16x8*)(src + (size_t)(2 * sp) * PROJW); }
#pragma unroll 1
        for (int c4 = 0; c4 < 4; ++c4) { const int ct = 4 * half + c4;
            f32x4_t acc = {0.f, 0.f, 0.f, 0.f};
            const bf16* wp = WIN + (((size_t)(g * 16) * 8 + ct) * 64 + lane_) * 8;
#pragma unroll
            for (int sp = 0; sp < 16; ++sp) { const bf16x8 bfr = *(const bf16x8*)(wp + (size_t)sp * 8 * 64 * 8); acc = __builtin_amdgcn_mfma_f32_16x16x32_bf16(af[sp], bfr, acc, 0, 0, 0); }
            const int comp = 16 * ct + row, n = comp >> 1, part = comp & 1;
#pragma unroll
            for (int r = 0; r < 4; ++r) XLOC[(((size_t)b * 128 + 16 * sc + 4 * q + r) * 16 + g) * 128 + comp] = acc[r];
            const float a32r = apw[((g * 33 + 32) * 64 + n) * 2], a32i = apw[((g * 33 + 32) * 64 + n) * 2 + 1];
            const float sg = part ? 1.f : -1.f;
            float h = acc[0];
#pragma unroll
            for (int r = 1; r < 4; ++r) { const float o = __shfl_xor(h, 1); h = a32r * h + sg * a32i * o + acc[r]; }
            float p64r = a32r * a32r - a32i * a32i, p64i = 2.f * a32r * a32i;
            float p128r = p64r * p64r - p64i * p64i, p128i = 2.f * p64r * p64i;
            float wr = 1.f, wi = 0.f;
            for (int k = 0; k < 3 - q; ++k) { const float t0 = wr * p128r - wi * p128i, t1 = wr * p128i + wi * p128r; wr = t0; wi = t1; }
            { const float o = __shfl_xor(h, 1); h = wr * h + sg * wi * o; }
            h += __shfl_xor(h, 16); h += __shfl_xor(h, 32);
            if (q == 0) XSUP[(((size_t)b * 8 + sc) * 16 + g) * 128 + comp] = h;
        }
    }
}
DI void mix_ssm_out(Frame& F, const Args& A, int l) {
    FRAME_IDS
    const bf16* P = (const bf16*)(F.ws + WS_PROJ); bf16* YG = (bf16*)(F.ws + WS_YG);
    const bf16* KT = (const bf16*)(F.ws + WS_SSM2 + l * SSM2_LAYER + S2_KT); const bf16* CT = (const bf16*)(F.ws + WS_SSM2 + l * SSM2_LAYER + S2_CT);
    const float* apw = (const float*)(F.ws + WS_SSM2 + l * SSM2_LAYER + S2_APW);
    const float* XLOC = (const float*)(F.ws + WS_XLOC); const float* XSUP = (const float*)(F.ws + WS_XSUP);
    LAS unsigned char* Ut = F.lds + RING_OFF + wave_ * 4096;
    LAS float* Xs = (LAS float*)(F.lds + RING_OFF + wave_ * 4096 + 2048);
    for (int i = lane_; i < 256; i += 64) ((LAS unsigned*)Ut)[i] = 0u;
    const int row = lane_ & 15, q = lane_ >> 4;
    for (int it = F.vcu; it < 256; it += F.G) {
        const int b = it >> 5, sc = (it >> 2) & 7, g = 4 * (it & 3) + (wave_ >> 1), half = wave_ & 1, n = lane_;
        const size_t tokA = (size_t)b * T + (size_t)(16 * sc + 8 * half) * 32;
        v4u unext = *(const v4u*)(P + (tokA + (lane_ >> 1)) * PROJW + COL_S + g * 16 + 8 * (lane_ & 1));
        f32x2_t psup[8], ploc[8];
#pragma unroll
        for (int s2 = 0; s2 < 8; ++s2) { psup[s2] = (f32x2_t){0.f, 0.f}; if (s2 < sc) psup[s2] = *(const f32x2_t*)(XSUP + (((size_t)b * 8 + s2) * 16 + g) * 128 + 2 * n); }
#pragma unroll
        for (int k2 = 0; k2 < 8; ++k2) { ploc[k2] = (f32x2_t){0.f, 0.f}; if (half) ploc[k2] = *(const f32x2_t*)(XLOC + (((size_t)b * 128 + 16 * sc + k2) * 16 + g) * 128 + 2 * n); }
        const float dsk = ((const float*)A.in[I_SSMD])[(l * 16 + g) * 16 + row];
        const float a32r = apw[((g * 33 + 32) * 64 + n) * 2], a32i = apw[((g * 33 + 32) * 64 + n) * 2 + 1];
        const float a16r = apw[((g * 33 + 16) * 64 + n) * 2], a16i = apw[((g * 33 + 16) * 64 + n) * 2 + 1];
        float a512r = a32r, a512i = a32i;
#pragma unroll
        for (int k = 0; k < 4; ++k) { const float t0 = a512r * a512r - a512i * a512i, t1 = 2.f * a512r * a512i; a512r = t0; a512i = t1; }
        float xr = 0.f, xi = 0.f;
#pragma unroll
        for (int s2 = 0; s2 < 8; ++s2) if (s2 < sc) cmul_acc(xr, xi, a512r, a512i, psup[s2].x, psup[s2].y);
        if (half) {
#pragma unroll
            for (int k2 = 0; k2 < 8; ++k2) cmul_acc(xr, xi, a32r, a32i, ploc[k2].x, ploc[k2].y); }
        asm volatile("" : "+v"(xr), "+v"(xi) :: "memory");
        bf16x8 kt[16], ctf[4];
#pragma unroll
        for (int p = 0; p < 16; ++p) kt[p] = *(const bf16x8*)(KT + ((size_t)(g * 16 + p) * 64 + lane_) * 8);
#pragma unroll
        for (int sx = 0; sx < 4; ++sx) ctf[sx] = *(const bf16x8*)(CT + ((size_t)(g * 4 + sx) * 64 + lane_) * 8);
        f32x4_t apr[4][2];
#pragma unroll
        for (int sx = 0; sx < 4; ++sx) { const f32x4_t* ap = (const f32x4_t*)(apw + ((size_t)(g * 33 + row + 1) * 64 + 16 * sx + 4 * q) * 2); apr[sx][0] = ap[0]; apr[sx][1] = ap[1]; }
#pragma unroll 1
        for (int kk = 0; kk < 8; ++kk) {
            const size_t tok0 = tokA + (size_t)kk * 32;
            const f32x2_t xl = *(const f32x2_t*)(XLOC + (((size_t)b * 128 + 16 * sc + 8 * half + kk) * 16 + g) * 128 + 2 * n);
            *(LAS v4u*)(Ut + 1024 + lane_ * 16) = unext;
            if (kk < 7) unext = *(const v4u*)(P + (tok0 + 32 + (lane_ >> 1)) * PROJW + COL_S + g * 16 + 8 * (lane_ & 1));
            Xs[2 * n] = xr; Xs[2 * n + 1] = xi; Xs[128 + 2 * n] = a16r * xr - a16i * xi; Xs[128 + 2 * n + 1] = a16r * xi + a16i * xr;
#pragma unroll
            for (int tau = 0; tau < 2; ++tau) { f32x4_t acc = (f32x4_t){0.f, 0.f, 0.f, 0.f};
                const int ti = 16 * tau + row;
#pragma unroll
                for (int sx = 0; sx < 4; ++sx) { const LAS f32x4_t* xp = (const LAS f32x4_t*)(Xs + 128 * tau + 2 * (16 * sx + 4 * q)); const f32x4_t x01 = xp[0], x23 = xp[1];
                    const f32x4_t a01 = apr[sx][0], a23 = apr[sx][1];
                    v4u zw; zw.x = cvtpk(a01.x * x01.x - a01.y * x01.y, a01.x * x01.y + a01.y * x01.x); zw.y = cvtpk(a01.z * x01.z - a01.w * x01.w, a01.z * x01.w + a01.w * x01.z);
                    zw.z = cvtpk(a23.x * x23.x - a23.y * x23.y, a23.x * x23.y + a23.y * x23.x); zw.w = cvtpk(a23.z * x23.z - a23.w * x23.w, a23.z * x23.w + a23.w * x23.z);
                    acc = __builtin_amdgcn_mfma_f32_16x16x32_bf16(__builtin_bit_cast(bf16x8, zw), ctf[sx], acc, 0, 0, 0);
                    asm volatile("" ::: "memory"); }
#pragma unroll
                for (int p = 0; p < 16; ++p) if (p < 8 * tau + 8) { const bf16x8 ua = *(const LAS bf16x8*)(Ut + (32 + ti - 2 * p - (q >> 1)) * 32 + 16 * (q & 1));
                    acc = __builtin_amdgcn_mfma_f32_16x16x32_bf16(ua, kt[p], acc, 0, 0, 0); if ((p & 3) == 3) asm volatile("" ::: "memory"); }
#pragma unroll
                for (int r = 0; r < 4; ++r) { const int t2 = 16 * tau + 4 * q + r; const float uu = bf2f(*(const LAS bf16*)(Ut + (32 + t2) * 32 + 2 * row));
                    YG[(tok0 + t2) * 256 + g * 16 + row] = (bf16)f2bf(gelu_tanh_f(acc[r] + dsk * uu)); }
            }
            cmul_acc(xr, xi, a32r, a32i, xl.x, xl.y);
        }
    }
}
DI void mix_gating_mfma(Frame& F, const Args& A, int l, int variant = 0) {
    FRAME_IDS
    const bf16* P = (const bf16*)(F.ws + WS_PROJ); bf16* MIX = (bf16*)(F.ws + WS_MIXCAT);
    const bf16* GW = (const bf16*)(F.ws + WS_SSM2 + l * SSM2_LAYER + S2_GW);
    const float* lng = (const float*)A.in[I_GMLNG] + l * AW; const float* lnb = (const float*)A.in[I_GMLNB] + l * AW;
    const float* bs_ = (const float*)A.in[I_GMBS] + l * 4 * 128;
    LAS unsigned char* VT = F.lds + RING_OFF;
    const int ql = lane_ & 31, hi = lane_ >> 5, trq = (lane_ & 15) >> 2, trg = (lane_ >> 4) & 1, trp = lane_ & 3;
    for (int it = F.vcu; it < BATCH * (T / 128); it += F.G) {
        const int m0 = it * 128;
        __syncthreads();
        if (variant != 2) {
        v2u wv[16];
#pragma unroll
        for (int j = 0; j < 16; ++j) wv[j] = *(const v2u*)(P + (size_t)(m0 + wave_ + 8 * j) * PROJW + COL_V + 4 * lane_);
        const f32x4 gg = *(const f32x4*)(lng + 4 * lane_), bb = *(const f32x4*)(lnb + 4 * lane_);
#pragma unroll
        for (int j = 0; j < 16; ++j) { const int r = wave_ + 8 * j; const v2u w = wv[j];
            float v[4] = {gelu_tanh_f(bflo(w.x)), gelu_tanh_f(bfhi(w.x)), gelu_tanh_f(bflo(w.y)), gelu_tanh_f(bfhi(w.y))};
            const float mean = wave_sum(v[0] + v[1] + v[2] + v[3]) * (1.f / 256.f);
            float s2 = 0.f;
#pragma unroll
            for (int i = 0; i < 4; ++i) { v[i] -= mean; s2 += v[i] * v[i]; }
            const float rstd = 1.0f / sqrtf(wave_sum(s2) * (1.f / 256.f) + LN_EPS);
            v2u o; o.x = cvtpk(v[0] * rstd * gg.x + bb.x, v[1] * rstd * gg.y + bb.y); o.y = cvtpk(v[2] * rstd * gg.z + bb.z, v[3] * rstd * gg.w + bb.w);
            *(LAS v2u*)(VT + r * 512 + (((lane_ >> 1) ^ ((r & 3) << 2)) << 4) + 8 * (lane_ & 1)) = o;
        }
        }
        __syncthreads();
        if (variant == 1) continue;
        const int h = wave_ >> 1, cb = 64 * h + 32 * (wave_ & 1);
        const int chunk = (cb >> 3) + 2 * trg + (trp >> 1);
#pragma unroll
        for (int rt = 0; rt < 4; ++rt) {
            f32x16 acc;
#pragma unroll
            for (int i = 0; i < 16; ++i) acc[i] = 0.f;
            bf16x8 wa[8];
#pragma unroll
            for (int ks = 0; ks < 2 * rt + 2; ++ks) wa[ks] = *(const bf16x8*)(GW + (size_t)(h * 128 + 32 * rt) * 128 + 16 * ks + (unsigned)(ql * 128 + 8 * hi));
#pragma unroll
            for (int ks = 0; ks < 2 * rt + 2; ++ks) {
                const int rlo = 16 * ks + 8 * hi + trq;
                const v4i16_t lo = __builtin_amdgcn_ds_read_tr16_b64_v4i16((LAS v4i16_t*)(VT + rlo * 512 + ((chunk ^ (trq << 2)) << 4) + 8 * (trp & 1)));
                const v4i16_t hh = __builtin_amdgcn_ds_read_tr16_b64_v4i16((LAS v4i16_t*)(VT + (rlo + 4) * 512 + ((chunk ^ (trq << 2)) << 4) + 8 * (trp & 1)));
                const bf16x8 va = (bf16x8){lo[0], lo[1], lo[2], lo[3], hh[0], hh[1], hh[2], hh[3]};
                acc = __builtin_amdgcn_mfma_f32_32x32x16_bf16(va, wa[ks], acc, 0, 0, 0); }
            { const int t = 32 * rt + ql; const float bsv = bs_[h * 128 + t];
              const bf16* up = P + (size_t)(m0 + t) * PROJW + COL_U + cb + 4 * hi; bf16* op = MIX + (size_t)(m0 + t) * D + cb + 4 * hi;
#pragma unroll
              for (int g4 = 0; g4 < 4; ++g4) { const v2u uw = *(const v2u*)(up + 8 * g4); v2u o;
                  o.x = cvtpk(gelu_tanh_f(bflo(uw.x)) * (acc[4 * g4] + bsv), gelu_tanh_f(bfhi(uw.x)) * (acc[4 * g4 + 1] + bsv)); o.y = cvtpk(gelu_tanh_f(bflo(uw.y)) * (acc[4 * g4 + 2] + bsv), gelu_tanh_f(bfhi(uw.y)) * (acc[4 * g4 + 3] + bsv));
                  *(v2u*)(op + 8 * g4) = o; } }
        }
    }
}

DI void p_glu(Frame& F, const Args& A, int l) {
    FRAME_IDS
    const bf16* YG = (const bf16*)(F.ws + WS_YG); bf16* MIX = (bf16*)(F.ws + WS_MIXCAT);
    const bf16* GluT = (const bf16*)(F.ws + WS_WSMALL + l * WSMALL_LAYER + WOFF_GLU); const float* gb = (const float*)A.in[I_GLUB] + l * 256;
    LAS unsigned char* Bs = F.lds + RING_OFF;
#pragma unroll
    for (int i = 0; i < 16; ++i) { const int idx = tid_ + 512 * i, n = idx >> 5, ch = idx & 31;
        *(LAS v4u*)(Bs + n * 512 + ((ch ^ (n & 15)) << 4)) = *(const v4u*)(GluT + (size_t)n * 256 + ch * 8); }
    __syncthreads();
    const int tk = lane_ & 15, q = lane_ >> 4;
    for (int rt = F.vcu; rt < M / 128; rt += F.G) {
        const size_t tok = (size_t)rt * 128 + wave_ * 16 + tk;
        bf16x8 yf[8];
#pragma unroll
        for (int ks = 0; ks < 8; ++ks) yf[ks] = *(const bf16x8*)(YG + tok * 256 + 32 * ks + 8 * q);
#pragma unroll 4
        for (int ct = 0; ct < 16; ++ct) {
            f32x4_t acc = {0.f, 0.f, 0.f, 0.f};
            const int n = 16 * ct + tk;
#pragma unroll
            for (int ks = 0; ks < 8; ++ks) { const bf16x8 wf = *(const LAS bf16x8*)(Bs + n * 512 + (((4 * ks + q) ^ (n & 15)) << 4));
                acc = __builtin_amdgcn_mfma_f32_16x16x32_bf16(wf, yf[ks], acc, 0, 0, 0); }
            const int n0 = 16 * ct + 4 * q; const v2u yw = *(const v2u*)(YG + tok * 256 + n0); const f32x4 bv = *(const f32x4*)(gb + n0);
            v2u o; o.x = cvtpk(bflo(yw.x) * sigmoid_f(acc[0] + bv.x), bfhi(yw.x) * sigmoid_f(acc[1] + bv.y)); o.y = cvtpk(bflo(yw.y) * sigmoid_f(acc[2] + bv.z), bfhi(yw.y) * sigmoid_f(acc[3] + bv.w));
            *(v2u*)(MIX + tok * D + 768 + n0) = o;
        }
    }
}
DI void mix_ssm_simple(Frame& F, const Args& A, int l) {
    FRAME_IDS
    const bf16* P = (const bf16*)(F.ws + WS_PROJ); bf16* YG = (bf16*)(F.ws + WS_YG);
    const float* tab = (const float*)(F.ws + WS_SSM) + (size_t)l * SSM_TAB;
    LAS float* fin = (LAS float*)(F.lds + RING_OFF);
    for (int it = F.vcu; it < BATCH * SSM_G; it += F.G) {
        const int b = it >> 4, g = it & 15, n = lane_, seg = wave_, gn = g * 64 + n;
        const float are = tab[gn], aim = tab[1024 + gn];
        float bre[16], bim[16], cre[16], cim[16];
#pragma unroll
        for (int c = 0; c < 16; ++c) { bre[c] = tab[2048 + gn * 16 + c]; bim[c] = tab[2048 + 16384 + gn * 16 + c];
            cre[c] = ((const float*)A.in[I_CRE])[(((size_t)l * 16 + g) * 16 + c) * 64 + n]; cim[c] = ((const float*)A.in[I_CIM])[(((size_t)l * 16 + g) * 16 + c) * 64 + n]; }
        const float dsk = ((const float*)A.in[I_SSMD])[(l * 16 + g) * 16 + (lane_ & 15)];
        const size_t mbase = (size_t)b * T + seg * 512;
        float xr = 0.f, xi = 0.f;
        for (int tt = 0; tt < 512; ++tt) { const v4u* up = (const v4u*)(P + (mbase + tt) * PROJW + COL_S + g * 16); const v4u u0 = up[0], u1 = up[1];
            const float u[16] = {bflo(u0.x), bfhi(u0.x), bflo(u0.y), bfhi(u0.y), bflo(u0.z), bfhi(u0.z), bflo(u0.w), bfhi(u0.w), bflo(u1.x), bfhi(u1.x), bflo(u1.y), bfhi(u1.y), bflo(u1.z), bfhi(u1.z), bflo(u1.w), bfhi(u1.w)};
            float br = 0.f, bi = 0.f;
#pragma unroll
            for (int c = 0; c < 16; ++c) { br += u[c] * bre[c]; bi += u[c] * bim[c]; }
            const float nr = are * xr - aim * xi + br, ni = are * xi + aim * xr + bi; xr = nr; xi = ni; }
        fin[(seg * 64 + n) * 2] = xr; fin[(seg * 64 + n) * 2 + 1] = xi;
        __syncthreads();
        float pr = are, pi = aim;
#pragma unroll
        for (int k = 0; k < 9; ++k) { const float t0 = pr * pr - pi * pi, t1 = 2.f * pr * pi; pr = t0; pi = t1; }
        xr = 0.f; xi = 0.f;
        for (int s = 0; s < seg; ++s) { const float fr_ = fin[(s * 64 + n) * 2], fi_ = fin[(s * 64 + n) * 2 + 1];
            const float nr = pr * xr - pi * xi + fr_, ni = pr * xi + pi * xr + fi_; xr = nr; xi = ni; }
        for (int tt = 0; tt < 512; ++tt) { const v4u* up = (const v4u*)(P + (mbase + tt) * PROJW + COL_S + g * 16); const v4u u0 = up[0], u1 = up[1];
            const float u[16] = {bflo(u0.x), bfhi(u0.x), bflo(u0.y), bfhi(u0.y), bflo(u0.z), bfhi(u0.z), bflo(u0.w), bfhi(u0.w), bflo(u1.x), bfhi(u1.x), bflo(u1.y), bfhi(u1.y), bflo(u1.z), bfhi(u1.z), bflo(u1.w), bfhi(u1.w)};
            float br = 0.f, bi = 0.f;
#pragma unroll
            for (int c = 0; c < 16; ++c) { br += u[c] * bre[c]; bi += u[c] * bim[c]; }
            const float nr = are * xr - aim * xi + br, ni = are * xi + aim * xr + bi; xr = nr; xi = ni;
            float ysel = 0.f, usel = 0.f;
#pragma unroll
            for (int c = 0; c < 16; ++c) { const float r = wave_sum(xr * cre[c] - xi * cim[c]); if ((lane_ & 15) == c) { ysel = r; usel = u[c]; } }
            if (lane_ < 16) { const float y = ysel + dsk * usel; YG[(mbase + tt) * 256 + g * 16 + lane_] = (bf16)f2bf(gelu_tanh_f(y)); } }
        __syncthreads();
    }
}

DI bool beats(float x, int i, float y, int j) { return x > y || (x == y && i < j); }
DI void p_row_b(Frame& F, const Args& A, int l, bool count = true) {
    FRAME_IDS
    const int gw = F.vcu * NWAVES + wave_, NGW = F.G * NWAVES;
    const bf16* PRE = (const bf16*)(F.ws + WS_PRE); bf16* X1 = (bf16*)(F.ws + WS_X1); bf16* XN = (bf16*)(F.ws + WS_XN);
    const float* mod = (const float*)(F.ws + WS_MOD) + (size_t)l * BATCH * 6 * D;
    const float* ln1g = (const float*)A.in[I_LN1G] + l * D; const float* ln1b = (const float*)A.in[I_LN1B] + l * D;
    const float* rw = (const float*)A.in[I_RW]; const float* rb = (const float*)A.in[I_RB];
    int* slot_a = (int*)(F.ws + WS_SLOT_A); float* slot_w = (float*)(F.ws + WS_SLOT_W);
    LAS float* rwS = (LAS float*)(F.lds + RING_OFF);
    volatile LAS unsigned* lcnt = (volatile LAS unsigned*)(F.lds + RING_OFF + 65536);
    LAS int* list_a = (LAS int*)(F.lds + RING_OFF + 66048); LAS float* list_w = (LAS float*)(F.lds + RING_OFF + 66048 + 8192);
    for (int i = tid_; i < D * NEXP; i += NTHR) rwS[(i & 15) * D + (i >> 4)] = rw[i];
    if (tid_ < 32) lcnt[tid_] = 0u;
    __syncthreads();
    const int hi5 = lane_ >> 5, b4 = (lane_ >> 4) & 1, b3 = (lane_ >> 3) & 1, b2 = (lane_ >> 2) & 1, emine = 8 * hi5 + 4 * b4 + 2 * b3 + b2;
    const int wi = 2 * b3 + b2, mygrp = 2 * hi5 + b4;
    const float rbm = rb[emine];
    Row16 lg1, lb1; row_load_f32(lg1, ln1g, lane_); row_load_f32(lb1, ln1b, lane_);
    v2u nraw[4];
    const int bq = gw / (NGW / BATCH), mbase = bq * T + gw % (NGW / BATCH), mstep = NGW / BATCH;
    const float* md = mod + (size_t)bq * 6 * D;
    Row16 msc, msh; row_load_f32(msc, md + 4 * D, lane_); row_load_f32(msh, md + 3 * D, lane_);
    { const v2u* q = (const v2u*)(PRE + (size_t)mbase * D);
#pragma unroll
      for (int k = 0; k < 4; ++k) nraw[k] = q[k * 64 + lane_]; }
    for (int m = mbase; m < (bq + 1) * T; m += mstep) {
        Row16 r;
#pragma unroll
        for (int k = 0; k < 4; ++k) { r.v[4 * k] = bflo(nraw[k].x); r.v[4 * k + 1] = bfhi(nraw[k].x); r.v[4 * k + 2] = bflo(nraw[k].y); r.v[4 * k + 3] = bfhi(nraw[k].y); }
        if (m + mstep < (bq + 1) * T) { const v2u* q = (const v2u*)(PRE + (size_t)(m + mstep) * D);
#pragma unroll
            for (int k = 0; k < 4; ++k) nraw[k] = q[k * 64 + lane_]; }
        row_ln(r);
#pragma unroll
        for (int i = 0; i < 16; ++i) r.v[i] = r.v[i] * lg1.v[i] + lb1.v[i];
        row_ln(r);
#pragma unroll
        for (int i = 0; i < 16; ++i) r.v[i] = r.v[i] * (1.0f + msc.v[i]) + msh.v[i];
        unsigned ib;
        { float am = 0.f;
#pragma unroll
          for (int i = 0; i < 16; ++i) am = fmaxf(am, fabsf(r.v[i]));
          am = wave_max(am); ib = (am > 1e-30f) ? ((__float_as_uint(am * (1.0f / 440.0f)) + 0xffffu) & 0xffff0000u) : 0x3f800000u;
          const float qs = 1.0f / __uint_as_float(ib);
          unsigned* q8 = (unsigned*)((unsigned char*)XN + (size_t)m * D);
#pragma unroll
          for (int k = 0; k < 4; ++k) q8[k * 64 + lane_] = pk4_fp8(r.v[4 * k] * qs, r.v[4 * k + 1] * qs, r.v[4 * k + 2] * qs, r.v[4 * k + 3] * qs); }
        float lg[16];
#pragma unroll
        for (int e = 0; e < 16; ++e) { float a = 0.f;
#pragma unroll
            for (int k = 0; k < 4; ++k) { const f32x4 w4 = *(const LAS f32x4*)(rwS + e * D + 256 * k + 4 * lane_); a += r.v[4 * k] * w4.x + r.v[4 * k + 1] * w4.y + r.v[4 * k + 2] * w4.z + r.v[4 * k + 3] * w4.w; }
            lg[e] = a; }
        float t8[8], t4[4], t2[2];
#pragma unroll
        for (int i = 0; i < 8; ++i) { const float keep = hi5 ? lg[8 + i] : lg[i], give = hi5 ? lg[i] : lg[8 + i]; t8[i] = keep + __shfl_xor(give, 32); }
#pragma unroll
        for (int i = 0; i < 4; ++i) { const float keep = b4 ? t8[4 + i] : t8[i], give = b4 ? t8[i] : t8[4 + i]; t4[i] = keep + __shfl_xor(give, 16); }
#pragma unroll
        for (int i = 0; i < 2; ++i) { const float keep = b3 ? t4[2 + i] : t4[i], give = b3 ? t4[i] : t4[2 + i]; t2[i] = keep + __shfl_xor(give, 8); }
        float z = (b2 ? t2[1] : t2[0]) + __shfl_xor(b2 ? t2[0] : t2[1], 4);
        z += __shfl_xor(z, 2); z += __shfl_xor(z, 1);
        const float scm = 1.0f / (1.0f + __builtin_amdgcn_exp2f(-1.4426950408889634f * z)), a = scm + rbm;
        const float p4 = __shfl_xor(a, 4), p8 = __shfl_xor(a, 8), p12 = __shfl_xor(a, 12);
        const float hi01 = fmaxf(a, p4), lo01 = fminf(a, p4), hi23 = fmaxf(p8, p12), lo23 = fminf(p8, p12);
        const float gs = fmaxf(hi01, hi23) + fmaxf(fmaxf(lo01, lo23), fminf(hi01, hi23));
        const float g16 = __shfl_xor(gs, 16), g32 = __shfl_xor(gs, 32), g48 = __shfl_xor(gs, 48);
        const bool best = beats(gs, mygrp, g16, mygrp ^ 1) && beats(gs, mygrp, g32, mygrp ^ 2) && beats(gs, mygrp, g48, mygrp ^ 3);
        const int rank = (beats(p4, wi ^ 1, a, wi) ? 1 : 0) + (beats(p8, wi ^ 2, a, wi) ? 1 : 0) + (beats(p12, wi ^ 3, a, wi) ? 1 : 0);
        const bool sel = best && rank < 2;
        float tot = sel ? scm : 0.f; tot += __shfl_xor(tot, 4); tot += __shfl_xor(tot, 8);
        if (count && sel && (lane_ & 3) == 0) { const unsigned rk = atomicAdd((unsigned*)&lcnt[emine], 1u);
            list_a[emine * 128 + rk] = (int)((unsigned)(2 * m + rank) | ib); list_w[emine * 128 + rk] = scm / tot; }
    }
    __syncthreads();
    if (count) {
        if (tid_ < 16) { const unsigned n = lcnt[tid_]; lcnt[16 + tid_] = n ? atomicAdd((unsigned*)(F.ctl + CW_CNT + l * 128 + tid_), n) : 0u; }
        __syncthreads();
        for (int idx = tid_; idx < 16 * 128; idx += NTHR) { const int e = idx >> 7, rk = idx & 127;
            if (rk < (int)lcnt[e]) { const size_t slot = (size_t)e * SLOT_CAP + lcnt[16 + e] + rk; slot_a[slot] = list_a[idx]; slot_w[slot] = list_w[idx]; } }
    }
}

DI void moe_tstart(Frame& F, int l) {
    FRAME_IDS
    volatile LAS int* ts = (volatile LAS int*)(F.lds + LDSCTL_OFF);
    __syncthreads();
    if (tid_ == 0) { int acc = 0;
        for (int e = 0; e < 16; ++e) { ts[e] = acc; const unsigned c = __hip_atomic_load(F.ctl + CW_CNT + l * 128 + e, RLX_AGENT); ts[32 + e] = (int)c; acc += (int)((c + 255u) >> 8); }
        ts[16] = acc; }
    __syncthreads();
}
DI void p_row_c(Frame& F, const Args& A, int l) {
    FRAME_IDS
    const int gw = F.vcu * NWAVES + wave_, NGW = F.G * NWAVES;
    const bf16* X1 = (const bf16*)(F.ws + WS_PRE); bf16* R2 = (bf16*)(F.ws + WS_ROWS2); bf16* XN = (bf16*)(F.ws + WS_XN);
    const float* ln1g = (const float*)A.in[I_LN1G] + l * D; const float* ln1b = (const float*)A.in[I_LN1B] + l * D;
    Row16 lg1, lb1; row_load_f32(lg1, ln1g, lane_); row_load_f32(lb1, ln1b, lane_);
    const float* mod = (const float*)(F.ws + WS_MOD) + (size_t)l * BATCH * 6 * D;
    const float* modn = (const float*)(F.ws + WS_MOD) + (size_t)(l + 1) * BATCH * 6 * D;
    const float* ln2g = (const float*)A.in[I_LN2G] + l * D; const float* ln2b = (const float*)A.in[I_LN2B] + l * D;
    Row16 lg2, lb2; row_load_f32(lg2, ln2g, lane_); row_load_f32(lb2, ln2b, lane_);
    v2u nx[4], n0[4], n1[4];
#define RC_LOAD(mm) do { const v2u* qa = (const v2u*)(X1 + (size_t)(mm) * D); const v2u* qb = (const v2u*)(R2 + (size_t)(2 * (mm)) * D); \
        _Pragma("unroll") for (int k = 0; k < 4; ++k) { nx[k] = __builtin_nontemporal_load(&qa[k * 64 + lane_]); n0[k] = __builtin_nontemporal_load(&qb[k * 64 + lane_]); n1[k] = __builtin_nontemporal_load(&qb[256 + k * 64 + lane_]); } } while (0)
    const int bq = gw / (NGW / BATCH), mbase = bq * T + gw % (NGW / BATCH), mstep = NGW / BATCH;
    const float* md = mod + (size_t)bq * 6 * D;
    Row16 gm; row_load_f32(gm, md + 5 * D, lane_);
    Row16 msc, msh;
    if (l != DEPTH - 1) { const float* mdn = modn + (size_t)bq * 6 * D; row_load_f32(msc, mdn + 1 * D, lane_); row_load_f32(msh, mdn + 0 * D, lane_); }
    RC_LOAD(mbase);
    for (int m = mbase; m < (bq + 1) * T; m += mstep) {
        Row16 x1, g2;
#pragma unroll
        for (int k = 0; k < 4; ++k) {
            x1.v[4 * k] = bflo(nx[k].x); x1.v[4 * k + 1] = bfhi(nx[k].x); x1.v[4 * k + 2] = bflo(nx[k].y); x1.v[4 * k + 3] = bfhi(nx[k].y);
            g2.v[4 * k] = bflo(n0[k].x) + bflo(n1[k].x); g2.v[4 * k + 1] = bfhi(n0[k].x) + bfhi(n1[k].x); g2.v[4 * k + 2] = bflo(n0[k].y) + bflo(n1[k].y); g2.v[4 * k + 3] = bfhi(n0[k].y) + bfhi(n1[k].y); }
        if (m + mstep < (bq + 1) * T) RC_LOAD(m + mstep);
        row_ln(x1);
#pragma unroll
        for (int i = 0; i < 16; ++i) x1.v[i] = ALPHA * (x1.v[i] * lg1.v[i] + lb1.v[i]) + (1.0f + gm.v[i]) * g2.v[i];
        row_ln(x1);
#pragma unroll
        for (int i = 0; i < 16; ++i) x1.v[i] = x1.v[i] * lg2.v[i] + lb2.v[i];
        if (l == DEPTH - 1) row_store_f32(x1, A.out + (size_t)m * D, lane_);
        else { row_store_bf16(x1, R2 + (size_t)(2 * m) * D, lane_);
            row_ln(x1);
#pragma unroll
            for (int i = 0; i < 16; ++i) x1.v[i] = x1.v[i] * (1.0f + msc.v[i]) + msh.v[i];
            row_store_fp8(x1, (unsigned char*)XN + (size_t)m * D, (float*)(F.ws + WS_SA) + m, lane_); }
    }
#undef RC_LOAD
}

#ifndef PHMASK
#define PHMASK 0xFFFFFFFFu
#endif
#define IN(k) (lo <= (k) && (k) < hi && ((PHMASK >> (((k) == 0) ? 31 : (((k) - 1) % PH_PER_LAYER))) & 1u))
#define SEAM(k) do { if (IN((k) + 1) && MK_ONE_LAUNCH) xcd_barrier(bar); else __syncthreads(); } while (0)
constexpr int PH_PER_LAYER = 9, N_PHASES = 1 + DEPTH * PH_PER_LAYER;
#ifndef REP_PH
#define REP_PH -1
#endif
#define NREP(k) (((k) == REP_PH) ? 2 : 1)
template <int l> DI void layer_body(Frame& F, const Args& args, const XcdBarrier& bar, const int lo, const int hi) {
    unsigned char* ws = args.ws;

        const int pb = 1 + l * PH_PER_LAYER;
        const bf16* WinT = (const bf16*)(ws + WS_WSMALL + l * WSMALL_LAYER + WOFF_IN);
        const bf16* WoutT = (const bf16*)(ws + WS_WSMALL + l * WSMALL_LAYER + WOFF_OUT);
        const bf16* GluT = (const bf16*)(ws + WS_WSMALL + l * WSMALL_LAYER + WOFF_GLU);
        const float* modl = (const float*)(ws + WS_MOD) + (size_t)l * BATCH * 6 * D;
        if (l == 0 && IN(pb + 0)) { p_wconv(F, args, 0, 4); p_wconv(F, args, 1, 4); p_ln_a0(F, args); SEAM(pb + 0); }
        if (IN(pb + 1)) for (int rep_ = 0; rep_ < NREP(1); ++rep_) {
            pg8::Gemm g{(const bf16*)(ws + WS_XN), WinT, M, PROJW, D / 2}; pg8::StaticOrder S; S.init(M, PROJW, F.G, (int)blockIdx.x);
            EpiInProj E{(bf16*)(ws + WS_PROJ), (const float*)(ws + WS_ROPE), args.pad, (const float*)(ws + WS_SA), (const float*)(ws + WS_CINV_IN) + l * PROJW};
            pg8::gemm_phase<EpiInProj, pg8::StaticOrder, PG8_ALIGN, PG8_SP2, true>(F.lds + RING_OFF, g, S, E);
            if (F.G == 256 && blockIdx.x >= 128) { __syncthreads(); p_wconv_gu(F, args, l, 256 + (int)blockIdx.x - 128, 128, WC_NGU); }
            SEAM(pb + 1); }
        if (IN(pb + 2)) for (int rep_ = 0; rep_ < NREP(2); ++rep_) {
#ifndef REP_SUB
#define REP_SUB -1
#endif
#define SUBREP(k) for (int rs_ = 0; rs_ < ((REP_SUB == (k)) ? 2 : 1); ++rs_)
            SUBREP(0) { mix_gating_mfma(F, args, l); __syncthreads(); }
#if REP_SUB >= 10 && REP_SUB < 20
            mix_gating_mfma(F, args, l, REP_SUB - 10); __syncthreads(); mix_gating_mfma(F, args, l); __syncthreads();
#endif
 SUBREP(1) { mix_ssm_in(F, l); } SUBREP(2) { mix_attn_mfma<0>(F, l); __syncthreads(); } SEAM(pb + 2); }
        if (IN(pb + 3)) for (int rep_ = 0; rep_ < NREP(3); ++rep_) { SUBREP(3) { mix_ssm_out(F, args, l); __syncthreads(); } SUBREP(4) { mix_attn_mfma<1>(F, l); __syncthreads(); } SEAM(pb + 3); }
        if (IN(pb + 4)) for (int rep_ = 0; rep_ < NREP(4); ++rep_) { p_glu(F, args, l); SEAM(pb + 4); }
        if (IN(pb + 5)) for (int rep_ = 0; rep_ < NREP(5); ++rep_) {
            pg8::Gemm g{(const bf16*)(ws + WS_MIXCAT), WoutT, M, D, D}; pg8::StaticOrder S; S.init(M, D, F.G, (int)blockIdx.x);
            if (l == 0) { EpiOut<true> E{(bf16*)(ws + WS_PRE), args.in[I_X], D, modl}; pg8::gemm_phase<EpiOut<true>, pg8::StaticOrder, PG8_ALIGN, PG8_SP2>(F.lds + RING_OFF, g, S, E); }
            else { EpiOut<false> E{(bf16*)(ws + WS_PRE), (const void*)(ws + WS_ROWS2), 2 * D, modl}; pg8::gemm_phase<EpiOut<false>, pg8::StaticOrder, PG8_ALIGN, PG8_SP2>(F.lds + RING_OFF, g, S, E); }
            SEAM(pb + 5); }
        if (IN(pb + 6)) { p_row_b(F, args, l); SUBREP(5) { if (REP_SUB == 5 && rs_ == 0) { __syncthreads(); p_row_b(F, args, l, false); } } SEAM(pb + 6); }
        if (IN(pb + 7)) { moe_tstart(F, l);
            gu32* dcnt = F.ctl + CW_DONE + l * 512;
            if (args.pad != 4)
            { pg8::Gemm g{(const bf16*)(ws + WS_XN), (const bf16*)(ws + WS_WGU), NSLOT_MAX, NEXP * 1024, D / 2};
              MoeOrderK<0> S{(const volatile LAS int*)(F.lds + LDSCTL_OFF), F.G, (int)blockIdx.x, (const int*)(ws + WS_SLOT_A), (const float*)(ws + WS_SLOT_W), dcnt, F.ctl + CW_QUEUE + l * 128, (volatile LAS int*)(F.lds + LDSCTL_OFF + 256)}; EpiG1 E{(bf16*)(ws + WS_HID), args.pad, (const float*)(ws + WS_CINV) + (size_t)l * 16 * 2 * 512};
              pg8::gemm_phase_g<EpiG1, MoeOrderK<0>, PG8_ALIGN, PG8_SP2, 0, true>(F.lds + RING_OFF, F.lds + GT_OFF, g, S, E); }
            if (args.pad != 3)
            { pg8::Gemm g{(const bf16*)(ws + WS_HID), (const bf16*)(ws + WS_WD), NSLOT_MAX, NEXP * 1024, DEXP};
              MoeOrderK<1> S{(const volatile LAS int*)(F.lds + LDSCTL_OFF), F.G, (int)blockIdx.x, (const int*)(ws + WS_SLOT_A), (const float*)(ws + WS_SLOT_W), dcnt, F.ctl + CW_QUEUE + l * 128, (volatile LAS int*)(F.lds + LDSCTL_OFF + 256)}; EpiG2 E{(bf16*)(ws + WS_ROWS2), args.pad};
              pg8::gemm_phase_g<EpiG2, MoeOrderK<1>, PG8_ALIGN, PG8_SP2, 0>(F.lds + RING_OFF, F.lds + GT_OFF, g, S, E); }
            SEAM(pb + 7); }
        if (IN(pb + 8)) { p_row_c(F, args, l); if (l == 0) { __syncthreads(); p_wconv_items(F, args, 1, WC_NS, WC_NW); __syncthreads(); p_wconv_gu(F, args, 1, F.vcu, F.G, F.G == 256 ? 256 : WC_NGU); } SUBREP(6) { if (REP_SUB == 6 && rs_ == 0 && l == DEPTH - 1) { __syncthreads(); p_row_c(F, args, l); } } SEAM(pb + 8); }
    }
__global__ void __launch_bounds__(NTHR, 2) mk_fwd(Args args) {
    extern __shared__ __attribute__((aligned(16))) unsigned char lds[];
    Frame F;
    F.lds = (LAS unsigned char*)lds; F.MISC = (volatile LAS unsigned*)(F.lds + MISC_OFF);
    F.G = gridDim.x; { const int bx = blockIdx.x; F.vcu = (F.G % 8 == 0) ? (bx % 8) * (F.G / 8) + bx / 8 : bx; }
    F.ws = args.ws; F.ctl = (gu32*)(args.ws + WS_CTL);
    for (int u = ftid(); u < (LDS_BYTES - LDSCTL_OFF) / 4; u += NTHR) ((LAS unsigned*)(F.lds + LDSCTL_OFF))[u] = 0u;
    __syncthreads();
    XcdBarrier bar; bar.bar = (unsigned*)(F.ctl + CW_BAR); bar.x = 0; bar.st = nullptr;
    if (MK_ONE_LAUNCH) bar = xcd_barrier_post((unsigned*)(F.ctl + CW_BAR), F.MISC + 8);
    const int lo = args.ph_lo, hi = args.ph_hi;
    unsigned char* ws = args.ws; (void)ws;
    if (IN(0)) { p0_tables(F, args); __syncthreads(); p_wconv_items(F, args, 0, 0, WC_NW); p_wconv_items(F, args, 1, 0, WC_NS); __syncthreads(); p_wconv_gu(F, args, 0, F.vcu, F.G, F.G == 256 ? 256 : WC_NGU);
        p_wconv_in(F, args, 0, (F.vcu + F.G - 112) % F.G, F.G); p_wconv_in(F, args, 1, (F.vcu + F.G - 184) % F.G, F.G); SEAM(0); }
    layer_body<0>(F, args, bar, lo, hi);
    layer_body<1>(F, args, bar, lo, hi);
#ifdef EXTRA_BARS
    if (MK_ONE_LAUNCH) for (int xb_ = 0; xb_ < EXTRA_BARS; ++xb_) xcd_barrier(bar);
#endif
#undef IN
#undef SEAM
}

extern "C" void kernel_launch(void* const* d_in, const int* in_sizes, int n_in, void* d_out, int out_size, void* d_ws, size_t ws_size, hipStream_t stream) {
    static int grid = 0;
    if (grid == 0) {
        if (n_in != 30 || in_sizes[0] != M * D || out_size != M * D || ws_size < WS_END) { fprintf(stderr, "kernel_launch: unexpected shapes (n_in %d, in0 %d, out %d, ws %zu, need %zu)\n", n_in, n_in > 0 ? in_sizes[0] : -1, out_size, ws_size, (size_t)WS_END); grid = -1; return; }
        int dev = 0, cus = 0, per_cu = 0;
        if (hipGetDevice(&dev) != hipSuccess || hipDeviceGetAttribute(&cus, hipDeviceAttributeMultiprocessorCount, dev) != hipSuccess) { grid = -1; return; }
        if (hipFuncSetAttribute((const void*)mk_fwd, hipFuncAttributeMaxDynamicSharedMemorySize, LDS_BYTES) != hipSuccess) { fprintf(stderr, "kernel_launch: hipFuncSetAttribute failed\n"); grid = -1; return; }
        if (hipOccupancyMaxActiveBlocksPerMultiprocessor(&per_cu, (const void*)mk_fwd, NTHR, LDS_BYTES) != hipSuccess || per_cu < 1) fprintf(stderr, "kernel_launch: occupancy query says %d\n", per_cu);
        (void)hipGetLastError();
        grid = cus;
    }
    if (grid < 0) return;
    if (hipMemsetAsync((char*)d_ws + WS_CTL, 0, CTL_ZERO_BYTES, stream) != hipSuccess) return;
    Args a{};
    for (int i = 0; i < 30; ++i) a.in[i] = d_in[i];
    a.out = (float*)d_out; a.ws = (unsigned char*)d_ws;
#if MK_ONE_LAUNCH
    a.ph_lo = 0; a.ph_hi = N_PHASES; a.li = 0;
    hipLaunchKernelGGL(mk_fwd, dim3(grid), dim3(NTHR), LDS_BYTES, stream, a);
#else
#ifndef REP_GLOBAL
#define REP_GLOBAL -1
#endif
#ifndef PROBE_SKIP
#define PROBE_SKIP 1
#endif
#ifndef REP_COUNT
#define REP_COUNT 2
#endif
    for (int p = 0; p < N_PHASES; ++p) { a.ph_lo = p; a.ph_hi = p + 1; a.li = p;
        const int nrep = ((p == 0 ? 100 : (p - 1) % PH_PER_LAYER) == REP_GLOBAL) ? REP_COUNT : 1;
        for (int r = 0; r < nrep; ++r) { a.pad = r ? PROBE_SKIP : 0; hipLaunchKernelGGL(mk_fwd, dim3(grid), dim3(NTHR), LDS_BYTES, stream, a); } a.pad = 0; }
#endif
}
```

```cpp
#include <hip/hip_runtime.h>
#include <cstdio>
#include <cstdint>
namespace pg8 {
#define PG8_LAS __attribute__((address_space(3)))
typedef unsigned short bf16_t;
typedef short bf16x8 __attribute__((ext_vector_type(8)));
typedef float f32x4 __attribute__((ext_vector_type(4)));
typedef unsigned u32x4 __attribute__((ext_vector_type(4)));
constexpr int BM = 256, BK = 64, HALF = 128, HTB = HALF * BK * 2  , STAGE_BYTES = 8 * HTB, NXCD = 8, WGM = 8;

__host__ __device__ __forceinline__ int lds_byte(int r, int c) { const int st = (r >> 4) * 2 + (c >> 5), rr = r & 15, cc = c & 31, ob = rr * 64 + cc * 2; return st * 1024 + (ob ^ (((ob >> 9) & 1) << 5)); }
__host__ __device__ __forceinline__ void stage_rc(int b, int& R, int& C) { const int st = b / 1024, sb = b % 1024, swz = sb ^ (((sb >> 9) & 1) << 5); R = (st >> 1) * 16 + swz / 64; C = (st & 1) * 32 + (swz % 64) / 2; }
__host__ __device__ __forceinline__ int perm32(int rho) { const int n = rho >> 4, i = rho & 15; return 8 * (i >> 2) + 4 * n + (i & 3); }

__device__ __forceinline__ int opaque_tid() { int t = threadIdx.x; asm volatile("" : "+v"(t)); return t; }
struct Unit { int pm, pn; };
struct Gemm { const bf16_t* A; const bf16_t* Bt; int M, N, K; };

struct StaticOrder {
    int nM, nN, nwg, G, c;
    __host__ __device__ void init(int M, int N, int G_, int c_) { nM = M / BM; nN = N / BM; nwg = nM * nN; G = G_; c = c_; }
    __host__ __device__ bool next(int i, Unit& u) const {
        const long L = (long)i * G + c; if (L >= nwg) return false;
        int wgid = (int)L; { const int q = nwg / NXCD, r = nwg % NXCD, xcd = wgid % NXCD, off = wgid / NXCD; wgid = (xcd < r ? xcd * (q + 1) : r * (q + 1) + (xcd - r) * q) + off; }
        const int nig = WGM * nN, gid = wgid / nig, fm = gid * WGM, gsz = (nM - fm) < WGM ? (nM - fm) : WGM;
        u.pm = fm + ((wgid % nig) % gsz); u.pn = (wgid % nig) / gsz; return true;
    }
    __device__ __forceinline__ void a_ready(const Unit&) const {}
    __device__ __forceinline__ void done(const Unit&) const {}
};

__device__ __forceinline__ unsigned cvt_pk_bf16(float lo, float hi) { unsigned r; asm volatile("v_cvt_pk_bf16_f32 %0, %1, %2" : "=v"(r) : "v"(lo), "v"(hi)); return r; }
template <class Epi, class Sched, bool ALIGN_EPI = false, bool SP2 = false, bool FP8 = false>
__device__ __forceinline__ void gemm_phase(PG8_LAS unsigned char* lds, const Gemm g, const Sched& S, const Epi& E) {
    const int tid = threadIdx.x, wid = __builtin_amdgcn_readfirstlane(tid >> 6), lane = tid & 63, wr = wid >> 2, wc = wid & 3, fr = lane & 15, fq = lane >> 4;
    const int K = g.K, nt = K / BK;
    unsigned voffA[2], voffB[2];
#pragma unroll
    for (int i = 0; i < 2; ++i) { int R, C; stage_rc(tid * 16 + i * 8192, R, C); const int Rb = Epi::PERM ? ((R & ~31) + perm32(R & 31)) : R;
        voffA[i] = (unsigned)(R * K + C) * 2u; voffB[i] = (unsigned)(Rb * K + C) * 2u; }
    const size_t kstep = (size_t)(BK * 2);
    const size_t hstep = (size_t)HALF * K * 2;
    const size_t tstep = 2 * hstep;
    const unsigned ldsw = (unsigned)wid * 1024u;
    const int aoff = lds_byte(wr * 64 + fr, fq * 8), boff = lds_byte(wc * 32 + fr, fq * 8);
#define PG8_SA(b, h) (((b) * 2 + (h)) * HTB)
#define PG8_SB(b, h) ((4 + (b) * 2 + (h)) * HTB)
#define PG8_STAGE(bufoff, gbase, voff) do { _Pragma("unroll") for (int _i = 0; _i < 2; ++_i) \
        __builtin_amdgcn_global_load_lds((const unsigned*)((const char*)(gbase) + (voff)[_i]), (PG8_LAS unsigned*)(lds + (bufoff) + ldsw + _i * 8192), 16, 0, 0); } while (0)
#define PG8_LDA(dst, b, h) do { if constexpr (FP8) { _Pragma("unroll") for (int m = 0; m < 4; ++m) { const PG8_LAS unsigned char* p_ = lds + PG8_SA(b, h) + aoff + m * 2048; \
            const i32x4_t lo_ = *(const PG8_LAS i32x4_t*)p_, hi_ = *(const PG8_LAS i32x4_t*)(p_ + 1024); dst##q[m] = __builtin_shufflevector(lo_, hi_, 0, 1, 2, 3, 4, 5, 6, 7); } } \
        else { _Pragma("unroll") for (int m = 0; m < 4; ++m) _Pragma("unroll") for (int k = 0; k < 2; ++k) dst[m][k] = *(const PG8_LAS bf16x8*)(lds + PG8_SA(b, h) + aoff + m * 2048 + k * 1024); } } while (0)
#define PG8_LDB(dst, b, h) do { if constexpr (FP8) { _Pragma("unroll") for (int n = 0; n < 2; ++n) { const PG8_LAS unsigned char* p_ = lds + PG8_SB(b, h) + boff + n * 2048; \
            const i32x4_t lo_ = *(const PG8_LAS i32x4_t*)p_, hi_ = *(const PG8_LAS i32x4_t*)(p_ + 1024); dst##q[n] = __builtin_shufflevector(lo_, hi_, 0, 1, 2, 3, 4, 5, 6, 7); } } \
        else { _Pragma("unroll") for (int n = 0; n < 2; ++n) _Pragma("unroll") for (int k = 0; k < 2; ++k) dst[n][k] = *(const PG8_LAS bf16x8*)(lds + PG8_SB(b, h) + boff + n * 2048 + k * 1024); } } while (0)
#define PG8_MMA(ai, bj, At, Bt) do { __builtin_amdgcn_s_setprio(1); \
        if constexpr (FP8) { _Pragma("unroll") for (int m = 0; m < 4; ++m) _Pragma("unroll") for (int n = 0; n < 2; ++n) { const int o_ = 8 * m + 4 * n; \
                f32x4 c_ = {accq[ai][bj][o_], accq[ai][bj][o_ + 1], accq[ai][bj][o_ + 2], accq[ai][bj][o_ + 3]}; \
                c_ = __builtin_amdgcn_mfma_scale_f32_16x16x128_f8f6f4(Bt##q[n], At##q[m], c_, 0, 0, 0, 0x7f7f7f7f, 0, 0x7f7f7f7f); \
                accq[ai][bj][o_] = c_[0]; accq[ai][bj][o_ + 1] = c_[1]; accq[ai][bj][o_ + 2] = c_[2]; accq[ai][bj][o_ + 3] = c_[3]; } } \
        else { _Pragma("unroll") for (int m = 0; m < 4; ++m) _Pragma("unroll") for (int n = 0; n < 2; ++n) _Pragma("unroll") for (int k = 0; k < 2; ++k) \
            acc[ai][bj][m][n] = __builtin_amdgcn_mfma_f32_16x16x32_bf16(Bt[n][k], At[m][k], acc[ai][bj][m][n], 0, 0, 0); } \
        __builtin_amdgcn_s_setprio(0); } while (0)
#define PG8_WAIT_V(n) asm volatile("s_waitcnt vmcnt(" #n ")" ::: "memory")
#define PG8_WAIT_L(n) asm volatile("s_waitcnt lgkmcnt(" #n ")" ::: "memory")
#define PG8_BAR __builtin_amdgcn_s_barrier()
#define PG8_SCHED __builtin_amdgcn_sched_barrier(0)
    Unit cur, nxt; int ui = 0;
    if (!S.next(0, cur)) return;
    f32x4 acc[2][2][4][2];
    typedef float f32x32_t __attribute__((ext_vector_type(32)));
    f32x32_t accq[2][2];
    if constexpr (FP8) { accq[0][0] = (f32x32_t)(0.f); accq[0][1] = (f32x32_t)(0.f); accq[1][0] = (f32x32_t)(0.f); accq[1][1] = (f32x32_t)(0.f); } (void)accq;
#pragma unroll
    for (int a = 0; a < 2; ++a)
#pragma unroll
        for (int b = 0; b < 2; ++b)
#pragma unroll
            for (int m = 0; m < 4; ++m)
#pragma unroll
                for (int n = 0; n < 2; ++n) acc[a][b][m][n] = (f32x4){0.f, 0.f, 0.f, 0.f};
    typedef int v8i_t __attribute__((ext_vector_type(8))); typedef int i32x4_t __attribute__((ext_vector_type(4)));
    bf16x8 At[4][2], B0[2][2], B1[2][2]; v8i_t Atq[4], B0q[2], B1q[2];
    (void)At; (void)B0; (void)B1; (void)Atq; (void)B0q; (void)B1q;
    const char* cA = (const char*)g.A + (size_t)cur.pm * tstep; const char* cB = (const char*)g.Bt + (size_t)cur.pn * tstep;
    S.a_ready(cur);
    if constexpr (SP2) {
        PG8_STAGE(PG8_SB(0, 0), cB, voffB); PG8_STAGE(PG8_SB(0, 1), cB + hstep, voffB); PG8_STAGE(PG8_SA(0, 0), cA, voffA); PG8_STAGE(PG8_SA(0, 1), cA + hstep, voffA);
        if (wr == 1) PG8_BAR;
        PG8_WAIT_V(2); PG8_BAR;
        PG8_STAGE(PG8_SB(1, 0), cB + kstep, voffB); PG8_STAGE(PG8_SA(1, 0), cA + kstep, voffA); PG8_STAGE(PG8_SB(1, 1), cB + hstep + kstep, voffB);
        PG8_WAIT_V(6); PG8_BAR;
    } else {
        PG8_STAGE(PG8_SB(0, 0), cB, voffB); PG8_STAGE(PG8_SA(0, 0), cA, voffA); PG8_STAGE(PG8_SB(0, 1), cB + hstep, voffB); PG8_STAGE(PG8_SA(0, 1), cA + hstep, voffA);
        if (wr == 1) PG8_BAR;
        PG8_WAIT_V(4); PG8_BAR;
        PG8_STAGE(PG8_SB(1, 0), cB + kstep, voffB); PG8_STAGE(PG8_SA(1, 0), cA + kstep, voffA); PG8_STAGE(PG8_SB(1, 1), cB + hstep + kstep, voffB);
        PG8_WAIT_V(6); PG8_BAR;
    }
    for (;;) {
        const bool has_next = S.next(ui + 1, nxt);
        const char* nA = has_next ? (const char*)g.A + (size_t)nxt.pm * tstep : cA; const char* nB = has_next ? (const char*)g.Bt + (size_t)nxt.pn * tstep : cB;
#pragma unroll 1
        for (int t = 0; t < nt; t += 2) {
            const bool last = (t == nt - 2);
            const char* a1 = cA + (size_t)(t + 1) * kstep;
            const char* a2 = last ? nA : cA + (size_t)(t + 2) * kstep; const char* b2 = last ? nB : cB + (size_t)(t + 2) * kstep;
            const char* a3 = a2 + kstep; const char* b3 = b2 + kstep;
            if (last && has_next) S.a_ready(nxt);
            if constexpr (SP2) {
            PG8_LDB(B0, 0, 0); PG8_LDB(B1, 0, 1); PG8_SCHED; PG8_LDA(At, 0, 0); PG8_STAGE(PG8_SA(1, 1), a1 + hstep, voffA);
            PG8_WAIT_V(8); PG8_WAIT_L(0); PG8_BAR; PG8_MMA(0, 0, At, B0); PG8_MMA(0, 1, At, B1); PG8_BAR; PG8_SCHED;
            PG8_LDA(At, 0, 1); PG8_STAGE(PG8_SB(0, 0), b2, voffB); PG8_STAGE(PG8_SB(0, 1), b2 + hstep, voffB); PG8_STAGE(PG8_SA(0, 0), a2, voffA);
            PG8_WAIT_V(8); PG8_WAIT_L(0); PG8_BAR; PG8_MMA(1, 0, At, B0); PG8_MMA(1, 1, At, B1); PG8_BAR; PG8_SCHED;
            PG8_LDB(B0, 1, 0); PG8_LDB(B1, 1, 1); PG8_SCHED; PG8_LDA(At, 1, 0); PG8_STAGE(PG8_SA(0, 1), a2 + hstep, voffA);
            PG8_WAIT_V(8); PG8_WAIT_L(0); PG8_BAR; PG8_MMA(0, 0, At, B0); PG8_MMA(0, 1, At, B1); PG8_BAR; PG8_SCHED;
            PG8_LDA(At, 1, 1); PG8_STAGE(PG8_SB(1, 0), b3, voffB); PG8_STAGE(PG8_SB(1, 1), b3 + hstep, voffB); PG8_STAGE(PG8_SA(1, 0), a3, voffA);
            PG8_WAIT_V(8); PG8_WAIT_L(0); PG8_BAR; PG8_MMA(1, 0, At, B0); PG8_MMA(1, 1, At, B1); PG8_BAR; PG8_SCHED;
            } else {
            PG8_LDB(B0, 0, 0); PG8_SCHED; PG8_LDA(At, 0, 0); PG8_STAGE(PG8_SA(1, 1), a1 + hstep, voffA);
            PG8_WAIT_L(8); PG8_BAR; PG8_WAIT_L(0); PG8_MMA(0, 0, At, B0); PG8_BAR; PG8_SCHED;
            PG8_LDB(B1, 0, 1); PG8_STAGE(PG8_SB(0, 0), b2, voffB);
            PG8_BAR; PG8_WAIT_L(0); PG8_MMA(0, 1, At, B1); PG8_BAR;
            PG8_LDA(At, 0, 1); PG8_STAGE(PG8_SA(0, 0), a2, voffA);
            PG8_BAR; PG8_WAIT_L(0); PG8_MMA(1, 0, At, B0); PG8_BAR; PG8_SCHED;
            PG8_STAGE(PG8_SB(0, 1), b2 + hstep, voffB);
            PG8_WAIT_V(6); PG8_BAR; PG8_MMA(1, 1, At, B1); PG8_BAR;
            PG8_LDB(B0, 1, 0); PG8_SCHED; PG8_LDA(At, 1, 0); PG8_STAGE(PG8_SA(0, 1), a2 + hstep, voffA);
            PG8_WAIT_L(8); PG8_BAR; PG8_WAIT_L(0); PG8_MMA(0, 0, At, B0); PG8_BAR; PG8_SCHED;
            PG8_LDB(B1, 1, 1); PG8_STAGE(PG8_SB(1, 0), b3, voffB);
            PG8_BAR; PG8_WAIT_L(0); PG8_MMA(0, 1, At, B1); PG8_BAR;
            PG8_LDA(At, 1, 1); PG8_STAGE(PG8_SA(1, 0), a3, voffA);
            PG8_BAR; PG8_WAIT_L(0); PG8_MMA(1, 0, At, B0); PG8_BAR; PG8_SCHED;
            PG8_STAGE(PG8_SB(1, 1), b3 + hstep, voffB);
            PG8_WAIT_V(6); PG8_BAR; PG8_MMA(1, 1, At, B1); PG8_BAR;
            }
        }
        if constexpr (ALIGN_EPI) { if (wr == 0) PG8_BAR; }
        if constexpr (FP8) {
#pragma unroll
            for (int a = 0; a < 2; ++a)
#pragma unroll
                for (int b = 0; b < 2; ++b)
#pragma unroll
                    for (int m = 0; m < 4; ++m)
#pragma unroll
                        for (int n = 0; n < 2; ++n) { const int o_ = 8 * m + 4 * n; acc[a][b][m][n] = (f32x4){accq[a][b][o_], accq[a][b][o_ + 1], accq[a][b][o_ + 2], accq[a][b][o_ + 3]}; }
        }
        if constexpr (!Epi::AFTER_DRAIN) { E(acc, cur, wr, wc, fr, fq); S.done(cur); }
        if (!has_next) break;
#pragma unroll
        for (int a = 0; a < 2; ++a)
#pragma unroll
            for (int b = 0; b < 2; ++b)
#pragma unroll
                for (int m = 0; m < 4; ++m)
#pragma unroll
                    for (int n = 0; n < 2; ++n) acc[a][b][m][n] = (f32x4){0.f, 0.f, 0.f, 0.f};
        if constexpr (FP8) { accq[0][0] = (f32x32_t)(0.f); accq[0][1] = (f32x32_t)(0.f); accq[1][0] = (f32x32_t)(0.f); accq[1][1] = (f32x32_t)(0.f); }
        cur = nxt; cA = nA; cB = nB; ++ui;
        if constexpr (ALIGN_EPI) { if (wr == 1) PG8_BAR; }
    }
    PG8_WAIT_V(0);
    if constexpr (!ALIGN_EPI) { if (wr == 0) PG8_BAR; }
    PG8_BAR;
    if constexpr (Epi::AFTER_DRAIN) { E.fused(acc, cur, wr, wc, fr, fq, lds, wid, lane); S.done(cur); }
#undef PG8_SA
#undef PG8_SB
#undef PG8_STAGE
#undef PG8_LDA
#undef PG8_LDB
#undef PG8_MMA
#undef PG8_WAIT_V
#undef PG8_WAIT_L
#undef PG8_BAR
#undef PG8_SCHED
}
template <class Epi, class Sched, bool ALIGN_EPI = false, bool SP2 = false, int AUXA = 0, bool FP8 = false, bool ASC = false>
__device__ __forceinline__ void gemm_phase_g(PG8_LAS unsigned char* lds, PG8_LAS unsigned char* gt, const Gemm g, const Sched& S, const Epi& E) {
    const int tid = threadIdx.x, wid = __builtin_amdgcn_readfirstlane(tid >> 6), lane = tid & 63, wr = wid >> 2, wc = wid & 3, fr = lane & 15, fq = lane >> 4;
    const int K = g.K, nt = K / BK;
    unsigned gpk0, voffB[2];
#pragma unroll
    for (int i = 0; i < 2; ++i) { int R, C; stage_rc(tid * 16 + i * 8192, R, C); const int Rb = Epi::PERM ? ((R & ~31) + perm32(R & 31)) : R;
        if (i == 0) gpk0 = (unsigned)(R * 4) | ((unsigned)(C * 2) << 16); voffB[i] = (unsigned)(Rb * K + C) * 2u; }
    int par = 0;
    const size_t kstep = (size_t)(BK * 2);
    const size_t hstep = (size_t)HALF * K * 2;
    const size_t tstep = 2 * hstep;
    const unsigned ldsw = (unsigned)wid * 1024u;
    const int aoff = lds_byte(wr * 64 + fr, fq * 8), boff = lds_byte(wc * 32 + fr, fq * 8);
#define PG8_SA(b, h) (((b) * 2 + (h)) * HTB)
#define PG8_SB(b, h) ((4 + (b) * 2 + (h)) * HTB)
#define PG8_STAGE(bufoff, gbase, voff) do { _Pragma("unroll") for (int _i = 0; _i < 2; ++_i) \
        __builtin_amdgcn_global_load_lds((const unsigned*)((const char*)(gbase) + (voff)[_i]), (PG8_LAS unsigned*)(lds + (bufoff) + ldsw + _i * 8192), 16, 0, 0); } while (0)
#define PG8_STAGE_A(bufoff, h, kbyte, PAR) do { _Pragma("unroll") for (int _i = 0; _i < 2; ++_i) { \
        const unsigned _vo = *(const PG8_LAS unsigned*)(gt + ((PAR) * 768 + (h) * 128 + _i * 64) * 4 + (gpk0 & 0xffffu)) + (gpk0 >> 16); \
        __builtin_amdgcn_global_load_lds((const unsigned*)((const char*)g.A + (size_t)(kbyte) + _vo), (PG8_LAS unsigned*)(lds + (bufoff) + ldsw + _i * 8192), 16, 0, AUXA); } } while (0)
#define PG8_FILL(u, PAR, PF, UI) do { S.wait_ready(u, tid, PF); if (tid < 256) { unsigned o_, a0_, a1_; S.finish_meta(u, tid, PF, o_, a0_, a1_); PG8_LAS unsigned* t_ = (PG8_LAS unsigned*)(gt + ((PAR) * 768 + tid) * 4); t_[0] = o_; t_[256] = a0_; t_[512] = a1_; } S.pull_publish(tid, PF, UI); asm volatile("s_waitcnt lgkmcnt(0)" ::: "memory"); __builtin_amdgcn_s_barrier(); asm volatile("" ::: "memory"); \
        if constexpr (ASC) { if (wid < 4) __builtin_amdgcn_global_load_lds((const unsigned*)(S.scale_base(u) + wid * 1024 + (opaque_tid() & 63) * 16), (PG8_LAS unsigned*)(gt + 6144 + (PAR) * 4096 + wid * 1024), 16, 0, 0); } } while (0)
#define PG8_LDA(dst, b, h) do { if constexpr (FP8) { _Pragma("unroll") for (int m = 0; m < 4; ++m) { const PG8_LAS unsigned char* p_ = lds + PG8_SA(b, h) + aoff + m * 2048; \
            const i32x4_t lo_ = *(const PG8_LAS i32x4_t*)p_, hi_ = *(const PG8_LAS i32x4_t*)(p_ + 1024); dst##q[m] = __builtin_shufflevector(lo_, hi_, 0, 1, 2, 3, 4, 5, 6, 7); } } \
        else { _Pragma("unroll") for (int m = 0; m < 4; ++m) _Pragma("unroll") for (int k = 0; k < 2; ++k) dst[m][k] = *(const PG8_LAS bf16x8*)(lds + PG8_SA(b, h) + aoff + m * 2048 + k * 1024); } } while (0)
#define PG8_LDB(dst, b, h) do { if constexpr (FP8) { _Pragma("unroll") for (int n = 0; n < 2; ++n) { const PG8_LAS unsigned char* p_ = lds + PG8_SB(b, h) + boff + n * 2048; \
            const i32x4_t lo_ = *(const PG8_LAS i32x4_t*)p_, hi_ = *(const PG8_LAS i32x4_t*)(p_ + 1024); dst##q[n] = __builtin_shufflevector(lo_, hi_, 0, 1, 2, 3, 4, 5, 6, 7); } } \
        else { _Pragma("unroll") for (int n = 0; n < 2; ++n) _Pragma("unroll") for (int k = 0; k < 2; ++k) dst[n][k] = *(const PG8_LAS bf16x8*)(lds + PG8_SB(b, h) + boff + n * 2048 + k * 1024); } } while (0)
#define PG8_MMA(ai, bj, At, Bt, KT) do { __builtin_amdgcn_s_setprio(1); \
        if constexpr (FP8) { _Pragma("unroll") for (int m = 0; m < 4; ++m) _Pragma("unroll") for (int n = 0; n < 2; ++n) { const int o_ = 8 * m + 4 * n; \
                f32x4 c_ = {accq[ai][bj][o_], accq[ai][bj][o_ + 1], accq[ai][bj][o_ + 2], accq[ai][bj][o_ + 3]}; \
                if constexpr (ASC) c_ = __builtin_amdgcn_mfma_scale_f32_16x16x128_f8f6f4(Bt##q[n], At##q[m], c_, 0, 0, 0, 0x7f7f7f7f, KT, (int)sca[ai][m]); \
                else c_ = __builtin_amdgcn_mfma_scale_f32_16x16x128_f8f6f4(Bt##q[n], At##q[m], c_, 0, 0, 0, 0x7f7f7f7f, 0, 0x7f7f7f7f); \
                accq[ai][bj][o_] = c_[0]; accq[ai][bj][o_ + 1] = c_[1]; accq[ai][bj][o_ + 2] = c_[2]; accq[ai][bj][o_ + 3] = c_[3]; } } \
        else { _Pragma("unroll") for (int m = 0; m < 4; ++m) _Pragma("unroll") for (int n = 0; n < 2; ++n) _Pragma("unroll") for (int k = 0; k < 2; ++k) \
            acc[ai][bj][m][n] = __builtin_amdgcn_mfma_f32_16x16x32_bf16(Bt[n][k], At[m][k], acc[ai][bj][m][n], 0, 0, 0); } \
        __builtin_amdgcn_s_setprio(0); } while (0)
#define PG8_WAIT_V(n) asm volatile("s_waitcnt vmcnt(" #n ")" ::: "memory")
#define PG8_WAIT_L(n) asm volatile("s_waitcnt lgkmcnt(" #n ")" ::: "memory")
#define PG8_BAR __builtin_amdgcn_s_barrier()
#define PG8_SCHED __builtin_amdgcn_sched_barrier(0)
    Unit cur, nxt; int ui = 0;
    if (!__builtin_amdgcn_readfirstlane((int)S.first(cur))) return;
    cur.pm = __builtin_amdgcn_readfirstlane(cur.pm); cur.pn = __builtin_amdgcn_readfirstlane(cur.pn);
    f32x4 acc[2][2][4][2];
    typedef float f32x32_t __attribute__((ext_vector_type(32)));
    f32x32_t accq[2][2];
    if constexpr (FP8) { accq[0][0] = (f32x32_t)(0.f); accq[0][1] = (f32x32_t)(0.f); accq[1][0] = (f32x32_t)(0.f); accq[1][1] = (f32x32_t)(0.f); } (void)accq;
#pragma unroll
    for (int a = 0; a < 2; ++a)
#pragma unroll
        for (int b = 0; b < 2; ++b)
#pragma unroll
            for (int m = 0; m < 4; ++m)
#pragma unroll
                for (int n = 0; n < 2; ++n) acc[a][b][m][n] = (f32x4){0.f, 0.f, 0.f, 0.f};
    typedef int v8i_t __attribute__((ext_vector_type(8))); typedef int i32x4_t __attribute__((ext_vector_type(4)));
    bf16x8 At[4][2], B0[2][2], B1[2][2]; v8i_t Atq[4], B0q[2], B1q[2];
    (void)At; (void)B0; (void)B1; (void)Atq; (void)B0q; (void)B1q;
    unsigned sca[2][4]; (void)sca;
#define PG8_LDSC(PAR) do { if constexpr (ASC) { _Pragma("unroll") for (int a_ = 0; a_ < 2; ++a_) _Pragma("unroll") for (int m_ = 0; m_ < 4; ++m_) { \
        const PG8_LAS unsigned* sp_ = (const PG8_LAS unsigned*)(gt + 6144 + (PAR) * 4096 + (wr * 64 + a_ * HALF + m_ * 16 + fr) * 4); const unsigned sh_ = (unsigned)fq * 8u; \
        sca[a_][m_] = ((sp_[0] >> sh_) & 0xffu) | (((sp_[256] >> sh_) & 0xffu) << 8) | (((sp_[512] >> sh_) & 0xffu) << 16) | ((sp_[768] >> sh_) << 24); } } } while (0)
    const char* cB = (const char*)g.Bt + (size_t)cur.pn * tstep;
    typename Sched::Pf pf; S.prefetch(cur, tid, pf); PG8_FILL(cur, 0, pf, -1);
    Unit pend; bool has_pend = false;
    if constexpr (SP2) {
        PG8_STAGE(PG8_SB(0, 0), cB, voffB); PG8_STAGE(PG8_SB(0, 1), cB + hstep, voffB); PG8_STAGE_A(PG8_SA(0, 0), 0, 0, par); PG8_STAGE_A(PG8_SA(0, 1), 1, 0, par);
        if (wr == 1) PG8_BAR;
        PG8_WAIT_V(2); PG8_BAR;
        PG8_STAGE(PG8_SB(1, 0), cB + kstep, voffB); PG8_STAGE_A(PG8_SA(1, 0), 0, kstep, par); PG8_STAGE(PG8_SB(1, 1), cB + hstep + kstep, voffB);
        PG8_WAIT_V(6); PG8_BAR;
    } else {
        PG8_STAGE(PG8_SB(0, 0), cB, voffB); PG8_STAGE_A(PG8_SA(0, 0), 0, 0, par); PG8_STAGE(PG8_SB(0, 1), cB + hstep, voffB); PG8_STAGE_A(PG8_SA(0, 1), 1, 0, par);
        if (wr == 1) PG8_BAR;
        PG8_WAIT_V(4); PG8_BAR;
        PG8_STAGE(PG8_SB(1, 0), cB + kstep, voffB); PG8_STAGE_A(PG8_SA(1, 0), 0, kstep, par); PG8_STAGE(PG8_SB(1, 1), cB + hstep + kstep, voffB);
        PG8_WAIT_V(6); PG8_BAR;
    }
    PG8_LDSC(0);
    for (;;) {
        const bool has_next = __builtin_amdgcn_readfirstlane((int)S.more(ui + 1, nxt)) != 0;
        nxt.pm = __builtin_amdgcn_readfirstlane(nxt.pm); nxt.pn = __builtin_amdgcn_readfirstlane(nxt.pn);
        if (has_next) { S.prefetch(nxt, tid, pf); S.pull_issue(tid, pf); }
        const char* nB = has_next ? (const char*)g.Bt + (size_t)nxt.pn * tstep : cB;
#pragma unroll 1
        for (int t = 0; t < nt; t += 2) {
            const bool last = (t == nt - 2);
            const char* b2 = last ? nB : cB + (size_t)(t + 2) * kstep;
            const char* b3 = b2 + kstep;
            if (last && has_next) PG8_FILL(nxt, par ^ 1, pf, ui);
            const size_t kA2 = last ? (size_t)0 : (size_t)(t + 2) * kstep; const int pA2 = (last && has_next) ? (par ^ 1) : par;
            if constexpr (SP2) {
            PG8_LDB(B0, 0, 0); PG8_LDB(B1, 0, 1); PG8_SCHED; PG8_LDA(At, 0, 0); PG8_STAGE_A(PG8_SA(1, 1), 1, (size_t)(t + 1) * kstep, par);
            PG8_WAIT_V(8); PG8_WAIT_L(0); PG8_BAR; PG8_MMA(0, 0, At, B0, 0); PG8_MMA(0, 1, At, B1, 0); PG8_BAR; PG8_SCHED;
            PG8_LDA(At, 0, 1); PG8_STAGE(PG8_SB(0, 0), b2, voffB); PG8_STAGE(PG8_SB(0, 1), b2 + hstep, voffB); PG8_STAGE_A(PG8_SA(0, 0), 0, kA2, pA2);
            PG8_WAIT_V(8); PG8_WAIT_L(0); PG8_BAR; PG8_MMA(1, 0, At, B0, 0); PG8_MMA(1, 1, At, B1, 0); PG8_BAR; PG8_SCHED;
            PG8_LDB(B0, 1, 0); PG8_LDB(B1, 1, 1); PG8_SCHED; PG8_LDA(At, 1, 0); PG8_STAGE_A(PG8_SA(0, 1), 1, kA2, pA2);
            PG8_WAIT_V(8); PG8_WAIT_L(0); PG8_BAR; PG8_MMA(0, 0, At, B0, 1); PG8_MMA(0, 1, At, B1, 1); PG8_BAR; PG8_SCHED;
            PG8_LDA(At, 1, 1); PG8_STAGE(PG8_SB(1, 0), b3, voffB); PG8_STAGE(PG8_SB(1, 1), b3 + hstep, voffB); PG8_STAGE_A(PG8_SA(1, 0), 0, kA2 + kstep, pA2);
            PG8_WAIT_V(8); PG8_WAIT_L(0); PG8_BAR; PG8_MMA(1, 0, At, B0, 1); PG8_MMA(1, 1, At, B1, 1); PG8_BAR; PG8_SCHED;
            } else {
            PG8_LDB(B0, 0, 0); PG8_SCHED; PG8_LDA(At, 0, 0); PG8_STAGE_A(PG8_SA(1, 1), 1, (size_t)(t + 1) * kstep, par);
            PG8_WAIT_L(8); PG8_BAR; PG8_WAIT_L(0); PG8_MMA(0, 0, At, B0, 0); PG8_BAR; PG8_SCHED;
            PG8_LDB(B1, 0, 1); PG8_STAGE(PG8_SB(0, 0), b2, voffB);
            PG8_BAR; PG8_WAIT_L(0); PG8_MMA(0, 1, At, B1, 0); PG8_BAR;
            PG8_LDA(At, 0, 1); PG8_STAGE_A(PG8_SA(0, 0), 0, kA2, pA2);
            PG8_BAR; PG8_WAIT_L(0); PG8_MMA(1, 0, At, B0, 0); PG8_BAR; PG8_SCHED;
            PG8_STAGE(PG8_SB(0, 1), b2 + hstep, voffB);
            PG8_WAIT_V(6); PG8_BAR; PG8_MMA(1, 1, At, B1, 0); PG8_BAR;
            PG8_LDB(B0, 1, 0); PG8_SCHED; PG8_LDA(At, 1, 0); PG8_STAGE_A(PG8_SA(0, 1), 1, kA2, pA2);
            PG8_WAIT_L(8); PG8_BAR; PG8_WAIT_L(0); PG8_MMA(0, 0, At, B0, 1); PG8_BAR; PG8_SCHED;
            PG8_LDB(B1, 1, 1); PG8_STAGE(PG8_SB(1, 0), b3, voffB);
            PG8_BAR; PG8_WAIT_L(0); PG8_MMA(0, 1, At, B1, 1); PG8_BAR;
            PG8_LDA(At, 1, 1); PG8_STAGE_A(PG8_SA(1, 0), 0, kA2 + kstep, pA2);
            PG8_BAR; PG8_WAIT_L(0); PG8_MMA(1, 0, At, B0, 1); PG8_BAR; PG8_SCHED;
            PG8_STAGE(PG8_SB(1, 1), b3 + hstep, voffB);
            PG8_WAIT_V(6); PG8_BAR; PG8_MMA(1, 1, At, B1, 1); PG8_BAR;
            }
            if constexpr (ASC) { _Pragma("unroll") for (int a_ = 0; a_ < 2; ++a_) _Pragma("unroll") for (int m_ = 0; m_ < 4; ++m_) sca[a_][m_] >>= 16; }
        }
        if constexpr (ALIGN_EPI) { if (wr == 0) PG8_BAR; }
        if constexpr (FP8) {
#pragma unroll
            for (int a = 0; a < 2; ++a)
#pragma unroll
                for (int b = 0; b < 2; ++b)
#pragma unroll
                    for (int m = 0; m < 4; ++m)
#pragma unroll
                        for (int n = 0; n < 2; ++n) { const int o_ = 8 * m + 4 * n; acc[a][b][m][n] = (f32x4){accq[a][b][o_], accq[a][b][o_ + 1], accq[a][b][o_ + 2], accq[a][b][o_ + 3]}; }
        }
        if constexpr (!Epi::AFTER_DRAIN) { if (has_pend) S.done_nowait(pend);     E(acc, cur, wr, wc, fr, fq, (const PG8_LAS unsigned*)(gt + par * 3072)); pend = cur; has_pend = true; }
        if (!has_next) break;
#pragma unroll
        for (int a = 0; a < 2; ++a)
#pragma unroll
            for (int b = 0; b < 2; ++b)
#pragma unroll
                for (int m = 0; m < 4; ++m)
#pragma unroll
                    for (int n = 0; n < 2; ++n) acc[a][b][m][n] = (f32x4){0.f, 0.f, 0.f, 0.f};
        if constexpr (FP8) { accq[0][0] = (f32x32_t)(0.f); accq[0][1] = (f32x32_t)(0.f); accq[1][0] = (f32x32_t)(0.f); accq[1][1] = (f32x32_t)(0.f); }
        cur = nxt; cB = nB; ++ui; par ^= 1; PG8_LDSC(par);
        if constexpr (ALIGN_EPI) { if (wr == 1) PG8_BAR; }
    }
    PG8_WAIT_V(0);
    if constexpr (!ALIGN_EPI) { if (wr == 0) PG8_BAR; }
    PG8_BAR;
    if (has_pend) S.done_nowait(pend);
#undef PG8_SA
#undef PG8_SB
#undef PG8_STAGE
#undef PG8_STAGE_A
#undef PG8_FILL
#undef PG8_LDSC
#undef PG8_LDA
#undef PG8_LDB
#undef PG8_MMA
#undef PG8_WAIT_V
#undef PG8_WAIT_L
#undef PG8_BAR
#undef PG8_SCHED
}
}

#ifndef PG8_SP2
#define PG8_SP2 true
#endif
#ifndef PG8_ALIGN
#define PG8_ALIGN true
#endif
#ifndef MK_ONE_LAUNCH
#define MK_ONE_LAUNCH 1
#endif

constexpr int NWAVES = 8, NTHR = 512;
constexpr int BATCH = 8, T = 4096, D = 1024, M = BATCH * T, DEPTH = 2;
constexpr int PROJW = 2304, AW = 256, BW = 512, CW = 256, NH = 8, HD = 64;
constexpr int COL_U = 0, COL_V = 256, COL_Q = 512, COL_K = 1024, COL_VA = 1536, COL_S = 2048;
constexpr int NEXP = 16, DEXP = 512, NGRP = 4;
constexpr int SSM_G = 16, SSM_N = 64, SSM_C = 16;
constexpr float LN_EPS = 1e-5f;
constexpr float ALPHA = 1.41421356237309515f;
constexpr float QSCALE = 0.125f * 1.4426950408889634f;
constexpr int NSLOT_MAX = 2 * M + NEXP * 256;

constexpr size_t MiB = 1u << 20;
constexpr size_t WS_CTL = 0, CTL_ZERO_BYTES = 1 * MiB;
constexpr size_t WS_MOD = 1 * MiB;
constexpr size_t WS_ROPE = WS_MOD + 512 * 1024;
constexpr size_t WS_SSM = WS_ROPE + 2 * MiB;
constexpr int SSM_TAB = 2 * 1024 + 2 * 16384;
constexpr int SLOT_CAP = 32768;
constexpr size_t WS_SLOT_A = 4 * MiB;
constexpr size_t WS_WSMALL = 6 * MiB;
constexpr size_t WSMALL_LAYER = 7 * MiB, WOFF_IN = 0, WOFF_OUT = (size_t)PROJW * D * 2, WOFF_GLU = WOFF_OUT + (size_t)D * D * 2;
constexpr size_t WS_WGU = 20 * MiB;
constexpr size_t WS_WD = 52 * MiB;
constexpr size_t WS_XN = 68 * MiB;
constexpr size_t WS_YG = 132 * MiB;
constexpr size_t WS_R = 148 * MiB;
constexpr size_t WS_PROJ = WS_R, WS_MIXCAT = WS_R + 144 * MiB, WS_PRE = WS_R, WS_HID = WS_R + 64 * MiB, WS_X1 = WS_R + 132 * MiB;
constexpr size_t WS_HSC = WS_HID + 36 * MiB;
constexpr size_t WS_ROWS2 = 356 * MiB;
constexpr size_t WS_STAT = 356 * MiB + (size_t)2 * M * D * 2;
constexpr size_t WS_SSM2 = WS_STAT + 4 * MiB;
constexpr size_t SSM2_LAYER = 3 * MiB, S2_APW = 0, S2_KT = 288 * 1024, S2_CT = S2_KT + 256 * 1024, S2_WIN = S2_CT + 64 * 1024, S2_GW = S2_WIN + 2 * MiB;
static_assert(S2_GW + 4 * 128 * 128 * 2 <= SSM2_LAYER, "ssm2 tables");
constexpr size_t WS_XLOC = WS_SSM2 + 2 * SSM2_LAYER;
constexpr size_t WS_XSUP = WS_XLOC + 8 * MiB;
constexpr size_t WS_SLOT_W = WS_XSUP + 512 * 1024;
constexpr size_t WS_CINV = WS_SLOT_W + 2 * MiB;
constexpr size_t WS_CINV_IN = WS_CINV + 128 * 1024;
constexpr size_t WS_CINV_D = WS_CINV + 256 * 1024;
constexpr size_t WS_SA = WS_CINV + 384 * 1024;
constexpr size_t WS_END = WS_SA + 128 * 1024;
static_assert(WOFF_GLU + 256 * 256 * 2 <= WSMALL_LAYER && WS_WSMALL + 2 * WSMALL_LAYER <= WS_WGU, "ws map");
static_assert(WS_SSM + 2 * SSM_TAB * 4 <= WS_SLOT_A && WS_HID + (size_t)NSLOT_MAX * DEXP * 2 <= WS_X1 && WS_X1 + (size_t)M * D * 2 <= WS_ROWS2, "ws map 2");
constexpr int CW_TMO = 0;
constexpr int CW_BAR = 4096;
constexpr int CW_CNT = 8192;
constexpr int CW_QUEUE = 11264;
constexpr int CW_DONE = 12288;

constexpr int RING_OFF = 0, RING_BYTES = 131072;
constexpr int ATT_STAGE_OFF = 98304;
constexpr int LDSCTL_OFF = 135168, MISC_OFF = LDSCTL_OFF + 320;
constexpr int GT_OFF = LDSCTL_OFF + 1024;
constexpr int LDS_BYTES = 150528;

#define GAS __attribute__((address_space(1)))
#define LAS __attribute__((address_space(3)))
#define DI __device__ __forceinline__
typedef unsigned short bf16;
typedef unsigned v4u __attribute__((ext_vector_type(4)));
typedef unsigned v2u __attribute__((ext_vector_type(2)));
typedef float f32x4 __attribute__((ext_vector_type(4)));
typedef short bf16x8 __attribute__((ext_vector_type(8)));
typedef GAS unsigned gu32;
#define RLX_AGENT __ATOMIC_RELAXED, __HIP_MEMORY_SCOPE_AGENT
#define LDS_WAIT() asm volatile("s_waitcnt lgkmcnt(0)" ::: "memory")
#define VM_WAIT() asm volatile("s_waitcnt vmcnt(0)" ::: "memory")
DI unsigned f2bf(float f) { unsigned u = __builtin_bit_cast(unsigned, f); return (u + 0x7fffu + ((u >> 16) & 1u)) >> 16; }
DI unsigned pk2(float lo, float hi) { return f2bf(lo) | (f2bf(hi) << 16); }
DI float bflo(unsigned w) { return __uint_as_float(w << 16); }
DI float bfhi(unsigned w) { return __uint_as_float(w & 0xffff0000u); }
DI float bf2f(bf16 h) { return __uint_as_float((unsigned)h << 16); }
template <int CTRL> DI float dpp_mov(float v) { return __builtin_bit_cast(float, __builtin_amdgcn_update_dpp(0, __builtin_bit_cast(int, v), CTRL, 0xf, 0xf, true)); }
DI float rdlane(float v, int l) { return __builtin_bit_cast(float, __builtin_amdgcn_readlane(__builtin_bit_cast(int, v), l)); }
DI float wave_sum(float v) {
    v += dpp_mov<0xB1>(v); v += dpp_mov<0x4E>(v); v += dpp_mov<0x141>(v); v += dpp_mov<0x140>(v);
    return (rdlane(v, 0) + rdlane(v, 16)) + (rdlane(v, 32) + rdlane(v, 48));
}
DI void st16_wt(void* p, v4u v) { asm volatile("global_store_dwordx4 %0, %1, off sc1\n\ts_nop 1" :: "v"(p), "v"(v) : "memory"); }
DI float wave_max(float v) {
    v = fmaxf(v, dpp_mov<0xB1>(v)); v = fmaxf(v, dpp_mov<0x4E>(v)); v = fmaxf(v, dpp_mov<0x141>(v)); v = fmaxf(v, dpp_mov<0x140>(v));
    return fmaxf(fmaxf(rdlane(v, 0), rdlane(v, 16)), fmaxf(rdlane(v, 32), rdlane(v, 48)));
}
DI unsigned pk4_fp8(float a, float b, float c, float d) { int w = __builtin_amdgcn_cvt_pk_fp8_f32(a, b, 0, false); w = __builtin_amdgcn_cvt_pk_fp8_f32(c, d, w, true); return (unsigned)w; }
DI float fast_rcp(float x) { return __builtin_amdgcn_rcpf(x); }
DI float sigmoid_f(float x) { return fast_rcp(1.0f + __builtin_amdgcn_exp2f(-1.4426950408889634f * x)); }
DI float silu_f(float x) { return x * sigmoid_f(x); }
DI float gelu_tanh_f(float x) { const float z2 = 1.5957691216057308f * (x + 0.044715f * x * x * x); return x * sigmoid_f(z2); }

#define XB_TMO      128
#define XB_XCNT(j)  (256  + 64 * (j))
#define XB_XSUB(j)  (1280 + 64 * (j))
#define XB_XGEN(j)  (2304 + 64 * (j))
#define XB_TOP      3328
#define XB_TOPGEN   3392
#define XCD_BAR_WORDS 3456
#define XB_SPIN_CAP (1u << 22)
DI unsigned xb_ld(unsigned* p)              { return __hip_atomic_load(p, __ATOMIC_RELAXED, __HIP_MEMORY_SCOPE_AGENT); }
DI unsigned xb_add(unsigned* p, unsigned v) { return __hip_atomic_fetch_add(p, v, __ATOMIC_RELAXED, __HIP_MEMORY_SCOPE_AGENT); }
DI unsigned xb_xcc_id() { return (unsigned)__builtin_amdgcn_s_getreg((3 << 11) | 20) & 0xFu; }
#define XB_SPIN(cond, bar) do { unsigned _sp = 0; while (cond) { __builtin_amdgcn_s_sleep(1); \
    if ((++_sp & 255u) == 0u) { if (xb_ld(&(bar)[XB_TMO])) break; if (_sp > XB_SPIN_CAP) { atomicAdd(&(bar)[XB_TMO], 1u); break; } } } } while (0)
struct XcdBarrier { unsigned* bar; unsigned x; volatile LAS unsigned* st; };
DI XcdBarrier xcd_barrier_post(unsigned* bar, volatile LAS unsigned* st) {
    XcdBarrier b; b.bar = bar; b.x = xb_xcc_id(); b.st = st;
    if (threadIdx.x == 0) (void)xb_add(&bar[XB_XCNT(b.x)], 1u);
    return b;
}
DI void xcd_barrier_complete(unsigned* bar, unsigned x, unsigned& nloc, unsigned& nx) {
    const unsigned G = gridDim.x * gridDim.y * gridDim.z;
    unsigned sum, cnt, mine, sp = 0u;
    for (;;) {
        sum = 0u; cnt = 0u; mine = 0u;
#pragma unroll
        for (unsigned j = 0; j < 16; ++j) { const unsigned c = xb_ld(&bar[XB_XCNT(j)]); sum += c; cnt += (c > 0u) ? 1u : 0u; mine = (j == x) ? c : mine; }
        if (sum == G) break;
        __builtin_amdgcn_s_sleep(1);
        if ((++sp & 255u) == 0u) { if (xb_ld(&bar[XB_TMO])) break; if (sp > XB_SPIN_CAP) { atomicAdd(&bar[XB_TMO], 1u); break; } }
    }
    nloc = mine > 0u ? mine : 1u; nx = cnt > 0u ? cnt : 1u;
}
DI void xcd_barrier(const XcdBarrier& b) {
    asm volatile("s_waitcnt vmcnt(0)" ::: "memory");
    __syncthreads();
    if (threadIdx.x == 0) {
        unsigned* bar = b.bar;
        __builtin_amdgcn_s_waitcnt(0);
        unsigned nloc = b.st[0], nx = b.st[1];
        if (nloc == 0u) { xcd_barrier_complete(bar, b.x, nloc, nx); b.st[0] = nloc; b.st[1] = nx; }
        const unsigned old = xb_add(&bar[XB_XSUB(b.x)], 1u);
        const unsigned gen = old / nloc;
        if (old + 1u == (gen + 1u) * nloc) {
            __builtin_amdgcn_fence(__ATOMIC_RELEASE, "agent");
            asm volatile("s_waitcnt vmcnt(0)" ::: "memory");
            const unsigned og = xb_add(&bar[XB_TOP], 1u);
            const unsigned tg = og / nx;
            if (og + 1u == (tg + 1u) * nx) xb_add(&bar[XB_TOPGEN], 1u);
            else XB_SPIN(xb_ld(&bar[XB_TOPGEN]) == tg, bar);
            __builtin_amdgcn_fence(__ATOMIC_ACQUIRE, "agent");
            xb_add(&bar[XB_XGEN(b.x)], 1u);
            asm volatile("s_waitcnt vmcnt(0)" ::: "memory");
        } else {
            XB_SPIN(xb_ld(&bar[XB_XGEN(b.x)]) == gen, bar);
            __builtin_amdgcn_fence(__ATOMIC_ACQUIRE, "agent");
            asm volatile("s_waitcnt vmcnt(0)" ::: "memory");
        }
    }
    __syncthreads();
}

struct Args { const void* in[30]; float* out; unsigned char* ws; int ph_lo, ph_hi, li, pad; };
enum { I_X = 0, I_C, I_POS, I_ADAW, I_ADAB, I_WIN, I_GMLNG, I_GMLNB, I_GMWS, I_GMBS, I_LAMRE, I_LAMIM, I_LOGDT, I_BRE, I_BIM, I_CRE, I_CIM, I_SSMD,
       I_GLUW, I_GLUB, I_WOUT, I_LN1G, I_LN1B, I_RW, I_RB, I_EWG, I_EWU, I_EWD, I_LN2G, I_LN2B };
struct Frame {
    LAS unsigned char* lds;
    volatile LAS unsigned* MISC;
    gu32* ctl;
    unsigned char* ws;
    int vcu, G;
};
DI int ftid() { int t = threadIdx.x; asm volatile("" : "+v"(t)); return t; }
#define FRAME_IDS const int tid_ = ftid(), lane_ = tid_ & 63, wave_ = __builtin_amdgcn_readfirstlane(tid_ >> 6); (void)lane_; (void)wave_;

template <class RowMap>
DI void transpose_item(const float* W, int K, int N, bf16* WT, const RowMap& rm, LAS float* scr, int item, int lane) {
    const int nblk = N / 32, kb = item / nblk, nb = item % nblk, k0 = 64 * kb, n0 = 32 * nb;
#pragma unroll 8
    for (int i = 0; i < 32; ++i) { const int kk = 2 * i + (lane >> 5); scr[kk * 33 + (lane & 31)] = W[(size_t)(k0 + kk) * N + n0 + (lane & 31)]; }
    LDS_WAIT(); asm volatile("" ::: "memory");
    const int c = lane & 7;
#pragma unroll
    for (int j = 0; j < 4; ++j) { const int n = (lane >> 3) + 8 * j; const LAS float* s = scr + (8 * c) * 33 + n;
        const float qs = (RowMap::SCALEQ && (n0 + n) >= COL_Q && (n0 + n) < COL_K) ? QSCALE : 1.0f;
        v4u o; o.x = pk2(s[0 * 33] * qs, s[1 * 33] * qs); o.y = pk2(s[2 * 33] * qs, s[3 * 33] * qs); o.z = pk2(s[4 * 33] * qs, s[5 * 33] * qs); o.w = pk2(s[6 * 33] * qs, s[7 * 33] * qs);
        *(GAS v4u*)(WT + (size_t)rm(n0 + n) * K + k0 + 8 * c) = o; }
    LDS_WAIT(); asm volatile("" ::: "memory");
}
struct RmIdent { static constexpr bool SCALEQ = false; int off; DI int operator()(int n) const { return off + n; } };
struct RmWin { static constexpr bool SCALEQ = true; DI int operator()(int n) const {
        if (n >= COL_Q && n < COL_VA) { const int d = n & 63; if (d < 16) return (n - d) + 2 * (d & 7) + (d >> 3); }
        return n; } };
struct RmGU { static constexpr bool SCALEQ = false; int e, up; DI int operator()(int n) const { return e * 1024 + (n >> 7) * 256 + (n & 127) + up * 128; } };

DI void p0_tables(Frame& F, const Args& A) {
    FRAME_IDS
    const float* c = (const float*)A.in[I_C];
    LAS float* condS = (LAS float*)(F.lds + RING_OFF);
    LAS float* red = (LAS float*)(F.lds + RING_OFF + 32768);
    for (int i = tid_; i < BATCH * D; i += NTHR) condS[i] = silu_f(c[i]);
    __syncthreads();
    float* mod = (float*)(F.ws + WS_MOD);
    for (int it = F.vcu; it < DEPTH * 96; it += F.G) {
        const int l = it / 96, jb = it % 96, ks = tid_ >> 6, jj = tid_ & 63, j = jb * 64 + jj;
        const float* w = (const float*)A.in[I_ADAW] + (size_t)l * D * 6 * D + j;
        float acc[8];
#pragma unroll
        for (int b = 0; b < 8; ++b) acc[b] = 0.f;
#pragma unroll 16
        for (int k = ks * 128; k < ks * 128 + 128; ++k) { const float wv = w[(size_t)k * (6 * D)];
#pragma unroll
            for (int b = 0; b < 8; ++b) acc[b] += condS[b * D + k] * wv; }
#pragma unroll
        for (int b = 0; b < 8; ++b) red[(ks * 8 + b) * 64 + jj] = acc[b];
        __syncthreads();
        { const int b = tid_ >> 6; float s = ((const float*)A.in[I_ADAB])[l * 6 * D + j];
#pragma unroll
          for (int k2 = 0; k2 < 8; ++k2) s += red[(k2 * 8 + b) * 64 + jj];
          mod[((size_t)l * BATCH + b) * 6 * D + j] = s; }
        __syncthreads();
    }
    const int gt = F.vcu * NTHR + tid_, NGT = F.G * NTHR;
    const int* pos = (const int*)A.in[I_POS]; float* rope = (float*)(F.ws + WS_ROPE);
    for (int w = gt; w < M * 8; w += NGT) { const int m = w >> 3, i = w & 7;
        const float freq = exp2f(-(float)i * 0.125f * 18.931568569324174f);
        const float ang = (float)pos[m] * freq; float s, cs; sincosf(ang, &s, &cs);
        rope[m * 16 + i] = cs; rope[m * 16 + 8 + i] = s; }
    for (int w = gt; w < DEPTH * 16 * 33 * 64; w += NGT) { const int n = w & 63, m = (w >> 6) % 33, g = ((w >> 6) / 33) & 15, l = (w >> 6) / (33 * 16);
        const int li = (l * 16 + g) * 64 + n;
        const float lre = ((const float*)A.in[I_LAMRE])[li], lim = ((const float*)A.in[I_LAMIM])[li], dt = expf(((const float*)A.in[I_LOGDT])[l * 16 + g]);
        const float mag = expf((float)m * (lre * dt)); float sn, cs; sincosf((float)m * (lim * dt), &sn, &cs);
        float* apw = (float*)(F.ws + WS_SSM2 + l * SSM2_LAYER + S2_APW) + ((size_t)(g * 33 + m) * 64 + n) * 2; apw[0] = mag * cs; apw[1] = mag * sn; }
    for (int w = gt; w < DEPTH * SSM_G * SSM_N; w += NGT) { const int l = w / 1024, gn = w % 1024, g = gn >> 6;
        float* tab = (float*)(F.ws + WS_SSM) + (size_t)l * SSM_TAB;
        const float lre = ((const float*)A.in[I_LAMRE])[w], lim = ((const float*)A.in[I_LAMIM])[w];
        const float dt = expf(((const float*)A.in[I_LOGDT])[l * 16 + g]);
        const float mag = expf(lre * dt); float sn, cs; sincosf(lim * dt, &sn, &cs);
        const float are = mag * cs, aim = mag * sn, nr = are - 1.0f, ni = aim, mod2 = lre * lre + lim * lim;
        const float fre = (nr * lre + ni * lim) / mod2, fim = (ni * lre - nr * lim) / mod2;
        tab[gn] = are; tab[1024 + gn] = aim;
        const float* bre = (const float*)A.in[I_BRE] + (size_t)w * 16; const float* bim = (const float*)A.in[I_BIM] + (size_t)w * 16;
#pragma unroll
        for (int cc = 0; cc < 16; ++cc) { tab[2048 + gn * 16 + cc] = fre * bre[cc] - fim * bim[cc]; tab[2048 + 16384 + gn * 16 + cc] = fre * bim[cc] + fim * bre[cc]; } }
}

DI void p_wconv(Frame& F, const Args& A, int l, int part) {
    FRAME_IDS
    if (part == 4) {
        const int gt = F.vcu * NTHR + tid_, NGT = F.G * NTHR;
        const float* tab = (const float*)(F.ws + WS_SSM) + (size_t)l * SSM_TAB;
        const float* apw = (const float*)(F.ws + WS_SSM2 + l * SSM2_LAYER + S2_APW);
        const float* cre = (const float*)A.in[I_CRE] + (size_t)l * 16 * 16 * 64; const float* cim = (const float*)A.in[I_CIM] + (size_t)l * 16 * 16 * 64;
        bf16* KT = (bf16*)(F.ws + WS_SSM2 + l * SSM2_LAYER + S2_KT); bf16* CT = (bf16*)(F.ws + WS_SSM2 + l * SSM2_LAYER + S2_CT);
        bf16* WIN = (bf16*)(F.ws + WS_SSM2 + l * SSM2_LAYER + S2_WIN); bf16* GW = (bf16*)(F.ws + WS_SSM2 + l * SSM2_LAYER + S2_GW);
        for (int w = gt; w < 16 * 16 * 64 * 8; w += NGT) { const int j = w & 7, ln = (w >> 3) & 63, p = (w >> 9) & 15, g = w >> 13;
            const int co = ln & 15, q = ln >> 4, m = 2 * p + (q >> 1), ci = 8 * (q & 1) + j; float acc = 0.f;
            for (int n = 0; n < 64; ++n) { const int gn = g * 64 + n; const float ar = apw[((g * 33 + m) * 64 + n) * 2], ai = apw[((g * 33 + m) * 64 + n) * 2 + 1];
                const float br = tab[2048 + gn * 16 + ci], bi = tab[2048 + 16384 + gn * 16 + ci], tre = ar * br - ai * bi, tim = ar * bi + ai * br;
                acc += cre[(g * 16 + co) * 64 + n] * tre - cim[(g * 16 + co) * 64 + n] * tim; }
            KT[w] = (bf16)f2bf(acc); }
        for (int w = gt; w < 16 * 4 * 64 * 8; w += NGT) { const int j = w & 7, ln = (w >> 3) & 63, sx = (w >> 9) & 3, g = w >> 11;
            const int co = ln & 15, q = ln >> 4, n = 16 * sx + 4 * q + (j >> 1);
            CT[w] = (bf16)f2bf((j & 1) ? -cim[(g * 16 + co) * 64 + n] : cre[(g * 16 + co) * 64 + n]); }
        for (int w = gt; w < 16 * 16 * 8 * 64 * 8; w += NGT) { const int jj = w & 7, ln = (w >> 3) & 63, ct = (w >> 9) & 7, sp = (w >> 12) & 15, g = w >> 16;
            const int cc = ln & 15, q = ln >> 4, n = 8 * ct + (cc >> 1), part = cc & 1, tj = 2 * sp + (q >> 1), ci = 8 * (q & 1) + jj, gn = g * 64 + n, m = 31 - tj;
            const float ar = apw[((g * 33 + m) * 64 + n) * 2], ai = apw[((g * 33 + m) * 64 + n) * 2 + 1], br = tab[2048 + gn * 16 + ci], bi = tab[2048 + 16384 + gn * 16 + ci];
            WIN[w] = (bf16)f2bf(part ? (ar * bi + ai * br) : (ar * br - ai * bi)); }
        const float* gws = (const float*)A.in[I_GMWS] + (size_t)l * 4 * 128 * 128;
        for (int w = gt; w < 4 * 128 * 128; w += NGT) { const int sx = w & 127, t = (w >> 7) & 127; GW[w] = (bf16)f2bf(sx <= t ? gws[w] : 0.f); }
    }
}
constexpr int WC_NS = 16 * 32 + 4 * 8;
DI void p_wconv_items(Frame& F, const Args& A, int l, int lo, int hi) {
    FRAME_IDS
    LAS float* scr = (LAS float*)(F.lds + RING_OFF + wave_ * 16384);
    bf16* WoutT = (bf16*)(F.ws + WS_WSMALL + l * WSMALL_LAYER + WOFF_OUT);
    bf16* GluT = (bf16*)(F.ws + WS_WSMALL + l * WSMALL_LAYER + WOFF_GLU);
    constexpr int I_OUTW = 16 * 32;
    for (int it = lo + F.vcu * NWAVES + wave_; it < hi; it += F.G * NWAVES) {
        int r = it;
        if (r < I_OUTW) { transpose_item((const float*)A.in[I_WOUT] + (size_t)l * D * D, D, D, WoutT, RmIdent{0}, scr, r, lane_); continue; } r -= I_OUTW;
        transpose_item((const float*)A.in[I_GLUW] + (size_t)l * 256 * 256, 256, 256, GluT, RmIdent{0}, scr, r, lane_);
    }
}
template <bool CI_DEST, int KW, class RowMap>
DI void quant_cols32(Frame& F, const float* Wm, int ldw, int n0, unsigned char* W8, const RowMap& rm, float* cinv) {
    FRAME_IDS
    LAS float* scr = (LAS float*)(F.lds + RING_OFF + wave_ * 16384);
    LAS float* red = (LAS float*)(F.lds + RING_OFF + 12288);
    constexpr int NV = KW / 2, KTOT = 8 * KW; const int k0 = KW * wave_;
    const float* W = Wm + (size_t)k0 * ldw + n0;
    const unsigned lofs = (unsigned)((lane_ >> 5) * ldw + (lane_ & 31));
    float v[NV]; float mx = 0.f;
#pragma unroll
    for (int i = 0; i < NV; ++i) v[i] = W[(size_t)(2 * i) * ldw + lofs];
#pragma unroll
    for (int i = 0; i < NV; ++i) mx = fmaxf(mx, fabsf(v[i]));
    red[wave_ * 4096 + lane_] = mx;
    __syncthreads();
    float m2 = 0.f;
#pragma unroll
    for (int w2 = 0; w2 < 8; ++w2) m2 = fmaxf(m2, fmaxf(red[w2 * 4096 + (lane_ & 31)], red[w2 * 4096 + 32 + (lane_ & 31)]));
    const bool z = !(m2 > 1e-30f); const float sc = z ? 1.0f : 440.0f / m2;
    if (tid_ < 32) { const int n = n0 + tid_; const float qf = (RowMap::SCALEQ && n >= COL_Q && n < COL_K) ? QSCALE : 1.0f; cinv[CI_DEST ? rm(n) : n] = (z ? 1.0f : m2 * (1.0f / 440.0f)) * qf; }
    const int c = lane_ & 7;
#pragma unroll
    for (int t = 0; t < KW / 64; ++t) {
#pragma unroll
        for (int i = 0; i < 32; ++i) scr[(2 * i + (lane_ >> 5)) * 33 + (lane_ & 31)] = v[32 * t + i] * sc;
        LDS_WAIT(); asm volatile("" ::: "memory");
#pragma unroll
        for (int jj = 0; jj < 4; ++jj) { const int n = (lane_ >> 3) + 8 * jj; const LAS float* sp = scr + (8 * c) * 33 + n;
            v2u o; o.x = pk4_fp8(sp[0 * 33], sp[1 * 33], sp[2 * 33], sp[3 * 33]); o.y = pk4_fp8(sp[4 * 33], sp[5 * 33], sp[6 * 33], sp[7 * 33]);
            *(GAS v2u*)(W8 + (size_t)rm(n0 + n) * KTOT + k0 + 64 * t + 8 * c) = o; }
        LDS_WAIT(); asm volatile("" ::: "memory");
    }
    __syncthreads();
}
constexpr int WC_NGU = 16 * 2 * 16, WC_NIN = PROJW / 32;
DI void p_wconv_gu(Frame& F, const Args& A, int l, int first, int stride, int hi) {
    for (int j = first; j < hi; j += stride) { const int e = j >> 5, up = (j >> 4) & 1;
        quant_cols32<false, 128>(F, (const float*)A.in[up ? I_EWU : I_EWG] + ((size_t)l * NEXP + e) * D * DEXP, DEXP, 32 * (j & 15), (unsigned char*)(F.ws + WS_WGU), RmGU{e, up},
                            (float*)(F.ws + WS_CINV) + (size_t)l * 16 * 2 * 512 + (e * 2 + up) * 512); }
}
constexpr int WC_NDN = 16 * 32;
DI void p_wconv_dn(Frame& F, const Args& A, int l, int first, int stride) {
    for (int j = first; j < WC_NDN; j += stride) { const int e = j >> 5;
        quant_cols32<false, 64>(F, (const float*)A.in[I_EWD] + ((size_t)l * NEXP + e) * D * DEXP, D, 32 * (j & 31), (unsigned char*)(F.ws + WS_WD), RmIdent{e * 1024},
                                (float*)(F.ws + WS_CINV_D) + ((size_t)l * NEXP + e) * D); }
}
DI void p_wconv_in(Frame& F, const Args& A, int l, int first, int stride) {
    for (int j = first; j < WC_NIN; j += stride)
        quant_cols32<true, 128>(F, (const float*)A.in[I_WIN] + (size_t)l * D * PROJW, PROJW, 32 * j, (unsigned char*)(F.ws + WS_WSMALL + l * WSMALL_LAYER + WOFF_IN), RmWin{}, (float*)(F.ws + WS_CINV_IN) + l * PROJW);
}

typedef float f32x2_t __attribute__((ext_vector_type(2)));
typedef __bf16 bf16x2_t __attribute__((ext_vector_type(2)));
DI unsigned cvtpk(float lo, float hi) { f32x2_t v = {lo, hi}; bf16x2_t b = __builtin_convertvector(v, bf16x2_t); return __builtin_bit_cast(unsigned, b); }
struct Row16 { float v[16]; };
DI void row_load_f32(Row16& r, const float* p, int lane) {
    const f32x4* q = (const f32x4*)p;
#pragma unroll
    for (int k = 0; k < 4; ++k) { const f32x4 a = q[k * 64 + lane]; r.v[4 * k] = a.x; r.v[4 * k + 1] = a.y; r.v[4 * k + 2] = a.z; r.v[4 * k + 3] = a.w; }
}
DI void row_load_f32_nt(Row16& r, const float* p, int lane) {
    const f32x4* q = (const f32x4*)p;
#pragma unroll
    for (int k = 0; k < 4; ++k) { const f32x4 a = __builtin_nontemporal_load(&q[k * 64 + lane]); r.v[4 * k] = a.x; r.v[4 * k + 1] = a.y; r.v[4 * k + 2] = a.z; r.v[4 * k + 3] = a.w; }
}
DI void row_load_bf16(Row16& r, const bf16* p, int lane) {
    const v2u* q = (const v2u*)p;
#pragma unroll
    for (int k = 0; k < 4; ++k) { const v2u a = q[k * 64 + lane]; r.v[4 * k] = bflo(a.x); r.v[4 * k + 1] = bfhi(a.x); r.v[4 * k + 2] = bflo(a.y); r.v[4 * k + 3] = bfhi(a.y); }
}
DI void row_store_bf16(const Row16& r, bf16* p, int lane) {
    v2u* q = (v2u*)p;
#pragma unroll
    for (int k = 0; k < 4; ++k) { v2u o; o.x = cvtpk(r.v[4 * k], r.v[4 * k + 1]); o.y = cvtpk(r.v[4 * k + 2], r.v[4 * k + 3]); q[k * 64 + lane] = o; }
}
DI void row_store_fp8(const Row16& r, unsigned char* p, float* sinv, int lane) {
    float am = 0.f;
#pragma unroll
    for (int i = 0; i < 16; ++i) am = fmaxf(am, fabsf(r.v[i]));
    am = wave_max(am); const bool z = !(am > 1e-30f); const float qs = z ? 1.0f : 440.0f / am;
    unsigned* q8 = (unsigned*)p;
#pragma unroll
    for (int k = 0; k < 4; ++k) q8[k * 64 + lane] = pk4_fp8(r.v[4 * k] * qs, r.v[4 * k + 1] * qs, r.v[4 * k + 2] * qs, r.v[4 * k + 3] * qs);
    if (lane == 0) *sinv = z ? 1.0f : am * (1.0f / 440.0f);
}
DI void row_store_f32(const Row16& r, float* p, int lane) {
    f32x4* q = (f32x4*)p;
#pragma unroll
    for (int k = 0; k < 4; ++k) __builtin_nontemporal_store((f32x4){r.v[4 * k], r.v[4 * k + 1], r.v[4 * k + 2], r.v[4 * k + 3]}, &q[k * 64 + lane]);
}
DI void row_ln(Row16& r) {
    float s = 0.f;
#pragma unroll
    for (int i = 0; i < 16; ++i) s += r.v[i];
    const float mean = wave_sum(s) * (1.f / D); float s2 = 0.f;
#pragma unroll
    for (int i = 0; i < 16; ++i) { r.v[i] -= mean; s2 += r.v[i] * r.v[i]; }
    const float rstd = 1.0f / sqrtf(wave_sum(s2) * (1.f / D) + LN_EPS);
#pragma unroll
    for (int i = 0; i < 16; ++i) r.v[i] *= rstd;
}
DI void row_mod(Row16& r, const float* a, const float* b, int lane) {
    Row16 av, bv; row_load_f32(av, a, lane); row_load_f32(bv, b, lane);
#pragma unroll
    for (int i = 0; i < 16; ++i) r.v[i] = r.v[i] * (1.0f + av.v[i]) + bv.v[i];
}
DI void row_affine(Row16& r, const float* g, const float* b, int lane) {
    Row16 av, bv; row_load_f32(av, g, lane); row_load_f32(bv, b, lane);
#pragma unroll
    for (int i = 0; i < 16; ++i) r.v[i] = r.v[i] * av.v[i] + bv.v[i];
}

DI void p_ln_a0(Frame& F, const Args& A) {
    FRAME_IDS
    const int gw = F.vcu * NWAVES + wave_, NGW = F.G * NWAVES;
    const float* x = (const float*)A.in[I_X]; bf16* XN = (bf16*)(F.ws + WS_XN); const float* mod = (const float*)(F.ws + WS_MOD);
    const int bq = gw / (NGW / BATCH), mbase = bq * T + gw % (NGW / BATCH), mstep = NGW / BATCH;
    const float* md = mod + (size_t)bq * 6 * D;
    Row16 msc, msh; row_load_f32(msc, md + 1 * D, lane_); row_load_f32(msh, md + 0 * D, lane_);
    Row16 nx; row_load_f32_nt(nx, x + (size_t)mbase * D, lane_);
    for (int m = mbase; m < (bq + 1) * T; m += mstep) {
        Row16 r = nx; if (m + mstep < (bq + 1) * T) row_load_f32_nt(nx, x + (size_t)(m + mstep) * D, lane_);
        row_ln(r);
#pragma unroll
        for (int i = 0; i < 16; ++i) r.v[i] = r.v[i] * (1.0f + msc.v[i]) + msh.v[i];
        row_store_fp8(r, (unsigned char*)XN + (size_t)m * D, (float*)(F.ws + WS_SA) + m, lane_); }
}

using pg8::Unit; using pg8::BM; using pg8::HALF;
struct EpiInProj {
    static constexpr bool PERM = true, AFTER_DRAIN = false;
    bf16* P; const float* rope; int skip; const float* sa; const float* cinv;
    DI void operator()(const pg8::f32x4 (&acc)[2][2][4][2], const Unit& u, int wr, int wc, int fr, int fq) const {
        if (skip == 1) { if (acc[0][0][0][0][0] == 12345.678f) P[0] = 1; return; }
        const int row0 = u.pm * BM + wr * 64 + fr, pn = u.pn;
        const bool isrope = (pn >= 2 && pn <= 5), dorope = isrope && ((wc & 1) == 0) && (fq < 2);
        asm volatile("" ::: "memory");
        pg8::f32x4 ci[2][2];
#pragma unroll
        for (int bj = 0; bj < 2; ++bj) { const float* cp = cinv + pn * BM + bj * HALF + wc * 32 + 8 * fq; ci[bj][0] = *(const pg8::f32x4*)cp; ci[bj][1] = *(const pg8::f32x4*)(cp + 4); }
#pragma unroll
        for (int ai = 0; ai < 2; ++ai)
#pragma unroll
            for (int m = 0; m < 4; ++m) { const int row = row0 + ai * HALF + m * 16; bf16* rowp = P + (size_t)row * PROJW + pn * BM + wc * 32 + 8 * fq; const float ra = sa[row];
                f32x4 cs = (f32x4){1.f, 1.f, 1.f, 1.f}, sn = (f32x4){0.f, 0.f, 0.f, 0.f};
                if (isrope) { const float* rp = rope + (size_t)row * 16 + 4 * (fq & 1); cs = *(const f32x4*)rp; sn = *(const f32x4*)(rp + 8); }
#pragma unroll
                for (int bj = 0; bj < 2; ++bj) { pg8::f32x4 v0 = acc[ai][bj][m][0] * (ci[bj][0] * ra), v1 = acc[ai][bj][m][1] * (ci[bj][1] * ra);
                    if (isrope) {
                        if (dorope) { const float a0 = v0[0] * cs.x - v0[1] * sn.x, b0 = v0[1] * cs.x + v0[0] * sn.x, a1 = v0[2] * cs.y - v0[3] * sn.y, b1 = v0[3] * cs.y + v0[2] * sn.y;
                            const float a2 = v1[0] * cs.z - v1[1] * sn.z, b2 = v1[1] * cs.z + v1[0] * sn.z, a3 = v1[2] * cs.w - v1[3] * sn.w, b3 = v1[3] * cs.w + v1[2] * sn.w;
                            v0 = (pg8::f32x4){a0, b0, a1, b1}; v1 = (pg8::f32x4){a2, b2, a3, b3}; }
                    }
                    pg8::u32x4 w; w.x = pg8::cvt_pk_bf16(v0[0], v0[1]); w.y = pg8::cvt_pk_bf16(v0[2], v0[3]); w.z = pg8::cvt_pk_bf16(v1[0], v1[1]); w.w = pg8::cvt_pk_bf16(v1[2], v1[3]);
                    if (skip == 2) { asm volatile("" :: "v"(w.x), "v"(w.y), "v"(w.z), "v"(w.w)); } else *(pg8::u32x4*)(rowp + bj * HALF) = w; } }
    }
};
template <bool XF32> struct EpiOut {
    static constexpr bool PERM = true, AFTER_DRAIN = false;
    bf16* PRE; const void* x; int xpitch; const float* mod;
    DI void operator()(const pg8::f32x4 (&acc)[2][2][4][2], const Unit& u, int wr, int wc, int fr, int fq) const {
        const int row0 = u.pm * BM + wr * 64 + fr, b = (u.pm * BM) / T, colb = u.pn * BM + wc * 32 + 8 * fq;
        const float* g1 = mod + (size_t)b * 6 * D + 2 * D;
        pg8::f32x4 gv[2][2];
#pragma unroll
        for (int bj = 0; bj < 2; ++bj) { gv[bj][0] = *(const pg8::f32x4*)(g1 + colb + bj * HALF) + 1.0f; gv[bj][1] = *(const pg8::f32x4*)(g1 + colb + bj * HALF + 4) + 1.0f; }
#pragma unroll
        for (int ai = 0; ai < 2; ++ai)
#pragma unroll
            for (int m = 0; m < 4; ++m) { const int row = row0 + ai * HALF + m * 16;
#pragma unroll
                for (int bj = 0; bj < 2; ++bj) { const int col = colb + bj * HALF; pg8::f32x4 x0, x1;
                    if (XF32) { const float* xp = (const float*)x + (size_t)row * xpitch + col; x0 = *(const pg8::f32x4*)xp; x1 = *(const pg8::f32x4*)(xp + 4); }
                    else { const pg8::u32x4 xw = *(const pg8::u32x4*)((const bf16*)x + (size_t)row * xpitch + col);
                        x0 = (pg8::f32x4){bflo(xw.x), bfhi(xw.x), bflo(xw.y), bfhi(xw.y)}; x1 = (pg8::f32x4){bflo(xw.z), bfhi(xw.z), bflo(xw.w), bfhi(xw.w)}; }
                    const pg8::f32x4 v0 = x0 * ALPHA + gv[bj][0] * acc[ai][bj][m][0], v1 = x1 * ALPHA + gv[bj][1] * acc[ai][bj][m][1];
                    pg8::u32x4 w; w.x = pg8::cvt_pk_bf16(v0[0], v0[1]); w.y = pg8::cvt_pk_bf16(v0[2], v0[3]); w.z = pg8::cvt_pk_bf16(v1[0], v1[1]); w.w = pg8::cvt_pk_bf16(v1[2], v1[3]);
                    *(pg8::u32x4*)(PRE + (size_t)row * D + col) = w; } }
    }
};
struct OutOrder : pg8::StaticOrder {
    const char* xbase; unsigned rowbytes, tilecolbytes; LAS unsigned char* dump;
    DI void a_ready(const Unit& u) const {
        const int tid = threadIdx.x, wid = __builtin_amdgcn_readfirstlane(tid >> 6), lane = tid & 63;
        const int lpr = (int)(tilecolbytes >> 7);
        const char* t0 = xbase + (size_t)u.pm * 256 * rowbytes + (size_t)u.pn * tilecolbytes;
        const int nline = 256 * lpr;
        for (int i = wid * 64 + lane; i < nline; i += 512) { const int r = i / lpr, c = i % lpr;
            __builtin_amdgcn_global_load_lds((const unsigned*)(t0 + (size_t)r * rowbytes + (size_t)c * 128), (LAS unsigned*)(dump + wid * 256), 4, 0, 0); }
    }
};
struct EpiGlu {
    static constexpr bool PERM = true, AFTER_DRAIN = false;
    const bf16* YG; bf16* MIX; const float* gb;
    DI void operator()(const pg8::f32x4 (&acc)[2][2][4][2], const Unit& u, int wr, int wc, int fr, int fq) const {
        const int row0 = u.pm * BM + wr * 64 + fr, colb = wc * 32 + 8 * fq;
#pragma unroll
        for (int ai = 0; ai < 2; ++ai)
#pragma unroll
            for (int m = 0; m < 4; ++m) { const int row = row0 + ai * HALF + m * 16;
#pragma unroll
                for (int bj = 0; bj < 2; ++bj) { const int col = colb + bj * HALF;
                    const pg8::u32x4 yw = *(const pg8::u32x4*)(YG + (size_t)row * 256 + col);
                    const pg8::f32x4 b0 = *(const pg8::f32x4*)(gb + col), b1 = *(const pg8::f32x4*)(gb + col + 4);
                    const pg8::f32x4 a0 = acc[ai][bj][m][0] + b0, a1 = acc[ai][bj][m][1] + b1;
                    const float y[8] = {bflo(yw.x), bfhi(yw.x), bflo(yw.y), bfhi(yw.y), bflo(yw.z), bfhi(yw.z), bflo(yw.w), bfhi(yw.w)};
                    float o[8];
#pragma unroll
                    for (int i = 0; i < 4; ++i) { o[i] = y[i] * sigmoid_f(a0[i]); o[4 + i] = y[4 + i] * sigmoid_f(a1[i]); }
                    pg8::u32x4 w; w.x = pg8::cvt_pk_bf16(o[0], o[1]); w.y = pg8::cvt_pk_bf16(o[2], o[3]); w.z = pg8::cvt_pk_bf16(o[4], o[5]); w.w = pg8::cvt_pk_bf16(o[6], o[7]);
                    *(pg8::u32x4*)(MIX + (size_t)row * D + 768 + col) = w; asm volatile("" ::: "memory"); } }
    }
};
template <int KIND> struct MoeOrderK {
    const volatile LAS int* ts; int G, c; const int* slot_a; const float* slot_w; gu32* done_cnt; gu32* queue; volatile LAS int* qs;
    DI bool decode(int off, Unit& u) const {
        const int nwg = ts[16] * 4, q = nwg / 8, r = nwg % 8, xcd = c % 8; const int cntx = q + (xcd < r ? 1 : 0); if (off >= cntx) return false;
        const int wgid = (xcd < r ? xcd * (q + 1) : r * (q + 1) + (xcd - r) * q) + off;
        const int tm = wgid >> 2, j = wgid & 3; int e = 0;
#pragma unroll
        for (int k = 1; k < 16; ++k) e += (ts[k] <= tm) ? 1 : 0;
        u.pm = tm; u.pn = e * 4 + j; return true; }
    DI bool first(Unit& u) const {
        if (KIND == 0) return next(0, u);
        if (threadIdx.x == 0) { const unsigned a = __hip_atomic_fetch_add(queue + 16 * (c % 8), 2u, RLX_AGENT); qs[0] = (int)a; qs[1] = (int)a + 1; }
        asm volatile("s_waitcnt vmcnt(0) lgkmcnt(0)" ::: "memory"); __builtin_amdgcn_s_barrier(); asm volatile("" ::: "memory");
        return decode(qs[0], u);
    }
    DI bool more(int i, Unit& u) const {
        if (KIND == 0) return next(i, u);
        return decode(qs[i & 1], u);
    }
    DI bool next(int i, Unit& u) const {
        const int nwg = ts[16] * 4; const int cc = c;
        const long L = (long)i * G + cc; if (L >= nwg) return false;
        int wgid = (int)L; { const int q = nwg / 8, r = nwg % 8, xcd = wgid % 8, off = wgid / 8; wgid = (xcd < r ? xcd * (q + 1) : r * (q + 1) + (xcd - r) * q) + off; }
        const int tm = wgid >> 2, j = wgid & 3; int e = 0;
#pragma unroll
        for (int k = 1; k < 16; ++k) e += (ts[k] <= tm) ? 1 : 0;
        u.pm = tm; u.pn = e * 4 + j; return true;
    }
    const unsigned char* hsc;
    struct Pf { unsigned a, w, c, q; };
    DI const unsigned char* scale_base(const Unit& u) const { return hsc + (size_t)u.pm * 4096; }
    DI void pull_issue(int tid, Pf& pf) const { if (KIND == 1 && tid == 0) pf.q = __hip_atomic_fetch_add(queue + 16 * (c % 8), 1u, RLX_AGENT); }
    DI void pull_publish(int tid, const Pf& pf, int ui) const { if (KIND == 1 && tid == 0 && ui >= 0) qs[ui & 1] = (int)pf.q; }
    DI void prefetch(const Unit& u, int r, Pf& pf) const {
        const int e = u.pn >> 2, idx = (u.pm - ts[e]) * 256 + (r & 255); const bool valid = idx < ts[32 + e];
        pf.a = 0xffffffffu; pf.w = 0u; pf.c = 32u;
        if (valid && r < 256) { pf.a = (unsigned)slot_a[(size_t)e * SLOT_CAP + idx]; if (KIND == 1) pf.w = __float_as_uint(slot_w[(size_t)e * SLOT_CAP + idx]); }
        if (KIND == 1 && r < 64) pf.c = __hip_atomic_load(done_cnt + u.pm, RLX_AGENT);
    }
    DI void finish_meta(const Unit& u, int r, const Pf& pf, unsigned& off, unsigned& a0, unsigned& a1) const {
        if (KIND == 0) { const bool pad = pf.a == 0xffffffffu; off = (pad ? 0u : ((pf.a & 0xffffu) >> 1)) * (unsigned)D; a0 = 0u; a1 = pad ? 0u : (pf.a & 0xffff0000u); }
        else { off = (unsigned)(u.pm * 256 + r) * (unsigned)DEXP; a0 = pf.a == 0xffffffffu ? pf.a : (pf.a & 0xffffu); a1 = pf.w; }
    }
    DI void wait_ready(const Unit& u, int tid, const Pf& pf) const {
        if (KIND == 1 && tid < 64) { unsigned sp = 0;
            if ((unsigned)__builtin_amdgcn_readfirstlane((int)pf.c) < 32u)
                while ((unsigned)__builtin_amdgcn_readfirstlane((int)__hip_atomic_load(done_cnt + u.pm, RLX_AGENT)) < 32u) { __builtin_amdgcn_s_sleep(2); if (++sp > (1u << 20)) break; } }
    }
    DI void a_ready(const Unit&) const {}
    DI void done_nowait(const Unit& u) const { if (KIND == 0 && (threadIdx.x & 63) == 0) __hip_atomic_fetch_add(done_cnt + u.pm, 1u, RLX_AGENT); }
};
struct EpiG1 {
    static constexpr bool PERM = true, AFTER_DRAIN = false;
    unsigned char* HID; int skip; const float* cinv; unsigned char* HSC;
    DI void operator()(const pg8::f32x4 (&acc)[2][2][4][2], const Unit& u, int wr, int wc, int fr, int fq, const LAS unsigned* meta) const {
        if (skip == 1) { if (acc[0][0][0][0][0] == 12345.678f) HID[0] = 1; return; }
        const __amdgpu_buffer_rsrc_t rs = __builtin_amdgcn_make_buffer_rsrc((void*)HID, 0, (int)((size_t)NSLOT_MAX * DEXP), 0x00020000);
        const __amdgpu_buffer_rsrc_t rsc = __builtin_amdgcn_make_buffer_rsrc((void*)HSC, 0, (int)((size_t)NSLOT_MAX * 16), 0x00020000);
        const int ln_ = ftid() & 63, fr_ = ln_ & 15, fq_ = ln_ >> 4; (void)fr; (void)fq;
        const int e = u.pn >> 2, j = u.pn & 3, r0 = wr * 64 + fr_, row0 = u.pm * BM + r0, col = j * 128 + wc * 32 + 8 * fq_;
        asm volatile("" ::: "memory");
        const float* cg = cinv + (e * 2 + 0) * 512 + col; const float* cu = cinv + (e * 2 + 1) * 512 + col;
        const pg8::f32x4 cg0 = *(const pg8::f32x4*)cg, cg1 = *(const pg8::f32x4*)(cg + 4), cu0 = *(const pg8::f32x4*)cu, cu1 = *(const pg8::f32x4*)(cu + 4);
#pragma unroll
        for (int ai = 0; ai < 2; ++ai)
#pragma unroll
            for (int m = 0; m < 4; ++m) { const int rl = r0 + ai * HALF + m * 16, row = row0 + ai * HALF + m * 16; float o[8];
                const float ra = __uint_as_float(meta[512 + rl]);
#pragma unroll
                for (int i = 0; i < 4; ++i) { o[i] = silu_f(acc[ai][0][m][0][i] * (ra * cg0[i])) * (acc[ai][1][m][0][i] * (ra * cu0[i])); o[4 + i] = silu_f(acc[ai][0][m][1][i] * (ra * cg1[i])) * (acc[ai][1][m][1][i] * (ra * cu1[i])); }
                float bm = fmaxf(fmaxf(fmaxf(fabsf(o[0]), fabsf(o[1])), fmaxf(fabsf(o[2]), fabsf(o[3]))), fmaxf(fmaxf(fabsf(o[4]), fabsf(o[5])), fmaxf(fabsf(o[6]), fabsf(o[7]))));
                bm = fmaxf(bm, __shfl_xor(bm, 16)); bm = fmaxf(bm, __shfl_xor(bm, 32));
                unsigned eb = (__float_as_uint(bm * (1.0f / 448.0f)) + 0x7fffffu) >> 23; eb = eb < 1u ? 1u : (eb > 254u ? 254u : eb);
                const float mult = __uint_as_float((254u - eb) << 23);
                v2u w; w.x = pk4_fp8(o[0] * mult, o[1] * mult, o[2] * mult, o[3] * mult); w.y = pk4_fp8(o[4] * mult, o[5] * mult, o[6] * mult, o[7] * mult);
                __builtin_amdgcn_raw_buffer_store_b64(w, rs, row * DEXP + col, 0, 16);
                if (fq_ == 0) __builtin_amdgcn_raw_buffer_store_b8((unsigned char)eb, rsc, ((u.pm * 4 + j) * 256 + rl) * 4 + wc, 0, 16); }
    }
};
struct EpiG2 {
    static constexpr bool PERM = true, AFTER_DRAIN = false;
    bf16* ROWS; int skip; const float* cinv;
    DI void operator()(const pg8::f32x4 (&acc)[2][2][4][2], const Unit& u, int wr, int wc, int fr, int fq, const LAS unsigned* meta) const {
        if (skip == 1) { if (acc[0][0][0][0][0] == 12345.678f) ROWS[0] = 1; return; }
        const int r0 = wr * 64 + fr, colb = (u.pn & 3) * BM + wc * 32 + 8 * fq;
        asm volatile("" ::: "memory");
        pg8::f32x4 ci[2][2];
#pragma unroll
        for (int bj = 0; bj < 2; ++bj) { const float* cp = cinv + (u.pn >> 2) * D + colb + bj * HALF; ci[bj][0] = *(const pg8::f32x4*)cp; ci[bj][1] = *(const pg8::f32x4*)(cp + 4); }
#pragma unroll
        for (int ai = 0; ai < 2; ++ai)
#pragma unroll
            for (int m = 0; m < 4; ++m) { const int r = r0 + ai * HALF + m * 16; const int d = (int)meta[256 + r]; const float wt = __uint_as_float(meta[512 + r]);
                if (d >= 0) {
#pragma unroll
                    for (int bj = 0; bj < 2; ++bj) { const pg8::f32x4 v0 = acc[ai][bj][m][0] * (ci[bj][0] * wt), v1 = acc[ai][bj][m][1] * (ci[bj][1] * wt);
                        pg8::u32x4 w; w.x = pg8::cvt_pk_bf16(v0[0], v0[1]); w.y = pg8::cvt_pk_bf16(v0[2], v0[3]); w.z = pg8::cvt_pk_bf16(v1[0], v1[1]); w.w = pg8::cvt_pk_bf16(v1[2], v1[3]);
                        *(pg8::u32x4*)(ROWS + (size_t)d * D + colb + bj * HALF) = w; } } }
    }
};

DI void mix_gating_simple(Frame& F, const Args& A, int l) {
    FRAME_IDS
    const bf16* P = (const bf16*)(F.ws + WS_PROJ); bf16* MIX = (bf16*)(F.ws + WS_MIXCAT);
    const float* lng = (const float*)A.in[I_GMLNG] + l * AW; const float* lnb = (const float*)A.in[I_GMLNB] + l * AW;
    const float* ws_ = (const float*)A.in[I_GMWS] + (size_t)l * 4 * 128 * 128; const float* bs_ = (const float*)A.in[I_GMBS] + l * 4 * 128;
    LAS float* vln = (LAS float*)(F.lds + RING_OFF);
    for (int it = F.vcu; it < BATCH * (T / 128); it += F.G) {
        const int m0 = it * 128;
        for (int r = wave_; r < 128; r += NWAVES) {
            const v2u w = *(const v2u*)(P + (size_t)(m0 + r) * PROJW + COL_V + 4 * lane_);
            float v[4] = {gelu_tanh_f(bflo(w.x)), gelu_tanh_f(bfhi(w.x)), gelu_tanh_f(bflo(w.y)), gelu_tanh_f(bfhi(w.y))};
            const float mean = wave_sum(v[0] + v[1] + v[2] + v[3]) * (1.f / 256.f);
            float s2 = 0.f;
#pragma unroll
            for (int i = 0; i < 4; ++i) { v[i] -= mean; s2 += v[i] * v[i]; }
            const float rstd = 1.0f / sqrtf(wave_sum(s2) * (1.f / 256.f) + LN_EPS);
#pragma unroll
            for (int i = 0; i < 4; ++i) vln[r * 256 + 4 * lane_ + i] = v[i] * rstd * lng[4 * lane_ + i] + lnb[4 * lane_ + i];
        }
        __syncthreads();
        { const int c = tid_ & 255, tp = tid_ >> 8, h = c >> 6;
          for (int t = tp; t < 128; t += 2) { const float* wrow = ws_ + ((size_t)h * 128 + t) * 128; float acc = 0.f;
              for (int s = 0; s <= t; ++s) acc += wrow[s] * vln[s * 256 + c];
              const float uu = gelu_tanh_f(bf2f(P[(size_t)(m0 + t) * PROJW + COL_U + c]));
              MIX[(size_t)(m0 + t) * D + c] = (bf16)f2bf(uu * (acc + bs_[h * 128 + t])); } }
        __syncthreads();
    }
}
DI void mix_attn_simple(Frame& F, int l) {
    FRAME_IDS
    const bf16* P = (const bf16*)(F.ws + WS_PROJ); bf16* MIX = (bf16*)(F.ws + WS_MIXCAT);
    const int gw = F.vcu * NWAVES + wave_, NGW = F.G * NWAVES;
    for (int it = gw; it < M * NH; it += NGW) {
        const int m = it >> 3, h = it & 7, t = m & (T - 1);
        const float q = bf2f(P[(size_t)m * PROJW + COL_Q + h * 64 + lane_]);
        float mx = -1e30f, den = 0.f, o = 0.f;
#pragma unroll 1
        for (int g = 0; g < 3; ++g) { const int dl = (g == 0) ? 1 : (g == 1 ? 4 : 16);
            int nk = t / dl; if (nk > 128) nk = 128;
#pragma unroll 2
            for (int j = 0; j <= nk; ++j) { const size_t mk = (size_t)(m - j * dl);
                const float kv = bf2f(P[mk * PROJW + COL_K + h * 64 + lane_]); const float vv = bf2f(P[mk * PROJW + COL_VA + h * 64 + lane_]);
                const float s = wave_sum(q * kv);
                const float mn = fmaxf(mx, s), f = __builtin_amdgcn_exp2f(mx - mn), p = __builtin_amdgcn_exp2f(s - mn);
                den = den * f + p; o = o * f + p * vv; mx = mn; } }
        MIX[(size_t)m * D + AW + h * 64 + lane_] = (bf16)f2bf(o / den);
    }
}

typedef float f32x16 __attribute__((ext_vector_type(16)));
typedef short v4i16_t __attribute__((ext_vector_type(4)));
DI int crow16(int r, int hi) { return (r & 3) + 8 * (r >> 2) + 4 * hi; }
template <int SUB> DI void mix_attn_mfma(Frame& F, int l) {
    FRAME_IDS
    const bf16* P = (const bf16*)(F.ws + WS_PROJ);
    LAS unsigned char* Ks = F.lds + RING_OFF; LAS unsigned char* Vs = Ks + 49152;
    LAS unsigned char* St = F.lds + ATT_STAGE_OFF + wave_ * 4608;
    const int ql = lane_ & 31, hi = lane_ >> 5, prow = lane_ >> 3, pch = lane_ & 7;
    constexpr int nitems = SUB == 0 ? 2048 : 1024;
    v4u kreg[6], vreg[6], qraw[4]; bf16x8 qf[4];
    int it = F.vcu; if (it >= nitems) return;
    int d, r, s0, b, h; size_t tokbase;
#define ATT_DECODE(IT) do { const int idx_ = (IT) & 1023; b = idx_ >> 7; h = (idx_ >> 4) & 7; int tile_; \
        if (SUB == 1) { d = 1; r = 0; tile_ = idx_ & 15; } else if ((IT) < 1024) { d = 16; r = idx_ & 15; tile_ = 0; } else { d = 4; r = (idx_ >> 2) & 3; tile_ = idx_ & 3; } \
        s0 = tile_ * 256; tokbase = (size_t)b * T + r; } while (0)
#define ATT_LOAD() do { const int tl_ = ftid(); _Pragma("unroll") for (int i = 0; i < 6; ++i) { const int idx2 = tl_ + 512 * i, row = idx2 >> 3, ch = idx2 & 7, step = s0 - 128 + row; \
            if (step >= 0) { const bf16* src = P + (tokbase + (size_t)step * d) * PROJW + h * 64 + ch * 8; kreg[i] = *(const v4u*)(src + COL_K); vreg[i] = *(const v4u*)(src + COL_VA); } \
            else { kreg[i] = (v4u){0u, 0u, 0u, 0u}; vreg[i] = (v4u){0u, 0u, 0u, 0u}; } } \
        _Pragma("unroll") for (int p = 0; p < 4; ++p) qraw[p] = *(const v4u*)(P + (tokbase + (size_t)(s0 + 32 * wave_ + 8 * p + prow) * d) * PROJW + COL_Q + h * 64 + pch * 8); } while (0)
#define ATT_WRITE() do { const int tw_ = ftid(); _Pragma("unroll") for (int i = 0; i < 6; ++i) { const int idx2 = tw_ + 512 * i, row = idx2 >> 3, ch = idx2 & 7; \
            *(LAS v4u*)(Ks + row * 128 + ((ch ^ ((row >> 1) & 7)) << 4)) = kreg[i]; \
            *(LAS v4u*)(Vs + row * 128 + ((ch ^ (((row >> 1) & 1) << 2)) << 4)) = vreg[i]; } \
        _Pragma("unroll") for (int p = 0; p < 4; ++p) *(LAS v4u*)(St + (8 * p + prow) * 144 + pch * 16) = qraw[p]; } while (0)
    ATT_DECODE(it); ATT_LOAD(); ATT_WRITE();
    __syncthreads();
    for (;;) {
        const size_t tb = tokbase; const int s0c = s0, dc = d, hcur = h, itcur = it;
        const bool first = (s0 == 0);
#pragma unroll
        for (int ks = 0; ks < 4; ++ks) qf[ks] = *(const LAS bf16x8*)(St + ql * 144 + (2 * ks + hi) * 16);
        const int itn = it + F.G; const bool has_next = itn < nitems;
        if (has_next) { ATT_DECODE(itn); ATT_LOAD(); }
        const int i0 = 32 * wave_;
        f32x16 S[5];
#pragma unroll
        for (int kb = 0; kb < 5; ++kb) { f32x16 acc;
#pragma unroll
            for (int i = 0; i < 16; ++i) acc[i] = 0.f;
            const int krow = i0 + 32 * kb + ql;
#pragma unroll
            for (int ks = 0; ks < 4; ++ks) { const bf16x8 a = *(const LAS bf16x8*)(Ks + krow * 128 + (((2 * ks + hi) ^ ((krow >> 1) & 7)) << 4)); acc = __builtin_amdgcn_mfma_f32_32x32x16_bf16(a, qf[ks], acc, 0, 0, 0); }
            S[kb] = acc; }
        int qrel = ql - 4 * hi; asm volatile("" : "+v"(qrel));
        float mx = -1e30f;
#pragma unroll
        for (int kb = 0; kb < 5; ++kb) {
            const bool bvalid = !first || (wave_ + kb >= 4);
            if (!bvalid) {
#pragma unroll
                for (int i = 0; i < 16; ++i) S[kb][i] = -1e30f;
            } else {
#pragma unroll
                for (int i = 0; i < 16; ++i) { const int c0 = crow16(i, 0); float v = S[kb][i];
                    if (kb == 0) v = (c0 >= qrel) ? v : -1e30f;
                    if (kb == 4) v = (c0 <= qrel) ? v : -1e30f;
                    S[kb][i] = v; mx = fmaxf(mx, v); }
            }
        }
        mx = fmaxf(mx, __shfl_xor(mx, 32));
        float lsum = 0.f;
#pragma unroll
        for (int kb = 0; kb < 5; ++kb)
#pragma unroll
            for (int i = 0; i < 16; ++i) { const float p = __builtin_amdgcn_exp2f(S[kb][i] - mx); S[kb][i] = p; lsum += p; }
        lsum += __shfl_xor(lsum, 32);
        v4u x16[4], x4[4]; f32x2_t s16 = {0.f, 0.f}, s4 = {0.f, 0.f};
        if (SUB == 1) {
            const size_t qt = tb + (size_t)(s0c + i0 + ql) * dc;
            s16 = *(const f32x2_t*)((const float*)(F.ws + WS_STAT) + (qt * NH + hcur) * 2); s4 = *(const f32x2_t*)((const float*)(F.ws + WS_STAT) + (size_t)M * NH * 2 + (qt * NH + hcur) * 2);
        }
        f32x16 O[2];
#pragma unroll
        for (int i = 0; i < 16; ++i) { O[0][i] = 0.f; O[1][i] = 0.f; }
        const int trq = (lane_ & 15) >> 2, trg = (lane_ >> 4) & 1, trp = lane_ & 3;
#pragma unroll
        for (int kb = 0; kb < 5; ++kb)
#pragma unroll
            for (int s = 0; s < 2; ++s) {
                if (SUB == 1 && kb == 2 && s == 0) {
#pragma unroll
                    for (int p = 0; p < 4; ++p) { const size_t rt = tb + (size_t)(s0c + i0 + 8 * p + prow) * dc; const bf16* pp = (const bf16*)(F.ws + WS_XN) + rt * BW + hcur * 64 + pch * 8;
                        x16[p] = *(const v4u*)pp; x4[p] = *(const v4u*)(pp + (size_t)M * BW); } }
                v4u pw; pw.x = cvtpk(S[kb][8 * s], S[kb][8 * s + 1]); pw.y = cvtpk(S[kb][8 * s + 2], S[kb][8 * s + 3]); pw.z = cvtpk(S[kb][8 * s + 4], S[kb][8 * s + 5]); pw.w = cvtpk(S[kb][8 * s + 6], S[kb][8 * s + 7]);
                const bf16x8 pb = __builtin_bit_cast(bf16x8, pw);
                const int rlo = i0 + 32 * kb + 16 * s + 4 * hi + trq, rhi = rlo + 8;
#pragma unroll
                for (int dh = 0; dh < 2; ++dh) { const int chunk = 4 * dh + 2 * trg + (trp >> 1);
                    const v4i16_t lo = __builtin_amdgcn_ds_read_tr16_b64_v4i16((LAS v4i16_t*)(Vs + rlo * 128 + ((chunk ^ (((rlo >> 1) & 1) << 2)) << 4) + 8 * (trp & 1)));
                    const v4i16_t hh = __builtin_amdgcn_ds_read_tr16_b64_v4i16((LAS v4i16_t*)(Vs + rhi * 128 + ((chunk ^ (((rhi >> 1) & 1) << 2)) << 4) + 8 * (trp & 1)));
                    const bf16x8 va = (bf16x8){lo[0], lo[1], lo[2], lo[3], hh[0], hh[1], hh[2], hh[3]};
                    O[dh] = __builtin_amdgcn_mfma_f32_32x32x16_bf16(va, pb, O[dh], 0, 0, 0); } }
        float osc;
        if (SUB == 0) osc = 1.0f / lsum;
        else { const float MM = fmaxf(mx, fmaxf(s16.x, s4.x)), a1 = __builtin_amdgcn_exp2f(mx - MM), a16 = s16.y * __builtin_amdgcn_exp2f(s16.x - MM), a4 = s4.y * __builtin_amdgcn_exp2f(s4.x - MM);
            const float inv = 1.0f / (lsum * a1 + a16 + a4); osc = a1 * inv;
            if (hi == 0) { f32x2_t cc = {a16 * inv, a4 * inv}; *(LAS f32x2_t*)(St + ql * 144 + 128) = cc; } }
#pragma unroll
        for (int dh = 0; dh < 2; ++dh)
#pragma unroll
            for (int g4 = 0; g4 < 4; ++g4) { v2u w; w.x = cvtpk(O[dh][4 * g4] * osc, O[dh][4 * g4 + 1] * osc); w.y = cvtpk(O[dh][4 * g4 + 2] * osc, O[dh][4 * g4 + 3] * osc);
                *(LAS v2u*)(St + ql * 144 + (32 * dh + 8 * g4 + 4 * hi) * 2) = w; }
        if (SUB == 0) {
            bf16* PART = (bf16*)(F.ws + WS_XN) + (itcur < 1024 ? 0 : (size_t)M * BW); float* ST = (float*)(F.ws + WS_STAT) + (itcur < 1024 ? 0 : (size_t)M * NH * 2);
            if (hi == 0) { const size_t qt = tb + (size_t)(s0c + i0 + ql) * dc; f32x2_t st = {mx, lsum}; *(f32x2_t*)(ST + (qt * NH + hcur) * 2) = st; }
#pragma unroll
            for (int p = 0; p < 4; ++p) { const size_t rt = tb + (size_t)(s0c + i0 + 8 * p + prow) * dc;
                *(v4u*)(PART + rt * BW + hcur * 64 + pch * 8) = *(const LAS v4u*)(St + (8 * p + prow) * 144 + pch * 16); }
        } else {
#pragma unroll
            for (int p = 0; p < 4; ++p) { const size_t rt = tb + (size_t)(s0c + i0 + 8 * p + prow) * dc;
                const v4u ov = *(const LAS v4u*)(St + (8 * p + prow) * 144 + pch * 16); const f32x2_t cc = *(const LAS f32x2_t*)(St + (8 * p + prow) * 144 + 128);
                v4u o;
                o.x = cvtpk(bflo(ov.x) + cc.x * bflo(x16[p].x) + cc.y * bflo(x4[p].x), bfhi(ov.x) + cc.x * bfhi(x16[p].x) + cc.y * bfhi(x4[p].x));
                o.y = cvtpk(bflo(ov.y) + cc.x * bflo(x16[p].y) + cc.y * bflo(x4[p].y), bfhi(ov.y) + cc.x * bfhi(x16[p].y) + cc.y * bfhi(x4[p].y));
                o.z = cvtpk(bflo(ov.z) + cc.x * bflo(x16[p].z) + cc.y * bflo(x4[p].z), bfhi(ov.z) + cc.x * bfhi(x16[p].z) + cc.y * bfhi(x4[p].z));
                o.w = cvtpk(bflo(ov.w) + cc.x * bflo(x16[p].w) + cc.y * bflo(x4[p].w), bfhi(ov.w) + cc.x * bfhi(x16[p].w) + cc.y * bfhi(x4[p].w));
                *(v4u*)((bf16*)(F.ws + WS_MIXCAT) + rt * D + AW + hcur * 64 + pch * 8) = o; }
        }
        __syncthreads();
        if (!has_next) break;
        ATT_WRITE(); it = itn;
        __syncthreads();
    }
#undef ATT_DECODE
#undef ATT_LOAD
#undef ATT_WRITE
}
typedef float f32x4_t __attribute__((ext_vector_type(4)));
DI void cmul_acc(float& xr, float& xi, float ar, float ai, float br, float bi) { const float nr = ar * xr - ai * xi + br, ni = ar * xi + ai * xr + bi; xr = nr; xi = ni; }
DI void mix_ssm_in(Frame& F, int l) {
    FRAME_IDS
    const bf16* P = (const bf16*)(F.ws + WS_PROJ);
    const bf16* WIN = (const bf16*)(F.ws + WS_SSM2 + l * SSM2_LAYER + S2_WIN);
    const float* apw = (const float*)(F.ws + WS_SSM2 + l * SSM2_LAYER + S2_APW);
    float* XLOC = (float*)(F.ws + WS_XLOC); float* XSUP = (float*)(F.ws + WS_XSUP);
    const int row = lane_ & 15, q = lane_ >> 4;
    for (int it = F.vcu; it < 256; it += F.G) {
        const int b = it >> 5, sc = (it >> 2) & 7, g = 4 * (it & 3) + (wave_ >> 1), half = wave_ & 1;
        bf16x8 af[16];
        { const bf16* src = P + ((size_t)b * T + (size_t)(16 * sc + row) * 32 + (q >> 1)) * PROJW + COL_S + g * 16 + 8 * (q & 1);
#pragma unroll
          for (int sp = 0; sp < 16; ++sp) af[sp] = *(const bf16x8*)(src + (size_t)(2 * sp) * PROJW); }
#pragma unroll 1
        for (int c4 = 0; c4 < 4; ++c4) { const int ct = 4 * half + c4;
            f32x4_t acc = {0.f, 0.f, 0.f, 0.f};
            const bf16* wp = WIN + (((size_t)(g * 16) * 8 + ct) * 64 + lane_) * 8;
#pragma unroll
            for (int sp = 0; sp < 16; ++sp) { const bf16x8 bfr = *(const bf16x8*)(wp + (size_t)sp * 8 * 64 * 8); acc = __builtin_amdgcn_mfma_f32_16x16x32_bf16(af[sp], bfr, acc, 0, 0, 0); }
            const int comp = 16 * ct + row, n = comp >> 1, part = comp & 1;
#pragma unroll
            for (int r = 0; r < 4; ++r) XLOC[(((size_t)b * 128 + 16 * sc + 4 * q + r) * 16 + g) * 128 + comp] = acc[r];
            const float a32r = apw[((g * 33 + 32) * 64 + n) * 2], a32i = apw[((g * 33 + 32) * 64 + n) * 2 + 1];
            const float sg = part ? 1.f : -1.f;
            float h = acc[0];
#pragma unroll
            for (int r = 1; r < 4; ++r) { const float o = __shfl_xor(h, 1); h = a32r * h + sg * a32i * o + acc[r]; }
            float p64r = a32r * a32r - a32i * a32i, p64i = 2.f * a32r * a32i;
            float p128r = p64r * p64r - p64i * p64i, p128i = 2.f * p64r * p64i;
            float wr = 1.f, wi = 0.f;
            for (int k = 0; k < 3 - q; ++k) { const float t0 = wr * p128r - wi * p128i, t1 = wr * p128i + wi * p128r; wr = t0; wi = t1; }
            { const float o = __shfl_xor(h, 1); h = wr * h + sg * wi * o; }
            h += __shfl_xor(h, 16); h += __shfl_xor(h, 32);
            if (q == 0) XSUP[(((size_t)b * 8 + sc) * 16 + g) * 128 + comp] = h;
        }
    }
}
DI void mix_ssm_out(Frame& F, const Args& A, int l) {
    FRAME_IDS
    const bf16* P = (const bf16*)(F.ws + WS_PROJ); bf16* YG = (bf16*)(F.ws + WS_YG);
    const bf16* KT = (const bf16*)(F.ws + WS_SSM2 + l * SSM2_LAYER + S2_KT); const bf16* CT = (const bf16*)(F.ws + WS_SSM2 + l * SSM2_LAYER + S2_CT);
    const float* apw = (const float*)(F.ws + WS_SSM2 + l * SSM2_LAYER + S2_APW);
    const float* XLOC = (const float*)(F.ws + WS_XLOC); const float* XSUP = (const float*)(F.ws + WS_XSUP);
    LAS unsigned char* Ut = F.lds + RING_OFF + wave_ * 4096;
    LAS float* Xs = (LAS float*)(F.lds + RING_OFF + wave_ * 4096 + 2048);
    for (int i = lane_; i < 256; i += 64) ((LAS unsigned*)Ut)[i] = 0u;
    const int row = lane_ & 15, q = lane_ >> 4;
    for (int it = F.vcu; it < 256; it += F.G) {
        const int b = it >> 5, sc = (it >> 2) & 7, g = 4 * (it & 3) + (wave_ >> 1), half = wave_ & 1, n = lane_;
        const size_t tokA = (size_t)b * T + (size_t)(16 * sc + 8 * half) * 32;
        v4u unext = *(const v4u*)(P + (tokA + (lane_ >> 1)) * PROJW + COL_S + g * 16 + 8 * (lane_ & 1));
        f32x2_t psup[8], ploc[8];
#pragma unroll
        for (int s2 = 0; s2 < 8; ++s2) { psup[s2] = (f32x2_t){0.f, 0.f}; if (s2 < sc) psup[s2] = *(const f32x2_t*)(XSUP + (((size_t)b * 8 + s2) * 16 + g) * 128 + 2 * n); }
#pragma unroll
        for (int k2 = 0; k2 < 8; ++k2) { ploc[k2] = (f32x2_t){0.f, 0.f}; if (half) ploc[k2] = *(const f32x2_t*)(XLOC + (((size_t)b * 128 + 16 * sc + k2) * 16 + g) * 128 + 2 * n); }
        const float dsk = ((const float*)A.in[I_SSMD])[(l * 16 + g) * 16 + row];
        const float a32r = apw[((g * 33 + 32) * 64 + n) * 2], a32i = apw[((g * 33 + 32) * 64 + n) * 2 + 1];
        const float a16r = apw[((g * 33 + 16) * 64 + n) * 2], a16i = apw[((g * 33 + 16) * 64 + n) * 2 + 1];
        float a512r = a32r, a512i = a32i;
#pragma unroll
        for (int k = 0; k < 4; ++k) { const float t0 = a512r * a512r - a512i * a512i, t1 = 2.f * a512r * a512i; a512r = t0; a512i = t1; }
        float xr = 0.f, xi = 0.f;
#pragma unroll
        for (int s2 = 0; s2 < 8; ++s2) if (s2 < sc) cmul_acc(xr, xi, a512r, a512i, psup[s2].x, psup[s2].y);
        if (half) {
#pragma unroll
            for (int k2 = 0; k2 < 8; ++k2) cmul_acc(xr, xi, a32r, a32i, ploc[k2].x, ploc[k2].y); }
        asm volatile("" : "+v"(xr), "+v"(xi) :: "memory");
        bf16x8 kt[16], ctf[4];
#pragma unroll
        for (int p = 0; p < 16; ++p) kt[p] = *(const bf16x8*)(KT + ((size_t)(g * 16 + p) * 64 + lane_) * 8);
#pragma unroll
        for (int sx = 0; sx < 4; ++sx) ctf[sx] = *(const bf16x8*)(CT + ((size_t)(g * 4 + sx) * 64 + lane_) * 8);
        f32x4_t apr[4][2];
#pragma unroll
        for (int sx = 0; sx < 4; ++sx) { const f32x4_t* ap = (const f32x4_t*)(apw + ((size_t)(g * 33 + row + 1) * 64 + 16 * sx + 4 * q) * 2); apr[sx][0] = ap[0]; apr[sx][1] = ap[1]; }
#pragma unroll 1
        for (int kk = 0; kk < 8; ++kk) {
            const size_t tok0 = tokA + (size_t)kk * 32;
            const f32x2_t xl = *(const f32x2_t*)(XLOC + (((size_t)b * 128 + 16 * sc + 8 * half + kk) * 16 + g) * 128 + 2 * n);
            *(LAS v4u*)(Ut + 1024 + lane_ * 16) = unext;
            if (kk < 7) unext = *(const v4u*)(P + (tok0 + 32 + (lane_ >> 1)) * PROJW + COL_S + g * 16 + 8 * (lane_ & 1));
            Xs[2 * n] = xr; Xs[2 * n + 1] = xi; Xs[128 + 2 * n] = a16r * xr - a16i * xi; Xs[128 + 2 * n + 1] = a16r * xi + a16i * xr;
#pragma unroll
            for (int tau = 0; tau < 2; ++tau) { f32x4_t acc = (f32x4_t){0.f, 0.f, 0.f, 0.f};
                const int ti = 16 * tau + row;
#pragma unroll
                for (int sx = 0; sx < 4; ++sx) { const LAS f32x4_t* xp = (const LAS f32x4_t*)(Xs + 128 * tau + 2 * (16 * sx + 4 * q)); const f32x4_t x01 = xp[0], x23 = xp[1];
                    const f32x4_t a01 = apr[sx][0], a23 = apr[sx][1];
                    v4u zw; zw.x = cvtpk(a01.x * x01.x - a01.y * x01.y, a01.x * x01.y + a01.y * x01.x); zw.y = cvtpk(a01.z * x01.z - a01.w * x01.w, a01.z * x01.w + a01.w * x01.z);
                    zw.z = cvtpk(a23.x * x23.x - a23.y * x23.y, a23.x * x23.y + a23.y * x23.x); zw.w = cvtpk(a23.z * x23.z - a23.w * x23.w, a23.z * x23.w + a23.w * x23.z);
                    acc = __builtin_amdgcn_mfma_f32_16x16x32_bf16(__builtin_bit_cast(bf16x8, zw), ctf[sx], acc, 0, 0, 0);
                    asm volatile("" ::: "memory"); }
#pragma unroll
                for (int p = 0; p < 16; ++p) if (p < 8 * tau + 8) { const bf16x8 ua = *(const LAS bf16x8*)(Ut + (32 + ti - 2 * p - (q >> 1)) * 32 + 16 * (q & 1));
                    acc = __builtin_amdgcn_mfma_f32_16x16x32_bf16(ua, kt[p], acc, 0, 0, 0); if ((p & 3) == 3) asm volatile("" ::: "memory"); }
#pragma unroll
                for (int r = 0; r < 4; ++r) { const int t2 = 16 * tau + 4 * q + r; const float uu = bf2f(*(const LAS bf16*)(Ut + (32 + t2) * 32 + 2 * row));
                    YG[(tok0 + t2) * 256 + g * 16 + row] = (bf16)f2bf(gelu_tanh_f(acc[r] + dsk * uu)); }
            }
            cmul_acc(xr, xi, a32r, a32i, xl.x, xl.y);
        }
    }
}
DI void mix_gating_mfma(Frame& F, const Args& A, int l, int variant = 0) {
    FRAME_IDS
    const bf16* P = (const bf16*)(F.ws + WS_PROJ); bf16* MIX = (bf16*)(F.ws + WS_MIXCAT);
    const bf16* GW = (const bf16*)(F.ws + WS_SSM2 + l * SSM2_LAYER + S2_GW);
    const float* lng = (const float*)A.in[I_GMLNG] + l * AW; const float* lnb = (const float*)A.in[I_GMLNB] + l * AW;
    const float* bs_ = (const float*)A.in[I_GMBS] + l * 4 * 128;
    LAS unsigned char* VT = F.lds + RING_OFF;
    const int ql = lane_ & 31, hi = lane_ >> 5, trq = (lane_ & 15) >> 2, trg = (lane_ >> 4) & 1, trp = lane_ & 3;
    for (int it = F.vcu; it < BATCH * (T / 128); it += F.G) {
        const int m0 = it * 128;
        __syncthreads();
        if (variant != 2) {
        v2u wv[16];
#pragma unroll
        for (int j = 0; j < 16; ++j) wv[j] = *(const v2u*)(P + (size_t)(m0 + wave_ + 8 * j) * PROJW + COL_V + 4 * lane_);
        const f32x4 gg = *(const f32x4*)(lng + 4 * lane_), bb = *(const f32x4*)(lnb + 4 * lane_);
#pragma unroll
        for (int j = 0; j < 16; ++j) { const int r = wave_ + 8 * j; const v2u w = wv[j];
            float v[4] = {gelu_tanh_f(bflo(w.x)), gelu_tanh_f(bfhi(w.x)), gelu_tanh_f(bflo(w.y)), gelu_tanh_f(bfhi(w.y))};
            const float mean = wave_sum(v[0] + v[1] + v[2] + v[3]) * (1.f / 256.f);
            float s2 = 0.f;
#pragma unroll
            for (int i = 0; i < 4; ++i) { v[i] -= mean; s2 += v[i] * v[i]; }
            const float rstd = 1.0f / sqrtf(wave_sum(s2) * (1.f / 256.f) + LN_EPS);
            v2u o; o.x = cvtpk(v[0] * rstd * gg.x + bb.x, v[1] * rstd * gg.y + bb.y); o.y = cvtpk(v[2] * rstd * gg.z + bb.z, v[3] * rstd * gg.w + bb.w);
            *(LAS v2u*)(VT + r * 512 + (((lane_ >> 1) ^ ((r & 3) << 2)) << 4) + 8 * (lane_ & 1)) = o;
        }
        }
        __syncthreads();
        if (variant == 1) continue;
        const int h = wave_ >> 1, cb = 64 * h + 32 * (wave_ & 1);
        const int chunk = (cb >> 3) + 2 * trg + (trp >> 1);
#pragma unroll
        for (int rt = 0; rt < 4; ++rt) {
            f32x16 acc;
#pragma unroll
            for (int i = 0; i < 16; ++i) acc[i] = 0.f;
            bf16x8 wa[8];
#pragma unroll
            for (int ks = 0; ks < 2 * rt + 2; ++ks) wa[ks] = *(const bf16x8*)(GW + (size_t)(h * 128 + 32 * rt) * 128 + 16 * ks + (unsigned)(ql * 128 + 8 * hi));
#pragma unroll
            for (int ks = 0; ks < 2 * rt + 2; ++ks) {
                const int rlo = 16 * ks + 8 * hi + trq;
                const v4i16_t lo = __builtin_amdgcn_ds_read_tr16_b64_v4i16((LAS v4i16_t*)(VT + rlo * 512 + ((chunk ^ (trq << 2)) << 4) + 8 * (trp & 1)));
                const v4i16_t hh = __builtin_amdgcn_ds_read_tr16_b64_v4i16((LAS v4i16_t*)(VT + (rlo + 4) * 512 + ((chunk ^ (trq << 2)) << 4) + 8 * (trp & 1)));
                const bf16x8 va = (bf16x8){lo[0], lo[1], lo[2], lo[3], hh[0], hh[1], hh[2], hh[3]};
                acc = __builtin_amdgcn_mfma_f32_32x32x16_bf16(va, wa[ks], acc, 0, 0, 0); }
            { const int t = 32 * rt + ql; const float bsv = bs_[h * 128 + t];
              const bf16* up = P + (size_t)(m0 + t) * PROJW + COL_U + cb + 4 * hi; bf16* op = MIX + (size_t)(m0 + t) * D + cb + 4 * hi;
#pragma unroll
              for (int g4 = 0; g4 < 4; ++g4) { const v2u uw = *(const v2u*)(up + 8 * g4); v2u o;
                  o.x = cvtpk(gelu_tanh_f(bflo(uw.x)) * (acc[4 * g4] + bsv), gelu_tanh_f(bfhi(uw.x)) * (acc[4 * g4 + 1] + bsv)); o.y = cvtpk(gelu_tanh_f(bflo(uw.y)) * (acc[4 * g4 + 2] + bsv), gelu_tanh_f(bfhi(uw.y)) * (acc[4 * g4 + 3] + bsv));
                  *(v2u*)(op + 8 * g4) = o; } }
        }
    }
}

DI void p_glu(Frame& F, const Args& A, int l) {
    FRAME_IDS
    const bf16* YG = (const bf16*)(F.ws + WS_YG); bf16* MIX = (bf16*)(F.ws + WS_MIXCAT);
    const bf16* GluT = (const bf16*)(F.ws + WS_WSMALL + l * WSMALL_LAYER + WOFF_GLU); const float* gb = (const float*)A.in[I_GLUB] + l * 256;
    LAS unsigned char* Bs = F.lds + RING_OFF;
#pragma unroll
    for (int i = 0; i < 16; ++i) { const int idx = tid_ + 512 * i, n = idx >> 5, ch = idx & 31;
        *(LAS v4u*)(Bs + n * 512 + ((ch ^ (n & 15)) << 4)) = *(const v4u*)(GluT + (size_t)n * 256 + ch * 8); }
    __syncthreads();
    const int tk = lane_ & 15, q = lane_ >> 4;
    for (int rt = F.vcu; rt < M / 128; rt += F.G) {
        const size_t tok = (size_t)rt * 128 + wave_ * 16 + tk;
        bf16x8 yf[8];
#pragma unroll
        for (int ks = 0; ks < 8; ++ks) yf[ks] = *(const bf16x8*)(YG + tok * 256 + 32 * ks + 8 * q);
#pragma unroll 4
        for (int ct = 0; ct < 16; ++ct) {
            f32x4_t acc = {0.f, 0.f, 0.f, 0.f};
            const int n = 16 * ct + tk;
#pragma unroll
            for (int ks = 0; ks < 8; ++ks) { const bf16x8 wf = *(const LAS bf16x8*)(Bs + n * 512 + (((4 * ks + q) ^ (n & 15)) << 4));
                acc = __builtin_amdgcn_mfma_f32_16x16x32_bf16(wf, yf[ks], acc, 0, 0, 0); }
            const int n0 = 16 * ct + 4 * q; const v2u yw = *(const v2u*)(YG + tok * 256 + n0); const f32x4 bv = *(const f32x4*)(gb + n0);
            v2u o; o.x = cvtpk(bflo(yw.x) * sigmoid_f(acc[0] + bv.x), bfhi(yw.x) * sigmoid_f(acc[1] + bv.y)); o.y = cvtpk(bflo(yw.y) * sigmoid_f(acc[2] + bv.z), bfhi(yw.y) * sigmoid_f(acc[3] + bv.w));
            *(v2u*)(MIX + tok * D + 768 + n0) = o;
        }
    }
}
DI void mix_ssm_simple(Frame& F, const Args& A, int l) {
    FRAME_IDS
    const bf16* P = (const bf16*)(F.ws + WS_PROJ); bf16* YG = (bf16*)(F.ws + WS_YG);
    const float* tab = (const float*)(F.ws + WS_SSM) + (size_t)l * SSM_TAB;
    LAS float* fin = (LAS float*)(F.lds + RING_OFF);
    for (int it = F.vcu; it < BATCH * SSM_G; it += F.G) {
        const int b = it >> 4, g = it & 15, n = lane_, seg = wave_, gn = g * 64 + n;
        const float are = tab[gn], aim = tab[1024 + gn];
        float bre[16], bim[16], cre[16], cim[16];
#pragma unroll
        for (int c = 0; c < 16; ++c) { bre[c] = tab[2048 + gn * 16 + c]; bim[c] = tab[2048 + 16384 + gn * 16 + c];
            cre[c] = ((const float*)A.in[I_CRE])[(((size_t)l * 16 + g) * 16 + c) * 64 + n]; cim[c] = ((const float*)A.in[I_CIM])[(((size_t)l * 16 + g) * 16 + c) * 64 + n]; }
        const float dsk = ((const float*)A.in[I_SSMD])[(l * 16 + g) * 16 + (lane_ & 15)];
        const size_t mbase = (size_t)b * T + seg * 512;
        float xr = 0.f, xi = 0.f;
        for (int tt = 0; tt < 512; ++tt) { const v4u* up = (const v4u*)(P + (mbase + tt) * PROJW + COL_S + g * 16); const v4u u0 = up[0], u1 = up[1];
            const float u[16] = {bflo(u0.x), bfhi(u0.x), bflo(u0.y), bfhi(u0.y), bflo(u0.z), bfhi(u0.z), bflo(u0.w), bfhi(u0.w), bflo(u1.x), bfhi(u1.x), bflo(u1.y), bfhi(u1.y), bflo(u1.z), bfhi(u1.z), bflo(u1.w), bfhi(u1.w)};
            float br = 0.f, bi = 0.f;
#pragma unroll
            for (int c = 0; c < 16; ++c) { br += u[c] * bre[c]; bi += u[c] * bim[c]; }
            const float nr = are * xr - aim * xi + br, ni = are * xi + aim * xr + bi; xr = nr; xi = ni; }
        fin[(seg * 64 + n) * 2] = xr; fin[(seg * 64 + n) * 2 + 1] = xi;
        __syncthreads();
        float pr = are, pi = aim;
#pragma unroll
        for (int k = 0; k < 9; ++k) { const float t0 = pr * pr - pi * pi, t1 = 2.f * pr * pi; pr = t0; pi = t1; }
        xr = 0.f; xi = 0.f;
        for (int s = 0; s < seg; ++s) { const float fr_ = fin[(s * 64 + n) * 2], fi_ = fin[(s * 64 + n) * 2 + 1];
            const float nr = pr * xr - pi * xi + fr_, ni = pr * xi + pi * xr + fi_; xr = nr; xi = ni; }
        for (int tt = 0; tt < 512; ++tt) { const v4u* up = (const v4u*)(P + (mbase + tt) * PROJW + COL_S + g * 16); const v4u u0 = up[0], u1 = up[1];
            const float u[16] = {bflo(u0.x), bfhi(u0.x), bflo(u0.y), bfhi(u0.y), bflo(u0.z), bfhi(u0.z), bflo(u0.w), bfhi(u0.w), bflo(u1.x), bfhi(u1.x), bflo(u1.y), bfhi(u1.y), bflo(u1.z), bfhi(u1.z), bflo(u1.w), bfhi(u1.w)};
            float br = 0.f, bi = 0.f;
#pragma unroll
            for (int c = 0; c < 16; ++c) { br += u[c] * bre[c]; bi += u[c] * bim[c]; }
            const float nr = are * xr - aim * xi + br, ni = are * xi + aim * xr + bi; xr = nr; xi = ni;
            float ysel = 0.f, usel = 0.f;
#pragma unroll
            for (int c = 0; c < 16; ++c) { const float r = wave_sum(xr * cre[c] - xi * cim[c]); if ((lane_ & 15) == c) { ysel = r; usel = u[c]; } }
            if (lane_ < 16) { const float y = ysel + dsk * usel; YG[(mbase + tt) * 256 + g * 16 + lane_] = (bf16)f2bf(gelu_tanh_f(y)); } }
        __syncthreads();
    }
}

DI bool beats(float x, int i, float y, int j) { return x > y || (x == y && i < j); }
DI void p_row_b(Frame& F, const Args& A, int l, bool count = true) {
    FRAME_IDS
    const int gw = F.vcu * NWAVES + wave_, NGW = F.G * NWAVES;
    const bf16* PRE = (const bf16*)(F.ws + WS_PRE); bf16* X1 = (bf16*)(F.ws + WS_X1); bf16* XN = (bf16*)(F.ws + WS_XN);
    const float* mod = (const float*)(F.ws + WS_MOD) + (size_t)l * BATCH * 6 * D;
    const float* ln1g = (const float*)A.in[I_LN1G] + l * D; const float* ln1b = (const float*)A.in[I_LN1B] + l * D;
    const float* rw = (const float*)A.in[I_RW]; const float* rb = (const float*)A.in[I_RB];
    int* slot_a = (int*)(F.ws + WS_SLOT_A); float* slot_w = (float*)(F.ws + WS_SLOT_W);
    LAS float* rwS = (LAS float*)(F.lds + RING_OFF);
    volatile LAS unsigned* lcnt = (volatile LAS unsigned*)(F.lds + RING_OFF + 65536);
    LAS int* list_a = (LAS int*)(F.lds + RING_OFF + 66048); LAS float* list_w = (LAS float*)(F.lds + RING_OFF + 66048 + 8192);
    for (int i = tid_; i < D * NEXP; i += NTHR) rwS[(i & 15) * D + (i >> 4)] = rw[i];
    if (tid_ < 32) lcnt[tid_] = 0u;
    __syncthreads();
    const int hi5 = lane_ >> 5, b4 = (lane_ >> 4) & 1, b3 = (lane_ >> 3) & 1, b2 = (lane_ >> 2) & 1, emine = 8 * hi5 + 4 * b4 + 2 * b3 + b2;
    const int wi = 2 * b3 + b2, mygrp = 2 * hi5 + b4;
    const float rbm = rb[emine];
    Row16 lg1, lb1; row_load_f32(lg1, ln1g, lane_); row_load_f32(lb1, ln1b, lane_);
    v2u nraw[4];
    const int bq = gw / (NGW / BATCH), mbase = bq * T + gw % (NGW / BATCH), mstep = NGW / BATCH;
    const float* md = mod + (size_t)bq * 6 * D;
    Row16 msc, msh; row_load_f32(msc, md + 4 * D, lane_); row_load_f32(msh, md + 3 * D, lane_);
    { const v2u* q = (const v2u*)(PRE + (size_t)mbase * D);
#pragma unroll
      for (int k = 0; k < 4; ++k) nraw[k] = q[k * 64 + lane_]; }
    for (int m = mbase; m < (bq + 1) * T; m += mstep) {
        Row16 r;
#pragma unroll
        for (int k = 0; k < 4; ++k) { r.v[4 * k] = bflo(nraw[k].x); r.v[4 * k + 1] = bfhi(nraw[k].x); r.v[4 * k + 2] = bflo(nraw[k].y); r.v[4 * k + 3] = bfhi(nraw[k].y); }
        if (m + mstep < (bq + 1) * T) { const v2u* q = (const v2u*)(PRE + (size_t)(m + mstep) * D);
#pragma unroll
            for (int k = 0; k < 4; ++k) nraw[k] = q[k * 64 + lane_]; }
        row_ln(r);
#pragma unroll
        for (int i = 0; i < 16; ++i) r.v[i] = r.v[i] * lg1.v[i] + lb1.v[i];
        row_ln(r);
#pragma unroll
        for (int i = 0; i < 16; ++i) r.v[i] = r.v[i] * (1.0f + msc.v[i]) + msh.v[i];
        unsigned ib;
        { float am = 0.f;
#pragma unroll
          for (int i = 0; i < 16; ++i) am = fmaxf(am, fabsf(r.v[i]));
          am = wave_max(am); ib = (am > 1e-30f) ? ((__float_as_uint(am * (1.0f / 440.0f)) + 0xffffu) & 0xffff0000u) : 0x3f800000u;
          const float qs = 1.0f / __uint_as_float(ib);
          unsigned* q8 = (unsigned*)((unsigned char*)XN + (size_t)m * D);
#pragma unroll
          for (int k = 0; k < 4; ++k) q8[k * 64 + lane_] = pk4_fp8(r.v[4 * k] * qs, r.v[4 * k + 1] * qs, r.v[4 * k + 2] * qs, r.v[4 * k + 3] * qs); }
        float lg[16];
#pragma unroll
        for (int e = 0; e < 16; ++e) { float a = 0.f;
#pragma unroll
            for (int k = 0; k < 4; ++k) { const f32x4 w4 = *(const LAS f32x4*)(rwS + e * D + 256 * k + 4 * lane_); a += r.v[4 * k] * w4.x + r.v[4 * k + 1] * w4.y + r.v[4 * k + 2] * w4.z + r.v[4 * k + 3] * w4.w; }
            lg[e] = a; }
        float t8[8], t4[4], t2[2];
#pragma unroll
        for (int i = 0; i < 8; ++i) { const float keep = hi5 ? lg[8 + i] : lg[i], give = hi5 ? lg[i] : lg[8 + i]; t8[i] = keep + __shfl_xor(give, 32); }
#pragma unroll
        for (int i = 0; i < 4; ++i) { const float keep = b4 ? t8[4 + i] : t8[i], give = b4 ? t8[i] : t8[4 + i]; t4[i] = keep + __shfl_xor(give, 16); }
#pragma unroll
        for (int i = 0; i < 2; ++i) { const float keep = b3 ? t4[2 + i] : t4[i], give = b3 ? t4[i] : t4[2 + i]; t2[i] = keep + __shfl_xor(give, 8); }
        float z = (b2 ? t2[1] : t2[0]) + __shfl_xor(b2 ? t2[0] : t2[1], 4);
        z += __shfl_xor(z, 2); z += __shfl_xor(z, 1);
        const float scm = 1.0f / (1.0f + __builtin_amdgcn_exp2f(-1.4426950408889634f * z)), a = scm + rbm;
        const float p4 = __shfl_xor(a, 4), p8 = __shfl_xor(a, 8), p12 = __shfl_xor(a, 12);
        const float hi01 = fmaxf(a, p4), lo01 = fminf(a, p4), hi23 = fmaxf(p8, p12), lo23 = fminf(p8, p12);
        const float gs = fmaxf(hi01, hi23) + fmaxf(fmaxf(lo01, lo23), fminf(hi01, hi23));
        const float g16 = __shfl_xor(gs, 16), g32 = __shfl_xor(gs, 32), g48 = __shfl_xor(gs, 48);
        const bool best = beats(gs, mygrp, g16, mygrp ^ 1) && beats(gs, mygrp, g32, mygrp ^ 2) && beats(gs, mygrp, g48, mygrp ^ 3);
        const int rank = (beats(p4, wi ^ 1, a, wi) ? 1 : 0) + (beats(p8, wi ^ 2, a, wi) ? 1 : 0) + (beats(p12, wi ^ 3, a, wi) ? 1 : 0);
        const bool sel = best && rank < 2;
        float tot = sel ? scm : 0.f; tot += __shfl_xor(tot, 4); tot += __shfl_xor(tot, 8);
        if (count && sel && (lane_ & 3) == 0) { const unsigned rk = atomicAdd((unsigned*)&lcnt[emine], 1u);
            list_a[emine * 128 + rk] = (int)((unsigned)(2 * m + rank) | ib); list_w[emine * 128 + rk] = scm / tot; }
    }
    __syncthreads();
    if (count) {
        if (tid_ < 16) { const unsigned n = lcnt[tid_]; lcnt[16 + tid_] = n ? atomicAdd((unsigned*)(F.ctl + CW_CNT + l * 128 + tid_), n) : 0u; }
        __syncthreads();
        for (int idx = tid_; idx < 16 * 128; idx += NTHR) { const int e = idx >> 7, rk = idx & 127;
            if (rk < (int)lcnt[e]) { const size_t slot = (size_t)e * SLOT_CAP + lcnt[16 + e] + rk; slot_a[slot] = list_a[idx]; slot_w[slot] = list_w[idx]; } }
    }
}

DI void moe_tstart(Frame& F, int l) {
    FRAME_IDS
    volatile LAS int* ts = (volatile LAS int*)(F.lds + LDSCTL_OFF);
    __syncthreads();
    if (tid_ == 0) { int acc = 0;
        for (int e = 0; e < 16; ++e) { ts[e] = acc; const unsigned c = __hip_atomic_load(F.ctl + CW_CNT + l * 128 + e, RLX_AGENT); ts[32 + e] = (int)c; acc += (int)((c + 255u) >> 8); }
        ts[16] = acc; }
    __syncthreads();
}
DI void p_row_c(Frame& F, const Args& A, int l) {
    FRAME_IDS
    const int gw = F.vcu * NWAVES + wave_, NGW = F.G * NWAVES;
    const bf16* X1 = (const bf16*)(F.ws + WS_PRE); bf16* R2 = (bf16*)(F.ws + WS_ROWS2); bf16* XN = (bf16*)(F.ws + WS_XN);
    const float* ln1g = (const float*)A.in[I_LN1G] + l * D; const float* ln1b = (const float*)A.in[I_LN1B] + l * D;
    Row16 lg1, lb1; row_load_f32(lg1, ln1g, lane_); row_load_f32(lb1, ln1b, lane_);
    const float* mod = (const float*)(F.ws + WS_MOD) + (size_t)l * BATCH * 6 * D;
    const float* modn = (const float*)(F.ws + WS_MOD) + (size_t)(l + 1) * BATCH * 6 * D;
    const float* ln2g = (const float*)A.in[I_LN2G] + l * D; const float* ln2b = (const float*)A.in[I_LN2B] + l * D;
    Row16 lg2, lb2; row_load_f32(lg2, ln2g, lane_); row_load_f32(lb2, ln2b, lane_);
    v2u nx[4], n0[4], n1[4];
#define RC_LOAD(mm) do { const v2u* qa = (const v2u*)(X1 + (size_t)(mm) * D); const v2u* qb = (const v2u*)(R2 + (size_t)(2 * (mm)) * D); \
        _Pragma("unroll") for (int k = 0; k < 4; ++k) { nx[k] = __builtin_nontemporal_load(&qa[k * 64 + lane_]); n0[k] = __builtin_nontemporal_load(&qb[k * 64 + lane_]); n1[k] = __builtin_nontemporal_load(&qb[256 + k * 64 + lane_]); } } while (0)
    const int bq = gw / (NGW / BATCH), mbase = bq * T + gw % (NGW / BATCH), mstep = NGW / BATCH;
    const float* md = mod + (size_t)bq * 6 * D;
    Row16 gm; row_load_f32(gm, md + 5 * D, lane_);
    Row16 msc, msh;
    if (l != DEPTH - 1) { const float* mdn = modn + (size_t)bq * 6 * D; row_load_f32(msc, mdn + 1 * D, lane_); row_load_f32(msh, mdn + 0 * D, lane_); }
    RC_LOAD(mbase);
    for (int m = mbase; m < (bq + 1) * T; m += mstep) {
        Row16 x1, g2;
#pragma unroll
        for (int k = 0; k < 4; ++k) {
            x1.v[4 * k] = bflo(nx[k].x); x1.v[4 * k + 1] = bfhi(nx[k].x); x1.v[4 * k + 2] = bflo(nx[k].y); x1.v[4 * k + 3] = bfhi(nx[k].y);
            g2.v[4 * k] = bflo(n0[k].x) + bflo(n1[k].x); g2.v[4 * k + 1] = bfhi(n0[k].x) + bfhi(n1[k].x); g2.v[4 * k + 2] = bflo(n0[k].y) + bflo(n1[k].y); g2.v[4 * k + 3] = bfhi(n0[k].y) + bfhi(n1[k].y); }
        if (m + mstep < (bq + 1) * T) RC_LOAD(m + mstep);
        row_ln(x1);
#pragma unroll
        for (int i = 0; i < 16; ++i) x1.v[i] = ALPHA * (x1.v[i] * lg1.v[i] + lb1.v[i]) + (1.0f + gm.v[i]) * g2.v[i];
        row_ln(x1);
#pragma unroll
        for (int i = 0; i < 16; ++i) x1.v[i] = x1.v[i] * lg2.v[i] + lb2.v[i];
        if (l == DEPTH - 1) row_store_f32(x1, A.out + (size_t)m * D, lane_);
        else { row_store_bf16(x1, R2 + (size_t)(2 * m) * D, lane_);
            row_ln(x1);
#pragma unroll
            for (int i = 0; i < 16; ++i) x1.v[i] = x1.v[i] * (1.0f + msc.v[i]) + msh.v[i];
            row_store_fp8(x1, (unsigned char*)XN + (size_t)m * D, (float*)(F.ws + WS_SA) + m, lane_); }
    }
#undef RC_LOAD
}

#ifndef PHMASK
#define PHMASK 0xFFFFFFFFu
#endif
#define IN(k) (lo <= (k) && (k) < hi && ((PHMASK >> (((k) == 0) ? 31 : (((k) - 1) % PH_PER_LAYER))) & 1u))
#define SEAM(k) do { if (IN((k) + 1) && MK_ONE_LAUNCH) xcd_barrier(bar); else __syncthreads(); } while (0)
constexpr int PH_PER_LAYER = 9, N_PHASES = 1 + DEPTH * PH_PER_LAYER;
#ifndef REP_PH
#define REP_PH -1
#endif
#define NREP(k) (((k) == REP_PH) ? 2 : 1)
template <int l> DI void layer_body(Frame& F, const Args& args, const XcdBarrier& bar, const int lo, const int hi) {
    unsigned char* ws = args.ws;

        const int pb = 1 + l * PH_PER_LAYER;
        const bf16* WinT = (const bf16*)(ws + WS_WSMALL + l * WSMALL_LAYER + WOFF_IN);
        const bf16* WoutT = (const bf16*)(ws + WS_WSMALL + l * WSMALL_LAYER + WOFF_OUT);
        const bf16* GluT = (const bf16*)(ws + WS_WSMALL + l * WSMALL_LAYER + WOFF_GLU);
        const float* modl = (const float*)(ws + WS_MOD) + (size_t)l * BATCH * 6 * D;
        if (l == 0 && IN(pb + 0)) { p_wconv(F, args, 0, 4); p_wconv(F, args, 1, 4); p_ln_a0(F, args); SEAM(pb + 0); }
        if (IN(pb + 1)) for (int rep_ = 0; rep_ < NREP(1); ++rep_) {
            pg8::Gemm g{(const bf16*)(ws + WS_XN), WinT, M, PROJW, D / 2}; pg8::StaticOrder S; S.init(M, PROJW, F.G, (int)blockIdx.x);
            EpiInProj E{(bf16*)(ws + WS_PROJ), (const float*)(ws + WS_ROPE), args.pad, (const float*)(ws + WS_SA), (const float*)(ws + WS_CINV_IN) + l * PROJW};
            pg8::gemm_phase<EpiInProj, pg8::StaticOrder, PG8_ALIGN, PG8_SP2, true>(F.lds + RING_OFF, g, S, E);
            if (F.G == 256 && blockIdx.x >= 128) { __syncthreads(); p_wconv_gu(F, args, l, 256 + (int)blockIdx.x - 128, 128, WC_NGU); }
            SEAM(pb + 1); }
        if (IN(pb + 2)) for (int rep_ = 0; rep_ < NREP(2); ++rep_) {
#ifndef REP_SUB
#define REP_SUB -1
#endif
#define SUBREP(k) for (int rs_ = 0; rs_ < ((REP_SUB == (k)) ? 2 : 1); ++rs_)
            SUBREP(0) { mix_gating_mfma(F, args, l); __syncthreads(); }
#if REP_SUB >= 10 && REP_SUB < 20
            mix_gating_mfma(F, args, l, REP_SUB - 10); __syncthreads(); mix_gating_mfma(F, args, l); __syncthreads();
#endif
 SUBREP(1) { mix_ssm_in(F, l); } SUBREP(2) { mix_attn_mfma<0>(F, l); __syncthreads(); } SEAM(pb + 2); }
        if (IN(pb + 3)) for (int rep_ = 0; rep_ < NREP(3); ++rep_) { SUBREP(3) { mix_ssm_out(F, args, l); __syncthreads(); } SUBREP(4) { mix_attn_mfma<1>(F, l); __syncthreads(); } SEAM(pb + 3); }
        if (IN(pb + 4)) for (int rep_ = 0; rep_ < NREP(4); ++rep_) { p_glu(F, args, l); SEAM(pb + 4); }
        if (IN(pb + 5)) for (int rep_ = 0; rep_ < NREP(5); ++rep_) {
            pg8::Gemm g{(const bf16*)(ws + WS_MIXCAT), WoutT, M, D, D}; pg8::StaticOrder S; S.init(M, D, F.G, (int)blockIdx.x);
            if (l == 0) { EpiOut<true> E{(bf16*)(ws + WS_PRE), args.in[I_X], D, modl}; pg8::gemm_phase<EpiOut<true>, pg8::StaticOrder, PG8_ALIGN, PG8_SP2>(F.lds + RING_OFF, g, S, E); }
            else { EpiOut<false> E{(bf16*)(ws + WS_PRE), (const void*)(ws + WS_ROWS2), 2 * D, modl}; pg8::gemm_phase<EpiOut<false>, pg8::StaticOrder, PG8_ALIGN, PG8_SP2>(F.lds + RING_OFF, g, S, E); }
            SEAM(pb + 5); }
        if (IN(pb + 6)) { p_row_b(F, args, l); SUBREP(5) { if (REP_SUB == 5 && rs_ == 0) { __syncthreads(); p_row_b(F, args, l, false); } } SEAM(pb + 6); }
        if (IN(pb + 7)) { moe_tstart(F, l);
            gu32* dcnt = F.ctl + CW_DONE + l * 512;
            if (args.pad != 4)
            { pg8::Gemm g{(const bf16*)(ws + WS_XN), (const bf16*)(ws + WS_WGU), NSLOT_MAX, NEXP * 1024, D / 2};
              MoeOrderK<0> S{(const volatile LAS int*)(F.lds + LDSCTL_OFF), F.G, (int)blockIdx.x, (const int*)(ws + WS_SLOT_A), (const float*)(ws + WS_SLOT_W), dcnt, F.ctl + CW_QUEUE + l * 128, (volatile LAS int*)(F.lds + LDSCTL_OFF + 256), nullptr}; EpiG1 E{(unsigned char*)(ws + WS_HID), args.pad, (const float*)(ws + WS_CINV) + (size_t)l * 16 * 2 * 512, (unsigned char*)(ws + WS_HSC)};
              pg8::gemm_phase_g<EpiG1, MoeOrderK<0>, PG8_ALIGN, PG8_SP2, 0, true>(F.lds + RING_OFF, F.lds + GT_OFF, g, S, E); }
            if (args.pad != 3)
            { pg8::Gemm g{(const bf16*)(ws + WS_HID), (const bf16*)(ws + WS_WD), NSLOT_MAX, NEXP * 1024, DEXP / 2};
              MoeOrderK<1> S{(const volatile LAS int*)(F.lds + LDSCTL_OFF), F.G, (int)blockIdx.x, (const int*)(ws + WS_SLOT_A), (const float*)(ws + WS_SLOT_W), dcnt, F.ctl + CW_QUEUE + l * 128, (volatile LAS int*)(F.lds + LDSCTL_OFF + 256), (const unsigned char*)(ws + WS_HSC)}; EpiG2 E{(bf16*)(ws + WS_ROWS2), args.pad, (const float*)(ws + WS_CINV_D) + (size_t)l * NEXP * D};
              pg8::gemm_phase_g<EpiG2, MoeOrderK<1>, PG8_ALIGN, PG8_SP2, 0, true, true>(F.lds + RING_OFF, F.lds + GT_OFF, g, S, E); }
            SEAM(pb + 7); }
        if (IN(pb + 8)) { p_row_c(F, args, l); if (l == 0) { __syncthreads(); p_wconv_dn(F, args, 1, F.vcu, F.G); p_wconv_gu(F, args, 1, F.vcu, F.G, F.G == 256 ? 256 : WC_NGU); } SUBREP(6) { if (REP_SUB == 6 && rs_ == 0 && l == DEPTH - 1) { __syncthreads(); p_row_c(F, args, l); } } SEAM(pb + 8); }
    }
__global__ void __launch_bounds__(NTHR, 2) mk_fwd(Args args) {
    extern __shared__ __attribute__((aligned(16))) unsigned char lds[];
    Frame F;
    F.lds = (LAS unsigned char*)lds; F.MISC = (volatile LAS unsigned*)(F.lds + MISC_OFF);
    F.G = gridDim.x; { const int bx = blockIdx.x; F.vcu = (F.G % 8 == 0) ? (bx % 8) * (F.G / 8) + bx / 8 : bx; }
    F.ws = args.ws; F.ctl = (gu32*)(args.ws + WS_CTL);
    for (int u = ftid(); u < (LDS_BYTES - LDSCTL_OFF) / 4; u += NTHR) ((LAS unsigned*)(F.lds + LDSCTL_OFF))[u] = 0u;
    __syncthreads();
    XcdBarrier bar; bar.bar = (unsigned*)(F.ctl + CW_BAR); bar.x = 0; bar.st = nullptr;
    if (MK_ONE_LAUNCH) bar = xcd_barrier_post((unsigned*)(F.ctl + CW_BAR), F.MISC + 8);
    const int lo = args.ph_lo, hi = args.ph_hi;
    unsigned char* ws = args.ws; (void)ws;
    if (IN(0)) { p0_tables(F, args); __syncthreads(); p_wconv_items(F, args, 0, 0, WC_NS); p_wconv_items(F, args, 1, 0, WC_NS); __syncthreads(); p_wconv_gu(F, args, 0, F.vcu, F.G, F.G == 256 ? 256 : WC_NGU); p_wconv_dn(F, args, 0, F.vcu, F.G);
        p_wconv_in(F, args, 0, (F.vcu + F.G - 112) % F.G, F.G); p_wconv_in(F, args, 1, (F.vcu + F.G - 184) % F.G, F.G); SEAM(0); }
    layer_body<0>(F, args, bar, lo, hi);
    layer_body<1>(F, args, bar, lo, hi);
#ifdef EXTRA_BARS
    if (MK_ONE_LAUNCH) for (int xb_ = 0; xb_ < EXTRA_BARS; ++xb_) xcd_barrier(bar);
#endif
#undef IN
#undef SEAM
}

extern "C" void kernel_launch(void* const* d_in, const int* in_sizes, int n_in, void* d_out, int out_size, void* d_ws, size_t ws_size, hipStream_t stream) {
    static int grid = 0;
    if (grid == 0) {
        if (n_in != 30 || in_sizes[0] != M * D || out_size != M * D || ws_size < WS_END) { fprintf(stderr, "kernel_launch: unexpected shapes (n_in %d, in0 %d, out %d, ws %zu, need %zu)\n", n_in, n_in > 0 ? in_sizes[0] : -1, out_size, ws_size, (size_t)WS_END); grid = -1; return; }
        int dev = 0, cus = 0, per_cu = 0;
        if (hipGetDevice(&dev) != hipSuccess || hipDeviceGetAttribute(&cus, hipDeviceAttributeMultiprocessorCount, dev) != hipSuccess) { grid = -1; return; }
        if (hipFuncSetAttribute((const void*)mk_fwd, hipFuncAttributeMaxDynamicSharedMemorySize, LDS_BYTES) != hipSuccess) { fprintf(stderr, "kernel_launch: hipFuncSetAttribute failed\n"); grid = -1; return; }
        if (hipOccupancyMaxActiveBlocksPerMultiprocessor(&per_cu, (const void*)mk_fwd, NTHR, LDS_BYTES) != hipSuccess || per_cu < 1) fprintf(stderr, "kernel_launch: occupancy query says %d\n", per_cu);
        (void)hipGetLastError();
        grid = cus;
    }
    if (grid < 0) return;
    if (hipMemsetAsync((char*)d_ws + WS_CTL, 0, CTL_ZERO_BYTES, stream) != hipSuccess) return;
    Args a{};
    for (int i = 0; i < 30; ++i) a.in[i] = d_in[i];
    a.out = (float*)d_out; a.ws = (unsigned char*)d_ws;
#if MK_ONE_LAUNCH
    a.ph_lo = 0; a.ph_hi = N_PHASES; a.li = 0;
    hipLaunchKernelGGL(mk_fwd, dim3(grid), dim3(NTHR), LDS_BYTES, stream, a);
#else
#ifndef REP_GLOBAL
#define REP_GLOBAL -1
#endif
#ifndef PROBE_SKIP
#define PROBE_SKIP 1
#endif
#ifndef REP_COUNT
#define REP_COUNT 2
#endif
    for (int p = 0; p < N_PHASES; ++p) { a.ph_lo = p; a.ph_hi = p + 1; a.li = p;
        const int nrep = ((p == 0 ? 100 : (p - 1) % PH_PER_LAYER) == REP_GLOBAL) ? REP_COUNT : 1;
        for (int r = 0; r < nrep; ++r) { a.pad = r ? PROBE_SKIP : 0; hipLaunchKernelGGL(mk_fwd, dim3(grid), dim3(NTHR), LDS_BYTES, stream, a); } a.pad = 0; }
#endif
}
```

```cpp
#include <hip/hip_runtime.h>
#include <cstdio>
#include <cstdint>
namespace pg8 {
#define PG8_LAS __attribute__((address_space(3)))
typedef unsigned short bf16_t;
typedef short bf16x8 __attribute__((ext_vector_type(8)));
typedef float f32x4 __attribute__((ext_vector_type(4)));
typedef unsigned u32x4 __attribute__((ext_vector_type(4)));
constexpr int BM = 256, BK = 64, HALF = 128, HTB = HALF * BK * 2  , STAGE_BYTES = 8 * HTB, NXCD = 8, WGM = 8;

__host__ __device__ __forceinline__ int lds_byte(int r, int c) { const int st = (r >> 4) * 2 + (c >> 5), rr = r & 15, cc = c & 31, ob = rr * 64 + cc * 2; return st * 1024 + (ob ^ (((ob >> 9) & 1) << 5)); }
__host__ __device__ __forceinline__ void stage_rc(int b, int& R, int& C) { const int st = b / 1024, sb = b % 1024, swz = sb ^ (((sb >> 9) & 1) << 5); R = (st >> 1) * 16 + swz / 64; C = (st & 1) * 32 + (swz % 64) / 2; }
__host__ __device__ __forceinline__ int perm32(int rho) { const int n = rho >> 4, i = rho & 15; return 8 * (i >> 2) + 4 * n + (i & 3); }

__device__ __forceinline__ int opaque_tid() { int t = threadIdx.x; asm volatile("" : "+v"(t)); return t; }
struct Unit { int pm, pn; };
struct Gemm { const bf16_t* A; const bf16_t* Bt; int M, N, K; };

struct StaticOrder {
    int nM, nN, nwg, G, c;
    __host__ __device__ void init(int M, int N, int G_, int c_) { nM = M / BM; nN = N / BM; nwg = nM * nN; G = G_; c = c_; }
    __host__ __device__ bool next(int i, Unit& u) const {
        const long L = (long)i * G + c; if (L >= nwg) return false;
        int wgid = (int)L; { const int q = nwg / NXCD, r = nwg % NXCD, xcd = wgid % NXCD, off = wgid / NXCD; wgid = (xcd < r ? xcd * (q + 1) : r * (q + 1) + (xcd - r) * q) + off; }
        const int nig = WGM * nN, gid = wgid / nig, fm = gid * WGM, gsz = (nM - fm) < WGM ? (nM - fm) : WGM;
        u.pm = fm + ((wgid % nig) % gsz); u.pn = (wgid % nig) / gsz; return true;
    }
    __device__ __forceinline__ void a_ready(const Unit&) const {}
    __device__ __forceinline__ void done(const Unit&) const {}
};

__device__ __forceinline__ unsigned cvt_pk_bf16(float lo, float hi) { unsigned r; asm volatile("v_cvt_pk_bf16_f32 %0, %1, %2" : "=v"(r) : "v"(lo), "v"(hi)); return r; }
template <class Epi, class Sched, bool ALIGN_EPI = false, bool SP2 = false, bool FP8 = false, bool ASC = false>
__device__ __forceinline__ void gemm_phase(PG8_LAS unsigned char* lds, const Gemm g, const Sched& S, const Epi& E, const unsigned char* scm = nullptr, PG8_LAS unsigned char* sct = nullptr) {
    const int tid = threadIdx.x, wid = __builtin_amdgcn_readfirstlane(tid >> 6), lane = tid & 63, wr = wid >> 2, wc = wid & 3, fr = lane & 15, fq = lane >> 4;
    const int K = g.K, nt = K / BK;
    unsigned voffA[2], voffB[2];
#pragma unroll
    for (int i = 0; i < 2; ++i) { int R, C; stage_rc(tid * 16 + i * 8192, R, C); const int Rb = Epi::PERM ? ((R & ~31) + perm32(R & 31)) : R;
        voffA[i] = (unsigned)(R * K + C) * 2u; voffB[i] = (unsigned)(Rb * K + C) * 2u; }
    const size_t kstep = (size_t)(BK * 2);
    const size_t hstep = (size_t)HALF * K * 2;
    const size_t tstep = 2 * hstep;
    const unsigned ldsw = (unsigned)wid * 1024u;
    const int aoff = lds_byte(wr * 64 + fr, fq * 8), boff = lds_byte(wc * 32 + fr, fq * 8);
#define PG8_SA(b, h) (((b) * 2 + (h)) * HTB)
#define PG8_SB(b, h) ((4 + (b) * 2 + (h)) * HTB)
#define PG8_STAGE(bufoff, gbase, voff) do { _Pragma("unroll") for (int _i = 0; _i < 2; ++_i) \
        __builtin_amdgcn_global_load_lds((const unsigned*)((const char*)(gbase) + (voff)[_i]), (PG8_LAS unsigned*)(lds + (bufoff) + ldsw + _i * 8192), 16, 0, 0); } while (0)
#define PG8_LDA(dst, b, h) do { if constexpr (FP8) { _Pragma("unroll") for (int m = 0; m < 4; ++m) { const PG8_LAS unsigned char* p_ = lds + PG8_SA(b, h) + aoff + m * 2048; \
            const i32x4_t lo_ = *(const PG8_LAS i32x4_t*)p_, hi_ = *(const PG8_LAS i32x4_t*)(p_ + 1024); dst##q[m] = __builtin_shufflevector(lo_, hi_, 0, 1, 2, 3, 4, 5, 6, 7); } } \
        else { _Pragma("unroll") for (int m = 0; m < 4; ++m) _Pragma("unroll") for (int k = 0; k < 2; ++k) dst[m][k] = *(const PG8_LAS bf16x8*)(lds + PG8_SA(b, h) + aoff + m * 2048 + k * 1024); } } while (0)
#define PG8_LDB(dst, b, h) do { if constexpr (FP8) { _Pragma("unroll") for (int n = 0; n < 2; ++n) { const PG8_LAS unsigned char* p_ = lds + PG8_SB(b, h) + boff + n * 2048; \
            const i32x4_t lo_ = *(const PG8_LAS i32x4_t*)p_, hi_ = *(const PG8_LAS i32x4_t*)(p_ + 1024); dst##q[n] = __builtin_shufflevector(lo_, hi_, 0, 1, 2, 3, 4, 5, 6, 7); } } \
        else { _Pragma("unroll") for (int n = 0; n < 2; ++n) _Pragma("unroll") for (int k = 0; k < 2; ++k) dst[n][k] = *(const PG8_LAS bf16x8*)(lds + PG8_SB(b, h) + boff + n * 2048 + k * 1024); } } while (0)
#define PG8_MMA(ai, bj, At, Bt, KT) do { __builtin_amdgcn_s_setprio(1); \
        if constexpr (FP8) { _Pragma("unroll") for (int m = 0; m < 4; ++m) _Pragma("unroll") for (int n = 0; n < 2; ++n) { const int o_ = 8 * m + 4 * n; \
                f32x4 c_ = {accq[ai][bj][o_], accq[ai][bj][o_ + 1], accq[ai][bj][o_ + 2], accq[ai][bj][o_ + 3]}; \
                if constexpr (ASC) c_ = __builtin_amdgcn_mfma_scale_f32_16x16x128_f8f6f4(Bt##q[n], At##q[m], c_, 0, 0, 0, 0x7f7f7f7f, KT, (int)sca[ai][m]); \
                else c_ = __builtin_amdgcn_mfma_scale_f32_16x16x128_f8f6f4(Bt##q[n], At##q[m], c_, 0, 0, 0, 0x7f7f7f7f, 0, 0x7f7f7f7f); \
                accq[ai][bj][o_] = c_[0]; accq[ai][bj][o_ + 1] = c_[1]; accq[ai][bj][o_ + 2] = c_[2]; accq[ai][bj][o_ + 3] = c_[3]; } } \
        else { _Pragma("unroll") for (int m = 0; m < 4; ++m) _Pragma("unroll") for (int n = 0; n < 2; ++n) _Pragma("unroll") for (int k = 0; k < 2; ++k) \
            acc[ai][bj][m][n] = __builtin_amdgcn_mfma_f32_16x16x32_bf16(Bt[n][k], At[m][k], acc[ai][bj][m][n], 0, 0, 0); } \
        __builtin_amdgcn_s_setprio(0); } while (0)
#define PG8_WAIT_V(n) asm volatile("s_waitcnt vmcnt(" #n ")" ::: "memory")
#define PG8_WAIT_L(n) asm volatile("s_waitcnt lgkmcnt(" #n ")" ::: "memory")
#define PG8_BAR __builtin_amdgcn_s_barrier()
#define PG8_SCHED __builtin_amdgcn_sched_barrier(0)
    Unit cur, nxt; int ui = 0;
    if (!S.next(0, cur)) return;
    f32x4 acc[2][2][4][2];
    typedef float f32x32_t __attribute__((ext_vector_type(32)));
    f32x32_t accq[2][2];
    if constexpr (FP8) { accq[0][0] = (f32x32_t)(0.f); accq[0][1] = (f32x32_t)(0.f); accq[1][0] = (f32x32_t)(0.f); accq[1][1] = (f32x32_t)(0.f); } (void)accq;
#pragma unroll
    for (int a = 0; a < 2; ++a)
#pragma unroll
        for (int b = 0; b < 2; ++b)
#pragma unroll
            for (int m = 0; m < 4; ++m)
#pragma unroll
                for (int n = 0; n < 2; ++n) acc[a][b][m][n] = (f32x4){0.f, 0.f, 0.f, 0.f};
    typedef int v8i_t __attribute__((ext_vector_type(8))); typedef int i32x4_t __attribute__((ext_vector_type(4)));
    bf16x8 At[4][2], B0[2][2], B1[2][2]; v8i_t Atq[4], B0q[2], B1q[2];
    (void)At; (void)B0; (void)B1; (void)Atq; (void)B0q; (void)B1q;
    unsigned sca[2][4]; (void)sca; int par = 0; (void)par;
#define PG8_LDSC(PAR, KH) do { if constexpr (ASC) { _Pragma("unroll") for (int a_ = 0; a_ < 2; ++a_) _Pragma("unroll") for (int m_ = 0; m_ < 4; ++m_) { \
        const PG8_LAS unsigned* sp_ = (const PG8_LAS unsigned*)(sct + (PAR) * 8192 + (KH) * 4096 + (wr * 64 + a_ * HALF + m_ * 16 + fr) * 4); const unsigned sh_ = (unsigned)fq * 8u; \
        sca[a_][m_] = ((sp_[0] >> sh_) & 0xffu) | (((sp_[256] >> sh_) & 0xffu) << 8) | (((sp_[512] >> sh_) & 0xffu) << 16) | ((sp_[768] >> sh_) << 24); } } } while (0)
#define PG8_SCDMA(u, PAR) do { if constexpr (ASC) __builtin_amdgcn_global_load_lds((const unsigned*)(scm + (size_t)(u).pm * 8192 + wid * 1024 + (opaque_tid() & 63) * 16), (PG8_LAS unsigned*)(sct + (PAR) * 8192 + wid * 1024), 16, 0, 0); } while (0)
    const char* cA = (const char*)g.A + (size_t)cur.pm * tstep; const char* cB = (const char*)g.Bt + (size_t)cur.pn * tstep;
    S.a_ready(cur); PG8_SCDMA(cur, 0);
    if constexpr (SP2) {
        PG8_STAGE(PG8_SB(0, 0), cB, voffB); PG8_STAGE(PG8_SB(0, 1), cB + hstep, voffB); PG8_STAGE(PG8_SA(0, 0), cA, voffA); PG8_STAGE(PG8_SA(0, 1), cA + hstep, voffA);
        if (wr == 1) PG8_BAR;
        PG8_WAIT_V(2); PG8_BAR;
        PG8_STAGE(PG8_SB(1, 0), cB + kstep, voffB); PG8_STAGE(PG8_SA(1, 0), cA + kstep, voffA); PG8_STAGE(PG8_SB(1, 1), cB + hstep + kstep, voffB);
        PG8_WAIT_V(6); PG8_BAR;
    } else {
        PG8_STAGE(PG8_SB(0, 0), cB, voffB); PG8_STAGE(PG8_SA(0, 0), cA, voffA); PG8_STAGE(PG8_SB(0, 1), cB + hstep, voffB); PG8_STAGE(PG8_SA(0, 1), cA + hstep, voffA);
        if (wr == 1) PG8_BAR;
        PG8_WAIT_V(4); PG8_BAR;
        PG8_STAGE(PG8_SB(1, 0), cB + kstep, voffB); PG8_STAGE(PG8_SA(1, 0), cA + kstep, voffA); PG8_STAGE(PG8_SB(1, 1), cB + hstep + kstep, voffB);
        PG8_WAIT_V(6); PG8_BAR;
    }
    PG8_LDSC(0, 0);
    for (;;) {
        const bool has_next = S.next(ui + 1, nxt);
        const char* nA = has_next ? (const char*)g.A + (size_t)nxt.pm * tstep : cA; const char* nB = has_next ? (const char*)g.Bt + (size_t)nxt.pn * tstep : cB;
#pragma unroll 1
        for (int t = 0; t < nt; t += 2) {
            const bool last = (t == nt - 2);
            const char* a1 = cA + (size_t)(t + 1) * kstep;
            const char* a2 = last ? nA : cA + (size_t)(t + 2) * kstep; const char* b2 = last ? nB : cB + (size_t)(t + 2) * kstep;
            const char* a3 = a2 + kstep; const char* b3 = b2 + kstep;
            if (last && has_next) { S.a_ready(nxt); PG8_SCDMA(nxt, par ^ 1); }
            if constexpr (ASC) { if (t == 4) PG8_LDSC(par, 1); }
            if constexpr (SP2) {
            PG8_LDB(B0, 0, 0); PG8_LDB(B1, 0, 1); PG8_SCHED; PG8_LDA(At, 0, 0); PG8_STAGE(PG8_SA(1, 1), a1 + hstep, voffA);
            PG8_WAIT_V(8); PG8_WAIT_L(0); PG8_BAR; PG8_MMA(0, 0, At, B0, 0); PG8_MMA(0, 1, At, B1, 0); PG8_BAR; PG8_SCHED;
            PG8_LDA(At, 0, 1); PG8_STAGE(PG8_SB(0, 0), b2, voffB); PG8_STAGE(PG8_SB(0, 1), b2 + hstep, voffB); PG8_STAGE(PG8_SA(0, 0), a2, voffA);
            PG8_WAIT_V(8); PG8_WAIT_L(0); PG8_BAR; PG8_MMA(1, 0, At, B0, 0); PG8_MMA(1, 1, At, B1, 0); PG8_BAR; PG8_SCHED;
            PG8_LDB(B0, 1, 0); PG8_LDB(B1, 1, 1); PG8_SCHED; PG8_LDA(At, 1, 0); PG8_STAGE(PG8_SA(0, 1), a2 + hstep, voffA);
            PG8_WAIT_V(8); PG8_WAIT_L(0); PG8_BAR; PG8_MMA(0, 0, At, B0, 1); PG8_MMA(0, 1, At, B1, 1); PG8_BAR; PG8_SCHED;
            PG8_LDA(At, 1, 1); PG8_STAGE(PG8_SB(1, 0), b3, voffB); PG8_STAGE(PG8_SB(1, 1), b3 + hstep, voffB); PG8_STAGE(PG8_SA(1, 0), a3, voffA);
            PG8_WAIT_V(8); PG8_WAIT_L(0); PG8_BAR; PG8_MMA(1, 0, At, B0, 1); PG8_MMA(1, 1, At, B1, 1); PG8_BAR; PG8_SCHED;
            } else {
            PG8_LDB(B0, 0, 0); PG8_SCHED; PG8_LDA(At, 0, 0); PG8_STAGE(PG8_SA(1, 1), a1 + hstep, voffA);
            PG8_WAIT_L(8); PG8_BAR; PG8_WAIT_L(0); PG8_MMA(0, 0, At, B0, 0); PG8_BAR; PG8_SCHED;
            PG8_LDB(B1, 0, 1); PG8_STAGE(PG8_SB(0, 0), b2, voffB);
            PG8_BAR; PG8_WAIT_L(0); PG8_MMA(0, 1, At, B1, 0); PG8_BAR;
            PG8_LDA(At, 0, 1); PG8_STAGE(PG8_SA(0, 0), a2, voffA);
            PG8_BAR; PG8_WAIT_L(0); PG8_MMA(1, 0, At, B0, 0); PG8_BAR; PG8_SCHED;
            PG8_STAGE(PG8_SB(0, 1), b2 + hstep, voffB);
            PG8_WAIT_V(6); PG8_BAR; PG8_MMA(1, 1, At, B1, 0); PG8_BAR;
            PG8_LDB(B0, 1, 0); PG8_SCHED; PG8_LDA(At, 1, 0); PG8_STAGE(PG8_SA(0, 1), a2 + hstep, voffA);
            PG8_WAIT_L(8); PG8_BAR; PG8_WAIT_L(0); PG8_MMA(0, 0, At, B0, 1); PG8_BAR; PG8_SCHED;
            PG8_LDB(B1, 1, 1); PG8_STAGE(PG8_SB(1, 0), b3, voffB);
            PG8_BAR; PG8_WAIT_L(0); PG8_MMA(0, 1, At, B1, 1); PG8_BAR;
            PG8_LDA(At, 1, 1); PG8_STAGE(PG8_SA(1, 0), a3, voffA);
            PG8_BAR; PG8_WAIT_L(0); PG8_MMA(1, 0, At, B0, 1); PG8_BAR; PG8_SCHED;
            PG8_STAGE(PG8_SB(1, 1), b3 + hstep, voffB);
            PG8_WAIT_V(6); PG8_BAR; PG8_MMA(1, 1, At, B1, 1); PG8_BAR;
            }
            if constexpr (ASC) { _Pragma("unroll") for (int a_ = 0; a_ < 2; ++a_) _Pragma("unroll") for (int m_ = 0; m_ < 4; ++m_) sca[a_][m_] >>= 16; }
        }
        if constexpr (ALIGN_EPI) { if (wr == 0) PG8_BAR; }
        if constexpr (FP8) {
#pragma unroll
            for (int a = 0; a < 2; ++a)
#pragma unroll
                for (int b = 0; b < 2; ++b)
#pragma unroll
                    for (int m = 0; m < 4; ++m)
#pragma unroll
                        for (int n = 0; n < 2; ++n) { const int o_ = 8 * m + 4 * n; acc[a][b][m][n] = (f32x4){accq[a][b][o_], accq[a][b][o_ + 1], accq[a][b][o_ + 2], accq[a][b][o_ + 3]}; }
        }
        if constexpr (!Epi::AFTER_DRAIN) { E(acc, cur, wr, wc, fr, fq); S.done(cur); }
        if (!has_next) break;
#pragma unroll
        for (int a = 0; a < 2; ++a)
#pragma unroll
            for (int b = 0; b < 2; ++b)
#pragma unroll
                for (int m = 0; m < 4; ++m)
#pragma unroll
                    for (int n = 0; n < 2; ++n) acc[a][b][m][n] = (f32x4){0.f, 0.f, 0.f, 0.f};
        if constexpr (FP8) { accq[0][0] = (f32x32_t)(0.f); accq[0][1] = (f32x32_t)(0.f); accq[1][0] = (f32x32_t)(0.f); accq[1][1] = (f32x32_t)(0.f); }
        cur = nxt; cA = nA; cB = nB; ++ui; par ^= 1; PG8_LDSC(par, 0);
        if constexpr (ALIGN_EPI) { if (wr == 1) PG8_BAR; }
    }
    PG8_WAIT_V(0);
    if constexpr (!ALIGN_EPI) { if (wr == 0) PG8_BAR; }
    PG8_BAR;
    if constexpr (Epi::AFTER_DRAIN) { E.fused(acc, cur, wr, wc, fr, fq, lds, wid, lane); S.done(cur); }
#undef PG8_SA
#undef PG8_SB
#undef PG8_STAGE
#undef PG8_LDSC
#undef PG8_SCDMA
#undef PG8_LDA
#undef PG8_LDB
#undef PG8_MMA
#undef PG8_WAIT_V
#undef PG8_WAIT_L
#undef PG8_BAR
#undef PG8_SCHED
}
template <class Epi, class Sched, bool ALIGN_EPI = false, bool SP2 = false, int AUXA = 0, bool FP8 = false, bool ASC = false>
__device__ __forceinline__ void gemm_phase_g(PG8_LAS unsigned char* lds, PG8_LAS unsigned char* gt, const Gemm g, const Sched& S, const Epi& E) {
    const int tid = threadIdx.x, wid = __builtin_amdgcn_readfirstlane(tid >> 6), lane = tid & 63, wr = wid >> 2, wc = wid & 3, fr = lane & 15, fq = lane >> 4;
    const int K = g.K, nt = K / BK;
    unsigned gpk0, voffB[2];
#pragma unroll
    for (int i = 0; i < 2; ++i) { int R, C; stage_rc(tid * 16 + i * 8192, R, C); const int Rb = Epi::PERM ? ((R & ~31) + perm32(R & 31)) : R;
        if (i == 0) gpk0 = (unsigned)(R * 4) | ((unsigned)(C * 2) << 16); voffB[i] = (unsigned)(Rb * K + C) * 2u; }
    int par = 0;
    const size_t kstep = (size_t)(BK * 2);
    const size_t hstep = (size_t)HALF * K * 2;
    const size_t tstep = 2 * hstep;
    const unsigned ldsw = (unsigned)wid * 1024u;
    const int aoff = lds_byte(wr * 64 + fr, fq * 8), boff = lds_byte(wc * 32 + fr, fq * 8);
#define PG8_SA(b, h) (((b) * 2 + (h)) * HTB)
#define PG8_SB(b, h) ((4 + (b) * 2 + (h)) * HTB)
#define PG8_STAGE(bufoff, gbase, voff) do { _Pragma("unroll") for (int _i = 0; _i < 2; ++_i) \
        __builtin_amdgcn_global_load_lds((const unsigned*)((const char*)(gbase) + (voff)[_i]), (PG8_LAS unsigned*)(lds + (bufoff) + ldsw + _i * 8192), 16, 0, 0); } while (0)
#define PG8_STAGE_A(bufoff, h, kbyte, PAR) do { _Pragma("unroll") for (int _i = 0; _i < 2; ++_i) { \
        const unsigned _vo = *(const PG8_LAS unsigned*)(gt + ((PAR) * 768 + (h) * 128 + _i * 64) * 4 + (gpk0 & 0xffffu)) + (gpk0 >> 16); \
        __builtin_amdgcn_global_load_lds((const unsigned*)((const char*)g.A + (size_t)(kbyte) + _vo), (PG8_LAS unsigned*)(lds + (bufoff) + ldsw + _i * 8192), 16, 0, AUXA); } } while (0)
#define PG8_FILL(u, PAR, PF, UI) do { S.wait_ready(u, tid, PF); if (tid < 256) { unsigned o_, a0_, a1_; S.finish_meta(u, tid, PF, o_, a0_, a1_); PG8_LAS unsigned* t_ = (PG8_LAS unsigned*)(gt + ((PAR) * 768 + tid) * 4); t_[0] = o_; t_[256] = a0_; t_[512] = a1_; } S.pull_publish(tid, PF, UI); asm volatile("s_waitcnt lgkmcnt(0)" ::: "memory"); __builtin_amdgcn_s_barrier(); asm volatile("" ::: "memory"); \
        if constexpr (ASC) { if (wid < 4) __builtin_amdgcn_global_load_lds((const unsigned*)(S.scale_base(u) + wid * 1024 + (opaque_tid() & 63) * 16), (PG8_LAS unsigned*)(gt + 6144 + (PAR) * 4096 + wid * 1024), 16, 0, 0); } } while (0)
#define PG8_LDA(dst, b, h) do { if constexpr (FP8) { _Pragma("unroll") for (int m = 0; m < 4; ++m) { const PG8_LAS unsigned char* p_ = lds + PG8_SA(b, h) + aoff + m * 2048; \
            const i32x4_t lo_ = *(const PG8_LAS i32x4_t*)p_, hi_ = *(const PG8_LAS i32x4_t*)(p_ + 1024); dst##q[m] = __builtin_shufflevector(lo_, hi_, 0, 1, 2, 3, 4, 5, 6, 7); } } \
        else { _Pragma("unroll") for (int m = 0; m < 4; ++m) _Pragma("unroll") for (int k = 0; k < 2; ++k) dst[m][k] = *(const PG8_LAS bf16x8*)(lds + PG8_SA(b, h) + aoff + m * 2048 + k * 1024); } } while (0)
#define PG8_LDB(dst, b, h) do { if constexpr (FP8) { _Pragma("unroll") for (int n = 0; n < 2; ++n) { const PG8_LAS unsigned char* p_ = lds + PG8_SB(b, h) + boff + n * 2048; \
            const i32x4_t lo_ = *(const PG8_LAS i32x4_t*)p_, hi_ = *(const PG8_LAS i32x4_t*)(p_ + 1024); dst##q[n] = __builtin_shufflevector(lo_, hi_, 0, 1, 2, 3, 4, 5, 6, 7); } } \
        else { _Pragma("unroll") for (int n = 0; n < 2; ++n) _Pragma("unroll") for (int k = 0; k < 2; ++k) dst[n][k] = *(const PG8_LAS bf16x8*)(lds + PG8_SB(b, h) + boff + n * 2048 + k * 1024); } } while (0)
#define PG8_MMA(ai, bj, At, Bt, KT) do { __builtin_amdgcn_s_setprio(1); \
        if constexpr (FP8) { _Pragma("unroll") for (int m = 0; m < 4; ++m) _Pragma("unroll") for (int n = 0; n < 2; ++n) { const int o_ = 8 * m + 4 * n; \
                f32x4 c_ = {accq[ai][bj][o_], accq[ai][bj][o_ + 1], accq[ai][bj][o_ + 2], accq[ai][bj][o_ + 3]}; \
                if constexpr (ASC) c_ = __builtin_amdgcn_mfma_scale_f32_16x16x128_f8f6f4(Bt##q[n], At##q[m], c_, 0, 0, 0, 0x7f7f7f7f, KT, (int)sca[ai][m]); \
                else c_ = __builtin_amdgcn_mfma_scale_f32_16x16x128_f8f6f4(Bt##q[n], At##q[m], c_, 0, 0, 0, 0x7f7f7f7f, 0, 0x7f7f7f7f); \
                accq[ai][bj][o_] = c_[0]; accq[ai][bj][o_ + 1] = c_[1]; accq[ai][bj][o_ + 2] = c_[2]; accq[ai][bj][o_ + 3] = c_[3]; } } \
        else { _Pragma("unroll") for (int m = 0; m < 4; ++m) _Pragma("unroll") for (int n = 0; n < 2; ++n) _Pragma("unroll") for (int k = 0; k < 2; ++k) \
            acc[ai][bj][m][n] = __builtin_amdgcn_mfma_f32_16x16x32_bf16(Bt[n][k], At[m][k], acc[ai][bj][m][n], 0, 0, 0); } \
        __builtin_amdgcn_s_setprio(0); } while (0)
#define PG8_WAIT_V(n) asm volatile("s_waitcnt vmcnt(" #n ")" ::: "memory")
#define PG8_WAIT_L(n) asm volatile("s_waitcnt lgkmcnt(" #n ")" ::: "memory")
#define PG8_BAR __builtin_amdgcn_s_barrier()
#define PG8_SCHED __builtin_amdgcn_sched_barrier(0)
    Unit cur, nxt; int ui = 0;
    if (!__builtin_amdgcn_readfirstlane((int)S.first(cur))) return;
    cur.pm = __builtin_amdgcn_readfirstlane(cur.pm); cur.pn = __builtin_amdgcn_readfirstlane(cur.pn);
    f32x4 acc[2][2][4][2];
    typedef float f32x32_t __attribute__((ext_vector_type(32)));
    f32x32_t accq[2][2];
    if constexpr (FP8) { accq[0][0] = (f32x32_t)(0.f); accq[0][1] = (f32x32_t)(0.f); accq[1][0] = (f32x32_t)(0.f); accq[1][1] = (f32x32_t)(0.f); } (void)accq;
#pragma unroll
    for (int a = 0; a < 2; ++a)
#pragma unroll
        for (int b = 0; b < 2; ++b)
#pragma unroll
            for (int m = 0; m < 4; ++m)
#pragma unroll
                for (int n = 0; n < 2; ++n) acc[a][b][m][n] = (f32x4){0.f, 0.f, 0.f, 0.f};
    typedef int v8i_t __attribute__((ext_vector_type(8))); typedef int i32x4_t __attribute__((ext_vector_type(4)));
    bf16x8 At[4][2], B0[2][2], B1[2][2]; v8i_t Atq[4], B0q[2], B1q[2];
    (void)At; (void)B0; (void)B1; (void)Atq; (void)B0q; (void)B1q;
    unsigned sca[2][4]; (void)sca;
#define PG8_LDSC(PAR) do { if constexpr (ASC) { _Pragma("unroll") for (int a_ = 0; a_ < 2; ++a_) _Pragma("unroll") for (int m_ = 0; m_ < 4; ++m_) { \
        const PG8_LAS unsigned* sp_ = (const PG8_LAS unsigned*)(gt + 6144 + (PAR) * 4096 + (wr * 64 + a_ * HALF + m_ * 16 + fr) * 4); const unsigned sh_ = (unsigned)fq * 8u; \
        sca[a_][m_] = ((sp_[0] >> sh_) & 0xffu) | (((sp_[256] >> sh_) & 0xffu) << 8) | (((sp_[512] >> sh_) & 0xffu) << 16) | ((sp_[768] >> sh_) << 24); } } } while (0)
    const char* cB = (const char*)g.Bt + (size_t)cur.pn * tstep;
    typename Sched::Pf pf; S.prefetch(cur, tid, pf); PG8_FILL(cur, 0, pf, -1);
    Unit pend; bool has_pend = false;
    if constexpr (SP2) {
        PG8_STAGE(PG8_SB(0, 0), cB, voffB); PG8_STAGE(PG8_SB(0, 1), cB + hstep, voffB); PG8_STAGE_A(PG8_SA(0, 0), 0, 0, par); PG8_STAGE_A(PG8_SA(0, 1), 1, 0, par);
        if (wr == 1) PG8_BAR;
        PG8_WAIT_V(2); PG8_BAR;
        PG8_STAGE(PG8_SB(1, 0), cB + kstep, voffB); PG8_STAGE_A(PG8_SA(1, 0), 0, kstep, par); PG8_STAGE(PG8_SB(1, 1), cB + hstep + kstep, voffB);
        PG8_WAIT_V(6); PG8_BAR;
    } else {
        PG8_STAGE(PG8_SB(0, 0), cB, voffB); PG8_STAGE_A(PG8_SA(0, 0), 0, 0, par); PG8_STAGE(PG8_SB(0, 1), cB + hstep, voffB); PG8_STAGE_A(PG8_SA(0, 1), 1, 0, par);
        if (wr == 1) PG8_BAR;
        PG8_WAIT_V(4); PG8_BAR;
        PG8_STAGE(PG8_SB(1, 0), cB + kstep, voffB); PG8_STAGE_A(PG8_SA(1, 0), 0, kstep, par); PG8_STAGE(PG8_SB(1, 1), cB + hstep + kstep, voffB);
        PG8_WAIT_V(6); PG8_BAR;
    }
    PG8_LDSC(0);
    for (;;) {
        const bool has_next = __builtin_amdgcn_readfirstlane((int)S.more(ui + 1, nxt)) != 0;
        nxt.pm = __builtin_amdgcn_readfirstlane(nxt.pm); nxt.pn = __builtin_amdgcn_readfirstlane(nxt.pn);
        if (has_next) { S.prefetch(nxt, tid, pf); S.pull_issue(tid, pf); }
        const char* nB = has_next ? (const char*)g.Bt + (size_t)nxt.pn * tstep : cB;
#pragma unroll 1
        for (int t = 0; t < nt; t += 2) {
            const bool last = (t == nt - 2);
            const char* b2 = last ? nB : cB + (size_t)(t + 2) * kstep;
            const char* b3 = b2 + kstep;
            if (last && has_next) PG8_FILL(nxt, par ^ 1, pf, ui);
            const size_t kA2 = last ? (size_t)0 : (size_t)(t + 2) * kstep; const int pA2 = (last && has_next) ? (par ^ 1) : par;
            if constexpr (SP2) {
            PG8_LDB(B0, 0, 0); PG8_LDB(B1, 0, 1); PG8_SCHED; PG8_LDA(At, 0, 0); PG8_STAGE_A(PG8_SA(1, 1), 1, (size_t)(t + 1) * kstep, par);
            PG8_WAIT_V(8); PG8_WAIT_L(0); PG8_BAR; PG8_MMA(0, 0, At, B0, 0); PG8_MMA(0, 1, At, B1, 0); PG8_BAR; PG8_SCHED;
            PG8_LDA(At, 0, 1); PG8_STAGE(PG8_SB(0, 0), b2, voffB); PG8_STAGE(PG8_SB(0, 1), b2 + hstep, voffB); PG8_STAGE_A(PG8_SA(0, 0), 0, kA2, pA2);
            PG8_WAIT_V(8); PG8_WAIT_L(0); PG8_BAR; PG8_MMA(1, 0, At, B0, 0); PG8_MMA(1, 1, At, B1, 0); PG8_BAR; PG8_SCHED;
            PG8_LDB(B0, 1, 0); PG8_LDB(B1, 1, 1); PG8_SCHED; PG8_LDA(At, 1, 0); PG8_STAGE_A(PG8_SA(0, 1), 1, kA2, pA2);
            PG8_WAIT_V(8); PG8_WAIT_L(0); PG8_BAR; PG8_MMA(0, 0, At, B0, 1); PG8_MMA(0, 1, At, B1, 1); PG8_BAR; PG8_SCHED;
            PG8_LDA(At, 1, 1); PG8_STAGE(PG8_SB(1, 0), b3, voffB); PG8_STAGE(PG8_SB(1, 1), b3 + hstep, voffB); PG8_STAGE_A(PG8_SA(1, 0), 0, kA2 + kstep, pA2);
            PG8_WAIT_V(8); PG8_WAIT_L(0); PG8_BAR; PG8_MMA(1, 0, At, B0, 1); PG8_MMA(1, 1, At, B1, 1); PG8_BAR; PG8_SCHED;
            } else {
            PG8_LDB(B0, 0, 0); PG8_SCHED; PG8_LDA(At, 0, 0); PG8_STAGE_A(PG8_SA(1, 1), 1, (size_t)(t + 1) * kstep, par);
            PG8_WAIT_L(8); PG8_BAR; PG8_WAIT_L(0); PG8_MMA(0, 0, At, B0, 0); PG8_BAR; PG8_SCHED;
            PG8_LDB(B1, 0, 1); PG8_STAGE(PG8_SB(0, 0), b2, voffB);
            PG8_BAR; PG8_WAIT_L(0); PG8_MMA(0, 1, At, B1, 0); PG8_BAR;
            PG8_LDA(At, 0, 1); PG8_STAGE_A(PG8_SA(0, 0), 0, kA2, pA2);
            PG8_BAR; PG8_WAIT_L(0); PG8_MMA(1, 0, At, B0, 0); PG8_BAR; PG8_SCHED;
            PG8_STAGE(PG8_SB(0, 1), b2 + hstep, voffB);
            PG8_WAIT_V(6); PG8_BAR; PG8_MMA(1, 1, At, B1, 0); PG8_BAR;
            PG8_LDB(B0, 1, 0); PG8_SCHED; PG8_LDA(At, 1, 0); PG8_STAGE_A(PG8_SA(0, 1), 1, kA2, pA2);
            PG8_WAIT_L(8); PG8_BAR; PG8_WAIT_L(0); PG8_MMA(0, 0, At, B0, 1); PG8_BAR; PG8_SCHED;
            PG8_LDB(B1, 1, 1); PG8_STAGE(PG8_SB(1, 0), b3, voffB);
            PG8_BAR; PG8_WAIT_L(0); PG8_MMA(0, 1, At, B1, 1); PG8_BAR;
            PG8_LDA(At, 1, 1); PG8_STAGE_A(PG8_SA(1, 0), 0, kA2 + kstep, pA2);
            PG8_BAR; PG8_WAIT_L(0); PG8_MMA(1, 0, At, B0, 1); PG8_BAR; PG8_SCHED;
            PG8_STAGE(PG8_SB(1, 1), b3 + hstep, voffB);
            PG8_WAIT_V(6); PG8_BAR; PG8_MMA(1, 1, At, B1, 1); PG8_BAR;
            }
            if constexpr (ASC) { _Pragma("unroll") for (int a_ = 0; a_ < 2; ++a_) _Pragma("unroll") for (int m_ = 0; m_ < 4; ++m_) sca[a_][m_] >>= 16; }
        }
        if constexpr (ALIGN_EPI) { if (wr == 0) PG8_BAR; }
        if constexpr (FP8) {
#pragma unroll
            for (int a = 0; a < 2; ++a)
#pragma unroll
                for (int b = 0; b < 2; ++b)
#pragma unroll
                    for (int m = 0; m < 4; ++m)
#pragma unroll
                        for (int n = 0; n < 2; ++n) { const int o_ = 8 * m + 4 * n; acc[a][b][m][n] = (f32x4){accq[a][b][o_], accq[a][b][o_ + 1], accq[a][b][o_ + 2], accq[a][b][o_ + 3]}; }
        }
        if constexpr (!Epi::AFTER_DRAIN) { if (has_pend) S.done_nowait(pend);     E(acc, cur, wr, wc, fr, fq, (const PG8_LAS unsigned*)(gt + par * 3072)); pend = cur; has_pend = true; }
        if (!has_next) break;
#pragma unroll
        for (int a = 0; a < 2; ++a)
#pragma unroll
            for (int b = 0; b < 2; ++b)
#pragma unroll
                for (int m = 0; m < 4; ++m)
#pragma unroll
                    for (int n = 0; n < 2; ++n) acc[a][b][m][n] = (f32x4){0.f, 0.f, 0.f, 0.f};
        if constexpr (FP8) { accq[0][0] = (f32x32_t)(0.f); accq[0][1] = (f32x32_t)(0.f); accq[1][0] = (f32x32_t)(0.f); accq[1][1] = (f32x32_t)(0.f); }
        cur = nxt; cB = nB; ++ui; par ^= 1; PG8_LDSC(par);
        if constexpr (ALIGN_EPI) { if (wr == 1) PG8_BAR; }
    }
    PG8_WAIT_V(0);
    if constexpr (!ALIGN_EPI) { if (wr == 0) PG8_BAR; }
    PG8_BAR;
    if (has_pend) S.done_nowait(pend);
#undef PG8_SA
#undef PG8_SB
#undef PG8_STAGE
#undef PG8_STAGE_A
#undef PG8_FILL
#undef PG8_LDSC
#undef PG8_LDA
#undef PG8_LDB
#undef PG8_MMA
#undef PG8_WAIT_V
#undef PG8_WAIT_L
#undef PG8_BAR
#undef PG8_SCHED
}
}

#ifndef PG8_SP2
#define PG8_SP2 true
#endif
#ifndef PG8_ALIGN
#define PG8_ALIGN true
#endif
#ifndef MK_ONE_LAUNCH
#define MK_ONE_LAUNCH 1
#endif

constexpr int NWAVES = 8, NTHR = 512;
constexpr int BATCH = 8, T = 4096, D = 1024, M = BATCH * T, DEPTH = 2;
constexpr int PROJW = 2304, AW = 256, BW = 512, CW = 256, NH = 8, HD = 64;
constexpr int COL_U = 0, COL_V = 256, COL_Q = 512, COL_K = 1024, COL_VA = 1536, COL_S = 2048;
constexpr int NEXP = 16, DEXP = 512, NGRP = 4;
constexpr int SSM_G = 16, SSM_N = 64, SSM_C = 16;
constexpr float LN_EPS = 1e-5f;
constexpr float ALPHA = 1.41421356237309515f;
constexpr float QSCALE = 0.125f * 1.4426950408889634f;
constexpr int NSLOT_MAX = 2 * M + NEXP * 256;

constexpr size_t MiB = 1u << 20;
constexpr size_t WS_CTL = 0, CTL_ZERO_BYTES = 1 * MiB;
constexpr size_t WS_MOD = 1 * MiB;
constexpr size_t WS_ROPE = WS_MOD + 512 * 1024;
constexpr size_t WS_SSM = WS_ROPE + 2 * MiB;
constexpr int SSM_TAB = 2 * 1024 + 2 * 16384;
constexpr int SLOT_CAP = 32768;
constexpr size_t WS_SLOT_A = 4 * MiB;
constexpr size_t WS_WSMALL = 6 * MiB;
constexpr size_t WSMALL_LAYER = 7 * MiB, WOFF_IN = 0, WOFF_OUT = (size_t)PROJW * D * 2, WOFF_GLU = WOFF_OUT + (size_t)D * D * 2;
constexpr size_t WS_WGU = 20 * MiB;
constexpr size_t WS_WD = 52 * MiB;
constexpr size_t WS_XN = 68 * MiB;
constexpr size_t WS_YG = 132 * MiB;
constexpr size_t WS_R = 148 * MiB;
constexpr size_t WS_PROJ = WS_R, WS_MIXCAT = WS_R + 144 * MiB, WS_PRE = WS_R, WS_HID = WS_R + 64 * MiB, WS_X1 = WS_R + 132 * MiB;
constexpr size_t WS_HSC = WS_HID + 36 * MiB;
constexpr size_t WS_ROWS2 = 356 * MiB;
constexpr size_t WS_STAT = 356 * MiB + (size_t)2 * M * D * 2;
constexpr size_t WS_SSM2 = WS_STAT + 4 * MiB;
constexpr size_t SSM2_LAYER = 3 * MiB, S2_APW = 0, S2_KT = 288 * 1024, S2_CT = S2_KT + 256 * 1024, S2_WIN = S2_CT + 64 * 1024, S2_GW = S2_WIN + 2 * MiB;
static_assert(S2_GW + 4 * 128 * 128 * 2 <= SSM2_LAYER, "ssm2 tables");
constexpr size_t WS_XLOC = WS_SSM2 + 2 * SSM2_LAYER;
constexpr size_t WS_XSUP = WS_XLOC + 8 * MiB;
constexpr size_t WS_SLOT_W = WS_XSUP + 512 * 1024;
constexpr size_t WS_CINV = WS_SLOT_W + 2 * MiB;
constexpr size_t WS_CINV_IN = WS_CINV + 128 * 1024;
constexpr size_t WS_CINV_D = WS_CINV + 256 * 1024;
constexpr size_t WS_SA = WS_CINV + 384 * 1024;
constexpr size_t WS_SCM = WS_SA + 128 * 1024;
constexpr size_t WS_CINV_O = WS_SCM + 1 * MiB;
constexpr size_t WS_END = WS_CINV_O + 64 * 1024;
static_assert(WOFF_GLU + 256 * 256 * 2 <= WSMALL_LAYER && WS_WSMALL + 2 * WSMALL_LAYER <= WS_WGU, "ws map");
static_assert(WS_SSM + 2 * SSM_TAB * 4 <= WS_SLOT_A && WS_HID + (size_t)NSLOT_MAX * DEXP * 2 <= WS_X1 && WS_X1 + (size_t)M * D * 2 <= WS_ROWS2, "ws map 2");
constexpr int CW_TMO = 0;
constexpr int CW_BAR = 4096;
constexpr int CW_CNT = 8192;
constexpr int CW_QUEUE = 11264;
constexpr int CW_DONE = 12288;

constexpr int RING_OFF = 0, RING_BYTES = 131072;
constexpr int ATT_STAGE_OFF = 98304;
constexpr int LDSCTL_OFF = 135168, MISC_OFF = LDSCTL_OFF + 320;
constexpr int GT_OFF = LDSCTL_OFF + 1024;
constexpr int SCT_OFF = GT_OFF + 6144;
constexpr int LDS_BYTES = 158720;

#define GAS __attribute__((address_space(1)))
#define LAS __attribute__((address_space(3)))
#define DI __device__ __forceinline__
typedef unsigned short bf16;
typedef unsigned v4u __attribute__((ext_vector_type(4)));
typedef unsigned v2u __attribute__((ext_vector_type(2)));
typedef float f32x4 __attribute__((ext_vector_type(4)));
typedef short bf16x8 __attribute__((ext_vector_type(8)));
typedef GAS unsigned gu32;
#define RLX_AGENT __ATOMIC_RELAXED, __HIP_MEMORY_SCOPE_AGENT
#define LDS_WAIT() asm volatile("s_waitcnt lgkmcnt(0)" ::: "memory")
#define VM_WAIT() asm volatile("s_waitcnt vmcnt(0)" ::: "memory")
DI unsigned f2bf(float f) { unsigned u = __builtin_bit_cast(unsigned, f); return (u + 0x7fffu + ((u >> 16) & 1u)) >> 16; }
DI unsigned pk2(float lo, float hi) { return f2bf(lo) | (f2bf(hi) << 16); }
DI float bflo(unsigned w) { return __uint_as_float(w << 16); }
DI float bfhi(unsigned w) { return __uint_as_float(w & 0xffff0000u); }
DI float bf2f(bf16 h) { return __uint_as_float((unsigned)h << 16); }
template <int CTRL> DI float dpp_mov(float v) { return __builtin_bit_cast(float, __builtin_amdgcn_update_dpp(0, __builtin_bit_cast(int, v), CTRL, 0xf, 0xf, true)); }
DI float rdlane(float v, int l) { return __builtin_bit_cast(float, __builtin_amdgcn_readlane(__builtin_bit_cast(int, v), l)); }
DI float wave_sum(float v) {
    v += dpp_mov<0xB1>(v); v += dpp_mov<0x4E>(v); v += dpp_mov<0x141>(v); v += dpp_mov<0x140>(v);
    return (rdlane(v, 0) + rdlane(v, 16)) + (rdlane(v, 32) + rdlane(v, 48));
}
DI void st16_wt(void* p, v4u v) { asm volatile("global_store_dwordx4 %0, %1, off sc1\n\ts_nop 1" :: "v"(p), "v"(v) : "memory"); }
DI float wave_max(float v) {
    v = fmaxf(v, dpp_mov<0xB1>(v)); v = fmaxf(v, dpp_mov<0x4E>(v)); v = fmaxf(v, dpp_mov<0x141>(v)); v = fmaxf(v, dpp_mov<0x140>(v));
    return fmaxf(fmaxf(rdlane(v, 0), rdlane(v, 16)), fmaxf(rdlane(v, 32), rdlane(v, 48)));
}
DI unsigned pk4_fp8(float a, float b, float c, float d) { int w = __builtin_amdgcn_cvt_pk_fp8_f32(a, b, 0, false); w = __builtin_amdgcn_cvt_pk_fp8_f32(c, d, w, true); return (unsigned)w; }
DI unsigned mx_scale(float bm, float& mult) { unsigned eb = (__float_as_uint(bm * (1.0f / 448.0f)) + 0x7fffffu) >> 23; eb = eb < 1u ? 1u : (eb > 254u ? 254u : eb); mult = __uint_as_float((254u - eb) << 23); return eb; }
DI size_t scm_index(int m, int b32) { return ((size_t)(m >> 8) * 8 + (b32 >> 2)) * 1024 + (size_t)(m & 255) * 4 + (b32 & 3); }
DI float fast_rcp(float x) { return __builtin_amdgcn_rcpf(x); }
DI float sigmoid_f(float x) { return fast_rcp(1.0f + __builtin_amdgcn_exp2f(-1.4426950408889634f * x)); }
DI float silu_f(float x) { return x * sigmoid_f(x); }
DI float gelu_tanh_f(float x) { const float z2 = 1.5957691216057308f * (x + 0.044715f * x * x * x); return x * sigmoid_f(z2); }

#define XB_TMO      128
#define XB_XCNT(j)  (256  + 64 * (j))
#define XB_XSUB(j)  (1280 + 64 * (j))
#define XB_XGEN(j)  (2304 + 64 * (j))
#define XB_TOP      3328
#define XB_TOPGEN   3392
#define XCD_BAR_WORDS 3456
#define XB_SPIN_CAP (1u << 22)
DI unsigned xb_ld(unsigned* p)              { return __hip_atomic_load(p, __ATOMIC_RELAXED, __HIP_MEMORY_SCOPE_AGENT); }
DI unsigned xb_add(unsigned* p, unsigned v) { return __hip_atomic_fetch_add(p, v, __ATOMIC_RELAXED, __HIP_MEMORY_SCOPE_AGENT); }
DI unsigned xb_xcc_id() { return (unsigned)__builtin_amdgcn_s_getreg((3 << 11) | 20) & 0xFu; }
#define XB_SPIN(cond, bar) do { unsigned _sp = 0; while (cond) { __builtin_amdgcn_s_sleep(1); \
    if ((++_sp & 255u) == 0u) { if (xb_ld(&(bar)[XB_TMO])) break; if (_sp > XB_SPIN_CAP) { atomicAdd(&(bar)[XB_TMO], 1u); break; } } } } while (0)
struct XcdBarrier { unsigned* bar; unsigned x; volatile LAS unsigned* st; };
DI XcdBarrier xcd_barrier_post(unsigned* bar, volatile LAS unsigned* st) {
    XcdBarrier b; b.bar = bar; b.x = xb_xcc_id(); b.st = st;
    if (threadIdx.x == 0) (void)xb_add(&bar[XB_XCNT(b.x)], 1u);
    return b;
}
DI void xcd_barrier_complete(unsigned* bar, unsigned x, unsigned& nloc, unsigned& nx) {
    const unsigned G = gridDim.x * gridDim.y * gridDim.z;
    unsigned sum, cnt, mine, sp = 0u;
    for (;;) {
        sum = 0u; cnt = 0u; mine = 0u;
#pragma unroll
        for (unsigned j = 0; j < 16; ++j) { const unsigned c = xb_ld(&bar[XB_XCNT(j)]); sum += c; cnt += (c > 0u) ? 1u : 0u; mine = (j == x) ? c : mine; }
        if (sum == G) break;
        __builtin_amdgcn_s_sleep(1);
        if ((++sp & 255u) == 0u) { if (xb_ld(&bar[XB_TMO])) break; if (sp > XB_SPIN_CAP) { atomicAdd(&bar[XB_TMO], 1u); break; } }
    }
    nloc = mine > 0u ? mine : 1u; nx = cnt > 0u ? cnt : 1u;
}
DI void xcd_barrier(const XcdBarrier& b) {
    asm volatile("s_waitcnt vmcnt(0)" ::: "memory");
    __syncthreads();
    if (threadIdx.x == 0) {
        unsigned* bar = b.bar;
        __builtin_amdgcn_s_waitcnt(0);
        unsigned nloc = b.st[0], nx = b.st[1];
        if (nloc == 0u) { xcd_barrier_complete(bar, b.x, nloc, nx); b.st[0] = nloc; b.st[1] = nx; }
        const unsigned old = xb_add(&bar[XB_XSUB(b.x)], 1u);
        const unsigned gen = old / nloc;
        if (old + 1u == (gen + 1u) * nloc) {
            __builtin_amdgcn_fence(__ATOMIC_RELEASE, "agent");
            asm volatile("s_waitcnt vmcnt(0)" ::: "memory");
            const unsigned og = xb_add(&bar[XB_TOP], 1u);
            const unsigned tg = og / nx;
            if (og + 1u == (tg + 1u) * nx) xb_add(&bar[XB_TOPGEN], 1u);
            else XB_SPIN(xb_ld(&bar[XB_TOPGEN]) == tg, bar);
            __builtin_amdgcn_fence(__ATOMIC_ACQUIRE, "agent");
            xb_add(&bar[XB_XGEN(b.x)], 1u);
            asm volatile("s_waitcnt vmcnt(0)" ::: "memory");
        } else {
            XB_SPIN(xb_ld(&bar[XB_XGEN(b.x)]) == gen, bar);
            __builtin_amdgcn_fence(__ATOMIC_ACQUIRE, "agent");
            asm volatile("s_waitcnt vmcnt(0)" ::: "memory");
        }
    }
    __syncthreads();
}

struct Args { const void* in[30]; float* out; unsigned char* ws; int ph_lo, ph_hi, li, pad; };
enum { I_X = 0, I_C, I_POS, I_ADAW, I_ADAB, I_WIN, I_GMLNG, I_GMLNB, I_GMWS, I_GMBS, I_LAMRE, I_LAMIM, I_LOGDT, I_BRE, I_BIM, I_CRE, I_CIM, I_SSMD,
       I_GLUW, I_GLUB, I_WOUT, I_LN1G, I_LN1B, I_RW, I_RB, I_EWG, I_EWU, I_EWD, I_LN2G, I_LN2B };
struct Frame {
    LAS unsigned char* lds;
    volatile LAS unsigned* MISC;
    gu32* ctl;
    unsigned char* ws;
    int vcu, G;
};
DI int ftid() { int t = threadIdx.x; asm volatile("" : "+v"(t)); return t; }
#define FRAME_IDS const int tid_ = ftid(), lane_ = tid_ & 63, wave_ = __builtin_amdgcn_readfirstlane(tid_ >> 6); (void)lane_; (void)wave_;

template <class RowMap>
DI void transpose_item(const float* W, int K, int N, bf16* WT, const RowMap& rm, LAS float* scr, int item, int lane) {
    const int nblk = N / 32, kb = item / nblk, nb = item % nblk, k0 = 64 * kb, n0 = 32 * nb;
#pragma unroll 8
    for (int i = 0; i < 32; ++i) { const int kk = 2 * i + (lane >> 5); scr[kk * 33 + (lane & 31)] = W[(size_t)(k0 + kk) * N + n0 + (lane & 31)]; }
    LDS_WAIT(); asm volatile("" ::: "memory");
    const int c = lane & 7;
#pragma unroll
    for (int j = 0; j < 4; ++j) { const int n = (lane >> 3) + 8 * j; const LAS float* s = scr + (8 * c) * 33 + n;
        const float qs = (RowMap::SCALEQ && (n0 + n) >= COL_Q && (n0 + n) < COL_K) ? QSCALE : 1.0f;
        v4u o; o.x = pk2(s[0 * 33] * qs, s[1 * 33] * qs); o.y = pk2(s[2 * 33] * qs, s[3 * 33] * qs); o.z = pk2(s[4 * 33] * qs, s[5 * 33] * qs); o.w = pk2(s[6 * 33] * qs, s[7 * 33] * qs);
        *(GAS v4u*)(WT + (size_t)rm(n0 + n) * K + k0 + 8 * c) = o; }
    LDS_WAIT(); asm volatile("" ::: "memory");
}
struct RmIdent { static constexpr bool SCALEQ = false; int off; DI int operator()(int n) const { return off + n; } };
struct RmWin { static constexpr bool SCALEQ = true; DI int operator()(int n) const {
        if (n >= COL_Q && n < COL_VA) { const int d = n & 63; if (d < 16) return (n - d) + 2 * (d & 7) + (d >> 3); }
        return n; } };
struct RmGU { static constexpr bool SCALEQ = false; int e, up; DI int operator()(int n) const { return e * 1024 + (n >> 7) * 256 + (n & 127) + up * 128; } };

DI void p0_tables(Frame& F, const Args& A) {
    FRAME_IDS
    const float* c = (const float*)A.in[I_C];
    LAS float* condS = (LAS float*)(F.lds + RING_OFF);
    LAS float* red = (LAS float*)(F.lds + RING_OFF + 32768);
    for (int i = tid_; i < BATCH * D; i += NTHR) condS[i] = silu_f(c[i]);
    __syncthreads();
    float* mod = (float*)(F.ws + WS_MOD);
    for (int it = F.vcu; it < DEPTH * 96; it += F.G) {
        const int l = it / 96, jb = it % 96, ks = tid_ >> 6, jj = tid_ & 63, j = jb * 64 + jj;
        const float* w = (const float*)A.in[I_ADAW] + (size_t)l * D * 6 * D + j;
        float acc[8];
#pragma unroll
        for (int b = 0; b < 8; ++b) acc[b] = 0.f;
#pragma unroll 16
        for (int k = ks * 128; k < ks * 128 + 128; ++k) { const float wv = w[(size_t)k * (6 * D)];
#pragma unroll
            for (int b = 0; b < 8; ++b) acc[b] += condS[b * D + k] * wv; }
#pragma unroll
        for (int b = 0; b < 8; ++b) red[(ks * 8 + b) * 64 + jj] = acc[b];
        __syncthreads();
        { const int b = tid_ >> 6; float s = ((const float*)A.in[I_ADAB])[l * 6 * D + j];
#pragma unroll
          for (int k2 = 0; k2 < 8; ++k2) s += red[(k2 * 8 + b) * 64 + jj];
          mod[((size_t)l * BATCH + b) * 6 * D + j] = s; }
        __syncthreads();
    }
    const int gt = F.vcu * NTHR + tid_, NGT = F.G * NTHR;
    const int* pos = (const int*)A.in[I_POS]; float* rope = (float*)(F.ws + WS_ROPE);
    for (int w = gt; w < M * 8; w += NGT) { const int m = w >> 3, i = w & 7;
        const float freq = exp2f(-(float)i * 0.125f * 18.931568569324174f);
        const float ang = (float)pos[m] * freq; float s, cs; sincosf(ang, &s, &cs);
        rope[m * 16 + i] = cs; rope[m * 16 + 8 + i] = s; }
    for (int w = gt; w < DEPTH * 16 * 33 * 64; w += NGT) { const int n = w & 63, m = (w >> 6) % 33, g = ((w >> 6) / 33) & 15, l = (w >> 6) / (33 * 16);
        const int li = (l * 16 + g) * 64 + n;
        const float lre = ((const float*)A.in[I_LAMRE])[li], lim = ((const float*)A.in[I_LAMIM])[li], dt = expf(((const float*)A.in[I_LOGDT])[l * 16 + g]);
        const float mag = expf((float)m * (lre * dt)); float sn, cs; sincosf((float)m * (lim * dt), &sn, &cs);
        float* apw = (float*)(F.ws + WS_SSM2 + l * SSM2_LAYER + S2_APW) + ((size_t)(g * 33 + m) * 64 + n) * 2; apw[0] = mag * cs; apw[1] = mag * sn; }
    for (int w = gt; w < DEPTH * SSM_G * SSM_N; w += NGT) { const int l = w / 1024, gn = w % 1024, g = gn >> 6;
        float* tab = (float*)(F.ws + WS_SSM) + (size_t)l * SSM_TAB;
        const float lre = ((const float*)A.in[I_LAMRE])[w], lim = ((const float*)A.in[I_LAMIM])[w];
        const float dt = expf(((const float*)A.in[I_LOGDT])[l * 16 + g]);
        const float mag = expf(lre * dt); float sn, cs; sincosf(lim * dt, &sn, &cs);
        const float are = mag * cs, aim = mag * sn, nr = are - 1.0f, ni = aim, mod2 = lre * lre + lim * lim;
        const float fre = (nr * lre + ni * lim) / mod2, fim = (ni * lre - nr * lim) / mod2;
        tab[gn] = are; tab[1024 + gn] = aim;
        const float* bre = (const float*)A.in[I_BRE] + (size_t)w * 16; const float* bim = (const float*)A.in[I_BIM] + (size_t)w * 16;
#pragma unroll
        for (int cc = 0; cc < 16; ++cc) { tab[2048 + gn * 16 + cc] = fre * bre[cc] - fim * bim[cc]; tab[2048 + 16384 + gn * 16 + cc] = fre * bim[cc] + fim * bre[cc]; } }
}

DI void p_wconv(Frame& F, const Args& A, int l, int part) {
    FRAME_IDS
    if (part == 4) {
        const int gt = F.vcu * NTHR + tid_, NGT = F.G * NTHR;
        const float* tab = (const float*)(F.ws + WS_SSM) + (size_t)l * SSM_TAB;
        const float* apw = (const float*)(F.ws + WS_SSM2 + l * SSM2_LAYER + S2_APW);
        const float* cre = (const float*)A.in[I_CRE] + (size_t)l * 16 * 16 * 64; const float* cim = (const float*)A.in[I_CIM] + (size_t)l * 16 * 16 * 64;
        bf16* KT = (bf16*)(F.ws + WS_SSM2 + l * SSM2_LAYER + S2_KT); bf16* CT = (bf16*)(F.ws + WS_SSM2 + l * SSM2_LAYER + S2_CT);
        bf16* WIN = (bf16*)(F.ws + WS_SSM2 + l * SSM2_LAYER + S2_WIN); bf16* GW = (bf16*)(F.ws + WS_SSM2 + l * SSM2_LAYER + S2_GW);
        for (int w = gt; w < 16 * 16 * 64 * 8; w += NGT) { const int j = w & 7, ln = (w >> 3) & 63, p = (w >> 9) & 15, g = w >> 13;
            const int co = ln & 15, q = ln >> 4, m = 2 * p + (q >> 1), ci = 8 * (q & 1) + j; float acc = 0.f;
            for (int n = 0; n < 64; ++n) { const int gn = g * 64 + n; const float ar = apw[((g * 33 + m) * 64 + n) * 2], ai = apw[((g * 33 + m) * 64 + n) * 2 + 1];
                const float br = tab[2048 + gn * 16 + ci], bi = tab[2048 + 16384 + gn * 16 + ci], tre = ar * br - ai * bi, tim = ar * bi + ai * br;
                acc += cre[(g * 16 + co) * 64 + n] * tre - cim[(g * 16 + co) * 64 + n] * tim; }
            KT[w] = (bf16)f2bf(acc); }
        for (int w = gt; w < 16 * 4 * 64 * 8; w += NGT) { const int j = w & 7, ln = (w >> 3) & 63, sx = (w >> 9) & 3, g = w >> 11;
            const int co = ln & 15, q = ln >> 4, n = 16 * sx + 4 * q + (j >> 1);
            CT[w] = (bf16)f2bf((j & 1) ? -cim[(g * 16 + co) * 64 + n] : cre[(g * 16 + co) * 64 + n]); }
        for (int w = gt; w < 16 * 16 * 8 * 64 * 8; w += NGT) { const int jj = w & 7, ln = (w >> 3) & 63, ct = (w >> 9) & 7, sp = (w >> 12) & 15, g = w >> 16;
            const int cc = ln & 15, q = ln >> 4, n = 8 * ct + (cc >> 1), part = cc & 1, tj = 2 * sp + (q >> 1), ci = 8 * (q & 1) + jj, gn = g * 64 + n, m = 31 - tj;
            const float ar = apw[((g * 33 + m) * 64 + n) * 2], ai = apw[((g * 33 + m) * 64 + n) * 2 + 1], br = tab[2048 + gn * 16 + ci], bi = tab[2048 + 16384 + gn * 16 + ci];
            WIN[w] = (bf16)f2bf(part ? (ar * bi + ai * br) : (ar * br - ai * bi)); }
        const float* gws = (const float*)A.in[I_GMWS] + (size_t)l * 4 * 128 * 128;
        for (int w = gt; w < 4 * 128 * 128; w += NGT) { const int sx = w & 127, t = (w >> 7) & 127; GW[w] = (bf16)f2bf(sx <= t ? gws[w] : 0.f); }
    }
}
constexpr int WC_NS = 4 * 8;
DI void p_wconv_items(Frame& F, const Args& A, int l, int lo, int hi) {
    FRAME_IDS
    LAS float* scr = (LAS float*)(F.lds + RING_OFF + wave_ * 16384);
    bf16* GluT = (bf16*)(F.ws + WS_WSMALL + l * WSMALL_LAYER + WOFF_GLU);
    for (int it = lo + F.vcu * NWAVES + wave_; it < hi; it += F.G * NWAVES)
        transpose_item((const float*)A.in[I_GLUW] + (size_t)l * 256 * 256, 256, 256, GluT, RmIdent{0}, scr, it, lane_);
}
template <bool CI_DEST, int KW, class RowMap>
DI void quant_cols32(Frame& F, const float* Wm, int ldw, int n0, unsigned char* W8, const RowMap& rm, float* cinv) {
    FRAME_IDS
    LAS float* scr = (LAS float*)(F.lds + RING_OFF + wave_ * 16384);
    LAS float* red = (LAS float*)(F.lds + RING_OFF + 12288);
    constexpr int NV = KW / 2, KTOT = 8 * KW; const int k0 = KW * wave_;
    const float* W = Wm + (size_t)k0 * ldw + n0;
    const unsigned lofs = (unsigned)((lane_ >> 5) * ldw + (lane_ & 31));
    float v[NV]; float mx = 0.f;
#pragma unroll
    for (int i = 0; i < NV; ++i) v[i] = W[(size_t)(2 * i) * ldw + lofs];
#pragma unroll
    for (int i = 0; i < NV; ++i) mx = fmaxf(mx, fabsf(v[i]));
    red[wave_ * 4096 + lane_] = mx;
    __syncthreads();
    float m2 = 0.f;
#pragma unroll
    for (int w2 = 0; w2 < 8; ++w2) m2 = fmaxf(m2, fmaxf(red[w2 * 4096 + (lane_ & 31)], red[w2 * 4096 + 32 + (lane_ & 31)]));
    const bool z = !(m2 > 1e-30f); const float sc = z ? 1.0f : 440.0f / m2;
    if (tid_ < 32) { const int n = n0 + tid_; const float qf = (RowMap::SCALEQ && n >= COL_Q && n < COL_K) ? QSCALE : 1.0f; cinv[CI_DEST ? rm(n) : n] = (z ? 1.0f : m2 * (1.0f / 440.0f)) * qf; }
    const int c = lane_ & 7;
#pragma unroll
    for (int t = 0; t < KW / 64; ++t) {
#pragma unroll
        for (int i = 0; i < 32; ++i) scr[(2 * i + (lane_ >> 5)) * 33 + (lane_ & 31)] = v[32 * t + i] * sc;
        LDS_WAIT(); asm volatile("" ::: "memory");
#pragma unroll
        for (int jj = 0; jj < 4; ++jj) { const int n = (lane_ >> 3) + 8 * jj; const LAS float* sp = scr + (8 * c) * 33 + n;
            v2u o; o.x = pk4_fp8(sp[0 * 33], sp[1 * 33], sp[2 * 33], sp[3 * 33]); o.y = pk4_fp8(sp[4 * 33], sp[5 * 33], sp[6 * 33], sp[7 * 33]);
            *(GAS v2u*)(W8 + (size_t)rm(n0 + n) * KTOT + k0 + 64 * t + 8 * c) = o; }
        LDS_WAIT(); asm volatile("" ::: "memory");
    }
    __syncthreads();
}
constexpr int WC_NGU = 16 * 2 * 16, WC_NIN = PROJW / 32;
DI void p_wconv_gu(Frame& F, const Args& A, int l, int first, int stride, int hi) {
    for (int j = first; j < hi; j += stride) { const int e = j >> 5, up = (j >> 4) & 1;
        quant_cols32<false, 128>(F, (const float*)A.in[up ? I_EWU : I_EWG] + ((size_t)l * NEXP + e) * D * DEXP, DEXP, 32 * (j & 15), (unsigned char*)(F.ws + WS_WGU), RmGU{e, up},
                            (float*)(F.ws + WS_CINV) + (size_t)l * 16 * 2 * 512 + (e * 2 + up) * 512); }
}
constexpr int WC_NDN = 16 * 32;
DI void p_wconv_dn(Frame& F, const Args& A, int l, int first, int stride) {
    for (int j = first; j < WC_NDN; j += stride) { const int e = j >> 5;
        quant_cols32<false, 64>(F, (const float*)A.in[I_EWD] + ((size_t)l * NEXP + e) * D * DEXP, D, 32 * (j & 31), (unsigned char*)(F.ws + WS_WD), RmIdent{e * 1024},
                                (float*)(F.ws + WS_CINV_D) + ((size_t)l * NEXP + e) * D); }
}
constexpr int WC_NOUT = D / 32;
DI void p_wconv_out(Frame& F, const Args& A, int l, int first, int stride) {
    for (int j = first; j < WC_NOUT; j += stride)
        quant_cols32<false, 128>(F, (const float*)A.in[I_WOUT] + (size_t)l * D * D, D, 32 * j, (unsigned char*)(F.ws + WS_WSMALL + l * WSMALL_LAYER + WOFF_OUT), RmIdent{0}, (float*)(F.ws + WS_CINV_O) + l * D);
}
DI void p_wconv_in(Frame& F, const Args& A, int l, int first, int stride) {
    for (int j = first; j < WC_NIN; j += stride)
        quant_cols32<true, 128>(F, (const float*)A.in[I_WIN] + (size_t)l * D * PROJW, PROJW, 32 * j, (unsigned char*)(F.ws + WS_WSMALL + l * WSMALL_LAYER + WOFF_IN), RmWin{}, (float*)(F.ws + WS_CINV_IN) + l * PROJW);
}

typedef float f32x2_t __attribute__((ext_vector_type(2)));
typedef __bf16 bf16x2_t __attribute__((ext_vector_type(2)));
DI unsigned cvtpk(float lo, float hi) { f32x2_t v = {lo, hi}; bf16x2_t b = __builtin_convertvector(v, bf16x2_t); return __builtin_bit_cast(unsigned, b); }
struct Row16 { float v[16]; };
DI void row_load_f32(Row16& r, const float* p, int lane) {
    const f32x4* q = (const f32x4*)p;
#pragma unroll
    for (int k = 0; k < 4; ++k) { const f32x4 a = q[k * 64 + lane]; r.v[4 * k] = a.x; r.v[4 * k + 1] = a.y; r.v[4 * k + 2] = a.z; r.v[4 * k + 3] = a.w; }
}
DI void row_load_f32_nt(Row16& r, const float* p, int lane) {
    const f32x4* q = (const f32x4*)p;
#pragma unroll
    for (int k = 0; k < 4; ++k) { const f32x4 a = __builtin_nontemporal_load(&q[k * 64 + lane]); r.v[4 * k] = a.x; r.v[4 * k + 1] = a.y; r.v[4 * k + 2] = a.z; r.v[4 * k + 3] = a.w; }
}
DI void row_load_bf16(Row16& r, const bf16* p, int lane) {
    const v2u* q = (const v2u*)p;
#pragma unroll
    for (int k = 0; k < 4; ++k) { const v2u a = q[k * 64 + lane]; r.v[4 * k] = bflo(a.x); r.v[4 * k + 1] = bfhi(a.x); r.v[4 * k + 2] = bflo(a.y); r.v[4 * k + 3] = bfhi(a.y); }
}
DI void row_store_bf16(const Row16& r, bf16* p, int lane) {
    v2u* q = (v2u*)p;
#pragma unroll
    for (int k = 0; k < 4; ++k) { v2u o; o.x = cvtpk(r.v[4 * k], r.v[4 * k + 1]); o.y = cvtpk(r.v[4 * k + 2], r.v[4 * k + 3]); q[k * 64 + lane] = o; }
}
DI void row_store_fp8(const Row16& r, unsigned char* p, float* sinv, int lane) {
    float am = 0.f;
#pragma unroll
    for (int i = 0; i < 16; ++i) am = fmaxf(am, fabsf(r.v[i]));
    am = wave_max(am); const bool z = !(am > 1e-30f); const float qs = z ? 1.0f : 440.0f / am;
    unsigned* q8 = (unsigned*)p;
#pragma unroll
    for (int k = 0; k < 4; ++k) q8[k * 64 + lane] = pk4_fp8(r.v[4 * k] * qs, r.v[4 * k + 1] * qs, r.v[4 * k + 2] * qs, r.v[4 * k + 3] * qs);
    if (lane == 0) *sinv = z ? 1.0f : am * (1.0f / 440.0f);
}
DI void row_store_f32(const Row16& r, float* p, int lane) {
    f32x4* q = (f32x4*)p;
#pragma unroll
    for (int k = 0; k < 4; ++k) __builtin_nontemporal_store((f32x4){r.v[4 * k], r.v[4 * k + 1], r.v[4 * k + 2], r.v[4 * k + 3]}, &q[k * 64 + lane]);
}
DI void row_ln(Row16& r) {
    float s = 0.f;
#pragma unroll
    for (int i = 0; i < 16; ++i) s += r.v[i];
    const float mean = wave_sum(s) * (1.f / D); float s2 = 0.f;
#pragma unroll
    for (int i = 0; i < 16; ++i) { r.v[i] -= mean; s2 += r.v[i] * r.v[i]; }
    const float rstd = 1.0f / sqrtf(wave_sum(s2) * (1.f / D) + LN_EPS);
#pragma unroll
    for (int i = 0; i < 16; ++i) r.v[i] *= rstd;
}
DI void row_mod(Row16& r, const float* a, const float* b, int lane) {
    Row16 av, bv; row_load_f32(av, a, lane); row_load_f32(bv, b, lane);
#pragma unroll
    for (int i = 0; i < 16; ++i) r.v[i] = r.v[i] * (1.0f + av.v[i]) + bv.v[i];
}
DI void row_affine(Row16& r, const float* g, const float* b, int lane) {
    Row16 av, bv; row_load_f32(av, g, lane); row_load_f32(bv, b, lane);
#pragma unroll
    for (int i = 0; i < 16; ++i) r.v[i] = r.v[i] * av.v[i] + bv.v[i];
}

DI void p_ln_a0(Frame& F, const Args& A) {
    FRAME_IDS
    const int gw = F.vcu * NWAVES + wave_, NGW = F.G * NWAVES;
    const float* x = (const float*)A.in[I_X]; bf16* XN = (bf16*)(F.ws + WS_XN); const float* mod = (const float*)(F.ws + WS_MOD);
    const int bq = gw / (NGW / BATCH), mbase = bq * T + gw % (NGW / BATCH), mstep = NGW / BATCH;
    const float* md = mod + (size_t)bq * 6 * D;
    Row16 msc, msh; row_load_f32(msc, md + 1 * D, lane_); row_load_f32(msh, md + 0 * D, lane_);
    Row16 nx; row_load_f32_nt(nx, x + (size_t)mbase * D, lane_);
    for (int m = mbase; m < (bq + 1) * T; m += mstep) {
        Row16 r = nx; if (m + mstep < (bq + 1) * T) row_load_f32_nt(nx, x + (size_t)(m + mstep) * D, lane_);
        row_ln(r);
#pragma unroll
        for (int i = 0; i < 16; ++i) r.v[i] = r.v[i] * (1.0f + msc.v[i]) + msh.v[i];
        row_store_fp8(r, (unsigned char*)XN + (size_t)m * D, (float*)(F.ws + WS_SA) + m, lane_); }
}

using pg8::Unit; using pg8::BM; using pg8::HALF;
struct EpiInProj {
    static constexpr bool PERM = true, AFTER_DRAIN = false;
    bf16* P; const float* rope; int skip; const float* sa; const float* cinv;
    DI void operator()(const pg8::f32x4 (&acc)[2][2][4][2], const Unit& u, int wr, int wc, int fr, int fq) const {
        if (skip == 1) { if (acc[0][0][0][0][0] == 12345.678f) P[0] = 1; return; }
        const int row0 = u.pm * BM + wr * 64 + fr, pn = u.pn;
        const bool isrope = (pn >= 2 && pn <= 5), dorope = isrope && ((wc & 1) == 0) && (fq < 2);
        asm volatile("" ::: "memory");
        pg8::f32x4 ci[2][2];
#pragma unroll
        for (int bj = 0; bj < 2; ++bj) { const float* cp = cinv + pn * BM + bj * HALF + wc * 32 + 8 * fq; ci[bj][0] = *(const pg8::f32x4*)cp; ci[bj][1] = *(const pg8::f32x4*)(cp + 4); }
#pragma unroll
        for (int ai = 0; ai < 2; ++ai)
#pragma unroll
            for (int m = 0; m < 4; ++m) { const int row = row0 + ai * HALF + m * 16; bf16* rowp = P + (size_t)row * PROJW + pn * BM + wc * 32 + 8 * fq; const float ra = sa[row];
                f32x4 cs = (f32x4){1.f, 1.f, 1.f, 1.f}, sn = (f32x4){0.f, 0.f, 0.f, 0.f};
                if (isrope) { const float* rp = rope + (size_t)row * 16 + 4 * (fq & 1); cs = *(const f32x4*)rp; sn = *(const f32x4*)(rp + 8); }
#pragma unroll
                for (int bj = 0; bj < 2; ++bj) { pg8::f32x4 v0 = acc[ai][bj][m][0] * (ci[bj][0] * ra), v1 = acc[ai][bj][m][1] * (ci[bj][1] * ra);
                    if (isrope) {
                        if (dorope) { const float a0 = v0[0] * cs.x - v0[1] * sn.x, b0 = v0[1] * cs.x + v0[0] * sn.x, a1 = v0[2] * cs.y - v0[3] * sn.y, b1 = v0[3] * cs.y + v0[2] * sn.y;
                            const float a2 = v1[0] * cs.z - v1[1] * sn.z, b2 = v1[1] * cs.z + v1[0] * sn.z, a3 = v1[2] * cs.w - v1[3] * sn.w, b3 = v1[3] * cs.w + v1[2] * sn.w;
                            v0 = (pg8::f32x4){a0, b0, a1, b1}; v1 = (pg8::f32x4){a2, b2, a3, b3}; }
                    }
                    pg8::u32x4 w; w.x = pg8::cvt_pk_bf16(v0[0], v0[1]); w.y = pg8::cvt_pk_bf16(v0[2], v0[3]); w.z = pg8::cvt_pk_bf16(v1[0], v1[1]); w.w = pg8::cvt_pk_bf16(v1[2], v1[3]);
                    if (skip == 2) { asm volatile("" :: "v"(w.x), "v"(w.y), "v"(w.z), "v"(w.w)); } else *(pg8::u32x4*)(rowp + bj * HALF) = w; } }
    }
};
template <bool XF32> struct EpiOut {
    static constexpr bool PERM = true, AFTER_DRAIN = false;
    bf16* PRE; const void* x; int xpitch; const float* mod; const float* cinv;
    DI void operator()(const pg8::f32x4 (&acc)[2][2][4][2], const Unit& u, int wr, int wc, int fr, int fq) const {
        const int row0 = u.pm * BM + wr * 64 + fr, b = (u.pm * BM) / T, colb = u.pn * BM + wc * 32 + 8 * fq;
        const float* g1 = mod + (size_t)b * 6 * D + 2 * D;
        pg8::f32x4 gv[2][2];
#pragma unroll
        for (int bj = 0; bj < 2; ++bj) { gv[bj][0] = (*(const pg8::f32x4*)(g1 + colb + bj * HALF) + 1.0f) * *(const pg8::f32x4*)(cinv + colb + bj * HALF); gv[bj][1] = (*(const pg8::f32x4*)(g1 + colb + bj * HALF + 4) + 1.0f) * *(const pg8::f32x4*)(cinv + colb + bj * HALF + 4); }
#pragma unroll
        for (int ai = 0; ai < 2; ++ai)
#pragma unroll
            for (int m = 0; m < 4; ++m) { const int row = row0 + ai * HALF + m * 16;
#pragma unroll
                for (int bj = 0; bj < 2; ++bj) { const int col = colb + bj * HALF; pg8::f32x4 x0, x1;
                    if (XF32) { const float* xp = (const float*)x + (size_t)row * xpitch + col; x0 = *(const pg8::f32x4*)xp; x1 = *(const pg8::f32x4*)(xp + 4); }
                    else { const pg8::u32x4 xw = *(const pg8::u32x4*)((const bf16*)x + (size_t)row * xpitch + col);
                        x0 = (pg8::f32x4){bflo(xw.x), bfhi(xw.x), bflo(xw.y), bfhi(xw.y)}; x1 = (pg8::f32x4){bflo(xw.z), bfhi(xw.z), bflo(xw.w), bfhi(xw.w)}; }
                    const pg8::f32x4 v0 = x0 * ALPHA + gv[bj][0] * acc[ai][bj][m][0], v1 = x1 * ALPHA + gv[bj][1] * acc[ai][bj][m][1];
                    pg8::u32x4 w; w.x = pg8::cvt_pk_bf16(v0[0], v0[1]); w.y = pg8::cvt_pk_bf16(v0[2], v0[3]); w.z = pg8::cvt_pk_bf16(v1[0], v1[1]); w.w = pg8::cvt_pk_bf16(v1[2], v1[3]);
                    *(pg8::u32x4*)(PRE + (size_t)row * D + col) = w; } }
    }
};
struct OutOrder : pg8::StaticOrder {
    const char* xbase; unsigned rowbytes, tilecolbytes; LAS unsigned char* dump;
    DI void a_ready(const Unit& u) const {
        const int tid = threadIdx.x, wid = __builtin_amdgcn_readfirstlane(tid >> 6), lane = tid & 63;
        const int lpr = (int)(tilecolbytes >> 7);
        const char* t0 = xbase + (size_t)u.pm * 256 * rowbytes + (size_t)u.pn * tilecolbytes;
        const int nline = 256 * lpr;
        for (int i = wid * 64 + lane; i < nline; i += 512) { const int r = i / lpr, c = i % lpr;
            __builtin_amdgcn_global_load_lds((const unsigned*)(t0 + (size_t)r * rowbytes + (size_t)c * 128), (LAS unsigned*)(dump + wid * 256), 4, 0, 0); }
    }
};
struct EpiGlu {
    static constexpr bool PERM = true, AFTER_DRAIN = false;
    const bf16* YG; bf16* MIX; const float* gb;
    DI void operator()(const pg8::f32x4 (&acc)[2][2][4][2], const Unit& u, int wr, int wc, int fr, int fq) const {
        const int row0 = u.pm * BM + wr * 64 + fr, colb = wc * 32 + 8 * fq;
#pragma unroll
        for (int ai = 0; ai < 2; ++ai)
#pragma unroll
            for (int m = 0; m < 4; ++m) { const int row = row0 + ai * HALF + m * 16;
#pragma unroll
                for (int bj = 0; bj < 2; ++bj) { const int col = colb + bj * HALF;
                    const pg8::u32x4 yw = *(const pg8::u32x4*)(YG + (size_t)row * 256 + col);
                    const pg8::f32x4 b0 = *(const pg8::f32x4*)(gb + col), b1 = *(const pg8::f32x4*)(gb + col + 4);
                    const pg8::f32x4 a0 = acc[ai][bj][m][0] + b0, a1 = acc[ai][bj][m][1] + b1;
                    const float y[8] = {bflo(yw.x), bfhi(yw.x), bflo(yw.y), bfhi(yw.y), bflo(yw.z), bfhi(yw.z), bflo(yw.w), bfhi(yw.w)};
                    float o[8];
#pragma unroll
                    for (int i = 0; i < 4; ++i) { o[i] = y[i] * sigmoid_f(a0[i]); o[4 + i] = y[4 + i] * sigmoid_f(a1[i]); }
                    pg8::u32x4 w; w.x = pg8::cvt_pk_bf16(o[0], o[1]); w.y = pg8::cvt_pk_bf16(o[2], o[3]); w.z = pg8::cvt_pk_bf16(o[4], o[5]); w.w = pg8::cvt_pk_bf16(o[6], o[7]);
                    *(pg8::u32x4*)(MIX + (size_t)row * D + 768 + col) = w; asm volatile("" ::: "memory"); } }
    }
};
template <int KIND> struct MoeOrderK {
    const volatile LAS int* ts; int G, c; const int* slot_a; const float* slot_w; gu32* done_cnt; gu32* queue; volatile LAS int* qs;
    DI bool decode(int off, Unit& u) const {
        const int nwg = ts[16] * 4, q = nwg / 8, r = nwg % 8, xcd = c % 8; const int cntx = q + (xcd < r ? 1 : 0); if (off >= cntx) return false;
        const int wgid = (xcd < r ? xcd * (q + 1) : r * (q + 1) + (xcd - r) * q) + off;
        const int tm = wgid >> 2, j = wgid & 3; int e = 0;
#pragma unroll
        for (int k = 1; k < 16; ++k) e += (ts[k] <= tm) ? 1 : 0;
        u.pm = tm; u.pn = e * 4 + j; return true; }
    DI bool first(Unit& u) const {
        if (KIND == 0) return next(0, u);
        if (threadIdx.x == 0) { const unsigned a = __hip_atomic_fetch_add(queue + 16 * (c % 8), 2u, RLX_AGENT); qs[0] = (int)a; qs[1] = (int)a + 1; }
        asm volatile("s_waitcnt vmcnt(0) lgkmcnt(0)" ::: "memory"); __builtin_amdgcn_s_barrier(); asm volatile("" ::: "memory");
        return decode(qs[0], u);
    }
    DI bool more(int i, Unit& u) const {
        if (KIND == 0) return next(i, u);
        return decode(qs[i & 1], u);
    }
    DI bool next(int i, Unit& u) const {
        const int nwg = ts[16] * 4; const int cc = c;
        const long L = (long)i * G + cc; if (L >= nwg) return false;
        int wgid = (int)L; { const int q = nwg / 8, r = nwg % 8, xcd = wgid % 8, off = wgid / 8; wgid = (xcd < r ? xcd * (q + 1) : r * (q + 1) + (xcd - r) * q) + off; }
        const int tm = wgid >> 2, j = wgid & 3; int e = 0;
#pragma unroll
        for (int k = 1; k < 16; ++k) e += (ts[k] <= tm) ? 1 : 0;
        u.pm = tm; u.pn = e * 4 + j; return true;
    }
    const unsigned char* hsc;
    struct Pf { unsigned a, w, c, q; };
    DI const unsigned char* scale_base(const Unit& u) const { return hsc + (size_t)u.pm * 4096; }
    DI void pull_issue(int tid, Pf& pf) const { if (KIND == 1 && tid == 0) pf.q = __hip_atomic_fetch_add(queue + 16 * (c % 8), 1u, RLX_AGENT); }
    DI void pull_publish(int tid, const Pf& pf, int ui) const { if (KIND == 1 && tid == 0 && ui >= 0) qs[ui & 1] = (int)pf.q; }
    DI void prefetch(const Unit& u, int r, Pf& pf) const {
        const int e = u.pn >> 2, idx = (u.pm - ts[e]) * 256 + (r & 255); const bool valid = idx < ts[32 + e];
        pf.a = 0xffffffffu; pf.w = 0u; pf.c = 32u;
        if (valid && r < 256) { pf.a = (unsigned)slot_a[(size_t)e * SLOT_CAP + idx]; if (KIND == 1) pf.w = __float_as_uint(slot_w[(size_t)e * SLOT_CAP + idx]); }
        if (KIND == 1 && r < 64) pf.c = __hip_atomic_load(done_cnt + u.pm, RLX_AGENT);
    }
    DI void finish_meta(const Unit& u, int r, const Pf& pf, unsigned& off, unsigned& a0, unsigned& a1) const {
        if (KIND == 0) { const bool pad = pf.a == 0xffffffffu; off = (pad ? 0u : ((pf.a & 0xffffu) >> 1)) * (unsigned)D; a0 = 0u; a1 = pad ? 0u : (pf.a & 0xffff0000u); }
        else { off = (unsigned)(u.pm * 256 + r) * (unsigned)DEXP; a0 = pf.a == 0xffffffffu ? pf.a : (pf.a & 0xffffu); a1 = pf.w; }
    }
    DI void wait_ready(const Unit& u, int tid, const Pf& pf) const {
        if (KIND == 1 && tid < 64) { unsigned sp = 0;
            if ((unsigned)__builtin_amdgcn_readfirstlane((int)pf.c) < 32u)
                while ((unsigned)__builtin_amdgcn_readfirstlane((int)__hip_atomic_load(done_cnt + u.pm, RLX_AGENT)) < 32u) { __builtin_amdgcn_s_sleep(2); if (++sp > (1u << 20)) break; } }
    }
    DI void a_ready(const Unit&) const {}
    DI void done_nowait(const Unit& u) const { if (KIND == 0 && (threadIdx.x & 63) == 0) __hip_atomic_fetch_add(done_cnt + u.pm, 1u, RLX_AGENT); }
};
struct EpiG1 {
    static constexpr bool PERM = true, AFTER_DRAIN = false;
    unsigned char* HID; int skip; const float* cinv; unsigned char* HSC;
    DI void operator()(const pg8::f32x4 (&acc)[2][2][4][2], const Unit& u, int wr, int wc, int fr, int fq, const LAS unsigned* meta) const {
        if (skip == 1) { if (acc[0][0][0][0][0] == 12345.678f) HID[0] = 1; return; }
        const __amdgpu_buffer_rsrc_t rs = __builtin_amdgcn_make_buffer_rsrc((void*)HID, 0, (int)((size_t)NSLOT_MAX * DEXP), 0x00020000);
        const __amdgpu_buffer_rsrc_t rsc = __builtin_amdgcn_make_buffer_rsrc((void*)HSC, 0, (int)((size_t)NSLOT_MAX * 16), 0x00020000);
        const int ln_ = ftid() & 63, fr_ = ln_ & 15, fq_ = ln_ >> 4; (void)fr; (void)fq;
        const int e = u.pn >> 2, j = u.pn & 3, r0 = wr * 64 + fr_, row0 = u.pm * BM + r0, col = j * 128 + wc * 32 + 8 * fq_;
        asm volatile("" ::: "memory");
        const float* cg = cinv + (e * 2 + 0) * 512 + col; const float* cu = cinv + (e * 2 + 1) * 512 + col;
        const pg8::f32x4 cg0 = *(const pg8::f32x4*)cg, cg1 = *(const pg8::f32x4*)(cg + 4), cu0 = *(const pg8::f32x4*)cu, cu1 = *(const pg8::f32x4*)(cu + 4);
#pragma unroll
        for (int ai = 0; ai < 2; ++ai)
#pragma unroll
            for (int m = 0; m < 4; ++m) { const int rl = r0 + ai * HALF + m * 16, row = row0 + ai * HALF + m * 16; float o[8];
                const float ra = __uint_as_float(meta[512 + rl]);
#pragma unroll
                for (int i = 0; i < 4; ++i) { o[i] = silu_f(acc[ai][0][m][0][i] * (ra * cg0[i])) * (acc[ai][1][m][0][i] * (ra * cu0[i])); o[4 + i] = silu_f(acc[ai][0][m][1][i] * (ra * cg1[i])) * (acc[ai][1][m][1][i] * (ra * cu1[i])); }
                float bm = fmaxf(fmaxf(fmaxf(fabsf(o[0]), fabsf(o[1])), fmaxf(fabsf(o[2]), fabsf(o[3]))), fmaxf(fmaxf(fabsf(o[4]), fabsf(o[5])), fmaxf(fabsf(o[6]), fabsf(o[7]))));
                bm = fmaxf(bm, __shfl_xor(bm, 16)); bm = fmaxf(bm, __shfl_xor(bm, 32));
                unsigned eb = (__float_as_uint(bm * (1.0f / 448.0f)) + 0x7fffffu) >> 23; eb = eb < 1u ? 1u : (eb > 254u ? 254u : eb);
                const float mult = __uint_as_float((254u - eb) << 23);
                v2u w; w.x = pk4_fp8(o[0] * mult, o[1] * mult, o[2] * mult, o[3] * mult); w.y = pk4_fp8(o[4] * mult, o[5] * mult, o[6] * mult, o[7] * mult);
                __builtin_amdgcn_raw_buffer_store_b64(w, rs, row * DEXP + col, 0, 16);
                if (fq_ == 0) __builtin_amdgcn_raw_buffer_store_b8((unsigned char)eb, rsc, ((u.pm * 4 + j) * 256 + rl) * 4 + wc, 0, 16); }
    }
};
struct EpiG2 {
    static constexpr bool PERM = true, AFTER_DRAIN = false;
    bf16* ROWS; int skip; const float* cinv;
    DI void operator()(const pg8::f32x4 (&acc)[2][2][4][2], const Unit& u, int wr, int wc, int fr, int fq, const LAS unsigned* meta) const {
        if (skip == 1) { if (acc[0][0][0][0][0] == 12345.678f) ROWS[0] = 1; return; }
        const int r0 = wr * 64 + fr, colb = (u.pn & 3) * BM + wc * 32 + 8 * fq;
        asm volatile("" ::: "memory");
        pg8::f32x4 ci[2][2];
#pragma unroll
        for (int bj = 0; bj < 2; ++bj) { const float* cp = cinv + (u.pn >> 2) * D + colb + bj * HALF; ci[bj][0] = *(const pg8::f32x4*)cp; ci[bj][1] = *(const pg8::f32x4*)(cp + 4); }
#pragma unroll
        for (int ai = 0; ai < 2; ++ai)
#pragma unroll
            for (int m = 0; m < 4; ++m) { const int r = r0 + ai * HALF + m * 16; const int d = (int)meta[256 + r]; const float wt = __uint_as_float(meta[512 + r]);
                if (d >= 0) {
#pragma unroll
                    for (int bj = 0; bj < 2; ++bj) { const pg8::f32x4 v0 = acc[ai][bj][m][0] * (ci[bj][0] * wt), v1 = acc[ai][bj][m][1] * (ci[bj][1] * wt);
                        pg8::u32x4 w; w.x = pg8::cvt_pk_bf16(v0[0], v0[1]); w.y = pg8::cvt_pk_bf16(v0[2], v0[3]); w.z = pg8::cvt_pk_bf16(v1[0], v1[1]); w.w = pg8::cvt_pk_bf16(v1[2], v1[3]);
                        *(pg8::u32x4*)(ROWS + (size_t)d * D + colb + bj * HALF) = w; } } }
    }
};

DI void mix_gating_simple(Frame& F, const Args& A, int l) {
    FRAME_IDS
    const bf16* P = (const bf16*)(F.ws + WS_PROJ); bf16* MIX = (bf16*)(F.ws + WS_MIXCAT);
    const float* lng = (const float*)A.in[I_GMLNG] + l * AW; const float* lnb = (const float*)A.in[I_GMLNB] + l * AW;
    const float* ws_ = (const float*)A.in[I_GMWS] + (size_t)l * 4 * 128 * 128; const float* bs_ = (const float*)A.in[I_GMBS] + l * 4 * 128;
    LAS float* vln = (LAS float*)(F.lds + RING_OFF);
    for (int it = F.vcu; it < BATCH * (T / 128); it += F.G) {
        const int m0 = it * 128;
        for (int r = wave_; r < 128; r += NWAVES) {
            const v2u w = *(const v2u*)(P + (size_t)(m0 + r) * PROJW + COL_V + 4 * lane_);
            float v[4] = {gelu_tanh_f(bflo(w.x)), gelu_tanh_f(bfhi(w.x)), gelu_tanh_f(bflo(w.y)), gelu_tanh_f(bfhi(w.y))};
            const float mean = wave_sum(v[0] + v[1] + v[2] + v[3]) * (1.f / 256.f);
            float s2 = 0.f;
#pragma unroll
            for (int i = 0; i < 4; ++i) { v[i] -= mean; s2 += v[i] * v[i]; }
            const float rstd = 1.0f / sqrtf(wave_sum(s2) * (1.f / 256.f) + LN_EPS);
#pragma unroll
            for (int i = 0; i < 4; ++i) vln[r * 256 + 4 * lane_ + i] = v[i] * rstd * lng[4 * lane_ + i] + lnb[4 * lane_ + i];
        }
        __syncthreads();
        { const int c = tid_ & 255, tp = tid_ >> 8, h = c >> 6;
          for (int t = tp; t < 128; t += 2) { const float* wrow = ws_ + ((size_t)h * 128 + t) * 128; float acc = 0.f;
              for (int s = 0; s <= t; ++s) acc += wrow[s] * vln[s * 256 + c];
              const float uu = gelu_tanh_f(bf2f(P[(size_t)(m0 + t) * PROJW + COL_U + c]));
              MIX[(size_t)(m0 + t) * D + c] = (bf16)f2bf(uu * (acc + bs_[h * 128 + t])); } }
        __syncthreads();
    }
}
DI void mix_attn_simple(Frame& F, int l) {
    FRAME_IDS
    const bf16* P = (const bf16*)(F.ws + WS_PROJ); bf16* MIX = (bf16*)(F.ws + WS_MIXCAT);
    const int gw = F.vcu * NWAVES + wave_, NGW = F.G * NWAVES;
    for (int it = gw; it < M * NH; it += NGW) {
        const int m = it >> 3, h = it & 7, t = m & (T - 1);
        const float q = bf2f(P[(size_t)m * PROJW + COL_Q + h * 64 + lane_]);
        float mx = -1e30f, den = 0.f, o = 0.f;
#pragma unroll 1
        for (int g = 0; g < 3; ++g) { const int dl = (g == 0) ? 1 : (g == 1 ? 4 : 16);
            int nk = t / dl; if (nk > 128) nk = 128;
#pragma unroll 2
            for (int j = 0; j <= nk; ++j) { const size_t mk = (size_t)(m - j * dl);
                const float kv = bf2f(P[mk * PROJW + COL_K + h * 64 + lane_]); const float vv = bf2f(P[mk * PROJW + COL_VA + h * 64 + lane_]);
                const float s = wave_sum(q * kv);
                const float mn = fmaxf(mx, s), f = __builtin_amdgcn_exp2f(mx - mn), p = __builtin_amdgcn_exp2f(s - mn);
                den = den * f + p; o = o * f + p * vv; mx = mn; } }
        MIX[(size_t)m * D + AW + h * 64 + lane_] = (bf16)f2bf(o / den);
    }
}

typedef float f32x16 __attribute__((ext_vector_type(16)));
typedef short v4i16_t __attribute__((ext_vector_type(4)));
DI int crow16(int r, int hi) { return (r & 3) + 8 * (r >> 2) + 4 * hi; }
template <int SUB> DI void mix_attn_mfma(Frame& F, int l) {
    FRAME_IDS
    const bf16* P = (const bf16*)(F.ws + WS_PROJ);
    LAS unsigned char* Ks = F.lds + RING_OFF; LAS unsigned char* Vs = Ks + 49152;
    LAS unsigned char* St = F.lds + ATT_STAGE_OFF + wave_ * 4608;
    const int ql = lane_ & 31, hi = lane_ >> 5, prow = lane_ >> 3, pch = lane_ & 7;
    constexpr int nitems = SUB == 0 ? 2048 : 1024;
    v4u kreg[6], vreg[6], qraw[4]; bf16x8 qf[4];
    int it = F.vcu; if (it >= nitems) return;
    int d, r, s0, b, h; size_t tokbase;
#define ATT_DECODE(IT) do { const int idx_ = (IT) & 1023; b = idx_ >> 7; h = (idx_ >> 4) & 7; int tile_; \
        if (SUB == 1) { d = 1; r = 0; tile_ = idx_ & 15; } else if ((IT) < 1024) { d = 16; r = idx_ & 15; tile_ = 0; } else { d = 4; r = (idx_ >> 2) & 3; tile_ = idx_ & 3; } \
        s0 = tile_ * 256; tokbase = (size_t)b * T + r; } while (0)
#define ATT_LOAD() do { const int tl_ = ftid(); _Pragma("unroll") for (int i = 0; i < 6; ++i) { const int idx2 = tl_ + 512 * i, row = idx2 >> 3, ch = idx2 & 7, step = s0 - 128 + row; \
            if (step >= 0) { const bf16* src = P + (tokbase + (size_t)step * d) * PROJW + h * 64 + ch * 8; kreg[i] = *(const v4u*)(src + COL_K); vreg[i] = *(const v4u*)(src + COL_VA); } \
            else { kreg[i] = (v4u){0u, 0u, 0u, 0u}; vreg[i] = (v4u){0u, 0u, 0u, 0u}; } } \
        _Pragma("unroll") for (int p = 0; p < 4; ++p) qraw[p] = *(const v4u*)(P + (tokbase + (size_t)(s0 + 32 * wave_ + 8 * p + prow) * d) * PROJW + COL_Q + h * 64 + pch * 8); } while (0)
#define ATT_WRITE() do { const int tw_ = ftid(); _Pragma("unroll") for (int i = 0; i < 6; ++i) { const int idx2 = tw_ + 512 * i, row = idx2 >> 3, ch = idx2 & 7; \
            *(LAS v4u*)(Ks + row * 128 + ((ch ^ ((row >> 1) & 7)) << 4)) = kreg[i]; \
            *(LAS v4u*)(Vs + row * 128 + ((ch ^ (((row >> 1) & 1) << 2)) << 4)) = vreg[i]; } \
        _Pragma("unroll") for (int p = 0; p < 4; ++p) *(LAS v4u*)(St + (8 * p + prow) * 144 + pch * 16) = qraw[p]; } while (0)
    ATT_DECODE(it); ATT_LOAD(); ATT_WRITE();
    __syncthreads();
    for (;;) {
        const size_t tb = tokbase; const int s0c = s0, dc = d, hcur = h, itcur = it;
        const bool first = (s0 == 0);
#pragma unroll
        for (int ks = 0; ks < 4; ++ks) qf[ks] = *(const LAS bf16x8*)(St + ql * 144 + (2 * ks + hi) * 16);
        const int itn = it + F.G; const bool has_next = itn < nitems;
        if (has_next) { ATT_DECODE(itn); ATT_LOAD(); }
        const int i0 = 32 * wave_;
        f32x16 S[5];
#pragma unroll
        for (int kb = 0; kb < 5; ++kb) { f32x16 acc;
#pragma unroll
            for (int i = 0; i < 16; ++i) acc[i] = 0.f;
            const int krow = i0 + 32 * kb + ql;
#pragma unroll
            for (int ks = 0; ks < 4; ++ks) { const bf16x8 a = *(const LAS bf16x8*)(Ks + krow * 128 + (((2 * ks + hi) ^ ((krow >> 1) & 7)) << 4)); acc = __builtin_amdgcn_mfma_f32_32x32x16_bf16(a, qf[ks], acc, 0, 0, 0); }
            S[kb] = acc; }
        int qrel = ql - 4 * hi; asm volatile("" : "+v"(qrel));
        float mx = -1e30f;
#pragma unroll
        for (int kb = 0; kb < 5; ++kb) {
            const bool bvalid = !first || (wave_ + kb >= 4);
            if (!bvalid) {
#pragma unroll
                for (int i = 0; i < 16; ++i) S[kb][i] = -1e30f;
            } else {
#pragma unroll
                for (int i = 0; i < 16; ++i) { const int c0 = crow16(i, 0); float v = S[kb][i];
                    if (kb == 0) v = (c0 >= qrel) ? v : -1e30f;
                    if (kb == 4) v = (c0 <= qrel) ? v : -1e30f;
                    S[kb][i] = v; mx = fmaxf(mx, v); }
            }
        }
        mx = fmaxf(mx, __shfl_xor(mx, 32));
        float lsum = 0.f;
#pragma unroll
        for (int kb = 0; kb < 5; ++kb)
#pragma unroll
            for (int i = 0; i < 16; ++i) { const float p = __builtin_amdgcn_exp2f(S[kb][i] - mx); S[kb][i] = p; lsum += p; }
        lsum += __shfl_xor(lsum, 32);
        v4u x16[4], x4[4]; f32x2_t s16 = {0.f, 0.f}, s4 = {0.f, 0.f};
        if (SUB == 1) {
            const size_t qt = tb + (size_t)(s0c + i0 + ql) * dc;
            s16 = *(const f32x2_t*)((const float*)(F.ws + WS_STAT) + (qt * NH + hcur) * 2); s4 = *(const f32x2_t*)((const float*)(F.ws + WS_STAT) + (size_t)M * NH * 2 + (qt * NH + hcur) * 2);
        }
        f32x16 O[2];
#pragma unroll
        for (int i = 0; i < 16; ++i) { O[0][i] = 0.f; O[1][i] = 0.f; }
        const int trq = (lane_ & 15) >> 2, trg = (lane_ >> 4) & 1, trp = lane_ & 3;
#pragma unroll
        for (int kb = 0; kb < 5; ++kb)
#pragma unroll
            for (int s = 0; s < 2; ++s) {
                if (SUB == 1 && kb == 2 && s == 0) {
#pragma unroll
                    for (int p = 0; p < 4; ++p) { const size_t rt = tb + (size_t)(s0c + i0 + 8 * p + prow) * dc; const bf16* pp = (const bf16*)(F.ws + WS_XN) + rt * BW + hcur * 64 + pch * 8;
                        x16[p] = *(const v4u*)pp; x4[p] = *(const v4u*)(pp + (size_t)M * BW); } }
                v4u pw; pw.x = cvtpk(S[kb][8 * s], S[kb][8 * s + 1]); pw.y = cvtpk(S[kb][8 * s + 2], S[kb][8 * s + 3]); pw.z = cvtpk(S[kb][8 * s + 4], S[kb][8 * s + 5]); pw.w = cvtpk(S[kb][8 * s + 6], S[kb][8 * s + 7]);
                const bf16x8 pb = __builtin_bit_cast(bf16x8, pw);
                const int rlo = i0 + 32 * kb + 16 * s + 4 * hi + trq, rhi = rlo + 8;
#pragma unroll
                for (int dh = 0; dh < 2; ++dh) { const int chunk = 4 * dh + 2 * trg + (trp >> 1);
                    const v4i16_t lo = __builtin_amdgcn_ds_read_tr16_b64_v4i16((LAS v4i16_t*)(Vs + rlo * 128 + ((chunk ^ (((rlo >> 1) & 1) << 2)) << 4) + 8 * (trp & 1)));
                    const v4i16_t hh = __builtin_amdgcn_ds_read_tr16_b64_v4i16((LAS v4i16_t*)(Vs + rhi * 128 + ((chunk ^ (((rhi >> 1) & 1) << 2)) << 4) + 8 * (trp & 1)));
                    const bf16x8 va = (bf16x8){lo[0], lo[1], lo[2], lo[3], hh[0], hh[1], hh[2], hh[3]};
                    O[dh] = __builtin_amdgcn_mfma_f32_32x32x16_bf16(va, pb, O[dh], 0, 0, 0); } }
        float osc;
        if (SUB == 0) osc = 1.0f / lsum;
        else { const float MM = fmaxf(mx, fmaxf(s16.x, s4.x)), a1 = __builtin_amdgcn_exp2f(mx - MM), a16 = s16.y * __builtin_amdgcn_exp2f(s16.x - MM), a4 = s4.y * __builtin_amdgcn_exp2f(s4.x - MM);
            const float inv = 1.0f / (lsum * a1 + a16 + a4); osc = a1 * inv;
            if (hi == 0) { f32x2_t cc = {a16 * inv, a4 * inv}; *(LAS f32x2_t*)(St + ql * 144 + 128) = cc; } }
#pragma unroll
        for (int dh = 0; dh < 2; ++dh)
#pragma unroll
            for (int g4 = 0; g4 < 4; ++g4) { v2u w; w.x = cvtpk(O[dh][4 * g4] * osc, O[dh][4 * g4 + 1] * osc); w.y = cvtpk(O[dh][4 * g4 + 2] * osc, O[dh][4 * g4 + 3] * osc);
                *(LAS v2u*)(St + ql * 144 + (32 * dh + 8 * g4 + 4 * hi) * 2) = w; }
        if (SUB == 0) {
            bf16* PART = (bf16*)(F.ws + WS_XN) + (itcur < 1024 ? 0 : (size_t)M * BW); float* ST = (float*)(F.ws + WS_STAT) + (itcur < 1024 ? 0 : (size_t)M * NH * 2);
            if (hi == 0) { const size_t qt = tb + (size_t)(s0c + i0 + ql) * dc; f32x2_t st = {mx, lsum}; *(f32x2_t*)(ST + (qt * NH + hcur) * 2) = st; }
#pragma unroll
            for (int p = 0; p < 4; ++p) { const size_t rt = tb + (size_t)(s0c + i0 + 8 * p + prow) * dc;
                *(v4u*)(PART + rt * BW + hcur * 64 + pch * 8) = *(const LAS v4u*)(St + (8 * p + prow) * 144 + pch * 16); }
        } else {
#pragma unroll
            for (int p = 0; p < 4; ++p) { const size_t rt = tb + (size_t)(s0c + i0 + 8 * p + prow) * dc;
                const v4u ov = *(const LAS v4u*)(St + (8 * p + prow) * 144 + pch * 16); const f32x2_t cc = *(const LAS f32x2_t*)(St + (8 * p + prow) * 144 + 128);
                float f[8];
                f[0] = bflo(ov.x) + cc.x * bflo(x16[p].x) + cc.y * bflo(x4[p].x); f[1] = bfhi(ov.x) + cc.x * bfhi(x16[p].x) + cc.y * bfhi(x4[p].x);
                f[2] = bflo(ov.y) + cc.x * bflo(x16[p].y) + cc.y * bflo(x4[p].y); f[3] = bfhi(ov.y) + cc.x * bfhi(x16[p].y) + cc.y * bfhi(x4[p].y);
                f[4] = bflo(ov.z) + cc.x * bflo(x16[p].z) + cc.y * bflo(x4[p].z); f[5] = bfhi(ov.z) + cc.x * bfhi(x16[p].z) + cc.y * bfhi(x4[p].z);
                f[6] = bflo(ov.w) + cc.x * bflo(x16[p].w) + cc.y * bflo(x4[p].w); f[7] = bfhi(ov.w) + cc.x * bfhi(x16[p].w) + cc.y * bfhi(x4[p].w);
                float bm = fmaxf(fmaxf(fmaxf(fabsf(f[0]), fabsf(f[1])), fmaxf(fabsf(f[2]), fabsf(f[3]))), fmaxf(fmaxf(fabsf(f[4]), fabsf(f[5])), fmaxf(fabsf(f[6]), fabsf(f[7]))));
                bm = fmaxf(bm, dpp_mov<0xB1>(bm)); bm = fmaxf(bm, dpp_mov<0x4E>(bm)); float mult; const unsigned eb = mx_scale(bm, mult);
                v2u o; o.x = pk4_fp8(f[0] * mult, f[1] * mult, f[2] * mult, f[3] * mult); o.y = pk4_fp8(f[4] * mult, f[5] * mult, f[6] * mult, f[7] * mult);
                *(v2u*)((unsigned char*)(F.ws + WS_MIXCAT) + rt * D + AW + hcur * 64 + pch * 8) = o;
                if ((pch & 3) == 0) ((unsigned char*)(F.ws + WS_SCM))[scm_index((int)rt, (AW + hcur * 64 + pch * 8) >> 5)] = (unsigned char)eb; }
        }
        __syncthreads();
        if (!has_next) break;
        ATT_WRITE(); it = itn;
        __syncthreads();
    }
#undef ATT_DECODE
#undef ATT_LOAD
#undef ATT_WRITE
}
typedef float f32x4_t __attribute__((ext_vector_type(4)));
DI void cmul_acc(float& xr, float& xi, float ar, float ai, float br, float bi) { const float nr = ar * xr - ai * xi + br, ni = ar * xi + ai * xr + bi; xr = nr; xi = ni; }
DI void mix_ssm_in(Frame& F, int l) {
    FRAME_IDS
    const bf16* P = (const bf16*)(F.ws + WS_PROJ);
    const bf16* WIN = (const bf16*)(F.ws + WS_SSM2 + l * SSM2_LAYER + S2_WIN);
    const float* apw = (const float*)(F.ws + WS_SSM2 + l * SSM2_LAYER + S2_APW);
    float* XLOC = (float*)(F.ws + WS_XLOC); float* XSUP = (float*)(F.ws + WS_XSUP);
    const int row = lane_ & 15, q = lane_ >> 4;
    for (int it = F.vcu; it < 256; it += F.G) {
        const int b = it >> 5, sc = (it >> 2) & 7, g = 4 * (it & 3) + (wave_ >> 1), half = wave_ & 1;
        bf16x8 af[16];
        { const bf16* src = P + ((size_t)b * T + (size_t)(16 * sc + row) * 32 + (q >> 1)) * PROJW + COL_S + g * 16 + 8 * (q & 1);
#pragma unroll
          for (int sp = 0; sp < 16; ++sp) af[sp] = *(const bf16x8*)(src + (size_t)(2 * sp) * PROJW); }
#pragma unroll 1
        for (int c4 = 0; c4 < 4; ++c4) { const int ct = 4 * half + c4;
            f32x4_t acc = {0.f, 0.f, 0.f, 0.f};
            const bf16* wp = WIN + (((size_t)(g * 16) * 8 + ct) * 64 + lane_) * 8;
#pragma unroll
            for (int sp = 0; sp < 16; ++sp) { const bf16x8 bfr = *(const bf16x8*)(wp + (size_t)sp * 8 * 64 * 8); acc = __builtin_amdgcn_mfma_f32_16x16x32_bf16(af[sp], bfr, acc, 0, 0, 0); }
            const int comp = 16 * ct + row, n = comp >> 1, part = comp & 1;
#pragma unroll
            for (int r = 0; r < 4; ++r) XLOC[(((size_t)b * 128 + 16 * sc + 4 * q + r) * 16 + g) * 128 + comp] = acc[r];
            const float a32r = apw[((g * 33 + 32) * 64 + n) * 2], a32i = apw[((g * 33 + 32) * 64 + n) * 2 + 1];
            const float sg = part ? 1.f : -1.f;
            float h = acc[0];
#pragma unroll
            for (int r = 1; r < 4; ++r) { const float o = __shfl_xor(h, 1); h = a32r * h + sg * a32i * o + acc[r]; }
            float p64r = a32r * a32r - a32i * a32i, p64i = 2.f * a32r * a32i;
            float p128r = p64r * p64r - p64i * p64i, p128i = 2.f * p64r * p64i;
            float wr = 1.f, wi = 0.f;
            for (int k = 0; k < 3 - q; ++k) { const float t0 = wr * p128r - wi * p128i, t1 = wr * p128i + wi * p128r; wr = t0; wi = t1; }
            { const float o = __shfl_xor(h, 1); h = wr * h + sg * wi * o; }
            h += __shfl_xor(h, 16); h += __shfl_xor(h, 32);
            if (q == 0) XSUP[(((size_t)b * 8 + sc) * 16 + g) * 128 + comp] = h;
        }
    }
}
DI void mix_ssm_out(Frame& F, const Args& A, int l) {
    FRAME_IDS
    const bf16* P = (const bf16*)(F.ws + WS_PROJ); bf16* YG = (bf16*)(F.ws + WS_YG);
    const bf16* KT = (const bf16*)(F.ws + WS_SSM2 + l * SSM2_LAYER + S2_KT); const bf16* CT = (const bf16*)(F.ws + WS_SSM2 + l * SSM2_LAYER + S2_CT);
    const float* apw = (const float*)(F.ws + WS_SSM2 + l * SSM2_LAYER + S2_APW);
    const float* XLOC = (const float*)(F.ws + WS_XLOC); const float* XSUP = (const float*)(F.ws + WS_XSUP);
    LAS unsigned char* Ut = F.lds + RING_OFF + wave_ * 4096;
    LAS float* Xs = (LAS float*)(F.lds + RING_OFF + wave_ * 4096 + 2048);
    for (int i = lane_; i < 256; i += 64) ((LAS unsigned*)Ut)[i] = 0u;
    const int row = lane_ & 15, q = lane_ >> 4;
    for (int it = F.vcu; it < 256; it += F.G) {
        const int b = it >> 5, sc = (it >> 2) & 7, g = 4 * (it & 3) + (wave_ >> 1), half = wave_ & 1, n = lane_;
        const size_t tokA = (size_t)b * T + (size_t)(16 * sc + 8 * half) * 32;
        v4u unext = *(const v4u*)(P + (tokA + (lane_ >> 1)) * PROJW + COL_S + g * 16 + 8 * (lane_ & 1));
        f32x2_t psup[8], ploc[8];
#pragma unroll
        for (int s2 = 0; s2 < 8; ++s2) { psup[s2] = (f32x2_t){0.f, 0.f}; if (s2 < sc) psup[s2] = *(const f32x2_t*)(XSUP + (((size_t)b * 8 + s2) * 16 + g) * 128 + 2 * n); }
#pragma unroll
        for (int k2 = 0; k2 < 8; ++k2) { ploc[k2] = (f32x2_t){0.f, 0.f}; if (half) ploc[k2] = *(const f32x2_t*)(XLOC + (((size_t)b * 128 + 16 * sc + k2) * 16 + g) * 128 + 2 * n); }
        const float dsk = ((const float*)A.in[I_SSMD])[(l * 16 + g) * 16 + row];
        const float a32r = apw[((g * 33 + 32) * 64 + n) * 2], a32i = apw[((g * 33 + 32) * 64 + n) * 2 + 1];
        const float a16r = apw[((g * 33 + 16) * 64 + n) * 2], a16i = apw[((g * 33 + 16) * 64 + n) * 2 + 1];
        float a512r = a32r, a512i = a32i;
#pragma unroll
        for (int k = 0; k < 4; ++k) { const float t0 = a512r * a512r - a512i * a512i, t1 = 2.f * a512r * a512i; a512r = t0; a512i = t1; }
        float xr = 0.f, xi = 0.f;
#pragma unroll
        for (int s2 = 0; s2 < 8; ++s2) if (s2 < sc) cmul_acc(xr, xi, a512r, a512i, psup[s2].x, psup[s2].y);
        if (half) {
#pragma unroll
            for (int k2 = 0; k2 < 8; ++k2) cmul_acc(xr, xi, a32r, a32i, ploc[k2].x, ploc[k2].y); }
        asm volatile("" : "+v"(xr), "+v"(xi) :: "memory");
        bf16x8 kt[16], ctf[4];
#pragma unroll
        for (int p = 0; p < 16; ++p) kt[p] = *(const bf16x8*)(KT + ((size_t)(g * 16 + p) * 64 + lane_) * 8);
#pragma unroll
        for (int sx = 0; sx < 4; ++sx) ctf[sx] = *(const bf16x8*)(CT + ((size_t)(g * 4 + sx) * 64 + lane_) * 8);
        f32x4_t apr[4][2];
#pragma unroll
        for (int sx = 0; sx < 4; ++sx) { const f32x4_t* ap = (const f32x4_t*)(apw + ((size_t)(g * 33 + row + 1) * 64 + 16 * sx + 4 * q) * 2); apr[sx][0] = ap[0]; apr[sx][1] = ap[1]; }
#pragma unroll 1
        for (int kk = 0; kk < 8; ++kk) {
            const size_t tok0 = tokA + (size_t)kk * 32;
            const f32x2_t xl = *(const f32x2_t*)(XLOC + (((size_t)b * 128 + 16 * sc + 8 * half + kk) * 16 + g) * 128 + 2 * n);
            *(LAS v4u*)(Ut + 1024 + lane_ * 16) = unext;
            if (kk < 7) unext = *(const v4u*)(P + (tok0 + 32 + (lane_ >> 1)) * PROJW + COL_S + g * 16 + 8 * (lane_ & 1));
            Xs[2 * n] = xr; Xs[2 * n + 1] = xi; Xs[128 + 2 * n] = a16r * xr - a16i * xi; Xs[128 + 2 * n + 1] = a16r * xi + a16i * xr;
#pragma unroll
            for (int tau = 0; tau < 2; ++tau) { f32x4_t acc = (f32x4_t){0.f, 0.f, 0.f, 0.f};
                const int ti = 16 * tau + row;
#pragma unroll
                for (int sx = 0; sx < 4; ++sx) { const LAS f32x4_t* xp = (const LAS f32x4_t*)(Xs + 128 * tau + 2 * (16 * sx + 4 * q)); const f32x4_t x01 = xp[0], x23 = xp[1];
                    const f32x4_t a01 = apr[sx][0], a23 = apr[sx][1];
                    v4u zw; zw.x = cvtpk(a01.x * x01.x - a01.y * x01.y, a01.x * x01.y + a01.y * x01.x); zw.y = cvtpk(a01.z * x01.z - a01.w * x01.w, a01.z * x01.w + a01.w * x01.z);
                    zw.z = cvtpk(a23.x * x23.x - a23.y * x23.y, a23.x * x23.y + a23.y * x23.x); zw.w = cvtpk(a23.z * x23.z - a23.w * x23.w, a23.z * x23.w + a23.w * x23.z);
                    acc = __builtin_amdgcn_mfma_f32_16x16x32_bf16(__builtin_bit_cast(bf16x8, zw), ctf[sx], acc, 0, 0, 0);
                    asm volatile("" ::: "memory"); }
#pragma unroll
                for (int p = 0; p < 16; ++p) if (p < 8 * tau + 8) { const bf16x8 ua = *(const LAS bf16x8*)(Ut + (32 + ti - 2 * p - (q >> 1)) * 32 + 16 * (q & 1));
                    acc = __builtin_amdgcn_mfma_f32_16x16x32_bf16(ua, kt[p], acc, 0, 0, 0); if ((p & 3) == 3) asm volatile("" ::: "memory"); }
#pragma unroll
                for (int r = 0; r < 4; ++r) { const int t2 = 16 * tau + 4 * q + r; const float uu = bf2f(*(const LAS bf16*)(Ut + (32 + t2) * 32 + 2 * row));
                    YG[(tok0 + t2) * 256 + g * 16 + row] = (bf16)f2bf(gelu_tanh_f(acc[r] + dsk * uu)); }
            }
            cmul_acc(xr, xi, a32r, a32i, xl.x, xl.y);
        }
    }
}
DI void mix_gating_mfma(Frame& F, const Args& A, int l, int variant = 0) {
    FRAME_IDS
    const bf16* P = (const bf16*)(F.ws + WS_PROJ); bf16* MIX = (bf16*)(F.ws + WS_MIXCAT);
    const bf16* GW = (const bf16*)(F.ws + WS_SSM2 + l * SSM2_LAYER + S2_GW);
    const float* lng = (const float*)A.in[I_GMLNG] + l * AW; const float* lnb = (const float*)A.in[I_GMLNB] + l * AW;
    const float* bs_ = (const float*)A.in[I_GMBS] + l * 4 * 128;
    LAS unsigned char* VT = F.lds + RING_OFF;
    const int ql = lane_ & 31, hi = lane_ >> 5, trq = (lane_ & 15) >> 2, trg = (lane_ >> 4) & 1, trp = lane_ & 3;
    for (int it = F.vcu; it < BATCH * (T / 128); it += F.G) {
        const int m0 = it * 128;
        __syncthreads();
        if (variant != 2) {
        v2u wv[16];
#pragma unroll
        for (int j = 0; j < 16; ++j) wv[j] = *(const v2u*)(P + (size_t)(m0 + wave_ + 8 * j) * PROJW + COL_V + 4 * lane_);
        const f32x4 gg = *(const f32x4*)(lng + 4 * lane_), bb = *(const f32x4*)(lnb + 4 * lane_);
#pragma unroll
        for (int j = 0; j < 16; ++j) { const int r = wave_ + 8 * j; const v2u w = wv[j];
            float v[4] = {gelu_tanh_f(bflo(w.x)), gelu_tanh_f(bfhi(w.x)), gelu_tanh_f(bflo(w.y)), gelu_tanh_f(bfhi(w.y))};
            const float mean = wave_sum(v[0] + v[1] + v[2] + v[3]) * (1.f / 256.f);
            float s2 = 0.f;
#pragma unroll
            for (int i = 0; i < 4; ++i) { v[i] -= mean; s2 += v[i] * v[i]; }
            const float rstd = 1.0f / sqrtf(wave_sum(s2) * (1.f / 256.f) + LN_EPS);
            v2u o; o.x = cvtpk(v[0] * rstd * gg.x + bb.x, v[1] * rstd * gg.y + bb.y); o.y = cvtpk(v[2] * rstd * gg.z + bb.z, v[3] * rstd * gg.w + bb.w);
            *(LAS v2u*)(VT + r * 512 + (((lane_ >> 1) ^ ((r & 3) << 2)) << 4) + 8 * (lane_ & 1)) = o;
        }
        }
        __syncthreads();
        if (variant == 1) continue;
        const int h = wave_ >> 1, cb = 64 * h + 32 * (wave_ & 1);
        const int chunk = (cb >> 3) + 2 * trg + (trp >> 1);
#pragma unroll
        for (int rt = 0; rt < 4; ++rt) {
            f32x16 acc;
#pragma unroll
            for (int i = 0; i < 16; ++i) acc[i] = 0.f;
            bf16x8 wa[8];
#pragma unroll
            for (int ks = 0; ks < 2 * rt + 2; ++ks) wa[ks] = *(const bf16x8*)(GW + (size_t)(h * 128 + 32 * rt) * 128 + 16 * ks + (unsigned)(ql * 128 + 8 * hi));
#pragma unroll
            for (int ks = 0; ks < 2 * rt + 2; ++ks) {
                const int rlo = 16 * ks + 8 * hi + trq;
                const v4i16_t lo = __builtin_amdgcn_ds_read_tr16_b64_v4i16((LAS v4i16_t*)(VT + rlo * 512 + ((chunk ^ (trq << 2)) << 4) + 8 * (trp & 1)));
                const v4i16_t hh = __builtin_amdgcn_ds_read_tr16_b64_v4i16((LAS v4i16_t*)(VT + (rlo + 4) * 512 + ((chunk ^ (trq << 2)) << 4) + 8 * (trp & 1)));
                const bf16x8 va = (bf16x8){lo[0], lo[1], lo[2], lo[3], hh[0], hh[1], hh[2], hh[3]};
                acc = __builtin_amdgcn_mfma_f32_32x32x16_bf16(va, wa[ks], acc, 0, 0, 0); }
            { const int t = 32 * rt + ql; const float bsv = bs_[h * 128 + t];
              const bf16* up = P + (size_t)(m0 + t) * PROJW + COL_U + cb + 4 * hi; unsigned char* op = (unsigned char*)MIX + (size_t)(m0 + t) * D + cb + 4 * hi;
              float ov[16]; float bm = 0.f;
#pragma unroll
              for (int g4 = 0; g4 < 4; ++g4) { const v2u uw = *(const v2u*)(up + 8 * g4);
                  ov[4 * g4] = gelu_tanh_f(bflo(uw.x)) * (acc[4 * g4] + bsv); ov[4 * g4 + 1] = gelu_tanh_f(bfhi(uw.x)) * (acc[4 * g4 + 1] + bsv); ov[4 * g4 + 2] = gelu_tanh_f(bflo(uw.y)) * (acc[4 * g4 + 2] + bsv); ov[4 * g4 + 3] = gelu_tanh_f(bfhi(uw.y)) * (acc[4 * g4 + 3] + bsv); }
#pragma unroll
              for (int i = 0; i < 16; ++i) bm = fmaxf(bm, fabsf(ov[i]));
              bm = fmaxf(bm, __shfl_xor(bm, 32)); float mult; const unsigned eb = mx_scale(bm, mult);
#pragma unroll
              for (int g4 = 0; g4 < 4; ++g4) *(unsigned*)(op + 8 * g4) = pk4_fp8(ov[4 * g4] * mult, ov[4 * g4 + 1] * mult, ov[4 * g4 + 2] * mult, ov[4 * g4 + 3] * mult);
              if (hi == 0) ((unsigned char*)(F.ws + WS_SCM))[scm_index(m0 + t, cb >> 5)] = (unsigned char)eb; }
        }
    }
}

DI void p_glu(Frame& F, const Args& A, int l) {
    FRAME_IDS
    const bf16* YG = (const bf16*)(F.ws + WS_YG); bf16* MIX = (bf16*)(F.ws + WS_MIXCAT);
    const bf16* GluT = (const bf16*)(F.ws + WS_WSMALL + l * WSMALL_LAYER + WOFF_GLU); const float* gb = (const float*)A.in[I_GLUB] + l * 256;
    LAS unsigned char* Bs = F.lds + RING_OFF;
#pragma unroll
    for (int i = 0; i < 16; ++i) { const int idx = tid_ + 512 * i, n = idx >> 5, ch = idx & 31;
        *(LAS v4u*)(Bs + n * 512 + ((ch ^ (n & 15)) << 4)) = *(const v4u*)(GluT + (size_t)n * 256 + ch * 8); }
    __syncthreads();
    const int tk = lane_ & 15, q = lane_ >> 4;
    for (int rt = F.vcu; rt < M / 128; rt += F.G) {
        const size_t tok = (size_t)rt * 128 + wave_ * 16 + tk;
        bf16x8 yf[8];
#pragma unroll
        for (int ks = 0; ks < 8; ++ks) yf[ks] = *(const bf16x8*)(YG + tok * 256 + 32 * ks + 8 * q);
#pragma unroll 2
        for (int cp = 0; cp < 8; ++cp) {
            float ov[8];
#pragma unroll
            for (int c2 = 0; c2 < 2; ++c2) { const int ct = 2 * cp + c2;
                f32x4_t acc = {0.f, 0.f, 0.f, 0.f};
                const int n = 16 * ct + tk;
#pragma unroll
                for (int ks = 0; ks < 8; ++ks) { const bf16x8 wf = *(const LAS bf16x8*)(Bs + n * 512 + (((4 * ks + q) ^ (n & 15)) << 4));
                    acc = __builtin_amdgcn_mfma_f32_16x16x32_bf16(wf, yf[ks], acc, 0, 0, 0); }
                const int n0 = 16 * ct + 4 * q; const v2u yw = *(const v2u*)(YG + tok * 256 + n0); const f32x4 bv = *(const f32x4*)(gb + n0);
                ov[4 * c2] = bflo(yw.x) * sigmoid_f(acc[0] + bv.x); ov[4 * c2 + 1] = bfhi(yw.x) * sigmoid_f(acc[1] + bv.y); ov[4 * c2 + 2] = bflo(yw.y) * sigmoid_f(acc[2] + bv.z); ov[4 * c2 + 3] = bfhi(yw.y) * sigmoid_f(acc[3] + bv.w); }
            float bm = fmaxf(fmaxf(fmaxf(fabsf(ov[0]), fabsf(ov[1])), fmaxf(fabsf(ov[2]), fabsf(ov[3]))), fmaxf(fmaxf(fabsf(ov[4]), fabsf(ov[5])), fmaxf(fabsf(ov[6]), fabsf(ov[7]))));
            bm = fmaxf(bm, __shfl_xor(bm, 16)); bm = fmaxf(bm, __shfl_xor(bm, 32)); float mult; const unsigned eb = mx_scale(bm, mult);
            unsigned char* op = (unsigned char*)MIX + tok * D + 768 + 32 * cp + 4 * q;
            *(unsigned*)op = pk4_fp8(ov[0] * mult, ov[1] * mult, ov[2] * mult, ov[3] * mult); *(unsigned*)(op + 16) = pk4_fp8(ov[4] * mult, ov[5] * mult, ov[6] * mult, ov[7] * mult);
            if (q == 0) ((unsigned char*)(F.ws + WS_SCM))[scm_index((int)tok, 24 + cp)] = (unsigned char)eb;
        }
    }
}
DI void mix_ssm_simple(Frame& F, const Args& A, int l) {
    FRAME_IDS
    const bf16* P = (const bf16*)(F.ws + WS_PROJ); bf16* YG = (bf16*)(F.ws + WS_YG);
    const float* tab = (const float*)(F.ws + WS_SSM) + (size_t)l * SSM_TAB;
    LAS float* fin = (LAS float*)(F.lds + RING_OFF);
    for (int it = F.vcu; it < BATCH * SSM_G; it += F.G) {
        const int b = it >> 4, g = it & 15, n = lane_, seg = wave_, gn = g * 64 + n;
        const float are = tab[gn], aim = tab[1024 + gn];
        float bre[16], bim[16], cre[16], cim[16];
#pragma unroll
        for (int c = 0; c < 16; ++c) { bre[c] = tab[2048 + gn * 16 + c]; bim[c] = tab[2048 + 16384 + gn * 16 + c];
            cre[c] = ((const float*)A.in[I_CRE])[(((size_t)l * 16 + g) * 16 + c) * 64 + n]; cim[c] = ((const float*)A.in[I_CIM])[(((size_t)l * 16 + g) * 16 + c) * 64 + n]; }
        const float dsk = ((const float*)A.in[I_SSMD])[(l * 16 + g) * 16 + (lane_ & 15)];
        const size_t mbase = (size_t)b * T + seg * 512;
        float xr = 0.f, xi = 0.f;
        for (int tt = 0; tt < 512; ++tt) { const v4u* up = (const v4u*)(P + (mbase + tt) * PROJW + COL_S + g * 16); const v4u u0 = up[0], u1 = up[1];
            const float u[16] = {bflo(u0.x), bfhi(u0.x), bflo(u0.y), bfhi(u0.y), bflo(u0.z), bfhi(u0.z), bflo(u0.w), bfhi(u0.w), bflo(u1.x), bfhi(u1.x), bflo(u1.y), bfhi(u1.y), bflo(u1.z), bfhi(u1.z), bflo(u1.w), bfhi(u1.w)};
            float br = 0.f, bi = 0.f;
#pragma unroll
            for (int c = 0; c < 16; ++c) { br += u[c] * bre[c]; bi += u[c] * bim[c]; }
            const float nr = are * xr - aim * xi + br, ni = are * xi + aim * xr + bi; xr = nr; xi = ni; }
        fin[(seg * 64 + n) * 2] = xr; fin[(seg * 64 + n) * 2 + 1] = xi;
        __syncthreads();
        float pr = are, pi = aim;
#pragma unroll
        for (int k = 0; k < 9; ++k) { const float t0 = pr * pr - pi * pi, t1 = 2.f * pr * pi; pr = t0; pi = t1; }
        xr = 0.f; xi = 0.f;
        for (int s = 0; s < seg; ++s) { const float fr_ = fin[(s * 64 + n) * 2], fi_ = fin[(s * 64 + n) * 2 + 1];
            const float nr = pr * xr - pi * xi + fr_, ni = pr * xi + pi * xr + fi_; xr = nr; xi = ni; }
        for (int tt = 0; tt < 512; ++tt) { const v4u* up = (const v4u*)(P + (mbase + tt) * PROJW + COL_S + g * 16); const v4u u0 = up[0], u1 = up[1];
            const float u[16] = {bflo(u0.x), bfhi(u0.x), bflo(u0.y), bfhi(u0.y), bflo(u0.z), bfhi(u0.z), bflo(u0.w), bfhi(u0.w), bflo(u1.x), bfhi(u1.x), bflo(u1.y), bfhi(u1.y), bflo(u1.z), bfhi(u1.z), bflo(u1.w), bfhi(u1.w)};
            float br = 0.f, bi = 0.f;
#pragma unroll
            for (int c = 0; c < 16; ++c) { br += u[c] * bre[c]; bi += u[c] * bim[c]; }
            const float nr = are * xr - aim * xi + br, ni = are * xi + aim * xr + bi; xr = nr; xi = ni;
            float ysel = 0.f, usel = 0.f;
#pragma unroll
            for (int c = 0; c < 16; ++c) { const float r = wave_sum(xr * cre[c] - xi * cim[c]); if ((lane_ & 15) == c) { ysel = r; usel = u[c]; } }
            if (lane_ < 16) { const float y = ysel + dsk * usel; YG[(mbase + tt) * 256 + g * 16 + lane_] = (bf16)f2bf(gelu_tanh_f(y)); } }
        __syncthreads();
    }
}

DI bool beats(float x, int i, float y, int j) { return x > y || (x == y && i < j); }
DI void p_row_b(Frame& F, const Args& A, int l, bool count = true) {
    FRAME_IDS
    const int gw = F.vcu * NWAVES + wave_, NGW = F.G * NWAVES;
    const bf16* PRE = (const bf16*)(F.ws + WS_PRE); bf16* X1 = (bf16*)(F.ws + WS_X1); bf16* XN = (bf16*)(F.ws + WS_XN);
    const float* mod = (const float*)(F.ws + WS_MOD) + (size_t)l * BATCH * 6 * D;
    const float* ln1g = (const float*)A.in[I_LN1G] + l * D; const float* ln1b = (const float*)A.in[I_LN1B] + l * D;
    const float* rw = (const float*)A.in[I_RW]; const float* rb = (const float*)A.in[I_RB];
    int* slot_a = (int*)(F.ws + WS_SLOT_A); float* slot_w = (float*)(F.ws + WS_SLOT_W);
    LAS float* rwS = (LAS float*)(F.lds + RING_OFF);
    volatile LAS unsigned* lcnt = (volatile LAS unsigned*)(F.lds + RING_OFF + 65536);
    LAS int* list_a = (LAS int*)(F.lds + RING_OFF + 66048); LAS float* list_w = (LAS float*)(F.lds + RING_OFF + 66048 + 8192);
    for (int i = tid_; i < D * NEXP; i += NTHR) rwS[(i & 15) * D + (i >> 4)] = rw[i];
    if (tid_ < 32) lcnt[tid_] = 0u;
    __syncthreads();
    const int hi5 = lane_ >> 5, b4 = (lane_ >> 4) & 1, b3 = (lane_ >> 3) & 1, b2 = (lane_ >> 2) & 1, emine = 8 * hi5 + 4 * b4 + 2 * b3 + b2;
    const int wi = 2 * b3 + b2, mygrp = 2 * hi5 + b4;
    const float rbm = rb[emine];
    Row16 lg1, lb1; row_load_f32(lg1, ln1g, lane_); row_load_f32(lb1, ln1b, lane_);
    v2u nraw[4];
    const int bq = gw / (NGW / BATCH), mbase = bq * T + gw % (NGW / BATCH), mstep = NGW / BATCH;
    const float* md = mod + (size_t)bq * 6 * D;
    Row16 msc, msh; row_load_f32(msc, md + 4 * D, lane_); row_load_f32(msh, md + 3 * D, lane_);
    { const v2u* q = (const v2u*)(PRE + (size_t)mbase * D);
#pragma unroll
      for (int k = 0; k < 4; ++k) nraw[k] = q[k * 64 + lane_]; }
    for (int m = mbase; m < (bq + 1) * T; m += mstep) {
        Row16 r;
#pragma unroll
        for (int k = 0; k < 4; ++k) { r.v[4 * k] = bflo(nraw[k].x); r.v[4 * k + 1] = bfhi(nraw[k].x); r.v[4 * k + 2] = bflo(nraw[k].y); r.v[4 * k + 3] = bfhi(nraw[k].y); }
        if (m + mstep < (bq + 1) * T) { const v2u* q = (const v2u*)(PRE + (size_t)(m + mstep) * D);
#pragma unroll
            for (int k = 0; k < 4; ++k) nraw[k] = q[k * 64 + lane_]; }
        row_ln(r);
#pragma unroll
        for (int i = 0; i < 16; ++i) r.v[i] = r.v[i] * lg1.v[i] + lb1.v[i];
        row_ln(r);
#pragma unroll
        for (int i = 0; i < 16; ++i) r.v[i] = r.v[i] * (1.0f + msc.v[i]) + msh.v[i];
        unsigned ib;
        { float am = 0.f;
#pragma unroll
          for (int i = 0; i < 16; ++i) am = fmaxf(am, fabsf(r.v[i]));
          am = wave_max(am); ib = (am > 1e-30f) ? ((__float_as_uint(am * (1.0f / 440.0f)) + 0xffffu) & 0xffff0000u) : 0x3f800000u;
          const float qs = 1.0f / __uint_as_float(ib);
          unsigned* q8 = (unsigned*)((unsigned char*)XN + (size_t)m * D);
#pragma unroll
          for (int k = 0; k < 4; ++k) q8[k * 64 + lane_] = pk4_fp8(r.v[4 * k] * qs, r.v[4 * k + 1] * qs, r.v[4 * k + 2] * qs, r.v[4 * k + 3] * qs); }
        float lg[16];
#pragma unroll
        for (int e = 0; e < 16; ++e) { float a = 0.f;
#pragma unroll
            for (int k = 0; k < 4; ++k) { const f32x4 w4 = *(const LAS f32x4*)(rwS + e * D + 256 * k + 4 * lane_); a += r.v[4 * k] * w4.x + r.v[4 * k + 1] * w4.y + r.v[4 * k + 2] * w4.z + r.v[4 * k + 3] * w4.w; }
            lg[e] = a; }
        float t8[8], t4[4], t2[2];
#pragma unroll
        for (int i = 0; i < 8; ++i) { const float keep = hi5 ? lg[8 + i] : lg[i], give = hi5 ? lg[i] : lg[8 + i]; t8[i] = keep + __shfl_xor(give, 32); }
#pragma unroll
        for (int i = 0; i < 4; ++i) { const float keep = b4 ? t8[4 + i] : t8[i], give = b4 ? t8[i] : t8[4 + i]; t4[i] = keep + __shfl_xor(give, 16); }
#pragma unroll
        for (int i = 0; i < 2; ++i) { const float keep = b3 ? t4[2 + i] : t4[i], give = b3 ? t4[i] : t4[2 + i]; t2[i] = keep + __shfl_xor(give, 8); }
        float z = (b2 ? t2[1] : t2[0]) + __shfl_xor(b2 ? t2[0] : t2[1], 4);
        z += __shfl_xor(z, 2); z += __shfl_xor(z, 1);
        const float scm = 1.0f / (1.0f + __builtin_amdgcn_exp2f(-1.4426950408889634f * z)), a = scm + rbm;
        const float p4 = __shfl_xor(a, 4), p8 = __shfl_xor(a, 8), p12 = __shfl_xor(a, 12);
        const float hi01 = fmaxf(a, p4), lo01 = fminf(a, p4), hi23 = fmaxf(p8, p12), lo23 = fminf(p8, p12);
        const float gs = fmaxf(hi01, hi23) + fmaxf(fmaxf(lo01, lo23), fminf(hi01, hi23));
        const float g16 = __shfl_xor(gs, 16), g32 = __shfl_xor(gs, 32), g48 = __shfl_xor(gs, 48);
        const bool best = beats(gs, mygrp, g16, mygrp ^ 1) && beats(gs, mygrp, g32, mygrp ^ 2) && beats(gs, mygrp, g48, mygrp ^ 3);
        const int rank = (beats(p4, wi ^ 1, a, wi) ? 1 : 0) + (beats(p8, wi ^ 2, a, wi) ? 1 : 0) + (beats(p12, wi ^ 3, a, wi) ? 1 : 0);
        const bool sel = best && rank < 2;
        float tot = sel ? scm : 0.f; tot += __shfl_xor(tot, 4); tot += __shfl_xor(tot, 8);
        if (count && sel && (lane_ & 3) == 0) { const unsigned rk = atomicAdd((unsigned*)&lcnt[emine], 1u);
            list_a[emine * 128 + rk] = (int)((unsigned)(2 * m + rank) | ib); list_w[emine * 128 + rk] = scm / tot; }
    }
    __syncthreads();
    if (count) {
        if (tid_ < 16) { const unsigned n = lcnt[tid_]; lcnt[16 + tid_] = n ? atomicAdd((unsigned*)(F.ctl + CW_CNT + l * 128 + tid_), n) : 0u; }
        __syncthreads();
        for (int idx = tid_; idx < 16 * 128; idx += NTHR) { const int e = idx >> 7, rk = idx & 127;
            if (rk < (int)lcnt[e]) { const size_t slot = (size_t)e * SLOT_CAP + lcnt[16 + e] + rk; slot_a[slot] = list_a[idx]; slot_w[slot] = list_w[idx]; } }
    }
}

DI void moe_tstart(Frame& F, int l) {
    FRAME_IDS
    volatile LAS int* ts = (volatile LAS int*)(F.lds + LDSCTL_OFF);
    __syncthreads();
    if (tid_ == 0) { int acc = 0;
        for (int e = 0; e < 16; ++e) { ts[e] = acc; const unsigned c = __hip_atomic_load(F.ctl + CW_CNT + l * 128 + e, RLX_AGENT); ts[32 + e] = (int)c; acc += (int)((c + 255u) >> 8); }
        ts[16] = acc; }
    __syncthreads();
}
DI void p_row_c(Frame& F, const Args& A, int l) {
    FRAME_IDS
    const int gw = F.vcu * NWAVES + wave_, NGW = F.G * NWAVES;
    const bf16* X1 = (const bf16*)(F.ws + WS_PRE); bf16* R2 = (bf16*)(F.ws + WS_ROWS2); bf16* XN = (bf16*)(F.ws + WS_XN);
    const float* ln1g = (const float*)A.in[I_LN1G] + l * D; const float* ln1b = (const float*)A.in[I_LN1B] + l * D;
    Row16 lg1, lb1; row_load_f32(lg1, ln1g, lane_); row_load_f32(lb1, ln1b, lane_);
    const float* mod = (const float*)(F.ws + WS_MOD) + (size_t)l * BATCH * 6 * D;
    const float* modn = (const float*)(F.ws + WS_MOD) + (size_t)(l + 1) * BATCH * 6 * D;
    const float* ln2g = (const float*)A.in[I_LN2G] + l * D; const float* ln2b = (const float*)A.in[I_LN2B] + l * D;
    Row16 lg2, lb2; row_load_f32(lg2, ln2g, lane_); row_load_f32(lb2, ln2b, lane_);
    v2u nx[4], n0[4], n1[4];
#define RC_LOAD(mm) do { const v2u* qa = (const v2u*)(X1 + (size_t)(mm) * D); const v2u* qb = (const v2u*)(R2 + (size_t)(2 * (mm)) * D); \
        _Pragma("unroll") for (int k = 0; k < 4; ++k) { nx[k] = __builtin_nontemporal_load(&qa[k * 64 + lane_]); n0[k] = __builtin_nontemporal_load(&qb[k * 64 + lane_]); n1[k] = __builtin_nontemporal_load(&qb[256 + k * 64 + lane_]); } } while (0)
    const int bq = gw / (NGW / BATCH), mbase = bq * T + gw % (NGW / BATCH), mstep = NGW / BATCH;
    const float* md = mod + (size_t)bq * 6 * D;
    Row16 gm; row_load_f32(gm, md + 5 * D, lane_);
    Row16 msc, msh;
    if (l != DEPTH - 1) { const float* mdn = modn + (size_t)bq * 6 * D; row_load_f32(msc, mdn + 1 * D, lane_); row_load_f32(msh, mdn + 0 * D, lane_); }
    RC_LOAD(mbase);
    for (int m = mbase; m < (bq + 1) * T; m += mstep) {
        Row16 x1, g2;
#pragma unroll
        for (int k = 0; k < 4; ++k) {
            x1.v[4 * k] = bflo(nx[k].x); x1.v[4 * k + 1] = bfhi(nx[k].x); x1.v[4 * k + 2] = bflo(nx[k].y); x1.v[4 * k + 3] = bfhi(nx[k].y);
            g2.v[4 * k] = bflo(n0[k].x) + bflo(n1[k].x); g2.v[4 * k + 1] = bfhi(n0[k].x) + bfhi(n1[k].x); g2.v[4 * k + 2] = bflo(n0[k].y) + bflo(n1[k].y); g2.v[4 * k + 3] = bfhi(n0[k].y) + bfhi(n1[k].y); }
        if (m + mstep < (bq + 1) * T) RC_LOAD(m + mstep);
        row_ln(x1);
#pragma unroll
        for (int i = 0; i < 16; ++i) x1.v[i] = ALPHA * (x1.v[i] * lg1.v[i] + lb1.v[i]) + (1.0f + gm.v[i]) * g2.v[i];
        row_ln(x1);
#pragma unroll
        for (int i = 0; i < 16; ++i) x1.v[i] = x1.v[i] * lg2.v[i] + lb2.v[i];
        if (l == DEPTH - 1) row_store_f32(x1, A.out + (size_t)m * D, lane_);
        else { row_store_bf16(x1, R2 + (size_t)(2 * m) * D, lane_);
            row_ln(x1);
#pragma unroll
            for (int i = 0; i < 16; ++i) x1.v[i] = x1.v[i] * (1.0f + msc.v[i]) + msh.v[i];
            row_store_fp8(x1, (unsigned char*)XN + (size_t)m * D, (float*)(F.ws + WS_SA) + m, lane_); }
    }
#undef RC_LOAD
}

#ifndef PHMASK
#define PHMASK 0xFFFFFFFFu
#endif
#define IN(k) (lo <= (k) && (k) < hi && ((PHMASK >> (((k) == 0) ? 31 : (((k) - 1) % PH_PER_LAYER))) & 1u))
#define SEAM(k) do { if (IN((k) + 1) && MK_ONE_LAUNCH) xcd_barrier(bar); else __syncthreads(); } while (0)
constexpr int PH_PER_LAYER = 9, N_PHASES = 1 + DEPTH * PH_PER_LAYER;
#ifndef REP_PH
#define REP_PH -1
#endif
#define NREP(k) (((k) == REP_PH) ? 2 : 1)
template <int l> DI void layer_body(Frame& F, const Args& args, const XcdBarrier& bar, const int lo, const int hi) {
    unsigned char* ws = args.ws;

        const int pb = 1 + l * PH_PER_LAYER;
        const bf16* WinT = (const bf16*)(ws + WS_WSMALL + l * WSMALL_LAYER + WOFF_IN);
        const bf16* WoutT = (const bf16*)(ws + WS_WSMALL + l * WSMALL_LAYER + WOFF_OUT);
        const bf16* GluT = (const bf16*)(ws + WS_WSMALL + l * WSMALL_LAYER + WOFF_GLU);
        const float* modl = (const float*)(ws + WS_MOD) + (size_t)l * BATCH * 6 * D;
        if (l == 0 && IN(pb + 0)) { p_wconv(F, args, 0, 4); p_wconv(F, args, 1, 4); p_ln_a0(F, args); SEAM(pb + 0); }
        if (IN(pb + 1)) for (int rep_ = 0; rep_ < NREP(1); ++rep_) {
            pg8::Gemm g{(const bf16*)(ws + WS_XN), WinT, M, PROJW, D / 2}; pg8::StaticOrder S; S.init(M, PROJW, F.G, (int)blockIdx.x);
            EpiInProj E{(bf16*)(ws + WS_PROJ), (const float*)(ws + WS_ROPE), args.pad, (const float*)(ws + WS_SA), (const float*)(ws + WS_CINV_IN) + l * PROJW};
            pg8::gemm_phase<EpiInProj, pg8::StaticOrder, PG8_ALIGN, PG8_SP2, true>(F.lds + RING_OFF, g, S, E);
            if (F.G == 256 && blockIdx.x >= 128) { __syncthreads(); p_wconv_gu(F, args, l, 256 + (int)blockIdx.x - 128, 128, WC_NGU); }
            SEAM(pb + 1); }
        if (IN(pb + 2)) for (int rep_ = 0; rep_ < NREP(2); ++rep_) {
#ifndef REP_SUB
#define REP_SUB -1
#endif
#define SUBREP(k) for (int rs_ = 0; rs_ < ((REP_SUB == (k)) ? 2 : 1); ++rs_)
            SUBREP(0) { mix_gating_mfma(F, args, l); __syncthreads(); }
#if REP_SUB >= 10 && REP_SUB < 20
            mix_gating_mfma(F, args, l, REP_SUB - 10); __syncthreads(); mix_gating_mfma(F, args, l); __syncthreads();
#endif
 SUBREP(1) { mix_ssm_in(F, l); } SUBREP(2) { mix_attn_mfma<0>(F, l); __syncthreads(); } SEAM(pb + 2); }
        if (IN(pb + 3)) for (int rep_ = 0; rep_ < NREP(3); ++rep_) { SUBREP(3) { mix_ssm_out(F, args, l); __syncthreads(); } SUBREP(4) { mix_attn_mfma<1>(F, l); __syncthreads(); } SEAM(pb + 3); }
        if (IN(pb + 4)) for (int rep_ = 0; rep_ < NREP(4); ++rep_) { p_glu(F, args, l); SEAM(pb + 4); }
        if (IN(pb + 5)) for (int rep_ = 0; rep_ < NREP(5); ++rep_) {
            pg8::Gemm g{(const bf16*)(ws + WS_MIXCAT), WoutT, M, D, D / 2}; pg8::StaticOrder S; S.init(M, D, F.G, (int)blockIdx.x);
            const float* cio = (const float*)(ws + WS_CINV_O) + l * D; const unsigned char* scm = (const unsigned char*)(ws + WS_SCM);
            if (l == 0) { EpiOut<true> E{(bf16*)(ws + WS_PRE), args.in[I_X], D, modl, cio}; pg8::gemm_phase<EpiOut<true>, pg8::StaticOrder, PG8_ALIGN, PG8_SP2, true, true>(F.lds + RING_OFF, g, S, E, scm, F.lds + SCT_OFF); }
            else { EpiOut<false> E{(bf16*)(ws + WS_PRE), (const void*)(ws + WS_ROWS2), 2 * D, modl, cio}; pg8::gemm_phase<EpiOut<false>, pg8::StaticOrder, PG8_ALIGN, PG8_SP2, true, true>(F.lds + RING_OFF, g, S, E, scm, F.lds + SCT_OFF); }
            SEAM(pb + 5); }
        if (IN(pb + 6)) { p_row_b(F, args, l); SUBREP(5) { if (REP_SUB == 5 && rs_ == 0) { __syncthreads(); p_row_b(F, args, l, false); } } SEAM(pb + 6); }
        if (IN(pb + 7)) { moe_tstart(F, l);
            gu32* dcnt = F.ctl + CW_DONE + l * 512;
            if (args.pad != 4)
            { pg8::Gemm g{(const bf16*)(ws + WS_XN), (const bf16*)(ws + WS_WGU), NSLOT_MAX, NEXP * 1024, D / 2};
              MoeOrderK<0> S{(const volatile LAS int*)(F.lds + LDSCTL_OFF), F.G, (int)blockIdx.x, (const int*)(ws + WS_SLOT_A), (const float*)(ws + WS_SLOT_W), dcnt, F.ctl + CW_QUEUE + l * 128, (volatile LAS int*)(F.lds + LDSCTL_OFF + 256), nullptr}; EpiG1 E{(unsigned char*)(ws + WS_HID), args.pad, (const float*)(ws + WS_CINV) + (size_t)l * 16 * 2 * 512, (unsigned char*)(ws + WS_HSC)};
              pg8::gemm_phase_g<EpiG1, MoeOrderK<0>, PG8_ALIGN, PG8_SP2, 0, true>(F.lds + RING_OFF, F.lds + GT_OFF, g, S, E); }
            if (args.pad != 3)
            { pg8::Gemm g{(const bf16*)(ws + WS_HID), (const bf16*)(ws + WS_WD), NSLOT_MAX, NEXP * 1024, DEXP / 2};
              MoeOrderK<1> S{(const volatile LAS int*)(F.lds + LDSCTL_OFF), F.G, (int)blockIdx.x, (const int*)(ws + WS_SLOT_A), (const float*)(ws + WS_SLOT_W), dcnt, F.ctl + CW_QUEUE + l * 128, (volatile LAS int*)(F.lds + LDSCTL_OFF + 256), (const unsigned char*)(ws + WS_HSC)}; EpiG2 E{(bf16*)(ws + WS_ROWS2), args.pad, (const float*)(ws + WS_CINV_D) + (size_t)l * NEXP * D};
              pg8::gemm_phase_g<EpiG2, MoeOrderK<1>, PG8_ALIGN, PG8_SP2, 0, true, true>(F.lds + RING_OFF, F.lds + GT_OFF, g, S, E); }
            SEAM(pb + 7); }
        if (IN(pb + 8)) { p_row_c(F, args, l); if (l == 0) { __syncthreads(); p_wconv_dn(F, args, 1, F.vcu, F.G); p_wconv_gu(F, args, 1, F.vcu, F.G, F.G == 256 ? 256 : WC_NGU); } SUBREP(6) { if (REP_SUB == 6 && rs_ == 0 && l == DEPTH - 1) { __syncthreads(); p_row_c(F, args, l); } } SEAM(pb + 8); }
    }
__global__ void __launch_bounds__(NTHR, 2) mk_fwd(Args args) {
    extern __shared__ __attribute__((aligned(16))) unsigned char lds[];
    Frame F;
    F.lds = (LAS unsigned char*)lds; F.MISC = (volatile LAS unsigned*)(F.lds + MISC_OFF);
    F.G = gridDim.x; { const int bx = blockIdx.x; F.vcu = (F.G % 8 == 0) ? (bx % 8) * (F.G / 8) + bx / 8 : bx; }
    F.ws = args.ws; F.ctl = (gu32*)(args.ws + WS_CTL);
    for (int u = ftid(); u < (LDS_BYTES - LDSCTL_OFF) / 4; u += NTHR) ((LAS unsigned*)(F.lds + LDSCTL_OFF))[u] = 0u;
    __syncthreads();
    XcdBarrier bar; bar.bar = (unsigned*)(F.ctl + CW_BAR); bar.x = 0; bar.st = nullptr;
    if (MK_ONE_LAUNCH) bar = xcd_barrier_post((unsigned*)(F.ctl + CW_BAR), F.MISC + 8);
    const int lo = args.ph_lo, hi = args.ph_hi;
    unsigned char* ws = args.ws; (void)ws;
    if (IN(0)) { p0_tables(F, args); __syncthreads(); p_wconv_items(F, args, 0, 0, WC_NS); p_wconv_items(F, args, 1, 0, WC_NS); __syncthreads(); p_wconv_gu(F, args, 0, F.vcu, F.G, F.G == 256 ? 256 : WC_NGU); p_wconv_dn(F, args, 0, F.vcu, F.G);
        p_wconv_in(F, args, 0, (F.vcu + F.G - 112) % F.G, F.G); p_wconv_in(F, args, 1, (F.vcu + F.G - 184) % F.G, F.G);
        p_wconv_out(F, args, 0, F.vcu, F.G); p_wconv_out(F, args, 1, (F.vcu + F.G - 32) % F.G, F.G); SEAM(0); }
    layer_body<0>(F, args, bar, lo, hi);
    layer_body<1>(F, args, bar, lo, hi);
#ifdef EXTRA_BARS
    if (MK_ONE_LAUNCH) for (int xb_ = 0; xb_ < EXTRA_BARS; ++xb_) xcd_barrier(bar);
#endif
#undef IN
#undef SEAM
}

extern "C" void kernel_launch(void* const* d_in, const int* in_sizes, int n_in, void* d_out, int out_size, void* d_ws, size_t ws_size, hipStream_t stream) {
    static int grid = 0;
    if (grid == 0) {
        if (n_in != 30 || in_sizes[0] != M * D || out_size != M * D || ws_size < WS_END) { fprintf(stderr, "kernel_launch: unexpected shapes (n_in %d, in0 %d, out %d, ws %zu, need %zu)\n", n_in, n_in > 0 ? in_sizes[0] : -1, out_size, ws_size, (size_t)WS_END); grid = -1; return; }
        int dev = 0, cus = 0, per_cu = 0;
        if (hipGetDevice(&dev) != hipSuccess || hipDeviceGetAttribute(&cus, hipDeviceAttributeMultiprocessorCount, dev) != hipSuccess) { grid = -1; return; }
        if (hipFuncSetAttribute((const void*)mk_fwd, hipFuncAttributeMaxDynamicSharedMemorySize, LDS_BYTES) != hipSuccess) { fprintf(stderr, "kernel_launch: hipFuncSetAttribute failed\n"); grid = -1; return; }
        if (hipOccupancyMaxActiveBlocksPerMultiprocessor(&per_cu, (const void*)mk_fwd, NTHR, LDS_BYTES) != hipSuccess || per_cu < 1) fprintf(stderr, "kernel_launch: occupancy query says %d\n", per_cu);
        (void)hipGetLastError();
        grid = cus;
    }
    if (grid < 0) return;
    if (hipMemsetAsync((char*)d_ws + WS_CTL, 0, CTL_ZERO_BYTES, stream) != hipSuccess) return;
    Args a{};
    for (int i = 0; i < 30; ++i) a.in[i] = d_in[i];
    a.out = (float*)d_out; a.ws = (unsigned char*)d_ws;
#if MK_ONE_LAUNCH
    a.ph_lo = 0; a.ph_hi = N_PHASES; a.li = 0;
    hipLaunchKernelGGL(mk_fwd, dim3(grid), dim3(NTHR), LDS_BYTES, stream, a);
#else
#ifndef REP_GLOBAL
#define REP_GLOBAL -1
#endif
#ifndef PROBE_SKIP
#define PROBE_SKIP 1
#endif
#ifndef REP_COUNT
#define REP_COUNT 2
#endif
    for (int p = 0; p < N_PHASES; ++p) { a.ph_lo = p; a.ph_hi = p + 1; a.li = p;
        const int nrep = ((p == 0 ? 100 : (p - 1) % PH_PER_LAYER) == REP_GLOBAL) ? REP_COUNT : 1;
        for (int r = 0; r < nrep; ++r) { a.pad = r ? PROBE_SKIP : 0; hipLaunchKernelGGL(mk_fwd, dim3(grid), dim3(NTHR), LDS_BYTES, stream, a); } a.pad = 0; }
#endif
}
```

```cpp
#include <hip/hip_runtime.h>
#include <cstdio>
#include <cstdint>
namespace pg8 {
#define PG8_LAS __attribute__((address_space(3)))
typedef unsigned short bf16_t;
typedef short bf16x8 __attribute__((ext_vector_type(8)));
typedef float f32x4 __attribute__((ext_vector_type(4)));
typedef unsigned u32x4 __attribute__((ext_vector_type(4)));
constexpr int BM = 256, BK = 64, HALF = 128, HTB = HALF * BK * 2  , STAGE_BYTES = 8 * HTB, NXCD = 8, WGM = 8;

__host__ __device__ __forceinline__ int lds_byte(int r, int c) { const int st = (r >> 4) * 2 + (c >> 5), rr = r & 15, cc = c & 31, ob = rr * 64 + cc * 2; return st * 1024 + (ob ^ (((ob >> 9) & 1) << 5)); }
__host__ __device__ __forceinline__ void stage_rc(int b, int& R, int& C) { const int st = b / 1024, sb = b % 1024, swz = sb ^ (((sb >> 9) & 1) << 5); R = (st >> 1) * 16 + swz / 64; C = (st & 1) * 32 + (swz % 64) / 2; }
__host__ __device__ __forceinline__ int perm32(int rho) { const int n = rho >> 4, i = rho & 15; return 8 * (i >> 2) + 4 * n + (i & 3); }

__device__ __forceinline__ int opaque_tid() { int t = threadIdx.x; asm volatile("" : "+v"(t)); return t; }
struct Unit { int pm, pn; };
struct Gemm { const bf16_t* A; const bf16_t* Bt; int M, N, K; };

struct StaticOrder {
    int nM, nN, nwg, G, c;
    __host__ __device__ void init(int M, int N, int G_, int c_) { nM = M / BM; nN = N / BM; nwg = nM * nN; G = G_; c = c_; }
    __host__ __device__ bool next(int i, Unit& u) const {
        const long L = (long)i * G + c; if (L >= nwg) return false;
        int wgid = (int)L; { const int q = nwg / NXCD, r = nwg % NXCD, xcd = wgid % NXCD, off = wgid / NXCD; wgid = (xcd < r ? xcd * (q + 1) : r * (q + 1) + (xcd - r) * q) + off; }
        const int nig = WGM * nN, gid = wgid / nig, fm = gid * WGM, gsz = (nM - fm) < WGM ? (nM - fm) : WGM;
        u.pm = fm + ((wgid % nig) % gsz); u.pn = (wgid % nig) / gsz; return true;
    }
    __device__ __forceinline__ void a_ready(const Unit&) const {}
    __device__ __forceinline__ void done(const Unit&) const {}
};

__device__ __forceinline__ unsigned cvt_pk_bf16(float lo, float hi) { unsigned r; asm volatile("v_cvt_pk_bf16_f32 %0, %1, %2" : "=v"(r) : "v"(lo), "v"(hi)); return r; }
template <class Epi, class Sched, bool ALIGN_EPI = false, bool SP2 = false, bool FP8 = false, bool ASC = false>
__device__ __forceinline__ void gemm_phase(PG8_LAS unsigned char* lds, const Gemm g, const Sched& S, const Epi& E, const unsigned char* scm = nullptr, PG8_LAS unsigned char* sct = nullptr) {
    const int tid = threadIdx.x, wid = __builtin_amdgcn_readfirstlane(tid >> 6), lane = tid & 63, wr = wid >> 2, wc = wid & 3, fr = lane & 15, fq = lane >> 4;
    const int K = g.K, nt = K / BK;
    unsigned voffA[2], voffB[2];
#pragma unroll
    for (int i = 0; i < 2; ++i) { int R, C; stage_rc(tid * 16 + i * 8192, R, C); const int Rb = Epi::PERM ? ((R & ~31) + perm32(R & 31)) : R;
        voffA[i] = (unsigned)(R * K + C) * 2u; voffB[i] = (unsigned)(Rb * K + C) * 2u; }
    const size_t kstep = (size_t)(BK * 2);
    const size_t hstep = (size_t)HALF * K * 2;
    const size_t tstep = 2 * hstep;
    const unsigned ldsw = (unsigned)wid * 1024u;
    const int aoff = lds_byte(wr * 64 + fr, fq * 8), boff = lds_byte(wc * 32 + fr, fq * 8);
#define PG8_SA(b, h) (((b) * 2 + (h)) * HTB)
#define PG8_SB(b, h) ((4 + (b) * 2 + (h)) * HTB)
#define PG8_STAGE(bufoff, gbase, voff) do { _Pragma("unroll") for (int _i = 0; _i < 2; ++_i) \
        __builtin_amdgcn_global_load_lds((const unsigned*)((const char*)(gbase) + (voff)[_i]), (PG8_LAS unsigned*)(lds + (bufoff) + ldsw + _i * 8192), 16, 0, 0); } while (0)
#define PG8_LDA(dst, b, h) do { if constexpr (FP8) { _Pragma("unroll") for (int m = 0; m < 4; ++m) { const PG8_LAS unsigned char* p_ = lds + PG8_SA(b, h) + aoff + m * 2048; \
            const i32x4_t lo_ = *(const PG8_LAS i32x4_t*)p_, hi_ = *(const PG8_LAS i32x4_t*)(p_ + 1024); dst##q[m] = __builtin_shufflevector(lo_, hi_, 0, 1, 2, 3, 4, 5, 6, 7); } } \
        else { _Pragma("unroll") for (int m = 0; m < 4; ++m) _Pragma("unroll") for (int k = 0; k < 2; ++k) dst[m][k] = *(const PG8_LAS bf16x8*)(lds + PG8_SA(b, h) + aoff + m * 2048 + k * 1024); } } while (0)
#define PG8_LDB(dst, b, h) do { if constexpr (FP8) { _Pragma("unroll") for (int n = 0; n < 2; ++n) { const PG8_LAS unsigned char* p_ = lds + PG8_SB(b, h) + boff + n * 2048; \
            const i32x4_t lo_ = *(const PG8_LAS i32x4_t*)p_, hi_ = *(const PG8_LAS i32x4_t*)(p_ + 1024); dst##q[n] = __builtin_shufflevector(lo_, hi_, 0, 1, 2, 3, 4, 5, 6, 7); } } \
        else { _Pragma("unroll") for (int n = 0; n < 2; ++n) _Pragma("unroll") for (int k = 0; k < 2; ++k) dst[n][k] = *(const PG8_LAS bf16x8*)(lds + PG8_SB(b, h) + boff + n * 2048 + k * 1024); } } while (0)
#define PG8_MMA(ai, bj, At, Bt, KT) do { __builtin_amdgcn_s_setprio(1); \
        if constexpr (FP8) { _Pragma("unroll") for (int m = 0; m < 4; ++m) _Pragma("unroll") for (int n = 0; n < 2; ++n) { const int o_ = 8 * m + 4 * n; \
                f32x4 c_ = {accq[ai][bj][o_], accq[ai][bj][o_ + 1], accq[ai][bj][o_ + 2], accq[ai][bj][o_ + 3]}; \
                if constexpr (ASC) c_ = __builtin_amdgcn_mfma_scale_f32_16x16x128_f8f6f4(Bt##q[n], At##q[m], c_, 0, 0, 0, 0x7f7f7f7f, KT, (int)sca[ai][m]); \
                else c_ = __builtin_amdgcn_mfma_scale_f32_16x16x128_f8f6f4(Bt##q[n], At##q[m], c_, 0, 0, 0, 0x7f7f7f7f, 0, 0x7f7f7f7f); \
                accq[ai][bj][o_] = c_[0]; accq[ai][bj][o_ + 1] = c_[1]; accq[ai][bj][o_ + 2] = c_[2]; accq[ai][bj][o_ + 3] = c_[3]; } } \
        else { _Pragma("unroll") for (int m = 0; m < 4; ++m) _Pragma("unroll") for (int n = 0; n < 2; ++n) _Pragma("unroll") for (int k = 0; k < 2; ++k) \
            acc[ai][bj][m][n] = __builtin_amdgcn_mfma_f32_16x16x32_bf16(Bt[n][k], At[m][k], acc[ai][bj][m][n], 0, 0, 0); } \
        __builtin_amdgcn_s_setprio(0); } while (0)
#define PG8_WAIT_V(n) asm volatile("s_waitcnt vmcnt(" #n ")" ::: "memory")
#define PG8_WAIT_L(n) asm volatile("s_waitcnt lgkmcnt(" #n ")" ::: "memory")
#define PG8_BAR __builtin_amdgcn_s_barrier()
#define PG8_SCHED __builtin_amdgcn_sched_barrier(0)
    Unit cur, nxt; int ui = 0;
    if (!S.next(0, cur)) return;
    f32x4 acc[2][2][4][2];
    typedef float f32x32_t __attribute__((ext_vector_type(32)));
    f32x32_t accq[2][2];
    if constexpr (FP8) { accq[0][0] = (f32x32_t)(0.f); accq[0][1] = (f32x32_t)(0.f); accq[1][0] = (f32x32_t)(0.f); accq[1][1] = (f32x32_t)(0.f); } (void)accq;
#pragma unroll
    for (int a = 0; a < 2; ++a)
#pragma unroll
        for (int b = 0; b < 2; ++b)
#pragma unroll
            for (int m = 0; m < 4; ++m)
#pragma unroll
                for (int n = 0; n < 2; ++n) acc[a][b][m][n] = (f32x4){0.f, 0.f, 0.f, 0.f};
    typedef int v8i_t __attribute__((ext_vector_type(8))); typedef int i32x4_t __attribute__((ext_vector_type(4)));
    bf16x8 At[4][2], B0[2][2], B1[2][2]; v8i_t Atq[4], B0q[2], B1q[2];
    (void)At; (void)B0; (void)B1; (void)Atq; (void)B0q; (void)B1q;
    unsigned sca[2][4]; (void)sca; int par = 0; (void)par;
#define PG8_LDSC(PAR, KH) do { if constexpr (ASC) { _Pragma("unroll") for (int a_ = 0; a_ < 2; ++a_) _Pragma("unroll") for (int m_ = 0; m_ < 4; ++m_) { \
        const PG8_LAS unsigned* sp_ = (const PG8_LAS unsigned*)(sct + (PAR) * 8192 + (KH) * 4096 + (wr * 64 + a_ * HALF + m_ * 16 + fr) * 4); const unsigned sh_ = (unsigned)fq * 8u; \
        sca[a_][m_] = ((sp_[0] >> sh_) & 0xffu) | (((sp_[256] >> sh_) & 0xffu) << 8) | (((sp_[512] >> sh_) & 0xffu) << 16) | ((sp_[768] >> sh_) << 24); } } } while (0)
#define PG8_SCDMA(u, PAR) do { if constexpr (ASC) __builtin_amdgcn_global_load_lds((const unsigned*)(scm + (size_t)(u).pm * 8192 + wid * 1024 + (opaque_tid() & 63) * 16), (PG8_LAS unsigned*)(sct + (PAR) * 8192 + wid * 1024), 16, 0, 0); } while (0)
    const char* cA = (const char*)g.A + (size_t)cur.pm * tstep; const char* cB = (const char*)g.Bt + (size_t)cur.pn * tstep;
    S.a_ready(cur); PG8_SCDMA(cur, 0);
    if constexpr (SP2) {
        PG8_STAGE(PG8_SB(0, 0), cB, voffB); PG8_STAGE(PG8_SB(0, 1), cB + hstep, voffB); PG8_STAGE(PG8_SA(0, 0), cA, voffA); PG8_STAGE(PG8_SA(0, 1), cA + hstep, voffA);
        if (wr == 1) PG8_BAR;
        PG8_WAIT_V(2); PG8_BAR;
        PG8_STAGE(PG8_SB(1, 0), cB + kstep, voffB); PG8_STAGE(PG8_SA(1, 0), cA + kstep, voffA); PG8_STAGE(PG8_SB(1, 1), cB + hstep + kstep, voffB);
        PG8_WAIT_V(6); PG8_BAR;
    } else {
        PG8_STAGE(PG8_SB(0, 0), cB, voffB); PG8_STAGE(PG8_SA(0, 0), cA, voffA); PG8_STAGE(PG8_SB(0, 1), cB + hstep, voffB); PG8_STAGE(PG8_SA(0, 1), cA + hstep, voffA);
        if (wr == 1) PG8_BAR;
        PG8_WAIT_V(4); PG8_BAR;
        PG8_STAGE(PG8_SB(1, 0), cB + kstep, voffB); PG8_STAGE(PG8_SA(1, 0), cA + kstep, voffA); PG8_STAGE(PG8_SB(1, 1), cB + hstep + kstep, voffB);
        PG8_WAIT_V(6); PG8_BAR;
    }
    PG8_LDSC(0, 0);
    for (;;) {
        const bool has_next = S.next(ui + 1, nxt);
        const char* nA = has_next ? (const char*)g.A + (size_t)nxt.pm * tstep : cA; const char* nB = has_next ? (const char*)g.Bt + (size_t)nxt.pn * tstep : cB;
#pragma unroll 1
        for (int t = 0; t < nt; t += 2) {
            const bool last = (t == nt - 2);
            const char* a1 = cA + (size_t)(t + 1) * kstep;
            const char* a2 = last ? nA : cA + (size_t)(t + 2) * kstep; const char* b2 = last ? nB : cB + (size_t)(t + 2) * kstep;
            const char* a3 = a2 + kstep; const char* b3 = b2 + kstep;
            if (last && has_next) { S.a_ready(nxt); PG8_SCDMA(nxt, par ^ 1); }
            if constexpr (ASC) { if (t == 4) PG8_LDSC(par, 1); }
            if constexpr (SP2) {
            PG8_LDB(B0, 0, 0); PG8_LDB(B1, 0, 1); PG8_SCHED; PG8_LDA(At, 0, 0); PG8_STAGE(PG8_SA(1, 1), a1 + hstep, voffA);
            PG8_WAIT_V(8); PG8_WAIT_L(0); PG8_BAR; PG8_MMA(0, 0, At, B0, 0); PG8_MMA(0, 1, At, B1, 0); PG8_BAR; PG8_SCHED;
            PG8_LDA(At, 0, 1); PG8_STAGE(PG8_SB(0, 0), b2, voffB); PG8_STAGE(PG8_SB(0, 1), b2 + hstep, voffB); PG8_STAGE(PG8_SA(0, 0), a2, voffA);
            PG8_WAIT_V(8); PG8_WAIT_L(0); PG8_BAR; PG8_MMA(1, 0, At, B0, 0); PG8_MMA(1, 1, At, B1, 0); PG8_BAR; PG8_SCHED;
            PG8_LDB(B0, 1, 0); PG8_LDB(B1, 1, 1); PG8_SCHED; PG8_LDA(At, 1, 0); PG8_STAGE(PG8_SA(0, 1), a2 + hstep, voffA);
            PG8_WAIT_V(8); PG8_WAIT_L(0); PG8_BAR; PG8_MMA(0, 0, At, B0, 1); PG8_MMA(0, 1, At, B1, 1); PG8_BAR; PG8_SCHED;
            PG8_LDA(At, 1, 1); PG8_STAGE(PG8_SB(1, 0), b3, voffB); PG8_STAGE(PG8_SB(1, 1), b3 + hstep, voffB); PG8_STAGE(PG8_SA(1, 0), a3, voffA);
            PG8_WAIT_V(8); PG8_WAIT_L(0); PG8_BAR; PG8_MMA(1, 0, At, B0, 1); PG8_MMA(1, 1, At, B1, 1); PG8_BAR; PG8_SCHED;
            } else {
            PG8_LDB(B0, 0, 0); PG8_SCHED; PG8_LDA(At, 0, 0); PG8_STAGE(PG8_SA(1, 1), a1 + hstep, voffA);
            PG8_WAIT_L(8); PG8_BAR; PG8_WAIT_L(0); PG8_MMA(0, 0, At, B0, 0); PG8_BAR; PG8_SCHED;
            PG8_LDB(B1, 0, 1); PG8_STAGE(PG8_SB(0, 0), b2, voffB);
            PG8_BAR; PG8_WAIT_L(0); PG8_MMA(0, 1, At, B1, 0); PG8_BAR;
            PG8_LDA(At, 0, 1); PG8_STAGE(PG8_SA(0, 0), a2, voffA);
            PG8_BAR; PG8_WAIT_L(0); PG8_MMA(1, 0, At, B0, 0); PG8_BAR; PG8_SCHED;
            PG8_STAGE(PG8_SB(0, 1), b2 + hstep, voffB);
            PG8_WAIT_V(6); PG8_BAR; PG8_MMA(1, 1, At, B1, 0); PG8_BAR;
            PG8_LDB(B0, 1, 0); PG8_SCHED; PG8_LDA(At, 1, 0); PG8_STAGE(PG8_SA(0, 1), a2 + hstep, voffA);
            PG8_WAIT_L(8); PG8_BAR; PG8_WAIT_L(0); PG8_MMA(0, 0, At, B0, 1); PG8_BAR; PG8_SCHED;
            PG8_LDB(B1, 1, 1); PG8_STAGE(PG8_SB(1, 0), b3, voffB);
            PG8_BAR; PG8_WAIT_L(0); PG8_MMA(0, 1, At, B1, 1); PG8_BAR;
            PG8_LDA(At, 1, 1); PG8_STAGE(PG8_SA(1, 0), a3, voffA);
            PG8_BAR; PG8_WAIT_L(0); PG8_MMA(1, 0, At, B0, 1); PG8_BAR; PG8_SCHED;
            PG8_STAGE(PG8_SB(1, 1), b3 + hstep, voffB);
            PG8_WAIT_V(6); PG8_BAR; PG8_MMA(1, 1, At, B1, 1); PG8_BAR;
            }
            if constexpr (ASC) { _Pragma("unroll") for (int a_ = 0; a_ < 2; ++a_) _Pragma("unroll") for (int m_ = 0; m_ < 4; ++m_) sca[a_][m_] >>= 16; }
        }
        if constexpr (ALIGN_EPI) { if (wr == 0) PG8_BAR; }
        if constexpr (FP8) {
#pragma unroll
            for (int a = 0; a < 2; ++a)
#pragma unroll
                for (int b = 0; b < 2; ++b)
#pragma unroll
                    for (int m = 0; m < 4; ++m)
#pragma unroll
                        for (int n = 0; n < 2; ++n) { const int o_ = 8 * m + 4 * n; acc[a][b][m][n] = (f32x4){accq[a][b][o_], accq[a][b][o_ + 1], accq[a][b][o_ + 2], accq[a][b][o_ + 3]}; }
        }
        if constexpr (!Epi::AFTER_DRAIN) { E(acc, cur, wr, wc, fr, fq); S.done(cur); }
        if (!has_next) break;
#pragma unroll
        for (int a = 0; a < 2; ++a)
#pragma unroll
            for (int b = 0; b < 2; ++b)
#pragma unroll
                for (int m = 0; m < 4; ++m)
#pragma unroll
                    for (int n = 0; n < 2; ++n) acc[a][b][m][n] = (f32x4){0.f, 0.f, 0.f, 0.f};
        if constexpr (FP8) { accq[0][0] = (f32x32_t)(0.f); accq[0][1] = (f32x32_t)(0.f); accq[1][0] = (f32x32_t)(0.f); accq[1][1] = (f32x32_t)(0.f); }
        cur = nxt; cA = nA; cB = nB; ++ui; par ^= 1; PG8_LDSC(par, 0);
        if constexpr (ALIGN_EPI) { if (wr == 1) PG8_BAR; }
    }
    PG8_WAIT_V(0);
    if constexpr (!ALIGN_EPI) { if (wr == 0) PG8_BAR; }
    PG8_BAR;
    if constexpr (Epi::AFTER_DRAIN) { E.fused(acc, cur, wr, wc, fr, fq, lds, wid, lane); S.done(cur); }
#undef PG8_SA
#undef PG8_SB
#undef PG8_STAGE
#undef PG8_LDSC
#undef PG8_SCDMA
#undef PG8_LDA
#undef PG8_LDB
#undef PG8_MMA
#undef PG8_WAIT_V
#undef PG8_WAIT_L
#undef PG8_BAR
#undef PG8_SCHED
}
template <class Epi, class Sched, bool ALIGN_EPI = false, bool SP2 = false, int AUXA = 0, bool FP8 = false, bool ASC = false>
__device__ __forceinline__ void gemm_phase_g(PG8_LAS unsigned char* lds, PG8_LAS unsigned char* gt, const Gemm g, const Sched& S, const Epi& E) {
    const int tid = threadIdx.x, wid = __builtin_amdgcn_readfirstlane(tid >> 6), lane = tid & 63, wr = wid >> 2, wc = wid & 3, fr = lane & 15, fq = lane >> 4;
    const int K = g.K, nt = K / BK;
    unsigned gpk0, voffB[2];
#pragma unroll
    for (int i = 0; i < 2; ++i) { int R, C; stage_rc(tid * 16 + i * 8192, R, C); const int Rb = Epi::PERM ? ((R & ~31) + perm32(R & 31)) : R;
        if (i == 0) gpk0 = (unsigned)(R * 4) | ((unsigned)(C * 2) << 16); voffB[i] = (unsigned)(Rb * K + C) * 2u; }
    int par = 0;
    const size_t kstep = (size_t)(BK * 2);
    const size_t hstep = (size_t)HALF * K * 2;
    const size_t tstep = 2 * hstep;
    const unsigned ldsw = (unsigned)wid * 1024u;
    const int aoff = lds_byte(wr * 64 + fr, fq * 8), boff = lds_byte(wc * 32 + fr, fq * 8);
#define PG8_SA(b, h) (((b) * 2 + (h)) * HTB)
#define PG8_SB(b, h) ((4 + (b) * 2 + (h)) * HTB)
#define PG8_STAGE(bufoff, gbase, voff) do { _Pragma("unroll") for (int _i = 0; _i < 2; ++_i) \
        __builtin_amdgcn_global_load_lds((const unsigned*)((const char*)(gbase) + (voff)[_i]), (PG8_LAS unsigned*)(lds + (bufoff) + ldsw + _i * 8192), 16, 0, 0); } while (0)
#define PG8_STAGE_A(bufoff, h, kbyte, PAR) do { _Pragma("unroll") for (int _i = 0; _i < 2; ++_i) { \
        const unsigned _vo = *(const PG8_LAS unsigned*)(gt + ((PAR) * 768 + (h) * 128 + _i * 64) * 4 + (gpk0 & 0xffffu)) + (gpk0 >> 16); \
        __builtin_amdgcn_global_load_lds((const unsigned*)((const char*)g.A + (size_t)(kbyte) + _vo), (PG8_LAS unsigned*)(lds + (bufoff) + ldsw + _i * 8192), 16, 0, AUXA); } } while (0)
#define PG8_FILL(u, PAR, PF, UI) do { S.wait_ready(u, tid, PF); if (tid < 256) { unsigned o_, a0_, a1_; S.finish_meta(u, tid, PF, o_, a0_, a1_); PG8_LAS unsigned* t_ = (PG8_LAS unsigned*)(gt + ((PAR) * 768 + tid) * 4); t_[0] = o_; t_[256] = a0_; t_[512] = a1_; } S.pull_publish(tid, PF, UI); asm volatile("s_waitcnt lgkmcnt(0)" ::: "memory"); __builtin_amdgcn_s_barrier(); asm volatile("" ::: "memory"); \
        if constexpr (ASC) { if (wid < 4) __builtin_amdgcn_global_load_lds((const unsigned*)(S.scale_base(u) + wid * 1024 + (opaque_tid() & 63) * 16), (PG8_LAS unsigned*)(gt + 6144 + (PAR) * 4096 + wid * 1024), 16, 0, 0); } } while (0)
#define PG8_LDA(dst, b, h) do { if constexpr (FP8) { _Pragma("unroll") for (int m = 0; m < 4; ++m) { const PG8_LAS unsigned char* p_ = lds + PG8_SA(b, h) + aoff + m * 2048; \
            const i32x4_t lo_ = *(const PG8_LAS i32x4_t*)p_, hi_ = *(const PG8_LAS i32x4_t*)(p_ + 1024); dst##q[m] = __builtin_shufflevector(lo_, hi_, 0, 1, 2, 3, 4, 5, 6, 7); } } \
        else { _Pragma("unroll") for (int m = 0; m < 4; ++m) _Pragma("unroll") for (int k = 0; k < 2; ++k) dst[m][k] = *(const PG8_LAS bf16x8*)(lds + PG8_SA(b, h) + aoff + m * 2048 + k * 1024); } } while (0)
#define PG8_LDB(dst, b, h) do { if constexpr (FP8) { _Pragma("unroll") for (int n = 0; n < 2; ++n) { const PG8_LAS unsigned char* p_ = lds + PG8_SB(b, h) + boff + n * 2048; \
            const i32x4_t lo_ = *(const PG8_LAS i32x4_t*)p_, hi_ = *(const PG8_LAS i32x4_t*)(p_ + 1024); dst##q[n] = __builtin_shufflevector(lo_, hi_, 0, 1, 2, 3, 4, 5, 6, 7); } } \
        else { _Pragma("unroll") for (int n = 0; n < 2; ++n) _Pragma("unroll") for (int k = 0; k < 2; ++k) dst[n][k] = *(const PG8_LAS bf16x8*)(lds + PG8_SB(b, h) + boff + n * 2048 + k * 1024); } } while (0)
#define PG8_MMA(ai, bj, At, Bt, KT) do { __builtin_amdgcn_s_setprio(1); \
        if constexpr (FP8) { _Pragma("unroll") for (int m = 0; m < 4; ++m) _Pragma("unroll") for (int n = 0; n < 2; ++n) { const int o_ = 8 * m + 4 * n; \
                f32x4 c_ = {accq[ai][bj][o_], accq[ai][bj][o_ + 1], accq[ai][bj][o_ + 2], accq[ai][bj][o_ + 3]}; \
                if constexpr (ASC) c_ = __builtin_amdgcn_mfma_scale_f32_16x16x128_f8f6f4(Bt##q[n], At##q[m], c_, 0, 0, 0, 0x7f7f7f7f, KT, (int)sca[ai][m]); \
                else c_ = __builtin_amdgcn_mfma_scale_f32_16x16x128_f8f6f4(Bt##q[n], At##q[m], c_, 0, 0, 0, 0x7f7f7f7f, 0, 0x7f7f7f7f); \
                accq[ai][bj][o_] = c_[0]; accq[ai][bj][o_ + 1] = c_[1]; accq[ai][bj][o_ + 2] = c_[2]; accq[ai][bj][o_ + 3] = c_[3]; } } \
        else { _Pragma("unroll") for (int m = 0; m < 4; ++m) _Pragma("unroll") for (int n = 0; n < 2; ++n) _Pragma("unroll") for (int k = 0; k < 2; ++k) \
            acc[ai][bj][m][n] = __builtin_amdgcn_mfma_f32_16x16x32_bf16(Bt[n][k], At[m][k], acc[ai][bj][m][n], 0, 0, 0); } \
        __builtin_amdgcn_s_setprio(0); } while (0)
#define PG8_WAIT_V(n) asm volatile("s_waitcnt vmcnt(" #n ")" ::: "memory")
#define PG8_WAIT_L(n) asm volatile("s_waitcnt lgkmcnt(" #n ")" ::: "memory")
#define PG8_BAR __builtin_amdgcn_s_barrier()
#define PG8_SCHED __builtin_amdgcn_sched_barrier(0)
    Unit cur, nxt; int ui = 0;
    if (!__builtin_amdgcn_readfirstlane((int)S.first(cur))) return;
    cur.pm = __builtin_amdgcn_readfirstlane(cur.pm); cur.pn = __builtin_amdgcn_readfirstlane(cur.pn);
    f32x4 acc[2][2][4][2];
    typedef float f32x32_t __attribute__((ext_vector_type(32)));
    f32x32_t accq[2][2];
    if constexpr (FP8) { accq[0][0] = (f32x32_t)(0.f); accq[0][1] = (f32x32_t)(0.f); accq[1][0] = (f32x32_t)(0.f); accq[1][1] = (f32x32_t)(0.f); } (void)accq;
#pragma unroll
    for (int a = 0; a < 2; ++a)
#pragma unroll
        for (int b = 0; b < 2; ++b)
#pragma unroll
            for (int m = 0; m < 4; ++m)
#pragma unroll
                for (int n = 0; n < 2; ++n) acc[a][b][m][n] = (f32x4){0.f, 0.f, 0.f, 0.f};
    typedef int v8i_t __attribute__((ext_vector_type(8))); typedef int i32x4_t __attribute__((ext_vector_type(4)));
    bf16x8 At[4][2], B0[2][2], B1[2][2]; v8i_t Atq[4], B0q[2], B1q[2];
    (void)At; (void)B0; (void)B1; (void)Atq; (void)B0q; (void)B1q;
    unsigned sca[2][4]; (void)sca;
#define PG8_LDSC(PAR) do { if constexpr (ASC) { _Pragma("unroll") for (int a_ = 0; a_ < 2; ++a_) _Pragma("unroll") for (int m_ = 0; m_ < 4; ++m_) { \
        const PG8_LAS unsigned* sp_ = (const PG8_LAS unsigned*)(gt + 6144 + (PAR) * 4096 + (wr * 64 + a_ * HALF + m_ * 16 + fr) * 4); const unsigned sh_ = (unsigned)fq * 8u; \
        sca[a_][m_] = ((sp_[0] >> sh_) & 0xffu) | (((sp_[256] >> sh_) & 0xffu) << 8) | (((sp_[512] >> sh_) & 0xffu) << 16) | ((sp_[768] >> sh_) << 24); } } } while (0)
    const char* cB = (const char*)g.Bt + (size_t)cur.pn * tstep;
    typename Sched::Pf pf; S.prefetch(cur, tid, pf); PG8_FILL(cur, 0, pf, -1);
    Unit pend; bool has_pend = false;
    if constexpr (SP2) {
        PG8_STAGE(PG8_SB(0, 0), cB, voffB); PG8_STAGE(PG8_SB(0, 1), cB + hstep, voffB); PG8_STAGE_A(PG8_SA(0, 0), 0, 0, par); PG8_STAGE_A(PG8_SA(0, 1), 1, 0, par);
        if (wr == 1) PG8_BAR;
        PG8_WAIT_V(2); PG8_BAR;
        PG8_STAGE(PG8_SB(1, 0), cB + kstep, voffB); PG8_STAGE_A(PG8_SA(1, 0), 0, kstep, par); PG8_STAGE(PG8_SB(1, 1), cB + hstep + kstep, voffB);
        PG8_WAIT_V(6); PG8_BAR;
    } else {
        PG8_STAGE(PG8_SB(0, 0), cB, voffB); PG8_STAGE_A(PG8_SA(0, 0), 0, 0, par); PG8_STAGE(PG8_SB(0, 1), cB + hstep, voffB); PG8_STAGE_A(PG8_SA(0, 1), 1, 0, par);
        if (wr == 1) PG8_BAR;
        PG8_WAIT_V(4); PG8_BAR;
        PG8_STAGE(PG8_SB(1, 0), cB + kstep, voffB); PG8_STAGE_A(PG8_SA(1, 0), 0, kstep, par); PG8_STAGE(PG8_SB(1, 1), cB + hstep + kstep, voffB);
        PG8_WAIT_V(6); PG8_BAR;
    }
    PG8_LDSC(0);
    for (;;) {
        const bool has_next = __builtin_amdgcn_readfirstlane((int)S.more(ui + 1, nxt)) != 0;
        nxt.pm = __builtin_amdgcn_readfirstlane(nxt.pm); nxt.pn = __builtin_amdgcn_readfirstlane(nxt.pn);
        if (has_next) { S.prefetch(nxt, tid, pf); S.pull_issue(tid, pf); }
        const char* nB = has_next ? (const char*)g.Bt + (size_t)nxt.pn * tstep : cB;
#pragma unroll 1
        for (int t = 0; t < nt; t += 2) {
            const bool last = (t == nt - 2);
            const char* b2 = last ? nB : cB + (size_t)(t + 2) * kstep;
            const char* b3 = b2 + kstep;
            if (last && has_next) PG8_FILL(nxt, par ^ 1, pf, ui);
            const size_t kA2 = last ? (size_t)0 : (size_t)(t + 2) * kstep; const int pA2 = (last && has_next) ? (par ^ 1) : par;
            if constexpr (SP2) {
            PG8_LDB(B0, 0, 0); PG8_LDB(B1, 0, 1); PG8_SCHED; PG8_LDA(At, 0, 0); PG8_STAGE_A(PG8_SA(1, 1), 1, (size_t)(t + 1) * kstep, par);
            PG8_WAIT_V(8); PG8_WAIT_L(0); PG8_BAR; PG8_MMA(0, 0, At, B0, 0); PG8_MMA(0, 1, At, B1, 0); PG8_BAR; PG8_SCHED;
            PG8_LDA(At, 0, 1); PG8_STAGE(PG8_SB(0, 0), b2, voffB); PG8_STAGE(PG8_SB(0, 1), b2 + hstep, voffB); PG8_STAGE_A(PG8_SA(0, 0), 0, kA2, pA2);
            PG8_WAIT_V(8); PG8_WAIT_L(0); PG8_BAR; PG8_MMA(1, 0, At, B0, 0); PG8_MMA(1, 1, At, B1, 0); PG8_BAR; PG8_SCHED;
            PG8_LDB(B0, 1, 0); PG8_LDB(B1, 1, 1); PG8_SCHED; PG8_LDA(At, 1, 0); PG8_STAGE_A(PG8_SA(0, 1), 1, kA2, pA2);
            PG8_WAIT_V(8); PG8_WAIT_L(0); PG8_BAR; PG8_MMA(0, 0, At, B0, 1); PG8_MMA(0, 1, At, B1, 1); PG8_BAR; PG8_SCHED;
            PG8_LDA(At, 1, 1); PG8_STAGE(PG8_SB(1, 0), b3, voffB); PG8_STAGE(PG8_SB(1, 1), b3 + hstep, voffB); PG8_STAGE_A(PG8_SA(1, 0), 0, kA2 + kstep, pA2);
            PG8_WAIT_V(8); PG8_WAIT_L(0); PG8_BAR; PG8_MMA(1, 0, At, B0, 1); PG8_MMA(1, 1, At, B1, 1); PG8_BAR; PG8_SCHED;
            } else {
            PG8_LDB(B0, 0, 0); PG8_SCHED; PG8_LDA(At, 0, 0); PG8_STAGE_A(PG8_SA(1, 1), 1, (size_t)(t + 1) * kstep, par);
            PG8_WAIT_L(8); PG8_BAR; PG8_WAIT_L(0); PG8_MMA(0, 0, At, B0, 0); PG8_BAR; PG8_SCHED;
            PG8_LDB(B1, 0, 1); PG8_STAGE(PG8_SB(0, 0), b2, voffB);
            PG8_BAR; PG8_WAIT_L(0); PG8_MMA(0, 1, At, B1, 0); PG8_BAR;
            PG8_LDA(At, 0, 1); PG8_STAGE_A(PG8_SA(0, 0), 0, kA2, pA2);
            PG8_BAR; PG8_WAIT_L(0); PG8_MMA(1, 0, At, B0, 0); PG8_BAR; PG8_SCHED;
            PG8_STAGE(PG8_SB(0, 1), b2 + hstep, voffB);
            PG8_WAIT_V(6); PG8_BAR; PG8_MMA(1, 1, At, B1, 0); PG8_BAR;
            PG8_LDB(B0, 1, 0); PG8_SCHED; PG8_LDA(At, 1, 0); PG8_STAGE_A(PG8_SA(0, 1), 1, kA2, pA2);
            PG8_WAIT_L(8); PG8_BAR; PG8_WAIT_L(0); PG8_MMA(0, 0, At, B0, 1); PG8_BAR; PG8_SCHED;
            PG8_LDB(B1, 1, 1); PG8_STAGE(PG8_SB(1, 0), b3, voffB);
            PG8_BAR; PG8_WAIT_L(0); PG8_MMA(0, 1, At, B1, 1); PG8_BAR;
            PG8_LDA(At, 1, 1); PG8_STAGE_A(PG8_SA(1, 0), 0, kA2 + kstep, pA2);
            PG8_BAR; PG8_WAIT_L(0); PG8_MMA(1, 0, At, B0, 1); PG8_BAR; PG8_SCHED;
            PG8_STAGE(PG8_SB(1, 1), b3 + hstep, voffB);
            PG8_WAIT_V(6); PG8_BAR; PG8_MMA(1, 1, At, B1, 1); PG8_BAR;
            }
            if constexpr (ASC) { _Pragma("unroll") for (int a_ = 0; a_ < 2; ++a_) _Pragma("unroll") for (int m_ = 0; m_ < 4; ++m_) sca[a_][m_] >>= 16; }
        }
        if constexpr (ALIGN_EPI) { if (wr == 0) PG8_BAR; }
        if constexpr (FP8) {
#pragma unroll
            for (int a = 0; a < 2; ++a)
#pragma unroll
                for (int b = 0; b < 2; ++b)
#pragma unroll
                    for (int m = 0; m < 4; ++m)
#pragma unroll
                        for (int n = 0; n < 2; ++n) { const int o_ = 8 * m + 4 * n; acc[a][b][m][n] = (f32x4){accq[a][b][o_], accq[a][b][o_ + 1], accq[a][b][o_ + 2], accq[a][b][o_ + 3]}; }
        }
        if constexpr (!Epi::AFTER_DRAIN) { if (has_pend) S.done_nowait(pend);     E(acc, cur, wr, wc, fr, fq, (const PG8_LAS unsigned*)(gt + par * 3072)); pend = cur; has_pend = true; }
        if (!has_next) break;
#pragma unroll
        for (int a = 0; a < 2; ++a)
#pragma unroll
            for (int b = 0; b < 2; ++b)
#pragma unroll
                for (int m = 0; m < 4; ++m)
#pragma unroll
                    for (int n = 0; n < 2; ++n) acc[a][b][m][n] = (f32x4){0.f, 0.f, 0.f, 0.f};
        if constexpr (FP8) { accq[0][0] = (f32x32_t)(0.f); accq[0][1] = (f32x32_t)(0.f); accq[1][0] = (f32x32_t)(0.f); accq[1][1] = (f32x32_t)(0.f); }
        cur = nxt; cB = nB; ++ui; par ^= 1; PG8_LDSC(par);
        if constexpr (ALIGN_EPI) { if (wr == 1) PG8_BAR; }
    }
    PG8_WAIT_V(0);
    if constexpr (!ALIGN_EPI) { if (wr == 0) PG8_BAR; }
    PG8_BAR;
    if (has_pend) S.done_nowait(pend);
#undef PG8_SA
#undef PG8_SB
#undef PG8_STAGE
#undef PG8_STAGE_A
#undef PG8_FILL
#undef PG8_LDSC
#undef PG8_LDA
#undef PG8_LDB
#undef PG8_MMA
#undef PG8_WAIT_V
#undef PG8_WAIT_L
#undef PG8_BAR
#undef PG8_SCHED
}
}

#ifndef PG8_SP2
#define PG8_SP2 true
#endif
#ifndef PG8_ALIGN
#define PG8_ALIGN true
#endif
#ifndef MK_ONE_LAUNCH
#define MK_ONE_LAUNCH 1
#endif

constexpr int NWAVES = 8, NTHR = 512;
constexpr int BATCH = 8, T = 4096, D = 1024, M = BATCH * T, DEPTH = 2;
constexpr int PROJW = 2304, AW = 256, BW = 512, CW = 256, NH = 8, HD = 64;
constexpr int COL_U = 0, COL_V = 256, COL_Q = 512, COL_K = 1024, COL_VA = 1536, COL_S = 2048;
constexpr int NEXP = 16, DEXP = 512, NGRP = 4;
constexpr int SSM_G = 16, SSM_N = 64, SSM_C = 16;
constexpr float LN_EPS = 1e-5f;
constexpr float ALPHA = 1.41421356237309515f;
constexpr float QSCALE = 0.125f * 1.4426950408889634f;
constexpr int NSLOT_MAX = 2 * M + NEXP * 256;

constexpr size_t MiB = 1u << 20;
constexpr size_t WS_CTL = 0, CTL_ZERO_BYTES = 1 * MiB;
constexpr size_t WS_MOD = 1 * MiB;
constexpr size_t WS_ROPE = WS_MOD + 512 * 1024;
constexpr size_t WS_SSM = WS_ROPE + 2 * MiB;
constexpr int SSM_TAB = 2 * 1024 + 2 * 16384;
constexpr int SLOT_CAP = 32768;
constexpr size_t WS_SLOT_A = 4 * MiB;
constexpr size_t WS_WSMALL = 6 * MiB;
constexpr size_t WSMALL_LAYER = 7 * MiB, WOFF_IN = 0, WOFF_OUT = (size_t)PROJW * D * 2, WOFF_GLU = WOFF_OUT + (size_t)D * D * 2;
constexpr size_t WS_WGU = 20 * MiB;
constexpr size_t WS_WD = 52 * MiB;
constexpr size_t WS_XN = 68 * MiB;
constexpr size_t WS_YG = 132 * MiB;
constexpr size_t WS_R = 148 * MiB;
constexpr size_t WS_PROJ = WS_R, WS_MIXCAT = WS_R + 144 * MiB, WS_PRE = WS_R, WS_HID = WS_R + 64 * MiB, WS_X1 = WS_R + 132 * MiB;
constexpr size_t WS_HSC = WS_HID + 36 * MiB;
constexpr size_t WS_ROWS2 = 356 * MiB;
constexpr size_t WS_STAT = 356 * MiB + (size_t)2 * M * D * 2;
constexpr size_t WS_SSM2 = WS_STAT + 4 * MiB;
constexpr size_t SSM2_LAYER = 3 * MiB, S2_APW = 0, S2_KT = 288 * 1024, S2_CT = S2_KT + 256 * 1024, S2_WIN = S2_CT + 64 * 1024, S2_GW = S2_WIN + 2 * MiB;
static_assert(S2_GW + 4 * 128 * 128 * 2 <= SSM2_LAYER, "ssm2 tables");
constexpr size_t WS_XLOC = WS_SSM2 + 2 * SSM2_LAYER;
constexpr size_t WS_XSUP = WS_XLOC + 8 * MiB;
constexpr size_t WS_SLOT_W = WS_XSUP + 512 * 1024;
constexpr size_t WS_CINV = WS_SLOT_W + 2 * MiB;
constexpr size_t WS_CINV_IN = WS_CINV + 128 * 1024;
constexpr size_t WS_CINV_D = WS_CINV + 256 * 1024;
constexpr size_t WS_SA = WS_CINV + 384 * 1024;
constexpr size_t WS_SCM = WS_SA + 128 * 1024;
constexpr size_t WS_CINV_O = WS_SCM + 1 * MiB;
constexpr size_t WS_SCR = WS_CINV_O + 64 * 1024;
constexpr size_t WS_END = WS_SCR + 2 * MiB;
static_assert(WOFF_GLU + 256 * 256 * 2 <= WSMALL_LAYER && WS_WSMALL + 2 * WSMALL_LAYER <= WS_WGU, "ws map");
static_assert(WS_SSM + 2 * SSM_TAB * 4 <= WS_SLOT_A && WS_HID + (size_t)NSLOT_MAX * DEXP * 2 <= WS_X1 && WS_X1 + (size_t)M * D * 2 <= WS_ROWS2, "ws map 2");
constexpr int CW_TMO = 0;
constexpr int CW_BAR = 4096;
constexpr int CW_CNT = 8192;
constexpr int CW_QUEUE = 11264;
constexpr int CW_DONE = 12288;

constexpr int RING_OFF = 0, RING_BYTES = 131072;
constexpr int ATT_STAGE_OFF = 98304;
constexpr int LDSCTL_OFF = 135168, MISC_OFF = LDSCTL_OFF + 320;
constexpr int GT_OFF = LDSCTL_OFF + 1024;
constexpr int SCT_OFF = GT_OFF + 6144;
constexpr int LDS_BYTES = 158720;

#define GAS __attribute__((address_space(1)))
#define LAS __attribute__((address_space(3)))
#define DI __device__ __forceinline__
typedef unsigned short bf16;
typedef unsigned v4u __attribute__((ext_vector_type(4)));
typedef unsigned v2u __attribute__((ext_vector_type(2)));
typedef float f32x4 __attribute__((ext_vector_type(4)));
typedef short bf16x8 __attribute__((ext_vector_type(8)));
typedef GAS unsigned gu32;
#define RLX_AGENT __ATOMIC_RELAXED, __HIP_MEMORY_SCOPE_AGENT
#define LDS_WAIT() asm volatile("s_waitcnt lgkmcnt(0)" ::: "memory")
#define VM_WAIT() asm volatile("s_waitcnt vmcnt(0)" ::: "memory")
DI unsigned f2bf(float f) { unsigned u = __builtin_bit_cast(unsigned, f); return (u + 0x7fffu + ((u >> 16) & 1u)) >> 16; }
DI unsigned pk2(float lo, float hi) { return f2bf(lo) | (f2bf(hi) << 16); }
DI float bflo(unsigned w) { return __uint_as_float(w << 16); }
DI float bfhi(unsigned w) { return __uint_as_float(w & 0xffff0000u); }
DI float bf2f(bf16 h) { return __uint_as_float((unsigned)h << 16); }
template <int CTRL> DI float dpp_mov(float v) { return __builtin_bit_cast(float, __builtin_amdgcn_update_dpp(0, __builtin_bit_cast(int, v), CTRL, 0xf, 0xf, true)); }
DI float rdlane(float v, int l) { return __builtin_bit_cast(float, __builtin_amdgcn_readlane(__builtin_bit_cast(int, v), l)); }
DI float wave_sum(float v) {
    v += dpp_mov<0xB1>(v); v += dpp_mov<0x4E>(v); v += dpp_mov<0x141>(v); v += dpp_mov<0x140>(v);
    return (rdlane(v, 0) + rdlane(v, 16)) + (rdlane(v, 32) + rdlane(v, 48));
}
DI void st16_wt(void* p, v4u v) { asm volatile("global_store_dwordx4 %0, %1, off sc1\n\ts_nop 1" :: "v"(p), "v"(v) : "memory"); }
DI float wave_max(float v) {
    v = fmaxf(v, dpp_mov<0xB1>(v)); v = fmaxf(v, dpp_mov<0x4E>(v)); v = fmaxf(v, dpp_mov<0x141>(v)); v = fmaxf(v, dpp_mov<0x140>(v));
    return fmaxf(fmaxf(rdlane(v, 0), rdlane(v, 16)), fmaxf(rdlane(v, 32), rdlane(v, 48)));
}
DI unsigned pk4_fp8(float a, float b, float c, float d) { int w = __builtin_amdgcn_cvt_pk_fp8_f32(a, b, 0, false); w = __builtin_amdgcn_cvt_pk_fp8_f32(c, d, w, true); return (unsigned)w; }
DI unsigned mx_scale(float bm, float& mult) { unsigned eb = (__float_as_uint(bm * (1.0f / 448.0f)) + 0x7fffffu) >> 23; eb = eb < 1u ? 1u : (eb > 254u ? 254u : eb); mult = __uint_as_float((254u - eb) << 23); return eb; }
DI size_t scm_index(int m, int b32) { return ((size_t)(m >> 8) * 8 + (b32 >> 2)) * 1024 + (size_t)(m & 255) * 4 + (b32 & 3); }
DI float fast_rcp(float x) { return __builtin_amdgcn_rcpf(x); }
DI float sigmoid_f(float x) { return fast_rcp(1.0f + __builtin_amdgcn_exp2f(-1.4426950408889634f * x)); }
DI float silu_f(float x) { return x * sigmoid_f(x); }
DI float gelu_tanh_f(float x) { const float z2 = 1.5957691216057308f * (x + 0.044715f * x * x * x); return x * sigmoid_f(z2); }

#define XB_TMO      128
#define XB_XCNT(j)  (256  + 64 * (j))
#define XB_XSUB(j)  (1280 + 64 * (j))
#define XB_XGEN(j)  (2304 + 64 * (j))
#define XB_TOP      3328
#define XB_TOPGEN   3392
#define XCD_BAR_WORDS 3456
#define XB_SPIN_CAP (1u << 22)
DI unsigned xb_ld(unsigned* p)              { return __hip_atomic_load(p, __ATOMIC_RELAXED, __HIP_MEMORY_SCOPE_AGENT); }
DI unsigned xb_add(unsigned* p, unsigned v) { return __hip_atomic_fetch_add(p, v, __ATOMIC_RELAXED, __HIP_MEMORY_SCOPE_AGENT); }
DI unsigned xb_xcc_id() { return (unsigned)__builtin_amdgcn_s_getreg((3 << 11) | 20) & 0xFu; }
#define XB_SPIN(cond, bar) do { unsigned _sp = 0; while (cond) { __builtin_amdgcn_s_sleep(1); \
    if ((++_sp & 255u) == 0u) { if (xb_ld(&(bar)[XB_TMO])) break; if (_sp > XB_SPIN_CAP) { atomicAdd(&(bar)[XB_TMO], 1u); break; } } } } while (0)
struct XcdBarrier { unsigned* bar; unsigned x; volatile LAS unsigned* st; };
DI XcdBarrier xcd_barrier_post(unsigned* bar, volatile LAS unsigned* st) {
    XcdBarrier b; b.bar = bar; b.x = xb_xcc_id(); b.st = st;
    if (threadIdx.x == 0) (void)xb_add(&bar[XB_XCNT(b.x)], 1u);
    return b;
}
DI void xcd_barrier_complete(unsigned* bar, unsigned x, unsigned& nloc, unsigned& nx) {
    const unsigned G = gridDim.x * gridDim.y * gridDim.z;
    unsigned sum, cnt, mine, sp = 0u;
    for (;;) {
        sum = 0u; cnt = 0u; mine = 0u;
#pragma unroll
        for (unsigned j = 0; j < 16; ++j) { const unsigned c = xb_ld(&bar[XB_XCNT(j)]); sum += c; cnt += (c > 0u) ? 1u : 0u; mine = (j == x) ? c : mine; }
        if (sum == G) break;
        __builtin_amdgcn_s_sleep(1);
        if ((++sp & 255u) == 0u) { if (xb_ld(&bar[XB_TMO])) break; if (sp > XB_SPIN_CAP) { atomicAdd(&bar[XB_TMO], 1u); break; } }
    }
    nloc = mine > 0u ? mine : 1u; nx = cnt > 0u ? cnt : 1u;
}
DI void xcd_barrier(const XcdBarrier& b) {
    asm volatile("s_waitcnt vmcnt(0)" ::: "memory");
    __syncthreads();
    if (threadIdx.x == 0) {
        unsigned* bar = b.bar;
        __builtin_amdgcn_s_waitcnt(0);
        unsigned nloc = b.st[0], nx = b.st[1];
        if (nloc == 0u) { xcd_barrier_complete(bar, b.x, nloc, nx); b.st[0] = nloc; b.st[1] = nx; }
        const unsigned old = xb_add(&bar[XB_XSUB(b.x)], 1u);
        const unsigned gen = old / nloc;
        if (old + 1u == (gen + 1u) * nloc) {
            __builtin_amdgcn_fence(__ATOMIC_RELEASE, "agent");
            asm volatile("s_waitcnt vmcnt(0)" ::: "memory");
            const unsigned og = xb_add(&bar[XB_TOP], 1u);
            const unsigned tg = og / nx;
            if (og + 1u == (tg + 1u) * nx) xb_add(&bar[XB_TOPGEN], 1u);
            else XB_SPIN(xb_ld(&bar[XB_TOPGEN]) == tg, bar);
            __builtin_amdgcn_fence(__ATOMIC_ACQUIRE, "agent");
            xb_add(&bar[XB_XGEN(b.x)], 1u);
            asm volatile("s_waitcnt vmcnt(0)" ::: "memory");
        } else {
            XB_SPIN(xb_ld(&bar[XB_XGEN(b.x)]) == gen, bar);
            __builtin_amdgcn_fence(__ATOMIC_ACQUIRE, "agent");
            asm volatile("s_waitcnt vmcnt(0)" ::: "memory");
        }
    }
    __syncthreads();
}

struct Args { const void* in[30]; float* out; unsigned char* ws; int ph_lo, ph_hi, li, pad; };
enum { I_X = 0, I_C, I_POS, I_ADAW, I_ADAB, I_WIN, I_GMLNG, I_GMLNB, I_GMWS, I_GMBS, I_LAMRE, I_LAMIM, I_LOGDT, I_BRE, I_BIM, I_CRE, I_CIM, I_SSMD,
       I_GLUW, I_GLUB, I_WOUT, I_LN1G, I_LN1B, I_RW, I_RB, I_EWG, I_EWU, I_EWD, I_LN2G, I_LN2B };
struct Frame {
    LAS unsigned char* lds;
    volatile LAS unsigned* MISC;
    gu32* ctl;
    unsigned char* ws;
    int vcu, G;
};
DI int ftid() { int t = threadIdx.x; asm volatile("" : "+v"(t)); return t; }
#define FRAME_IDS const int tid_ = ftid(), lane_ = tid_ & 63, wave_ = __builtin_amdgcn_readfirstlane(tid_ >> 6); (void)lane_; (void)wave_;

template <class RowMap>
DI void transpose_item(const float* W, int K, int N, bf16* WT, const RowMap& rm, LAS float* scr, int item, int lane) {
    const int nblk = N / 32, kb = item / nblk, nb = item % nblk, k0 = 64 * kb, n0 = 32 * nb;
#pragma unroll 8
    for (int i = 0; i < 32; ++i) { const int kk = 2 * i + (lane >> 5); scr[kk * 33 + (lane & 31)] = W[(size_t)(k0 + kk) * N + n0 + (lane & 31)]; }
    LDS_WAIT(); asm volatile("" ::: "memory");
    const int c = lane & 7;
#pragma unroll
    for (int j = 0; j < 4; ++j) { const int n = (lane >> 3) + 8 * j; const LAS float* s = scr + (8 * c) * 33 + n;
        const float qs = (RowMap::SCALEQ && (n0 + n) >= COL_Q && (n0 + n) < COL_K) ? QSCALE : 1.0f;
        v4u o; o.x = pk2(s[0 * 33] * qs, s[1 * 33] * qs); o.y = pk2(s[2 * 33] * qs, s[3 * 33] * qs); o.z = pk2(s[4 * 33] * qs, s[5 * 33] * qs); o.w = pk2(s[6 * 33] * qs, s[7 * 33] * qs);
        *(GAS v4u*)(WT + (size_t)rm(n0 + n) * K + k0 + 8 * c) = o; }
    LDS_WAIT(); asm volatile("" ::: "memory");
}
struct RmIdent { static constexpr bool SCALEQ = false; int off; DI int operator()(int n) const { return off + n; } };
struct RmWin { static constexpr bool SCALEQ = true; DI int operator()(int n) const {
        if (n >= COL_Q && n < COL_VA) { const int d = n & 63; if (d < 16) return (n - d) + 2 * (d & 7) + (d >> 3); }
        return n; } };
struct RmGU { static constexpr bool SCALEQ = false; int e, up; DI int operator()(int n) const { return e * 1024 + (n >> 7) * 256 + (n & 127) + up * 128; } };

DI void p0_tables(Frame& F, const Args& A) {
    FRAME_IDS
    const float* c = (const float*)A.in[I_C];
    LAS float* condS = (LAS float*)(F.lds + RING_OFF);
    LAS float* red = (LAS float*)(F.lds + RING_OFF + 32768);
    for (int i = tid_; i < BATCH * D; i += NTHR) condS[i] = silu_f(c[i]);
    __syncthreads();
    float* mod = (float*)(F.ws + WS_MOD);
    for (int it = F.vcu; it < DEPTH * 96; it += F.G) {
        const int l = it / 96, jb = it % 96, ks = tid_ >> 6, jj = tid_ & 63, j = jb * 64 + jj;
        const float* w = (const float*)A.in[I_ADAW] + (size_t)l * D * 6 * D + j;
        float acc[8];
#pragma unroll
        for (int b = 0; b < 8; ++b) acc[b] = 0.f;
#pragma unroll 16
        for (int k = ks * 128; k < ks * 128 + 128; ++k) { const float wv = w[(size_t)k * (6 * D)];
#pragma unroll
            for (int b = 0; b < 8; ++b) acc[b] += condS[b * D + k] * wv; }
#pragma unroll
        for (int b = 0; b < 8; ++b) red[(ks * 8 + b) * 64 + jj] = acc[b];
        __syncthreads();
        { const int b = tid_ >> 6; float s = ((const float*)A.in[I_ADAB])[l * 6 * D + j];
#pragma unroll
          for (int k2 = 0; k2 < 8; ++k2) s += red[(k2 * 8 + b) * 64 + jj];
          mod[((size_t)l * BATCH + b) * 6 * D + j] = s; }
        __syncthreads();
    }
    const int gt = F.vcu * NTHR + tid_, NGT = F.G * NTHR;
    const int* pos = (const int*)A.in[I_POS]; float* rope = (float*)(F.ws + WS_ROPE);
    for (int w = gt; w < M * 8; w += NGT) { const int m = w >> 3, i = w & 7;
        const float freq = exp2f(-(float)i * 0.125f * 18.931568569324174f);
        const float ang = (float)pos[m] * freq; float s, cs; sincosf(ang, &s, &cs);
        rope[m * 16 + i] = cs; rope[m * 16 + 8 + i] = s; }
    for (int w = gt; w < DEPTH * 16 * 33 * 64; w += NGT) { const int n = w & 63, m = (w >> 6) % 33, g = ((w >> 6) / 33) & 15, l = (w >> 6) / (33 * 16);
        const int li = (l * 16 + g) * 64 + n;
        const float lre = ((const float*)A.in[I_LAMRE])[li], lim = ((const float*)A.in[I_LAMIM])[li], dt = expf(((const float*)A.in[I_LOGDT])[l * 16 + g]);
        const float mag = expf((float)m * (lre * dt)); float sn, cs; sincosf((float)m * (lim * dt), &sn, &cs);
        float* apw = (float*)(F.ws + WS_SSM2 + l * SSM2_LAYER + S2_APW) + ((size_t)(g * 33 + m) * 64 + n) * 2; apw[0] = mag * cs; apw[1] = mag * sn; }
    for (int w = gt; w < DEPTH * SSM_G * SSM_N; w += NGT) { const int l = w / 1024, gn = w % 1024, g = gn >> 6;
        float* tab = (float*)(F.ws + WS_SSM) + (size_t)l * SSM_TAB;
        const float lre = ((const float*)A.in[I_LAMRE])[w], lim = ((const float*)A.in[I_LAMIM])[w];
        const float dt = expf(((const float*)A.in[I_LOGDT])[l * 16 + g]);
        const float mag = expf(lre * dt); float sn, cs; sincosf(lim * dt, &sn, &cs);
        const float are = mag * cs, aim = mag * sn, nr = are - 1.0f, ni = aim, mod2 = lre * lre + lim * lim;
        const float fre = (nr * lre + ni * lim) / mod2, fim = (ni * lre - nr * lim) / mod2;
        tab[gn] = are; tab[1024 + gn] = aim;
        const float* bre = (const float*)A.in[I_BRE] + (size_t)w * 16; const float* bim = (const float*)A.in[I_BIM] + (size_t)w * 16;
#pragma unroll
        for (int cc = 0; cc < 16; ++cc) { tab[2048 + gn * 16 + cc] = fre * bre[cc] - fim * bim[cc]; tab[2048 + 16384 + gn * 16 + cc] = fre * bim[cc] + fim * bre[cc]; } }
}

DI void p_wconv(Frame& F, const Args& A, int l, int part) {
    FRAME_IDS
    if (part == 4) {
        const int gt = F.vcu * NTHR + tid_, NGT = F.G * NTHR;
        const float* tab = (const float*)(F.ws + WS_SSM) + (size_t)l * SSM_TAB;
        const float* apw = (const float*)(F.ws + WS_SSM2 + l * SSM2_LAYER + S2_APW);
        const float* cre = (const float*)A.in[I_CRE] + (size_t)l * 16 * 16 * 64; const float* cim = (const float*)A.in[I_CIM] + (size_t)l * 16 * 16 * 64;
        bf16* KT = (bf16*)(F.ws + WS_SSM2 + l * SSM2_LAYER + S2_KT); bf16* CT = (bf16*)(F.ws + WS_SSM2 + l * SSM2_LAYER + S2_CT);
        bf16* WIN = (bf16*)(F.ws + WS_SSM2 + l * SSM2_LAYER + S2_WIN); bf16* GW = (bf16*)(F.ws + WS_SSM2 + l * SSM2_LAYER + S2_GW);
        for (int w = gt; w < 16 * 16 * 64 * 8; w += NGT) { const int j = w & 7, ln = (w >> 3) & 63, p = (w >> 9) & 15, g = w >> 13;
            const int co = ln & 15, q = ln >> 4, m = 2 * p + (q >> 1), ci = 8 * (q & 1) + j; float acc = 0.f;
            for (int n = 0; n < 64; ++n) { const int gn = g * 64 + n; const float ar = apw[((g * 33 + m) * 64 + n) * 2], ai = apw[((g * 33 + m) * 64 + n) * 2 + 1];
                const float br = tab[2048 + gn * 16 + ci], bi = tab[2048 + 16384 + gn * 16 + ci], tre = ar * br - ai * bi, tim = ar * bi + ai * br;
                acc += cre[(g * 16 + co) * 64 + n] * tre - cim[(g * 16 + co) * 64 + n] * tim; }
            KT[w] = (bf16)f2bf(acc); }
        for (int w = gt; w < 16 * 4 * 64 * 8; w += NGT) { const int j = w & 7, ln = (w >> 3) & 63, sx = (w >> 9) & 3, g = w >> 11;
            const int co = ln & 15, q = ln >> 4, n = 16 * sx + 4 * q + (j >> 1);
            CT[w] = (bf16)f2bf((j & 1) ? -cim[(g * 16 + co) * 64 + n] : cre[(g * 16 + co) * 64 + n]); }
        for (int w = gt; w < 16 * 16 * 8 * 64 * 8; w += NGT) { const int jj = w & 7, ln = (w >> 3) & 63, ct = (w >> 9) & 7, sp = (w >> 12) & 15, g = w >> 16;
            const int cc = ln & 15, q = ln >> 4, n = 8 * ct + (cc >> 1), part = cc & 1, tj = 2 * sp + (q >> 1), ci = 8 * (q & 1) + jj, gn = g * 64 + n, m = 31 - tj;
            const float ar = apw[((g * 33 + m) * 64 + n) * 2], ai = apw[((g * 33 + m) * 64 + n) * 2 + 1], br = tab[2048 + gn * 16 + ci], bi = tab[2048 + 16384 + gn * 16 + ci];
            WIN[w] = (bf16)f2bf(part ? (ar * bi + ai * br) : (ar * br - ai * bi)); }
        const float* gws = (const float*)A.in[I_GMWS] + (size_t)l * 4 * 128 * 128;
        for (int w = gt; w < 4 * 128 * 128; w += NGT) { const int sx = w & 127, t = (w >> 7) & 127; GW[w] = (bf16)f2bf(sx <= t ? gws[w] : 0.f); }
    }
}
constexpr int WC_NS = 4 * 8;
DI void p_wconv_items(Frame& F, const Args& A, int l, int lo, int hi) {
    FRAME_IDS
    LAS float* scr = (LAS float*)(F.lds + RING_OFF + wave_ * 16384);
    bf16* GluT = (bf16*)(F.ws + WS_WSMALL + l * WSMALL_LAYER + WOFF_GLU);
    for (int it = lo + F.vcu * NWAVES + wave_; it < hi; it += F.G * NWAVES)
        transpose_item((const float*)A.in[I_GLUW] + (size_t)l * 256 * 256, 256, 256, GluT, RmIdent{0}, scr, it, lane_);
}
template <bool CI_DEST, int KW, class RowMap>
DI void quant_cols32(Frame& F, const float* Wm, int ldw, int n0, unsigned char* W8, const RowMap& rm, float* cinv) {
    FRAME_IDS
    LAS float* scr = (LAS float*)(F.lds + RING_OFF + wave_ * 16384);
    LAS float* red = (LAS float*)(F.lds + RING_OFF + 12288);
    constexpr int NV = KW / 2, KTOT = 8 * KW; const int k0 = KW * wave_;
    const float* W = Wm + (size_t)k0 * ldw + n0;
    const unsigned lofs = (unsigned)((lane_ >> 5) * ldw + (lane_ & 31));
    float v[NV]; float mx = 0.f;
#pragma unroll
    for (int i = 0; i < NV; ++i) v[i] = W[(size_t)(2 * i) * ldw + lofs];
#pragma unroll
    for (int i = 0; i < NV; ++i) mx = fmaxf(mx, fabsf(v[i]));
    red[wave_ * 4096 + lane_] = mx;
    __syncthreads();
    float m2 = 0.f;
#pragma unroll
    for (int w2 = 0; w2 < 8; ++w2) m2 = fmaxf(m2, fmaxf(red[w2 * 4096 + (lane_ & 31)], red[w2 * 4096 + 32 + (lane_ & 31)]));
    const bool z = !(m2 > 1e-30f); const float sc = z ? 1.0f : 440.0f / m2;
    if (tid_ < 32) { const int n = n0 + tid_; const float qf = (RowMap::SCALEQ && n >= COL_Q && n < COL_K) ? QSCALE : 1.0f; cinv[CI_DEST ? rm(n) : n] = (z ? 1.0f : m2 * (1.0f / 440.0f)) * qf; }
    const int c = lane_ & 7;
#pragma unroll
    for (int t = 0; t < KW / 64; ++t) {
#pragma unroll
        for (int i = 0; i < 32; ++i) scr[(2 * i + (lane_ >> 5)) * 33 + (lane_ & 31)] = v[32 * t + i] * sc;
        LDS_WAIT(); asm volatile("" ::: "memory");
#pragma unroll
        for (int jj = 0; jj < 4; ++jj) { const int n = (lane_ >> 3) + 8 * jj; const LAS float* sp = scr + (8 * c) * 33 + n;
            v2u o; o.x = pk4_fp8(sp[0 * 33], sp[1 * 33], sp[2 * 33], sp[3 * 33]); o.y = pk4_fp8(sp[4 * 33], sp[5 * 33], sp[6 * 33], sp[7 * 33]);
            *(GAS v2u*)(W8 + (size_t)rm(n0 + n) * KTOT + k0 + 64 * t + 8 * c) = o; }
        LDS_WAIT(); asm volatile("" ::: "memory");
    }
    __syncthreads();
}
constexpr int WC_NGU = 16 * 2 * 16, WC_NIN = PROJW / 32;
DI void p_wconv_gu(Frame& F, const Args& A, int l, int first, int stride, int hi) {
    for (int j = first; j < hi; j += stride) { const int e = j >> 5, up = (j >> 4) & 1;
        quant_cols32<false, 128>(F, (const float*)A.in[up ? I_EWU : I_EWG] + ((size_t)l * NEXP + e) * D * DEXP, DEXP, 32 * (j & 15), (unsigned char*)(F.ws + WS_WGU), RmGU{e, up},
                            (float*)(F.ws + WS_CINV) + (size_t)l * 16 * 2 * 512 + (e * 2 + up) * 512); }
}
constexpr int WC_NDN = 16 * 32;
DI void p_wconv_dn(Frame& F, const Args& A, int l, int first, int stride) {
    for (int j = first; j < WC_NDN; j += stride) { const int e = j >> 5;
        quant_cols32<false, 64>(F, (const float*)A.in[I_EWD] + ((size_t)l * NEXP + e) * D * DEXP, D, 32 * (j & 31), (unsigned char*)(F.ws + WS_WD), RmIdent{e * 1024},
                                (float*)(F.ws + WS_CINV_D) + ((size_t)l * NEXP + e) * D); }
}
constexpr int WC_NOUT = D / 32;
DI void p_wconv_out(Frame& F, const Args& A, int l, int first, int stride) {
    for (int j = first; j < WC_NOUT; j += stride)
        quant_cols32<false, 128>(F, (const float*)A.in[I_WOUT] + (size_t)l * D * D, D, 32 * j, (unsigned char*)(F.ws + WS_WSMALL + l * WSMALL_LAYER + WOFF_OUT), RmIdent{0}, (float*)(F.ws + WS_CINV_O) + l * D);
}
DI void p_wconv_in(Frame& F, const Args& A, int l, int first, int stride) {
    for (int j = first; j < WC_NIN; j += stride)
        quant_cols32<true, 128>(F, (const float*)A.in[I_WIN] + (size_t)l * D * PROJW, PROJW, 32 * j, (unsigned char*)(F.ws + WS_WSMALL + l * WSMALL_LAYER + WOFF_IN), RmWin{}, (float*)(F.ws + WS_CINV_IN) + l * PROJW);
}

typedef float f32x2_t __attribute__((ext_vector_type(2)));
typedef __bf16 bf16x2_t __attribute__((ext_vector_type(2)));
DI unsigned cvtpk(float lo, float hi) { f32x2_t v = {lo, hi}; bf16x2_t b = __builtin_convertvector(v, bf16x2_t); return __builtin_bit_cast(unsigned, b); }
struct Row16 { float v[16]; };
DI void row_load_f32(Row16& r, const float* p, int lane) {
    const f32x4* q = (const f32x4*)p;
#pragma unroll
    for (int k = 0; k < 4; ++k) { const f32x4 a = q[k * 64 + lane]; r.v[4 * k] = a.x; r.v[4 * k + 1] = a.y; r.v[4 * k + 2] = a.z; r.v[4 * k + 3] = a.w; }
}
DI void row_load_f32_nt(Row16& r, const float* p, int lane) {
    const f32x4* q = (const f32x4*)p;
#pragma unroll
    for (int k = 0; k < 4; ++k) { const f32x4 a = __builtin_nontemporal_load(&q[k * 64 + lane]); r.v[4 * k] = a.x; r.v[4 * k + 1] = a.y; r.v[4 * k + 2] = a.z; r.v[4 * k + 3] = a.w; }
}
DI void row_load_bf16(Row16& r, const bf16* p, int lane) {
    const v2u* q = (const v2u*)p;
#pragma unroll
    for (int k = 0; k < 4; ++k) { const v2u a = q[k * 64 + lane]; r.v[4 * k] = bflo(a.x); r.v[4 * k + 1] = bfhi(a.x); r.v[4 * k + 2] = bflo(a.y); r.v[4 * k + 3] = bfhi(a.y); }
}
DI void row_store_bf16(const Row16& r, bf16* p, int lane) {
    v2u* q = (v2u*)p;
#pragma unroll
    for (int k = 0; k < 4; ++k) { v2u o; o.x = cvtpk(r.v[4 * k], r.v[4 * k + 1]); o.y = cvtpk(r.v[4 * k + 2], r.v[4 * k + 3]); q[k * 64 + lane] = o; }
}
DI void row_store_fp8(const Row16& r, unsigned char* p, float* sinv, int lane) {
    float am = 0.f;
#pragma unroll
    for (int i = 0; i < 16; ++i) am = fmaxf(am, fabsf(r.v[i]));
    am = wave_max(am); const bool z = !(am > 1e-30f); const float qs = z ? 1.0f : 440.0f / am;
    unsigned* q8 = (unsigned*)p;
#pragma unroll
    for (int k = 0; k < 4; ++k) q8[k * 64 + lane] = pk4_fp8(r.v[4 * k] * qs, r.v[4 * k + 1] * qs, r.v[4 * k + 2] * qs, r.v[4 * k + 3] * qs);
    if (lane == 0) *sinv = z ? 1.0f : am * (1.0f / 440.0f);
}
DI void row_store_f32(const Row16& r, float* p, int lane) {
    f32x4* q = (f32x4*)p;
#pragma unroll
    for (int k = 0; k < 4; ++k) __builtin_nontemporal_store((f32x4){r.v[4 * k], r.v[4 * k + 1], r.v[4 * k + 2], r.v[4 * k + 3]}, &q[k * 64 + lane]);
}
DI void row_ln(Row16& r) {
    float s = 0.f;
#pragma unroll
    for (int i = 0; i < 16; ++i) s += r.v[i];
    const float mean = wave_sum(s) * (1.f / D); float s2 = 0.f;
#pragma unroll
    for (int i = 0; i < 16; ++i) { r.v[i] -= mean; s2 += r.v[i] * r.v[i]; }
    const float rstd = 1.0f / sqrtf(wave_sum(s2) * (1.f / D) + LN_EPS);
#pragma unroll
    for (int i = 0; i < 16; ++i) r.v[i] *= rstd;
}
DI void row_mod(Row16& r, const float* a, const float* b, int lane) {
    Row16 av, bv; row_load_f32(av, a, lane); row_load_f32(bv, b, lane);
#pragma unroll
    for (int i = 0; i < 16; ++i) r.v[i] = r.v[i] * (1.0f + av.v[i]) + bv.v[i];
}
DI void row_affine(Row16& r, const float* g, const float* b, int lane) {
    Row16 av, bv; row_load_f32(av, g, lane); row_load_f32(bv, b, lane);
#pragma unroll
    for (int i = 0; i < 16; ++i) r.v[i] = r.v[i] * av.v[i] + bv.v[i];
}

DI void p_ln_a0(Frame& F, const Args& A) {
    FRAME_IDS
    const int gw = F.vcu * NWAVES + wave_, NGW = F.G * NWAVES;
    const float* x = (const float*)A.in[I_X]; bf16* XN = (bf16*)(F.ws + WS_XN); const float* mod = (const float*)(F.ws + WS_MOD);
    const int bq = gw / (NGW / BATCH), mbase = bq * T + gw % (NGW / BATCH), mstep = NGW / BATCH;
    const float* md = mod + (size_t)bq * 6 * D;
    Row16 msc, msh; row_load_f32(msc, md + 1 * D, lane_); row_load_f32(msh, md + 0 * D, lane_);
    Row16 nx; row_load_f32_nt(nx, x + (size_t)mbase * D, lane_);
    for (int m = mbase; m < (bq + 1) * T; m += mstep) {
        Row16 r = nx; if (m + mstep < (bq + 1) * T) row_load_f32_nt(nx, x + (size_t)(m + mstep) * D, lane_);
        row_ln(r);
#pragma unroll
        for (int i = 0; i < 16; ++i) r.v[i] = r.v[i] * (1.0f + msc.v[i]) + msh.v[i];
        row_store_fp8(r, (unsigned char*)XN + (size_t)m * D, (float*)(F.ws + WS_SA) + m, lane_); }
}

using pg8::Unit; using pg8::BM; using pg8::HALF;
struct EpiInProj {
    static constexpr bool PERM = true, AFTER_DRAIN = false;
    bf16* P; const float* rope; int skip; const float* sa; const float* cinv;
    DI void operator()(const pg8::f32x4 (&acc)[2][2][4][2], const Unit& u, int wr, int wc, int fr, int fq) const {
        if (skip == 1) { if (acc[0][0][0][0][0] == 12345.678f) P[0] = 1; return; }
        const int row0 = u.pm * BM + wr * 64 + fr, pn = u.pn;
        const bool isrope = (pn >= 2 && pn <= 5), dorope = isrope && ((wc & 1) == 0) && (fq < 2);
        asm volatile("" ::: "memory");
        pg8::f32x4 ci[2][2];
#pragma unroll
        for (int bj = 0; bj < 2; ++bj) { const float* cp = cinv + pn * BM + bj * HALF + wc * 32 + 8 * fq; ci[bj][0] = *(const pg8::f32x4*)cp; ci[bj][1] = *(const pg8::f32x4*)(cp + 4); }
#pragma unroll
        for (int ai = 0; ai < 2; ++ai)
#pragma unroll
            for (int m = 0; m < 4; ++m) { const int row = row0 + ai * HALF + m * 16; bf16* rowp = P + (size_t)row * PROJW + pn * BM + wc * 32 + 8 * fq; const float ra = sa[row];
                f32x4 cs = (f32x4){1.f, 1.f, 1.f, 1.f}, sn = (f32x4){0.f, 0.f, 0.f, 0.f};
                if (isrope) { const float* rp = rope + (size_t)row * 16 + 4 * (fq & 1); cs = *(const f32x4*)rp; sn = *(const f32x4*)(rp + 8); }
#pragma unroll
                for (int bj = 0; bj < 2; ++bj) { pg8::f32x4 v0 = acc[ai][bj][m][0] * (ci[bj][0] * ra), v1 = acc[ai][bj][m][1] * (ci[bj][1] * ra);
                    if (isrope) {
                        if (dorope) { const float a0 = v0[0] * cs.x - v0[1] * sn.x, b0 = v0[1] * cs.x + v0[0] * sn.x, a1 = v0[2] * cs.y - v0[3] * sn.y, b1 = v0[3] * cs.y + v0[2] * sn.y;
                            const float a2 = v1[0] * cs.z - v1[1] * sn.z, b2 = v1[1] * cs.z + v1[0] * sn.z, a3 = v1[2] * cs.w - v1[3] * sn.w, b3 = v1[3] * cs.w + v1[2] * sn.w;
                            v0 = (pg8::f32x4){a0, b0, a1, b1}; v1 = (pg8::f32x4){a2, b2, a3, b3}; }
                    }
                    pg8::u32x4 w; w.x = pg8::cvt_pk_bf16(v0[0], v0[1]); w.y = pg8::cvt_pk_bf16(v0[2], v0[3]); w.z = pg8::cvt_pk_bf16(v1[0], v1[1]); w.w = pg8::cvt_pk_bf16(v1[2], v1[3]);
                    if (skip == 2) { asm volatile("" :: "v"(w.x), "v"(w.y), "v"(w.z), "v"(w.w)); } else *(pg8::u32x4*)(rowp + bj * HALF) = w; } }
    }
};
template <bool XF32> struct EpiOut {
    static constexpr bool PERM = true, AFTER_DRAIN = false;
    bf16* PRE; const void* x; int xpitch; const float* mod; const float* cinv;
    DI void operator()(const pg8::f32x4 (&acc)[2][2][4][2], const Unit& u, int wr, int wc, int fr, int fq) const {
        const int row0 = u.pm * BM + wr * 64 + fr, b = (u.pm * BM) / T, colb = u.pn * BM + wc * 32 + 8 * fq;
        const float* g1 = mod + (size_t)b * 6 * D + 2 * D;
        pg8::f32x4 gv[2][2];
#pragma unroll
        for (int bj = 0; bj < 2; ++bj) { gv[bj][0] = (*(const pg8::f32x4*)(g1 + colb + bj * HALF) + 1.0f) * *(const pg8::f32x4*)(cinv + colb + bj * HALF); gv[bj][1] = (*(const pg8::f32x4*)(g1 + colb + bj * HALF + 4) + 1.0f) * *(const pg8::f32x4*)(cinv + colb + bj * HALF + 4); }
#pragma unroll
        for (int ai = 0; ai < 2; ++ai)
#pragma unroll
            for (int m = 0; m < 4; ++m) { const int row = row0 + ai * HALF + m * 16;
#pragma unroll
                for (int bj = 0; bj < 2; ++bj) { const int col = colb + bj * HALF; pg8::f32x4 x0, x1;
                    if (XF32) { const float* xp = (const float*)x + (size_t)row * xpitch + col; x0 = *(const pg8::f32x4*)xp; x1 = *(const pg8::f32x4*)(xp + 4); }
                    else { const pg8::u32x4 xw = *(const pg8::u32x4*)((const bf16*)x + (size_t)row * xpitch + col);
                        x0 = (pg8::f32x4){bflo(xw.x), bfhi(xw.x), bflo(xw.y), bfhi(xw.y)}; x1 = (pg8::f32x4){bflo(xw.z), bfhi(xw.z), bflo(xw.w), bfhi(xw.w)}; }
                    const pg8::f32x4 v0 = x0 * ALPHA + gv[bj][0] * acc[ai][bj][m][0], v1 = x1 * ALPHA + gv[bj][1] * acc[ai][bj][m][1];
                    pg8::u32x4 w; w.x = pg8::cvt_pk_bf16(v0[0], v0[1]); w.y = pg8::cvt_pk_bf16(v0[2], v0[3]); w.z = pg8::cvt_pk_bf16(v1[0], v1[1]); w.w = pg8::cvt_pk_bf16(v1[2], v1[3]);
                    *(pg8::u32x4*)(PRE + (size_t)row * D + col) = w; } }
    }
};
struct OutOrder : pg8::StaticOrder {
    const char* xbase; unsigned rowbytes, tilecolbytes; LAS unsigned char* dump;
    DI void a_ready(const Unit& u) const {
        const int tid = threadIdx.x, wid = __builtin_amdgcn_readfirstlane(tid >> 6), lane = tid & 63;
        const int lpr = (int)(tilecolbytes >> 7);
        const char* t0 = xbase + (size_t)u.pm * 256 * rowbytes + (size_t)u.pn * tilecolbytes;
        const int nline = 256 * lpr;
        for (int i = wid * 64 + lane; i < nline; i += 512) { const int r = i / lpr, c = i % lpr;
            __builtin_amdgcn_global_load_lds((const unsigned*)(t0 + (size_t)r * rowbytes + (size_t)c * 128), (LAS unsigned*)(dump + wid * 256), 4, 0, 0); }
    }
};
struct EpiGlu {
    static constexpr bool PERM = true, AFTER_DRAIN = false;
    const bf16* YG; bf16* MIX; const float* gb;
    DI void operator()(const pg8::f32x4 (&acc)[2][2][4][2], const Unit& u, int wr, int wc, int fr, int fq) const {
        const int row0 = u.pm * BM + wr * 64 + fr, colb = wc * 32 + 8 * fq;
#pragma unroll
        for (int ai = 0; ai < 2; ++ai)
#pragma unroll
            for (int m = 0; m < 4; ++m) { const int row = row0 + ai * HALF + m * 16;
#pragma unroll
                for (int bj = 0; bj < 2; ++bj) { const int col = colb + bj * HALF;
                    const pg8::u32x4 yw = *(const pg8::u32x4*)(YG + (size_t)row * 256 + col);
                    const pg8::f32x4 b0 = *(const pg8::f32x4*)(gb + col), b1 = *(const pg8::f32x4*)(gb + col + 4);
                    const pg8::f32x4 a0 = acc[ai][bj][m][0] + b0, a1 = acc[ai][bj][m][1] + b1;
                    const float y[8] = {bflo(yw.x), bfhi(yw.x), bflo(yw.y), bfhi(yw.y), bflo(yw.z), bfhi(yw.z), bflo(yw.w), bfhi(yw.w)};
                    float o[8];
#pragma unroll
                    for (int i = 0; i < 4; ++i) { o[i] = y[i] * sigmoid_f(a0[i]); o[4 + i] = y[4 + i] * sigmoid_f(a1[i]); }
                    pg8::u32x4 w; w.x = pg8::cvt_pk_bf16(o[0], o[1]); w.y = pg8::cvt_pk_bf16(o[2], o[3]); w.z = pg8::cvt_pk_bf16(o[4], o[5]); w.w = pg8::cvt_pk_bf16(o[6], o[7]);
                    *(pg8::u32x4*)(MIX + (size_t)row * D + 768 + col) = w; asm volatile("" ::: "memory"); } }
    }
};
template <int KIND> struct MoeOrderK {
    const volatile LAS int* ts; int G, c; const int* slot_a; const float* slot_w; gu32* done_cnt; gu32* queue; volatile LAS int* qs;
    DI bool decode(int off, Unit& u) const {
        const int nwg = ts[16] * 4, q = nwg / 8, r = nwg % 8, xcd = c % 8; const int cntx = q + (xcd < r ? 1 : 0); if (off >= cntx) return false;
        const int wgid = (xcd < r ? xcd * (q + 1) : r * (q + 1) + (xcd - r) * q) + off;
        const int tm = wgid >> 2, j = wgid & 3; int e = 0;
#pragma unroll
        for (int k = 1; k < 16; ++k) e += (ts[k] <= tm) ? 1 : 0;
        u.pm = tm; u.pn = e * 4 + j; return true; }
    DI bool first(Unit& u) const {
        if (KIND == 0) return next(0, u);
        if (threadIdx.x == 0) { const unsigned a = __hip_atomic_fetch_add(queue + 16 * (c % 8), 2u, RLX_AGENT); qs[0] = (int)a; qs[1] = (int)a + 1; }
        asm volatile("s_waitcnt vmcnt(0) lgkmcnt(0)" ::: "memory"); __builtin_amdgcn_s_barrier(); asm volatile("" ::: "memory");
        return decode(qs[0], u);
    }
    DI bool more(int i, Unit& u) const {
        if (KIND == 0) return next(i, u);
        return decode(qs[i & 1], u);
    }
    DI bool next(int i, Unit& u) const {
        const int nwg = ts[16] * 4; const int cc = c;
        const long L = (long)i * G + cc; if (L >= nwg) return false;
        int wgid = (int)L; { const int q = nwg / 8, r = nwg % 8, xcd = wgid % 8, off = wgid / 8; wgid = (xcd < r ? xcd * (q + 1) : r * (q + 1) + (xcd - r) * q) + off; }
        const int tm = wgid >> 2, j = wgid & 3; int e = 0;
#pragma unroll
        for (int k = 1; k < 16; ++k) e += (ts[k] <= tm) ? 1 : 0;
        u.pm = tm; u.pn = e * 4 + j; return true;
    }
    const unsigned char* hsc;
    struct Pf { unsigned a, w, c, q; };
    DI const unsigned char* scale_base(const Unit& u) const { return hsc + (size_t)u.pm * 4096; }
    DI void pull_issue(int tid, Pf& pf) const { if (KIND == 1 && tid == 0) pf.q = __hip_atomic_fetch_add(queue + 16 * (c % 8), 1u, RLX_AGENT); }
    DI void pull_publish(int tid, const Pf& pf, int ui) const { if (KIND == 1 && tid == 0 && ui >= 0) qs[ui & 1] = (int)pf.q; }
    DI void prefetch(const Unit& u, int r, Pf& pf) const {
        const int e = u.pn >> 2, idx = (u.pm - ts[e]) * 256 + (r & 255); const bool valid = idx < ts[32 + e];
        pf.a = 0xffffffffu; pf.w = 0u; pf.c = 32u;
        if (valid && r < 256) { pf.a = (unsigned)slot_a[(size_t)e * SLOT_CAP + idx]; if (KIND == 1) pf.w = __float_as_uint(slot_w[(size_t)e * SLOT_CAP + idx]); }
        if (KIND == 1 && r < 64) pf.c = __hip_atomic_load(done_cnt + u.pm, RLX_AGENT);
    }
    DI void finish_meta(const Unit& u, int r, const Pf& pf, unsigned& off, unsigned& a0, unsigned& a1) const {
        if (KIND == 0) { const bool pad = pf.a == 0xffffffffu; off = (pad ? 0u : ((pf.a & 0xffffu) >> 1)) * (unsigned)D; a0 = 0u; a1 = pad ? 0u : (pf.a & 0xffff0000u); }
        else { off = (unsigned)(u.pm * 256 + r) * (unsigned)DEXP; a0 = pf.a == 0xffffffffu ? pf.a : (pf.a & 0xffffu); a1 = pf.w; }
    }
    DI void wait_ready(const Unit& u, int tid, const Pf& pf) const {
        if (KIND == 1 && tid < 64) { unsigned sp = 0;
            if ((unsigned)__builtin_amdgcn_readfirstlane((int)pf.c) < 32u)
                while ((unsigned)__builtin_amdgcn_readfirstlane((int)__hip_atomic_load(done_cnt + u.pm, RLX_AGENT)) < 32u) { __builtin_amdgcn_s_sleep(2); if (++sp > (1u << 20)) break; } }
    }
    DI void a_ready(const Unit&) const {}
    DI void done_nowait(const Unit& u) const { if (KIND == 0 && (threadIdx.x & 63) == 0) __hip_atomic_fetch_add(done_cnt + u.pm, 1u, RLX_AGENT); }
};
struct EpiG1 {
    static constexpr bool PERM = true, AFTER_DRAIN = false;
    unsigned char* HID; int skip; const float* cinv; unsigned char* HSC;
    DI void operator()(const pg8::f32x4 (&acc)[2][2][4][2], const Unit& u, int wr, int wc, int fr, int fq, const LAS unsigned* meta) const {
        if (skip == 1) { if (acc[0][0][0][0][0] == 12345.678f) HID[0] = 1; return; }
        const __amdgpu_buffer_rsrc_t rs = __builtin_amdgcn_make_buffer_rsrc((void*)HID, 0, (int)((size_t)NSLOT_MAX * DEXP), 0x00020000);
        const __amdgpu_buffer_rsrc_t rsc = __builtin_amdgcn_make_buffer_rsrc((void*)HSC, 0, (int)((size_t)NSLOT_MAX * 16), 0x00020000);
        const int ln_ = ftid() & 63, fr_ = ln_ & 15, fq_ = ln_ >> 4; (void)fr; (void)fq;
        const int e = u.pn >> 2, j = u.pn & 3, r0 = wr * 64 + fr_, row0 = u.pm * BM + r0, col = j * 128 + wc * 32 + 8 * fq_;
        asm volatile("" ::: "memory");
        const float* cg = cinv + (e * 2 + 0) * 512 + col; const float* cu = cinv + (e * 2 + 1) * 512 + col;
        const pg8::f32x4 cg0 = *(const pg8::f32x4*)cg, cg1 = *(const pg8::f32x4*)(cg + 4), cu0 = *(const pg8::f32x4*)cu, cu1 = *(const pg8::f32x4*)(cu + 4);
#pragma unroll
        for (int ai = 0; ai < 2; ++ai)
#pragma unroll
            for (int m = 0; m < 4; ++m) { const int rl = r0 + ai * HALF + m * 16, row = row0 + ai * HALF + m * 16; float o[8];
                const float ra = __uint_as_float(meta[512 + rl]);
#pragma unroll
                for (int i = 0; i < 4; ++i) { o[i] = silu_f(acc[ai][0][m][0][i] * (ra * cg0[i])) * (acc[ai][1][m][0][i] * (ra * cu0[i])); o[4 + i] = silu_f(acc[ai][0][m][1][i] * (ra * cg1[i])) * (acc[ai][1][m][1][i] * (ra * cu1[i])); }
                float bm = fmaxf(fmaxf(fmaxf(fabsf(o[0]), fabsf(o[1])), fmaxf(fabsf(o[2]), fabsf(o[3]))), fmaxf(fmaxf(fabsf(o[4]), fabsf(o[5])), fmaxf(fabsf(o[6]), fabsf(o[7]))));
                bm = fmaxf(bm, __shfl_xor(bm, 16)); bm = fmaxf(bm, __shfl_xor(bm, 32));
                unsigned eb = (__float_as_uint(bm * (1.0f / 448.0f)) + 0x7fffffu) >> 23; eb = eb < 1u ? 1u : (eb > 254u ? 254u : eb);
                const float mult = __uint_as_float((254u - eb) << 23);
                v2u w; w.x = pk4_fp8(o[0] * mult, o[1] * mult, o[2] * mult, o[3] * mult); w.y = pk4_fp8(o[4] * mult, o[5] * mult, o[6] * mult, o[7] * mult);
                __builtin_amdgcn_raw_buffer_store_b64(w, rs, row * DEXP + col, 0, 16);
                if (fq_ == 0) __builtin_amdgcn_raw_buffer_store_b8((unsigned char)eb, rsc, ((u.pm * 4 + j) * 256 + rl) * 4 + wc, 0, 16); }
    }
};
struct EpiG2 {
    static constexpr bool PERM = true, AFTER_DRAIN = false;
    unsigned char* ROWS; int skip; const float* cinv; unsigned char* SCR;
    DI void operator()(const pg8::f32x4 (&acc)[2][2][4][2], const Unit& u, int wr, int wc, int fr, int fq, const LAS unsigned* meta) const {
        if (skip == 1) { if (acc[0][0][0][0][0] == 12345.678f) ROWS[0] = 1; return; }
        const int r0 = wr * 64 + fr, colb = (u.pn & 3) * BM + wc * 32 + 8 * fq;
        asm volatile("" ::: "memory");
        pg8::f32x4 ci[2][2];
#pragma unroll
        for (int bj = 0; bj < 2; ++bj) { const float* cp = cinv + (u.pn >> 2) * D + colb + bj * HALF; ci[bj][0] = *(const pg8::f32x4*)cp; ci[bj][1] = *(const pg8::f32x4*)(cp + 4); }
#pragma unroll
        for (int ai = 0; ai < 2; ++ai)
#pragma unroll
            for (int m = 0; m < 4; ++m) { const int r = r0 + ai * HALF + m * 16; const int d = (int)meta[256 + r]; const float wt = __uint_as_float(meta[512 + r]);
#pragma unroll
                for (int bj = 0; bj < 2; ++bj) { const pg8::f32x4 v0 = acc[ai][bj][m][0] * (ci[bj][0] * wt), v1 = acc[ai][bj][m][1] * (ci[bj][1] * wt);
                    float bm = fmaxf(fmaxf(fmaxf(fabsf(v0[0]), fabsf(v0[1])), fmaxf(fabsf(v0[2]), fabsf(v0[3]))), fmaxf(fmaxf(fabsf(v1[0]), fabsf(v1[1])), fmaxf(fabsf(v1[2]), fabsf(v1[3]))));
                    bm = fmaxf(bm, __shfl_xor(bm, 16)); bm = fmaxf(bm, __shfl_xor(bm, 32)); float mult; const unsigned eb = mx_scale(bm, mult);
                    if (d >= 0) { v2u w; w.x = pk4_fp8(v0[0] * mult, v0[1] * mult, v0[2] * mult, v0[3] * mult); w.y = pk4_fp8(v1[0] * mult, v1[1] * mult, v1[2] * mult, v1[3] * mult);
                        *(v2u*)(ROWS + (size_t)d * 2048 + colb + bj * HALF) = w;
                        if (fq == 0) SCR[(size_t)d * 32 + (4 * bj + wc) * 4 + (u.pn & 3)] = (unsigned char)eb; } } }
    }
};

DI void mix_gating_simple(Frame& F, const Args& A, int l) {
    FRAME_IDS
    const bf16* P = (const bf16*)(F.ws + WS_PROJ); bf16* MIX = (bf16*)(F.ws + WS_MIXCAT);
    const float* lng = (const float*)A.in[I_GMLNG] + l * AW; const float* lnb = (const float*)A.in[I_GMLNB] + l * AW;
    const float* ws_ = (const float*)A.in[I_GMWS] + (size_t)l * 4 * 128 * 128; const float* bs_ = (const float*)A.in[I_GMBS] + l * 4 * 128;
    LAS float* vln = (LAS float*)(F.lds + RING_OFF);
    for (int it = F.vcu; it < BATCH * (T / 128); it += F.G) {
        const int m0 = it * 128;
        for (int r = wave_; r < 128; r += NWAVES) {
            const v2u w = *(const v2u*)(P + (size_t)(m0 + r) * PROJW + COL_V + 4 * lane_);
            float v[4] = {gelu_tanh_f(bflo(w.x)), gelu_tanh_f(bfhi(w.x)), gelu_tanh_f(bflo(w.y)), gelu_tanh_f(bfhi(w.y))};
            const float mean = wave_sum(v[0] + v[1] + v[2] + v[3]) * (1.f / 256.f);
            float s2 = 0.f;
#pragma unroll
            for (int i = 0; i < 4; ++i) { v[i] -= mean; s2 += v[i] * v[i]; }
            const float rstd = 1.0f / sqrtf(wave_sum(s2) * (1.f / 256.f) + LN_EPS);
#pragma unroll
            for (int i = 0; i < 4; ++i) vln[r * 256 + 4 * lane_ + i] = v[i] * rstd * lng[4 * lane_ + i] + lnb[4 * lane_ + i];
        }
        __syncthreads();
        { const int c = tid_ & 255, tp = tid_ >> 8, h = c >> 6;
          for (int t = tp; t < 128; t += 2) { const float* wrow = ws_ + ((size_t)h * 128 + t) * 128; float acc = 0.f;
              for (int s = 0; s <= t; ++s) acc += wrow[s] * vln[s * 256 + c];
              const float uu = gelu_tanh_f(bf2f(P[(size_t)(m0 + t) * PROJW + COL_U + c]));
              MIX[(size_t)(m0 + t) * D + c] = (bf16)f2bf(uu * (acc + bs_[h * 128 + t])); } }
        __syncthreads();
    }
}
DI void mix_attn_simple(Frame& F, int l) {
    FRAME_IDS
    const bf16* P = (const bf16*)(F.ws + WS_PROJ); bf16* MIX = (bf16*)(F.ws + WS_MIXCAT);
    const int gw = F.vcu * NWAVES + wave_, NGW = F.G * NWAVES;
    for (int it = gw; it < M * NH; it += NGW) {
        const int m = it >> 3, h = it & 7, t = m & (T - 1);
        const float q = bf2f(P[(size_t)m * PROJW + COL_Q + h * 64 + lane_]);
        float mx = -1e30f, den = 0.f, o = 0.f;
#pragma unroll 1
        for (int g = 0; g < 3; ++g) { const int dl = (g == 0) ? 1 : (g == 1 ? 4 : 16);
            int nk = t / dl; if (nk > 128) nk = 128;
#pragma unroll 2
            for (int j = 0; j <= nk; ++j) { const size_t mk = (size_t)(m - j * dl);
                const float kv = bf2f(P[mk * PROJW + COL_K + h * 64 + lane_]); const float vv = bf2f(P[mk * PROJW + COL_VA + h * 64 + lane_]);
                const float s = wave_sum(q * kv);
                const float mn = fmaxf(mx, s), f = __builtin_amdgcn_exp2f(mx - mn), p = __builtin_amdgcn_exp2f(s - mn);
                den = den * f + p; o = o * f + p * vv; mx = mn; } }
        MIX[(size_t)m * D + AW + h * 64 + lane_] = (bf16)f2bf(o / den);
    }
}

typedef float f32x16 __attribute__((ext_vector_type(16)));
typedef short v4i16_t __attribute__((ext_vector_type(4)));
DI int crow16(int r, int hi) { return (r & 3) + 8 * (r >> 2) + 4 * hi; }
template <int SUB> DI void mix_attn_mfma(Frame& F, int l) {
    FRAME_IDS
    const bf16* P = (const bf16*)(F.ws + WS_PROJ);
    LAS unsigned char* Ks = F.lds + RING_OFF; LAS unsigned char* Vs = Ks + 49152;
    LAS unsigned char* St = F.lds + ATT_STAGE_OFF + wave_ * 4608;
    const int ql = lane_ & 31, hi = lane_ >> 5, prow = lane_ >> 3, pch = lane_ & 7;
    constexpr int nitems = SUB == 0 ? 2048 : 1024;
    v4u kreg[6], vreg[6], qraw[4]; bf16x8 qf[4];
    int it = F.vcu; if (it >= nitems) return;
    int d, r, s0, b, h; size_t tokbase;
#define ATT_DECODE(IT) do { const int idx_ = (IT) & 1023; b = idx_ >> 7; h = (idx_ >> 4) & 7; int tile_; \
        if (SUB == 1) { d = 1; r = 0; tile_ = idx_ & 15; } else if ((IT) < 1024) { d = 16; r = idx_ & 15; tile_ = 0; } else { d = 4; r = (idx_ >> 2) & 3; tile_ = idx_ & 3; } \
        s0 = tile_ * 256; tokbase = (size_t)b * T + r; } while (0)
#define ATT_LOAD() do { const int tl_ = ftid(); _Pragma("unroll") for (int i = 0; i < 6; ++i) { const int idx2 = tl_ + 512 * i, row = idx2 >> 3, ch = idx2 & 7, step = s0 - 128 + row; \
            if (step >= 0) { const bf16* src = P + (tokbase + (size_t)step * d) * PROJW + h * 64 + ch * 8; kreg[i] = *(const v4u*)(src + COL_K); vreg[i] = *(const v4u*)(src + COL_VA); } \
            else { kreg[i] = (v4u){0u, 0u, 0u, 0u}; vreg[i] = (v4u){0u, 0u, 0u, 0u}; } } \
        _Pragma("unroll") for (int p = 0; p < 4; ++p) qraw[p] = *(const v4u*)(P + (tokbase + (size_t)(s0 + 32 * wave_ + 8 * p + prow) * d) * PROJW + COL_Q + h * 64 + pch * 8); } while (0)
#define ATT_WRITE() do { const int tw_ = ftid(); _Pragma("unroll") for (int i = 0; i < 6; ++i) { const int idx2 = tw_ + 512 * i, row = idx2 >> 3, ch = idx2 & 7; \
            *(LAS v4u*)(Ks + row * 128 + ((ch ^ ((row >> 1) & 7)) << 4)) = kreg[i]; \
            *(LAS v4u*)(Vs + row * 128 + ((ch ^ (((row >> 1) & 1) << 2)) << 4)) = vreg[i]; } \
        _Pragma("unroll") for (int p = 0; p < 4; ++p) *(LAS v4u*)(St + (8 * p + prow) * 144 + pch * 16) = qraw[p]; } while (0)
    ATT_DECODE(it); ATT_LOAD(); ATT_WRITE();
    __syncthreads();
    for (;;) {
        const size_t tb = tokbase; const int s0c = s0, dc = d, hcur = h, itcur = it;
        const bool first = (s0 == 0);
#pragma unroll
        for (int ks = 0; ks < 4; ++ks) qf[ks] = *(const LAS bf16x8*)(St + ql * 144 + (2 * ks + hi) * 16);
        const int itn = it + F.G; const bool has_next = itn < nitems;
        if (has_next) { ATT_DECODE(itn); ATT_LOAD(); }
        const int i0 = 32 * wave_;
        f32x16 S[5];
#pragma unroll
        for (int kb = 0; kb < 5; ++kb) { f32x16 acc;
#pragma unroll
            for (int i = 0; i < 16; ++i) acc[i] = 0.f;
            const int krow = i0 + 32 * kb + ql;
#pragma unroll
            for (int ks = 0; ks < 4; ++ks) { const bf16x8 a = *(const LAS bf16x8*)(Ks + krow * 128 + (((2 * ks + hi) ^ ((krow >> 1) & 7)) << 4)); acc = __builtin_amdgcn_mfma_f32_32x32x16_bf16(a, qf[ks], acc, 0, 0, 0); }
            S[kb] = acc; }
        int qrel = ql - 4 * hi; asm volatile("" : "+v"(qrel));
        float mx = -1e30f;
#pragma unroll
        for (int kb = 0; kb < 5; ++kb) {
            const bool bvalid = !first || (wave_ + kb >= 4);
            if (!bvalid) {
#pragma unroll
                for (int i = 0; i < 16; ++i) S[kb][i] = -1e30f;
            } else {
#pragma unroll
                for (int i = 0; i < 16; ++i) { const int c0 = crow16(i, 0); float v = S[kb][i];
                    if (kb == 0) v = (c0 >= qrel) ? v : -1e30f;
                    if (kb == 4) v = (c0 <= qrel) ? v : -1e30f;
                    S[kb][i] = v; mx = fmaxf(mx, v); }
            }
        }
        mx = fmaxf(mx, __shfl_xor(mx, 32));
        float lsum = 0.f;
#pragma unroll
        for (int kb = 0; kb < 5; ++kb)
#pragma unroll
            for (int i = 0; i < 16; ++i) { const float p = __builtin_amdgcn_exp2f(S[kb][i] - mx); S[kb][i] = p; lsum += p; }
        lsum += __shfl_xor(lsum, 32);
        v4u x16[4], x4[4]; f32x2_t s16 = {0.f, 0.f}, s4 = {0.f, 0.f};
        if (SUB == 1) {
            const size_t qt = tb + (size_t)(s0c + i0 + ql) * dc;
            s16 = *(const f32x2_t*)((const float*)(F.ws + WS_STAT) + (qt * NH + hcur) * 2); s4 = *(const f32x2_t*)((const float*)(F.ws + WS_STAT) + (size_t)M * NH * 2 + (qt * NH + hcur) * 2);
        }
        f32x16 O[2];
#pragma unroll
        for (int i = 0; i < 16; ++i) { O[0][i] = 0.f; O[1][i] = 0.f; }
        const int trq = (lane_ & 15) >> 2, trg = (lane_ >> 4) & 1, trp = lane_ & 3;
#pragma unroll
        for (int kb = 0; kb < 5; ++kb)
#pragma unroll
            for (int s = 0; s < 2; ++s) {
                if (SUB == 1 && kb == 2 && s == 0) {
#pragma unroll
                    for (int p = 0; p < 4; ++p) { const size_t rt = tb + (size_t)(s0c + i0 + 8 * p + prow) * dc; const bf16* pp = (const bf16*)(F.ws + WS_XN) + rt * BW + hcur * 64 + pch * 8;
                        x16[p] = *(const v4u*)pp; x4[p] = *(const v4u*)(pp + (size_t)M * BW); } }
                v4u pw; pw.x = cvtpk(S[kb][8 * s], S[kb][8 * s + 1]); pw.y = cvtpk(S[kb][8 * s + 2], S[kb][8 * s + 3]); pw.z = cvtpk(S[kb][8 * s + 4], S[kb][8 * s + 5]); pw.w = cvtpk(S[kb][8 * s + 6], S[kb][8 * s + 7]);
                const bf16x8 pb = __builtin_bit_cast(bf16x8, pw);
                const int rlo = i0 + 32 * kb + 16 * s + 4 * hi + trq, rhi = rlo + 8;
#pragma unroll
                for (int dh = 0; dh < 2; ++dh) { const int chunk = 4 * dh + 2 * trg + (trp >> 1);
                    const v4i16_t lo = __builtin_amdgcn_ds_read_tr16_b64_v4i16((LAS v4i16_t*)(Vs + rlo * 128 + ((chunk ^ (((rlo >> 1) & 1) << 2)) << 4) + 8 * (trp & 1)));
                    const v4i16_t hh = __builtin_amdgcn_ds_read_tr16_b64_v4i16((LAS v4i16_t*)(Vs + rhi * 128 + ((chunk ^ (((rhi >> 1) & 1) << 2)) << 4) + 8 * (trp & 1)));
                    const bf16x8 va = (bf16x8){lo[0], lo[1], lo[2], lo[3], hh[0], hh[1], hh[2], hh[3]};
                    O[dh] = __builtin_amdgcn_mfma_f32_32x32x16_bf16(va, pb, O[dh], 0, 0, 0); } }
        float osc;
        if (SUB == 0) osc = 1.0f / lsum;
        else { const float MM = fmaxf(mx, fmaxf(s16.x, s4.x)), a1 = __builtin_amdgcn_exp2f(mx - MM), a16 = s16.y * __builtin_amdgcn_exp2f(s16.x - MM), a4 = s4.y * __builtin_amdgcn_exp2f(s4.x - MM);
            const float inv = 1.0f / (lsum * a1 + a16 + a4); osc = a1 * inv;
            if (hi == 0) { f32x2_t cc = {a16 * inv, a4 * inv}; *(LAS f32x2_t*)(St + ql * 144 + 128) = cc; } }
#pragma unroll
        for (int dh = 0; dh < 2; ++dh)
#pragma unroll
            for (int g4 = 0; g4 < 4; ++g4) { v2u w; w.x = cvtpk(O[dh][4 * g4] * osc, O[dh][4 * g4 + 1] * osc); w.y = cvtpk(O[dh][4 * g4 + 2] * osc, O[dh][4 * g4 + 3] * osc);
                *(LAS v2u*)(St + ql * 144 + (32 * dh + 8 * g4 + 4 * hi) * 2) = w; }
        if (SUB == 0) {
            bf16* PART = (bf16*)(F.ws + WS_XN) + (itcur < 1024 ? 0 : (size_t)M * BW); float* ST = (float*)(F.ws + WS_STAT) + (itcur < 1024 ? 0 : (size_t)M * NH * 2);
            if (hi == 0) { const size_t qt = tb + (size_t)(s0c + i0 + ql) * dc; f32x2_t st = {mx, lsum}; *(f32x2_t*)(ST + (qt * NH + hcur) * 2) = st; }
#pragma unroll
            for (int p = 0; p < 4; ++p) { const size_t rt = tb + (size_t)(s0c + i0 + 8 * p + prow) * dc;
                *(v4u*)(PART + rt * BW + hcur * 64 + pch * 8) = *(const LAS v4u*)(St + (8 * p + prow) * 144 + pch * 16); }
        } else {
#pragma unroll
            for (int p = 0; p < 4; ++p) { const size_t rt = tb + (size_t)(s0c + i0 + 8 * p + prow) * dc;
                const v4u ov = *(const LAS v4u*)(St + (8 * p + prow) * 144 + pch * 16); const f32x2_t cc = *(const LAS f32x2_t*)(St + (8 * p + prow) * 144 + 128);
                float f[8];
                f[0] = bflo(ov.x) + cc.x * bflo(x16[p].x) + cc.y * bflo(x4[p].x); f[1] = bfhi(ov.x) + cc.x * bfhi(x16[p].x) + cc.y * bfhi(x4[p].x);
                f[2] = bflo(ov.y) + cc.x * bflo(x16[p].y) + cc.y * bflo(x4[p].y); f[3] = bfhi(ov.y) + cc.x * bfhi(x16[p].y) + cc.y * bfhi(x4[p].y);
                f[4] = bflo(ov.z) + cc.x * bflo(x16[p].z) + cc.y * bflo(x4[p].z); f[5] = bfhi(ov.z) + cc.x * bfhi(x16[p].z) + cc.y * bfhi(x4[p].z);
                f[6] = bflo(ov.w) + cc.x * bflo(x16[p].w) + cc.y * bflo(x4[p].w); f[7] = bfhi(ov.w) + cc.x * bfhi(x16[p].w) + cc.y * bfhi(x4[p].w);
                float bm = fmaxf(fmaxf(fmaxf(fabsf(f[0]), fabsf(f[1])), fmaxf(fabsf(f[2]), fabsf(f[3]))), fmaxf(fmaxf(fabsf(f[4]), fabsf(f[5])), fmaxf(fabsf(f[6]), fabsf(f[7]))));
                bm = fmaxf(bm, dpp_mov<0xB1>(bm)); bm = fmaxf(bm, dpp_mov<0x4E>(bm)); float mult; const unsigned eb = mx_scale(bm, mult);
                v2u o; o.x = pk4_fp8(f[0] * mult, f[1] * mult, f[2] * mult, f[3] * mult); o.y = pk4_fp8(f[4] * mult, f[5] * mult, f[6] * mult, f[7] * mult);
                *(v2u*)((unsigned char*)(F.ws + WS_MIXCAT) + rt * D + AW + hcur * 64 + pch * 8) = o;
                if ((pch & 3) == 0) ((unsigned char*)(F.ws + WS_SCM))[scm_index((int)rt, (AW + hcur * 64 + pch * 8) >> 5)] = (unsigned char)eb; }
        }
        __syncthreads();
        if (!has_next) break;
        ATT_WRITE(); it = itn;
        __syncthreads();
    }
#undef ATT_DECODE
#undef ATT_LOAD
#undef ATT_WRITE
}
typedef float f32x4_t __attribute__((ext_vector_type(4)));
DI void cmul_acc(float& xr, float& xi, float ar, float ai, float br, float bi) { const float nr = ar * xr - ai * xi + br, ni = ar * xi + ai * xr + bi; xr = nr; xi = ni; }
DI void mix_ssm_in(Frame& F, int l) {
    FRAME_IDS
    const bf16* P = (const bf16*)(F.ws + WS_PROJ);
    const bf16* WIN = (const bf16*)(F.ws + WS_SSM2 + l * SSM2_LAYER + S2_WIN);
    const float* apw = (const float*)(F.ws + WS_SSM2 + l * SSM2_LAYER + S2_APW);
    float* XLOC = (float*)(F.ws + WS_XLOC); float* XSUP = (float*)(F.ws + WS_XSUP);
    const int row = lane_ & 15, q = lane_ >> 4;
    for (int it = F.vcu; it < 256; it += F.G) {
        const int b = it >> 5, sc = (it >> 2) & 7, g = 4 * (it & 3) + (wave_ >> 1), half = wave_ & 1;
        bf16x8 af[16];
        { const bf16* src = P + ((size_t)b * T + (size_t)(16 * sc + row) * 32 + (q >> 1)) * PROJW + COL_S + g * 16 + 8 * (q & 1);
#pragma unroll
          for (int sp = 0; sp < 16; ++sp) af[sp] = *(const bf16x8*)(src + (size_t)(2 * sp) * PROJW); }
#pragma unroll 1
        for (int c4 = 0; c4 < 4; ++c4) { const int ct = 4 * half + c4;
            f32x4_t acc = {0.f, 0.f, 0.f, 0.f};
            const bf16* wp = WIN + (((size_t)(g * 16) * 8 + ct) * 64 + lane_) * 8;
#pragma unroll
            for (int sp = 0; sp < 16; ++sp) { const bf16x8 bfr = *(const bf16x8*)(wp + (size_t)sp * 8 * 64 * 8); acc = __builtin_amdgcn_mfma_f32_16x16x32_bf16(af[sp], bfr, acc, 0, 0, 0); }
            const int comp = 16 * ct + row, n = comp >> 1, part = comp & 1;
#pragma unroll
            for (int r = 0; r < 4; ++r) XLOC[(((size_t)b * 128 + 16 * sc + 4 * q + r) * 16 + g) * 128 + comp] = acc[r];
            const float a32r = apw[((g * 33 + 32) * 64 + n) * 2], a32i = apw[((g * 33 + 32) * 64 + n) * 2 + 1];
            const float sg = part ? 1.f : -1.f;
            float h = acc[0];
#pragma unroll
            for (int r = 1; r < 4; ++r) { const float o = __shfl_xor(h, 1); h = a32r * h + sg * a32i * o + acc[r]; }
            float p64r = a32r * a32r - a32i * a32i, p64i = 2.f * a32r * a32i;
            float p128r = p64r * p64r - p64i * p64i, p128i = 2.f * p64r * p64i;
            float wr = 1.f, wi = 0.f;
            for (int k = 0; k < 3 - q; ++k) { const float t0 = wr * p128r - wi * p128i, t1 = wr * p128i + wi * p128r; wr = t0; wi = t1; }
            { const float o = __shfl_xor(h, 1); h = wr * h + sg * wi * o; }
            h += __shfl_xor(h, 16); h += __shfl_xor(h, 32);
            if (q == 0) XSUP[(((size_t)b * 8 + sc) * 16 + g) * 128 + comp] = h;
        }
    }
}
DI void mix_ssm_out(Frame& F, const Args& A, int l) {
    FRAME_IDS
    const bf16* P = (const bf16*)(F.ws + WS_PROJ); bf16* YG = (bf16*)(F.ws + WS_YG);
    const bf16* KT = (const bf16*)(F.ws + WS_SSM2 + l * SSM2_LAYER + S2_KT); const bf16* CT = (const bf16*)(F.ws + WS_SSM2 + l * SSM2_LAYER + S2_CT);
    const float* apw = (const float*)(F.ws + WS_SSM2 + l * SSM2_LAYER + S2_APW);
    const float* XLOC = (const float*)(F.ws + WS_XLOC); const float* XSUP = (const float*)(F.ws + WS_XSUP);
    LAS unsigned char* Ut = F.lds + RING_OFF + wave_ * 4096;
    LAS float* Xs = (LAS float*)(F.lds + RING_OFF + wave_ * 4096 + 2048);
    for (int i = lane_; i < 256; i += 64) ((LAS unsigned*)Ut)[i] = 0u;
    const int row = lane_ & 15, q = lane_ >> 4;
    for (int it = F.vcu; it < 256; it += F.G) {
        const int b = it >> 5, sc = (it >> 2) & 7, g = 4 * (it & 3) + (wave_ >> 1), half = wave_ & 1, n = lane_;
        const size_t tokA = (size_t)b * T + (size_t)(16 * sc + 8 * half) * 32;
        v4u unext = *(const v4u*)(P + (tokA + (lane_ >> 1)) * PROJW + COL_S + g * 16 + 8 * (lane_ & 1));
        f32x2_t psup[8], ploc[8];
#pragma unroll
        for (int s2 = 0; s2 < 8; ++s2) { psup[s2] = (f32x2_t){0.f, 0.f}; if (s2 < sc) psup[s2] = *(const f32x2_t*)(XSUP + (((size_t)b * 8 + s2) * 16 + g) * 128 + 2 * n); }
#pragma unroll
        for (int k2 = 0; k2 < 8; ++k2) { ploc[k2] = (f32x2_t){0.f, 0.f}; if (half) ploc[k2] = *(const f32x2_t*)(XLOC + (((size_t)b * 128 + 16 * sc + k2) * 16 + g) * 128 + 2 * n); }
        const float dsk = ((const float*)A.in[I_SSMD])[(l * 16 + g) * 16 + row];
        const float a32r = apw[((g * 33 + 32) * 64 + n) * 2], a32i = apw[((g * 33 + 32) * 64 + n) * 2 + 1];
        const float a16r = apw[((g * 33 + 16) * 64 + n) * 2], a16i = apw[((g * 33 + 16) * 64 + n) * 2 + 1];
        float a512r = a32r, a512i = a32i;
#pragma unroll
        for (int k = 0; k < 4; ++k) { const float t0 = a512r * a512r - a512i * a512i, t1 = 2.f * a512r * a512i; a512r = t0; a512i = t1; }
        float xr = 0.f, xi = 0.f;
#pragma unroll
        for (int s2 = 0; s2 < 8; ++s2) if (s2 < sc) cmul_acc(xr, xi, a512r, a512i, psup[s2].x, psup[s2].y);
        if (half) {
#pragma unroll
            for (int k2 = 0; k2 < 8; ++k2) cmul_acc(xr, xi, a32r, a32i, ploc[k2].x, ploc[k2].y); }
        asm volatile("" : "+v"(xr), "+v"(xi) :: "memory");
        bf16x8 kt[16], ctf[4];
#pragma unroll
        for (int p = 0; p < 16; ++p) kt[p] = *(const bf16x8*)(KT + ((size_t)(g * 16 + p) * 64 + lane_) * 8);
#pragma unroll
        for (int sx = 0; sx < 4; ++sx) ctf[sx] = *(const bf16x8*)(CT + ((size_t)(g * 4 + sx) * 64 + lane_) * 8);
        f32x4_t apr[4][2];
#pragma unroll
        for (int sx = 0; sx < 4; ++sx) { const f32x4_t* ap = (const f32x4_t*)(apw + ((size_t)(g * 33 + row + 1) * 64 + 16 * sx + 4 * q) * 2); apr[sx][0] = ap[0]; apr[sx][1] = ap[1]; }
#pragma unroll 1
        for (int kk = 0; kk < 8; ++kk) {
            const size_t tok0 = tokA + (size_t)kk * 32;
            const f32x2_t xl = *(const f32x2_t*)(XLOC + (((size_t)b * 128 + 16 * sc + 8 * half + kk) * 16 + g) * 128 + 2 * n);
            *(LAS v4u*)(Ut + 1024 + lane_ * 16) = unext;
            if (kk < 7) unext = *(const v4u*)(P + (tok0 + 32 + (lane_ >> 1)) * PROJW + COL_S + g * 16 + 8 * (lane_ & 1));
            Xs[2 * n] = xr; Xs[2 * n + 1] = xi; Xs[128 + 2 * n] = a16r * xr - a16i * xi; Xs[128 + 2 * n + 1] = a16r * xi + a16i * xr;
#pragma unroll
            for (int tau = 0; tau < 2; ++tau) { f32x4_t acc = (f32x4_t){0.f, 0.f, 0.f, 0.f};
                const int ti = 16 * tau + row;
#pragma unroll
                for (int sx = 0; sx < 4; ++sx) { const LAS f32x4_t* xp = (const LAS f32x4_t*)(Xs + 128 * tau + 2 * (16 * sx + 4 * q)); const f32x4_t x01 = xp[0], x23 = xp[1];
                    const f32x4_t a01 = apr[sx][0], a23 = apr[sx][1];
                    v4u zw; zw.x = cvtpk(a01.x * x01.x - a01.y * x01.y, a01.x * x01.y + a01.y * x01.x); zw.y = cvtpk(a01.z * x01.z - a01.w * x01.w, a01.z * x01.w + a01.w * x01.z);
                    zw.z = cvtpk(a23.x * x23.x - a23.y * x23.y, a23.x * x23.y + a23.y * x23.x); zw.w = cvtpk(a23.z * x23.z - a23.w * x23.w, a23.z * x23.w + a23.w * x23.z);
                    acc = __builtin_amdgcn_mfma_f32_16x16x32_bf16(__builtin_bit_cast(bf16x8, zw), ctf[sx], acc, 0, 0, 0);
                    asm volatile("" ::: "memory"); }
#pragma unroll
                for (int p = 0; p < 16; ++p) if (p < 8 * tau + 8) { const bf16x8 ua = *(const LAS bf16x8*)(Ut + (32 + ti - 2 * p - (q >> 1)) * 32 + 16 * (q & 1));
                    acc = __builtin_amdgcn_mfma_f32_16x16x32_bf16(ua, kt[p], acc, 0, 0, 0); if ((p & 3) == 3) asm volatile("" ::: "memory"); }
#pragma unroll
                for (int r = 0; r < 4; ++r) { const int t2 = 16 * tau + 4 * q + r; const float uu = bf2f(*(const LAS bf16*)(Ut + (32 + t2) * 32 + 2 * row));
                    YG[(tok0 + t2) * 256 + g * 16 + row] = (bf16)f2bf(gelu_tanh_f(acc[r] + dsk * uu)); }
            }
            cmul_acc(xr, xi, a32r, a32i, xl.x, xl.y);
        }
    }
}
DI void mix_gating_mfma(Frame& F, const Args& A, int l, int variant = 0) {
    FRAME_IDS
    const bf16* P = (const bf16*)(F.ws + WS_PROJ); bf16* MIX = (bf16*)(F.ws + WS_MIXCAT);
    const bf16* GW = (const bf16*)(F.ws + WS_SSM2 + l * SSM2_LAYER + S2_GW);
    const float* lng = (const float*)A.in[I_GMLNG] + l * AW; const float* lnb = (const float*)A.in[I_GMLNB] + l * AW;
    const float* bs_ = (const float*)A.in[I_GMBS] + l * 4 * 128;
    LAS unsigned char* VT = F.lds + RING_OFF;
    const int ql = lane_ & 31, hi = lane_ >> 5, trq = (lane_ & 15) >> 2, trg = (lane_ >> 4) & 1, trp = lane_ & 3;
    for (int it = F.vcu; it < BATCH * (T / 128); it += F.G) {
        const int m0 = it * 128;
        __syncthreads();
        if (variant != 2) {
        v2u wv[16];
#pragma unroll
        for (int j = 0; j < 16; ++j) wv[j] = *(const v2u*)(P + (size_t)(m0 + wave_ + 8 * j) * PROJW + COL_V + 4 * lane_);
        const f32x4 gg = *(const f32x4*)(lng + 4 * lane_), bb = *(const f32x4*)(lnb + 4 * lane_);
#pragma unroll
        for (int j = 0; j < 16; ++j) { const int r = wave_ + 8 * j; const v2u w = wv[j];
            float v[4] = {gelu_tanh_f(bflo(w.x)), gelu_tanh_f(bfhi(w.x)), gelu_tanh_f(bflo(w.y)), gelu_tanh_f(bfhi(w.y))};
            const float mean = wave_sum(v[0] + v[1] + v[2] + v[3]) * (1.f / 256.f);
            float s2 = 0.f;
#pragma unroll
            for (int i = 0; i < 4; ++i) { v[i] -= mean; s2 += v[i] * v[i]; }
            const float rstd = 1.0f / sqrtf(wave_sum(s2) * (1.f / 256.f) + LN_EPS);
            v2u o; o.x = cvtpk(v[0] * rstd * gg.x + bb.x, v[1] * rstd * gg.y + bb.y); o.y = cvtpk(v[2] * rstd * gg.z + bb.z, v[3] * rstd * gg.w + bb.w);
            *(LAS v2u*)(VT + r * 512 + (((lane_ >> 1) ^ ((r & 3) << 2)) << 4) + 8 * (lane_ & 1)) = o;
        }
        }
        __syncthreads();
        if (variant == 1) continue;
        const int h = wave_ >> 1, cb = 64 * h + 32 * (wave_ & 1);
        const int chunk = (cb >> 3) + 2 * trg + (trp >> 1);
#pragma unroll
        for (int rt = 0; rt < 4; ++rt) {
            f32x16 acc;
#pragma unroll
            for (int i = 0; i < 16; ++i) acc[i] = 0.f;
            bf16x8 wa[8];
#pragma unroll
            for (int ks = 0; ks < 2 * rt + 2; ++ks) wa[ks] = *(const bf16x8*)(GW + (size_t)(h * 128 + 32 * rt) * 128 + 16 * ks + (unsigned)(ql * 128 + 8 * hi));
#pragma unroll
            for (int ks = 0; ks < 2 * rt + 2; ++ks) {
                const int rlo = 16 * ks + 8 * hi + trq;
                const v4i16_t lo = __builtin_amdgcn_ds_read_tr16_b64_v4i16((LAS v4i16_t*)(VT + rlo * 512 + ((chunk ^ (trq << 2)) << 4) + 8 * (trp & 1)));
                const v4i16_t hh = __builtin_amdgcn_ds_read_tr16_b64_v4i16((LAS v4i16_t*)(VT + (rlo + 4) * 512 + ((chunk ^ (trq << 2)) << 4) + 8 * (trp & 1)));
                const bf16x8 va = (bf16x8){lo[0], lo[1], lo[2], lo[3], hh[0], hh[1], hh[2], hh[3]};
                acc = __builtin_amdgcn_mfma_f32_32x32x16_bf16(va, wa[ks], acc, 0, 0, 0); }
            { const int t = 32 * rt + ql; const float bsv = bs_[h * 128 + t];
              const bf16* up = P + (size_t)(m0 + t) * PROJW + COL_U + cb + 4 * hi; unsigned char* op = (unsigned char*)MIX + (size_t)(m0 + t) * D + cb + 4 * hi;
              float ov[16]; float bm = 0.f;
#pragma unroll
              for (int g4 = 0; g4 < 4; ++g4) { const v2u uw = *(const v2u*)(up + 8 * g4);
                  ov[4 * g4] = gelu_tanh_f(bflo(uw.x)) * (acc[4 * g4] + bsv); ov[4 * g4 + 1] = gelu_tanh_f(bfhi(uw.x)) * (acc[4 * g4 + 1] + bsv); ov[4 * g4 + 2] = gelu_tanh_f(bflo(uw.y)) * (acc[4 * g4 + 2] + bsv); ov[4 * g4 + 3] = gelu_tanh_f(bfhi(uw.y)) * (acc[4 * g4 + 3] + bsv); }
#pragma unroll
              for (int i = 0; i < 16; ++i) bm = fmaxf(bm, fabsf(ov[i]));
              bm = fmaxf(bm, __shfl_xor(bm, 32)); float mult; const unsigned eb = mx_scale(bm, mult);
#pragma unroll
              for (int g4 = 0; g4 < 4; ++g4) *(unsigned*)(op + 8 * g4) = pk4_fp8(ov[4 * g4] * mult, ov[4 * g4 + 1] * mult, ov[4 * g4 + 2] * mult, ov[4 * g4 + 3] * mult);
              if (hi == 0) ((unsigned char*)(F.ws + WS_SCM))[scm_index(m0 + t, cb >> 5)] = (unsigned char)eb; }
        }
    }
}

DI void p_glu(Frame& F, const Args& A, int l) {
    FRAME_IDS
    const bf16* YG = (const bf16*)(F.ws + WS_YG); bf16* MIX = (bf16*)(F.ws + WS_MIXCAT);
    const bf16* GluT = (const bf16*)(F.ws + WS_WSMALL + l * WSMALL_LAYER + WOFF_GLU); const float* gb = (const float*)A.in[I_GLUB] + l * 256;
    LAS unsigned char* Bs = F.lds + RING_OFF;
#pragma unroll
    for (int i = 0; i < 16; ++i) { const int idx = tid_ + 512 * i, n = idx >> 5, ch = idx & 31;
        *(LAS v4u*)(Bs + n * 512 + ((ch ^ (n & 15)) << 4)) = *(const v4u*)(GluT + (size_t)n * 256 + ch * 8); }
    __syncthreads();
    const int tk = lane_ & 15, q = lane_ >> 4;
    for (int rt = F.vcu; rt < M / 128; rt += F.G) {
        const size_t tok = (size_t)rt * 128 + wave_ * 16 + tk;
        bf16x8 yf[8];
#pragma unroll
        for (int ks = 0; ks < 8; ++ks) yf[ks] = *(const bf16x8*)(YG + tok * 256 + 32 * ks + 8 * q);
#pragma unroll 2
        for (int cp = 0; cp < 8; ++cp) {
            float ov[8];
#pragma unroll
            for (int c2 = 0; c2 < 2; ++c2) { const int ct = 2 * cp + c2;
                f32x4_t acc = {0.f, 0.f, 0.f, 0.f};
                const int n = 16 * ct + tk;
#pragma unroll
                for (int ks = 0; ks < 8; ++ks) { const bf16x8 wf = *(const LAS bf16x8*)(Bs + n * 512 + (((4 * ks + q) ^ (n & 15)) << 4));
                    acc = __builtin_amdgcn_mfma_f32_16x16x32_bf16(wf, yf[ks], acc, 0, 0, 0); }
                const int n0 = 16 * ct + 4 * q; const v2u yw = *(const v2u*)(YG + tok * 256 + n0); const f32x4 bv = *(const f32x4*)(gb + n0);
                ov[4 * c2] = bflo(yw.x) * sigmoid_f(acc[0] + bv.x); ov[4 * c2 + 1] = bfhi(yw.x) * sigmoid_f(acc[1] + bv.y); ov[4 * c2 + 2] = bflo(yw.y) * sigmoid_f(acc[2] + bv.z); ov[4 * c2 + 3] = bfhi(yw.y) * sigmoid_f(acc[3] + bv.w); }
            float bm = fmaxf(fmaxf(fmaxf(fabsf(ov[0]), fabsf(ov[1])), fmaxf(fabsf(ov[2]), fabsf(ov[3]))), fmaxf(fmaxf(fabsf(ov[4]), fabsf(ov[5])), fmaxf(fabsf(ov[6]), fabsf(ov[7]))));
            bm = fmaxf(bm, __shfl_xor(bm, 16)); bm = fmaxf(bm, __shfl_xor(bm, 32)); float mult; const unsigned eb = mx_scale(bm, mult);
            unsigned char* op = (unsigned char*)MIX + tok * D + 768 + 32 * cp + 4 * q;
            *(unsigned*)op = pk4_fp8(ov[0] * mult, ov[1] * mult, ov[2] * mult, ov[3] * mult); *(unsigned*)(op + 16) = pk4_fp8(ov[4] * mult, ov[5] * mult, ov[6] * mult, ov[7] * mult);
            if (q == 0) ((unsigned char*)(F.ws + WS_SCM))[scm_index((int)tok, 24 + cp)] = (unsigned char)eb;
        }
    }
}
DI void mix_ssm_simple(Frame& F, const Args& A, int l) {
    FRAME_IDS
    const bf16* P = (const bf16*)(F.ws + WS_PROJ); bf16* YG = (bf16*)(F.ws + WS_YG);
    const float* tab = (const float*)(F.ws + WS_SSM) + (size_t)l * SSM_TAB;
    LAS float* fin = (LAS float*)(F.lds + RING_OFF);
    for (int it = F.vcu; it < BATCH * SSM_G; it += F.G) {
        const int b = it >> 4, g = it & 15, n = lane_, seg = wave_, gn = g * 64 + n;
        const float are = tab[gn], aim = tab[1024 + gn];
        float bre[16], bim[16], cre[16], cim[16];
#pragma unroll
        for (int c = 0; c < 16; ++c) { bre[c] = tab[2048 + gn * 16 + c]; bim[c] = tab[2048 + 16384 + gn * 16 + c];
            cre[c] = ((const float*)A.in[I_CRE])[(((size_t)l * 16 + g) * 16 + c) * 64 + n]; cim[c] = ((const float*)A.in[I_CIM])[(((size_t)l * 16 + g) * 16 + c) * 64 + n]; }
        const float dsk = ((const float*)A.in[I_SSMD])[(l * 16 + g) * 16 + (lane_ & 15)];
        const size_t mbase = (size_t)b * T + seg * 512;
        float xr = 0.f, xi = 0.f;
        for (int tt = 0; tt < 512; ++tt) { const v4u* up = (const v4u*)(P + (mbase + tt) * PROJW + COL_S + g * 16); const v4u u0 = up[0], u1 = up[1];
            const float u[16] = {bflo(u0.x), bfhi(u0.x), bflo(u0.y), bfhi(u0.y), bflo(u0.z), bfhi(u0.z), bflo(u0.w), bfhi(u0.w), bflo(u1.x), bfhi(u1.x), bflo(u1.y), bfhi(u1.y), bflo(u1.z), bfhi(u1.z), bflo(u1.w), bfhi(u1.w)};
            float br = 0.f, bi = 0.f;
#pragma unroll
            for (int c = 0; c < 16; ++c) { br += u[c] * bre[c]; bi += u[c] * bim[c]; }
            const float nr = are * xr - aim * xi + br, ni = are * xi + aim * xr + bi; xr = nr; xi = ni; }
        fin[(seg * 64 + n) * 2] = xr; fin[(seg * 64 + n) * 2 + 1] = xi;
        __syncthreads();
        float pr = are, pi = aim;
#pragma unroll
        for (int k = 0; k < 9; ++k) { const float t0 = pr * pr - pi * pi, t1 = 2.f * pr * pi; pr = t0; pi = t1; }
        xr = 0.f; xi = 0.f;
        for (int s = 0; s < seg; ++s) { const float fr_ = fin[(s * 64 + n) * 2], fi_ = fin[(s * 64 + n) * 2 + 1];
            const float nr = pr * xr - pi * xi + fr_, ni = pr * xi + pi * xr + fi_; xr = nr; xi = ni; }
        for (int tt = 0; tt < 512; ++tt) { const v4u* up = (const v4u*)(P + (mbase + tt) * PROJW + COL_S + g * 16); const v4u u0 = up[0], u1 = up[1];
            const float u[16] = {bflo(u0.x), bfhi(u0.x), bflo(u0.y), bfhi(u0.y), bflo(u0.z), bfhi(u0.z), bflo(u0.w), bfhi(u0.w), bflo(u1.x), bfhi(u1.x), bflo(u1.y), bfhi(u1.y), bflo(u1.z), bfhi(u1.z), bflo(u1.w), bfhi(u1.w)};
            float br = 0.f, bi = 0.f;
#pragma unroll
            for (int c = 0; c < 16; ++c) { br += u[c] * bre[c]; bi += u[c] * bim[c]; }
            const float nr = are * xr - aim * xi + br, ni = are * xi + aim * xr + bi; xr = nr; xi = ni;
            float ysel = 0.f, usel = 0.f;
#pragma unroll
            for (int c = 0; c < 16; ++c) { const float r = wave_sum(xr * cre[c] - xi * cim[c]); if ((lane_ & 15) == c) { ysel = r; usel = u[c]; } }
            if (lane_ < 16) { const float y = ysel + dsk * usel; YG[(mbase + tt) * 256 + g * 16 + lane_] = (bf16)f2bf(gelu_tanh_f(y)); } }
        __syncthreads();
    }
}

DI bool beats(float x, int i, float y, int j) { return x > y || (x == y && i < j); }
DI void p_row_b(Frame& F, const Args& A, int l, bool count = true) {
    FRAME_IDS
    const int gw = F.vcu * NWAVES + wave_, NGW = F.G * NWAVES;
    const bf16* PRE = (const bf16*)(F.ws + WS_PRE); bf16* X1 = (bf16*)(F.ws + WS_X1); bf16* XN = (bf16*)(F.ws + WS_XN);
    const float* mod = (const float*)(F.ws + WS_MOD) + (size_t)l * BATCH * 6 * D;
    const float* ln1g = (const float*)A.in[I_LN1G] + l * D; const float* ln1b = (const float*)A.in[I_LN1B] + l * D;
    const float* rw = (const float*)A.in[I_RW]; const float* rb = (const float*)A.in[I_RB];
    int* slot_a = (int*)(F.ws + WS_SLOT_A); float* slot_w = (float*)(F.ws + WS_SLOT_W);
    LAS float* rwS = (LAS float*)(F.lds + RING_OFF);
    volatile LAS unsigned* lcnt = (volatile LAS unsigned*)(F.lds + RING_OFF + 65536);
    LAS int* list_a = (LAS int*)(F.lds + RING_OFF + 66048); LAS float* list_w = (LAS float*)(F.lds + RING_OFF + 66048 + 8192);
    for (int i = tid_; i < D * NEXP; i += NTHR) rwS[(i & 15) * D + (i >> 4)] = rw[i];
    if (tid_ < 32) lcnt[tid_] = 0u;
    __syncthreads();
    const int hi5 = lane_ >> 5, b4 = (lane_ >> 4) & 1, b3 = (lane_ >> 3) & 1, b2 = (lane_ >> 2) & 1, emine = 8 * hi5 + 4 * b4 + 2 * b3 + b2;
    const int wi = 2 * b3 + b2, mygrp = 2 * hi5 + b4;
    const float rbm = rb[emine];
    Row16 lg1, lb1; row_load_f32(lg1, ln1g, lane_); row_load_f32(lb1, ln1b, lane_);
    v2u nraw[4];
    const int bq = gw / (NGW / BATCH), mbase = bq * T + gw % (NGW / BATCH), mstep = NGW / BATCH;
    const float* md = mod + (size_t)bq * 6 * D;
    Row16 msc, msh; row_load_f32(msc, md + 4 * D, lane_); row_load_f32(msh, md + 3 * D, lane_);
    { const v2u* q = (const v2u*)(PRE + (size_t)mbase * D);
#pragma unroll
      for (int k = 0; k < 4; ++k) nraw[k] = q[k * 64 + lane_]; }
    for (int m = mbase; m < (bq + 1) * T; m += mstep) {
        Row16 r;
#pragma unroll
        for (int k = 0; k < 4; ++k) { r.v[4 * k] = bflo(nraw[k].x); r.v[4 * k + 1] = bfhi(nraw[k].x); r.v[4 * k + 2] = bflo(nraw[k].y); r.v[4 * k + 3] = bfhi(nraw[k].y); }
        if (m + mstep < (bq + 1) * T) { const v2u* q = (const v2u*)(PRE + (size_t)(m + mstep) * D);
#pragma unroll
            for (int k = 0; k < 4; ++k) nraw[k] = q[k * 64 + lane_]; }
        row_ln(r);
#pragma unroll
        for (int i = 0; i < 16; ++i) r.v[i] = r.v[i] * lg1.v[i] + lb1.v[i];
        row_ln(r);
#pragma unroll
        for (int i = 0; i < 16; ++i) r.v[i] = r.v[i] * (1.0f + msc.v[i]) + msh.v[i];
        unsigned ib;
        { float am = 0.f;
#pragma unroll
          for (int i = 0; i < 16; ++i) am = fmaxf(am, fabsf(r.v[i]));
          am = wave_max(am); ib = (am > 1e-30f) ? ((__float_as_uint(am * (1.0f / 440.0f)) + 0xffffu) & 0xffff0000u) : 0x3f800000u;
          const float qs = 1.0f / __uint_as_float(ib);
          unsigned* q8 = (unsigned*)((unsigned char*)XN + (size_t)m * D);
#pragma unroll
          for (int k = 0; k < 4; ++k) q8[k * 64 + lane_] = pk4_fp8(r.v[4 * k] * qs, r.v[4 * k + 1] * qs, r.v[4 * k + 2] * qs, r.v[4 * k + 3] * qs); }
        float lg[16];
#pragma unroll
        for (int e = 0; e < 16; ++e) { float a = 0.f;
#pragma unroll
            for (int k = 0; k < 4; ++k) { const f32x4 w4 = *(const LAS f32x4*)(rwS + e * D + 256 * k + 4 * lane_); a += r.v[4 * k] * w4.x + r.v[4 * k + 1] * w4.y + r.v[4 * k + 2] * w4.z + r.v[4 * k + 3] * w4.w; }
            lg[e] = a; }
        float t8[8], t4[4], t2[2];
#pragma unroll
        for (int i = 0; i < 8; ++i) { const float keep = hi5 ? lg[8 + i] : lg[i], give = hi5 ? lg[i] : lg[8 + i]; t8[i] = keep + __shfl_xor(give, 32); }
#pragma unroll
        for (int i = 0; i < 4; ++i) { const float keep = b4 ? t8[4 + i] : t8[i], give = b4 ? t8[i] : t8[4 + i]; t4[i] = keep + __shfl_xor(give, 16); }
#pragma unroll
        for (int i = 0; i < 2; ++i) { const float keep = b3 ? t4[2 + i] : t4[i], give = b3 ? t4[i] : t4[2 + i]; t2[i] = keep + __shfl_xor(give, 8); }
        float z = (b2 ? t2[1] : t2[0]) + __shfl_xor(b2 ? t2[0] : t2[1], 4);
        z += __shfl_xor(z, 2); z += __shfl_xor(z, 1);
        const float scm = 1.0f / (1.0f + __builtin_amdgcn_exp2f(-1.4426950408889634f * z)), a = scm + rbm;
        const float p4 = __shfl_xor(a, 4), p8 = __shfl_xor(a, 8), p12 = __shfl_xor(a, 12);
        const float hi01 = fmaxf(a, p4), lo01 = fminf(a, p4), hi23 = fmaxf(p8, p12), lo23 = fminf(p8, p12);
        const float gs = fmaxf(hi01, hi23) + fmaxf(fmaxf(lo01, lo23), fminf(hi01, hi23));
        const float g16 = __shfl_xor(gs, 16), g32 = __shfl_xor(gs, 32), g48 = __shfl_xor(gs, 48);
        const bool best = beats(gs, mygrp, g16, mygrp ^ 1) && beats(gs, mygrp, g32, mygrp ^ 2) && beats(gs, mygrp, g48, mygrp ^ 3);
        const int rank = (beats(p4, wi ^ 1, a, wi) ? 1 : 0) + (beats(p8, wi ^ 2, a, wi) ? 1 : 0) + (beats(p12, wi ^ 3, a, wi) ? 1 : 0);
        const bool sel = best && rank < 2;
        float tot = sel ? scm : 0.f; tot += __shfl_xor(tot, 4); tot += __shfl_xor(tot, 8);
        if (count && sel && (lane_ & 3) == 0) { const unsigned rk = atomicAdd((unsigned*)&lcnt[emine], 1u);
            list_a[emine * 128 + rk] = (int)((unsigned)(2 * m + rank) | ib); list_w[emine * 128 + rk] = scm / tot; }
    }
    __syncthreads();
    if (count) {
        if (tid_ < 16) { const unsigned n = lcnt[tid_]; lcnt[16 + tid_] = n ? atomicAdd((unsigned*)(F.ctl + CW_CNT + l * 128 + tid_), n) : 0u; }
        __syncthreads();
        for (int idx = tid_; idx < 16 * 128; idx += NTHR) { const int e = idx >> 7, rk = idx & 127;
            if (rk < (int)lcnt[e]) { const size_t slot = (size_t)e * SLOT_CAP + lcnt[16 + e] + rk; slot_a[slot] = list_a[idx]; slot_w[slot] = list_w[idx]; } }
    }
}

DI void moe_tstart(Frame& F, int l) {
    FRAME_IDS
    volatile LAS int* ts = (volatile LAS int*)(F.lds + LDSCTL_OFF);
    __syncthreads();
    if (tid_ == 0) { int acc = 0;
        for (int e = 0; e < 16; ++e) { ts[e] = acc; const unsigned c = __hip_atomic_load(F.ctl + CW_CNT + l * 128 + e, RLX_AGENT); ts[32 + e] = (int)c; acc += (int)((c + 255u) >> 8); }
        ts[16] = acc; }
    __syncthreads();
}
DI void p_row_c(Frame& F, const Args& A, int l) {
    FRAME_IDS
    const int gw = F.vcu * NWAVES + wave_, NGW = F.G * NWAVES;
    const bf16* X1 = (const bf16*)(F.ws + WS_PRE); bf16* R2 = (bf16*)(F.ws + WS_ROWS2); bf16* XN = (bf16*)(F.ws + WS_XN);
    const float* ln1g = (const float*)A.in[I_LN1G] + l * D; const float* ln1b = (const float*)A.in[I_LN1B] + l * D;
    Row16 lg1, lb1; row_load_f32(lg1, ln1g, lane_); row_load_f32(lb1, ln1b, lane_);
    const float* mod = (const float*)(F.ws + WS_MOD) + (size_t)l * BATCH * 6 * D;
    const float* modn = (const float*)(F.ws + WS_MOD) + (size_t)(l + 1) * BATCH * 6 * D;
    const float* ln2g = (const float*)A.in[I_LN2G] + l * D; const float* ln2b = (const float*)A.in[I_LN2B] + l * D;
    Row16 lg2, lb2; row_load_f32(lg2, ln2g, lane_); row_load_f32(lb2, ln2b, lane_);
    v2u nx[4]; unsigned n0[4], n1[4], sc0, sc1;
    const unsigned char* SCR = (const unsigned char*)(F.ws + WS_SCR);
#define RC_LOAD(mm) do { const v2u* qa = (const v2u*)(X1 + (size_t)(mm) * D); const unsigned* qb = (const unsigned*)(R2 + (size_t)(2 * (mm)) * D); \
        _Pragma("unroll") for (int k = 0; k < 4; ++k) { nx[k] = __builtin_nontemporal_load(&qa[k * 64 + lane_]); n0[k] = __builtin_nontemporal_load(&qb[k * 64 + lane_]); n1[k] = __builtin_nontemporal_load(&qb[512 + k * 64 + lane_]); } \
        sc0 = ((const unsigned*)(SCR + (size_t)(2 * (mm)) * 32))[lane_ >> 3]; sc1 = ((const unsigned*)(SCR + (size_t)(2 * (mm) + 1) * 32))[lane_ >> 3]; } while (0)
    const int bq = gw / (NGW / BATCH), mbase = bq * T + gw % (NGW / BATCH), mstep = NGW / BATCH;
    const float* md = mod + (size_t)bq * 6 * D;
    Row16 gm; row_load_f32(gm, md + 5 * D, lane_);
    Row16 msc, msh;
    if (l != DEPTH - 1) { const float* mdn = modn + (size_t)bq * 6 * D; row_load_f32(msc, mdn + 1 * D, lane_); row_load_f32(msh, mdn + 0 * D, lane_); }
    RC_LOAD(mbase);
    for (int m = mbase; m < (bq + 1) * T; m += mstep) {
        Row16 x1, g2;
#pragma unroll
        for (int k = 0; k < 4; ++k) {
            x1.v[4 * k] = bflo(nx[k].x); x1.v[4 * k + 1] = bfhi(nx[k].x); x1.v[4 * k + 2] = bflo(nx[k].y); x1.v[4 * k + 3] = bfhi(nx[k].y);
            { const float f0 = __uint_as_float(((sc0 >> (8 * k)) & 0xffu) << 23), f1 = __uint_as_float(((sc1 >> (8 * k)) & 0xffu) << 23);
              g2.v[4 * k] = __builtin_amdgcn_cvt_f32_fp8((int)n0[k], 0) * f0 + __builtin_amdgcn_cvt_f32_fp8((int)n1[k], 0) * f1; g2.v[4 * k + 1] = __builtin_amdgcn_cvt_f32_fp8((int)n0[k], 1) * f0 + __builtin_amdgcn_cvt_f32_fp8((int)n1[k], 1) * f1;
              g2.v[4 * k + 2] = __builtin_amdgcn_cvt_f32_fp8((int)n0[k], 2) * f0 + __builtin_amdgcn_cvt_f32_fp8((int)n1[k], 2) * f1; g2.v[4 * k + 3] = __builtin_amdgcn_cvt_f32_fp8((int)n0[k], 3) * f0 + __builtin_amdgcn_cvt_f32_fp8((int)n1[k], 3) * f1; } }
        if (m + mstep < (bq + 1) * T) RC_LOAD(m + mstep);
        row_ln(x1);
#pragma unroll
        for (int i = 0; i < 16; ++i) x1.v[i] = ALPHA * (x1.v[i] * lg1.v[i] + lb1.v[i]) + (1.0f + gm.v[i]) * g2.v[i];
        row_ln(x1);
#pragma unroll
        for (int i = 0; i < 16; ++i) x1.v[i] = x1.v[i] * lg2.v[i] + lb2.v[i];
        if (l == DEPTH - 1) row_store_f32(x1, A.out + (size_t)m * D, lane_);
        else { row_store_bf16(x1, R2 + (size_t)(2 * m) * D, lane_);
            row_ln(x1);
#pragma unroll
            for (int i = 0; i < 16; ++i) x1.v[i] = x1.v[i] * (1.0f + msc.v[i]) + msh.v[i];
            row_store_fp8(x1, (unsigned char*)XN + (size_t)m * D, (float*)(F.ws + WS_SA) + m, lane_); }
    }
#undef RC_LOAD
}

#ifndef PHMASK
#define PHMASK 0xFFFFFFFFu
#endif
#define IN(k) (lo <= (k) && (k) < hi && ((PHMASK >> (((k) == 0) ? 31 : (((k) - 1) % PH_PER_LAYER))) & 1u))
#define SEAM(k) do { if (IN((k) + 1) && MK_ONE_LAUNCH) xcd_barrier(bar); else __syncthreads(); } while (0)
constexpr int PH_PER_LAYER = 9, N_PHASES = 1 + DEPTH * PH_PER_LAYER;
#ifndef REP_PH
#define REP_PH -1
#endif
#define NREP(k) (((k) == REP_PH) ? 2 : 1)
template <int l> DI void layer_body(Frame& F, const Args& args, const XcdBarrier& bar, const int lo, const int hi) {
    unsigned char* ws = args.ws;

        const int pb = 1 + l * PH_PER_LAYER;
        const bf16* WinT = (const bf16*)(ws + WS_WSMALL + l * WSMALL_LAYER + WOFF_IN);
        const bf16* WoutT = (const bf16*)(ws + WS_WSMALL + l * WSMALL_LAYER + WOFF_OUT);
        const bf16* GluT = (const bf16*)(ws + WS_WSMALL + l * WSMALL_LAYER + WOFF_GLU);
        const float* modl = (const float*)(ws + WS_MOD) + (size_t)l * BATCH * 6 * D;
        if (l == 0 && IN(pb + 0)) { p_wconv(F, args, 0, 4); p_wconv(F, args, 1, 4); p_ln_a0(F, args); SEAM(pb + 0); }
        if (IN(pb + 1)) for (int rep_ = 0; rep_ < NREP(1); ++rep_) {
            pg8::Gemm g{(const bf16*)(ws + WS_XN), WinT, M, PROJW, D / 2}; pg8::StaticOrder S; S.init(M, PROJW, F.G, (int)blockIdx.x);
            EpiInProj E{(bf16*)(ws + WS_PROJ), (const float*)(ws + WS_ROPE), args.pad, (const float*)(ws + WS_SA), (const float*)(ws + WS_CINV_IN) + l * PROJW};
            pg8::gemm_phase<EpiInProj, pg8::StaticOrder, PG8_ALIGN, PG8_SP2, true>(F.lds + RING_OFF, g, S, E);
            if (F.G == 256 && blockIdx.x >= 128) { __syncthreads(); p_wconv_gu(F, args, l, 256 + (int)blockIdx.x - 128, 128, WC_NGU); }
            SEAM(pb + 1); }
        if (IN(pb + 2)) for (int rep_ = 0; rep_ < NREP(2); ++rep_) {
#ifndef REP_SUB
#define REP_SUB -1
#endif
#define SUBREP(k) for (int rs_ = 0; rs_ < ((REP_SUB == (k)) ? 2 : 1); ++rs_)
            SUBREP(0) { mix_gating_mfma(F, args, l); __syncthreads(); }
#if REP_SUB >= 10 && REP_SUB < 20
            mix_gating_mfma(F, args, l, REP_SUB - 10); __syncthreads(); mix_gating_mfma(F, args, l); __syncthreads();
#endif
 SUBREP(1) { mix_ssm_in(F, l); } SUBREP(2) { mix_attn_mfma<0>(F, l); __syncthreads(); } SEAM(pb + 2); }
        if (IN(pb + 3)) for (int rep_ = 0; rep_ < NREP(3); ++rep_) { SUBREP(3) { mix_ssm_out(F, args, l); __syncthreads(); } SUBREP(4) { mix_attn_mfma<1>(F, l); __syncthreads(); } SEAM(pb + 3); }
        if (IN(pb + 4)) for (int rep_ = 0; rep_ < NREP(4); ++rep_) { p_glu(F, args, l); SEAM(pb + 4); }
        if (IN(pb + 5)) for (int rep_ = 0; rep_ < NREP(5); ++rep_) {
            pg8::Gemm g{(const bf16*)(ws + WS_MIXCAT), WoutT, M, D, D / 2}; pg8::StaticOrder S; S.init(M, D, F.G, (int)blockIdx.x);
            const float* cio = (const float*)(ws + WS_CINV_O) + l * D; const unsigned char* scm = (const unsigned char*)(ws + WS_SCM);
            if (l == 0) { EpiOut<true> E{(bf16*)(ws + WS_PRE), args.in[I_X], D, modl, cio}; pg8::gemm_phase<EpiOut<true>, pg8::StaticOrder, PG8_ALIGN, PG8_SP2, true, true>(F.lds + RING_OFF, g, S, E, scm, F.lds + SCT_OFF); }
            else { EpiOut<false> E{(bf16*)(ws + WS_PRE), (const void*)(ws + WS_ROWS2), 2 * D, modl, cio}; pg8::gemm_phase<EpiOut<false>, pg8::StaticOrder, PG8_ALIGN, PG8_SP2, true, true>(F.lds + RING_OFF, g, S, E, scm, F.lds + SCT_OFF); }
            SEAM(pb + 5); }
        if (IN(pb + 6)) { p_row_b(F, args, l); SUBREP(5) { if (REP_SUB == 5 && rs_ == 0) { __syncthreads(); p_row_b(F, args, l, false); } } SEAM(pb + 6); }
        if (IN(pb + 7)) { moe_tstart(F, l);
            gu32* dcnt = F.ctl + CW_DONE + l * 512;
            if (args.pad != 4)
            { pg8::Gemm g{(const bf16*)(ws + WS_XN), (const bf16*)(ws + WS_WGU), NSLOT_MAX, NEXP * 1024, D / 2};
              MoeOrderK<0> S{(const volatile LAS int*)(F.lds + LDSCTL_OFF), F.G, (int)blockIdx.x, (const int*)(ws + WS_SLOT_A), (const float*)(ws + WS_SLOT_W), dcnt, F.ctl + CW_QUEUE + l * 128, (volatile LAS int*)(F.lds + LDSCTL_OFF + 256), nullptr}; EpiG1 E{(unsigned char*)(ws + WS_HID), args.pad, (const float*)(ws + WS_CINV) + (size_t)l * 16 * 2 * 512, (unsigned char*)(ws + WS_HSC)};
              pg8::gemm_phase_g<EpiG1, MoeOrderK<0>, PG8_ALIGN, PG8_SP2, 0, true>(F.lds + RING_OFF, F.lds + GT_OFF, g, S, E); }
            if (args.pad != 3)
            { pg8::Gemm g{(const bf16*)(ws + WS_HID), (const bf16*)(ws + WS_WD), NSLOT_MAX, NEXP * 1024, DEXP / 2};
              MoeOrderK<1> S{(const volatile LAS int*)(F.lds + LDSCTL_OFF), F.G, (int)blockIdx.x, (const int*)(ws + WS_SLOT_A), (const float*)(ws + WS_SLOT_W), dcnt, F.ctl + CW_QUEUE + l * 128, (volatile LAS int*)(F.lds + LDSCTL_OFF + 256), (const unsigned char*)(ws + WS_HSC)}; EpiG2 E{(unsigned char*)(ws + WS_ROWS2), args.pad, (const float*)(ws + WS_CINV_D) + (size_t)l * NEXP * D, (unsigned char*)(ws + WS_SCR)};
              pg8::gemm_phase_g<EpiG2, MoeOrderK<1>, PG8_ALIGN, PG8_SP2, 0, true, true>(F.lds + RING_OFF, F.lds + GT_OFF, g, S, E); }
            SEAM(pb + 7); }
        if (IN(pb + 8)) { p_row_c(F, args, l); if (l == 0) { __syncthreads(); p_wconv_dn(F, args, 1, F.vcu, F.G); p_wconv_gu(F, args, 1, F.vcu, F.G, F.G == 256 ? 256 : WC_NGU); } SUBREP(6) { if (REP_SUB == 6 && rs_ == 0 && l == DEPTH - 1) { __syncthreads(); p_row_c(F, args, l); } } SEAM(pb + 8); }
    }
__global__ void __launch_bounds__(NTHR, 2) mk_fwd(Args args) {
    extern __shared__ __attribute__((aligned(16))) unsigned char lds[];
    Frame F;
    F.lds = (LAS unsigned char*)lds; F.MISC = (volatile LAS unsigned*)(F.lds + MISC_OFF);
    F.G = gridDim.x; { const int bx = blockIdx.x; F.vcu = (F.G % 8 == 0) ? (bx % 8) * (F.G / 8) + bx / 8 : bx; }
    F.ws = args.ws; F.ctl = (gu32*)(args.ws + WS_CTL);
    for (int u = ftid(); u < (LDS_BYTES - LDSCTL_OFF) / 4; u += NTHR) ((LAS unsigned*)(F.lds + LDSCTL_OFF))[u] = 0u;
    __syncthreads();
    XcdBarrier bar; bar.bar = (unsigned*)(F.ctl + CW_BAR); bar.x = 0; bar.st = nullptr;
    if (MK_ONE_LAUNCH) bar = xcd_barrier_post((unsigned*)(F.ctl + CW_BAR), F.MISC + 8);
    const int lo = args.ph_lo, hi = args.ph_hi;
    unsigned char* ws = args.ws; (void)ws;
    if (IN(0)) { p0_tables(F, args); __syncthreads(); p_wconv_items(F, args, 0, 0, WC_NS); p_wconv_items(F, args, 1, 0, WC_NS); __syncthreads(); p_wconv_gu(F, args, 0, F.vcu, F.G, F.G == 256 ? 256 : WC_NGU); p_wconv_dn(F, args, 0, F.vcu, F.G);
        p_wconv_in(F, args, 0, (F.vcu + F.G - 112) % F.G, F.G); p_wconv_in(F, args, 1, (F.vcu + F.G - 184) % F.G, F.G);
        p_wconv_out(F, args, 0, F.vcu, F.G); p_wconv_out(F, args, 1, (F.vcu + F.G - 32) % F.G, F.G); SEAM(0); }
    layer_body<0>(F, args, bar, lo, hi);
    layer_body<1>(F, args, bar, lo, hi);
#ifdef EXTRA_BARS
    if (MK_ONE_LAUNCH) for (int xb_ = 0; xb_ < EXTRA_BARS; ++xb_) xcd_barrier(bar);
#endif
#undef IN
#undef SEAM
}

extern "C" void kernel_launch(void* const* d_in, const int* in_sizes, int n_in, void* d_out, int out_size, void* d_ws, size_t ws_size, hipStream_t stream) {
    static int grid = 0;
    if (grid == 0) {
        if (n_in != 30 || in_sizes[0] != M * D || out_size != M * D || ws_size < WS_END) { fprintf(stderr, "kernel_launch: unexpected shapes (n_in %d, in0 %d, out %d, ws %zu, need %zu)\n", n_in, n_in > 0 ? in_sizes[0] : -1, out_size, ws_size, (size_t)WS_END); grid = -1; return; }
        int dev = 0, cus = 0, per_cu = 0;
        if (hipGetDevice(&dev) != hipSuccess || hipDeviceGetAttribute(&cus, hipDeviceAttributeMultiprocessorCount, dev) != hipSuccess) { grid = -1; return; }
        if (hipFuncSetAttribute((const void*)mk_fwd, hipFuncAttributeMaxDynamicSharedMemorySize, LDS_BYTES) != hipSuccess) { fprintf(stderr, "kernel_launch: hipFuncSetAttribute failed\n"); grid = -1; return; }
        if (hipOccupancyMaxActiveBlocksPerMultiprocessor(&per_cu, (const void*)mk_fwd, NTHR, LDS_BYTES) != hipSuccess || per_cu < 1) fprintf(stderr, "kernel_launch: occupancy query says %d\n", per_cu);
        (void)hipGetLastError();
        grid = cus;
    }
    if (grid < 0) return;
    if (hipMemsetAsync((char*)d_ws + WS_CTL, 0, CTL_ZERO_BYTES, stream) != hipSuccess) return;
    Args a{};
    for (int i = 0; i < 30; ++i) a.in[i] = d_in[i];
    a.out = (float*)d_out; a.ws = (unsigned char*)d_ws;
#if MK_ONE_LAUNCH
    a.ph_lo = 0; a.ph_hi = N_PHASES; a.li = 0;
    hipLaunchKernelGGL(mk_fwd, dim3(grid), dim3(NTHR), LDS_BYTES, stream, a);
#else
#ifndef REP_GLOBAL
#define REP_GLOBAL -1
#endif
#ifndef PROBE_SKIP
#define PROBE_SKIP 1
#endif
#ifndef REP_COUNT
#define REP_COUNT 2
#endif
    for (int p = 0; p < N_PHASES; ++p) { a.ph_lo = p; a.ph_hi = p + 1; a.li = p;
        const int nrep = ((p == 0 ? 100 : (p - 1) % PH_PER_LAYER) == REP_GLOBAL) ? REP_COUNT : 1;
        for (int r = 0; r < nrep; ++r) { a.pad = r ? PROBE_SKIP : 0; hipLaunchKernelGGL(mk_fwd, dim3(grid), dim3(NTHR), LDS_BYTES, stream, a); } a.pad = 0; }
#endif
}
```

```cpp
#include <hip/hip_runtime.h>
#include <cstdio>
#include <cstdint>
namespace pg8 {
#define PG8_LAS __attribute__((address_space(3)))
typedef unsigned short bf16_t;
typedef short bf16x8 __attribute__((ext_vector_type(8)));
typedef float f32x4 __attribute__((ext_vector_type(4)));
typedef unsigned u32x4 __attribute__((ext_vector_type(4)));
constexpr int BM = 256, BK = 64, HALF = 128, HTB = HALF * BK * 2  , STAGE_BYTES = 8 * HTB, NXCD = 8, WGM = 8;

__host__ __device__ __forceinline__ int lds_byte(int r, int c) { const int st = (r >> 4) * 2 + (c >> 5), rr = r & 15, cc = c & 31, ob = rr * 64 + cc * 2; return st * 1024 + (ob ^ (((ob >> 9) & 1) << 5)); }
__host__ __device__ __forceinline__ void stage_rc(int b, int& R, int& C) { const int st = b / 1024, sb = b % 1024, swz = sb ^ (((sb >> 9) & 1) << 5); R = (st >> 1) * 16 + swz / 64; C = (st & 1) * 32 + (swz % 64) / 2; }
__host__ __device__ __forceinline__ int perm32(int rho) { const int n = rho >> 4, i = rho & 15; return 8 * (i >> 2) + 4 * n + (i & 3); }

__device__ __forceinline__ int opaque_tid() { int t = threadIdx.x; asm volatile("" : "+v"(t)); return t; }
struct Unit { int pm, pn; };
struct Gemm { const bf16_t* A; const bf16_t* Bt; int M, N, K; };

struct StaticOrder {
    int nM, nN, nwg, G, c;
    __host__ __device__ void init(int M, int N, int G_, int c_) { nM = M / BM; nN = N / BM; nwg = nM * nN; G = G_; c = c_; }
    __host__ __device__ bool next(int i, Unit& u) const {
        const long L = (long)i * G + c; if (L >= nwg) return false;
        int wgid = (int)L; { const int q = nwg / NXCD, r = nwg % NXCD, xcd = wgid % NXCD, off = wgid / NXCD; wgid = (xcd < r ? xcd * (q + 1) : r * (q + 1) + (xcd - r) * q) + off; }
        const int nig = WGM * nN, gid = wgid / nig, fm = gid * WGM, gsz = (nM - fm) < WGM ? (nM - fm) : WGM;
        u.pm = fm + ((wgid % nig) % gsz); u.pn = (wgid % nig) / gsz; return true;
    }
    __device__ __forceinline__ void a_ready(const Unit&) const {}
    __device__ __forceinline__ void done(const Unit&) const {}
};

__device__ __forceinline__ unsigned cvt_pk_bf16(float lo, float hi) { unsigned r; asm volatile("v_cvt_pk_bf16_f32 %0, %1, %2" : "=v"(r) : "v"(lo), "v"(hi)); return r; }
template <class Epi, class Sched, bool ALIGN_EPI = false, bool SP2 = false, bool FP8 = false, bool ASC = false>
__device__ __forceinline__ void gemm_phase(PG8_LAS unsigned char* lds, const Gemm g, const Sched& S, const Epi& E, const unsigned char* scm = nullptr, PG8_LAS unsigned char* sct = nullptr) {
    const int tid = threadIdx.x, wid = __builtin_amdgcn_readfirstlane(tid >> 6), lane = tid & 63, wr = wid >> 2, wc = wid & 3, fr = lane & 15, fq = lane >> 4;
    const int K = g.K, nt = K / BK;
    unsigned voffA[2], voffB[2];
#pragma unroll
    for (int i = 0; i < 2; ++i) { int R, C; stage_rc(tid * 16 + i * 8192, R, C); const int Rb = Epi::PERM ? ((R & ~31) + perm32(R & 31)) : R;
        voffA[i] = (unsigned)(R * K + C) * 2u; voffB[i] = (unsigned)(Rb * K + C) * 2u; }
    const size_t kstep = (size_t)(BK * 2);
    const size_t hstep = (size_t)HALF * K * 2;
    const size_t tstep = 2 * hstep;
    const unsigned ldsw = (unsigned)wid * 1024u;
    const int aoff = lds_byte(wr * 64 + fr, fq * 8), boff = lds_byte(wc * 32 + fr, fq * 8);
#define PG8_SA(b, h) (((b) * 2 + (h)) * HTB)
#define PG8_SB(b, h) ((4 + (b) * 2 + (h)) * HTB)
#define PG8_STAGE(bufoff, gbase, voff) do { _Pragma("unroll") for (int _i = 0; _i < 2; ++_i) \
        __builtin_amdgcn_global_load_lds((const unsigned*)((const char*)(gbase) + (voff)[_i]), (PG8_LAS unsigned*)(lds + (bufoff) + ldsw + _i * 8192), 16, 0, 0); } while (0)
#define PG8_LDA(dst, b, h) do { if constexpr (FP8) { _Pragma("unroll") for (int m = 0; m < 4; ++m) { const PG8_LAS unsigned char* p_ = lds + PG8_SA(b, h) + aoff + m * 2048; \
            const i32x4_t lo_ = *(const PG8_LAS i32x4_t*)p_, hi_ = *(const PG8_LAS i32x4_t*)(p_ + 1024); dst##q[m] = __builtin_shufflevector(lo_, hi_, 0, 1, 2, 3, 4, 5, 6, 7); } } \
        else { _Pragma("unroll") for (int m = 0; m < 4; ++m) _Pragma("unroll") for (int k = 0; k < 2; ++k) dst[m][k] = *(const PG8_LAS bf16x8*)(lds + PG8_SA(b, h) + aoff + m * 2048 + k * 1024); } } while (0)
#define PG8_LDB(dst, b, h) do { if constexpr (FP8) { _Pragma("unroll") for (int n = 0; n < 2; ++n) { const PG8_LAS unsigned char* p_ = lds + PG8_SB(b, h) + boff + n * 2048; \
            const i32x4_t lo_ = *(const PG8_LAS i32x4_t*)p_, hi_ = *(const PG8_LAS i32x4_t*)(p_ + 1024); dst##q[n] = __builtin_shufflevector(lo_, hi_, 0, 1, 2, 3, 4, 5, 6, 7); } } \
        else { _Pragma("unroll") for (int n = 0; n < 2; ++n) _Pragma("unroll") for (int k = 0; k < 2; ++k) dst[n][k] = *(const PG8_LAS bf16x8*)(lds + PG8_SB(b, h) + boff + n * 2048 + k * 1024); } } while (0)
#define PG8_MMA(ai, bj, At, Bt, KT) do { __builtin_amdgcn_s_setprio(1); \
        if constexpr (FP8) { _Pragma("unroll") for (int m = 0; m < 4; ++m) _Pragma("unroll") for (int n = 0; n < 2; ++n) { const int o_ = 8 * m + 4 * n; \
                f32x4 c_ = {accq[ai][bj][o_], accq[ai][bj][o_ + 1], accq[ai][bj][o_ + 2], accq[ai][bj][o_ + 3]}; \
                if constexpr (ASC) c_ = __builtin_amdgcn_mfma_scale_f32_16x16x128_f8f6f4(Bt##q[n], At##q[m], c_, 0, 0, 0, 0x7f7f7f7f, KT, (int)sca[ai][m]); \
                else c_ = __builtin_amdgcn_mfma_scale_f32_16x16x128_f8f6f4(Bt##q[n], At##q[m], c_, 0, 0, 0, 0x7f7f7f7f, 0, 0x7f7f7f7f); \
                accq[ai][bj][o_] = c_[0]; accq[ai][bj][o_ + 1] = c_[1]; accq[ai][bj][o_ + 2] = c_[2]; accq[ai][bj][o_ + 3] = c_[3]; } } \
        else { _Pragma("unroll") for (int m = 0; m < 4; ++m) _Pragma("unroll") for (int n = 0; n < 2; ++n) _Pragma("unroll") for (int k = 0; k < 2; ++k) \
            acc[ai][bj][m][n] = __builtin_amdgcn_mfma_f32_16x16x32_bf16(Bt[n][k], At[m][k], acc[ai][bj][m][n], 0, 0, 0); } \
        __builtin_amdgcn_s_setprio(0); } while (0)
#define PG8_WAIT_V(n) asm volatile("s_waitcnt vmcnt(" #n ")" ::: "memory")
#define PG8_WAIT_L(n) asm volatile("s_waitcnt lgkmcnt(" #n ")" ::: "memory")
#define PG8_BAR __builtin_amdgcn_s_barrier()
#define PG8_SCHED __builtin_amdgcn_sched_barrier(0)
    Unit cur, nxt; int ui = 0;
    if (!S.next(0, cur)) return;
    f32x4 acc[2][2][4][2];
    typedef float f32x32_t __attribute__((ext_vector_type(32)));
    f32x32_t accq[2][2];
    if constexpr (FP8) { accq[0][0] = (f32x32_t)(0.f); accq[0][1] = (f32x32_t)(0.f); accq[1][0] = (f32x32_t)(0.f); accq[1][1] = (f32x32_t)(0.f); } (void)accq;
#pragma unroll
    for (int a = 0; a < 2; ++a)
#pragma unroll
        for (int b = 0; b < 2; ++b)
#pragma unroll
            for (int m = 0; m < 4; ++m)
#pragma unroll
                for (int n = 0; n < 2; ++n) acc[a][b][m][n] = (f32x4){0.f, 0.f, 0.f, 0.f};
    typedef int v8i_t __attribute__((ext_vector_type(8))); typedef int i32x4_t __attribute__((ext_vector_type(4)));
    bf16x8 At[4][2], B0[2][2], B1[2][2]; v8i_t Atq[4], B0q[2], B1q[2];
    (void)At; (void)B0; (void)B1; (void)Atq; (void)B0q; (void)B1q;
    unsigned sca[2][4]; (void)sca; int par = 0; (void)par;
#define PG8_LDSC(PAR, KH) do { if constexpr (ASC) { _Pragma("unroll") for (int a_ = 0; a_ < 2; ++a_) _Pragma("unroll") for (int m_ = 0; m_ < 4; ++m_) { \
        const PG8_LAS unsigned* sp_ = (const PG8_LAS unsigned*)(sct + (PAR) * 8192 + (KH) * 4096 + (wr * 64 + a_ * HALF + m_ * 16 + fr) * 4); const unsigned sh_ = (unsigned)fq * 8u; \
        sca[a_][m_] = ((sp_[0] >> sh_) & 0xffu) | (((sp_[256] >> sh_) & 0xffu) << 8) | (((sp_[512] >> sh_) & 0xffu) << 16) | ((sp_[768] >> sh_) << 24); } } } while (0)
#define PG8_SCDMA(u, PAR) do { if constexpr (ASC) __builtin_amdgcn_global_load_lds((const unsigned*)(scm + (size_t)(u).pm * 8192 + wid * 1024 + (opaque_tid() & 63) * 16), (PG8_LAS unsigned*)(sct + (PAR) * 8192 + wid * 1024), 16, 0, 0); } while (0)
    const char* cA = (const char*)g.A + (size_t)cur.pm * tstep; const char* cB = (const char*)g.Bt + (size_t)cur.pn * tstep;
    S.a_ready(cur); PG8_SCDMA(cur, 0);
    if constexpr (SP2) {
        PG8_STAGE(PG8_SB(0, 0), cB, voffB); PG8_STAGE(PG8_SB(0, 1), cB + hstep, voffB); PG8_STAGE(PG8_SA(0, 0), cA, voffA); PG8_STAGE(PG8_SA(0, 1), cA + hstep, voffA);
        if (wr == 1) PG8_BAR;
        PG8_WAIT_V(2); PG8_BAR;
        PG8_STAGE(PG8_SB(1, 0), cB + kstep, voffB); PG8_STAGE(PG8_SA(1, 0), cA + kstep, voffA); PG8_STAGE(PG8_SB(1, 1), cB + hstep + kstep, voffB);
        PG8_WAIT_V(6); PG8_BAR;
    } else {
        PG8_STAGE(PG8_SB(0, 0), cB, voffB); PG8_STAGE(PG8_SA(0, 0), cA, voffA); PG8_STAGE(PG8_SB(0, 1), cB + hstep, voffB); PG8_STAGE(PG8_SA(0, 1), cA + hstep, voffA);
        if (wr == 1) PG8_BAR;
        PG8_WAIT_V(4); PG8_BAR;
        PG8_STAGE(PG8_SB(1, 0), cB + kstep, voffB); PG8_STAGE(PG8_SA(1, 0), cA + kstep, voffA); PG8_STAGE(PG8_SB(1, 1), cB + hstep + kstep, voffB);
        PG8_WAIT_V(6); PG8_BAR;
    }
    PG8_LDSC(0, 0);
    for (;;) {
        const bool has_next = S.next(ui + 1, nxt);
        const char* nA = has_next ? (const char*)g.A + (size_t)nxt.pm * tstep : cA; const char* nB = has_next ? (const char*)g.Bt + (size_t)nxt.pn * tstep : cB;
#pragma unroll 1
        for (int t = 0; t < nt; t += 2) {
            const bool last = (t == nt - 2);
            const char* a1 = cA + (size_t)(t + 1) * kstep;
            const char* a2 = last ? nA : cA + (size_t)(t + 2) * kstep; const char* b2 = last ? nB : cB + (size_t)(t + 2) * kstep;
            const char* a3 = a2 + kstep; const char* b3 = b2 + kstep;
            if (last && has_next) { S.a_ready(nxt); PG8_SCDMA(nxt, par ^ 1); }
            if constexpr (ASC) { if (t == 4) PG8_LDSC(par, 1); }
            if constexpr (SP2) {
            PG8_LDB(B0, 0, 0); PG8_LDB(B1, 0, 1); PG8_SCHED; PG8_LDA(At, 0, 0); PG8_STAGE(PG8_SA(1, 1), a1 + hstep, voffA);
            PG8_WAIT_V(8); PG8_WAIT_L(0); PG8_BAR; PG8_MMA(0, 0, At, B0, 0); PG8_MMA(0, 1, At, B1, 0); PG8_BAR; PG8_SCHED;
            PG8_LDA(At, 0, 1); PG8_STAGE(PG8_SB(0, 0), b2, voffB); PG8_STAGE(PG8_SB(0, 1), b2 + hstep, voffB); PG8_STAGE(PG8_SA(0, 0), a2, voffA);
            PG8_WAIT_V(8); PG8_WAIT_L(0); PG8_BAR; PG8_MMA(1, 0, At, B0, 0); PG8_MMA(1, 1, At, B1, 0); PG8_BAR; PG8_SCHED;
            PG8_LDB(B0, 1, 0); PG8_LDB(B1, 1, 1); PG8_SCHED; PG8_LDA(At, 1, 0); PG8_STAGE(PG8_SA(0, 1), a2 + hstep, voffA);
            PG8_WAIT_V(8); PG8_WAIT_L(0); PG8_BAR; PG8_MMA(0, 0, At, B0, 1); PG8_MMA(0, 1, At, B1, 1); PG8_BAR; PG8_SCHED;
            PG8_LDA(At, 1, 1); PG8_STAGE(PG8_SB(1, 0), b3, voffB); PG8_STAGE(PG8_SB(1, 1), b3 + hstep, voffB); PG8_STAGE(PG8_SA(1, 0), a3, voffA);
            PG8_WAIT_V(8); PG8_WAIT_L(0); PG8_BAR; PG8_MMA(1, 0, At, B0, 1); PG8_MMA(1, 1, At, B1, 1); PG8_BAR; PG8_SCHED;
            } else {
            PG8_LDB(B0, 0, 0); PG8_SCHED; PG8_LDA(At, 0, 0); PG8_STAGE(PG8_SA(1, 1), a1 + hstep, voffA);
            PG8_WAIT_L(8); PG8_BAR; PG8_WAIT_L(0); PG8_MMA(0, 0, At, B0, 0); PG8_BAR; PG8_SCHED;
            PG8_LDB(B1, 0, 1); PG8_STAGE(PG8_SB(0, 0), b2, voffB);
            PG8_BAR; PG8_WAIT_L(0); PG8_MMA(0, 1, At, B1, 0); PG8_BAR;
            PG8_LDA(At, 0, 1); PG8_STAGE(PG8_SA(0, 0), a2, voffA);
            PG8_BAR; PG8_WAIT_L(0); PG8_MMA(1, 0, At, B0, 0); PG8_BAR; PG8_SCHED;
            PG8_STAGE(PG8_SB(0, 1), b2 + hstep, voffB);
            PG8_WAIT_V(6); PG8_BAR; PG8_MMA(1, 1, At, B1, 0); PG8_BAR;
            PG8_LDB(B0, 1, 0); PG8_SCHED; PG8_LDA(At, 1, 0); PG8_STAGE(PG8_SA(0, 1), a2 + hstep, voffA);
            PG8_WAIT_L(8); PG8_BAR; PG8_WAIT_L(0); PG8_MMA(0, 0, At, B0, 1); PG8_BAR; PG8_SCHED;
            PG8_LDB(B1, 1, 1); PG8_STAGE(PG8_SB(1, 0), b3, voffB);
            PG8_BAR; PG8_WAIT_L(0); PG8_MMA(0, 1, At, B1, 1); PG8_BAR;
            PG8_LDA(At, 1, 1); PG8_STAGE(PG8_SA(1, 0), a3, voffA);
            PG8_BAR; PG8_WAIT_L(0); PG8_MMA(1, 0, At, B0, 1); PG8_BAR; PG8_SCHED;
            PG8_STAGE(PG8_SB(1, 1), b3 + hstep, voffB);
            PG8_WAIT_V(6); PG8_BAR; PG8_MMA(1, 1, At, B1, 1); PG8_BAR;
            }
            if constexpr (ASC) { _Pragma("unroll") for (int a_ = 0; a_ < 2; ++a_) _Pragma("unroll") for (int m_ = 0; m_ < 4; ++m_) sca[a_][m_] >>= 16; }
        }
        if constexpr (ALIGN_EPI) { if (wr == 0) PG8_BAR; }
        if constexpr (FP8) {
#pragma unroll
            for (int a = 0; a < 2; ++a)
#pragma unroll
                for (int b = 0; b < 2; ++b)
#pragma unroll
                    for (int m = 0; m < 4; ++m)
#pragma unroll
                        for (int n = 0; n < 2; ++n) { const int o_ = 8 * m + 4 * n; acc[a][b][m][n] = (f32x4){accq[a][b][o_], accq[a][b][o_ + 1], accq[a][b][o_ + 2], accq[a][b][o_ + 3]}; }
        }
        if constexpr (!Epi::AFTER_DRAIN) { E(acc, cur, wr, wc, fr, fq); S.done(cur); }
        if (!has_next) break;
#pragma unroll
        for (int a = 0; a < 2; ++a)
#pragma unroll
            for (int b = 0; b < 2; ++b)
#pragma unroll
                for (int m = 0; m < 4; ++m)
#pragma unroll
                    for (int n = 0; n < 2; ++n) acc[a][b][m][n] = (f32x4){0.f, 0.f, 0.f, 0.f};
        if constexpr (FP8) { accq[0][0] = (f32x32_t)(0.f); accq[0][1] = (f32x32_t)(0.f); accq[1][0] = (f32x32_t)(0.f); accq[1][1] = (f32x32_t)(0.f); }
        cur = nxt; cA = nA; cB = nB; ++ui; par ^= 1; PG8_LDSC(par, 0);
        if constexpr (ALIGN_EPI) { if (wr == 1) PG8_BAR; }
    }
    PG8_WAIT_V(0);
    if constexpr (!ALIGN_EPI) { if (wr == 0) PG8_BAR; }
    PG8_BAR;
    if constexpr (Epi::AFTER_DRAIN) { E.fused(acc, cur, wr, wc, fr, fq, lds, wid, lane); S.done(cur); }
#undef PG8_SA
#undef PG8_SB
#undef PG8_STAGE
#undef PG8_LDSC
#undef PG8_SCDMA
#undef PG8_LDA
#undef PG8_LDB
#undef PG8_MMA
#undef PG8_WAIT_V
#undef PG8_WAIT_L
#undef PG8_BAR
#undef PG8_SCHED
}
template <class Epi, class Sched, bool ALIGN_EPI = false, bool SP2 = false, int AUXA = 0, bool FP8 = false, bool ASC = false>
__device__ __forceinline__ void gemm_phase_g(PG8_LAS unsigned char* lds, PG8_LAS unsigned char* gt, const Gemm g, const Sched& S, const Epi& E) {
    const int tid = threadIdx.x, wid = __builtin_amdgcn_readfirstlane(tid >> 6), lane = tid & 63, wr = wid >> 2, wc = wid & 3, fr = lane & 15, fq = lane >> 4;
    const int K = g.K, nt = K / BK;
    unsigned gpk0, voffB[2];
#pragma unroll
    for (int i = 0; i < 2; ++i) { int R, C; stage_rc(tid * 16 + i * 8192, R, C); const int Rb = Epi::PERM ? ((R & ~31) + perm32(R & 31)) : R;
        if (i == 0) gpk0 = (unsigned)(R * 4) | ((unsigned)(C * 2) << 16); voffB[i] = (unsigned)(Rb * K + C) * 2u; }
    int par = 0;
    const size_t kstep = (size_t)(BK * 2);
    const size_t hstep = (size_t)HALF * K * 2;
    const size_t tstep = 2 * hstep;
    const unsigned ldsw = (unsigned)wid * 1024u;
    const int aoff = lds_byte(wr * 64 + fr, fq * 8), boff = lds_byte(wc * 32 + fr, fq * 8);
#define PG8_SA(b, h) (((b) * 2 + (h)) * HTB)
#define PG8_SB(b, h) ((4 + (b) * 2 + (h)) * HTB)
#define PG8_STAGE(bufoff, gbase, voff) do { _Pragma("unroll") for (int _i = 0; _i < 2; ++_i) \
        __builtin_amdgcn_global_load_lds((const unsigned*)((const char*)(gbase) + (voff)[_i]), (PG8_LAS unsigned*)(lds + (bufoff) + ldsw + _i * 8192), 16, 0, 0); } while (0)
#define PG8_STAGE_A(bufoff, h, kbyte, PAR) do { _Pragma("unroll") for (int _i = 0; _i < 2; ++_i) { \
        const unsigned _vo = *(const PG8_LAS unsigned*)(gt + ((PAR) * 768 + (h) * 128 + _i * 64) * 4 + (gpk0 & 0xffffu)) + (gpk0 >> 16); \
        __builtin_amdgcn_global_load_lds((const unsigned*)((const char*)g.A + (size_t)(kbyte) + _vo), (PG8_LAS unsigned*)(lds + (bufoff) + ldsw + _i * 8192), 16, 0, AUXA); } } while (0)
#define PG8_FILL(u, PAR, PF, UI) do { S.wait_ready(u, tid, PF); if (tid < 256) { unsigned o_, a0_, a1_; S.finish_meta(u, tid, PF, o_, a0_, a1_); PG8_LAS unsigned* t_ = (PG8_LAS unsigned*)(gt + ((PAR) * 768 + tid) * 4); t_[0] = o_; t_[256] = a0_; t_[512] = a1_; } S.pull_publish(tid, PF, UI); asm volatile("s_waitcnt lgkmcnt(0)" ::: "memory"); __builtin_amdgcn_s_barrier(); asm volatile("" ::: "memory"); \
        if constexpr (ASC) { if (wid < 4) __builtin_amdgcn_global_load_lds((const unsigned*)(S.scale_base(u) + wid * 1024 + (opaque_tid() & 63) * 16), (PG8_LAS unsigned*)(gt + 6144 + (PAR) * 4096 + wid * 1024), 16, 0, 0); } } while (0)
#define PG8_LDA(dst, b, h) do { if constexpr (FP8) { _Pragma("unroll") for (int m = 0; m < 4; ++m) { const PG8_LAS unsigned char* p_ = lds + PG8_SA(b, h) + aoff + m * 2048; \
            const i32x4_t lo_ = *(const PG8_LAS i32x4_t*)p_, hi_ = *(const PG8_LAS i32x4_t*)(p_ + 1024); dst##q[m] = __builtin_shufflevector(lo_, hi_, 0, 1, 2, 3, 4, 5, 6, 7); } } \
        else { _Pragma("unroll") for (int m = 0; m < 4; ++m) _Pragma("unroll") for (int k = 0; k < 2; ++k) dst[m][k] = *(const PG8_LAS bf16x8*)(lds + PG8_SA(b, h) + aoff + m * 2048 + k * 1024); } } while (0)
#define PG8_LDB(dst, b, h) do { if constexpr (FP8) { _Pragma("unroll") for (int n = 0; n < 2; ++n) { const PG8_LAS unsigned char* p_ = lds + PG8_SB(b, h) + boff + n * 2048; \
            const i32x4_t lo_ = *(const PG8_LAS i32x4_t*)p_, hi_ = *(const PG8_LAS i32x4_t*)(p_ + 1024); dst##q[n] = __builtin_shufflevector(lo_, hi_, 0, 1, 2, 3, 4, 5, 6, 7); } } \
        else { _Pragma("unroll") for (int n = 0; n < 2; ++n) _Pragma("unroll") for (int k = 0; k < 2; ++k) dst[n][k] = *(const PG8_LAS bf16x8*)(lds + PG8_SB(b, h) + boff + n * 2048 + k * 1024); } } while (0)
#define PG8_MMA(ai, bj, At, Bt, KT) do { __builtin_amdgcn_s_setprio(1); \
        if constexpr (FP8) { _Pragma("unroll") for (int m = 0; m < 4; ++m) _Pragma("unroll") for (int n = 0; n < 2; ++n) { const int o_ = 8 * m + 4 * n; \
                f32x4 c_ = {accq[ai][bj][o_], accq[ai][bj][o_ + 1], accq[ai][bj][o_ + 2], accq[ai][bj][o_ + 3]}; \
                if constexpr (ASC) c_ = __builtin_amdgcn_mfma_scale_f32_16x16x128_f8f6f4(Bt##q[n], At##q[m], c_, 0, 0, 0, 0x7f7f7f7f, KT, (int)sca[ai][m]); \
                else c_ = __builtin_amdgcn_mfma_scale_f32_16x16x128_f8f6f4(Bt##q[n], At##q[m], c_, 0, 0, 0, 0x7f7f7f7f, 0, 0x7f7f7f7f); \
                accq[ai][bj][o_] = c_[0]; accq[ai][bj][o_ + 1] = c_[1]; accq[ai][bj][o_ + 2] = c_[2]; accq[ai][bj][o_ + 3] = c_[3]; } } \
        else { _Pragma("unroll") for (int m = 0; m < 4; ++m) _Pragma("unroll") for (int n = 0; n < 2; ++n) _Pragma("unroll") for (int k = 0; k < 2; ++k) \
            acc[ai][bj][m][n] = __builtin_amdgcn_mfma_f32_16x16x32_bf16(Bt[n][k], At[m][k], acc[ai][bj][m][n], 0, 0, 0); } \
        __builtin_amdgcn_s_setprio(0); } while (0)
#define PG8_WAIT_V(n) asm volatile("s_waitcnt vmcnt(" #n ")" ::: "memory")
#define PG8_WAIT_L(n) asm volatile("s_waitcnt lgkmcnt(" #n ")" ::: "memory")
#define PG8_BAR __builtin_amdgcn_s_barrier()
#define PG8_SCHED __builtin_amdgcn_sched_barrier(0)
    Unit cur, nxt; int ui = 0;
    if (!__builtin_amdgcn_readfirstlane((int)S.first(cur))) return;
    cur.pm = __builtin_amdgcn_readfirstlane(cur.pm); cur.pn = __builtin_amdgcn_readfirstlane(cur.pn);
    f32x4 acc[2][2][4][2];
    typedef float f32x32_t __attribute__((ext_vector_type(32)));
    f32x32_t accq[2][2];
    if constexpr (FP8) { accq[0][0] = (f32x32_t)(0.f); accq[0][1] = (f32x32_t)(0.f); accq[1][0] = (f32x32_t)(0.f); accq[1][1] = (f32x32_t)(0.f); } (void)accq;
#pragma unroll
    for (int a = 0; a < 2; ++a)
#pragma unroll
        for (int b = 0; b < 2; ++b)
#pragma unroll
            for (int m = 0; m < 4; ++m)
#pragma unroll
                for (int n = 0; n < 2; ++n) acc[a][b][m][n] = (f32x4){0.f, 0.f, 0.f, 0.f};
    typedef int v8i_t __attribute__((ext_vector_type(8))); typedef int i32x4_t __attribute__((ext_vector_type(4)));
    bf16x8 At[4][2], B0[2][2], B1[2][2]; v8i_t Atq[4], B0q[2], B1q[2];
    (void)At; (void)B0; (void)B1; (void)Atq; (void)B0q; (void)B1q;
    unsigned sca[2][4]; (void)sca;
#define PG8_LDSC(PAR) do { if constexpr (ASC) { _Pragma("unroll") for (int a_ = 0; a_ < 2; ++a_) _Pragma("unroll") for (int m_ = 0; m_ < 4; ++m_) { \
        const PG8_LAS unsigned* sp_ = (const PG8_LAS unsigned*)(gt + 6144 + (PAR) * 4096 + (wr * 64 + a_ * HALF + m_ * 16 + fr) * 4); const unsigned sh_ = (unsigned)fq * 8u; \
        sca[a_][m_] = ((sp_[0] >> sh_) & 0xffu) | (((sp_[256] >> sh_) & 0xffu) << 8) | (((sp_[512] >> sh_) & 0xffu) << 16) | ((sp_[768] >> sh_) << 24); } } } while (0)
    const char* cB = (const char*)g.Bt + (size_t)cur.pn * tstep;
    typename Sched::Pf pf; S.prefetch(cur, tid, pf); PG8_FILL(cur, 0, pf, -1);
    Unit pend; bool has_pend = false;
    if constexpr (SP2) {
        PG8_STAGE(PG8_SB(0, 0), cB, voffB); PG8_STAGE(PG8_SB(0, 1), cB + hstep, voffB); PG8_STAGE_A(PG8_SA(0, 0), 0, 0, par); PG8_STAGE_A(PG8_SA(0, 1), 1, 0, par);
        if (wr == 1) PG8_BAR;
        PG8_WAIT_V(2); PG8_BAR;
        PG8_STAGE(PG8_SB(1, 0), cB + kstep, voffB); PG8_STAGE_A(PG8_SA(1, 0), 0, kstep, par); PG8_STAGE(PG8_SB(1, 1), cB + hstep + kstep, voffB);
        PG8_WAIT_V(6); PG8_BAR;
    } else {
        PG8_STAGE(PG8_SB(0, 0), cB, voffB); PG8_STAGE_A(PG8_SA(0, 0), 0, 0, par); PG8_STAGE(PG8_SB(0, 1), cB + hstep, voffB); PG8_STAGE_A(PG8_SA(0, 1), 1, 0, par);
        if (wr == 1) PG8_BAR;
        PG8_WAIT_V(4); PG8_BAR;
        PG8_STAGE(PG8_SB(1, 0), cB + kstep, voffB); PG8_STAGE_A(PG8_SA(1, 0), 0, kstep, par); PG8_STAGE(PG8_SB(1, 1), cB + hstep + kstep, voffB);
        PG8_WAIT_V(6); PG8_BAR;
    }
    PG8_LDSC(0);
    for (;;) {
        const bool has_next = __builtin_amdgcn_readfirstlane((int)S.more(ui + 1, nxt)) != 0;
        nxt.pm = __builtin_amdgcn_readfirstlane(nxt.pm); nxt.pn = __builtin_amdgcn_readfirstlane(nxt.pn);
        if (has_next) { S.prefetch(nxt, tid, pf); S.pull_issue(tid, pf); }
        const char* nB = has_next ? (const char*)g.Bt + (size_t)nxt.pn * tstep : cB;
#pragma unroll 1
        for (int t = 0; t < nt; t += 2) {
            const bool last = (t == nt - 2);
            const char* b2 = last ? nB : cB + (size_t)(t + 2) * kstep;
            const char* b3 = b2 + kstep;
            if (last && has_next) PG8_FILL(nxt, par ^ 1, pf, ui);
            const size_t kA2 = last ? (size_t)0 : (size_t)(t + 2) * kstep; const int pA2 = (last && has_next) ? (par ^ 1) : par;
            if constexpr (SP2) {
            PG8_LDB(B0, 0, 0); PG8_LDB(B1, 0, 1); PG8_SCHED; PG8_LDA(At, 0, 0); PG8_STAGE_A(PG8_SA(1, 1), 1, (size_t)(t + 1) * kstep, par);
            PG8_WAIT_V(8); PG8_WAIT_L(0); PG8_BAR; PG8_MMA(0, 0, At, B0, 0); PG8_MMA(0, 1, At, B1, 0); PG8_BAR; PG8_SCHED;
            PG8_LDA(At, 0, 1); PG8_STAGE(PG8_SB(0, 0), b2, voffB); PG8_STAGE(PG8_SB(0, 1), b2 + hstep, voffB); PG8_STAGE_A(PG8_SA(0, 0), 0, kA2, pA2);
            PG8_WAIT_V(8); PG8_WAIT_L(0); PG8_BAR; PG8_MMA(1, 0, At, B0, 0); PG8_MMA(1, 1, At, B1, 0); PG8_BAR; PG8_SCHED;
            PG8_LDB(B0, 1, 0); PG8_LDB(B1, 1, 1); PG8_SCHED; PG8_LDA(At, 1, 0); PG8_STAGE_A(PG8_SA(0, 1), 1, kA2, pA2);
            PG8_WAIT_V(8); PG8_WAIT_L(0); PG8_BAR; PG8_MMA(0, 0, At, B0, 1); PG8_MMA(0, 1, At, B1, 1); PG8_BAR; PG8_SCHED;
            PG8_LDA(At, 1, 1); PG8_STAGE(PG8_SB(1, 0), b3, voffB); PG8_STAGE(PG8_SB(1, 1), b3 + hstep, voffB); PG8_STAGE_A(PG8_SA(1, 0), 0, kA2 + kstep, pA2);
            PG8_WAIT_V(8); PG8_WAIT_L(0); PG8_BAR; PG8_MMA(1, 0, At, B0, 1); PG8_MMA(1, 1, At, B1, 1); PG8_BAR; PG8_SCHED;
            } else {
            PG8_LDB(B0, 0, 0); PG8_SCHED; PG8_LDA(At, 0, 0); PG8_STAGE_A(PG8_SA(1, 1), 1, (size_t)(t + 1) * kstep, par);
            PG8_WAIT_L(8); PG8_BAR; PG8_WAIT_L(0); PG8_MMA(0, 0, At, B0, 0); PG8_BAR; PG8_SCHED;
            PG8_LDB(B1, 0, 1); PG8_STAGE(PG8_SB(0, 0), b2, voffB);
            PG8_BAR; PG8_WAIT_L(0); PG8_MMA(0, 1, At, B1, 0); PG8_BAR;
            PG8_LDA(At, 0, 1); PG8_STAGE_A(PG8_SA(0, 0), 0, kA2, pA2);
            PG8_BAR; PG8_WAIT_L(0); PG8_MMA(1, 0, At, B0, 0); PG8_BAR; PG8_SCHED;
            PG8_STAGE(PG8_SB(0, 1), b2 + hstep, voffB);
            PG8_WAIT_V(6); PG8_BAR; PG8_MMA(1, 1, At, B1, 0); PG8_BAR;
            PG8_LDB(B0, 1, 0); PG8_SCHED; PG8_LDA(At, 1, 0); PG8_STAGE_A(PG8_SA(0, 1), 1, kA2, pA2);
            PG8_WAIT_L(8); PG8_BAR; PG8_WAIT_L(0); PG8_MMA(0, 0, At, B0, 1); PG8_BAR; PG8_SCHED;
            PG8_LDB(B1, 1, 1); PG8_STAGE(PG8_SB(1, 0), b3, voffB);
            PG8_BAR; PG8_WAIT_L(0); PG8_MMA(0, 1, At, B1, 1); PG8_BAR;
            PG8_LDA(At, 1, 1); PG8_STAGE_A(PG8_SA(1, 0), 0, kA2 + kstep, pA2);
            PG8_BAR; PG8_WAIT_L(0); PG8_MMA(1, 0, At, B0, 1); PG8_BAR; PG8_SCHED;
            PG8_STAGE(PG8_SB(1, 1), b3 + hstep, voffB);
            PG8_WAIT_V(6); PG8_BAR; PG8_MMA(1, 1, At, B1, 1); PG8_BAR;
            }
            if constexpr (ASC) { _Pragma("unroll") for (int a_ = 0; a_ < 2; ++a_) _Pragma("unroll") for (int m_ = 0; m_ < 4; ++m_) sca[a_][m_] >>= 16; }
        }
        if constexpr (ALIGN_EPI) { if (wr == 0) PG8_BAR; }
        if constexpr (FP8) {
#pragma unroll
            for (int a = 0; a < 2; ++a)
#pragma unroll
                for (int b = 0; b < 2; ++b)
#pragma unroll
                    for (int m = 0; m < 4; ++m)
#pragma unroll
                        for (int n = 0; n < 2; ++n) { const int o_ = 8 * m + 4 * n; acc[a][b][m][n] = (f32x4){accq[a][b][o_], accq[a][b][o_ + 1], accq[a][b][o_ + 2], accq[a][b][o_ + 3]}; }
        }
        if constexpr (!Epi::AFTER_DRAIN) { if (has_pend) S.done_nowait(pend);     E(acc, cur, wr, wc, fr, fq, (const PG8_LAS unsigned*)(gt + par * 3072)); pend = cur; has_pend = true; }
        if (!has_next) break;
#pragma unroll
        for (int a = 0; a < 2; ++a)
#pragma unroll
            for (int b = 0; b < 2; ++b)
#pragma unroll
                for (int m = 0; m < 4; ++m)
#pragma unroll
                    for (int n = 0; n < 2; ++n) acc[a][b][m][n] = (f32x4){0.f, 0.f, 0.f, 0.f};
        if constexpr (FP8) { accq[0][0] = (f32x32_t)(0.f); accq[0][1] = (f32x32_t)(0.f); accq[1][0] = (f32x32_t)(0.f); accq[1][1] = (f32x32_t)(0.f); }
        cur = nxt; cB = nB; ++ui; par ^= 1; PG8_LDSC(par);
        if constexpr (ALIGN_EPI) { if (wr == 1) PG8_BAR; }
    }
    PG8_WAIT_V(0);
    if constexpr (!ALIGN_EPI) { if (wr == 0) PG8_BAR; }
    PG8_BAR;
    if (has_pend) S.done_nowait(pend);
#undef PG8_SA
#undef PG8_SB
#undef PG8_STAGE
#undef PG8_STAGE_A
#undef PG8_FILL
#undef PG8_LDSC
#undef PG8_LDA
#undef PG8_LDB
#undef PG8_MMA
#undef PG8_WAIT_V
#undef PG8_WAIT_L
#undef PG8_BAR
#undef PG8_SCHED
}
}

#ifndef PG8_SP2
#define PG8_SP2 true
#endif
#ifndef PG8_ALIGN
#define PG8_ALIGN true
#endif
#ifndef MK_ONE_LAUNCH
#define MK_ONE_LAUNCH 1
#endif

constexpr int NWAVES = 8, NTHR = 512;
constexpr int BATCH = 8, T = 4096, D = 1024, M = BATCH * T, DEPTH = 2;
constexpr int PROJW = 2304, AW = 256, BW = 512, CW = 256, NH = 8, HD = 64;
constexpr int COL_U = 0, COL_V = 256, COL_Q = 512, COL_K = 1024, COL_VA = 1536, COL_S = 2048;
constexpr int NEXP = 16, DEXP = 512, NGRP = 4;
constexpr int SSM_G = 16, SSM_N = 64, SSM_C = 16;
constexpr float LN_EPS = 1e-5f;
constexpr float ALPHA = 1.41421356237309515f;
constexpr float QSCALE = 0.125f * 1.4426950408889634f;
constexpr int NSLOT_MAX = 2 * M + NEXP * 256;

constexpr size_t MiB = 1u << 20;
constexpr size_t WS_CTL = 0, CTL_ZERO_BYTES = 1 * MiB;
constexpr size_t WS_MOD = 1 * MiB;
constexpr size_t WS_ROPE = WS_MOD + 512 * 1024;
constexpr size_t WS_SSM = WS_ROPE + 2 * MiB;
constexpr int SSM_TAB = 2 * 1024 + 2 * 16384;
constexpr int SLOT_CAP = 32768;
constexpr size_t WS_SLOT_A = 4 * MiB;
constexpr size_t WS_WSMALL = 6 * MiB;
constexpr size_t WSMALL_LAYER = 7 * MiB, WOFF_IN = 0, WOFF_OUT = (size_t)PROJW * D * 2, WOFF_GLU = WOFF_OUT + (size_t)D * D * 2;
constexpr size_t WS_WGU = 20 * MiB;
constexpr size_t WS_WD = 52 * MiB;
constexpr size_t WS_XN = 68 * MiB;
constexpr size_t WS_YG = 132 * MiB;
constexpr size_t WS_R = 148 * MiB;
constexpr size_t WS_PROJ = WS_R, WS_MIXCAT = WS_R + 144 * MiB, WS_PRE = WS_R, WS_HID = WS_R + 64 * MiB, WS_X1 = WS_R + 132 * MiB;
constexpr size_t WS_HSC = WS_HID + 36 * MiB;
constexpr size_t WS_ROWS2 = 356 * MiB;
constexpr size_t WS_STAT = 356 * MiB + (size_t)2 * M * D * 2;
constexpr size_t WS_SSM2 = WS_STAT + 4 * MiB;
constexpr size_t SSM2_LAYER = 3 * MiB, S2_APW = 0, S2_KT = 288 * 1024, S2_CT = S2_KT + 256 * 1024, S2_WIN = S2_CT + 64 * 1024, S2_GW = S2_WIN + 2 * MiB;
static_assert(S2_GW + 4 * 128 * 128 * 2 <= SSM2_LAYER, "ssm2 tables");
constexpr size_t WS_XLOC = WS_SSM2 + 2 * SSM2_LAYER;
constexpr size_t WS_XSUP = WS_XLOC + 8 * MiB;
constexpr size_t WS_SLOT_W = WS_XSUP + 512 * 1024;
constexpr size_t WS_CINV = WS_SLOT_W + 2 * MiB;
constexpr size_t WS_CINV_IN = WS_CINV + 128 * 1024;
constexpr size_t WS_CINV_D = WS_CINV + 256 * 1024;
constexpr size_t WS_SA = WS_CINV + 384 * 1024;
constexpr size_t WS_SCM = WS_SA + 128 * 1024;
constexpr size_t WS_CINV_O = WS_SCM + 1 * MiB;
constexpr size_t WS_SCR = WS_CINV_O + 64 * 1024;
constexpr size_t WS_PSC = WS_SCR + 2 * MiB;
constexpr size_t WS_END = WS_PSC + 1 * MiB;
static_assert(WOFF_GLU + 256 * 256 * 2 <= WSMALL_LAYER && WS_WSMALL + 2 * WSMALL_LAYER <= WS_WGU, "ws map");
static_assert(WS_SSM + 2 * SSM_TAB * 4 <= WS_SLOT_A && WS_HID + (size_t)NSLOT_MAX * DEXP * 2 <= WS_X1 && WS_X1 + (size_t)M * D * 2 <= WS_ROWS2, "ws map 2");
constexpr int CW_TMO = 0;
constexpr int CW_BAR = 4096;
constexpr int CW_CNT = 8192;
constexpr int CW_QUEUE = 11264;
constexpr int CW_DONE = 12288;

constexpr int RING_OFF = 0, RING_BYTES = 131072;
constexpr int ATT_STAGE_OFF = 98304;
constexpr int LDSCTL_OFF = 135168, MISC_OFF = LDSCTL_OFF + 320;
constexpr int GT_OFF = LDSCTL_OFF + 1024;
constexpr int SCT_OFF = GT_OFF + 6144;
constexpr int LDS_BYTES = 158720;

#define GAS __attribute__((address_space(1)))
#define LAS __attribute__((address_space(3)))
#define DI __device__ __forceinline__
typedef unsigned short bf16;
typedef unsigned v4u __attribute__((ext_vector_type(4)));
typedef unsigned v2u __attribute__((ext_vector_type(2)));
typedef float f32x4 __attribute__((ext_vector_type(4)));
typedef short bf16x8 __attribute__((ext_vector_type(8)));
typedef GAS unsigned gu32;
#define RLX_AGENT __ATOMIC_RELAXED, __HIP_MEMORY_SCOPE_AGENT
#define LDS_WAIT() asm volatile("s_waitcnt lgkmcnt(0)" ::: "memory")
#define VM_WAIT() asm volatile("s_waitcnt vmcnt(0)" ::: "memory")
DI unsigned f2bf(float f) { unsigned u = __builtin_bit_cast(unsigned, f); return (u + 0x7fffu + ((u >> 16) & 1u)) >> 16; }
DI unsigned pk2(float lo, float hi) { return f2bf(lo) | (f2bf(hi) << 16); }
DI float bflo(unsigned w) { return __uint_as_float(w << 16); }
DI float bfhi(unsigned w) { return __uint_as_float(w & 0xffff0000u); }
DI float bf2f(bf16 h) { return __uint_as_float((unsigned)h << 16); }
template <int CTRL> DI float dpp_mov(float v) { return __builtin_bit_cast(float, __builtin_amdgcn_update_dpp(0, __builtin_bit_cast(int, v), CTRL, 0xf, 0xf, true)); }
DI float rdlane(float v, int l) { return __builtin_bit_cast(float, __builtin_amdgcn_readlane(__builtin_bit_cast(int, v), l)); }
DI float wave_sum(float v) {
    v += dpp_mov<0xB1>(v); v += dpp_mov<0x4E>(v); v += dpp_mov<0x141>(v); v += dpp_mov<0x140>(v);
    return (rdlane(v, 0) + rdlane(v, 16)) + (rdlane(v, 32) + rdlane(v, 48));
}
DI void st16_wt(void* p, v4u v) { asm volatile("global_store_dwordx4 %0, %1, off sc1\n\ts_nop 1" :: "v"(p), "v"(v) : "memory"); }
DI float wave_max(float v) {
    v = fmaxf(v, dpp_mov<0xB1>(v)); v = fmaxf(v, dpp_mov<0x4E>(v)); v = fmaxf(v, dpp_mov<0x141>(v)); v = fmaxf(v, dpp_mov<0x140>(v));
    return fmaxf(fmaxf(rdlane(v, 0), rdlane(v, 16)), fmaxf(rdlane(v, 32), rdlane(v, 48)));
}
DI unsigned pk4_fp8(float a, float b, float c, float d) { int w = __builtin_amdgcn_cvt_pk_fp8_f32(a, b, 0, false); w = __builtin_amdgcn_cvt_pk_fp8_f32(c, d, w, true); return (unsigned)w; }
DI unsigned mx_scale(float bm, float& mult) { unsigned eb = (__float_as_uint(bm * (1.0f / 448.0f)) + 0x7fffffu) >> 23; eb = eb < 1u ? 1u : (eb > 254u ? 254u : eb); mult = __uint_as_float((254u - eb) << 23); return eb; }
DI size_t scm_index(int m, int b32) { return ((size_t)(m >> 8) * 8 + (b32 >> 2)) * 1024 + (size_t)(m & 255) * 4 + (b32 & 3); }
DI float fast_rcp(float x) { return __builtin_amdgcn_rcpf(x); }
DI float sigmoid_f(float x) { return fast_rcp(1.0f + __builtin_amdgcn_exp2f(-1.4426950408889634f * x)); }
DI float silu_f(float x) { return x * sigmoid_f(x); }
DI float gelu_tanh_f(float x) { const float z2 = 1.5957691216057308f * (x + 0.044715f * x * x * x); return x * sigmoid_f(z2); }

#define XB_TMO      128
#define XB_XCNT(j)  (256  + 64 * (j))
#define XB_XSUB(j)  (1280 + 64 * (j))
#define XB_XGEN(j)  (2304 + 64 * (j))
#define XB_TOP      3328
#define XB_TOPGEN   3392
#define XCD_BAR_WORDS 3456
#define XB_SPIN_CAP (1u << 22)
DI unsigned xb_ld(unsigned* p)              { return __hip_atomic_load(p, __ATOMIC_RELAXED, __HIP_MEMORY_SCOPE_AGENT); }
DI unsigned xb_add(unsigned* p, unsigned v) { return __hip_atomic_fetch_add(p, v, __ATOMIC_RELAXED, __HIP_MEMORY_SCOPE_AGENT); }
DI unsigned xb_xcc_id() { return (unsigned)__builtin_amdgcn_s_getreg((3 << 11) | 20) & 0xFu; }
#define XB_SPIN(cond, bar) do { unsigned _sp = 0; while (cond) { __builtin_amdgcn_s_sleep(1); \
    if ((++_sp & 255u) == 0u) { if (xb_ld(&(bar)[XB_TMO])) break; if (_sp > XB_SPIN_CAP) { atomicAdd(&(bar)[XB_TMO], 1u); break; } } } } while (0)
struct XcdBarrier { unsigned* bar; unsigned x; volatile LAS unsigned* st; };
DI XcdBarrier xcd_barrier_post(unsigned* bar, volatile LAS unsigned* st) {
    XcdBarrier b; b.bar = bar; b.x = xb_xcc_id(); b.st = st;
    if (threadIdx.x == 0) (void)xb_add(&bar[XB_XCNT(b.x)], 1u);
    return b;
}
DI void xcd_barrier_complete(unsigned* bar, unsigned x, unsigned& nloc, unsigned& nx) {
    const unsigned G = gridDim.x * gridDim.y * gridDim.z;
    unsigned sum, cnt, mine, sp = 0u;
    for (;;) {
        sum = 0u; cnt = 0u; mine = 0u;
#pragma unroll
        for (unsigned j = 0; j < 16; ++j) { const unsigned c = xb_ld(&bar[XB_XCNT(j)]); sum += c; cnt += (c > 0u) ? 1u : 0u; mine = (j == x) ? c : mine; }
        if (sum == G) break;
        __builtin_amdgcn_s_sleep(1);
        if ((++sp & 255u) == 0u) { if (xb_ld(&bar[XB_TMO])) break; if (sp > XB_SPIN_CAP) { atomicAdd(&bar[XB_TMO], 1u); break; } }
    }
    nloc = mine > 0u ? mine : 1u; nx = cnt > 0u ? cnt : 1u;
}
DI void xcd_barrier(const XcdBarrier& b) {
    asm volatile("s_waitcnt vmcnt(0)" ::: "memory");
    __syncthreads();
    if (threadIdx.x == 0) {
        unsigned* bar = b.bar;
        __builtin_amdgcn_s_waitcnt(0);
        unsigned nloc = b.st[0], nx = b.st[1];
        if (nloc == 0u) { xcd_barrier_complete(bar, b.x, nloc, nx); b.st[0] = nloc; b.st[1] = nx; }
        const unsigned old = xb_add(&bar[XB_XSUB(b.x)], 1u);
        const unsigned gen = old / nloc;
        if (old + 1u == (gen + 1u) * nloc) {
            __builtin_amdgcn_fence(__ATOMIC_RELEASE, "agent");
            asm volatile("s_waitcnt vmcnt(0)" ::: "memory");
            const unsigned og = xb_add(&bar[XB_TOP], 1u);
            const unsigned tg = og / nx;
            if (og + 1u == (tg + 1u) * nx) xb_add(&bar[XB_TOPGEN], 1u);
            else XB_SPIN(xb_ld(&bar[XB_TOPGEN]) == tg, bar);
            __builtin_amdgcn_fence(__ATOMIC_ACQUIRE, "agent");
            xb_add(&bar[XB_XGEN(b.x)], 1u);
            asm volatile("s_waitcnt vmcnt(0)" ::: "memory");
        } else {
            XB_SPIN(xb_ld(&bar[XB_XGEN(b.x)]) == gen, bar);
            __builtin_amdgcn_fence(__ATOMIC_ACQUIRE, "agent");
            asm volatile("s_waitcnt vmcnt(0)" ::: "memory");
        }
    }
    __syncthreads();
}

struct Args { const void* in[30]; float* out; unsigned char* ws; int ph_lo, ph_hi, li, pad; };
enum { I_X = 0, I_C, I_POS, I_ADAW, I_ADAB, I_WIN, I_GMLNG, I_GMLNB, I_GMWS, I_GMBS, I_LAMRE, I_LAMIM, I_LOGDT, I_BRE, I_BIM, I_CRE, I_CIM, I_SSMD,
       I_GLUW, I_GLUB, I_WOUT, I_LN1G, I_LN1B, I_RW, I_RB, I_EWG, I_EWU, I_EWD, I_LN2G, I_LN2B };
struct Frame {
    LAS unsigned char* lds;
    volatile LAS unsigned* MISC;
    gu32* ctl;
    unsigned char* ws;
    int vcu, G;
};
DI int ftid() { int t = threadIdx.x; asm volatile("" : "+v"(t)); return t; }
#define FRAME_IDS const int tid_ = ftid(), lane_ = tid_ & 63, wave_ = __builtin_amdgcn_readfirstlane(tid_ >> 6); (void)lane_; (void)wave_;

template <class RowMap>
DI void transpose_item(const float* W, int K, int N, bf16* WT, const RowMap& rm, LAS float* scr, int item, int lane) {
    const int nblk = N / 32, kb = item / nblk, nb = item % nblk, k0 = 64 * kb, n0 = 32 * nb;
#pragma unroll 8
    for (int i = 0; i < 32; ++i) { const int kk = 2 * i + (lane >> 5); scr[kk * 33 + (lane & 31)] = W[(size_t)(k0 + kk) * N + n0 + (lane & 31)]; }
    LDS_WAIT(); asm volatile("" ::: "memory");
    const int c = lane & 7;
#pragma unroll
    for (int j = 0; j < 4; ++j) { const int n = (lane >> 3) + 8 * j; const LAS float* s = scr + (8 * c) * 33 + n;
        const float qs = (RowMap::SCALEQ && (n0 + n) >= COL_Q && (n0 + n) < COL_K) ? QSCALE : 1.0f;
        v4u o; o.x = pk2(s[0 * 33] * qs, s[1 * 33] * qs); o.y = pk2(s[2 * 33] * qs, s[3 * 33] * qs); o.z = pk2(s[4 * 33] * qs, s[5 * 33] * qs); o.w = pk2(s[6 * 33] * qs, s[7 * 33] * qs);
        *(GAS v4u*)(WT + (size_t)rm(n0 + n) * K + k0 + 8 * c) = o; }
    LDS_WAIT(); asm volatile("" ::: "memory");
}
struct RmIdent { static constexpr bool SCALEQ = false; int off; DI int operator()(int n) const { return off + n; } };
struct RmWin { static constexpr bool SCALEQ = true; DI int operator()(int n) const {
        if (n >= COL_Q && n < COL_VA) { const int d = n & 63; if (d < 16) return (n - d) + 2 * (d & 7) + (d >> 3); }
        return n; } };
struct RmGU { static constexpr bool SCALEQ = false; int e, up; DI int operator()(int n) const { return e * 1024 + (n >> 7) * 256 + (n & 127) + up * 128; } };

DI void p0_tables(Frame& F, const Args& A) {
    FRAME_IDS
    const float* c = (const float*)A.in[I_C];
    LAS float* condS = (LAS float*)(F.lds + RING_OFF);
    LAS float* red = (LAS float*)(F.lds + RING_OFF + 32768);
    for (int i = tid_; i < BATCH * D; i += NTHR) condS[i] = silu_f(c[i]);
    __syncthreads();
    float* mod = (float*)(F.ws + WS_MOD);
    for (int it = F.vcu; it < DEPTH * 96; it += F.G) {
        const int l = it / 96, jb = it % 96, ks = tid_ >> 6, jj = tid_ & 63, j = jb * 64 + jj;
        const float* w = (const float*)A.in[I_ADAW] + (size_t)l * D * 6 * D + j;
        float acc[8];
#pragma unroll
        for (int b = 0; b < 8; ++b) acc[b] = 0.f;
#pragma unroll 16
        for (int k = ks * 128; k < ks * 128 + 128; ++k) { const float wv = w[(size_t)k * (6 * D)];
#pragma unroll
            for (int b = 0; b < 8; ++b) acc[b] += condS[b * D + k] * wv; }
#pragma unroll
        for (int b = 0; b < 8; ++b) red[(ks * 8 + b) * 64 + jj] = acc[b];
        __syncthreads();
        { const int b = tid_ >> 6; float s = ((const float*)A.in[I_ADAB])[l * 6 * D + j];
#pragma unroll
          for (int k2 = 0; k2 < 8; ++k2) s += red[(k2 * 8 + b) * 64 + jj];
          mod[((size_t)l * BATCH + b) * 6 * D + j] = s; }
        __syncthreads();
    }
    const int gt = F.vcu * NTHR + tid_, NGT = F.G * NTHR;
    const int* pos = (const int*)A.in[I_POS]; float* rope = (float*)(F.ws + WS_ROPE);
    for (int w = gt; w < M * 8; w += NGT) { const int m = w >> 3, i = w & 7;
        const float freq = exp2f(-(float)i * 0.125f * 18.931568569324174f);
        const float ang = (float)pos[m] * freq; float s, cs; sincosf(ang, &s, &cs);
        rope[m * 16 + i] = cs; rope[m * 16 + 8 + i] = s; }
    for (int w = gt; w < DEPTH * 16 * 33 * 64; w += NGT) { const int n = w & 63, m = (w >> 6) % 33, g = ((w >> 6) / 33) & 15, l = (w >> 6) / (33 * 16);
        const int li = (l * 16 + g) * 64 + n;
        const float lre = ((const float*)A.in[I_LAMRE])[li], lim = ((const float*)A.in[I_LAMIM])[li], dt = expf(((const float*)A.in[I_LOGDT])[l * 16 + g]);
        const float mag = expf((float)m * (lre * dt)); float sn, cs; sincosf((float)m * (lim * dt), &sn, &cs);
        float* apw = (float*)(F.ws + WS_SSM2 + l * SSM2_LAYER + S2_APW) + ((size_t)(g * 33 + m) * 64 + n) * 2; apw[0] = mag * cs; apw[1] = mag * sn; }
    for (int w = gt; w < DEPTH * SSM_G * SSM_N; w += NGT) { const int l = w / 1024, gn = w % 1024, g = gn >> 6;
        float* tab = (float*)(F.ws + WS_SSM) + (size_t)l * SSM_TAB;
        const float lre = ((const float*)A.in[I_LAMRE])[w], lim = ((const float*)A.in[I_LAMIM])[w];
        const float dt = expf(((const float*)A.in[I_LOGDT])[l * 16 + g]);
        const float mag = expf(lre * dt); float sn, cs; sincosf(lim * dt, &sn, &cs);
        const float are = mag * cs, aim = mag * sn, nr = are - 1.0f, ni = aim, mod2 = lre * lre + lim * lim;
        const float fre = (nr * lre + ni * lim) / mod2, fim = (ni * lre - nr * lim) / mod2;
        tab[gn] = are; tab[1024 + gn] = aim;
        const float* bre = (const float*)A.in[I_BRE] + (size_t)w * 16; const float* bim = (const float*)A.in[I_BIM] + (size_t)w * 16;
#pragma unroll
        for (int cc = 0; cc < 16; ++cc) { tab[2048 + gn * 16 + cc] = fre * bre[cc] - fim * bim[cc]; tab[2048 + 16384 + gn * 16 + cc] = fre * bim[cc] + fim * bre[cc]; } }
}

DI void p_wconv(Frame& F, const Args& A, int l, int part) {
    FRAME_IDS
    if (part == 4) {
        const int gt = F.vcu * NTHR + tid_, NGT = F.G * NTHR;
        const float* tab = (const float*)(F.ws + WS_SSM) + (size_t)l * SSM_TAB;
        const float* apw = (const float*)(F.ws + WS_SSM2 + l * SSM2_LAYER + S2_APW);
        const float* cre = (const float*)A.in[I_CRE] + (size_t)l * 16 * 16 * 64; const float* cim = (const float*)A.in[I_CIM] + (size_t)l * 16 * 16 * 64;
        bf16* KT = (bf16*)(F.ws + WS_SSM2 + l * SSM2_LAYER + S2_KT); bf16* CT = (bf16*)(F.ws + WS_SSM2 + l * SSM2_LAYER + S2_CT);
        bf16* WIN = (bf16*)(F.ws + WS_SSM2 + l * SSM2_LAYER + S2_WIN); bf16* GW = (bf16*)(F.ws + WS_SSM2 + l * SSM2_LAYER + S2_GW);
        for (int w = gt; w < 16 * 16 * 64 * 8; w += NGT) { const int j = w & 7, ln = (w >> 3) & 63, p = (w >> 9) & 15, g = w >> 13;
            const int co = ln & 15, q = ln >> 4, m = 2 * p + (q >> 1), ci = 8 * (q & 1) + j; float acc = 0.f;
            for (int n = 0; n < 64; ++n) { const int gn = g * 64 + n; const float ar = apw[((g * 33 + m) * 64 + n) * 2], ai = apw[((g * 33 + m) * 64 + n) * 2 + 1];
                const float br = tab[2048 + gn * 16 + ci], bi = tab[2048 + 16384 + gn * 16 + ci], tre = ar * br - ai * bi, tim = ar * bi + ai * br;
                acc += cre[(g * 16 + co) * 64 + n] * tre - cim[(g * 16 + co) * 64 + n] * tim; }
            KT[w] = (bf16)f2bf(acc); }
        for (int w = gt; w < 16 * 4 * 64 * 8; w += NGT) { const int j = w & 7, ln = (w >> 3) & 63, sx = (w >> 9) & 3, g = w >> 11;
            const int co = ln & 15, q = ln >> 4, n = 16 * sx + 4 * q + (j >> 1);
            CT[w] = (bf16)f2bf((j & 1) ? -cim[(g * 16 + co) * 64 + n] : cre[(g * 16 + co) * 64 + n]); }
        for (int w = gt; w < 16 * 16 * 8 * 64 * 8; w += NGT) { const int jj = w & 7, ln = (w >> 3) & 63, ct = (w >> 9) & 7, sp = (w >> 12) & 15, g = w >> 16;
            const int cc = ln & 15, q = ln >> 4, n = 8 * ct + (cc >> 1), part = cc & 1, tj = 2 * sp + (q >> 1), ci = 8 * (q & 1) + jj, gn = g * 64 + n, m = 31 - tj;
            const float ar = apw[((g * 33 + m) * 64 + n) * 2], ai = apw[((g * 33 + m) * 64 + n) * 2 + 1], br = tab[2048 + gn * 16 + ci], bi = tab[2048 + 16384 + gn * 16 + ci];
            WIN[w] = (bf16)f2bf(part ? (ar * bi + ai * br) : (ar * br - ai * bi)); }
        const float* gws = (const float*)A.in[I_GMWS] + (size_t)l * 4 * 128 * 128;
        for (int w = gt; w < 4 * 128 * 128; w += NGT) { const int sx = w & 127, t = (w >> 7) & 127; GW[w] = (bf16)f2bf(sx <= t ? gws[w] : 0.f); }
    }
}
constexpr int WC_NS = 4 * 8;
DI void p_wconv_items(Frame& F, const Args& A, int l, int lo, int hi) {
    FRAME_IDS
    LAS float* scr = (LAS float*)(F.lds + RING_OFF + wave_ * 16384);
    bf16* GluT = (bf16*)(F.ws + WS_WSMALL + l * WSMALL_LAYER + WOFF_GLU);
    for (int it = lo + F.vcu * NWAVES + wave_; it < hi; it += F.G * NWAVES)
        transpose_item((const float*)A.in[I_GLUW] + (size_t)l * 256 * 256, 256, 256, GluT, RmIdent{0}, scr, it, lane_);
}
template <bool CI_DEST, int KW, class RowMap>
DI void quant_cols32(Frame& F, const float* Wm, int ldw, int n0, unsigned char* W8, const RowMap& rm, float* cinv) {
    FRAME_IDS
    LAS float* scr = (LAS float*)(F.lds + RING_OFF + wave_ * 16384);
    LAS float* red = (LAS float*)(F.lds + RING_OFF + 12288);
    constexpr int NV = KW / 2, KTOT = 8 * KW; const int k0 = KW * wave_;
    const float* W = Wm + (size_t)k0 * ldw + n0;
    const unsigned lofs = (unsigned)((lane_ >> 5) * ldw + (lane_ & 31));
    float v[NV]; float mx = 0.f;
#pragma unroll
    for (int i = 0; i < NV; ++i) v[i] = W[(size_t)(2 * i) * ldw + lofs];
#pragma unroll
    for (int i = 0; i < NV; ++i) mx = fmaxf(mx, fabsf(v[i]));
    red[wave_ * 4096 + lane_] = mx;
    __syncthreads();
    float m2 = 0.f;
#pragma unroll
    for (int w2 = 0; w2 < 8; ++w2) m2 = fmaxf(m2, fmaxf(red[w2 * 4096 + (lane_ & 31)], red[w2 * 4096 + 32 + (lane_ & 31)]));
    const bool z = !(m2 > 1e-30f); const float sc = z ? 1.0f : 440.0f / m2;
    if (tid_ < 32) { const int n = n0 + tid_; const float qf = (RowMap::SCALEQ && n >= COL_Q && n < COL_K) ? QSCALE : 1.0f; cinv[CI_DEST ? rm(n) : n] = (z ? 1.0f : m2 * (1.0f / 440.0f)) * qf; }
    const int c = lane_ & 7;
#pragma unroll
    for (int t = 0; t < KW / 64; ++t) {
#pragma unroll
        for (int i = 0; i < 32; ++i) scr[(2 * i + (lane_ >> 5)) * 33 + (lane_ & 31)] = v[32 * t + i] * sc;
        LDS_WAIT(); asm volatile("" ::: "memory");
#pragma unroll
        for (int jj = 0; jj < 4; ++jj) { const int n = (lane_ >> 3) + 8 * jj; const LAS float* sp = scr + (8 * c) * 33 + n;
            v2u o; o.x = pk4_fp8(sp[0 * 33], sp[1 * 33], sp[2 * 33], sp[3 * 33]); o.y = pk4_fp8(sp[4 * 33], sp[5 * 33], sp[6 * 33], sp[7 * 33]);
            *(GAS v2u*)(W8 + (size_t)rm(n0 + n) * KTOT + k0 + 64 * t + 8 * c) = o; }
        LDS_WAIT(); asm volatile("" ::: "memory");
    }
    __syncthreads();
}
constexpr int WC_NGU = 16 * 2 * 16, WC_NIN = PROJW / 32;
DI void p_wconv_gu(Frame& F, const Args& A, int l, int first, int stride, int hi) {
    for (int j = first; j < hi; j += stride) { const int e = j >> 5, up = (j >> 4) & 1;
        quant_cols32<false, 128>(F, (const float*)A.in[up ? I_EWU : I_EWG] + ((size_t)l * NEXP + e) * D * DEXP, DEXP, 32 * (j & 15), (unsigned char*)(F.ws + WS_WGU), RmGU{e, up},
                            (float*)(F.ws + WS_CINV) + (size_t)l * 16 * 2 * 512 + (e * 2 + up) * 512); }
}
constexpr int WC_NDN = 16 * 32;
DI void p_wconv_dn(Frame& F, const Args& A, int l, int first, int stride) {
    for (int j = first; j < WC_NDN; j += stride) { const int e = j >> 5;
        quant_cols32<false, 64>(F, (const float*)A.in[I_EWD] + ((size_t)l * NEXP + e) * D * DEXP, D, 32 * (j & 31), (unsigned char*)(F.ws + WS_WD), RmIdent{e * 1024},
                                (float*)(F.ws + WS_CINV_D) + ((size_t)l * NEXP + e) * D); }
}
constexpr int WC_NOUT = D / 32;
DI void p_wconv_out(Frame& F, const Args& A, int l, int first, int stride) {
    for (int j = first; j < WC_NOUT; j += stride)
        quant_cols32<false, 128>(F, (const float*)A.in[I_WOUT] + (size_t)l * D * D, D, 32 * j, (unsigned char*)(F.ws + WS_WSMALL + l * WSMALL_LAYER + WOFF_OUT), RmIdent{0}, (float*)(F.ws + WS_CINV_O) + l * D);
}
DI void p_wconv_in(Frame& F, const Args& A, int l, int first, int stride) {
    for (int j = first; j < WC_NIN; j += stride)
        quant_cols32<true, 128>(F, (const float*)A.in[I_WIN] + (size_t)l * D * PROJW, PROJW, 32 * j, (unsigned char*)(F.ws + WS_WSMALL + l * WSMALL_LAYER + WOFF_IN), RmWin{}, (float*)(F.ws + WS_CINV_IN) + l * PROJW);
}

typedef float f32x2_t __attribute__((ext_vector_type(2)));
typedef __bf16 bf16x2_t __attribute__((ext_vector_type(2)));
DI unsigned cvtpk(float lo, float hi) { f32x2_t v = {lo, hi}; bf16x2_t b = __builtin_convertvector(v, bf16x2_t); return __builtin_bit_cast(unsigned, b); }
struct Row16 { float v[16]; };
DI void row_load_f32(Row16& r, const float* p, int lane) {
    const f32x4* q = (const f32x4*)p;
#pragma unroll
    for (int k = 0; k < 4; ++k) { const f32x4 a = q[k * 64 + lane]; r.v[4 * k] = a.x; r.v[4 * k + 1] = a.y; r.v[4 * k + 2] = a.z; r.v[4 * k + 3] = a.w; }
}
DI void row_load_f32_nt(Row16& r, const float* p, int lane) {
    const f32x4* q = (const f32x4*)p;
#pragma unroll
    for (int k = 0; k < 4; ++k) { const f32x4 a = __builtin_nontemporal_load(&q[k * 64 + lane]); r.v[4 * k] = a.x; r.v[4 * k + 1] = a.y; r.v[4 * k + 2] = a.z; r.v[4 * k + 3] = a.w; }
}
DI void row_load_bf16(Row16& r, const bf16* p, int lane) {
    const v2u* q = (const v2u*)p;
#pragma unroll
    for (int k = 0; k < 4; ++k) { const v2u a = q[k * 64 + lane]; r.v[4 * k] = bflo(a.x); r.v[4 * k + 1] = bfhi(a.x); r.v[4 * k + 2] = bflo(a.y); r.v[4 * k + 3] = bfhi(a.y); }
}
DI void row_store_bf16(const Row16& r, bf16* p, int lane) {
    v2u* q = (v2u*)p;
#pragma unroll
    for (int k = 0; k < 4; ++k) { v2u o; o.x = cvtpk(r.v[4 * k], r.v[4 * k + 1]); o.y = cvtpk(r.v[4 * k + 2], r.v[4 * k + 3]); q[k * 64 + lane] = o; }
}
DI void row_store_fp8(const Row16& r, unsigned char* p, float* sinv, int lane) {
    float am = 0.f;
#pragma unroll
    for (int i = 0; i < 16; ++i) am = fmaxf(am, fabsf(r.v[i]));
    am = wave_max(am); const bool z = !(am > 1e-30f); const float qs = z ? 1.0f : 440.0f / am;
    unsigned* q8 = (unsigned*)p;
#pragma unroll
    for (int k = 0; k < 4; ++k) q8[k * 64 + lane] = pk4_fp8(r.v[4 * k] * qs, r.v[4 * k + 1] * qs, r.v[4 * k + 2] * qs, r.v[4 * k + 3] * qs);
    if (lane == 0) *sinv = z ? 1.0f : am * (1.0f / 440.0f);
}
DI void row_store_f32(const Row16& r, float* p, int lane) {
    f32x4* q = (f32x4*)p;
#pragma unroll
    for (int k = 0; k < 4; ++k) __builtin_nontemporal_store((f32x4){r.v[4 * k], r.v[4 * k + 1], r.v[4 * k + 2], r.v[4 * k + 3]}, &q[k * 64 + lane]);
}
DI void row_ln(Row16& r) {
    float s = 0.f;
#pragma unroll
    for (int i = 0; i < 16; ++i) s += r.v[i];
    const float mean = wave_sum(s) * (1.f / D); float s2 = 0.f;
#pragma unroll
    for (int i = 0; i < 16; ++i) { r.v[i] -= mean; s2 += r.v[i] * r.v[i]; }
    const float rstd = 1.0f / sqrtf(wave_sum(s2) * (1.f / D) + LN_EPS);
#pragma unroll
    for (int i = 0; i < 16; ++i) r.v[i] *= rstd;
}
DI void row_mod(Row16& r, const float* a, const float* b, int lane) {
    Row16 av, bv; row_load_f32(av, a, lane); row_load_f32(bv, b, lane);
#pragma unroll
    for (int i = 0; i < 16; ++i) r.v[i] = r.v[i] * (1.0f + av.v[i]) + bv.v[i];
}
DI void row_affine(Row16& r, const float* g, const float* b, int lane) {
    Row16 av, bv; row_load_f32(av, g, lane); row_load_f32(bv, b, lane);
#pragma unroll
    for (int i = 0; i < 16; ++i) r.v[i] = r.v[i] * av.v[i] + bv.v[i];
}

DI void p_ln_a0(Frame& F, const Args& A) {
    FRAME_IDS
    const int gw = F.vcu * NWAVES + wave_, NGW = F.G * NWAVES;
    const float* x = (const float*)A.in[I_X]; bf16* XN = (bf16*)(F.ws + WS_XN); const float* mod = (const float*)(F.ws + WS_MOD);
    const int bq = gw / (NGW / BATCH), mbase = bq * T + gw % (NGW / BATCH), mstep = NGW / BATCH;
    const float* md = mod + (size_t)bq * 6 * D;
    Row16 msc, msh; row_load_f32(msc, md + 1 * D, lane_); row_load_f32(msh, md + 0 * D, lane_);
    Row16 nx; row_load_f32_nt(nx, x + (size_t)mbase * D, lane_);
    for (int m = mbase; m < (bq + 1) * T; m += mstep) {
        Row16 r = nx; if (m + mstep < (bq + 1) * T) row_load_f32_nt(nx, x + (size_t)(m + mstep) * D, lane_);
        row_ln(r);
#pragma unroll
        for (int i = 0; i < 16; ++i) r.v[i] = r.v[i] * (1.0f + msc.v[i]) + msh.v[i];
        row_store_fp8(r, (unsigned char*)XN + (size_t)m * D, (float*)(F.ws + WS_SA) + m, lane_); }
}

using pg8::Unit; using pg8::BM; using pg8::HALF;
struct EpiInProj {
    static constexpr bool PERM = true, AFTER_DRAIN = false;
    bf16* P; const float* rope; int skip; const float* sa; const float* cinv;
    DI void operator()(const pg8::f32x4 (&acc)[2][2][4][2], const Unit& u, int wr, int wc, int fr, int fq) const {
        if (skip == 1) { if (acc[0][0][0][0][0] == 12345.678f) P[0] = 1; return; }
        const int row0 = u.pm * BM + wr * 64 + fr, pn = u.pn;
        const bool isrope = (pn >= 2 && pn <= 5), dorope = isrope && ((wc & 1) == 0) && (fq < 2);
        asm volatile("" ::: "memory");
        pg8::f32x4 ci[2][2];
#pragma unroll
        for (int bj = 0; bj < 2; ++bj) { const float* cp = cinv + pn * BM + bj * HALF + wc * 32 + 8 * fq; ci[bj][0] = *(const pg8::f32x4*)cp; ci[bj][1] = *(const pg8::f32x4*)(cp + 4); }
#pragma unroll
        for (int ai = 0; ai < 2; ++ai)
#pragma unroll
            for (int m = 0; m < 4; ++m) { const int row = row0 + ai * HALF + m * 16; bf16* rowp = P + (size_t)row * PROJW + pn * BM + wc * 32 + 8 * fq; const float ra = sa[row];
                f32x4 cs = (f32x4){1.f, 1.f, 1.f, 1.f}, sn = (f32x4){0.f, 0.f, 0.f, 0.f};
                if (isrope) { const float* rp = rope + (size_t)row * 16 + 4 * (fq & 1); cs = *(const f32x4*)rp; sn = *(const f32x4*)(rp + 8); }
#pragma unroll
                for (int bj = 0; bj < 2; ++bj) { pg8::f32x4 v0 = acc[ai][bj][m][0] * (ci[bj][0] * ra), v1 = acc[ai][bj][m][1] * (ci[bj][1] * ra);
                    if (isrope) {
                        if (dorope) { const float a0 = v0[0] * cs.x - v0[1] * sn.x, b0 = v0[1] * cs.x + v0[0] * sn.x, a1 = v0[2] * cs.y - v0[3] * sn.y, b1 = v0[3] * cs.y + v0[2] * sn.y;
                            const float a2 = v1[0] * cs.z - v1[1] * sn.z, b2 = v1[1] * cs.z + v1[0] * sn.z, a3 = v1[2] * cs.w - v1[3] * sn.w, b3 = v1[3] * cs.w + v1[2] * sn.w;
                            v0 = (pg8::f32x4){a0, b0, a1, b1}; v1 = (pg8::f32x4){a2, b2, a3, b3}; }
                    }
                    pg8::u32x4 w; w.x = pg8::cvt_pk_bf16(v0[0], v0[1]); w.y = pg8::cvt_pk_bf16(v0[2], v0[3]); w.z = pg8::cvt_pk_bf16(v1[0], v1[1]); w.w = pg8::cvt_pk_bf16(v1[2], v1[3]);
                    if (skip == 2) { asm volatile("" :: "v"(w.x), "v"(w.y), "v"(w.z), "v"(w.w)); } else *(pg8::u32x4*)(rowp + bj * HALF) = w; } }
    }
};
template <bool XF32> struct EpiOut {
    static constexpr bool PERM = true, AFTER_DRAIN = false;
    bf16* PRE; const void* x; int xpitch; const float* mod; const float* cinv;
    DI void operator()(const pg8::f32x4 (&acc)[2][2][4][2], const Unit& u, int wr, int wc, int fr, int fq) const {
        const int row0 = u.pm * BM + wr * 64 + fr, b = (u.pm * BM) / T, colb = u.pn * BM + wc * 32 + 8 * fq;
        const float* g1 = mod + (size_t)b * 6 * D + 2 * D;
        pg8::f32x4 gv[2][2];
#pragma unroll
        for (int bj = 0; bj < 2; ++bj) { gv[bj][0] = (*(const pg8::f32x4*)(g1 + colb + bj * HALF) + 1.0f) * *(const pg8::f32x4*)(cinv + colb + bj * HALF); gv[bj][1] = (*(const pg8::f32x4*)(g1 + colb + bj * HALF + 4) + 1.0f) * *(const pg8::f32x4*)(cinv + colb + bj * HALF + 4); }
#pragma unroll
        for (int ai = 0; ai < 2; ++ai)
#pragma unroll
            for (int m = 0; m < 4; ++m) { const int row = row0 + ai * HALF + m * 16;
#pragma unroll
                for (int bj = 0; bj < 2; ++bj) { const int col = colb + bj * HALF; pg8::f32x4 x0, x1;
                    if (XF32) { const float* xp = (const float*)x + (size_t)row * xpitch + col; x0 = *(const pg8::f32x4*)xp; x1 = *(const pg8::f32x4*)(xp + 4); }
                    else { const pg8::u32x4 xw = *(const pg8::u32x4*)((const bf16*)x + (size_t)row * xpitch + col);
                        x0 = (pg8::f32x4){bflo(xw.x), bfhi(xw.x), bflo(xw.y), bfhi(xw.y)}; x1 = (pg8::f32x4){bflo(xw.z), bfhi(xw.z), bflo(xw.w), bfhi(xw.w)}; }
                    const pg8::f32x4 v0 = x0 * ALPHA + gv[bj][0] * acc[ai][bj][m][0], v1 = x1 * ALPHA + gv[bj][1] * acc[ai][bj][m][1];
                    pg8::u32x4 w; w.x = pg8::cvt_pk_bf16(v0[0], v0[1]); w.y = pg8::cvt_pk_bf16(v0[2], v0[3]); w.z = pg8::cvt_pk_bf16(v1[0], v1[1]); w.w = pg8::cvt_pk_bf16(v1[2], v1[3]);
                    *(pg8::u32x4*)(PRE + (size_t)row * D + col) = w; } }
    }
};
struct OutOrder : pg8::StaticOrder {
    const char* xbase; unsigned rowbytes, tilecolbytes; LAS unsigned char* dump;
    DI void a_ready(const Unit& u) const {
        const int tid = threadIdx.x, wid = __builtin_amdgcn_readfirstlane(tid >> 6), lane = tid & 63;
        const int lpr = (int)(tilecolbytes >> 7);
        const char* t0 = xbase + (size_t)u.pm * 256 * rowbytes + (size_t)u.pn * tilecolbytes;
        const int nline = 256 * lpr;
        for (int i = wid * 64 + lane; i < nline; i += 512) { const int r = i / lpr, c = i % lpr;
            __builtin_amdgcn_global_load_lds((const unsigned*)(t0 + (size_t)r * rowbytes + (size_t)c * 128), (LAS unsigned*)(dump + wid * 256), 4, 0, 0); }
    }
};
struct EpiGlu {
    static constexpr bool PERM = true, AFTER_DRAIN = false;
    const bf16* YG; bf16* MIX; const float* gb;
    DI void operator()(const pg8::f32x4 (&acc)[2][2][4][2], const Unit& u, int wr, int wc, int fr, int fq) const {
        const int row0 = u.pm * BM + wr * 64 + fr, colb = wc * 32 + 8 * fq;
#pragma unroll
        for (int ai = 0; ai < 2; ++ai)
#pragma unroll
            for (int m = 0; m < 4; ++m) { const int row = row0 + ai * HALF + m * 16;
#pragma unroll
                for (int bj = 0; bj < 2; ++bj) { const int col = colb + bj * HALF;
                    const pg8::u32x4 yw = *(const pg8::u32x4*)(YG + (size_t)row * 256 + col);
                    const pg8::f32x4 b0 = *(const pg8::f32x4*)(gb + col), b1 = *(const pg8::f32x4*)(gb + col + 4);
                    const pg8::f32x4 a0 = acc[ai][bj][m][0] + b0, a1 = acc[ai][bj][m][1] + b1;
                    const float y[8] = {bflo(yw.x), bfhi(yw.x), bflo(yw.y), bfhi(yw.y), bflo(yw.z), bfhi(yw.z), bflo(yw.w), bfhi(yw.w)};
                    float o[8];
#pragma unroll
                    for (int i = 0; i < 4; ++i) { o[i] = y[i] * sigmoid_f(a0[i]); o[4 + i] = y[4 + i] * sigmoid_f(a1[i]); }
                    pg8::u32x4 w; w.x = pg8::cvt_pk_bf16(o[0], o[1]); w.y = pg8::cvt_pk_bf16(o[2], o[3]); w.z = pg8::cvt_pk_bf16(o[4], o[5]); w.w = pg8::cvt_pk_bf16(o[6], o[7]);
                    *(pg8::u32x4*)(MIX + (size_t)row * D + 768 + col) = w; asm volatile("" ::: "memory"); } }
    }
};
template <int KIND> struct MoeOrderK {
    const volatile LAS int* ts; int G, c; const int* slot_a; const float* slot_w; gu32* done_cnt; gu32* queue; volatile LAS int* qs;
    DI bool decode(int off, Unit& u) const {
        const int nwg = ts[16] * 4, q = nwg / 8, r = nwg % 8, xcd = c % 8; const int cntx = q + (xcd < r ? 1 : 0); if (off >= cntx) return false;
        const int wgid = (xcd < r ? xcd * (q + 1) : r * (q + 1) + (xcd - r) * q) + off;
        const int tm = wgid >> 2, j = wgid & 3; int e = 0;
#pragma unroll
        for (int k = 1; k < 16; ++k) e += (ts[k] <= tm) ? 1 : 0;
        u.pm = tm; u.pn = e * 4 + j; return true; }
    DI bool first(Unit& u) const {
        if (KIND == 0) return next(0, u);
        if (threadIdx.x == 0) { const unsigned a = __hip_atomic_fetch_add(queue + 16 * (c % 8), 2u, RLX_AGENT); qs[0] = (int)a; qs[1] = (int)a + 1; }
        asm volatile("s_waitcnt vmcnt(0) lgkmcnt(0)" ::: "memory"); __builtin_amdgcn_s_barrier(); asm volatile("" ::: "memory");
        return decode(qs[0], u);
    }
    DI bool more(int i, Unit& u) const {
        if (KIND == 0) return next(i, u);
        return decode(qs[i & 1], u);
    }
    DI bool next(int i, Unit& u) const {
        const int nwg = ts[16] * 4; const int cc = c;
        const long L = (long)i * G + cc; if (L >= nwg) return false;
        int wgid = (int)L; { const int q = nwg / 8, r = nwg % 8, xcd = wgid % 8, off = wgid / 8; wgid = (xcd < r ? xcd * (q + 1) : r * (q + 1) + (xcd - r) * q) + off; }
        const int tm = wgid >> 2, j = wgid & 3; int e = 0;
#pragma unroll
        for (int k = 1; k < 16; ++k) e += (ts[k] <= tm) ? 1 : 0;
        u.pm = tm; u.pn = e * 4 + j; return true;
    }
    const unsigned char* hsc;
    struct Pf { unsigned a, w, c, q; };
    DI const unsigned char* scale_base(const Unit& u) const { return hsc + (size_t)u.pm * 4096; }
    DI void pull_issue(int tid, Pf& pf) const { if (KIND == 1 && tid == 0) pf.q = __hip_atomic_fetch_add(queue + 16 * (c % 8), 1u, RLX_AGENT); }
    DI void pull_publish(int tid, const Pf& pf, int ui) const { if (KIND == 1 && tid == 0 && ui >= 0) qs[ui & 1] = (int)pf.q; }
    DI void prefetch(const Unit& u, int r, Pf& pf) const {
        const int e = u.pn >> 2, idx = (u.pm - ts[e]) * 256 + (r & 255); const bool valid = idx < ts[32 + e];
        pf.a = 0xffffffffu; pf.w = 0u; pf.c = 32u;
        if (valid && r < 256) { pf.a = (unsigned)slot_a[(size_t)e * SLOT_CAP + idx]; if (KIND == 1) pf.w = __float_as_uint(slot_w[(size_t)e * SLOT_CAP + idx]); }
        if (KIND == 1 && r < 64) pf.c = __hip_atomic_load(done_cnt + u.pm, RLX_AGENT);
    }
    DI void finish_meta(const Unit& u, int r, const Pf& pf, unsigned& off, unsigned& a0, unsigned& a1) const {
        if (KIND == 0) { const bool pad = pf.a == 0xffffffffu; off = (pad ? 0u : ((pf.a & 0xffffu) >> 1)) * (unsigned)D; a0 = 0u; a1 = pad ? 0u : (pf.a & 0xffff0000u); }
        else { off = (unsigned)(u.pm * 256 + r) * (unsigned)DEXP; a0 = pf.a == 0xffffffffu ? pf.a : (pf.a & 0xffffu); a1 = pf.w; }
    }
    DI void wait_ready(const Unit& u, int tid, const Pf& pf) const {
        if (KIND == 1 && tid < 64) { unsigned sp = 0;
            if ((unsigned)__builtin_amdgcn_readfirstlane((int)pf.c) < 32u)
                while ((unsigned)__builtin_amdgcn_readfirstlane((int)__hip_atomic_load(done_cnt + u.pm, RLX_AGENT)) < 32u) { __builtin_amdgcn_s_sleep(2); if (++sp > (1u << 20)) break; } }
    }
    DI void a_ready(const Unit&) const {}
    DI void done_nowait(const Unit& u) const { if (KIND == 0 && (threadIdx.x & 63) == 0) __hip_atomic_fetch_add(done_cnt + u.pm, 1u, RLX_AGENT); }
};
struct EpiG1 {
    static constexpr bool PERM = true, AFTER_DRAIN = false;
    unsigned char* HID; int skip; const float* cinv; unsigned char* HSC;
    DI void operator()(const pg8::f32x4 (&acc)[2][2][4][2], const Unit& u, int wr, int wc, int fr, int fq, const LAS unsigned* meta) const {
        if (skip == 1) { if (acc[0][0][0][0][0] == 12345.678f) HID[0] = 1; return; }
        const __amdgpu_buffer_rsrc_t rs = __builtin_amdgcn_make_buffer_rsrc((void*)HID, 0, (int)((size_t)NSLOT_MAX * DEXP), 0x00020000);
        const __amdgpu_buffer_rsrc_t rsc = __builtin_amdgcn_make_buffer_rsrc((void*)HSC, 0, (int)((size_t)NSLOT_MAX * 16), 0x00020000);
        const int ln_ = ftid() & 63, fr_ = ln_ & 15, fq_ = ln_ >> 4; (void)fr; (void)fq;
        const int e = u.pn >> 2, j = u.pn & 3, r0 = wr * 64 + fr_, row0 = u.pm * BM + r0, col = j * 128 + wc * 32 + 8 * fq_;
        asm volatile("" ::: "memory");
        const float* cg = cinv + (e * 2 + 0) * 512 + col; const float* cu = cinv + (e * 2 + 1) * 512 + col;
        const pg8::f32x4 cg0 = *(const pg8::f32x4*)cg, cg1 = *(const pg8::f32x4*)(cg + 4), cu0 = *(const pg8::f32x4*)cu, cu1 = *(const pg8::f32x4*)(cu + 4);
#pragma unroll
        for (int ai = 0; ai < 2; ++ai)
#pragma unroll
            for (int m = 0; m < 4; ++m) { const int rl = r0 + ai * HALF + m * 16, row = row0 + ai * HALF + m * 16; float o[8];
                const float ra = __uint_as_float(meta[512 + rl]);
#pragma unroll
                for (int i = 0; i < 4; ++i) { o[i] = silu_f(acc[ai][0][m][0][i] * (ra * cg0[i])) * (acc[ai][1][m][0][i] * (ra * cu0[i])); o[4 + i] = silu_f(acc[ai][0][m][1][i] * (ra * cg1[i])) * (acc[ai][1][m][1][i] * (ra * cu1[i])); }
                float bm = fmaxf(fmaxf(fmaxf(fabsf(o[0]), fabsf(o[1])), fmaxf(fabsf(o[2]), fabsf(o[3]))), fmaxf(fmaxf(fabsf(o[4]), fabsf(o[5])), fmaxf(fabsf(o[6]), fabsf(o[7]))));
                bm = fmaxf(bm, __shfl_xor(bm, 16)); bm = fmaxf(bm, __shfl_xor(bm, 32));
                unsigned eb = (__float_as_uint(bm * (1.0f / 448.0f)) + 0x7fffffu) >> 23; eb = eb < 1u ? 1u : (eb > 254u ? 254u : eb);
                const float mult = __uint_as_float((254u - eb) << 23);
                v2u w; w.x = pk4_fp8(o[0] * mult, o[1] * mult, o[2] * mult, o[3] * mult); w.y = pk4_fp8(o[4] * mult, o[5] * mult, o[6] * mult, o[7] * mult);
                __builtin_amdgcn_raw_buffer_store_b64(w, rs, row * DEXP + col, 0, 16);
                if (fq_ == 0) __builtin_amdgcn_raw_buffer_store_b8((unsigned char)eb, rsc, ((u.pm * 4 + j) * 256 + rl) * 4 + wc, 0, 16); }
    }
};
struct EpiG2 {
    static constexpr bool PERM = true, AFTER_DRAIN = false;
    unsigned char* ROWS; int skip; const float* cinv; unsigned char* SCR;
    DI void operator()(const pg8::f32x4 (&acc)[2][2][4][2], const Unit& u, int wr, int wc, int fr, int fq, const LAS unsigned* meta) const {
        if (skip == 1) { if (acc[0][0][0][0][0] == 12345.678f) ROWS[0] = 1; return; }
        const int r0 = wr * 64 + fr, colb = (u.pn & 3) * BM + wc * 32 + 8 * fq;
        asm volatile("" ::: "memory");
        pg8::f32x4 ci[2][2];
#pragma unroll
        for (int bj = 0; bj < 2; ++bj) { const float* cp = cinv + (u.pn >> 2) * D + colb + bj * HALF; ci[bj][0] = *(const pg8::f32x4*)cp; ci[bj][1] = *(const pg8::f32x4*)(cp + 4); }
#pragma unroll
        for (int ai = 0; ai < 2; ++ai)
#pragma unroll
            for (int m = 0; m < 4; ++m) { const int r = r0 + ai * HALF + m * 16; const int d = (int)meta[256 + r]; const float wt = __uint_as_float(meta[512 + r]);
#pragma unroll
                for (int bj = 0; bj < 2; ++bj) { const pg8::f32x4 v0 = acc[ai][bj][m][0] * (ci[bj][0] * wt), v1 = acc[ai][bj][m][1] * (ci[bj][1] * wt);
                    float bm = fmaxf(fmaxf(fmaxf(fabsf(v0[0]), fabsf(v0[1])), fmaxf(fabsf(v0[2]), fabsf(v0[3]))), fmaxf(fmaxf(fabsf(v1[0]), fabsf(v1[1])), fmaxf(fabsf(v1[2]), fabsf(v1[3]))));
                    bm = fmaxf(bm, __shfl_xor(bm, 16)); bm = fmaxf(bm, __shfl_xor(bm, 32)); float mult; const unsigned eb = mx_scale(bm, mult);
                    if (d >= 0) { v2u w; w.x = pk4_fp8(v0[0] * mult, v0[1] * mult, v0[2] * mult, v0[3] * mult); w.y = pk4_fp8(v1[0] * mult, v1[1] * mult, v1[2] * mult, v1[3] * mult);
                        *(v2u*)(ROWS + (size_t)d * 2048 + colb + bj * HALF) = w;
                        if (fq == 0) SCR[(size_t)d * 32 + (4 * bj + wc) * 4 + (u.pn & 3)] = (unsigned char)eb; } } }
    }
};

DI void mix_gating_simple(Frame& F, const Args& A, int l) {
    FRAME_IDS
    const bf16* P = (const bf16*)(F.ws + WS_PROJ); bf16* MIX = (bf16*)(F.ws + WS_MIXCAT);
    const float* lng = (const float*)A.in[I_GMLNG] + l * AW; const float* lnb = (const float*)A.in[I_GMLNB] + l * AW;
    const float* ws_ = (const float*)A.in[I_GMWS] + (size_t)l * 4 * 128 * 128; const float* bs_ = (const float*)A.in[I_GMBS] + l * 4 * 128;
    LAS float* vln = (LAS float*)(F.lds + RING_OFF);
    for (int it = F.vcu; it < BATCH * (T / 128); it += F.G) {
        const int m0 = it * 128;
        for (int r = wave_; r < 128; r += NWAVES) {
            const v2u w = *(const v2u*)(P + (size_t)(m0 + r) * PROJW + COL_V + 4 * lane_);
            float v[4] = {gelu_tanh_f(bflo(w.x)), gelu_tanh_f(bfhi(w.x)), gelu_tanh_f(bflo(w.y)), gelu_tanh_f(bfhi(w.y))};
            const float mean = wave_sum(v[0] + v[1] + v[2] + v[3]) * (1.f / 256.f);
            float s2 = 0.f;
#pragma unroll
            for (int i = 0; i < 4; ++i) { v[i] -= mean; s2 += v[i] * v[i]; }
            const float rstd = 1.0f / sqrtf(wave_sum(s2) * (1.f / 256.f) + LN_EPS);
#pragma unroll
            for (int i = 0; i < 4; ++i) vln[r * 256 + 4 * lane_ + i] = v[i] * rstd * lng[4 * lane_ + i] + lnb[4 * lane_ + i];
        }
        __syncthreads();
        { const int c = tid_ & 255, tp = tid_ >> 8, h = c >> 6;
          for (int t = tp; t < 128; t += 2) { const float* wrow = ws_ + ((size_t)h * 128 + t) * 128; float acc = 0.f;
              for (int s = 0; s <= t; ++s) acc += wrow[s] * vln[s * 256 + c];
              const float uu = gelu_tanh_f(bf2f(P[(size_t)(m0 + t) * PROJW + COL_U + c]));
              MIX[(size_t)(m0 + t) * D + c] = (bf16)f2bf(uu * (acc + bs_[h * 128 + t])); } }
        __syncthreads();
    }
}
DI void mix_attn_simple(Frame& F, int l) {
    FRAME_IDS
    const bf16* P = (const bf16*)(F.ws + WS_PROJ); bf16* MIX = (bf16*)(F.ws + WS_MIXCAT);
    const int gw = F.vcu * NWAVES + wave_, NGW = F.G * NWAVES;
    for (int it = gw; it < M * NH; it += NGW) {
        const int m = it >> 3, h = it & 7, t = m & (T - 1);
        const float q = bf2f(P[(size_t)m * PROJW + COL_Q + h * 64 + lane_]);
        float mx = -1e30f, den = 0.f, o = 0.f;
#pragma unroll 1
        for (int g = 0; g < 3; ++g) { const int dl = (g == 0) ? 1 : (g == 1 ? 4 : 16);
            int nk = t / dl; if (nk > 128) nk = 128;
#pragma unroll 2
            for (int j = 0; j <= nk; ++j) { const size_t mk = (size_t)(m - j * dl);
                const float kv = bf2f(P[mk * PROJW + COL_K + h * 64 + lane_]); const float vv = bf2f(P[mk * PROJW + COL_VA + h * 64 + lane_]);
                const float s = wave_sum(q * kv);
                const float mn = fmaxf(mx, s), f = __builtin_amdgcn_exp2f(mx - mn), p = __builtin_amdgcn_exp2f(s - mn);
                den = den * f + p; o = o * f + p * vv; mx = mn; } }
        MIX[(size_t)m * D + AW + h * 64 + lane_] = (bf16)f2bf(o / den);
    }
}

typedef float f32x16 __attribute__((ext_vector_type(16)));
typedef short v4i16_t __attribute__((ext_vector_type(4)));
DI int crow16(int r, int hi) { return (r & 3) + 8 * (r >> 2) + 4 * hi; }
template <int SUB> DI void mix_attn_mfma(Frame& F, int l) {
    FRAME_IDS
    const bf16* P = (const bf16*)(F.ws + WS_PROJ);
    LAS unsigned char* Ks = F.lds + RING_OFF; LAS unsigned char* Vs = Ks + 49152;
    LAS unsigned char* St = F.lds + ATT_STAGE_OFF + wave_ * 4608;
    const int ql = lane_ & 31, hi = lane_ >> 5, prow = lane_ >> 3, pch = lane_ & 7;
    constexpr int nitems = SUB == 0 ? 2048 : 1024;
    v4u kreg[6], vreg[6], qraw[4]; bf16x8 qf[4];
    int it = F.vcu; if (it >= nitems) return;
    int d, r, s0, b, h; size_t tokbase;
#define ATT_DECODE(IT) do { const int idx_ = (IT) & 1023; b = idx_ >> 7; h = (idx_ >> 4) & 7; int tile_; \
        if (SUB == 1) { d = 1; r = 0; tile_ = idx_ & 15; } else if ((IT) < 1024) { d = 16; r = idx_ & 15; tile_ = 0; } else { d = 4; r = (idx_ >> 2) & 3; tile_ = idx_ & 3; } \
        s0 = tile_ * 256; tokbase = (size_t)b * T + r; } while (0)
#define ATT_LOAD() do { const int tl_ = ftid(); _Pragma("unroll") for (int i = 0; i < 6; ++i) { const int idx2 = tl_ + 512 * i, row = idx2 >> 3, ch = idx2 & 7, step = s0 - 128 + row; \
            if (step >= 0) { const bf16* src = P + (tokbase + (size_t)step * d) * PROJW + h * 64 + ch * 8; kreg[i] = *(const v4u*)(src + COL_K); vreg[i] = *(const v4u*)(src + COL_VA); } \
            else { kreg[i] = (v4u){0u, 0u, 0u, 0u}; vreg[i] = (v4u){0u, 0u, 0u, 0u}; } } \
        _Pragma("unroll") for (int p = 0; p < 4; ++p) qraw[p] = *(const v4u*)(P + (tokbase + (size_t)(s0 + 32 * wave_ + 8 * p + prow) * d) * PROJW + COL_Q + h * 64 + pch * 8); } while (0)
#define ATT_WRITE() do { const int tw_ = ftid(); _Pragma("unroll") for (int i = 0; i < 6; ++i) { const int idx2 = tw_ + 512 * i, row = idx2 >> 3, ch = idx2 & 7; \
            *(LAS v4u*)(Ks + row * 128 + ((ch ^ ((row >> 1) & 7)) << 4)) = kreg[i]; \
            *(LAS v4u*)(Vs + row * 128 + ((ch ^ (((row >> 1) & 1) << 2)) << 4)) = vreg[i]; } \
        _Pragma("unroll") for (int p = 0; p < 4; ++p) *(LAS v4u*)(St + (8 * p + prow) * 144 + pch * 16) = qraw[p]; } while (0)
    ATT_DECODE(it); ATT_LOAD(); ATT_WRITE();
    __syncthreads();
    for (;;) {
        const size_t tb = tokbase; const int s0c = s0, dc = d, hcur = h, itcur = it;
        const bool first = (s0 == 0);
#pragma unroll
        for (int ks = 0; ks < 4; ++ks) qf[ks] = *(const LAS bf16x8*)(St + ql * 144 + (2 * ks + hi) * 16);
        const int itn = it + F.G; const bool has_next = itn < nitems;
        if (has_next) { ATT_DECODE(itn); ATT_LOAD(); }
        const int i0 = 32 * wave_;
        f32x16 S[5];
#pragma unroll
        for (int kb = 0; kb < 5; ++kb) { f32x16 acc;
#pragma unroll
            for (int i = 0; i < 16; ++i) acc[i] = 0.f;
            const int krow = i0 + 32 * kb + ql;
#pragma unroll
            for (int ks = 0; ks < 4; ++ks) { const bf16x8 a = *(const LAS bf16x8*)(Ks + krow * 128 + (((2 * ks + hi) ^ ((krow >> 1) & 7)) << 4)); acc = __builtin_amdgcn_mfma_f32_32x32x16_bf16(a, qf[ks], acc, 0, 0, 0); }
            S[kb] = acc; }
        int qrel = ql - 4 * hi; asm volatile("" : "+v"(qrel));
        float mx = -1e30f;
#pragma unroll
        for (int kb = 0; kb < 5; ++kb) {
            const bool bvalid = !first || (wave_ + kb >= 4);
            if (!bvalid) {
#pragma unroll
                for (int i = 0; i < 16; ++i) S[kb][i] = -1e30f;
            } else {
#pragma unroll
                for (int i = 0; i < 16; ++i) { const int c0 = crow16(i, 0); float v = S[kb][i];
                    if (kb == 0) v = (c0 >= qrel) ? v : -1e30f;
                    if (kb == 4) v = (c0 <= qrel) ? v : -1e30f;
                    S[kb][i] = v; mx = fmaxf(mx, v); }
            }
        }
        mx = fmaxf(mx, __shfl_xor(mx, 32));
        float lsum = 0.f;
#pragma unroll
        for (int kb = 0; kb < 5; ++kb)
#pragma unroll
            for (int i = 0; i < 16; ++i) { const float p = __builtin_amdgcn_exp2f(S[kb][i] - mx); S[kb][i] = p; lsum += p; }
        lsum += __shfl_xor(lsum, 32);
        v2u x16[4], x4[4]; unsigned e16[4], e4[4]; f32x2_t s16 = {0.f, 0.f}, s4 = {0.f, 0.f};
        if (SUB == 1) {
            const size_t qt = tb + (size_t)(s0c + i0 + ql) * dc;
            s16 = *(const f32x2_t*)((const float*)(F.ws + WS_STAT) + (qt * NH + hcur) * 2); s4 = *(const f32x2_t*)((const float*)(F.ws + WS_STAT) + (size_t)M * NH * 2 + (qt * NH + hcur) * 2);
        }
        f32x16 O[2];
#pragma unroll
        for (int i = 0; i < 16; ++i) { O[0][i] = 0.f; O[1][i] = 0.f; }
        const int trq = (lane_ & 15) >> 2, trg = (lane_ >> 4) & 1, trp = lane_ & 3;
#pragma unroll
        for (int kb = 0; kb < 5; ++kb)
#pragma unroll
            for (int s = 0; s < 2; ++s) {
                if (SUB == 1 && kb == 2 && s == 0) {
#pragma unroll
                    for (int p = 0; p < 4; ++p) { const size_t rt = tb + (size_t)(s0c + i0 + 8 * p + prow) * dc; const unsigned char* pp = (const unsigned char*)(F.ws + WS_XN) + rt * BW + hcur * 64 + pch * 8;
                        const unsigned char* sp = (const unsigned char*)(F.ws + WS_PSC) + rt * 16 + hcur * 2 + (pch >> 2);
                        x16[p] = *(const v2u*)pp; x4[p] = *(const v2u*)(pp + (size_t)M * BW); e16[p] = sp[0]; e4[p] = sp[(size_t)M * 16]; } }
                v4u pw; pw.x = cvtpk(S[kb][8 * s], S[kb][8 * s + 1]); pw.y = cvtpk(S[kb][8 * s + 2], S[kb][8 * s + 3]); pw.z = cvtpk(S[kb][8 * s + 4], S[kb][8 * s + 5]); pw.w = cvtpk(S[kb][8 * s + 6], S[kb][8 * s + 7]);
                const bf16x8 pb = __builtin_bit_cast(bf16x8, pw);
                const int rlo = i0 + 32 * kb + 16 * s + 4 * hi + trq, rhi = rlo + 8;
#pragma unroll
                for (int dh = 0; dh < 2; ++dh) { const int chunk = 4 * dh + 2 * trg + (trp >> 1);
                    const v4i16_t lo = __builtin_amdgcn_ds_read_tr16_b64_v4i16((LAS v4i16_t*)(Vs + rlo * 128 + ((chunk ^ (((rlo >> 1) & 1) << 2)) << 4) + 8 * (trp & 1)));
                    const v4i16_t hh = __builtin_amdgcn_ds_read_tr16_b64_v4i16((LAS v4i16_t*)(Vs + rhi * 128 + ((chunk ^ (((rhi >> 1) & 1) << 2)) << 4) + 8 * (trp & 1)));
                    const bf16x8 va = (bf16x8){lo[0], lo[1], lo[2], lo[3], hh[0], hh[1], hh[2], hh[3]};
                    O[dh] = __builtin_amdgcn_mfma_f32_32x32x16_bf16(va, pb, O[dh], 0, 0, 0); } }
        float osc;
        if (SUB == 0) osc = 1.0f / lsum;
        else { const float MM = fmaxf(mx, fmaxf(s16.x, s4.x)), a1 = __builtin_amdgcn_exp2f(mx - MM), a16 = s16.y * __builtin_amdgcn_exp2f(s16.x - MM), a4 = s4.y * __builtin_amdgcn_exp2f(s4.x - MM);
            const float inv = 1.0f / (lsum * a1 + a16 + a4); osc = a1 * inv;
            if (hi == 0) { f32x2_t cc = {a16 * inv, a4 * inv}; *(LAS f32x2_t*)(St + ql * 144 + 128) = cc; } }
#pragma unroll
        for (int dh = 0; dh < 2; ++dh)
#pragma unroll
            for (int g4 = 0; g4 < 4; ++g4) { v2u w; w.x = cvtpk(O[dh][4 * g4] * osc, O[dh][4 * g4 + 1] * osc); w.y = cvtpk(O[dh][4 * g4 + 2] * osc, O[dh][4 * g4 + 3] * osc);
                *(LAS v2u*)(St + ql * 144 + (32 * dh + 8 * g4 + 4 * hi) * 2) = w; }
        if (SUB == 0) {
            unsigned char* PART = (unsigned char*)(F.ws + WS_XN) + (itcur < 1024 ? 0 : (size_t)M * BW); float* ST = (float*)(F.ws + WS_STAT) + (itcur < 1024 ? 0 : (size_t)M * NH * 2);
            unsigned char* PSC = (unsigned char*)(F.ws + WS_PSC) + (itcur < 1024 ? 0 : (size_t)M * 16);
            if (hi == 0) { const size_t qt = tb + (size_t)(s0c + i0 + ql) * dc; f32x2_t st = {mx, lsum}; *(f32x2_t*)(ST + (qt * NH + hcur) * 2) = st; }
#pragma unroll
            for (int p = 0; p < 4; ++p) { const size_t rt = tb + (size_t)(s0c + i0 + 8 * p + prow) * dc;
                const v4u ov = *(const LAS v4u*)(St + (8 * p + prow) * 144 + pch * 16);
                const float f0 = bflo(ov.x), f1 = bfhi(ov.x), f2 = bflo(ov.y), f3 = bfhi(ov.y), f4 = bflo(ov.z), f5 = bfhi(ov.z), f6 = bflo(ov.w), f7 = bfhi(ov.w);
                float bm = fmaxf(fmaxf(fmaxf(fabsf(f0), fabsf(f1)), fmaxf(fabsf(f2), fabsf(f3))), fmaxf(fmaxf(fabsf(f4), fabsf(f5)), fmaxf(fabsf(f6), fabsf(f7))));
                bm = fmaxf(bm, dpp_mov<0xB1>(bm)); bm = fmaxf(bm, dpp_mov<0x4E>(bm)); float mult; const unsigned eb = mx_scale(bm, mult);
                v2u o; o.x = pk4_fp8(f0 * mult, f1 * mult, f2 * mult, f3 * mult); o.y = pk4_fp8(f4 * mult, f5 * mult, f6 * mult, f7 * mult);
                *(v2u*)(PART + rt * BW + hcur * 64 + pch * 8) = o;
                if ((pch & 3) == 0) PSC[rt * 16 + hcur * 2 + (pch >> 2)] = (unsigned char)eb; }
        } else {
#pragma unroll
            for (int p = 0; p < 4; ++p) { const size_t rt = tb + (size_t)(s0c + i0 + 8 * p + prow) * dc;
                const v4u ov = *(const LAS v4u*)(St + (8 * p + prow) * 144 + pch * 16); const f32x2_t cc = *(const LAS f32x2_t*)(St + (8 * p + prow) * 144 + 128);
                float f[8];
                const float c16 = cc.x * __uint_as_float(e16[p] << 23), c4 = cc.y * __uint_as_float(e4[p] << 23);
                f[0] = bflo(ov.x) + c16 * __builtin_amdgcn_cvt_f32_fp8((int)x16[p].x, 0) + c4 * __builtin_amdgcn_cvt_f32_fp8((int)x4[p].x, 0); f[1] = bfhi(ov.x) + c16 * __builtin_amdgcn_cvt_f32_fp8((int)x16[p].x, 1) + c4 * __builtin_amdgcn_cvt_f32_fp8((int)x4[p].x, 1);
                f[2] = bflo(ov.y) + c16 * __builtin_amdgcn_cvt_f32_fp8((int)x16[p].x, 2) + c4 * __builtin_amdgcn_cvt_f32_fp8((int)x4[p].x, 2); f[3] = bfhi(ov.y) + c16 * __builtin_amdgcn_cvt_f32_fp8((int)x16[p].x, 3) + c4 * __builtin_amdgcn_cvt_f32_fp8((int)x4[p].x, 3);
                f[4] = bflo(ov.z) + c16 * __builtin_amdgcn_cvt_f32_fp8((int)x16[p].y, 0) + c4 * __builtin_amdgcn_cvt_f32_fp8((int)x4[p].y, 0); f[5] = bfhi(ov.z) + c16 * __builtin_amdgcn_cvt_f32_fp8((int)x16[p].y, 1) + c4 * __builtin_amdgcn_cvt_f32_fp8((int)x4[p].y, 1);
                f[6] = bflo(ov.w) + c16 * __builtin_amdgcn_cvt_f32_fp8((int)x16[p].y, 2) + c4 * __builtin_amdgcn_cvt_f32_fp8((int)x4[p].y, 2); f[7] = bfhi(ov.w) + c16 * __builtin_amdgcn_cvt_f32_fp8((int)x16[p].y, 3) + c4 * __builtin_amdgcn_cvt_f32_fp8((int)x4[p].y, 3);
                float bm = fmaxf(fmaxf(fmaxf(fabsf(f[0]), fabsf(f[1])), fmaxf(fabsf(f[2]), fabsf(f[3]))), fmaxf(fmaxf(fabsf(f[4]), fabsf(f[5])), fmaxf(fabsf(f[6]), fabsf(f[7]))));
                bm = fmaxf(bm, dpp_mov<0xB1>(bm)); bm = fmaxf(bm, dpp_mov<0x4E>(bm)); float mult; const unsigned eb = mx_scale(bm, mult);
                v2u o; o.x = pk4_fp8(f[0] * mult, f[1] * mult, f[2] * mult, f[3] * mult); o.y = pk4_fp8(f[4] * mult, f[5] * mult, f[6] * mult, f[7] * mult);
                *(v2u*)((unsigned char*)(F.ws + WS_MIXCAT) + rt * D + AW + hcur * 64 + pch * 8) = o;
                if ((pch & 3) == 0) ((unsigned char*)(F.ws + WS_SCM))[scm_index((int)rt, (AW + hcur * 64 + pch * 8) >> 5)] = (unsigned char)eb; }
        }
        __syncthreads();
        if (!has_next) break;
        ATT_WRITE(); it = itn;
        __syncthreads();
    }
#undef ATT_DECODE
#undef ATT_LOAD
#undef ATT_WRITE
}
typedef float f32x4_t __attribute__((ext_vector_type(4)));
DI void cmul_acc(float& xr, float& xi, float ar, float ai, float br, float bi) { const float nr = ar * xr - ai * xi + br, ni = ar * xi + ai * xr + bi; xr = nr; xi = ni; }
DI void mix_ssm_in(Frame& F, int l) {
    FRAME_IDS
    const bf16* P = (const bf16*)(F.ws + WS_PROJ);
    const bf16* WIN = (const bf16*)(F.ws + WS_SSM2 + l * SSM2_LAYER + S2_WIN);
    const float* apw = (const float*)(F.ws + WS_SSM2 + l * SSM2_LAYER + S2_APW);
    float* XLOC = (float*)(F.ws + WS_XLOC); float* XSUP = (float*)(F.ws + WS_XSUP);
    const int row = lane_ & 15, q = lane_ >> 4;
    for (int it = F.vcu; it < 256; it += F.G) {
        const int b = it >> 5, sc = (it >> 2) & 7, g = 4 * (it & 3) + (wave_ >> 1), half = wave_ & 1;
        bf16x8 af[16];
        { const bf16* src = P + ((size_t)b * T + (size_t)(16 * sc + row) * 32 + (q >> 1)) * PROJW + COL_S + g * 16 + 8 * (q & 1);
#pragma unroll
          for (int sp = 0; sp < 16; ++sp) af[sp] = *(const bf16x8*)(src + (size_t)(2 * sp) * PROJW); }
#pragma unroll 1
        for (int c4 = 0; c4 < 4; ++c4) { const int ct = 4 * half + c4;
            f32x4_t acc = {0.f, 0.f, 0.f, 0.f};
            const bf16* wp = WIN + (((size_t)(g * 16) * 8 + ct) * 64 + lane_) * 8;
#pragma unroll
            for (int sp = 0; sp < 16; ++sp) { const bf16x8 bfr = *(const bf16x8*)(wp + (size_t)sp * 8 * 64 * 8); acc = __builtin_amdgcn_mfma_f32_16x16x32_bf16(af[sp], bfr, acc, 0, 0, 0); }
            const int comp = 16 * ct + row, n = comp >> 1, part = comp & 1;
#pragma unroll
            for (int r = 0; r < 4; ++r) XLOC[(((size_t)b * 128 + 16 * sc + 4 * q + r) * 16 + g) * 128 + comp] = acc[r];
            const float a32r = apw[((g * 33 + 32) * 64 + n) * 2], a32i = apw[((g * 33 + 32) * 64 + n) * 2 + 1];
            const float sg = part ? 1.f : -1.f;
            float h = acc[0];
#pragma unroll
            for (int r = 1; r < 4; ++r) { const float o = __shfl_xor(h, 1); h = a32r * h + sg * a32i * o + acc[r]; }
            float p64r = a32r * a32r - a32i * a32i, p64i = 2.f * a32r * a32i;
            float p128r = p64r * p64r - p64i * p64i, p128i = 2.f * p64r * p64i;
            float wr = 1.f, wi = 0.f;
            for (int k = 0; k < 3 - q; ++k) { const float t0 = wr * p128r - wi * p128i, t1 = wr * p128i + wi * p128r; wr = t0; wi = t1; }
            { const float o = __shfl_xor(h, 1); h = wr * h + sg * wi * o; }
            h += __shfl_xor(h, 16); h += __shfl_xor(h, 32);
            if (q == 0) XSUP[(((size_t)b * 8 + sc) * 16 + g) * 128 + comp] = h;
        }
    }
}
DI void mix_ssm_out(Frame& F, const Args& A, int l) {
    FRAME_IDS
    const bf16* P = (const bf16*)(F.ws + WS_PROJ); bf16* YG = (bf16*)(F.ws + WS_YG);
    const bf16* KT = (const bf16*)(F.ws + WS_SSM2 + l * SSM2_LAYER + S2_KT); const bf16* CT = (const bf16*)(F.ws + WS_SSM2 + l * SSM2_LAYER + S2_CT);
    const float* apw = (const float*)(F.ws + WS_SSM2 + l * SSM2_LAYER + S2_APW);
    const float* XLOC = (const float*)(F.ws + WS_XLOC); const float* XSUP = (const float*)(F.ws + WS_XSUP);
    LAS unsigned char* Ut = F.lds + RING_OFF + wave_ * 4096;
    LAS float* Xs = (LAS float*)(F.lds + RING_OFF + wave_ * 4096 + 2048);
    for (int i = lane_; i < 256; i += 64) ((LAS unsigned*)Ut)[i] = 0u;
    const int row = lane_ & 15, q = lane_ >> 4;
    for (int it = F.vcu; it < 256; it += F.G) {
        const int b = it >> 5, sc = (it >> 2) & 7, g = 4 * (it & 3) + (wave_ >> 1), half = wave_ & 1, n = lane_;
        const size_t tokA = (size_t)b * T + (size_t)(16 * sc + 8 * half) * 32;
        v4u unext = *(const v4u*)(P + (tokA + (lane_ >> 1)) * PROJW + COL_S + g * 16 + 8 * (lane_ & 1));
        f32x2_t psup[8], ploc[8];
#pragma unroll
        for (int s2 = 0; s2 < 8; ++s2) { psup[s2] = (f32x2_t){0.f, 0.f}; if (s2 < sc) psup[s2] = *(const f32x2_t*)(XSUP + (((size_t)b * 8 + s2) * 16 + g) * 128 + 2 * n); }
#pragma unroll
        for (int k2 = 0; k2 < 8; ++k2) { ploc[k2] = (f32x2_t){0.f, 0.f}; if (half) ploc[k2] = *(const f32x2_t*)(XLOC + (((size_t)b * 128 + 16 * sc + k2) * 16 + g) * 128 + 2 * n); }
        const float dsk = ((const float*)A.in[I_SSMD])[(l * 16 + g) * 16 + row];
        const float a32r = apw[((g * 33 + 32) * 64 + n) * 2], a32i = apw[((g * 33 + 32) * 64 + n) * 2 + 1];
        const float a16r = apw[((g * 33 + 16) * 64 + n) * 2], a16i = apw[((g * 33 + 16) * 64 + n) * 2 + 1];
        float a512r = a32r, a512i = a32i;
#pragma unroll
        for (int k = 0; k < 4; ++k) { const float t0 = a512r * a512r - a512i * a512i, t1 = 2.f * a512r * a512i; a512r = t0; a512i = t1; }
        float xr = 0.f, xi = 0.f;
#pragma unroll
        for (int s2 = 0; s2 < 8; ++s2) if (s2 < sc) cmul_acc(xr, xi, a512r, a512i, psup[s2].x, psup[s2].y);
        if (half) {
#pragma unroll
            for (int k2 = 0; k2 < 8; ++k2) cmul_acc(xr, xi, a32r, a32i, ploc[k2].x, ploc[k2].y); }
        asm volatile("" : "+v"(xr), "+v"(xi) :: "memory");
        bf16x8 kt[16], ctf[4];
#pragma unroll
        for (int p = 0; p < 16; ++p) kt[p] = *(const bf16x8*)(KT + ((size_t)(g * 16 + p) * 64 + lane_) * 8);
#pragma unroll
        for (int sx = 0; sx < 4; ++sx) ctf[sx] = *(const bf16x8*)(CT + ((size_t)(g * 4 + sx) * 64 + lane_) * 8);
        f32x4_t apr[4][2];
#pragma unroll
        for (int sx = 0; sx < 4; ++sx) { const f32x4_t* ap = (const f32x4_t*)(apw + ((size_t)(g * 33 + row + 1) * 64 + 16 * sx + 4 * q) * 2); apr[sx][0] = ap[0]; apr[sx][1] = ap[1]; }
#pragma unroll 1
        for (int kk = 0; kk < 8; ++kk) {
            const size_t tok0 = tokA + (size_t)kk * 32;
            const f32x2_t xl = *(const f32x2_t*)(XLOC + (((size_t)b * 128 + 16 * sc + 8 * half + kk) * 16 + g) * 128 + 2 * n);
            *(LAS v4u*)(Ut + 1024 + lane_ * 16) = unext;
            if (kk < 7) unext = *(const v4u*)(P + (tok0 + 32 + (lane_ >> 1)) * PROJW + COL_S + g * 16 + 8 * (lane_ & 1));
            Xs[2 * n] = xr; Xs[2 * n + 1] = xi; Xs[128 + 2 * n] = a16r * xr - a16i * xi; Xs[128 + 2 * n + 1] = a16r * xi + a16i * xr;
#pragma unroll
            for (int tau = 0; tau < 2; ++tau) { f32x4_t acc = (f32x4_t){0.f, 0.f, 0.f, 0.f};
                const int ti = 16 * tau + row;
#pragma unroll
                for (int sx = 0; sx < 4; ++sx) { const LAS f32x4_t* xp = (const LAS f32x4_t*)(Xs + 128 * tau + 2 * (16 * sx + 4 * q)); const f32x4_t x01 = xp[0], x23 = xp[1];
                    const f32x4_t a01 = apr[sx][0], a23 = apr[sx][1];
                    v4u zw; zw.x = cvtpk(a01.x * x01.x - a01.y * x01.y, a01.x * x01.y + a01.y * x01.x); zw.y = cvtpk(a01.z * x01.z - a01.w * x01.w, a01.z * x01.w + a01.w * x01.z);
                    zw.z = cvtpk(a23.x * x23.x - a23.y * x23.y, a23.x * x23.y + a23.y * x23.x); zw.w = cvtpk(a23.z * x23.z - a23.w * x23.w, a23.z * x23.w + a23.w * x23.z);
                    acc = __builtin_amdgcn_mfma_f32_16x16x32_bf16(__builtin_bit_cast(bf16x8, zw), ctf[sx], acc, 0, 0, 0);
                    asm volatile("" ::: "memory"); }
#pragma unroll
                for (int p = 0; p < 16; ++p) if (p < 8 * tau + 8) { const bf16x8 ua = *(const LAS bf16x8*)(Ut + (32 + ti - 2 * p - (q >> 1)) * 32 + 16 * (q & 1));
                    acc = __builtin_amdgcn_mfma_f32_16x16x32_bf16(ua, kt[p], acc, 0, 0, 0); if ((p & 3) == 3) asm volatile("" ::: "memory"); }
#pragma unroll
                for (int r = 0; r < 4; ++r) { const int t2 = 16 * tau + 4 * q + r; const float uu = bf2f(*(const LAS bf16*)(Ut + (32 + t2) * 32 + 2 * row));
                    YG[(tok0 + t2) * 256 + g * 16 + row] = (bf16)f2bf(gelu_tanh_f(acc[r] + dsk * uu)); }
            }
            cmul_acc(xr, xi, a32r, a32i, xl.x, xl.y);
        }
    }
}
DI void mix_gating_mfma(Frame& F, const Args& A, int l, int variant = 0) {
    FRAME_IDS
    const bf16* P = (const bf16*)(F.ws + WS_PROJ); bf16* MIX = (bf16*)(F.ws + WS_MIXCAT);
    const bf16* GW = (const bf16*)(F.ws + WS_SSM2 + l * SSM2_LAYER + S2_GW);
    const float* lng = (const float*)A.in[I_GMLNG] + l * AW; const float* lnb = (const float*)A.in[I_GMLNB] + l * AW;
    const float* bs_ = (const float*)A.in[I_GMBS] + l * 4 * 128;
    LAS unsigned char* VT = F.lds + RING_OFF;
    const int ql = lane_ & 31, hi = lane_ >> 5, trq = (lane_ & 15) >> 2, trg = (lane_ >> 4) & 1, trp = lane_ & 3;
    for (int it = F.vcu; it < BATCH * (T / 128); it += F.G) {
        const int m0 = it * 128;
        __syncthreads();
        if (variant != 2) {
        v2u wv[16];
#pragma unroll
        for (int j = 0; j < 16; ++j) wv[j] = *(const v2u*)(P + (size_t)(m0 + wave_ + 8 * j) * PROJW + COL_V + 4 * lane_);
        const f32x4 gg = *(const f32x4*)(lng + 4 * lane_), bb = *(const f32x4*)(lnb + 4 * lane_);
#pragma unroll
        for (int j = 0; j < 16; ++j) { const int r = wave_ + 8 * j; const v2u w = wv[j];
            float v[4] = {gelu_tanh_f(bflo(w.x)), gelu_tanh_f(bfhi(w.x)), gelu_tanh_f(bflo(w.y)), gelu_tanh_f(bfhi(w.y))};
            const float mean = wave_sum(v[0] + v[1] + v[2] + v[3]) * (1.f / 256.f);
            float s2 = 0.f;
#pragma unroll
            for (int i = 0; i < 4; ++i) { v[i] -= mean; s2 += v[i] * v[i]; }
            const float rstd = 1.0f / sqrtf(wave_sum(s2) * (1.f / 256.f) + LN_EPS);
            v2u o; o.x = cvtpk(v[0] * rstd * gg.x + bb.x, v[1] * rstd * gg.y + bb.y); o.y = cvtpk(v[2] * rstd * gg.z + bb.z, v[3] * rstd * gg.w + bb.w);
            *(LAS v2u*)(VT + r * 512 + (((lane_ >> 1) ^ ((r & 3) << 2)) << 4) + 8 * (lane_ & 1)) = o;
        }
        }
        __syncthreads();
        if (variant == 1) continue;
        const int h = wave_ >> 1, cb = 64 * h + 32 * (wave_ & 1);
        const int chunk = (cb >> 3) + 2 * trg + (trp >> 1);
#pragma unroll
        for (int rt = 0; rt < 4; ++rt) {
            f32x16 acc;
#pragma unroll
            for (int i = 0; i < 16; ++i) acc[i] = 0.f;
            bf16x8 wa[8];
#pragma unroll
            for (int ks = 0; ks < 2 * rt + 2; ++ks) wa[ks] = *(const bf16x8*)(GW + (size_t)(h * 128 + 32 * rt) * 128 + 16 * ks + (unsigned)(ql * 128 + 8 * hi));
#pragma unroll
            for (int ks = 0; ks < 2 * rt + 2; ++ks) {
                const int rlo = 16 * ks + 8 * hi + trq;
                const v4i16_t lo = __builtin_amdgcn_ds_read_tr16_b64_v4i16((LAS v4i16_t*)(VT + rlo * 512 + ((chunk ^ (trq << 2)) << 4) + 8 * (trp & 1)));
                const v4i16_t hh = __builtin_amdgcn_ds_read_tr16_b64_v4i16((LAS v4i16_t*)(VT + (rlo + 4) * 512 + ((chunk ^ (trq << 2)) << 4) + 8 * (trp & 1)));
                const bf16x8 va = (bf16x8){lo[0], lo[1], lo[2], lo[3], hh[0], hh[1], hh[2], hh[3]};
                acc = __builtin_amdgcn_mfma_f32_32x32x16_bf16(va, wa[ks], acc, 0, 0, 0); }
            { const int t = 32 * rt + ql; const float bsv = bs_[h * 128 + t];
              const bf16* up = P + (size_t)(m0 + t) * PROJW + COL_U + cb + 4 * hi; unsigned char* op = (unsigned char*)MIX + (size_t)(m0 + t) * D + cb + 4 * hi;
              float ov[16]; float bm = 0.f;
#pragma unroll
              for (int g4 = 0; g4 < 4; ++g4) { const v2u uw = *(const v2u*)(up + 8 * g4);
                  ov[4 * g4] = gelu_tanh_f(bflo(uw.x)) * (acc[4 * g4] + bsv); ov[4 * g4 + 1] = gelu_tanh_f(bfhi(uw.x)) * (acc[4 * g4 + 1] + bsv); ov[4 * g4 + 2] = gelu_tanh_f(bflo(uw.y)) * (acc[4 * g4 + 2] + bsv); ov[4 * g4 + 3] = gelu_tanh_f(bfhi(uw.y)) * (acc[4 * g4 + 3] + bsv); }
#pragma unroll
              for (int i = 0; i < 16; ++i) bm = fmaxf(bm, fabsf(ov[i]));
              bm = fmaxf(bm, __shfl_xor(bm, 32)); float mult; const unsigned eb = mx_scale(bm, mult);
#pragma unroll
              for (int g4 = 0; g4 < 4; ++g4) *(unsigned*)(op + 8 * g4) = pk4_fp8(ov[4 * g4] * mult, ov[4 * g4 + 1] * mult, ov[4 * g4 + 2] * mult, ov[4 * g4 + 3] * mult);
              if (hi == 0) ((unsigned char*)(F.ws + WS_SCM))[scm_index(m0 + t, cb >> 5)] = (unsigned char)eb; }
        }
    }
}

DI void p_glu(Frame& F, const Args& A, int l) {
    FRAME_IDS
    const bf16* YG = (const bf16*)(F.ws + WS_YG); bf16* MIX = (bf16*)(F.ws + WS_MIXCAT);
    const bf16* GluT = (const bf16*)(F.ws + WS_WSMALL + l * WSMALL_LAYER + WOFF_GLU); const float* gb = (const float*)A.in[I_GLUB] + l * 256;
    LAS unsigned char* Bs = F.lds + RING_OFF;
#pragma unroll
    for (int i = 0; i < 16; ++i) { const int idx = tid_ + 512 * i, n = idx >> 5, ch = idx & 31;
        *(LAS v4u*)(Bs + n * 512 + ((ch ^ (n & 15)) << 4)) = *(const v4u*)(GluT + (size_t)n * 256 + ch * 8); }
    __syncthreads();
    const int tk = lane_ & 15, q = lane_ >> 4;
    for (int rt = F.vcu; rt < M / 128; rt += F.G) {
        const size_t tok = (size_t)rt * 128 + wave_ * 16 + tk;
        bf16x8 yf[8];
#pragma unroll
        for (int ks = 0; ks < 8; ++ks) yf[ks] = *(const bf16x8*)(YG + tok * 256 + 32 * ks + 8 * q);
#pragma unroll 2
        for (int cp = 0; cp < 8; ++cp) {
            float ov[8];
#pragma unroll
            for (int c2 = 0; c2 < 2; ++c2) { const int ct = 2 * cp + c2;
                f32x4_t acc = {0.f, 0.f, 0.f, 0.f};
                const int n = 16 * ct + tk;
#pragma unroll
                for (int ks = 0; ks < 8; ++ks) { const bf16x8 wf = *(const LAS bf16x8*)(Bs + n * 512 + (((4 * ks + q) ^ (n & 15)) << 4));
                    acc = __builtin_amdgcn_mfma_f32_16x16x32_bf16(wf, yf[ks], acc, 0, 0, 0); }
                const int n0 = 16 * ct + 4 * q; const v2u yw = *(const v2u*)(YG + tok * 256 + n0); const f32x4 bv = *(const f32x4*)(gb + n0);
                ov[4 * c2] = bflo(yw.x) * sigmoid_f(acc[0] + bv.x); ov[4 * c2 + 1] = bfhi(yw.x) * sigmoid_f(acc[1] + bv.y); ov[4 * c2 + 2] = bflo(yw.y) * sigmoid_f(acc[2] + bv.z); ov[4 * c2 + 3] = bfhi(yw.y) * sigmoid_f(acc[3] + bv.w); }
            float bm = fmaxf(fmaxf(fmaxf(fabsf(ov[0]), fabsf(ov[1])), fmaxf(fabsf(ov[2]), fabsf(ov[3]))), fmaxf(fmaxf(fabsf(ov[4]), fabsf(ov[5])), fmaxf(fabsf(ov[6]), fabsf(ov[7]))));
            bm = fmaxf(bm, __shfl_xor(bm, 16)); bm = fmaxf(bm, __shfl_xor(bm, 32)); float mult; const unsigned eb = mx_scale(bm, mult);
            unsigned char* op = (unsigned char*)MIX + tok * D + 768 + 32 * cp + 4 * q;
            *(unsigned*)op = pk4_fp8(ov[0] * mult, ov[1] * mult, ov[2] * mult, ov[3] * mult); *(unsigned*)(op + 16) = pk4_fp8(ov[4] * mult, ov[5] * mult, ov[6] * mult, ov[7] * mult);
            if (q == 0) ((unsigned char*)(F.ws + WS_SCM))[scm_index((int)tok, 24 + cp)] = (unsigned char)eb;
        }
    }
}
DI void mix_ssm_simple(Frame& F, const Args& A, int l) {
    FRAME_IDS
    const bf16* P = (const bf16*)(F.ws + WS_PROJ); bf16* YG = (bf16*)(F.ws + WS_YG);
    const float* tab = (const float*)(F.ws + WS_SSM) + (size_t)l * SSM_TAB;
    LAS float* fin = (LAS float*)(F.lds + RING_OFF);
    for (int it = F.vcu; it < BATCH * SSM_G; it += F.G) {
        const int b = it >> 4, g = it & 15, n = lane_, seg = wave_, gn = g * 64 + n;
        const float are = tab[gn], aim = tab[1024 + gn];
        float bre[16], bim[16], cre[16], cim[16];
#pragma unroll
        for (int c = 0; c < 16; ++c) { bre[c] = tab[2048 + gn * 16 + c]; bim[c] = tab[2048 + 16384 + gn * 16 + c];
            cre[c] = ((const float*)A.in[I_CRE])[(((size_t)l * 16 + g) * 16 + c) * 64 + n]; cim[c] = ((const float*)A.in[I_CIM])[(((size_t)l * 16 + g) * 16 + c) * 64 + n]; }
        const float dsk = ((const float*)A.in[I_SSMD])[(l * 16 + g) * 16 + (lane_ & 15)];
        const size_t mbase = (size_t)b * T + seg * 512;
        float xr = 0.f, xi = 0.f;
        for (int tt = 0; tt < 512; ++tt) { const v4u* up = (const v4u*)(P + (mbase + tt) * PROJW + COL_S + g * 16); const v4u u0 = up[0], u1 = up[1];
            const float u[16] = {bflo(u0.x), bfhi(u0.x), bflo(u0.y), bfhi(u0.y), bflo(u0.z), bfhi(u0.z), bflo(u0.w), bfhi(u0.w), bflo(u1.x), bfhi(u1.x), bflo(u1.y), bfhi(u1.y), bflo(u1.z), bfhi(u1.z), bflo(u1.w), bfhi(u1.w)};
            float br = 0.f, bi = 0.f;
#pragma unroll
            for (int c = 0; c < 16; ++c) { br += u[c] * bre[c]; bi += u[c] * bim[c]; }
            const float nr = are * xr - aim * xi + br, ni = are * xi + aim * xr + bi; xr = nr; xi = ni; }
        fin[(seg * 64 + n) * 2] = xr; fin[(seg * 64 + n) * 2 + 1] = xi;
        __syncthreads();
        float pr = are, pi = aim;
#pragma unroll
        for (int k = 0; k < 9; ++k) { const float t0 = pr * pr - pi * pi, t1 = 2.f * pr * pi; pr = t0; pi = t1; }
        xr = 0.f; xi = 0.f;
        for (int s = 0; s < seg; ++s) { const float fr_ = fin[(s * 64 + n) * 2], fi_ = fin[(s * 64 + n) * 2 + 1];
            const float nr = pr * xr - pi * xi + fr_, ni = pr * xi + pi * xr + fi_; xr = nr; xi = ni; }
        for (int tt = 0; tt < 512; ++tt) { const v4u* up = (const v4u*)(P + (mbase + tt) * PROJW + COL_S + g * 16); const v4u u0 = up[0], u1 = up[1];
            const float u[16] = {bflo(u0.x), bfhi(u0.x), bflo(u0.y), bfhi(u0.y), bflo(u0.z), bfhi(u0.z), bflo(u0.w), bfhi(u0.w), bflo(u1.x), bfhi(u1.x), bflo(u1.y), bfhi(u1.y), bflo(u1.z), bfhi(u1.z), bflo(u1.w), bfhi(u1.w)};
            float br = 0.f, bi = 0.f;
#pragma unroll
            for (int c = 0; c < 16; ++c) { br += u[c] * bre[c]; bi += u[c] * bim[c]; }
            const float nr = are * xr - aim * xi + br, ni = are * xi + aim * xr + bi; xr = nr; xi = ni;
            float ysel = 0.f, usel = 0.f;
#pragma unroll
            for (int c = 0; c < 16; ++c) { const float r = wave_sum(xr * cre[c] - xi * cim[c]); if ((lane_ & 15) == c) { ysel = r; usel = u[c]; } }
            if (lane_ < 16) { const float y = ysel + dsk * usel; YG[(mbase + tt) * 256 + g * 16 + lane_] = (bf16)f2bf(gelu_tanh_f(y)); } }
        __syncthreads();
    }
}

DI bool beats(float x, int i, float y, int j) { return x > y || (x == y && i < j); }
DI void p_row_b(Frame& F, const Args& A, int l, bool count = true) {
    FRAME_IDS
    const int gw = F.vcu * NWAVES + wave_, NGW = F.G * NWAVES;
    const bf16* PRE = (const bf16*)(F.ws + WS_PRE); bf16* X1 = (bf16*)(F.ws + WS_X1); bf16* XN = (bf16*)(F.ws + WS_XN);
    const float* mod = (const float*)(F.ws + WS_MOD) + (size_t)l * BATCH * 6 * D;
    const float* ln1g = (const float*)A.in[I_LN1G] + l * D; const float* ln1b = (const float*)A.in[I_LN1B] + l * D;
    const float* rw = (const float*)A.in[I_RW]; const float* rb = (const float*)A.in[I_RB];
    int* slot_a = (int*)(F.ws + WS_SLOT_A); float* slot_w = (float*)(F.ws + WS_SLOT_W);
    LAS float* rwS = (LAS float*)(F.lds + RING_OFF);
    volatile LAS unsigned* lcnt = (volatile LAS unsigned*)(F.lds + RING_OFF + 65536);
    LAS int* list_a = (LAS int*)(F.lds + RING_OFF + 66048); LAS float* list_w = (LAS float*)(F.lds + RING_OFF + 66048 + 8192);
    for (int i = tid_; i < D * NEXP; i += NTHR) rwS[(i & 15) * D + (i >> 4)] = rw[i];
    if (tid_ < 32) lcnt[tid_] = 0u;
    __syncthreads();
    const int hi5 = lane_ >> 5, b4 = (lane_ >> 4) & 1, b3 = (lane_ >> 3) & 1, b2 = (lane_ >> 2) & 1, emine = 8 * hi5 + 4 * b4 + 2 * b3 + b2;
    const int wi = 2 * b3 + b2, mygrp = 2 * hi5 + b4;
    const float rbm = rb[emine];
    Row16 lg1, lb1; row_load_f32(lg1, ln1g, lane_); row_load_f32(lb1, ln1b, lane_);
    v2u nraw[4];
    const int bq = gw / (NGW / BATCH), mbase = bq * T + gw % (NGW / BATCH), mstep = NGW / BATCH;
    const float* md = mod + (size_t)bq * 6 * D;
    Row16 msc, msh; row_load_f32(msc, md + 4 * D, lane_); row_load_f32(msh, md + 3 * D, lane_);
    { const v2u* q = (const v2u*)(PRE + (size_t)mbase * D);
#pragma unroll
      for (int k = 0; k < 4; ++k) nraw[k] = q[k * 64 + lane_]; }
    for (int m = mbase; m < (bq + 1) * T; m += mstep) {
        Row16 r;
#pragma unroll
        for (int k = 0; k < 4; ++k) { r.v[4 * k] = bflo(nraw[k].x); r.v[4 * k + 1] = bfhi(nraw[k].x); r.v[4 * k + 2] = bflo(nraw[k].y); r.v[4 * k + 3] = bfhi(nraw[k].y); }
        if (m + mstep < (bq + 1) * T) { const v2u* q = (const v2u*)(PRE + (size_t)(m + mstep) * D);
#pragma unroll
            for (int k = 0; k < 4; ++k) nraw[k] = q[k * 64 + lane_]; }
        row_ln(r);
#pragma unroll
        for (int i = 0; i < 16; ++i) r.v[i] = r.v[i] * lg1.v[i] + lb1.v[i];
        row_ln(r);
#pragma unroll
        for (int i = 0; i < 16; ++i) r.v[i] = r.v[i] * (1.0f + msc.v[i]) + msh.v[i];
        unsigned ib;
        { float am = 0.f;
#pragma unroll
          for (int i = 0; i < 16; ++i) am = fmaxf(am, fabsf(r.v[i]));
          am = wave_max(am); ib = (am > 1e-30f) ? ((__float_as_uint(am * (1.0f / 440.0f)) + 0xffffu) & 0xffff0000u) : 0x3f800000u;
          const float qs = 1.0f / __uint_as_float(ib);
          unsigned* q8 = (unsigned*)((unsigned char*)XN + (size_t)m * D);
#pragma unroll
          for (int k = 0; k < 4; ++k) q8[k * 64 + lane_] = pk4_fp8(r.v[4 * k] * qs, r.v[4 * k + 1] * qs, r.v[4 * k + 2] * qs, r.v[4 * k + 3] * qs); }
        float lg[16];
#pragma unroll
        for (int e = 0; e < 16; ++e) { float a = 0.f;
#pragma unroll
            for (int k = 0; k < 4; ++k) { const f32x4 w4 = *(const LAS f32x4*)(rwS + e * D + 256 * k + 4 * lane_); a += r.v[4 * k] * w4.x + r.v[4 * k + 1] * w4.y + r.v[4 * k + 2] * w4.z + r.v[4 * k + 3] * w4.w; }
            lg[e] = a; }
        float t8[8], t4[4], t2[2];
#pragma unroll
        for (int i = 0; i < 8; ++i) { const float keep = hi5 ? lg[8 + i] : lg[i], give = hi5 ? lg[i] : lg[8 + i]; t8[i] = keep + __shfl_xor(give, 32); }
#pragma unroll
        for (int i = 0; i < 4; ++i) { const float keep = b4 ? t8[4 + i] : t8[i], give = b4 ? t8[i] : t8[4 + i]; t4[i] = keep + __shfl_xor(give, 16); }
#pragma unroll
        for (int i = 0; i < 2; ++i) { const float keep = b3 ? t4[2 + i] : t4[i], give = b3 ? t4[i] : t4[2 + i]; t2[i] = keep + __shfl_xor(give, 8); }
        float z = (b2 ? t2[1] : t2[0]) + __shfl_xor(b2 ? t2[0] : t2[1], 4);
        z += __shfl_xor(z, 2); z += __shfl_xor(z, 1);
        const float scm = 1.0f / (1.0f + __builtin_amdgcn_exp2f(-1.4426950408889634f * z)), a = scm + rbm;
        const float p4 = __shfl_xor(a, 4), p8 = __shfl_xor(a, 8), p12 = __shfl_xor(a, 12);
        const float hi01 = fmaxf(a, p4), lo01 = fminf(a, p4), hi23 = fmaxf(p8, p12), lo23 = fminf(p8, p12);
        const float gs = fmaxf(hi01, hi23) + fmaxf(fmaxf(lo01, lo23), fminf(hi01, hi23));
        const float g16 = __shfl_xor(gs, 16), g32 = __shfl_xor(gs, 32), g48 = __shfl_xor(gs, 48);
        const bool best = beats(gs, mygrp, g16, mygrp ^ 1) && beats(gs, mygrp, g32, mygrp ^ 2) && beats(gs, mygrp, g48, mygrp ^ 3);
        const int rank = (beats(p4, wi ^ 1, a, wi) ? 1 : 0) + (beats(p8, wi ^ 2, a, wi) ? 1 : 0) + (beats(p12, wi ^ 3, a, wi) ? 1 : 0);
        const bool sel = best && rank < 2;
        float tot = sel ? scm : 0.f; tot += __shfl_xor(tot, 4); tot += __shfl_xor(tot, 8);
        if (count && sel && (lane_ & 3) == 0) { const unsigned rk = atomicAdd((unsigned*)&lcnt[emine], 1u);
            list_a[emine * 128 + rk] = (int)((unsigned)(2 * m + rank) | ib); list_w[emine * 128 + rk] = scm / tot; }
    }
    __syncthreads();
    if (count) {
        if (tid_ < 16) { const unsigned n = lcnt[tid_]; lcnt[16 + tid_] = n ? atomicAdd((unsigned*)(F.ctl + CW_CNT + l * 128 + tid_), n) : 0u; }
        __syncthreads();
        for (int idx = tid_; idx < 16 * 128; idx += NTHR) { const int e = idx >> 7, rk = idx & 127;
            if (rk < (int)lcnt[e]) { const size_t slot = (size_t)e * SLOT_CAP + lcnt[16 + e] + rk; slot_a[slot] = list_a[idx]; slot_w[slot] = list_w[idx]; } }
    }
}

DI void moe_tstart(Frame& F, int l) {
    FRAME_IDS
    volatile LAS int* ts = (volatile LAS int*)(F.lds + LDSCTL_OFF);
    __syncthreads();
    if (tid_ == 0) { int acc = 0;
        for (int e = 0; e < 16; ++e) { ts[e] = acc; const unsigned c = __hip_atomic_load(F.ctl + CW_CNT + l * 128 + e, RLX_AGENT); ts[32 + e] = (int)c; acc += (int)((c + 255u) >> 8); }
        ts[16] = acc; }
    __syncthreads();
}
DI void p_row_c(Frame& F, const Args& A, int l) {
    FRAME_IDS
    const int gw = F.vcu * NWAVES + wave_, NGW = F.G * NWAVES;
    const bf16* X1 = (const bf16*)(F.ws + WS_PRE); bf16* R2 = (bf16*)(F.ws + WS_ROWS2); bf16* XN = (bf16*)(F.ws + WS_XN);
    const float* ln1g = (const float*)A.in[I_LN1G] + l * D; const float* ln1b = (const float*)A.in[I_LN1B] + l * D;
    Row16 lg1, lb1; row_load_f32(lg1, ln1g, lane_); row_load_f32(lb1, ln1b, lane_);
    const float* mod = (const float*)(F.ws + WS_MOD) + (size_t)l * BATCH * 6 * D;
    const float* modn = (const float*)(F.ws + WS_MOD) + (size_t)(l + 1) * BATCH * 6 * D;
    const float* ln2g = (const float*)A.in[I_LN2G] + l * D; const float* ln2b = (const float*)A.in[I_LN2B] + l * D;
    Row16 lg2, lb2; row_load_f32(lg2, ln2g, lane_); row_load_f32(lb2, ln2b, lane_);
    v2u nx[4]; unsigned n0[4], n1[4], sc0, sc1;
    const unsigned char* SCR = (const unsigned char*)(F.ws + WS_SCR);
#define RC_LOAD(mm) do { const v2u* qa = (const v2u*)(X1 + (size_t)(mm) * D); const unsigned* qb = (const unsigned*)(R2 + (size_t)(2 * (mm)) * D); \
        _Pragma("unroll") for (int k = 0; k < 4; ++k) { nx[k] = __builtin_nontemporal_load(&qa[k * 64 + lane_]); n0[k] = __builtin_nontemporal_load(&qb[k * 64 + lane_]); n1[k] = __builtin_nontemporal_load(&qb[512 + k * 64 + lane_]); } \
        sc0 = ((const unsigned*)(SCR + (size_t)(2 * (mm)) * 32))[lane_ >> 3]; sc1 = ((const unsigned*)(SCR + (size_t)(2 * (mm) + 1) * 32))[lane_ >> 3]; } while (0)
    const int bq = gw / (NGW / BATCH), mbase = bq * T + gw % (NGW / BATCH), mstep = NGW / BATCH;
    const float* md = mod + (size_t)bq * 6 * D;
    Row16 gm; row_load_f32(gm, md + 5 * D, lane_);
    Row16 msc, msh;
    if (l != DEPTH - 1) { const float* mdn = modn + (size_t)bq * 6 * D; row_load_f32(msc, mdn + 1 * D, lane_); row_load_f32(msh, mdn + 0 * D, lane_); }
    RC_LOAD(mbase);
    for (int m = mbase; m < (bq + 1) * T; m += mstep) {
        Row16 x1, g2;
#pragma unroll
        for (int k = 0; k < 4; ++k) {
            x1.v[4 * k] = bflo(nx[k].x); x1.v[4 * k + 1] = bfhi(nx[k].x); x1.v[4 * k + 2] = bflo(nx[k].y); x1.v[4 * k + 3] = bfhi(nx[k].y);
            { const float f0 = __uint_as_float(((sc0 >> (8 * k)) & 0xffu) << 23), f1 = __uint_as_float(((sc1 >> (8 * k)) & 0xffu) << 23);
              g2.v[4 * k] = __builtin_amdgcn_cvt_f32_fp8((int)n0[k], 0) * f0 + __builtin_amdgcn_cvt_f32_fp8((int)n1[k], 0) * f1; g2.v[4 * k + 1] = __builtin_amdgcn_cvt_f32_fp8((int)n0[k], 1) * f0 + __builtin_amdgcn_cvt_f32_fp8((int)n1[k], 1) * f1;
              g2.v[4 * k + 2] = __builtin_amdgcn_cvt_f32_fp8((int)n0[k], 2) * f0 + __builtin_amdgcn_cvt_f32_fp8((int)n1[k], 2) * f1; g2.v[4 * k + 3] = __builtin_amdgcn_cvt_f32_fp8((int)n0[k], 3) * f0 + __builtin_amdgcn_cvt_f32_fp8((int)n1[k], 3) * f1; } }
        if (m + mstep < (bq + 1) * T) RC_LOAD(m + mstep);
        row_ln(x1);
#pragma unroll
        for (int i = 0; i < 16; ++i) x1.v[i] = ALPHA * (x1.v[i] * lg1.v[i] + lb1.v[i]) + (1.0f + gm.v[i]) * g2.v[i];
        row_ln(x1);
#pragma unroll
        for (int i = 0; i < 16; ++i) x1.v[i] = x1.v[i] * lg2.v[i] + lb2.v[i];
        if (l == DEPTH - 1) row_store_f32(x1, A.out + (size_t)m * D, lane_);
        else { row_store_bf16(x1, R2 + (size_t)(2 * m) * D, lane_);
            row_ln(x1);
#pragma unroll
            for (int i = 0; i < 16; ++i) x1.v[i] = x1.v[i] * (1.0f + msc.v[i]) + msh.v[i];
            row_store_fp8(x1, (unsigned char*)XN + (size_t)m * D, (float*)(F.ws + WS_SA) + m, lane_); }
    }
#undef RC_LOAD
}

#ifndef PHMASK
#define PHMASK 0xFFFFFFFFu
#endif
#define IN(k) (lo <= (k) && (k) < hi && ((PHMASK >> (((k) == 0) ? 31 : (((k) - 1) % PH_PER_LAYER))) & 1u))
#define SEAM(k) do { if (IN((k) + 1) && MK_ONE_LAUNCH) xcd_barrier(bar); else __syncthreads(); } while (0)
constexpr int PH_PER_LAYER = 9, N_PHASES = 1 + DEPTH * PH_PER_LAYER;
#ifndef REP_PH
#define REP_PH -1
#endif
#define NREP(k) (((k) == REP_PH) ? 2 : 1)
template <int l> DI void layer_body(Frame& F, const Args& args, const XcdBarrier& bar, const int lo, const int hi) {
    unsigned char* ws = args.ws;

        const int pb = 1 + l * PH_PER_LAYER;
        const bf16* WinT = (const bf16*)(ws + WS_WSMALL + l * WSMALL_LAYER + WOFF_IN);
        const bf16* WoutT = (const bf16*)(ws + WS_WSMALL + l * WSMALL_LAYER + WOFF_OUT);
        const bf16* GluT = (const bf16*)(ws + WS_WSMALL + l * WSMALL_LAYER + WOFF_GLU);
        const float* modl = (const float*)(ws + WS_MOD) + (size_t)l * BATCH * 6 * D;
        if (l == 0 && IN(pb + 0)) { p_wconv(F, args, 0, 4); p_wconv(F, args, 1, 4); p_ln_a0(F, args); SEAM(pb + 0); }
        if (IN(pb + 1)) for (int rep_ = 0; rep_ < NREP(1); ++rep_) {
            pg8::Gemm g{(const bf16*)(ws + WS_XN), WinT, M, PROJW, D / 2}; pg8::StaticOrder S; S.init(M, PROJW, F.G, (int)blockIdx.x);
            EpiInProj E{(bf16*)(ws + WS_PROJ), (const float*)(ws + WS_ROPE), args.pad, (const float*)(ws + WS_SA), (const float*)(ws + WS_CINV_IN) + l * PROJW};
            pg8::gemm_phase<EpiInProj, pg8::StaticOrder, PG8_ALIGN, PG8_SP2, true>(F.lds + RING_OFF, g, S, E);
            if (F.G == 256 && blockIdx.x >= 128) { __syncthreads(); p_wconv_gu(F, args, l, 256 + (int)blockIdx.x - 128, 128, WC_NGU); }
            SEAM(pb + 1); }
        if (IN(pb + 2)) for (int rep_ = 0; rep_ < NREP(2); ++rep_) {
#ifndef REP_SUB
#define REP_SUB -1
#endif
#define SUBREP(k) for (int rs_ = 0; rs_ < ((REP_SUB == (k)) ? 2 : 1); ++rs_)
            SUBREP(0) { mix_gating_mfma(F, args, l); __syncthreads(); }
#if REP_SUB >= 10 && REP_SUB < 20
            mix_gating_mfma(F, args, l, REP_SUB - 10); __syncthreads(); mix_gating_mfma(F, args, l); __syncthreads();
#endif
 SUBREP(1) { mix_ssm_in(F, l); } SUBREP(2) { mix_attn_mfma<0>(F, l); __syncthreads(); } SEAM(pb + 2); }
        if (IN(pb + 3)) for (int rep_ = 0; rep_ < NREP(3); ++rep_) { SUBREP(3) { mix_ssm_out(F, args, l); __syncthreads(); } SUBREP(4) { mix_attn_mfma<1>(F, l); __syncthreads(); } SEAM(pb + 3); }
        if (IN(pb + 4)) for (int rep_ = 0; rep_ < NREP(4); ++rep_) { p_glu(F, args, l); SEAM(pb + 4); }
        if (IN(pb + 5)) for (int rep_ = 0; rep_ < NREP(5); ++rep_) {
            pg8::Gemm g{(const bf16*)(ws + WS_MIXCAT), WoutT, M, D, D / 2}; pg8::StaticOrder S; S.init(M, D, F.G, (int)blockIdx.x);
            const float* cio = (const float*)(ws + WS_CINV_O) + l * D; const unsigned char* scm = (const unsigned char*)(ws + WS_SCM);
            if (l == 0) { EpiOut<true> E{(bf16*)(ws + WS_PRE), args.in[I_X], D, modl, cio}; pg8::gemm_phase<EpiOut<true>, pg8::StaticOrder, PG8_ALIGN, PG8_SP2, true, true>(F.lds + RING_OFF, g, S, E, scm, F.lds + SCT_OFF); }
            else { EpiOut<false> E{(bf16*)(ws + WS_PRE), (const void*)(ws + WS_ROWS2), 2 * D, modl, cio}; pg8::gemm_phase<EpiOut<false>, pg8::StaticOrder, PG8_ALIGN, PG8_SP2, true, true>(F.lds + RING_OFF, g, S, E, scm, F.lds + SCT_OFF); }
            SEAM(pb + 5); }
        if (IN(pb + 6)) { p_row_b(F, args, l); SUBREP(5) { if (REP_SUB == 5 && rs_ == 0) { __syncthreads(); p_row_b(F, args, l, false); } } SEAM(pb + 6); }
        if (IN(pb + 7)) { moe_tstart(F, l);
            gu32* dcnt = F.ctl + CW_DONE + l * 512;
            if (args.pad != 4)
            { pg8::Gemm g{(const bf16*)(ws + WS_XN), (const bf16*)(ws + WS_WGU), NSLOT_MAX, NEXP * 1024, D / 2};
              MoeOrderK<0> S{(const volatile LAS int*)(F.lds + LDSCTL_OFF), F.G, (int)blockIdx.x, (const int*)(ws + WS_SLOT_A), (const float*)(ws + WS_SLOT_W), dcnt, F.ctl + CW_QUEUE + l * 128, (volatile LAS int*)(F.lds + LDSCTL_OFF + 256), nullptr}; EpiG1 E{(unsigned char*)(ws + WS_HID), args.pad, (const float*)(ws + WS_CINV) + (size_t)l * 16 * 2 * 512, (unsigned char*)(ws + WS_HSC)};
              pg8::gemm_phase_g<EpiG1, MoeOrderK<0>, PG8_ALIGN, PG8_SP2, 0, true>(F.lds + RING_OFF, F.lds + GT_OFF, g, S, E); }
            if (args.pad != 3)
            { pg8::Gemm g{(const bf16*)(ws + WS_HID), (const bf16*)(ws + WS_WD), NSLOT_MAX, NEXP * 1024, DEXP / 2};
              MoeOrderK<1> S{(const volatile LAS int*)(F.lds + LDSCTL_OFF), F.G, (int)blockIdx.x, (const int*)(ws + WS_SLOT_A), (const float*)(ws + WS_SLOT_W), dcnt, F.ctl + CW_QUEUE + l * 128, (volatile LAS int*)(F.lds + LDSCTL_OFF + 256), (const unsigned char*)(ws + WS_HSC)}; EpiG2 E{(unsigned char*)(ws + WS_ROWS2), args.pad, (const float*)(ws + WS_CINV_D) + (size_t)l * NEXP * D, (unsigned char*)(ws + WS_SCR)};
              pg8::gemm_phase_g<EpiG2, MoeOrderK<1>, PG8_ALIGN, PG8_SP2, 0, true, true>(F.lds + RING_OFF, F.lds + GT_OFF, g, S, E); }
            SEAM(pb + 7); }
        if (IN(pb + 8)) { p_row_c(F, args, l); if (l == 0) { __syncthreads(); p_wconv_dn(F, args, 1, F.vcu, F.G); p_wconv_gu(F, args, 1, F.vcu, F.G, F.G == 256 ? 256 : WC_NGU); } SUBREP(6) { if (REP_SUB == 6 && rs_ == 0 && l == DEPTH - 1) { __syncthreads(); p_row_c(F, args, l); } } SEAM(pb + 8); }
    }
__global__ void __launch_bounds__(NTHR, 2) mk_fwd(Args args) {
    extern __shared__ __attribute__((aligned(16))) unsigned char lds[];
    Frame F;
    F.lds = (LAS unsigned char*)lds; F.MISC = (volatile LAS unsigned*)(F.lds + MISC_OFF);
    F.G = gridDim.x; { const int bx = blockIdx.x; F.vcu = (F.G % 8 == 0) ? (bx % 8) * (F.G / 8) + bx / 8 : bx; }
    F.ws = args.ws; F.ctl = (gu32*)(args.ws + WS_CTL);
    for (int u = ftid(); u < (LDS_BYTES - LDSCTL_OFF) / 4; u += NTHR) ((LAS unsigned*)(F.lds + LDSCTL_OFF))[u] = 0u;
    __syncthreads();
    XcdBarrier bar; bar.bar = (unsigned*)(F.ctl + CW_BAR); bar.x = 0; bar.st = nullptr;
    if (MK_ONE_LAUNCH) bar = xcd_barrier_post((unsigned*)(F.ctl + CW_BAR), F.MISC + 8);
    const int lo = args.ph_lo, hi = args.ph_hi;
    unsigned char* ws = args.ws; (void)ws;
    if (IN(0)) { p0_tables(F, args); __syncthreads(); p_wconv_items(F, args, 0, 0, WC_NS); p_wconv_items(F, args, 1, 0, WC_NS); __syncthreads(); p_wconv_gu(F, args, 0, F.vcu, F.G, F.G == 256 ? 256 : WC_NGU); p_wconv_dn(F, args, 0, F.vcu, F.G);
        p_wconv_in(F, args, 0, (F.vcu + F.G - 112) % F.G, F.G); p_wconv_in(F, args, 1, (F.vcu + F.G - 184) % F.G, F.G);
        p_wconv_out(F, args, 0, F.vcu, F.G); p_wconv_out(F, args, 1, (F.vcu + F.G - 32) % F.G, F.G); SEAM(0); }
    layer_body<0>(F, args, bar, lo, hi);
    layer_body<1>(F, args, bar, lo, hi);
#ifdef EXTRA_BARS
    if (MK_ONE_LAUNCH) for (int xb_ = 0; xb_ < EXTRA_BARS; ++xb_) xcd_barrier(bar);
#endif
#undef IN
#undef SEAM
}

extern "C" void kernel_launch(void* const* d_in, const int* in_sizes, int n_in, void* d_out, int out_size, void* d_ws, size_t ws_size, hipStream_t stream) {
    static int grid = 0;
    if (grid == 0) {
        if (n_in != 30 || in_sizes[0] != M * D || out_size != M * D || ws_size < WS_END) { fprintf(stderr, "kernel_launch: unexpected shapes (n_in %d, in0 %d, out %d, ws %zu, need %zu)\n", n_in, n_in > 0 ? in_sizes[0] : -1, out_size, ws_size, (size_t)WS_END); grid = -1; return; }
        int dev = 0, cus = 0, per_cu = 0;
        if (hipGetDevice(&dev) != hipSuccess || hipDeviceGetAttribute(&cus, hipDeviceAttributeMultiprocessorCount, dev) != hipSuccess) { grid = -1; return; }
        if (hipFuncSetAttribute((const void*)mk_fwd, hipFuncAttributeMaxDynamicSharedMemorySize, LDS_BYTES) != hipSuccess) { fprintf(stderr, "kernel_launch: hipFuncSetAttribute failed\n"); grid = -1; return; }
        if (hipOccupancyMaxActiveBlocksPerMultiprocessor(&per_cu, (const void*)mk_fwd, NTHR, LDS_BYTES) != hipSuccess || per_cu < 1) fprintf(stderr, "kernel_launch: occupancy query says %d\n", per_cu);
        (void)hipGetLastError();
        grid = cus;
    }
    if (grid < 0) return;
    if (hipMemsetAsync((char*)d_ws + WS_CTL, 0, CTL_ZERO_BYTES, stream) != hipSuccess) return;
    Args a{};
    for (int i = 0; i < 30; ++i) a.in[i] = d_in[i];
    a.out = (float*)d_out; a.ws = (unsigned char*)d_ws;
#if MK_ONE_LAUNCH
    a.ph_lo = 0; a.ph_hi = N_PHASES; a.li = 0;
    hipLaunchKernelGGL(mk_fwd, dim3(grid), dim3(NTHR), LDS_BYTES, stream, a);
#else
#ifndef REP_GLOBAL
#define REP_GLOBAL -1
#endif
#ifndef PROBE_SKIP
#define PROBE_SKIP 1
#endif
#ifndef REP_COUNT
#define REP_COUNT 2
#endif
    for (int p = 0; p < N_PHASES; ++p) { a.ph_lo = p; a.ph_hi = p + 1; a.li = p;
        const int nrep = ((p == 0 ? 100 : (p - 1) % PH_PER_LAYER) == REP_GLOBAL) ? REP_COUNT : 1;
        for (int r = 0; r < nrep; ++r) { a.pad = r ? PROBE_SKIP : 0; hipLaunchKernelGGL(mk_fwd, dim3(grid), dim3(NTHR), LDS_BYTES, stream, a); } a.pad = 0; }
#endif
}
```

```cpp
#include <hip/hip_runtime.h>
#include <cstdio>
#include <cstdint>
namespace pg8 {
#define PG8_LAS __attribute__((address_space(3)))
typedef unsigned short bf16_t;
typedef short bf16x8 __attribute__((ext_vector_type(8)));
typedef float f32x4 __attribute__((ext_vector_type(4)));
typedef unsigned u32x4 __attribute__((ext_vector_type(4)));
constexpr int BM = 256, BK = 64, HALF = 128, HTB = HALF * BK * 2  , STAGE_BYTES = 8 * HTB, NXCD = 8, WGM = 8;

__host__ __device__ __forceinline__ int lds_byte(int r, int c) { const int st = (r >> 4) * 2 + (c >> 5), rr = r & 15, cc = c & 31, ob = rr * 64 + cc * 2; return st * 1024 + (ob ^ (((ob >> 9) & 1) << 5)); }
__host__ __device__ __forceinline__ void stage_rc(int b, int& R, int& C) { const int st = b / 1024, sb = b % 1024, swz = sb ^ (((sb >> 9) & 1) << 5); R = (st >> 1) * 16 + swz / 64; C = (st & 1) * 32 + (swz % 64) / 2; }
__host__ __device__ __forceinline__ int perm32(int rho) { const int n = rho >> 4, i = rho & 15; return 8 * (i >> 2) + 4 * n + (i & 3); }

__device__ __forceinline__ int opaque_tid() { int t = threadIdx.x; asm volatile("" : "+v"(t)); return t; }
struct Unit { int pm, pn; };
struct Gemm { const bf16_t* A; const bf16_t* Bt; int M, N, K; };

struct StaticOrder {
    int nM, nN, nwg, G, c;
    __host__ __device__ void init(int M, int N, int G_, int c_) { nM = M / BM; nN = N / BM; nwg = nM * nN; G = G_; c = c_; }
    __host__ __device__ bool next(int i, Unit& u) const {
        const long L = (long)i * G + c; if (L >= nwg) return false;
        int wgid = (int)L; { const int q = nwg / NXCD, r = nwg % NXCD, xcd = wgid % NXCD, off = wgid / NXCD; wgid = (xcd < r ? xcd * (q + 1) : r * (q + 1) + (xcd - r) * q) + off; }
        const int nig = WGM * nN, gid = wgid / nig, fm = gid * WGM, gsz = (nM - fm) < WGM ? (nM - fm) : WGM;
        u.pm = fm + ((wgid % nig) % gsz); u.pn = (wgid % nig) / gsz; return true;
    }
    __device__ __forceinline__ void a_ready(const Unit&) const {}
    __device__ __forceinline__ void done(const Unit&) const {}
};

__device__ __forceinline__ unsigned cvt_pk_bf16(float lo, float hi) { unsigned r; asm volatile("v_cvt_pk_bf16_f32 %0, %1, %2" : "=v"(r) : "v"(lo), "v"(hi)); return r; }
template <class Epi, class Sched, bool ALIGN_EPI = false, bool SP2 = false, bool FP8 = false, bool ASC = false>
__device__ __forceinline__ void gemm_phase(PG8_LAS unsigned char* lds, const Gemm g, const Sched& S, const Epi& E, const unsigned char* scm = nullptr, PG8_LAS unsigned char* sct = nullptr) {
    const int tid = opaque_tid(), wid = __builtin_amdgcn_readfirstlane(tid >> 6), lane = tid & 63, wr = wid >> 2, wc = wid & 3, fr = lane & 15, fq = lane >> 4;
    const int K = g.K, nt = K / BK;
    unsigned voffA[2], voffB[2];
#pragma unroll
    for (int i = 0; i < 2; ++i) { int R, C; stage_rc(tid * 16 + i * 8192, R, C); const int Rb = Epi::PERM ? ((R & ~31) + perm32(R & 31)) : R;
        voffA[i] = (unsigned)(R * K + C) * 2u; voffB[i] = (unsigned)(Rb * K + C) * 2u; }
    const size_t kstep = (size_t)(BK * 2);
    const size_t hstep = (size_t)HALF * K * 2;
    const size_t tstep = 2 * hstep;
    const unsigned ldsw = (unsigned)wid * 1024u;
    const int aoff = lds_byte(wr * 64 + fr, fq * 8), boff = lds_byte(wc * 32 + fr, fq * 8);
#define PG8_SA(b, h) (((b) * 2 + (h)) * HTB)
#define PG8_SB(b, h) ((4 + (b) * 2 + (h)) * HTB)
#define PG8_STAGE(bufoff, gbase, voff) do { _Pragma("unroll") for (int _i = 0; _i < 2; ++_i) \
        __builtin_amdgcn_global_load_lds((const unsigned*)((const char*)(gbase) + (voff)[_i]), (PG8_LAS unsigned*)(lds + (bufoff) + ldsw + _i * 8192), 16, 0, 0); } while (0)
#define PG8_LDA(dst, b, h) do { if constexpr (FP8) { _Pragma("unroll") for (int m = 0; m < 4; ++m) { const PG8_LAS unsigned char* p_ = lds + PG8_SA(b, h) + aoff + m * 2048; \
            const i32x4_t lo_ = *(const PG8_LAS i32x4_t*)p_, hi_ = *(const PG8_LAS i32x4_t*)(p_ + 1024); dst##q[m] = __builtin_shufflevector(lo_, hi_, 0, 1, 2, 3, 4, 5, 6, 7); } } \
        else { _Pragma("unroll") for (int m = 0; m < 4; ++m) _Pragma("unroll") for (int k = 0; k < 2; ++k) dst[m][k] = *(const PG8_LAS bf16x8*)(lds + PG8_SA(b, h) + aoff + m * 2048 + k * 1024); } } while (0)
#define PG8_LDB(dst, b, h) do { if constexpr (FP8) { _Pragma("unroll") for (int n = 0; n < 2; ++n) { const PG8_LAS unsigned char* p_ = lds + PG8_SB(b, h) + boff + n * 2048; \
            const i32x4_t lo_ = *(const PG8_LAS i32x4_t*)p_, hi_ = *(const PG8_LAS i32x4_t*)(p_ + 1024); dst##q[n] = __builtin_shufflevector(lo_, hi_, 0, 1, 2, 3, 4, 5, 6, 7); } } \
        else { _Pragma("unroll") for (int n = 0; n < 2; ++n) _Pragma("unroll") for (int k = 0; k < 2; ++k) dst[n][k] = *(const PG8_LAS bf16x8*)(lds + PG8_SB(b, h) + boff + n * 2048 + k * 1024); } } while (0)
#define PG8_MMA(ai, bj, At, Bt, KT) do { __builtin_amdgcn_s_setprio(1); \
        if constexpr (FP8) { _Pragma("unroll") for (int m = 0; m < 4; ++m) _Pragma("unroll") for (int n = 0; n < 2; ++n) { const int o_ = 8 * m + 4 * n; \
                f32x4 c_ = {accq[ai][bj][o_], accq[ai][bj][o_ + 1], accq[ai][bj][o_ + 2], accq[ai][bj][o_ + 3]}; \
                if constexpr (ASC) c_ = __builtin_amdgcn_mfma_scale_f32_16x16x128_f8f6f4(Bt##q[n], At##q[m], c_, 0, 0, 0, 0x7f7f7f7f, KT, (int)sca[ai][m]); \
                else c_ = __builtin_amdgcn_mfma_scale_f32_16x16x128_f8f6f4(Bt##q[n], At##q[m], c_, 0, 0, 0, 0x7f7f7f7f, 0, 0x7f7f7f7f); \
                accq[ai][bj][o_] = c_[0]; accq[ai][bj][o_ + 1] = c_[1]; accq[ai][bj][o_ + 2] = c_[2]; accq[ai][bj][o_ + 3] = c_[3]; } } \
        else { _Pragma("unroll") for (int m = 0; m < 4; ++m) _Pragma("unroll") for (int n = 0; n < 2; ++n) _Pragma("unroll") for (int k = 0; k < 2; ++k) \
            acc[ai][bj][m][n] = __builtin_amdgcn_mfma_f32_16x16x32_bf16(Bt[n][k], At[m][k], acc[ai][bj][m][n], 0, 0, 0); } \
        __builtin_amdgcn_s_setprio(0); } while (0)
#define PG8_WAIT_V(n) asm volatile("s_waitcnt vmcnt(" #n ")" ::: "memory")
#define PG8_WAIT_L(n) asm volatile("s_waitcnt lgkmcnt(" #n ")" ::: "memory")
#define PG8_BAR __builtin_amdgcn_s_barrier()
#define PG8_SCHED __builtin_amdgcn_sched_barrier(0)
    Unit cur, nxt; int ui = 0;
    if (!S.next(0, cur)) return;
    f32x4 acc[2][2][4][2];
    typedef float f32x32_t __attribute__((ext_vector_type(32)));
    f32x32_t accq[2][2];
    if constexpr (FP8) { accq[0][0] = (f32x32_t)(0.f); accq[0][1] = (f32x32_t)(0.f); accq[1][0] = (f32x32_t)(0.f); accq[1][1] = (f32x32_t)(0.f); } (void)accq;
#pragma unroll
    for (int a = 0; a < 2; ++a)
#pragma unroll
        for (int b = 0; b < 2; ++b)
#pragma unroll
            for (int m = 0; m < 4; ++m)
#pragma unroll
                for (int n = 0; n < 2; ++n) acc[a][b][m][n] = (f32x4){0.f, 0.f, 0.f, 0.f};
    typedef int v8i_t __attribute__((ext_vector_type(8))); typedef int i32x4_t __attribute__((ext_vector_type(4)));
    bf16x8 At[4][2], B0[2][2], B1[2][2]; v8i_t Atq[4], B0q[2], B1q[2];
    (void)At; (void)B0; (void)B1; (void)Atq; (void)B0q; (void)B1q;
    unsigned sca[2][4]; (void)sca; int par = 0; (void)par;
#define PG8_LDSC(PAR, KH) do { if constexpr (ASC) { _Pragma("unroll") for (int a_ = 0; a_ < 2; ++a_) _Pragma("unroll") for (int m_ = 0; m_ < 4; ++m_) { \
        const PG8_LAS unsigned* sp_ = (const PG8_LAS unsigned*)(sct + (PAR) * 8192 + (KH) * 4096 + (wr * 64 + a_ * HALF + m_ * 16 + fr) * 4); const unsigned sh_ = (unsigned)fq * 8u; \
        sca[a_][m_] = ((sp_[0] >> sh_) & 0xffu) | (((sp_[256] >> sh_) & 0xffu) << 8) | (((sp_[512] >> sh_) & 0xffu) << 16) | ((sp_[768] >> sh_) << 24); } } } while (0)
#define PG8_SCDMA(u, PAR) do { if constexpr (ASC) __builtin_amdgcn_global_load_lds((const unsigned*)(scm + (size_t)(u).pm * 8192 + wid * 1024 + (opaque_tid() & 63) * 16), (PG8_LAS unsigned*)(sct + (PAR) * 8192 + wid * 1024), 16, 0, 0); } while (0)
    const char* cA = (const char*)g.A + (size_t)cur.pm * tstep; const char* cB = (const char*)g.Bt + (size_t)cur.pn * tstep;
    S.a_ready(cur); PG8_SCDMA(cur, 0);
    if constexpr (SP2) {
        PG8_STAGE(PG8_SB(0, 0), cB, voffB); PG8_STAGE(PG8_SB(0, 1), cB + hstep, voffB); PG8_STAGE(PG8_SA(0, 0), cA, voffA); PG8_STAGE(PG8_SA(0, 1), cA + hstep, voffA);
        if (wr == 1) PG8_BAR;
        PG8_WAIT_V(2); PG8_BAR;
        PG8_STAGE(PG8_SB(1, 0), cB + kstep, voffB); PG8_STAGE(PG8_SA(1, 0), cA + kstep, voffA); PG8_STAGE(PG8_SB(1, 1), cB + hstep + kstep, voffB);
        PG8_WAIT_V(6); PG8_BAR;
    } else {
        PG8_STAGE(PG8_SB(0, 0), cB, voffB); PG8_STAGE(PG8_SA(0, 0), cA, voffA); PG8_STAGE(PG8_SB(0, 1), cB + hstep, voffB); PG8_STAGE(PG8_SA(0, 1), cA + hstep, voffA);
        if (wr == 1) PG8_BAR;
        PG8_WAIT_V(4); PG8_BAR;
        PG8_STAGE(PG8_SB(1, 0), cB + kstep, voffB); PG8_STAGE(PG8_SA(1, 0), cA + kstep, voffA); PG8_STAGE(PG8_SB(1, 1), cB + hstep + kstep, voffB);
        PG8_WAIT_V(6); PG8_BAR;
    }
    PG8_LDSC(0, 0);
    for (;;) {
        const bool has_next = S.next(ui + 1, nxt);
        const char* nA = has_next ? (const char*)g.A + (size_t)nxt.pm * tstep : cA; const char* nB = has_next ? (const char*)g.Bt + (size_t)nxt.pn * tstep : cB;
#pragma unroll 1
        for (int t = 0; t < nt; t += 2) {
            const bool last = (t == nt - 2);
            const char* a1 = cA + (size_t)(t + 1) * kstep;
            const char* a2 = last ? nA : cA + (size_t)(t + 2) * kstep; const char* b2 = last ? nB : cB + (size_t)(t + 2) * kstep;
            const char* a3 = a2 + kstep; const char* b3 = b2 + kstep;
            if (last && has_next) { S.a_ready(nxt); PG8_SCDMA(nxt, par ^ 1); }
            if constexpr (ASC) { if (t == 4) PG8_LDSC(par, 1); }
            if constexpr (SP2) {
            PG8_LDB(B0, 0, 0); PG8_LDB(B1, 0, 1); PG8_SCHED; PG8_LDA(At, 0, 0); PG8_STAGE(PG8_SA(1, 1), a1 + hstep, voffA);
            PG8_WAIT_V(8); PG8_WAIT_L(0); PG8_BAR; PG8_MMA(0, 0, At, B0, 0); PG8_MMA(0, 1, At, B1, 0); PG8_BAR; PG8_SCHED;
            PG8_LDA(At, 0, 1); PG8_STAGE(PG8_SB(0, 0), b2, voffB); PG8_STAGE(PG8_SB(0, 1), b2 + hstep, voffB); PG8_STAGE(PG8_SA(0, 0), a2, voffA);
            PG8_WAIT_V(8); PG8_WAIT_L(0); PG8_BAR; PG8_MMA(1, 0, At, B0, 0); PG8_MMA(1, 1, At, B1, 0); PG8_BAR; PG8_SCHED;
            PG8_LDB(B0, 1, 0); PG8_LDB(B1, 1, 1); PG8_SCHED; PG8_LDA(At, 1, 0); PG8_STAGE(PG8_SA(0, 1), a2 + hstep, voffA);
            PG8_WAIT_V(8); PG8_WAIT_L(0); PG8_BAR; PG8_MMA(0, 0, At, B0, 1); PG8_MMA(0, 1, At, B1, 1); PG8_BAR; PG8_SCHED;
            PG8_LDA(At, 1, 1); PG8_STAGE(PG8_SB(1, 0), b3, voffB); PG8_STAGE(PG8_SB(1, 1), b3 + hstep, voffB); PG8_STAGE(PG8_SA(1, 0), a3, voffA);
            PG8_WAIT_V(8); PG8_WAIT_L(0); PG8_BAR; PG8_MMA(1, 0, At, B0, 1); PG8_MMA(1, 1, At, B1, 1); PG8_BAR; PG8_SCHED;
            } else {
            PG8_LDB(B0, 0, 0); PG8_SCHED; PG8_LDA(At, 0, 0); PG8_STAGE(PG8_SA(1, 1), a1 + hstep, voffA);
            PG8_WAIT_L(8); PG8_BAR; PG8_WAIT_L(0); PG8_MMA(0, 0, At, B0, 0); PG8_BAR; PG8_SCHED;
            PG8_LDB(B1, 0, 1); PG8_STAGE(PG8_SB(0, 0), b2, voffB);
            PG8_BAR; PG8_WAIT_L(0); PG8_MMA(0, 1, At, B1, 0); PG8_BAR;
            PG8_LDA(At, 0, 1); PG8_STAGE(PG8_SA(0, 0), a2, voffA);
            PG8_BAR; PG8_WAIT_L(0); PG8_MMA(1, 0, At, B0, 0); PG8_BAR; PG8_SCHED;
            PG8_STAGE(PG8_SB(0, 1), b2 + hstep, voffB);
            PG8_WAIT_V(6); PG8_BAR; PG8_MMA(1, 1, At, B1, 0); PG8_BAR;
            PG8_LDB(B0, 1, 0); PG8_SCHED; PG8_LDA(At, 1, 0); PG8_STAGE(PG8_SA(0, 1), a2 + hstep, voffA);
            PG8_WAIT_L(8); PG8_BAR; PG8_WAIT_L(0); PG8_MMA(0, 0, At, B0, 1); PG8_BAR; PG8_SCHED;
            PG8_LDB(B1, 1, 1); PG8_STAGE(PG8_SB(1, 0), b3, voffB);
            PG8_BAR; PG8_WAIT_L(0); PG8_MMA(0, 1, At, B1, 1); PG8_BAR;
            PG8_LDA(At, 1, 1); PG8_STAGE(PG8_SA(1, 0), a3, voffA);
            PG8_BAR; PG8_WAIT_L(0); PG8_MMA(1, 0, At, B0, 1); PG8_BAR; PG8_SCHED;
            PG8_STAGE(PG8_SB(1, 1), b3 + hstep, voffB);
            PG8_WAIT_V(6); PG8_BAR; PG8_MMA(1, 1, At, B1, 1); PG8_BAR;
            }
            if constexpr (ASC) { _Pragma("unroll") for (int a_ = 0; a_ < 2; ++a_) _Pragma("unroll") for (int m_ = 0; m_ < 4; ++m_) sca[a_][m_] >>= 16; }
        }
        if constexpr (ALIGN_EPI) { if (wr == 0) PG8_BAR; }
        if constexpr (FP8) {
#pragma unroll
            for (int a = 0; a < 2; ++a)
#pragma unroll
                for (int b = 0; b < 2; ++b)
#pragma unroll
                    for (int m = 0; m < 4; ++m)
#pragma unroll
                        for (int n = 0; n < 2; ++n) { const int o_ = 8 * m + 4 * n; acc[a][b][m][n] = (f32x4){accq[a][b][o_], accq[a][b][o_ + 1], accq[a][b][o_ + 2], accq[a][b][o_ + 3]}; }
        }
        if constexpr (!Epi::AFTER_DRAIN) { E(acc, cur, wr, wc, fr, fq); S.done(cur); }
        if (!has_next) break;
#pragma unroll
        for (int a = 0; a < 2; ++a)
#pragma unroll
            for (int b = 0; b < 2; ++b)
#pragma unroll
                for (int m = 0; m < 4; ++m)
#pragma unroll
                    for (int n = 0; n < 2; ++n) acc[a][b][m][n] = (f32x4){0.f, 0.f, 0.f, 0.f};
        if constexpr (FP8) { accq[0][0] = (f32x32_t)(0.f); accq[0][1] = (f32x32_t)(0.f); accq[1][0] = (f32x32_t)(0.f); accq[1][1] = (f32x32_t)(0.f); }
        cur = nxt; cA = nA; cB = nB; ++ui; par ^= 1; PG8_LDSC(par, 0);
        if constexpr (ALIGN_EPI) { if (wr == 1) PG8_BAR; }
    }
    PG8_WAIT_V(0);
    if constexpr (!ALIGN_EPI) { if (wr == 0) PG8_BAR; }
    PG8_BAR;
    if constexpr (Epi::AFTER_DRAIN) { E.fused(acc, cur, wr, wc, fr, fq, lds, wid, lane); S.done(cur); }
#undef PG8_SA
#undef PG8_SB
#undef PG8_STAGE
#undef PG8_LDSC
#undef PG8_SCDMA
#undef PG8_LDA
#undef PG8_LDB
#undef PG8_MMA
#undef PG8_WAIT_V
#undef PG8_WAIT_L
#undef PG8_BAR
#undef PG8_SCHED
}
template <class Epi, class Sched, bool ALIGN_EPI = false, bool SP2 = false, int AUXA = 0, bool FP8 = false, bool ASC = false>
__device__ __forceinline__ void gemm_phase_g(PG8_LAS unsigned char* lds, PG8_LAS unsigned char* gt, const Gemm g, const Sched& S, const Epi& E) {
    const int tid = opaque_tid(), wid = __builtin_amdgcn_readfirstlane(tid >> 6), lane = tid & 63, wr = wid >> 2, wc = wid & 3, fr = lane & 15, fq = lane >> 4;
    const int K = g.K, nt = K / BK;
    unsigned gpk0, voffB[2];
#pragma unroll
    for (int i = 0; i < 2; ++i) { int R, C; stage_rc(tid * 16 + i * 8192, R, C); const int Rb = Epi::PERM ? ((R & ~31) + perm32(R & 31)) : R;
        if (i == 0) gpk0 = (unsigned)(R * 4) | ((unsigned)(C * 2) << 16); voffB[i] = (unsigned)(Rb * K + C) * 2u; }
    int par = 0;
    const size_t kstep = (size_t)(BK * 2);
    const size_t hstep = (size_t)HALF * K * 2;
    const size_t tstep = 2 * hstep;
    const unsigned ldsw = (unsigned)wid * 1024u;
    const int aoff = lds_byte(wr * 64 + fr, fq * 8), boff = lds_byte(wc * 32 + fr, fq * 8);
#define PG8_SA(b, h) (((b) * 2 + (h)) * HTB)
#define PG8_SB(b, h) ((4 + (b) * 2 + (h)) * HTB)
#define PG8_STAGE(bufoff, gbase, voff) do { _Pragma("unroll") for (int _i = 0; _i < 2; ++_i) \
        __builtin_amdgcn_global_load_lds((const unsigned*)((const char*)(gbase) + (voff)[_i]), (PG8_LAS unsigned*)(lds + (bufoff) + ldsw + _i * 8192), 16, 0, 0); } while (0)
#define PG8_STAGE_A(bufoff, h, kbyte, PAR) do { _Pragma("unroll") for (int _i = 0; _i < 2; ++_i) { \
        const unsigned _vo = *(const PG8_LAS unsigned*)(gt + ((PAR) * 768 + (h) * 128 + _i * 64) * 4 + (gpk0 & 0xffffu)) + (gpk0 >> 16); \
        __builtin_amdgcn_global_load_lds((const unsigned*)((const char*)g.A + (size_t)(kbyte) + _vo), (PG8_LAS unsigned*)(lds + (bufoff) + ldsw + _i * 8192), 16, 0, AUXA); } } while (0)
#define PG8_FILL(u, PAR, PF, UI) do { S.wait_ready(u, tid, PF); if (tid < 256) { unsigned o_, a0_, a1_; S.finish_meta(u, tid, PF, o_, a0_, a1_); PG8_LAS unsigned* t_ = (PG8_LAS unsigned*)(gt + ((PAR) * 768 + tid) * 4); t_[0] = o_; t_[256] = a0_; t_[512] = a1_; } S.pull_publish(tid, PF, UI); asm volatile("s_waitcnt lgkmcnt(0)" ::: "memory"); __builtin_amdgcn_s_barrier(); asm volatile("" ::: "memory"); \
        if constexpr (ASC) { if (wid < 4) __builtin_amdgcn_global_load_lds((const unsigned*)(S.scale_base(u) + wid * 1024 + (opaque_tid() & 63) * 16), (PG8_LAS unsigned*)(gt + 6144 + (PAR) * 4096 + wid * 1024), 16, 0, 0); } } while (0)
#define PG8_LDA(dst, b, h) do { if constexpr (FP8) { _Pragma("unroll") for (int m = 0; m < 4; ++m) { const PG8_LAS unsigned char* p_ = lds + PG8_SA(b, h) + aoff + m * 2048; \
            const i32x4_t lo_ = *(const PG8_LAS i32x4_t*)p_, hi_ = *(const PG8_LAS i32x4_t*)(p_ + 1024); dst##q[m] = __builtin_shufflevector(lo_, hi_, 0, 1, 2, 3, 4, 5, 6, 7); } } \
        else { _Pragma("unroll") for (int m = 0; m < 4; ++m) _Pragma("unroll") for (int k = 0; k < 2; ++k) dst[m][k] = *(const PG8_LAS bf16x8*)(lds + PG8_SA(b, h) + aoff + m * 2048 + k * 1024); } } while (0)
#define PG8_LDB(dst, b, h) do { if constexpr (FP8) { _Pragma("unroll") for (int n = 0; n < 2; ++n) { const PG8_LAS unsigned char* p_ = lds + PG8_SB(b, h) + boff + n * 2048; \
            const i32x4_t lo_ = *(const PG8_LAS i32x4_t*)p_, hi_ = *(const PG8_LAS i32x4_t*)(p_ + 1024); dst##q[n] = __builtin_shufflevector(lo_, hi_, 0, 1, 2, 3, 4, 5, 6, 7); } } \
        else { _Pragma("unroll") for (int n = 0; n < 2; ++n) _Pragma("unroll") for (int k = 0; k < 2; ++k) dst[n][k] = *(const PG8_LAS bf16x8*)(lds + PG8_SB(b, h) + boff + n * 2048 + k * 1024); } } while (0)
#define PG8_MMA(ai, bj, At, Bt, KT) do { __builtin_amdgcn_s_setprio(1); \
        if constexpr (FP8) { _Pragma("unroll") for (int m = 0; m < 4; ++m) _Pragma("unroll") for (int n = 0; n < 2; ++n) { const int o_ = 8 * m + 4 * n; \
                f32x4 c_ = {accq[ai][bj][o_], accq[ai][bj][o_ + 1], accq[ai][bj][o_ + 2], accq[ai][bj][o_ + 3]}; \
                if constexpr (ASC) c_ = __builtin_amdgcn_mfma_scale_f32_16x16x128_f8f6f4(Bt##q[n], At##q[m], c_, 0, 0, 0, 0x7f7f7f7f, KT, (int)sca[ai][m]); \
                else c_ = __builtin_amdgcn_mfma_scale_f32_16x16x128_f8f6f4(Bt##q[n], At##q[m], c_, 0, 0, 0, 0x7f7f7f7f, 0, 0x7f7f7f7f); \
                accq[ai][bj][o_] = c_[0]; accq[ai][bj][o_ + 1] = c_[1]; accq[ai][bj][o_ + 2] = c_[2]; accq[ai][bj][o_ + 3] = c_[3]; } } \
        else { _Pragma("unroll") for (int m = 0; m < 4; ++m) _Pragma("unroll") for (int n = 0; n < 2; ++n) _Pragma("unroll") for (int k = 0; k < 2; ++k) \
            acc[ai][bj][m][n] = __builtin_amdgcn_mfma_f32_16x16x32_bf16(Bt[n][k], At[m][k], acc[ai][bj][m][n], 0, 0, 0); } \
        __builtin_amdgcn_s_setprio(0); } while (0)
#define PG8_WAIT_V(n) asm volatile("s_waitcnt vmcnt(" #n ")" ::: "memory")
#define PG8_WAIT_L(n) asm volatile("s_waitcnt lgkmcnt(" #n ")" ::: "memory")
#define PG8_BAR __builtin_amdgcn_s_barrier()
#define PG8_SCHED __builtin_amdgcn_sched_barrier(0)
    Unit cur, nxt; int ui = 0;
    if (!__builtin_amdgcn_readfirstlane((int)S.first(cur))) return;
    cur.pm = __builtin_amdgcn_readfirstlane(cur.pm); cur.pn = __builtin_amdgcn_readfirstlane(cur.pn);
    f32x4 acc[2][2][4][2];
    typedef float f32x32_t __attribute__((ext_vector_type(32)));
    f32x32_t accq[2][2];
    if constexpr (FP8) { accq[0][0] = (f32x32_t)(0.f); accq[0][1] = (f32x32_t)(0.f); accq[1][0] = (f32x32_t)(0.f); accq[1][1] = (f32x32_t)(0.f); } (void)accq;
#pragma unroll
    for (int a = 0; a < 2; ++a)
#pragma unroll
        for (int b = 0; b < 2; ++b)
#pragma unroll
            for (int m = 0; m < 4; ++m)
#pragma unroll
                for (int n = 0; n < 2; ++n) acc[a][b][m][n] = (f32x4){0.f, 0.f, 0.f, 0.f};
    typedef int v8i_t __attribute__((ext_vector_type(8))); typedef int i32x4_t __attribute__((ext_vector_type(4)));
    bf16x8 At[4][2], B0[2][2], B1[2][2]; v8i_t Atq[4], B0q[2], B1q[2];
    (void)At; (void)B0; (void)B1; (void)Atq; (void)B0q; (void)B1q;
    unsigned sca[2][4]; (void)sca;
#define PG8_LDSC(PAR) do { if constexpr (ASC) { _Pragma("unroll") for (int a_ = 0; a_ < 2; ++a_) _Pragma("unroll") for (int m_ = 0; m_ < 4; ++m_) { \
        const PG8_LAS unsigned* sp_ = (const PG8_LAS unsigned*)(gt + 6144 + (PAR) * 4096 + (wr * 64 + a_ * HALF + m_ * 16 + fr) * 4); const unsigned sh_ = (unsigned)fq * 8u; \
        sca[a_][m_] = ((sp_[0] >> sh_) & 0xffu) | (((sp_[256] >> sh_) & 0xffu) << 8) | (((sp_[512] >> sh_) & 0xffu) << 16) | ((sp_[768] >> sh_) << 24); } } } while (0)
    const char* cB = (const char*)g.Bt + (size_t)cur.pn * tstep;
    typename Sched::Pf pf; S.prefetch(cur, tid, pf); PG8_FILL(cur, 0, pf, -1);
    Unit pend; bool has_pend = false;
    if constexpr (SP2) {
        PG8_STAGE(PG8_SB(0, 0), cB, voffB); PG8_STAGE(PG8_SB(0, 1), cB + hstep, voffB); PG8_STAGE_A(PG8_SA(0, 0), 0, 0, par); PG8_STAGE_A(PG8_SA(0, 1), 1, 0, par);
        if (wr == 1) PG8_BAR;
        PG8_WAIT_V(2); PG8_BAR;
        PG8_STAGE(PG8_SB(1, 0), cB + kstep, voffB); PG8_STAGE_A(PG8_SA(1, 0), 0, kstep, par); PG8_STAGE(PG8_SB(1, 1), cB + hstep + kstep, voffB);
        PG8_WAIT_V(6); PG8_BAR;
    } else {
        PG8_STAGE(PG8_SB(0, 0), cB, voffB); PG8_STAGE_A(PG8_SA(0, 0), 0, 0, par); PG8_STAGE(PG8_SB(0, 1), cB + hstep, voffB); PG8_STAGE_A(PG8_SA(0, 1), 1, 0, par);
        if (wr == 1) PG8_BAR;
        PG8_WAIT_V(4); PG8_BAR;
        PG8_STAGE(PG8_SB(1, 0), cB + kstep, voffB); PG8_STAGE_A(PG8_SA(1, 0), 0, kstep, par); PG8_STAGE(PG8_SB(1, 1), cB + hstep + kstep, voffB);
        PG8_WAIT_V(6); PG8_BAR;
    }
    PG8_LDSC(0);
    for (;;) {
        const bool has_next = __builtin_amdgcn_readfirstlane((int)S.more(ui + 1, nxt)) != 0;
        nxt.pm = __builtin_amdgcn_readfirstlane(nxt.pm); nxt.pn = __builtin_amdgcn_readfirstlane(nxt.pn);
        if (has_next) { S.prefetch(nxt, tid, pf); S.pull_issue(tid, pf); }
        const char* nB = has_next ? (const char*)g.Bt + (size_t)nxt.pn * tstep : cB;
#pragma unroll 1
        for (int t = 0; t < nt; t += 2) {
            const bool last = (t == nt - 2);
            const char* b2 = last ? nB : cB + (size_t)(t + 2) * kstep;
            const char* b3 = b2 + kstep;
            if (last && has_next) PG8_FILL(nxt, par ^ 1, pf, ui);
            const size_t kA2 = last ? (size_t)0 : (size_t)(t + 2) * kstep; const int pA2 = (last && has_next) ? (par ^ 1) : par;
            if constexpr (SP2) {
            PG8_LDB(B0, 0, 0); PG8_LDB(B1, 0, 1); PG8_SCHED; PG8_LDA(At, 0, 0); PG8_STAGE_A(PG8_SA(1, 1), 1, (size_t)(t + 1) * kstep, par);
            PG8_WAIT_V(8); PG8_WAIT_L(0); PG8_BAR; PG8_MMA(0, 0, At, B0, 0); PG8_MMA(0, 1, At, B1, 0); PG8_BAR; PG8_SCHED;
            PG8_LDA(At, 0, 1); PG8_STAGE(PG8_SB(0, 0), b2, voffB); PG8_STAGE(PG8_SB(0, 1), b2 + hstep, voffB); PG8_STAGE_A(PG8_SA(0, 0), 0, kA2, pA2);
            PG8_WAIT_V(8); PG8_WAIT_L(0); PG8_BAR; PG8_MMA(1, 0, At, B0, 0); PG8_MMA(1, 1, At, B1, 0); PG8_BAR; PG8_SCHED;
            PG8_LDB(B0, 1, 0); PG8_LDB(B1, 1, 1); PG8_SCHED; PG8_LDA(At, 1, 0); PG8_STAGE_A(PG8_SA(0, 1), 1, kA2, pA2);
            PG8_WAIT_V(8); PG8_WAIT_L(0); PG8_BAR; PG8_MMA(0, 0, At, B0, 1); PG8_MMA(0, 1, At, B1, 1); PG8_BAR; PG8_SCHED;
            PG8_LDA(At, 1, 1); PG8_STAGE(PG8_SB(1, 0), b3, voffB); PG8_STAGE(PG8_SB(1, 1), b3 + hstep, voffB); PG8_STAGE_A(PG8_SA(1, 0), 0, kA2 + kstep, pA2);
            PG8_WAIT_V(8); PG8_WAIT_L(0); PG8_BAR; PG8_MMA(1, 0, At, B0, 1); PG8_MMA(1, 1, At, B1, 1); PG8_BAR; PG8_SCHED;
            } else {
            PG8_LDB(B0, 0, 0); PG8_SCHED; PG8_LDA(At, 0, 0); PG8_STAGE_A(PG8_SA(1, 1), 1, (size_t)(t + 1) * kstep, par);
            PG8_WAIT_L(8); PG8_BAR; PG8_WAIT_L(0); PG8_MMA(0, 0, At, B0, 0); PG8_BAR; PG8_SCHED;
            PG8_LDB(B1, 0, 1); PG8_STAGE(PG8_SB(0, 0), b2, voffB);
            PG8_BAR; PG8_WAIT_L(0); PG8_MMA(0, 1, At, B1, 0); PG8_BAR;
            PG8_LDA(At, 0, 1); PG8_STAGE_A(PG8_SA(0, 0), 0, kA2, pA2);
            PG8_BAR; PG8_WAIT_L(0); PG8_MMA(1, 0, At, B0, 0); PG8_BAR; PG8_SCHED;
            PG8_STAGE(PG8_SB(0, 1), b2 + hstep, voffB);
            PG8_WAIT_V(6); PG8_BAR; PG8_MMA(1, 1, At, B1, 0); PG8_BAR;
            PG8_LDB(B0, 1, 0); PG8_SCHED; PG8_LDA(At, 1, 0); PG8_STAGE_A(PG8_SA(0, 1), 1, kA2, pA2);
            PG8_WAIT_L(8); PG8_BAR; PG8_WAIT_L(0); PG8_MMA(0, 0, At, B0, 1); PG8_BAR; PG8_SCHED;
            PG8_LDB(B1, 1, 1); PG8_STAGE(PG8_SB(1, 0), b3, voffB);
            PG8_BAR; PG8_WAIT_L(0); PG8_MMA(0, 1, At, B1, 1); PG8_BAR;
            PG8_LDA(At, 1, 1); PG8_STAGE_A(PG8_SA(1, 0), 0, kA2 + kstep, pA2);
            PG8_BAR; PG8_WAIT_L(0); PG8_MMA(1, 0, At, B0, 1); PG8_BAR; PG8_SCHED;
            PG8_STAGE(PG8_SB(1, 1), b3 + hstep, voffB);
            PG8_WAIT_V(6); PG8_BAR; PG8_MMA(1, 1, At, B1, 1); PG8_BAR;
            }
            if constexpr (ASC) { _Pragma("unroll") for (int a_ = 0; a_ < 2; ++a_) _Pragma("unroll") for (int m_ = 0; m_ < 4; ++m_) sca[a_][m_] >>= 16; }
        }
        if constexpr (ALIGN_EPI) { if (wr == 0) PG8_BAR; }
        if constexpr (FP8) {
#pragma unroll
            for (int a = 0; a < 2; ++a)
#pragma unroll
                for (int b = 0; b < 2; ++b)
#pragma unroll
                    for (int m = 0; m < 4; ++m)
#pragma unroll
                        for (int n = 0; n < 2; ++n) { const int o_ = 8 * m + 4 * n; acc[a][b][m][n] = (f32x4){accq[a][b][o_], accq[a][b][o_ + 1], accq[a][b][o_ + 2], accq[a][b][o_ + 3]}; }
        }
        if constexpr (!Epi::AFTER_DRAIN) { if (has_pend) S.done_nowait(pend);     E(acc, cur, wr, wc, fr, fq, (const PG8_LAS unsigned*)(gt + par * 3072)); pend = cur; has_pend = true; }
        if (!has_next) break;
#pragma unroll
        for (int a = 0; a < 2; ++a)
#pragma unroll
            for (int b = 0; b < 2; ++b)
#pragma unroll
                for (int m = 0; m < 4; ++m)
#pragma unroll
                    for (int n = 0; n < 2; ++n) acc[a][b][m][n] = (f32x4){0.f, 0.f, 0.f, 0.f};
        if constexpr (FP8) { accq[0][0] = (f32x32_t)(0.f); accq[0][1] = (f32x32_t)(0.f); accq[1][0] = (f32x32_t)(0.f); accq[1][1] = (f32x32_t)(0.f); }
        cur = nxt; cB = nB; ++ui; par ^= 1; PG8_LDSC(par);
        if constexpr (ALIGN_EPI) { if (wr == 1) PG8_BAR; }
    }
    PG8_WAIT_V(0);
    if constexpr (!ALIGN_EPI) { if (wr == 0) PG8_BAR; }
    PG8_BAR;
    if (has_pend) S.done_nowait(pend);
#undef PG8_SA
#undef PG8_SB
#undef PG8_STAGE
#undef PG8_STAGE_A
#undef PG8_FILL
#undef PG8_LDSC
#undef PG8_LDA
#undef PG8_LDB
#undef PG8_MMA
#undef PG8_WAIT_V
#undef PG8_WAIT_L
#undef PG8_BAR
#undef PG8_SCHED
}
}

#ifndef PG8_SP2
#define PG8_SP2 true
#endif
#ifndef PG8_ALIGN
#define PG8_ALIGN true
#endif
#ifndef MK_ONE_LAUNCH
#define MK_ONE_LAUNCH 1
#endif

constexpr int NWAVES = 8, NTHR = 512;
constexpr int BATCH = 8, T = 4096, D = 1024, M = BATCH * T, DEPTH = 2;
constexpr int PROJW = 2304, AW = 256, BW = 512, CW = 256, NH = 8, HD = 64;
constexpr int COL_U = 0, COL_V = 256, COL_Q = 512, COL_K = 1024, COL_VA = 1536, COL_S = 2048;
constexpr int NEXP = 16, DEXP = 512, NGRP = 4;
constexpr int SSM_G = 16, SSM_N = 64, SSM_C = 16;
constexpr float LN_EPS = 1e-5f;
constexpr float ALPHA = 1.41421356237309515f;
constexpr float QSCALE = 0.125f * 1.4426950408889634f;
constexpr int NSLOT_MAX = 2 * M + NEXP * 256;

constexpr size_t MiB = 1u << 20;
constexpr size_t WS_CTL = 0, CTL_ZERO_BYTES = 1 * MiB;
constexpr size_t WS_MOD = 1 * MiB;
constexpr size_t WS_ROPE = WS_MOD + 512 * 1024;
constexpr size_t WS_SSM = WS_ROPE + 2 * MiB;
constexpr int SSM_TAB = 2 * 1024 + 2 * 16384;
constexpr int SLOT_CAP = 32768;
constexpr size_t WS_SLOT_A = 4 * MiB;
constexpr size_t WS_WSMALL = 6 * MiB;
constexpr size_t WSMALL_LAYER = 7 * MiB, WOFF_IN = 0, WOFF_OUT = (size_t)PROJW * D * 2, WOFF_GLU = WOFF_OUT + (size_t)D * D * 2;
constexpr size_t WS_WGU = 20 * MiB;
constexpr size_t WS_WD = 52 * MiB;
constexpr size_t WS_XN = 68 * MiB;
constexpr size_t WS_YG = 132 * MiB;
constexpr size_t WS_R = 148 * MiB;
constexpr size_t WS_PROJ = WS_R, WS_MIXCAT = WS_R + 144 * MiB, WS_PRE = WS_R, WS_HID = WS_R + 64 * MiB, WS_X1 = WS_R + 132 * MiB;
constexpr size_t WS_HSC = WS_HID + 36 * MiB;
constexpr size_t WS_ROWS2 = 356 * MiB;
constexpr size_t WS_STAT = 356 * MiB + (size_t)2 * M * D * 2;
constexpr size_t WS_SSM2 = WS_STAT + 4 * MiB;
constexpr size_t SSM2_LAYER = 3 * MiB, S2_APW = 0, S2_KT = 288 * 1024, S2_CT = S2_KT + 256 * 1024, S2_WIN = S2_CT + 64 * 1024, S2_GW = S2_WIN + 2 * MiB;
static_assert(S2_GW + 4 * 128 * 128 * 2 <= SSM2_LAYER, "ssm2 tables");
constexpr size_t WS_XLOC = WS_SSM2 + 2 * SSM2_LAYER;
constexpr size_t WS_XSUP = WS_XLOC + 8 * MiB;
constexpr size_t WS_SLOT_W = WS_XSUP + 512 * 1024;
constexpr size_t WS_CINV = WS_SLOT_W + 2 * MiB;
constexpr size_t WS_CINV_IN = WS_CINV + 128 * 1024;
constexpr size_t WS_CINV_D = WS_CINV + 256 * 1024;
constexpr size_t WS_SA = WS_CINV + 384 * 1024;
constexpr size_t WS_SCM = WS_SA + 128 * 1024;
constexpr size_t WS_CINV_O = WS_SCM + 1 * MiB;
constexpr size_t WS_SCR = WS_CINV_O + 128 * 1024;
constexpr size_t WS_GVC = WS_CINV_O + 16 * 1024;
constexpr size_t WS_PSC = WS_SCR + 2 * MiB;
constexpr size_t WS_END = WS_PSC + 1 * MiB;
static_assert(WOFF_GLU + 256 * 256 * 2 <= WSMALL_LAYER && WS_WSMALL + 2 * WSMALL_LAYER <= WS_WGU, "ws map");
static_assert(WS_SSM + 2 * SSM_TAB * 4 <= WS_SLOT_A && WS_HID + (size_t)NSLOT_MAX * DEXP * 2 <= WS_X1 && WS_X1 + (size_t)M * D * 2 <= WS_ROWS2, "ws map 2");
constexpr int CW_TMO = 0;
constexpr int CW_BAR = 4096;
constexpr int CW_CNT = 8192;
constexpr int CW_QUEUE = 11264;
constexpr int CW_DONE = 12288;

constexpr int RING_OFF = 0, RING_BYTES = 131072;
constexpr int ATT_STAGE_OFF = 98304;
constexpr int LDSCTL_OFF = 135168, MISC_OFF = LDSCTL_OFF + 320;
constexpr int GT_OFF = LDSCTL_OFF + 1024;
constexpr int SCT_OFF = GT_OFF + 6144;
constexpr int LDS_BYTES = 158720;

#define GAS __attribute__((address_space(1)))
#define LAS __attribute__((address_space(3)))
#define DI __device__ __forceinline__
typedef unsigned short bf16;
typedef unsigned v4u __attribute__((ext_vector_type(4)));
typedef unsigned v2u __attribute__((ext_vector_type(2)));
typedef float f32x4 __attribute__((ext_vector_type(4)));
typedef short bf16x8 __attribute__((ext_vector_type(8)));
typedef GAS unsigned gu32;
#define RLX_AGENT __ATOMIC_RELAXED, __HIP_MEMORY_SCOPE_AGENT
#define LDS_WAIT() asm volatile("s_waitcnt lgkmcnt(0)" ::: "memory")
#define VM_WAIT() asm volatile("s_waitcnt vmcnt(0)" ::: "memory")
DI unsigned f2bf(float f) { unsigned u = __builtin_bit_cast(unsigned, f); return (u + 0x7fffu + ((u >> 16) & 1u)) >> 16; }
DI unsigned pk2(float lo, float hi) { return f2bf(lo) | (f2bf(hi) << 16); }
DI float bflo(unsigned w) { return __uint_as_float(w << 16); }
DI float bfhi(unsigned w) { return __uint_as_float(w & 0xffff0000u); }
DI float bf2f(bf16 h) { return __uint_as_float((unsigned)h << 16); }
template <int CTRL> DI float dpp_mov(float v) { return __builtin_bit_cast(float, __builtin_amdgcn_update_dpp(0, __builtin_bit_cast(int, v), CTRL, 0xf, 0xf, true)); }
DI float rdlane(float v, int l) { return __builtin_bit_cast(float, __builtin_amdgcn_readlane(__builtin_bit_cast(int, v), l)); }
DI float wave_sum(float v) {
    v += dpp_mov<0xB1>(v); v += dpp_mov<0x4E>(v); v += dpp_mov<0x141>(v); v += dpp_mov<0x140>(v);
    return (rdlane(v, 0) + rdlane(v, 16)) + (rdlane(v, 32) + rdlane(v, 48));
}
DI void st16_wt(void* p, v4u v) { asm volatile("global_store_dwordx4 %0, %1, off sc1\n\ts_nop 1" :: "v"(p), "v"(v) : "memory"); }
DI float wave_max(float v) {
    v = fmaxf(v, dpp_mov<0xB1>(v)); v = fmaxf(v, dpp_mov<0x4E>(v)); v = fmaxf(v, dpp_mov<0x141>(v)); v = fmaxf(v, dpp_mov<0x140>(v));
    return fmaxf(fmaxf(rdlane(v, 0), rdlane(v, 16)), fmaxf(rdlane(v, 32), rdlane(v, 48)));
}
DI unsigned pk4_fp8(float a, float b, float c, float d) { int w = __builtin_amdgcn_cvt_pk_fp8_f32(a, b, 0, false); w = __builtin_amdgcn_cvt_pk_fp8_f32(c, d, w, true); return (unsigned)w; }
DI unsigned mx_scale(float bm, float& mult) { unsigned eb = (__float_as_uint(bm * (1.0f / 448.0f)) + 0x7fffffu) >> 23; eb = eb < 1u ? 1u : (eb > 254u ? 254u : eb); mult = __uint_as_float((254u - eb) << 23); return eb; }
DI size_t scm_index(int m, int b32) { return ((size_t)(m >> 8) * 8 + (b32 >> 2)) * 1024 + (size_t)(m & 255) * 4 + (b32 & 3); }
DI float fast_rcp(float x) { return __builtin_amdgcn_rcpf(x); }
DI float sigmoid_f(float x) { return fast_rcp(1.0f + __builtin_amdgcn_exp2f(-1.4426950408889634f * x)); }
DI float silu_f(float x) { return x * sigmoid_f(x); }
DI float gelu_tanh_f(float x) { const float z2 = 1.5957691216057308f * (x + 0.044715f * x * x * x); return x * sigmoid_f(z2); }

#define XB_TMO      128
#define XB_XCNT(j)  (256  + 64 * (j))
#define XB_XSUB(j)  (1280 + 64 * (j))
#define XB_XGEN(j)  (2304 + 64 * (j))
#define XB_TOP      3328
#define XB_TOPGEN   3392
#define XCD_BAR_WORDS 3456
#define XB_SPIN_CAP (1u << 22)
DI unsigned xb_ld(unsigned* p)              { return __hip_atomic_load(p, __ATOMIC_RELAXED, __HIP_MEMORY_SCOPE_AGENT); }
DI unsigned xb_add(unsigned* p, unsigned v) { return __hip_atomic_fetch_add(p, v, __ATOMIC_RELAXED, __HIP_MEMORY_SCOPE_AGENT); }
DI unsigned xb_xcc_id() { return (unsigned)__builtin_amdgcn_s_getreg((3 << 11) | 20) & 0xFu; }
#define XB_SPIN(cond, bar) do { unsigned _sp = 0; while (cond) { __builtin_amdgcn_s_sleep(1); \
    if ((++_sp & 255u) == 0u) { if (xb_ld(&(bar)[XB_TMO])) break; if (_sp > XB_SPIN_CAP) { atomicAdd(&(bar)[XB_TMO], 1u); break; } } } } while (0)
struct XcdBarrier { unsigned* bar; unsigned x; volatile LAS unsigned* st; };
DI XcdBarrier xcd_barrier_post(unsigned* bar, volatile LAS unsigned* st) {
    XcdBarrier b; b.bar = bar; b.x = xb_xcc_id(); b.st = st;
    if (threadIdx.x == 0) (void)xb_add(&bar[XB_XCNT(b.x)], 1u);
    return b;
}
DI void xcd_barrier_complete(unsigned* bar, unsigned x, unsigned& nloc, unsigned& nx) {
    const unsigned G = gridDim.x * gridDim.y * gridDim.z;
    unsigned sum, cnt, mine, sp = 0u;
    for (;;) {
        sum = 0u; cnt = 0u; mine = 0u;
#pragma unroll
        for (unsigned j = 0; j < 16; ++j) { const unsigned c = xb_ld(&bar[XB_XCNT(j)]); sum += c; cnt += (c > 0u) ? 1u : 0u; mine = (j == x) ? c : mine; }
        if (sum == G) break;
        __builtin_amdgcn_s_sleep(1);
        if ((++sp & 255u) == 0u) { if (xb_ld(&bar[XB_TMO])) break; if (sp > XB_SPIN_CAP) { atomicAdd(&bar[XB_TMO], 1u); break; } }
    }
    nloc = mine > 0u ? mine : 1u; nx = cnt > 0u ? cnt : 1u;
}
DI void xcd_barrier(const XcdBarrier& b) {
    asm volatile("s_waitcnt vmcnt(0)" ::: "memory");
    __syncthreads();
    if (threadIdx.x == 0) {
        unsigned* bar = b.bar;
        __builtin_amdgcn_s_waitcnt(0);
        unsigned nloc = b.st[0], nx = b.st[1];
        if (nloc == 0u) { xcd_barrier_complete(bar, b.x, nloc, nx); b.st[0] = nloc; b.st[1] = nx; }
        const unsigned old = xb_add(&bar[XB_XSUB(b.x)], 1u);
        const unsigned gen = old / nloc;
        if (old + 1u == (gen + 1u) * nloc) {
            __builtin_amdgcn_fence(__ATOMIC_RELEASE, "agent");
            asm volatile("s_waitcnt vmcnt(0)" ::: "memory");
            const unsigned og = xb_add(&bar[XB_TOP], 1u);
            const unsigned tg = og / nx;
            if (og + 1u == (tg + 1u) * nx) xb_add(&bar[XB_TOPGEN], 1u);
            else XB_SPIN(xb_ld(&bar[XB_TOPGEN]) == tg, bar);
            __builtin_amdgcn_fence(__ATOMIC_ACQUIRE, "agent");
            xb_add(&bar[XB_XGEN(b.x)], 1u);
            asm volatile("s_waitcnt vmcnt(0)" ::: "memory");
        } else {
            XB_SPIN(xb_ld(&bar[XB_XGEN(b.x)]) == gen, bar);
            __builtin_amdgcn_fence(__ATOMIC_ACQUIRE, "agent");
            asm volatile("s_waitcnt vmcnt(0)" ::: "memory");
        }
    }
    __syncthreads();
}

struct Args { const void* in[30]; float* out; unsigned char* ws; int ph_lo, ph_hi, li, pad; };
enum { I_X = 0, I_C, I_POS, I_ADAW, I_ADAB, I_WIN, I_GMLNG, I_GMLNB, I_GMWS, I_GMBS, I_LAMRE, I_LAMIM, I_LOGDT, I_BRE, I_BIM, I_CRE, I_CIM, I_SSMD,
       I_GLUW, I_GLUB, I_WOUT, I_LN1G, I_LN1B, I_RW, I_RB, I_EWG, I_EWU, I_EWD, I_LN2G, I_LN2B };
struct Frame {
    LAS unsigned char* lds;
    volatile LAS unsigned* MISC;
    gu32* ctl;
    unsigned char* ws;
    int vcu, G;
};
DI int ftid() { int t = threadIdx.x; asm volatile("" : "+v"(t)); return t; }
#define FRAME_IDS const int tid_ = ftid(), lane_ = tid_ & 63, wave_ = __builtin_amdgcn_readfirstlane(tid_ >> 6); (void)lane_; (void)wave_;

template <class RowMap>
DI void transpose_item(const float* W, int K, int N, bf16* WT, const RowMap& rm, LAS float* scr, int item, int lane) {
    const int nblk = N / 32, kb = item / nblk, nb = item % nblk, k0 = 64 * kb, n0 = 32 * nb;
#pragma unroll 8
    for (int i = 0; i < 32; ++i) { const int kk = 2 * i + (lane >> 5); scr[kk * 33 + (lane & 31)] = W[(size_t)(k0 + kk) * N + n0 + (lane & 31)]; }
    LDS_WAIT(); asm volatile("" ::: "memory");
    const int c = lane & 7;
#pragma unroll
    for (int j = 0; j < 4; ++j) { const int n = (lane >> 3) + 8 * j; const LAS float* s = scr + (8 * c) * 33 + n;
        const float qs = (RowMap::SCALEQ && (n0 + n) >= COL_Q && (n0 + n) < COL_K) ? QSCALE : 1.0f;
        v4u o; o.x = pk2(s[0 * 33] * qs, s[1 * 33] * qs); o.y = pk2(s[2 * 33] * qs, s[3 * 33] * qs); o.z = pk2(s[4 * 33] * qs, s[5 * 33] * qs); o.w = pk2(s[6 * 33] * qs, s[7 * 33] * qs);
        *(GAS v4u*)(WT + (size_t)rm(n0 + n) * K + k0 + 8 * c) = o; }
    LDS_WAIT(); asm volatile("" ::: "memory");
}
struct RmIdent { static constexpr bool SCALEQ = false; int off; DI int operator()(int n) const { return off + n; } };
struct RmWin { static constexpr bool SCALEQ = true; DI int operator()(int n) const {
        if (n >= COL_Q && n < COL_VA) { const int d = n & 63; if (d < 16) return (n - d) + 2 * (d & 7) + (d >> 3); }
        return n; } };
struct RmGU { static constexpr bool SCALEQ = false; int e, up; DI int operator()(int n) const { return e * 1024 + (n >> 7) * 256 + (n & 127) + up * 128; } };

DI void p0_tables(Frame& F, const Args& A) {
    FRAME_IDS
    const float* c = (const float*)A.in[I_C];
    LAS float* condS = (LAS float*)(F.lds + RING_OFF);
    LAS float* red = (LAS float*)(F.lds + RING_OFF + 32768);
    for (int i = tid_; i < BATCH * D; i += NTHR) condS[i] = silu_f(c[i]);
    __syncthreads();
    float* mod = (float*)(F.ws + WS_MOD);
    for (int it = F.vcu; it < DEPTH * 96; it += F.G) {
        const int l = it / 96, jb = it % 96, ks = tid_ >> 6, jj = tid_ & 63, j = jb * 64 + jj;
        const float* w = (const float*)A.in[I_ADAW] + (size_t)l * D * 6 * D + j;
        float acc[8];
#pragma unroll
        for (int b = 0; b < 8; ++b) acc[b] = 0.f;
#pragma unroll 16
        for (int k = ks * 128; k < ks * 128 + 128; ++k) { const float wv = w[(size_t)k * (6 * D)];
#pragma unroll
            for (int b = 0; b < 8; ++b) acc[b] += condS[b * D + k] * wv; }
#pragma unroll
        for (int b = 0; b < 8; ++b) red[(ks * 8 + b) * 64 + jj] = acc[b];
        __syncthreads();
        { const int b = tid_ >> 6; float s = ((const float*)A.in[I_ADAB])[l * 6 * D + j];
#pragma unroll
          for (int k2 = 0; k2 < 8; ++k2) s += red[(k2 * 8 + b) * 64 + jj];
          mod[((size_t)l * BATCH + b) * 6 * D + j] = s; }
        __syncthreads();
    }
    const int gt = F.vcu * NTHR + tid_, NGT = F.G * NTHR;
    const int* pos = (const int*)A.in[I_POS]; float* rope = (float*)(F.ws + WS_ROPE);
    for (int w = gt; w < M * 8; w += NGT) { const int m = w >> 3, i = w & 7;
        const float freq = exp2f(-(float)i * 0.125f * 18.931568569324174f);
        const float ang = (float)pos[m] * freq; float s, cs; sincosf(ang, &s, &cs);
        rope[m * 16 + i] = cs; rope[m * 16 + 8 + i] = s; }
    for (int w = gt; w < DEPTH * 16 * 33 * 64; w += NGT) { const int n = w & 63, m = (w >> 6) % 33, g = ((w >> 6) / 33) & 15, l = (w >> 6) / (33 * 16);
        const int li = (l * 16 + g) * 64 + n;
        const float lre = ((const float*)A.in[I_LAMRE])[li], lim = ((const float*)A.in[I_LAMIM])[li], dt = expf(((const float*)A.in[I_LOGDT])[l * 16 + g]);
        const float mag = expf((float)m * (lre * dt)); float sn, cs; sincosf((float)m * (lim * dt), &sn, &cs);
        float* apw = (float*)(F.ws + WS_SSM2 + l * SSM2_LAYER + S2_APW) + ((size_t)(g * 33 + m) * 64 + n) * 2; apw[0] = mag * cs; apw[1] = mag * sn; }
    for (int w = gt; w < DEPTH * SSM_G * SSM_N; w += NGT) { const int l = w / 1024, gn = w % 1024, g = gn >> 6;
        float* tab = (float*)(F.ws + WS_SSM) + (size_t)l * SSM_TAB;
        const float lre = ((const float*)A.in[I_LAMRE])[w], lim = ((const float*)A.in[I_LAMIM])[w];
        const float dt = expf(((const float*)A.in[I_LOGDT])[l * 16 + g]);
        const float mag = expf(lre * dt); float sn, cs; sincosf(lim * dt, &sn, &cs);
        const float are = mag * cs, aim = mag * sn, nr = are - 1.0f, ni = aim, mod2 = lre * lre + lim * lim;
        const float fre = (nr * lre + ni * lim) / mod2, fim = (ni * lre - nr * lim) / mod2;
        tab[gn] = are; tab[1024 + gn] = aim;
        const float* bre = (const float*)A.in[I_BRE] + (size_t)w * 16; const float* bim = (const float*)A.in[I_BIM] + (size_t)w * 16;
#pragma unroll
        for (int cc = 0; cc < 16; ++cc) { tab[2048 + gn * 16 + cc] = fre * bre[cc] - fim * bim[cc]; tab[2048 + 16384 + gn * 16 + cc] = fre * bim[cc] + fim * bre[cc]; } }
}

DI void p_wconv(Frame& F, const Args& A, int l, int part) {
    FRAME_IDS
    if (part == 4) {
        const int gt = F.vcu * NTHR + tid_, NGT = F.G * NTHR;
        const float* tab = (const float*)(F.ws + WS_SSM) + (size_t)l * SSM_TAB;
        const float* apw = (const float*)(F.ws + WS_SSM2 + l * SSM2_LAYER + S2_APW);
        const float* cre = (const float*)A.in[I_CRE] + (size_t)l * 16 * 16 * 64; const float* cim = (const float*)A.in[I_CIM] + (size_t)l * 16 * 16 * 64;
        bf16* KT = (bf16*)(F.ws + WS_SSM2 + l * SSM2_LAYER + S2_KT); bf16* CT = (bf16*)(F.ws + WS_SSM2 + l * SSM2_LAYER + S2_CT);
        bf16* WIN = (bf16*)(F.ws + WS_SSM2 + l * SSM2_LAYER + S2_WIN); bf16* GW = (bf16*)(F.ws + WS_SSM2 + l * SSM2_LAYER + S2_GW);
        for (int w = gt; w < 16 * 16 * 64 * 8; w += NGT) { const int j = w & 7, ln = (w >> 3) & 63, p = (w >> 9) & 15, g = w >> 13;
            const int co = ln & 15, q = ln >> 4, m = 2 * p + (q >> 1), ci = 8 * (q & 1) + j; float acc = 0.f;
            for (int n = 0; n < 64; ++n) { const int gn = g * 64 + n; const float ar = apw[((g * 33 + m) * 64 + n) * 2], ai = apw[((g * 33 + m) * 64 + n) * 2 + 1];
                const float br = tab[2048 + gn * 16 + ci], bi = tab[2048 + 16384 + gn * 16 + ci], tre = ar * br - ai * bi, tim = ar * bi + ai * br;
                acc += cre[(g * 16 + co) * 64 + n] * tre - cim[(g * 16 + co) * 64 + n] * tim; }
            KT[w] = (bf16)f2bf(acc); }
        for (int w = gt; w < 16 * 4 * 64 * 8; w += NGT) { const int j = w & 7, ln = (w >> 3) & 63, sx = (w >> 9) & 3, g = w >> 11;
            const int co = ln & 15, q = ln >> 4, n = 16 * sx + 4 * q + (j >> 1);
            CT[w] = (bf16)f2bf((j & 1) ? -cim[(g * 16 + co) * 64 + n] : cre[(g * 16 + co) * 64 + n]); }
        for (int w = gt; w < 16 * 16 * 8 * 64 * 8; w += NGT) { const int jj = w & 7, ln = (w >> 3) & 63, ct = (w >> 9) & 7, sp = (w >> 12) & 15, g = w >> 16;
            const int cc = ln & 15, q = ln >> 4, n = 8 * ct + (cc >> 1), part = cc & 1, tj = 2 * sp + (q >> 1), ci = 8 * (q & 1) + jj, gn = g * 64 + n, m = 31 - tj;
            const float ar = apw[((g * 33 + m) * 64 + n) * 2], ai = apw[((g * 33 + m) * 64 + n) * 2 + 1], br = tab[2048 + gn * 16 + ci], bi = tab[2048 + 16384 + gn * 16 + ci];
            WIN[w] = (bf16)f2bf(part ? (ar * bi + ai * br) : (ar * br - ai * bi)); }
        const float* gws = (const float*)A.in[I_GMWS] + (size_t)l * 4 * 128 * 128;
        for (int w = gt; w < 4 * 128 * 128; w += NGT) { const int sx = w & 127, t = (w >> 7) & 127; GW[w] = (bf16)f2bf(sx <= t ? gws[w] : 0.f); }
        { const float* modl_ = (const float*)(F.ws + WS_MOD) + (size_t)l * BATCH * 6 * D; const float* cio_ = (const float*)(F.ws + WS_CINV_O) + l * D; float* gvc_ = (float*)(F.ws + WS_GVC) + (size_t)l * BATCH * D;
          for (int w = gt; w < BATCH * D; w += NGT) { const int b = w >> 10, c = w & 1023; gvc_[w] = (1.0f + modl_[(size_t)b * 6 * D + 2 * D + c]) * cio_[c]; } }
    }
}
constexpr int WC_NS = 4 * 8;
DI void p_wconv_items(Frame& F, const Args& A, int l, int lo, int hi) {
    FRAME_IDS
    LAS float* scr = (LAS float*)(F.lds + RING_OFF + wave_ * 16384);
    bf16* GluT = (bf16*)(F.ws + WS_WSMALL + l * WSMALL_LAYER + WOFF_GLU);
    for (int it = lo + F.vcu * NWAVES + wave_; it < hi; it += F.G * NWAVES)
        transpose_item((const float*)A.in[I_GLUW] + (size_t)l * 256 * 256, 256, 256, GluT, RmIdent{0}, scr, it, lane_);
}
template <bool CI_DEST, int KW, class RowMap>
DI void quant_cols32(Frame& F, const float* Wm, int ldw, int n0, unsigned char* W8, const RowMap& rm, float* cinv) {
    FRAME_IDS
    LAS float* scr = (LAS float*)(F.lds + RING_OFF + wave_ * 16384);
    LAS float* red = (LAS float*)(F.lds + RING_OFF + 12288);
    constexpr int NV = KW / 2, KTOT = 8 * KW; const int k0 = KW * wave_;
    const float* W = Wm + (size_t)k0 * ldw + n0;
    const unsigned lofs = (unsigned)((lane_ >> 5) * ldw + (lane_ & 31));
    float v[NV]; float mx = 0.f;
#pragma unroll
    for (int i = 0; i < NV; ++i) v[i] = W[(size_t)(2 * i) * ldw + lofs];
#pragma unroll
    for (int i = 0; i < NV; ++i) mx = fmaxf(mx, fabsf(v[i]));
    red[wave_ * 4096 + lane_] = mx;
    __syncthreads();
    float m2 = 0.f;
#pragma unroll
    for (int w2 = 0; w2 < 8; ++w2) m2 = fmaxf(m2, fmaxf(red[w2 * 4096 + (lane_ & 31)], red[w2 * 4096 + 32 + (lane_ & 31)]));
    const bool z = !(m2 > 1e-30f); const float sc = z ? 1.0f : 440.0f / m2;
    if (tid_ < 32) { const int n = n0 + tid_; const float qf = (RowMap::SCALEQ && n >= COL_Q && n < COL_K) ? QSCALE : 1.0f; cinv[CI_DEST ? rm(n) : n] = (z ? 1.0f : m2 * (1.0f / 440.0f)) * qf; }
    const int c = lane_ & 7;
#pragma unroll
    for (int t = 0; t < KW / 64; ++t) {
#pragma unroll
        for (int i = 0; i < 32; ++i) scr[(2 * i + (lane_ >> 5)) * 33 + (lane_ & 31)] = v[32 * t + i] * sc;
        LDS_WAIT(); asm volatile("" ::: "memory");
#pragma unroll
        for (int jj = 0; jj < 4; ++jj) { const int n = (lane_ >> 3) + 8 * jj; const LAS float* sp = scr + (8 * c) * 33 + n;
            v2u o; o.x = pk4_fp8(sp[0 * 33], sp[1 * 33], sp[2 * 33], sp[3 * 33]); o.y = pk4_fp8(sp[4 * 33], sp[5 * 33], sp[6 * 33], sp[7 * 33]);
            *(GAS v2u*)(W8 + (size_t)rm(n0 + n) * KTOT + k0 + 64 * t + 8 * c) = o; }
        LDS_WAIT(); asm volatile("" ::: "memory");
    }
    __syncthreads();
}
constexpr int WC_NGU = 16 * 2 * 16, WC_NIN = PROJW / 32;
DI void p_wconv_gu(Frame& F, const Args& A, int l, int first, int stride, int hi) {
    for (int j = first; j < hi; j += stride) { const int e = j >> 5, up = (j >> 4) & 1;
        quant_cols32<false, 128>(F, (const float*)A.in[up ? I_EWU : I_EWG] + ((size_t)l * NEXP + e) * D * DEXP, DEXP, 32 * (j & 15), (unsigned char*)(F.ws + WS_WGU), RmGU{e, up},
                            (float*)(F.ws + WS_CINV) + (size_t)l * 16 * 2 * 512 + (e * 2 + up) * 512); }
}
constexpr int WC_NDN = 16 * 32;
DI void p_wconv_dn(Frame& F, const Args& A, int l, int first, int stride) {
    for (int j = first; j < WC_NDN; j += stride) { const int e = j >> 5;
        quant_cols32<false, 64>(F, (const float*)A.in[I_EWD] + ((size_t)l * NEXP + e) * D * DEXP, D, 32 * (j & 31), (unsigned char*)(F.ws + WS_WD), RmIdent{e * 1024},
                                (float*)(F.ws + WS_CINV_D) + ((size_t)l * NEXP + e) * D); }
}
constexpr int WC_NOUT = D / 32;
DI void p_wconv_out(Frame& F, const Args& A, int l, int first, int stride) {
    for (int j = first; j < WC_NOUT; j += stride)
        quant_cols32<false, 128>(F, (const float*)A.in[I_WOUT] + (size_t)l * D * D, D, 32 * j, (unsigned char*)(F.ws + WS_WSMALL + l * WSMALL_LAYER + WOFF_OUT), RmIdent{0}, (float*)(F.ws + WS_CINV_O) + l * D);
}
DI void p_wconv_in(Frame& F, const Args& A, int l, int first, int stride) {
    for (int j = first; j < WC_NIN; j += stride)
        quant_cols32<true, 128>(F, (const float*)A.in[I_WIN] + (size_t)l * D * PROJW, PROJW, 32 * j, (unsigned char*)(F.ws + WS_WSMALL + l * WSMALL_LAYER + WOFF_IN), RmWin{}, (float*)(F.ws + WS_CINV_IN) + l * PROJW);
}

typedef float f32x2_t __attribute__((ext_vector_type(2)));
typedef __bf16 bf16x2_t __attribute__((ext_vector_type(2)));
DI unsigned cvtpk(float lo, float hi) { f32x2_t v = {lo, hi}; bf16x2_t b = __builtin_convertvector(v, bf16x2_t); return __builtin_bit_cast(unsigned, b); }
struct Row16 { float v[16]; };
DI void row_load_f32(Row16& r, const float* p, int lane) {
    const f32x4* q = (const f32x4*)p;
#pragma unroll
    for (int k = 0; k < 4; ++k) { const f32x4 a = q[k * 64 + lane]; r.v[4 * k] = a.x; r.v[4 * k + 1] = a.y; r.v[4 * k + 2] = a.z; r.v[4 * k + 3] = a.w; }
}
DI void row_load_f32_nt(Row16& r, const float* p, int lane) {
    const f32x4* q = (const f32x4*)p;
#pragma unroll
    for (int k = 0; k < 4; ++k) { const f32x4 a = __builtin_nontemporal_load(&q[k * 64 + lane]); r.v[4 * k] = a.x; r.v[4 * k + 1] = a.y; r.v[4 * k + 2] = a.z; r.v[4 * k + 3] = a.w; }
}
DI void row_load_bf16(Row16& r, const bf16* p, int lane) {
    const v2u* q = (const v2u*)p;
#pragma unroll
    for (int k = 0; k < 4; ++k) { const v2u a = q[k * 64 + lane]; r.v[4 * k] = bflo(a.x); r.v[4 * k + 1] = bfhi(a.x); r.v[4 * k + 2] = bflo(a.y); r.v[4 * k + 3] = bfhi(a.y); }
}
DI void row_store_bf16(const Row16& r, bf16* p, int lane) {
    v2u* q = (v2u*)p;
#pragma unroll
    for (int k = 0; k < 4; ++k) { v2u o; o.x = cvtpk(r.v[4 * k], r.v[4 * k + 1]); o.y = cvtpk(r.v[4 * k + 2], r.v[4 * k + 3]); q[k * 64 + lane] = o; }
}
DI void row_store_fp8(const Row16& r, unsigned char* p, float* sinv, int lane) {
    float am = 0.f;
#pragma unroll
    for (int i = 0; i < 16; ++i) am = fmaxf(am, fabsf(r.v[i]));
    am = wave_max(am); const bool z = !(am > 1e-30f); const float qs = z ? 1.0f : 440.0f / am;
    unsigned* q8 = (unsigned*)p;
#pragma unroll
    for (int k = 0; k < 4; ++k) q8[k * 64 + lane] = pk4_fp8(r.v[4 * k] * qs, r.v[4 * k + 1] * qs, r.v[4 * k + 2] * qs, r.v[4 * k + 3] * qs);
    if (lane == 0) *sinv = z ? 1.0f : am * (1.0f / 440.0f);
}
DI void row_store_f32(const Row16& r, float* p, int lane) {
    f32x4* q = (f32x4*)p;
#pragma unroll
    for (int k = 0; k < 4; ++k) __builtin_nontemporal_store((f32x4){r.v[4 * k], r.v[4 * k + 1], r.v[4 * k + 2], r.v[4 * k + 3]}, &q[k * 64 + lane]);
}
DI void row_ln(Row16& r) {
    float s = 0.f;
#pragma unroll
    for (int i = 0; i < 16; ++i) s += r.v[i];
    const float mean = wave_sum(s) * (1.f / D); float s2 = 0.f;
#pragma unroll
    for (int i = 0; i < 16; ++i) { r.v[i] -= mean; s2 += r.v[i] * r.v[i]; }
    const float rstd = 1.0f / sqrtf(wave_sum(s2) * (1.f / D) + LN_EPS);
#pragma unroll
    for (int i = 0; i < 16; ++i) r.v[i] *= rstd;
}
DI void row_mod(Row16& r, const float* a, const float* b, int lane) {
    Row16 av, bv; row_load_f32(av, a, lane); row_load_f32(bv, b, lane);
#pragma unroll
    for (int i = 0; i < 16; ++i) r.v[i] = r.v[i] * (1.0f + av.v[i]) + bv.v[i];
}
DI void row_affine(Row16& r, const float* g, const float* b, int lane) {
    Row16 av, bv; row_load_f32(av, g, lane); row_load_f32(bv, b, lane);
#pragma unroll
    for (int i = 0; i < 16; ++i) r.v[i] = r.v[i] * av.v[i] + bv.v[i];
}

DI void p_ln_a0(Frame& F, const Args& A) {
    FRAME_IDS
    const int gw = F.vcu * NWAVES + wave_, NGW = F.G * NWAVES;
    const float* x = (const float*)A.in[I_X]; bf16* XN = (bf16*)(F.ws + WS_XN); const float* mod = (const float*)(F.ws + WS_MOD);
    const int bq = gw / (NGW / BATCH), mbase = bq * T + gw % (NGW / BATCH), mstep = NGW / BATCH;
    const float* md = mod + (size_t)bq * 6 * D;
    Row16 msc, msh; row_load_f32(msc, md + 1 * D, lane_); row_load_f32(msh, md + 0 * D, lane_);
    Row16 nx; row_load_f32_nt(nx, x + (size_t)mbase * D, lane_);
    for (int m = mbase; m < (bq + 1) * T; m += mstep) {
        Row16 r = nx; if (m + mstep < (bq + 1) * T) row_load_f32_nt(nx, x + (size_t)(m + mstep) * D, lane_);
        row_ln(r);
#pragma unroll
        for (int i = 0; i < 16; ++i) r.v[i] = r.v[i] * (1.0f + msc.v[i]) + msh.v[i];
        row_store_fp8(r, (unsigned char*)XN + (size_t)m * D, (float*)(F.ws + WS_SA) + m, lane_); }
}

using pg8::Unit; using pg8::BM; using pg8::HALF;
struct EpiInProj {
    static constexpr bool PERM = true, AFTER_DRAIN = false;
    bf16* P; const float* rope; int skip; const float* sa; const float* cinv;
    DI void operator()(const pg8::f32x4 (&acc)[2][2][4][2], const Unit& u, int wr, int wc, int fr, int fq) const {
        if (skip == 1) { if (acc[0][0][0][0][0] == 12345.678f) P[0] = 1; return; }
        const int row0 = u.pm * BM + wr * 64 + fr, pn = u.pn;
        const bool isrope = (pn >= 2 && pn <= 5), dorope = isrope && ((wc & 1) == 0) && (fq < 2);
        asm volatile("" ::: "memory");
        pg8::f32x4 ci[2][2]; float ra[2][4];
#pragma unroll
        for (int bj = 0; bj < 2; ++bj) { const float* cp = cinv + pn * BM + bj * HALF + wc * 32 + 8 * fq; ci[bj][0] = *(const pg8::f32x4*)cp; ci[bj][1] = *(const pg8::f32x4*)(cp + 4); }
#pragma unroll
        for (int ai = 0; ai < 2; ++ai)
#pragma unroll
            for (int m = 0; m < 4; ++m) ra[ai][m] = sa[row0 + ai * HALF + m * 16];
#pragma unroll
        for (int ai = 0; ai < 2; ++ai) {
            f32x4 cs[4], sn[4];
#pragma unroll
            for (int m = 0; m < 4; ++m) { const int row = row0 + ai * HALF + m * 16; cs[m] = (f32x4){1.f, 1.f, 1.f, 1.f}; sn[m] = (f32x4){0.f, 0.f, 0.f, 0.f};
                if (isrope) { const float* rp = rope + (size_t)row * 16 + 4 * (fq & 1); cs[m] = *(const f32x4*)rp; sn[m] = *(const f32x4*)(rp + 8); } }
            __builtin_amdgcn_sched_barrier(0);
#pragma unroll
            for (int m = 0; m < 4; ++m) { const int row = row0 + ai * HALF + m * 16; bf16* rowp = P + (size_t)row * PROJW + pn * BM + wc * 32 + 8 * fq; const float rav = ra[ai][m];
                const f32x4 c4 = cs[m], s4 = sn[m];
#pragma unroll
                for (int bj = 0; bj < 2; ++bj) { pg8::f32x4 v0 = acc[ai][bj][m][0] * (ci[bj][0] * rav), v1 = acc[ai][bj][m][1] * (ci[bj][1] * rav);
                    if (isrope) {
                        if (dorope) { const float a0 = v0[0] * c4.x - v0[1] * s4.x, b0 = v0[1] * c4.x + v0[0] * s4.x, a1 = v0[2] * c4.y - v0[3] * s4.y, b1 = v0[3] * c4.y + v0[2] * s4.y;
                            const float a2 = v1[0] * c4.z - v1[1] * s4.z, b2 = v1[1] * c4.z + v1[0] * s4.z, a3 = v1[2] * c4.w - v1[3] * s4.w, b3 = v1[3] * c4.w + v1[2] * s4.w;
                            v0 = (pg8::f32x4){a0, b0, a1, b1}; v1 = (pg8::f32x4){a2, b2, a3, b3}; }
                    }
                    pg8::u32x4 w; w.x = pg8::cvt_pk_bf16(v0[0], v0[1]); w.y = pg8::cvt_pk_bf16(v0[2], v0[3]); w.z = pg8::cvt_pk_bf16(v1[0], v1[1]); w.w = pg8::cvt_pk_bf16(v1[2], v1[3]);
                    if (skip == 2) { asm volatile("" :: "v"(w.x), "v"(w.y), "v"(w.z), "v"(w.w)); } else *(pg8::u32x4*)(rowp + bj * HALF) = w; } }
            __builtin_amdgcn_sched_barrier(0);
        }
    }
};
template <bool XF32> struct EpiOut {
    static constexpr bool PERM = true, AFTER_DRAIN = false;
    bf16* PRE; const void* x; int xpitch; const float* mod; const float* cinv;
    DI void operator()(const pg8::f32x4 (&acc)[2][2][4][2], const Unit& u, int wr, int wc, int fr, int fq) const {
        const int row0 = u.pm * BM + wr * 64 + fr, b = (u.pm * BM) / T, colb = u.pn * BM + wc * 32 + 8 * fq;
        const float* g1 = cinv + (size_t)b * D;
        asm volatile("" ::: "memory");
        pg8::f32x4 gv[2][2];
#pragma unroll
        for (int bj = 0; bj < 2; ++bj) { gv[bj][0] = *(const pg8::f32x4*)(g1 + colb + bj * HALF); gv[bj][1] = *(const pg8::f32x4*)(g1 + colb + bj * HALF + 4); }
#pragma unroll
        for (int ai = 0; ai < 2; ++ai) {
            pg8::f32x4 x0[4][2], x1[4][2];
#pragma unroll
            for (int m = 0; m < 4; ++m) { const int row = row0 + ai * HALF + m * 16;
#pragma unroll
                for (int bj = 0; bj < 2; ++bj) { const int col = colb + bj * HALF;
                    if (XF32) { const float* xp = (const float*)x + (size_t)row * xpitch + col; x0[m][bj] = *(const pg8::f32x4*)xp; x1[m][bj] = *(const pg8::f32x4*)(xp + 4); }
                    else { const pg8::u32x4 xw = *(const pg8::u32x4*)((const bf16*)x + (size_t)row * xpitch + col);
                        x0[m][bj] = (pg8::f32x4){bflo(xw.x), bfhi(xw.x), bflo(xw.y), bfhi(xw.y)}; x1[m][bj] = (pg8::f32x4){bflo(xw.z), bfhi(xw.z), bflo(xw.w), bfhi(xw.w)}; } } }
            __builtin_amdgcn_sched_barrier(0);
#pragma unroll
            for (int m = 0; m < 4; ++m) { const int row = row0 + ai * HALF + m * 16;
#pragma unroll
                for (int bj = 0; bj < 2; ++bj) { const int col = colb + bj * HALF;
                    const pg8::f32x4 v0 = x0[m][bj] * ALPHA + gv[bj][0] * acc[ai][bj][m][0], v1 = x1[m][bj] * ALPHA + gv[bj][1] * acc[ai][bj][m][1];
                    pg8::u32x4 w; w.x = pg8::cvt_pk_bf16(v0[0], v0[1]); w.y = pg8::cvt_pk_bf16(v0[2], v0[3]); w.z = pg8::cvt_pk_bf16(v1[0], v1[1]); w.w = pg8::cvt_pk_bf16(v1[2], v1[3]);
                    *(pg8::u32x4*)(PRE + (size_t)row * D + col) = w; } }
            __builtin_amdgcn_sched_barrier(0);
        }
    }
};
struct OutOrder : pg8::StaticOrder {
    const char* xbase; unsigned rowbytes, tilecolbytes; LAS unsigned char* dump;
    DI void a_ready(const Unit& u) const {
        const int tid = threadIdx.x, wid = __builtin_amdgcn_readfirstlane(tid >> 6), lane = tid & 63;
        const int lpr = (int)(tilecolbytes >> 7);
        const char* t0 = xbase + (size_t)u.pm * 256 * rowbytes + (size_t)u.pn * tilecolbytes;
        const int nline = 256 * lpr;
        for (int i = wid * 64 + lane; i < nline; i += 512) { const int r = i / lpr, c = i % lpr;
            __builtin_amdgcn_global_load_lds((const unsigned*)(t0 + (size_t)r * rowbytes + (size_t)c * 128), (LAS unsigned*)(dump + wid * 256), 4, 0, 0); }
    }
};
struct EpiGlu {
    static constexpr bool PERM = true, AFTER_DRAIN = false;
    const bf16* YG; bf16* MIX; const float* gb;
    DI void operator()(const pg8::f32x4 (&acc)[2][2][4][2], const Unit& u, int wr, int wc, int fr, int fq) const {
        const int row0 = u.pm * BM + wr * 64 + fr, colb = wc * 32 + 8 * fq;
#pragma unroll
        for (int ai = 0; ai < 2; ++ai)
#pragma unroll
            for (int m = 0; m < 4; ++m) { const int row = row0 + ai * HALF + m * 16;
#pragma unroll
                for (int bj = 0; bj < 2; ++bj) { const int col = colb + bj * HALF;
                    const pg8::u32x4 yw = *(const pg8::u32x4*)(YG + (size_t)row * 256 + col);
                    const pg8::f32x4 b0 = *(const pg8::f32x4*)(gb + col), b1 = *(const pg8::f32x4*)(gb + col + 4);
                    const pg8::f32x4 a0 = acc[ai][bj][m][0] + b0, a1 = acc[ai][bj][m][1] + b1;
                    const float y[8] = {bflo(yw.x), bfhi(yw.x), bflo(yw.y), bfhi(yw.y), bflo(yw.z), bfhi(yw.z), bflo(yw.w), bfhi(yw.w)};
                    float o[8];
#pragma unroll
                    for (int i = 0; i < 4; ++i) { o[i] = y[i] * sigmoid_f(a0[i]); o[4 + i] = y[4 + i] * sigmoid_f(a1[i]); }
                    pg8::u32x4 w; w.x = pg8::cvt_pk_bf16(o[0], o[1]); w.y = pg8::cvt_pk_bf16(o[2], o[3]); w.z = pg8::cvt_pk_bf16(o[4], o[5]); w.w = pg8::cvt_pk_bf16(o[6], o[7]);
                    *(pg8::u32x4*)(MIX + (size_t)row * D + 768 + col) = w; asm volatile("" ::: "memory"); } }
    }
};
template <int KIND> struct MoeOrderK {
    const volatile LAS int* ts; int G, c; const int* slot_a; const float* slot_w; gu32* done_cnt; gu32* queue; volatile LAS int* qs;
    DI bool decode(int off, Unit& u) const {
        const int nwg = ts[16] * 4, q = nwg / 8, r = nwg % 8, xcd = c % 8; const int cntx = q + (xcd < r ? 1 : 0); if (off >= cntx) return false;
        const int wgid = (xcd < r ? xcd * (q + 1) : r * (q + 1) + (xcd - r) * q) + off;
        const int tm = wgid >> 2, j = wgid & 3; int e = 0;
#pragma unroll
        for (int k = 1; k < 16; ++k) e += (ts[k] <= tm) ? 1 : 0;
        u.pm = tm; u.pn = e * 4 + j; return true; }
    DI bool first(Unit& u) const {
        if (KIND == 0) return next(0, u);
        if (threadIdx.x == 0) { const unsigned a = __hip_atomic_fetch_add(queue + 16 * (c % 8), 2u, RLX_AGENT); qs[0] = (int)a; qs[1] = (int)a + 1; }
        asm volatile("s_waitcnt vmcnt(0) lgkmcnt(0)" ::: "memory"); __builtin_amdgcn_s_barrier(); asm volatile("" ::: "memory");
        return decode(qs[0], u);
    }
    DI bool more(int i, Unit& u) const {
        if (KIND == 0) return next(i, u);
        return decode(qs[i & 1], u);
    }
    DI bool next(int i, Unit& u) const {
        const int nwg = ts[16] * 4; const int cc = c;
        const long L = (long)i * G + cc; if (L >= nwg) return false;
        int wgid = (int)L; { const int q = nwg / 8, r = nwg % 8, xcd = wgid % 8, off = wgid / 8; wgid = (xcd < r ? xcd * (q + 1) : r * (q + 1) + (xcd - r) * q) + off; }
        const int tm = wgid >> 2, j = wgid & 3; int e = 0;
#pragma unroll
        for (int k = 1; k < 16; ++k) e += (ts[k] <= tm) ? 1 : 0;
        u.pm = tm; u.pn = e * 4 + j; return true;
    }
    const unsigned char* hsc;
    struct Pf { unsigned a, w, c, q; };
    DI const unsigned char* scale_base(const Unit& u) const { return hsc + (size_t)u.pm * 4096; }
    DI void pull_issue(int tid, Pf& pf) const { if (KIND == 1 && tid == 0) pf.q = __hip_atomic_fetch_add(queue + 16 * (c % 8), 1u, RLX_AGENT); }
    DI void pull_publish(int tid, const Pf& pf, int ui) const { if (KIND == 1 && tid == 0 && ui >= 0) qs[ui & 1] = (int)pf.q; }
    DI void prefetch(const Unit& u, int r, Pf& pf) const {
        const int e = u.pn >> 2, idx = (u.pm - ts[e]) * 256 + (r & 255); const bool valid = idx < ts[32 + e];
        pf.a = 0xffffffffu; pf.w = 0u; pf.c = 32u;
        if (valid && r < 256) { pf.a = (unsigned)slot_a[(size_t)e * SLOT_CAP + idx]; if (KIND == 1) pf.w = __float_as_uint(slot_w[(size_t)e * SLOT_CAP + idx]); }
        if (KIND == 1 && r < 64) pf.c = __hip_atomic_load(done_cnt + u.pm, RLX_AGENT);
    }
    DI void finish_meta(const Unit& u, int r, const Pf& pf, unsigned& off, unsigned& a0, unsigned& a1) const {
        if (KIND == 0) { const bool pad = pf.a == 0xffffffffu; off = (pad ? 0u : ((pf.a & 0xffffu) >> 1)) * (unsigned)D; a0 = 0u; a1 = pad ? 0u : (pf.a & 0xffff0000u); }
        else { off = (unsigned)(u.pm * 256 + r) * (unsigned)DEXP; a0 = pf.a == 0xffffffffu ? pf.a : (pf.a & 0xffffu); a1 = pf.w; }
    }
    DI void wait_ready(const Unit& u, int tid, const Pf& pf) const {
        if (KIND == 1 && tid < 64) { unsigned sp = 0;
            if ((unsigned)__builtin_amdgcn_readfirstlane((int)pf.c) < 32u)
                while ((unsigned)__builtin_amdgcn_readfirstlane((int)__hip_atomic_load(done_cnt + u.pm, RLX_AGENT)) < 32u) { __builtin_amdgcn_s_sleep(2); if (++sp > (1u << 20)) break; } }
    }
    DI void a_ready(const Unit&) const {}
    DI void done_nowait(const Unit& u) const { if (KIND == 0 && (threadIdx.x & 63) == 0) __hip_atomic_fetch_add(done_cnt + u.pm, 1u, RLX_AGENT); }
};
struct EpiG1 {
    static constexpr bool PERM = true, AFTER_DRAIN = false;
    unsigned char* HID; int skip; const float* cinv; unsigned char* HSC;
    DI void operator()(const pg8::f32x4 (&acc)[2][2][4][2], const Unit& u, int wr, int wc, int fr, int fq, const LAS unsigned* meta) const {
        if (skip == 1) { if (acc[0][0][0][0][0] == 12345.678f) HID[0] = 1; return; }
        const __amdgpu_buffer_rsrc_t rs = __builtin_amdgcn_make_buffer_rsrc((void*)HID, 0, (int)((size_t)NSLOT_MAX * DEXP), 0x00020000);
        const __amdgpu_buffer_rsrc_t rsc = __builtin_amdgcn_make_buffer_rsrc((void*)HSC, 0, (int)((size_t)NSLOT_MAX * 16), 0x00020000);
        const int ln_ = ftid() & 63, fr_ = ln_ & 15, fq_ = ln_ >> 4; (void)fr; (void)fq;
        const int e = u.pn >> 2, j = u.pn & 3, r0 = wr * 64 + fr_, row0 = u.pm * BM + r0, col = j * 128 + wc * 32 + 8 * fq_;
        asm volatile("" ::: "memory");
        const float* cg = cinv + (e * 2 + 0) * 512 + col; const float* cu = cinv + (e * 2 + 1) * 512 + col;
        const pg8::f32x4 cg0 = *(const pg8::f32x4*)cg, cg1 = *(const pg8::f32x4*)(cg + 4), cu0 = *(const pg8::f32x4*)cu, cu1 = *(const pg8::f32x4*)(cu + 4);
#pragma unroll
        for (int ai = 0; ai < 2; ++ai)
#pragma unroll
            for (int m = 0; m < 4; ++m) { const int rl = r0 + ai * HALF + m * 16, row = row0 + ai * HALF + m * 16; float o[8];
                const float ra = __uint_as_float(meta[512 + rl]);
#pragma unroll
                for (int i = 0; i < 4; ++i) { o[i] = silu_f(acc[ai][0][m][0][i] * (ra * cg0[i])) * (acc[ai][1][m][0][i] * (ra * cu0[i])); o[4 + i] = silu_f(acc[ai][0][m][1][i] * (ra * cg1[i])) * (acc[ai][1][m][1][i] * (ra * cu1[i])); }
                float bm = fmaxf(fmaxf(fmaxf(fabsf(o[0]), fabsf(o[1])), fmaxf(fabsf(o[2]), fabsf(o[3]))), fmaxf(fmaxf(fabsf(o[4]), fabsf(o[5])), fmaxf(fabsf(o[6]), fabsf(o[7]))));
                bm = fmaxf(bm, __shfl_xor(bm, 16)); bm = fmaxf(bm, __shfl_xor(bm, 32));
                unsigned eb = (__float_as_uint(bm * (1.0f / 448.0f)) + 0x7fffffu) >> 23; eb = eb < 1u ? 1u : (eb > 254u ? 254u : eb);
                const float mult = __uint_as_float((254u - eb) << 23);
                v2u w; w.x = pk4_fp8(o[0] * mult, o[1] * mult, o[2] * mult, o[3] * mult); w.y = pk4_fp8(o[4] * mult, o[5] * mult, o[6] * mult, o[7] * mult);
                __builtin_amdgcn_raw_buffer_store_b64(w, rs, row * DEXP + col, 0, 16);
                if (fq_ == 0) __builtin_amdgcn_raw_buffer_store_b8((unsigned char)eb, rsc, ((u.pm * 4 + j) * 256 + rl) * 4 + wc, 0, 16); }
    }
};
struct EpiG2 {
    static constexpr bool PERM = true, AFTER_DRAIN = false;
    unsigned char* ROWS; int skip; const float* cinv; unsigned char* SCR;
    DI void operator()(const pg8::f32x4 (&acc)[2][2][4][2], const Unit& u, int wr, int wc, int fr, int fq, const LAS unsigned* meta) const {
        if (skip == 1) { if (acc[0][0][0][0][0] == 12345.678f) ROWS[0] = 1; return; }
        const int r0 = wr * 64 + fr, colb = (u.pn & 3) * BM + wc * 32 + 8 * fq;
        asm volatile("" ::: "memory");
        pg8::f32x4 ci[2][2];
#pragma unroll
        for (int bj = 0; bj < 2; ++bj) { const float* cp = cinv + (u.pn >> 2) * D + colb + bj * HALF; ci[bj][0] = *(const pg8::f32x4*)cp; ci[bj][1] = *(const pg8::f32x4*)(cp + 4); }
#pragma unroll
        for (int ai = 0; ai < 2; ++ai)
#pragma unroll
            for (int m = 0; m < 4; ++m) { const int r = r0 + ai * HALF + m * 16; const int d = (int)meta[256 + r]; const float wt = __uint_as_float(meta[512 + r]);
#pragma unroll
                for (int bj = 0; bj < 2; ++bj) { const pg8::f32x4 v0 = acc[ai][bj][m][0] * (ci[bj][0] * wt), v1 = acc[ai][bj][m][1] * (ci[bj][1] * wt);
                    float bm = fmaxf(fmaxf(fmaxf(fabsf(v0[0]), fabsf(v0[1])), fmaxf(fabsf(v0[2]), fabsf(v0[3]))), fmaxf(fmaxf(fabsf(v1[0]), fabsf(v1[1])), fmaxf(fabsf(v1[2]), fabsf(v1[3]))));
                    bm = fmaxf(bm, __shfl_xor(bm, 16)); bm = fmaxf(bm, __shfl_xor(bm, 32)); float mult; const unsigned eb = mx_scale(bm, mult);
                    if (d >= 0) { v2u w; w.x = pk4_fp8(v0[0] * mult, v0[1] * mult, v0[2] * mult, v0[3] * mult); w.y = pk4_fp8(v1[0] * mult, v1[1] * mult, v1[2] * mult, v1[3] * mult);
                        *(v2u*)(ROWS + (size_t)d * 2048 + colb + bj * HALF) = w;
                        if (fq == 0) SCR[(size_t)d * 32 + (4 * bj + wc) * 4 + (u.pn & 3)] = (unsigned char)eb; } } }
    }
};

DI void mix_gating_simple(Frame& F, const Args& A, int l) {
    FRAME_IDS
    const bf16* P = (const bf16*)(F.ws + WS_PROJ); bf16* MIX = (bf16*)(F.ws + WS_MIXCAT);
    const float* lng = (const float*)A.in[I_GMLNG] + l * AW; const float* lnb = (const float*)A.in[I_GMLNB] + l * AW;
    const float* ws_ = (const float*)A.in[I_GMWS] + (size_t)l * 4 * 128 * 128; const float* bs_ = (const float*)A.in[I_GMBS] + l * 4 * 128;
    LAS float* vln = (LAS float*)(F.lds + RING_OFF);
    for (int it = F.vcu; it < BATCH * (T / 128); it += F.G) {
        const int m0 = it * 128;
        for (int r = wave_; r < 128; r += NWAVES) {
            const v2u w = *(const v2u*)(P + (size_t)(m0 + r) * PROJW + COL_V + 4 * lane_);
            float v[4] = {gelu_tanh_f(bflo(w.x)), gelu_tanh_f(bfhi(w.x)), gelu_tanh_f(bflo(w.y)), gelu_tanh_f(bfhi(w.y))};
            const float mean = wave_sum(v[0] + v[1] + v[2] + v[3]) * (1.f / 256.f);
            float s2 = 0.f;
#pragma unroll
            for (int i = 0; i < 4; ++i) { v[i] -= mean; s2 += v[i] * v[i]; }
            const float rstd = 1.0f / sqrtf(wave_sum(s2) * (1.f / 256.f) + LN_EPS);
#pragma unroll
            for (int i = 0; i < 4; ++i) vln[r * 256 + 4 * lane_ + i] = v[i] * rstd * lng[4 * lane_ + i] + lnb[4 * lane_ + i];
        }
        __syncthreads();
        { const int c = tid_ & 255, tp = tid_ >> 8, h = c >> 6;
          for (int t = tp; t < 128; t += 2) { const float* wrow = ws_ + ((size_t)h * 128 + t) * 128; float acc = 0.f;
              for (int s = 0; s <= t; ++s) acc += wrow[s] * vln[s * 256 + c];
              const float uu = gelu_tanh_f(bf2f(P[(size_t)(m0 + t) * PROJW + COL_U + c]));
              MIX[(size_t)(m0 + t) * D + c] = (bf16)f2bf(uu * (acc + bs_[h * 128 + t])); } }
        __syncthreads();
    }
}
DI void mix_attn_simple(Frame& F, int l) {
    FRAME_IDS
    const bf16* P = (const bf16*)(F.ws + WS_PROJ); bf16* MIX = (bf16*)(F.ws + WS_MIXCAT);
    const int gw = F.vcu * NWAVES + wave_, NGW = F.G * NWAVES;
    for (int it = gw; it < M * NH; it += NGW) {
        const int m = it >> 3, h = it & 7, t = m & (T - 1);
        const float q = bf2f(P[(size_t)m * PROJW + COL_Q + h * 64 + lane_]);
        float mx = -1e30f, den = 0.f, o = 0.f;
#pragma unroll 1
        for (int g = 0; g < 3; ++g) { const int dl = (g == 0) ? 1 : (g == 1 ? 4 : 16);
            int nk = t / dl; if (nk > 128) nk = 128;
#pragma unroll 2
            for (int j = 0; j <= nk; ++j) { const size_t mk = (size_t)(m - j * dl);
                const float kv = bf2f(P[mk * PROJW + COL_K + h * 64 + lane_]); const float vv = bf2f(P[mk * PROJW + COL_VA + h * 64 + lane_]);
                const float s = wave_sum(q * kv);
                const float mn = fmaxf(mx, s), f = __builtin_amdgcn_exp2f(mx - mn), p = __builtin_amdgcn_exp2f(s - mn);
                den = den * f + p; o = o * f + p * vv; mx = mn; } }
        MIX[(size_t)m * D + AW + h * 64 + lane_] = (bf16)f2bf(o / den);
    }
}

typedef float f32x16 __attribute__((ext_vector_type(16)));
typedef short v4i16_t __attribute__((ext_vector_type(4)));
DI int crow16(int r, int hi) { return (r & 3) + 8 * (r >> 2) + 4 * hi; }
template <int SUB> DI void mix_attn_mfma(Frame& F, int l) {
    FRAME_IDS
    const bf16* P = (const bf16*)(F.ws + WS_PROJ);
    LAS unsigned char* Ks = F.lds + RING_OFF; LAS unsigned char* Vs = Ks + 49152;
    LAS unsigned char* St = F.lds + ATT_STAGE_OFF + wave_ * 4608;
    const int ql = lane_ & 31, hi = lane_ >> 5, prow = lane_ >> 3, pch = lane_ & 7;
    constexpr int nitems = SUB == 0 ? 2048 : 1024;
    v4u kreg[6], vreg[6], qraw[4]; bf16x8 qf[4];
    int it = F.vcu; if (it >= nitems) return;
    int d, r, s0, b, h; size_t tokbase;
#define ATT_DECODE(IT) do { const int idx_ = (IT) & 1023; b = idx_ >> 7; h = (idx_ >> 4) & 7; int tile_; \
        if (SUB == 1) { d = 1; r = 0; tile_ = idx_ & 15; } else if ((IT) < 1024) { d = 16; r = idx_ & 15; tile_ = 0; } else { d = 4; r = (idx_ >> 2) & 3; tile_ = idx_ & 3; } \
        s0 = tile_ * 256; tokbase = (size_t)b * T + r; } while (0)
#define ATT_LOAD() do { const int tl_ = ftid(); _Pragma("unroll") for (int i = 0; i < 6; ++i) { const int idx2 = tl_ + 512 * i, row = idx2 >> 3, ch = idx2 & 7, step = s0 - 128 + row; \
            if (step >= 0) { const bf16* src = P + (tokbase + (size_t)step * d) * PROJW + h * 64 + ch * 8; kreg[i] = *(const v4u*)(src + COL_K); vreg[i] = *(const v4u*)(src + COL_VA); } \
            else { kreg[i] = (v4u){0u, 0u, 0u, 0u}; vreg[i] = (v4u){0u, 0u, 0u, 0u}; } } \
        _Pragma("unroll") for (int p = 0; p < 4; ++p) qraw[p] = *(const v4u*)(P + (tokbase + (size_t)(s0 + 32 * wave_ + 8 * p + prow) * d) * PROJW + COL_Q + h * 64 + pch * 8); } while (0)
#define ATT_WRITE() do { const int tw_ = ftid(); _Pragma("unroll") for (int i = 0; i < 6; ++i) { const int idx2 = tw_ + 512 * i, row = idx2 >> 3, ch = idx2 & 7; \
            *(LAS v4u*)(Ks + row * 128 + ((ch ^ ((row >> 1) & 7)) << 4)) = kreg[i]; \
            *(LAS v4u*)(Vs + row * 128 + ((ch ^ (((row >> 1) & 1) << 2)) << 4)) = vreg[i]; } \
        _Pragma("unroll") for (int p = 0; p < 4; ++p) *(LAS v4u*)(St + (8 * p + prow) * 144 + pch * 16) = qraw[p]; } while (0)
    ATT_DECODE(it); ATT_LOAD(); ATT_WRITE();
    __syncthreads();
    for (;;) {
        const size_t tb = tokbase; const int s0c = s0, dc = d, hcur = h, itcur = it;
        const bool first = (s0 == 0);
#pragma unroll
        for (int ks = 0; ks < 4; ++ks) qf[ks] = *(const LAS bf16x8*)(St + ql * 144 + (2 * ks + hi) * 16);
        const int itn = it + F.G; const bool has_next = itn < nitems;
        if (has_next) { ATT_DECODE(itn); ATT_LOAD(); }
        const int i0 = 32 * wave_;
        f32x16 S[5];
#pragma unroll
        for (int kb = 0; kb < 5; ++kb) { f32x16 acc;
#pragma unroll
            for (int i = 0; i < 16; ++i) acc[i] = 0.f;
            const int krow = i0 + 32 * kb + ql;
#pragma unroll
            for (int ks = 0; ks < 4; ++ks) { const bf16x8 a = *(const LAS bf16x8*)(Ks + krow * 128 + (((2 * ks + hi) ^ ((krow >> 1) & 7)) << 4)); acc = __builtin_amdgcn_mfma_f32_32x32x16_bf16(a, qf[ks], acc, 0, 0, 0); }
            S[kb] = acc; }
        int qrel = ql - 4 * hi; asm volatile("" : "+v"(qrel));
        float mx = -1e30f;
#pragma unroll
        for (int kb = 0; kb < 5; ++kb) {
            const bool bvalid = !first || (wave_ + kb >= 4);
            if (!bvalid) {
#pragma unroll
                for (int i = 0; i < 16; ++i) S[kb][i] = -1e30f;
            } else {
#pragma unroll
                for (int i = 0; i < 16; ++i) { const int c0 = crow16(i, 0); float v = S[kb][i];
                    if (kb == 0) v = (c0 >= qrel) ? v : -1e30f;
                    if (kb == 4) v = (c0 <= qrel) ? v : -1e30f;
                    S[kb][i] = v; mx = fmaxf(mx, v); }
            }
        }
        mx = fmaxf(mx, __shfl_xor(mx, 32));
        float lsum = 0.f;
#pragma unroll
        for (int kb = 0; kb < 5; ++kb)
#pragma unroll
            for (int i = 0; i < 16; ++i) { const float p = __builtin_amdgcn_exp2f(S[kb][i] - mx); S[kb][i] = p; lsum += p; }
        lsum += __shfl_xor(lsum, 32);
        v2u x16[4], x4[4]; unsigned e16[4], e4[4]; f32x2_t s16 = {0.f, 0.f}, s4 = {0.f, 0.f};
        if (SUB == 1) {
            const size_t qt = tb + (size_t)(s0c + i0 + ql) * dc;
            s16 = *(const f32x2_t*)((const float*)(F.ws + WS_STAT) + (qt * NH + hcur) * 2); s4 = *(const f32x2_t*)((const float*)(F.ws + WS_STAT) + (size_t)M * NH * 2 + (qt * NH + hcur) * 2);
        }
        f32x16 O[2];
#pragma unroll
        for (int i = 0; i < 16; ++i) { O[0][i] = 0.f; O[1][i] = 0.f; }
        const int trq = (lane_ & 15) >> 2, trg = (lane_ >> 4) & 1, trp = lane_ & 3;
#pragma unroll
        for (int kb = 0; kb < 5; ++kb)
#pragma unroll
            for (int s = 0; s < 2; ++s) {
                if (SUB == 1 && kb == 2 && s == 0) {
#pragma unroll
                    for (int p = 0; p < 4; ++p) { const size_t rt = tb + (size_t)(s0c + i0 + 8 * p + prow) * dc; const unsigned char* pp = (const unsigned char*)(F.ws + WS_XN) + rt * BW + hcur * 64 + pch * 8;
                        const unsigned char* sp = (const unsigned char*)(F.ws + WS_PSC) + rt * 16 + hcur * 2 + (pch >> 2);
                        x16[p] = *(const v2u*)pp; x4[p] = *(const v2u*)(pp + (size_t)M * BW); e16[p] = sp[0]; e4[p] = sp[(size_t)M * 16]; } }
                v4u pw; pw.x = cvtpk(S[kb][8 * s], S[kb][8 * s + 1]); pw.y = cvtpk(S[kb][8 * s + 2], S[kb][8 * s + 3]); pw.z = cvtpk(S[kb][8 * s + 4], S[kb][8 * s + 5]); pw.w = cvtpk(S[kb][8 * s + 6], S[kb][8 * s + 7]);
                const bf16x8 pb = __builtin_bit_cast(bf16x8, pw);
                const int rlo = i0 + 32 * kb + 16 * s + 4 * hi + trq, rhi = rlo + 8;
#pragma unroll
                for (int dh = 0; dh < 2; ++dh) { const int chunk = 4 * dh + 2 * trg + (trp >> 1);
                    const v4i16_t lo = __builtin_amdgcn_ds_read_tr16_b64_v4i16((LAS v4i16_t*)(Vs + rlo * 128 + ((chunk ^ (((rlo >> 1) & 1) << 2)) << 4) + 8 * (trp & 1)));
                    const v4i16_t hh = __builtin_amdgcn_ds_read_tr16_b64_v4i16((LAS v4i16_t*)(Vs + rhi * 128 + ((chunk ^ (((rhi >> 1) & 1) << 2)) << 4) + 8 * (trp & 1)));
                    const bf16x8 va = (bf16x8){lo[0], lo[1], lo[2], lo[3], hh[0], hh[1], hh[2], hh[3]};
                    O[dh] = __builtin_amdgcn_mfma_f32_32x32x16_bf16(va, pb, O[dh], 0, 0, 0); } }
        float osc;
        if (SUB == 0) osc = 1.0f / lsum;
        else { const float MM = fmaxf(mx, fmaxf(s16.x, s4.x)), a1 = __builtin_amdgcn_exp2f(mx - MM), a16 = s16.y * __builtin_amdgcn_exp2f(s16.x - MM), a4 = s4.y * __builtin_amdgcn_exp2f(s4.x - MM);
            const float inv = 1.0f / (lsum * a1 + a16 + a4); osc = a1 * inv;
            if (hi == 0) { f32x2_t cc = {a16 * inv, a4 * inv}; *(LAS f32x2_t*)(St + ql * 144 + 128) = cc; } }
#pragma unroll
        for (int dh = 0; dh < 2; ++dh)
#pragma unroll
            for (int g4 = 0; g4 < 4; ++g4) { v2u w; w.x = cvtpk(O[dh][4 * g4] * osc, O[dh][4 * g4 + 1] * osc); w.y = cvtpk(O[dh][4 * g4 + 2] * osc, O[dh][4 * g4 + 3] * osc);
                *(LAS v2u*)(St + ql * 144 + (32 * dh + 8 * g4 + 4 * hi) * 2) = w; }
        if (SUB == 0) {
            unsigned char* PART = (unsigned char*)(F.ws + WS_XN) + (itcur < 1024 ? 0 : (size_t)M * BW); float* ST = (float*)(F.ws + WS_STAT) + (itcur < 1024 ? 0 : (size_t)M * NH * 2);
            unsigned char* PSC = (unsigned char*)(F.ws + WS_PSC) + (itcur < 1024 ? 0 : (size_t)M * 16);
            if (hi == 0) { const size_t qt = tb + (size_t)(s0c + i0 + ql) * dc; f32x2_t st = {mx, lsum}; *(f32x2_t*)(ST + (qt * NH + hcur) * 2) = st; }
#pragma unroll
            for (int p = 0; p < 4; ++p) { const size_t rt = tb + (size_t)(s0c + i0 + 8 * p + prow) * dc;
                const v4u ov = *(const LAS v4u*)(St + (8 * p + prow) * 144 + pch * 16);
                const float f0 = bflo(ov.x), f1 = bfhi(ov.x), f2 = bflo(ov.y), f3 = bfhi(ov.y), f4 = bflo(ov.z), f5 = bfhi(ov.z), f6 = bflo(ov.w), f7 = bfhi(ov.w);
                float bm = fmaxf(fmaxf(fmaxf(fabsf(f0), fabsf(f1)), fmaxf(fabsf(f2), fabsf(f3))), fmaxf(fmaxf(fabsf(f4), fabsf(f5)), fmaxf(fabsf(f6), fabsf(f7))));
                bm = fmaxf(bm, dpp_mov<0xB1>(bm)); bm = fmaxf(bm, dpp_mov<0x4E>(bm)); float mult; const unsigned eb = mx_scale(bm, mult);
                v2u o; o.x = pk4_fp8(f0 * mult, f1 * mult, f2 * mult, f3 * mult); o.y = pk4_fp8(f4 * mult, f5 * mult, f6 * mult, f7 * mult);
                *(v2u*)(PART + rt * BW + hcur * 64 + pch * 8) = o;
                if ((pch & 3) == 0) PSC[rt * 16 + hcur * 2 + (pch >> 2)] = (unsigned char)eb; }
        } else {
#pragma unroll
            for (int p = 0; p < 4; ++p) { const size_t rt = tb + (size_t)(s0c + i0 + 8 * p + prow) * dc;
                const v4u ov = *(const LAS v4u*)(St + (8 * p + prow) * 144 + pch * 16); const f32x2_t cc = *(const LAS f32x2_t*)(St + (8 * p + prow) * 144 + 128);
                float f[8];
                const float c16 = cc.x * __uint_as_float(e16[p] << 23), c4 = cc.y * __uint_as_float(e4[p] << 23);
                f[0] = bflo(ov.x) + c16 * __builtin_amdgcn_cvt_f32_fp8((int)x16[p].x, 0) + c4 * __builtin_amdgcn_cvt_f32_fp8((int)x4[p].x, 0); f[1] = bfhi(ov.x) + c16 * __builtin_amdgcn_cvt_f32_fp8((int)x16[p].x, 1) + c4 * __builtin_amdgcn_cvt_f32_fp8((int)x4[p].x, 1);
                f[2] = bflo(ov.y) + c16 * __builtin_amdgcn_cvt_f32_fp8((int)x16[p].x, 2) + c4 * __builtin_amdgcn_cvt_f32_fp8((int)x4[p].x, 2); f[3] = bfhi(ov.y) + c16 * __builtin_amdgcn_cvt_f32_fp8((int)x16[p].x, 3) + c4 * __builtin_amdgcn_cvt_f32_fp8((int)x4[p].x, 3);
                f[4] = bflo(ov.z) + c16 * __builtin_amdgcn_cvt_f32_fp8((int)x16[p].y, 0) + c4 * __builtin_amdgcn_cvt_f32_fp8((int)x4[p].y, 0); f[5] = bfhi(ov.z) + c16 * __builtin_amdgcn_cvt_f32_fp8((int)x16[p].y, 1) + c4 * __builtin_amdgcn_cvt_f32_fp8((int)x4[p].y, 1);
                f[6] = bflo(ov.w) + c16 * __builtin_amdgcn_cvt_f32_fp8((int)x16[p].y, 2) + c4 * __builtin_amdgcn_cvt_f32_fp8((int)x4[p].y, 2); f[7] = bfhi(ov.w) + c16 * __builtin_amdgcn_cvt_f32_fp8((int)x16[p].y, 3) + c4 * __builtin_amdgcn_cvt_f32_fp8((int)x4[p].y, 3);
                float bm = fmaxf(fmaxf(fmaxf(fabsf(f[0]), fabsf(f[1])), fmaxf(fabsf(f[2]), fabsf(f[3]))), fmaxf(fmaxf(fabsf(f[4]), fabsf(f[5])), fmaxf(fabsf(f[6]), fabsf(f[7]))));
                bm = fmaxf(bm, dpp_mov<0xB1>(bm)); bm = fmaxf(bm, dpp_mov<0x4E>(bm)); float mult; const unsigned eb = mx_scale(bm, mult);
                v2u o; o.x = pk4_fp8(f[0] * mult, f[1] * mult, f[2] * mult, f[3] * mult); o.y = pk4_fp8(f[4] * mult, f[5] * mult, f[6] * mult, f[7] * mult);
                *(v2u*)((unsigned char*)(F.ws + WS_MIXCAT) + rt * D + AW + hcur * 64 + pch * 8) = o;
                if ((pch & 3) == 0) ((unsigned char*)(F.ws + WS_SCM))[scm_index((int)rt, (AW + hcur * 64 + pch * 8) >> 5)] = (unsigned char)eb; }
        }
        __syncthreads();
        if (!has_next) break;
        ATT_WRITE(); it = itn;
        __syncthreads();
    }
#undef ATT_DECODE
#undef ATT_LOAD
#undef ATT_WRITE
}
typedef float f32x4_t __attribute__((ext_vector_type(4)));
DI void cmul_acc(float& xr, float& xi, float ar, float ai, float br, float bi) { const float nr = ar * xr - ai * xi + br, ni = ar * xi + ai * xr + bi; xr = nr; xi = ni; }
DI void mix_ssm_in(Frame& F, int l) {
    FRAME_IDS
    const bf16* P = (const bf16*)(F.ws + WS_PROJ);
    const bf16* WIN = (const bf16*)(F.ws + WS_SSM2 + l * SSM2_LAYER + S2_WIN);
    const float* apw = (const float*)(F.ws + WS_SSM2 + l * SSM2_LAYER + S2_APW);
    float* XLOC = (float*)(F.ws + WS_XLOC); float* XSUP = (float*)(F.ws + WS_XSUP);
    const int row = lane_ & 15, q = lane_ >> 4;
    for (int it = F.vcu; it < 256; it += F.G) {
        const int b = it >> 5, sc = (it >> 2) & 7, g = 4 * (it & 3) + (wave_ >> 1), half = wave_ & 1;
        bf16x8 af[16];
        { const bf16* src = P + ((size_t)b * T + (size_t)(16 * sc + row) * 32 + (q >> 1)) * PROJW + COL_S + g * 16 + 8 * (q & 1);
#pragma unroll
          for (int sp = 0; sp < 16; ++sp) af[sp] = *(const bf16x8*)(src + (size_t)(2 * sp) * PROJW); }
#pragma unroll 1
        for (int c4 = 0; c4 < 4; ++c4) { const int ct = 4 * half + c4;
            f32x4_t acc = {0.f, 0.f, 0.f, 0.f};
            const bf16* wp = WIN + (((size_t)(g * 16) * 8 + ct) * 64 + lane_) * 8;
#pragma unroll
            for (int sp = 0; sp < 16; ++sp) { const bf16x8 bfr = *(const bf16x8*)(wp + (size_t)sp * 8 * 64 * 8); acc = __builtin_amdgcn_mfma_f32_16x16x32_bf16(af[sp], bfr, acc, 0, 0, 0); }
            const int comp = 16 * ct + row, n = comp >> 1, part = comp & 1;
#pragma unroll
            for (int r = 0; r < 4; ++r) XLOC[(((size_t)b * 128 + 16 * sc + 4 * q + r) * 16 + g) * 128 + comp] = acc[r];
            const float a32r = apw[((g * 33 + 32) * 64 + n) * 2], a32i = apw[((g * 33 + 32) * 64 + n) * 2 + 1];
            const float sg = part ? 1.f : -1.f;
            float h = acc[0];
#pragma unroll
            for (int r = 1; r < 4; ++r) { const float o = __shfl_xor(h, 1); h = a32r * h + sg * a32i * o + acc[r]; }
            float p64r = a32r * a32r - a32i * a32i, p64i = 2.f * a32r * a32i;
            float p128r = p64r * p64r - p64i * p64i, p128i = 2.f * p64r * p64i;
            float wr = 1.f, wi = 0.f;
            for (int k = 0; k < 3 - q; ++k) { const float t0 = wr * p128r - wi * p128i, t1 = wr * p128i + wi * p128r; wr = t0; wi = t1; }
            { const float o = __shfl_xor(h, 1); h = wr * h + sg * wi * o; }
            h += __shfl_xor(h, 16); h += __shfl_xor(h, 32);
            if (q == 0) XSUP[(((size_t)b * 8 + sc) * 16 + g) * 128 + comp] = h;
        }
    }
}
DI void mix_ssm_out(Frame& F, const Args& A, int l) {
    FRAME_IDS
    const bf16* P = (const bf16*)(F.ws + WS_PROJ); bf16* YG = (bf16*)(F.ws + WS_YG);
    const bf16* KT = (const bf16*)(F.ws + WS_SSM2 + l * SSM2_LAYER + S2_KT); const bf16* CT = (const bf16*)(F.ws + WS_SSM2 + l * SSM2_LAYER + S2_CT);
    const float* apw = (const float*)(F.ws + WS_SSM2 + l * SSM2_LAYER + S2_APW);
    const float* XLOC = (const float*)(F.ws + WS_XLOC); const float* XSUP = (const float*)(F.ws + WS_XSUP);
    LAS unsigned char* Ut = F.lds + RING_OFF + wave_ * 4096;
    LAS float* Xs = (LAS float*)(F.lds + RING_OFF + wave_ * 4096 + 2048);
    for (int i = lane_; i < 256; i += 64) ((LAS unsigned*)Ut)[i] = 0u;
    const int row = lane_ & 15, q = lane_ >> 4;
    for (int it = F.vcu; it < 256; it += F.G) {
        const int b = it >> 5, sc = (it >> 2) & 7, g = 4 * (it & 3) + (wave_ >> 1), half = wave_ & 1, n = lane_;
        const size_t tokA = (size_t)b * T + (size_t)(16 * sc + 8 * half) * 32;
        v4u unext = *(const v4u*)(P + (tokA + (lane_ >> 1)) * PROJW + COL_S + g * 16 + 8 * (lane_ & 1));
        f32x2_t psup[8], ploc[8];
#pragma unroll
        for (int s2 = 0; s2 < 8; ++s2) { psup[s2] = (f32x2_t){0.f, 0.f}; if (s2 < sc) psup[s2] = *(const f32x2_t*)(XSUP + (((size_t)b * 8 + s2) * 16 + g) * 128 + 2 * n); }
#pragma unroll
        for (int k2 = 0; k2 < 8; ++k2) { ploc[k2] = (f32x2_t){0.f, 0.f}; if (half) ploc[k2] = *(const f32x2_t*)(XLOC + (((size_t)b * 128 + 16 * sc + k2) * 16 + g) * 128 + 2 * n); }
        const float dsk = ((const float*)A.in[I_SSMD])[(l * 16 + g) * 16 + row];
        const float a32r = apw[((g * 33 + 32) * 64 + n) * 2], a32i = apw[((g * 33 + 32) * 64 + n) * 2 + 1];
        const float a16r = apw[((g * 33 + 16) * 64 + n) * 2], a16i = apw[((g * 33 + 16) * 64 + n) * 2 + 1];
        float a512r = a32r, a512i = a32i;
#pragma unroll
        for (int k = 0; k < 4; ++k) { const float t0 = a512r * a512r - a512i * a512i, t1 = 2.f * a512r * a512i; a512r = t0; a512i = t1; }
        float xr = 0.f, xi = 0.f;
#pragma unroll
        for (int s2 = 0; s2 < 8; ++s2) if (s2 < sc) cmul_acc(xr, xi, a512r, a512i, psup[s2].x, psup[s2].y);
        if (half) {
#pragma unroll
            for (int k2 = 0; k2 < 8; ++k2) cmul_acc(xr, xi, a32r, a32i, ploc[k2].x, ploc[k2].y); }
        asm volatile("" : "+v"(xr), "+v"(xi) :: "memory");
        bf16x8 kt[16], ctf[4];
#pragma unroll
        for (int p = 0; p < 16; ++p) kt[p] = *(const bf16x8*)(KT + ((size_t)(g * 16 + p) * 64 + lane_) * 8);
#pragma unroll
        for (int sx = 0; sx < 4; ++sx) ctf[sx] = *(const bf16x8*)(CT + ((size_t)(g * 4 + sx) * 64 + lane_) * 8);
        f32x4_t apr[4][2];
#pragma unroll
        for (int sx = 0; sx < 4; ++sx) { const f32x4_t* ap = (const f32x4_t*)(apw + ((size_t)(g * 33 + row + 1) * 64 + 16 * sx + 4 * q) * 2); apr[sx][0] = ap[0]; apr[sx][1] = ap[1]; }
#pragma unroll 1
        for (int kk = 0; kk < 8; ++kk) {
            const size_t tok0 = tokA + (size_t)kk * 32;
            const f32x2_t xl = *(const f32x2_t*)(XLOC + (((size_t)b * 128 + 16 * sc + 8 * half + kk) * 16 + g) * 128 + 2 * n);
            *(LAS v4u*)(Ut + 1024 + lane_ * 16) = unext;
            if (kk < 7) unext = *(const v4u*)(P + (tok0 + 32 + (lane_ >> 1)) * PROJW + COL_S + g * 16 + 8 * (lane_ & 1));
            Xs[2 * n] = xr; Xs[2 * n + 1] = xi; Xs[128 + 2 * n] = a16r * xr - a16i * xi; Xs[128 + 2 * n + 1] = a16r * xi + a16i * xr;
#pragma unroll
            for (int tau = 0; tau < 2; ++tau) { f32x4_t acc = (f32x4_t){0.f, 0.f, 0.f, 0.f};
                const int ti = 16 * tau + row;
#pragma unroll
                for (int sx = 0; sx < 4; ++sx) { const LAS f32x4_t* xp = (const LAS f32x4_t*)(Xs + 128 * tau + 2 * (16 * sx + 4 * q)); const f32x4_t x01 = xp[0], x23 = xp[1];
                    const f32x4_t a01 = apr[sx][0], a23 = apr[sx][1];
                    v4u zw; zw.x = cvtpk(a01.x * x01.x - a01.y * x01.y, a01.x * x01.y + a01.y * x01.x); zw.y = cvtpk(a01.z * x01.z - a01.w * x01.w, a01.z * x01.w + a01.w * x01.z);
                    zw.z = cvtpk(a23.x * x23.x - a23.y * x23.y, a23.x * x23.y + a23.y * x23.x); zw.w = cvtpk(a23.z * x23.z - a23.w * x23.w, a23.z * x23.w + a23.w * x23.z);
                    acc = __builtin_amdgcn_mfma_f32_16x16x32_bf16(__builtin_bit_cast(bf16x8, zw), ctf[sx], acc, 0, 0, 0);
                    asm volatile("" ::: "memory"); }
#pragma unroll
                for (int p = 0; p < 16; ++p) if (p < 8 * tau + 8) { const bf16x8 ua = *(const LAS bf16x8*)(Ut + (32 + ti - 2 * p - (q >> 1)) * 32 + 16 * (q & 1));
                    acc = __builtin_amdgcn_mfma_f32_16x16x32_bf16(ua, kt[p], acc, 0, 0, 0); if ((p & 3) == 3) asm volatile("" ::: "memory"); }
#pragma unroll
                for (int r = 0; r < 4; ++r) { const int t2 = 16 * tau + 4 * q + r; const float uu = bf2f(*(const LAS bf16*)(Ut + (32 + t2) * 32 + 2 * row));
                    YG[(tok0 + t2) * 256 + g * 16 + row] = (bf16)f2bf(gelu_tanh_f(acc[r] + dsk * uu)); }
            }
            cmul_acc(xr, xi, a32r, a32i, xl.x, xl.y);
        }
    }
}
DI void mix_gating_mfma(Frame& F, const Args& A, int l, int variant = 0) {
    FRAME_IDS
    const bf16* P = (const bf16*)(F.ws + WS_PROJ); bf16* MIX = (bf16*)(F.ws + WS_MIXCAT);
    const bf16* GW = (const bf16*)(F.ws + WS_SSM2 + l * SSM2_LAYER + S2_GW);
    const float* lng = (const float*)A.in[I_GMLNG] + l * AW; const float* lnb = (const float*)A.in[I_GMLNB] + l * AW;
    const float* bs_ = (const float*)A.in[I_GMBS] + l * 4 * 128;
    LAS unsigned char* VT = F.lds + RING_OFF;
    const int ql = lane_ & 31, hi = lane_ >> 5, trq = (lane_ & 15) >> 2, trg = (lane_ >> 4) & 1, trp = lane_ & 3;
    for (int it = F.vcu; it < BATCH * (T / 128); it += F.G) {
        const int m0 = it * 128;
        __syncthreads();
        if (variant != 2) {
        v2u wv[16];
#pragma unroll
        for (int j = 0; j < 16; ++j) wv[j] = *(const v2u*)(P + (size_t)(m0 + wave_ + 8 * j) * PROJW + COL_V + 4 * lane_);
        const f32x4 gg = *(const f32x4*)(lng + 4 * lane_), bb = *(const f32x4*)(lnb + 4 * lane_);
#pragma unroll
        for (int j = 0; j < 16; ++j) { const int r = wave_ + 8 * j; const v2u w = wv[j];
            float v[4] = {gelu_tanh_f(bflo(w.x)), gelu_tanh_f(bfhi(w.x)), gelu_tanh_f(bflo(w.y)), gelu_tanh_f(bfhi(w.y))};
            const float mean = wave_sum(v[0] + v[1] + v[2] + v[3]) * (1.f / 256.f);
            float s2 = 0.f;
#pragma unroll
            for (int i = 0; i < 4; ++i) { v[i] -= mean; s2 += v[i] * v[i]; }
            const float rstd = 1.0f / sqrtf(wave_sum(s2) * (1.f / 256.f) + LN_EPS);
            v2u o; o.x = cvtpk(v[0] * rstd * gg.x + bb.x, v[1] * rstd * gg.y + bb.y); o.y = cvtpk(v[2] * rstd * gg.z + bb.z, v[3] * rstd * gg.w + bb.w);
            *(LAS v2u*)(VT + r * 512 + (((lane_ >> 1) ^ ((r & 3) << 2)) << 4) + 8 * (lane_ & 1)) = o;
        }
        }
        __syncthreads();
        if (variant == 1) continue;
        const int h = wave_ >> 1, cb = 64 * h + 32 * (wave_ & 1);
        const int chunk = (cb >> 3) + 2 * trg + (trp >> 1);
#pragma unroll
        for (int rt = 0; rt < 4; ++rt) {
            f32x16 acc;
#pragma unroll
            for (int i = 0; i < 16; ++i) acc[i] = 0.f;
            bf16x8 wa[8];
#pragma unroll
            for (int ks = 0; ks < 2 * rt + 2; ++ks) wa[ks] = *(const bf16x8*)(GW + (size_t)(h * 128 + 32 * rt) * 128 + 16 * ks + (unsigned)(ql * 128 + 8 * hi));
#pragma unroll
            for (int ks = 0; ks < 2 * rt + 2; ++ks) {
                const int rlo = 16 * ks + 8 * hi + trq;
                const v4i16_t lo = __builtin_amdgcn_ds_read_tr16_b64_v4i16((LAS v4i16_t*)(VT + rlo * 512 + ((chunk ^ (trq << 2)) << 4) + 8 * (trp & 1)));
                const v4i16_t hh = __builtin_amdgcn_ds_read_tr16_b64_v4i16((LAS v4i16_t*)(VT + (rlo + 4) * 512 + ((chunk ^ (trq << 2)) << 4) + 8 * (trp & 1)));
                const bf16x8 va = (bf16x8){lo[0], lo[1], lo[2], lo[3], hh[0], hh[1], hh[2], hh[3]};
                acc = __builtin_amdgcn_mfma_f32_32x32x16_bf16(va, wa[ks], acc, 0, 0, 0); }
            { const int t = 32 * rt + ql; const float bsv = bs_[h * 128 + t];
              const bf16* up = P + (size_t)(m0 + t) * PROJW + COL_U + cb + 4 * hi; unsigned char* op = (unsigned char*)MIX + (size_t)(m0 + t) * D + cb + 4 * hi;
              float ov[16]; float bm = 0.f;
#pragma unroll
              for (int g4 = 0; g4 < 4; ++g4) { const v2u uw = *(const v2u*)(up + 8 * g4);
                  ov[4 * g4] = gelu_tanh_f(bflo(uw.x)) * (acc[4 * g4] + bsv); ov[4 * g4 + 1] = gelu_tanh_f(bfhi(uw.x)) * (acc[4 * g4 + 1] + bsv); ov[4 * g4 + 2] = gelu_tanh_f(bflo(uw.y)) * (acc[4 * g4 + 2] + bsv); ov[4 * g4 + 3] = gelu_tanh_f(bfhi(uw.y)) * (acc[4 * g4 + 3] + bsv); }
#pragma unroll
              for (int i = 0; i < 16; ++i) bm = fmaxf(bm, fabsf(ov[i]));
              bm = fmaxf(bm, __shfl_xor(bm, 32)); float mult; const unsigned eb = mx_scale(bm, mult);
#pragma unroll
              for (int g4 = 0; g4 < 4; ++g4) *(unsigned*)(op + 8 * g4) = pk4_fp8(ov[4 * g4] * mult, ov[4 * g4 + 1] * mult, ov[4 * g4 + 2] * mult, ov[4 * g4 + 3] * mult);
              if (hi == 0) ((unsigned char*)(F.ws + WS_SCM))[scm_index(m0 + t, cb >> 5)] = (unsigned char)eb; }
        }
    }
}

DI void p_glu(Frame& F, const Args& A, int l) {
    FRAME_IDS
    const bf16* YG = (const bf16*)(F.ws + WS_YG); bf16* MIX = (bf16*)(F.ws + WS_MIXCAT);
    const bf16* GluT = (const bf16*)(F.ws + WS_WSMALL + l * WSMALL_LAYER + WOFF_GLU); const float* gb = (const float*)A.in[I_GLUB] + l * 256;
    LAS unsigned char* Bs = F.lds + RING_OFF;
#pragma unroll
    for (int i = 0; i < 16; ++i) { const int idx = tid_ + 512 * i, n = idx >> 5, ch = idx & 31;
        *(LAS v4u*)(Bs + n * 512 + ((ch ^ (n & 15)) << 4)) = *(const v4u*)(GluT + (size_t)n * 256 + ch * 8); }
    __syncthreads();
    const int tk = lane_ & 15, q = lane_ >> 4;
    for (int rt = F.vcu; rt < M / 128; rt += F.G) {
        const size_t tok = (size_t)rt * 128 + wave_ * 16 + tk;
        bf16x8 yf[8];
#pragma unroll
        for (int ks = 0; ks < 8; ++ks) yf[ks] = *(const bf16x8*)(YG + tok * 256 + 32 * ks + 8 * q);
#pragma unroll 2
        for (int cp = 0; cp < 8; ++cp) {
            float ov[8];
#pragma unroll
            for (int c2 = 0; c2 < 2; ++c2) { const int ct = 2 * cp + c2;
                f32x4_t acc = {0.f, 0.f, 0.f, 0.f};
                const int n = 16 * ct + tk;
#pragma unroll
                for (int ks = 0; ks < 8; ++ks) { const bf16x8 wf = *(const LAS bf16x8*)(Bs + n * 512 + (((4 * ks + q) ^ (n & 15)) << 4));
                    acc = __builtin_amdgcn_mfma_f32_16x16x32_bf16(wf, yf[ks], acc, 0, 0, 0); }
                const int n0 = 16 * ct + 4 * q; const v2u yw = *(const v2u*)(YG + tok * 256 + n0); const f32x4 bv = *(const f32x4*)(gb + n0);
                ov[4 * c2] = bflo(yw.x) * sigmoid_f(acc[0] + bv.x); ov[4 * c2 + 1] = bfhi(yw.x) * sigmoid_f(acc[1] + bv.y); ov[4 * c2 + 2] = bflo(yw.y) * sigmoid_f(acc[2] + bv.z); ov[4 * c2 + 3] = bfhi(yw.y) * sigmoid_f(acc[3] + bv.w); }
            float bm = fmaxf(fmaxf(fmaxf(fabsf(ov[0]), fabsf(ov[1])), fmaxf(fabsf(ov[2]), fabsf(ov[3]))), fmaxf(fmaxf(fabsf(ov[4]), fabsf(ov[5])), fmaxf(fabsf(ov[6]), fabsf(ov[7]))));
            bm = fmaxf(bm, __shfl_xor(bm, 16)); bm = fmaxf(bm, __shfl_xor(bm, 32)); float mult; const unsigned eb = mx_scale(bm, mult);
            unsigned char* op = (unsigned char*)MIX + tok * D + 768 + 32 * cp + 4 * q;
            *(unsigned*)op = pk4_fp8(ov[0] * mult, ov[1] * mult, ov[2] * mult, ov[3] * mult); *(unsigned*)(op + 16) = pk4_fp8(ov[4] * mult, ov[5] * mult, ov[6] * mult, ov[7] * mult);
            if (q == 0) ((unsigned char*)(F.ws + WS_SCM))[scm_index((int)tok, 24 + cp)] = (unsigned char)eb;
        }
    }
}
DI void mix_ssm_simple(Frame& F, const Args& A, int l) {
    FRAME_IDS
    const bf16* P = (const bf16*)(F.ws + WS_PROJ); bf16* YG = (bf16*)(F.ws + WS_YG);
    const float* tab = (const float*)(F.ws + WS_SSM) + (size_t)l * SSM_TAB;
    LAS float* fin = (LAS float*)(F.lds + RING_OFF);
    for (int it = F.vcu; it < BATCH * SSM_G; it += F.G) {
        const int b = it >> 4, g = it & 15, n = lane_, seg = wave_, gn = g * 64 + n;
        const float are = tab[gn], aim = tab[1024 + gn];
        float bre[16], bim[16], cre[16], cim[16];
#pragma unroll
        for (int c = 0; c < 16; ++c) { bre[c] = tab[2048 + gn * 16 + c]; bim[c] = tab[2048 + 16384 + gn * 16 + c];
            cre[c] = ((const float*)A.in[I_CRE])[(((size_t)l * 16 + g) * 16 + c) * 64 + n]; cim[c] = ((const float*)A.in[I_CIM])[(((size_t)l * 16 + g) * 16 + c) * 64 + n]; }
        const float dsk = ((const float*)A.in[I_SSMD])[(l * 16 + g) * 16 + (lane_ & 15)];
        const size_t mbase = (size_t)b * T + seg * 512;
        float xr = 0.f, xi = 0.f;
        for (int tt = 0; tt < 512; ++tt) { const v4u* up = (const v4u*)(P + (mbase + tt) * PROJW + COL_S + g * 16); const v4u u0 = up[0], u1 = up[1];
            const float u[16] = {bflo(u0.x), bfhi(u0.x), bflo(u0.y), bfhi(u0.y), bflo(u0.z), bfhi(u0.z), bflo(u0.w), bfhi(u0.w), bflo(u1.x), bfhi(u1.x), bflo(u1.y), bfhi(u1.y), bflo(u1.z), bfhi(u1.z), bflo(u1.w), bfhi(u1.w)};
            float br = 0.f, bi = 0.f;
#pragma unroll
            for (int c = 0; c < 16; ++c) { br += u[c] * bre[c]; bi += u[c] * bim[c]; }
            const float nr = are * xr - aim * xi + br, ni = are * xi + aim * xr + bi; xr = nr; xi = ni; }
        fin[(seg * 64 + n) * 2] = xr; fin[(seg * 64 + n) * 2 + 1] = xi;
        __syncthreads();
        float pr = are, pi = aim;
#pragma unroll
        for (int k = 0; k < 9; ++k) { const float t0 = pr * pr - pi * pi, t1 = 2.f * pr * pi; pr = t0; pi = t1; }
        xr = 0.f; xi = 0.f;
        for (int s = 0; s < seg; ++s) { const float fr_ = fin[(s * 64 + n) * 2], fi_ = fin[(s * 64 + n) * 2 + 1];
            const float nr = pr * xr - pi * xi + fr_, ni = pr * xi + pi * xr + fi_; xr = nr; xi = ni; }
        for (int tt = 0; tt < 512; ++tt) { const v4u* up = (const v4u*)(P + (mbase + tt) * PROJW + COL_S + g * 16); const v4u u0 = up[0], u1 = up[1];
            const float u[16] = {bflo(u0.x), bfhi(u0.x), bflo(u0.y), bfhi(u0.y), bflo(u0.z), bfhi(u0.z), bflo(u0.w), bfhi(u0.w), bflo(u1.x), bfhi(u1.x), bflo(u1.y), bfhi(u1.y), bflo(u1.z), bfhi(u1.z), bflo(u1.w), bfhi(u1.w)};
            float br = 0.f, bi = 0.f;
#pragma unroll
            for (int c = 0; c < 16; ++c) { br += u[c] * bre[c]; bi += u[c] * bim[c]; }
            const float nr = are * xr - aim * xi + br, ni = are * xi + aim * xr + bi; xr = nr; xi = ni;
            float ysel = 0.f, usel = 0.f;
#pragma unroll
            for (int c = 0; c < 16; ++c) { const float r = wave_sum(xr * cre[c] - xi * cim[c]); if ((lane_ & 15) == c) { ysel = r; usel = u[c]; } }
            if (lane_ < 16) { const float y = ysel + dsk * usel; YG[(mbase + tt) * 256 + g * 16 + lane_] = (bf16)f2bf(gelu_tanh_f(y)); } }
        __syncthreads();
    }
}

DI bool beats(float x, int i, float y, int j) { return x > y || (x == y && i < j); }
DI void p_row_b(Frame& F, const Args& A, int l, bool count = true) {
    FRAME_IDS
    const int gw = F.vcu * NWAVES + wave_, NGW = F.G * NWAVES;
    const bf16* PRE = (const bf16*)(F.ws + WS_PRE); bf16* X1 = (bf16*)(F.ws + WS_X1); bf16* XN = (bf16*)(F.ws + WS_XN);
    const float* mod = (const float*)(F.ws + WS_MOD) + (size_t)l * BATCH * 6 * D;
    const float* ln1g = (const float*)A.in[I_LN1G] + l * D; const float* ln1b = (const float*)A.in[I_LN1B] + l * D;
    const float* rw = (const float*)A.in[I_RW]; const float* rb = (const float*)A.in[I_RB];
    int* slot_a = (int*)(F.ws + WS_SLOT_A); float* slot_w = (float*)(F.ws + WS_SLOT_W);
    LAS float* rwS = (LAS float*)(F.lds + RING_OFF);
    volatile LAS unsigned* lcnt = (volatile LAS unsigned*)(F.lds + RING_OFF + 65536);
    LAS int* list_a = (LAS int*)(F.lds + RING_OFF + 66048); LAS float* list_w = (LAS float*)(F.lds + RING_OFF + 66048 + 8192);
    for (int i = tid_; i < D * NEXP; i += NTHR) rwS[(i & 15) * D + (i >> 4)] = rw[i];
    if (tid_ < 32) lcnt[tid_] = 0u;
    __syncthreads();
    const int hi5 = lane_ >> 5, b4 = (lane_ >> 4) & 1, b3 = (lane_ >> 3) & 1, b2 = (lane_ >> 2) & 1, emine = 8 * hi5 + 4 * b4 + 2 * b3 + b2;
    const int wi = 2 * b3 + b2, mygrp = 2 * hi5 + b4;
    const float rbm = rb[emine];
    Row16 lg1, lb1; row_load_f32(lg1, ln1g, lane_); row_load_f32(lb1, ln1b, lane_);
    v2u nraw[4];
    const int bq = gw / (NGW / BATCH), mbase = bq * T + gw % (NGW / BATCH), mstep = NGW / BATCH;
    const float* md = mod + (size_t)bq * 6 * D;
    Row16 msc, msh; row_load_f32(msc, md + 4 * D, lane_); row_load_f32(msh, md + 3 * D, lane_);
    { const v2u* q = (const v2u*)(PRE + (size_t)mbase * D);
#pragma unroll
      for (int k = 0; k < 4; ++k) nraw[k] = q[k * 64 + lane_]; }
    for (int m = mbase; m < (bq + 1) * T; m += mstep) {
        Row16 r;
#pragma unroll
        for (int k = 0; k < 4; ++k) { r.v[4 * k] = bflo(nraw[k].x); r.v[4 * k + 1] = bfhi(nraw[k].x); r.v[4 * k + 2] = bflo(nraw[k].y); r.v[4 * k + 3] = bfhi(nraw[k].y); }
        if (m + mstep < (bq + 1) * T) { const v2u* q = (const v2u*)(PRE + (size_t)(m + mstep) * D);
#pragma unroll
            for (int k = 0; k < 4; ++k) nraw[k] = q[k * 64 + lane_]; }
        row_ln(r);
#pragma unroll
        for (int i = 0; i < 16; ++i) r.v[i] = r.v[i] * lg1.v[i] + lb1.v[i];
        row_ln(r);
#pragma unroll
        for (int i = 0; i < 16; ++i) r.v[i] = r.v[i] * (1.0f + msc.v[i]) + msh.v[i];
        unsigned ib;
        { float am = 0.f;
#pragma unroll
          for (int i = 0; i < 16; ++i) am = fmaxf(am, fabsf(r.v[i]));
          am = wave_max(am); ib = (am > 1e-30f) ? ((__float_as_uint(am * (1.0f / 440.0f)) + 0xffffu) & 0xffff0000u) : 0x3f800000u;
          const float qs = 1.0f / __uint_as_float(ib);
          unsigned* q8 = (unsigned*)((unsigned char*)XN + (size_t)m * D);
#pragma unroll
          for (int k = 0; k < 4; ++k) q8[k * 64 + lane_] = pk4_fp8(r.v[4 * k] * qs, r.v[4 * k + 1] * qs, r.v[4 * k + 2] * qs, r.v[4 * k + 3] * qs); }
        float lg[16];
#pragma unroll
        for (int e = 0; e < 16; ++e) { float a = 0.f;
#pragma unroll
            for (int k = 0; k < 4; ++k) { const f32x4 w4 = *(const LAS f32x4*)(rwS + e * D + 256 * k + 4 * lane_); a += r.v[4 * k] * w4.x + r.v[4 * k + 1] * w4.y + r.v[4 * k + 2] * w4.z + r.v[4 * k + 3] * w4.w; }
            lg[e] = a; }
        float t8[8], t4[4], t2[2];
#pragma unroll
        for (int i = 0; i < 8; ++i) { const float keep = hi5 ? lg[8 + i] : lg[i], give = hi5 ? lg[i] : lg[8 + i]; t8[i] = keep + __shfl_xor(give, 32); }
#pragma unroll
        for (int i = 0; i < 4; ++i) { const float keep = b4 ? t8[4 + i] : t8[i], give = b4 ? t8[i] : t8[4 + i]; t4[i] = keep + __shfl_xor(give, 16); }
#pragma unroll
        for (int i = 0; i < 2; ++i) { const float keep = b3 ? t4[2 + i] : t4[i], give = b3 ? t4[i] : t4[2 + i]; t2[i] = keep + __shfl_xor(give, 8); }
        float z = (b2 ? t2[1] : t2[0]) + __shfl_xor(b2 ? t2[0] : t2[1], 4);
        z += __shfl_xor(z, 2); z += __shfl_xor(z, 1);
        const float scm = 1.0f / (1.0f + __builtin_amdgcn_exp2f(-1.4426950408889634f * z)), a = scm + rbm;
        const float p4 = __shfl_xor(a, 4), p8 = __shfl_xor(a, 8), p12 = __shfl_xor(a, 12);
        const float hi01 = fmaxf(a, p4), lo01 = fminf(a, p4), hi23 = fmaxf(p8, p12), lo23 = fminf(p8, p12);
        const float gs = fmaxf(hi01, hi23) + fmaxf(fmaxf(lo01, lo23), fminf(hi01, hi23));
        const float g16 = __shfl_xor(gs, 16), g32 = __shfl_xor(gs, 32), g48 = __shfl_xor(gs, 48);
        const bool best = beats(gs, mygrp, g16, mygrp ^ 1) && beats(gs, mygrp, g32, mygrp ^ 2) && beats(gs, mygrp, g48, mygrp ^ 3);
        const int rank = (beats(p4, wi ^ 1, a, wi) ? 1 : 0) + (beats(p8, wi ^ 2, a, wi) ? 1 : 0) + (beats(p12, wi ^ 3, a, wi) ? 1 : 0);
        const bool sel = best && rank < 2;
        float tot = sel ? scm : 0.f; tot += __shfl_xor(tot, 4); tot += __shfl_xor(tot, 8);
        if (count && sel && (lane_ & 3) == 0) { const unsigned rk = atomicAdd((unsigned*)&lcnt[emine], 1u);
            list_a[emine * 128 + rk] = (int)((unsigned)(2 * m + rank) | ib); list_w[emine * 128 + rk] = scm / tot; }
    }
    __syncthreads();
    if (count) {
        if (tid_ < 16) { const unsigned n = lcnt[tid_]; lcnt[16 + tid_] = n ? atomicAdd((unsigned*)(F.ctl + CW_CNT + l * 128 + tid_), n) : 0u; }
        __syncthreads();
        for (int idx = tid_; idx < 16 * 128; idx += NTHR) { const int e = idx >> 7, rk = idx & 127;
            if (rk < (int)lcnt[e]) { const size_t slot = (size_t)e * SLOT_CAP + lcnt[16 + e] + rk; slot_a[slot] = list_a[idx]; slot_w[slot] = list_w[idx]; } }
    }
}

DI void moe_tstart(Frame& F, int l) {
    FRAME_IDS
    volatile LAS int* ts = (volatile LAS int*)(F.lds + LDSCTL_OFF);
    __syncthreads();
    if (tid_ == 0) { int acc = 0;
        for (int e = 0; e < 16; ++e) { ts[e] = acc; const unsigned c = __hip_atomic_load(F.ctl + CW_CNT + l * 128 + e, RLX_AGENT); ts[32 + e] = (int)c; acc += (int)((c + 255u) >> 8); }
        ts[16] = acc; }
    __syncthreads();
}
DI void p_row_c(Frame& F, const Args& A, int l) {
    FRAME_IDS
    const int gw = F.vcu * NWAVES + wave_, NGW = F.G * NWAVES;
    const bf16* X1 = (const bf16*)(F.ws + WS_PRE); bf16* R2 = (bf16*)(F.ws + WS_ROWS2); bf16* XN = (bf16*)(F.ws + WS_XN);
    const float* ln1g = (const float*)A.in[I_LN1G] + l * D; const float* ln1b = (const float*)A.in[I_LN1B] + l * D;
    Row16 lg1, lb1; row_load_f32(lg1, ln1g, lane_); row_load_f32(lb1, ln1b, lane_);
    const float* mod = (const float*)(F.ws + WS_MOD) + (size_t)l * BATCH * 6 * D;
    const float* modn = (const float*)(F.ws + WS_MOD) + (size_t)(l + 1) * BATCH * 6 * D;
    const float* ln2g = (const float*)A.in[I_LN2G] + l * D; const float* ln2b = (const float*)A.in[I_LN2B] + l * D;
    Row16 lg2, lb2; row_load_f32(lg2, ln2g, lane_); row_load_f32(lb2, ln2b, lane_);
    v2u nx[4]; unsigned n0[4], n1[4], sc0, sc1;
    const unsigned char* SCR = (const unsigned char*)(F.ws + WS_SCR);
#define RC_LOAD(mm) do { const v2u* qa = (const v2u*)(X1 + (size_t)(mm) * D); const unsigned* qb = (const unsigned*)(R2 + (size_t)(2 * (mm)) * D); \
        _Pragma("unroll") for (int k = 0; k < 4; ++k) { nx[k] = __builtin_nontemporal_load(&qa[k * 64 + lane_]); n0[k] = __builtin_nontemporal_load(&qb[k * 64 + lane_]); n1[k] = __builtin_nontemporal_load(&qb[512 + k * 64 + lane_]); } \
        sc0 = ((const unsigned*)(SCR + (size_t)(2 * (mm)) * 32))[lane_ >> 3]; sc1 = ((const unsigned*)(SCR + (size_t)(2 * (mm) + 1) * 32))[lane_ >> 3]; } while (0)
    const int bq = gw / (NGW / BATCH), mbase = bq * T + gw % (NGW / BATCH), mstep = NGW / BATCH;
    const float* md = mod + (size_t)bq * 6 * D;
    Row16 gm; row_load_f32(gm, md + 5 * D, lane_);
    Row16 msc, msh;
    if (l != DEPTH - 1) { const float* mdn = modn + (size_t)bq * 6 * D; row_load_f32(msc, mdn + 1 * D, lane_); row_load_f32(msh, mdn + 0 * D, lane_); }
    RC_LOAD(mbase);
    for (int m = mbase; m < (bq + 1) * T; m += mstep) {
        Row16 x1, g2;
#pragma unroll
        for (int k = 0; k < 4; ++k) {
            x1.v[4 * k] = bflo(nx[k].x); x1.v[4 * k + 1] = bfhi(nx[k].x); x1.v[4 * k + 2] = bflo(nx[k].y); x1.v[4 * k + 3] = bfhi(nx[k].y);
            { const float f0 = __uint_as_float(((sc0 >> (8 * k)) & 0xffu) << 23), f1 = __uint_as_float(((sc1 >> (8 * k)) & 0xffu) << 23);
              g2.v[4 * k] = __builtin_amdgcn_cvt_f32_fp8((int)n0[k], 0) * f0 + __builtin_amdgcn_cvt_f32_fp8((int)n1[k], 0) * f1; g2.v[4 * k + 1] = __builtin_amdgcn_cvt_f32_fp8((int)n0[k], 1) * f0 + __builtin_amdgcn_cvt_f32_fp8((int)n1[k], 1) * f1;
              g2.v[4 * k + 2] = __builtin_amdgcn_cvt_f32_fp8((int)n0[k], 2) * f0 + __builtin_amdgcn_cvt_f32_fp8((int)n1[k], 2) * f1; g2.v[4 * k + 3] = __builtin_amdgcn_cvt_f32_fp8((int)n0[k], 3) * f0 + __builtin_amdgcn_cvt_f32_fp8((int)n1[k], 3) * f1; } }
        if (m + mstep < (bq + 1) * T) RC_LOAD(m + mstep);
        row_ln(x1);
#pragma unroll
        for (int i = 0; i < 16; ++i) x1.v[i] = ALPHA * (x1.v[i] * lg1.v[i] + lb1.v[i]) + (1.0f + gm.v[i]) * g2.v[i];
        row_ln(x1);
#pragma unroll
        for (int i = 0; i < 16; ++i) x1.v[i] = x1.v[i] * lg2.v[i] + lb2.v[i];
        if (l == DEPTH - 1) row_store_f32(x1, A.out + (size_t)m * D, lane_);
        else { row_store_bf16(x1, R2 + (size_t)(2 * m) * D, lane_);
            row_ln(x1);
#pragma unroll
            for (int i = 0; i < 16; ++i) x1.v[i] = x1.v[i] * (1.0f + msc.v[i]) + msh.v[i];
            row_store_fp8(x1, (unsigned char*)XN + (size_t)m * D, (float*)(F.ws + WS_SA) + m, lane_); }
    }
#undef RC_LOAD
}

#ifndef PHMASK
#define PHMASK 0xFFFFFFFFu
#endif
#define IN(k) (lo <= (k) && (k) < hi && ((PHMASK >> (((k) == 0) ? 31 : (((k) - 1) % PH_PER_LAYER))) & 1u))
#define SEAM(k) do { if (IN((k) + 1) && MK_ONE_LAUNCH) xcd_barrier(bar); else __syncthreads(); } while (0)
constexpr int PH_PER_LAYER = 9, N_PHASES = 1 + DEPTH * PH_PER_LAYER;
#ifndef REP_PH
#define REP_PH -1
#endif
#define NREP(k) (((k) == REP_PH) ? 2 : 1)
template <int l> DI void layer_body(Frame& F, const Args& args, const XcdBarrier& bar, const int lo, const int hi) {
    unsigned char* ws = args.ws;

        const int pb = 1 + l * PH_PER_LAYER;
        const bf16* WinT = (const bf16*)(ws + WS_WSMALL + l * WSMALL_LAYER + WOFF_IN);
        const bf16* WoutT = (const bf16*)(ws + WS_WSMALL + l * WSMALL_LAYER + WOFF_OUT);
        const bf16* GluT = (const bf16*)(ws + WS_WSMALL + l * WSMALL_LAYER + WOFF_GLU);
        const float* modl = (const float*)(ws + WS_MOD) + (size_t)l * BATCH * 6 * D;
        if (l == 0 && IN(pb + 0)) { p_wconv(F, args, 0, 4); p_wconv(F, args, 1, 4); p_ln_a0(F, args); SEAM(pb + 0); }
        if (IN(pb + 1)) for (int rep_ = 0; rep_ < NREP(1); ++rep_) {
            pg8::Gemm g{(const bf16*)(ws + WS_XN), WinT, M, PROJW, D / 2}; pg8::StaticOrder S; S.init(M, PROJW, F.G, (int)blockIdx.x);
            EpiInProj E{(bf16*)(ws + WS_PROJ), (const float*)(ws + WS_ROPE), args.pad, (const float*)(ws + WS_SA), (const float*)(ws + WS_CINV_IN) + l * PROJW};
            pg8::gemm_phase<EpiInProj, pg8::StaticOrder, PG8_ALIGN, PG8_SP2, true>(F.lds + RING_OFF, g, S, E);
            if (F.G == 256 && blockIdx.x >= 128) { __syncthreads(); p_wconv_gu(F, args, l, 256 + (int)blockIdx.x - 128, 128, WC_NGU); }
            SEAM(pb + 1); }
        if (IN(pb + 2)) for (int rep_ = 0; rep_ < NREP(2); ++rep_) {
#ifndef REP_SUB
#define REP_SUB -1
#endif
#define SUBREP(k) for (int rs_ = 0; rs_ < ((REP_SUB == (k)) ? 2 : 1); ++rs_)
            SUBREP(0) { mix_gating_mfma(F, args, l); __syncthreads(); }
#if REP_SUB >= 10 && REP_SUB < 20
            mix_gating_mfma(F, args, l, REP_SUB - 10); __syncthreads(); mix_gating_mfma(F, args, l); __syncthreads();
#endif
 SUBREP(1) { mix_ssm_in(F, l); } SUBREP(2) { mix_attn_mfma<0>(F, l); __syncthreads(); } SEAM(pb + 2); }
        if (IN(pb + 3)) for (int rep_ = 0; rep_ < NREP(3); ++rep_) { SUBREP(3) { mix_ssm_out(F, args, l); __syncthreads(); } SUBREP(4) { mix_attn_mfma<1>(F, l); __syncthreads(); } SEAM(pb + 3); }
        if (IN(pb + 4)) for (int rep_ = 0; rep_ < NREP(4); ++rep_) { p_glu(F, args, l); SEAM(pb + 4); }
        if (IN(pb + 5)) for (int rep_ = 0; rep_ < NREP(5); ++rep_) {
            pg8::Gemm g{(const bf16*)(ws + WS_MIXCAT), WoutT, M, D, D / 2}; pg8::StaticOrder S; S.init(M, D, F.G, (int)blockIdx.x);
            const float* cio = (const float*)(ws + WS_GVC) + (size_t)l * BATCH * D; const unsigned char* scm = (const unsigned char*)(ws + WS_SCM);
            if (l == 0) { EpiOut<true> E{(bf16*)(ws + WS_PRE), args.in[I_X], D, modl, cio}; pg8::gemm_phase<EpiOut<true>, pg8::StaticOrder, PG8_ALIGN, PG8_SP2, true, true>(F.lds + RING_OFF, g, S, E, scm, F.lds + SCT_OFF); }
            else { EpiOut<false> E{(bf16*)(ws + WS_PRE), (const void*)(ws + WS_ROWS2), 2 * D, modl, cio}; pg8::gemm_phase<EpiOut<false>, pg8::StaticOrder, PG8_ALIGN, PG8_SP2, true, true>(F.lds + RING_OFF, g, S, E, scm, F.lds + SCT_OFF); }
            SEAM(pb + 5); }
        if (IN(pb + 6)) { p_row_b(F, args, l); SUBREP(5) { if (REP_SUB == 5 && rs_ == 0) { __syncthreads(); p_row_b(F, args, l, false); } } SEAM(pb + 6); }
        if (IN(pb + 7)) { moe_tstart(F, l);
            gu32* dcnt = F.ctl + CW_DONE + l * 512;
            if (args.pad != 4)
            { pg8::Gemm g{(const bf16*)(ws + WS_XN), (const bf16*)(ws + WS_WGU), NSLOT_MAX, NEXP * 1024, D / 2};
              MoeOrderK<0> S{(const volatile LAS int*)(F.lds + LDSCTL_OFF), F.G, (int)blockIdx.x, (const int*)(ws + WS_SLOT_A), (const float*)(ws + WS_SLOT_W), dcnt, F.ctl + CW_QUEUE + l * 128, (volatile LAS int*)(F.lds + LDSCTL_OFF + 256), nullptr}; EpiG1 E{(unsigned char*)(ws + WS_HID), args.pad, (const float*)(ws + WS_CINV) + (size_t)l * 16 * 2 * 512, (unsigned char*)(ws + WS_HSC)};
              pg8::gemm_phase_g<EpiG1, MoeOrderK<0>, PG8_ALIGN, PG8_SP2, 0, true>(F.lds + RING_OFF, F.lds + GT_OFF, g, S, E); }
            if (args.pad != 3)
            { pg8::Gemm g{(const bf16*)(ws + WS_HID), (const bf16*)(ws + WS_WD), NSLOT_MAX, NEXP * 1024, DEXP / 2};
              MoeOrderK<1> S{(const volatile LAS int*)(F.lds + LDSCTL_OFF), F.G, (int)blockIdx.x, (const int*)(ws + WS_SLOT_A), (const float*)(ws + WS_SLOT_W), dcnt, F.ctl + CW_QUEUE + l * 128, (volatile LAS int*)(F.lds + LDSCTL_OFF + 256), (const unsigned char*)(ws + WS_HSC)}; EpiG2 E{(unsigned char*)(ws + WS_ROWS2), args.pad, (const float*)(ws + WS_CINV_D) + (size_t)l * NEXP * D, (unsigned char*)(ws + WS_SCR)};
              pg8::gemm_phase_g<EpiG2, MoeOrderK<1>, PG8_ALIGN, PG8_SP2, 0, true, true>(F.lds + RING_OFF, F.lds + GT_OFF, g, S, E); }
            SEAM(pb + 7); }
        if (IN(pb + 8)) { p_row_c(F, args, l); if (l == 0) { __syncthreads(); p_wconv_dn(F, args, 1, F.vcu, F.G); p_wconv_gu(F, args, 1, F.vcu, F.G, F.G == 256 ? 256 : WC_NGU); } SUBREP(6) { if (REP_SUB == 6 && rs_ == 0 && l == DEPTH - 1) { __syncthreads(); p_row_c(F, args, l); } } SEAM(pb + 8); }
    }
__global__ void __launch_bounds__(NTHR, 2) mk_fwd(Args args) {
    extern __shared__ __attribute__((aligned(16))) unsigned char lds[];
    Frame F;
    F.lds = (LAS unsigned char*)lds; F.MISC = (volatile LAS unsigned*)(F.lds + MISC_OFF);
    F.G = gridDim.x; { const int bx = blockIdx.x; F.vcu = (F.G % 8 == 0) ? (bx % 8) * (F.G / 8) + bx / 8 : bx; }
    F.ws = args.ws; F.ctl = (gu32*)(args.ws + WS_CTL);
    for (int u = ftid(); u < (LDS_BYTES - LDSCTL_OFF) / 4; u += NTHR) ((LAS unsigned*)(F.lds + LDSCTL_OFF))[u] = 0u;
    __syncthreads();
    XcdBarrier bar; bar.bar = (unsigned*)(F.ctl + CW_BAR); bar.x = 0; bar.st = nullptr;
    if (MK_ONE_LAUNCH) bar = xcd_barrier_post((unsigned*)(F.ctl + CW_BAR), F.MISC + 8);
    const int lo = args.ph_lo, hi = args.ph_hi;
    unsigned char* ws = args.ws; (void)ws;
    if (IN(0)) { p0_tables(F, args); __syncthreads(); p_wconv_items(F, args, 0, 0, WC_NS); p_wconv_items(F, args, 1, 0, WC_NS); __syncthreads(); p_wconv_gu(F, args, 0, F.vcu, F.G, F.G == 256 ? 256 : WC_NGU); p_wconv_dn(F, args, 0, F.vcu, F.G);
        p_wconv_in(F, args, 0, (F.vcu + F.G - 112) % F.G, F.G); p_wconv_in(F, args, 1, (F.vcu + F.G - 184) % F.G, F.G);
        p_wconv_out(F, args, 0, F.vcu, F.G); p_wconv_out(F, args, 1, (F.vcu + F.G - 32) % F.G, F.G); SEAM(0); }
    layer_body<0>(F, args, bar, lo, hi);
    layer_body<1>(F, args, bar, lo, hi);
#ifdef EXTRA_BARS
    if (MK_ONE_LAUNCH) for (int xb_ = 0; xb_ < EXTRA_BARS; ++xb_) xcd_barrier(bar);
#endif
#undef IN
#undef SEAM
}

extern "C" void kernel_launch(void* const* d_in, const int* in_sizes, int n_in, void* d_out, int out_size, void* d_ws, size_t ws_size, hipStream_t stream) {
    static int grid = 0;
    if (grid == 0) {
        if (n_in != 30 || in_sizes[0] != M * D || out_size != M * D || ws_size < WS_END) { fprintf(stderr, "kernel_launch: unexpected shapes (n_in %d, in0 %d, out %d, ws %zu, need %zu)\n", n_in, n_in > 0 ? in_sizes[0] : -1, out_size, ws_size, (size_t)WS_END); grid = -1; return; }
        int dev = 0, cus = 0, per_cu = 0;
        if (hipGetDevice(&dev) != hipSuccess || hipDeviceGetAttribute(&cus, hipDeviceAttributeMultiprocessorCount, dev) != hipSuccess) { grid = -1; return; }
        if (hipFuncSetAttribute((const void*)mk_fwd, hipFuncAttributeMaxDynamicSharedMemorySize, LDS_BYTES) != hipSuccess) { fprintf(stderr, "kernel_launch: hipFuncSetAttribute failed\n"); grid = -1; return; }
        if (hipOccupancyMaxActiveBlocksPerMultiprocessor(&per_cu, (const void*)mk_fwd, NTHR, LDS_BYTES) != hipSuccess || per_cu < 1) fprintf(stderr, "kernel_launch: occupancy query says %d\n", per_cu);
        (void)hipGetLastError();
        grid = cus;
    }
    if (grid < 0) return;
    if (hipMemsetAsync((char*)d_ws + WS_CTL, 0, CTL_ZERO_BYTES, stream) != hipSuccess) return;
    Args a{};
    for (int i = 0; i < 30; ++i) a.in[i] = d_in[i];
    a.out = (float*)d_out; a.ws = (unsigned char*)d_ws;
#if MK_ONE_LAUNCH
    a.ph_lo = 0; a.ph_hi = N_PHASES; a.li = 0;
    hipLaunchKernelGGL(mk_fwd, dim3(grid), dim3(NTHR), LDS_BYTES, stream, a);
#else
#ifndef REP_GLOBAL
#define REP_GLOBAL -1
#endif
#ifndef PROBE_SKIP
#define PROBE_SKIP 1
#endif
#ifndef REP_COUNT
#define REP_COUNT 2
#endif
    for (int p = 0; p < N_PHASES; ++p) { a.ph_lo = p; a.ph_hi = p + 1; a.li = p;
        const int nrep = ((p == 0 ? 100 : (p - 1) % PH_PER_LAYER) == REP_GLOBAL) ? REP_COUNT : 1;
        for (int r = 0; r < nrep; ++r) { a.pad = r ? PROBE_SKIP : 0; hipLaunchKernelGGL(mk_fwd, dim3(grid), dim3(NTHR), LDS_BYTES, stream, a); } a.pad = 0; }
#endif
}
```
